# Optimizing an MI355X kernel written in HIP

```python
import math
import jax
import jax.numpy as jnp
from jax import lax
import numpy as np

D_MODEL = 1024
BATCH = 2
SEQ = 8192
DEPTH = 2

GRID_W = 64
CTX_LEN = 256
CHUNK = 128
Q_BLOCK = 128
N_DIR = 2

M_HEADS = 4
M_QK_DIM = D_MODEL // 8
M_V_DIM = D_MODEL // 4
M_WIDTH = M_HEADS * M_V_DIM

S_HEADS = 16
S_HEAD_DIM = D_MODEL // 16
S_GROUPS = 2
S_HEADS_PER_GROUP = S_HEADS // S_GROUPS
S_STATE = 128
S_WIDTH = S_HEADS * S_HEAD_DIM
S_CONV_CH = S_WIDTH + 2 * S_GROUPS * S_STATE
CONV_K = 4

AB_WIDTHS = (M_HEADS * M_QK_DIM, M_HEADS * M_QK_DIM, M_WIDTH, M_WIDTH, N_DIR * M_HEADS, N_DIR * M_HEADS, S_WIDTH, S_CONV_CH, N_DIR * S_HEADS)
AB_IN = sum(AB_WIDTHS)
AB_SPLITS = tuple(int(v) for v in np.cumsum(AB_WIDTHS)[:-1])
AB_MIX = M_WIDTH + S_WIDTH

A_HEADS = 8
A_KV_HEADS = 2
A_HEAD_DIM = D_MODEL // A_HEADS
A_Q_W = A_HEADS * A_HEAD_DIM
A_KV_W = A_KV_HEADS * A_HEAD_DIM
AT_IN = A_Q_W + 2 * A_KV_W
ROPE_THETA = 10000.0

N_EXPERTS = 16
N_EXPERT_GROUPS = 4
EXPERTS_PER_GROUP = N_EXPERTS // N_EXPERT_GROUPS
TOP_K = 2
D_FF = D_MODEL
MOE_BLOCK = 256

DEEPNORM_ALPHA = (2 * DEPTH) ** 0.25
DEEPNORM_BETA = (8 * DEPTH) ** -0.25
N_EVEN = (DEPTH + 1) // 2
N_ODD = DEPTH // 2
LN_EPS = 1e-5
RMS_EPS = 1e-6
F32 = jnp.float32

kernel_name = 'hybrid_mlstm_ssd_gqa_moe_diffusion_block'


def layer_norm(x, g, b):
    xf = x.astype(F32)
    mu = xf.mean(-1, keepdims=True)
    var = jnp.mean(jnp.square(xf - mu), -1, keepdims=True)
    return ((xf - mu) * lax.rsqrt(var + LN_EPS) * g + b).astype(x.dtype)


def rms_norm(x, g):
    xf = x.astype(F32)
    return (xf * lax.rsqrt(jnp.mean(xf * xf, -1, keepdims=True) + RMS_EPS) * g).astype(x.dtype)


def head_layer_norm(h, g):
    mu = h.mean(-1, keepdims=True)
    var = jnp.mean(jnp.square(h - mu), -1, keepdims=True)
    y = (h - mu) * lax.rsqrt(var + LN_EPS)
    return y.reshape(h.shape[0], h.shape[1], -1) * g


def ada_params(cvec, w, b):
    m = jax.nn.silu(cvec) @ w + b
    return jnp.split(m, 6, axis=-1)


def modulate(h, shift, scale):
    return h * (1 + scale) + shift


def axial_rope_tables(n_tokens):
    rows = n_tokens // GRID_W
    row = jnp.repeat(jnp.arange(rows), GRID_W).astype(F32)
    col = jnp.tile(jnp.arange(GRID_W), rows).astype(F32)
    n_freq = A_HEAD_DIM // 4
    inv = ROPE_THETA ** (-jnp.arange(n_freq, dtype=F32) / n_freq)
    ang = jnp.concatenate([row[:, None] * inv, col[:, None] * inv], -1)
    return jnp.cos(ang), jnp.sin(ang)


def apply_rope(x, cos, sin):
    half = x.shape[-1] // 2
    x1, x2 = x[..., :half].astype(F32), x[..., half:].astype(F32)
    c = cos[None, :, None, :]
    s = sin[None, :, None, :]
    return jnp.concatenate([x1 * c - x2 * s, x2 * c + x1 * s], -1).astype(x.dtype)


def dwconv_centred(x, w, b):
    k = w.shape[0]
    y = lax.conv_general_dilated(x, w[:, None, :].astype(x.dtype), window_strides=(1,),
                                 padding=[(k // 2, k - 1 - k // 2)],
                                 dimension_numbers=('NWC', 'WIO', 'NWC'),
                                 feature_group_count=x.shape[-1])
    return y + b


def mlstm_chunkwise(q, k, v, ig, lf, state):
    bsz, t_len, nh, dk = q.shape
    dv = v.shape[-1]
    nc, L = t_len // CHUNK, CHUNK
    q = q.astype(F32).reshape(bsz, nc, L, nh, dk)
    k = k.astype(F32).reshape(bsz, nc, L, nh, dk)
    v = v.astype(F32).reshape(bsz, nc, L, nh, dv)
    ig = ig.reshape(bsz, nc, L, nh)
    lf = lf.reshape(bsz, nc, L, nh)
    b = jnp.cumsum(lf, axis=2)
    b_end = b[:, :, -1]
    g = b_end[:, :, None] - b + ig
    g_max = g.max(axis=2)
    w = jnp.exp(g - g_max[:, :, None])
    d_c = jnp.einsum('bcshv,bcshd->bchvd', v * w[..., None], k)
    d_n = jnp.einsum('bcsh,bcshd->bchd', w, k)

    def step(carry, inp):
        c_st, n_st, m_st = carry
        dc, dn, be, gm = inp
        m_new = jnp.maximum(be + m_st, gm)
        a = jnp.exp(be + m_st - m_new)
        s = jnp.exp(gm - m_new)
        c_new = a[..., None, None] * c_st + s[..., None, None] * dc
        n_new = a[..., None] * n_st + s[..., None] * dn
        return (c_new, n_new, m_new), (c_st, n_st, m_st)

    final, (cs, ns, ms) = lax.scan(step, state, (jnp.moveaxis(d_c, 1, 0), jnp.moveaxis(d_n, 1, 0),
                                                 jnp.moveaxis(b_end, 1, 0), jnp.moveaxis(g_max, 1, 0)))
    cs, ns, ms = jnp.moveaxis(cs, 0, 1), jnp.moveaxis(ns, 0, 1), jnp.moveaxis(ms, 0, 1)
    lower = jnp.tril(jnp.ones((L, L), bool))
    dmat = jnp.where(lower[:, :, None], b[:, :, :, None, :] - b[:, :, None, :, :] + ig[:, :, None, :, :], -jnp.inf)
    inter = b + ms[:, :, None, :]
    m_t = jnp.maximum(inter, dmat.max(axis=3))
    sc = jnp.einsum('bcthd,bcshd->bctsh', q, k) * jnp.exp(dmat - m_t[:, :, :, None, :])
    a_in = jnp.exp(inter - m_t)
    num = jnp.einsum('bctsh,bcshv->bcthv', sc, v) + a_in[..., None] * jnp.einsum('bcthd,bchvd->bcthv', q, cs)
    den = sc.sum(axis=3) + a_in * jnp.einsum('bcthd,bchd->bcth', q, ns)
    h = num / jnp.maximum(jnp.abs(den), jnp.exp(-m_t))[..., None]
    return h.reshape(bsz, t_len, nh, dv), final


def ssd_chunked(xs, a, bm, cm, h0):
    bsz, t_len, ng, nj, p = xs.shape
    n = bm.shape[-1]
    nc, L = t_len // CHUNK, CHUNK
    xs = xs.astype(F32).reshape(bsz, nc, L, ng, nj, p)
    a = a.astype(F32).reshape(bsz, nc, L, ng, nj)
    bm = bm.astype(F32).reshape(bsz, nc, L, ng, n)
    cm = cm.astype(F32).reshape(bsz, nc, L, ng, n)
    a_cs = jnp.cumsum(a, axis=2)
    lower = jnp.tril(jnp.ones((L, L), bool))
    seg = a_cs[:, :, :, None] - a_cs[:, :, None]
    decay = jnp.exp(jnp.where(lower[:, :, None, None], seg, -jnp.inf))
    cb = jnp.einsum('bctgn,bcsgn->bctsg', cm, bm)
    y = jnp.einsum('bctsgj,bcsgjp->bctgjp', cb[..., None] * decay, xs)
    a_end = a_cs[:, :, -1]
    xw = xs * jnp.exp(a_end[:, :, None] - a_cs)[..., None]
    d_states = jnp.einsum('bcsgn,bcsgjp->bcgjpn', bm, xw)

    def step(h, inp):
        ds, ae = inp
        return jnp.exp(ae)[..., None, None] * h + ds, h

    h_final, hs = lax.scan(step, h0, (jnp.moveaxis(d_states, 1, 0), jnp.moveaxis(a_end, 1, 0)))
    hs = jnp.moveaxis(hs, 0, 1)
    y = y + jnp.einsum('bctgn,bcgjpn->bctgjp', cm, hs) * jnp.exp(a_cs)[..., None]
    return y.reshape(bsz, t_len, ng, nj, p), h_final


def _flip_time(t):
    return jnp.flip(t, axis=1)


def _identity(t):
    return t


def bidirectional_prefix_scan(run, ctx_dirs, lat_dirs, zero_state):
    outs_c, outs_l = [], []
    for d in range(N_DIR):
        f = _flip_time if d == 1 else _identity
        yc, st = run(*[f(t) for t in ctx_dirs[d]], zero_state)
        yl, _ = run(*[f(t) for t in lat_dirs[d]], st)
        outs_c.append(f(yc))
        outs_l.append(f(yl))
    return outs_c[0] + outs_c[1], outs_l[0] + outs_l[1]


def mixer_mlstm_ssd(hl, hc, w_in, w_out, ig_b, fg_b, m_norm_g, conv_w, conv_b, dt_b, a_log, d_skip, s_norm_g):
    a_neg = (-jnp.exp(a_log.astype(F32))).reshape(N_DIR, S_GROUPS, S_HEADS_PER_GROUP)

    def prepare(h):
        bsz, t_len, _ = h.shape
        q, k, v, o, ig, fg, z, xbc, dt = jnp.split(h @ w_in, AB_SPLITS, axis=-1)
        q = q.reshape(bsz, t_len, M_HEADS, M_QK_DIM) * (M_QK_DIM ** -0.5)
        k = k.reshape(bsz, t_len, M_HEADS, M_QK_DIM)
        v = v.reshape(bsz, t_len, M_HEADS, M_V_DIM)
        ig = ig.reshape(bsz, t_len, N_DIR, M_HEADS).astype(F32) + ig_b
        lf = jax.nn.log_sigmoid(fg.reshape(bsz, t_len, N_DIR, M_HEADS).astype(F32) + fg_b)
        xbc = jax.nn.silu(dwconv_centred(xbc, conv_w, conv_b))
        xs, bm, cm = jnp.split(xbc, [S_WIDTH, S_WIDTH + S_GROUPS * S_STATE], axis=-1)
        xs = xs.reshape(bsz, t_len, S_GROUPS, S_HEADS_PER_GROUP, S_HEAD_DIM).astype(F32)
        bm = bm.reshape(bsz, t_len, S_GROUPS, S_STATE)
        cm = cm.reshape(bsz, t_len, S_GROUPS, S_STATE)
        dt = jax.nn.softplus(dt.reshape(bsz, t_len, N_DIR, S_HEADS).astype(F32) + dt_b)
        dt = dt.reshape(bsz, t_len, N_DIR, S_GROUPS, S_HEADS_PER_GROUP)
        m_dirs = [(q, k, v, ig[:, :, d], lf[:, :, d]) for d in range(N_DIR)]
        s_dirs = [(xs * dt[:, :, d][..., None], dt[:, :, d] * a_neg[d], bm, cm) for d in range(N_DIR)]
        return m_dirs, s_dirs, o, z, xs

    mc, sc, oc, zc, xsc = prepare(hc)
    ml, sl, ol, zl, xsl = prepare(hl)
    bsz = hl.shape[0]
    m_zero = (jnp.zeros((bsz, M_HEADS, M_V_DIM, M_QK_DIM), F32), jnp.zeros((bsz, M_HEADS, M_QK_DIM), F32),
              jnp.zeros((bsz, M_HEADS), F32))
    s_zero = jnp.zeros((bsz, S_GROUPS, S_HEADS_PER_GROUP, S_HEAD_DIM, S_STATE), F32)
    hm_c, hm_l = bidirectional_prefix_scan(mlstm_chunkwise, mc, ml, m_zero)
    hs_c, hs_l = bidirectional_prefix_scan(ssd_chunked, sc, sl, s_zero)

    def finish(hm, hs, o, z, xs):
        bsz_, t_len = o.shape[:2]
        ym = head_layer_norm(hm, m_norm_g) * jax.nn.sigmoid(o.astype(F32))
        ys = (hs + d_skip.astype(F32).reshape(S_GROUPS, S_HEADS_PER_GROUP, 1) * xs).reshape(bsz_, t_len, S_WIDTH)
        ys = rms_norm(ys * jax.nn.silu(z.astype(F32)), s_norm_g)
        return jnp.concatenate([ym, ys], -1).astype(o.dtype) @ w_out

    return finish(hm_l, hs_l, ol, zl, xsl), finish(hm_c, hs_c, oc, zc, xsc)


def blocked_attention(q, k, v):
    bsz, t_len, _, dh = q.shape
    nb = t_len // Q_BLOCK
    qb = jnp.moveaxis(q.reshape(bsz, nb, Q_BLOCK, A_KV_HEADS, A_HEADS // A_KV_HEADS, dh), 1, 0)
    scale = dh ** -0.5

    def one(qblk):
        s = jnp.einsum('bqkgd,bskd->bkgqs', qblk, k).astype(F32) * scale
        p = jax.nn.softmax(s, axis=-1).astype(v.dtype)
        return jnp.einsum('bkgqs,bskd->bqkgd', p, v)

    o = lax.map(one, qb)
    return jnp.moveaxis(o, 0, 1).reshape(bsz, t_len, A_Q_W)


def mixer_gqa(hl, hc, w_in, w_out, q_g, k_g, cos, sin, need_ctx):
    def q_proj(h):
        bsz, t_len, _ = h.shape
        return rms_norm((h @ w_in[:, :A_Q_W]).reshape(bsz, t_len, A_HEADS, A_HEAD_DIM), q_g)

    def kv_proj(h):
        bsz, t_len, _ = h.shape
        k, v = jnp.split(h @ w_in[:, A_Q_W:], [A_KV_W], axis=-1)
        k = rms_norm(k.reshape(bsz, t_len, A_KV_HEADS, A_HEAD_DIM), k_g)
        return k, v.reshape(bsz, t_len, A_KV_HEADS, A_HEAD_DIM)

    kl, vl = kv_proj(hl)
    kl = apply_rope(kl, cos, sin)
    ql = apply_rope(q_proj(hl), cos, sin)
    kc, vc = kv_proj(hc)
    k_all = jnp.concatenate([kc, kl], axis=1)
    v_all = jnp.concatenate([vc, vl], axis=1)
    yl = blocked_attention(ql, k_all, v_all) @ w_out
    yc = blocked_attention(q_proj(hc), kc, vc) @ w_out if need_ctx else None
    return yl, yc


def moe_ffn(h, router_w, router_b, w_gate, w_up, w_down):
    n_tok, d = h.shape
    probs = jax.nn.softmax((h @ router_w).astype(F32), axis=-1)
    sel = (probs + router_b).reshape(n_tok, N_EXPERT_GROUPS, EXPERTS_PER_GROUP)
    g_score = lax.top_k(sel, TOP_K)[0].sum(-1)
    g_idx = jnp.argmax(g_score, axis=-1)
    in_group = jnp.take_along_axis(sel, g_idx[:, None, None], axis=1)[:, 0]
    _, local = lax.top_k(in_group, TOP_K)
    e_idx = g_idx[:, None] * EXPERTS_PER_GROUP + local
    gate = jnp.take_along_axis(probs, e_idx, axis=1)
    gate = gate / gate.sum(-1, keepdims=True)
    n_asg = n_tok * TOP_K
    flat_e = e_idx.reshape(-1)
    flat_tok = jnp.repeat(jnp.arange(n_tok), TOP_K)
    order = jnp.argsort(flat_e)
    se, stok, sgate = flat_e[order], flat_tok[order], gate.reshape(-1)[order]
    counts = jnp.bincount(flat_e, length=N_EXPERTS)
    padded = (counts + MOE_BLOCK - 1) // MOE_BLOCK * MOE_BLOCK
    start = jnp.cumsum(counts) - counts
    pend = jnp.cumsum(padded)
    pstart = pend - padded
    dest = pstart[se] + jnp.arange(n_asg) - start[se]
    n_blocks = -(-n_asg // MOE_BLOCK) + N_EXPERTS
    slot_tok = jnp.zeros((n_blocks * MOE_BLOCK,), jnp.int32).at[dest].set(stok)
    blk_exp = jnp.minimum(jnp.searchsorted(pend, jnp.arange(n_blocks) * MOE_BLOCK, side='right'), N_EXPERTS - 1)

    def expert_block(args):
        toks, e = args
        xb = h[toks]
        return (jax.nn.silu(xb @ w_gate[e]) * (xb @ w_up[e])) @ w_down[e]

    y_slots = lax.map(expert_block, (slot_tok.reshape(n_blocks, MOE_BLOCK), blk_exp)).reshape(-1, d)
    contrib = y_slots[dest] * sgate[:, None].astype(h.dtype)
    return jnp.zeros_like(h).at[stok].add(contrib)


def setup_inputs(seed: int = 0) -> dict:
    key = jax.random.key(seed)
    keys = iter(jax.random.split(key, 40))
    D = D_MODEL

    def nrm(shape, scale):
        return jax.random.normal(next(keys), shape, F32) * scale

    def uni(shape, lo, hi):
        return jax.random.uniform(next(keys), shape, F32, lo, hi)

    dt0 = jnp.exp(uni((N_EVEN, N_DIR, S_HEADS), math.log(1e-3), math.log(1e-1)))
    return {
        'x': nrm((BATCH, SEQ, D), 1.0),
        'c': nrm((BATCH, D), 1.0),
        'ctx': nrm((BATCH, CTX_LEN, D), 1.0),
        'c_ctx': nrm((D,), 1.0),
        'ada_w': nrm((DEPTH, D, 6 * D), 0.5 * D ** -0.5),
        'ada_b': nrm((DEPTH, 6 * D), 0.02),
        'ln_g': 1.0 + nrm((DEPTH, 2, D), 0.02),
        'ln_b': nrm((DEPTH, 2, D), 0.02),
        'ab_w_in': nrm((N_EVEN, D, AB_IN), D ** -0.5),
        'ab_w_out': nrm((N_EVEN, AB_MIX, D), AB_MIX ** -0.5 * DEEPNORM_BETA),
        'ml_ig_b': nrm((N_EVEN, N_DIR, M_HEADS), 0.1),
        'ml_fg_b': uni((N_EVEN, N_DIR, M_HEADS), 3.0, 6.0),
        'ml_norm_g': 1.0 + nrm((N_EVEN, M_WIDTH), 0.02),
        'ssm_conv_w': nrm((N_EVEN, CONV_K, S_CONV_CH), CONV_K ** -0.5),
        'ssm_conv_b': nrm((N_EVEN, S_CONV_CH), 0.02),
        'ssm_dt_b': dt0 + jnp.log(-jnp.expm1(-dt0)),
        'ssm_a_log': jnp.log(uni((N_EVEN, N_DIR, S_HEADS), 1.0, 16.0)),
        'ssm_d': 1.0 + nrm((N_EVEN, S_HEADS), 0.1),
        'ssm_norm_g': 1.0 + nrm((N_EVEN, S_WIDTH), 0.02),
        'at_w_in': nrm((N_ODD, D, AT_IN), D ** -0.5),
        'at_w_out': nrm((N_ODD, A_Q_W, D), A_Q_W ** -0.5 * DEEPNORM_BETA),
        'at_q_g': 1.0 + nrm((N_ODD, A_HEAD_DIM), 0.02),
        'at_k_g': 1.0 + nrm((N_ODD, A_HEAD_DIM), 0.02),
        'router_w': nrm((D, N_EXPERTS), D ** -0.5),
        'router_b': nrm((N_EXPERTS,), 0.01),
        'moe_w_gate': nrm((DEPTH, N_EXPERTS, D, D_FF), D ** -0.5),
        'moe_w_up': nrm((DEPTH, N_EXPERTS, D, D_FF), D ** -0.5),
        'moe_w_down': nrm((DEPTH, N_EXPERTS, D_FF, D), D_FF ** -0.5 * DEEPNORM_BETA),
    }


def reference(x, c, ctx, c_ctx, ada_w, ada_b, ln_g, ln_b, ab_w_in, ab_w_out, ml_ig_b, ml_fg_b, ml_norm_g,
              ssm_conv_w, ssm_conv_b, ssm_dt_b, ssm_a_log, ssm_d, ssm_norm_g, at_w_in, at_w_out, at_q_g, at_k_g,
              router_w, router_b, moe_w_gate, moe_w_up, moe_w_down):
    bsz, n_lat, d = x.shape
    cos, sin = axial_rope_tables(n_lat)
    xl, xc = x, ctx
    for i in range(DEPTH):
        last = i == DEPTH - 1
        j = i // 2
        sh1l, sc1l, gt1l, sh2l, sc2l, gt2l = ada_params(c[:, None, :], ada_w[i], ada_b[i])
        sh1c, sc1c, gt1c, sh2c, sc2c, gt2c = ada_params(c_ctx, ada_w[i], ada_b[i])
        hl = modulate(xl, sh1l, sc1l)
        hc = modulate(xc, sh1c, sc1c)
        if i % 2 == 0:
            yl, yc = mixer_mlstm_ssd(hl, hc, ab_w_in[j], ab_w_out[j], ml_ig_b[j], ml_fg_b[j], ml_norm_g[j],
                                     ssm_conv_w[j], ssm_conv_b[j], ssm_dt_b[j], ssm_a_log[j], ssm_d[j], ssm_norm_g[j])
        else:
            yl, yc = mixer_gqa(hl, hc, at_w_in[j], at_w_out[j], at_q_g[j], at_k_g[j], cos, sin, not last)
        xl = layer_norm(DEEPNORM_ALPHA * xl + gt1l * yl, ln_g[i, 0], ln_b[i, 0])
        hl = modulate(xl, sh2l, sc2l)
        if last:
            yl = moe_ffn(hl.reshape(-1, d), router_w, router_b, moe_w_gate[i], moe_w_up[i], moe_w_down[i]).reshape(xl.shape)
        else:
            xc = layer_norm(DEEPNORM_ALPHA * xc + gt1c * yc, ln_g[i, 0], ln_b[i, 0])
            hc = modulate(xc, sh2c, sc2c)
            y_tok = moe_ffn(jnp.concatenate([hl.reshape(-1, d), hc.reshape(-1, d)], axis=0),
                            router_w, router_b, moe_w_gate[i], moe_w_up[i], moe_w_down[i])
            yl = y_tok[:bsz * n_lat].reshape(xl.shape)
            yc = y_tok[bsz * n_lat:].reshape(xc.shape)
            xc = layer_norm(DEEPNORM_ALPHA * xc + gt2c * yc, ln_g[i, 1], ln_b[i, 1])
        xl = layer_norm(DEEPNORM_ALPHA * xl + gt2l * yl, ln_g[i, 1], ln_b[i, 1])
    return xl
```

```cpp
#include <hip/hip_runtime.h>
#include <cstdint>
#include <cstdio>

namespace {
constexpr int D = 1024, NBATCH = 2, SEQ = 8192, CTXL = 256;
constexpr int NLAT = NBATCH * SEQ;
constexpr int NCTX = NBATCH * CTXL;
constexpr int NTOK = NLAT + NCTX;
constexpr int SLEN = CTXL + SEQ;
constexpr int ABIN = 5680;
constexpr int P1W = 3088;
constexpr int P2W = 2592;
constexpr int NEXP = 16;
constexpr float ALPHA = 1.4142135623730951f;

__device__ __forceinline__ float siluf(float x) { return x / (1.f + expf(-x)); }
__device__ __forceinline__ float sigmf(float x) { return 1.f / (1.f + expf(-x)); }
__device__ __forceinline__ float softplusf(float x) { return x > 20.f ? x : log1pf(expf(x)); }

__device__ __forceinline__ float block_sum256(float v, float* red) {
    for (int o = 32; o > 0; o >>= 1) v += __shfl_xor(v, o);
    __syncthreads();
    if ((threadIdx.x & 63) == 0) red[threadIdx.x >> 6] = v;
    __syncthreads();
    float r = 0.f;
    for (int i = 0; i < (int)(blockDim.x >> 6); ++i) r += red[i];
    return r;
}

__global__ void ada_kernel(const float* c, const float* cctx, const float* ada_w, const float* ada_b, float* modv) {
    int idx = blockIdx.x * 256 + threadIdx.x;
    int l = idx / 6144, n = idx % 6144;
    float a0 = 0.f, a1 = 0.f, a2 = 0.f;
    for (int k = 0; k < 1024; ++k) {
        float w = ada_w[((size_t)l * 1024 + k) * 6144 + n];
        a0 += siluf(c[k]) * w; a1 += siluf(c[1024 + k]) * w; a2 += siluf(cctx[k]) * w;
    }
    float b = ada_b[l * 6144 + n];
    modv[(l * 3 + 0) * 6144 + n] = a0 + b;
    modv[(l * 3 + 1) * 6144 + n] = a1 + b;
    modv[(l * 3 + 2) * 6144 + n] = a2 + b;
}

__device__ __forceinline__ int mod_index(int row) { return row < NLAT ? row / SEQ : 2; }

__global__ void modulate_kernel(const float* XL, const float* modl, int sh_off, int sc_off, float* H) {
    int row = blockIdx.x; const float* m = modl + mod_index(row) * 6144;
    for (int d = threadIdx.x; d < D; d += 256) H[(size_t)row * D + d] = XL[(size_t)row * D + d] * (1.f + m[sc_off + d]) + m[sh_off + d];
}

struct GemmP {
    const float* A; const float* B; float* C; const int* rowidx; const int* cnt; const int* offs;
    int lda, ldb, ldc, M, N, K; int bt, accum, moe, gather; long sA, sB, sC; int cap;
};
__global__ void __launch_bounds__(256) gemm_kernel(GemmP p) {
    __shared__ float As[16][128 + 4];
    __shared__ float Bs[16][128 + 4];
    const int z = blockIdx.z;
    const float* A = p.A; const float* B = p.B; float* C = p.C; const int* ridx = p.rowidx; int M = p.M;
    if (p.moe) {
        M = p.cnt[z]; const int off = p.offs[z];
        B += (size_t)z * p.sB; C += (size_t)off * p.ldc;
        if (p.gather) ridx = p.rowidx + (size_t)z * p.cap; else A += (size_t)off * p.lda;
    } else { A += (size_t)z * p.sA; B += (size_t)z * p.sB; C += (size_t)z * p.sC; }
    const int m0 = blockIdx.y * 128, n0 = blockIdx.x * 128;
    if (m0 >= M) return;
    const int tid = threadIdx.x, tx = tid & 15, ty = tid >> 4;
    float acc[8][8];
#pragma unroll
    for (int i = 0; i < 8; ++i)
#pragma unroll
        for (int j = 0; j < 8; ++j) acc[i][j] = 0.f;
    const float* arow[2]; int ar[2], akq[2];
#pragma unroll
    for (int i = 0; i < 2; ++i) {
        int idx = tid + i * 256; ar[i] = idx >> 2; akq[i] = idx & 3;
        int gm = m0 + ar[i]; const float* rp = nullptr;
        if (gm < M) { int src = ridx ? ridx[gm] : gm; rp = A + (size_t)src * p.lda; }
        arow[i] = rp;
    }
    for (int k0 = 0; k0 < p.K; k0 += 16) {
#pragma unroll
        for (int i = 0; i < 2; ++i) {
            float4 v = make_float4(0.f, 0.f, 0.f, 0.f);
            if (arow[i]) v = *(const float4*)(arow[i] + k0 + akq[i] * 4);
            As[akq[i] * 4 + 0][ar[i]] = v.x; As[akq[i] * 4 + 1][ar[i]] = v.y; As[akq[i] * 4 + 2][ar[i]] = v.z; As[akq[i] * 4 + 3][ar[i]] = v.w;
        }
        if (!p.bt) {
#pragma unroll
            for (int i = 0; i < 2; ++i) {
                int idx = tid + i * 256; int kk = idx >> 5, nq = idx & 31; int gn = n0 + nq * 4;
                float4 v = make_float4(0.f, 0.f, 0.f, 0.f);
                if (gn < p.N) v = *(const float4*)(B + (size_t)(k0 + kk) * p.ldb + gn);
                *(float4*)&Bs[kk][nq * 4] = v;
            }
        } else {
#pragma unroll
            for (int i = 0; i < 2; ++i) {
                int idx = tid + i * 256; int n = idx >> 2, kq = idx & 3; int gn = n0 + n;
                float4 v = make_float4(0.f, 0.f, 0.f, 0.f);
                if (gn < p.N) v = *(const float4*)(B + (size_t)gn * p.ldb + k0 + kq * 4);
                Bs[kq * 4 + 0][n] = v.x; Bs[kq * 4 + 1][n] = v.y; Bs[kq * 4 + 2][n] = v.z; Bs[kq * 4 + 3][n] = v.w;
            }
        }
        __syncthreads();
#pragma unroll
        for (int kk = 0; kk < 16; ++kk) {
            float4 a0 = *(const float4*)&As[kk][ty * 4], a1 = *(const float4*)&As[kk][64 + ty * 4];
            float4 b0 = *(const float4*)&Bs[kk][tx * 4], b1 = *(const float4*)&Bs[kk][64 + tx * 4];
            float a[8] = {a0.x, a0.y, a0.z, a0.w, a1.x, a1.y, a1.z, a1.w};
            float b[8] = {b0.x, b0.y, b0.z, b0.w, b1.x, b1.y, b1.z, b1.w};
#pragma unroll
            for (int i = 0; i < 8; ++i)
#pragma unroll
                for (int j = 0; j < 8; ++j) acc[i][j] += a[i] * b[j];
        }
        __syncthreads();
    }
#pragma unroll
    for (int i = 0; i < 8; ++i) {
        int gm = m0 + (i < 4 ? ty * 4 + i : 64 + ty * 4 + (i - 4));
        if (gm >= M) continue;
#pragma unroll
        for (int jh = 0; jh < 2; ++jh) {
            int gn = n0 + jh * 64 + tx * 4;
            if (gn >= p.N) continue;
            float* cp = C + (size_t)gm * p.ldc + gn;
            float4 v = make_float4(acc[i][jh * 4 + 0], acc[i][jh * 4 + 1], acc[i][jh * 4 + 2], acc[i][jh * 4 + 3]);
            if (p.accum) { float4 o = *(float4*)cp; v.x += o.x; v.y += o.y; v.z += o.z; v.w += o.w; }
            *(float4*)cp = v;
        }
    }
}

__device__ __forceinline__ int seq_row(int b, int dir, int i) {
    if (i < CTXL) { int t = dir ? (CTXL - 1 - i) : i; return NLAT + b * CTXL + t; }
    int t = i - CTXL; if (dir) t = SEQ - 1 - t; return b * SEQ + t;
}

__global__ void __launch_bounds__(256) mlstm_rec_kernel(const float* P1, const float* ig_b, const float* fg_b, float* HM, int dir) {
    const int vs = blockIdx.x, h = blockIdx.y, b = blockIdx.z;
    const int tid = threadIdx.x, vi = tid >> 4, dj = tid & 15;
    float Cst[8], nst[8];
#pragma unroll
    for (int j = 0; j < 8; ++j) { Cst[j] = 0.f; nst[j] = 0.f; }
    const float igb = ig_b[dir * 4 + h], fgb = fg_b[dir * 4 + h];
    const float qs = 0.08838834764831845f;
#pragma unroll 2
    for (int i = 0; i < SLEN; ++i) {
        const int row = seq_row(b, dir, i);
        const float* p = P1 + (size_t)row * P1W;
        const float ig = p[3072 + dir * 4 + h] + igb;
        const float fg = p[3080 + dir * 4 + h] + fgb;
        const float f = sigmf(fg), ii = expf(ig);
        const float v = p[1024 + h * 256 + vs * 16 + vi];
        const float4 k0 = *(const float4*)(p + 512 + h * 128 + dj * 8), k1 = *(const float4*)(p + 512 + h * 128 + dj * 8 + 4);
        const float4 q0 = *(const float4*)(p + h * 128 + dj * 8), q1 = *(const float4*)(p + h * 128 + dj * 8 + 4);
        const float k[8] = {k0.x, k0.y, k0.z, k0.w, k1.x, k1.y, k1.z, k1.w};
        const float q[8] = {q0.x, q0.y, q0.z, q0.w, q1.x, q1.y, q1.z, q1.w};
        float num = 0.f, den = 0.f; const float iv = ii * v;
#pragma unroll
        for (int j = 0; j < 8; ++j) {
            Cst[j] = f * Cst[j] + iv * k[j]; nst[j] = f * nst[j] + ii * k[j];
            num += Cst[j] * q[j]; den += nst[j] * q[j];
        }
#pragma unroll
        for (int o = 1; o < 16; o <<= 1) { num += __shfl_xor(num, o); den += __shfl_xor(den, o); }
        num *= qs; den *= qs;
        if (dj == 0) {
            float hv = num / fmaxf(fabsf(den), 1.f);
            float* o = HM + (size_t)row * D + h * 256 + vs * 16 + vi;
            if (dir) *o += hv; else *o = hv;
        }
    }
}
__global__ void finish_m_kernel(float* HM, const float* P1, const float* g) {
    __shared__ float red[4];
    const int row = blockIdx.x, tid = threadIdx.x;
    for (int h = 0; h < 4; ++h) {
        float v = HM[(size_t)row * D + h * 256 + tid];
        float mu = block_sum256(v, red) * (1.f / 256.f);
        float dv = v - mu;
        float var = block_sum256(dv * dv, red) * (1.f / 256.f);
        float y = dv * rsqrtf(var + 1e-5f) * g[h * 256 + tid] * sigmf(P1[(size_t)row * P1W + 2048 + h * 256 + tid]);
        HM[(size_t)row * D + h * 256 + tid] = y;
    }
}

__global__ void conv_kernel(const float* P2, const float* cw, const float* cb, float* XC) {
    const int row = blockIdx.x;
    int t, base, len;
    if (row < NLAT) { t = row % SEQ; base = row - t; len = SEQ; } else { int r = row - NLAT; t = r % CTXL; base = row - t; len = CTXL; }
    for (int c = threadIdx.x; c < 1536; c += 256) {
        float a = cb[c];
#pragma unroll
        for (int j = 0; j < 4; ++j) { int tt = t - 2 + j; if (tt >= 0 && tt < len) a += cw[j * 1536 + c] * P2[(size_t)(base + tt) * P2W + 1024 + c]; }
        XC[(size_t)row * 1536 + c] = siluf(a);
    }
}
__global__ void __launch_bounds__(256) ssd_rec_kernel(const float* P2, const float* XC, const float* dt_b, const float* a_log, float* HS, int dir) {
    const int head = blockIdx.x, b = blockIdx.y, g = head >> 3;
    const int tid = threadIdx.x, pp = tid >> 2, nq = tid & 3;
    float hst[32];
#pragma unroll
    for (int j = 0; j < 32; ++j) hst[j] = 0.f;
    const float dtb = dt_b[dir * 16 + head], aneg = -expf(a_log[dir * 16 + head]);
    for (int i = 0; i < SLEN; ++i) {
        const int row = seq_row(b, dir, i);
        const float dtv = softplusf(P2[(size_t)row * P2W + 2560 + dir * 16 + head] + dtb);
        const float dA = expf(dtv * aneg);
        const float* xc = XC + (size_t)row * 1536;
        const float xv = xc[head * 64 + pp] * dtv;
        const float* bp = xc + 1024 + g * 128 + nq * 32; const float* cp = xc + 1280 + g * 128 + nq * 32;
        float y = 0.f;
#pragma unroll
        for (int j4 = 0; j4 < 8; ++j4) {
            const float4 bv = *(const float4*)(bp + j4 * 4), cv = *(const float4*)(cp + j4 * 4);
            hst[j4 * 4 + 0] = dA * hst[j4 * 4 + 0] + bv.x * xv; y += cv.x * hst[j4 * 4 + 0];
            hst[j4 * 4 + 1] = dA * hst[j4 * 4 + 1] + bv.y * xv; y += cv.y * hst[j4 * 4 + 1];
            hst[j4 * 4 + 2] = dA * hst[j4 * 4 + 2] + bv.z * xv; y += cv.z * hst[j4 * 4 + 2];
            hst[j4 * 4 + 3] = dA * hst[j4 * 4 + 3] + bv.w * xv; y += cv.w * hst[j4 * 4 + 3];
        }
        y += __shfl_xor(y, 1); y += __shfl_xor(y, 2);
        if (nq == 0) { float* o = HS + (size_t)row * D + head * 64 + pp; if (dir) *o += y; else *o = y; }
    }
}
__global__ void finish_s_kernel(float* HS, const float* P2, const float* XC, const float* dsk, const float* g) {
    __shared__ float red[4];
    const int row = blockIdx.x, tid = threadIdx.x;
    float v[4]; float ss = 0.f;
#pragma unroll
    for (int j = 0; j < 4; ++j) {
        int c = tid + 256 * j;
        float y = HS[(size_t)row * D + c] + dsk[c >> 6] * XC[(size_t)row * 1536 + c];
        y *= siluf(P2[(size_t)row * P2W + c]);
        v[j] = y; ss += y * y;
    }
    float ms = block_sum256(ss, red) * (1.f / 1024.f);
    float r = rsqrtf(ms + 1e-6f);
#pragma unroll
    for (int j = 0; j < 4; ++j) { int c = tid + 256 * j; HS[(size_t)row * D + c] = v[j] * r * g[c]; }
}

__global__ void resid_ln_kernel(const float* XL, const float* Y, const float* YS, const int* tok_e, const int* tok_pos, const float* tok_g, const int* offs,
                                const float* modl, int gt_off, const float* lg, const float* lb, float* OUT) {
    __shared__ float red[4];
    const int row = blockIdx.x, tid = threadIdx.x;
    const float* m = modl + mod_index(row) * 6144 + gt_off;
    const float* y0 = nullptr; const float* y1 = nullptr; float g0 = 0.f, g1 = 0.f;
    if (YS) {
        int e0 = tok_e[row * 2], e1 = tok_e[row * 2 + 1];
        y0 = YS + (size_t)(offs[e0] + tok_pos[row * 2]) * D; y1 = YS + (size_t)(offs[e1] + tok_pos[row * 2 + 1]) * D;
        g0 = tok_g[row * 2]; g1 = tok_g[row * 2 + 1];
    }
    float v[4]; float s = 0.f;
#pragma unroll
    for (int j = 0; j < 4; ++j) {
        int d = tid + 256 * j;
        float y = YS ? (g0 * y0[d] + g1 * y1[d]) : Y[(size_t)row * D + d];
        v[j] = ALPHA * XL[(size_t)row * D + d] + m[d] * y; s += v[j];
    }
    float mu = block_sum256(s, red) * (1.f / 1024.f);
    float q = 0.f;
#pragma unroll
    for (int j = 0; j < 4; ++j) { v[j] -= mu; q += v[j] * v[j]; }
    float var = block_sum256(q, red) * (1.f / 1024.f);
    float r = rsqrtf(var + 1e-5f);
#pragma unroll
    for (int j = 0; j < 4; ++j) { int d = tid + 256 * j; OUT[(size_t)row * D + d] = v[j] * r * lg[d] + lb[d]; }
}

__global__ void zero_counts_kernel(int* cnt) { if (threadIdx.x < 32) cnt[threadIdx.x] = 0; }
__global__ void router_kernel(const float* H2, const float* rw, const float* rb, int nrows, int* cnt, int* list, int* tok_e, int* tok_pos, float* tok_g) {
    const int row = blockIdx.x * 4 + (threadIdx.x >> 6), lane = threadIdx.x & 63;
    if (row >= nrows) return;
    float acc[16];
#pragma unroll
    for (int e = 0; e < 16; ++e) acc[e] = 0.f;
    for (int d = lane; d < D; d += 64) {
        const float x = H2[(size_t)row * D + d];
        const float4* w = (const float4*)(rw + d * 16);
        const float4 w0 = w[0], w1 = w[1], w2 = w[2], w3 = w[3];
        acc[0] += x * w0.x; acc[1] += x * w0.y; acc[2] += x * w0.z; acc[3] += x * w0.w;
        acc[4] += x * w1.x; acc[5] += x * w1.y; acc[6] += x * w1.z; acc[7] += x * w1.w;
        acc[8] += x * w2.x; acc[9] += x * w2.y; acc[10] += x * w2.z; acc[11] += x * w2.w;
        acc[12] += x * w3.x; acc[13] += x * w3.y; acc[14] += x * w3.z; acc[15] += x * w3.w;
    }
#pragma unroll
    for (int e = 0; e < 16; ++e)
#pragma unroll
        for (int o = 32; o > 0; o >>= 1) acc[e] += __shfl_xor(acc[e], o);
    if (lane != 0) return;
    float mx = acc[0];
#pragma unroll
    for (int e = 1; e < 16; ++e) mx = fmaxf(mx, acc[e]);
    float sum = 0.f;
#pragma unroll
    for (int e = 0; e < 16; ++e) { acc[e] = expf(acc[e] - mx); sum += acc[e]; }
    const float inv = 1.f / sum;
    float best = -1e30f; int be0 = 0, be1 = 0; float bp0 = 0.f, bp1 = 0.f;
#pragma unroll
    for (int g = 0; g < 4; ++g) {
        float pr[4], sl[4];
#pragma unroll
        for (int i = 0; i < 4; ++i) { pr[i] = acc[g * 4 + i] * inv; sl[i] = pr[i] + rb[g * 4 + i]; }
        int i1 = 0; float v1 = sl[0], p1 = pr[0];
#pragma unroll
        for (int i = 1; i < 4; ++i) if (sl[i] > v1) { v1 = sl[i]; i1 = i; p1 = pr[i]; }
        int i2 = -1; float v2 = -1e30f, p2 = 0.f;
#pragma unroll
        for (int i = 0; i < 4; ++i) if (i != i1 && sl[i] > v2) { v2 = sl[i]; i2 = i; p2 = pr[i]; }
        const float gs = v1 + v2;
        if (gs > best) { best = gs; be0 = g * 4 + i1; be1 = g * 4 + i2; bp0 = p1; bp1 = p2; }
    }
    const float gsum = bp0 + bp1;
    const int pos0 = atomicAdd(&cnt[be0], 1), pos1 = atomicAdd(&cnt[be1], 1);
    list[(size_t)be0 * NTOK + pos0] = row; list[(size_t)be1 * NTOK + pos1] = row;
    tok_e[row * 2] = be0; tok_e[row * 2 + 1] = be1; tok_pos[row * 2] = pos0; tok_pos[row * 2 + 1] = pos1;
    tok_g[row * 2] = bp0 / gsum; tok_g[row * 2 + 1] = bp1 / gsum;
}
__global__ void offsets_kernel(const int* cnt, int* offs) { if (threadIdx.x == 0) { int a = 0; for (int e = 0; e < 16; ++e) { offs[e] = a; a += cnt[e]; } } }
__global__ void swiglu_kernel(float* G, const float* U, size_t n) {
    size_t i = (size_t)blockIdx.x * 256 + threadIdx.x;
    if (i < n) G[i] = siluf(G[i]) * U[i];
}

__global__ void qk_prep_kernel(const float* QKV, const float* qg, const float* kg, float* QN, float* KN, float* VN) {
    __shared__ float xs[128]; __shared__ float red[2];
    const int row = blockIdx.x, hh = blockIdx.y, d = threadIdx.x;
    const bool lat = row < NLAT;
    if (hh < 8 && !lat) return;
    int b, t; if (lat) { b = row / SEQ; t = row % SEQ; } else { b = (row - NLAT) / CTXL; t = (row - NLAT) % CTXL; }
    const int kpos = lat ? CTXL + t : t;
    float x = QKV[(size_t)row * 1536 + hh * 128 + d];
    if (hh >= 10) { VN[((size_t)b * SLEN + kpos) * 256 + (hh - 10) * 128 + d] = x; return; }
    float s = x * x;
    for (int o = 32; o > 0; o >>= 1) s += __shfl_xor(s, o);
    if ((d & 63) == 0) red[d >> 6] = s;
    __syncthreads();
    const float ms = (red[0] + red[1]) * (1.f / 128.f);
    const float xn = x * rsqrtf(ms + 1e-6f) * (hh < 8 ? qg[d] : kg[d]);
    xs[d] = xn;
    __syncthreads();
    float out = xn;
    if (lat) {
        const int i = d & 63; const int fi = i & 31;
        const float pos = (i < 32) ? (float)(t / 64) : (float)(t % 64);
        const float invf = expf(-(float)fi * (9.210340371976184f / 32.f));
        float sn, cs; sincosf(pos * invf, &sn, &cs);
        out = (d < 64) ? (xs[d] * cs - xs[d + 64] * sn) : (xs[d] * cs + xs[d - 64] * sn);
    }
    if (hh < 8) QN[(size_t)row * D + hh * 128 + d] = out;
    else KN[((size_t)b * SLEN + kpos) * 256 + (hh - 8) * 128 + d] = out;
}
__global__ void softmax_kernel(float* S, int ncols, float scale) {
    __shared__ float red[4];
    float* s = S + (size_t)blockIdx.x * ncols; const int tid = threadIdx.x;
    float mx = -1e30f;
    for (int j = tid; j < ncols; j += 256) mx = fmaxf(mx, s[j]);
    for (int o = 32; o > 0; o >>= 1) mx = fmaxf(mx, __shfl_xor(mx, o));
    __syncthreads(); if ((tid & 63) == 0) red[tid >> 6] = mx; __syncthreads();
    mx = fmaxf(fmaxf(red[0], red[1]), fmaxf(red[2], red[3]));
    float sum = 0.f;
    for (int j = tid; j < ncols; j += 256) { float e = expf((s[j] - mx) * scale); s[j] = e; sum += e; }
    sum = block_sum256(sum, red);
    const float inv = 1.f / sum;
    for (int j = tid; j < ncols; j += 256) s[j] *= inv;
}

void gemm(hipStream_t st, const float* A, int lda, const float* B, int ldb, float* C, int ldc, int M, int N, int K, int bt = 0, int accum = 0) {
    GemmP p{}; p.A = A; p.B = B; p.C = C; p.lda = lda; p.ldb = ldb; p.ldc = ldc; p.M = M; p.N = N; p.K = K; p.bt = bt; p.accum = accum;
    dim3 grid((N + 127) / 128, (M + 127) / 128, 1);
    hipLaunchKernelGGL(gemm_kernel, grid, dim3(256), 0, st, p);
}
void gemm_moe(hipStream_t st, const float* A, int lda, const int* list, const float* W, float* C, int ldc, const int* cnt, const int* offs, int gather, int maxM) {
    GemmP p{}; p.A = A; p.B = W; p.C = C; p.lda = lda; p.ldb = 1024; p.ldc = ldc; p.M = 0; p.N = 1024; p.K = 1024; p.moe = 1; p.gather = gather;
    p.rowidx = list; p.cnt = cnt; p.offs = offs; p.sB = 1024L * 1024L; p.cap = NTOK;
    dim3 grid(8, (maxM + 127) / 128, 16);
    hipLaunchKernelGGL(gemm_kernel, grid, dim3(256), 0, st, p);
}
}

extern "C" void kernel_launch(void* const* d_in, const int* in_sizes, int n_in, void* d_out, int out_size, void* d_ws, size_t ws_size, hipStream_t stream) {
    const size_t MiB = 1u << 20;
    if (ws_size < 500 * MiB) { fprintf(stderr, "ws too small: %zu\n", ws_size); return; }
    const float* x = (const float*)d_in[0]; const float* c = (const float*)d_in[1]; const float* ctx = (const float*)d_in[2]; const float* c_ctx = (const float*)d_in[3];
    const float* ada_w = (const float*)d_in[4]; const float* ada_b = (const float*)d_in[5]; const float* ln_g = (const float*)d_in[6]; const float* ln_b = (const float*)d_in[7];
    const float* ab_w_in = (const float*)d_in[8]; const float* ab_w_out = (const float*)d_in[9]; const float* ml_ig_b = (const float*)d_in[10]; const float* ml_fg_b = (const float*)d_in[11];
    const float* ml_norm_g = (const float*)d_in[12]; const float* conv_w = (const float*)d_in[13]; const float* conv_b = (const float*)d_in[14]; const float* dt_b = (const float*)d_in[15];
    const float* a_log = (const float*)d_in[16]; const float* ssm_d = (const float*)d_in[17]; const float* ssm_norm_g = (const float*)d_in[18];
    const float* at_w_in = (const float*)d_in[19]; const float* at_w_out = (const float*)d_in[20]; const float* at_q_g = (const float*)d_in[21]; const float* at_k_g = (const float*)d_in[22];
    const float* router_w = (const float*)d_in[23]; const float* router_b = (const float*)d_in[24];
    const float* w_gate = (const float*)d_in[25]; const float* w_up = (const float*)d_in[26]; const float* w_down = (const float*)d_in[27];
    float* out = (float*)d_out;
    char* ws = (char*)d_ws;
    float* XL = (float*)(ws);
    float* HB = (float*)(ws + 66 * MiB);
    float* PB = (float*)(ws + 132 * MiB);
    float* HM = (float*)(ws + 332 * MiB);
    float* XC = (float*)(ws + 398 * MiB);
    char* sm = ws + 497 * MiB;
    float* modv = (float*)sm;
    int* cnt = (int*)(sm + 1 * MiB); int* offs = cnt + 32;
    int* tok_e = (int*)(sm + 2 * MiB); int* tok_pos = tok_e + 2 * NTOK; float* tok_g = (float*)(tok_pos + 2 * NTOK);
    int* list = (int*)(sm + 3 * MiB);

    hipMemcpyAsync(XL, x, (size_t)NLAT * D * 4, hipMemcpyDeviceToDevice, stream);
    hipMemcpyAsync(XL + (size_t)NLAT * D, ctx, (size_t)NCTX * D * 4, hipMemcpyDeviceToDevice, stream);
    hipLaunchKernelGGL(ada_kernel, dim3(2 * 6144 / 256), dim3(256), 0, stream, c, c_ctx, ada_w, ada_b, modv);

    auto moe = [&](int layer, int nrows, float* OUT) {
        const float* modl = modv + layer * 3 * 6144;
        hipLaunchKernelGGL(modulate_kernel, dim3(nrows), dim3(256), 0, stream, XL, modl, 3 * 1024, 4 * 1024, HB);
        hipLaunchKernelGGL(zero_counts_kernel, dim3(1), dim3(64), 0, stream, cnt);
        hipLaunchKernelGGL(router_kernel, dim3((nrows + 3) / 4), dim3(256), 0, stream, HB, router_w, router_b, nrows, cnt, list, tok_e, tok_pos, tok_g);
        hipLaunchKernelGGL(offsets_kernel, dim3(1), dim3(64), 0, stream, cnt, offs);
        float* G = PB; float* U = PB + (size_t)2 * NTOK * D;
        const size_t wl = (size_t)layer * 16 * 1024 * 1024;
        gemm_moe(stream, HB, D, list, w_gate + wl, G, D, cnt, offs, 1, nrows);
        gemm_moe(stream, HB, D, list, w_up + wl, U, D, cnt, offs, 1, nrows);
        const size_t n = (size_t)2 * nrows * D;
        hipLaunchKernelGGL(swiglu_kernel, dim3((unsigned)((n + 255) / 256)), dim3(256), 0, stream, G, U, n);
        gemm_moe(stream, G, D, nullptr, w_down + wl, U, D, cnt, offs, 0, nrows);
        hipLaunchKernelGGL(resid_ln_kernel, dim3(nrows), dim3(256), 0, stream, XL, nullptr, U, tok_e, tok_pos, tok_g, offs, modl, 5 * 1024, ln_g + (layer * 2 + 1) * D, ln_b + (layer * 2 + 1) * D, OUT);
    };

    {
        const float* modl = modv;
        hipLaunchKernelGGL(modulate_kernel, dim3(NTOK), dim3(256), 0, stream, XL, modl, 0, 1024, HB);
        gemm(stream, HB, D, ab_w_in, ABIN, PB, P1W, NTOK, P1W, D);
        hipLaunchKernelGGL(mlstm_rec_kernel, dim3(16, 4, 2), dim3(256), 0, stream, PB, ml_ig_b, ml_fg_b, HM, 0);
        hipLaunchKernelGGL(mlstm_rec_kernel, dim3(16, 4, 2), dim3(256), 0, stream, PB, ml_ig_b, ml_fg_b, HM, 1);
        hipLaunchKernelGGL(finish_m_kernel, dim3(NTOK), dim3(256), 0, stream, HM, PB, ml_norm_g);
        gemm(stream, HB, D, ab_w_in + P1W, ABIN, PB, P2W, NTOK, P2W, D);
        hipLaunchKernelGGL(conv_kernel, dim3(NTOK), dim3(256), 0, stream, PB, conv_w, conv_b, XC);
        hipLaunchKernelGGL(ssd_rec_kernel, dim3(16, 2), dim3(256), 0, stream, PB, XC, dt_b, a_log, HB, 0);
        hipLaunchKernelGGL(ssd_rec_kernel, dim3(16, 2), dim3(256), 0, stream, PB, XC, dt_b, a_log, HB, 1);
        hipLaunchKernelGGL(finish_s_kernel, dim3(NTOK), dim3(256), 0, stream, HB, PB, XC, ssm_d, ssm_norm_g);
        gemm(stream, HM, D, ab_w_out, D, PB, D, NTOK, D, D, 0, 0);
        gemm(stream, HB, D, ab_w_out + (size_t)1024 * D, D, PB, D, NTOK, D, D, 0, 1);
        hipLaunchKernelGGL(resid_ln_kernel, dim3(NTOK), dim3(256), 0, stream, XL, PB, nullptr, nullptr, nullptr, nullptr, nullptr, modl, 2 * 1024, ln_g, ln_b, XL);
        moe(0, NTOK, XL);
    }
    {
        const float* modl = modv + 3 * 6144;
        hipLaunchKernelGGL(modulate_kernel, dim3(NTOK), dim3(256), 0, stream, XL, modl, 0, 1024, HB);
        float* QKV = PB;
        float* QN = (float*)(ws + 231 * MiB);
        float* KN = (float*)(ws + 295 * MiB);
        float* VN = (float*)(ws + 312 * MiB);
        float* S = HM;
        float* AO = HB;
        float* Y1 = XC;
        gemm(stream, HB, D, at_w_in, 1536, QKV, 1536, NTOK, 1536, D);
        hipLaunchKernelGGL(qk_prep_kernel, dim3(NTOK, 12), dim3(128), 0, stream, QKV, at_q_g, at_k_g, QN, KN, VN);
        for (int b = 0; b < 2; ++b)
            for (int h = 0; h < 8; ++h)
                for (int ch = 0; ch < 4; ++ch) {
                    const int kvh = h / 4;
                    const float* Aq = QN + ((size_t)b * SEQ + ch * 2048) * D + h * 128;
                    const float* Kb = KN + (size_t)b * SLEN * 256 + kvh * 128;
                    const float* Vb = VN + (size_t)b * SLEN * 256 + kvh * 128;
                    gemm(stream, Aq, D, Kb, 256, S, SLEN, 2048, SLEN, 128, 1, 0);
                    hipLaunchKernelGGL(softmax_kernel, dim3(2048), dim3(256), 0, stream, S, SLEN, 0.08838834764831845f);
                    gemm(stream, S, SLEN, Vb, 256, AO + ((size_t)b * SEQ + ch * 2048) * D + h * 128, D, 2048, 128, SLEN, 0, 0);
                }
        gemm(stream, AO, D, at_w_out, D, Y1, D, NLAT, D, D);
        hipLaunchKernelGGL(resid_ln_kernel, dim3(NLAT), dim3(256), 0, stream, XL, Y1, nullptr, nullptr, nullptr, nullptr, nullptr, modl, 2 * 1024, ln_g + 2 * D, ln_b + 2 * D, XL);
        moe(1, NLAT, out);
    }
}
```

```cpp
#include <hip/hip_runtime.h>
#include <hip/hip_cooperative_groups.h>
#include <cstdint>
#include <cstdio>
namespace cg = cooperative_groups;

namespace pg8 {
#define PG8_LAS __attribute__((address_space(3)))
typedef unsigned short bf16_t;
typedef short bf16x8 __attribute__((ext_vector_type(8)));
typedef float f32x4 __attribute__((ext_vector_type(4)));
typedef unsigned u32x4 __attribute__((ext_vector_type(4)));
constexpr int BM = 256, BK = 64, HALF = 128, HTB = HALF * BK * 2  , STAGE_BYTES = 8 * HTB, NXCD = 8, WGM = 8;

__host__ __device__ __forceinline__ int lds_byte(int r, int c) { const int st = (r >> 4) * 2 + (c >> 5), rr = r & 15, cc = c & 31, ob = rr * 64 + cc * 2; return st * 1024 + (ob ^ (((ob >> 9) & 1) << 5)); }
__host__ __device__ __forceinline__ void stage_rc(int b, int& R, int& C) { const int st = b / 1024, sb = b % 1024, swz = sb ^ (((sb >> 9) & 1) << 5); R = (st >> 1) * 16 + swz / 64; C = (st & 1) * 32 + (swz % 64) / 2; }
__host__ __device__ __forceinline__ int perm32(int rho) { const int n = rho >> 4, i = rho & 15; return 8 * (i >> 2) + 4 * n + (i & 3); }

struct Unit { int pm, pn; };
struct Gemm { const bf16_t* A; const bf16_t* Bt; int M, N, K; };

struct StaticOrder {
    int nM, nN, nwg, G, c;
    __host__ __device__ void init(int M, int N, int G_, int c_) { nM = M / BM; nN = N / BM; nwg = nM * nN; G = G_; c = c_; }
    __host__ __device__ bool next(int i, Unit& u) const {
        const long L = (long)i * G + c; if (L >= nwg) return false;
        int wgid = (int)L; { const int q = nwg / NXCD, r = nwg % NXCD, xcd = wgid % NXCD, off = wgid / NXCD; wgid = (xcd < r ? xcd * (q + 1) : r * (q + 1) + (xcd - r) * q) + off; }
        const int nig = WGM * nN, gid = wgid / nig, fm = gid * WGM, gsz = (nM - fm) < WGM ? (nM - fm) : WGM;
        u.pm = fm + ((wgid % nig) % gsz); u.pn = (wgid % nig) / gsz; return true;
    }
    __device__ __forceinline__ void a_ready(const Unit&) const {}
    __device__ __forceinline__ void done(const Unit&) const {}
};

template <class Epi, class Sched, bool ALIGN_EPI = false, bool SP2 = false>
__device__ __forceinline__ void gemm_phase(PG8_LAS unsigned char* lds, const Gemm g, const Sched& S, const Epi& E, const int tid) {
    const int wid = __builtin_amdgcn_readfirstlane(tid >> 6), lane = tid & 63, wr = wid >> 2, wc = wid & 3, fr = lane & 15, fq = lane >> 4;
    const int K = g.K, nt = K / BK;
    unsigned voffA[2], voffB[2];
#pragma unroll
    for (int i = 0; i < 2; ++i) { int R, C; stage_rc(tid * 16 + i * 8192, R, C); const int Rb = Epi::PERM ? ((R & ~31) + perm32(R & 31)) : R;
        voffA[i] = (unsigned)(R * K + C) * 2u; voffB[i] = (unsigned)(Rb * K + C) * 2u; }
    const size_t kstep = (size_t)(BK * 2);
    const size_t hstep = (size_t)HALF * K * 2;
    const size_t tstep = 2 * hstep;
    const unsigned ldsw = (unsigned)wid * 1024u;
    const int aoff = lds_byte(wr * 64 + fr, fq * 8), boff = lds_byte(wc * 32 + fr, fq * 8);
#define PG8_SA(b, h) (((b) * 2 + (h)) * HTB)
#define PG8_SB(b, h) ((4 + (b) * 2 + (h)) * HTB)
#define PG8_STAGE(bufoff, gbase, voff) do { _Pragma("unroll") for (int _i = 0; _i < 2; ++_i) \
        __builtin_amdgcn_global_load_lds((const unsigned*)((const char*)(gbase) + (voff)[_i]), (PG8_LAS unsigned*)(lds + (bufoff) + ldsw + _i * 8192), 16, 0, 0); } while (0)
#define PG8_LDA(dst, b, h) do { _Pragma("unroll") for (int m = 0; m < 4; ++m) _Pragma("unroll") for (int k = 0; k < 2; ++k) dst[m][k] = *(const PG8_LAS bf16x8*)(lds + PG8_SA(b, h) + aoff + m * 2048 + k * 1024); } while (0)
#define PG8_LDB(dst, b, h) do { _Pragma("unroll") for (int n = 0; n < 2; ++n) _Pragma("unroll") for (int k = 0; k < 2; ++k) dst[n][k] = *(const PG8_LAS bf16x8*)(lds + PG8_SB(b, h) + boff + n * 2048 + k * 1024); } while (0)
#define PG8_MMA(ai, bj, At, Bt) do { __builtin_amdgcn_s_setprio(1); _Pragma("unroll") for (int m = 0; m < 4; ++m) _Pragma("unroll") for (int n = 0; n < 2; ++n) _Pragma("unroll") for (int k = 0; k < 2; ++k) \
        acc[ai][bj][m][n] = __builtin_amdgcn_mfma_f32_16x16x32_bf16(Bt[n][k], At[m][k], acc[ai][bj][m][n], 0, 0, 0); __builtin_amdgcn_s_setprio(0); } while (0)
#define PG8_WAIT_V(n) asm volatile("s_waitcnt vmcnt(" #n ")" ::: "memory")
#define PG8_WAIT_L(n) asm volatile("s_waitcnt lgkmcnt(" #n ")" ::: "memory")
#define PG8_BAR __builtin_amdgcn_s_barrier()
#define PG8_SCHED __builtin_amdgcn_sched_barrier(0)
    Unit cur, nxt; int ui = 0;
    if (!S.next(0, cur)) return;
    f32x4 acc[2][2][4][2];
#pragma unroll
    for (int a = 0; a < 2; ++a)
#pragma unroll
        for (int b = 0; b < 2; ++b)
#pragma unroll
            for (int m = 0; m < 4; ++m)
#pragma unroll
                for (int n = 0; n < 2; ++n) acc[a][b][m][n] = (f32x4){0.f, 0.f, 0.f, 0.f};
    bf16x8 At[4][2], B0[2][2], B1[2][2];
    const char* cA = (const char*)g.A + (size_t)cur.pm * tstep; const char* cB = (const char*)g.Bt + (size_t)cur.pn * tstep;
    S.a_ready(cur);
    if constexpr (SP2) {
        PG8_STAGE(PG8_SB(0, 0), cB, voffB); PG8_STAGE(PG8_SB(0, 1), cB + hstep, voffB); PG8_STAGE(PG8_SA(0, 0), cA, voffA); PG8_STAGE(PG8_SA(0, 1), cA + hstep, voffA);
        if (wr == 1) PG8_BAR;
        PG8_WAIT_V(2); PG8_BAR;
        PG8_STAGE(PG8_SB(1, 0), cB + kstep, voffB); PG8_STAGE(PG8_SA(1, 0), cA + kstep, voffA); PG8_STAGE(PG8_SB(1, 1), cB + hstep + kstep, voffB);
        PG8_WAIT_V(6); PG8_BAR;
    } else {
        PG8_STAGE(PG8_SB(0, 0), cB, voffB); PG8_STAGE(PG8_SA(0, 0), cA, voffA); PG8_STAGE(PG8_SB(0, 1), cB + hstep, voffB); PG8_STAGE(PG8_SA(0, 1), cA + hstep, voffA);
        if (wr == 1) PG8_BAR;
        PG8_WAIT_V(4); PG8_BAR;
        PG8_STAGE(PG8_SB(1, 0), cB + kstep, voffB); PG8_STAGE(PG8_SA(1, 0), cA + kstep, voffA); PG8_STAGE(PG8_SB(1, 1), cB + hstep + kstep, voffB);
        PG8_WAIT_V(6); PG8_BAR;
    }
    for (;;) {
        const bool has_next = S.next(ui + 1, nxt);
        const char* nA = has_next ? (const char*)g.A + (size_t)nxt.pm * tstep : cA; const char* nB = has_next ? (const char*)g.Bt + (size_t)nxt.pn * tstep : cB;
        for (int t = 0; t < nt; t += 2) {
            const bool last = (t == nt - 2);
            const char* a1 = cA + (size_t)(t + 1) * kstep;
            const char* a2 = last ? nA : cA + (size_t)(t + 2) * kstep; const char* b2 = last ? nB : cB + (size_t)(t + 2) * kstep;
            const char* a3 = a2 + kstep; const char* b3 = b2 + kstep;
            if (last && has_next) S.a_ready(nxt);
            if constexpr (SP2) {
            PG8_LDB(B0, 0, 0); PG8_LDB(B1, 0, 1); PG8_SCHED; PG8_LDA(At, 0, 0); PG8_STAGE(PG8_SA(1, 1), a1 + hstep, voffA);
            PG8_WAIT_V(8); PG8_WAIT_L(0); PG8_BAR; PG8_MMA(0, 0, At, B0); PG8_MMA(0, 1, At, B1); PG8_BAR; PG8_SCHED;
            PG8_LDA(At, 0, 1); PG8_STAGE(PG8_SB(0, 0), b2, voffB); PG8_STAGE(PG8_SB(0, 1), b2 + hstep, voffB); PG8_STAGE(PG8_SA(0, 0), a2, voffA);
            PG8_WAIT_V(8); PG8_WAIT_L(0); PG8_BAR; PG8_MMA(1, 0, At, B0); PG8_MMA(1, 1, At, B1); PG8_BAR; PG8_SCHED;
            PG8_LDB(B0, 1, 0); PG8_LDB(B1, 1, 1); PG8_SCHED; PG8_LDA(At, 1, 0); PG8_STAGE(PG8_SA(0, 1), a2 + hstep, voffA);
            PG8_WAIT_V(8); PG8_WAIT_L(0); PG8_BAR; PG8_MMA(0, 0, At, B0); PG8_MMA(0, 1, At, B1); PG8_BAR; PG8_SCHED;
            PG8_LDA(At, 1, 1); PG8_STAGE(PG8_SB(1, 0), b3, voffB); PG8_STAGE(PG8_SB(1, 1), b3 + hstep, voffB); PG8_STAGE(PG8_SA(1, 0), a3, voffA);
            PG8_WAIT_V(8); PG8_WAIT_L(0); PG8_BAR; PG8_MMA(1, 0, At, B0); PG8_MMA(1, 1, At, B1); PG8_BAR; PG8_SCHED;
            } else {
            PG8_LDB(B0, 0, 0); PG8_SCHED; PG8_LDA(At, 0, 0); PG8_STAGE(PG8_SA(1, 1), a1 + hstep, voffA);
            PG8_WAIT_L(8); PG8_BAR; PG8_WAIT_L(0); PG8_MMA(0, 0, At, B0); PG8_BAR; PG8_SCHED;
            PG8_LDB(B1, 0, 1); PG8_STAGE(PG8_SB(0, 0), b2, voffB);
            PG8_BAR; PG8_WAIT_L(0); PG8_MMA(0, 1, At, B1); PG8_BAR;
            PG8_LDA(At, 0, 1); PG8_STAGE(PG8_SA(0, 0), a2, voffA);
            PG8_BAR; PG8_WAIT_L(0); PG8_MMA(1, 0, At, B0); PG8_BAR; PG8_SCHED;
            PG8_STAGE(PG8_SB(0, 1), b2 + hstep, voffB);
            PG8_WAIT_V(6); PG8_BAR; PG8_MMA(1, 1, At, B1); PG8_BAR;
            PG8_LDB(B0, 1, 0); PG8_SCHED; PG8_LDA(At, 1, 0); PG8_STAGE(PG8_SA(0, 1), a2 + hstep, voffA);
            PG8_WAIT_L(8); PG8_BAR; PG8_WAIT_L(0); PG8_MMA(0, 0, At, B0); PG8_BAR; PG8_SCHED;
            PG8_LDB(B1, 1, 1); PG8_STAGE(PG8_SB(1, 0), b3, voffB);
            PG8_BAR; PG8_WAIT_L(0); PG8_MMA(0, 1, At, B1); PG8_BAR;
            PG8_LDA(At, 1, 1); PG8_STAGE(PG8_SA(1, 0), a3, voffA);
            PG8_BAR; PG8_WAIT_L(0); PG8_MMA(1, 0, At, B0); PG8_BAR; PG8_SCHED;
            PG8_STAGE(PG8_SB(1, 1), b3 + hstep, voffB);
            PG8_WAIT_V(6); PG8_BAR; PG8_MMA(1, 1, At, B1); PG8_BAR;
            }
        }
        if constexpr (ALIGN_EPI) { if (wr == 0) PG8_BAR; }
        if constexpr (!Epi::AFTER_DRAIN) { E(acc, cur, wr, wc, fr, fq); S.done(cur); }
        if (!has_next) break;
#pragma unroll
        for (int a = 0; a < 2; ++a)
#pragma unroll
            for (int b = 0; b < 2; ++b)
#pragma unroll
                for (int m = 0; m < 4; ++m)
#pragma unroll
                    for (int n = 0; n < 2; ++n) acc[a][b][m][n] = (f32x4){0.f, 0.f, 0.f, 0.f};
        cur = nxt; cA = nA; cB = nB; ++ui;
        if constexpr (ALIGN_EPI) { if (wr == 1) PG8_BAR; }
    }
    PG8_WAIT_V(0);
    if constexpr (!ALIGN_EPI) { if (wr == 0) PG8_BAR; }
    PG8_BAR;
    if constexpr (Epi::AFTER_DRAIN) { E.fused(acc, cur, wr, wc, fr, fq, lds, wid, lane); S.done(cur); }
#undef PG8_SA
#undef PG8_SB
#undef PG8_STAGE
#undef PG8_LDA
#undef PG8_LDB
#undef PG8_MMA
#undef PG8_WAIT_V
#undef PG8_WAIT_L
#undef PG8_BAR
#undef PG8_SCHED
}
}
namespace attn {
using bf16 = unsigned short;
constexpr int D = 128, NW = 8, QBLK = 32, KVBLK = 64;
constexpr float SCALE = 0.088388347648318440f;
constexpr float THR = 8.f;
constexpr int SDEPTH = 1;
constexpr int LDQ = 1024, LDK = 256, LDO = 1024;
constexpr size_t SHM_V = KVBLK * D * 2, SHM_K = KVBLK * D * 2, SHM_ATTN = 2 * SHM_V + 2 * SHM_K + NW * 64 * 4;
using bf16x8 = __attribute__((ext_vector_type(8))) short;
using s16x4  = __attribute__((ext_vector_type(4))) short;
using f32x16 = __attribute__((ext_vector_type(16))) float;
using f32x8  = __attribute__((ext_vector_type(8))) float;
using u32x4  = __attribute__((ext_vector_type(4))) unsigned;
#define KSWZ(row, colB) ((row) * 256 + ((colB) ^ (((row) & 7) << 4)))
#define SBAR() __builtin_amdgcn_sched_barrier(0)
__device__ __forceinline__ int crow(int r, int hi) { return (r & 3) + 8 * (r >> 2) + 4 * hi; }
__device__ __forceinline__ unsigned cvtpk(float lo, float hi) {
  unsigned r; asm volatile("v_cvt_pk_bf16_f32 %0, %1, %2" : "=v"(r) : "v"(lo), "v"(hi)); return r;
}
template <typename TIn> struct Stage;
template <> struct Stage<bf16>  { using T = bf16x8;
  __device__ static __forceinline__ T ld8(const bf16* p) { return *reinterpret_cast<const bf16x8*>(p); }
  __device__ static __forceinline__ bf16x8 tobf(T x) { return x; } };
template <> struct Stage<float> { using T = f32x8;
  __device__ static __forceinline__ T ld8(const float* p) { return *reinterpret_cast<const f32x8*>(p); }
  __device__ static __forceinline__ bf16x8 tobf(T x) {
    u32x4 w = {cvtpk(x[0], x[1]), cvtpk(x[2], x[3]), cvtpk(x[4], x[5]), cvtpk(x[6], x[7])}; return *reinterpret_cast<bf16x8*>(&w); } };

__device__ __forceinline__ void partialSM(f32x16& p0, f32x16& p1, float& m_reg, float& mn, float& alpha) {
  constexpr float C = SCALE * 1.4426950408889634f;
  float pmax = p0[0]; for (int r = 1; r < 16; ++r) pmax = fmaxf(pmax, p0[r]); for (int r = 0; r < 16; ++r) pmax = fmaxf(pmax, p1[r]);
  { auto rr = __builtin_amdgcn_permlane32_swap(__float_as_uint(pmax), __float_as_uint(pmax), false, false);
    pmax = fmaxf(__uint_as_float(rr[0]), __uint_as_float(rr[1])); }
  if (__builtin_expect(__all(pmax - m_reg <= THR / SCALE), 1)) { mn = m_reg; alpha = 1.f; }
  else { mn = fmaxf(m_reg, pmax); alpha = __builtin_amdgcn_exp2f((m_reg - mn) * C); m_reg = mn; }
  float mnC = -mn * C;
  for (int r = 0; r < 16; ++r) p0[r] = fmaf(p0[r], C, mnC); for (int r = 0; r < 16; ++r) p1[r] = fmaf(p1[r], C, mnC);
  for (int r = 0; r < 16; ++r) p0[r] = __builtin_amdgcn_exp2f(p0[r]);
}
__device__ __forceinline__ void finishSM(f32x16& p0, f32x16& p1, float alpha, float& l_reg, bf16x8& pa0, bf16x8& pa1, bf16x8& pa2, bf16x8& pa3) {
  for (int r = 0; r < 16; ++r) p1[r] = __builtin_amdgcn_exp2f(p1[r]);
  float ps = 0; for (int r = 0; r < 16; ++r) ps += p0[r]; for (int r = 0; r < 16; ++r) ps += p1[r];
  { auto rr = __builtin_amdgcn_permlane32_swap(__float_as_uint(ps), __float_as_uint(ps), false, false);
    ps = __uint_as_float(rr[0]) + __uint_as_float(rr[1]); }
  l_reg = l_reg * alpha + ps;
#define PK4(P, BASE, OUT) do { unsigned a0 = cvtpk(P[BASE + 0], P[BASE + 1]), a1 = cvtpk(P[BASE + 2], P[BASE + 3]);   \
    unsigned b0 = cvtpk(P[BASE + 4], P[BASE + 5]), b1 = cvtpk(P[BASE + 6], P[BASE + 7]);                              \
    auto r0 = __builtin_amdgcn_permlane32_swap(a0, b0, false, false); auto r1 = __builtin_amdgcn_permlane32_swap(a1, b1, false, false); \
    u32x4 w = {r0[0], r1[0], r0[1], r1[1]}; OUT = *reinterpret_cast<bf16x8*>(&w); } while (0)
  PK4(p0, 0, pa0); PK4(p0, 8, pa1); PK4(p1, 0, pa2); PK4(p1, 8, pa3);
#undef PK4
}
__device__ __forceinline__ void qkt(f32x16& p0, f32x16& p1, const bf16* Ks, const bf16x8* qr, int r32, int hi) {
  p0 = f32x16{}; p1 = f32x16{};
  for (int d0 = 0; d0 < 8; ++d0) { int cb = (d0 * 16 + hi * 8) * 2;
    bf16x8 b0 = *reinterpret_cast<const bf16x8*>((const char*)Ks + KSWZ(r32, cb));
    bf16x8 b1 = *reinterpret_cast<const bf16x8*>((const char*)Ks + KSWZ(32 + r32, cb));
    p0 = __builtin_amdgcn_mfma_f32_32x32x16_bf16(b0, qr[d0], p0, 0, 0, 0);
    p1 = __builtin_amdgcn_mfma_f32_32x32x16_bf16(b1, qr[d0], p1, 0, 0, 0); }
}
__device__ __forceinline__ int v_st(int k, int c) { const int kk = (k & ~0xC) | ((k & 4) << 1) | ((k & 8) >> 1); return ((kk >> 3) * 4 + (c >> 5)) * 512 + ((kk & 7) * 32 + (c & 31)) * 2; }
__device__ __forceinline__ int v_rd_base(int lane) { return ((lane & 3) << 3) | (((lane >> 2) & 3) << 6) | (((lane >> 4) & 1) << 5) | (((lane >> 5) & 1) << 8); }
constexpr int v_rd_off(int d0, int ks, int half) { return d0 * 512 + ks * 4096 + half * 2048; }
template <int OFF> __device__ __forceinline__ s16x4 tr_read(int vb) {
  s16x4 r; asm volatile("ds_read_b64_tr_b16 %0, %1 offset:%2" : "=&v"(r) : "v"(vb), "i"(OFF) : "memory"); return r;
}
template <int D0> __device__ __forceinline__ void pv_one(f32x16& od, int vb, bf16x8 pa0, bf16x8 pa1, bf16x8 pa2, bf16x8 pa3) {
  const s16x4 l0 = tr_read<v_rd_off(D0, 0, 0)>(vb), h0 = tr_read<v_rd_off(D0, 0, 1)>(vb), l1 = tr_read<v_rd_off(D0, 1, 0)>(vb), h1 = tr_read<v_rd_off(D0, 1, 1)>(vb);
  const s16x4 l2 = tr_read<v_rd_off(D0, 2, 0)>(vb), h2 = tr_read<v_rd_off(D0, 2, 1)>(vb), l3 = tr_read<v_rd_off(D0, 3, 0)>(vb), h3 = tr_read<v_rd_off(D0, 3, 1)>(vb);
  asm volatile("s_waitcnt lgkmcnt(0)" ::: "memory"); SBAR();
#define PK(L, H) (bf16x8){L[0], L[1], L[2], L[3], H[0], H[1], H[2], H[3]}
  od = __builtin_amdgcn_mfma_f32_32x32x16_bf16(pa0, PK(l0, h0), od, 0, 0, 0);
  od = __builtin_amdgcn_mfma_f32_32x32x16_bf16(pa1, PK(l1, h1), od, 0, 0, 0);
  od = __builtin_amdgcn_mfma_f32_32x32x16_bf16(pa2, PK(l2, h2), od, 0, 0, 0);
  od = __builtin_amdgcn_mfma_f32_32x32x16_bf16(pa3, PK(l3, h3), od, 0, 0, 0);
#undef PK
}
__device__ __forceinline__ void pv_d0(f32x16* o, int vb, bf16x8 pa0, bf16x8 pa1, bf16x8 pa2, bf16x8 pa3) {
  pv_one<0>(o[0], vb, pa0, pa1, pa2, pa3); pv_one<1>(o[1], vb, pa0, pa1, pa2, pa3); pv_one<2>(o[2], vb, pa0, pa1, pa2, pa3); pv_one<3>(o[3], vb, pa0, pa1, pa2, pa3);
}

template <typename TQ>
__device__ __forceinline__ void attn_dense_body(const TQ* __restrict__ Qb, const bf16* __restrict__ Kh, const bf16* __restrict__ Vh,
                                                bf16* __restrict__ Ob, int seq, char* lds, const int tid) {
  using St = Stage<bf16>; using SQ = Stage<TQ>;
  const int wid = tid >> 6, lane = tid & 63, r32 = lane & 31, hi = lane >> 5;
  bf16* V_lds = (bf16*)lds; bf16* K_lds = (bf16*)(lds + 2 * SHM_V);
  float* ws = (float*)(lds + 2 * SHM_V + 2 * SHM_K) + wid * 64; float* li_l = ws; float* al_l = ws + 32;
  float m_reg = -1e30f, l_reg = 0; f32x16 o[4] = {}; bf16x8 qr[8];
  const TQ* Qw = Qb + (long)(wid * QBLK + r32) * LDQ + hi * 8;
#pragma unroll
  for (int d0 = 0; d0 < 8; ++d0) qr[d0] = SQ::tobf(SQ::ld8(Qw + d0 * 16));
  const int sr = tid >> 4, sc = (tid & 15) * 8, vst0 = v_st(sr, sc), vst1 = v_st(32 + sr, sc);
  const int vb0 = (int)(uintptr_t)V_lds + v_rd_base(lane);
  struct { typename St::T vs0, vs1, ks0, ks1; } sr_[SDEPTH];
#define SLOAD(i, k0) do { sr_[i].vs0 = St::ld8(&Vh[(long)((k0) + sr) * LDK + sc]); sr_[i].vs1 = St::ld8(&Vh[(long)((k0) + 32 + sr) * LDK + sc]); \
    sr_[i].ks0 = St::ld8(&Kh[(long)((k0) + sr) * LDK + sc]); sr_[i].ks1 = St::ld8(&Kh[(long)((k0) + 32 + sr) * LDK + sc]); } while (0)
#define SWRITE(b, i) do { *(bf16x8*)((char*)V_lds + (b) * SHM_V + vst0) = St::tobf(sr_[i].vs0);          \
    *(bf16x8*)((char*)V_lds + (b) * SHM_V + vst1) = St::tobf(sr_[i].vs1); int kc = sc * 2;               \
    *(bf16x8*)((char*)K_lds + (b) * SHM_K + KSWZ(sr, kc)) = St::tobf(sr_[i].ks0);                       \
    *(bf16x8*)((char*)K_lds + (b) * SHM_K + KSWZ(32 + sr, kc)) = St::tobf(sr_[i].ks1); } while (0)
#define SWAIT() do { if constexpr (SDEPTH == 2) asm volatile("s_waitcnt vmcnt(4)" ::: "memory"); else asm volatile("s_waitcnt vmcnt(0)" ::: "memory"); } while (0)
#define RESC(a) do { if (__any((a) < 1.f)) { if (hi == 0) al_l[r32] = (a); asm volatile("s_waitcnt lgkmcnt(0)" ::: "memory"); \
    for (int d = 0; d < 4; ++d) for (int r = 0; r < 16; ++r) o[d][r] *= al_l[crow(r, hi)]; } } while (0)
  f32x16 pA0, pA1, pB0, pB1; float mnA, mnB, alA, alB; bf16x8 pa0, pa1, pa2, pa3; const int NT = seq / KVBLK;
  constexpr int SE = 0, SO = SDEPTH - 1;
  SLOAD(SE, 0); asm volatile("s_waitcnt vmcnt(0)" ::: "memory"); SWRITE(0, SE); __syncthreads();
  qkt(pA0, pA1, K_lds, qr, r32, hi); partialSM(pA0, pA1, m_reg, mnA, alA);
  SLOAD(SO, KVBLK); if constexpr (SDEPTH == 2) { if (2 < NT) SLOAD(SE, 2 * KVBLK); }
  SWAIT(); SWRITE(1, SO); __syncthreads();
  for (int j = 1; j + 1 < NT; j += 2) {
    SBAR(); qkt(pB0, pB1, (bf16*)((char*)K_lds + SHM_K), qr, r32, hi);
    finishSM(pA0, pA1, alA, l_reg, pa0, pa1, pa2, pa3); SBAR();
    SLOAD(SO, (j + SDEPTH) * KVBLK); SBAR();
    pv_d0(o, vb0, pa0, pa1, pa2, pa3); partialSM(pB0, pB1, m_reg, mnB, alB);
    __syncthreads(); SWAIT(); SWRITE(0, SE);
    RESC(alB); __syncthreads();
    SBAR(); qkt(pA0, pA1, K_lds, qr, r32, hi);
    finishSM(pB0, pB1, alB, l_reg, pa0, pa1, pa2, pa3); SBAR();
    if (SDEPTH == 1 || j + 3 < NT) SLOAD(SE, (j + 1 + SDEPTH) * KVBLK); SBAR();
    pv_d0(o, vb0 + (int)SHM_V, pa0, pa1, pa2, pa3); partialSM(pA0, pA1, m_reg, mnA, alA);
    __syncthreads(); SWAIT(); SWRITE(1, SO);
    RESC(alA); __syncthreads();
  }
  SBAR(); qkt(pB0, pB1, (bf16*)((char*)K_lds + SHM_K), qr, r32, hi);
  finishSM(pA0, pA1, alA, l_reg, pa0, pa1, pa2, pa3); SBAR();
  pv_d0(o, vb0, pa0, pa1, pa2, pa3); partialSM(pB0, pB1, m_reg, mnB, alB);
  __syncthreads(); RESC(alB);
  finishSM(pB0, pB1, alB, l_reg, pa0, pa1, pa2, pa3); SBAR();
  pv_d0(o, vb0 + (int)SHM_V, pa0, pa1, pa2, pa3);
  if (hi == 0) li_l[r32] = l_reg; asm volatile("s_waitcnt lgkmcnt(0)" ::: "memory");
  float rli[16];
#pragma unroll
  for (int r = 0; r < 16; ++r) rli[r] = __builtin_amdgcn_rcpf(li_l[crow(r, hi)]);
  bf16* Ow = Ob + (long)(wid * QBLK) * LDO;
#pragma unroll
  for (int r = 0; r < 16; ++r) { int orow = crow(r, hi);
    for (int d0 = 0; d0 < 4; ++d0) Ow[(long)orow * LDO + d0 * 32 + r32] = (bf16)(cvtpk(o[d0][r] * rli[r], 0.f) & 0xffffu); }
#undef SLOAD
#undef SWRITE
#undef SWAIT
#undef RESC
}
}

namespace {
using pg8::bf16_t; using pg8::bf16x8; using pg8::f32x4; using pg8::u32x4;
typedef unsigned u32x2 __attribute__((ext_vector_type(2)));
typedef float f32x16 __attribute__((ext_vector_type(16)));
typedef short s16x4 __attribute__((ext_vector_type(4)));
#define LAS __attribute__((address_space(3)))

constexpr int D = 1024, NBATCH = 2, SEQ = 8192, CTXL = 256;
constexpr int NLAT = NBATCH * SEQ, NCTX = NBATCH * CTXL, NTOK = NLAT + NCTX;
constexpr int SLEN = CTXL + SEQ;
constexpr int NCH = SLEN / 128;
constexpr int ABIN = 5680, NWIN = 5632;
constexpr int NGATE = 48;
constexpr float ALPHA = 1.4142135623730951f;
constexpr int NWAVES = 8, NTHREADS = 512;
constexpr int MOE_MAXTILES = 148;

constexpr size_t MiB = 1u << 20;
constexpr size_t WS_CTL = 0;
constexpr size_t WS_MODV = 1 * MiB;
constexpr size_t WS_GW = WS_MODV + 160 * 1024;
constexpr size_t WS_DN = WS_MODV + 352 * 1024;
constexpr size_t WS_MS = WS_MODV + 880 * 1024;
constexpr size_t WS_AEND = WS_MODV + 900 * 1024;
constexpr size_t WS_SS = WS_MODV + 920 * 1024;
constexpr size_t WS_WIN = 2 * MiB;
constexpr size_t WS_WOUT = 13 * MiB;
constexpr size_t WS_ATIN = 17 * MiB;
constexpr size_t WS_ATOUT = 20 * MiB;
constexpr size_t WS_XL = 22 * MiB;
constexpr size_t WS_HB = 88 * MiB;
constexpr size_t WS_MOEW = 121 * MiB;
constexpr size_t WS_ROUTE = 217 * MiB;
constexpr size_t WS_R = 219 * MiB;
constexpr size_t WS_QK = WS_R, WS_V = WS_R + 33 * MiB, WS_O = WS_R + 66 * MiB, WS_Z = WS_R + 99 * MiB, WS_XBC = WS_R + 132 * MiB;
constexpr size_t WS_GATES = WS_R + 182 * MiB;
constexpr size_t WS_SSQ = WS_R + 185 * MiB + 256 * 1024;
constexpr size_t WS_MIX = WS_R + 186 * MiB;
constexpr size_t WS_XC = WS_HB;
constexpr size_t WS_DS = 138 * MiB;
constexpr size_t WS_DC = WS_XL;
constexpr size_t WS_YB = WS_R;
constexpr size_t WS_XS = WS_R, WS_HMID = WS_R + 74 * MiB, WS_YS = WS_R + 148 * MiB;
constexpr size_t WS_Q = WS_R, WS_KB = WS_R + 33 * MiB, WS_VB = WS_R + 42 * MiB, WS_AO = WS_R + 51 * MiB, WS_YB1 = WS_R + 84 * MiB, WS_S = WS_R + 117 * MiB;
constexpr size_t WS_END = 472 * MiB;

constexpr int CW_CNT0 = 64, CW_CNT1 = 128;
constexpr int CW_BAR = 1024;

__device__ __forceinline__ float bf2f(unsigned short v) { return __uint_as_float((unsigned)v << 16); }
typedef float f32x2_t __attribute__((ext_vector_type(2))); typedef __bf16 bf16x2_t __attribute__((ext_vector_type(2)));
__device__ __forceinline__ unsigned pk2(float lo, float hi) { f32x2_t v = {lo, hi}; bf16x2_t b = __builtin_convertvector(v, bf16x2_t); return __builtin_bit_cast(unsigned, b); }
__device__ __forceinline__ bf16_t f2bf(float f) { return (bf16_t)(pk2(f, 0.f) & 0xffffu); }
__device__ __forceinline__ float siluf(float x) { return x * __builtin_amdgcn_rcpf(1.f + __expf(-x)); }
__device__ __forceinline__ float sigmf(float x) { return __builtin_amdgcn_rcpf(1.f + __expf(-x)); }
__device__ __forceinline__ float softplusf(float x) { return x > 20.f ? x : log1pf(expf(x)); }
__device__ __forceinline__ float logsigf(float x) { return -softplusf(-x); }
__device__ __forceinline__ float wave_sum(float v) {
#pragma unroll
    for (int o = 1; o < 64; o <<= 1) v += __shfl_xor(v, o);
    return v;
}
__device__ __forceinline__ unsigned char* launder_ptr(unsigned char* p) { asm volatile("" : "+s"(p)); return p; }
__device__ __forceinline__ int fresh_lane() { int z = 0; asm volatile("" : "+s"(z)); return (int)__builtin_amdgcn_mbcnt_hi(~0u, __builtin_amdgcn_mbcnt_lo(~0u, (unsigned)z)); }
__device__ __forceinline__ int mod_index(int row) { return row < NLAT ? row / SEQ : 2; }
__device__ __forceinline__ int seq_row(int b, int dir, int i) {
    if (i < CTXL) { int t = dir ? (CTXL - 1 - i) : i; return NLAT + b * CTXL + t; }
    int t = i - CTXL; if (dir) t = SEQ - 1 - t; return b * SEQ + t;
}
__device__ __forceinline__ int chunk_row0(int b, int cid) { return cid < 2 ? NLAT + b * CTXL + cid * 128 : b * SEQ + (cid - 2) * 128; }
__device__ __forceinline__ int scan_cid(int dir, int p) { return dir == 0 ? p : (p < 2 ? 1 - p : 67 - p); }

struct RowF { f32x4 v[4]; };
__device__ __forceinline__ RowF row_ld_f32(const float* p, int lane) { RowF r; const f32x4* q = (const f32x4*)p + lane;
#pragma unroll
    for (int j = 0; j < 4; ++j) r.v[j] = q[64 * j];
    return r; }
__device__ __forceinline__ RowF row_ld_bf16(const bf16_t* p, int lane) { RowF r; const u32x2* q = (const u32x2*)p + lane;
#pragma unroll
    for (int j = 0; j < 4; ++j) { const u32x2 w = q[64 * j]; r.v[j] = (f32x4){__uint_as_float(w.x << 16), __uint_as_float(w.x & 0xffff0000u), __uint_as_float(w.y << 16), __uint_as_float(w.y & 0xffff0000u)}; }
    return r; }
__device__ __forceinline__ void row_st_f32(float* p, int lane, const RowF& r) { f32x4* q = (f32x4*)p + lane;
#pragma unroll
    for (int j = 0; j < 4; ++j) q[64 * j] = r.v[j]; }
__device__ __forceinline__ void row_st_bf16(bf16_t* p, int lane, const RowF& r) { u32x2* q = (u32x2*)p + lane;
#pragma unroll
    for (int j = 0; j < 4; ++j) { u32x2 w; w.x = pk2(r.v[j][0], r.v[j][1]); w.y = pk2(r.v[j][2], r.v[j][3]); q[64 * j] = w; } }
__device__ __forceinline__ float row_sum(const RowF& r) { float s = 0.f;
#pragma unroll
    for (int j = 0; j < 4; ++j) s += (r.v[j][0] + r.v[j][1]) + (r.v[j][2] + r.v[j][3]);
    return wave_sum(s); }
__device__ __forceinline__ void row_layernorm(RowF& r, const float* g, const float* b, int lane) {
    const float mu = row_sum(r) * (1.f / D); float q = 0.f;
#pragma unroll
    for (int j = 0; j < 4; ++j) { r.v[j] = r.v[j] - mu; q += (r.v[j][0] * r.v[j][0] + r.v[j][1] * r.v[j][1]) + (r.v[j][2] * r.v[j][2] + r.v[j][3] * r.v[j][3]); }
    const float rstd = rsqrtf(wave_sum(q) * (1.f / D) + 1e-5f);
    const RowF gg = row_ld_f32(g, lane), bb = row_ld_f32(b, lane);
#pragma unroll
    for (int j = 0; j < 4; ++j) r.v[j] = r.v[j] * rstd * gg.v[j] + bb.v[j];
}
__device__ __forceinline__ RowF row_modulate(const RowF& x, const float* sh, const float* sc, int lane) {
    const RowF s = row_ld_f32(sh, lane), c = row_ld_f32(sc, lane); RowF h;
#pragma unroll
    for (int j = 0; j < 4; ++j) h.v[j] = x.v[j] * (1.f + c.v[j]) + s.v[j];
    return h; }

template <class Dest> struct EpiStore {
    static constexpr bool PERM = true, AFTER_DRAIN = false; Dest d;
    __device__ __forceinline__ void operator()(const f32x4 (&acc)[2][2][4][2], const pg8::Unit& u, int wr, int wc, int fr, int fq) const {
#pragma unroll
        for (int ai = 0; ai < 2; ++ai)
#pragma unroll
            for (int m = 0; m < 4; ++m) {
                const int row = u.pm * 256 + ai * 128 + wr * 64 + m * 16 + fr;
                bf16_t* rp = d.rowptr(row, u.pn); if (!rp) continue;
#pragma unroll
                for (int bj = 0; bj < 2; ++bj) { const f32x4 v0 = acc[ai][bj][m][0], v1 = acc[ai][bj][m][1];
                    u32x4 w; w.x = pk2(v0[0], v0[1]); w.y = pk2(v0[2], v0[3]); w.z = pk2(v1[0], v1[1]); w.w = pk2(v1[2], v1[3]);
                    *(u32x4*)(rp + bj * 128 + wc * 32 + 8 * fq) = w; }
            }
    }
};
struct DestWin { bf16_t* base;
    __device__ __forceinline__ bf16_t* rowptr(int row, int pn) const {
        if (pn < 16) { const int seg = pn >> 2; return base + (size_t)seg * (33 * MiB / 2) + (size_t)row * 1024 + (pn & 3) * 256; }
        return base + (size_t)4 * (33 * MiB / 2) + (size_t)row * 1536 + (pn - 16) * 256; } };
struct DestPlain { bf16_t* base; int ld; int pnmask;
    __device__ __forceinline__ bf16_t* rowptr(int row, int pn) const { return base + (size_t)row * ld + (pn & pnmask) * 256; } };
struct DestQKV { bf16_t* q; bf16_t* kb; bf16_t* vb;
    __device__ __forceinline__ bf16_t* rowptr(int row, int pn) const {
        if (pn < 4) return row < NLAT ? q + (size_t)row * 1024 + pn * 256 : nullptr;
        int key; if (row < NLAT) { const int b = row / SEQ, t = row % SEQ; key = b * SLEN + CTXL + t; } else { const int r = row - NLAT; key = (r / CTXL) * SLEN + (r % CTXL); }
        return (pn == 4 ? kb : vb) + (size_t)key * 256; } };
struct EpiSwiglu {
    static constexpr bool PERM = true, AFTER_DRAIN = false; bf16_t* out;
    __device__ __forceinline__ void operator()(const f32x4 (&acc)[2][2][4][2], const pg8::Unit& u, int wr, int wc, int fr, int fq) const {
        const int pnl = u.pn & 7;
#pragma unroll
        for (int ai = 0; ai < 2; ++ai)
#pragma unroll
            for (int m = 0; m < 4; ++m) {
                const int row = u.pm * 256 + ai * 128 + wr * 64 + m * 16 + fr;
                bf16_t* rp = out + (size_t)row * 1024 + pnl * 128 + wc * 16 + 4 * fq;
#pragma unroll
                for (int bj = 0; bj < 2; ++bj) { const f32x4 g = acc[ai][bj][m][0], up = acc[ai][bj][m][1];
                    u32x2 w; w.x = pk2(siluf(g[0]) * up[0], siluf(g[1]) * up[1]); w.y = pk2(siluf(g[2]) * up[2], siluf(g[3]) * up[3]);
                    *(u32x2*)(rp + bj * 64) = w; }
            }
    }
};
struct MoeOrder {
    int ntm, npn, nwg, G, c; const LAS int* toff;
    __device__ __forceinline__ void init(const LAS int* toff_, int npn_, int G_, int c_) { toff = toff_; ntm = toff_[16]; npn = npn_; nwg = ntm * npn_; G = G_; c = c_; }
    __device__ __forceinline__ bool next(int i, pg8::Unit& u) const {
        const long L = (long)i * G + c; if (L >= nwg) return false;
        int wgid = (int)L; { const int q = nwg / 8, r = nwg % 8, xcd = wgid % 8, off = wgid / 8; wgid = (xcd < r ? xcd * (q + 1) : r * (q + 1) + (xcd - r) * q) + off; }
        const int pm = wgid / npn, pnl = wgid % npn; int e = 0;
#pragma unroll
        for (int k = 1; k < 16; ++k) e += (toff[k] <= pm) ? 1 : 0;
        u.pm = pm; u.pn = e * npn + pnl; return true;
    }
    __device__ __forceinline__ void a_ready(const pg8::Unit&) const {}
    __device__ __forceinline__ void done(const pg8::Unit&) const {}
};

#define XB_TMO      128
#define XB_XCNT(j)  (256  + 64 * (j))
#define XB_XSUB(j)  (1280 + 64 * (j))
#define XB_XGEN(j)  (2304 + 64 * (j))
#define XB_TOP      3328
#define XB_TOPGEN   3392
#define XCD_BAR_WORDS 3456
#define XB_SPIN_CAP (1u << 18)

__device__ __forceinline__ unsigned xb_ld(unsigned* p)              { return __hip_atomic_load(p, __ATOMIC_RELAXED, __HIP_MEMORY_SCOPE_AGENT); }
__device__ __forceinline__ unsigned xb_add(unsigned* p, unsigned v) { return __hip_atomic_fetch_add(p, v, __ATOMIC_RELAXED, __HIP_MEMORY_SCOPE_AGENT); }
__device__ __forceinline__ unsigned xb_xcc_id() { return (unsigned)__builtin_amdgcn_s_getreg((3 << 11) | 20) & 0xFu; }
#define XB_SPIN(cond, bar) do { unsigned _sp = 0; while (cond) { __builtin_amdgcn_s_sleep(1); \
    if ((++_sp & 255u) == 0u) { if (xb_ld(&(bar)[XB_TMO])) break; if (_sp > XB_SPIN_CAP) { atomicAdd(&(bar)[XB_TMO], 1u); break; } } } } while (0)

struct XcdBarrier {
    unsigned* bar; unsigned x;
    volatile LAS unsigned* st;
};

__device__ __forceinline__ XcdBarrier xcd_barrier_post(unsigned* bar, volatile LAS unsigned* st, int tid) {
    XcdBarrier b; b.bar = bar; b.x = xb_xcc_id(); b.st = st;
    if (tid == 0) (void)xb_add(&bar[XB_XCNT(b.x)], 1u);
    return b;
}
__device__ __forceinline__ void xcd_barrier_complete(unsigned* bar, unsigned x, unsigned& nloc, unsigned& nx) {
    const unsigned G = gridDim.x * gridDim.y * gridDim.z;
    unsigned sum, cnt, mine, sp = 0u;
    for (;;) {
        sum = 0u; cnt = 0u; mine = 0u;
#pragma unroll
        for (unsigned j = 0; j < 16; ++j) { const unsigned c = xb_ld(&bar[XB_XCNT(j)]); sum += c; cnt += (c > 0u) ? 1u : 0u; mine = (j == x) ? c : mine; }
        if (sum == G) break;
        __builtin_amdgcn_s_sleep(1);
        if ((++sp & 255u) == 0u) { if (xb_ld(&bar[XB_TMO])) break; if (sp > XB_SPIN_CAP) { atomicAdd(&bar[XB_TMO], 1u); break; } }
    }
    nloc = mine > 0u ? mine : 1u; nx = cnt > 0u ? cnt : 1u;
}

__device__ __forceinline__ void xcd_barrier(const XcdBarrier& b, int tid) {
    asm volatile("s_waitcnt vmcnt(0)" ::: "memory");
    __syncthreads();
    if (tid == 0) {
        unsigned* bar = b.bar;
        __builtin_amdgcn_s_waitcnt(0);
        unsigned nloc = b.st[0], nx = b.st[1];
        if (nloc == 0u) { xcd_barrier_complete(bar, b.x, nloc, nx); b.st[0] = nloc; b.st[1] = nx; }
        const unsigned old = xb_add(&bar[XB_XSUB(b.x)], 1u);
        const unsigned gen = old / nloc;
        if (old + 1u == (gen + 1u) * nloc) {
            __builtin_amdgcn_fence(__ATOMIC_RELEASE, "agent");
            asm volatile("s_waitcnt vmcnt(0)" ::: "memory");
            const unsigned og = xb_add(&bar[XB_TOP], 1u);
            const unsigned tg = og / nx;
            if (og + 1u == (tg + 1u) * nx) xb_add(&bar[XB_TOPGEN], 1u);
            else XB_SPIN(xb_ld(&bar[XB_TOPGEN]) == tg, bar);
            __builtin_amdgcn_fence(__ATOMIC_ACQUIRE, "agent");
            xb_add(&bar[XB_XGEN(b.x)], 1u);
            asm volatile("s_waitcnt vmcnt(0)" ::: "memory");
        } else {
            XB_SPIN(xb_ld(&bar[XB_XGEN(b.x)]) == gen, bar);
            __builtin_amdgcn_fence(__ATOMIC_ACQUIRE, "agent");
            asm volatile("s_waitcnt vmcnt(0)" ::: "memory");
        }
    }
    __syncthreads();
}

struct Args {
    const float* in[28]; float* out; unsigned char* ws; int ph_lo, ph_hi, li, pad;
};
struct Ctx {
    LAS unsigned char* lds; unsigned char* ws;
    int tid, lane, wave, G, bid;
};
#define CTLP(F) ((unsigned*)((F).ws + WS_CTL))
#define MISCP(F) ((LAS int*)((F).lds + MISC_OFF))
#define GWID(F) ((F).bid * NWAVES + (F).wave)
#define NGW(F) ((F).G * NWAVES)
enum { I_X = 0, I_C, I_CTX, I_CCTX, I_ADAW, I_ADAB, I_LNG, I_LNB, I_ABWIN, I_ABWOUT, I_IGB, I_FGB, I_MNG, I_CONVW, I_CONVB, I_DTB, I_ALOG, I_SSMD, I_SNG,
       I_ATWIN, I_ATWOUT, I_QG, I_KG, I_RW, I_RB, I_WG, I_WU, I_WD };
constexpr int RING_BYTES = 131072, MISC_OFF = RING_BYTES, LDS_BYTES = RING_BYTES + 12288;

template <class Src> __device__ __forceinline__ void transpose_item(const Src& S, bf16_t* WT, int K, int orow0, int k0, LAS float* scr, int lane, float scale) {
#pragma unroll 8
    for (int i = 0; i < 32; ++i) { const int kk = 2 * i + (lane >> 5); scr[kk * 33 + (lane & 31)] = S.ld(k0 + kk, lane & 31); }
    asm volatile("s_waitcnt lgkmcnt(0)" ::: "memory");
    const int c = lane & 7;
#pragma unroll
    for (int j = 0; j < 4; ++j) { const int n = (lane >> 3) + 8 * j; const LAS float* s = scr + (8 * c) * 33 + S.scol(n);
        u32x4 o; o.x = pk2(s[0 * 33] * scale, s[1 * 33] * scale); o.y = pk2(s[2 * 33] * scale, s[3 * 33] * scale); o.z = pk2(s[4 * 33] * scale, s[5 * 33] * scale); o.w = pk2(s[6 * 33] * scale, s[7 * 33] * scale);
        *(u32x4*)(WT + (size_t)(orow0 + n) * K + k0 + 8 * c) = o; }
    asm volatile("s_waitcnt lgkmcnt(0)" ::: "memory");
}
struct SrcPlain { const float* W; int N; int n0;
    __device__ __forceinline__ float ld(int k, int j) const { return W[(size_t)k * N + n0 + j]; }
    __device__ __forceinline__ int scol(int n) const { return n; } };
struct SrcGU { const float* Wg; const float* Wu; int c0;
    __device__ __forceinline__ float ld(int k, int j) const { return (j < 16 ? Wg : Wu)[(size_t)k * 1024 + c0 + (j & 15)]; }
    __device__ __forceinline__ int scol(int n) const { const int b4 = n >> 3, w = n & 7; return (w < 4 ? 0 : 16) + 4 * b4 + (w & 3); } };

__device__ __forceinline__ void convert_small_weights(Ctx& F, const Args& a) {
    LAS float* scr = (LAS float*)(F.lds + F.wave * 16384);
    bf16_t* WinT = (bf16_t*)(F.ws + WS_WIN); bf16_t* WoutT = (bf16_t*)(F.ws + WS_WOUT); bf16_t* AtInT = (bf16_t*)(F.ws + WS_ATIN); bf16_t* AtOutT = (bf16_t*)(F.ws + WS_ATOUT);
    constexpr int I0 = 16 * (NWIN / 32), I1 = 32 * 32, I2 = 16 * 48, I3 = 16 * 32, NI = I0 + I1 + I2 + I3;
    for (int it = GWID(F); it < NI; it += NGW(F)) {
        int r = it;
        if (r < I0) { const int kb = r / (NWIN / 32), nb = r % (NWIN / 32), n0 = 32 * nb; SrcPlain S{a.in[I_ABWIN], ABIN, n0 < 3072 ? n0 : n0 + 16};
            transpose_item(S, WinT, 1024, n0, 64 * kb, scr, F.lane, n0 < 512 ? 0.08838834764831845f : 1.f); continue; } r -= I0;
        if (r < I1) { const int kb = r / 32, nb = r % 32; SrcPlain S{a.in[I_ABWOUT], 1024, 32 * nb}; transpose_item(S, WoutT, 2048, 32 * nb, 64 * kb, scr, F.lane, 1.f); continue; } r -= I1;
        if (r < I2) { const int kb = r / 48, nb = r % 48; SrcPlain S{a.in[I_ATWIN], 1536, 32 * nb}; transpose_item(S, AtInT, 1024, 32 * nb, 64 * kb, scr, F.lane, 1.f); continue; } r -= I2;
        { const int kb = r / 32, nb = r % 32; SrcPlain S{a.in[I_ATWOUT], 1024, 32 * nb}; transpose_item(S, AtOutT, 1024, 32 * nb, 64 * kb, scr, F.lane, 1.f); }
    }
    float* GW = (float*)(F.ws + WS_GW);
    for (int i = F.bid * NTHREADS + F.tid; i < 1024 * NGATE; i += F.G * NTHREADS) { const int k = i / NGATE, j = i % NGATE; GW[i] = a.in[I_ABWIN][(size_t)k * ABIN + (j < 16 ? 3072 + j : 5648 + (j - 16))]; }
}
__device__ __forceinline__ void convert_moe_weights(Ctx& F, const Args& a, int layer) {
    LAS float* scr = (LAS float*)(F.lds + F.wave * 16384);
    bf16_t* WGU = (bf16_t*)(F.ws + WS_MOEW); bf16_t* WD = (bf16_t*)(F.ws + WS_MOEW + 64 * MiB);
    const size_t wl = (size_t)layer * 16 * 1024 * 1024;
    constexpr int IGU = 16 * 16 * 64, IDN = 16 * 16 * 32;
    for (int it = GWID(F); it < IGU + IDN; it += NGW(F)) {
        if (it < IGU) { const int e = it / 1024, r = it % 1024, kb = r / 64, nb = r % 64;
            SrcGU S{a.in[I_WG] + wl + (size_t)e * 1048576, a.in[I_WU] + wl + (size_t)e * 1048576, 16 * nb};
            transpose_item(S, WGU + (size_t)e * 2048 * 1024, 1024, 32 * nb, 64 * kb, scr, F.lane, 1.f); }
        else { const int r0 = it - IGU, e = r0 / 512, r = r0 % 512, kb = r / 32, nb = r % 32;
            SrcPlain S{a.in[I_WD] + wl + (size_t)e * 1048576, 1024, 32 * nb};
            transpose_item(S, WD + (size_t)e * 1024 * 1024, 1024, 32 * nb, 64 * kb, scr, F.lane, 1.f); }
    }
}
__device__ __forceinline__ void ada_phase(Ctx& F, const Args& a) {
    LAS float* red = (LAS float*)(F.lds + 8 * 16384);
    float* modv = (float*)(F.ws + WS_MODV);
    for (int item = F.bid; item < 2 * 96; item += F.G) {
        const int l = item / 96, n = (item % 96) * 64 + F.lane;
        float a0 = 0.f, a1 = 0.f, a2 = 0.f;
        const float* w = a.in[I_ADAW] + ((size_t)l * 1024 + F.wave * 128) * 6144 + n;
#pragma unroll 16
        for (int k = 0; k < 128; ++k) { const float wv = w[(size_t)k * 6144]; const int kk = F.wave * 128 + k;
            a0 += siluf(a.in[I_C][kk]) * wv; a1 += siluf(a.in[I_C][1024 + kk]) * wv; a2 += siluf(a.in[I_CCTX][kk]) * wv; }
        LAS float* rr = (LAS float*)F.lds;
        rr[(F.wave * 3 + 0) * 64 + F.lane] = a0; rr[(F.wave * 3 + 1) * 64 + F.lane] = a1; rr[(F.wave * 3 + 2) * 64 + F.lane] = a2;
        __syncthreads();
        if (F.wave < 3) { float s = 0.f;
#pragma unroll
            for (int w8 = 0; w8 < 8; ++w8) s += rr[(w8 * 3 + F.wave) * 64 + F.lane];
            modv[(l * 3 + F.wave) * 6144 + n] = s + a.in[I_ADAB][l * 6144 + n]; }
        __syncthreads();
    }
    (void)red;
}

template <int NC> __device__ __forceinline__ void row_dots(const RowF& h, const float* W, int lane, float (&acc)[NC]) {
#pragma unroll
    for (int i = 0; i < NC; ++i) acc[i] = 0.f;
#pragma unroll
    for (int j = 0; j < 4; ++j)
#pragma unroll
        for (int e = 0; e < 4; ++e) { const float x = h.v[j][e]; const f32x4* w = (const f32x4*)(W + (size_t)(4 * lane + 256 * j + e) * NC);
#pragma unroll
            for (int q = 0; q < NC / 4; ++q) { const f32x4 wv = w[q]; acc[4 * q + 0] += x * wv[0]; acc[4 * q + 1] += x * wv[1]; acc[4 * q + 2] += x * wv[2]; acc[4 * q + 3] += x * wv[3]; } }
}
template <int O, int N> __device__ __forceinline__ void xreduce_step(float (&acc)[N], int lane) {
    const bool up = (lane & O) != 0;
#pragma unroll
    for (int i = 0; i < O; ++i) { const float keep = up ? acc[i + O] : acc[i], send = up ? acc[i] : acc[i + O]; acc[i] = keep + __shfl_xor(send, O); }
}
template <int N> __device__ __forceinline__ float xreduce(float (&acc)[N], int lane) {
    if constexpr (N == 16) {
#pragma unroll
        for (int i = 0; i < 16; ++i) { acc[i] += __shfl_xor(acc[i], 32); acc[i] += __shfl_xor(acc[i], 16); }
    }
    if constexpr (N == 64) { xreduce_step<32, N>(acc, lane); xreduce_step<16, N>(acc, lane); }
    xreduce_step<8, N>(acc, lane); xreduce_step<4, N>(acc, lane); xreduce_step<2, N>(acc, lane); xreduce_step<1, N>(acc, lane);
    return acc[0];
}

__device__ __forceinline__ void rowpass_a(Ctx& F, const Args& a) {
    const float* modv = (const float*)(F.ws + WS_MODV); const float* GW = (const float*)(F.ws + WS_GW);
    bf16_t* HB = (bf16_t*)(F.ws + WS_HB); float* GATES = (float*)(F.ws + WS_GATES);
    for (int row = GWID(F); row < NTOK; row += NGW(F)) {
        const float* src = row < NLAT ? a.in[I_X] + (size_t)row * D : a.in[I_CTX] + (size_t)(row - NLAT) * D;
        const float* m = modv + mod_index(row) * 6144;
        const RowF x = row_ld_f32(src, F.lane); const RowF h = row_modulate(x, m, m + 1024, F.lane);
        row_st_bf16(HB + (size_t)row * D, F.lane, h);
        float acc[64];
        { float a48[NGATE]; row_dots<NGATE>(h, GW, F.lane, a48);
#pragma unroll
          for (int i = 0; i < 64; ++i) acc[i] = i < NGATE ? a48[i] : 0.f; }
        float t = xreduce<64>(acc, F.lane);
        const int l = F.lane;
        if (l < 8) t = t + a.in[I_IGB][l];
        else if (l < 16) t = logsigf(t + a.in[I_FGB][l - 8]);
        else if (l < 48) t = softplusf(t + a.in[I_DTB][l - 16]);
        if (l < NGATE) GATES[(size_t)row * NGATE + l] = t;
    }
}

__device__ __forceinline__ void route_row(const RowF& h2, const float* rw, const float* rb, int lane, int& e0, int& e1, float& g0, float& g1) {
    float acc[16]; row_dots<16>(h2, rw, lane, acc);
    const float logit = xreduce<16>(acc, lane);
    float mx = logit;
#pragma unroll
    for (int o = 8; o >= 1; o >>= 1) mx = fmaxf(mx, __shfl_xor(mx, o));
    const float ex = expf(logit - mx); float sm = ex;
#pragma unroll
    for (int o = 8; o >= 1; o >>= 1) sm += __shfl_xor(sm, o);
    const float p = ex / sm, sel = p + rb[lane & 15];
    float s4[4], p4[4];
#pragma unroll
    for (int i = 0; i < 4; ++i) s4[i] = __shfl(sel, (lane & 12) + i);
    float v1 = s4[0]; int i1 = 0;
#pragma unroll
    for (int i = 1; i < 4; ++i) if (s4[i] > v1) { v1 = s4[i]; i1 = i; }
    float v2 = -1e30f;
#pragma unroll
    for (int i = 0; i < 4; ++i) if (i != i1 && s4[i] > v2) v2 = s4[i];
    const float gs = v1 + v2;
    float best = __shfl(gs, 0); int bg = 0;
#pragma unroll
    for (int g = 1; g < 4; ++g) { const float t = __shfl(gs, 4 * g); if (t > best) { best = t; bg = g; } }
#pragma unroll
    for (int i = 0; i < 4; ++i) { s4[i] = __shfl(sel, 4 * bg + i); p4[i] = __shfl(p, 4 * bg + i); }
    v1 = s4[0]; i1 = 0; float q1 = p4[0];
#pragma unroll
    for (int i = 1; i < 4; ++i) if (s4[i] > v1) { v1 = s4[i]; i1 = i; q1 = p4[i]; }
    v2 = -1e30f; int i2 = 0; float q2 = 0.f;
#pragma unroll
    for (int i = 0; i < 4; ++i) if (i != i1 && s4[i] > v2) { v2 = s4[i]; i2 = i; q2 = p4[i]; }
    e0 = 4 * bg + i1; e1 = 4 * bg + i2; const float s = q1 + q2; g0 = q1 / s; g1 = q2 / s;
}
__device__ __forceinline__ void rowpass_b(Ctx& F, const Args& a, int layer, int nrows, const bf16_t* YB) {
    const float* modl = (const float*)(F.ws + WS_MODV) + layer * 3 * 6144;
    float* XL = (float*)(F.ws + WS_XL); bf16_t* HB = (bf16_t*)(F.ws + WS_HB);
    int* tok_e = (int*)(F.ws + WS_ROUTE); int* tok_pos = tok_e + 2 * NTOK; float* tok_g = (float*)(tok_pos + 2 * NTOK);
    unsigned* cnt = CTLP(F) + (layer ? CW_CNT1 : CW_CNT0);
    for (int row = GWID(F); row < nrows; row += NGW(F)) {
        const float* m = modl + mod_index(row) * 6144;
        const float* src = layer ? XL + (size_t)row * D : (row < NLAT ? a.in[I_X] + (size_t)row * D : a.in[I_CTX] + (size_t)(row - NLAT) * D);
        RowF x = row_ld_f32(src, F.lane); const RowF y = row_ld_bf16(YB + (size_t)row * D, F.lane); const RowF gt = row_ld_f32(m + 2048, F.lane);
#pragma unroll
        for (int j = 0; j < 4; ++j) x.v[j] = ALPHA * x.v[j] + gt.v[j] * y.v[j];
        row_layernorm(x, a.in[I_LNG] + (layer * 2) * D, a.in[I_LNB] + (layer * 2) * D, F.lane);
        row_st_f32(XL + (size_t)row * D, F.lane, x);
        const RowF h2 = row_modulate(x, m + 3072, m + 4096, F.lane);
        row_st_bf16(HB + (size_t)row * D, F.lane, h2);
        int e0, e1; float g0, g1; route_row(h2, a.in[I_RW], a.in[I_RB], F.lane, e0, e1, g0, g1);
        if (F.lane == 0) {
            const int p0 = (int)atomicAdd(cnt + e0, 1u), p1 = (int)atomicAdd(cnt + e1, 1u);
            tok_e[row * 2] = e0; tok_e[row * 2 + 1] = e1; tok_pos[row * 2] = p0; tok_pos[row * 2 + 1] = p1; tok_g[row * 2] = g0; tok_g[row * 2 + 1] = g1;
        }
    }
}
__device__ __forceinline__ void moe_offsets(Ctx& F, int layer) {
    __syncthreads();
    if (F.tid == 0) { const unsigned* cnt = CTLP(F) + (layer ? CW_CNT1 : CW_CNT0); int acc = 0;
        for (int e = 0; e < 16; ++e) { MISCP(F)[e] = acc; acc += ((int)__hip_atomic_load(cnt + e, __ATOMIC_RELAXED, __HIP_MEMORY_SCOPE_AGENT) + 255) >> 8; }
        MISCP(F)[16] = acc; }
    __syncthreads();
}
__device__ __forceinline__ void moe_scatter(Ctx& F, int layer, int nrows) {
    moe_offsets(F, layer);
    const bf16_t* HB = (const bf16_t*)(F.ws + WS_HB); bf16_t* XS = (bf16_t*)(F.ws + WS_XS);
    const int* tok_e = (const int*)(F.ws + WS_ROUTE); const int* tok_pos = tok_e + 2 * NTOK; int* tok_slot = (int*)(F.ws + WS_ROUTE + MiB);
    for (int row = GWID(F); row < nrows; row += NGW(F)) {
        const int e0 = tok_e[row * 2], e1 = tok_e[row * 2 + 1];
        const int s0 = MISCP(F)[e0] * 256 + tok_pos[row * 2], s1 = MISCP(F)[e1] * 256 + tok_pos[row * 2 + 1];
        const u32x4* src = (const u32x4*)(HB + (size_t)row * D) + F.lane; const u32x4 v0 = src[0], v1 = src[64];
        u32x4* d0 = (u32x4*)(XS + (size_t)s0 * D) + F.lane; u32x4* d1 = (u32x4*)(XS + (size_t)s1 * D) + F.lane;
        d0[0] = v0; d0[64] = v1; d1[0] = v0; d1[64] = v1;
        if (F.lane == 0) { tok_slot[row * 2] = s0; tok_slot[row * 2 + 1] = s1; }
    }
}
__device__ __forceinline__ void rowpass_c(Ctx& F, const Args& a, int layer, int nrows, bool last) {
    const float* modl = (const float*)(F.ws + WS_MODV) + layer * 3 * 6144;
    float* XL = (float*)(F.ws + WS_XL); bf16_t* HB = (bf16_t*)(F.ws + WS_HB); const bf16_t* YS = (const bf16_t*)(F.ws + WS_YS);
    const float* tok_g = (const float*)(F.ws + WS_ROUTE) + 4 * NTOK; const int* tok_slot = (const int*)(F.ws + WS_ROUTE + MiB);
    for (int row = GWID(F); row < nrows; row += NGW(F)) {
        const float* m = modl + mod_index(row) * 6144;
        RowF x = row_ld_f32(XL + (size_t)row * D, F.lane);
        const RowF y0 = row_ld_bf16(YS + (size_t)tok_slot[row * 2] * D, F.lane), y1 = row_ld_bf16(YS + (size_t)tok_slot[row * 2 + 1] * D, F.lane);
        const float g0 = tok_g[row * 2], g1 = tok_g[row * 2 + 1]; const RowF gt = row_ld_f32(m + 5120, F.lane);
#pragma unroll
        for (int j = 0; j < 4; ++j) x.v[j] = ALPHA * x.v[j] + gt.v[j] * (g0 * y0.v[j] + g1 * y1.v[j]);
        row_layernorm(x, a.in[I_LNG] + (layer * 2 + 1) * D, a.in[I_LNB] + (layer * 2 + 1) * D, F.lane);
        if (last) { row_st_f32(a.out + (size_t)row * D, F.lane, x); }
        else { row_st_f32(XL + (size_t)row * D, F.lane, x); const float* m1 = modl + 3 * 6144 + mod_index(row) * 6144;
            const RowF h = row_modulate(x, m1, m1 + 1024, F.lane); row_st_bf16(HB + (size_t)row * D, F.lane, h); }
    }
}

template <class Epi, class Sched> __device__ __forceinline__ void run_gemm(Ctx& F, const bf16_t* A, const bf16_t* Bt, int M, int N, int K, const Sched& S, const Epi& E) {
    pg8::Gemm g{A, Bt, M, N, K};
    pg8::gemm_phase<Epi, Sched, true, true>(F.lds, g, S, E, F.wave * 64 + fresh_lane());
    __syncthreads();
}

__device__ __forceinline__ void qkprep_phase(Ctx& F, const Args& a) {
    bf16_t* Q = (bf16_t*)(F.ws + WS_Q); bf16_t* KB = (bf16_t*)(F.ws + WS_KB);
    constexpr int NQ = NLAT * 8, NK = NBATCH * SLEN * 2;
    const float qg0 = a.in[I_QG][F.lane], qg1 = a.in[I_QG][F.lane + 64], kg0 = a.in[I_KG][F.lane], kg1 = a.in[I_KG][F.lane + 64];
    const float invf = expf(-(float)(F.lane & 31) * (9.210340371976184f / 32.f));
    for (int it = GWID(F); it < NQ + NK; it += NGW(F)) {
        bf16_t* p; int t; bool rope; float g0, g1;
        if (it < NQ) { const int row = it >> 3, hh = it & 7; p = Q + (size_t)row * 1024 + hh * 128; t = row % SEQ; rope = true; g0 = qg0; g1 = qg1; }
        else { const int r = it - NQ, krow = r >> 1, kvh = r & 1, key = krow % SLEN; p = KB + (size_t)krow * 256 + kvh * 128; rope = key >= CTXL; t = key - CTXL; g0 = kg0; g1 = kg1; }
        float x1 = bf2f(p[F.lane]), x2 = bf2f(p[F.lane + 64]);
        const float r = rsqrtf(wave_sum(x1 * x1 + x2 * x2) * (1.f / 128.f) + 1e-6f);
        x1 *= r * g0; x2 *= r * g1;
        float o1 = x1, o2 = x2;
        if (rope) { const float pos = (F.lane < 32) ? (float)(t / 64) : (float)(t % 64); float sn, cs; sincosf(pos * invf, &sn, &cs); o1 = x1 * cs - x2 * sn; o2 = x2 * cs + x1 * sn; }
        p[F.lane] = f2bf(o1); p[F.lane + 64] = f2bf(o2);
    }
}
__device__ __forceinline__ void attn_phase(Ctx& F) {
    const bf16_t* Q = (const bf16_t*)(F.ws + WS_Q); const bf16_t* KB = (const bf16_t*)(F.ws + WS_KB); const bf16_t* VB = (const bf16_t*)(F.ws + WS_VB); bf16_t* AO = (bf16_t*)(F.ws + WS_AO);
    for (int i = 0;; ++i) {
        const int L = i * F.G + F.bid; if (L >= 512) break;
        const int xcd = L & 7, off = L >> 3, combo = xcd >> 1, idx = (xcd & 1) * 64 + off, hl = idx >> 5, qb = idx & 31;
        const int b = combo >> 1, kvh = combo & 1, h = kvh * 4 + hl;
        const size_t qoff = ((size_t)b * SEQ + qb * 256) * 1024 + h * 128, koff = (size_t)b * SLEN * 256 + kvh * 128;
        attn::attn_dense_body<attn::bf16>(Q + qoff, KB + koff, VB + koff, AO + qoff, SLEN, (char*)F.lds, F.wave * 64 + fresh_lane());
        __syncthreads();
    }
}

typedef short v4i16_t __attribute__((ext_vector_type(4)));
typedef const LAS unsigned char* lds_cptr;
constexpr float LOG2E = 1.4426950408889634f;
__device__ __forceinline__ s16x4 vtr(lds_cptr p) { return __builtin_bit_cast(s16x4, __builtin_amdgcn_ds_read_tr16_b64_v4i16((LAS v4i16_t*)p)); }
__device__ __forceinline__ bf16x8 trfrag(lds_cptr tb, int d0, int ks) {
    const s16x4 l = vtr(tb + attn::v_rd_off(d0, ks, 0)), h = vtr(tb + attn::v_rd_off(d0, ks, 1));
    return (bf16x8){l[0], l[1], l[2], l[3], h[0], h[1], h[2], h[3]}; }
__device__ __forceinline__ bf16x8 rowfrag(lds_cptr tile, int blk, int d0, int r32, int hi) { return *(const LAS bf16x8*)(tile + KSWZ(32 * blk + r32, (d0 * 16 + hi * 8) * 2)); }
__device__ __forceinline__ u32x4 scale8(u32x4 v, float s) { u32x4 o;
#pragma unroll
    for (int i = 0; i < 4; ++i) o[i] = pk2(__uint_as_float(v[i] << 16) * s, __uint_as_float(v[i] & 0xffff0000u) * s);
    return o; }
__device__ __forceinline__ bf16x8 scale8f(bf16x8 v, float s) { return __builtin_bit_cast(bf16x8, scale8(__builtin_bit_cast(u32x4, v), s)); }
__device__ __forceinline__ float wave_incl_sum(float v, int lane) {
#pragma unroll
    for (int o = 1; o < 64; o <<= 1) { const float t = __shfl_up(v, o); if (lane >= o) v += t; }
    return v; }
__device__ __forceinline__ float wave_incl_max(float v, int lane) {
#pragma unroll
    for (int o = 1; o < 64; o <<= 1) { const float t = __shfl_up(v, o); if (lane >= o) v = fmaxf(v, t); }
    return v; }
__device__ __forceinline__ float wave_incl_max_rev(float v, int lane) {
#pragma unroll
    for (int o = 1; o < 64; o <<= 1) { const float t = __shfl_down(v, o); if (lane + o < 64) v = fmaxf(v, t); }
    return v; }
__device__ __forceinline__ float wave_max(float v) {
#pragma unroll
    for (int o = 1; o < 64; o <<= 1) v = fmaxf(v, __shfl_xor(v, o));
    return v; }
__device__ __forceinline__ float half_swap_add(float v) { auto rr = __builtin_amdgcn_permlane32_swap(__float_as_uint(v), __float_as_uint(v), false, false); return __uint_as_float(rr[0]) + __uint_as_float(rr[1]); }
#define MX_PK4(P, BASE, OUT) do { unsigned a0_ = pk2(P[BASE + 0], P[BASE + 1]), a1_ = pk2(P[BASE + 2], P[BASE + 3]); \
    unsigned b0_ = pk2(P[BASE + 4], P[BASE + 5]), b1_ = pk2(P[BASE + 6], P[BASE + 7]); \
    auto r0_ = __builtin_amdgcn_permlane32_swap(a0_, b0_, false, false); auto r1_ = __builtin_amdgcn_permlane32_swap(a1_, b1_, false, false); \
    u32x4 w_ = {r0_[0], r1_[0], r0_[1], r1_[1]}; OUT = __builtin_bit_cast(bf16x8, w_); } while (0)

__device__ __forceinline__ const bf16_t* launder_v(const bf16_t* p) { asm volatile("" : "+v"(p)); return p; }
constexpr int MX_MISC = MISC_OFF + 1024;

__device__ __forceinline__ void conv_phase(Ctx& F, const Args& a) {
    const bf16_t* XBC = (const bf16_t*)(F.ws + WS_XBC); bf16_t* XC = (bf16_t*)(F.ws + WS_XC);
    const float* cw = a.in[I_CONVW]; const float* cb = a.in[I_CONVB];
    for (int it = F.bid * NTHREADS + F.tid; it < NTOK * 192; it += F.G * NTHREADS) {
        const int row = it / 192, c8 = (it % 192) * 8;
        int t, base, len;
        if (row < NLAT) { t = row % SEQ; base = row - t; len = SEQ; } else { const int r = row - NLAT; t = r % CTXL; base = row - t; len = CTXL; }
        float acc[8];
        { const f32x4 b0 = *(const f32x4*)(cb + c8), b1 = *(const f32x4*)(cb + c8 + 4); acc[0] = b0[0]; acc[1] = b0[1]; acc[2] = b0[2]; acc[3] = b0[3]; acc[4] = b1[0]; acc[5] = b1[1]; acc[6] = b1[2]; acc[7] = b1[3]; }
#pragma unroll
        for (int j = 0; j < 4; ++j) { const int tt = t - 2 + j;
            if (tt >= 0 && tt < len) { const u32x4 v = *(const u32x4*)(XBC + (size_t)(base + tt) * 1536 + c8); const f32x4 w0 = *(const f32x4*)(cw + j * 1536 + c8), w1 = *(const f32x4*)(cw + j * 1536 + c8 + 4);
                acc[0] += w0[0] * __uint_as_float(v[0] << 16); acc[1] += w0[1] * __uint_as_float(v[0] & 0xffff0000u); acc[2] += w0[2] * __uint_as_float(v[1] << 16); acc[3] += w0[3] * __uint_as_float(v[1] & 0xffff0000u);
                acc[4] += w1[0] * __uint_as_float(v[2] << 16); acc[5] += w1[1] * __uint_as_float(v[2] & 0xffff0000u); acc[6] += w1[2] * __uint_as_float(v[3] << 16); acc[7] += w1[3] * __uint_as_float(v[3] & 0xffff0000u); } }
        u32x4 o; o[0] = pk2(siluf(acc[0]), siluf(acc[1])); o[1] = pk2(siluf(acc[2]), siluf(acc[3])); o[2] = pk2(siluf(acc[4]), siluf(acc[5])); o[3] = pk2(siluf(acc[6]), siluf(acc[7]));
        *(u32x4*)(XC + (size_t)row * 1536 + c8) = o;
    }
}

struct MlGate { float b0, b1, G0, G1, total; };
__device__ __forceinline__ MlGate ml_gate(const float* GATES, int row0, int dir, int h, int lane) {
    const float* g0 = GATES + (size_t)(row0 + 2 * lane) * NGATE; const float* g1 = g0 + NGATE;
    const float lf0 = g0[8 + dir * 4 + h], lf1 = g1[8 + dir * 4 + h], ig0 = g0[dir * 4 + h], ig1 = g1[dir * 4 + h];
    const float incl = wave_incl_sum(lf0 + lf1, lane), total = __shfl(incl, 63);
    MlGate r; r.total = total;
    if (dir == 0) { r.b0 = incl - lf1; r.b1 = incl; } else { r.b0 = total - incl + lf0 + lf1; r.b1 = total - incl + lf1; }
    r.G0 = ig0 - r.b0; r.G1 = ig1 - r.b1; return r;
}

__device__ __forceinline__ void mlstm_a_phase(Ctx& F) {
    const bf16_t* QK = (const bf16_t*)(F.ws + WS_QK); const bf16_t* V = (const bf16_t*)(F.ws + WS_V); const float* GATES = (const float*)(F.ws + WS_GATES);
    bf16_t* DC = (bf16_t*)(F.ws + WS_DC); float* DN = (float*)(F.ws + WS_DN); float* MS = (float*)(F.ws + WS_MS);
    LAS unsigned char* Vt = F.lds; LAS unsigned char* Kw = F.lds + 65536;
    LAS float* wsc = (LAS float*)(F.lds + MX_MISC); LAS float* dnp = (LAS float*)(F.lds + MX_MISC + 1024);
    for (int u = F.bid; u < 528; u += F.G) {
        const int lane = fresh_lane(), tid = F.wave * 64 + lane, r32 = lane & 31, hi = lane >> 5, sr = tid >> 4, sc8 = (tid & 15) * 8, rdb = attn::v_rd_base(lane);
        const int b = u / 264, rem = u % 264, cid = rem >> 2, h = rem & 3, row0 = chunk_row0(b, cid);
        if (F.wave < 2) { const int dir = F.wave; const MlGate g = ml_gate(GATES, row0, dir, h, lane);
            const float gm = wave_max(fmaxf(g.G0, g.G1));
            wsc[dir * 128 + 2 * lane] = expf(g.G0 - gm); wsc[dir * 128 + 2 * lane + 1] = expf(g.G1 - gm);
            if (lane == 0) { const int chain = (b * 4 + h) * 2 + dir; MS[(chain * NCH + cid) * 4 + 0] = g.total; MS[(chain * NCH + cid) * 4 + 1] = g.total + gm; } }
        __syncthreads();
        float dnacc[2][8];
#pragma unroll
        for (int d = 0; d < 2; ++d)
#pragma unroll
            for (int e = 0; e < 8; ++e) dnacc[d][e] = 0.f;
#pragma unroll
        for (int i = 0; i < 4; ++i) { const int s = sr + 32 * i; const size_t grow = (size_t)(row0 + s) * 1024;
#pragma unroll
            for (int vb = 0; vb < 2; ++vb) { const u32x4 v = *(const u32x4*)(V + grow + h * 256 + vb * 128 + sc8); *(LAS u32x4*)(Vt + ((s >> 6) * 2 + vb) * 16384 + attn::v_st(s & 63, sc8)) = v; }
            const u32x4 kv = *(const u32x4*)(QK + grow + 512 + h * 128 + sc8);
#pragma unroll
            for (int d = 0; d < 2; ++d) { const float w = wsc[d * 128 + s];
                *(LAS u32x4*)(Kw + (d * 2 + (s >> 6)) * 16384 + attn::v_st(s & 63, sc8)) = scale8(kv, w);
#pragma unroll
                for (int e = 0; e < 4; ++e) { dnacc[d][2 * e] += w * __uint_as_float(kv[e] << 16); dnacc[d][2 * e + 1] += w * __uint_as_float(kv[e] & 0xffff0000u); } } }
#pragma unroll
        for (int d = 0; d < 2; ++d)
#pragma unroll
            for (int e = 0; e < 8; ++e) { float t = dnacc[d][e]; t += __shfl_xor(t, 16); t += __shfl_xor(t, 32); if ((lane >> 4) == 0) dnp[(F.wave * 2 + d) * 128 + sc8 + e] = t; }
        __syncthreads();
        {   const int dir = F.wave >> 2, vq = F.wave & 3;
            f32x16 acc[2][4];
#pragma unroll
            for (int i = 0; i < 2; ++i)
#pragma unroll
                for (int n = 0; n < 4; ++n) acc[i][n] = f32x16{};
#pragma unroll
            for (int ks = 0; ks < 8; ++ks) { const int sblk = ks >> 2, KS = ks & 3;
                bf16x8 af[2], bfr[4];
#pragma unroll
                for (int i = 0; i < 2; ++i) af[i] = trfrag(Vt + (sblk * 2 + (vq >> 1)) * 16384 + rdb, (2 * vq + i) & 3, KS);
#pragma unroll
                for (int n = 0; n < 4; ++n) bfr[n] = trfrag(Kw + (dir * 2 + sblk) * 16384 + rdb, n, KS);
#pragma unroll
                for (int i = 0; i < 2; ++i)
#pragma unroll
                    for (int n = 0; n < 4; ++n) acc[i][n] = __builtin_amdgcn_mfma_f32_32x32x16_bf16(af[i], bfr[n], acc[i][n], 0, 0, 0); }
            const int chain = (b * 4 + h) * 2 + dir;
            bf16_t* dst = DC + ((size_t)(chain * NCH + cid) * 256 + 64 * vq) * 128;
#pragma unroll
            for (int i = 0; i < 2; ++i)
#pragma unroll
                for (int n = 0; n < 4; ++n)
#pragma unroll
                    for (int r = 0; r < 16; ++r) dst[(size_t)(32 * i + attn::crow(r, hi)) * 128 + 32 * n + r32] = f2bf(acc[i][n][r]);
        }
        if (tid < 256) { const int dir = tid >> 7, d = tid & 127; float s = 0.f;
#pragma unroll
            for (int w = 0; w < 8; ++w) s += dnp[(w * 2 + dir) * 128 + d];
            const int chain = (b * 4 + h) * 2 + dir; DN[(size_t)(chain * NCH + cid) * 128 + d] = s; }
        __syncthreads();
    }
}

struct SsGate { float dt0, dt1, acs0, acs1, total; };
__device__ __forceinline__ SsGate ss_gate(const float* GATES, int row0, int dir, int head, float aneg, int lane) {
    const float* g0 = GATES + (size_t)(row0 + 2 * lane) * NGATE; const float* g1 = g0 + NGATE;
    SsGate r; r.dt0 = g0[16 + dir * 16 + head]; r.dt1 = g1[16 + dir * 16 + head];
    const float a0 = r.dt0 * aneg, a1 = r.dt1 * aneg;
    const float incl = wave_incl_sum(a0 + a1, lane); r.total = __shfl(incl, 63);
    if (dir == 0) { r.acs0 = incl - a1; r.acs1 = incl; } else { r.acs0 = r.total - incl + a0 + a1; r.acs1 = r.total - incl + a1; }
    return r;
}
template <bool BM_ROW> __device__ __forceinline__ void ssd_stage(Ctx& F, const bf16_t* XC, int row0, int g, int hh, LAS unsigned char* Xt, LAS unsigned char* Bt) {
    const int tid_ = F.wave * 64 + fresh_lane(), sr = tid_ >> 4, sc8 = (tid_ & 15) * 8;
#pragma unroll
    for (int i = 0; i < 4; ++i) { const int s = sr + 32 * i; const bf16_t* rowp = XC + (size_t)(row0 + s) * 1536;
#pragma unroll
        for (int cb = 0; cb < 2; ++cb) { const u32x4 v = *(const u32x4*)(rowp + (g * 8 + hh * 4) * 64 + cb * 128 + sc8); *(LAS u32x4*)(Xt + ((s >> 6) * 2 + cb) * 16384 + attn::v_st(s & 63, sc8)) = v; }
        const u32x4 bv = *(const u32x4*)(rowp + 1024 + g * 128 + sc8);
        if (BM_ROW) *(LAS u32x4*)(Bt + (s >> 6) * 16384 + KSWZ(s & 63, sc8 * 2)) = bv; else *(LAS u32x4*)(Bt + (s >> 6) * 16384 + attn::v_st(s & 63, sc8)) = bv; }
}
__device__ __forceinline__ void ssd_a_phase(Ctx& F, const Args& a) {
    const bf16_t* XC = (const bf16_t*)(F.ws + WS_XC); const float* GATES = (const float*)(F.ws + WS_GATES);
    bf16_t* DS = (bf16_t*)(F.ws + WS_DS); float* AEND = (float*)(F.ws + WS_AEND);
    LAS unsigned char* Xt = F.lds; LAS unsigned char* Bt = F.lds + 65536;
    LAS float* wtl = (LAS float*)(F.lds + MX_MISC);
    for (int u = F.bid; u < 528; u += F.G) {
        const int lane = fresh_lane(), r32 = lane & 31, hi = lane >> 5, rdb = attn::v_rd_base(lane);
        const int b = u / 264, rem = u % 264, cid = rem >> 2, g = (rem >> 1) & 1, hh = rem & 1, row0 = chunk_row0(b, cid);
        const int dir = F.wave >> 2, j = F.wave & 3, head = g * 8 + hh * 4 + j, chain = (b * 16 + head) * 2 + dir;
        { const float aneg = -expf(a.in[I_ALOG][dir * 16 + head]); const SsGate s = ss_gate(GATES, row0, dir, head, aneg, lane);
          wtl[F.wave * 128 + 2 * lane] = s.dt0 * expf(s.total - s.acs0); wtl[F.wave * 128 + 2 * lane + 1] = s.dt1 * expf(s.total - s.acs1);
          if (lane == 0) AEND[chain * NCH + cid] = s.total; }
        ssd_stage<false>(F, XC, row0, g, hh, Xt, Bt);
        __syncthreads();
        f32x16 acc[2][4];
#pragma unroll
        for (int i = 0; i < 2; ++i)
#pragma unroll
            for (int n = 0; n < 4; ++n) acc[i][n] = f32x16{};
#pragma unroll
        for (int ks = 0; ks < 8; ++ks) { const int sblk = ks >> 2, KS = ks & 3;
            const f32x4 w0 = *(const LAS f32x4*)(wtl + F.wave * 128 + 16 * ks + 8 * hi), w1 = *(const LAS f32x4*)(wtl + F.wave * 128 + 16 * ks + 8 * hi + 4);
            bf16x8 af[2], bfr[4];
#pragma unroll
            for (int i = 0; i < 2; ++i) { const u32x4 x = __builtin_bit_cast(u32x4, trfrag(Xt + (sblk * 2 + (j >> 1)) * 16384 + rdb, (j & 1) * 2 + i, KS)); u32x4 o;
                o[0] = pk2(__uint_as_float(x[0] << 16) * w0[0], __uint_as_float(x[0] & 0xffff0000u) * w0[1]); o[1] = pk2(__uint_as_float(x[1] << 16) * w0[2], __uint_as_float(x[1] & 0xffff0000u) * w0[3]);
                o[2] = pk2(__uint_as_float(x[2] << 16) * w1[0], __uint_as_float(x[2] & 0xffff0000u) * w1[1]); o[3] = pk2(__uint_as_float(x[3] << 16) * w1[2], __uint_as_float(x[3] & 0xffff0000u) * w1[3]);
                af[i] = __builtin_bit_cast(bf16x8, o); }
#pragma unroll
            for (int n = 0; n < 4; ++n) bfr[n] = trfrag(Bt + sblk * 16384 + rdb, n, KS);
#pragma unroll
            for (int i = 0; i < 2; ++i)
#pragma unroll
                for (int n = 0; n < 4; ++n) acc[i][n] = __builtin_amdgcn_mfma_f32_32x32x16_bf16(af[i], bfr[n], acc[i][n], 0, 0, 0); }
        bf16_t* dst = DS + (size_t)(chain * NCH + cid) * 64 * 128;
#pragma unroll
        for (int i = 0; i < 2; ++i)
#pragma unroll
            for (int n = 0; n < 4; ++n)
#pragma unroll
                for (int r = 0; r < 16; ++r) dst[(size_t)(32 * i + attn::crow(r, hi)) * 128 + 32 * n + r32] = f2bf(acc[i][n][r]);
        __syncthreads();
    }
}

__device__ __forceinline__ void scan_phase(Ctx& F) {
    LAS float* sa = (LAS float*)(F.lds + MX_MISC); LAS float* ss = sa + 80;
    for (int vb = F.bid; vb < 256; vb += F.G) {
        __syncthreads();
        if (vb < 128) {
            const int chain = vb >> 3, dir = chain & 1; float* MS = (float*)(F.ws + WS_MS) + (size_t)chain * NCH * 4;
            LAS float* sbe = ss + 80; LAS float* sgm = sbe + 80;
            if (F.tid < NCH) { const int cid = scan_cid(dir, F.tid); sbe[F.tid] = MS[cid * 4 + 0]; sgm[F.tid] = MS[cid * 4 + 1]; }
            __syncthreads();
            if (F.tid == 0) { float m = 0.f;
                for (int p = 0; p < NCH; ++p) { const float be = sbe[p], gm = sgm[p];
                    const float mn = fmaxf(be + m, gm); sa[p] = expf(be + m - mn); ss[p] = expf(gm - mn); if ((vb & 7) == 0) MS[scan_cid(dir, p) * 4 + 2] = m; m = mn; } }
            __syncthreads();
            {   bf16_t* base = (bf16_t*)(F.ws + WS_DC) + (size_t)chain * NCH * 32768 + ((size_t)(vb & 7) * 512 + F.tid) * 8;
                u32x4 buf[8]; float run[8];
#pragma unroll
                for (int e = 0; e < 8; ++e) run[e] = 0.f;
#pragma unroll
                for (int k = 0; k < 8; ++k) buf[k] = *(const u32x4*)(base + (size_t)scan_cid(dir, k) * 32768);
                for (int p0 = 0; p0 < 72; p0 += 8) {
#pragma unroll
                    for (int k = 0; k < 8; ++k) { const int p = p0 + k;
                        if (p < NCH) { const u32x4 d = buf[k]; bf16_t* loc = base + (size_t)scan_cid(dir, p) * 32768;
                            if (p + 8 < NCH) buf[k] = *(const u32x4*)(base + (size_t)scan_cid(dir, p + 8) * 32768);
                            u32x4 o; o[0] = pk2(run[0], run[1]); o[1] = pk2(run[2], run[3]); o[2] = pk2(run[4], run[5]); o[3] = pk2(run[6], run[7]);
                            *(u32x4*)loc = o;
                            const float av = sa[p], sv = ss[p];
#pragma unroll
                            for (int e = 0; e < 4; ++e) { run[2 * e] = av * run[2 * e] + sv * __uint_as_float(d[e] << 16); run[2 * e + 1] = av * run[2 * e + 1] + sv * __uint_as_float(d[e] & 0xffff0000u); } } }
                }
            }
            if ((vb & 7) == 0 && F.tid < 32) {
                float* nb = (float*)(F.ws + WS_DN) + (size_t)chain * NCH * 128 + F.tid * 4;
                f32x4 buf[8]; f32x4 run = {0.f, 0.f, 0.f, 0.f};
#pragma unroll
                for (int k = 0; k < 8; ++k) buf[k] = *(const f32x4*)(nb + (size_t)scan_cid(dir, k) * 128);
                for (int p0 = 0; p0 < 72; p0 += 8) {
#pragma unroll
                    for (int k = 0; k < 8; ++k) { const int p = p0 + k;
                        if (p < NCH) { const f32x4 d = buf[k]; float* loc = nb + (size_t)scan_cid(dir, p) * 128;
                            if (p + 8 < NCH) buf[k] = *(const f32x4*)(nb + (size_t)scan_cid(dir, p + 8) * 128);
                            *(f32x4*)loc = run; run = sa[p] * run + ss[p] * d; } }
                }
            }
        } else {
            const int chain = (vb - 128) >> 1, dir = chain & 1; const float* AEND = (const float*)(F.ws + WS_AEND) + (size_t)chain * NCH;
            if (F.tid < NCH) sa[F.tid] = expf(AEND[scan_cid(dir, F.tid)]);
            __syncthreads();
            bf16_t* base = (bf16_t*)(F.ws + WS_DS) + (size_t)chain * NCH * 8192 + ((size_t)(vb & 1) * 512 + F.tid) * 8;
            u32x4 buf[8]; float run[8];
#pragma unroll
            for (int e = 0; e < 8; ++e) run[e] = 0.f;
#pragma unroll
            for (int k = 0; k < 8; ++k) buf[k] = *(const u32x4*)(base + (size_t)scan_cid(dir, k) * 8192);
            for (int p0 = 0; p0 < 72; p0 += 8) {
#pragma unroll
                for (int k = 0; k < 8; ++k) { const int p = p0 + k;
                    if (p < NCH) { const u32x4 d = buf[k]; bf16_t* loc = base + (size_t)scan_cid(dir, p) * 8192;
                        if (p + 8 < NCH) buf[k] = *(const u32x4*)(base + (size_t)scan_cid(dir, p + 8) * 8192);
                        u32x4 o; o[0] = pk2(run[0], run[1]); o[1] = pk2(run[2], run[3]); o[2] = pk2(run[4], run[5]); o[3] = pk2(run[6], run[7]);
                        *(u32x4*)loc = o;
                        const float av = sa[p];
#pragma unroll
                        for (int e = 0; e < 4; ++e) { run[2 * e] = av * run[2 * e] + __uint_as_float(d[e] << 16); run[2 * e + 1] = av * run[2 * e + 1] + __uint_as_float(d[e] & 0xffff0000u); } } }
            }
        }
    }
}


template <bool DIAG> __device__ __forceinline__ void ml_block(const f32x16& S, const LAS float* Gp, float Mt, float sgn, float sb, float scale, f32x16& out) {
#pragma unroll
    for (int g4 = 0; g4 < 4; ++g4) { const f32x4 Gv = *(const LAS f32x4*)(Gp + 8 * g4);
#pragma unroll
        for (int e = 0; e < 4; ++e) { float arg = (Gv[e] - Mt) * LOG2E;
            if (DIAG) arg = fmaf(fminf(fmaf(-sgn, (float)(8 * g4 + e), sb), 0.f), 1e30f, arg);
            out[4 * g4 + e] = S[4 * g4 + e] * __builtin_amdgcn_exp2f(arg) * scale; } }
}
template <bool DIAG> __device__ __forceinline__ void ss_block(const f32x16& S, const LAS float* ap, const LAS float* dp, float At, float sgn, float sb, f32x16& out) {
#pragma unroll
    for (int g4 = 0; g4 < 4; ++g4) { const f32x4 av = *(const LAS f32x4*)(ap + 8 * g4), dv = *(const LAS f32x4*)(dp + 8 * g4);
#pragma unroll
        for (int e = 0; e < 4; ++e) { float arg = (At - av[e]) * LOG2E;
            if (DIAG) arg = fmaf(fminf(fmaf(-sgn, (float)(8 * g4 + e), sb), 0.f), 1e30f, arg);
            out[4 * g4 + e] = S[4 * g4 + e] * __builtin_amdgcn_exp2f(arg) * dv[e]; } }
}
__device__ __forceinline__ float sum16(const f32x16& v) { float s = 0.f;
#pragma unroll
    for (int r = 0; r < 16; ++r) s += v[r];
    return s; }
__device__ __forceinline__ void mlstm_c_phase(Ctx& F, const Args& a) {
    const bf16_t* QK = (const bf16_t*)(F.ws + WS_QK); const bf16_t* V = (const bf16_t*)(F.ws + WS_V); const bf16_t* OG = (const bf16_t*)(F.ws + WS_O); const float* GATES = (const float*)(F.ws + WS_GATES);
    const bf16_t* DC = (const bf16_t*)(F.ws + WS_DC); const float* DN = (const float*)(F.ws + WS_DN); const float* MS = (const float*)(F.ws + WS_MS); bf16_t* MIX = (bf16_t*)(F.ws + WS_MIX);
    LAS unsigned char* Kt = F.lds; LAS unsigned char* Vt = F.lds + 32768; LAS float* stat = (LAS float*)(F.lds + 98304);
    LAS float* Gs = (LAS float*)(F.lds + MX_MISC); LAS float* Ms = Gs + 256; LAS float* Bs = Gs + 512; LAS float* ns = Gs + 768; LAS float* mst = Gs + 1024;
    for (int u = F.bid; u < 528; u += F.G) {
        const int lane = fresh_lane(), tid = F.wave * 64 + lane, r32 = lane & 31, hi = lane >> 5, sr = tid >> 4, sc8 = (tid & 15) * 8, rdb = attn::v_rd_base(lane);
        const int b = u / 264, rem = u % 264, cid = rem >> 2, h = rem & 3, row0 = chunk_row0(b, cid);
        if (F.wave < 2) { const int dir = F.wave, chain = (b * 4 + h) * 2 + dir; const MlGate g = ml_gate(GATES, row0, dir, h, lane);
            const float m0 = MS[(chain * NCH + cid) * 4 + 2];
            const float gmx = fmaxf(g.G0, g.G1); float M0, M1;
            if (dir == 0) { const float pm = wave_incl_max(gmx, lane); float ex = __shfl_up(pm, 1); if (lane == 0) ex = -1e30f; M0 = fmaxf(ex, g.G0); M1 = pm; }
            else { const float pm = wave_incl_max_rev(gmx, lane); float ex = __shfl_down(pm, 1); if (lane == 63) ex = -1e30f; M1 = fmaxf(ex, g.G1); M0 = pm; }
            M0 = fmaxf(M0, m0); M1 = fmaxf(M1, m0);
            Gs[dir * 128 + 2 * lane] = g.G0; Gs[dir * 128 + 2 * lane + 1] = g.G1; Ms[dir * 128 + 2 * lane] = M0; Ms[dir * 128 + 2 * lane + 1] = M1;
            Bs[dir * 128 + 2 * lane] = g.b0; Bs[dir * 128 + 2 * lane + 1] = g.b1;
            const float* nsrc = DN + (size_t)(chain * NCH + cid) * 128; ns[dir * 128 + 2 * lane] = nsrc[2 * lane]; ns[dir * 128 + 2 * lane + 1] = nsrc[2 * lane + 1];
            if (lane == 0) mst[dir] = m0; }
#pragma unroll
        for (int i = 0; i < 4; ++i) { const int s = sr + 32 * i; const size_t grow = (size_t)(row0 + s) * 1024;
#pragma unroll
            for (int vb = 0; vb < 2; ++vb) { const u32x4 v = *(const u32x4*)(V + grow + h * 256 + vb * 128 + sc8); *(LAS u32x4*)(Vt + ((s >> 6) * 2 + vb) * 16384 + attn::v_st(s & 63, sc8)) = v; }
            const u32x4 kv = *(const u32x4*)(QK + grow + 512 + h * 128 + sc8);
            *(LAS u32x4*)(Kt + (s >> 6) * 16384 + KSWZ(s & 63, sc8 * 2)) = kv; }
        __syncthreads();
        const int tq = F.wave & 3, vh = F.wave >> 2, tau = 32 * tq + r32;
        const bf16_t* qptr = QK + (size_t)(row0 + tau) * 1024 + h * 128 + hi * 8;
        f32x16 pS[2][2];
        {   bf16x8 qr[8];
#pragma unroll
        for (int d0 = 0; d0 < 8; ++d0) qr[d0] = *(const bf16x8*)(qptr + d0 * 16);
#pragma unroll
        for (int j = 0; j < 2; ++j)
#pragma unroll
            for (int blk = 0; blk < 2; ++blk) { pS[j][blk] = f32x16{};
#pragma unroll
                for (int d0 = 0; d0 < 8; ++d0) pS[j][blk] = __builtin_amdgcn_mfma_f32_32x32x16_bf16(rowfrag(Kt + j * 16384, blk, d0, r32, hi), qr[d0], pS[j][blk], 0, 0, 0); }
        }
        f32x16 o[4];
#pragma unroll
        for (int d = 0; d < 4; ++d) o[d] = f32x16{};
#pragma unroll 1
        for (int dir = 0; dir < 2; ++dir) {
            const float Mt = Ms[dir * 128 + tau], m0 = mst[dir];
            const float sgn = dir ? -1.f : 1.f, sb = sgn * (float)(r32 - 4 * hi);
            float rs = 0.f;
#pragma unroll
            for (int j = 0; j < 2; ++j)
#pragma unroll
                for (int blk = 0; blk < 2; ++blk) { const int kb = 2 * j + blk; const bool vis = dir ? (kb >= tq) : (kb <= tq);
                    if (vis) { f32x16 pp; const LAS float* Gp = Gs + dir * 128 + 32 * kb + 4 * hi;
                        if (kb == tq) ml_block<true>(pS[j][blk], Gp, Mt, sgn, sb, 1.f, pp); else ml_block<false>(pS[j][blk], Gp, Mt, sgn, sb, 1.f, pp);
                        rs += sum16(pp); } }
            rs = half_swap_add(rs);
            float qn = 0.f; const bf16_t* qp2 = launder_v(qptr);
#pragma unroll
            for (int d0 = 0; d0 < 8; ++d0) { const bf16x8 qv = *(const bf16x8*)(qp2 + d0 * 16); const f32x4 n0 = *(const LAS f32x4*)(ns + dir * 128 + 16 * d0 + 8 * hi), n1 = *(const LAS f32x4*)(ns + dir * 128 + 16 * d0 + 8 * hi + 4);
                const u32x4 q = __builtin_bit_cast(u32x4, qv);
                qn += __uint_as_float(q[0] << 16) * n0[0] + __uint_as_float(q[0] & 0xffff0000u) * n0[1] + __uint_as_float(q[1] << 16) * n0[2] + __uint_as_float(q[1] & 0xffff0000u) * n0[3]
                    + __uint_as_float(q[2] << 16) * n1[0] + __uint_as_float(q[2] & 0xffff0000u) * n1[1] + __uint_as_float(q[3] << 16) * n1[2] + __uint_as_float(q[3] & 0xffff0000u) * n1[3]; }
            qn = half_swap_add(qn);
#if defined(EXP_NO_INTER) && EXP_NO_INTER == 1
            const float ain = 0.f, den = rs;
#else
            const float ain = expf(m0 - Mt), den = rs + ain * qn;
#endif
            const float inv = __builtin_amdgcn_rcpf(fmaxf(fabsf(den), expf(-(Bs[dir * 128 + tau] + Mt))));
#pragma unroll
            for (int j = 0; j < 2; ++j)
#pragma unroll
                for (int blk = 0; blk < 2; ++blk) { const int kb = 2 * j + blk; const bool vis = dir ? (kb >= tq) : (kb <= tq);
                    if (vis) { f32x16 pp; const LAS float* Gp = Gs + dir * 128 + 32 * kb + 4 * hi;
                        if (kb == tq) ml_block<true>(pS[j][blk], Gp, Mt, sgn, sb, inv, pp); else ml_block<false>(pS[j][blk], Gp, Mt, sgn, sb, inv, pp);
                        bf16x8 pa0, pa1;
                        MX_PK4(pp, 0, pa0); MX_PK4(pp, 8, pa1);
#pragma unroll
                        for (int d = 0; d < 4; ++d) { o[d] = __builtin_amdgcn_mfma_f32_32x32x16_bf16(pa0, trfrag(Vt + (j * 2 + vh) * 16384 + rdb, d, 2 * blk), o[d], 0, 0, 0);
                            o[d] = __builtin_amdgcn_mfma_f32_32x32x16_bf16(pa1, trfrag(Vt + (j * 2 + vh) * 16384 + rdb, d, 2 * blk + 1), o[d], 0, 0, 0); } }
                    __builtin_amdgcn_sched_barrier(0); }
#if !defined(EXP_NO_INTER) || EXP_NO_INTER == 3
            const float qsc = ain * inv; const int chain = (b * 4 + h) * 2 + dir;
            const bf16_t* Cb = DC + ((size_t)(chain * NCH + cid) * 256 + 128 * vh + r32) * 128 + hi * 8;
            const bf16_t* qp3 = launder_v(qptr);
            bf16x8 cf[2][4];
#pragma unroll
            for (int d = 0; d < 4; ++d) cf[0][d] = *(const bf16x8*)(Cb + (size_t)(32 * d) * 128);
            __builtin_amdgcn_sched_barrier(0);
#pragma unroll
            for (int d0 = 0; d0 < 8; ++d0) {
                if (d0 + 1 < 8) {
#pragma unroll
                    for (int d = 0; d < 4; ++d) cf[(d0 + 1) & 1][d] = *(const bf16x8*)(Cb + (size_t)(32 * d) * 128 + 16 * (d0 + 1)); }
#if defined(EXP_NO_INTER) && EXP_NO_INTER == 3
                const bf16x8 qs = scale8f(*(const bf16x8*)(qp3 + d0 * 16), 0.f * qsc);
#else
                const bf16x8 qs = scale8f(*(const bf16x8*)(qp3 + d0 * 16), qsc);
#endif
#pragma unroll
                for (int d = 0; d < 4; ++d) o[d] = __builtin_amdgcn_mfma_f32_32x32x16_bf16(qs, cf[d0 & 1][d], o[d], 0, 0, 0);
                __builtin_amdgcn_sched_barrier(0); }
#endif
        }
        float s1[16], s2[16];
#pragma unroll
        for (int r = 0; r < 16; ++r) { float x = 0.f, y = 0.f;
#pragma unroll
            for (int d = 0; d < 4; ++d) { x += o[d][r]; y += o[d][r] * o[d][r]; }
#pragma unroll
            for (int of = 1; of < 32; of <<= 1) { x += __shfl_xor(x, of); y += __shfl_xor(y, of); }
            s1[r] = x; s2[r] = y; }
        if (r32 == 0) {
#pragma unroll
            for (int r = 0; r < 16; ++r) { const int row = 32 * tq + attn::crow(r, hi); stat[(vh * 128 + row) * 2] = s1[r]; stat[(vh * 128 + row) * 2 + 1] = s2[r]; } }
        __syncthreads();
        {   float gg[4];
#pragma unroll
            for (int d = 0; d < 4; ++d) gg[d] = a.in[I_MNG][h * 256 + 128 * vh + 32 * d + r32];
#pragma unroll
            for (int r = 0; r < 16; ++r) { const int row = 32 * tq + attn::crow(r, hi);
                const float t1 = stat[row * 2] + stat[(128 + row) * 2], t2 = stat[row * 2 + 1] + stat[(128 + row) * 2 + 1];
                const float mu = t1 * (1.f / 256.f), rstd = rsqrtf(fmaxf(t2 * (1.f / 256.f) - mu * mu, 0.f) + 1e-5f);
                const size_t grow = (size_t)(row0 + row);
                const bf16_t* ogp = OG + grow * 1024 + h * 256 + 128 * vh + r32; bf16_t* mxp = MIX + grow * 2048 + h * 256 + 128 * vh + r32;
#pragma unroll
                for (int d = 0; d < 4; ++d) { const float og = bf2f(ogp[32 * d]); mxp[32 * d] = f2bf((o[d][r] - mu) * rstd * gg[d] * sigmf(og)); }
                __builtin_amdgcn_sched_barrier(0); } }
        __syncthreads();
    }
}

__device__ __forceinline__ void ssd_c_phase(Ctx& F, const Args& a) {
    const bf16_t* XC = (const bf16_t*)(F.ws + WS_XC); const bf16_t* Z = (const bf16_t*)(F.ws + WS_Z); const float* GATES = (const float*)(F.ws + WS_GATES);
    const bf16_t* DS = (const bf16_t*)(F.ws + WS_DS); bf16_t* MIX = (bf16_t*)(F.ws + WS_MIX); float* SSQ = (float*)(F.ws + WS_SSQ);
    LAS unsigned char* Bt = F.lds; LAS unsigned char* Xt = F.lds + 32768;
    LAS float* acsl = (LAS float*)(F.lds + MX_MISC); LAS float* dtl = acsl + 1024;
    for (int u = F.bid; u < 528; u += F.G) {
        const int lane = fresh_lane(), r32 = lane & 31, hi = lane >> 5, rdb = attn::v_rd_base(lane);
        const int b = u / 264, rem = u % 264, cid = rem >> 2, g = (rem >> 1) & 1, hh = rem & 1, row0 = chunk_row0(b, cid);
        {   const int dir = F.wave >> 2, j = F.wave & 3, head = g * 8 + hh * 4 + j; const float aneg = -expf(a.in[I_ALOG][dir * 16 + head]);
            const SsGate s = ss_gate(GATES, row0, dir, head, aneg, lane); const int o = (j * 2 + dir) * 128 + 2 * lane;
            acsl[o] = s.acs0; acsl[o + 1] = s.acs1; dtl[o] = s.dt0; dtl[o + 1] = s.dt1; }
        ssd_stage<true>(F, XC, row0, g, hh, Xt, Bt);
        __syncthreads();
        const int tq = F.wave & 3, jp = F.wave >> 2, tau = 32 * tq + r32;
        const bf16_t* cptr = XC + (size_t)(row0 + tau) * 1536 + 1280 + g * 128 + hi * 8;
        f32x16 pS[2][2];
        {   bf16x8 cr[8];
#pragma unroll
        for (int d0 = 0; d0 < 8; ++d0) cr[d0] = *(const bf16x8*)(cptr + d0 * 16);
#pragma unroll
        for (int j = 0; j < 2; ++j)
#pragma unroll
            for (int blk = 0; blk < 2; ++blk) { pS[j][blk] = f32x16{};
#pragma unroll
                for (int d0 = 0; d0 < 8; ++d0) pS[j][blk] = __builtin_amdgcn_mfma_f32_32x32x16_bf16(rowfrag(Bt + j * 16384, blk, d0, r32, hi), cr[d0], pS[j][blk], 0, 0, 0); }
        }
        f32x16 y[2][2];
#pragma unroll
        for (int jj = 0; jj < 2; ++jj) { y[jj][0] = f32x16{}; y[jj][1] = f32x16{}; }
#pragma unroll
        for (int jj = 0; jj < 2; ++jj) { const int hl = 2 * jp + jj;
#pragma unroll
            for (int dir = 0; dir < 2; ++dir) {
                const LAS float* ac = acsl + (hl * 2 + dir) * 128; const LAS float* dtp = dtl + (hl * 2 + dir) * 128;
                const float At = ac[tau];
                const float sgn = dir ? -1.f : 1.f, sb = sgn * (float)(r32 - 4 * hi);
#pragma unroll
                for (int j = 0; j < 2; ++j)
#pragma unroll
                    for (int blk = 0; blk < 2; ++blk) { const int kb = 2 * j + blk; const bool vis = dir ? (kb >= tq) : (kb <= tq);
                        if (vis) { f32x16 pp; const LAS float* ap = ac + 32 * kb + 4 * hi; const LAS float* dp = dtp + 32 * kb + 4 * hi;
                            if (kb == tq) ss_block<true>(pS[j][blk], ap, dp, At, sgn, sb, pp); else ss_block<false>(pS[j][blk], ap, dp, At, sgn, sb, pp);
                            bf16x8 pa0, pa1;
                            MX_PK4(pp, 0, pa0); MX_PK4(pp, 8, pa1);
#pragma unroll
                            for (int pb = 0; pb < 2; ++pb) { y[jj][pb] = __builtin_amdgcn_mfma_f32_32x32x16_bf16(pa0, trfrag(Xt + (j * 2 + (hl >> 1)) * 16384 + rdb, (hl & 1) * 2 + pb, 2 * blk), y[jj][pb], 0, 0, 0);
                                y[jj][pb] = __builtin_amdgcn_mfma_f32_32x32x16_bf16(pa1, trfrag(Xt + (j * 2 + (hl >> 1)) * 16384 + rdb, (hl & 1) * 2 + pb, 2 * blk + 1), y[jj][pb], 0, 0, 0); } }
                        __builtin_amdgcn_sched_barrier(0); }
                const float ea = expf(At); const int chain = (b * 16 + g * 8 + hh * 4 + hl) * 2 + dir;
                const bf16_t* Hb = DS + ((size_t)(chain * NCH + cid) * 64 + r32) * 128 + hi * 8;
                const bf16_t* cp3 = launder_v(cptr);
                bf16x8 hf[2][2];
#pragma unroll
                for (int pb = 0; pb < 2; ++pb) hf[0][pb] = *(const bf16x8*)(Hb + (size_t)(32 * pb) * 128);
                __builtin_amdgcn_sched_barrier(0);
#pragma unroll
                for (int d0 = 0; d0 < 8; ++d0) {
                    if (d0 + 1 < 8) {
#pragma unroll
                        for (int pb = 0; pb < 2; ++pb) hf[(d0 + 1) & 1][pb] = *(const bf16x8*)(Hb + (size_t)(32 * pb) * 128 + 16 * (d0 + 1)); }
                    const bf16x8 cs = scale8f(*(const bf16x8*)(cp3 + d0 * 16), ea);
#pragma unroll
                    for (int pb = 0; pb < 2; ++pb) y[jj][pb] = __builtin_amdgcn_mfma_f32_32x32x16_bf16(cs, hf[d0 & 1][pb], y[jj][pb], 0, 0, 0);
                    __builtin_amdgcn_sched_barrier(0); }
            } }
        const int headb = g * 8 + hh * 4 + 2 * jp; const float dsk0 = a.in[I_SSMD][headb], dsk1 = a.in[I_SSMD][headb + 1];
#pragma unroll
        for (int r = 0; r < 16; ++r) { const size_t grow = (size_t)(row0 + 32 * tq + attn::crow(r, hi));
            const bf16_t* xp = XC + grow * 1536 + headb * 64 + r32; const bf16_t* zp = Z + grow * 1024 + headb * 64 + r32; bf16_t* mp = MIX + grow * 2048 + 1024 + headb * 64 + r32;
            float sq = 0.f;
#pragma unroll
            for (int jj = 0; jj < 2; ++jj)
#pragma unroll
                for (int pb = 0; pb < 2; ++pb) { const int co = jj * 64 + pb * 32; const float xs = bf2f(xp[co]), z = bf2f(zp[co]);
                    const float val = (y[jj][pb][r] + (jj ? dsk1 : dsk0) * xs) * siluf(z); mp[co] = f2bf(val); sq += val * val; }
#pragma unroll
            for (int of = 1; of < 32; of <<= 1) sq += __shfl_xor(sq, of);
            if (r32 == 0) SSQ[grow * 8 + g * 4 + hh * 2 + jp] = sq;
            __builtin_amdgcn_sched_barrier(0); }
        __syncthreads();
    }
}
__device__ __forceinline__ void ysnorm_phase(Ctx& F, const Args& a) {
    bf16_t* MIX = (bf16_t*)(F.ws + WS_MIX); const float* SSQ = (const float*)(F.ws + WS_SSQ);
    const RowF gg = row_ld_f32(a.in[I_SNG], F.lane);
    for (int row = GWID(F); row < NTOK; row += NGW(F)) {
        const f32x4 s0 = *(const f32x4*)(SSQ + (size_t)row * 8), s1 = *(const f32x4*)(SSQ + (size_t)row * 8 + 4);
        const float ms = (((s0[0] + s0[1]) + (s0[2] + s0[3])) + ((s1[0] + s1[1]) + (s1[2] + s1[3]))) * (1.f / 1024.f), r = rsqrtf(ms + 1e-6f);
        RowF v = row_ld_bf16(MIX + (size_t)row * 2048 + 1024, F.lane);
#pragma unroll
        for (int j = 0; j < 4; ++j) v.v[j] = v.v[j] * r * gg.v[j];
        row_st_bf16(MIX + (size_t)row * 2048 + 1024, F.lane, v);
    }
}

enum { PH_PRO = 0, PH_ROWA, PH_GEMM_IN, PH_CONV, PH_MLA, PH_SSA, PH_SCAN, PH_MLC, PH_SSC, PH_YSN, PH_GEMM_OUT, PH_ROWB0, PH_SCAT0, PH_MOE1_0, PH_MOE2_0, PH_ROWC,
       PH_GEMM_QKV, PH_QKPREP, PH_ATTN, PH_GEMM_AO, PH_ROWB1, PH_SCAT1, PH_MOE1_1, PH_MOE2_1, PH_FINAL, PH_COUNT };

__device__ __forceinline__ const Args& fresh_args() { auto p = __builtin_amdgcn_kernarg_segment_ptr(); asm volatile("" : "+s"(p)); return *(const Args*)p; }
__global__ void __launch_bounds__(NTHREADS, 2) mk_fwd(Args a_) {
    extern __shared__ __attribute__((aligned(16))) unsigned char lds_raw[];
    cg::grid_group grid = cg::this_grid();
    Ctx F; F.lds = (LAS unsigned char*)lds_raw; F.ws = a_.ws;
    F.wave = __builtin_amdgcn_readfirstlane(threadIdx.x >> 6); F.lane = fresh_lane(); F.tid = F.wave * 64 + F.lane; F.G = gridDim.x; F.bid = blockIdx.x;
    const int lo = a_.ph_lo, hi = a_.ph_hi;
    if (threadIdx.x < 64) MISCP(F)[32 + threadIdx.x] = 0;
    __syncthreads();
    XcdBarrier xbar = xcd_barrier_post(CTLP(F) + CW_BAR + a_.li * 4096, (volatile LAS unsigned*)(MISCP(F) + 32), (int)threadIdx.x);
#define PHASE(k) if (lo <= (k) && (k) < hi && ((F.lane = fresh_lane()), (F.tid = F.wave * 64 + F.lane), true))
#define ENDPH(k) do { if ((k) + 1 < hi) { if ((k) == PH_PRO) grid.sync(); else { XcdBarrier xb_ = xbar; xb_.bar = (unsigned*)launder_ptr((unsigned char*)xb_.bar); xcd_barrier(xb_, F.wave * 64 + fresh_lane()); } } } while (0)
#define WSP(off) (launder_ptr(a_.ws) + (off))
    PHASE(PH_PRO) { const Args& a = fresh_args(); (void)a; ada_phase(F, a); __syncthreads(); convert_small_weights(F, a); ENDPH(PH_PRO); }
    PHASE(PH_ROWA) { const Args& a = fresh_args(); (void)a; rowpass_a(F, a); ENDPH(PH_ROWA); }
    PHASE(PH_GEMM_IN) { const Args& a = fresh_args(); (void)a; unsigned char* ws = WSP(0); pg8::StaticOrder S; S.init(NTOK, NWIN, F.G, F.bid); EpiStore<DestWin> E{{(bf16_t*)(ws + WS_QK)}};
        run_gemm(F, (const bf16_t*)(ws + WS_HB), (const bf16_t*)(ws + WS_WIN), NTOK, NWIN, 1024, S, E); ENDPH(PH_GEMM_IN); }
    PHASE(PH_CONV) { const Args& a = fresh_args(); (void)a; conv_phase(F, a); ENDPH(PH_CONV); }
    PHASE(PH_MLA) { const Args& a = fresh_args(); (void)a; mlstm_a_phase(F); ENDPH(PH_MLA); }
    PHASE(PH_SSA) { const Args& a = fresh_args(); (void)a; ssd_a_phase(F, a); ENDPH(PH_SSA); }
    PHASE(PH_SCAN) { const Args& a = fresh_args(); (void)a; scan_phase(F); ENDPH(PH_SCAN); }
    PHASE(PH_MLC) { const Args& a = fresh_args(); (void)a; mlstm_c_phase(F, a); ENDPH(PH_MLC); }
    PHASE(PH_SSC) { const Args& a = fresh_args(); (void)a; ssd_c_phase(F, a); ENDPH(PH_SSC); }
    PHASE(PH_YSN) { const Args& a = fresh_args(); (void)a;
#if !defined(EXP_NAIVE_MIXER) || EXP_NAIVE_MIXER == 4
        ysnorm_phase(F, a); __syncthreads();
#endif
        convert_moe_weights(F, a, 0); ENDPH(PH_YSN); }
    PHASE(PH_GEMM_OUT) { const Args& a = fresh_args(); (void)a; unsigned char* ws = WSP(0); pg8::StaticOrder S; S.init(NTOK, 1024, F.G, F.bid); EpiStore<DestPlain> E{{(bf16_t*)(ws + WS_YB), 1024, 3}};
        run_gemm(F, (const bf16_t*)(ws + WS_MIX), (const bf16_t*)(ws + WS_WOUT), NTOK, 1024, 2048, S, E); ENDPH(PH_GEMM_OUT); }
    PHASE(PH_ROWB0) { const Args& a = fresh_args(); (void)a; rowpass_b(F, a, 0, NTOK, (const bf16_t*)(WSP(WS_YB))); ENDPH(PH_ROWB0); }
    PHASE(PH_SCAT0) { const Args& a = fresh_args(); (void)a; moe_scatter(F, 0, NTOK); ENDPH(PH_SCAT0); }
    PHASE(PH_MOE1_0) { const Args& a = fresh_args(); (void)a; unsigned char* ws = WSP(0); moe_offsets(F, 0); MoeOrder S; S.init(MISCP(F), 8, F.G, F.bid); EpiSwiglu E{(bf16_t*)(ws + WS_HMID)};
        run_gemm(F, (const bf16_t*)(ws + WS_XS), (const bf16_t*)(ws + WS_MOEW), 0, 0, 1024, S, E); ENDPH(PH_MOE1_0); }
    PHASE(PH_MOE2_0) { const Args& a = fresh_args(); (void)a; unsigned char* ws = WSP(0); moe_offsets(F, 0); MoeOrder S; S.init(MISCP(F), 4, F.G, F.bid); EpiStore<DestPlain> E{{(bf16_t*)(ws + WS_YS), 1024, 3}};
        run_gemm(F, (const bf16_t*)(ws + WS_HMID), (const bf16_t*)(ws + WS_MOEW + 64 * MiB), 0, 0, 1024, S, E); ENDPH(PH_MOE2_0); }
    PHASE(PH_ROWC) { const Args& a = fresh_args(); (void)a; rowpass_c(F, a, 0, NTOK, false); __syncthreads(); convert_moe_weights(F, a, 1); ENDPH(PH_ROWC); }
    PHASE(PH_GEMM_QKV) { const Args& a = fresh_args(); (void)a; unsigned char* ws = WSP(0); pg8::StaticOrder S; S.init(NTOK, 1536, F.G, F.bid); EpiStore<DestQKV> E{{(bf16_t*)(ws + WS_Q), (bf16_t*)(ws + WS_KB), (bf16_t*)(ws + WS_VB)}};
        run_gemm(F, (const bf16_t*)(ws + WS_HB), (const bf16_t*)(ws + WS_ATIN), NTOK, 1536, 1024, S, E); ENDPH(PH_GEMM_QKV); }
    PHASE(PH_QKPREP) { const Args& a = fresh_args(); (void)a; qkprep_phase(F, a); ENDPH(PH_QKPREP); }
    PHASE(PH_ATTN) { const Args& a = fresh_args(); (void)a; attn_phase(F); ENDPH(PH_ATTN); }
    PHASE(PH_GEMM_AO) { const Args& a = fresh_args(); (void)a; unsigned char* ws = WSP(0); pg8::StaticOrder S; S.init(NLAT, 1024, F.G, F.bid); EpiStore<DestPlain> E{{(bf16_t*)(ws + WS_YB1), 1024, 3}};
        run_gemm(F, (const bf16_t*)(ws + WS_AO), (const bf16_t*)(ws + WS_ATOUT), NLAT, 1024, 1024, S, E); ENDPH(PH_GEMM_AO); }
    PHASE(PH_ROWB1) { const Args& a = fresh_args(); (void)a; rowpass_b(F, a, 1, NLAT, (const bf16_t*)(WSP(WS_YB1))); ENDPH(PH_ROWB1); }
    PHASE(PH_SCAT1) { const Args& a = fresh_args(); (void)a; moe_scatter(F, 1, NLAT); ENDPH(PH_SCAT1); }
    PHASE(PH_MOE1_1) { const Args& a = fresh_args(); (void)a; unsigned char* ws = WSP(0); moe_offsets(F, 1); MoeOrder S; S.init(MISCP(F), 8, F.G, F.bid); EpiSwiglu E{(bf16_t*)(ws + WS_HMID)};
        run_gemm(F, (const bf16_t*)(ws + WS_XS), (const bf16_t*)(ws + WS_MOEW), 0, 0, 1024, S, E); ENDPH(PH_MOE1_1); }
    PHASE(PH_MOE2_1) { const Args& a = fresh_args(); (void)a; unsigned char* ws = WSP(0); moe_offsets(F, 1); MoeOrder S; S.init(MISCP(F), 4, F.G, F.bid); EpiStore<DestPlain> E{{(bf16_t*)(ws + WS_YS), 1024, 3}};
        run_gemm(F, (const bf16_t*)(ws + WS_HMID), (const bf16_t*)(ws + WS_MOEW + 64 * MiB), 0, 0, 1024, S, E); ENDPH(PH_MOE2_1); }
    PHASE(PH_FINAL) { const Args& a = fresh_args(); (void)a; rowpass_c(F, a, 1, NLAT, true); }
}

__device__ __forceinline__ float block_sum256(float v, float* red) {
    for (int o = 32; o > 0; o >>= 1) v += __shfl_xor(v, o);
    __syncthreads();
    if ((threadIdx.x & 63) == 0) red[threadIdx.x >> 6] = v;
    __syncthreads();
    float r = 0.f;
    for (int i = 0; i < (int)(blockDim.x >> 6); ++i) r += red[i];
    return r;
}
__global__ void nv_conv_kernel(const bf16_t* XBC, const float* cw, const float* cb, bf16_t* XC) {
    const int row = blockIdx.x;
    int t, base, len;
    if (row < NLAT) { t = row % SEQ; base = row - t; len = SEQ; } else { int r = row - NLAT; t = r % CTXL; base = row - t; len = CTXL; }
    for (int c = threadIdx.x; c < 1536; c += 256) {
        float acc = cb[c];
#pragma unroll
        for (int j = 0; j < 4; ++j) { int tt = t - 2 + j; if (tt >= 0 && tt < len) acc += cw[j * 1536 + c] * bf2f(XBC[(size_t)(base + tt) * 1536 + c]); }
        XC[(size_t)row * 1536 + c] = f2bf(siluf(acc));
    }
}
__global__ void __launch_bounds__(256) nv_mlstm_rec_kernel(const bf16_t* QK, const bf16_t* V, const float* GATES, float* HM, int dir) {
    const int vs = blockIdx.x, h = blockIdx.y, b = blockIdx.z;
    const int tid = threadIdx.x, vi = tid >> 4, dj = tid & 15;
    float Cst[8], nst[8];
#pragma unroll
    for (int j = 0; j < 8; ++j) { Cst[j] = 0.f; nst[j] = 0.f; }
#pragma unroll 2
    for (int i = 0; i < SLEN; ++i) {
        const int row = seq_row(b, dir, i);
        const float ig = GATES[(size_t)row * NGATE + dir * 4 + h], lf = GATES[(size_t)row * NGATE + 8 + dir * 4 + h];
        const float f = expf(lf), ii = expf(ig);
        const float v = bf2f(V[(size_t)row * 1024 + h * 256 + vs * 16 + vi]);
        const u32x4 kq = *(const u32x4*)(QK + (size_t)row * 1024 + 512 + h * 128 + dj * 8), qq = *(const u32x4*)(QK + (size_t)row * 1024 + h * 128 + dj * 8);
        float k[8], q[8];
#pragma unroll
        for (int j = 0; j < 4; ++j) { k[2 * j] = __uint_as_float(kq[j] << 16); k[2 * j + 1] = __uint_as_float(kq[j] & 0xffff0000u); q[2 * j] = __uint_as_float(qq[j] << 16); q[2 * j + 1] = __uint_as_float(qq[j] & 0xffff0000u); }
        float num = 0.f, den = 0.f; const float iv = ii * v;
#pragma unroll
        for (int j = 0; j < 8; ++j) { Cst[j] = f * Cst[j] + iv * k[j]; nst[j] = f * nst[j] + ii * k[j]; num += Cst[j] * q[j]; den += nst[j] * q[j]; }
#pragma unroll
        for (int o = 1; o < 16; o <<= 1) { num += __shfl_xor(num, o); den += __shfl_xor(den, o); }
        if (dj == 0) { float hv = num / fmaxf(fabsf(den), 1.f); float* o = HM + (size_t)row * D + h * 256 + vs * 16 + vi; if (dir) *o += hv; else *o = hv; }
    }
}
__global__ void nv_finish_m_kernel(const float* HM, const bf16_t* O, const float* g, bf16_t* MIX) {
    __shared__ float red[4];
    const int row = blockIdx.x, tid = threadIdx.x;
    for (int h = 0; h < 4; ++h) {
        float v = HM[(size_t)row * D + h * 256 + tid];
        float mu = block_sum256(v, red) * (1.f / 256.f);
        float dv = v - mu;
        float var = block_sum256(dv * dv, red) * (1.f / 256.f);
        float y = dv * rsqrtf(var + 1e-5f) * g[h * 256 + tid] * sigmf(bf2f(O[(size_t)row * 1024 + h * 256 + tid]));
        MIX[(size_t)row * 2048 + h * 256 + tid] = f2bf(y);
    }
}
__global__ void __launch_bounds__(256) nv_ssd_rec_kernel(const bf16_t* XC, const float* GATES, const float* a_log, float* HS, int dir) {
    const int head = blockIdx.x, b = blockIdx.y, g = head >> 3;
    const int tid = threadIdx.x, pp = tid >> 2, nq = tid & 3;
    float hst[32];
#pragma unroll
    for (int j = 0; j < 32; ++j) hst[j] = 0.f;
    const float aneg = -expf(a_log[dir * 16 + head]);
    for (int i = 0; i < SLEN; ++i) {
        const int row = seq_row(b, dir, i);
        const float dtv = GATES[(size_t)row * NGATE + 16 + dir * 16 + head];
        const float dA = expf(dtv * aneg);
        const bf16_t* xc = XC + (size_t)row * 1536;
        const float xv = bf2f(xc[head * 64 + pp]) * dtv;
        const bf16_t* bp = xc + 1024 + g * 128 + nq * 32; const bf16_t* cp = xc + 1280 + g * 128 + nq * 32;
        float y = 0.f;
#pragma unroll
        for (int j = 0; j < 32; ++j) { hst[j] = dA * hst[j] + bf2f(bp[j]) * xv; y += bf2f(cp[j]) * hst[j]; }
        y += __shfl_xor(y, 1); y += __shfl_xor(y, 2);
        if (nq == 0) { float* o = HS + (size_t)row * D + head * 64 + pp; if (dir) *o += y; else *o = y; }
    }
}
__global__ void nv_finish_s_kernel(const float* HS, const bf16_t* Z, const bf16_t* XC, const float* dsk, const float* g, bf16_t* MIX) {
    __shared__ float red[4];
    const int row = blockIdx.x, tid = threadIdx.x;
    float v[4]; float ss = 0.f;
#pragma unroll
    for (int j = 0; j < 4; ++j) { int c = tid + 256 * j;
        float y = HS[(size_t)row * D + c] + dsk[c >> 6] * bf2f(XC[(size_t)row * 1536 + c]);
        y *= siluf(bf2f(Z[(size_t)row * 1024 + c])); v[j] = y; ss += y * y; }
    float ms = block_sum256(ss, red) * (1.f / 1024.f);
    float r = rsqrtf(ms + 1e-6f);
#pragma unroll
    for (int j = 0; j < 4; ++j) { int c = tid + 256 * j; MIX[(size_t)row * 2048 + 1024 + c] = f2bf(v[j] * r * g[c]); }
}
__global__ void nv_qk_prep_kernel(bf16_t* Q, bf16_t* KB, const float* qg, const float* kg) {
    __shared__ float xs[128]; __shared__ float red[2];
    const int row = blockIdx.x, hh = blockIdx.y, d = threadIdx.x;
    bf16_t* p; bool rope; int t = 0;
    if (hh < 8) { if (row >= NLAT) return; p = Q + (size_t)row * 1024 + hh * 128; rope = true; t = row % SEQ; }
    else { if (row >= NBATCH * SLEN) return; p = KB + (size_t)row * 256 + (hh - 8) * 128; const int key = row % SLEN; rope = key >= CTXL; t = key - CTXL; }
    float x = bf2f(p[d]);
    float s = x * x;
    for (int o = 32; o > 0; o >>= 1) s += __shfl_xor(s, o);
    if ((d & 63) == 0) red[d >> 6] = s;
    __syncthreads();
    const float ms = (red[0] + red[1]) * (1.f / 128.f);
    const float xn = x * rsqrtf(ms + 1e-6f) * (hh < 8 ? qg[d] : kg[d]);
    xs[d] = xn;
    __syncthreads();
    float out = xn;
    if (rope) {
        const int i = d & 63; const int fi = i & 31;
        const float pos = (i < 32) ? (float)(t / 64) : (float)(t % 64);
        const float invf = expf(-(float)fi * (9.210340371976184f / 32.f));
        float sn, cs; sincosf(pos * invf, &sn, &cs);
        out = (d < 64) ? (xs[d] * cs - xs[d + 64] * sn) : (xs[d] * cs + xs[d - 64] * sn);
    }
    p[d] = f2bf(out);
}
__global__ void nv_softmax_kernel(float* S, int ncols, float scale) {
    __shared__ float red[4];
    float* s = S + (size_t)blockIdx.x * ncols; const int tid = threadIdx.x;
    float mx = -1e30f;
    for (int j = tid; j < ncols; j += 256) mx = fmaxf(mx, s[j]);
    for (int o = 32; o > 0; o >>= 1) mx = fmaxf(mx, __shfl_xor(mx, o));
    __syncthreads(); if ((tid & 63) == 0) red[tid >> 6] = mx; __syncthreads();
    mx = fmaxf(fmaxf(red[0], red[1]), fmaxf(red[2], red[3]));
    float sum = 0.f;
    for (int j = tid; j < ncols; j += 256) { float e = expf((s[j] - mx) * scale); s[j] = e; sum += e; }
    sum = block_sum256(sum, red);
    const float inv = 1.f / sum;
    for (int j = tid; j < ncols; j += 256) s[j] *= inv;
}
template <typename T> __device__ __forceinline__ float4 ld4(const T* p);
template <> __device__ __forceinline__ float4 ld4<float>(const float* p) { return *(const float4*)p; }
template <> __device__ __forceinline__ float4 ld4<bf16_t>(const bf16_t* p) { const u32x2 w = *(const u32x2*)p; return make_float4(__uint_as_float(w.x << 16), __uint_as_float(w.x & 0xffff0000u), __uint_as_float(w.y << 16), __uint_as_float(w.y & 0xffff0000u)); }
__device__ __forceinline__ void st4(float* p, float4 v) { *(float4*)p = v; }
__device__ __forceinline__ void st4(bf16_t* p, float4 v) { u32x2 w; w.x = pk2(v.x, v.y); w.y = pk2(v.z, v.w); *(u32x2*)p = w; }
template <typename TA, typename TB, typename TC>
__global__ void __launch_bounds__(256) nv_gemm_kernel(const TA* A, int lda, const TB* B, int ldb, TC* C, int ldc, int M, int N, int K, int bt) {
    __shared__ float As[16][128 + 4];
    __shared__ float Bs[16][128 + 4];
    const int m0 = blockIdx.y * 128, n0 = blockIdx.x * 128;
    const int tid = threadIdx.x, tx = tid & 15, ty = tid >> 4;
    float acc[8][8];
#pragma unroll
    for (int i = 0; i < 8; ++i)
#pragma unroll
        for (int j = 0; j < 8; ++j) acc[i][j] = 0.f;
    for (int k0 = 0; k0 < K; k0 += 16) {
#pragma unroll
        for (int i = 0; i < 2; ++i) { const int idx = tid + i * 256, r = idx >> 2, kq = idx & 3; float4 v = make_float4(0.f, 0.f, 0.f, 0.f);
            if (m0 + r < M) v = ld4<TA>(A + (size_t)(m0 + r) * lda + k0 + kq * 4);
            As[kq * 4 + 0][r] = v.x; As[kq * 4 + 1][r] = v.y; As[kq * 4 + 2][r] = v.z; As[kq * 4 + 3][r] = v.w; }
        if (!bt) {
#pragma unroll
            for (int i = 0; i < 2; ++i) { const int idx = tid + i * 256, kk = idx >> 5, nq = idx & 31, gn = n0 + nq * 4; float4 v = make_float4(0.f, 0.f, 0.f, 0.f);
                if (gn < N) v = ld4<TB>(B + (size_t)(k0 + kk) * ldb + gn);
                *(float4*)&Bs[kk][nq * 4] = v; }
        } else {
#pragma unroll
            for (int i = 0; i < 2; ++i) { const int idx = tid + i * 256, n = idx >> 2, kq = idx & 3, gn = n0 + n; float4 v = make_float4(0.f, 0.f, 0.f, 0.f);
                if (gn < N) v = ld4<TB>(B + (size_t)gn * ldb + k0 + kq * 4);
                Bs[kq * 4 + 0][n] = v.x; Bs[kq * 4 + 1][n] = v.y; Bs[kq * 4 + 2][n] = v.z; Bs[kq * 4 + 3][n] = v.w; }
        }
        __syncthreads();
#pragma unroll
        for (int kk = 0; kk < 16; ++kk) {
            const float4 a0 = *(const float4*)&As[kk][ty * 4], a1 = *(const float4*)&As[kk][64 + ty * 4];
            const float4 b0 = *(const float4*)&Bs[kk][tx * 4], b1 = *(const float4*)&Bs[kk][64 + tx * 4];
            const float av[8] = {a0.x, a0.y, a0.z, a0.w, a1.x, a1.y, a1.z, a1.w};
            const float bv[8] = {b0.x, b0.y, b0.z, b0.w, b1.x, b1.y, b1.z, b1.w};
#pragma unroll
            for (int i = 0; i < 8; ++i)
#pragma unroll
                for (int j = 0; j < 8; ++j) acc[i][j] += av[i] * bv[j];
        }
        __syncthreads();
    }
#pragma unroll
    for (int i = 0; i < 8; ++i) {
        const int gm = m0 + (i < 4 ? ty * 4 + i : 64 + ty * 4 + (i - 4));
        if (gm >= M) continue;
#pragma unroll
        for (int jh = 0; jh < 2; ++jh) { const int gn = n0 + jh * 64 + tx * 4; if (gn >= N) continue;
            st4(C + (size_t)gm * ldc + gn, make_float4(acc[i][jh * 4 + 0], acc[i][jh * 4 + 1], acc[i][jh * 4 + 2], acc[i][jh * 4 + 3])); }
    }
}

#ifdef DIAG_SEL
__global__ void dg_count_nonfinite(const bf16_t* p, size_t n, unsigned* cnt) {
    for (size_t i = (size_t)blockIdx.x * 256 + threadIdx.x; i < n; i += (size_t)gridDim.x * 256) {
        if ((p[i] & 0x7f80u) == 0x7f80u) { const unsigned blk = (unsigned)(i >> 15), chain = blk / 66, cid = blk % 66, v = (unsigned)(i >> 7) & 255, d = (unsigned)i & 127;
            atomicAdd(cnt, 1u); if (chain & 1) atomicAdd(cnt + 1, 1u); if (cid < 2) atomicAdd(cnt + 2, 1u); if (d < 32) atomicAdd(cnt + 3, 1u); if ((v & 31) < 16) atomicAdd(cnt + 4, 1u);
            atomicAdd(cnt + 12288 + blk, 1u); }
    }
}
__global__ void dg_reduce(unsigned* cnt) {
    if (threadIdx.x == 0) { unsigned nb = 0, mx = 0; for (int i = 0; i < 1056; ++i) { const unsigned c = cnt[12288 + i]; if (c) ++nb; if (c > mx) mx = c; } cnt[5] = nb; cnt[6] = mx; }
}
__global__ void dg_scale_out(float* out, size_t n, const unsigned* cnt) {
    const unsigned c = cnt[DIAG_SEL];
    const float f = 1.f + 0.01f * ((float)c / (float)DIAG_DIV);
    for (size_t i = (size_t)blockIdx.x * 256 + threadIdx.x; i < n; i += (size_t)gridDim.x * 256) out[i] *= f;
}
#endif
template <typename TA, typename TB, typename TC>
void nv_gemm(hipStream_t st, const TA* A, int lda, const TB* B, int ldb, TC* C, int ldc, int M, int N, int K, int bt) {
    dim3 grid((N + 127) / 128, (M + 127) / 128, 1);
    hipLaunchKernelGGL((nv_gemm_kernel<TA, TB, TC>), grid, dim3(256), 0, st, A, lda, B, ldb, C, ldc, M, N, K, bt);
}
}

static int g_grid = 0;
static void launch_phases(hipStream_t stream, Args a, int lo, int hi, int li = 0) {
    a.ph_lo = lo; a.ph_hi = hi; a.li = li;
    void* args[] = {&a};
    hipError_t e;
    if (hi - lo > 1) e = hipLaunchCooperativeKernel((const void*)mk_fwd, dim3(g_grid), dim3(NTHREADS), args, LDS_BYTES, stream);
    else { hipLaunchKernelGGL(mk_fwd, dim3(g_grid), dim3(NTHREADS), LDS_BYTES, stream, a); e = hipPeekAtLastError(); }
    if (e != hipSuccess) fprintf(stderr, "launch [%d,%d) failed: %s\n", lo, hi, hipGetErrorString(e));
}
extern "C" void kernel_launch(void* const* d_in, const int* in_sizes, int n_in, void* d_out, int out_size, void* d_ws, size_t ws_size, hipStream_t stream) {
    if (g_grid == 0) {
        if (ws_size < WS_END || n_in != 28) { fprintf(stderr, "kernel_launch: ws %zu < %zu or n_in %d\n", ws_size, (size_t)WS_END, n_in); g_grid = -1; return; }
        int dev = 0, cus = 0, per_cu = 0;
        (void)hipGetDevice(&dev); (void)hipDeviceGetAttribute(&cus, hipDeviceAttributeMultiprocessorCount, dev);
        if (hipFuncSetAttribute((const void*)mk_fwd, hipFuncAttributeMaxDynamicSharedMemorySize, LDS_BYTES) != hipSuccess) { fprintf(stderr, "hipFuncSetAttribute failed\n"); g_grid = -1; return; }
        if (hipOccupancyMaxActiveBlocksPerMultiprocessor(&per_cu, (const void*)mk_fwd, NTHREADS, LDS_BYTES) != hipSuccess || per_cu < 1) { fprintf(stderr, "occupancy query failed (%d)\n", per_cu); g_grid = -1; return; }
        g_grid = cus;
        fprintf(stderr, "kernel_launch: cus %d per_cu %d grid %d\n", cus, per_cu, g_grid);
    }
    if (g_grid < 0) return;
    unsigned char* ws = (unsigned char*)d_ws;
    (void)hipMemsetAsync(ws + WS_CTL, 0, 65536, stream);
    Args a{};
    for (int i = 0; i < 28; ++i) a.in[i] = (const float*)d_in[i];
    a.out = (float*)d_out; a.ws = ws;
    const float** in = a.in;

#ifdef EXP_NAIVE_MIXER
    launch_phases(stream, a, PH_PRO, PH_GEMM_IN + 1, 0);
    {
        const bf16_t* QK = (const bf16_t*)(ws + WS_QK); const bf16_t* V = (const bf16_t*)(ws + WS_V); const bf16_t* O = (const bf16_t*)(ws + WS_O); const bf16_t* Z = (const bf16_t*)(ws + WS_Z);
        const bf16_t* XBC = (const bf16_t*)(ws + WS_XBC); bf16_t* XC = (bf16_t*)(ws + WS_XC); const float* GATES = (const float*)(ws + WS_GATES);
        float* HM = (float*)(ws + WS_DC); float* HS = (float*)(ws + WS_DS); bf16_t* MIX = (bf16_t*)(ws + WS_MIX);
#if EXP_NAIVE_MIXER == 2
        launch_phases(stream, a, PH_CONV, PH_CONV + 1);
#else
        hipLaunchKernelGGL(nv_conv_kernel, dim3(NTOK), dim3(256), 0, stream, XBC, in[I_CONVW], in[I_CONVB], XC);
#endif
#if EXP_NAIVE_MIXER == 5
#ifdef DIAG_HOLES
        (void)hipMemsetAsync(ws + WS_DC, 0x3C, (size_t)66 * MiB, stream);
#endif
        launch_phases(stream, a, PH_MLA, PH_MLA + 1);
#ifdef DIAG_SCAN
        launch_phases(stream, a, PH_SCAN, PH_SCAN + 1);
#endif
        hipLaunchKernelGGL(dg_count_nonfinite, dim3(2048), dim3(256), 0, stream, (const bf16_t*)(ws + WS_DC), (size_t)16 * 66 * 32768, (unsigned*)(ws + WS_CTL) + 16);
        hipLaunchKernelGGL(dg_reduce, dim3(1), dim3(64), 0, stream, (unsigned*)(ws + WS_CTL) + 16);
#endif
#if EXP_NAIVE_MIXER == 3
        launch_phases(stream, a, PH_MLA, PH_MLA + 1); launch_phases(stream, a, PH_SCAN, PH_SCAN + 1); launch_phases(stream, a, PH_MLC, PH_MLC + 1);
#endif
#if EXP_NAIVE_MIXER == 4
        launch_phases(stream, a, PH_SSA, PH_SSA + 1); launch_phases(stream, a, PH_SCAN, PH_SCAN + 1); launch_phases(stream, a, PH_SSC, PH_SSC + 1);
#endif
#if EXP_NAIVE_MIXER != 3
        hipLaunchKernelGGL(nv_mlstm_rec_kernel, dim3(16, 4, 2), dim3(256), 0, stream, QK, V, GATES, HM, 0);
        hipLaunchKernelGGL(nv_mlstm_rec_kernel, dim3(16, 4, 2), dim3(256), 0, stream, QK, V, GATES, HM, 1);
        hipLaunchKernelGGL(nv_finish_m_kernel, dim3(NTOK), dim3(256), 0, stream, HM, O, in[I_MNG], MIX);
#endif
#if EXP_NAIVE_MIXER != 4
        hipLaunchKernelGGL(nv_ssd_rec_kernel, dim3(16, 2), dim3(256), 0, stream, XC, GATES, in[I_ALOG], HS, 0);
        hipLaunchKernelGGL(nv_ssd_rec_kernel, dim3(16, 2), dim3(256), 0, stream, XC, GATES, in[I_ALOG], HS, 1);
        hipLaunchKernelGGL(nv_finish_s_kernel, dim3(NTOK), dim3(256), 0, stream, HS, Z, XC, in[I_SSMD], in[I_SNG], MIX);
#endif
    }
    launch_phases(stream, a, PH_GEMM_OUT - 1, PH_COUNT, 1);
#if EXP_NAIVE_MIXER == 5
    hipLaunchKernelGGL(dg_scale_out, dim3(2048), dim3(256), 0, stream, (float*)d_out, (size_t)NLAT * D, (const unsigned*)(ws + WS_CTL) + 16);
#endif
#else
    launch_phases(stream, a, PH_PRO, PH_COUNT);
#endif
}
```

```cpp
#include <hip/hip_runtime.h>
#include <hip/hip_cooperative_groups.h>
#include <cstdint>
#include <cstdio>
namespace cg = cooperative_groups;

namespace pg8 {
#define PG8_LAS __attribute__((address_space(3)))
typedef unsigned short bf16_t;
typedef short bf16x8 __attribute__((ext_vector_type(8)));
typedef float f32x4 __attribute__((ext_vector_type(4)));
typedef unsigned u32x4 __attribute__((ext_vector_type(4)));
constexpr int BM = 256, BK = 64, HALF = 128, HTB = HALF * BK * 2  , STAGE_BYTES = 8 * HTB, NXCD = 8, WGM = 8;

__host__ __device__ __forceinline__ int lds_byte(int r, int c) { const int st = (r >> 4) * 2 + (c >> 5), rr = r & 15, cc = c & 31, ob = rr * 64 + cc * 2; return st * 1024 + (ob ^ (((ob >> 9) & 1) << 5)); }
__host__ __device__ __forceinline__ void stage_rc(int b, int& R, int& C) { const int st = b / 1024, sb = b % 1024, swz = sb ^ (((sb >> 9) & 1) << 5); R = (st >> 1) * 16 + swz / 64; C = (st & 1) * 32 + (swz % 64) / 2; }
__host__ __device__ __forceinline__ int perm32(int rho) { const int n = rho >> 4, i = rho & 15; return 8 * (i >> 2) + 4 * n + (i & 3); }

struct Unit { int pm, pn; };
struct Gemm { const bf16_t* A; const bf16_t* Bt; int M, N, K; };

struct StaticOrder {
    int nM, nN, nwg, G, c;
    __host__ __device__ void init(int M, int N, int G_, int c_) { nM = M / BM; nN = N / BM; nwg = nM * nN; G = G_; c = c_; }
    __host__ __device__ bool next(int i, Unit& u) const {
        const long L = (long)i * G + c; if (L >= nwg) return false;
        int wgid = (int)L; { const int q = nwg / NXCD, r = nwg % NXCD, xcd = wgid % NXCD, off = wgid / NXCD; wgid = (xcd < r ? xcd * (q + 1) : r * (q + 1) + (xcd - r) * q) + off; }
        const int nig = WGM * nN, gid = wgid / nig, fm = gid * WGM, gsz = (nM - fm) < WGM ? (nM - fm) : WGM;
        u.pm = fm + ((wgid % nig) % gsz); u.pn = (wgid % nig) / gsz; return true;
    }
    static constexpr bool LATE = false;
    __device__ __forceinline__ void a_ready(const Unit&) const {}
    __device__ __forceinline__ void done(const Unit&) const {}
    __device__ __forceinline__ void late(const Unit&) const {}
};

template <class Epi, class Sched, bool ALIGN_EPI = false, bool SP2 = false, bool GATHER = false>
__device__ __forceinline__ void gemm_phase(PG8_LAS unsigned char* lds, const Gemm g, const Sched& S, const Epi& E, const int tid) {
    const int wid = __builtin_amdgcn_readfirstlane(tid >> 6), lane = tid & 63, wr = wid >> 2, wc = wid & 3, fr = lane & 15, fq = lane >> 4;
    const int K = g.K, nt = K / BK;
    unsigned voffA[2], voffB[2];
#pragma unroll
    for (int i = 0; i < 2; ++i) { int R, C; stage_rc(tid * 16 + i * 8192, R, C); const int Rb = Epi::PERM ? ((R & ~31) + perm32(R & 31)) : R;
        voffA[i] = (unsigned)(R * K + C) * 2u; voffB[i] = (unsigned)(Rb * K + C) * 2u; }
    static_assert(!GATHER || SP2, "GATHER needs the SP2 loop");
    int gR0 = 0; unsigned gC2 = 0; { int R, C; stage_rc(tid * 16, R, C); gR0 = R; gC2 = (unsigned)C * 2u; }
    unsigned vA[2][2] = {{0u, 0u}, {0u, 0u}}, vN[2][2] = {{0u, 0u}, {0u, 0u}};
    const char* gA = (const char*)g.A;
#define PG8_GV(v, u) do { _Pragma("unroll") for (int h_ = 0; h_ < 2; ++h_) _Pragma("unroll") for (int i_ = 0; i_ < 2; ++i_) v[h_][i_] = (unsigned)S.arow(u, h_ * HALF + gR0 + 64 * i_) * (unsigned)(K * 2) + gC2; } while (0)
    const size_t kstep = (size_t)(BK * 2);
    const size_t hstep = (size_t)HALF * K * 2;
    const size_t tstep = 2 * hstep;
    const unsigned ldsw = (unsigned)wid * 1024u;
    const int aoff = lds_byte(wr * 64 + fr, fq * 8), boff = lds_byte(wc * 32 + fr, fq * 8);
#define PG8_SA(b, h) (((b) * 2 + (h)) * HTB)
#define PG8_SB(b, h) ((4 + (b) * 2 + (h)) * HTB)
#define PG8_STAGE(bufoff, gbase, voff) do { _Pragma("unroll") for (int _i = 0; _i < 2; ++_i) \
        __builtin_amdgcn_global_load_lds((const unsigned*)((const char*)(gbase) + (voff)[_i]), (PG8_LAS unsigned*)(lds + (bufoff) + ldsw + _i * 8192), 16, 0, 0); } while (0)
#define PG8_LDA(dst, b, h) do { _Pragma("unroll") for (int m = 0; m < 4; ++m) _Pragma("unroll") for (int k = 0; k < 2; ++k) dst[m][k] = *(const PG8_LAS bf16x8*)(lds + PG8_SA(b, h) + aoff + m * 2048 + k * 1024); } while (0)
#define PG8_LDB(dst, b, h) do { _Pragma("unroll") for (int n = 0; n < 2; ++n) _Pragma("unroll") for (int k = 0; k < 2; ++k) dst[n][k] = *(const PG8_LAS bf16x8*)(lds + PG8_SB(b, h) + boff + n * 2048 + k * 1024); } while (0)
#define PG8_MMA(ai, bj, At, Bt) do { __builtin_amdgcn_s_setprio(1); _Pragma("unroll") for (int m = 0; m < 4; ++m) _Pragma("unroll") for (int n = 0; n < 2; ++n) _Pragma("unroll") for (int k = 0; k < 2; ++k) \
        acc[ai][bj][m][n] = __builtin_amdgcn_mfma_f32_16x16x32_bf16(Bt[n][k], At[m][k], acc[ai][bj][m][n], 0, 0, 0); __builtin_amdgcn_s_setprio(0); } while (0)
#define PG8_WAIT_V(n) asm volatile("s_waitcnt vmcnt(" #n ")" ::: "memory")
#define PG8_WAIT_L(n) asm volatile("s_waitcnt lgkmcnt(" #n ")" ::: "memory")
#define PG8_BAR __builtin_amdgcn_s_barrier()
#define PG8_SCHED __builtin_amdgcn_sched_barrier(0)
    Unit cur, nxt, prv; int ui = 0;
    if (!S.next(0, cur)) return;
    f32x4 acc[2][2][4][2];
#pragma unroll
    for (int a = 0; a < 2; ++a)
#pragma unroll
        for (int b = 0; b < 2; ++b)
#pragma unroll
            for (int m = 0; m < 4; ++m)
#pragma unroll
                for (int n = 0; n < 2; ++n) acc[a][b][m][n] = (f32x4){0.f, 0.f, 0.f, 0.f};
    bf16x8 At[4][2], B0[2][2], B1[2][2];
    const char* cA = (const char*)g.A + (size_t)cur.pm * tstep; const char* cB = (const char*)g.Bt + (size_t)cur.pn * tstep;
    S.a_ready(cur);
    if constexpr (SP2) {
        if constexpr (GATHER) { PG8_GV(vA, cur); }
        PG8_STAGE(PG8_SB(0, 0), cB, voffB); PG8_STAGE(PG8_SB(0, 1), cB + hstep, voffB);
        if constexpr (GATHER) { PG8_STAGE(PG8_SA(0, 0), gA, vA[0]); PG8_STAGE(PG8_SA(0, 1), gA, vA[1]); } else { PG8_STAGE(PG8_SA(0, 0), cA, voffA); PG8_STAGE(PG8_SA(0, 1), cA + hstep, voffA); }
        if (wr == 1) PG8_BAR;
        PG8_WAIT_V(2); PG8_BAR;
        PG8_STAGE(PG8_SB(1, 0), cB + kstep, voffB); if constexpr (GATHER) { PG8_STAGE(PG8_SA(1, 0), gA + kstep, vA[0]); } else { PG8_STAGE(PG8_SA(1, 0), cA + kstep, voffA); } PG8_STAGE(PG8_SB(1, 1), cB + hstep + kstep, voffB);
        PG8_WAIT_V(6); PG8_BAR;
    } else {
        PG8_STAGE(PG8_SB(0, 0), cB, voffB); PG8_STAGE(PG8_SA(0, 0), cA, voffA); PG8_STAGE(PG8_SB(0, 1), cB + hstep, voffB); PG8_STAGE(PG8_SA(0, 1), cA + hstep, voffA);
        if (wr == 1) PG8_BAR;
        PG8_WAIT_V(4); PG8_BAR;
        PG8_STAGE(PG8_SB(1, 0), cB + kstep, voffB); PG8_STAGE(PG8_SA(1, 0), cA + kstep, voffA); PG8_STAGE(PG8_SB(1, 1), cB + hstep + kstep, voffB);
        PG8_WAIT_V(6); PG8_BAR;
    }
    for (;;) {
        const bool has_next = S.next(ui + 1, nxt);
        if constexpr (GATHER) { if (has_next) { PG8_GV(vN, nxt); } else { _Pragma("unroll") for (int h_ = 0; h_ < 2; ++h_) _Pragma("unroll") for (int i_ = 0; i_ < 2; ++i_) vN[h_][i_] = vA[h_][i_]; } }
        const char* nA = has_next ? (const char*)g.A + (size_t)nxt.pm * tstep : cA; const char* nB = has_next ? (const char*)g.Bt + (size_t)nxt.pn * tstep : cB;
        for (int t = 0; t < nt; t += 2) {
            if constexpr (Epi::MIDK) { if (t == nt / 2) E.midk(acc, cur, wr, wc, fr, fq); }
            if constexpr (Sched::LATE) { if (t == 2 && ui > 0) S.late(prv); }
            const bool last = (t == nt - 2);
            const char* a1 = cA + (size_t)(t + 1) * kstep;
            const char* a2 = last ? nA : cA + (size_t)(t + 2) * kstep; const char* b2 = last ? nB : cB + (size_t)(t + 2) * kstep;
            const char* a3 = a2 + kstep; const char* b3 = b2 + kstep;
            if (last && has_next) S.a_ready(nxt);
            const size_t ka1 = (size_t)(t + 1) * kstep, ka2 = last ? (size_t)0 : (size_t)(t + 2) * kstep, ka3 = ka2 + kstep;
            unsigned vs0[2] = {last ? vN[0][0] : vA[0][0], last ? vN[0][1] : vA[0][1]}, vs1[2] = {last ? vN[1][0] : vA[1][0], last ? vN[1][1] : vA[1][1]};
            if constexpr (SP2) {
            PG8_LDB(B0, 0, 0); PG8_LDB(B1, 0, 1); PG8_SCHED; PG8_LDA(At, 0, 0); if constexpr (GATHER) { PG8_STAGE(PG8_SA(1, 1), gA + ka1, vA[1]); } else { PG8_STAGE(PG8_SA(1, 1), a1 + hstep, voffA); }
            PG8_WAIT_V(8); PG8_WAIT_L(0); PG8_BAR; PG8_MMA(0, 0, At, B0); PG8_MMA(0, 1, At, B1); PG8_BAR; PG8_SCHED;
            PG8_LDA(At, 0, 1); PG8_STAGE(PG8_SB(0, 0), b2, voffB); PG8_STAGE(PG8_SB(0, 1), b2 + hstep, voffB); if constexpr (GATHER) { PG8_STAGE(PG8_SA(0, 0), gA + ka2, vs0); } else { PG8_STAGE(PG8_SA(0, 0), a2, voffA); }
            PG8_WAIT_V(8); PG8_WAIT_L(0); PG8_BAR; PG8_MMA(1, 0, At, B0); PG8_MMA(1, 1, At, B1); PG8_BAR; PG8_SCHED;
            PG8_LDB(B0, 1, 0); PG8_LDB(B1, 1, 1); PG8_SCHED; PG8_LDA(At, 1, 0); if constexpr (GATHER) { PG8_STAGE(PG8_SA(0, 1), gA + ka2, vs1); } else { PG8_STAGE(PG8_SA(0, 1), a2 + hstep, voffA); }
            PG8_WAIT_V(8); PG8_WAIT_L(0); PG8_BAR; PG8_MMA(0, 0, At, B0); PG8_MMA(0, 1, At, B1); PG8_BAR; PG8_SCHED;
            PG8_LDA(At, 1, 1); PG8_STAGE(PG8_SB(1, 0), b3, voffB); PG8_STAGE(PG8_SB(1, 1), b3 + hstep, voffB); if constexpr (GATHER) { PG8_STAGE(PG8_SA(1, 0), gA + ka3, vs0); } else { PG8_STAGE(PG8_SA(1, 0), a3, voffA); }
            PG8_WAIT_V(8); PG8_WAIT_L(0); PG8_BAR; PG8_MMA(1, 0, At, B0); PG8_MMA(1, 1, At, B1); PG8_BAR; PG8_SCHED;
            } else {
            PG8_LDB(B0, 0, 0); PG8_SCHED; PG8_LDA(At, 0, 0); PG8_STAGE(PG8_SA(1, 1), a1 + hstep, voffA);
            PG8_WAIT_L(8); PG8_BAR; PG8_WAIT_L(0); PG8_MMA(0, 0, At, B0); PG8_BAR; PG8_SCHED;
            PG8_LDB(B1, 0, 1); PG8_STAGE(PG8_SB(0, 0), b2, voffB);
            PG8_BAR; PG8_WAIT_L(0); PG8_MMA(0, 1, At, B1); PG8_BAR;
            PG8_LDA(At, 0, 1); PG8_STAGE(PG8_SA(0, 0), a2, voffA);
            PG8_BAR; PG8_WAIT_L(0); PG8_MMA(1, 0, At, B0); PG8_BAR; PG8_SCHED;
            PG8_STAGE(PG8_SB(0, 1), b2 + hstep, voffB);
            PG8_WAIT_V(6); PG8_BAR; PG8_MMA(1, 1, At, B1); PG8_BAR;
            PG8_LDB(B0, 1, 0); PG8_SCHED; PG8_LDA(At, 1, 0); PG8_STAGE(PG8_SA(0, 1), a2 + hstep, voffA);
            PG8_WAIT_L(8); PG8_BAR; PG8_WAIT_L(0); PG8_MMA(0, 0, At, B0); PG8_BAR; PG8_SCHED;
            PG8_LDB(B1, 1, 1); PG8_STAGE(PG8_SB(1, 0), b3, voffB);
            PG8_BAR; PG8_WAIT_L(0); PG8_MMA(0, 1, At, B1); PG8_BAR;
            PG8_LDA(At, 1, 1); PG8_STAGE(PG8_SA(1, 0), a3, voffA);
            PG8_BAR; PG8_WAIT_L(0); PG8_MMA(1, 0, At, B0); PG8_BAR; PG8_SCHED;
            PG8_STAGE(PG8_SB(1, 1), b3 + hstep, voffB);
            PG8_WAIT_V(6); PG8_BAR; PG8_MMA(1, 1, At, B1); PG8_BAR;
            }
        }
        if constexpr (ALIGN_EPI) { if (wr == 0) PG8_BAR; }
        if constexpr (!Epi::AFTER_DRAIN) { E(acc, cur, wr, wc, fr, fq); S.done(cur); }
        if constexpr (Sched::LATE) prv = cur;
        if (!has_next) break;
#pragma unroll
        for (int a = 0; a < 2; ++a)
#pragma unroll
            for (int b = 0; b < 2; ++b)
#pragma unroll
                for (int m = 0; m < 4; ++m)
#pragma unroll
                    for (int n = 0; n < 2; ++n) acc[a][b][m][n] = (f32x4){0.f, 0.f, 0.f, 0.f};
        cur = nxt; cA = nA; cB = nB; ++ui;
        if constexpr (GATHER) { _Pragma("unroll") for (int h_ = 0; h_ < 2; ++h_) _Pragma("unroll") for (int i_ = 0; i_ < 2; ++i_) vA[h_][i_] = vN[h_][i_]; }
        if constexpr (ALIGN_EPI) { if (wr == 1) PG8_BAR; }
    }
    PG8_WAIT_V(0);
    if constexpr (Sched::LATE) S.late(cur);
    if constexpr (!ALIGN_EPI) { if (wr == 0) PG8_BAR; }
    PG8_BAR;
    if constexpr (Epi::AFTER_DRAIN) { E.fused(acc, cur, wr, wc, fr, fq, lds, wid, lane); S.done(cur); }
#undef PG8_GV
#undef PG8_SA
#undef PG8_SB
#undef PG8_STAGE
#undef PG8_LDA
#undef PG8_LDB
#undef PG8_MMA
#undef PG8_WAIT_V
#undef PG8_WAIT_L
#undef PG8_BAR
#undef PG8_SCHED
}
}
namespace attn {
using bf16 = unsigned short;
constexpr int D = 128, NW = 8, QBLK = 32, KVBLK = 64;
constexpr float SCALE = 0.088388347648318440f;
constexpr float THR = 8.f;
constexpr int LDQ = 1024, LDK = 256, LDO = 1024;
constexpr size_t SHM_V = KVBLK * D * 2, SHM_K = KVBLK * D * 2, SHM_ATTN = 2 * SHM_V + 2 * SHM_K + NW * 64 * 4;
using bf16x8 = __attribute__((ext_vector_type(8))) short;
using s16x4  = __attribute__((ext_vector_type(4))) short;
using f32x16 = __attribute__((ext_vector_type(16))) float;
using f32x8  = __attribute__((ext_vector_type(8))) float;
using u32x4  = __attribute__((ext_vector_type(4))) unsigned;
#define KSWZ(row, colB) ((row) * 256 + ((colB) ^ (((row) & 7) << 4)))
#define SBAR() __builtin_amdgcn_sched_barrier(0)
__device__ __forceinline__ int crow(int r, int hi) { return (r & 3) + 8 * (r >> 2) + 4 * hi; }
__device__ __forceinline__ unsigned cvtpk(float lo, float hi) {
  unsigned r; asm volatile("v_cvt_pk_bf16_f32 %0, %1, %2" : "=v"(r) : "v"(lo), "v"(hi)); return r;
}
template <typename TIn> struct Stage;
template <> struct Stage<bf16>  { using T = bf16x8;
  __device__ static __forceinline__ T ld8(const bf16* p) { return *reinterpret_cast<const bf16x8*>(p); }
  __device__ static __forceinline__ bf16x8 tobf(T x) { return x; } };
template <> struct Stage<float> { using T = f32x8;
  __device__ static __forceinline__ T ld8(const float* p) { return *reinterpret_cast<const f32x8*>(p); }
  __device__ static __forceinline__ bf16x8 tobf(T x) {
    u32x4 w = {cvtpk(x[0], x[1]), cvtpk(x[2], x[3]), cvtpk(x[4], x[5]), cvtpk(x[6], x[7])}; return *reinterpret_cast<bf16x8*>(&w); } };

template <bool NOREF> __device__ __forceinline__ void partialSM(f32x16& p0, f32x16& p1, float& m_reg, float& mn, float& alpha) {
  if constexpr (NOREF) { alpha = 1.f; for (int r = 0; r < 16; ++r) p0[r] = __builtin_amdgcn_exp2f(p0[r]); return; }
  constexpr float C = SCALE * 1.4426950408889634f;
  float pmax = p0[0]; for (int r = 1; r < 16; ++r) pmax = fmaxf(pmax, p0[r]); for (int r = 0; r < 16; ++r) pmax = fmaxf(pmax, p1[r]);
  { auto rr = __builtin_amdgcn_permlane32_swap(__float_as_uint(pmax), __float_as_uint(pmax), false, false);
    pmax = fmaxf(__uint_as_float(rr[0]), __uint_as_float(rr[1])); }
  if (__builtin_expect(__all(pmax - m_reg <= THR / SCALE), 1)) { mn = m_reg; alpha = 1.f; }
  else { mn = fmaxf(m_reg, pmax); alpha = __builtin_amdgcn_exp2f((m_reg - mn) * C); m_reg = mn; }
  float mnC = -mn * C;
  for (int r = 0; r < 16; ++r) p0[r] = fmaf(p0[r], C, mnC); for (int r = 0; r < 16; ++r) p1[r] = fmaf(p1[r], C, mnC);
  for (int r = 0; r < 16; ++r) p0[r] = __builtin_amdgcn_exp2f(p0[r]);
}
template <bool NOREF> __device__ __forceinline__ void finishSM(f32x16& p0, f32x16& p1, float alpha, float& l_reg, bf16x8& pa0, bf16x8& pa1, bf16x8& pa2, bf16x8& pa3) {
  for (int r = 0; r < 16; ++r) p1[r] = __builtin_amdgcn_exp2f(p1[r]);
  float ps = 0; for (int r = 0; r < 16; ++r) ps += p0[r]; for (int r = 0; r < 16; ++r) ps += p1[r];
  if constexpr (NOREF) { l_reg += ps; }
  else {
  { auto rr = __builtin_amdgcn_permlane32_swap(__float_as_uint(ps), __float_as_uint(ps), false, false);
    ps = __uint_as_float(rr[0]) + __uint_as_float(rr[1]); }
  l_reg = l_reg * alpha + ps; }
#define PK4(P, BASE, OUT) do { unsigned a0 = cvtpk(P[BASE + 0], P[BASE + 1]), a1 = cvtpk(P[BASE + 2], P[BASE + 3]);   \
    unsigned b0 = cvtpk(P[BASE + 4], P[BASE + 5]), b1 = cvtpk(P[BASE + 6], P[BASE + 7]);                              \
    auto r0 = __builtin_amdgcn_permlane32_swap(a0, b0, false, false); auto r1 = __builtin_amdgcn_permlane32_swap(a1, b1, false, false); \
    u32x4 w = {r0[0], r1[0], r0[1], r1[1]}; OUT = *reinterpret_cast<bf16x8*>(&w); } while (0)
  PK4(p0, 0, pa0); PK4(p0, 8, pa1); PK4(p1, 0, pa2); PK4(p1, 8, pa3);
#undef PK4
}
__device__ __forceinline__ void qkt(f32x16& p0, f32x16& p1, const bf16* Ks, const bf16x8* qr, int r32, int hi) {
  p0 = f32x16{}; p1 = f32x16{};
  for (int d0 = 0; d0 < 8; ++d0) { int cb = (d0 * 16 + hi * 8) * 2;
    bf16x8 b0 = *reinterpret_cast<const bf16x8*>((const char*)Ks + KSWZ(r32, cb));
    bf16x8 b1 = *reinterpret_cast<const bf16x8*>((const char*)Ks + KSWZ(32 + r32, cb));
    p0 = __builtin_amdgcn_mfma_f32_32x32x16_bf16(b0, qr[d0], p0, 0, 0, 0);
    p1 = __builtin_amdgcn_mfma_f32_32x32x16_bf16(b1, qr[d0], p1, 0, 0, 0); }
}
__device__ __forceinline__ int v_st(int k, int c) { const int kk = (k & ~0xC) | ((k & 4) << 1) | ((k & 8) >> 1); return ((kk >> 3) * 4 + (c >> 5)) * 512 + ((kk & 7) * 32 + (c & 31)) * 2; }
__device__ __forceinline__ int v_rd_base(int lane) { return ((lane & 3) << 3) | (((lane >> 2) & 3) << 6) | (((lane >> 4) & 1) << 5) | (((lane >> 5) & 1) << 8); }
constexpr int v_rd_off(int d0, int ks, int half) { return d0 * 512 + ks * 4096 + half * 2048; }
template <int OFF> __device__ __forceinline__ s16x4 tr_read(int vb) {
  s16x4 r; asm volatile("ds_read_b64_tr_b16 %0, %1 offset:%2" : "=&v"(r) : "v"(vb), "i"(OFF) : "memory"); return r;
}
template <int D0> __device__ __forceinline__ void pv_one(f32x16& od, int vb, bf16x8 pa0, bf16x8 pa1, bf16x8 pa2, bf16x8 pa3) {
  const s16x4 l0 = tr_read<v_rd_off(D0, 0, 0)>(vb), h0 = tr_read<v_rd_off(D0, 0, 1)>(vb), l1 = tr_read<v_rd_off(D0, 1, 0)>(vb), h1 = tr_read<v_rd_off(D0, 1, 1)>(vb);
  const s16x4 l2 = tr_read<v_rd_off(D0, 2, 0)>(vb), h2 = tr_read<v_rd_off(D0, 2, 1)>(vb), l3 = tr_read<v_rd_off(D0, 3, 0)>(vb), h3 = tr_read<v_rd_off(D0, 3, 1)>(vb);
  asm volatile("s_waitcnt lgkmcnt(0)" ::: "memory"); SBAR();
#define PK(L, H) (bf16x8){L[0], L[1], L[2], L[3], H[0], H[1], H[2], H[3]}
  od = __builtin_amdgcn_mfma_f32_32x32x16_bf16(pa0, PK(l0, h0), od, 0, 0, 0);
  od = __builtin_amdgcn_mfma_f32_32x32x16_bf16(pa1, PK(l1, h1), od, 0, 0, 0);
  od = __builtin_amdgcn_mfma_f32_32x32x16_bf16(pa2, PK(l2, h2), od, 0, 0, 0);
  od = __builtin_amdgcn_mfma_f32_32x32x16_bf16(pa3, PK(l3, h3), od, 0, 0, 0);
#undef PK
}
__device__ __forceinline__ void pv_d0(f32x16* o, int vb, bf16x8 pa0, bf16x8 pa1, bf16x8 pa2, bf16x8 pa3) {
  pv_one<0>(o[0], vb, pa0, pa1, pa2, pa3); pv_one<1>(o[1], vb, pa0, pa1, pa2, pa3); pv_one<2>(o[2], vb, pa0, pa1, pa2, pa3); pv_one<3>(o[3], vb, pa0, pa1, pa2, pa3);
}

template <typename TQ, bool NOREF, int SDEPTH>
__device__ __forceinline__ void attn_dense_body(const TQ* __restrict__ Qb, const bf16* __restrict__ Kh, const bf16* __restrict__ Vh,
                                                bf16* __restrict__ Ob, int seq, char* lds, const int tid, const float* __restrict__ qg, const int t0, const float* __restrict__ rope) {
  using St = Stage<bf16>; using SQ = Stage<TQ>;
  const int wid = tid >> 6, lane = tid & 63, r32 = lane & 31, hi = lane >> 5;
  bf16* V_lds = (bf16*)lds; bf16* K_lds = (bf16*)(lds + 2 * SHM_V);
  float* ws = (float*)(lds + 2 * SHM_V + 2 * SHM_K) + wid * 64; float* li_l = ws; float* al_l = ws + 32;
  float m_reg = -1e30f, l_reg = 0; f32x16 o[4] = {}; bf16x8 qr[8];
  const TQ* Qw = Qb + (long)(wid * QBLK + r32) * LDQ + hi * 8;
#pragma unroll
  for (int d0 = 0; d0 < 8; ++d0) qr[d0] = SQ::tobf(SQ::ld8(Qw + d0 * 16));
  if (qg) {
    float f[8][8]; float ss = 0.f;
#pragma unroll
    for (int d0 = 0; d0 < 8; ++d0) { const u32x4 w = *reinterpret_cast<const u32x4*>(&qr[d0]);
#pragma unroll
      for (int e = 0; e < 4; ++e) { f[d0][2 * e] = __uint_as_float(w[e] << 16); f[d0][2 * e + 1] = __uint_as_float(w[e] & 0xffff0000u); ss += f[d0][2 * e] * f[d0][2 * e] + f[d0][2 * e + 1] * f[d0][2 * e + 1]; } }
    { auto rr = __builtin_amdgcn_permlane32_swap(__float_as_uint(ss), __float_as_uint(ss), false, false); ss = __uint_as_float(rr[0]) + __uint_as_float(rr[1]); }
    const float rs = rsqrtf(ss * (1.f / 128.f) + 1e-6f);
#pragma unroll
    for (int d0 = 0; d0 < 8; ++d0)
#pragma unroll
      for (int j = 0; j < 8; ++j) f[d0][j] *= rs * qg[16 * d0 + 8 * hi + j] * (NOREF ? SCALE * 1.4426950408889634f : 1.f);
    const int t = t0 + wid * QBLK + r32;
#pragma unroll
    for (int d0 = 0; d0 < 4; ++d0) { const float* rp = rope + (d0 < 2 ? (t / 64) : (t % 64)) * 64;
#pragma unroll
      for (int j = 0; j < 8; ++j) { const int fi = (16 * d0 + 8 * hi + j) & 31; const float cs = rp[2 * fi], sn = rp[2 * fi + 1];
        const float x1 = f[d0][j], x2 = f[d0 + 4][j]; f[d0][j] = x1 * cs - x2 * sn; f[d0 + 4][j] = x2 * cs + x1 * sn; } }
#pragma unroll
    for (int d0 = 0; d0 < 8; ++d0) { u32x4 w = {cvtpk(f[d0][0], f[d0][1]), cvtpk(f[d0][2], f[d0][3]), cvtpk(f[d0][4], f[d0][5]), cvtpk(f[d0][6], f[d0][7])}; qr[d0] = *reinterpret_cast<bf16x8*>(&w); }
  }
  const int sr = tid >> 4, sc = (tid & 15) * 8, vst0 = v_st(sr, sc), vst1 = v_st(32 + sr, sc);
  const int vb0 = (int)(uintptr_t)V_lds + v_rd_base(lane);
  struct { typename St::T vs0, vs1, ks0, ks1; } sr_[SDEPTH];
#define SLOAD(i, k0) do { const unsigned o0_ = (unsigned)(((k0) + sr) * LDK + sc), o1_ = o0_ + 32u * LDK;   \
    sr_[i].vs0 = St::ld8(Vh + o0_); sr_[i].vs1 = St::ld8(Vh + o1_); sr_[i].ks0 = St::ld8(Kh + o0_); sr_[i].ks1 = St::ld8(Kh + o1_); } while (0)
#define SWRITE(b, i) do { *(bf16x8*)((char*)V_lds + (b) * SHM_V + vst0) = St::tobf(sr_[i].vs0);          \
    *(bf16x8*)((char*)V_lds + (b) * SHM_V + vst1) = St::tobf(sr_[i].vs1); int kc = sc * 2;               \
    *(bf16x8*)((char*)K_lds + (b) * SHM_K + KSWZ(sr, kc)) = St::tobf(sr_[i].ks0);                       \
    *(bf16x8*)((char*)K_lds + (b) * SHM_K + KSWZ(32 + sr, kc)) = St::tobf(sr_[i].ks1); } while (0)
#define SWAIT() do { if constexpr (SDEPTH == 2) asm volatile("s_waitcnt vmcnt(4)" ::: "memory"); else asm volatile("s_waitcnt vmcnt(0)" ::: "memory"); } while (0)
#define RESC(a) do { if (!NOREF && __any((a) < 1.f)) { if (hi == 0) al_l[r32] = (a); asm volatile("s_waitcnt lgkmcnt(0)" ::: "memory"); \
    for (int d = 0; d < 4; ++d) for (int r = 0; r < 16; ++r) o[d][r] *= al_l[crow(r, hi)]; } } while (0)
  f32x16 pA0, pA1, pB0, pB1; float mnA, mnB, alA, alB; bf16x8 pa0, pa1, pa2, pa3; const int NT = seq / KVBLK;
  constexpr int SE = 0, SO = SDEPTH - 1;
  SLOAD(SE, 0); asm volatile("s_waitcnt vmcnt(0)" ::: "memory"); SWRITE(0, SE); __syncthreads();
  qkt(pA0, pA1, K_lds, qr, r32, hi); partialSM<NOREF>(pA0, pA1, m_reg, mnA, alA);
  SLOAD(SO, KVBLK); if constexpr (SDEPTH == 2) { if (2 < NT) SLOAD(SE, 2 * KVBLK); }
  SWAIT(); SWRITE(1, SO); __syncthreads();
  for (int j = 1; j + 1 < NT; j += 2) {
    SBAR(); qkt(pB0, pB1, (bf16*)((char*)K_lds + SHM_K), qr, r32, hi);
    finishSM<NOREF>(pA0, pA1, alA, l_reg, pa0, pa1, pa2, pa3); SBAR();
    SLOAD(SO, (j + SDEPTH) * KVBLK); SBAR();
    pv_d0(o, vb0, pa0, pa1, pa2, pa3); partialSM<NOREF>(pB0, pB1, m_reg, mnB, alB);
    __syncthreads(); SWAIT(); SWRITE(0, SE);
    RESC(alB); __syncthreads();
    SBAR(); qkt(pA0, pA1, K_lds, qr, r32, hi);
    finishSM<NOREF>(pB0, pB1, alB, l_reg, pa0, pa1, pa2, pa3); SBAR();
    if (SDEPTH == 1 || j + 3 < NT) SLOAD(SE, (j + 1 + SDEPTH) * KVBLK); SBAR();
    pv_d0(o, vb0 + (int)SHM_V, pa0, pa1, pa2, pa3); partialSM<NOREF>(pA0, pA1, m_reg, mnA, alA);
    __syncthreads(); SWAIT(); SWRITE(1, SO);
    RESC(alA); __syncthreads();
  }
  SBAR(); qkt(pB0, pB1, (bf16*)((char*)K_lds + SHM_K), qr, r32, hi);
  finishSM<NOREF>(pA0, pA1, alA, l_reg, pa0, pa1, pa2, pa3); SBAR();
  pv_d0(o, vb0, pa0, pa1, pa2, pa3); partialSM<NOREF>(pB0, pB1, m_reg, mnB, alB);
  __syncthreads(); RESC(alB);
  finishSM<NOREF>(pB0, pB1, alB, l_reg, pa0, pa1, pa2, pa3); SBAR();
  pv_d0(o, vb0 + (int)SHM_V, pa0, pa1, pa2, pa3);
  if constexpr (NOREF) { auto rr = __builtin_amdgcn_permlane32_swap(__float_as_uint(l_reg), __float_as_uint(l_reg), false, false); l_reg = __uint_as_float(rr[0]) + __uint_as_float(rr[1]); }
  if (hi == 0) li_l[r32] = l_reg; asm volatile("s_waitcnt lgkmcnt(0)" ::: "memory");
  float rli[16];
#pragma unroll
  for (int r = 0; r < 16; ++r) rli[r] = __builtin_amdgcn_rcpf(li_l[crow(r, hi)]);
  bf16* Ow = Ob + (long)(wid * QBLK) * LDO;
#pragma unroll
  for (int r = 0; r < 16; ++r) { int orow = crow(r, hi);
    for (int d0 = 0; d0 < 4; ++d0) Ow[(long)orow * LDO + d0 * 32 + r32] = (bf16)(cvtpk(o[d0][r] * rli[r], 0.f) & 0xffffu); }
#undef SLOAD
#undef SWRITE
#undef SWAIT
#undef RESC
}
}

namespace {
using pg8::bf16_t; using pg8::bf16x8; using pg8::f32x4; using pg8::u32x4;
typedef unsigned u32x2 __attribute__((ext_vector_type(2)));
typedef float f32x16 __attribute__((ext_vector_type(16)));
typedef short s16x4 __attribute__((ext_vector_type(4)));
#define LAS __attribute__((address_space(3)))

constexpr int D = 1024, NBATCH = 2, SEQ = 8192, CTXL = 256;
constexpr int NLAT = NBATCH * SEQ, NCTX = NBATCH * CTXL, NTOK = NLAT + NCTX;
constexpr int SLEN = CTXL + SEQ;
constexpr int NCH = SLEN / 128;
constexpr int ABIN = 5680, NWIN = 5888;
constexpr int NGATE = 48;
constexpr float ALPHA = 1.4142135623730951f;
constexpr int NWAVES = 8, NTHREADS = 512;
constexpr int MOE_MAXTILES = 148;

constexpr size_t MiB = 1u << 20;
constexpr size_t WS_CTL = 0;
constexpr size_t WS_MODV = 64 * 1024;
constexpr size_t WS_ROPE = 208 * 1024;
constexpr size_t WS_DN = 256 * 1024;
constexpr size_t WS_MS = 784 * 1024;
constexpr size_t WS_AEND = 808 * 1024;
constexpr size_t WS_WIN = 1 * MiB;
constexpr size_t WS_WOUT = 12 * MiB + 512 * 1024;
constexpr size_t WS_ATIN = 16 * MiB + 512 * 1024;
constexpr size_t WS_ATOUT = 19 * MiB + 512 * 1024;
constexpr size_t WS_XL = 22 * MiB;
constexpr size_t WS_HB = 88 * MiB;
constexpr size_t WS_MOEW = 121 * MiB;
constexpr size_t WS_ROUTE = 217 * MiB;
constexpr size_t WS_R = 219 * MiB;
constexpr size_t WS_QK = WS_R, WS_V = WS_R + 33 * MiB, WS_O = WS_R + 66 * MiB, WS_Z = WS_R + 99 * MiB, WS_XBC = WS_R + 132 * MiB;
constexpr size_t WS_GATES = WS_R + 182 * MiB;
constexpr size_t WS_SSQ = WS_R + 185 * MiB + 256 * 1024;
constexpr size_t WS_MIX = WS_R + 186 * MiB;
constexpr size_t WS_XC = WS_HB;
constexpr size_t WS_DS = 138 * MiB;
constexpr size_t WS_DC = WS_XL;
constexpr size_t WS_YB = WS_R;
constexpr size_t WS_XS = WS_R, WS_HMID = WS_R + 74 * MiB, WS_YS = WS_R + 148 * MiB;
constexpr size_t WS_Q = WS_R, WS_KB = WS_R + 33 * MiB, WS_VB = WS_R + 42 * MiB, WS_AO = WS_R + 51 * MiB, WS_YB1 = WS_R + 84 * MiB, WS_S = WS_R + 117 * MiB;
constexpr size_t WS_TOKTAB = 472 * MiB;
constexpr size_t WS_MLG = 476 * MiB;
constexpr size_t WS_SSG = 479 * MiB;
constexpr size_t WS_END = 486 * MiB;

constexpr int CW_CNT0 = 64, CW_CNT1 = 128;
constexpr int CW_DEP0 = 256, CW_DEP1 = 512;
constexpr int CW_BAR = 1024;

__device__ __forceinline__ float bf2f(unsigned short v) { return __uint_as_float((unsigned)v << 16); }
typedef float f32x2_t __attribute__((ext_vector_type(2))); typedef __bf16 bf16x2_t __attribute__((ext_vector_type(2)));
__device__ __forceinline__ unsigned pk2(float lo, float hi) { f32x2_t v = {lo, hi}; bf16x2_t b = __builtin_convertvector(v, bf16x2_t); return __builtin_bit_cast(unsigned, b); }
__device__ __forceinline__ bf16_t f2bf(float f) { return (bf16_t)(pk2(f, 0.f) & 0xffffu); }
__device__ __forceinline__ float siluf(float x) { return x * __builtin_amdgcn_rcpf(1.f + __expf(-x)); }
__device__ __forceinline__ float sigmf(float x) { return __builtin_amdgcn_rcpf(1.f + __expf(-x)); }
__device__ __forceinline__ float softplusf(float x) { return x > 20.f ? x : log1pf(expf(x)); }
__device__ __forceinline__ float logsigf(float x) { return -softplusf(-x); }
__device__ __forceinline__ float wave_sum(float v) {
#pragma unroll
    for (int o = 1; o < 64; o <<= 1) v += __shfl_xor(v, o);
    return v;
}
__device__ __forceinline__ float wave_max(float v) {
#pragma unroll
    for (int o = 1; o < 64; o <<= 1) v = fmaxf(v, __shfl_xor(v, o));
    return v; }
__device__ __forceinline__ unsigned char* launder_ptr(unsigned char* p) { asm volatile("" : "+s"(p)); return p; }
__device__ __forceinline__ int fresh_lane() { int z = 0; asm volatile("" : "+s"(z)); return (int)__builtin_amdgcn_mbcnt_hi(~0u, __builtin_amdgcn_mbcnt_lo(~0u, (unsigned)z)); }
__device__ __forceinline__ int mod_index(int row) { return row < NLAT ? row / SEQ : 2; }
__device__ __forceinline__ int seq_row(int b, int dir, int i) {
    if (i < CTXL) { int t = dir ? (CTXL - 1 - i) : i; return NLAT + b * CTXL + t; }
    int t = i - CTXL; if (dir) t = SEQ - 1 - t; return b * SEQ + t;
}
__device__ __forceinline__ int chunk_row0(int b, int cid) { return cid < 2 ? NLAT + b * CTXL + cid * 128 : b * SEQ + (cid - 2) * 128; }
__device__ __forceinline__ int scan_cid(int dir, int p) { return dir == 0 ? p : (p < 2 ? 1 - p : 67 - p); }

struct RowF { f32x4 v[4]; };
__device__ __forceinline__ RowF row_ld_f32(const float* p, int lane) { RowF r; const f32x4* q = (const f32x4*)p + lane;
#pragma unroll
    for (int j = 0; j < 4; ++j) r.v[j] = q[64 * j];
    return r; }
__device__ __forceinline__ RowF row_ld_bf16(const bf16_t* p, int lane) { RowF r; const u32x2* q = (const u32x2*)p + lane;
#pragma unroll
    for (int j = 0; j < 4; ++j) { const u32x2 w = q[64 * j]; r.v[j] = (f32x4){__uint_as_float(w.x << 16), __uint_as_float(w.x & 0xffff0000u), __uint_as_float(w.y << 16), __uint_as_float(w.y & 0xffff0000u)}; }
    return r; }
struct RowRaw { u32x2 w[4]; };
__device__ __forceinline__ RowRaw row_ldraw_bf16(const bf16_t* p, int lane) { RowRaw r; const u32x2* q = (const u32x2*)p + lane;
#pragma unroll
    for (int j = 0; j < 4; ++j) r.w[j] = q[64 * j];
    return r; }
__device__ __forceinline__ RowF row_cvt(const RowRaw& t) { RowF r;
#pragma unroll
    for (int j = 0; j < 4; ++j) r.v[j] = (f32x4){__uint_as_float(t.w[j].x << 16), __uint_as_float(t.w[j].x & 0xffff0000u), __uint_as_float(t.w[j].y << 16), __uint_as_float(t.w[j].y & 0xffff0000u)};
    return r; }
__device__ __forceinline__ void row_st_f32(float* p, int lane, const RowF& r) { f32x4* q = (f32x4*)p + lane;
#pragma unroll
    for (int j = 0; j < 4; ++j) q[64 * j] = r.v[j]; }
__device__ __forceinline__ void row_st_bf16(bf16_t* p, int lane, const RowF& r) { u32x2* q = (u32x2*)p + lane;
#pragma unroll
    for (int j = 0; j < 4; ++j) { u32x2 w; w.x = pk2(r.v[j][0], r.v[j][1]); w.y = pk2(r.v[j][2], r.v[j][3]); q[64 * j] = w; } }
__device__ __forceinline__ float row_sum(const RowF& r) { float s = 0.f;
#pragma unroll
    for (int j = 0; j < 4; ++j) s += (r.v[j][0] + r.v[j][1]) + (r.v[j][2] + r.v[j][3]);
    return wave_sum(s); }
__device__ __forceinline__ void row_layernorm(RowF& r, const float* g, const float* b, int lane) {
    const float mu = row_sum(r) * (1.f / D); float q = 0.f;
#pragma unroll
    for (int j = 0; j < 4; ++j) { r.v[j] = r.v[j] - mu; q += (r.v[j][0] * r.v[j][0] + r.v[j][1] * r.v[j][1]) + (r.v[j][2] * r.v[j][2] + r.v[j][3] * r.v[j][3]); }
    const float rstd = rsqrtf(wave_sum(q) * (1.f / D) + 1e-5f);
    const RowF gg = row_ld_f32(g, lane), bb = row_ld_f32(b, lane);
#pragma unroll
    for (int j = 0; j < 4; ++j) r.v[j] = r.v[j] * rstd * gg.v[j] + bb.v[j];
}
__device__ __forceinline__ RowF row_modulate(const RowF& x, const float* sh, const float* sc, int lane) {
    const RowF s = row_ld_f32(sh, lane), c = row_ld_f32(sc, lane); RowF h;
#pragma unroll
    for (int j = 0; j < 4; ++j) h.v[j] = x.v[j] * (1.f + c.v[j]) + s.v[j];
    return h; }

template <class Dest> struct EpiStore {
    static constexpr bool PERM = true, AFTER_DRAIN = false, MIDK = false; Dest d;
    __device__ __forceinline__ void operator()(const f32x4 (&acc)[2][2][4][2], const pg8::Unit& u, int wr, int wc, int fr, int fq) const {
#pragma unroll
        for (int ai = 0; ai < 2; ++ai)
#pragma unroll
            for (int m = 0; m < 4; ++m) {
                const int row = u.pm * 256 + ai * 128 + wr * 64 + m * 16 + fr;
                bf16_t* rp = d.rowptr(row, u.pn); if (!rp) continue;
#pragma unroll
                for (int bj = 0; bj < 2; ++bj) { const f32x4 v0 = acc[ai][bj][m][0], v1 = acc[ai][bj][m][1];
                    u32x4 w; w.x = pk2(v0[0], v0[1]); w.y = pk2(v0[2], v0[3]); w.z = pk2(v1[0], v1[1]); w.w = pk2(v1[2], v1[3]);
                    *(u32x4*)(rp + bj * 128 + wc * 32 + 8 * fq) = w; }
            }
    }
};
struct DestWin { bf16_t* base;
    __device__ __forceinline__ bf16_t* rowptr(int row, int pn) const {
        if (pn < 16) { const int seg = pn >> 2; return base + (size_t)seg * (33 * MiB / 2) + (size_t)row * 1024 + (pn & 3) * 256; }
        return base + (size_t)4 * (33 * MiB / 2) + (size_t)row * 1536 + (pn - 16) * 256; } };
struct EpiWin {
    static constexpr bool PERM = true, AFTER_DRAIN = false, MIDK = false; EpiStore<DestWin> st; float* gates; const float* igb; const float* fgb; const float* dtb;
    __device__ __forceinline__ void operator()(const f32x4 (&acc)[2][2][4][2], const pg8::Unit& u, int wr, int wc, int fr, int fq) const {
        if (u.pn < 22) { st(acc, u, wr, wc, fr, fq); return; }
        const int c0 = wc * 32 + 8 * fq;
        if (c0 >= NGATE) return;
        float bias[8];
#pragma unroll
        for (int i = 0; i < 8; ++i) { const int c = c0 + i; bias[i] = c < 8 ? igb[c] : (c < 16 ? fgb[c - 8] : dtb[c - 16]); }
#pragma unroll
        for (int ai = 0; ai < 2; ++ai)
#pragma unroll
            for (int m = 0; m < 4; ++m) { const int row = u.pm * 256 + ai * 128 + wr * 64 + m * 16 + fr;
                float v[8];
#pragma unroll
                for (int i = 0; i < 8; ++i) { const float x = acc[ai][0][m][i >> 2][i & 3] + bias[i]; const int c = c0 + i; v[i] = c < 8 ? x : (c < 16 ? logsigf(x) : softplusf(x)); }
                float* gp = gates + (size_t)row * NGATE + c0;
                *(f32x4*)gp = (f32x4){v[0], v[1], v[2], v[3]}; *(f32x4*)(gp + 4) = (f32x4){v[4], v[5], v[6], v[7]}; }
    }
};
struct DestPlain { bf16_t* base; int ld; int pnmask;
    __device__ __forceinline__ bf16_t* rowptr(int row, int pn) const { return base + (size_t)row * ld + (pn & pnmask) * 256; } };
struct DestQKV { bf16_t* q; bf16_t* kb; bf16_t* vb;
    __device__ __forceinline__ bf16_t* rowptr(int row, int pn) const {
        if (pn < 4) return row < NLAT ? q + (size_t)row * 1024 + pn * 256 : nullptr;
        int key; if (row < NLAT) { const int b = row / SEQ, t = row % SEQ; key = b * SLEN + CTXL + t; } else { const int r = row - NLAT; key = (r / CTXL) * SLEN + (r % CTXL); }
        return (pn == 4 ? kb : vb) + (size_t)key * 256; } };
struct EpiWout {
    static constexpr bool PERM = true, AFTER_DRAIN = false, MIDK = true; EpiStore<DestPlain> st; const float* ssq;
    __device__ __forceinline__ void operator()(const f32x4 (&acc)[2][2][4][2], const pg8::Unit& u, int wr, int wc, int fr, int fq) const { st(acc, u, wr, wc, fr, fq); }
    __device__ __forceinline__ void midk(f32x4 (&acc)[2][2][4][2], const pg8::Unit& u, int wr, int wc, int fr, int fq) const {
        const float* p0 = ssq + (size_t)(u.pm * 256 + wr * 64 + fr) * 8; asm volatile("" : "+v"(p0));
#pragma unroll
        for (int ai = 0; ai < 2; ++ai)
#pragma unroll
            for (int m = 0; m < 4; ++m) { const float* p = p0 + (ai * 128 + m * 16) * 8;
                const f32x4 s0 = *(const f32x4*)p, s1 = *(const f32x4*)(p + 4);
                const float r = rsqrtf((((s0[0] + s0[1]) + (s0[2] + s0[3])) + ((s1[0] + s1[1]) + (s1[2] + s1[3]))) * (1.f / 1024.f) + 1e-6f);
#pragma unroll
                for (int bj = 0; bj < 2; ++bj)
#pragma unroll
                    for (int n = 0; n < 2; ++n) acc[ai][bj][m][n] = acc[ai][bj][m][n] * r;
                __builtin_amdgcn_sched_barrier(0); }
    }
};
template <bool WT = false> struct EpiSwigluT {
    static constexpr bool PERM = true, AFTER_DRAIN = false, MIDK = false; bf16_t* out;
    __device__ __forceinline__ void operator()(const f32x4 (&acc)[2][2][4][2], const pg8::Unit& u, int wr, int wc, int fr, int fq) const {
        const int pnl = u.pn & 7;
#pragma unroll
        for (int ai = 0; ai < 2; ++ai)
#pragma unroll
            for (int m = 0; m < 4; ++m) {
                const int row = u.pm * 256 + ai * 128 + wr * 64 + m * 16 + fr;
                bf16_t* rp = out + (size_t)row * 1024 + pnl * 128 + wc * 16 + 4 * fq;
#pragma unroll
                for (int bj = 0; bj < 2; ++bj) { const f32x4 g = acc[ai][bj][m][0], up = acc[ai][bj][m][1];
                    u32x2 w; w.x = pk2(siluf(g[0]) * up[0], siluf(g[1]) * up[1]); w.y = pk2(siluf(g[2]) * up[2], siluf(g[3]) * up[3]);
                    if constexpr (WT) __hip_atomic_store((__attribute__((address_space(1))) unsigned long long*)(rp + bj * 64), (unsigned long long)w.x | ((unsigned long long)w.y << 32), __ATOMIC_RELAXED, __HIP_MEMORY_SCOPE_AGENT);
                    else *(u32x2*)(rp + bj * 64) = w; }
            }
    }
};
using EpiSwiglu = EpiSwigluT<false>;
struct MoeOrder {
    int ntm, npn, nwg, G, c; const LAS int* toff; const int* tab;
    __device__ __forceinline__ void init(const LAS int* toff_, int npn_, int G_, int c_) { toff = toff_; ntm = toff_[16]; npn = npn_; nwg = ntm * npn_; G = G_; c = c_; }
    __device__ __forceinline__ bool next(int i, pg8::Unit& u) const {
        const long L = (long)i * G + c; if (L >= nwg) return false;
        int wgid = (int)L; { const int q = nwg / 8, r = nwg % 8, xcd = wgid % 8, off = wgid / 8; wgid = (xcd < r ? xcd * (q + 1) : r * (q + 1) + (xcd - r) * q) + off; }
        const int pm = wgid / npn, pnl = wgid % npn; int e = 0;
#pragma unroll
        for (int k = 1; k < 16; ++k) e += (toff[k] <= pm) ? 1 : 0;
        u.pm = pm; u.pn = e * npn + pnl; return true;
    }
    __device__ __forceinline__ int arow(const pg8::Unit& u, int r) const { const int e = u.pn / npn, pos = (u.pm - toff[e]) * 256 + r; return pos < toff[100 + e] ? tab[(size_t)e * NTOK + pos] : 0; }
    static constexpr bool LATE = false;
    __device__ __forceinline__ void a_ready(const pg8::Unit&) const {}
    __device__ __forceinline__ void done(const pg8::Unit&) const {}
    __device__ __forceinline__ void late(const pg8::Unit&) const {}
};

struct MoeMerged {
    static constexpr bool LATE = true;
    int m0, nm, nloc, rank, n1c, crot; const LAS int* toff; const int* tab; unsigned* dep; unsigned* tot;
    __device__ __forceinline__ void init(const LAS int* toff_, const int* tab_, unsigned* dep_, unsigned* tot_ = nullptr) {
        toff = toff_; tab = tab_; dep = dep_; tot = tot_; m0 = toff_[120]; nm = toff_[121]; nloc = toff_[122]; rank = toff_[123];
        const int n1 = nm * 8; n1c = rank < n1 ? (n1 - rank + nloc - 1) / nloc : 0; const int rot = n1 % nloc; crot = (rank - rot + nloc) % nloc; }
    __device__ __forceinline__ bool next(int i, pg8::Unit& u) const {
        int pm, pnl, npn, base;
        if (i < n1c) { const int t1 = i * nloc + rank; pm = m0 + (t1 >> 3); pnl = t1 & 7; npn = 8; base = 0; }
        else { const int t2 = (i - n1c) * nloc + crot; if (t2 >= nm * 4) return false; pm = m0 + (t2 >> 2); pnl = t2 & 3; npn = 4; base = 128; }
        int e = 0;
#pragma unroll
        for (int k = 1; k < 16; ++k) e += (toff[k] <= pm) ? 1 : 0;
        u.pm = pm; u.pn = base + e * npn + pnl; return true;
    }
    __device__ __forceinline__ int arow(const pg8::Unit& u, int r) const {
        if (u.pn >= 128) return (int)((WS_HMID - WS_HB) / 2048) + u.pm * 256 + r;
        const int e = u.pn >> 3, pos = (u.pm - toff[e]) * 256 + r; return pos < toff[100 + e] ? tab[(size_t)e * NTOK + pos] : 0; }
    __device__ __forceinline__ void a_ready(const pg8::Unit& u) const {
        if (u.pn >= 128) { unsigned* w = dep + u.pm; unsigned sp = 0;
            while ((unsigned)__builtin_amdgcn_readfirstlane(__hip_atomic_load(w, __ATOMIC_RELAXED, __HIP_MEMORY_SCOPE_AGENT)) < 64u) { __builtin_amdgcn_s_sleep(1); if (++sp > (1u << 22)) break; }
            asm volatile("" ::: "memory"); }
    }
    __device__ __forceinline__ void done(const pg8::Unit&) const {}
    __device__ __forceinline__ void late(const pg8::Unit& u) const {
        if (u.pn < 128) { asm volatile("s_waitcnt vmcnt(0)" ::: "memory"); if (fresh_lane() == 0) { (void)__hip_atomic_fetch_add(dep + u.pm, 1u, __ATOMIC_RELAXED, __HIP_MEMORY_SCOPE_AGENT); if (tot) (void)__hip_atomic_fetch_add(tot, 1u, __ATOMIC_RELAXED, __HIP_MEMORY_SCOPE_AGENT); } }
    }
};
struct EpiMoe {
    static constexpr bool PERM = true, AFTER_DRAIN = false, MIDK = false; EpiSwigluT<false> sw; EpiStore<DestPlain> st;
    __device__ __forceinline__ void operator()(const f32x4 (&acc)[2][2][4][2], const pg8::Unit& u, int wr, int wc, int fr, int fq) const {
        if (u.pn < 128) sw(acc, u, wr, wc, fr, fq); else st(acc, u, wr, wc, fr, fq); }
};

#define XB_TMO      128
#define XB_XCNT(j)  (256  + 64 * (j))
#define XB_XSUB(j)  (1280 + 64 * (j))
#define XB_XGEN(j)  (2304 + 64 * (j))
#define XB_TOP      3328
#define XB_TOPGEN   3392
#define XCD_BAR_WORDS 3456
#define XB_SPIN_CAP (1u << 18)

__device__ __forceinline__ unsigned xb_ld(unsigned* p)              { return __hip_atomic_load(p, __ATOMIC_RELAXED, __HIP_MEMORY_SCOPE_AGENT); }
__device__ __forceinline__ unsigned xb_add(unsigned* p, unsigned v) { return __hip_atomic_fetch_add(p, v, __ATOMIC_RELAXED, __HIP_MEMORY_SCOPE_AGENT); }
__device__ __forceinline__ unsigned xb_xcc_id() { return (unsigned)__builtin_amdgcn_s_getreg((3 << 11) | 20) & 0xFu; }
#define XB_SPIN(cond, bar) do { unsigned _sp = 0; while (cond) { __builtin_amdgcn_s_sleep(1); \
    if ((++_sp & 255u) == 0u) { if (xb_ld(&(bar)[XB_TMO])) break; if (_sp > XB_SPIN_CAP) { atomicAdd(&(bar)[XB_TMO], 1u); break; } } } } while (0)

struct XcdBarrier {
    unsigned* bar; unsigned x;
    volatile LAS unsigned* st;
};

__device__ __forceinline__ XcdBarrier xcd_barrier_post(unsigned* bar, volatile LAS unsigned* st, int tid) {
    XcdBarrier b; b.bar = bar; b.x = xb_xcc_id(); b.st = st;
    if (tid == 0) { st[2] = xb_add(&bar[XB_XCNT(b.x)], 1u); st[3] = b.x; }
    return b;
}
__device__ __forceinline__ void xcd_barrier_complete(unsigned* bar, unsigned x, unsigned& nloc, unsigned& nx) {
    const unsigned G = gridDim.x * gridDim.y * gridDim.z;
    unsigned sum, cnt, mine, sp = 0u;
    for (;;) {
        sum = 0u; cnt = 0u; mine = 0u;
#pragma unroll
        for (unsigned j = 0; j < 16; ++j) { const unsigned c = xb_ld(&bar[XB_XCNT(j)]); sum += c; cnt += (c > 0u) ? 1u : 0u; mine = (j == x) ? c : mine; }
        if (sum == G) break;
        __builtin_amdgcn_s_sleep(1);
        if ((++sp & 255u) == 0u) { if (xb_ld(&bar[XB_TMO])) break; if (sp > XB_SPIN_CAP) { atomicAdd(&bar[XB_TMO], 1u); break; } }
    }
    nloc = mine > 0u ? mine : 1u; nx = cnt > 0u ? cnt : 1u;
}

__device__ __forceinline__ void xcd_barrier(const XcdBarrier& b, int tid) {
    asm volatile("s_waitcnt vmcnt(0)" ::: "memory");
    __syncthreads();
    if (tid == 0) {
        unsigned* bar = b.bar;
        __builtin_amdgcn_s_waitcnt(0);
        unsigned nloc = b.st[0], nx = b.st[1];
        if (nloc == 0u) { xcd_barrier_complete(bar, b.x, nloc, nx); b.st[0] = nloc; b.st[1] = nx; }
        const unsigned old = xb_add(&bar[XB_XSUB(b.x)], 1u);
        const unsigned gen = old / nloc;
        if (old + 1u == (gen + 1u) * nloc) {
            __builtin_amdgcn_fence(__ATOMIC_RELEASE, "agent");
            asm volatile("s_waitcnt vmcnt(0)" ::: "memory");
            const unsigned og = xb_add(&bar[XB_TOP], 1u);
            const unsigned tg = og / nx;
            if (og + 1u == (tg + 1u) * nx) xb_add(&bar[XB_TOPGEN], 1u);
            else XB_SPIN(xb_ld(&bar[XB_TOPGEN]) == tg, bar);
            __builtin_amdgcn_fence(__ATOMIC_ACQUIRE, "agent");
            xb_add(&bar[XB_XGEN(b.x)], 1u);
            asm volatile("s_waitcnt vmcnt(0)" ::: "memory");
        } else {
            XB_SPIN(xb_ld(&bar[XB_XGEN(b.x)]) == gen, bar);
            __builtin_amdgcn_fence(__ATOMIC_ACQUIRE, "agent");
            asm volatile("s_waitcnt vmcnt(0)" ::: "memory");
        }
    }
    __syncthreads();
}

struct Args {
    const float* in[28]; float* out; unsigned char* ws; int ph_lo, ph_hi, li, pad;
};
struct Ctx {
    LAS unsigned char* lds; unsigned char* ws;
    int tid, lane, wave, G, bid;
};
#define CTLP(F) ((unsigned*)((F).ws + WS_CTL))
#define MISCP(F) ((LAS int*)((F).lds + MISC_OFF))
#define GWID(F) ((F).bid * NWAVES + (F).wave)
#define NGW(F) ((F).G * NWAVES)
enum { I_X = 0, I_C, I_CTX, I_CCTX, I_ADAW, I_ADAB, I_LNG, I_LNB, I_ABWIN, I_ABWOUT, I_IGB, I_FGB, I_MNG, I_CONVW, I_CONVB, I_DTB, I_ALOG, I_SSMD, I_SNG,
       I_ATWIN, I_ATWOUT, I_QG, I_KG, I_RW, I_RB, I_WG, I_WU, I_WD };
constexpr int RING_BYTES = 131072, MISC_OFF = RING_BYTES, LDS_BYTES = RING_BYTES + 12288;

template <class Src> __device__ __forceinline__ void transpose_item(const Src& S, bf16_t* WT, int K, int orow0, int k0, LAS float* scr, int lane, float scale) {
#pragma unroll 8
    for (int i = 0; i < 32; ++i) { const int kk = 2 * i + (lane >> 5); scr[kk * 33 + (lane & 31)] = S.ld(k0 + kk, lane & 31); }
    asm volatile("s_waitcnt lgkmcnt(0)" ::: "memory");
    const int c = lane & 7;
#pragma unroll
    for (int j = 0; j < 4; ++j) { const int n = (lane >> 3) + 8 * j; const LAS float* s = scr + (8 * c) * 33 + S.scol(n);
        u32x4 o; o.x = pk2(s[0 * 33] * scale, s[1 * 33] * scale); o.y = pk2(s[2 * 33] * scale, s[3 * 33] * scale); o.z = pk2(s[4 * 33] * scale, s[5 * 33] * scale); o.w = pk2(s[6 * 33] * scale, s[7 * 33] * scale);
        *(u32x4*)(WT + (size_t)(orow0 + n) * K + k0 + 8 * c) = o; }
    asm volatile("s_waitcnt lgkmcnt(0)" ::: "memory");
}
struct SrcPlain { const float* W; int N; int n0;
    __device__ __forceinline__ float ld(int k, int j) const { return W[(size_t)k * N + n0 + j]; }
    __device__ __forceinline__ int scol(int n) const { return n; } };
struct SrcGate { const float* W; int j0;
    __device__ __forceinline__ float ld(int k, int j) const { const int jj = j0 + j; return jj < 16 ? W[(size_t)k * ABIN + 3072 + jj] : (jj < NGATE ? W[(size_t)k * ABIN + 5648 + (jj - 16)] : 0.f); }
    __device__ __forceinline__ int scol(int n) const { return n; } };
struct SrcWout { const float* W; const float* g; int n0;
    __device__ __forceinline__ float ld(int k, int j) const { return k < 1024 ? W[(size_t)(k + 1024) * 1024 + n0 + j] * g[k] : W[(size_t)(k - 1024) * 1024 + n0 + j]; }
    __device__ __forceinline__ int scol(int n) const { return n; } };
struct SrcGU { const float* Wg; const float* Wu; int c0;
    __device__ __forceinline__ float ld(int k, int j) const { return (j < 16 ? Wg : Wu)[(size_t)k * 1024 + c0 + (j & 15)]; }
    __device__ __forceinline__ int scol(int n) const { const int b4 = n >> 3, w = n & 7; return (w < 4 ? 0 : 16) + 4 * b4 + (w & 3); } };

__device__ __forceinline__ void convert_small_weights(Ctx& F, const Args& a) {
    {   float* rope = (float*)(F.ws + WS_ROPE);
        for (int i = F.bid * NTHREADS + F.tid; i < 128 * 32; i += F.G * NTHREADS) { const int pos = i >> 5, fi = i & 31; float sn, cs; sincosf((float)pos * expf(-(float)fi * (9.210340371976184f / 32.f)), &sn, &cs); rope[2 * i] = cs; rope[2 * i + 1] = sn; } }
    LAS float* scr = (LAS float*)(F.lds + F.wave * 16384);
    bf16_t* WinT = (bf16_t*)(F.ws + WS_WIN); bf16_t* WoutT = (bf16_t*)(F.ws + WS_WOUT); bf16_t* AtInT = (bf16_t*)(F.ws + WS_ATIN); bf16_t* AtOutT = (bf16_t*)(F.ws + WS_ATOUT);
    constexpr int I0 = 16 * (NWIN / 32), I1 = 32 * 32, I2 = 16 * 48, I3 = 16 * 32, NI = I0 + I1 + I2 + I3;
    for (int it = GWID(F); it < NI; it += NGW(F)) {
        int r = it;
        if (r < I0) { const int kb = r / (NWIN / 32), nb = r % (NWIN / 32), n0 = 32 * nb;
            if (n0 < 5632) { SrcPlain S{a.in[I_ABWIN], ABIN, n0 < 3072 ? n0 : n0 + 16}; transpose_item(S, WinT, 1024, n0, 64 * kb, scr, F.lane, n0 < 512 ? 0.08838834764831845f : 1.f); }
            else { SrcGate S{a.in[I_ABWIN], n0 - 5632}; transpose_item(S, WinT, 1024, n0, 64 * kb, scr, F.lane, 1.f); }
            continue; } r -= I0;
        if (r < I1) { const int kb = r / 32, nb = r % 32; SrcWout S{a.in[I_ABWOUT], a.in[I_SNG], 32 * nb}; transpose_item(S, WoutT, 2048, 32 * nb, 64 * kb, scr, F.lane, 1.f); continue; } r -= I1;
        if (r < I2) { const int kb = r / 48, nb = r % 48; SrcPlain S{a.in[I_ATWIN], 1536, 32 * nb}; transpose_item(S, AtInT, 1024, 32 * nb, 64 * kb, scr, F.lane, 1.f); continue; } r -= I2;
        { const int kb = r / 32, nb = r % 32; SrcPlain S{a.in[I_ATWOUT], 1024, 32 * nb}; transpose_item(S, AtOutT, 1024, 32 * nb, 64 * kb, scr, F.lane, 1.f); }
    }
}
__device__ __forceinline__ void convert_moe_weights(Ctx& F, const Args& a, int layer, int skip_blocks, int it0 = 0, int it1 = 16 * 16 * 64 + 16 * 16 * 32) {
    if (F.bid < skip_blocks) return;
    LAS float* scr = (LAS float*)(F.lds + F.wave * 16384);
    bf16_t* WGU = (bf16_t*)(F.ws + WS_MOEW); bf16_t* WD = (bf16_t*)(F.ws + WS_MOEW + 64 * MiB);
    const size_t wl = (size_t)layer * 16 * 1024 * 1024;
    constexpr int IGU = 16 * 16 * 64, IDN = 16 * 16 * 32;
    for (int it = it0 + (F.bid - skip_blocks) * NWAVES + F.wave; it < it1; it += (F.G - skip_blocks) * NWAVES) {
        if (it < IGU) { const int e = it / 1024, r = it % 1024, kb = r / 64, nb = r % 64;
            SrcGU S{a.in[I_WG] + wl + (size_t)e * 1048576, a.in[I_WU] + wl + (size_t)e * 1048576, 16 * nb};
            transpose_item(S, WGU + (size_t)e * 2048 * 1024, 1024, 32 * nb, 64 * kb, scr, F.lane, 1.f); }
        else { const int r0 = it - IGU, e = r0 / 512, r = r0 % 512, kb = r / 32, nb = r % 32;
            SrcPlain S{a.in[I_WD] + wl + (size_t)e * 1048576, 1024, 32 * nb};
            transpose_item(S, WD + (size_t)e * 1024 * 1024, 1024, 32 * nb, 64 * kb, scr, F.lane, 1.f); }
    }
}
__device__ __forceinline__ void convert_moe_gu_dyn(Ctx& F, const Args& a, int layer, unsigned* claim, unsigned* tot, unsigned want) {
    { unsigned sp = 0; while ((unsigned)__builtin_amdgcn_readfirstlane(__hip_atomic_load(tot, __ATOMIC_RELAXED, __HIP_MEMORY_SCOPE_AGENT)) < want) { __builtin_amdgcn_s_sleep(4); if (++sp > (1u << 22)) break; } asm volatile("" ::: "memory"); }
    LAS float* scr = (LAS float*)(F.lds + F.wave * 16384);
    bf16_t* WGU = (bf16_t*)(F.ws + WS_MOEW); const size_t wl = (size_t)layer * 16 * 1024 * 1024;
    for (;;) { unsigned c = 0; if (F.lane == 0) c = __hip_atomic_fetch_add(claim, 1u, __ATOMIC_RELAXED, __HIP_MEMORY_SCOPE_AGENT); const int it0 = __builtin_amdgcn_readfirstlane((int)c) * 4; if (it0 >= 16 * 16 * 64) break;
        for (int it = it0; it < it0 + 4; ++it) { const int e = it / 1024, r = it % 1024, kb = r / 64, nb = r % 64;
            SrcGU S{a.in[I_WG] + wl + (size_t)e * 1048576, a.in[I_WU] + wl + (size_t)e * 1048576, 16 * nb};
            transpose_item(S, WGU + (size_t)e * 2048 * 1024, 1024, 32 * nb, 64 * kb, scr, F.lane, 1.f); } }
}
__device__ __forceinline__ void ada_phase(Ctx& F, const Args& a) {
    LAS float* red = (LAS float*)(F.lds + 8 * 16384);
    float* modv = (float*)(F.ws + WS_MODV);
    for (int item = F.bid; item < 2 * 96; item += F.G) {
        const int l = item / 96, n = (item % 96) * 64 + F.lane;
        float a0 = 0.f, a1 = 0.f, a2 = 0.f;
        const float* w = a.in[I_ADAW] + ((size_t)l * 1024 + F.wave * 128) * 6144 + n;
#pragma unroll 16
        for (int k = 0; k < 128; ++k) { const float wv = w[(size_t)k * 6144]; const int kk = F.wave * 128 + k;
            a0 += siluf(a.in[I_C][kk]) * wv; a1 += siluf(a.in[I_C][1024 + kk]) * wv; a2 += siluf(a.in[I_CCTX][kk]) * wv; }
        LAS float* rr = (LAS float*)F.lds;
        rr[(F.wave * 3 + 0) * 64 + F.lane] = a0; rr[(F.wave * 3 + 1) * 64 + F.lane] = a1; rr[(F.wave * 3 + 2) * 64 + F.lane] = a2;
        __syncthreads();
        if (F.wave < 3) { float s = 0.f;
#pragma unroll
            for (int w8 = 0; w8 < 8; ++w8) s += rr[(w8 * 3 + F.wave) * 64 + F.lane];
            modv[(l * 3 + F.wave) * 6144 + n] = s + a.in[I_ADAB][l * 6144 + n]; }
        __syncthreads();
    }
    (void)red;
}

template <int NC> __device__ __forceinline__ void row_dots(const RowF& h, const float* W, int lane, float (&acc)[NC]) {
#pragma unroll
    for (int i = 0; i < NC; ++i) acc[i] = 0.f;
#pragma unroll
    for (int j = 0; j < 4; ++j)
#pragma unroll
        for (int e = 0; e < 4; ++e) { const float x = h.v[j][e]; const f32x4* w = (const f32x4*)(W + (size_t)(4 * lane + 256 * j + e) * NC);
#pragma unroll
            for (int q = 0; q < NC / 4; ++q) { const f32x4 wv = w[q]; acc[4 * q + 0] += x * wv[0]; acc[4 * q + 1] += x * wv[1]; acc[4 * q + 2] += x * wv[2]; acc[4 * q + 3] += x * wv[3]; } }
}
template <int O, int N> __device__ __forceinline__ void xreduce_step(float (&acc)[N], int lane) {
    const bool up = (lane & O) != 0;
#pragma unroll
    for (int i = 0; i < O; ++i) { const float keep = up ? acc[i + O] : acc[i], send = up ? acc[i] : acc[i + O]; acc[i] = keep + __shfl_xor(send, O); }
}
template <int N> __device__ __forceinline__ float xreduce(float (&acc)[N], int lane) {
    if constexpr (N == 16) {
#pragma unroll
        for (int i = 0; i < 16; ++i) { acc[i] += __shfl_xor(acc[i], 32); acc[i] += __shfl_xor(acc[i], 16); }
    }
    if constexpr (N == 64) { xreduce_step<32, N>(acc, lane); xreduce_step<16, N>(acc, lane); }
    xreduce_step<8, N>(acc, lane); xreduce_step<4, N>(acc, lane); xreduce_step<2, N>(acc, lane); xreduce_step<1, N>(acc, lane);
    return acc[0];
}

__device__ __forceinline__ const float* x_row(const Args& a, int row) { return row < NLAT ? a.in[I_X] + (size_t)row * D : a.in[I_CTX] + (size_t)(row - NLAT) * D; }
__device__ __forceinline__ void rowpass_a(Ctx& F, const Args& a) {
    const float* modv = (const float*)(F.ws + WS_MODV);
    bf16_t* HB = (bf16_t*)(F.ws + WS_HB);
    int row = GWID(F); if (row >= NTOK) return;
    RowF xn = row_ld_f32(x_row(a, row), F.lane);
    for (; row < NTOK; row += NGW(F)) {
        const RowF x = xn; const int nrow = row + NGW(F);
        if (nrow < NTOK) xn = row_ld_f32(x_row(a, nrow), F.lane);
        const float* m = modv + mod_index(row) * 6144;
        const RowF h = row_modulate(x, m, m + 1024, F.lane);
        row_st_bf16(HB + (size_t)row * D, F.lane, h);
    }
}
__device__ __forceinline__ void stage_router(Ctx& F, const float* rw) {
    LAS f32x4* Wl = (LAS f32x4*)F.lds;
    for (int i = F.tid; i < 4096; i += NTHREADS) { const int d = i >> 2, q = i & 3; const f32x4 w = *(const f32x4*)(rw + d * 16 + q * 4);
        Wl[q * 1024 + ((d >> 8) * 4 + (d & 3)) * 64 + ((d >> 2) & 63)] = w; }
    __syncthreads();
}
__device__ __forceinline__ void row_dots16_lds(const RowF& h, const LAS f32x4* Wl, int lane, float (&acc)[16]) {
#pragma unroll
    for (int i = 0; i < 16; ++i) acc[i] = 0.f;
#pragma unroll
    for (int j = 0; j < 4; ++j)
#pragma unroll
        for (int e = 0; e < 4; ++e) { const float x = h.v[j][e];
#pragma unroll
            for (int q = 0; q < 4; ++q) { const f32x4 wv = Wl[q * 1024 + (j * 4 + e) * 64 + lane]; acc[4 * q + 0] += x * wv[0]; acc[4 * q + 1] += x * wv[1]; acc[4 * q + 2] += x * wv[2]; acc[4 * q + 3] += x * wv[3]; }
            if (e & 1) __builtin_amdgcn_sched_barrier(0); }
}
__device__ __forceinline__ void route_row(const RowF& h2, const LAS f32x4* Wl, const float* rb, int lane, int& e0, int& e1, float& g0, float& g1) {
    float acc[16]; row_dots16_lds(h2, Wl, lane, acc);
    const float logit = xreduce<16>(acc, lane);
    float mx = logit;
#pragma unroll
    for (int o = 8; o >= 1; o >>= 1) mx = fmaxf(mx, __shfl_xor(mx, o));
    const float ex = expf(logit - mx); float sm = ex;
#pragma unroll
    for (int o = 8; o >= 1; o >>= 1) sm += __shfl_xor(sm, o);
    const float p = ex / sm, sel = p + rb[lane & 15];
    float s4[4], p4[4];
#pragma unroll
    for (int i = 0; i < 4; ++i) s4[i] = __shfl(sel, (lane & 12) + i);
    float v1 = s4[0]; int i1 = 0;
#pragma unroll
    for (int i = 1; i < 4; ++i) if (s4[i] > v1) { v1 = s4[i]; i1 = i; }
    float v2 = -1e30f;
#pragma unroll
    for (int i = 0; i < 4; ++i) if (i != i1 && s4[i] > v2) v2 = s4[i];
    const float gs = v1 + v2;
    float best = __shfl(gs, 0); int bg = 0;
#pragma unroll
    for (int g = 1; g < 4; ++g) { const float t = __shfl(gs, 4 * g); if (t > best) { best = t; bg = g; } }
#pragma unroll
    for (int i = 0; i < 4; ++i) { s4[i] = __shfl(sel, 4 * bg + i); p4[i] = __shfl(p, 4 * bg + i); }
    v1 = s4[0]; i1 = 0; float q1 = p4[0];
#pragma unroll
    for (int i = 1; i < 4; ++i) if (s4[i] > v1) { v1 = s4[i]; i1 = i; q1 = p4[i]; }
    v2 = -1e30f; int i2 = 0; float q2 = 0.f;
#pragma unroll
    for (int i = 0; i < 4; ++i) if (i != i1 && s4[i] > v2) { v2 = s4[i]; i2 = i; q2 = p4[i]; }
    e0 = 4 * bg + i1; e1 = 4 * bg + i2; const float s = q1 + q2; g0 = q1 / s; g1 = q2 / s;
}
__device__ __forceinline__ void rowpass_b(Ctx& F, const Args& a, int layer, int nrows, const bf16_t* YB) {
    const float* modl = (const float*)(F.ws + WS_MODV) + layer * 3 * 6144;
    bf16_t* XL = (bf16_t*)(F.ws + WS_XL); bf16_t* HB = (bf16_t*)(F.ws + WS_HB);
    int* tok_e = (int*)(F.ws + WS_ROUTE); int* tok_pos = tok_e + 2 * NTOK; float* tok_g = (float*)(tok_pos + 2 * NTOK);
    unsigned* cnt = CTLP(F) + (layer ? CW_CNT1 : CW_CNT0);
    stage_router(F, a.in[I_RW]);
    LAS int* lcnt = (LAS int*)(F.lds + 65536); LAS int* gbase = lcnt + 16; LAS int* nrow = lcnt + 32; LAS int* lrow = lcnt + 64;
    if (F.tid < 33) lcnt[F.tid] = 0;
    __syncthreads();
    RowF xf_n; RowRaw xr_n, y_n;
    { const int r0 = GWID(F); if (r0 < nrows) { if (layer) xr_n = row_ldraw_bf16(XL + (size_t)r0 * D, F.lane); else xf_n = row_ld_f32(x_row(a, r0), F.lane); y_n = row_ldraw_bf16(YB + (size_t)r0 * D, F.lane); } }
    for (int row = GWID(F); row < nrows; row += NGW(F)) {
        const float* m = modl + mod_index(row) * 6144;
        RowF x = layer ? row_cvt(xr_n) : xf_n; const RowF y = row_cvt(y_n); const int nxr = row + NGW(F);
        if (nxr < nrows) { if (layer) xr_n = row_ldraw_bf16(XL + (size_t)nxr * D, F.lane); else xf_n = row_ld_f32(x_row(a, nxr), F.lane); y_n = row_ldraw_bf16(YB + (size_t)nxr * D, F.lane); }
        const RowF gt = row_ld_f32(m + 2048, F.lane);
#pragma unroll
        for (int j = 0; j < 4; ++j) x.v[j] = ALPHA * x.v[j] + gt.v[j] * y.v[j];
        row_layernorm(x, a.in[I_LNG] + (layer * 2) * D, a.in[I_LNB] + (layer * 2) * D, F.lane);
        row_st_bf16(XL + (size_t)row * D, F.lane, x);
        const RowF h2 = row_modulate(x, m + 3072, m + 4096, F.lane);
        row_st_bf16(HB + (size_t)row * D, F.lane, h2);
        int e0, e1; float g0, g1; route_row(h2, (const LAS f32x4*)F.lds, a.in[I_RB], F.lane, e0, e1, g0, g1);
        if (F.lane == 0) {
            const int p0 = __hip_atomic_fetch_add(lcnt + e0, 1, __ATOMIC_RELAXED, __HIP_MEMORY_SCOPE_WORKGROUP), p1 = __hip_atomic_fetch_add(lcnt + e1, 1, __ATOMIC_RELAXED, __HIP_MEMORY_SCOPE_WORKGROUP);
            const int ix = __hip_atomic_fetch_add(nrow, 1, __ATOMIC_RELAXED, __HIP_MEMORY_SCOPE_WORKGROUP);
            lrow[ix * 4 + 0] = row; lrow[ix * 4 + 1] = e0 | (e1 << 8); lrow[ix * 4 + 2] = p0; lrow[ix * 4 + 3] = p1;
            tok_e[row * 2] = e0; tok_e[row * 2 + 1] = e1; tok_g[row * 2] = g0; tok_g[row * 2 + 1] = g1;
        }
    }
    __syncthreads();
    if (F.tid < 16) gbase[F.tid] = (int)atomicAdd(cnt + F.tid, (unsigned)lcnt[F.tid]);
    __syncthreads();
    if (F.tid < nrow[0]) { const int row = lrow[F.tid * 4], ee = lrow[F.tid * 4 + 1];
        const int e0 = ee & 255, e1 = ee >> 8, p0 = gbase[e0] + lrow[F.tid * 4 + 2], p1 = gbase[e1] + lrow[F.tid * 4 + 3];
        tok_pos[row * 2] = p0; tok_pos[row * 2 + 1] = p1; int* tab = (int*)(F.ws + WS_TOKTAB); tab[(size_t)e0 * NTOK + p0] = row; tab[(size_t)e1 * NTOK + p1] = row; }
}
__device__ __forceinline__ void moe_offsets(Ctx& F, int layer) {
    __syncthreads();
    if (F.tid == 0) { const unsigned* cnt = CTLP(F) + (layer ? CW_CNT1 : CW_CNT0); int acc = 0;
        for (int e = 0; e < 16; ++e) { const int c = (int)__hip_atomic_load(cnt + e, __ATOMIC_RELAXED, __HIP_MEMORY_SCOPE_AGENT); MISCP(F)[e] = acc; MISCP(F)[100 + e] = c; acc += (c + 255) >> 8; }
        MISCP(F)[16] = acc; }
    __syncthreads();
}
__device__ __forceinline__ void moe_streams(Ctx& F, int layer, int li) {
    moe_offsets(F, layer);
    if (F.tid == 0) { const unsigned* bar = CTLP(F) + CW_BAR + li * 4096; const int x = MISCP(F)[35]; int tot = 0, before = 0, mine = 1;
        for (int j = 0; j < 16; ++j) { const int c = (int)__hip_atomic_load(bar + XB_XCNT(j), __ATOMIC_RELAXED, __HIP_MEMORY_SCOPE_AGENT); tot += c; before += (j < x) ? c : 0; mine = (j == x) ? c : mine; }
        const int ntm = MISCP(F)[16]; const int m0 = (int)((long)ntm * before / tot), m1 = (int)((long)ntm * (before + mine) / tot);
        MISCP(F)[120] = m0; MISCP(F)[121] = m1 - m0; MISCP(F)[122] = mine; MISCP(F)[123] = MISCP(F)[34]; }
    __syncthreads();
}
__device__ __forceinline__ void moe_scatter(Ctx& F, int layer, int nrows) {
    moe_offsets(F, layer);
    const bf16_t* HB = (const bf16_t*)(F.ws + WS_HB); bf16_t* XS = (bf16_t*)(F.ws + WS_XS);
    const int* tok_e = (const int*)(F.ws + WS_ROUTE); const int* tok_pos = tok_e + 2 * NTOK; int* tok_slot = (int*)(F.ws + WS_ROUTE + MiB);
    for (int row = GWID(F); row < nrows; row += NGW(F)) {
        const int e0 = tok_e[row * 2], e1 = tok_e[row * 2 + 1];
        const int s0 = MISCP(F)[e0] * 256 + tok_pos[row * 2], s1 = MISCP(F)[e1] * 256 + tok_pos[row * 2 + 1];
        const u32x4* src = (const u32x4*)(HB + (size_t)row * D) + F.lane; const u32x4 v0 = src[0], v1 = src[64];
        u32x4* d0 = (u32x4*)(XS + (size_t)s0 * D) + F.lane; u32x4* d1 = (u32x4*)(XS + (size_t)s1 * D) + F.lane;
        d0[0] = v0; d0[64] = v1; d1[0] = v0; d1[64] = v1;
        if (F.lane == 0) { tok_slot[row * 2] = s0; tok_slot[row * 2 + 1] = s1; }
    }
}
__device__ __forceinline__ void rowpass_c(Ctx& F, const Args& a, int layer, int nrows, bool last) {
    const float* modl = (const float*)(F.ws + WS_MODV) + layer * 3 * 6144;
    bf16_t* XL = (bf16_t*)(F.ws + WS_XL); bf16_t* HB = (bf16_t*)(F.ws + WS_HB); const bf16_t* YS = (const bf16_t*)(F.ws + WS_YS);
    const int* tok_e = (const int*)(F.ws + WS_ROUTE); const int* tok_pos = tok_e + 2 * NTOK; const float* tok_g = (const float*)(F.ws + WS_ROUTE) + 4 * NTOK;
    moe_offsets(F, layer);
    const int step = NGW(F); int row = GWID(F);
    int s0n = 0, s1n = 0, s0nn = 0, s1nn = 0; float g0n = 0.f, g1n = 0.f, g0nn = 0.f, g1nn = 0.f; RowRaw xr_n, y0_n, y1_n;
#define RC_SLOTS(r_, s0_, s1_, g0_, g1_) do { s0_ = MISCP(F)[tok_e[(r_) * 2]] * 256 + tok_pos[(r_) * 2]; s1_ = MISCP(F)[tok_e[(r_) * 2 + 1]] * 256 + tok_pos[(r_) * 2 + 1]; g0_ = tok_g[(r_) * 2]; g1_ = tok_g[(r_) * 2 + 1]; } while (0)
    if (row < nrows) { RC_SLOTS(row, s0n, s1n, g0n, g1n); xr_n = row_ldraw_bf16(XL + (size_t)row * D, F.lane); y0_n = row_ldraw_bf16(YS + (size_t)s0n * D, F.lane); y1_n = row_ldraw_bf16(YS + (size_t)s1n * D, F.lane);
        if (row + step < nrows) RC_SLOTS(row + step, s0nn, s1nn, g0nn, g1nn); }
    for (; row < nrows; row += step) {
        const float* m = modl + mod_index(row) * 6144;
        RowF x = row_cvt(xr_n); const RowF y0 = row_cvt(y0_n), y1 = row_cvt(y1_n); const float g0 = g0n, g1 = g1n;
        if (row + step < nrows) { const int nr = row + step; s0n = s0nn; s1n = s1nn; g0n = g0nn; g1n = g1nn;
            xr_n = row_ldraw_bf16(XL + (size_t)nr * D, F.lane); y0_n = row_ldraw_bf16(YS + (size_t)s0n * D, F.lane); y1_n = row_ldraw_bf16(YS + (size_t)s1n * D, F.lane);
            if (nr + step < nrows) RC_SLOTS(nr + step, s0nn, s1nn, g0nn, g1nn); }
        const RowF gt = row_ld_f32(m + 5120, F.lane);
#pragma unroll
        for (int j = 0; j < 4; ++j) x.v[j] = ALPHA * x.v[j] + gt.v[j] * (g0 * y0.v[j] + g1 * y1.v[j]);
        row_layernorm(x, a.in[I_LNG] + (layer * 2 + 1) * D, a.in[I_LNB] + (layer * 2 + 1) * D, F.lane);
        if (last) { row_st_f32(a.out + (size_t)row * D, F.lane, x); }
        else { row_st_bf16(XL + (size_t)row * D, F.lane, x); const float* m1 = modl + 3 * 6144 + mod_index(row) * 6144;
            const RowF h = row_modulate(x, m1, m1 + 1024, F.lane); row_st_bf16(HB + (size_t)row * D, F.lane, h); }
    }
#undef RC_SLOTS
}

template <class Epi, class Sched> __device__ __forceinline__ void run_gemm_gather(Ctx& F, const bf16_t* A, const bf16_t* Bt, int K, const Sched& S, const Epi& E) {
    pg8::Gemm g{A, Bt, 0, 0, K};
    pg8::gemm_phase<Epi, Sched, true, true, true>(F.lds, g, S, E, F.wave * 64 + fresh_lane());
    __syncthreads();
}
template <class Epi, class Sched> __device__ __forceinline__ void run_gemm(Ctx& F, const bf16_t* A, const bf16_t* Bt, int M, int N, int K, const Sched& S, const Epi& E) {
    pg8::Gemm g{A, Bt, M, N, K};
    pg8::gemm_phase<Epi, Sched, true, true>(F.lds, g, S, E, F.wave * 64 + fresh_lane());
    __syncthreads();
}

__device__ __forceinline__ void qkprep_phase(Ctx& F, const Args& a) {
    bf16_t* Q = (bf16_t*)(F.ws + WS_Q); bf16_t* KB = (bf16_t*)(F.ws + WS_KB);
    constexpr int NQ = NLAT * 8, NK = NBATCH * SLEN * 2;
    const float qg0 = a.in[I_QG][F.lane], qg1 = a.in[I_QG][F.lane + 64], kg0 = a.in[I_KG][F.lane], kg1 = a.in[I_KG][F.lane + 64];
    const float* ropet = (const float*)(F.ws + WS_ROPE);
    for (int it = NQ + GWID(F); it < NQ + NK; it += NGW(F)) {
        bf16_t* p; int t; bool rope; float g0, g1;
        if (it < NQ) { const int row = it >> 3, hh = it & 7; p = Q + (size_t)row * 1024 + hh * 128; t = row % SEQ; rope = true; g0 = qg0; g1 = qg1; }
        else { const int r = it - NQ, krow = r >> 1, kvh = r & 1, key = krow % SLEN; p = KB + (size_t)krow * 256 + kvh * 128; rope = key >= CTXL; t = key - CTXL; g0 = kg0; g1 = kg1; }
        float x1 = bf2f(p[F.lane]), x2 = bf2f(p[F.lane + 64]);
        const float r = rsqrtf(wave_sum(x1 * x1 + x2 * x2) * (1.f / 128.f) + 1e-6f);
        x1 *= r * g0; x2 *= r * g1;
        float o1 = x1, o2 = x2;
        if (rope) { const float* rp = ropet + ((F.lane < 32) ? (t / 64) : (t % 64)) * 64 + 2 * (F.lane & 31); const float cs = rp[0], sn = rp[1]; o1 = x1 * cs - x2 * sn; o2 = x2 * cs + x1 * sn; }
        p[F.lane] = f2bf(o1); p[F.lane + 64] = f2bf(o2);
    }
}
__device__ __forceinline__ void attn_phase(Ctx& F, const Args& a) {
    const bf16_t* Q = (const bf16_t*)(F.ws + WS_Q); const bf16_t* KB = (const bf16_t*)(F.ws + WS_KB); const bf16_t* VB = (const bf16_t*)(F.ws + WS_VB); bf16_t* AO = (bf16_t*)(F.ws + WS_AO);
    const float gq = wave_max(fmaxf(fabsf(a.in[I_QG][F.lane]), fabsf(a.in[I_QG][F.lane + 64]))), gk = wave_max(fmaxf(fabsf(a.in[I_KG][F.lane]), fabsf(a.in[I_KG][F.lane + 64])));
    const bool fast = 11.3137085f * 1.4426950408889634f * 1.02f * gq * gk < 60.f;
    for (int i = 0;; ++i) {
        const int L = i * F.G + F.bid; if (L >= 512) break;
        const int xcd = L & 7, off = L >> 3, combo = xcd >> 1, idx = (xcd & 1) * 64 + off, hl = idx >> 5, qb = idx & 31;
        const int b = combo >> 1, kvh = combo & 1, h = kvh * 4 + hl;
        const size_t qoff = ((size_t)b * SEQ + qb * 256) * 1024 + h * 128, koff = (size_t)b * SLEN * 256 + kvh * 128;
        if (fast) attn::attn_dense_body<attn::bf16, true, 1>(Q + qoff, KB + koff, VB + koff, AO + qoff, SLEN, (char*)F.lds, F.wave * 64 + fresh_lane(), a.in[I_QG], qb * 256, (const float*)(F.ws + WS_ROPE));
        else attn::attn_dense_body<attn::bf16, false, 1>(Q + qoff, KB + koff, VB + koff, AO + qoff, SLEN, (char*)F.lds, F.wave * 64 + fresh_lane(), a.in[I_QG], qb * 256, (const float*)(F.ws + WS_ROPE));
        __syncthreads();
    }
}

typedef short v4i16_t __attribute__((ext_vector_type(4)));
typedef const LAS unsigned char* lds_cptr;
constexpr float LOG2E = 1.4426950408889634f;
__device__ __forceinline__ s16x4 vtr(lds_cptr p) { return __builtin_bit_cast(s16x4, __builtin_amdgcn_ds_read_tr16_b64_v4i16((LAS v4i16_t*)p)); }
__device__ __forceinline__ bf16x8 trfrag(lds_cptr tb, int d0, int ks) {
    const s16x4 l = vtr(tb + attn::v_rd_off(d0, ks, 0)), h = vtr(tb + attn::v_rd_off(d0, ks, 1));
    return (bf16x8){l[0], l[1], l[2], l[3], h[0], h[1], h[2], h[3]}; }
__device__ __forceinline__ bf16x8 rowfrag(lds_cptr tile, int blk, int d0, int r32, int hi) { return *(const LAS bf16x8*)(tile + KSWZ(32 * blk + r32, (d0 * 16 + hi * 8) * 2)); }
__device__ __forceinline__ u32x4 scale8(u32x4 v, float s) { u32x4 o;
#pragma unroll
    for (int i = 0; i < 4; ++i) o[i] = pk2(__uint_as_float(v[i] << 16) * s, __uint_as_float(v[i] & 0xffff0000u) * s);
    return o; }
__device__ __forceinline__ bf16x8 scale8f(bf16x8 v, float s) { return __builtin_bit_cast(bf16x8, scale8(__builtin_bit_cast(u32x4, v), s)); }
__device__ __forceinline__ float wave_incl_sum(float v, int lane) {
#pragma unroll
    for (int o = 1; o < 64; o <<= 1) { const float t = __shfl_up(v, o); if (lane >= o) v += t; }
    return v; }
__device__ __forceinline__ float wave_incl_max(float v, int lane) {
#pragma unroll
    for (int o = 1; o < 64; o <<= 1) { const float t = __shfl_up(v, o); if (lane >= o) v = fmaxf(v, t); }
    return v; }
__device__ __forceinline__ float wave_incl_max_rev(float v, int lane) {
#pragma unroll
    for (int o = 1; o < 64; o <<= 1) { const float t = __shfl_down(v, o); if (lane + o < 64) v = fmaxf(v, t); }
    return v; }
__device__ __forceinline__ float half_swap_add(float v) { auto rr = __builtin_amdgcn_permlane32_swap(__float_as_uint(v), __float_as_uint(v), false, false); return __uint_as_float(rr[0]) + __uint_as_float(rr[1]); }
#define MX_PK4(P, BASE, OUT) do { unsigned a0_ = pk2(P[BASE + 0], P[BASE + 1]), a1_ = pk2(P[BASE + 2], P[BASE + 3]); \
    unsigned b0_ = pk2(P[BASE + 4], P[BASE + 5]), b1_ = pk2(P[BASE + 6], P[BASE + 7]); \
    auto r0_ = __builtin_amdgcn_permlane32_swap(a0_, b0_, false, false); auto r1_ = __builtin_amdgcn_permlane32_swap(a1_, b1_, false, false); \
    u32x4 w_ = {r0_[0], r1_[0], r0_[1], r1_[1]}; OUT = __builtin_bit_cast(bf16x8, w_); } while (0)

__device__ __forceinline__ const bf16_t* launder_v(const bf16_t* p) { asm volatile("" : "+v"(p)); return p; }
constexpr int MX_MISC = MISC_OFF + 1024;
__device__ __forceinline__ int st_off(int row, int col) { return (((row >> 5) * 8 + (col >> 4)) << 9) + ((row & 31) << 4) + (col & 15); }
__device__ __forceinline__ int mx_unit(int bid, int G, int k, int off) { const int kmain = 528 / G, nmain = kmain * G; if (k < kmain) return bid + k * G; if (k == kmain) { const int j = bid - off; return (j >= 0 && j < 528 - nmain) ? nmain + j : -1; } return -1; }

constexpr int CONV_RUN = 26;
__device__ __forceinline__ int conv_seg(int row) { return row < NLAT ? row / SEQ : 2 + (row - NLAT) / CTXL; }
__device__ __forceinline__ void conv_unpack(u32x4 v, float (&f)[8]) {
#pragma unroll
    for (int e = 0; e < 4; ++e) { f[2 * e] = __uint_as_float(v[e] << 16); f[2 * e + 1] = __uint_as_float(v[e] & 0xffff0000u); } }
__device__ __forceinline__ void conv_phase(Ctx& F, const Args& a) {
    const bf16_t* XBC = (const bf16_t*)(F.ws + WS_XBC); bf16_t* XC = (bf16_t*)(F.ws + WS_XC);
    const float* cw = a.in[I_CONVW]; const float* cb = a.in[I_CONVB];
    constexpr int NRUN = (NTOK + CONV_RUN - 1) / CONV_RUN;
    for (int it = F.bid * NTHREADS + F.tid; it < NRUN * 192; it += F.G * NTHREADS) {
        const int c8 = (it % 192) * 8, r0 = (it / 192) * CONV_RUN, r1 = (r0 + CONV_RUN < NTOK) ? r0 + CONV_RUN : NTOK;
        float w[4][8], bias[8];
#pragma unroll
        for (int j = 0; j < 4; ++j) { const f32x4 w0 = *(const f32x4*)(cw + j * 1536 + c8), w1 = *(const f32x4*)(cw + j * 1536 + c8 + 4); w[j][0] = w0[0]; w[j][1] = w0[1]; w[j][2] = w0[2]; w[j][3] = w0[3]; w[j][4] = w1[0]; w[j][5] = w1[1]; w[j][6] = w1[2]; w[j][7] = w1[3]; }
        { const f32x4 b0 = *(const f32x4*)(cb + c8), b1 = *(const f32x4*)(cb + c8 + 4); bias[0] = b0[0]; bias[1] = b0[1]; bias[2] = b0[2]; bias[3] = b0[3]; bias[4] = b1[0]; bias[5] = b1[1]; bias[6] = b1[2]; bias[7] = b1[3]; }
        const u32x4 zero = {0u, 0u, 0u, 0u};
        const bf16_t* base = XBC + c8;
        u32x4 xm2 = r0 >= 2 ? *(const u32x4*)(base + (size_t)(r0 - 2) * 1536) : zero, xm1 = r0 >= 1 ? *(const u32x4*)(base + (size_t)(r0 - 1) * 1536) : zero;
        u32x4 x0 = *(const u32x4*)(base + (size_t)r0 * 1536), xp1 = r0 + 1 < NTOK ? *(const u32x4*)(base + (size_t)(r0 + 1) * 1536) : zero;
        for (int r = r0; r < r1; ++r) {
            const u32x4 xp2 = r + 2 < NTOK ? *(const u32x4*)(base + (size_t)(r + 2) * 1536) : zero;
            const int sg = conv_seg(r);
            const bool v0 = r >= 2 && conv_seg(r - 2) == sg, v1 = r >= 1 && conv_seg(r - 1) == sg, v3 = r + 1 < NTOK && conv_seg(r + 1) == sg;
            float f0[8], f1[8], f2[8], f3[8]; conv_unpack(xm2, f0); conv_unpack(xm1, f1); conv_unpack(x0, f2); conv_unpack(xp1, f3);
            float acc[8];
#pragma unroll
            for (int e = 0; e < 8; ++e) acc[e] = bias[e] + (v0 ? w[0][e] * f0[e] : 0.f) + (v1 ? w[1][e] * f1[e] : 0.f) + w[2][e] * f2[e] + (v3 ? w[3][e] * f3[e] : 0.f);
            u32x4 o; o[0] = pk2(siluf(acc[0]), siluf(acc[1])); o[1] = pk2(siluf(acc[2]), siluf(acc[3])); o[2] = pk2(siluf(acc[4]), siluf(acc[5])); o[3] = pk2(siluf(acc[6]), siluf(acc[7]));
            *(u32x4*)(XC + (size_t)r * 1536 + c8) = o;
            xm2 = xm1; xm1 = x0; x0 = xp1; xp1 = xp2;
        }
    }
}

struct MlGate { float b0, b1, G0, G1, total; };
__device__ __forceinline__ MlGate ml_gate(const float* GATES, int row0, int dir, int h, int lane) {
    const float* g0 = GATES + (size_t)(row0 + 2 * lane) * NGATE; const float* g1 = g0 + NGATE;
    const float lf0 = g0[8 + dir * 4 + h], lf1 = g1[8 + dir * 4 + h], ig0 = g0[dir * 4 + h], ig1 = g1[dir * 4 + h];
    const float incl = wave_incl_sum(lf0 + lf1, lane), total = __shfl(incl, 63);
    MlGate r; r.total = total;
    if (dir == 0) { r.b0 = incl - lf1; r.b1 = incl; } else { r.b0 = total - incl + lf0 + lf1; r.b1 = total - incl + lf1; }
    r.G0 = ig0 - r.b0; r.G1 = ig1 - r.b1; return r;
}


__device__ __forceinline__ void mlstm_a_phase(Ctx& F, int off) {
    const bf16_t* QK = (const bf16_t*)(F.ws + WS_QK); const bf16_t* V = (const bf16_t*)(F.ws + WS_V); const float* GATES = (const float*)(F.ws + WS_GATES);
    bf16_t* DC = (bf16_t*)(F.ws + WS_DC); float* DN = (float*)(F.ws + WS_DN); float* MS = (float*)(F.ws + WS_MS);
    LAS unsigned char* Vt = F.lds; LAS unsigned char* Kw = F.lds + 65536;
    LAS float* wsc = (LAS float*)(F.lds + MX_MISC); LAS float* dnp = (LAS float*)(F.lds + MX_MISC + 1024);
    for (int k_ = 0;; ++k_) { const int u = mx_unit(F.bid, F.G, k_, off); if (u < 0) break;
        const int lane = fresh_lane(), tid = F.wave * 64 + lane, r32 = lane & 31, hi = lane >> 5, sr = tid >> 4, sc8 = (tid & 15) * 8, rdb = attn::v_rd_base(lane);
        const int b = u / 264, rem = u % 264, cid = rem >> 2, h = rem & 3, row0 = chunk_row0(b, cid);
        if (F.wave < 2) { const int dir = F.wave, chain = (b * 4 + h) * 2 + dir; typedef float f32x2v __attribute__((ext_vector_type(2)));
            *(LAS f32x2v*)(wsc + dir * 128 + 2 * lane) = *(const f32x2v*)((const float*)(F.ws + WS_MLG) + (size_t)(chain * NCH + cid) * 512 + 384 + 2 * lane); }
        __syncthreads();
        float dnacc[2][8];
#pragma unroll
        for (int d = 0; d < 2; ++d)
#pragma unroll
            for (int e = 0; e < 8; ++e) dnacc[d][e] = 0.f;
#pragma unroll
        for (int i = 0; i < 4; ++i) { const int s = sr + 32 * i; const size_t grow = (size_t)(row0 + s) * 1024;
#pragma unroll
            for (int vb = 0; vb < 2; ++vb) { const u32x4 v = *(const u32x4*)(V + grow + h * 256 + vb * 128 + sc8); *(LAS u32x4*)(Vt + ((s >> 6) * 2 + vb) * 16384 + attn::v_st(s & 63, sc8)) = v; }
            const u32x4 kv = *(const u32x4*)(QK + grow + 512 + h * 128 + sc8);
#pragma unroll
            for (int d = 0; d < 2; ++d) { const float w = wsc[d * 128 + s];
                *(LAS u32x4*)(Kw + (d * 2 + (s >> 6)) * 16384 + attn::v_st(s & 63, sc8)) = scale8(kv, w);
#pragma unroll
                for (int e = 0; e < 4; ++e) { dnacc[d][2 * e] += w * __uint_as_float(kv[e] << 16); dnacc[d][2 * e + 1] += w * __uint_as_float(kv[e] & 0xffff0000u); } } }
#pragma unroll
        for (int d = 0; d < 2; ++d)
#pragma unroll
            for (int e = 0; e < 8; ++e) { float t = dnacc[d][e]; t += __shfl_xor(t, 16); t += __shfl_xor(t, 32); if ((lane >> 4) == 0) dnp[(F.wave * 2 + d) * 128 + sc8 + e] = t; }
        __syncthreads();
        {   const int dir = F.wave >> 2, vq = F.wave & 3;
            f32x16 acc[2][4];
#pragma unroll
            for (int i = 0; i < 2; ++i)
#pragma unroll
                for (int n = 0; n < 4; ++n) acc[i][n] = f32x16{};
#pragma unroll
            for (int ks = 0; ks < 8; ++ks) { const int sblk = ks >> 2, KS = ks & 3;
                bf16x8 af[2], bfr[4];
#pragma unroll
                for (int i = 0; i < 2; ++i) af[i] = trfrag(Vt + (sblk * 2 + (vq >> 1)) * 16384 + rdb, (2 * vq + i) & 3, KS);
#pragma unroll
                for (int n = 0; n < 4; ++n) bfr[n] = trfrag(Kw + (dir * 2 + sblk) * 16384 + rdb, n, KS);
#pragma unroll
                for (int i = 0; i < 2; ++i)
#pragma unroll
                    for (int n = 0; n < 4; ++n) acc[i][n] = __builtin_amdgcn_mfma_f32_32x32x16_bf16(af[i], bfr[n], acc[i][n], 0, 0, 0); }
            const int chain = (b * 4 + h) * 2 + dir;
            bf16_t* dst = DC + (size_t)(chain * NCH + cid) * 256 * 128;
#pragma unroll
            for (int i = 0; i < 2; ++i)
#pragma unroll
                for (int n = 0; n < 4; ++n)
#pragma unroll
                    for (int r = 0; r < 16; ++r) dst[st_off(64 * vq + 32 * i + attn::crow(r, hi), 32 * n + r32)] = f2bf(acc[i][n][r]);
        }
        if (tid < 256) { const int dir = tid >> 7, d = tid & 127; float s = 0.f;
#pragma unroll
            for (int w = 0; w < 8; ++w) s += dnp[(w * 2 + dir) * 128 + d];
            const int chain = (b * 4 + h) * 2 + dir; DN[(size_t)(chain * NCH + cid) * 128 + d] = s; }
        __syncthreads();
    }
}

struct SsGate { float dt0, dt1, acs0, acs1, total; };
__device__ __forceinline__ SsGate ss_gate(const float* GATES, int row0, int dir, int head, float aneg, int lane) {
    const float* g0 = GATES + (size_t)(row0 + 2 * lane) * NGATE; const float* g1 = g0 + NGATE;
    SsGate r; r.dt0 = g0[16 + dir * 16 + head]; r.dt1 = g1[16 + dir * 16 + head];
    const float a0 = r.dt0 * aneg, a1 = r.dt1 * aneg;
    const float incl = wave_incl_sum(a0 + a1, lane); r.total = __shfl(incl, 63);
    if (dir == 0) { r.acs0 = incl - a1; r.acs1 = incl; } else { r.acs0 = r.total - incl + a0 + a1; r.acs1 = r.total - incl + a1; }
    return r;
}
__device__ __forceinline__ void gatescan_phase(Ctx& F, const Args& a) {
    const float* GATES = (const float*)(F.ws + WS_GATES); float* MLG = (float*)(F.ws + WS_MLG); float* SSG = (float*)(F.ws + WS_SSG);
    float* MS = (float*)(F.ws + WS_MS); float* AEND = (float*)(F.ws + WS_AEND);
    typedef float f32x2v __attribute__((ext_vector_type(2)));
    const int lane = F.lane;
    for (int it = GWID(F); it < 16 * NCH + 64 * NCH; it += NGW(F)) {
        if (it < 16 * NCH) { const int chain = it / NCH, cid = it % NCH, dir = chain & 1, h = (chain >> 1) & 3, b = chain >> 3, row0 = chunk_row0(b, cid);
            const MlGate g = ml_gate(GATES, row0, dir, h, lane);
            const float gmx = fmaxf(g.G0, g.G1), gm = wave_max(gmx); float P0, P1;
            if (dir == 0) { const float pm = wave_incl_max(gmx, lane); float ex = __shfl_up(pm, 1); if (lane == 0) ex = -1e30f; P0 = fmaxf(ex, g.G0); P1 = pm; }
            else { const float pm = wave_incl_max_rev(gmx, lane); float ex = __shfl_down(pm, 1); if (lane == 63) ex = -1e30f; P1 = fmaxf(ex, g.G1); P0 = pm; }
            float* o = MLG + (size_t)it * 512 + 2 * lane;
            *(f32x2v*)(o) = (f32x2v){g.b0, g.b1}; *(f32x2v*)(o + 128) = (f32x2v){g.G0, g.G1}; *(f32x2v*)(o + 256) = (f32x2v){P0, P1}; *(f32x2v*)(o + 384) = (f32x2v){expf(g.G0 - gm), expf(g.G1 - gm)};
            if (lane == 0) { MS[it * 4 + 0] = g.total; MS[it * 4 + 1] = g.total + gm; } }
        else { const int i2 = it - 16 * NCH, chain = i2 / NCH, cid = i2 % NCH, dir = chain & 1, head = (chain >> 1) & 15, b = chain >> 5, row0 = chunk_row0(b, cid);
            const float aneg = -expf(a.in[I_ALOG][dir * 16 + head]); const SsGate s = ss_gate(GATES, row0, dir, head, aneg, lane);
            float* o = SSG + (size_t)i2 * 384 + 2 * lane;
            *(f32x2v*)(o) = (f32x2v){s.acs0, s.acs1}; *(f32x2v*)(o + 128) = (f32x2v){s.dt0, s.dt1}; *(f32x2v*)(o + 256) = (f32x2v){s.dt0 * expf(s.total - s.acs0), s.dt1 * expf(s.total - s.acs1)};
            if (lane == 0) AEND[i2] = s.total; }
    }
}
template <bool BM_ROW> __device__ __forceinline__ void ssd_stage(Ctx& F, const bf16_t* XC, int row0, int g, int hh, LAS unsigned char* Xt, LAS unsigned char* Bt) {
    const int tid_ = F.wave * 64 + fresh_lane(), sr = tid_ >> 4, sc8 = (tid_ & 15) * 8;
#pragma unroll
    for (int i = 0; i < 4; ++i) { const int s = sr + 32 * i; const bf16_t* rowp = XC + (size_t)(row0 + s) * 1536;
#pragma unroll
        for (int cb = 0; cb < 2; ++cb) { const u32x4 v = *(const u32x4*)(rowp + (g * 8 + hh * 4) * 64 + cb * 128 + sc8); *(LAS u32x4*)(Xt + ((s >> 6) * 2 + cb) * 16384 + attn::v_st(s & 63, sc8)) = v; }
        const u32x4 bv = *(const u32x4*)(rowp + 1024 + g * 128 + sc8);
        if (BM_ROW) *(LAS u32x4*)(Bt + (s >> 6) * 16384 + KSWZ(s & 63, sc8 * 2)) = bv; else *(LAS u32x4*)(Bt + (s >> 6) * 16384 + attn::v_st(s & 63, sc8)) = bv; }
}
__device__ __forceinline__ void ssd_a_phase(Ctx& F, const Args& a, int off) {
    const bf16_t* XC = (const bf16_t*)(F.ws + WS_XC); const float* GATES = (const float*)(F.ws + WS_GATES);
    bf16_t* DS = (bf16_t*)(F.ws + WS_DS); float* AEND = (float*)(F.ws + WS_AEND);
    LAS unsigned char* Xt = F.lds; LAS unsigned char* Bt = F.lds + 65536;
    LAS float* wtl = (LAS float*)(F.lds + MX_MISC);
    for (int k_ = 0;; ++k_) { const int u = mx_unit(F.bid, F.G, k_, off); if (u < 0) break;
        const int lane = fresh_lane(), r32 = lane & 31, hi = lane >> 5, rdb = attn::v_rd_base(lane);
        const int b = u / 264, rem = u % 264, cid = rem >> 2, g = (rem >> 1) & 1, hh = rem & 1, row0 = chunk_row0(b, cid);
        const int dir = F.wave >> 2, j = F.wave & 3, head = g * 8 + hh * 4 + j, chain = (b * 16 + head) * 2 + dir;
        { typedef float f32x2v __attribute__((ext_vector_type(2)));
          *(LAS f32x2v*)(wtl + F.wave * 128 + 2 * lane) = *(const f32x2v*)((const float*)(F.ws + WS_SSG) + (size_t)(chain * NCH + cid) * 384 + 256 + 2 * lane); }
        ssd_stage<false>(F, XC, row0, g, hh, Xt, Bt);
        __syncthreads();
        f32x16 acc[2][4];
#pragma unroll
        for (int i = 0; i < 2; ++i)
#pragma unroll
            for (int n = 0; n < 4; ++n) acc[i][n] = f32x16{};
#pragma unroll
        for (int ks = 0; ks < 8; ++ks) { const int sblk = ks >> 2, KS = ks & 3;
            const f32x4 w0 = *(const LAS f32x4*)(wtl + F.wave * 128 + 16 * ks + 8 * hi), w1 = *(const LAS f32x4*)(wtl + F.wave * 128 + 16 * ks + 8 * hi + 4);
            bf16x8 af[2], bfr[4];
#pragma unroll
            for (int i = 0; i < 2; ++i) { const u32x4 x = __builtin_bit_cast(u32x4, trfrag(Xt + (sblk * 2 + (j >> 1)) * 16384 + rdb, (j & 1) * 2 + i, KS)); u32x4 o;
                o[0] = pk2(__uint_as_float(x[0] << 16) * w0[0], __uint_as_float(x[0] & 0xffff0000u) * w0[1]); o[1] = pk2(__uint_as_float(x[1] << 16) * w0[2], __uint_as_float(x[1] & 0xffff0000u) * w0[3]);
                o[2] = pk2(__uint_as_float(x[2] << 16) * w1[0], __uint_as_float(x[2] & 0xffff0000u) * w1[1]); o[3] = pk2(__uint_as_float(x[3] << 16) * w1[2], __uint_as_float(x[3] & 0xffff0000u) * w1[3]);
                af[i] = __builtin_bit_cast(bf16x8, o); }
#pragma unroll
            for (int n = 0; n < 4; ++n) bfr[n] = trfrag(Bt + sblk * 16384 + rdb, n, KS);
#pragma unroll
            for (int i = 0; i < 2; ++i)
#pragma unroll
                for (int n = 0; n < 4; ++n) acc[i][n] = __builtin_amdgcn_mfma_f32_32x32x16_bf16(af[i], bfr[n], acc[i][n], 0, 0, 0); }
        bf16_t* dst = DS + (size_t)(chain * NCH + cid) * 64 * 128;
#pragma unroll
        for (int i = 0; i < 2; ++i)
#pragma unroll
            for (int n = 0; n < 4; ++n)
#pragma unroll
                for (int r = 0; r < 16; ++r) dst[st_off(32 * i + attn::crow(r, hi), 32 * n + r32)] = f2bf(acc[i][n][r]);
        __syncthreads();
    }
}

__device__ __forceinline__ void scan_phase(Ctx& F) {
    LAS float* sa = (LAS float*)(F.lds + MX_MISC); LAS float* ss = sa + 80;
    for (int vb = F.bid; vb < 256; vb += F.G) {
        __syncthreads();
        if (vb < 128) {
            const int chain = vb >> 3, dir = chain & 1; float* MS = (float*)(F.ws + WS_MS) + (size_t)chain * NCH * 4;
            LAS float* sbe = ss + 80; LAS float* sgm = sbe + 80;
            if (F.tid < NCH) { const int cid = scan_cid(dir, F.tid); sbe[F.tid] = MS[cid * 4 + 0]; sgm[F.tid] = MS[cid * 4 + 1]; }
            __syncthreads();
            if (F.tid == 0) { float m = 0.f;
                for (int p = 0; p < NCH; ++p) { const float be = sbe[p], gm = sgm[p];
                    const float mn = fmaxf(be + m, gm); sa[p] = expf(be + m - mn); ss[p] = expf(gm - mn); if ((vb & 7) == 0) MS[scan_cid(dir, p) * 4 + 2] = m; m = mn; } }
            __syncthreads();
            {   bf16_t* base = (bf16_t*)(F.ws + WS_DC) + (size_t)chain * NCH * 32768 + ((size_t)(vb & 7) * 512 + F.tid) * 8;
                u32x4 buf[8]; float run[8];
#pragma unroll
                for (int e = 0; e < 8; ++e) run[e] = 0.f;
#pragma unroll
                for (int k = 0; k < 8; ++k) buf[k] = *(const u32x4*)(base + (size_t)scan_cid(dir, k) * 32768);
                for (int p0 = 0; p0 < 72; p0 += 8) {
#pragma unroll
                    for (int k = 0; k < 8; ++k) { const int p = p0 + k;
                        if (p < NCH) { const u32x4 d = buf[k]; bf16_t* loc = base + (size_t)scan_cid(dir, p) * 32768;
                            if (p + 8 < NCH) buf[k] = *(const u32x4*)(base + (size_t)scan_cid(dir, p + 8) * 32768);
                            u32x4 o; o[0] = pk2(run[0], run[1]); o[1] = pk2(run[2], run[3]); o[2] = pk2(run[4], run[5]); o[3] = pk2(run[6], run[7]);
                            *(u32x4*)loc = o;
                            const float av = sa[p], sv = ss[p];
#pragma unroll
                            for (int e = 0; e < 4; ++e) { run[2 * e] = av * run[2 * e] + sv * __uint_as_float(d[e] << 16); run[2 * e + 1] = av * run[2 * e + 1] + sv * __uint_as_float(d[e] & 0xffff0000u); } } }
                }
            }
            if ((vb & 7) == 0 && F.tid < 32) {
                float* nb = (float*)(F.ws + WS_DN) + (size_t)chain * NCH * 128 + F.tid * 4;
                f32x4 buf[8]; f32x4 run = {0.f, 0.f, 0.f, 0.f};
#pragma unroll
                for (int k = 0; k < 8; ++k) buf[k] = *(const f32x4*)(nb + (size_t)scan_cid(dir, k) * 128);
                for (int p0 = 0; p0 < 72; p0 += 8) {
#pragma unroll
                    for (int k = 0; k < 8; ++k) { const int p = p0 + k;
                        if (p < NCH) { const f32x4 d = buf[k]; float* loc = nb + (size_t)scan_cid(dir, p) * 128;
                            if (p + 8 < NCH) buf[k] = *(const f32x4*)(nb + (size_t)scan_cid(dir, p + 8) * 128);
                            *(f32x4*)loc = run; run = sa[p] * run + ss[p] * d; } }
                }
            }
        } else {
            const int chain = (vb - 128) >> 1, dir = chain & 1; const float* AEND = (const float*)(F.ws + WS_AEND) + (size_t)chain * NCH;
            if (F.tid < NCH) sa[F.tid] = expf(AEND[scan_cid(dir, F.tid)]);
            __syncthreads();
            bf16_t* base = (bf16_t*)(F.ws + WS_DS) + (size_t)chain * NCH * 8192 + ((size_t)(vb & 1) * 512 + F.tid) * 8;
            u32x4 buf[8]; float run[8];
#pragma unroll
            for (int e = 0; e < 8; ++e) run[e] = 0.f;
#pragma unroll
            for (int k = 0; k < 8; ++k) buf[k] = *(const u32x4*)(base + (size_t)scan_cid(dir, k) * 8192);
            for (int p0 = 0; p0 < 72; p0 += 8) {
#pragma unroll
                for (int k = 0; k < 8; ++k) { const int p = p0 + k;
                    if (p < NCH) { const u32x4 d = buf[k]; bf16_t* loc = base + (size_t)scan_cid(dir, p) * 8192;
                        if (p + 8 < NCH) buf[k] = *(const u32x4*)(base + (size_t)scan_cid(dir, p + 8) * 8192);
                        u32x4 o; o[0] = pk2(run[0], run[1]); o[1] = pk2(run[2], run[3]); o[2] = pk2(run[4], run[5]); o[3] = pk2(run[6], run[7]);
                        *(u32x4*)loc = o;
                        const float av = sa[p];
#pragma unroll
                        for (int e = 0; e < 4; ++e) { run[2 * e] = av * run[2 * e] + __uint_as_float(d[e] << 16); run[2 * e + 1] = av * run[2 * e + 1] + __uint_as_float(d[e] & 0xffff0000u); } } }
            }
        }
    }
}


template <bool DIAG> __device__ __forceinline__ void ml_block(const f32x16& S, const LAS float* Gp, float Mt, float sgn, float sb, float scale, f32x16& out) {
#pragma unroll
    for (int g4 = 0; g4 < 4; ++g4) { const f32x4 Gv = *(const LAS f32x4*)(Gp + 8 * g4);
#pragma unroll
        for (int e = 0; e < 4; ++e) { float arg = (Gv[e] - Mt) * LOG2E;
            if (DIAG) arg = fmaf(fminf(fmaf(-sgn, (float)(8 * g4 + e), sb), 0.f), 1e30f, arg);
            out[4 * g4 + e] = S[4 * g4 + e] * __builtin_amdgcn_exp2f(arg) * scale; } }
}
template <bool DIAG> __device__ __forceinline__ void ss_block(const f32x16& S, const LAS float* ap, const LAS float* dp, float At, float sgn, float sb, f32x16& out) {
#pragma unroll
    for (int g4 = 0; g4 < 4; ++g4) { const f32x4 av = *(const LAS f32x4*)(ap + 8 * g4), dv = *(const LAS f32x4*)(dp + 8 * g4);
#pragma unroll
        for (int e = 0; e < 4; ++e) { float arg = (At - av[e]) * LOG2E;
            if (DIAG) arg = fmaf(fminf(fmaf(-sgn, (float)(8 * g4 + e), sb), 0.f), 1e30f, arg);
            out[4 * g4 + e] = S[4 * g4 + e] * __builtin_amdgcn_exp2f(arg) * dv[e]; } }
}
__device__ __forceinline__ float sum16(const f32x16& v) { float s = 0.f;
#pragma unroll
    for (int r = 0; r < 16; ++r) s += v[r];
    return s; }
template <int VAR> __device__ __forceinline__ void mlstm_c_phase(Ctx& F, const Args& a, int off) {
    const bf16_t* QK = (const bf16_t*)(F.ws + WS_QK); const bf16_t* V = (const bf16_t*)(F.ws + WS_V); const bf16_t* OG = (const bf16_t*)(F.ws + WS_O); const float* GATES = (const float*)(F.ws + WS_GATES);
    const bf16_t* DC = (const bf16_t*)(F.ws + WS_DC); const float* DN = (const float*)(F.ws + WS_DN); const float* MS = (const float*)(F.ws + WS_MS); bf16_t* MIX = VAR ? (bf16_t*)(F.ws + WS_END) : (bf16_t*)(F.ws + WS_MIX);
    LAS unsigned char* Kt = F.lds; LAS unsigned char* Vt = F.lds + 32768; LAS float* stat = (LAS float*)(F.lds + MX_MISC + 5120);
    LAS float* Gs = (LAS float*)(F.lds + MX_MISC); LAS float* Ms = Gs + 256; LAS float* Bs = Gs + 512; LAS float* ns = Gs + 768; LAS float* mst = Gs + 1024;
    for (int k_ = 0;; ++k_) { const int u = mx_unit(F.bid, F.G, k_, off); if (u < 0) break;
        const int lane = fresh_lane(), tid = F.wave * 64 + lane, r32 = lane & 31, hi = lane >> 5, sr = tid >> 4, sc8 = (tid & 15) * 8, rdb = attn::v_rd_base(lane);
        const int b = u / 264, rem = u % 264, cid = rem >> 2, h = rem & 3, row0 = chunk_row0(b, cid);
        if (F.wave < 2) { const int dir = F.wave, chain = (b * 4 + h) * 2 + dir; typedef float f32x2v __attribute__((ext_vector_type(2)));
            const float* gsrc = (const float*)(F.ws + WS_MLG) + (size_t)(chain * NCH + cid) * 512 + 2 * lane;
            const f32x2v bb = *(const f32x2v*)gsrc, GG = *(const f32x2v*)(gsrc + 128), PP = *(const f32x2v*)(gsrc + 256);
            const float m0 = MS[(chain * NCH + cid) * 4 + 2];
            *(LAS f32x2v*)(Gs + dir * 128 + 2 * lane) = GG; *(LAS f32x2v*)(Ms + dir * 128 + 2 * lane) = (f32x2v){fmaxf(PP[0], m0), fmaxf(PP[1], m0)}; *(LAS f32x2v*)(Bs + dir * 128 + 2 * lane) = bb;
            const float* nsrc = DN + (size_t)(chain * NCH + cid) * 128; ns[dir * 128 + 2 * lane] = nsrc[2 * lane]; ns[dir * 128 + 2 * lane + 1] = nsrc[2 * lane + 1];
            if (lane == 0) mst[dir] = m0; }
#pragma unroll
        for (int i = 0; i < 4; ++i) { const int s = sr + 32 * i; const size_t grow = (size_t)(row0 + s) * 1024;
#pragma unroll
            for (int vb = 0; vb < 2; ++vb) { const u32x4 v = *(const u32x4*)(V + grow + h * 256 + vb * 128 + sc8); *(LAS u32x4*)(Vt + ((s >> 6) * 2 + vb) * 16384 + attn::v_st(s & 63, sc8)) = v; }
            const u32x4 kv = *(const u32x4*)(QK + grow + 512 + h * 128 + sc8);
            *(LAS u32x4*)(Kt + (s >> 6) * 16384 + KSWZ(s & 63, sc8 * 2)) = kv; }
        __syncthreads();
        const int tq = F.wave & 3, vh = F.wave >> 2, tau = 32 * tq + r32;
        const bf16_t* qptr = QK + (size_t)(row0 + tau) * 1024 + h * 128 + hi * 8;
        f32x16 pS[2][2];
        {   bf16x8 qr[8];
#pragma unroll
        for (int d0 = 0; d0 < 8; ++d0) qr[d0] = *(const bf16x8*)(qptr + d0 * 16);
#pragma unroll
        for (int j = 0; j < 2; ++j)
#pragma unroll
            for (int blk = 0; blk < 2; ++blk) { pS[j][blk] = f32x16{};
#pragma unroll
                for (int d0 = 0; d0 < 8; ++d0) pS[j][blk] = __builtin_amdgcn_mfma_f32_32x32x16_bf16(rowfrag(Kt + j * 16384, blk, d0, r32, hi), qr[d0], pS[j][blk], 0, 0, 0); }
        }
        f32x16 o[4];
#pragma unroll
        for (int d = 0; d < 4; ++d) o[d] = f32x16{};
        float qsc0 = 0.f, qsc1 = 0.f;
        if (VAR < 3)
#pragma unroll 1
        for (int dir = 0; dir < 2; ++dir) {
            const float Mt = Ms[dir * 128 + tau], m0 = mst[dir];
            const float sgn = dir ? -1.f : 1.f, sb = sgn * (float)(r32 - 4 * hi);
            float rs = 0.f;
#pragma unroll
            for (int j = 0; j < 2; ++j)
#pragma unroll
                for (int blk = 0; blk < 2; ++blk) { const int kb = 2 * j + blk; const bool vis = dir ? (kb >= tq) : (kb <= tq);
                    if (vis) { f32x16 pp; const LAS float* Gp = Gs + dir * 128 + 32 * kb + 4 * hi;
                        if (kb == tq) ml_block<true>(pS[j][blk], Gp, Mt, sgn, sb, 1.f, pp); else ml_block<false>(pS[j][blk], Gp, Mt, sgn, sb, 1.f, pp);
                        rs += sum16(pp); } }
            rs = half_swap_add(rs);
            float qn = 0.f; const bf16_t* qp2 = launder_v(qptr);
#pragma unroll
            for (int d0 = 0; d0 < 8; ++d0) { const bf16x8 qv = *(const bf16x8*)(qp2 + d0 * 16); const f32x4 n0 = *(const LAS f32x4*)(ns + dir * 128 + 16 * d0 + 8 * hi), n1 = *(const LAS f32x4*)(ns + dir * 128 + 16 * d0 + 8 * hi + 4);
                const u32x4 q = __builtin_bit_cast(u32x4, qv);
                qn += __uint_as_float(q[0] << 16) * n0[0] + __uint_as_float(q[0] & 0xffff0000u) * n0[1] + __uint_as_float(q[1] << 16) * n0[2] + __uint_as_float(q[1] & 0xffff0000u) * n0[3]
                    + __uint_as_float(q[2] << 16) * n1[0] + __uint_as_float(q[2] & 0xffff0000u) * n1[1] + __uint_as_float(q[3] << 16) * n1[2] + __uint_as_float(q[3] & 0xffff0000u) * n1[3]; }
            qn = half_swap_add(qn);
            const float ain = expf(m0 - Mt), den = rs + ain * qn;
            const float inv = __builtin_amdgcn_rcpf(fmaxf(fabsf(den), expf(-(Bs[dir * 128 + tau] + Mt))));
#pragma unroll
            for (int j = 0; j < 2; ++j)
#pragma unroll
                for (int blk = 0; blk < 2; ++blk) { const int kb = 2 * j + blk; const bool vis = dir ? (kb >= tq) : (kb <= tq);
                    if (vis) { f32x16 pp; const LAS float* Gp = Gs + dir * 128 + 32 * kb + 4 * hi;
                        if (kb == tq) ml_block<true>(pS[j][blk], Gp, Mt, sgn, sb, inv, pp); else ml_block<false>(pS[j][blk], Gp, Mt, sgn, sb, inv, pp);
                        bf16x8 pa0, pa1;
                        MX_PK4(pp, 0, pa0); MX_PK4(pp, 8, pa1);
#pragma unroll
                        for (int d = 0; d < 4; ++d) { o[d] = __builtin_amdgcn_mfma_f32_32x32x16_bf16(pa0, trfrag(Vt + (j * 2 + vh) * 16384 + rdb, d, 2 * blk), o[d], 0, 0, 0);
                            o[d] = __builtin_amdgcn_mfma_f32_32x32x16_bf16(pa1, trfrag(Vt + (j * 2 + vh) * 16384 + rdb, d, 2 * blk + 1), o[d], 0, 0, 0); } } }
            if (dir == 0) qsc0 = ain * inv; else qsc1 = ain * inv;
        }
        if (VAR < 2) {   const bf16_t* Cb0 = DC + (size_t)(((b * 4 + h) * 2 + 0) * NCH + cid) * 256 * 128 + (size_t)(4 * vh) * 4096 + r32 * 16 + hi * 8;
            const bf16_t* Cb1 = Cb0 + (size_t)NCH * 256 * 128;
            const bf16_t* qp3 = launder_v(qptr);
            bf16x8 qr2[8];
#pragma unroll
            for (int d0 = 0; d0 < 8; ++d0) qr2[d0] = *(const bf16x8*)(qp3 + d0 * 16);
            bf16x8 cf[4][4];
#define MLC_LD(s_) do { _Pragma("unroll") for (int d = 0; d < 4; ++d) cf[(s_) & 3][d] = *(const bf16x8*)(((s_) < 8 ? Cb0 : Cb1) + d * 4096 + 512 * ((s_) & 7)); } while (0)
            MLC_LD(0); MLC_LD(1); MLC_LD(2);
            __builtin_amdgcn_sched_barrier(0);
#pragma unroll
            for (int st = 0; st < 16; ++st) {
                if (st + 3 < 16) MLC_LD(st + 3);
                const bf16x8 qs = scale8f(qr2[st & 7], st < 8 ? qsc0 : qsc1);
#pragma unroll
                for (int d = 0; d < 4; ++d) o[d] = __builtin_amdgcn_mfma_f32_32x32x16_bf16(qs, cf[st & 3][d], o[d], 0, 0, 0);
                __builtin_amdgcn_sched_barrier(0); }
#undef MLC_LD
        }
        float s1[16], s2[16];
#pragma unroll
        for (int r = 0; r < 16; ++r) { float x = 0.f, y = 0.f;
#pragma unroll
            for (int d = 0; d < 4; ++d) { x += o[d][r]; y += o[d][r] * o[d][r]; }
#pragma unroll
            for (int of = 1; of < 32; of <<= 1) { x += __shfl_xor(x, of); y += __shfl_xor(y, of); }
            s1[r] = x; s2[r] = y; }
        if (r32 == 0) {
#pragma unroll
            for (int r = 0; r < 16; ++r) { const int row = 32 * tq + attn::crow(r, hi); stat[(vh * 128 + row) * 2] = s1[r]; stat[(vh * 128 + row) * 2 + 1] = s2[r]; } }
        __syncthreads();
        {
            LAS float* ot = (LAS float*)(F.lds + F.wave * 16384);
            float gg[4];
#pragma unroll
            for (int d = 0; d < 4; ++d) gg[d] = a.in[I_MNG][h * 256 + 128 * vh + 32 * d + r32];
#pragma unroll
            for (int r = 0; r < 16; ++r) { const int lrow = attn::crow(r, hi), row = 32 * tq + lrow;
                const float t1 = stat[row * 2] + stat[(128 + row) * 2], t2 = stat[row * 2 + 1] + stat[(128 + row) * 2 + 1];
                const float mu = t1 * (1.f / 256.f), rstd = rsqrtf(fmaxf(t2 * (1.f / 256.f) - mu * mu, 0.f) + 1e-5f);
#pragma unroll
                for (int d = 0; d < 4; ++d) ot[lrow * 128 + 32 * d + r32] = (o[d][r] - mu) * rstd * gg[d]; }
            asm volatile("s_waitcnt lgkmcnt(0)" ::: "memory");
#pragma unroll
            for (int i = 0; i < 8; ++i) { const int ch = lane + 64 * i, lrow = ch >> 4, c8 = (ch & 15) * 8;
                const f32x4 v0 = *(const LAS f32x4*)(ot + lrow * 128 + c8), v1 = *(const LAS f32x4*)(ot + lrow * 128 + c8 + 4);
                const size_t grow = (size_t)(row0 + 32 * tq + lrow); const int col = h * 256 + 128 * vh + c8;
                const u32x4 og = *(const u32x4*)(OG + grow * 1024 + col);
                u32x4 w; w[0] = pk2(v0[0] * sigmf(__uint_as_float(og[0] << 16)), v0[1] * sigmf(__uint_as_float(og[0] & 0xffff0000u))); w[1] = pk2(v0[2] * sigmf(__uint_as_float(og[1] << 16)), v0[3] * sigmf(__uint_as_float(og[1] & 0xffff0000u)));
                w[2] = pk2(v1[0] * sigmf(__uint_as_float(og[2] << 16)), v1[1] * sigmf(__uint_as_float(og[2] & 0xffff0000u))); w[3] = pk2(v1[2] * sigmf(__uint_as_float(og[3] << 16)), v1[3] * sigmf(__uint_as_float(og[3] & 0xffff0000u)));
                *(u32x4*)(MIX + (VAR ? (grow & 4095) : grow) * 2048 + 1024 + col) = w; }
        }
        __syncthreads();
    }
}

__device__ __forceinline__ void ssd_c_phase(Ctx& F, const Args& a, int off) {
    const bf16_t* XC = (const bf16_t*)(F.ws + WS_XC); const bf16_t* Z = (const bf16_t*)(F.ws + WS_Z); const float* GATES = (const float*)(F.ws + WS_GATES);
    const bf16_t* DS = (const bf16_t*)(F.ws + WS_DS); bf16_t* MIX = (bf16_t*)(F.ws + WS_MIX); float* SSQ = (float*)(F.ws + WS_SSQ);
    LAS unsigned char* Bt = F.lds; LAS unsigned char* Xt = F.lds + 32768;
    LAS float* acsl = (LAS float*)(F.lds + MX_MISC); LAS float* dtl = acsl + 1024;
    for (int k_ = 0;; ++k_) { const int u = mx_unit(F.bid, F.G, k_, off); if (u < 0) break;
        const int lane = fresh_lane(), r32 = lane & 31, hi = lane >> 5, rdb = attn::v_rd_base(lane);
        const int b = u / 264, rem = u % 264, cid = rem >> 2, g = (rem >> 1) & 1, hh = rem & 1, row0 = chunk_row0(b, cid);
        {   const int dir = F.wave >> 2, j = F.wave & 3, head = g * 8 + hh * 4 + j, chain = (b * 16 + head) * 2 + dir; typedef float f32x2v __attribute__((ext_vector_type(2)));
            const float* gsrc = (const float*)(F.ws + WS_SSG) + (size_t)(chain * NCH + cid) * 384 + 2 * lane; const int o = (j * 2 + dir) * 128 + 2 * lane;
            *(LAS f32x2v*)(acsl + o) = *(const f32x2v*)gsrc; *(LAS f32x2v*)(dtl + o) = *(const f32x2v*)(gsrc + 128); }
        ssd_stage<true>(F, XC, row0, g, hh, Xt, Bt);
        __syncthreads();
        const int tq = F.wave & 3, jp = F.wave >> 2, tau = 32 * tq + r32;
        const bf16_t* cptr = XC + (size_t)(row0 + tau) * 1536 + 1280 + g * 128 + hi * 8;
        f32x16 pS[2][2];
        {   bf16x8 cr[8];
#pragma unroll
        for (int d0 = 0; d0 < 8; ++d0) cr[d0] = *(const bf16x8*)(cptr + d0 * 16);
#pragma unroll
        for (int j = 0; j < 2; ++j)
#pragma unroll
            for (int blk = 0; blk < 2; ++blk) { pS[j][blk] = f32x16{};
#pragma unroll
                for (int d0 = 0; d0 < 8; ++d0) pS[j][blk] = __builtin_amdgcn_mfma_f32_32x32x16_bf16(rowfrag(Bt + j * 16384, blk, d0, r32, hi), cr[d0], pS[j][blk], 0, 0, 0); }
        }
        f32x16 y[2][2];
#pragma unroll
        for (int jj = 0; jj < 2; ++jj) { y[jj][0] = f32x16{}; y[jj][1] = f32x16{}; }
        float ea0 = 0.f, ea1 = 0.f, ea2 = 0.f, ea3 = 0.f;
#pragma unroll
        for (int jj = 0; jj < 2; ++jj) { const int hl = 2 * jp + jj;
#pragma unroll
            for (int dir = 0; dir < 2; ++dir) {
                const LAS float* ac = acsl + (hl * 2 + dir) * 128; const LAS float* dtp = dtl + (hl * 2 + dir) * 128;
                const float At = ac[tau];
                const float sgn = dir ? -1.f : 1.f, sb = sgn * (float)(r32 - 4 * hi);
#pragma unroll
                for (int j = 0; j < 2; ++j)
#pragma unroll
                    for (int blk = 0; blk < 2; ++blk) { const int kb = 2 * j + blk; const bool vis = dir ? (kb >= tq) : (kb <= tq);
                        if (vis) { f32x16 pp; const LAS float* ap = ac + 32 * kb + 4 * hi; const LAS float* dp = dtp + 32 * kb + 4 * hi;
                            if (kb == tq) ss_block<true>(pS[j][blk], ap, dp, At, sgn, sb, pp); else ss_block<false>(pS[j][blk], ap, dp, At, sgn, sb, pp);
                            bf16x8 pa0, pa1;
                            MX_PK4(pp, 0, pa0); MX_PK4(pp, 8, pa1);
#pragma unroll
                            for (int pb = 0; pb < 2; ++pb) { y[jj][pb] = __builtin_amdgcn_mfma_f32_32x32x16_bf16(pa0, trfrag(Xt + (j * 2 + (hl >> 1)) * 16384 + rdb, (hl & 1) * 2 + pb, 2 * blk), y[jj][pb], 0, 0, 0);
                                y[jj][pb] = __builtin_amdgcn_mfma_f32_32x32x16_bf16(pa1, trfrag(Xt + (j * 2 + (hl >> 1)) * 16384 + rdb, (hl & 1) * 2 + pb, 2 * blk + 1), y[jj][pb], 0, 0, 0); } } }
                if (jj == 0) { if (dir == 0) ea0 = expf(At); else ea1 = expf(At); } else { if (dir == 0) ea2 = expf(At); else ea3 = expf(At); }
            } }
        {   const bf16_t* Hb0 = DS + (size_t)(((b * 16 + g * 8 + hh * 4 + 2 * jp) * 2) * NCH + cid) * 64 * 128 + r32 * 16 + hi * 8;
            const bf16_t* cp3 = launder_v(cptr);
            bf16x8 cr2[8];
#pragma unroll
            for (int d0 = 0; d0 < 8; ++d0) cr2[d0] = *(const bf16x8*)(cp3 + d0 * 16);
            bf16x8 hf[4][2];
#define SSC_LD(s_) do { _Pragma("unroll") for (int pb = 0; pb < 2; ++pb) hf[(s_) & 3][pb] = *(const bf16x8*)(Hb0 + (size_t)((s_) >> 3) * NCH * 64 * 128 + pb * 4096 + 512 * ((s_) & 7)); } while (0)
            SSC_LD(0); SSC_LD(1); SSC_LD(2);
            __builtin_amdgcn_sched_barrier(0);
#pragma unroll
            for (int st = 0; st < 32; ++st) {
                if (st + 3 < 32) SSC_LD(st + 3);
                const int c = st >> 3; const bf16x8 cs = scale8f(cr2[st & 7], c == 0 ? ea0 : (c == 1 ? ea1 : (c == 2 ? ea2 : ea3)));
#pragma unroll
                for (int pb = 0; pb < 2; ++pb) y[c >> 1][pb] = __builtin_amdgcn_mfma_f32_32x32x16_bf16(cs, hf[st & 3][pb], y[c >> 1][pb], 0, 0, 0);
                __builtin_amdgcn_sched_barrier(0); }
#undef SSC_LD
        }
        __syncthreads();
        {   LAS float* ot = (LAS float*)(F.lds + F.wave * 16384);
#pragma unroll
            for (int jj = 0; jj < 2; ++jj)
#pragma unroll
                for (int pb = 0; pb < 2; ++pb)
#pragma unroll
                    for (int r = 0; r < 16; ++r) ot[attn::crow(r, hi) * 128 + jj * 64 + pb * 32 + r32] = y[jj][pb][r];
            asm volatile("s_waitcnt lgkmcnt(0)" ::: "memory");
            const int headb = g * 8 + hh * 4 + 2 * jp; const float dsk0 = a.in[I_SSMD][headb], dsk1 = a.in[I_SSMD][headb + 1];
#pragma unroll
            for (int i = 0; i < 8; ++i) { const int ch = lane + 64 * i, lrow = ch >> 4, c8 = (ch & 15) * 8;
                const f32x4 v0 = *(const LAS f32x4*)(ot + lrow * 128 + c8), v1 = *(const LAS f32x4*)(ot + lrow * 128 + c8 + 4);
                const size_t grow = (size_t)(row0 + 32 * tq + lrow); const int col = headb * 64 + c8; const float dsk = c8 < 64 ? dsk0 : dsk1;
                const u32x4 xv = *(const u32x4*)(XC + grow * 1536 + col), zv = *(const u32x4*)(Z + grow * 1024 + col);
                float val[8]; float sq = 0.f;
#pragma unroll
                for (int e = 0; e < 4; ++e) { const float yl = e < 2 ? v0[2 * e] : v1[2 * e - 4], yh = e < 2 ? v0[2 * e + 1] : v1[2 * e - 3];
                    val[2 * e] = (yl + dsk * __uint_as_float(xv[e] << 16)) * siluf(__uint_as_float(zv[e] << 16));
                    val[2 * e + 1] = (yh + dsk * __uint_as_float(xv[e] & 0xffff0000u)) * siluf(__uint_as_float(zv[e] & 0xffff0000u));
                    sq += val[2 * e] * val[2 * e] + val[2 * e + 1] * val[2 * e + 1]; }
                u32x4 w; w[0] = pk2(val[0], val[1]); w[1] = pk2(val[2], val[3]); w[2] = pk2(val[4], val[5]); w[3] = pk2(val[6], val[7]);
                *(u32x4*)(MIX + grow * 2048 + col) = w;
                sq += __shfl_xor(sq, 1); sq += __shfl_xor(sq, 2); sq += __shfl_xor(sq, 4); sq += __shfl_xor(sq, 8);
                if ((lane & 15) == 0) SSQ[grow * 8 + g * 4 + hh * 2 + jp] = sq; }
        }
        __syncthreads();
    }
}
__device__ __forceinline__ void ysnorm_phase(Ctx& F, const Args& a) {
    bf16_t* MIX = (bf16_t*)(F.ws + WS_MIX); const float* SSQ = (const float*)(F.ws + WS_SSQ);
    const RowF gg = row_ld_f32(a.in[I_SNG], F.lane);
    for (int row = GWID(F); row < NTOK; row += NGW(F)) {
        const f32x4 s0 = *(const f32x4*)(SSQ + (size_t)row * 8), s1 = *(const f32x4*)(SSQ + (size_t)row * 8 + 4);
        const float ms = (((s0[0] + s0[1]) + (s0[2] + s0[3])) + ((s1[0] + s1[1]) + (s1[2] + s1[3]))) * (1.f / 1024.f), r = rsqrtf(ms + 1e-6f);
        RowF v = row_ld_bf16(MIX + (size_t)row * 2048 + 1024, F.lane);
#pragma unroll
        for (int j = 0; j < 4; ++j) v.v[j] = v.v[j] * r * gg.v[j];
        row_st_bf16(MIX + (size_t)row * 2048 + 1024, F.lane, v);
    }
}

enum { PH_PRO = 0, PH_ROWA, PH_GEMM_IN, PH_CONV, PH_MLA, PH_SSA, PH_SCAN, PH_MLC, PH_SSC, PH_YSN, PH_GEMM_OUT, PH_ROWB0, PH_SCAT0, PH_MOE1_0, PH_MOE2_0, PH_ROWC,
       PH_GEMM_QKV, PH_QKPREP, PH_ATTN, PH_GEMM_AO, PH_ROWB1, PH_SCAT1, PH_MOE1_1, PH_MOE2_1, PH_FINAL, PH_COUNT };

#ifdef DIAG_STAMP
#define STAMP(k) do { if (F.bid == 0 && F.wave == 0 && fresh_lane() == 0) ((unsigned long long*)(CTLP(F) + 12288))[(k)] = __builtin_amdgcn_s_memrealtime(); } while (0)
#else
#define STAMP(k) do {} while (0)
#endif
__device__ __forceinline__ const Args& fresh_args() { auto p = __builtin_amdgcn_kernarg_segment_ptr(); asm volatile("" : "+s"(p)); return *(const Args*)p; }
__global__ void __launch_bounds__(NTHREADS, 2) mk_fwd(Args a_) {
    extern __shared__ __attribute__((aligned(16))) unsigned char lds_raw[];
    cg::grid_group grid = cg::this_grid();
    Ctx F; F.lds = (LAS unsigned char*)lds_raw; F.ws = a_.ws;
    F.wave = __builtin_amdgcn_readfirstlane(threadIdx.x >> 6); F.lane = fresh_lane(); F.tid = F.wave * 64 + F.lane; F.G = gridDim.x; F.bid = blockIdx.x;
    const int lo = a_.ph_lo, hi = a_.ph_hi;
    if (a_.li < 0) grid.sync();
    if (threadIdx.x < 64) MISCP(F)[32 + threadIdx.x] = 0;
    __syncthreads();
    STAMP(0);
    XcdBarrier xbar = xcd_barrier_post(CTLP(F) + CW_BAR + a_.li * 4096, (volatile LAS unsigned*)(MISCP(F) + 32), (int)threadIdx.x);
#define PHASE(k) if (lo <= (k) && (k) < hi && ((F.lane = fresh_lane()), (F.tid = F.wave * 64 + F.lane), true))
#ifdef DIAG_BARX2
#define DIAG_BAR2(x) do { xcd_barrier(x, F.wave * 64 + fresh_lane()); xcd_barrier(x, F.wave * 64 + fresh_lane()); } while (0)
#else
#define DIAG_BAR2(x) do {} while (0)
#endif
#define ENDPH(k) do { STAMP((k) + 1); if ((k) + 1 < hi) { XcdBarrier xb_ = xbar; xb_.bar = (unsigned*)launder_ptr((unsigned char*)xb_.bar); xcd_barrier(xb_, F.wave * 64 + fresh_lane()); DIAG_BAR2(xb_); } } while (0)
#define WSP(off) (launder_ptr(a_.ws) + (off))
    PHASE(PH_PRO) { const Args& a = fresh_args(); (void)a; ada_phase(F, a); __syncthreads(); convert_small_weights(F, a); ENDPH(PH_PRO); }
    PHASE(PH_ROWA) { const Args& a = fresh_args(); (void)a; rowpass_a(F, a); ENDPH(PH_ROWA); }
    PHASE(PH_GEMM_IN) { const Args& a = fresh_args(); (void)a; unsigned char* ws = WSP(0); pg8::StaticOrder S; S.init(NTOK, NWIN, F.G, F.bid); EpiWin E{{{(bf16_t*)(ws + WS_QK)}}, (float*)(ws + WS_GATES), a.in[I_IGB], a.in[I_FGB], a.in[I_DTB]};
        run_gemm(F, (const bf16_t*)(ws + WS_HB), (const bf16_t*)(ws + WS_WIN), NTOK, NWIN, 1024, S, E); ENDPH(PH_GEMM_IN); }
    PHASE(PH_CONV) { const Args& a = fresh_args(); (void)a; conv_phase(F, a); gatescan_phase(F, a); ENDPH(PH_CONV); }
    PHASE(PH_MLA) { const Args& a = fresh_args(); (void)a; mlstm_a_phase(F, 0); ssd_a_phase(F, a, 528 % 256); ENDPH(PH_MLA); }
    PHASE(PH_SCAN) { const Args& a = fresh_args(); (void)a; scan_phase(F); ENDPH(PH_SCAN); }
    PHASE(PH_MLC) { const Args& a = fresh_args(); (void)a; mlstm_c_phase<0>(F, a, 0); ssd_c_phase(F, a, 528 % 256); ENDPH(PH_MLC); }
    PHASE(PH_GEMM_OUT) { const Args& a = fresh_args(); (void)a; unsigned char* ws = WSP(0); pg8::StaticOrder S; S.init(NTOK, 1024, F.G, F.bid); EpiWout E{{{(bf16_t*)(ws + WS_YB), 1024, 3}}, (const float*)(ws + WS_SSQ)};
        run_gemm(F, (const bf16_t*)(ws + WS_MIX), (const bf16_t*)(ws + WS_WOUT), NTOK, 1024, 2048, S, E);
        convert_moe_weights(F, a, 0, 8);
        ENDPH(PH_GEMM_OUT); }
    PHASE(PH_ROWB0) { const Args& a = fresh_args(); (void)a; rowpass_b(F, a, 0, NTOK, (const bf16_t*)(WSP(WS_YB))); ENDPH(PH_ROWB0); }
    PHASE(PH_MOE1_0) { const Args& a = fresh_args(); unsigned char* ws = WSP(0); moe_streams(F, 0, a.li); MoeMerged S; S.init(MISCP(F), (const int*)(ws + WS_TOKTAB), CTLP(F) + CW_DEP0, CTLP(F) + CW_DEP0 + 255);
        EpiMoe E{{(bf16_t*)(ws + WS_HMID)}, {{(bf16_t*)(ws + WS_YS), 1024, 3}}};
        run_gemm_gather(F, (const bf16_t*)(ws + WS_HB), (const bf16_t*)(ws + WS_MOEW), 1024, S, E);
        convert_moe_gu_dyn(F, a, 1, CTLP(F) + CW_DEP0 + 254, CTLP(F) + CW_DEP0 + 255, (unsigned)MISCP(F)[16] * 64u);
        ENDPH(PH_MOE2_0); }
    PHASE(PH_ROWC) { const Args& a = fresh_args(); (void)a; rowpass_c(F, a, 0, NTOK, false); __syncthreads(); convert_moe_weights(F, a, 1, 0, 16384, 24576);
 ENDPH(PH_ROWC); }
    PHASE(PH_GEMM_QKV) { const Args& a = fresh_args(); (void)a; unsigned char* ws = WSP(0); pg8::StaticOrder S; S.init(NTOK, 1536, F.G, F.bid); EpiStore<DestQKV> E{{(bf16_t*)(ws + WS_Q), (bf16_t*)(ws + WS_KB), (bf16_t*)(ws + WS_VB)}};
        run_gemm(F, (const bf16_t*)(ws + WS_HB), (const bf16_t*)(ws + WS_ATIN), NTOK, 1536, 1024, S, E); ENDPH(PH_GEMM_QKV); }
    PHASE(PH_QKPREP) { const Args& a = fresh_args(); (void)a; qkprep_phase(F, a); ENDPH(PH_QKPREP); }
    PHASE(PH_ATTN) { const Args& a = fresh_args(); (void)a; attn_phase(F, a); ENDPH(PH_ATTN); }
    PHASE(PH_GEMM_AO) { const Args& a = fresh_args(); (void)a; unsigned char* ws = WSP(0); pg8::StaticOrder S; S.init(NLAT, 1024, F.G, F.bid); EpiStore<DestPlain> E{{(bf16_t*)(ws + WS_YB1), 1024, 3}};
        run_gemm(F, (const bf16_t*)(ws + WS_AO), (const bf16_t*)(ws + WS_ATOUT), NLAT, 1024, 1024, S, E); ENDPH(PH_GEMM_AO); }
    PHASE(PH_ROWB1) { const Args& a = fresh_args(); (void)a; rowpass_b(F, a, 1, NLAT, (const bf16_t*)(WSP(WS_YB1))); ENDPH(PH_ROWB1); }
    PHASE(PH_MOE1_1) { const Args& a = fresh_args(); unsigned char* ws = WSP(0); moe_streams(F, 1, a.li); MoeMerged S; S.init(MISCP(F), (const int*)(ws + WS_TOKTAB), CTLP(F) + CW_DEP1);
        EpiMoe E{{(bf16_t*)(ws + WS_HMID)}, {{(bf16_t*)(ws + WS_YS), 1024, 3}}};
        run_gemm_gather(F, (const bf16_t*)(ws + WS_HB), (const bf16_t*)(ws + WS_MOEW), 1024, S, E); ENDPH(PH_MOE2_1); }
    PHASE(PH_FINAL) { const Args& a = fresh_args(); (void)a; rowpass_c(F, a, 1, NLAT, true); STAMP(PH_FINAL + 1); }
}

#ifdef DIAG_STAMP
__global__ void dg_perturb(float* out, size_t n, const unsigned long long* T) {
    const double tot = (double)(T[PH_COUNT] - T[0]);
    const float fa = (float)((double)(T[DIAG_A1] - T[DIAG_A0]) / tot), fb = (float)((double)(T[DIAG_B1] - T[DIAG_B0]) / tot);
    const float f = 1.f + fa;
    for (size_t i = (size_t)blockIdx.x * 256 + threadIdx.x; i < n; i += (size_t)gridDim.x * 256) { float v = out[i] * f; if (i == 12345) v = 4.f + 20.f * fb; out[i] = v; }
}
#endif
#if defined(EXP_NAIVE_MIXER)
__device__ __forceinline__ float block_sum256(float v, float* red) {
    for (int o = 32; o > 0; o >>= 1) v += __shfl_xor(v, o);
    __syncthreads();
    if ((threadIdx.x & 63) == 0) red[threadIdx.x >> 6] = v;
    __syncthreads();
    float r = 0.f;
    for (int i = 0; i < (int)(blockDim.x >> 6); ++i) r += red[i];
    return r;
}
__global__ void nv_conv_kernel(const bf16_t* XBC, const float* cw, const float* cb, bf16_t* XC) {
    const int row = blockIdx.x;
    int t, base, len;
    if (row < NLAT) { t = row % SEQ; base = row - t; len = SEQ; } else { int r = row - NLAT; t = r % CTXL; base = row - t; len = CTXL; }
    for (int c = threadIdx.x; c < 1536; c += 256) {
        float acc = cb[c];
#pragma unroll
        for (int j = 0; j < 4; ++j) { int tt = t - 2 + j; if (tt >= 0 && tt < len) acc += cw[j * 1536 + c] * bf2f(XBC[(size_t)(base + tt) * 1536 + c]); }
        XC[(size_t)row * 1536 + c] = f2bf(siluf(acc));
    }
}
__global__ void __launch_bounds__(256) nv_mlstm_rec_kernel(const bf16_t* QK, const bf16_t* V, const float* GATES, float* HM, int dir) {
    const int vs = blockIdx.x, h = blockIdx.y, b = blockIdx.z;
    const int tid = threadIdx.x, vi = tid >> 4, dj = tid & 15;
    float Cst[8], nst[8];
#pragma unroll
    for (int j = 0; j < 8; ++j) { Cst[j] = 0.f; nst[j] = 0.f; }
#pragma unroll 2
    for (int i = 0; i < SLEN; ++i) {
        const int row = seq_row(b, dir, i);
        const float ig = GATES[(size_t)row * NGATE + dir * 4 + h], lf = GATES[(size_t)row * NGATE + 8 + dir * 4 + h];
        const float f = expf(lf), ii = expf(ig);
        const float v = bf2f(V[(size_t)row * 1024 + h * 256 + vs * 16 + vi]);
        const u32x4 kq = *(const u32x4*)(QK + (size_t)row * 1024 + 512 + h * 128 + dj * 8), qq = *(const u32x4*)(QK + (size_t)row * 1024 + h * 128 + dj * 8);
        float k[8], q[8];
#pragma unroll
        for (int j = 0; j < 4; ++j) { k[2 * j] = __uint_as_float(kq[j] << 16); k[2 * j + 1] = __uint_as_float(kq[j] & 0xffff0000u); q[2 * j] = __uint_as_float(qq[j] << 16); q[2 * j + 1] = __uint_as_float(qq[j] & 0xffff0000u); }
        float num = 0.f, den = 0.f; const float iv = ii * v;
#pragma unroll
        for (int j = 0; j < 8; ++j) { Cst[j] = f * Cst[j] + iv * k[j]; nst[j] = f * nst[j] + ii * k[j]; num += Cst[j] * q[j]; den += nst[j] * q[j]; }
#pragma unroll
        for (int o = 1; o < 16; o <<= 1) { num += __shfl_xor(num, o); den += __shfl_xor(den, o); }
        if (dj == 0) { float hv = num / fmaxf(fabsf(den), 1.f); float* o = HM + (size_t)row * D + h * 256 + vs * 16 + vi; if (dir) *o += hv; else *o = hv; }
    }
}
__global__ void nv_finish_m_kernel(const float* HM, const bf16_t* O, const float* g, bf16_t* MIX) {
    __shared__ float red[4];
    const int row = blockIdx.x, tid = threadIdx.x;
    for (int h = 0; h < 4; ++h) {
        float v = HM[(size_t)row * D + h * 256 + tid];
        float mu = block_sum256(v, red) * (1.f / 256.f);
        float dv = v - mu;
        float var = block_sum256(dv * dv, red) * (1.f / 256.f);
        float y = dv * rsqrtf(var + 1e-5f) * g[h * 256 + tid] * sigmf(bf2f(O[(size_t)row * 1024 + h * 256 + tid]));
        MIX[(size_t)row * 2048 + h * 256 + tid] = f2bf(y);
    }
}
__global__ void __launch_bounds__(256) nv_ssd_rec_kernel(const bf16_t* XC, const float* GATES, const float* a_log, float* HS, int dir) {
    const int head = blockIdx.x, b = blockIdx.y, g = head >> 3;
    const int tid = threadIdx.x, pp = tid >> 2, nq = tid & 3;
    float hst[32];
#pragma unroll
    for (int j = 0; j < 32; ++j) hst[j] = 0.f;
    const float aneg = -expf(a_log[dir * 16 + head]);
    for (int i = 0; i < SLEN; ++i) {
        const int row = seq_row(b, dir, i);
        const float dtv = GATES[(size_t)row * NGATE + 16 + dir * 16 + head];
        const float dA = expf(dtv * aneg);
        const bf16_t* xc = XC + (size_t)row * 1536;
        const float xv = bf2f(xc[head * 64 + pp]) * dtv;
        const bf16_t* bp = xc + 1024 + g * 128 + nq * 32; const bf16_t* cp = xc + 1280 + g * 128 + nq * 32;
        float y = 0.f;
#pragma unroll
        for (int j = 0; j < 32; ++j) { hst[j] = dA * hst[j] + bf2f(bp[j]) * xv; y += bf2f(cp[j]) * hst[j]; }
        y += __shfl_xor(y, 1); y += __shfl_xor(y, 2);
        if (nq == 0) { float* o = HS + (size_t)row * D + head * 64 + pp; if (dir) *o += y; else *o = y; }
    }
}
__global__ void nv_finish_s_kernel(const float* HS, const bf16_t* Z, const bf16_t* XC, const float* dsk, const float* g, bf16_t* MIX) {
    __shared__ float red[4];
    const int row = blockIdx.x, tid = threadIdx.x;
    float v[4]; float ss = 0.f;
#pragma unroll
    for (int j = 0; j < 4; ++j) { int c = tid + 256 * j;
        float y = HS[(size_t)row * D + c] + dsk[c >> 6] * bf2f(XC[(size_t)row * 1536 + c]);
        y *= siluf(bf2f(Z[(size_t)row * 1024 + c])); v[j] = y; ss += y * y; }
    float ms = block_sum256(ss, red) * (1.f / 1024.f);
    float r = rsqrtf(ms + 1e-6f);
#pragma unroll
    for (int j = 0; j < 4; ++j) { int c = tid + 256 * j; MIX[(size_t)row * 2048 + 1024 + c] = f2bf(v[j] * r * g[c]); }
}
__global__ void nv_qk_prep_kernel(bf16_t* Q, bf16_t* KB, const float* qg, const float* kg) {
    __shared__ float xs[128]; __shared__ float red[2];
    const int row = blockIdx.x, hh = blockIdx.y, d = threadIdx.x;
    bf16_t* p; bool rope; int t = 0;
    if (hh < 8) { if (row >= NLAT) return; p = Q + (size_t)row * 1024 + hh * 128; rope = true; t = row % SEQ; }
    else { if (row >= NBATCH * SLEN) return; p = KB + (size_t)row * 256 + (hh - 8) * 128; const int key = row % SLEN; rope = key >= CTXL; t = key - CTXL; }
    float x = bf2f(p[d]);
    float s = x * x;
    for (int o = 32; o > 0; o >>= 1) s += __shfl_xor(s, o);
    if ((d & 63) == 0) red[d >> 6] = s;
    __syncthreads();
    const float ms = (red[0] + red[1]) * (1.f / 128.f);
    const float xn = x * rsqrtf(ms + 1e-6f) * (hh < 8 ? qg[d] : kg[d]);
    xs[d] = xn;
    __syncthreads();
    float out = xn;
    if (rope) {
        const int i = d & 63; const int fi = i & 31;
        const float pos = (i < 32) ? (float)(t / 64) : (float)(t % 64);
        const float invf = expf(-(float)fi * (9.210340371976184f / 32.f));
        float sn, cs; sincosf(pos * invf, &sn, &cs);
        out = (d < 64) ? (xs[d] * cs - xs[d + 64] * sn) : (xs[d] * cs + xs[d - 64] * sn);
    }
    p[d] = f2bf(out);
}
__global__ void nv_softmax_kernel(float* S, int ncols, float scale) {
    __shared__ float red[4];
    float* s = S + (size_t)blockIdx.x * ncols; const int tid = threadIdx.x;
    float mx = -1e30f;
    for (int j = tid; j < ncols; j += 256) mx = fmaxf(mx, s[j]);
    for (int o = 32; o > 0; o >>= 1) mx = fmaxf(mx, __shfl_xor(mx, o));
    __syncthreads(); if ((tid & 63) == 0) red[tid >> 6] = mx; __syncthreads();
    mx = fmaxf(fmaxf(red[0], red[1]), fmaxf(red[2], red[3]));
    float sum = 0.f;
    for (int j = tid; j < ncols; j += 256) { float e = expf((s[j] - mx) * scale); s[j] = e; sum += e; }
    sum = block_sum256(sum, red);
    const float inv = 1.f / sum;
    for (int j = tid; j < ncols; j += 256) s[j] *= inv;
}
template <typename T> __device__ __forceinline__ float4 ld4(const T* p);
template <> __device__ __forceinline__ float4 ld4<float>(const float* p) { return *(const float4*)p; }
template <> __device__ __forceinline__ float4 ld4<bf16_t>(const bf16_t* p) { const u32x2 w = *(const u32x2*)p; return make_float4(__uint_as_float(w.x << 16), __uint_as_float(w.x & 0xffff0000u), __uint_as_float(w.y << 16), __uint_as_float(w.y & 0xffff0000u)); }
__device__ __forceinline__ void st4(float* p, float4 v) { *(float4*)p = v; }
__device__ __forceinline__ void st4(bf16_t* p, float4 v) { u32x2 w; w.x = pk2(v.x, v.y); w.y = pk2(v.z, v.w); *(u32x2*)p = w; }
template <typename TA, typename TB, typename TC>
__global__ void __launch_bounds__(256) nv_gemm_kernel(const TA* A, int lda, const TB* B, int ldb, TC* C, int ldc, int M, int N, int K, int bt) {
    __shared__ float As[16][128 + 4];
    __shared__ float Bs[16][128 + 4];
    const int m0 = blockIdx.y * 128, n0 = blockIdx.x * 128;
    const int tid = threadIdx.x, tx = tid & 15, ty = tid >> 4;
    float acc[8][8];
#pragma unroll
    for (int i = 0; i < 8; ++i)
#pragma unroll
        for (int j = 0; j < 8; ++j) acc[i][j] = 0.f;
    for (int k0 = 0; k0 < K; k0 += 16) {
#pragma unroll
        for (int i = 0; i < 2; ++i) { const int idx = tid + i * 256, r = idx >> 2, kq = idx & 3; float4 v = make_float4(0.f, 0.f, 0.f, 0.f);
            if (m0 + r < M) v = ld4<TA>(A + (size_t)(m0 + r) * lda + k0 + kq * 4);
            As[kq * 4 + 0][r] = v.x; As[kq * 4 + 1][r] = v.y; As[kq * 4 + 2][r] = v.z; As[kq * 4 + 3][r] = v.w; }
        if (!bt) {
#pragma unroll
            for (int i = 0; i < 2; ++i) { const int idx = tid + i * 256, kk = idx >> 5, nq = idx & 31, gn = n0 + nq * 4; float4 v = make_float4(0.f, 0.f, 0.f, 0.f);
                if (gn < N) v = ld4<TB>(B + (size_t)(k0 + kk) * ldb + gn);
                *(float4*)&Bs[kk][nq * 4] = v; }
        } else {
#pragma unroll
            for (int i = 0; i < 2; ++i) { const int idx = tid + i * 256, n = idx >> 2, kq = idx & 3, gn = n0 + n; float4 v = make_float4(0.f, 0.f, 0.f, 0.f);
                if (gn < N) v = ld4<TB>(B + (size_t)gn * ldb + k0 + kq * 4);
                Bs[kq * 4 + 0][n] = v.x; Bs[kq * 4 + 1][n] = v.y; Bs[kq * 4 + 2][n] = v.z; Bs[kq * 4 + 3][n] = v.w; }
        }
        __syncthreads();
#pragma unroll
        for (int kk = 0; kk < 16; ++kk) {
            const float4 a0 = *(const float4*)&As[kk][ty * 4], a1 = *(const float4*)&As[kk][64 + ty * 4];
            const float4 b0 = *(const float4*)&Bs[kk][tx * 4], b1 = *(const float4*)&Bs[kk][64 + tx * 4];
            const float av[8] = {a0.x, a0.y, a0.z, a0.w, a1.x, a1.y, a1.z, a1.w};
            const float bv[8] = {b0.x, b0.y, b0.z, b0.w, b1.x, b1.y, b1.z, b1.w};
#pragma unroll
            for (int i = 0; i < 8; ++i)
#pragma unroll
                for (int j = 0; j < 8; ++j) acc[i][j] += av[i] * bv[j];
        }
        __syncthreads();
    }
#pragma unroll
    for (int i = 0; i < 8; ++i) {
        const int gm = m0 + (i < 4 ? ty * 4 + i : 64 + ty * 4 + (i - 4));
        if (gm >= M) continue;
#pragma unroll
        for (int jh = 0; jh < 2; ++jh) { const int gn = n0 + jh * 64 + tx * 4; if (gn >= N) continue;
            st4(C + (size_t)gm * ldc + gn, make_float4(acc[i][jh * 4 + 0], acc[i][jh * 4 + 1], acc[i][jh * 4 + 2], acc[i][jh * 4 + 3])); }
    }
}

#ifdef DIAG_SEL
__global__ void dg_count_nonfinite(const bf16_t* p, size_t n, unsigned* cnt) {
    for (size_t i = (size_t)blockIdx.x * 256 + threadIdx.x; i < n; i += (size_t)gridDim.x * 256) {
        if ((p[i] & 0x7f80u) == 0x7f80u) { const unsigned blk = (unsigned)(i >> 15), chain = blk / 66, cid = blk % 66, v = (unsigned)(i >> 7) & 255, d = (unsigned)i & 127;
            atomicAdd(cnt, 1u); if (chain & 1) atomicAdd(cnt + 1, 1u); if (cid < 2) atomicAdd(cnt + 2, 1u); if (d < 32) atomicAdd(cnt + 3, 1u); if ((v & 31) < 16) atomicAdd(cnt + 4, 1u);
            atomicAdd(cnt + 12288 + blk, 1u); }
    }
}
__global__ void dg_reduce(unsigned* cnt) {
    if (threadIdx.x == 0) { unsigned nb = 0, mx = 0; for (int i = 0; i < 1056; ++i) { const unsigned c = cnt[12288 + i]; if (c) ++nb; if (c > mx) mx = c; } cnt[5] = nb; cnt[6] = mx; }
}
__global__ void dg_scale_out(float* out, size_t n, const unsigned* cnt) {
    const unsigned c = cnt[DIAG_SEL];
    const float f = 1.f + 0.01f * ((float)c / (float)DIAG_DIV);
    for (size_t i = (size_t)blockIdx.x * 256 + threadIdx.x; i < n; i += (size_t)gridDim.x * 256) out[i] *= f;
}
#endif
template <typename TA, typename TB, typename TC>
void nv_gemm(hipStream_t st, const TA* A, int lda, const TB* B, int ldb, TC* C, int ldc, int M, int N, int K, int bt) {
    dim3 grid((N + 127) / 128, (M + 127) / 128, 1);
    hipLaunchKernelGGL((nv_gemm_kernel<TA, TB, TC>), grid, dim3(256), 0, st, A, lda, B, ldb, C, ldc, M, N, K, bt);
}
#endif
}

static int g_grid = 0;
static void launch_phases(hipStream_t stream, Args a, int lo, int hi, int li = 0) {
    a.ph_lo = lo; a.ph_hi = hi; a.li = li;
    void* args[] = {&a};
    hipError_t e;
    if (hi - lo > 1) e = hipLaunchCooperativeKernel((const void*)mk_fwd, dim3(g_grid), dim3(NTHREADS), args, LDS_BYTES, stream);
    else { hipLaunchKernelGGL(mk_fwd, dim3(g_grid), dim3(NTHREADS), LDS_BYTES, stream, a); e = hipPeekAtLastError(); }
    if (e != hipSuccess) fprintf(stderr, "launch [%d,%d) failed: %s\n", lo, hi, hipGetErrorString(e));
}
extern "C" void kernel_launch(void* const* d_in, const int* in_sizes, int n_in, void* d_out, int out_size, void* d_ws, size_t ws_size, hipStream_t stream) {
    if (g_grid == 0) {
        if (ws_size < WS_END || n_in != 28) { fprintf(stderr, "kernel_launch: ws %zu < %zu or n_in %d\n", ws_size, (size_t)WS_END, n_in); g_grid = -1; return; }
        int dev = 0, cus = 0, per_cu = 0;
        (void)hipGetDevice(&dev); (void)hipDeviceGetAttribute(&cus, hipDeviceAttributeMultiprocessorCount, dev);
        if (hipFuncSetAttribute((const void*)mk_fwd, hipFuncAttributeMaxDynamicSharedMemorySize, LDS_BYTES) != hipSuccess) { fprintf(stderr, "hipFuncSetAttribute failed\n"); g_grid = -1; return; }
        if (hipOccupancyMaxActiveBlocksPerMultiprocessor(&per_cu, (const void*)mk_fwd, NTHREADS, LDS_BYTES) != hipSuccess || per_cu < 1) { fprintf(stderr, "occupancy query failed (%d)\n", per_cu); g_grid = -1; return; }
        g_grid = cus;
        fprintf(stderr, "kernel_launch: cus %d per_cu %d grid %d\n", cus, per_cu, g_grid);
    }
    if (g_grid < 0) return;
    unsigned char* ws = (unsigned char*)d_ws;
    (void)hipMemsetAsync(ws + WS_CTL, 0, 65536, stream);
    Args a{};
    for (int i = 0; i < 28; ++i) a.in[i] = (const float*)d_in[i];
    a.out = (float*)d_out; a.ws = ws;
    const float** in = a.in;

#ifdef EXP_NAIVE_MIXER
    launch_phases(stream, a, PH_PRO, PH_GEMM_IN + 1, 0);
    {
        const bf16_t* QK = (const bf16_t*)(ws + WS_QK); const bf16_t* V = (const bf16_t*)(ws + WS_V); const bf16_t* O = (const bf16_t*)(ws + WS_O); const bf16_t* Z = (const bf16_t*)(ws + WS_Z);
        const bf16_t* XBC = (const bf16_t*)(ws + WS_XBC); bf16_t* XC = (bf16_t*)(ws + WS_XC); const float* GATES = (const float*)(ws + WS_GATES);
        float* HM = (float*)(ws + WS_DC); float* HS = (float*)(ws + WS_DS); bf16_t* MIX = (bf16_t*)(ws + WS_MIX);
#if EXP_NAIVE_MIXER == 2
        launch_phases(stream, a, PH_CONV, PH_CONV + 1);
#else
        hipLaunchKernelGGL(nv_conv_kernel, dim3(NTOK), dim3(256), 0, stream, XBC, in[I_CONVW], in[I_CONVB], XC);
#endif
#if EXP_NAIVE_MIXER == 5
#ifdef DIAG_HOLES
        (void)hipMemsetAsync(ws + WS_DC, 0x3C, (size_t)66 * MiB, stream);
#endif
        launch_phases(stream, a, PH_MLA, PH_MLA + 1);
#ifdef DIAG_SCAN
        launch_phases(stream, a, PH_SCAN, PH_SCAN + 1);
#endif
        hipLaunchKernelGGL(dg_count_nonfinite, dim3(2048), dim3(256), 0, stream, (const bf16_t*)(ws + WS_DC), (size_t)16 * 66 * 32768, (unsigned*)(ws + WS_CTL) + 16);
        hipLaunchKernelGGL(dg_reduce, dim3(1), dim3(64), 0, stream, (unsigned*)(ws + WS_CTL) + 16);
#endif
#if EXP_NAIVE_MIXER == 3
        launch_phases(stream, a, PH_MLA, PH_MLA + 1); launch_phases(stream, a, PH_SCAN, PH_SCAN + 1); launch_phases(stream, a, PH_MLC, PH_MLC + 1);
#endif
#if EXP_NAIVE_MIXER == 4
        launch_phases(stream, a, PH_SSA, PH_SSA + 1); launch_phases(stream, a, PH_SCAN, PH_SCAN + 1); launch_phases(stream, a, PH_SSC, PH_SSC + 1);
#endif
#if EXP_NAIVE_MIXER != 3
        hipLaunchKernelGGL(nv_mlstm_rec_kernel, dim3(16, 4, 2), dim3(256), 0, stream, QK, V, GATES, HM, 0);
        hipLaunchKernelGGL(nv_mlstm_rec_kernel, dim3(16, 4, 2), dim3(256), 0, stream, QK, V, GATES, HM, 1);
        hipLaunchKernelGGL(nv_finish_m_kernel, dim3(NTOK), dim3(256), 0, stream, HM, O, in[I_MNG], MIX);
#endif
#if EXP_NAIVE_MIXER != 4
        hipLaunchKernelGGL(nv_ssd_rec_kernel, dim3(16, 2), dim3(256), 0, stream, XC, GATES, in[I_ALOG], HS, 0);
        hipLaunchKernelGGL(nv_ssd_rec_kernel, dim3(16, 2), dim3(256), 0, stream, XC, GATES, in[I_ALOG], HS, 1);
        hipLaunchKernelGGL(nv_finish_s_kernel, dim3(NTOK), dim3(256), 0, stream, HS, Z, XC, in[I_SSMD], in[I_SNG], MIX);
#endif
    }
    launch_phases(stream, a, PH_GEMM_OUT - 1, PH_COUNT, 1);
#if EXP_NAIVE_MIXER == 5
    hipLaunchKernelGGL(dg_scale_out, dim3(2048), dim3(256), 0, stream, (float*)d_out, (size_t)NLAT * D, (const unsigned*)(ws + WS_CTL) + 16);
#endif
#elif defined(DIAG_SPLIT_A)
    launch_phases(stream, a, PH_PRO, DIAG_SPLIT_A, 0);
#ifdef DIAG_SPLIT_RESETDEP
    (void)hipMemsetAsync(ws + WS_CTL + CW_DEP0 * 4, 0, 2048, stream);
#endif
    launch_phases(stream, a, DIAG_SPLIT_B, PH_COUNT, 1);
#else
    launch_phases(stream, a, PH_PRO, PH_COUNT);
#ifdef DIAG_STAMP
    hipLaunchKernelGGL(dg_perturb, dim3(2048), dim3(256), 0, stream, (float*)d_out, (size_t)NLAT * D, (const unsigned long long*)((unsigned*)(ws + WS_CTL) + 12288));
#endif
#endif
}
```

```cpp
#include <hip/hip_runtime.h>
#include <hip/hip_cooperative_groups.h>
#include <cstdint>
#include <cstdio>
namespace cg = cooperative_groups;

namespace pg8 {
#define PG8_LAS __attribute__((address_space(3)))
typedef unsigned short bf16_t;
typedef short bf16x8 __attribute__((ext_vector_type(8)));
typedef float f32x4 __attribute__((ext_vector_type(4)));
typedef unsigned u32x4 __attribute__((ext_vector_type(4)));
constexpr int BM = 256, BK = 64, HALF = 128, HTB = HALF * BK * 2  , STAGE_BYTES = 8 * HTB, NXCD = 8, WGM = 8;

__host__ __device__ __forceinline__ int lds_byte(int r, int c) { const int st = (r >> 4) * 2 + (c >> 5), rr = r & 15, cc = c & 31, ob = rr * 64 + cc * 2; return st * 1024 + (ob ^ (((ob >> 9) & 1) << 5)); }
__host__ __device__ __forceinline__ void stage_rc(int b, int& R, int& C) { const int st = b / 1024, sb = b % 1024, swz = sb ^ (((sb >> 9) & 1) << 5); R = (st >> 1) * 16 + swz / 64; C = (st & 1) * 32 + (swz % 64) / 2; }
__host__ __device__ __forceinline__ int perm32(int rho) { const int n = rho >> 4, i = rho & 15; return 8 * (i >> 2) + 4 * n + (i & 3); }

struct Unit { int pm, pn; };
struct Gemm { const bf16_t* A; const bf16_t* Bt; int M, N, K; };

struct StaticOrder {
    int nM, nN, nwg, G, c;
    __host__ __device__ void init(int M, int N, int G_, int c_) { nM = M / BM; nN = N / BM; nwg = nM * nN; G = G_; c = c_; }
    __host__ __device__ bool next(int i, Unit& u) const {
        const long L = (long)i * G + c; if (L >= nwg) return false;
        int wgid = (int)L; { const int q = nwg / NXCD, r = nwg % NXCD, xcd = wgid % NXCD, off = wgid / NXCD; wgid = (xcd < r ? xcd * (q + 1) : r * (q + 1) + (xcd - r) * q) + off; }
        const int nig = WGM * nN, gid = wgid / nig, fm = gid * WGM, gsz = (nM - fm) < WGM ? (nM - fm) : WGM;
        u.pm = fm + ((wgid % nig) % gsz); u.pn = (wgid % nig) / gsz; return true;
    }
    static constexpr bool LATE = false;
    __device__ __forceinline__ void a_ready(const Unit&) const {}
    __device__ __forceinline__ void done(const Unit&) const {}
    __device__ __forceinline__ void late(const Unit&) const {}
};

template <class Epi, class Sched, bool ALIGN_EPI = false, bool SP2 = false, bool GATHER = false>
__device__ __forceinline__ void gemm_phase(PG8_LAS unsigned char* lds, const Gemm g, const Sched& S, const Epi& E, const int tid) {
    const int wid = __builtin_amdgcn_readfirstlane(tid >> 6), lane = tid & 63, wr = wid >> 2, wc = wid & 3, fr = lane & 15, fq = lane >> 4;
    const int K = g.K, nt = K / BK;
    unsigned voffA[2], voffB[2];
#pragma unroll
    for (int i = 0; i < 2; ++i) { int R, C; stage_rc(tid * 16 + i * 8192, R, C); const int Rb = Epi::PERM ? ((R & ~31) + perm32(R & 31)) : R;
        voffA[i] = (unsigned)(R * K + C) * 2u; voffB[i] = (unsigned)(Rb * K + C) * 2u; }
    static_assert(!GATHER || SP2, "GATHER needs the SP2 loop");
    int gR0 = 0; unsigned gC2 = 0; { int R, C; stage_rc(tid * 16, R, C); gR0 = R; gC2 = (unsigned)C * 2u; }
    unsigned vA[2][2] = {{0u, 0u}, {0u, 0u}}, vN[2][2] = {{0u, 0u}, {0u, 0u}};
    const char* gA = (const char*)g.A;
#define PG8_GV(v, u) do { _Pragma("unroll") for (int h_ = 0; h_ < 2; ++h_) _Pragma("unroll") for (int i_ = 0; i_ < 2; ++i_) v[h_][i_] = (unsigned)S.arow(u, h_ * HALF + gR0 + 64 * i_) * (unsigned)(K * 2) + gC2; } while (0)
    const size_t kstep = (size_t)(BK * 2);
    const size_t hstep = (size_t)HALF * K * 2;
    const size_t tstep = 2 * hstep;
    const unsigned ldsw = (unsigned)wid * 1024u;
    const int aoff = lds_byte(wr * 64 + fr, fq * 8), boff = lds_byte(wc * 32 + fr, fq * 8);
#define PG8_SA(b, h) (((b) * 2 + (h)) * HTB)
#define PG8_SB(b, h) ((4 + (b) * 2 + (h)) * HTB)
#define PG8_STAGE(bufoff, gbase, voff) do { _Pragma("unroll") for (int _i = 0; _i < 2; ++_i) \
        __builtin_amdgcn_global_load_lds((const unsigned*)((const char*)(gbase) + (voff)[_i]), (PG8_LAS unsigned*)(lds + (bufoff) + ldsw + _i * 8192), 16, 0, 0); } while (0)
#define PG8_LDA(dst, b, h) do { _Pragma("unroll") for (int m = 0; m < 4; ++m) _Pragma("unroll") for (int k = 0; k < 2; ++k) dst[m][k] = *(const PG8_LAS bf16x8*)(lds + PG8_SA(b, h) + aoff + m * 2048 + k * 1024); } while (0)
#define PG8_LDB(dst, b, h) do { _Pragma("unroll") for (int n = 0; n < 2; ++n) _Pragma("unroll") for (int k = 0; k < 2; ++k) dst[n][k] = *(const PG8_LAS bf16x8*)(lds + PG8_SB(b, h) + boff + n * 2048 + k * 1024); } while (0)
#define PG8_MMA(ai, bj, At, Bt) do { __builtin_amdgcn_s_setprio(1); _Pragma("unroll") for (int m = 0; m < 4; ++m) _Pragma("unroll") for (int n = 0; n < 2; ++n) _Pragma("unroll") for (int k = 0; k < 2; ++k) \
        acc[ai][bj][m][n] = __builtin_amdgcn_mfma_f32_16x16x32_bf16(Bt[n][k], At[m][k], acc[ai][bj][m][n], 0, 0, 0); __builtin_amdgcn_s_setprio(0); } while (0)
#define PG8_WAIT_V(n) asm volatile("s_waitcnt vmcnt(" #n ")" ::: "memory")
#define PG8_WAIT_L(n) asm volatile("s_waitcnt lgkmcnt(" #n ")" ::: "memory")
#define PG8_BAR __builtin_amdgcn_s_barrier()
#define PG8_SCHED __builtin_amdgcn_sched_barrier(0)
    Unit cur, nxt, prv; int ui = 0;
    if (!S.next(0, cur)) return;
    f32x4 acc[2][2][4][2];
#pragma unroll
    for (int a = 0; a < 2; ++a)
#pragma unroll
        for (int b = 0; b < 2; ++b)
#pragma unroll
            for (int m = 0; m < 4; ++m)
#pragma unroll
                for (int n = 0; n < 2; ++n) acc[a][b][m][n] = (f32x4){0.f, 0.f, 0.f, 0.f};
    bf16x8 At[4][2], B0[2][2], B1[2][2];
    const char* cA = (const char*)g.A + (size_t)cur.pm * tstep; const char* cB = (const char*)g.Bt + (size_t)cur.pn * tstep;
    S.a_ready(cur);
    if constexpr (SP2) {
        if constexpr (GATHER) { PG8_GV(vA, cur); }
        PG8_STAGE(PG8_SB(0, 0), cB, voffB); PG8_STAGE(PG8_SB(0, 1), cB + hstep, voffB);
        if constexpr (GATHER) { PG8_STAGE(PG8_SA(0, 0), gA, vA[0]); PG8_STAGE(PG8_SA(0, 1), gA, vA[1]); } else { PG8_STAGE(PG8_SA(0, 0), cA, voffA); PG8_STAGE(PG8_SA(0, 1), cA + hstep, voffA); }
        if (wr == 1) PG8_BAR;
        PG8_WAIT_V(2); PG8_BAR;
        PG8_STAGE(PG8_SB(1, 0), cB + kstep, voffB); if constexpr (GATHER) { PG8_STAGE(PG8_SA(1, 0), gA + kstep, vA[0]); } else { PG8_STAGE(PG8_SA(1, 0), cA + kstep, voffA); } PG8_STAGE(PG8_SB(1, 1), cB + hstep + kstep, voffB);
        PG8_WAIT_V(6); PG8_BAR;
    } else {
        PG8_STAGE(PG8_SB(0, 0), cB, voffB); PG8_STAGE(PG8_SA(0, 0), cA, voffA); PG8_STAGE(PG8_SB(0, 1), cB + hstep, voffB); PG8_STAGE(PG8_SA(0, 1), cA + hstep, voffA);
        if (wr == 1) PG8_BAR;
        PG8_WAIT_V(4); PG8_BAR;
        PG8_STAGE(PG8_SB(1, 0), cB + kstep, voffB); PG8_STAGE(PG8_SA(1, 0), cA + kstep, voffA); PG8_STAGE(PG8_SB(1, 1), cB + hstep + kstep, voffB);
        PG8_WAIT_V(6); PG8_BAR;
    }
    for (;;) {
        const bool has_next = S.next(ui + 1, nxt);
        if constexpr (GATHER) { if (has_next) { PG8_GV(vN, nxt); } else { _Pragma("unroll") for (int h_ = 0; h_ < 2; ++h_) _Pragma("unroll") for (int i_ = 0; i_ < 2; ++i_) vN[h_][i_] = vA[h_][i_]; } }
        const char* nA = has_next ? (const char*)g.A + (size_t)nxt.pm * tstep : cA; const char* nB = has_next ? (const char*)g.Bt + (size_t)nxt.pn * tstep : cB;
        for (int t = 0; t < nt; t += 2) {
            if constexpr (Epi::MIDK) { if (t == nt / 2) E.midk(acc, cur, wr, wc, fr, fq); }
            if constexpr (Sched::LATE) { if (t == 2 && ui > 0) S.late(prv); }
            const bool last = (t == nt - 2);
            const char* a1 = cA + (size_t)(t + 1) * kstep;
            const char* a2 = last ? nA : cA + (size_t)(t + 2) * kstep; const char* b2 = last ? nB : cB + (size_t)(t + 2) * kstep;
            const char* a3 = a2 + kstep; const char* b3 = b2 + kstep;
            if (last && has_next) S.a_ready(nxt);
            const size_t ka1 = (size_t)(t + 1) * kstep, ka2 = last ? (size_t)0 : (size_t)(t + 2) * kstep, ka3 = ka2 + kstep;
            unsigned vs0[2] = {last ? vN[0][0] : vA[0][0], last ? vN[0][1] : vA[0][1]}, vs1[2] = {last ? vN[1][0] : vA[1][0], last ? vN[1][1] : vA[1][1]};
            if constexpr (SP2) {
            PG8_LDB(B0, 0, 0); PG8_LDB(B1, 0, 1); PG8_SCHED; PG8_LDA(At, 0, 0); if constexpr (GATHER) { PG8_STAGE(PG8_SA(1, 1), gA + ka1, vA[1]); } else { PG8_STAGE(PG8_SA(1, 1), a1 + hstep, voffA); }
            PG8_WAIT_V(8); PG8_WAIT_L(0); PG8_BAR; PG8_MMA(0, 0, At, B0); PG8_MMA(0, 1, At, B1); PG8_BAR; PG8_SCHED;
            PG8_LDA(At, 0, 1); PG8_STAGE(PG8_SB(0, 0), b2, voffB); PG8_STAGE(PG8_SB(0, 1), b2 + hstep, voffB); if constexpr (GATHER) { PG8_STAGE(PG8_SA(0, 0), gA + ka2, vs0); } else { PG8_STAGE(PG8_SA(0, 0), a2, voffA); }
            PG8_WAIT_V(8); PG8_WAIT_L(0); PG8_BAR; PG8_MMA(1, 0, At, B0); PG8_MMA(1, 1, At, B1); PG8_BAR; PG8_SCHED;
            PG8_LDB(B0, 1, 0); PG8_LDB(B1, 1, 1); PG8_SCHED; PG8_LDA(At, 1, 0); if constexpr (GATHER) { PG8_STAGE(PG8_SA(0, 1), gA + ka2, vs1); } else { PG8_STAGE(PG8_SA(0, 1), a2 + hstep, voffA); }
            PG8_WAIT_V(8); PG8_WAIT_L(0); PG8_BAR; PG8_MMA(0, 0, At, B0); PG8_MMA(0, 1, At, B1); PG8_BAR; PG8_SCHED;
            PG8_LDA(At, 1, 1); PG8_STAGE(PG8_SB(1, 0), b3, voffB); PG8_STAGE(PG8_SB(1, 1), b3 + hstep, voffB); if constexpr (GATHER) { PG8_STAGE(PG8_SA(1, 0), gA + ka3, vs0); } else { PG8_STAGE(PG8_SA(1, 0), a3, voffA); }
            PG8_WAIT_V(8); PG8_WAIT_L(0); PG8_BAR; PG8_MMA(1, 0, At, B0); PG8_MMA(1, 1, At, B1); PG8_BAR; PG8_SCHED;
            } else {
            PG8_LDB(B0, 0, 0); PG8_SCHED; PG8_LDA(At, 0, 0); PG8_STAGE(PG8_SA(1, 1), a1 + hstep, voffA);
            PG8_WAIT_L(8); PG8_BAR; PG8_WAIT_L(0); PG8_MMA(0, 0, At, B0); PG8_BAR; PG8_SCHED;
            PG8_LDB(B1, 0, 1); PG8_STAGE(PG8_SB(0, 0), b2, voffB);
            PG8_BAR; PG8_WAIT_L(0); PG8_MMA(0, 1, At, B1); PG8_BAR;
            PG8_LDA(At, 0, 1); PG8_STAGE(PG8_SA(0, 0), a2, voffA);
            PG8_BAR; PG8_WAIT_L(0); PG8_MMA(1, 0, At, B0); PG8_BAR; PG8_SCHED;
            PG8_STAGE(PG8_SB(0, 1), b2 + hstep, voffB);
            PG8_WAIT_V(6); PG8_BAR; PG8_MMA(1, 1, At, B1); PG8_BAR;
            PG8_LDB(B0, 1, 0); PG8_SCHED; PG8_LDA(At, 1, 0); PG8_STAGE(PG8_SA(0, 1), a2 + hstep, voffA);
            PG8_WAIT_L(8); PG8_BAR; PG8_WAIT_L(0); PG8_MMA(0, 0, At, B0); PG8_BAR; PG8_SCHED;
            PG8_LDB(B1, 1, 1); PG8_STAGE(PG8_SB(1, 0), b3, voffB);
            PG8_BAR; PG8_WAIT_L(0); PG8_MMA(0, 1, At, B1); PG8_BAR;
            PG8_LDA(At, 1, 1); PG8_STAGE(PG8_SA(1, 0), a3, voffA);
            PG8_BAR; PG8_WAIT_L(0); PG8_MMA(1, 0, At, B0); PG8_BAR; PG8_SCHED;
            PG8_STAGE(PG8_SB(1, 1), b3 + hstep, voffB);
            PG8_WAIT_V(6); PG8_BAR; PG8_MMA(1, 1, At, B1); PG8_BAR;
            }
        }
        if constexpr (ALIGN_EPI) { if (wr == 0) PG8_BAR; }
        if constexpr (!Epi::AFTER_DRAIN) { E(acc, cur, wr, wc, fr, fq); S.done(cur); }
        if constexpr (Sched::LATE) prv = cur;
        if (!has_next) break;
#pragma unroll
        for (int a = 0; a < 2; ++a)
#pragma unroll
            for (int b = 0; b < 2; ++b)
#pragma unroll
                for (int m = 0; m < 4; ++m)
#pragma unroll
                    for (int n = 0; n < 2; ++n) acc[a][b][m][n] = (f32x4){0.f, 0.f, 0.f, 0.f};
        cur = nxt; cA = nA; cB = nB; ++ui;
        if constexpr (GATHER) { _Pragma("unroll") for (int h_ = 0; h_ < 2; ++h_) _Pragma("unroll") for (int i_ = 0; i_ < 2; ++i_) vA[h_][i_] = vN[h_][i_]; }
        if constexpr (ALIGN_EPI) { if (wr == 1) PG8_BAR; }
    }
    PG8_WAIT_V(0);
    if constexpr (Sched::LATE) S.late(cur);
    if constexpr (!ALIGN_EPI) { if (wr == 0) PG8_BAR; }
    PG8_BAR;
    if constexpr (Epi::AFTER_DRAIN) { E.fused(acc, cur, wr, wc, fr, fq, lds, wid, lane); S.done(cur); }
#undef PG8_GV
#undef PG8_SA
#undef PG8_SB
#undef PG8_STAGE
#undef PG8_LDA
#undef PG8_LDB
#undef PG8_MMA
#undef PG8_WAIT_V
#undef PG8_WAIT_L
#undef PG8_BAR
#undef PG8_SCHED
}
}
namespace attn {
using bf16 = unsigned short;
constexpr int D = 128, NW = 8, QBLK = 32, KVBLK = 64;
constexpr float SCALE = 0.088388347648318440f;
constexpr float THR = 8.f;
constexpr int LDQ = 1024, LDK = 256, LDO = 1024;
constexpr size_t SHM_V = KVBLK * D * 2, SHM_K = KVBLK * D * 2, SHM_ATTN = 2 * SHM_V + 2 * SHM_K + NW * 64 * 4;
using bf16x8 = __attribute__((ext_vector_type(8))) short;
using s16x4  = __attribute__((ext_vector_type(4))) short;
using f32x16 = __attribute__((ext_vector_type(16))) float;
using f32x8  = __attribute__((ext_vector_type(8))) float;
using u32x4  = __attribute__((ext_vector_type(4))) unsigned;
#define KSWZ(row, colB) ((row) * 256 + ((colB) ^ (((row) & 7) << 4)))
#define SBAR() __builtin_amdgcn_sched_barrier(0)
__device__ __forceinline__ int crow(int r, int hi) { return (r & 3) + 8 * (r >> 2) + 4 * hi; }
__device__ __forceinline__ unsigned cvtpk(float lo, float hi) {
  unsigned r; asm volatile("v_cvt_pk_bf16_f32 %0, %1, %2" : "=v"(r) : "v"(lo), "v"(hi)); return r;
}
template <typename TIn> struct Stage;
template <> struct Stage<bf16>  { using T = bf16x8;
  __device__ static __forceinline__ T ld8(const bf16* p) { return *reinterpret_cast<const bf16x8*>(p); }
  __device__ static __forceinline__ bf16x8 tobf(T x) { return x; } };
template <> struct Stage<float> { using T = f32x8;
  __device__ static __forceinline__ T ld8(const float* p) { return *reinterpret_cast<const f32x8*>(p); }
  __device__ static __forceinline__ bf16x8 tobf(T x) {
    u32x4 w = {cvtpk(x[0], x[1]), cvtpk(x[2], x[3]), cvtpk(x[4], x[5]), cvtpk(x[6], x[7])}; return *reinterpret_cast<bf16x8*>(&w); } };

template <bool NOREF> __device__ __forceinline__ void partialSM(f32x16& p0, f32x16& p1, float& m_reg, float& mn, float& alpha) {
  if constexpr (NOREF) { alpha = 1.f; for (int r = 0; r < 16; ++r) p0[r] = __builtin_amdgcn_exp2f(p0[r]); return; }
  constexpr float C = SCALE * 1.4426950408889634f;
  float pmax = p0[0]; for (int r = 1; r < 16; ++r) pmax = fmaxf(pmax, p0[r]); for (int r = 0; r < 16; ++r) pmax = fmaxf(pmax, p1[r]);
  { auto rr = __builtin_amdgcn_permlane32_swap(__float_as_uint(pmax), __float_as_uint(pmax), false, false);
    pmax = fmaxf(__uint_as_float(rr[0]), __uint_as_float(rr[1])); }
  if (__builtin_expect(__all(pmax - m_reg <= THR / SCALE), 1)) { mn = m_reg; alpha = 1.f; }
  else { mn = fmaxf(m_reg, pmax); alpha = __builtin_amdgcn_exp2f((m_reg - mn) * C); m_reg = mn; }
  float mnC = -mn * C;
  for (int r = 0; r < 16; ++r) p0[r] = fmaf(p0[r], C, mnC); for (int r = 0; r < 16; ++r) p1[r] = fmaf(p1[r], C, mnC);
  for (int r = 0; r < 16; ++r) p0[r] = __builtin_amdgcn_exp2f(p0[r]);
}
template <bool NOREF> __device__ __forceinline__ void finishSM(f32x16& p0, f32x16& p1, float alpha, float& l_reg, bf16x8& pa0, bf16x8& pa1, bf16x8& pa2, bf16x8& pa3) {
  for (int r = 0; r < 16; ++r) p1[r] = __builtin_amdgcn_exp2f(p1[r]);
  float ps = 0; for (int r = 0; r < 16; ++r) ps += p0[r]; for (int r = 0; r < 16; ++r) ps += p1[r];
  if constexpr (NOREF) { l_reg += ps; }
  else {
  { auto rr = __builtin_amdgcn_permlane32_swap(__float_as_uint(ps), __float_as_uint(ps), false, false);
    ps = __uint_as_float(rr[0]) + __uint_as_float(rr[1]); }
  l_reg = l_reg * alpha + ps; }
#define PK4(P, BASE, OUT) do { unsigned a0 = cvtpk(P[BASE + 0], P[BASE + 1]), a1 = cvtpk(P[BASE + 2], P[BASE + 3]);   \
    unsigned b0 = cvtpk(P[BASE + 4], P[BASE + 5]), b1 = cvtpk(P[BASE + 6], P[BASE + 7]);                              \
    auto r0 = __builtin_amdgcn_permlane32_swap(a0, b0, false, false); auto r1 = __builtin_amdgcn_permlane32_swap(a1, b1, false, false); \
    u32x4 w = {r0[0], r1[0], r0[1], r1[1]}; OUT = *reinterpret_cast<bf16x8*>(&w); } while (0)
  PK4(p0, 0, pa0); PK4(p0, 8, pa1); PK4(p1, 0, pa2); PK4(p1, 8, pa3);
#undef PK4
}
__device__ __forceinline__ void qkt(f32x16& p0, f32x16& p1, const bf16* Ks, const bf16x8* qr, int r32, int hi) {
  p0 = f32x16{}; p1 = f32x16{};
  for (int d0 = 0; d0 < 8; ++d0) { int cb = (d0 * 16 + hi * 8) * 2;
    bf16x8 b0 = *reinterpret_cast<const bf16x8*>((const char*)Ks + KSWZ(r32, cb));
    bf16x8 b1 = *reinterpret_cast<const bf16x8*>((const char*)Ks + KSWZ(32 + r32, cb));
    p0 = __builtin_amdgcn_mfma_f32_32x32x16_bf16(b0, qr[d0], p0, 0, 0, 0);
    p1 = __builtin_amdgcn_mfma_f32_32x32x16_bf16(b1, qr[d0], p1, 0, 0, 0); }
}
__device__ __forceinline__ int v_st(int k, int c) { const int kk = (k & ~0xC) | ((k & 4) << 1) | ((k & 8) >> 1); return ((kk >> 3) * 4 + (c >> 5)) * 512 + ((kk & 7) * 32 + (c & 31)) * 2; }
__device__ __forceinline__ int v_rd_base(int lane) { return ((lane & 3) << 3) | (((lane >> 2) & 3) << 6) | (((lane >> 4) & 1) << 5) | (((lane >> 5) & 1) << 8); }
constexpr int v_rd_off(int d0, int ks, int half) { return d0 * 512 + ks * 4096 + half * 2048; }
template <int OFF> __device__ __forceinline__ s16x4 tr_read(int vb) {
  s16x4 r; asm volatile("ds_read_b64_tr_b16 %0, %1 offset:%2" : "=&v"(r) : "v"(vb), "i"(OFF) : "memory"); return r;
}
template <int D0, bool SM = false> __device__ __forceinline__ void pv_one(f32x16& od, int vb, bf16x8 pa0, bf16x8 pa1, bf16x8 pa2, bf16x8 pa3, f32x16* pn = nullptr) {
  const s16x4 l0 = tr_read<v_rd_off(D0, 0, 0)>(vb), h0 = tr_read<v_rd_off(D0, 0, 1)>(vb), l1 = tr_read<v_rd_off(D0, 1, 0)>(vb), h1 = tr_read<v_rd_off(D0, 1, 1)>(vb);
  const s16x4 l2 = tr_read<v_rd_off(D0, 2, 0)>(vb), h2 = tr_read<v_rd_off(D0, 2, 1)>(vb), l3 = tr_read<v_rd_off(D0, 3, 0)>(vb), h3 = tr_read<v_rd_off(D0, 3, 1)>(vb);
  if constexpr (SM) {
#pragma unroll
    for (int r = 4 * D0; r < 4 * D0 + 4; ++r) (*pn)[r] = __builtin_amdgcn_exp2f((*pn)[r]); }
  asm volatile("s_waitcnt lgkmcnt(0)" ::: "memory"); SBAR();
#define PK(L, H) (bf16x8){L[0], L[1], L[2], L[3], H[0], H[1], H[2], H[3]}
  od = __builtin_amdgcn_mfma_f32_32x32x16_bf16(pa0, PK(l0, h0), od, 0, 0, 0);
  od = __builtin_amdgcn_mfma_f32_32x32x16_bf16(pa1, PK(l1, h1), od, 0, 0, 0);
  od = __builtin_amdgcn_mfma_f32_32x32x16_bf16(pa2, PK(l2, h2), od, 0, 0, 0);
  od = __builtin_amdgcn_mfma_f32_32x32x16_bf16(pa3, PK(l3, h3), od, 0, 0, 0);
#undef PK
}
__device__ __forceinline__ void pv_d0(f32x16* o, int vb, bf16x8 pa0, bf16x8 pa1, bf16x8 pa2, bf16x8 pa3) {
  pv_one<0>(o[0], vb, pa0, pa1, pa2, pa3); pv_one<1>(o[1], vb, pa0, pa1, pa2, pa3); pv_one<2>(o[2], vb, pa0, pa1, pa2, pa3); pv_one<3>(o[3], vb, pa0, pa1, pa2, pa3);
}
__device__ __forceinline__ void pv_d0_sm(f32x16* o, int vb, bf16x8 pa0, bf16x8 pa1, bf16x8 pa2, bf16x8 pa3, f32x16& pn) {
  pv_one<0, true>(o[0], vb, pa0, pa1, pa2, pa3, &pn); pv_one<1, true>(o[1], vb, pa0, pa1, pa2, pa3, &pn); pv_one<2, true>(o[2], vb, pa0, pa1, pa2, pa3, &pn); pv_one<3, true>(o[3], vb, pa0, pa1, pa2, pa3, &pn);
}

template <typename TQ, bool NOREF, int SDEPTH>
__device__ __forceinline__ void attn_dense_body(const TQ* __restrict__ Qb, const bf16* __restrict__ Kh, const bf16* __restrict__ Vh,
                                                bf16* __restrict__ Ob, int seq, char* lds, const int tid, const float* __restrict__ qg, const int t0, const float* __restrict__ rope) {
  using St = Stage<bf16>; using SQ = Stage<TQ>;
  const int wid = tid >> 6, lane = tid & 63, r32 = lane & 31, hi = lane >> 5;
  bf16* V_lds = (bf16*)lds; bf16* K_lds = (bf16*)(lds + 2 * SHM_V);
  float* ws = (float*)(lds + 2 * SHM_V + 2 * SHM_K) + wid * 64; float* li_l = ws; float* al_l = ws + 32;
  float m_reg = -1e30f, l_reg = 0; f32x16 o[4] = {}; bf16x8 qr[8];
  const TQ* Qw = Qb + (long)(wid * QBLK + r32) * LDQ + hi * 8;
#pragma unroll
  for (int d0 = 0; d0 < 8; ++d0) qr[d0] = SQ::tobf(SQ::ld8(Qw + d0 * 16));
  if (qg) {
    float f[8][8]; float ss = 0.f;
#pragma unroll
    for (int d0 = 0; d0 < 8; ++d0) { const u32x4 w = *reinterpret_cast<const u32x4*>(&qr[d0]);
#pragma unroll
      for (int e = 0; e < 4; ++e) { f[d0][2 * e] = __uint_as_float(w[e] << 16); f[d0][2 * e + 1] = __uint_as_float(w[e] & 0xffff0000u); ss += f[d0][2 * e] * f[d0][2 * e] + f[d0][2 * e + 1] * f[d0][2 * e + 1]; } }
    { auto rr = __builtin_amdgcn_permlane32_swap(__float_as_uint(ss), __float_as_uint(ss), false, false); ss = __uint_as_float(rr[0]) + __uint_as_float(rr[1]); }
    const float rs = rsqrtf(ss * (1.f / 128.f) + 1e-6f);
#pragma unroll
    for (int d0 = 0; d0 < 8; ++d0)
#pragma unroll
      for (int j = 0; j < 8; ++j) f[d0][j] *= rs * qg[16 * d0 + 8 * hi + j] * (NOREF ? SCALE * 1.4426950408889634f : 1.f);
    const int t = t0 + wid * QBLK + r32;
#pragma unroll
    for (int d0 = 0; d0 < 4; ++d0) { const float* rp = rope + (d0 < 2 ? (t / 64) : (t % 64)) * 64;
#pragma unroll
      for (int j = 0; j < 8; ++j) { const int fi = (16 * d0 + 8 * hi + j) & 31; const float cs = rp[2 * fi], sn = rp[2 * fi + 1];
        const float x1 = f[d0][j], x2 = f[d0 + 4][j]; f[d0][j] = x1 * cs - x2 * sn; f[d0 + 4][j] = x2 * cs + x1 * sn; } }
#pragma unroll
    for (int d0 = 0; d0 < 8; ++d0) { u32x4 w = {cvtpk(f[d0][0], f[d0][1]), cvtpk(f[d0][2], f[d0][3]), cvtpk(f[d0][4], f[d0][5]), cvtpk(f[d0][6], f[d0][7])}; qr[d0] = *reinterpret_cast<bf16x8*>(&w); }
  }
  const int sr = tid >> 4, sc = (tid & 15) * 8, vst0 = v_st(sr, sc), vst1 = v_st(32 + sr, sc);
  const int vb0 = (int)(uintptr_t)V_lds + v_rd_base(lane);
  struct { typename St::T vs0, vs1, ks0, ks1; } sr_[SDEPTH];
#define SLOAD(i, k0) do { const unsigned o0_ = (unsigned)(((k0) + sr) * LDK + sc), o1_ = o0_ + 32u * LDK;   \
    sr_[i].vs0 = St::ld8(Vh + o0_); sr_[i].vs1 = St::ld8(Vh + o1_); sr_[i].ks0 = St::ld8(Kh + o0_); sr_[i].ks1 = St::ld8(Kh + o1_); } while (0)
#define SWRITE(b, i) do { *(bf16x8*)((char*)V_lds + (b) * SHM_V + vst0) = St::tobf(sr_[i].vs0);          \
    *(bf16x8*)((char*)V_lds + (b) * SHM_V + vst1) = St::tobf(sr_[i].vs1); int kc = sc * 2;               \
    *(bf16x8*)((char*)K_lds + (b) * SHM_K + KSWZ(sr, kc)) = St::tobf(sr_[i].ks0);                       \
    *(bf16x8*)((char*)K_lds + (b) * SHM_K + KSWZ(32 + sr, kc)) = St::tobf(sr_[i].ks1); } while (0)
#define SWAIT() do { if constexpr (SDEPTH == 2) asm volatile("s_waitcnt vmcnt(4)" ::: "memory"); else asm volatile("s_waitcnt vmcnt(0)" ::: "memory"); } while (0)
#define RESC(a) do { if (!NOREF && __any((a) < 1.f)) { if (hi == 0) al_l[r32] = (a); asm volatile("s_waitcnt lgkmcnt(0)" ::: "memory"); \
    for (int d = 0; d < 4; ++d) for (int r = 0; r < 16; ++r) o[d][r] *= al_l[crow(r, hi)]; } } while (0)
  f32x16 pA0, pA1, pB0, pB1; float mnA, mnB, alA, alB; bf16x8 pa0, pa1, pa2, pa3; const int NT = seq / KVBLK;
  constexpr int SE = 0, SO = SDEPTH - 1;
  SLOAD(SE, 0); asm volatile("s_waitcnt vmcnt(0)" ::: "memory"); SWRITE(0, SE); __syncthreads();
  qkt(pA0, pA1, K_lds, qr, r32, hi); partialSM<NOREF>(pA0, pA1, m_reg, mnA, alA);
  SLOAD(SO, KVBLK); if constexpr (SDEPTH == 2) { if (2 < NT) SLOAD(SE, 2 * KVBLK); }
  SWAIT(); SWRITE(1, SO); __syncthreads();
  for (int j = 1; j + 1 < NT; j += 2) {
    SBAR(); qkt(pB0, pB1, (bf16*)((char*)K_lds + SHM_K), qr, r32, hi);
    finishSM<NOREF>(pA0, pA1, alA, l_reg, pa0, pa1, pa2, pa3); SBAR();
    SLOAD(SO, (j + SDEPTH) * KVBLK); SBAR();
    if constexpr (NOREF) { pv_d0_sm(o, vb0, pa0, pa1, pa2, pa3, pB0); alB = 1.f; } else { pv_d0(o, vb0, pa0, pa1, pa2, pa3); partialSM<NOREF>(pB0, pB1, m_reg, mnB, alB); }
    __syncthreads(); SWAIT(); SWRITE(0, SE);
    RESC(alB); __syncthreads();
    SBAR(); qkt(pA0, pA1, K_lds, qr, r32, hi);
    finishSM<NOREF>(pB0, pB1, alB, l_reg, pa0, pa1, pa2, pa3); SBAR();
    if (SDEPTH == 1 || j + 3 < NT) SLOAD(SE, (j + 1 + SDEPTH) * KVBLK); SBAR();
    if constexpr (NOREF) { pv_d0_sm(o, vb0 + (int)SHM_V, pa0, pa1, pa2, pa3, pA0); alA = 1.f; } else { pv_d0(o, vb0 + (int)SHM_V, pa0, pa1, pa2, pa3); partialSM<NOREF>(pA0, pA1, m_reg, mnA, alA); }
    __syncthreads(); SWAIT(); SWRITE(1, SO);
    RESC(alA); __syncthreads();
  }
  SBAR(); qkt(pB0, pB1, (bf16*)((char*)K_lds + SHM_K), qr, r32, hi);
  finishSM<NOREF>(pA0, pA1, alA, l_reg, pa0, pa1, pa2, pa3); SBAR();
  if constexpr (NOREF) { pv_d0_sm(o, vb0, pa0, pa1, pa2, pa3, pB0); alB = 1.f; } else { pv_d0(o, vb0, pa0, pa1, pa2, pa3); partialSM<NOREF>(pB0, pB1, m_reg, mnB, alB); }
  __syncthreads(); RESC(alB);
  finishSM<NOREF>(pB0, pB1, alB, l_reg, pa0, pa1, pa2, pa3); SBAR();
  pv_d0(o, vb0 + (int)SHM_V, pa0, pa1, pa2, pa3);
  if constexpr (NOREF) { auto rr = __builtin_amdgcn_permlane32_swap(__float_as_uint(l_reg), __float_as_uint(l_reg), false, false); l_reg = __uint_as_float(rr[0]) + __uint_as_float(rr[1]); }
  if (hi == 0) li_l[r32] = l_reg; asm volatile("s_waitcnt lgkmcnt(0)" ::: "memory");
  float rli[16];
#pragma unroll
  for (int r = 0; r < 16; ++r) rli[r] = __builtin_amdgcn_rcpf(li_l[crow(r, hi)]);
  bf16* Ow = Ob + (long)(wid * QBLK) * LDO;
#pragma unroll
  for (int r = 0; r < 16; ++r) { int orow = crow(r, hi);
    for (int d0 = 0; d0 < 4; ++d0) Ow[(long)orow * LDO + d0 * 32 + r32] = (bf16)(cvtpk(o[d0][r] * rli[r], 0.f) & 0xffffu); }
#undef SLOAD
#undef SWRITE
#undef SWAIT
#undef RESC
}
}

namespace {
using pg8::bf16_t; using pg8::bf16x8; using pg8::f32x4; using pg8::u32x4;
typedef unsigned u32x2 __attribute__((ext_vector_type(2)));
typedef float f32x16 __attribute__((ext_vector_type(16)));
typedef short s16x4 __attribute__((ext_vector_type(4)));
#define LAS __attribute__((address_space(3)))

constexpr int D = 1024, NBATCH = 2, SEQ = 8192, CTXL = 256;
constexpr int NLAT = NBATCH * SEQ, NCTX = NBATCH * CTXL, NTOK = NLAT + NCTX;
constexpr int SLEN = CTXL + SEQ;
constexpr int NCH = SLEN / 128;
constexpr int ABIN = 5680, NWIN = 5888;
constexpr int NGATE = 48;
constexpr float ALPHA = 1.4142135623730951f;
constexpr int NWAVES = 8, NTHREADS = 512;
constexpr int MOE_MAXTILES = 148;

constexpr size_t MiB = 1u << 20;
constexpr size_t WS_CTL = 0;
constexpr size_t WS_MODV = 64 * 1024;
constexpr size_t WS_ROPE = 208 * 1024;
constexpr size_t WS_DN = 256 * 1024;
constexpr size_t WS_MS = 784 * 1024;
constexpr size_t WS_AEND = 808 * 1024;
constexpr size_t WS_WIN = 1 * MiB;
constexpr size_t WS_WOUT = 12 * MiB + 512 * 1024;
constexpr size_t WS_ATIN = 16 * MiB + 512 * 1024;
constexpr size_t WS_ATOUT = 19 * MiB + 512 * 1024;
constexpr size_t WS_XL = 22 * MiB;
constexpr size_t WS_HB = 88 * MiB;
constexpr size_t WS_MOEW = 121 * MiB;
constexpr size_t WS_ROUTE = 217 * MiB;
constexpr size_t WS_R = 219 * MiB;
constexpr size_t WS_QK = WS_R, WS_V = WS_R + 33 * MiB, WS_O = WS_R + 66 * MiB, WS_Z = WS_R + 99 * MiB, WS_XBC = WS_R + 132 * MiB;
constexpr size_t WS_GATES = WS_R + 182 * MiB;
constexpr size_t WS_SSQ = WS_R + 185 * MiB + 256 * 1024;
constexpr size_t WS_MIX = WS_R + 186 * MiB;
constexpr size_t WS_XC = WS_HB;
constexpr size_t WS_DS = 138 * MiB;
constexpr size_t WS_DC = WS_XL;
constexpr size_t WS_YB = WS_R;
constexpr size_t WS_XS = WS_R, WS_HMID = WS_R + 74 * MiB, WS_YS = WS_R + 148 * MiB;
constexpr size_t WS_Q = WS_R, WS_KB = WS_R + 33 * MiB, WS_VB = WS_R + 42 * MiB, WS_AO = WS_R + 51 * MiB, WS_YB1 = WS_R + 84 * MiB, WS_S = WS_R + 117 * MiB;
constexpr size_t WS_TOKTAB = 472 * MiB;
constexpr size_t WS_MLG = 476 * MiB;
constexpr size_t WS_SSG = 479 * MiB;
constexpr size_t WS_END = 486 * MiB;

constexpr int CW_CNT0 = 64, CW_CNT1 = 128;
constexpr int CW_DEP0 = 256, CW_DEP1 = 512;
constexpr int CW_BAR = 1024;

__device__ __forceinline__ float bf2f(unsigned short v) { return __uint_as_float((unsigned)v << 16); }
typedef float f32x2_t __attribute__((ext_vector_type(2))); typedef __bf16 bf16x2_t __attribute__((ext_vector_type(2)));
__device__ __forceinline__ unsigned pk2(float lo, float hi) { f32x2_t v = {lo, hi}; bf16x2_t b = __builtin_convertvector(v, bf16x2_t); return __builtin_bit_cast(unsigned, b); }
__device__ __forceinline__ bf16_t f2bf(float f) { return (bf16_t)(pk2(f, 0.f) & 0xffffu); }
__device__ __forceinline__ float siluf(float x) { return x * __builtin_amdgcn_rcpf(1.f + __expf(-x)); }
__device__ __forceinline__ float sigmf(float x) { return __builtin_amdgcn_rcpf(1.f + __expf(-x)); }
__device__ __forceinline__ float softplusf(float x) { return x > 20.f ? x : log1pf(expf(x)); }
__device__ __forceinline__ float logsigf(float x) { return -softplusf(-x); }
__device__ __forceinline__ float wave_sum(float v) {
#pragma unroll
    for (int o = 1; o < 64; o <<= 1) v += __shfl_xor(v, o);
    return v;
}
__device__ __forceinline__ float wave_max(float v) {
#pragma unroll
    for (int o = 1; o < 64; o <<= 1) v = fmaxf(v, __shfl_xor(v, o));
    return v; }
__device__ __forceinline__ unsigned char* launder_ptr(unsigned char* p) { asm volatile("" : "+s"(p)); return p; }
__device__ __forceinline__ int fresh_lane() { int z = 0; asm volatile("" : "+s"(z)); return (int)__builtin_amdgcn_mbcnt_hi(~0u, __builtin_amdgcn_mbcnt_lo(~0u, (unsigned)z)); }
__device__ __forceinline__ int mod_index(int row) { return row < NLAT ? row / SEQ : 2; }
__device__ __forceinline__ int seq_row(int b, int dir, int i) {
    if (i < CTXL) { int t = dir ? (CTXL - 1 - i) : i; return NLAT + b * CTXL + t; }
    int t = i - CTXL; if (dir) t = SEQ - 1 - t; return b * SEQ + t;
}
__device__ __forceinline__ int chunk_row0(int b, int cid) { return cid < 2 ? NLAT + b * CTXL + cid * 128 : b * SEQ + (cid - 2) * 128; }
__device__ __forceinline__ int scan_cid(int dir, int p) { return dir == 0 ? p : (p < 2 ? 1 - p : 67 - p); }

struct RowF { f32x4 v[4]; };
__device__ __forceinline__ RowF row_ld_f32(const float* p, int lane) { RowF r; const f32x4* q = (const f32x4*)p + lane;
#pragma unroll
    for (int j = 0; j < 4; ++j) r.v[j] = q[64 * j];
    return r; }
__device__ __forceinline__ RowF row_ld_bf16(const bf16_t* p, int lane) { RowF r; const u32x2* q = (const u32x2*)p + lane;
#pragma unroll
    for (int j = 0; j < 4; ++j) { const u32x2 w = q[64 * j]; r.v[j] = (f32x4){__uint_as_float(w.x << 16), __uint_as_float(w.x & 0xffff0000u), __uint_as_float(w.y << 16), __uint_as_float(w.y & 0xffff0000u)}; }
    return r; }
struct RowRaw { u32x2 w[4]; };
__device__ __forceinline__ RowRaw row_ldraw_bf16(const bf16_t* p, int lane) { RowRaw r; const u32x2* q = (const u32x2*)p + lane;
#pragma unroll
    for (int j = 0; j < 4; ++j) r.w[j] = q[64 * j];
    return r; }
__device__ __forceinline__ RowF row_cvt(const RowRaw& t) { RowF r;
#pragma unroll
    for (int j = 0; j < 4; ++j) r.v[j] = (f32x4){__uint_as_float(t.w[j].x << 16), __uint_as_float(t.w[j].x & 0xffff0000u), __uint_as_float(t.w[j].y << 16), __uint_as_float(t.w[j].y & 0xffff0000u)};
    return r; }
__device__ __forceinline__ void row_st_f32(float* p, int lane, const RowF& r) { f32x4* q = (f32x4*)p + lane;
#pragma unroll
    for (int j = 0; j < 4; ++j) q[64 * j] = r.v[j]; }
__device__ __forceinline__ void row_st_bf16(bf16_t* p, int lane, const RowF& r) { u32x2* q = (u32x2*)p + lane;
#pragma unroll
    for (int j = 0; j < 4; ++j) { u32x2 w; w.x = pk2(r.v[j][0], r.v[j][1]); w.y = pk2(r.v[j][2], r.v[j][3]); q[64 * j] = w; } }
__device__ __forceinline__ float row_sum(const RowF& r) { float s = 0.f;
#pragma unroll
    for (int j = 0; j < 4; ++j) s += (r.v[j][0] + r.v[j][1]) + (r.v[j][2] + r.v[j][3]);
    return wave_sum(s); }
__device__ __forceinline__ void row_layernorm(RowF& r, const float* g, const float* b, int lane) {
    const float mu = row_sum(r) * (1.f / D); float q = 0.f;
#pragma unroll
    for (int j = 0; j < 4; ++j) { r.v[j] = r.v[j] - mu; q += (r.v[j][0] * r.v[j][0] + r.v[j][1] * r.v[j][1]) + (r.v[j][2] * r.v[j][2] + r.v[j][3] * r.v[j][3]); }
    const float rstd = rsqrtf(wave_sum(q) * (1.f / D) + 1e-5f);
    const RowF gg = row_ld_f32(g, lane), bb = row_ld_f32(b, lane);
#pragma unroll
    for (int j = 0; j < 4; ++j) r.v[j] = r.v[j] * rstd * gg.v[j] + bb.v[j];
}
__device__ __forceinline__ RowF row_modulate(const RowF& x, const float* sh, const float* sc, int lane) {
    const RowF s = row_ld_f32(sh, lane), c = row_ld_f32(sc, lane); RowF h;
#pragma unroll
    for (int j = 0; j < 4; ++j) h.v[j] = x.v[j] * (1.f + c.v[j]) + s.v[j];
    return h; }

template <class Dest> struct EpiStore {
    static constexpr bool PERM = true, AFTER_DRAIN = false, MIDK = false; Dest d;
    __device__ __forceinline__ void operator()(const f32x4 (&acc)[2][2][4][2], const pg8::Unit& u, int wr, int wc, int fr, int fq) const {
#pragma unroll
        for (int ai = 0; ai < 2; ++ai)
#pragma unroll
            for (int m = 0; m < 4; ++m) {
                const int row = u.pm * 256 + ai * 128 + wr * 64 + m * 16 + fr;
                bf16_t* rp = d.rowptr(row, u.pn); if (!rp) continue;
#pragma unroll
                for (int bj = 0; bj < 2; ++bj) { const f32x4 v0 = acc[ai][bj][m][0], v1 = acc[ai][bj][m][1];
                    u32x4 w; w.x = pk2(v0[0], v0[1]); w.y = pk2(v0[2], v0[3]); w.z = pk2(v1[0], v1[1]); w.w = pk2(v1[2], v1[3]);
                    *(u32x4*)(rp + bj * 128 + wc * 32 + 8 * fq) = w; }
            }
    }
};
struct DestWin { bf16_t* base;
    __device__ __forceinline__ bf16_t* rowptr(int row, int pn) const {
        if (pn < 16) { const int seg = pn >> 2; return base + (size_t)seg * (33 * MiB / 2) + (size_t)row * 1024 + (pn & 3) * 256; }
        return base + (size_t)4 * (33 * MiB / 2) + (size_t)row * 1536 + (pn - 16) * 256; } };
struct EpiWin {
    static constexpr bool PERM = true, AFTER_DRAIN = false, MIDK = false; EpiStore<DestWin> st; float* gates; const float* igb; const float* fgb; const float* dtb;
    __device__ __forceinline__ void operator()(const f32x4 (&acc)[2][2][4][2], const pg8::Unit& u, int wr, int wc, int fr, int fq) const {
        if (u.pn < 22) { st(acc, u, wr, wc, fr, fq); return; }
        const int c0 = wc * 32 + 8 * fq;
        if (c0 >= NGATE) return;
        float bias[8];
#pragma unroll
        for (int i = 0; i < 8; ++i) { const int c = c0 + i; bias[i] = c < 8 ? igb[c] : (c < 16 ? fgb[c - 8] : dtb[c - 16]); }
#pragma unroll
        for (int ai = 0; ai < 2; ++ai)
#pragma unroll
            for (int m = 0; m < 4; ++m) { const int row = u.pm * 256 + ai * 128 + wr * 64 + m * 16 + fr;
                float v[8];
#pragma unroll
                for (int i = 0; i < 8; ++i) { const float x = acc[ai][0][m][i >> 2][i & 3] + bias[i]; const int c = c0 + i; v[i] = c < 8 ? x : (c < 16 ? logsigf(x) : softplusf(x)); }
                float* gp = gates + (size_t)row * NGATE + c0;
                *(f32x4*)gp = (f32x4){v[0], v[1], v[2], v[3]}; *(f32x4*)(gp + 4) = (f32x4){v[4], v[5], v[6], v[7]}; }
    }
};
struct DestPlain { bf16_t* base; int ld; int pnmask;
    __device__ __forceinline__ bf16_t* rowptr(int row, int pn) const { return base + (size_t)row * ld + (pn & pnmask) * 256; } };
struct DestQKV { bf16_t* q; bf16_t* kb; bf16_t* vb;
    __device__ __forceinline__ bf16_t* rowptr(int row, int pn) const {
        if (pn < 4) return row < NLAT ? q + (size_t)row * 1024 + pn * 256 : nullptr;
        int key; if (row < NLAT) { const int b = row / SEQ, t = row % SEQ; key = b * SLEN + CTXL + t; } else { const int r = row - NLAT; key = (r / CTXL) * SLEN + (r % CTXL); }
        return (pn == 4 ? kb : vb) + (size_t)key * 256; } };
struct EpiWout {
    static constexpr bool PERM = true, AFTER_DRAIN = false, MIDK = true; EpiStore<DestPlain> st; const float* ssq;
    __device__ __forceinline__ void operator()(const f32x4 (&acc)[2][2][4][2], const pg8::Unit& u, int wr, int wc, int fr, int fq) const { st(acc, u, wr, wc, fr, fq); }
    __device__ __forceinline__ void midk(f32x4 (&acc)[2][2][4][2], const pg8::Unit& u, int wr, int wc, int fr, int fq) const {
        const float* p0 = ssq + (size_t)(u.pm * 256 + wr * 64 + fr) * 8; asm volatile("" : "+v"(p0));
#pragma unroll
        for (int ai = 0; ai < 2; ++ai)
#pragma unroll
            for (int m = 0; m < 4; ++m) { const float* p = p0 + (ai * 128 + m * 16) * 8;
                const f32x4 s0 = *(const f32x4*)p, s1 = *(const f32x4*)(p + 4);
                const float r = rsqrtf((((s0[0] + s0[1]) + (s0[2] + s0[3])) + ((s1[0] + s1[1]) + (s1[2] + s1[3]))) * (1.f / 1024.f) + 1e-6f);
#pragma unroll
                for (int bj = 0; bj < 2; ++bj)
#pragma unroll
                    for (int n = 0; n < 2; ++n) acc[ai][bj][m][n] = acc[ai][bj][m][n] * r;
                __builtin_amdgcn_sched_barrier(0); }
    }
};
template <bool WT = false> struct EpiSwigluT {
    static constexpr bool PERM = true, AFTER_DRAIN = false, MIDK = false; bf16_t* out;
    __device__ __forceinline__ void operator()(const f32x4 (&acc)[2][2][4][2], const pg8::Unit& u, int wr, int wc, int fr, int fq) const {
        const int pnl = u.pn & 7;
#pragma unroll
        for (int ai = 0; ai < 2; ++ai)
#pragma unroll
            for (int m = 0; m < 4; ++m) {
                const int row = u.pm * 256 + ai * 128 + wr * 64 + m * 16 + fr;
                bf16_t* rp = out + (size_t)row * 1024 + pnl * 128 + wc * 16 + 4 * fq;
#pragma unroll
                for (int bj = 0; bj < 2; ++bj) { const f32x4 g = acc[ai][bj][m][0], up = acc[ai][bj][m][1];
                    u32x2 w; w.x = pk2(siluf(g[0]) * up[0], siluf(g[1]) * up[1]); w.y = pk2(siluf(g[2]) * up[2], siluf(g[3]) * up[3]);
                    if constexpr (WT) __hip_atomic_store((__attribute__((address_space(1))) unsigned long long*)(rp + bj * 64), (unsigned long long)w.x | ((unsigned long long)w.y << 32), __ATOMIC_RELAXED, __HIP_MEMORY_SCOPE_AGENT);
                    else *(u32x2*)(rp + bj * 64) = w; }
            }
    }
};
using EpiSwiglu = EpiSwigluT<false>;
struct MoeOrder {
    int ntm, npn, nwg, G, c; const LAS int* toff; const int* tab;
    __device__ __forceinline__ void init(const LAS int* toff_, int npn_, int G_, int c_) { toff = toff_; ntm = toff_[16]; npn = npn_; nwg = ntm * npn_; G = G_; c = c_; }
    __device__ __forceinline__ bool next(int i, pg8::Unit& u) const {
        const long L = (long)i * G + c; if (L >= nwg) return false;
        int wgid = (int)L; { const int q = nwg / 8, r = nwg % 8, xcd = wgid % 8, off = wgid / 8; wgid = (xcd < r ? xcd * (q + 1) : r * (q + 1) + (xcd - r) * q) + off; }
        const int pm = wgid / npn, pnl = wgid % npn; int e = 0;
#pragma unroll
        for (int k = 1; k < 16; ++k) e += (toff[k] <= pm) ? 1 : 0;
        u.pm = pm; u.pn = e * npn + pnl; return true;
    }
    __device__ __forceinline__ int arow(const pg8::Unit& u, int r) const { const int e = u.pn / npn, pos = (u.pm - toff[e]) * 256 + r; return pos < toff[100 + e] ? tab[(size_t)e * NTOK + pos] : 0; }
    static constexpr bool LATE = false;
    __device__ __forceinline__ void a_ready(const pg8::Unit&) const {}
    __device__ __forceinline__ void done(const pg8::Unit&) const {}
    __device__ __forceinline__ void late(const pg8::Unit&) const {}
};

struct MoeMerged {
    static constexpr bool LATE = true;
    int m0, nm, nloc, rank, n1c, crot; const LAS int* toff; const int* tab; unsigned* dep;
    __device__ __forceinline__ void init(const LAS int* toff_, const int* tab_, unsigned* dep_) {
        toff = toff_; tab = tab_; dep = dep_; m0 = toff_[120]; nm = toff_[121]; nloc = toff_[122]; rank = toff_[123];
        const int n1 = nm * 8; n1c = rank < n1 ? (n1 - rank + nloc - 1) / nloc : 0; const int rot = n1 % nloc; crot = (rank - rot + nloc) % nloc; }
    __device__ __forceinline__ bool next(int i, pg8::Unit& u) const {
        int pm, pnl, npn, base;
        if (i < n1c) { const int t1 = i * nloc + rank; pm = m0 + (t1 >> 3); pnl = t1 & 7; npn = 8; base = 0; }
        else { const int t2 = (i - n1c) * nloc + crot; if (t2 >= nm * 4) return false; pm = m0 + (t2 >> 2); pnl = t2 & 3; npn = 4; base = 128; }
        int e = 0;
#pragma unroll
        for (int k = 1; k < 16; ++k) e += (toff[k] <= pm) ? 1 : 0;
        u.pm = pm; u.pn = base + e * npn + pnl; return true;
    }
    __device__ __forceinline__ int arow(const pg8::Unit& u, int r) const {
        if (u.pn >= 128) return (int)((WS_HMID - WS_HB) / 2048) + u.pm * 256 + r;
        const int e = u.pn >> 3, pos = (u.pm - toff[e]) * 256 + r; return pos < toff[100 + e] ? tab[(size_t)e * NTOK + pos] : 0; }
    __device__ __forceinline__ void a_ready(const pg8::Unit& u) const {
        if (u.pn >= 128) { unsigned* w = dep + u.pm; unsigned sp = 0;
            while ((unsigned)__builtin_amdgcn_readfirstlane(__hip_atomic_load(w, __ATOMIC_RELAXED, __HIP_MEMORY_SCOPE_AGENT)) < 64u) { __builtin_amdgcn_s_sleep(1); if (++sp > (1u << 22)) break; }
            asm volatile("" ::: "memory"); }
    }
    __device__ __forceinline__ void done(const pg8::Unit&) const {}
    __device__ __forceinline__ void late(const pg8::Unit& u) const {
        if (u.pn < 128) { asm volatile("s_waitcnt vmcnt(0)" ::: "memory"); if (fresh_lane() == 0) (void)__hip_atomic_fetch_add(dep + u.pm, 1u, __ATOMIC_RELAXED, __HIP_MEMORY_SCOPE_AGENT); }
    }
};
struct EpiMoe {
    static constexpr bool PERM = true, AFTER_DRAIN = false, MIDK = false; EpiSwigluT<false> sw; EpiStore<DestPlain> st;
    __device__ __forceinline__ void operator()(const f32x4 (&acc)[2][2][4][2], const pg8::Unit& u, int wr, int wc, int fr, int fq) const {
        if (u.pn < 128) sw(acc, u, wr, wc, fr, fq); else st(acc, u, wr, wc, fr, fq); }
};

#define XB_TMO      128
#define XB_XCNT(j)  (256  + 64 * (j))
#define XB_XSUB(j)  (1280 + 64 * (j))
#define XB_XGEN(j)  (2304 + 64 * (j))
#define XB_TOP      3328
#define XB_TOPGEN   3392
#define XCD_BAR_WORDS 3456
#define XB_SPIN_CAP (1u << 18)

__device__ __forceinline__ unsigned xb_ld(unsigned* p)              { return __hip_atomic_load(p, __ATOMIC_RELAXED, __HIP_MEMORY_SCOPE_AGENT); }
__device__ __forceinline__ unsigned xb_add(unsigned* p, unsigned v) { return __hip_atomic_fetch_add(p, v, __ATOMIC_RELAXED, __HIP_MEMORY_SCOPE_AGENT); }
__device__ __forceinline__ unsigned xb_xcc_id() { return (unsigned)__builtin_amdgcn_s_getreg((3 << 11) | 20) & 0xFu; }
#define XB_SPIN(cond, bar) do { unsigned _sp = 0; while (cond) { __builtin_amdgcn_s_sleep(1); \
    if ((++_sp & 255u) == 0u) { if (xb_ld(&(bar)[XB_TMO])) break; if (_sp > XB_SPIN_CAP) { atomicAdd(&(bar)[XB_TMO], 1u); break; } } } } while (0)

struct XcdBarrier {
    unsigned* bar; unsigned x;
    volatile LAS unsigned* st;
};

__device__ __forceinline__ XcdBarrier xcd_barrier_post(unsigned* bar, volatile LAS unsigned* st, int tid) {
    XcdBarrier b; b.bar = bar; b.x = xb_xcc_id(); b.st = st;
    if (tid == 0) { st[2] = xb_add(&bar[XB_XCNT(b.x)], 1u); st[3] = b.x; }
    return b;
}
__device__ __forceinline__ void xcd_barrier_complete(unsigned* bar, unsigned x, unsigned& nloc, unsigned& nx) {
    const unsigned G = gridDim.x * gridDim.y * gridDim.z;
    unsigned sum, cnt, mine, sp = 0u;
    for (;;) {
        sum = 0u; cnt = 0u; mine = 0u;
#pragma unroll
        for (unsigned j = 0; j < 16; ++j) { const unsigned c = xb_ld(&bar[XB_XCNT(j)]); sum += c; cnt += (c > 0u) ? 1u : 0u; mine = (j == x) ? c : mine; }
        if (sum == G) break;
        __builtin_amdgcn_s_sleep(1);
        if ((++sp & 255u) == 0u) { if (xb_ld(&bar[XB_TMO])) break; if (sp > XB_SPIN_CAP) { atomicAdd(&bar[XB_TMO], 1u); break; } }
    }
    nloc = mine > 0u ? mine : 1u; nx = cnt > 0u ? cnt : 1u;
}

__device__ __forceinline__ void xcd_barrier(const XcdBarrier& b, int tid) {
    asm volatile("s_waitcnt vmcnt(0)" ::: "memory");
    __syncthreads();
    if (tid == 0) {
        unsigned* bar = b.bar;
        __builtin_amdgcn_s_waitcnt(0);
        unsigned nloc = b.st[0], nx = b.st[1];
        if (nloc == 0u) { xcd_barrier_complete(bar, b.x, nloc, nx); b.st[0] = nloc; b.st[1] = nx; }
        const unsigned old = xb_add(&bar[XB_XSUB(b.x)], 1u);
        const unsigned gen = old / nloc;
        if (old + 1u == (gen + 1u) * nloc) {
            __builtin_amdgcn_fence(__ATOMIC_RELEASE, "agent");
            asm volatile("s_waitcnt vmcnt(0)" ::: "memory");
            const unsigned og = xb_add(&bar[XB_TOP], 1u);
            const unsigned tg = og / nx;
            if (og + 1u == (tg + 1u) * nx) xb_add(&bar[XB_TOPGEN], 1u);
            else XB_SPIN(xb_ld(&bar[XB_TOPGEN]) == tg, bar);
            __builtin_amdgcn_fence(__ATOMIC_ACQUIRE, "agent");
            xb_add(&bar[XB_XGEN(b.x)], 1u);
            asm volatile("s_waitcnt vmcnt(0)" ::: "memory");
        } else {
            XB_SPIN(xb_ld(&bar[XB_XGEN(b.x)]) == gen, bar);
            __builtin_amdgcn_fence(__ATOMIC_ACQUIRE, "agent");
            asm volatile("s_waitcnt vmcnt(0)" ::: "memory");
        }
    }
    __syncthreads();
}

struct Args {
    const float* in[28]; float* out; unsigned char* ws; int ph_lo, ph_hi, li, pad;
};
struct Ctx {
    LAS unsigned char* lds; unsigned char* ws;
    int tid, lane, wave, G, bid;
};
#define CTLP(F) ((unsigned*)((F).ws + WS_CTL))
#define MISCP(F) ((LAS int*)((F).lds + MISC_OFF))
#define GWID(F) ((F).bid * NWAVES + (F).wave)
#define NGW(F) ((F).G * NWAVES)
enum { I_X = 0, I_C, I_CTX, I_CCTX, I_ADAW, I_ADAB, I_LNG, I_LNB, I_ABWIN, I_ABWOUT, I_IGB, I_FGB, I_MNG, I_CONVW, I_CONVB, I_DTB, I_ALOG, I_SSMD, I_SNG,
       I_ATWIN, I_ATWOUT, I_QG, I_KG, I_RW, I_RB, I_WG, I_WU, I_WD };
constexpr int RING_BYTES = 131072, MISC_OFF = RING_BYTES, LDS_BYTES = RING_BYTES + 12288;

template <class Src> __device__ __forceinline__ void transpose_item(const Src& S, bf16_t* WT, int K, int orow0, int k0, LAS float* scr, int lane, float scale) {
#pragma unroll 8
    for (int i = 0; i < 32; ++i) { const int kk = 2 * i + (lane >> 5); scr[kk * 33 + (lane & 31)] = S.ld(k0 + kk, lane & 31); }
    asm volatile("s_waitcnt lgkmcnt(0)" ::: "memory");
    const int c = lane & 7;
#pragma unroll
    for (int j = 0; j < 4; ++j) { const int n = (lane >> 3) + 8 * j; const LAS float* s = scr + (8 * c) * 33 + S.scol(n);
        u32x4 o; o.x = pk2(s[0 * 33] * scale, s[1 * 33] * scale); o.y = pk2(s[2 * 33] * scale, s[3 * 33] * scale); o.z = pk2(s[4 * 33] * scale, s[5 * 33] * scale); o.w = pk2(s[6 * 33] * scale, s[7 * 33] * scale);
        *(u32x4*)(WT + (size_t)(orow0 + n) * K + k0 + 8 * c) = o; }
    asm volatile("s_waitcnt lgkmcnt(0)" ::: "memory");
}
struct SrcPlain { const float* W; int N; int n0;
    __device__ __forceinline__ float ld(int k, int j) const { return W[(size_t)k * N + n0 + j]; }
    __device__ __forceinline__ int scol(int n) const { return n; } };
struct SrcGate { const float* W; int j0;
    __device__ __forceinline__ float ld(int k, int j) const { const int jj = j0 + j; return jj < 16 ? W[(size_t)k * ABIN + 3072 + jj] : (jj < NGATE ? W[(size_t)k * ABIN + 5648 + (jj - 16)] : 0.f); }
    __device__ __forceinline__ int scol(int n) const { return n; } };
struct SrcWout { const float* W; const float* g; int n0;
    __device__ __forceinline__ float ld(int k, int j) const { return k < 1024 ? W[(size_t)(k + 1024) * 1024 + n0 + j] * g[k] : W[(size_t)(k - 1024) * 1024 + n0 + j]; }
    __device__ __forceinline__ int scol(int n) const { return n; } };
struct SrcGU { const float* Wg; const float* Wu; int c0;
    __device__ __forceinline__ float ld(int k, int j) const { return (j < 16 ? Wg : Wu)[(size_t)k * 1024 + c0 + (j & 15)]; }
    __device__ __forceinline__ int scol(int n) const { const int b4 = n >> 3, w = n & 7; return (w < 4 ? 0 : 16) + 4 * b4 + (w & 3); } };

__device__ __forceinline__ void convert_small_weights(Ctx& F, const Args& a) {
    {   float* rope = (float*)(F.ws + WS_ROPE);
        for (int i = F.bid * NTHREADS + F.tid; i < 128 * 32; i += F.G * NTHREADS) { const int pos = i >> 5, fi = i & 31; float sn, cs; sincosf((float)pos * expf(-(float)fi * (9.210340371976184f / 32.f)), &sn, &cs); rope[2 * i] = cs; rope[2 * i + 1] = sn; } }
    LAS float* scr = (LAS float*)(F.lds + F.wave * 16384);
    bf16_t* WinT = (bf16_t*)(F.ws + WS_WIN); bf16_t* WoutT = (bf16_t*)(F.ws + WS_WOUT); bf16_t* AtInT = (bf16_t*)(F.ws + WS_ATIN); bf16_t* AtOutT = (bf16_t*)(F.ws + WS_ATOUT);
    constexpr int I0 = 16 * (NWIN / 32), I1 = 32 * 32, I2 = 16 * 48, I3 = 16 * 32, NI = I0 + I1 + I2 + I3;
    for (int it = GWID(F); it < NI; it += NGW(F)) {
        int r = it;
        if (r < I0) { const int kb = r / (NWIN / 32), nb = r % (NWIN / 32), n0 = 32 * nb;
            if (n0 < 5632) { SrcPlain S{a.in[I_ABWIN], ABIN, n0 < 3072 ? n0 : n0 + 16}; transpose_item(S, WinT, 1024, n0, 64 * kb, scr, F.lane, n0 < 512 ? 0.08838834764831845f : 1.f); }
            else { SrcGate S{a.in[I_ABWIN], n0 - 5632}; transpose_item(S, WinT, 1024, n0, 64 * kb, scr, F.lane, 1.f); }
            continue; } r -= I0;
        if (r < I1) { const int kb = r / 32, nb = r % 32; SrcWout S{a.in[I_ABWOUT], a.in[I_SNG], 32 * nb}; transpose_item(S, WoutT, 2048, 32 * nb, 64 * kb, scr, F.lane, 1.f); continue; } r -= I1;
        if (r < I2) { const int kb = r / 48, nb = r % 48; SrcPlain S{a.in[I_ATWIN], 1536, 32 * nb}; transpose_item(S, AtInT, 1024, 32 * nb, 64 * kb, scr, F.lane, 1.f); continue; } r -= I2;
        { const int kb = r / 32, nb = r % 32; SrcPlain S{a.in[I_ATWOUT], 1024, 32 * nb}; transpose_item(S, AtOutT, 1024, 32 * nb, 64 * kb, scr, F.lane, 1.f); }
    }
}
__device__ __forceinline__ void convert_moe_weights(Ctx& F, const Args& a, int layer, int skip_blocks, int it0 = 0, int it1 = 16 * 16 * 64 + 16 * 16 * 32) {
    if (F.bid < skip_blocks) return;
    LAS float* scr = (LAS float*)(F.lds + F.wave * 16384);
    bf16_t* WGU = (bf16_t*)(F.ws + WS_MOEW); bf16_t* WD = (bf16_t*)(F.ws + WS_MOEW + 64 * MiB);
    const size_t wl = (size_t)layer * 16 * 1024 * 1024;
    constexpr int IGU = 16 * 16 * 64, IDN = 16 * 16 * 32;
    for (int it = it0 + (F.bid - skip_blocks) * NWAVES + F.wave; it < it1; it += (F.G - skip_blocks) * NWAVES) {
        if (it < IGU) { const int e = it / 1024, r = it % 1024, kb = r / 64, nb = r % 64;
            SrcGU S{a.in[I_WG] + wl + (size_t)e * 1048576, a.in[I_WU] + wl + (size_t)e * 1048576, 16 * nb};
            transpose_item(S, WGU + (size_t)e * 2048 * 1024, 1024, 32 * nb, 64 * kb, scr, F.lane, 1.f); }
        else { const int r0 = it - IGU, e = r0 / 512, r = r0 % 512, kb = r / 32, nb = r % 32;
            SrcPlain S{a.in[I_WD] + wl + (size_t)e * 1048576, 1024, 32 * nb};
            transpose_item(S, WD + (size_t)e * 1024 * 1024, 1024, 32 * nb, 64 * kb, scr, F.lane, 1.f); }
    }
}
__device__ __forceinline__ void ada_phase(Ctx& F, const Args& a) {
    LAS float* red = (LAS float*)(F.lds + 8 * 16384);
    float* modv = (float*)(F.ws + WS_MODV);
    for (int item = F.bid; item < 2 * 96; item += F.G) {
        const int l = item / 96, n = (item % 96) * 64 + F.lane;
        float a0 = 0.f, a1 = 0.f, a2 = 0.f;
        const float* w = a.in[I_ADAW] + ((size_t)l * 1024 + F.wave * 128) * 6144 + n;
#pragma unroll 16
        for (int k = 0; k < 128; ++k) { const float wv = w[(size_t)k * 6144]; const int kk = F.wave * 128 + k;
            a0 += siluf(a.in[I_C][kk]) * wv; a1 += siluf(a.in[I_C][1024 + kk]) * wv; a2 += siluf(a.in[I_CCTX][kk]) * wv; }
        LAS float* rr = (LAS float*)F.lds;
        rr[(F.wave * 3 + 0) * 64 + F.lane] = a0; rr[(F.wave * 3 + 1) * 64 + F.lane] = a1; rr[(F.wave * 3 + 2) * 64 + F.lane] = a2;
        __syncthreads();
        if (F.wave < 3) { float s = 0.f;
#pragma unroll
            for (int w8 = 0; w8 < 8; ++w8) s += rr[(w8 * 3 + F.wave) * 64 + F.lane];
            modv[(l * 3 + F.wave) * 6144 + n] = s + a.in[I_ADAB][l * 6144 + n]; }
        __syncthreads();
    }
    (void)red;
}

template <int NC> __device__ __forceinline__ void row_dots(const RowF& h, const float* W, int lane, float (&acc)[NC]) {
#pragma unroll
    for (int i = 0; i < NC; ++i) acc[i] = 0.f;
#pragma unroll
    for (int j = 0; j < 4; ++j)
#pragma unroll
        for (int e = 0; e < 4; ++e) { const float x = h.v[j][e]; const f32x4* w = (const f32x4*)(W + (size_t)(4 * lane + 256 * j + e) * NC);
#pragma unroll
            for (int q = 0; q < NC / 4; ++q) { const f32x4 wv = w[q]; acc[4 * q + 0] += x * wv[0]; acc[4 * q + 1] += x * wv[1]; acc[4 * q + 2] += x * wv[2]; acc[4 * q + 3] += x * wv[3]; } }
}
template <int O, int N> __device__ __forceinline__ void xreduce_step(float (&acc)[N], int lane) {
    const bool up = (lane & O) != 0;
#pragma unroll
    for (int i = 0; i < O; ++i) { const float keep = up ? acc[i + O] : acc[i], send = up ? acc[i] : acc[i + O]; acc[i] = keep + __shfl_xor(send, O); }
}
template <int N> __device__ __forceinline__ float xreduce(float (&acc)[N], int lane) {
    if constexpr (N == 16) {
#pragma unroll
        for (int i = 0; i < 16; ++i) { acc[i] += __shfl_xor(acc[i], 32); acc[i] += __shfl_xor(acc[i], 16); }
    }
    if constexpr (N == 64) { xreduce_step<32, N>(acc, lane); xreduce_step<16, N>(acc, lane); }
    xreduce_step<8, N>(acc, lane); xreduce_step<4, N>(acc, lane); xreduce_step<2, N>(acc, lane); xreduce_step<1, N>(acc, lane);
    return acc[0];
}

__device__ __forceinline__ const float* x_row(const Args& a, int row) { return row < NLAT ? a.in[I_X] + (size_t)row * D : a.in[I_CTX] + (size_t)(row - NLAT) * D; }
__device__ __forceinline__ void rowpass_a(Ctx& F, const Args& a) {
    const float* modv = (const float*)(F.ws + WS_MODV);
    bf16_t* HB = (bf16_t*)(F.ws + WS_HB);
    int row = GWID(F); if (row >= NTOK) return;
    RowF xn = row_ld_f32(x_row(a, row), F.lane);
    for (; row < NTOK; row += NGW(F)) {
        const RowF x = xn; const int nrow = row + NGW(F);
        if (nrow < NTOK) xn = row_ld_f32(x_row(a, nrow), F.lane);
        const float* m = modv + mod_index(row) * 6144;
        const RowF h = row_modulate(x, m, m + 1024, F.lane);
        row_st_bf16(HB + (size_t)row * D, F.lane, h);
    }
}
__device__ __forceinline__ void stage_router(Ctx& F, const float* rw) {
    LAS f32x4* Wl = (LAS f32x4*)F.lds;
    for (int i = F.tid; i < 4096; i += NTHREADS) { const int d = i >> 2, q = i & 3; const f32x4 w = *(const f32x4*)(rw + d * 16 + q * 4);
        Wl[q * 1024 + ((d >> 8) * 4 + (d & 3)) * 64 + ((d >> 2) & 63)] = w; }
    __syncthreads();
}
__device__ __forceinline__ void row_dots16_lds(const RowF& h, const LAS f32x4* Wl, int lane, float (&acc)[16]) {
#pragma unroll
    for (int i = 0; i < 16; ++i) acc[i] = 0.f;
#pragma unroll
    for (int j = 0; j < 4; ++j)
#pragma unroll
        for (int e = 0; e < 4; ++e) { const float x = h.v[j][e];
#pragma unroll
            for (int q = 0; q < 4; ++q) { const f32x4 wv = Wl[q * 1024 + (j * 4 + e) * 64 + lane]; acc[4 * q + 0] += x * wv[0]; acc[4 * q + 1] += x * wv[1]; acc[4 * q + 2] += x * wv[2]; acc[4 * q + 3] += x * wv[3]; }
            if (e & 1) __builtin_amdgcn_sched_barrier(0); }
}
__device__ __forceinline__ void route_row(const RowF& h2, const LAS f32x4* Wl, const float* rb, int lane, int& e0, int& e1, float& g0, float& g1) {
    float acc[16]; row_dots16_lds(h2, Wl, lane, acc);
    const float logit = xreduce<16>(acc, lane);
    float mx = logit;
#pragma unroll
    for (int o = 8; o >= 1; o >>= 1) mx = fmaxf(mx, __shfl_xor(mx, o));
    const float ex = expf(logit - mx); float sm = ex;
#pragma unroll
    for (int o = 8; o >= 1; o >>= 1) sm += __shfl_xor(sm, o);
    const float p = ex / sm, sel = p + rb[lane & 15];
    float s4[4], p4[4];
#pragma unroll
    for (int i = 0; i < 4; ++i) s4[i] = __shfl(sel, (lane & 12) + i);
    float v1 = s4[0]; int i1 = 0;
#pragma unroll
    for (int i = 1; i < 4; ++i) if (s4[i] > v1) { v1 = s4[i]; i1 = i; }
    float v2 = -1e30f;
#pragma unroll
    for (int i = 0; i < 4; ++i) if (i != i1 && s4[i] > v2) v2 = s4[i];
    const float gs = v1 + v2;
    float best = __shfl(gs, 0); int bg = 0;
#pragma unroll
    for (int g = 1; g < 4; ++g) { const float t = __shfl(gs, 4 * g); if (t > best) { best = t; bg = g; } }
#pragma unroll
    for (int i = 0; i < 4; ++i) { s4[i] = __shfl(sel, 4 * bg + i); p4[i] = __shfl(p, 4 * bg + i); }
    v1 = s4[0]; i1 = 0; float q1 = p4[0];
#pragma unroll
    for (int i = 1; i < 4; ++i) if (s4[i] > v1) { v1 = s4[i]; i1 = i; q1 = p4[i]; }
    v2 = -1e30f; int i2 = 0; float q2 = 0.f;
#pragma unroll
    for (int i = 0; i < 4; ++i) if (i != i1 && s4[i] > v2) { v2 = s4[i]; i2 = i; q2 = p4[i]; }
    e0 = 4 * bg + i1; e1 = 4 * bg + i2; const float s = q1 + q2; g0 = q1 / s; g1 = q2 / s;
}
__device__ __forceinline__ void rowpass_b(Ctx& F, const Args& a, int layer, int nrows, const bf16_t* YB) {
    const float* modl = (const float*)(F.ws + WS_MODV) + layer * 3 * 6144;
    bf16_t* XL = (bf16_t*)(F.ws + WS_XL); bf16_t* HB = (bf16_t*)(F.ws + WS_HB);
    int* tok_e = (int*)(F.ws + WS_ROUTE); int* tok_pos = tok_e + 2 * NTOK; float* tok_g = (float*)(tok_pos + 2 * NTOK);
    unsigned* cnt = CTLP(F) + (layer ? CW_CNT1 : CW_CNT0);
    stage_router(F, a.in[I_RW]);
    LAS int* lcnt = (LAS int*)(F.lds + 65536); LAS int* gbase = lcnt + 16; LAS int* nrow = lcnt + 32; LAS int* lrow = lcnt + 64;
    if (F.tid < 33) lcnt[F.tid] = 0;
    __syncthreads();
    RowF xf_n; RowRaw xr_n, y_n;
    { const int r0 = GWID(F); if (r0 < nrows) { if (layer) xr_n = row_ldraw_bf16(XL + (size_t)r0 * D, F.lane); else xf_n = row_ld_f32(x_row(a, r0), F.lane); y_n = row_ldraw_bf16(YB + (size_t)r0 * D, F.lane); } }
    for (int row = GWID(F); row < nrows; row += NGW(F)) {
        const float* m = modl + mod_index(row) * 6144;
        RowF x = layer ? row_cvt(xr_n) : xf_n; const RowF y = row_cvt(y_n); const int nxr = row + NGW(F);
        if (nxr < nrows) { if (layer) xr_n = row_ldraw_bf16(XL + (size_t)nxr * D, F.lane); else xf_n = row_ld_f32(x_row(a, nxr), F.lane); y_n = row_ldraw_bf16(YB + (size_t)nxr * D, F.lane); }
        const RowF gt = row_ld_f32(m + 2048, F.lane);
#pragma unroll
        for (int j = 0; j < 4; ++j) x.v[j] = ALPHA * x.v[j] + gt.v[j] * y.v[j];
        row_layernorm(x, a.in[I_LNG] + (layer * 2) * D, a.in[I_LNB] + (layer * 2) * D, F.lane);
        row_st_bf16(XL + (size_t)row * D, F.lane, x);
        const RowF h2 = row_modulate(x, m + 3072, m + 4096, F.lane);
        row_st_bf16(HB + (size_t)row * D, F.lane, h2);
        int e0, e1; float g0, g1; route_row(h2, (const LAS f32x4*)F.lds, a.in[I_RB], F.lane, e0, e1, g0, g1);
        if (F.lane == 0) {
            const int p0 = __hip_atomic_fetch_add(lcnt + e0, 1, __ATOMIC_RELAXED, __HIP_MEMORY_SCOPE_WORKGROUP), p1 = __hip_atomic_fetch_add(lcnt + e1, 1, __ATOMIC_RELAXED, __HIP_MEMORY_SCOPE_WORKGROUP);
            const int ix = __hip_atomic_fetch_add(nrow, 1, __ATOMIC_RELAXED, __HIP_MEMORY_SCOPE_WORKGROUP);
            lrow[ix * 4 + 0] = row; lrow[ix * 4 + 1] = e0 | (e1 << 8); lrow[ix * 4 + 2] = p0; lrow[ix * 4 + 3] = p1;
            tok_e[row * 2] = e0; tok_e[row * 2 + 1] = e1; tok_g[row * 2] = g0; tok_g[row * 2 + 1] = g1;
        }
    }
    __syncthreads();
    if (F.tid < 16) gbase[F.tid] = (int)atomicAdd(cnt + F.tid, (unsigned)lcnt[F.tid]);
    __syncthreads();
    if (F.tid < nrow[0]) { const int row = lrow[F.tid * 4], ee = lrow[F.tid * 4 + 1];
        const int e0 = ee & 255, e1 = ee >> 8, p0 = gbase[e0] + lrow[F.tid * 4 + 2], p1 = gbase[e1] + lrow[F.tid * 4 + 3];
        tok_pos[row * 2] = p0; tok_pos[row * 2 + 1] = p1; int* tab = (int*)(F.ws + WS_TOKTAB); tab[(size_t)e0 * NTOK + p0] = row; tab[(size_t)e1 * NTOK + p1] = row; }
}
__device__ __forceinline__ void moe_offsets(Ctx& F, int layer) {
    __syncthreads();
    if (F.tid == 0) { const unsigned* cnt = CTLP(F) + (layer ? CW_CNT1 : CW_CNT0); int acc = 0;
        for (int e = 0; e < 16; ++e) { const int c = (int)__hip_atomic_load(cnt + e, __ATOMIC_RELAXED, __HIP_MEMORY_SCOPE_AGENT); MISCP(F)[e] = acc; MISCP(F)[100 + e] = c; acc += (c + 255) >> 8; }
        MISCP(F)[16] = acc; }
    __syncthreads();
}
__device__ __forceinline__ void moe_streams(Ctx& F, int layer, int li) {
    moe_offsets(F, layer);
    if (F.tid == 0) { const unsigned* bar = CTLP(F) + CW_BAR + li * 4096; const int x = MISCP(F)[35]; int tot = 0, before = 0, mine = 1;
        for (int j = 0; j < 16; ++j) { const int c = (int)__hip_atomic_load(bar + XB_XCNT(j), __ATOMIC_RELAXED, __HIP_MEMORY_SCOPE_AGENT); tot += c; before += (j < x) ? c : 0; mine = (j == x) ? c : mine; }
        const int ntm = MISCP(F)[16]; const int m0 = (int)((long)ntm * before / tot), m1 = (int)((long)ntm * (before + mine) / tot);
        MISCP(F)[120] = m0; MISCP(F)[121] = m1 - m0; MISCP(F)[122] = mine; MISCP(F)[123] = MISCP(F)[34]; }
    __syncthreads();
}
__device__ __forceinline__ void moe_scatter(Ctx& F, int layer, int nrows) {
    moe_offsets(F, layer);
    const bf16_t* HB = (const bf16_t*)(F.ws + WS_HB); bf16_t* XS = (bf16_t*)(F.ws + WS_XS);
    const int* tok_e = (const int*)(F.ws + WS_ROUTE); const int* tok_pos = tok_e + 2 * NTOK; int* tok_slot = (int*)(F.ws + WS_ROUTE + MiB);
    for (int row = GWID(F); row < nrows; row += NGW(F)) {
        const int e0 = tok_e[row * 2], e1 = tok_e[row * 2 + 1];
        const int s0 = MISCP(F)[e0] * 256 + tok_pos[row * 2], s1 = MISCP(F)[e1] * 256 + tok_pos[row * 2 + 1];
        const u32x4* src = (const u32x4*)(HB + (size_t)row * D) + F.lane; const u32x4 v0 = src[0], v1 = src[64];
        u32x4* d0 = (u32x4*)(XS + (size_t)s0 * D) + F.lane; u32x4* d1 = (u32x4*)(XS + (size_t)s1 * D) + F.lane;
        d0[0] = v0; d0[64] = v1; d1[0] = v0; d1[64] = v1;
        if (F.lane == 0) { tok_slot[row * 2] = s0; tok_slot[row * 2 + 1] = s1; }
    }
}
__device__ __forceinline__ void rowpass_c(Ctx& F, const Args& a, int layer, int nrows, bool last) {
    const float* modl = (const float*)(F.ws + WS_MODV) + layer * 3 * 6144;
    bf16_t* XL = (bf16_t*)(F.ws + WS_XL); bf16_t* HB = (bf16_t*)(F.ws + WS_HB); const bf16_t* YS = (const bf16_t*)(F.ws + WS_YS);
    const int* tok_e = (const int*)(F.ws + WS_ROUTE); const int* tok_pos = tok_e + 2 * NTOK; const float* tok_g = (const float*)(F.ws + WS_ROUTE) + 4 * NTOK;
    moe_offsets(F, layer);
    const int step = NGW(F); int row = GWID(F);
    int s0n = 0, s1n = 0, s0nn = 0, s1nn = 0; float g0n = 0.f, g1n = 0.f, g0nn = 0.f, g1nn = 0.f; RowRaw xr_n, y0_n, y1_n;
#define RC_SLOTS(r_, s0_, s1_, g0_, g1_) do { s0_ = MISCP(F)[tok_e[(r_) * 2]] * 256 + tok_pos[(r_) * 2]; s1_ = MISCP(F)[tok_e[(r_) * 2 + 1]] * 256 + tok_pos[(r_) * 2 + 1]; g0_ = tok_g[(r_) * 2]; g1_ = tok_g[(r_) * 2 + 1]; } while (0)
    if (row < nrows) { RC_SLOTS(row, s0n, s1n, g0n, g1n); xr_n = row_ldraw_bf16(XL + (size_t)row * D, F.lane); y0_n = row_ldraw_bf16(YS + (size_t)s0n * D, F.lane); y1_n = row_ldraw_bf16(YS + (size_t)s1n * D, F.lane);
        if (row + step < nrows) RC_SLOTS(row + step, s0nn, s1nn, g0nn, g1nn); }
    for (; row < nrows; row += step) {
        const float* m = modl + mod_index(row) * 6144;
        RowF x = row_cvt(xr_n); const RowF y0 = row_cvt(y0_n), y1 = row_cvt(y1_n); const float g0 = g0n, g1 = g1n;
        if (row + step < nrows) { const int nr = row + step; s0n = s0nn; s1n = s1nn; g0n = g0nn; g1n = g1nn;
            xr_n = row_ldraw_bf16(XL + (size_t)nr * D, F.lane); y0_n = row_ldraw_bf16(YS + (size_t)s0n * D, F.lane); y1_n = row_ldraw_bf16(YS + (size_t)s1n * D, F.lane);
            if (nr + step < nrows) RC_SLOTS(nr + step, s0nn, s1nn, g0nn, g1nn); }
        const RowF gt = row_ld_f32(m + 5120, F.lane);
#pragma unroll
        for (int j = 0; j < 4; ++j) x.v[j] = ALPHA * x.v[j] + gt.v[j] * (g0 * y0.v[j] + g1 * y1.v[j]);
        row_layernorm(x, a.in[I_LNG] + (layer * 2 + 1) * D, a.in[I_LNB] + (layer * 2 + 1) * D, F.lane);
        if (last) { row_st_f32(a.out + (size_t)row * D, F.lane, x); }
        else { row_st_bf16(XL + (size_t)row * D, F.lane, x); const float* m1 = modl + 3 * 6144 + mod_index(row) * 6144;
            const RowF h = row_modulate(x, m1, m1 + 1024, F.lane); row_st_bf16(HB + (size_t)row * D, F.lane, h); }
    }
#undef RC_SLOTS
}

template <class Epi, class Sched> __device__ __forceinline__ void run_gemm_gather(Ctx& F, const bf16_t* A, const bf16_t* Bt, int K, const Sched& S, const Epi& E) {
    pg8::Gemm g{A, Bt, 0, 0, K};
    pg8::gemm_phase<Epi, Sched, true, true, true>(F.lds, g, S, E, F.wave * 64 + fresh_lane());
    __syncthreads();
}
template <class Epi, class Sched> __device__ __forceinline__ void run_gemm(Ctx& F, const bf16_t* A, const bf16_t* Bt, int M, int N, int K, const Sched& S, const Epi& E) {
    pg8::Gemm g{A, Bt, M, N, K};
    pg8::gemm_phase<Epi, Sched, true, true>(F.lds, g, S, E, F.wave * 64 + fresh_lane());
    __syncthreads();
}

__device__ __forceinline__ void qkprep_phase(Ctx& F, const Args& a) {
    bf16_t* Q = (bf16_t*)(F.ws + WS_Q); bf16_t* KB = (bf16_t*)(F.ws + WS_KB);
    constexpr int NQ = NLAT * 8, NK = NBATCH * SLEN * 2;
    const float qg0 = a.in[I_QG][F.lane], qg1 = a.in[I_QG][F.lane + 64], kg0 = a.in[I_KG][F.lane], kg1 = a.in[I_KG][F.lane + 64];
    const float* ropet = (const float*)(F.ws + WS_ROPE);
    for (int it = NQ + GWID(F); it < NQ + NK; it += NGW(F)) {
        bf16_t* p; int t; bool rope; float g0, g1;
        if (it < NQ) { const int row = it >> 3, hh = it & 7; p = Q + (size_t)row * 1024 + hh * 128; t = row % SEQ; rope = true; g0 = qg0; g1 = qg1; }
        else { const int r = it - NQ, krow = r >> 1, kvh = r & 1, key = krow % SLEN; p = KB + (size_t)krow * 256 + kvh * 128; rope = key >= CTXL; t = key - CTXL; g0 = kg0; g1 = kg1; }
        float x1 = bf2f(p[F.lane]), x2 = bf2f(p[F.lane + 64]);
        const float r = rsqrtf(wave_sum(x1 * x1 + x2 * x2) * (1.f / 128.f) + 1e-6f);
        x1 *= r * g0; x2 *= r * g1;
        float o1 = x1, o2 = x2;
        if (rope) { const float* rp = ropet + ((F.lane < 32) ? (t / 64) : (t % 64)) * 64 + 2 * (F.lane & 31); const float cs = rp[0], sn = rp[1]; o1 = x1 * cs - x2 * sn; o2 = x2 * cs + x1 * sn; }
        p[F.lane] = f2bf(o1); p[F.lane + 64] = f2bf(o2);
    }
}
__device__ __forceinline__ void attn_phase(Ctx& F, const Args& a) {
    const bf16_t* Q = (const bf16_t*)(F.ws + WS_Q); const bf16_t* KB = (const bf16_t*)(F.ws + WS_KB); const bf16_t* VB = (const bf16_t*)(F.ws + WS_VB); bf16_t* AO = (bf16_t*)(F.ws + WS_AO);
    const float gq = wave_max(fmaxf(fabsf(a.in[I_QG][F.lane]), fabsf(a.in[I_QG][F.lane + 64]))), gk = wave_max(fmaxf(fabsf(a.in[I_KG][F.lane]), fabsf(a.in[I_KG][F.lane + 64])));
    const bool fast = 11.3137085f * 1.4426950408889634f * 1.02f * gq * gk < 60.f;
    for (int i = 0;; ++i) {
        const int L = i * F.G + F.bid; if (L >= 512) break;
        const int xcd = L & 7, off = L >> 3, combo = xcd >> 1, idx = (xcd & 1) * 64 + off, hl = idx >> 5, qb = idx & 31;
        const int b = combo >> 1, kvh = combo & 1, h = kvh * 4 + hl;
        const size_t qoff = ((size_t)b * SEQ + qb * 256) * 1024 + h * 128, koff = (size_t)b * SLEN * 256 + kvh * 128;
        if (fast) attn::attn_dense_body<attn::bf16, true, 1>(Q + qoff, KB + koff, VB + koff, AO + qoff, SLEN, (char*)F.lds, F.wave * 64 + fresh_lane(), a.in[I_QG], qb * 256, (const float*)(F.ws + WS_ROPE));
        else attn::attn_dense_body<attn::bf16, false, 1>(Q + qoff, KB + koff, VB + koff, AO + qoff, SLEN, (char*)F.lds, F.wave * 64 + fresh_lane(), a.in[I_QG], qb * 256, (const float*)(F.ws + WS_ROPE));
        __syncthreads();
    }
}

typedef short v4i16_t __attribute__((ext_vector_type(4)));
typedef const LAS unsigned char* lds_cptr;
constexpr float LOG2E = 1.4426950408889634f;
__device__ __forceinline__ s16x4 vtr(lds_cptr p) { return __builtin_bit_cast(s16x4, __builtin_amdgcn_ds_read_tr16_b64_v4i16((LAS v4i16_t*)p)); }
__device__ __forceinline__ bf16x8 trfrag(lds_cptr tb, int d0, int ks) {
    const s16x4 l = vtr(tb + attn::v_rd_off(d0, ks, 0)), h = vtr(tb + attn::v_rd_off(d0, ks, 1));
    return (bf16x8){l[0], l[1], l[2], l[3], h[0], h[1], h[2], h[3]}; }
__device__ __forceinline__ bf16x8 rowfrag(lds_cptr tile, int blk, int d0, int r32, int hi) { return *(const LAS bf16x8*)(tile + KSWZ(32 * blk + r32, (d0 * 16 + hi * 8) * 2)); }
__device__ __forceinline__ u32x4 scale8(u32x4 v, float s) { u32x4 o;
#pragma unroll
    for (int i = 0; i < 4; ++i) o[i] = pk2(__uint_as_float(v[i] << 16) * s, __uint_as_float(v[i] & 0xffff0000u) * s);
    return o; }
__device__ __forceinline__ bf16x8 scale8f(bf16x8 v, float s) { return __builtin_bit_cast(bf16x8, scale8(__builtin_bit_cast(u32x4, v), s)); }
__device__ __forceinline__ float wave_incl_sum(float v, int lane) {
#pragma unroll
    for (int o = 1; o < 64; o <<= 1) { const float t = __shfl_up(v, o); if (lane >= o) v += t; }
    return v; }
__device__ __forceinline__ float wave_incl_max(float v, int lane) {
#pragma unroll
    for (int o = 1; o < 64; o <<= 1) { const float t = __shfl_up(v, o); if (lane >= o) v = fmaxf(v, t); }
    return v; }
__device__ __forceinline__ float wave_incl_max_rev(float v, int lane) {
#pragma unroll
    for (int o = 1; o < 64; o <<= 1) { const float t = __shfl_down(v, o); if (lane + o < 64) v = fmaxf(v, t); }
    return v; }
__device__ __forceinline__ float half_swap_add(float v) { auto rr = __builtin_amdgcn_permlane32_swap(__float_as_uint(v), __float_as_uint(v), false, false); return __uint_as_float(rr[0]) + __uint_as_float(rr[1]); }
#define MX_PK4(P, BASE, OUT) do { unsigned a0_ = pk2(P[BASE + 0], P[BASE + 1]), a1_ = pk2(P[BASE + 2], P[BASE + 3]); \
    unsigned b0_ = pk2(P[BASE + 4], P[BASE + 5]), b1_ = pk2(P[BASE + 6], P[BASE + 7]); \
    auto r0_ = __builtin_amdgcn_permlane32_swap(a0_, b0_, false, false); auto r1_ = __builtin_amdgcn_permlane32_swap(a1_, b1_, false, false); \
    u32x4 w_ = {r0_[0], r1_[0], r0_[1], r1_[1]}; OUT = __builtin_bit_cast(bf16x8, w_); } while (0)

__device__ __forceinline__ const bf16_t* launder_v(const bf16_t* p) { asm volatile("" : "+v"(p)); return p; }
constexpr int MX_MISC = MISC_OFF + 1024;
__device__ __forceinline__ int st_off(int row, int col) { return (((row >> 5) * 8 + (col >> 4)) << 9) + ((row & 31) << 4) + (col & 15); }
__device__ __forceinline__ int mx_unit(int bid, int G, int k, int off) { const int kmain = 528 / G, nmain = kmain * G; if (k < kmain) return bid + k * G; if (k == kmain) { const int j = bid - off; return (j >= 0 && j < 528 - nmain) ? nmain + j : -1; } return -1; }

constexpr int CONV_RUN = 26;
__device__ __forceinline__ int conv_seg(int row) { return row < NLAT ? row / SEQ : 2 + (row - NLAT) / CTXL; }
__device__ __forceinline__ void conv_unpack(u32x4 v, float (&f)[8]) {
#pragma unroll
    for (int e = 0; e < 4; ++e) { f[2 * e] = __uint_as_float(v[e] << 16); f[2 * e + 1] = __uint_as_float(v[e] & 0xffff0000u); } }
__device__ __forceinline__ void conv_phase(Ctx& F, const Args& a) {
    const bf16_t* XBC = (const bf16_t*)(F.ws + WS_XBC); bf16_t* XC = (bf16_t*)(F.ws + WS_XC);
    const float* cw = a.in[I_CONVW]; const float* cb = a.in[I_CONVB];
    constexpr int NRUN = (NTOK + CONV_RUN - 1) / CONV_RUN;
    for (int it = F.bid * NTHREADS + F.tid; it < NRUN * 192; it += F.G * NTHREADS) {
        const int c8 = (it % 192) * 8, r0 = (it / 192) * CONV_RUN, r1 = (r0 + CONV_RUN < NTOK) ? r0 + CONV_RUN : NTOK;
        float w[4][8], bias[8];
#pragma unroll
        for (int j = 0; j < 4; ++j) { const f32x4 w0 = *(const f32x4*)(cw + j * 1536 + c8), w1 = *(const f32x4*)(cw + j * 1536 + c8 + 4); w[j][0] = w0[0]; w[j][1] = w0[1]; w[j][2] = w0[2]; w[j][3] = w0[3]; w[j][4] = w1[0]; w[j][5] = w1[1]; w[j][6] = w1[2]; w[j][7] = w1[3]; }
        { const f32x4 b0 = *(const f32x4*)(cb + c8), b1 = *(const f32x4*)(cb + c8 + 4); bias[0] = b0[0]; bias[1] = b0[1]; bias[2] = b0[2]; bias[3] = b0[3]; bias[4] = b1[0]; bias[5] = b1[1]; bias[6] = b1[2]; bias[7] = b1[3]; }
        const u32x4 zero = {0u, 0u, 0u, 0u};
        const bf16_t* base = XBC + c8;
        u32x4 xm2 = r0 >= 2 ? *(const u32x4*)(base + (size_t)(r0 - 2) * 1536) : zero, xm1 = r0 >= 1 ? *(const u32x4*)(base + (size_t)(r0 - 1) * 1536) : zero;
        u32x4 x0 = *(const u32x4*)(base + (size_t)r0 * 1536), xp1 = r0 + 1 < NTOK ? *(const u32x4*)(base + (size_t)(r0 + 1) * 1536) : zero;
        for (int r = r0; r < r1; ++r) {
            const u32x4 xp2 = r + 2 < NTOK ? *(const u32x4*)(base + (size_t)(r + 2) * 1536) : zero;
            const int sg = conv_seg(r);
            const bool v0 = r >= 2 && conv_seg(r - 2) == sg, v1 = r >= 1 && conv_seg(r - 1) == sg, v3 = r + 1 < NTOK && conv_seg(r + 1) == sg;
            float f0[8], f1[8], f2[8], f3[8]; conv_unpack(xm2, f0); conv_unpack(xm1, f1); conv_unpack(x0, f2); conv_unpack(xp1, f3);
            float acc[8];
#pragma unroll
            for (int e = 0; e < 8; ++e) acc[e] = bias[e] + (v0 ? w[0][e] * f0[e] : 0.f) + (v1 ? w[1][e] * f1[e] : 0.f) + w[2][e] * f2[e] + (v3 ? w[3][e] * f3[e] : 0.f);
            u32x4 o; o[0] = pk2(siluf(acc[0]), siluf(acc[1])); o[1] = pk2(siluf(acc[2]), siluf(acc[3])); o[2] = pk2(siluf(acc[4]), siluf(acc[5])); o[3] = pk2(siluf(acc[6]), siluf(acc[7]));
            *(u32x4*)(XC + (size_t)r * 1536 + c8) = o;
            xm2 = xm1; xm1 = x0; x0 = xp1; xp1 = xp2;
        }
    }
}

struct MlGate { float b0, b1, G0, G1, total; };
__device__ __forceinline__ MlGate ml_gate(const float* GATES, int row0, int dir, int h, int lane) {
    const float* g0 = GATES + (size_t)(row0 + 2 * lane) * NGATE; const float* g1 = g0 + NGATE;
    const float lf0 = g0[8 + dir * 4 + h], lf1 = g1[8 + dir * 4 + h], ig0 = g0[dir * 4 + h], ig1 = g1[dir * 4 + h];
    const float incl = wave_incl_sum(lf0 + lf1, lane), total = __shfl(incl, 63);
    MlGate r; r.total = total;
    if (dir == 0) { r.b0 = incl - lf1; r.b1 = incl; } else { r.b0 = total - incl + lf0 + lf1; r.b1 = total - incl + lf1; }
    r.G0 = ig0 - r.b0; r.G1 = ig1 - r.b1; return r;
}


__device__ __forceinline__ void mlstm_a_phase(Ctx& F, int off) {
    const bf16_t* QK = (const bf16_t*)(F.ws + WS_QK); const bf16_t* V = (const bf16_t*)(F.ws + WS_V); const float* GATES = (const float*)(F.ws + WS_GATES);
    bf16_t* DC = (bf16_t*)(F.ws + WS_DC); float* DN = (float*)(F.ws + WS_DN); float* MS = (float*)(F.ws + WS_MS);
    LAS unsigned char* Vt = F.lds; LAS unsigned char* Kw = F.lds + 65536;
    LAS float* wsc = (LAS float*)(F.lds + MX_MISC); LAS float* dnp = (LAS float*)(F.lds + MX_MISC + 1024);
    for (int k_ = 0;; ++k_) { const int u = mx_unit(F.bid, F.G, k_, off); if (u < 0) break;
        const int lane = fresh_lane(), tid = F.wave * 64 + lane, r32 = lane & 31, hi = lane >> 5, sr = tid >> 4, sc8 = (tid & 15) * 8, rdb = attn::v_rd_base(lane);
        const int b = u / 264, rem = u % 264, cid = rem >> 2, h = rem & 3, row0 = chunk_row0(b, cid);
        if (F.wave < 2) { const int dir = F.wave, chain = (b * 4 + h) * 2 + dir; typedef float f32x2v __attribute__((ext_vector_type(2)));
            *(LAS f32x2v*)(wsc + dir * 128 + 2 * lane) = *(const f32x2v*)((const float*)(F.ws + WS_MLG) + (size_t)(chain * NCH + cid) * 512 + 384 + 2 * lane); }
        __syncthreads();
        float dnacc[2][8];
#pragma unroll
        for (int d = 0; d < 2; ++d)
#pragma unroll
            for (int e = 0; e < 8; ++e) dnacc[d][e] = 0.f;
#pragma unroll
        for (int i = 0; i < 4; ++i) { const int s = sr + 32 * i; const size_t grow = (size_t)(row0 + s) * 1024;
#pragma unroll
            for (int vb = 0; vb < 2; ++vb) { const u32x4 v = *(const u32x4*)(V + grow + h * 256 + vb * 128 + sc8); *(LAS u32x4*)(Vt + ((s >> 6) * 2 + vb) * 16384 + attn::v_st(s & 63, sc8)) = v; }
            const u32x4 kv = *(const u32x4*)(QK + grow + 512 + h * 128 + sc8);
#pragma unroll
            for (int d = 0; d < 2; ++d) { const float w = wsc[d * 128 + s];
                *(LAS u32x4*)(Kw + (d * 2 + (s >> 6)) * 16384 + attn::v_st(s & 63, sc8)) = scale8(kv, w);
#pragma unroll
                for (int e = 0; e < 4; ++e) { dnacc[d][2 * e] += w * __uint_as_float(kv[e] << 16); dnacc[d][2 * e + 1] += w * __uint_as_float(kv[e] & 0xffff0000u); } } }
#pragma unroll
        for (int d = 0; d < 2; ++d)
#pragma unroll
            for (int e = 0; e < 8; ++e) { float t = dnacc[d][e]; t += __shfl_xor(t, 16); t += __shfl_xor(t, 32); if ((lane >> 4) == 0) dnp[(F.wave * 2 + d) * 128 + sc8 + e] = t; }
        __syncthreads();
        {   const int dir = F.wave >> 2, vq = F.wave & 3;
            f32x16 acc[2][4];
#pragma unroll
            for (int i = 0; i < 2; ++i)
#pragma unroll
                for (int n = 0; n < 4; ++n) acc[i][n] = f32x16{};
#pragma unroll
            for (int ks = 0; ks < 8; ++ks) { const int sblk = ks >> 2, KS = ks & 3;
                bf16x8 af[2], bfr[4];
#pragma unroll
                for (int i = 0; i < 2; ++i) af[i] = trfrag(Vt + (sblk * 2 + (vq >> 1)) * 16384 + rdb, (2 * vq + i) & 3, KS);
#pragma unroll
                for (int n = 0; n < 4; ++n) bfr[n] = trfrag(Kw + (dir * 2 + sblk) * 16384 + rdb, n, KS);
#pragma unroll
                for (int i = 0; i < 2; ++i)
#pragma unroll
                    for (int n = 0; n < 4; ++n) acc[i][n] = __builtin_amdgcn_mfma_f32_32x32x16_bf16(af[i], bfr[n], acc[i][n], 0, 0, 0); }
            const int chain = (b * 4 + h) * 2 + dir;
            bf16_t* dst = DC + (size_t)(chain * NCH + cid) * 256 * 128;
#pragma unroll
            for (int i = 0; i < 2; ++i)
#pragma unroll
                for (int n = 0; n < 4; ++n)
#pragma unroll
                    for (int r = 0; r < 16; ++r) dst[st_off(64 * vq + 32 * i + attn::crow(r, hi), 32 * n + r32)] = f2bf(acc[i][n][r]);
        }
        if (tid < 256) { const int dir = tid >> 7, d = tid & 127; float s = 0.f;
#pragma unroll
            for (int w = 0; w < 8; ++w) s += dnp[(w * 2 + dir) * 128 + d];
            const int chain = (b * 4 + h) * 2 + dir; DN[(size_t)(chain * NCH + cid) * 128 + d] = s; }
        __syncthreads();
    }
}

struct SsGate { float dt0, dt1, acs0, acs1, total; };
__device__ __forceinline__ SsGate ss_gate(const float* GATES, int row0, int dir, int head, float aneg, int lane) {
    const float* g0 = GATES + (size_t)(row0 + 2 * lane) * NGATE; const float* g1 = g0 + NGATE;
    SsGate r; r.dt0 = g0[16 + dir * 16 + head]; r.dt1 = g1[16 + dir * 16 + head];
    const float a0 = r.dt0 * aneg, a1 = r.dt1 * aneg;
    const float incl = wave_incl_sum(a0 + a1, lane); r.total = __shfl(incl, 63);
    if (dir == 0) { r.acs0 = incl - a1; r.acs1 = incl; } else { r.acs0 = r.total - incl + a0 + a1; r.acs1 = r.total - incl + a1; }
    return r;
}
__device__ __forceinline__ void gatescan_phase(Ctx& F, const Args& a) {
    const float* GATES = (const float*)(F.ws + WS_GATES); float* MLG = (float*)(F.ws + WS_MLG); float* SSG = (float*)(F.ws + WS_SSG);
    float* MS = (float*)(F.ws + WS_MS); float* AEND = (float*)(F.ws + WS_AEND);
    typedef float f32x2v __attribute__((ext_vector_type(2)));
    const int lane = F.lane;
    for (int it = GWID(F); it < 16 * NCH + 64 * NCH; it += NGW(F)) {
        if (it < 16 * NCH) { const int chain = it / NCH, cid = it % NCH, dir = chain & 1, h = (chain >> 1) & 3, b = chain >> 3, row0 = chunk_row0(b, cid);
            const MlGate g = ml_gate(GATES, row0, dir, h, lane);
            const float gmx = fmaxf(g.G0, g.G1), gm = wave_max(gmx); float P0, P1;
            if (dir == 0) { const float pm = wave_incl_max(gmx, lane); float ex = __shfl_up(pm, 1); if (lane == 0) ex = -1e30f; P0 = fmaxf(ex, g.G0); P1 = pm; }
            else { const float pm = wave_incl_max_rev(gmx, lane); float ex = __shfl_down(pm, 1); if (lane == 63) ex = -1e30f; P1 = fmaxf(ex, g.G1); P0 = pm; }
            float* o = MLG + (size_t)it * 512 + 2 * lane;
            *(f32x2v*)(o) = (f32x2v){g.b0, g.b1}; *(f32x2v*)(o + 128) = (f32x2v){g.G0, g.G1}; *(f32x2v*)(o + 256) = (f32x2v){P0, P1}; *(f32x2v*)(o + 384) = (f32x2v){expf(g.G0 - gm), expf(g.G1 - gm)};
            if (lane == 0) { MS[it * 4 + 0] = g.total; MS[it * 4 + 1] = g.total + gm; } }
        else { const int i2 = it - 16 * NCH, chain = i2 / NCH, cid = i2 % NCH, dir = chain & 1, head = (chain >> 1) & 15, b = chain >> 5, row0 = chunk_row0(b, cid);
            const float aneg = -expf(a.in[I_ALOG][dir * 16 + head]); const SsGate s = ss_gate(GATES, row0, dir, head, aneg, lane);
            float* o = SSG + (size_t)i2 * 384 + 2 * lane;
            *(f32x2v*)(o) = (f32x2v){s.acs0, s.acs1}; *(f32x2v*)(o + 128) = (f32x2v){s.dt0, s.dt1}; *(f32x2v*)(o + 256) = (f32x2v){s.dt0 * expf(s.total - s.acs0), s.dt1 * expf(s.total - s.acs1)};
            if (lane == 0) AEND[i2] = s.total; }
    }
}
template <bool BM_ROW> __device__ __forceinline__ void ssd_stage(Ctx& F, const bf16_t* XC, int row0, int g, int hh, LAS unsigned char* Xt, LAS unsigned char* Bt) {
    const int tid_ = F.wave * 64 + fresh_lane(), sr = tid_ >> 4, sc8 = (tid_ & 15) * 8;
#pragma unroll
    for (int i = 0; i < 4; ++i) { const int s = sr + 32 * i; const bf16_t* rowp = XC + (size_t)(row0 + s) * 1536;
#pragma unroll
        for (int cb = 0; cb < 2; ++cb) { const u32x4 v = *(const u32x4*)(rowp + (g * 8 + hh * 4) * 64 + cb * 128 + sc8); *(LAS u32x4*)(Xt + ((s >> 6) * 2 + cb) * 16384 + attn::v_st(s & 63, sc8)) = v; }
        const u32x4 bv = *(const u32x4*)(rowp + 1024 + g * 128 + sc8);
        if (BM_ROW) *(LAS u32x4*)(Bt + (s >> 6) * 16384 + KSWZ(s & 63, sc8 * 2)) = bv; else *(LAS u32x4*)(Bt + (s >> 6) * 16384 + attn::v_st(s & 63, sc8)) = bv; }
}
__device__ __forceinline__ void ssd_a_phase(Ctx& F, const Args& a, int off) {
    const bf16_t* XC = (const bf16_t*)(F.ws + WS_XC); const float* GATES = (const float*)(F.ws + WS_GATES);
    bf16_t* DS = (bf16_t*)(F.ws + WS_DS); float* AEND = (float*)(F.ws + WS_AEND);
    LAS unsigned char* Xt = F.lds; LAS unsigned char* Bt = F.lds + 65536;
    LAS float* wtl = (LAS float*)(F.lds + MX_MISC);
    for (int k_ = 0;; ++k_) { const int u = mx_unit(F.bid, F.G, k_, off); if (u < 0) break;
        const int lane = fresh_lane(), r32 = lane & 31, hi = lane >> 5, rdb = attn::v_rd_base(lane);
        const int b = u / 264, rem = u % 264, cid = rem >> 2, g = (rem >> 1) & 1, hh = rem & 1, row0 = chunk_row0(b, cid);
        const int dir = F.wave >> 2, j = F.wave & 3, head = g * 8 + hh * 4 + j, chain = (b * 16 + head) * 2 + dir;
        { typedef float f32x2v __attribute__((ext_vector_type(2)));
          *(LAS f32x2v*)(wtl + F.wave * 128 + 2 * lane) = *(const f32x2v*)((const float*)(F.ws + WS_SSG) + (size_t)(chain * NCH + cid) * 384 + 256 + 2 * lane); }
        ssd_stage<false>(F, XC, row0, g, hh, Xt, Bt);
        __syncthreads();
        f32x16 acc[2][4];
#pragma unroll
        for (int i = 0; i < 2; ++i)
#pragma unroll
            for (int n = 0; n < 4; ++n) acc[i][n] = f32x16{};
#pragma unroll
        for (int ks = 0; ks < 8; ++ks) { const int sblk = ks >> 2, KS = ks & 3;
            const f32x4 w0 = *(const LAS f32x4*)(wtl + F.wave * 128 + 16 * ks + 8 * hi), w1 = *(const LAS f32x4*)(wtl + F.wave * 128 + 16 * ks + 8 * hi + 4);
            bf16x8 af[2], bfr[4];
#pragma unroll
            for (int i = 0; i < 2; ++i) { const u32x4 x = __builtin_bit_cast(u32x4, trfrag(Xt + (sblk * 2 + (j >> 1)) * 16384 + rdb, (j & 1) * 2 + i, KS)); u32x4 o;
                o[0] = pk2(__uint_as_float(x[0] << 16) * w0[0], __uint_as_float(x[0] & 0xffff0000u) * w0[1]); o[1] = pk2(__uint_as_float(x[1] << 16) * w0[2], __uint_as_float(x[1] & 0xffff0000u) * w0[3]);
                o[2] = pk2(__uint_as_float(x[2] << 16) * w1[0], __uint_as_float(x[2] & 0xffff0000u) * w1[1]); o[3] = pk2(__uint_as_float(x[3] << 16) * w1[2], __uint_as_float(x[3] & 0xffff0000u) * w1[3]);
                af[i] = __builtin_bit_cast(bf16x8, o); }
#pragma unroll
            for (int n = 0; n < 4; ++n) bfr[n] = trfrag(Bt + sblk * 16384 + rdb, n, KS);
#pragma unroll
            for (int i = 0; i < 2; ++i)
#pragma unroll
                for (int n = 0; n < 4; ++n) acc[i][n] = __builtin_amdgcn_mfma_f32_32x32x16_bf16(af[i], bfr[n], acc[i][n], 0, 0, 0); }
        bf16_t* dst = DS + (size_t)(chain * NCH + cid) * 64 * 128;
#pragma unroll
        for (int i = 0; i < 2; ++i)
#pragma unroll
            for (int n = 0; n < 4; ++n)
#pragma unroll
                for (int r = 0; r < 16; ++r) dst[st_off(32 * i + attn::crow(r, hi), 32 * n + r32)] = f2bf(acc[i][n][r]);
        __syncthreads();
    }
}

__device__ __forceinline__ void scan_phase(Ctx& F) {
    LAS float* sa = (LAS float*)(F.lds + MX_MISC); LAS float* ss = sa + 80;
    for (int vb = F.bid; vb < 256; vb += F.G) {
        __syncthreads();
        if (vb < 128) {
            const int chain = vb >> 3, dir = chain & 1; float* MS = (float*)(F.ws + WS_MS) + (size_t)chain * NCH * 4;
            LAS float* sbe = ss + 80; LAS float* sgm = sbe + 80;
            if (F.tid < NCH) { const int cid = scan_cid(dir, F.tid); sbe[F.tid] = MS[cid * 4 + 0]; sgm[F.tid] = MS[cid * 4 + 1]; }
            __syncthreads();
            if (F.tid == 0) { float m = 0.f;
                for (int p = 0; p < NCH; ++p) { const float be = sbe[p], gm = sgm[p];
                    const float mn = fmaxf(be + m, gm); sa[p] = expf(be + m - mn); ss[p] = expf(gm - mn); if ((vb & 7) == 0) MS[scan_cid(dir, p) * 4 + 2] = m; m = mn; } }
            __syncthreads();
            {   bf16_t* base = (bf16_t*)(F.ws + WS_DC) + (size_t)chain * NCH * 32768 + ((size_t)(vb & 7) * 512 + F.tid) * 8;
                u32x4 buf[8]; float run[8];
#pragma unroll
                for (int e = 0; e < 8; ++e) run[e] = 0.f;
#pragma unroll
                for (int k = 0; k < 8; ++k) buf[k] = *(const u32x4*)(base + (size_t)scan_cid(dir, k) * 32768);
                for (int p0 = 0; p0 < 72; p0 += 8) {
#pragma unroll
                    for (int k = 0; k < 8; ++k) { const int p = p0 + k;
                        if (p < NCH) { const u32x4 d = buf[k]; bf16_t* loc = base + (size_t)scan_cid(dir, p) * 32768;
                            if (p + 8 < NCH) buf[k] = *(const u32x4*)(base + (size_t)scan_cid(dir, p + 8) * 32768);
                            u32x4 o; o[0] = pk2(run[0], run[1]); o[1] = pk2(run[2], run[3]); o[2] = pk2(run[4], run[5]); o[3] = pk2(run[6], run[7]);
                            *(u32x4*)loc = o;
                            const float av = sa[p], sv = ss[p];
#pragma unroll
                            for (int e = 0; e < 4; ++e) { run[2 * e] = av * run[2 * e] + sv * __uint_as_float(d[e] << 16); run[2 * e + 1] = av * run[2 * e + 1] + sv * __uint_as_float(d[e] & 0xffff0000u); } } }
                }
            }
            if ((vb & 7) == 0 && F.tid < 32) {
                float* nb = (float*)(F.ws + WS_DN) + (size_t)chain * NCH * 128 + F.tid * 4;
                f32x4 buf[8]; f32x4 run = {0.f, 0.f, 0.f, 0.f};
#pragma unroll
                for (int k = 0; k < 8; ++k) buf[k] = *(const f32x4*)(nb + (size_t)scan_cid(dir, k) * 128);
                for (int p0 = 0; p0 < 72; p0 += 8) {
#pragma unroll
                    for (int k = 0; k < 8; ++k) { const int p = p0 + k;
                        if (p < NCH) { const f32x4 d = buf[k]; float* loc = nb + (size_t)scan_cid(dir, p) * 128;
                            if (p + 8 < NCH) buf[k] = *(const f32x4*)(nb + (size_t)scan_cid(dir, p + 8) * 128);
                            *(f32x4*)loc = run; run = sa[p] * run + ss[p] * d; } }
                }
            }
        } else {
            const int chain = (vb - 128) >> 1, dir = chain & 1; const float* AEND = (const float*)(F.ws + WS_AEND) + (size_t)chain * NCH;
            if (F.tid < NCH) sa[F.tid] = expf(AEND[scan_cid(dir, F.tid)]);
            __syncthreads();
            bf16_t* base = (bf16_t*)(F.ws + WS_DS) + (size_t)chain * NCH * 8192 + ((size_t)(vb & 1) * 512 + F.tid) * 8;
            u32x4 buf[8]; float run[8];
#pragma unroll
            for (int e = 0; e < 8; ++e) run[e] = 0.f;
#pragma unroll
            for (int k = 0; k < 8; ++k) buf[k] = *(const u32x4*)(base + (size_t)scan_cid(dir, k) * 8192);
            for (int p0 = 0; p0 < 72; p0 += 8) {
#pragma unroll
                for (int k = 0; k < 8; ++k) { const int p = p0 + k;
                    if (p < NCH) { const u32x4 d = buf[k]; bf16_t* loc = base + (size_t)scan_cid(dir, p) * 8192;
                        if (p + 8 < NCH) buf[k] = *(const u32x4*)(base + (size_t)scan_cid(dir, p + 8) * 8192);
                        u32x4 o; o[0] = pk2(run[0], run[1]); o[1] = pk2(run[2], run[3]); o[2] = pk2(run[4], run[5]); o[3] = pk2(run[6], run[7]);
                        *(u32x4*)loc = o;
                        const float av = sa[p];
#pragma unroll
                        for (int e = 0; e < 4; ++e) { run[2 * e] = av * run[2 * e] + __uint_as_float(d[e] << 16); run[2 * e + 1] = av * run[2 * e + 1] + __uint_as_float(d[e] & 0xffff0000u); } } }
            }
        }
    }
}


template <bool DIAG> __device__ __forceinline__ void ml_block(const f32x16& S, const LAS float* Gp, float Mt, float sgn, float sb, float scale, f32x16& out) {
#pragma unroll
    for (int g4 = 0; g4 < 4; ++g4) { const f32x4 Gv = *(const LAS f32x4*)(Gp + 8 * g4);
#pragma unroll
        for (int e = 0; e < 4; ++e) { float arg = (Gv[e] - Mt) * LOG2E;
            if (DIAG) arg = fmaf(fminf(fmaf(-sgn, (float)(8 * g4 + e), sb), 0.f), 1e30f, arg);
            out[4 * g4 + e] = S[4 * g4 + e] * __builtin_amdgcn_exp2f(arg) * scale; } }
}
template <bool DIAG> __device__ __forceinline__ void ss_block(const f32x16& S, const LAS float* ap, const LAS float* dp, float At, float sgn, float sb, f32x16& out) {
#pragma unroll
    for (int g4 = 0; g4 < 4; ++g4) { const f32x4 av = *(const LAS f32x4*)(ap + 8 * g4), dv = *(const LAS f32x4*)(dp + 8 * g4);
#pragma unroll
        for (int e = 0; e < 4; ++e) { float arg = (At - av[e]) * LOG2E;
            if (DIAG) arg = fmaf(fminf(fmaf(-sgn, (float)(8 * g4 + e), sb), 0.f), 1e30f, arg);
            out[4 * g4 + e] = S[4 * g4 + e] * __builtin_amdgcn_exp2f(arg) * dv[e]; } }
}
__device__ __forceinline__ float sum16(const f32x16& v) { float s = 0.f;
#pragma unroll
    for (int r = 0; r < 16; ++r) s += v[r];
    return s; }
template <int VAR> __device__ __forceinline__ void mlstm_c_phase(Ctx& F, const Args& a, int off) {
    const bf16_t* QK = (const bf16_t*)(F.ws + WS_QK); const bf16_t* V = (const bf16_t*)(F.ws + WS_V); const bf16_t* OG = (const bf16_t*)(F.ws + WS_O); const float* GATES = (const float*)(F.ws + WS_GATES);
    const bf16_t* DC = (const bf16_t*)(F.ws + WS_DC); const float* DN = (const float*)(F.ws + WS_DN); const float* MS = (const float*)(F.ws + WS_MS); bf16_t* MIX = VAR ? (bf16_t*)(F.ws + WS_END) : (bf16_t*)(F.ws + WS_MIX);
    LAS unsigned char* Kt = F.lds; LAS unsigned char* Vt = F.lds + 32768; LAS float* stat = (LAS float*)(F.lds + MX_MISC + 5120);
    LAS float* Gs = (LAS float*)(F.lds + MX_MISC); LAS float* Ms = Gs + 256; LAS float* Bs = Gs + 512; LAS float* ns = Gs + 768; LAS float* mst = Gs + 1024;
    for (int k_ = 0;; ++k_) { const int u = mx_unit(F.bid, F.G, k_, off); if (u < 0) break;
        const int lane = fresh_lane(), tid = F.wave * 64 + lane, r32 = lane & 31, hi = lane >> 5, sr = tid >> 4, sc8 = (tid & 15) * 8, rdb = attn::v_rd_base(lane);
        const int b = u / 264, rem = u % 264, cid = rem >> 2, h = rem & 3, row0 = chunk_row0(b, cid);
        if (F.wave < 2) { const int dir = F.wave, chain = (b * 4 + h) * 2 + dir; typedef float f32x2v __attribute__((ext_vector_type(2)));
            const float* gsrc = (const float*)(F.ws + WS_MLG) + (size_t)(chain * NCH + cid) * 512 + 2 * lane;
            const f32x2v bb = *(const f32x2v*)gsrc, GG = *(const f32x2v*)(gsrc + 128), PP = *(const f32x2v*)(gsrc + 256);
            const float m0 = MS[(chain * NCH + cid) * 4 + 2];
            *(LAS f32x2v*)(Gs + dir * 128 + 2 * lane) = GG; *(LAS f32x2v*)(Ms + dir * 128 + 2 * lane) = (f32x2v){fmaxf(PP[0], m0), fmaxf(PP[1], m0)}; *(LAS f32x2v*)(Bs + dir * 128 + 2 * lane) = bb;
            const float* nsrc = DN + (size_t)(chain * NCH + cid) * 128; ns[dir * 128 + 2 * lane] = nsrc[2 * lane]; ns[dir * 128 + 2 * lane + 1] = nsrc[2 * lane + 1];
            if (lane == 0) mst[dir] = m0; }
#pragma unroll
        for (int i = 0; i < 4; ++i) { const int s = sr + 32 * i; const size_t grow = (size_t)(row0 + s) * 1024;
#pragma unroll
            for (int vb = 0; vb < 2; ++vb) { const u32x4 v = *(const u32x4*)(V + grow + h * 256 + vb * 128 + sc8); *(LAS u32x4*)(Vt + ((s >> 6) * 2 + vb) * 16384 + attn::v_st(s & 63, sc8)) = v; }
            const u32x4 kv = *(const u32x4*)(QK + grow + 512 + h * 128 + sc8);
            *(LAS u32x4*)(Kt + (s >> 6) * 16384 + KSWZ(s & 63, sc8 * 2)) = kv; }
        __syncthreads();
        const int tq = F.wave & 3, vh = F.wave >> 2, tau = 32 * tq + r32;
        const bf16_t* qptr = QK + (size_t)(row0 + tau) * 1024 + h * 128 + hi * 8;
        f32x16 pS[2][2];
        {   bf16x8 qr[8];
#pragma unroll
        for (int d0 = 0; d0 < 8; ++d0) qr[d0] = *(const bf16x8*)(qptr + d0 * 16);
#pragma unroll
        for (int j = 0; j < 2; ++j)
#pragma unroll
            for (int blk = 0; blk < 2; ++blk) { pS[j][blk] = f32x16{};
#pragma unroll
                for (int d0 = 0; d0 < 8; ++d0) pS[j][blk] = __builtin_amdgcn_mfma_f32_32x32x16_bf16(rowfrag(Kt + j * 16384, blk, d0, r32, hi), qr[d0], pS[j][blk], 0, 0, 0); }
        }
        f32x16 o[4];
#pragma unroll
        for (int d = 0; d < 4; ++d) o[d] = f32x16{};
        float qsc0 = 0.f, qsc1 = 0.f;
        if (VAR < 3)
#pragma unroll 1
        for (int dir = 0; dir < 2; ++dir) {
            const float Mt = Ms[dir * 128 + tau], m0 = mst[dir];
            const float sgn = dir ? -1.f : 1.f, sb = sgn * (float)(r32 - 4 * hi);
            float rs = 0.f;
#pragma unroll
            for (int j = 0; j < 2; ++j)
#pragma unroll
                for (int blk = 0; blk < 2; ++blk) { const int kb = 2 * j + blk; const bool vis = dir ? (kb >= tq) : (kb <= tq);
                    if (vis) { f32x16 pp; const LAS float* Gp = Gs + dir * 128 + 32 * kb + 4 * hi;
                        if (kb == tq) ml_block<true>(pS[j][blk], Gp, Mt, sgn, sb, 1.f, pp); else ml_block<false>(pS[j][blk], Gp, Mt, sgn, sb, 1.f, pp);
                        rs += sum16(pp); } }
            rs = half_swap_add(rs);
            float qn = 0.f; const bf16_t* qp2 = launder_v(qptr);
#pragma unroll
            for (int d0 = 0; d0 < 8; ++d0) { const bf16x8 qv = *(const bf16x8*)(qp2 + d0 * 16); const f32x4 n0 = *(const LAS f32x4*)(ns + dir * 128 + 16 * d0 + 8 * hi), n1 = *(const LAS f32x4*)(ns + dir * 128 + 16 * d0 + 8 * hi + 4);
                const u32x4 q = __builtin_bit_cast(u32x4, qv);
                qn += __uint_as_float(q[0] << 16) * n0[0] + __uint_as_float(q[0] & 0xffff0000u) * n0[1] + __uint_as_float(q[1] << 16) * n0[2] + __uint_as_float(q[1] & 0xffff0000u) * n0[3]
                    + __uint_as_float(q[2] << 16) * n1[0] + __uint_as_float(q[2] & 0xffff0000u) * n1[1] + __uint_as_float(q[3] << 16) * n1[2] + __uint_as_float(q[3] & 0xffff0000u) * n1[3]; }
            qn = half_swap_add(qn);
            const float ain = expf(m0 - Mt), den = rs + ain * qn;
            const float inv = __builtin_amdgcn_rcpf(fmaxf(fabsf(den), expf(-(Bs[dir * 128 + tau] + Mt))));
#pragma unroll
            for (int j = 0; j < 2; ++j)
#pragma unroll
                for (int blk = 0; blk < 2; ++blk) { const int kb = 2 * j + blk; const bool vis = dir ? (kb >= tq) : (kb <= tq);
                    if (vis) { f32x16 pp; const LAS float* Gp = Gs + dir * 128 + 32 * kb + 4 * hi;
                        if (kb == tq) ml_block<true>(pS[j][blk], Gp, Mt, sgn, sb, inv, pp); else ml_block<false>(pS[j][blk], Gp, Mt, sgn, sb, inv, pp);
                        bf16x8 pa0, pa1;
                        MX_PK4(pp, 0, pa0); MX_PK4(pp, 8, pa1);
#pragma unroll
                        for (int d = 0; d < 4; ++d) { o[d] = __builtin_amdgcn_mfma_f32_32x32x16_bf16(pa0, trfrag(Vt + (j * 2 + vh) * 16384 + rdb, d, 2 * blk), o[d], 0, 0, 0);
                            o[d] = __builtin_amdgcn_mfma_f32_32x32x16_bf16(pa1, trfrag(Vt + (j * 2 + vh) * 16384 + rdb, d, 2 * blk + 1), o[d], 0, 0, 0); } } }
            if (dir == 0) qsc0 = ain * inv; else qsc1 = ain * inv;
        }
        if (VAR < 2) {   const bf16_t* Cb0 = DC + (size_t)(((b * 4 + h) * 2 + 0) * NCH + cid) * 256 * 128 + (size_t)(4 * vh) * 4096 + r32 * 16 + hi * 8;
            const bf16_t* Cb1 = Cb0 + (size_t)NCH * 256 * 128;
            const bf16_t* qp3 = launder_v(qptr);
            bf16x8 qr2[8];
#pragma unroll
            for (int d0 = 0; d0 < 8; ++d0) qr2[d0] = *(const bf16x8*)(qp3 + d0 * 16);
            bf16x8 cf[4][4];
#define MLC_LD(s_) do { _Pragma("unroll") for (int d = 0; d < 4; ++d) cf[(s_) & 3][d] = *(const bf16x8*)(((s_) < 8 ? Cb0 : Cb1) + d * 4096 + 512 * ((s_) & 7)); } while (0)
            MLC_LD(0); MLC_LD(1); MLC_LD(2);
            __builtin_amdgcn_sched_barrier(0);
#pragma unroll
            for (int st = 0; st < 16; ++st) {
                if (st + 3 < 16) MLC_LD(st + 3);
                const bf16x8 qs = scale8f(qr2[st & 7], st < 8 ? qsc0 : qsc1);
#pragma unroll
                for (int d = 0; d < 4; ++d) o[d] = __builtin_amdgcn_mfma_f32_32x32x16_bf16(qs, cf[st & 3][d], o[d], 0, 0, 0);
                __builtin_amdgcn_sched_barrier(0); }
#undef MLC_LD
        }
        float s1[16], s2[16];
#pragma unroll
        for (int r = 0; r < 16; ++r) { float x = 0.f, y = 0.f;
#pragma unroll
            for (int d = 0; d < 4; ++d) { x += o[d][r]; y += o[d][r] * o[d][r]; }
#pragma unroll
            for (int of = 1; of < 32; of <<= 1) { x += __shfl_xor(x, of); y += __shfl_xor(y, of); }
            s1[r] = x; s2[r] = y; }
        if (r32 == 0) {
#pragma unroll
            for (int r = 0; r < 16; ++r) { const int row = 32 * tq + attn::crow(r, hi); stat[(vh * 128 + row) * 2] = s1[r]; stat[(vh * 128 + row) * 2 + 1] = s2[r]; } }
        __syncthreads();
        {
            LAS float* ot = (LAS float*)(F.lds + F.wave * 16384);
            float gg[4];
#pragma unroll
            for (int d = 0; d < 4; ++d) gg[d] = a.in[I_MNG][h * 256 + 128 * vh + 32 * d + r32];
#pragma unroll
            for (int r = 0; r < 16; ++r) { const int lrow = attn::crow(r, hi), row = 32 * tq + lrow;
                const float t1 = stat[row * 2] + stat[(128 + row) * 2], t2 = stat[row * 2 + 1] + stat[(128 + row) * 2 + 1];
                const float mu = t1 * (1.f / 256.f), rstd = rsqrtf(fmaxf(t2 * (1.f / 256.f) - mu * mu, 0.f) + 1e-5f);
#pragma unroll
                for (int d = 0; d < 4; ++d) ot[lrow * 128 + 32 * d + r32] = (o[d][r] - mu) * rstd * gg[d]; }
            asm volatile("s_waitcnt lgkmcnt(0)" ::: "memory");
#pragma unroll
            for (int i = 0; i < 8; ++i) { const int ch = lane + 64 * i, lrow = ch >> 4, c8 = (ch & 15) * 8;
                const f32x4 v0 = *(const LAS f32x4*)(ot + lrow * 128 + c8), v1 = *(const LAS f32x4*)(ot + lrow * 128 + c8 + 4);
                const size_t grow = (size_t)(row0 + 32 * tq + lrow); const int col = h * 256 + 128 * vh + c8;
                const u32x4 og = *(const u32x4*)(OG + grow * 1024 + col);
                u32x4 w; w[0] = pk2(v0[0] * sigmf(__uint_as_float(og[0] << 16)), v0[1] * sigmf(__uint_as_float(og[0] & 0xffff0000u))); w[1] = pk2(v0[2] * sigmf(__uint_as_float(og[1] << 16)), v0[3] * sigmf(__uint_as_float(og[1] & 0xffff0000u)));
                w[2] = pk2(v1[0] * sigmf(__uint_as_float(og[2] << 16)), v1[1] * sigmf(__uint_as_float(og[2] & 0xffff0000u))); w[3] = pk2(v1[2] * sigmf(__uint_as_float(og[3] << 16)), v1[3] * sigmf(__uint_as_float(og[3] & 0xffff0000u)));
                *(u32x4*)(MIX + (VAR ? (grow & 4095) : grow) * 2048 + 1024 + col) = w; }
        }
        __syncthreads();
    }
}

__device__ __forceinline__ void ssd_c_phase(Ctx& F, const Args& a, int off) {
    const bf16_t* XC = (const bf16_t*)(F.ws + WS_XC); const bf16_t* Z = (const bf16_t*)(F.ws + WS_Z); const float* GATES = (const float*)(F.ws + WS_GATES);
    const bf16_t* DS = (const bf16_t*)(F.ws + WS_DS); bf16_t* MIX = (bf16_t*)(F.ws + WS_MIX); float* SSQ = (float*)(F.ws + WS_SSQ);
    LAS unsigned char* Bt = F.lds; LAS unsigned char* Xt = F.lds + 32768;
    LAS float* acsl = (LAS float*)(F.lds + MX_MISC); LAS float* dtl = acsl + 1024;
    for (int k_ = 0;; ++k_) { const int u = mx_unit(F.bid, F.G, k_, off); if (u < 0) break;
        const int lane = fresh_lane(), r32 = lane & 31, hi = lane >> 5, rdb = attn::v_rd_base(lane);
        const int b = u / 264, rem = u % 264, cid = rem >> 2, g = (rem >> 1) & 1, hh = rem & 1, row0 = chunk_row0(b, cid);
        {   const int dir = F.wave >> 2, j = F.wave & 3, head = g * 8 + hh * 4 + j, chain = (b * 16 + head) * 2 + dir; typedef float f32x2v __attribute__((ext_vector_type(2)));
            const float* gsrc = (const float*)(F.ws + WS_SSG) + (size_t)(chain * NCH + cid) * 384 + 2 * lane; const int o = (j * 2 + dir) * 128 + 2 * lane;
            *(LAS f32x2v*)(acsl + o) = *(const f32x2v*)gsrc; *(LAS f32x2v*)(dtl + o) = *(const f32x2v*)(gsrc + 128); }
        ssd_stage<true>(F, XC, row0, g, hh, Xt, Bt);
        __syncthreads();
        const int tq = F.wave & 3, jp = F.wave >> 2, tau = 32 * tq + r32;
        const bf16_t* cptr = XC + (size_t)(row0 + tau) * 1536 + 1280 + g * 128 + hi * 8;
        f32x16 pS[2][2];
        {   bf16x8 cr[8];
#pragma unroll
        for (int d0 = 0; d0 < 8; ++d0) cr[d0] = *(const bf16x8*)(cptr + d0 * 16);
#pragma unroll
        for (int j = 0; j < 2; ++j)
#pragma unroll
            for (int blk = 0; blk < 2; ++blk) { pS[j][blk] = f32x16{};
#pragma unroll
                for (int d0 = 0; d0 < 8; ++d0) pS[j][blk] = __builtin_amdgcn_mfma_f32_32x32x16_bf16(rowfrag(Bt + j * 16384, blk, d0, r32, hi), cr[d0], pS[j][blk], 0, 0, 0); }
        }
        f32x16 y[2][2];
#pragma unroll
        for (int jj = 0; jj < 2; ++jj) { y[jj][0] = f32x16{}; y[jj][1] = f32x16{}; }
        float ea0 = 0.f, ea1 = 0.f, ea2 = 0.f, ea3 = 0.f;
#pragma unroll
        for (int jj = 0; jj < 2; ++jj) { const int hl = 2 * jp + jj;
#pragma unroll
            for (int dir = 0; dir < 2; ++dir) {
                const LAS float* ac = acsl + (hl * 2 + dir) * 128; const LAS float* dtp = dtl + (hl * 2 + dir) * 128;
                const float At = ac[tau];
                const float sgn = dir ? -1.f : 1.f, sb = sgn * (float)(r32 - 4 * hi);
#pragma unroll
                for (int j = 0; j < 2; ++j)
#pragma unroll
                    for (int blk = 0; blk < 2; ++blk) { const int kb = 2 * j + blk; const bool vis = dir ? (kb >= tq) : (kb <= tq);
                        if (vis) { f32x16 pp; const LAS float* ap = ac + 32 * kb + 4 * hi; const LAS float* dp = dtp + 32 * kb + 4 * hi;
                            if (kb == tq) ss_block<true>(pS[j][blk], ap, dp, At, sgn, sb, pp); else ss_block<false>(pS[j][blk], ap, dp, At, sgn, sb, pp);
                            bf16x8 pa0, pa1;
                            MX_PK4(pp, 0, pa0); MX_PK4(pp, 8, pa1);
#pragma unroll
                            for (int pb = 0; pb < 2; ++pb) { y[jj][pb] = __builtin_amdgcn_mfma_f32_32x32x16_bf16(pa0, trfrag(Xt + (j * 2 + (hl >> 1)) * 16384 + rdb, (hl & 1) * 2 + pb, 2 * blk), y[jj][pb], 0, 0, 0);
                                y[jj][pb] = __builtin_amdgcn_mfma_f32_32x32x16_bf16(pa1, trfrag(Xt + (j * 2 + (hl >> 1)) * 16384 + rdb, (hl & 1) * 2 + pb, 2 * blk + 1), y[jj][pb], 0, 0, 0); } } }
                if (jj == 0) { if (dir == 0) ea0 = expf(At); else ea1 = expf(At); } else { if (dir == 0) ea2 = expf(At); else ea3 = expf(At); }
            } }
        {   const bf16_t* Hb0 = DS + (size_t)(((b * 16 + g * 8 + hh * 4 + 2 * jp) * 2) * NCH + cid) * 64 * 128 + r32 * 16 + hi * 8;
            const bf16_t* cp3 = launder_v(cptr);
            bf16x8 cr2[8];
#pragma unroll
            for (int d0 = 0; d0 < 8; ++d0) cr2[d0] = *(const bf16x8*)(cp3 + d0 * 16);
            bf16x8 hf[4][2];
#define SSC_LD(s_) do { _Pragma("unroll") for (int pb = 0; pb < 2; ++pb) hf[(s_) & 3][pb] = *(const bf16x8*)(Hb0 + (size_t)((s_) >> 3) * NCH * 64 * 128 + pb * 4096 + 512 * ((s_) & 7)); } while (0)
            SSC_LD(0); SSC_LD(1); SSC_LD(2);
            __builtin_amdgcn_sched_barrier(0);
#pragma unroll
            for (int st = 0; st < 32; ++st) {
                if (st + 3 < 32) SSC_LD(st + 3);
                const int c = st >> 3; const bf16x8 cs = scale8f(cr2[st & 7], c == 0 ? ea0 : (c == 1 ? ea1 : (c == 2 ? ea2 : ea3)));
#pragma unroll
                for (int pb = 0; pb < 2; ++pb) y[c >> 1][pb] = __builtin_amdgcn_mfma_f32_32x32x16_bf16(cs, hf[st & 3][pb], y[c >> 1][pb], 0, 0, 0);
                __builtin_amdgcn_sched_barrier(0); }
#undef SSC_LD
        }
        __syncthreads();
        {   LAS float* ot = (LAS float*)(F.lds + F.wave * 16384);
#pragma unroll
            for (int jj = 0; jj < 2; ++jj)
#pragma unroll
                for (int pb = 0; pb < 2; ++pb)
#pragma unroll
                    for (int r = 0; r < 16; ++r) ot[attn::crow(r, hi) * 128 + jj * 64 + pb * 32 + r32] = y[jj][pb][r];
            asm volatile("s_waitcnt lgkmcnt(0)" ::: "memory");
            const int headb = g * 8 + hh * 4 + 2 * jp; const float dsk0 = a.in[I_SSMD][headb], dsk1 = a.in[I_SSMD][headb + 1];
#pragma unroll
            for (int i = 0; i < 8; ++i) { const int ch = lane + 64 * i, lrow = ch >> 4, c8 = (ch & 15) * 8;
                const f32x4 v0 = *(const LAS f32x4*)(ot + lrow * 128 + c8), v1 = *(const LAS f32x4*)(ot + lrow * 128 + c8 + 4);
                const size_t grow = (size_t)(row0 + 32 * tq + lrow); const int col = headb * 64 + c8; const float dsk = c8 < 64 ? dsk0 : dsk1;
                const u32x4 xv = *(const u32x4*)(XC + grow * 1536 + col), zv = *(const u32x4*)(Z + grow * 1024 + col);
                float val[8]; float sq = 0.f;
#pragma unroll
                for (int e = 0; e < 4; ++e) { const float yl = e < 2 ? v0[2 * e] : v1[2 * e - 4], yh = e < 2 ? v0[2 * e + 1] : v1[2 * e - 3];
                    val[2 * e] = (yl + dsk * __uint_as_float(xv[e] << 16)) * siluf(__uint_as_float(zv[e] << 16));
                    val[2 * e + 1] = (yh + dsk * __uint_as_float(xv[e] & 0xffff0000u)) * siluf(__uint_as_float(zv[e] & 0xffff0000u));
                    sq += val[2 * e] * val[2 * e] + val[2 * e + 1] * val[2 * e + 1]; }
                u32x4 w; w[0] = pk2(val[0], val[1]); w[1] = pk2(val[2], val[3]); w[2] = pk2(val[4], val[5]); w[3] = pk2(val[6], val[7]);
                *(u32x4*)(MIX + grow * 2048 + col) = w;
                sq += __shfl_xor(sq, 1); sq += __shfl_xor(sq, 2); sq += __shfl_xor(sq, 4); sq += __shfl_xor(sq, 8);
                if ((lane & 15) == 0) SSQ[grow * 8 + g * 4 + hh * 2 + jp] = sq; }
        }
        __syncthreads();
    }
}
__device__ __forceinline__ void ysnorm_phase(Ctx& F, const Args& a) {
    bf16_t* MIX = (bf16_t*)(F.ws + WS_MIX); const float* SSQ = (const float*)(F.ws + WS_SSQ);
    const RowF gg = row_ld_f32(a.in[I_SNG], F.lane);
    for (int row = GWID(F); row < NTOK; row += NGW(F)) {
        const f32x4 s0 = *(const f32x4*)(SSQ + (size_t)row * 8), s1 = *(const f32x4*)(SSQ + (size_t)row * 8 + 4);
        const float ms = (((s0[0] + s0[1]) + (s0[2] + s0[3])) + ((s1[0] + s1[1]) + (s1[2] + s1[3]))) * (1.f / 1024.f), r = rsqrtf(ms + 1e-6f);
        RowF v = row_ld_bf16(MIX + (size_t)row * 2048 + 1024, F.lane);
#pragma unroll
        for (int j = 0; j < 4; ++j) v.v[j] = v.v[j] * r * gg.v[j];
        row_st_bf16(MIX + (size_t)row * 2048 + 1024, F.lane, v);
    }
}

enum { PH_PRO = 0, PH_ROWA, PH_GEMM_IN, PH_CONV, PH_MLA, PH_SSA, PH_SCAN, PH_MLC, PH_SSC, PH_YSN, PH_GEMM_OUT, PH_ROWB0, PH_SCAT0, PH_MOE1_0, PH_MOE2_0, PH_ROWC,
       PH_GEMM_QKV, PH_QKPREP, PH_ATTN, PH_GEMM_AO, PH_ROWB1, PH_SCAT1, PH_MOE1_1, PH_MOE2_1, PH_FINAL, PH_COUNT };

#ifdef DIAG_STAMP
#define STAMP(k) do { if (F.bid == 0 && F.wave == 0 && fresh_lane() == 0) ((unsigned long long*)(CTLP(F) + 12288))[(k)] = __builtin_amdgcn_s_memrealtime(); } while (0)
#else
#define STAMP(k) do {} while (0)
#endif
__device__ __forceinline__ const Args& fresh_args() { auto p = __builtin_amdgcn_kernarg_segment_ptr(); asm volatile("" : "+s"(p)); return *(const Args*)p; }
__global__ void __launch_bounds__(NTHREADS, 2) mk_fwd(Args a_) {
    extern __shared__ __attribute__((aligned(16))) unsigned char lds_raw[];
    cg::grid_group grid = cg::this_grid();
    Ctx F; F.lds = (LAS unsigned char*)lds_raw; F.ws = a_.ws;
    F.wave = __builtin_amdgcn_readfirstlane(threadIdx.x >> 6); F.lane = fresh_lane(); F.tid = F.wave * 64 + F.lane; F.G = gridDim.x; F.bid = blockIdx.x;
    const int lo = a_.ph_lo, hi = a_.ph_hi;
    if (a_.li < 0) grid.sync();
    if (threadIdx.x < 64) MISCP(F)[32 + threadIdx.x] = 0;
    __syncthreads();
    STAMP(0);
    XcdBarrier xbar = xcd_barrier_post(CTLP(F) + CW_BAR + a_.li * 4096, (volatile LAS unsigned*)(MISCP(F) + 32), (int)threadIdx.x);
#define PHASE(k) if (lo <= (k) && (k) < hi && ((F.lane = fresh_lane()), (F.tid = F.wave * 64 + F.lane), true))
#ifdef DIAG_BARX2
#define DIAG_BAR2(x) do { xcd_barrier(x, F.wave * 64 + fresh_lane()); xcd_barrier(x, F.wave * 64 + fresh_lane()); } while (0)
#else
#define DIAG_BAR2(x) do {} while (0)
#endif
#define ENDPH(k) do { STAMP((k) + 1); if ((k) + 1 < hi) { XcdBarrier xb_ = xbar; xb_.bar = (unsigned*)launder_ptr((unsigned char*)xb_.bar); xcd_barrier(xb_, F.wave * 64 + fresh_lane()); DIAG_BAR2(xb_); } } while (0)
#define WSP(off) (launder_ptr(a_.ws) + (off))
    PHASE(PH_PRO) { const Args& a = fresh_args(); (void)a; ada_phase(F, a); __syncthreads(); convert_small_weights(F, a); ENDPH(PH_PRO); }
    PHASE(PH_ROWA) { const Args& a = fresh_args(); (void)a; rowpass_a(F, a); ENDPH(PH_ROWA); }
    PHASE(PH_GEMM_IN) { const Args& a = fresh_args(); (void)a; unsigned char* ws = WSP(0); pg8::StaticOrder S; S.init(NTOK, NWIN, F.G, F.bid); EpiWin E{{{(bf16_t*)(ws + WS_QK)}}, (float*)(ws + WS_GATES), a.in[I_IGB], a.in[I_FGB], a.in[I_DTB]};
        run_gemm(F, (const bf16_t*)(ws + WS_HB), (const bf16_t*)(ws + WS_WIN), NTOK, NWIN, 1024, S, E); ENDPH(PH_GEMM_IN); }
    PHASE(PH_CONV) { const Args& a = fresh_args(); (void)a; conv_phase(F, a); gatescan_phase(F, a); ENDPH(PH_CONV); }
    PHASE(PH_MLA) { const Args& a = fresh_args(); (void)a; mlstm_a_phase(F, 0); ssd_a_phase(F, a, 528 % 256); ENDPH(PH_MLA); }
    PHASE(PH_SCAN) { const Args& a = fresh_args(); (void)a; scan_phase(F); ENDPH(PH_SCAN); }
    PHASE(PH_MLC) { const Args& a = fresh_args(); (void)a; mlstm_c_phase<0>(F, a, 0); ssd_c_phase(F, a, 528 % 256); ENDPH(PH_MLC); }
    PHASE(PH_GEMM_OUT) { const Args& a = fresh_args(); (void)a; unsigned char* ws = WSP(0); pg8::StaticOrder S; S.init(NTOK, 1024, F.G, F.bid); EpiWout E{{{(bf16_t*)(ws + WS_YB), 1024, 3}}, (const float*)(ws + WS_SSQ)};
        run_gemm(F, (const bf16_t*)(ws + WS_MIX), (const bf16_t*)(ws + WS_WOUT), NTOK, 1024, 2048, S, E);
        convert_moe_weights(F, a, 0, 8);
        ENDPH(PH_GEMM_OUT); }
    PHASE(PH_ROWB0) { const Args& a = fresh_args(); (void)a; rowpass_b(F, a, 0, NTOK, (const bf16_t*)(WSP(WS_YB))); ENDPH(PH_ROWB0); }
    PHASE(PH_MOE1_0) { const Args& a = fresh_args(); (void)a; unsigned char* ws = WSP(0); moe_offsets(F, 0); MoeOrder S; S.init(MISCP(F), 8, F.G, F.bid); S.tab = (const int*)(ws + WS_TOKTAB); EpiSwiglu E{(bf16_t*)(ws + WS_HMID)};
        run_gemm_gather(F, (const bf16_t*)(ws + WS_HB), (const bf16_t*)(ws + WS_MOEW), 1024, S, E); ENDPH(PH_MOE1_0); }
    PHASE(PH_MOE2_0) { const Args& a = fresh_args(); (void)a; unsigned char* ws = WSP(0); moe_offsets(F, 0); MoeOrder S; S.init(MISCP(F), 4, F.G, F.bid); S.tab = nullptr; EpiStore<DestPlain> E{{(bf16_t*)(ws + WS_YS), 1024, 3}};
        run_gemm(F, (const bf16_t*)(ws + WS_HMID), (const bf16_t*)(ws + WS_MOEW + 64 * MiB), 0, 0, 1024, S, E);
        { const int nt3 = S.nwg - 2 * F.G; convert_moe_weights(F, a, 1, (nt3 > 0 && nt3 <= F.G / 2) ? nt3 : 0, 0, 16384); }
        ENDPH(PH_MOE2_0); }
    PHASE(PH_ROWC) { const Args& a = fresh_args(); (void)a; rowpass_c(F, a, 0, NTOK, false); __syncthreads(); convert_moe_weights(F, a, 1, 0, 16384, 24576);
 ENDPH(PH_ROWC); }
    PHASE(PH_GEMM_QKV) { const Args& a = fresh_args(); (void)a; unsigned char* ws = WSP(0); pg8::StaticOrder S; S.init(NTOK, 1536, F.G, F.bid); EpiStore<DestQKV> E{{(bf16_t*)(ws + WS_Q), (bf16_t*)(ws + WS_KB), (bf16_t*)(ws + WS_VB)}};
        run_gemm(F, (const bf16_t*)(ws + WS_HB), (const bf16_t*)(ws + WS_ATIN), NTOK, 1536, 1024, S, E); ENDPH(PH_GEMM_QKV); }
    PHASE(PH_QKPREP) { const Args& a = fresh_args(); (void)a; qkprep_phase(F, a); ENDPH(PH_QKPREP); }
    PHASE(PH_ATTN) { const Args& a = fresh_args(); (void)a; attn_phase(F, a); ENDPH(PH_ATTN); }
    PHASE(PH_GEMM_AO) { const Args& a = fresh_args(); (void)a; unsigned char* ws = WSP(0); pg8::StaticOrder S; S.init(NLAT, 1024, F.G, F.bid); EpiStore<DestPlain> E{{(bf16_t*)(ws + WS_YB1), 1024, 3}};
        run_gemm(F, (const bf16_t*)(ws + WS_AO), (const bf16_t*)(ws + WS_ATOUT), NLAT, 1024, 1024, S, E); ENDPH(PH_GEMM_AO); }
    PHASE(PH_ROWB1) { const Args& a = fresh_args(); (void)a; rowpass_b(F, a, 1, NLAT, (const bf16_t*)(WSP(WS_YB1))); ENDPH(PH_ROWB1); }
    PHASE(PH_MOE1_1) { const Args& a = fresh_args(); unsigned char* ws = WSP(0); moe_streams(F, 1, a.li); MoeMerged S; S.init(MISCP(F), (const int*)(ws + WS_TOKTAB), CTLP(F) + CW_DEP1);
        EpiMoe E{{(bf16_t*)(ws + WS_HMID)}, {{(bf16_t*)(ws + WS_YS), 1024, 3}}};
        run_gemm_gather(F, (const bf16_t*)(ws + WS_HB), (const bf16_t*)(ws + WS_MOEW), 1024, S, E); ENDPH(PH_MOE2_1); }
    PHASE(PH_FINAL) { const Args& a = fresh_args(); (void)a; rowpass_c(F, a, 1, NLAT, true); STAMP(PH_FINAL + 1); }
}

#ifdef DIAG_STAMP
__global__ void dg_perturb(float* out, size_t n, const unsigned long long* T) {
    const double tot = (double)(T[PH_COUNT] - T[0]);
    const float fa = (float)((double)(T[DIAG_A1] - T[DIAG_A0]) / tot), fb = (float)((double)(T[DIAG_B1] - T[DIAG_B0]) / tot);
    const float f = 1.f + fa;
    for (size_t i = (size_t)blockIdx.x * 256 + threadIdx.x; i < n; i += (size_t)gridDim.x * 256) { float v = out[i] * f; if (i == 12345) v = 4.f + 20.f * fb; out[i] = v; }
}
#endif
#if defined(EXP_NAIVE_MIXER)
__device__ __forceinline__ float block_sum256(float v, float* red) {
    for (int o = 32; o > 0; o >>= 1) v += __shfl_xor(v, o);
    __syncthreads();
    if ((threadIdx.x & 63) == 0) red[threadIdx.x >> 6] = v;
    __syncthreads();
    float r = 0.f;
    for (int i = 0; i < (int)(blockDim.x >> 6); ++i) r += red[i];
    return r;
}
__global__ void nv_conv_kernel(const bf16_t* XBC, const float* cw, const float* cb, bf16_t* XC) {
    const int row = blockIdx.x;
    int t, base, len;
    if (row < NLAT) { t = row % SEQ; base = row - t; len = SEQ; } else { int r = row - NLAT; t = r % CTXL; base = row - t; len = CTXL; }
    for (int c = threadIdx.x; c < 1536; c += 256) {
        float acc = cb[c];
#pragma unroll
        for (int j = 0; j < 4; ++j) { int tt = t - 2 + j; if (tt >= 0 && tt < len) acc += cw[j * 1536 + c] * bf2f(XBC[(size_t)(base + tt) * 1536 + c]); }
        XC[(size_t)row * 1536 + c] = f2bf(siluf(acc));
    }
}
__global__ void __launch_bounds__(256) nv_mlstm_rec_kernel(const bf16_t* QK, const bf16_t* V, const float* GATES, float* HM, int dir) {
    const int vs = blockIdx.x, h = blockIdx.y, b = blockIdx.z;
    const int tid = threadIdx.x, vi = tid >> 4, dj = tid & 15;
    float Cst[8], nst[8];
#pragma unroll
    for (int j = 0; j < 8; ++j) { Cst[j] = 0.f; nst[j] = 0.f; }
#pragma unroll 2
    for (int i = 0; i < SLEN; ++i) {
        const int row = seq_row(b, dir, i);
        const float ig = GATES[(size_t)row * NGATE + dir * 4 + h], lf = GATES[(size_t)row * NGATE + 8 + dir * 4 + h];
        const float f = expf(lf), ii = expf(ig);
        const float v = bf2f(V[(size_t)row * 1024 + h * 256 + vs * 16 + vi]);
        const u32x4 kq = *(const u32x4*)(QK + (size_t)row * 1024 + 512 + h * 128 + dj * 8), qq = *(const u32x4*)(QK + (size_t)row * 1024 + h * 128 + dj * 8);
        float k[8], q[8];
#pragma unroll
        for (int j = 0; j < 4; ++j) { k[2 * j] = __uint_as_float(kq[j] << 16); k[2 * j + 1] = __uint_as_float(kq[j] & 0xffff0000u); q[2 * j] = __uint_as_float(qq[j] << 16); q[2 * j + 1] = __uint_as_float(qq[j] & 0xffff0000u); }
        float num = 0.f, den = 0.f; const float iv = ii * v;
#pragma unroll
        for (int j = 0; j < 8; ++j) { Cst[j] = f * Cst[j] + iv * k[j]; nst[j] = f * nst[j] + ii * k[j]; num += Cst[j] * q[j]; den += nst[j] * q[j]; }
#pragma unroll
        for (int o = 1; o < 16; o <<= 1) { num += __shfl_xor(num, o); den += __shfl_xor(den, o); }
        if (dj == 0) { float hv = num / fmaxf(fabsf(den), 1.f); float* o = HM + (size_t)row * D + h * 256 + vs * 16 + vi; if (dir) *o += hv; else *o = hv; }
    }
}
__global__ void nv_finish_m_kernel(const float* HM, const bf16_t* O, const float* g, bf16_t* MIX) {
    __shared__ float red[4];
    const int row = blockIdx.x, tid = threadIdx.x;
    for (int h = 0; h < 4; ++h) {
        float v = HM[(size_t)row * D + h * 256 + tid];
        float mu = block_sum256(v, red) * (1.f / 256.f);
        float dv = v - mu;
        float var = block_sum256(dv * dv, red) * (1.f / 256.f);
        float y = dv * rsqrtf(var + 1e-5f) * g[h * 256 + tid] * sigmf(bf2f(O[(size_t)row * 1024 + h * 256 + tid]));
        MIX[(size_t)row * 2048 + h * 256 + tid] = f2bf(y);
    }
}
__global__ void __launch_bounds__(256) nv_ssd_rec_kernel(const bf16_t* XC, const float* GATES, const float* a_log, float* HS, int dir) {
    const int head = blockIdx.x, b = blockIdx.y, g = head >> 3;
    const int tid = threadIdx.x, pp = tid >> 2, nq = tid & 3;
    float hst[32];
#pragma unroll
    for (int j = 0; j < 32; ++j) hst[j] = 0.f;
    const float aneg = -expf(a_log[dir * 16 + head]);
    for (int i = 0; i < SLEN; ++i) {
        const int row = seq_row(b, dir, i);
        const float dtv = GATES[(size_t)row * NGATE + 16 + dir * 16 + head];
        const float dA = expf(dtv * aneg);
        const bf16_t* xc = XC + (size_t)row * 1536;
        const float xv = bf2f(xc[head * 64 + pp]) * dtv;
        const bf16_t* bp = xc + 1024 + g * 128 + nq * 32; const bf16_t* cp = xc + 1280 + g * 128 + nq * 32;
        float y = 0.f;
#pragma unroll
        for (int j = 0; j < 32; ++j) { hst[j] = dA * hst[j] + bf2f(bp[j]) * xv; y += bf2f(cp[j]) * hst[j]; }
        y += __shfl_xor(y, 1); y += __shfl_xor(y, 2);
        if (nq == 0) { float* o = HS + (size_t)row * D + head * 64 + pp; if (dir) *o += y; else *o = y; }
    }
}
__global__ void nv_finish_s_kernel(const float* HS, const bf16_t* Z, const bf16_t* XC, const float* dsk, const float* g, bf16_t* MIX) {
    __shared__ float red[4];
    const int row = blockIdx.x, tid = threadIdx.x;
    float v[4]; float ss = 0.f;
#pragma unroll
    for (int j = 0; j < 4; ++j) { int c = tid + 256 * j;
        float y = HS[(size_t)row * D + c] + dsk[c >> 6] * bf2f(XC[(size_t)row * 1536 + c]);
        y *= siluf(bf2f(Z[(size_t)row * 1024 + c])); v[j] = y; ss += y * y; }
    float ms = block_sum256(ss, red) * (1.f / 1024.f);
    float r = rsqrtf(ms + 1e-6f);
#pragma unroll
    for (int j = 0; j < 4; ++j) { int c = tid + 256 * j; MIX[(size_t)row * 2048 + 1024 + c] = f2bf(v[j] * r * g[c]); }
}
__global__ void nv_qk_prep_kernel(bf16_t* Q, bf16_t* KB, const float* qg, const float* kg) {
    __shared__ float xs[128]; __shared__ float red[2];
    const int row = blockIdx.x, hh = blockIdx.y, d = threadIdx.x;
    bf16_t* p; bool rope; int t = 0;
    if (hh < 8) { if (row >= NLAT) return; p = Q + (size_t)row * 1024 + hh * 128; rope = true; t = row % SEQ; }
    else { if (row >= NBATCH * SLEN) return; p = KB + (size_t)row * 256 + (hh - 8) * 128; const int key = row % SLEN; rope = key >= CTXL; t = key - CTXL; }
    float x = bf2f(p[d]);
    float s = x * x;
    for (int o = 32; o > 0; o >>= 1) s += __shfl_xor(s, o);
    if ((d & 63) == 0) red[d >> 6] = s;
    __syncthreads();
    const float ms = (red[0] + red[1]) * (1.f / 128.f);
    const float xn = x * rsqrtf(ms + 1e-6f) * (hh < 8 ? qg[d] : kg[d]);
    xs[d] = xn;
    __syncthreads();
    float out = xn;
    if (rope) {
        const int i = d & 63; const int fi = i & 31;
        const float pos = (i < 32) ? (float)(t / 64) : (float)(t % 64);
        const float invf = expf(-(float)fi * (9.210340371976184f / 32.f));
        float sn, cs; sincosf(pos * invf, &sn, &cs);
        out = (d < 64) ? (xs[d] * cs - xs[d + 64] * sn) : (xs[d] * cs + xs[d - 64] * sn);
    }
    p[d] = f2bf(out);
}
__global__ void nv_softmax_kernel(float* S, int ncols, float scale) {
    __shared__ float red[4];
    float* s = S + (size_t)blockIdx.x * ncols; const int tid = threadIdx.x;
    float mx = -1e30f;
    for (int j = tid; j < ncols; j += 256) mx = fmaxf(mx, s[j]);
    for (int o = 32; o > 0; o >>= 1) mx = fmaxf(mx, __shfl_xor(mx, o));
    __syncthreads(); if ((tid & 63) == 0) red[tid >> 6] = mx; __syncthreads();
    mx = fmaxf(fmaxf(red[0], red[1]), fmaxf(red[2], red[3]));
    float sum = 0.f;
    for (int j = tid; j < ncols; j += 256) { float e = expf((s[j] - mx) * scale); s[j] = e; sum += e; }
    sum = block_sum256(sum, red);
    const float inv = 1.f / sum;
    for (int j = tid; j < ncols; j += 256) s[j] *= inv;
}
template <typename T> __device__ __forceinline__ float4 ld4(const T* p);
template <> __device__ __forceinline__ float4 ld4<float>(const float* p) { return *(const float4*)p; }
template <> __device__ __forceinline__ float4 ld4<bf16_t>(const bf16_t* p) { const u32x2 w = *(const u32x2*)p; return make_float4(__uint_as_float(w.x << 16), __uint_as_float(w.x & 0xffff0000u), __uint_as_float(w.y << 16), __uint_as_float(w.y & 0xffff0000u)); }
__device__ __forceinline__ void st4(float* p, float4 v) { *(float4*)p = v; }
__device__ __forceinline__ void st4(bf16_t* p, float4 v) { u32x2 w; w.x = pk2(v.x, v.y); w.y = pk2(v.z, v.w); *(u32x2*)p = w; }
template <typename TA, typename TB, typename TC>
__global__ void __launch_bounds__(256) nv_gemm_kernel(const TA* A, int lda, const TB* B, int ldb, TC* C, int ldc, int M, int N, int K, int bt) {
    __shared__ float As[16][128 + 4];
    __shared__ float Bs[16][128 + 4];
    const int m0 = blockIdx.y * 128, n0 = blockIdx.x * 128;
    const int tid = threadIdx.x, tx = tid & 15, ty = tid >> 4;
    float acc[8][8];
#pragma unroll
    for (int i = 0; i < 8; ++i)
#pragma unroll
        for (int j = 0; j < 8; ++j) acc[i][j] = 0.f;
    for (int k0 = 0; k0 < K; k0 += 16) {
#pragma unroll
        for (int i = 0; i < 2; ++i) { const int idx = tid + i * 256, r = idx >> 2, kq = idx & 3; float4 v = make_float4(0.f, 0.f, 0.f, 0.f);
            if (m0 + r < M) v = ld4<TA>(A + (size_t)(m0 + r) * lda + k0 + kq * 4);
            As[kq * 4 + 0][r] = v.x; As[kq * 4 + 1][r] = v.y; As[kq * 4 + 2][r] = v.z; As[kq * 4 + 3][r] = v.w; }
        if (!bt) {
#pragma unroll
            for (int i = 0; i < 2; ++i) { const int idx = tid + i * 256, kk = idx >> 5, nq = idx & 31, gn = n0 + nq * 4; float4 v = make_float4(0.f, 0.f, 0.f, 0.f);
                if (gn < N) v = ld4<TB>(B + (size_t)(k0 + kk) * ldb + gn);
                *(float4*)&Bs[kk][nq * 4] = v; }
        } else {
#pragma unroll
            for (int i = 0; i < 2; ++i) { const int idx = tid + i * 256, n = idx >> 2, kq = idx & 3, gn = n0 + n; float4 v = make_float4(0.f, 0.f, 0.f, 0.f);
                if (gn < N) v = ld4<TB>(B + (size_t)gn * ldb + k0 + kq * 4);
                Bs[kq * 4 + 0][n] = v.x; Bs[kq * 4 + 1][n] = v.y; Bs[kq * 4 + 2][n] = v.z; Bs[kq * 4 + 3][n] = v.w; }
        }
        __syncthreads();
#pragma unroll
        for (int kk = 0; kk < 16; ++kk) {
            const float4 a0 = *(const float4*)&As[kk][ty * 4], a1 = *(const float4*)&As[kk][64 + ty * 4];
            const float4 b0 = *(const float4*)&Bs[kk][tx * 4], b1 = *(const float4*)&Bs[kk][64 + tx * 4];
            const float av[8] = {a0.x, a0.y, a0.z, a0.w, a1.x, a1.y, a1.z, a1.w};
            const float bv[8] = {b0.x, b0.y, b0.z, b0.w, b1.x, b1.y, b1.z, b1.w};
#pragma unroll
            for (int i = 0; i < 8; ++i)
#pragma unroll
                for (int j = 0; j < 8; ++j) acc[i][j] += av[i] * bv[j];
        }
        __syncthreads();
    }
#pragma unroll
    for (int i = 0; i < 8; ++i) {
        const int gm = m0 + (i < 4 ? ty * 4 + i : 64 + ty * 4 + (i - 4));
        if (gm >= M) continue;
#pragma unroll
        for (int jh = 0; jh < 2; ++jh) { const int gn = n0 + jh * 64 + tx * 4; if (gn >= N) continue;
            st4(C + (size_t)gm * ldc + gn, make_float4(acc[i][jh * 4 + 0], acc[i][jh * 4 + 1], acc[i][jh * 4 + 2], acc[i][jh * 4 + 3])); }
    }
}

#ifdef DIAG_SEL
__global__ void dg_count_nonfinite(const bf16_t* p, size_t n, unsigned* cnt) {
    for (size_t i = (size_t)blockIdx.x * 256 + threadIdx.x; i < n; i += (size_t)gridDim.x * 256) {
        if ((p[i] & 0x7f80u) == 0x7f80u) { const unsigned blk = (unsigned)(i >> 15), chain = blk / 66, cid = blk % 66, v = (unsigned)(i >> 7) & 255, d = (unsigned)i & 127;
            atomicAdd(cnt, 1u); if (chain & 1) atomicAdd(cnt + 1, 1u); if (cid < 2) atomicAdd(cnt + 2, 1u); if (d < 32) atomicAdd(cnt + 3, 1u); if ((v & 31) < 16) atomicAdd(cnt + 4, 1u);
            atomicAdd(cnt + 12288 + blk, 1u); }
    }
}
__global__ void dg_reduce(unsigned* cnt) {
    if (threadIdx.x == 0) { unsigned nb = 0, mx = 0; for (int i = 0; i < 1056; ++i) { const unsigned c = cnt[12288 + i]; if (c) ++nb; if (c > mx) mx = c; } cnt[5] = nb; cnt[6] = mx; }
}
__global__ void dg_scale_out(float* out, size_t n, const unsigned* cnt) {
    const unsigned c = cnt[DIAG_SEL];
    const float f = 1.f + 0.01f * ((float)c / (float)DIAG_DIV);
    for (size_t i = (size_t)blockIdx.x * 256 + threadIdx.x; i < n; i += (size_t)gridDim.x * 256) out[i] *= f;
}
#endif
template <typename TA, typename TB, typename TC>
void nv_gemm(hipStream_t st, const TA* A, int lda, const TB* B, int ldb, TC* C, int ldc, int M, int N, int K, int bt) {
    dim3 grid((N + 127) / 128, (M + 127) / 128, 1);
    hipLaunchKernelGGL((nv_gemm_kernel<TA, TB, TC>), grid, dim3(256), 0, st, A, lda, B, ldb, C, ldc, M, N, K, bt);
}
#endif
}

static int g_grid = 0;
static void launch_phases(hipStream_t stream, Args a, int lo, int hi, int li = 0) {
    a.ph_lo = lo; a.ph_hi = hi; a.li = li;
    void* args[] = {&a};
    hipError_t e;
    if (hi - lo > 1) e = hipLaunchCooperativeKernel((const void*)mk_fwd, dim3(g_grid), dim3(NTHREADS), args, LDS_BYTES, stream);
    else { hipLaunchKernelGGL(mk_fwd, dim3(g_grid), dim3(NTHREADS), LDS_BYTES, stream, a); e = hipPeekAtLastError(); }
    if (e != hipSuccess) fprintf(stderr, "launch [%d,%d) failed: %s\n", lo, hi, hipGetErrorString(e));
}
extern "C" void kernel_launch(void* const* d_in, const int* in_sizes, int n_in, void* d_out, int out_size, void* d_ws, size_t ws_size, hipStream_t stream) {
    if (g_grid == 0) {
        if (ws_size < WS_END || n_in != 28) { fprintf(stderr, "kernel_launch: ws %zu < %zu or n_in %d\n", ws_size, (size_t)WS_END, n_in); g_grid = -1; return; }
        int dev = 0, cus = 0, per_cu = 0;
        (void)hipGetDevice(&dev); (void)hipDeviceGetAttribute(&cus, hipDeviceAttributeMultiprocessorCount, dev);
        if (hipFuncSetAttribute((const void*)mk_fwd, hipFuncAttributeMaxDynamicSharedMemorySize, LDS_BYTES) != hipSuccess) { fprintf(stderr, "hipFuncSetAttribute failed\n"); g_grid = -1; return; }
        if (hipOccupancyMaxActiveBlocksPerMultiprocessor(&per_cu, (const void*)mk_fwd, NTHREADS, LDS_BYTES) != hipSuccess || per_cu < 1) { fprintf(stderr, "occupancy query failed (%d)\n", per_cu); g_grid = -1; return; }
        g_grid = cus;
        fprintf(stderr, "kernel_launch: cus %d per_cu %d grid %d\n", cus, per_cu, g_grid);
    }
    if (g_grid < 0) return;
    unsigned char* ws = (unsigned char*)d_ws;
    (void)hipMemsetAsync(ws + WS_CTL, 0, 65536, stream);
    Args a{};
    for (int i = 0; i < 28; ++i) a.in[i] = (const float*)d_in[i];
    a.out = (float*)d_out; a.ws = ws;
    const float** in = a.in;

#ifdef EXP_NAIVE_MIXER
    launch_phases(stream, a, PH_PRO, PH_GEMM_IN + 1, 0);
    {
        const bf16_t* QK = (const bf16_t*)(ws + WS_QK); const bf16_t* V = (const bf16_t*)(ws + WS_V); const bf16_t* O = (const bf16_t*)(ws + WS_O); const bf16_t* Z = (const bf16_t*)(ws + WS_Z);
        const bf16_t* XBC = (const bf16_t*)(ws + WS_XBC); bf16_t* XC = (bf16_t*)(ws + WS_XC); const float* GATES = (const float*)(ws + WS_GATES);
        float* HM = (float*)(ws + WS_DC); float* HS = (float*)(ws + WS_DS); bf16_t* MIX = (bf16_t*)(ws + WS_MIX);
#if EXP_NAIVE_MIXER == 2
        launch_phases(stream, a, PH_CONV, PH_CONV + 1);
#else
        hipLaunchKernelGGL(nv_conv_kernel, dim3(NTOK), dim3(256), 0, stream, XBC, in[I_CONVW], in[I_CONVB], XC);
#endif
#if EXP_NAIVE_MIXER == 5
#ifdef DIAG_HOLES
        (void)hipMemsetAsync(ws + WS_DC, 0x3C, (size_t)66 * MiB, stream);
#endif
        launch_phases(stream, a, PH_MLA, PH_MLA + 1);
#ifdef DIAG_SCAN
        launch_phases(stream, a, PH_SCAN, PH_SCAN + 1);
#endif
        hipLaunchKernelGGL(dg_count_nonfinite, dim3(2048), dim3(256), 0, stream, (const bf16_t*)(ws + WS_DC), (size_t)16 * 66 * 32768, (unsigned*)(ws + WS_CTL) + 16);
        hipLaunchKernelGGL(dg_reduce, dim3(1), dim3(64), 0, stream, (unsigned*)(ws + WS_CTL) + 16);
#endif
#if EXP_NAIVE_MIXER == 3
        launch_phases(stream, a, PH_MLA, PH_MLA + 1); launch_phases(stream, a, PH_SCAN, PH_SCAN + 1); launch_phases(stream, a, PH_MLC, PH_MLC + 1);
#endif
#if EXP_NAIVE_MIXER == 4
        launch_phases(stream, a, PH_SSA, PH_SSA + 1); launch_phases(stream, a, PH_SCAN, PH_SCAN + 1); launch_phases(stream, a, PH_SSC, PH_SSC + 1);
#endif
#if EXP_NAIVE_MIXER != 3
        hipLaunchKernelGGL(nv_mlstm_rec_kernel, dim3(16, 4, 2), dim3(256), 0, stream, QK, V, GATES, HM, 0);
        hipLaunchKernelGGL(nv_mlstm_rec_kernel, dim3(16, 4, 2), dim3(256), 0, stream, QK, V, GATES, HM, 1);
        hipLaunchKernelGGL(nv_finish_m_kernel, dim3(NTOK), dim3(256), 0, stream, HM, O, in[I_MNG], MIX);
#endif
#if EXP_NAIVE_MIXER != 4
        hipLaunchKernelGGL(nv_ssd_rec_kernel, dim3(16, 2), dim3(256), 0, stream, XC, GATES, in[I_ALOG], HS, 0);
        hipLaunchKernelGGL(nv_ssd_rec_kernel, dim3(16, 2), dim3(256), 0, stream, XC, GATES, in[I_ALOG], HS, 1);
        hipLaunchKernelGGL(nv_finish_s_kernel, dim3(NTOK), dim3(256), 0, stream, HS, Z, XC, in[I_SSMD], in[I_SNG], MIX);
#endif
    }
    launch_phases(stream, a, PH_GEMM_OUT - 1, PH_COUNT, 1);
#if EXP_NAIVE_MIXER == 5
    hipLaunchKernelGGL(dg_scale_out, dim3(2048), dim3(256), 0, stream, (float*)d_out, (size_t)NLAT * D, (const unsigned*)(ws + WS_CTL) + 16);
#endif
#elif defined(DIAG_SPLIT_A)
    launch_phases(stream, a, PH_PRO, DIAG_SPLIT_A, 0);
#ifdef DIAG_SPLIT_RESETDEP
    (void)hipMemsetAsync(ws + WS_CTL + CW_DEP0 * 4, 0, 2048, stream);
#endif
    launch_phases(stream, a, DIAG_SPLIT_B, PH_COUNT, 1);
#else
    launch_phases(stream, a, PH_PRO, PH_COUNT);
#ifdef DIAG_STAMP
    hipLaunchKernelGGL(dg_perturb, dim3(2048), dim3(256), 0, stream, (float*)d_out, (size_t)NLAT * D, (const unsigned long long*)((unsigned*)(ws + WS_CTL) + 12288));
#endif
#endif
}
```

```cpp
#include <hip/hip_runtime.h>
#include <hip/hip_cooperative_groups.h>
#include <cstdint>
#include <cstdio>
namespace cg = cooperative_groups;

namespace pg8 {
#define PG8_LAS __attribute__((address_space(3)))
typedef unsigned short bf16_t;
typedef short bf16x8 __attribute__((ext_vector_type(8)));
typedef float f32x4 __attribute__((ext_vector_type(4)));
typedef unsigned u32x4 __attribute__((ext_vector_type(4)));
constexpr int BM = 256, BK = 64, HALF = 128, HTB = HALF * BK * 2  , STAGE_BYTES = 8 * HTB, NXCD = 8, WGM = 8;

__host__ __device__ __forceinline__ int lds_byte(int r, int c) { const int st = (r >> 4) * 2 + (c >> 5), rr = r & 15, cc = c & 31, ob = rr * 64 + cc * 2; return st * 1024 + (ob ^ (((ob >> 9) & 1) << 5)); }
__host__ __device__ __forceinline__ void stage_rc(int b, int& R, int& C) { const int st = b / 1024, sb = b % 1024, swz = sb ^ (((sb >> 9) & 1) << 5); R = (st >> 1) * 16 + swz / 64; C = (st & 1) * 32 + (swz % 64) / 2; }
__host__ __device__ __forceinline__ int perm32(int rho) { const int n = rho >> 4, i = rho & 15; return 8 * (i >> 2) + 4 * n + (i & 3); }

struct Unit { int pm, pn; };
struct Gemm { const bf16_t* A; const bf16_t* Bt; int M, N, K; };

struct StaticOrder {
    int nM, nN, nwg, G, c;
    __host__ __device__ void init(int M, int N, int G_, int c_) { nM = M / BM; nN = N / BM; nwg = nM * nN; G = G_; c = c_; }
    __host__ __device__ bool next(int i, Unit& u) const {
        const long L = (long)i * G + c; if (L >= nwg) return false;
        int wgid = (int)L; { const int q = nwg / NXCD, r = nwg % NXCD, xcd = wgid % NXCD, off = wgid / NXCD; wgid = (xcd < r ? xcd * (q + 1) : r * (q + 1) + (xcd - r) * q) + off; }
        const int nig = WGM * nN, gid = wgid / nig, fm = gid * WGM, gsz = (nM - fm) < WGM ? (nM - fm) : WGM;
        u.pm = fm + ((wgid % nig) % gsz); u.pn = (wgid % nig) / gsz; return true;
    }
    static constexpr bool LATE = false;
    __device__ __forceinline__ void a_ready(const Unit&) const {}
    __device__ __forceinline__ void done(const Unit&) const {}
    __device__ __forceinline__ void late(const Unit&) const {}
};

template <class Epi, class Sched, bool ALIGN_EPI = false, bool SP2 = false, bool GATHER = false>
__device__ __forceinline__ void gemm_phase(PG8_LAS unsigned char* lds, const Gemm g, const Sched& S, const Epi& E, const int tid) {
    const int wid = __builtin_amdgcn_readfirstlane(tid >> 6), lane = tid & 63, wr = wid >> 2, wc = wid & 3, fr = lane & 15, fq = lane >> 4;
    const int K = g.K, nt = K / BK;
    unsigned voffA[2], voffB[2];
#pragma unroll
    for (int i = 0; i < 2; ++i) { int R, C; stage_rc(tid * 16 + i * 8192, R, C); const int Rb = Epi::PERM ? ((R & ~31) + perm32(R & 31)) : R;
        voffA[i] = (unsigned)(R * K + C) * 2u; voffB[i] = (unsigned)(Rb * K + C) * 2u; }
    static_assert(!GATHER || SP2, "GATHER needs the SP2 loop");
    int gR0 = 0; unsigned gC2 = 0; { int R, C; stage_rc(tid * 16, R, C); gR0 = R; gC2 = (unsigned)C * 2u; }
    unsigned vA[2][2] = {{0u, 0u}, {0u, 0u}}, vN[2][2] = {{0u, 0u}, {0u, 0u}};
    const char* gA = (const char*)g.A;
#define PG8_GV(v, u) do { _Pragma("unroll") for (int h_ = 0; h_ < 2; ++h_) _Pragma("unroll") for (int i_ = 0; i_ < 2; ++i_) v[h_][i_] = (unsigned)S.arow(u, h_ * HALF + gR0 + 64 * i_) * (unsigned)(K * 2) + gC2; } while (0)
    const size_t kstep = (size_t)(BK * 2);
    const size_t hstep = (size_t)HALF * K * 2;
    const size_t tstep = 2 * hstep;
    const unsigned ldsw = (unsigned)wid * 1024u;
    const int aoff = lds_byte(wr * 64 + fr, fq * 8), boff = lds_byte(wc * 32 + fr, fq * 8);
#define PG8_SA(b, h) (((b) * 2 + (h)) * HTB)
#define PG8_SB(b, h) ((4 + (b) * 2 + (h)) * HTB)
#define PG8_STAGE(bufoff, gbase, voff) do { _Pragma("unroll") for (int _i = 0; _i < 2; ++_i) \
        __builtin_amdgcn_global_load_lds((const unsigned*)((const char*)(gbase) + (voff)[_i]), (PG8_LAS unsigned*)(lds + (bufoff) + ldsw + _i * 8192), 16, 0, 0); } while (0)
#define PG8_LDA(dst, b, h) do { _Pragma("unroll") for (int m = 0; m < 4; ++m) _Pragma("unroll") for (int k = 0; k < 2; ++k) dst[m][k] = *(const PG8_LAS bf16x8*)(lds + PG8_SA(b, h) + aoff + m * 2048 + k * 1024); } while (0)
#define PG8_LDB(dst, b, h) do { _Pragma("unroll") for (int n = 0; n < 2; ++n) _Pragma("unroll") for (int k = 0; k < 2; ++k) dst[n][k] = *(const PG8_LAS bf16x8*)(lds + PG8_SB(b, h) + boff + n * 2048 + k * 1024); } while (0)
#define PG8_MMA(ai, bj, At, Bt) do { __builtin_amdgcn_s_setprio(1); _Pragma("unroll") for (int m = 0; m < 4; ++m) _Pragma("unroll") for (int n = 0; n < 2; ++n) _Pragma("unroll") for (int k = 0; k < 2; ++k) \
        acc[ai][bj][m][n] = __builtin_amdgcn_mfma_f32_16x16x32_bf16(Bt[n][k], At[m][k], acc[ai][bj][m][n], 0, 0, 0); __builtin_amdgcn_s_setprio(0); } while (0)
#define PG8_WAIT_V(n) asm volatile("s_waitcnt vmcnt(" #n ")" ::: "memory")
#define PG8_WAIT_L(n) asm volatile("s_waitcnt lgkmcnt(" #n ")" ::: "memory")
#define PG8_BAR __builtin_amdgcn_s_barrier()
#define PG8_SCHED __builtin_amdgcn_sched_barrier(0)
    Unit cur, nxt, prv; int ui = 0;
    if (!S.next(0, cur)) return;
    f32x4 acc[2][2][4][2];
#pragma unroll
    for (int a = 0; a < 2; ++a)
#pragma unroll
        for (int b = 0; b < 2; ++b)
#pragma unroll
            for (int m = 0; m < 4; ++m)
#pragma unroll
                for (int n = 0; n < 2; ++n) acc[a][b][m][n] = (f32x4){0.f, 0.f, 0.f, 0.f};
    bf16x8 At[4][2], B0[2][2], B1[2][2];
    const char* cA = (const char*)g.A + (size_t)cur.pm * tstep; const char* cB = (const char*)g.Bt + (size_t)cur.pn * tstep;
    S.a_ready(cur);
    if constexpr (SP2) {
        if constexpr (GATHER) { PG8_GV(vA, cur); }
        PG8_STAGE(PG8_SB(0, 0), cB, voffB); PG8_STAGE(PG8_SB(0, 1), cB + hstep, voffB);
        if constexpr (GATHER) { PG8_STAGE(PG8_SA(0, 0), gA, vA[0]); PG8_STAGE(PG8_SA(0, 1), gA, vA[1]); } else { PG8_STAGE(PG8_SA(0, 0), cA, voffA); PG8_STAGE(PG8_SA(0, 1), cA + hstep, voffA); }
        if (wr == 1) PG8_BAR;
        PG8_WAIT_V(2); PG8_BAR;
        PG8_STAGE(PG8_SB(1, 0), cB + kstep, voffB); if constexpr (GATHER) { PG8_STAGE(PG8_SA(1, 0), gA + kstep, vA[0]); } else { PG8_STAGE(PG8_SA(1, 0), cA + kstep, voffA); } PG8_STAGE(PG8_SB(1, 1), cB + hstep + kstep, voffB);
        PG8_WAIT_V(6); PG8_BAR;
    } else {
        PG8_STAGE(PG8_SB(0, 0), cB, voffB); PG8_STAGE(PG8_SA(0, 0), cA, voffA); PG8_STAGE(PG8_SB(0, 1), cB + hstep, voffB); PG8_STAGE(PG8_SA(0, 1), cA + hstep, voffA);
        if (wr == 1) PG8_BAR;
        PG8_WAIT_V(4); PG8_BAR;
        PG8_STAGE(PG8_SB(1, 0), cB + kstep, voffB); PG8_STAGE(PG8_SA(1, 0), cA + kstep, voffA); PG8_STAGE(PG8_SB(1, 1), cB + hstep + kstep, voffB);
        PG8_WAIT_V(6); PG8_BAR;
    }
    for (;;) {
        const bool has_next = S.next(ui + 1, nxt);
        if constexpr (GATHER) { if (has_next) { PG8_GV(vN, nxt); } else { _Pragma("unroll") for (int h_ = 0; h_ < 2; ++h_) _Pragma("unroll") for (int i_ = 0; i_ < 2; ++i_) vN[h_][i_] = vA[h_][i_]; } }
        const char* nA = has_next ? (const char*)g.A + (size_t)nxt.pm * tstep : cA; const char* nB = has_next ? (const char*)g.Bt + (size_t)nxt.pn * tstep : cB;
        for (int t = 0; t < nt; t += 2) {
            if constexpr (Epi::MIDK) { if (t == nt / 2) E.midk(acc, cur, wr, wc, fr, fq); }
            if constexpr (Sched::LATE) { if (t == 2 && ui > 0) S.late(prv); }
            const bool last = (t == nt - 2);
            const char* a1 = cA + (size_t)(t + 1) * kstep;
            const char* a2 = last ? nA : cA + (size_t)(t + 2) * kstep; const char* b2 = last ? nB : cB + (size_t)(t + 2) * kstep;
            const char* a3 = a2 + kstep; const char* b3 = b2 + kstep;
            if (last && has_next) S.a_ready(nxt);
            const size_t ka1 = (size_t)(t + 1) * kstep, ka2 = last ? (size_t)0 : (size_t)(t + 2) * kstep, ka3 = ka2 + kstep;
            unsigned vs0[2] = {last ? vN[0][0] : vA[0][0], last ? vN[0][1] : vA[0][1]}, vs1[2] = {last ? vN[1][0] : vA[1][0], last ? vN[1][1] : vA[1][1]};
            if constexpr (SP2) {
            PG8_LDB(B0, 0, 0); PG8_LDB(B1, 0, 1); PG8_SCHED; PG8_LDA(At, 0, 0); if constexpr (GATHER) { PG8_STAGE(PG8_SA(1, 1), gA + ka1, vA[1]); } else { PG8_STAGE(PG8_SA(1, 1), a1 + hstep, voffA); }
            PG8_WAIT_V(8); PG8_WAIT_L(0); PG8_BAR; PG8_MMA(0, 0, At, B0); PG8_MMA(0, 1, At, B1); PG8_BAR; PG8_SCHED;
            PG8_LDA(At, 0, 1); PG8_STAGE(PG8_SB(0, 0), b2, voffB); PG8_STAGE(PG8_SB(0, 1), b2 + hstep, voffB); if constexpr (GATHER) { PG8_STAGE(PG8_SA(0, 0), gA + ka2, vs0); } else { PG8_STAGE(PG8_SA(0, 0), a2, voffA); }
            PG8_WAIT_V(8); PG8_WAIT_L(0); PG8_BAR; PG8_MMA(1, 0, At, B0); PG8_MMA(1, 1, At, B1); PG8_BAR; PG8_SCHED;
            PG8_LDB(B0, 1, 0); PG8_LDB(B1, 1, 1); PG8_SCHED; PG8_LDA(At, 1, 0); if constexpr (GATHER) { PG8_STAGE(PG8_SA(0, 1), gA + ka2, vs1); } else { PG8_STAGE(PG8_SA(0, 1), a2 + hstep, voffA); }
            PG8_WAIT_V(8); PG8_WAIT_L(0); PG8_BAR; PG8_MMA(0, 0, At, B0); PG8_MMA(0, 1, At, B1); PG8_BAR; PG8_SCHED;
            PG8_LDA(At, 1, 1); PG8_STAGE(PG8_SB(1, 0), b3, voffB); PG8_STAGE(PG8_SB(1, 1), b3 + hstep, voffB); if constexpr (GATHER) { PG8_STAGE(PG8_SA(1, 0), gA + ka3, vs0); } else { PG8_STAGE(PG8_SA(1, 0), a3, voffA); }
            PG8_WAIT_V(8); PG8_WAIT_L(0); PG8_BAR; PG8_MMA(1, 0, At, B0); PG8_MMA(1, 1, At, B1); PG8_BAR; PG8_SCHED;
            } else {
            PG8_LDB(B0, 0, 0); PG8_SCHED; PG8_LDA(At, 0, 0); PG8_STAGE(PG8_SA(1, 1), a1 + hstep, voffA);
            PG8_WAIT_L(8); PG8_BAR; PG8_WAIT_L(0); PG8_MMA(0, 0, At, B0); PG8_BAR; PG8_SCHED;
            PG8_LDB(B1, 0, 1); PG8_STAGE(PG8_SB(0, 0), b2, voffB);
            PG8_BAR; PG8_WAIT_L(0); PG8_MMA(0, 1, At, B1); PG8_BAR;
            PG8_LDA(At, 0, 1); PG8_STAGE(PG8_SA(0, 0), a2, voffA);
            PG8_BAR; PG8_WAIT_L(0); PG8_MMA(1, 0, At, B0); PG8_BAR; PG8_SCHED;
            PG8_STAGE(PG8_SB(0, 1), b2 + hstep, voffB);
            PG8_WAIT_V(6); PG8_BAR; PG8_MMA(1, 1, At, B1); PG8_BAR;
            PG8_LDB(B0, 1, 0); PG8_SCHED; PG8_LDA(At, 1, 0); PG8_STAGE(PG8_SA(0, 1), a2 + hstep, voffA);
            PG8_WAIT_L(8); PG8_BAR; PG8_WAIT_L(0); PG8_MMA(0, 0, At, B0); PG8_BAR; PG8_SCHED;
            PG8_LDB(B1, 1, 1); PG8_STAGE(PG8_SB(1, 0), b3, voffB);
            PG8_BAR; PG8_WAIT_L(0); PG8_MMA(0, 1, At, B1); PG8_BAR;
            PG8_LDA(At, 1, 1); PG8_STAGE(PG8_SA(1, 0), a3, voffA);
            PG8_BAR; PG8_WAIT_L(0); PG8_MMA(1, 0, At, B0); PG8_BAR; PG8_SCHED;
            PG8_STAGE(PG8_SB(1, 1), b3 + hstep, voffB);
            PG8_WAIT_V(6); PG8_BAR; PG8_MMA(1, 1, At, B1); PG8_BAR;
            }
        }
        if constexpr (ALIGN_EPI) { if (wr == 0) PG8_BAR; }
        if constexpr (!Epi::AFTER_DRAIN) { E(acc, cur, wr, wc, fr, fq); S.done(cur); }
        if constexpr (Sched::LATE) prv = cur;
        if (!has_next) break;
#pragma unroll
        for (int a = 0; a < 2; ++a)
#pragma unroll
            for (int b = 0; b < 2; ++b)
#pragma unroll
                for (int m = 0; m < 4; ++m)
#pragma unroll
                    for (int n = 0; n < 2; ++n) acc[a][b][m][n] = (f32x4){0.f, 0.f, 0.f, 0.f};
        cur = nxt; cA = nA; cB = nB; ++ui;
        if constexpr (GATHER) { _Pragma("unroll") for (int h_ = 0; h_ < 2; ++h_) _Pragma("unroll") for (int i_ = 0; i_ < 2; ++i_) vA[h_][i_] = vN[h_][i_]; }
        if constexpr (ALIGN_EPI) { if (wr == 1) PG8_BAR; }
    }
    PG8_WAIT_V(0);
    if constexpr (Sched::LATE) S.late(cur);
    if constexpr (!ALIGN_EPI) { if (wr == 0) PG8_BAR; }
    PG8_BAR;
    if constexpr (Epi::AFTER_DRAIN) { E.fused(acc, cur, wr, wc, fr, fq, lds, wid, lane); S.done(cur); }
#undef PG8_GV
#undef PG8_SA
#undef PG8_SB
#undef PG8_STAGE
#undef PG8_LDA
#undef PG8_LDB
#undef PG8_MMA
#undef PG8_WAIT_V
#undef PG8_WAIT_L
#undef PG8_BAR
#undef PG8_SCHED
}
}
namespace attn {
using bf16 = unsigned short;
constexpr int D = 128, NW = 8, QBLK = 32, KVBLK = 64;
constexpr float SCALE = 0.088388347648318440f;
constexpr float THR = 8.f;
constexpr int LDQ = 1024, LDK = 256, LDO = 1024;
constexpr size_t SHM_V = KVBLK * D * 2, SHM_K = KVBLK * D * 2, SHM_ATTN = 2 * SHM_V + 2 * SHM_K + NW * 64 * 4;
using bf16x8 = __attribute__((ext_vector_type(8))) short;
using s16x4  = __attribute__((ext_vector_type(4))) short;
using f32x16 = __attribute__((ext_vector_type(16))) float;
using f32x8  = __attribute__((ext_vector_type(8))) float;
using u32x4  = __attribute__((ext_vector_type(4))) unsigned;
#define KSWZ(row, colB) ((row) * 256 + ((colB) ^ (((row) & 7) << 4)))
#define SBAR() __builtin_amdgcn_sched_barrier(0)
__device__ __forceinline__ int crow(int r, int hi) { return (r & 3) + 8 * (r >> 2) + 4 * hi; }
__device__ __forceinline__ unsigned cvtpk(float lo, float hi) {
  unsigned r; asm volatile("v_cvt_pk_bf16_f32 %0, %1, %2" : "=v"(r) : "v"(lo), "v"(hi)); return r;
}
template <typename TIn> struct Stage;
template <> struct Stage<bf16>  { using T = bf16x8;
  __device__ static __forceinline__ T ld8(const bf16* p) { return *reinterpret_cast<const bf16x8*>(p); }
  __device__ static __forceinline__ bf16x8 tobf(T x) { return x; } };
template <> struct Stage<float> { using T = f32x8;
  __device__ static __forceinline__ T ld8(const float* p) { return *reinterpret_cast<const f32x8*>(p); }
  __device__ static __forceinline__ bf16x8 tobf(T x) {
    u32x4 w = {cvtpk(x[0], x[1]), cvtpk(x[2], x[3]), cvtpk(x[4], x[5]), cvtpk(x[6], x[7])}; return *reinterpret_cast<bf16x8*>(&w); } };

template <bool NOREF> __device__ __forceinline__ void partialSM(f32x16& p0, f32x16& p1, float& m_reg, float& mn, float& alpha) {
  if constexpr (NOREF) { alpha = 1.f; for (int r = 0; r < 16; ++r) p0[r] = __builtin_amdgcn_exp2f(p0[r]); return; }
  constexpr float C = SCALE * 1.4426950408889634f;
  float pmax = p0[0]; for (int r = 1; r < 16; ++r) pmax = fmaxf(pmax, p0[r]); for (int r = 0; r < 16; ++r) pmax = fmaxf(pmax, p1[r]);
  { auto rr = __builtin_amdgcn_permlane32_swap(__float_as_uint(pmax), __float_as_uint(pmax), false, false);
    pmax = fmaxf(__uint_as_float(rr[0]), __uint_as_float(rr[1])); }
  if (__builtin_expect(__all(pmax - m_reg <= THR / SCALE), 1)) { mn = m_reg; alpha = 1.f; }
  else { mn = fmaxf(m_reg, pmax); alpha = __builtin_amdgcn_exp2f((m_reg - mn) * C); m_reg = mn; }
  float mnC = -mn * C;
  for (int r = 0; r < 16; ++r) p0[r] = fmaf(p0[r], C, mnC); for (int r = 0; r < 16; ++r) p1[r] = fmaf(p1[r], C, mnC);
  for (int r = 0; r < 16; ++r) p0[r] = __builtin_amdgcn_exp2f(p0[r]);
}
template <bool NOREF> __device__ __forceinline__ void finishSM(f32x16& p0, f32x16& p1, float alpha, float& l_reg, bf16x8& pa0, bf16x8& pa1, bf16x8& pa2, bf16x8& pa3) {
  for (int r = 0; r < 16; ++r) p1[r] = __builtin_amdgcn_exp2f(p1[r]);
  float ps = 0; for (int r = 0; r < 16; ++r) ps += p0[r]; for (int r = 0; r < 16; ++r) ps += p1[r];
  if constexpr (NOREF) { l_reg += ps; }
  else {
  { auto rr = __builtin_amdgcn_permlane32_swap(__float_as_uint(ps), __float_as_uint(ps), false, false);
    ps = __uint_as_float(rr[0]) + __uint_as_float(rr[1]); }
  l_reg = l_reg * alpha + ps; }
#define PK4(P, BASE, OUT) do { u32x4 w = {cvtpk(P[BASE + 0], P[BASE + 1]), cvtpk(P[BASE + 2], P[BASE + 3]), cvtpk(P[BASE + 4], P[BASE + 5]), cvtpk(P[BASE + 6], P[BASE + 7])}; OUT = *reinterpret_cast<bf16x8*>(&w); } while (0)
  PK4(p0, 0, pa0); PK4(p0, 8, pa1); PK4(p1, 0, pa2); PK4(p1, 8, pa3);
#undef PK4
}
__device__ __forceinline__ void qkt(f32x16& p0, f32x16& p1, const bf16* Ks, const bf16x8* qr, int r32, int hi) {
  p0 = f32x16{}; p1 = f32x16{};
  for (int d0 = 0; d0 < 8; ++d0) { int cb = (d0 * 16 + hi * 8) * 2;
    bf16x8 b0 = *reinterpret_cast<const bf16x8*>((const char*)Ks + KSWZ(r32, cb));
    bf16x8 b1 = *reinterpret_cast<const bf16x8*>((const char*)Ks + KSWZ(32 + r32, cb));
    p0 = __builtin_amdgcn_mfma_f32_32x32x16_bf16(b0, qr[d0], p0, 0, 0, 0);
    p1 = __builtin_amdgcn_mfma_f32_32x32x16_bf16(b1, qr[d0], p1, 0, 0, 0); }
}
__device__ __forceinline__ int v_st(int k, int c) { const int kk = (k & ~0xC) | ((k & 4) << 1) | ((k & 8) >> 1); return ((kk >> 3) * 4 + (c >> 5)) * 512 + ((kk & 7) * 32 + (c & 31)) * 2; }
__device__ __forceinline__ int v_st_nat(int k, int c) { return ((k >> 3) * 4 + (c >> 5)) * 512 + ((k & 7) * 32 + (c & 31)) * 2; }
__device__ __forceinline__ int v_rd_base(int lane) { return ((lane & 3) << 3) | (((lane >> 2) & 3) << 6) | (((lane >> 4) & 1) << 5) | (((lane >> 5) & 1) << 8); }
constexpr int v_rd_off(int d0, int ks, int half) { return d0 * 512 + ks * 4096 + half * 2048; }
template <int OFF> __device__ __forceinline__ s16x4 tr_read(int vb) {
  s16x4 r; asm volatile("ds_read_b64_tr_b16 %0, %1 offset:%2" : "=&v"(r) : "v"(vb), "i"(OFF) : "memory"); return r;
}
template <int D0, bool SM = false> __device__ __forceinline__ void pv_one(f32x16& od, int vb, bf16x8 pa0, bf16x8 pa1, bf16x8 pa2, bf16x8 pa3, f32x16* pn = nullptr) {
  const s16x4 l0 = tr_read<v_rd_off(D0, 0, 0)>(vb), h0 = tr_read<v_rd_off(D0, 0, 1)>(vb), l1 = tr_read<v_rd_off(D0, 1, 0)>(vb), h1 = tr_read<v_rd_off(D0, 1, 1)>(vb);
  const s16x4 l2 = tr_read<v_rd_off(D0, 2, 0)>(vb), h2 = tr_read<v_rd_off(D0, 2, 1)>(vb), l3 = tr_read<v_rd_off(D0, 3, 0)>(vb), h3 = tr_read<v_rd_off(D0, 3, 1)>(vb);
  if constexpr (SM) {
#pragma unroll
    for (int r = 4 * D0; r < 4 * D0 + 4; ++r) (*pn)[r] = __builtin_amdgcn_exp2f((*pn)[r]); }
  asm volatile("s_waitcnt lgkmcnt(0)" ::: "memory"); SBAR();
#define PK(L, H) (bf16x8){L[0], L[1], L[2], L[3], H[0], H[1], H[2], H[3]}
  od = __builtin_amdgcn_mfma_f32_32x32x16_bf16(pa0, PK(l0, h0), od, 0, 0, 0);
  od = __builtin_amdgcn_mfma_f32_32x32x16_bf16(pa1, PK(l1, h1), od, 0, 0, 0);
  od = __builtin_amdgcn_mfma_f32_32x32x16_bf16(pa2, PK(l2, h2), od, 0, 0, 0);
  od = __builtin_amdgcn_mfma_f32_32x32x16_bf16(pa3, PK(l3, h3), od, 0, 0, 0);
#undef PK
}
__device__ __forceinline__ void pv_d0(f32x16* o, int vb, bf16x8 pa0, bf16x8 pa1, bf16x8 pa2, bf16x8 pa3) {
  pv_one<0>(o[0], vb, pa0, pa1, pa2, pa3); pv_one<1>(o[1], vb, pa0, pa1, pa2, pa3); pv_one<2>(o[2], vb, pa0, pa1, pa2, pa3); pv_one<3>(o[3], vb, pa0, pa1, pa2, pa3);
}
__device__ __forceinline__ void pv_d0_sm(f32x16* o, int vb, bf16x8 pa0, bf16x8 pa1, bf16x8 pa2, bf16x8 pa3, f32x16& pn) {
  pv_one<0, true>(o[0], vb, pa0, pa1, pa2, pa3, &pn); pv_one<1, true>(o[1], vb, pa0, pa1, pa2, pa3, &pn); pv_one<2, true>(o[2], vb, pa0, pa1, pa2, pa3, &pn); pv_one<3, true>(o[3], vb, pa0, pa1, pa2, pa3, &pn);
}

template <typename TQ, bool NOREF, int SDEPTH>
__device__ __forceinline__ void attn_dense_body(const TQ* __restrict__ Qb, const bf16* __restrict__ Kh, const bf16* __restrict__ Vh,
                                                bf16* __restrict__ Ob, int seq, char* lds, const int tid, const float* __restrict__ qg, const int t0, const float* __restrict__ rope) {
  using St = Stage<bf16>; using SQ = Stage<TQ>;
  const int wid = tid >> 6, lane = tid & 63, r32 = lane & 31, hi = lane >> 5;
  bf16* V_lds = (bf16*)lds; bf16* K_lds = (bf16*)(lds + 2 * SHM_V);
  float* ws = (float*)(lds + 2 * SHM_V + 2 * SHM_K) + wid * 64; float* li_l = ws; float* al_l = ws + 32;
  float m_reg = -1e30f, l_reg = 0; f32x16 o[4] = {}; bf16x8 qr[8];
  const TQ* Qw = Qb + (long)(wid * QBLK + r32) * LDQ + hi * 8;
#pragma unroll
  for (int d0 = 0; d0 < 8; ++d0) qr[d0] = SQ::tobf(SQ::ld8(Qw + d0 * 16));
  if (qg) {
    float f[8][8]; float ss = 0.f;
#pragma unroll
    for (int d0 = 0; d0 < 8; ++d0) { const u32x4 w = *reinterpret_cast<const u32x4*>(&qr[d0]);
#pragma unroll
      for (int e = 0; e < 4; ++e) { f[d0][2 * e] = __uint_as_float(w[e] << 16); f[d0][2 * e + 1] = __uint_as_float(w[e] & 0xffff0000u); ss += f[d0][2 * e] * f[d0][2 * e] + f[d0][2 * e + 1] * f[d0][2 * e + 1]; } }
    { auto rr = __builtin_amdgcn_permlane32_swap(__float_as_uint(ss), __float_as_uint(ss), false, false); ss = __uint_as_float(rr[0]) + __uint_as_float(rr[1]); }
    const float rs = rsqrtf(ss * (1.f / 128.f) + 1e-6f);
#pragma unroll
    for (int d0 = 0; d0 < 8; ++d0)
#pragma unroll
      for (int j = 0; j < 8; ++j) f[d0][j] *= rs * qg[16 * d0 + 8 * hi + j] * (NOREF ? SCALE * 1.4426950408889634f : 1.f);
    const int t = t0 + wid * QBLK + r32;
#pragma unroll
    for (int d0 = 0; d0 < 4; ++d0) { const float* rp = rope + (d0 < 2 ? (t / 64) : (t % 64)) * 64;
#pragma unroll
      for (int j = 0; j < 8; ++j) { const int fi = (16 * d0 + 8 * hi + j) & 31; const float cs = rp[2 * fi], sn = rp[2 * fi + 1];
        const float x1 = f[d0][j], x2 = f[d0 + 4][j]; f[d0][j] = x1 * cs - x2 * sn; f[d0 + 4][j] = x2 * cs + x1 * sn; } }
#pragma unroll
    for (int d0 = 0; d0 < 8; ++d0) { u32x4 w = {cvtpk(f[d0][0], f[d0][1]), cvtpk(f[d0][2], f[d0][3]), cvtpk(f[d0][4], f[d0][5]), cvtpk(f[d0][6], f[d0][7])}; qr[d0] = *reinterpret_cast<bf16x8*>(&w); }
  }
  const int sr = tid >> 4, sc = (tid & 15) * 8, vst0 = v_st_nat(sr, sc), vst1 = v_st_nat(32 + sr, sc);
  const int vb0 = (int)(uintptr_t)V_lds + v_rd_base(lane);
  struct { typename St::T vs0, vs1, ks0, ks1; } sr_[SDEPTH];
#define SLOAD(i, k0) do { const unsigned o0_ = (unsigned)(((k0) + sr) * LDK + sc), o1_ = o0_ + 32u * LDK;   \
    sr_[i].vs0 = St::ld8(Vh + o0_); sr_[i].vs1 = St::ld8(Vh + o1_); sr_[i].ks0 = St::ld8(Kh + o0_); sr_[i].ks1 = St::ld8(Kh + o1_); } while (0)
#define SWRITE(b, i) do { *(bf16x8*)((char*)V_lds + (b) * SHM_V + vst0) = St::tobf(sr_[i].vs0);          \
    *(bf16x8*)((char*)V_lds + (b) * SHM_V + vst1) = St::tobf(sr_[i].vs1); int kc = sc * 2;               \
    *(bf16x8*)((char*)K_lds + (b) * SHM_K + KSWZ(sr, kc)) = St::tobf(sr_[i].ks0);                       \
    *(bf16x8*)((char*)K_lds + (b) * SHM_K + KSWZ(32 + sr, kc)) = St::tobf(sr_[i].ks1); } while (0)
#define SWAIT() do { if constexpr (SDEPTH == 2) asm volatile("s_waitcnt vmcnt(4)" ::: "memory"); else asm volatile("s_waitcnt vmcnt(0)" ::: "memory"); } while (0)
#define RESC(a) do { if (!NOREF && __any((a) < 1.f)) { if (hi == 0) al_l[r32] = (a); asm volatile("s_waitcnt lgkmcnt(0)" ::: "memory"); \
    for (int d = 0; d < 4; ++d) for (int r = 0; r < 16; ++r) o[d][r] *= al_l[crow(r, hi)]; } } while (0)
  f32x16 pA0, pA1, pB0, pB1; float mnA, mnB, alA, alB; bf16x8 pa0, pa1, pa2, pa3; const int NT = seq / KVBLK;
  constexpr int SE = 0, SO = SDEPTH - 1;
  SLOAD(SE, 0); asm volatile("s_waitcnt vmcnt(0)" ::: "memory"); SWRITE(0, SE); __syncthreads();
  qkt(pA0, pA1, K_lds, qr, r32, hi); partialSM<NOREF>(pA0, pA1, m_reg, mnA, alA);
  SLOAD(SO, KVBLK); if constexpr (SDEPTH == 2) { if (2 < NT) SLOAD(SE, 2 * KVBLK); }
  SWAIT(); SWRITE(1, SO); __syncthreads();
  for (int j = 1; j + 1 < NT; j += 2) {
    SBAR(); qkt(pB0, pB1, (bf16*)((char*)K_lds + SHM_K), qr, r32, hi);
    finishSM<NOREF>(pA0, pA1, alA, l_reg, pa0, pa1, pa2, pa3); SBAR();
    SLOAD(SO, (j + SDEPTH) * KVBLK); SBAR();
    if constexpr (NOREF) { pv_d0_sm(o, vb0, pa0, pa1, pa2, pa3, pB0); alB = 1.f; } else { pv_d0(o, vb0, pa0, pa1, pa2, pa3); partialSM<NOREF>(pB0, pB1, m_reg, mnB, alB); }
    __syncthreads(); SWAIT(); SWRITE(0, SE);
    RESC(alB); __syncthreads();
    SBAR(); qkt(pA0, pA1, K_lds, qr, r32, hi);
    finishSM<NOREF>(pB0, pB1, alB, l_reg, pa0, pa1, pa2, pa3); SBAR();
    if (SDEPTH == 1 || j + 3 < NT) SLOAD(SE, (j + 1 + SDEPTH) * KVBLK); SBAR();
    if constexpr (NOREF) { pv_d0_sm(o, vb0 + (int)SHM_V, pa0, pa1, pa2, pa3, pA0); alA = 1.f; } else { pv_d0(o, vb0 + (int)SHM_V, pa0, pa1, pa2, pa3); partialSM<NOREF>(pA0, pA1, m_reg, mnA, alA); }
    __syncthreads(); SWAIT(); SWRITE(1, SO);
    RESC(alA); __syncthreads();
  }
  SBAR(); qkt(pB0, pB1, (bf16*)((char*)K_lds + SHM_K), qr, r32, hi);
  finishSM<NOREF>(pA0, pA1, alA, l_reg, pa0, pa1, pa2, pa3); SBAR();
  if constexpr (NOREF) { pv_d0_sm(o, vb0, pa0, pa1, pa2, pa3, pB0); alB = 1.f; } else { pv_d0(o, vb0, pa0, pa1, pa2, pa3); partialSM<NOREF>(pB0, pB1, m_reg, mnB, alB); }
  __syncthreads(); RESC(alB);
  finishSM<NOREF>(pB0, pB1, alB, l_reg, pa0, pa1, pa2, pa3); SBAR();
  pv_d0(o, vb0 + (int)SHM_V, pa0, pa1, pa2, pa3);
  if constexpr (NOREF) { auto rr = __builtin_amdgcn_permlane32_swap(__float_as_uint(l_reg), __float_as_uint(l_reg), false, false); l_reg = __uint_as_float(rr[0]) + __uint_as_float(rr[1]); }
  if (hi == 0) li_l[r32] = l_reg; asm volatile("s_waitcnt lgkmcnt(0)" ::: "memory");
  float rli[16];
#pragma unroll
  for (int r = 0; r < 16; ++r) rli[r] = __builtin_amdgcn_rcpf(li_l[crow(r, hi)]);
  bf16* Ow = Ob + (long)(wid * QBLK) * LDO;
#pragma unroll
  for (int r = 0; r < 16; ++r) { int orow = crow(r, hi);
    for (int d0 = 0; d0 < 4; ++d0) Ow[(long)orow * LDO + d0 * 32 + r32] = (bf16)(cvtpk(o[d0][r] * rli[r], 0.f) & 0xffffu); }
#undef SLOAD
#undef SWRITE
#undef SWAIT
#undef RESC
}
}

namespace {
using pg8::bf16_t; using pg8::bf16x8; using pg8::f32x4; using pg8::u32x4;
typedef unsigned u32x2 __attribute__((ext_vector_type(2)));
typedef float f32x16 __attribute__((ext_vector_type(16)));
typedef short s16x4 __attribute__((ext_vector_type(4)));
#define LAS __attribute__((address_space(3)))

constexpr int D = 1024, NBATCH = 2, SEQ = 8192, CTXL = 256;
constexpr int NLAT = NBATCH * SEQ, NCTX = NBATCH * CTXL, NTOK = NLAT + NCTX;
constexpr int SLEN = CTXL + SEQ;
constexpr int NCH = SLEN / 128;
constexpr int ABIN = 5680, NWIN = 5888;
constexpr int NGATE = 48;
constexpr float ALPHA = 1.4142135623730951f;
constexpr int NWAVES = 8, NTHREADS = 512;
constexpr int MOE_MAXTILES = 148;

constexpr size_t MiB = 1u << 20;
constexpr size_t WS_CTL = 0;
constexpr size_t WS_MODV = 64 * 1024;
constexpr size_t WS_ROPE = 208 * 1024;
constexpr size_t WS_DN = 256 * 1024;
constexpr size_t WS_MS = 784 * 1024;
constexpr size_t WS_AEND = 808 * 1024;
constexpr size_t WS_WIN = 1 * MiB;
constexpr size_t WS_WOUT = 12 * MiB + 512 * 1024;
constexpr size_t WS_ATIN = 16 * MiB + 512 * 1024;
constexpr size_t WS_ATOUT = 19 * MiB + 512 * 1024;
constexpr size_t WS_XL = 22 * MiB;
constexpr size_t WS_HB = 88 * MiB;
constexpr size_t WS_MOEW = 121 * MiB;
constexpr size_t WS_ROUTE = 217 * MiB;
constexpr size_t WS_R = 219 * MiB;
constexpr size_t WS_QK = WS_R, WS_V = WS_R + 33 * MiB, WS_O = WS_R + 66 * MiB, WS_Z = WS_R + 99 * MiB, WS_XBC = WS_R + 132 * MiB;
constexpr size_t WS_GATES = WS_R + 182 * MiB;
constexpr size_t WS_SSQ = WS_R + 185 * MiB + 256 * 1024;
constexpr size_t WS_MIX = WS_R + 186 * MiB;
constexpr size_t WS_XC = WS_HB;
constexpr size_t WS_DS = 138 * MiB;
constexpr size_t WS_DC = WS_XL;
constexpr size_t WS_YB = WS_R;
constexpr size_t WS_XS = WS_R, WS_HMID = WS_R + 74 * MiB, WS_YS = WS_R + 148 * MiB;
constexpr size_t WS_Q = WS_R, WS_KB = WS_R + 33 * MiB, WS_VB = WS_R + 42 * MiB, WS_AO = WS_R + 51 * MiB, WS_YB1 = WS_R + 84 * MiB, WS_S = WS_R + 117 * MiB;
constexpr size_t WS_TOKTAB = 472 * MiB;
constexpr size_t WS_MLG = 476 * MiB;
constexpr size_t WS_SSG = 479 * MiB;
constexpr size_t WS_END = 486 * MiB;

constexpr int CW_CNT0 = 64, CW_CNT1 = 128;
constexpr int CW_DEP0 = 256, CW_DEP1 = 512;
constexpr int CW_BAR = 1024;

__device__ __forceinline__ float bf2f(unsigned short v) { return __uint_as_float((unsigned)v << 16); }
typedef float f32x2_t __attribute__((ext_vector_type(2))); typedef __bf16 bf16x2_t __attribute__((ext_vector_type(2)));
__device__ __forceinline__ unsigned pk2(float lo, float hi) { f32x2_t v = {lo, hi}; bf16x2_t b = __builtin_convertvector(v, bf16x2_t); return __builtin_bit_cast(unsigned, b); }
__device__ __forceinline__ bf16_t f2bf(float f) { return (bf16_t)(pk2(f, 0.f) & 0xffffu); }
__device__ __forceinline__ float siluf(float x) { return x * __builtin_amdgcn_rcpf(1.f + __expf(-x)); }
__device__ __forceinline__ float sigmf(float x) { return __builtin_amdgcn_rcpf(1.f + __expf(-x)); }
__device__ __forceinline__ float softplusf(float x) { return x > 20.f ? x : log1pf(expf(x)); }
__device__ __forceinline__ float logsigf(float x) { return -softplusf(-x); }
__device__ __forceinline__ float wave_sum(float v) {
#pragma unroll
    for (int o = 1; o < 64; o <<= 1) v += __shfl_xor(v, o);
    return v;
}
__device__ __forceinline__ float wave_max(float v) {
#pragma unroll
    for (int o = 1; o < 64; o <<= 1) v = fmaxf(v, __shfl_xor(v, o));
    return v; }
__device__ __forceinline__ unsigned char* launder_ptr(unsigned char* p) { asm volatile("" : "+s"(p)); return p; }
__device__ __forceinline__ int fresh_lane() { int z = 0; asm volatile("" : "+s"(z)); return (int)__builtin_amdgcn_mbcnt_hi(~0u, __builtin_amdgcn_mbcnt_lo(~0u, (unsigned)z)); }
__device__ __forceinline__ int mod_index(int row) { return row < NLAT ? row / SEQ : 2; }
__device__ __forceinline__ int seq_row(int b, int dir, int i) {
    if (i < CTXL) { int t = dir ? (CTXL - 1 - i) : i; return NLAT + b * CTXL + t; }
    int t = i - CTXL; if (dir) t = SEQ - 1 - t; return b * SEQ + t;
}
__device__ __forceinline__ int chunk_row0(int b, int cid) { return cid < 2 ? NLAT + b * CTXL + cid * 128 : b * SEQ + (cid - 2) * 128; }
__device__ __forceinline__ int scan_cid(int dir, int p) { return dir == 0 ? p : (p < 2 ? 1 - p : 67 - p); }

struct RowF { f32x4 v[4]; };
__device__ __forceinline__ RowF row_ld_f32(const float* p, int lane) { RowF r; const f32x4* q = (const f32x4*)p + lane;
#pragma unroll
    for (int j = 0; j < 4; ++j) r.v[j] = q[64 * j];
    return r; }
__device__ __forceinline__ RowF row_ld_bf16(const bf16_t* p, int lane) { RowF r; const u32x2* q = (const u32x2*)p + lane;
#pragma unroll
    for (int j = 0; j < 4; ++j) { const u32x2 w = q[64 * j]; r.v[j] = (f32x4){__uint_as_float(w.x << 16), __uint_as_float(w.x & 0xffff0000u), __uint_as_float(w.y << 16), __uint_as_float(w.y & 0xffff0000u)}; }
    return r; }
struct RowRaw { u32x2 w[4]; };
__device__ __forceinline__ RowRaw row_ldraw_bf16(const bf16_t* p, int lane) { RowRaw r; const u32x2* q = (const u32x2*)p + lane;
#pragma unroll
    for (int j = 0; j < 4; ++j) r.w[j] = q[64 * j];
    return r; }
__device__ __forceinline__ RowF row_cvt(const RowRaw& t) { RowF r;
#pragma unroll
    for (int j = 0; j < 4; ++j) r.v[j] = (f32x4){__uint_as_float(t.w[j].x << 16), __uint_as_float(t.w[j].x & 0xffff0000u), __uint_as_float(t.w[j].y << 16), __uint_as_float(t.w[j].y & 0xffff0000u)};
    return r; }
__device__ __forceinline__ void row_st_f32(float* p, int lane, const RowF& r) { f32x4* q = (f32x4*)p + lane;
#pragma unroll
    for (int j = 0; j < 4; ++j) q[64 * j] = r.v[j]; }
__device__ __forceinline__ void row_st_bf16(bf16_t* p, int lane, const RowF& r) { u32x2* q = (u32x2*)p + lane;
#pragma unroll
    for (int j = 0; j < 4; ++j) { u32x2 w; w.x = pk2(r.v[j][0], r.v[j][1]); w.y = pk2(r.v[j][2], r.v[j][3]); q[64 * j] = w; } }
__device__ __forceinline__ float row_sum(const RowF& r) { float s = 0.f;
#pragma unroll
    for (int j = 0; j < 4; ++j) s += (r.v[j][0] + r.v[j][1]) + (r.v[j][2] + r.v[j][3]);
    return wave_sum(s); }
__device__ __forceinline__ void row_layernorm(RowF& r, const float* g, const float* b, int lane) {
    const float mu = row_sum(r) * (1.f / D); float q = 0.f;
#pragma unroll
    for (int j = 0; j < 4; ++j) { r.v[j] = r.v[j] - mu; q += (r.v[j][0] * r.v[j][0] + r.v[j][1] * r.v[j][1]) + (r.v[j][2] * r.v[j][2] + r.v[j][3] * r.v[j][3]); }
    const float rstd = rsqrtf(wave_sum(q) * (1.f / D) + 1e-5f);
    const RowF gg = row_ld_f32(g, lane), bb = row_ld_f32(b, lane);
#pragma unroll
    for (int j = 0; j < 4; ++j) r.v[j] = r.v[j] * rstd * gg.v[j] + bb.v[j];
}
__device__ __forceinline__ RowF row_modulate(const RowF& x, const float* sh, const float* sc, int lane) {
    const RowF s = row_ld_f32(sh, lane), c = row_ld_f32(sc, lane); RowF h;
#pragma unroll
    for (int j = 0; j < 4; ++j) h.v[j] = x.v[j] * (1.f + c.v[j]) + s.v[j];
    return h; }

template <class Dest> struct EpiStore {
    static constexpr bool PERM = true, AFTER_DRAIN = false, MIDK = false; Dest d;
    __device__ __forceinline__ void operator()(const f32x4 (&acc)[2][2][4][2], const pg8::Unit& u, int wr, int wc, int fr, int fq) const {
#pragma unroll
        for (int ai = 0; ai < 2; ++ai)
#pragma unroll
            for (int m = 0; m < 4; ++m) {
                const int row = u.pm * 256 + ai * 128 + wr * 64 + m * 16 + fr;
                bf16_t* rp = d.rowptr(row, u.pn); if (!rp) continue;
#pragma unroll
                for (int bj = 0; bj < 2; ++bj) { const f32x4 v0 = acc[ai][bj][m][0], v1 = acc[ai][bj][m][1];
                    u32x4 w; w.x = pk2(v0[0], v0[1]); w.y = pk2(v0[2], v0[3]); w.z = pk2(v1[0], v1[1]); w.w = pk2(v1[2], v1[3]);
                    *(u32x4*)(rp + bj * 128 + wc * 32 + 8 * fq) = w; }
            }
    }
};
struct DestWin { bf16_t* base;
    __device__ __forceinline__ bf16_t* rowptr(int row, int pn) const {
        if (pn < 16) { const int seg = pn >> 2; return base + (size_t)seg * (33 * MiB / 2) + (size_t)row * 1024 + (pn & 3) * 256; }
        return base + (size_t)4 * (33 * MiB / 2) + (size_t)row * 1536 + (pn - 16) * 256; } };
struct EpiWin {
    static constexpr bool PERM = true, AFTER_DRAIN = false, MIDK = false; EpiStore<DestWin> st; float* gates; const float* igb; const float* fgb; const float* dtb;
    __device__ __forceinline__ void operator()(const f32x4 (&acc)[2][2][4][2], const pg8::Unit& u, int wr, int wc, int fr, int fq) const {
        if (u.pn < 22) { st(acc, u, wr, wc, fr, fq); return; }
        const int c0 = wc * 32 + 8 * fq;
        if (c0 >= NGATE) return;
        float bias[8];
#pragma unroll
        for (int i = 0; i < 8; ++i) { const int c = c0 + i; bias[i] = c < 8 ? igb[c] : (c < 16 ? fgb[c - 8] : dtb[c - 16]); }
#pragma unroll
        for (int ai = 0; ai < 2; ++ai)
#pragma unroll
            for (int m = 0; m < 4; ++m) { const int row = u.pm * 256 + ai * 128 + wr * 64 + m * 16 + fr;
                float v[8];
#pragma unroll
                for (int i = 0; i < 8; ++i) { const float x = acc[ai][0][m][i >> 2][i & 3] + bias[i]; const int c = c0 + i; v[i] = c < 8 ? x : (c < 16 ? logsigf(x) : softplusf(x)); }
                float* gp = gates + (size_t)row * NGATE + c0;
                *(f32x4*)gp = (f32x4){v[0], v[1], v[2], v[3]}; *(f32x4*)(gp + 4) = (f32x4){v[4], v[5], v[6], v[7]}; }
    }
};
struct DestPlain { bf16_t* base; int ld; int pnmask;
    __device__ __forceinline__ bf16_t* rowptr(int row, int pn) const { return base + (size_t)row * ld + (pn & pnmask) * 256; } };
struct DestQKV { bf16_t* q; bf16_t* kb; bf16_t* vb;
    __device__ __forceinline__ bf16_t* rowptr(int row, int pn) const {
        if (pn < 4) return row < NLAT ? q + (size_t)row * 1024 + pn * 256 : nullptr;
        int key; if (row < NLAT) { const int b = row / SEQ, t = row % SEQ; key = b * SLEN + CTXL + t; } else { const int r = row - NLAT; key = (r / CTXL) * SLEN + (r % CTXL); }
        return (pn == 4 ? kb : vb) + (size_t)key * 256; } };
struct EpiWout {
    static constexpr bool PERM = true, AFTER_DRAIN = false, MIDK = true; EpiStore<DestPlain> st; const float* ssq;
    __device__ __forceinline__ void operator()(const f32x4 (&acc)[2][2][4][2], const pg8::Unit& u, int wr, int wc, int fr, int fq) const { st(acc, u, wr, wc, fr, fq); }
    __device__ __forceinline__ void midk(f32x4 (&acc)[2][2][4][2], const pg8::Unit& u, int wr, int wc, int fr, int fq) const {
        const float* p0 = ssq + (size_t)(u.pm * 256 + wr * 64 + fr) * 8; asm volatile("" : "+v"(p0));
#pragma unroll
        for (int ai = 0; ai < 2; ++ai)
#pragma unroll
            for (int m = 0; m < 4; ++m) { const float* p = p0 + (ai * 128 + m * 16) * 8;
                const f32x4 s0 = *(const f32x4*)p, s1 = *(const f32x4*)(p + 4);
                const float r = rsqrtf((((s0[0] + s0[1]) + (s0[2] + s0[3])) + ((s1[0] + s1[1]) + (s1[2] + s1[3]))) * (1.f / 1024.f) + 1e-6f);
#pragma unroll
                for (int bj = 0; bj < 2; ++bj)
#pragma unroll
                    for (int n = 0; n < 2; ++n) acc[ai][bj][m][n] = acc[ai][bj][m][n] * r;
                __builtin_amdgcn_sched_barrier(0); }
    }
};
template <bool WT = false> struct EpiSwigluT {
    static constexpr bool PERM = true, AFTER_DRAIN = false, MIDK = false; bf16_t* out;
    __device__ __forceinline__ void operator()(const f32x4 (&acc)[2][2][4][2], const pg8::Unit& u, int wr, int wc, int fr, int fq) const {
        const int pnl = u.pn & 7;
#pragma unroll
        for (int ai = 0; ai < 2; ++ai)
#pragma unroll
            for (int m = 0; m < 4; ++m) {
                const int row = u.pm * 256 + ai * 128 + wr * 64 + m * 16 + fr;
                bf16_t* rp = out + (size_t)row * 1024 + pnl * 128 + wc * 16 + 4 * fq;
#pragma unroll
                for (int bj = 0; bj < 2; ++bj) { const f32x4 g = acc[ai][bj][m][0], up = acc[ai][bj][m][1];
                    u32x2 w; w.x = pk2(siluf(g[0]) * up[0], siluf(g[1]) * up[1]); w.y = pk2(siluf(g[2]) * up[2], siluf(g[3]) * up[3]);
                    if constexpr (WT) __hip_atomic_store((__attribute__((address_space(1))) unsigned long long*)(rp + bj * 64), (unsigned long long)w.x | ((unsigned long long)w.y << 32), __ATOMIC_RELAXED, __HIP_MEMORY_SCOPE_AGENT);
                    else *(u32x2*)(rp + bj * 64) = w; }
            }
    }
};
using EpiSwiglu = EpiSwigluT<false>;
struct MoeOrder {
    int ntm, npn, nwg, G, c; const LAS int* toff; const int* tab;
    __device__ __forceinline__ void init(const LAS int* toff_, int npn_, int G_, int c_) { toff = toff_; ntm = toff_[16]; npn = npn_; nwg = ntm * npn_; G = G_; c = c_; }
    __device__ __forceinline__ bool next(int i, pg8::Unit& u) const {
        const long L = (long)i * G + c; if (L >= nwg) return false;
        int wgid = (int)L; { const int q = nwg / 8, r = nwg % 8, xcd = wgid % 8, off = wgid / 8; wgid = (xcd < r ? xcd * (q + 1) : r * (q + 1) + (xcd - r) * q) + off; }
        const int pm = wgid / npn, pnl = wgid % npn; int e = 0;
#pragma unroll
        for (int k = 1; k < 16; ++k) e += (toff[k] <= pm) ? 1 : 0;
        u.pm = pm; u.pn = e * npn + pnl; return true;
    }
    __device__ __forceinline__ int arow(const pg8::Unit& u, int r) const { const int e = u.pn / npn, pos = (u.pm - toff[e]) * 256 + r; return pos < toff[100 + e] ? tab[(size_t)e * NTOK + pos] : 0; }
    static constexpr bool LATE = false;
    __device__ __forceinline__ void a_ready(const pg8::Unit&) const {}
    __device__ __forceinline__ void done(const pg8::Unit&) const {}
    __device__ __forceinline__ void late(const pg8::Unit&) const {}
};

struct MoeMerged {
    static constexpr bool LATE = true;
    int m0, nm, nloc, rank, n1c, crot; const LAS int* toff; const int* tab; unsigned* dep;
    __device__ __forceinline__ void init(const LAS int* toff_, const int* tab_, unsigned* dep_) {
        toff = toff_; tab = tab_; dep = dep_; m0 = toff_[120]; nm = toff_[121]; nloc = toff_[122]; rank = toff_[123];
        const int n1 = nm * 8; n1c = rank < n1 ? (n1 - rank + nloc - 1) / nloc : 0; const int rot = n1 % nloc; crot = (rank - rot + nloc) % nloc; }
    __device__ __forceinline__ bool next(int i, pg8::Unit& u) const {
        int pm, pnl, npn, base;
        if (i < n1c) { const int t1 = i * nloc + rank; pm = m0 + (t1 >> 3); pnl = t1 & 7; npn = 8; base = 0; }
        else { const int t2 = (i - n1c) * nloc + crot; if (t2 >= nm * 4) return false; pm = m0 + (t2 >> 2); pnl = t2 & 3; npn = 4; base = 128; }
        int e = 0;
#pragma unroll
        for (int k = 1; k < 16; ++k) e += (toff[k] <= pm) ? 1 : 0;
        u.pm = pm; u.pn = base + e * npn + pnl; return true;
    }
    __device__ __forceinline__ int arow(const pg8::Unit& u, int r) const {
        if (u.pn >= 128) return (int)((WS_HMID - WS_HB) / 2048) + u.pm * 256 + r;
        const int e = u.pn >> 3, pos = (u.pm - toff[e]) * 256 + r; return pos < toff[100 + e] ? tab[(size_t)e * NTOK + pos] : 0; }
    __device__ __forceinline__ void a_ready(const pg8::Unit& u) const {
        if (u.pn >= 128) { unsigned* w = dep + u.pm; unsigned sp = 0;
            while ((unsigned)__builtin_amdgcn_readfirstlane(__hip_atomic_load(w, __ATOMIC_RELAXED, __HIP_MEMORY_SCOPE_AGENT)) < 64u) { __builtin_amdgcn_s_sleep(1); if (++sp > (1u << 22)) break; }
            asm volatile("" ::: "memory"); }
    }
    __device__ __forceinline__ void done(const pg8::Unit&) const {}
    __device__ __forceinline__ void late(const pg8::Unit& u) const {
        if (u.pn < 128) { asm volatile("s_waitcnt vmcnt(0)" ::: "memory"); if (fresh_lane() == 0) (void)__hip_atomic_fetch_add(dep + u.pm, 1u, __ATOMIC_RELAXED, __HIP_MEMORY_SCOPE_AGENT); }
    }
};
struct EpiMoe {
    static constexpr bool PERM = true, AFTER_DRAIN = false, MIDK = false; EpiSwigluT<false> sw; EpiStore<DestPlain> st;
    __device__ __forceinline__ void operator()(const f32x4 (&acc)[2][2][4][2], const pg8::Unit& u, int wr, int wc, int fr, int fq) const {
        if (u.pn < 128) sw(acc, u, wr, wc, fr, fq); else st(acc, u, wr, wc, fr, fq); }
};

#define XB_TMO      128
#define XB_XCNT(j)  (256  + 64 * (j))
#define XB_XSUB(j)  (1280 + 64 * (j))
#define XB_XGEN(j)  (2304 + 64 * (j))
#define XB_TOP      3328
#define XB_TOPGEN   3392
#define XCD_BAR_WORDS 3456
#define XB_SPIN_CAP (1u << 18)

__device__ __forceinline__ unsigned xb_ld(unsigned* p)              { return __hip_atomic_load(p, __ATOMIC_RELAXED, __HIP_MEMORY_SCOPE_AGENT); }
__device__ __forceinline__ unsigned xb_add(unsigned* p, unsigned v) { return __hip_atomic_fetch_add(p, v, __ATOMIC_RELAXED, __HIP_MEMORY_SCOPE_AGENT); }
__device__ __forceinline__ unsigned xb_xcc_id() { return (unsigned)__builtin_amdgcn_s_getreg((3 << 11) | 20) & 0xFu; }
#define XB_SPIN(cond, bar) do { unsigned _sp = 0; while (cond) { __builtin_amdgcn_s_sleep(1); \
    if ((++_sp & 255u) == 0u) { if (xb_ld(&(bar)[XB_TMO])) break; if (_sp > XB_SPIN_CAP) { atomicAdd(&(bar)[XB_TMO], 1u); break; } } } } while (0)

struct XcdBarrier {
    unsigned* bar; unsigned x;
    volatile LAS unsigned* st;
};

__device__ __forceinline__ XcdBarrier xcd_barrier_post(unsigned* bar, volatile LAS unsigned* st, int tid) {
    XcdBarrier b; b.bar = bar; b.x = xb_xcc_id(); b.st = st;
    if (tid == 0) { st[2] = xb_add(&bar[XB_XCNT(b.x)], 1u); st[3] = b.x; }
    return b;
}
__device__ __forceinline__ void xcd_barrier_complete(unsigned* bar, unsigned x, unsigned& nloc, unsigned& nx) {
    const unsigned G = gridDim.x * gridDim.y * gridDim.z;
    unsigned sum, cnt, mine, sp = 0u;
    for (;;) {
        sum = 0u; cnt = 0u; mine = 0u;
#pragma unroll
        for (unsigned j = 0; j < 16; ++j) { const unsigned c = xb_ld(&bar[XB_XCNT(j)]); sum += c; cnt += (c > 0u) ? 1u : 0u; mine = (j == x) ? c : mine; }
        if (sum == G) break;
        __builtin_amdgcn_s_sleep(1);
        if ((++sp & 255u) == 0u) { if (xb_ld(&bar[XB_TMO])) break; if (sp > XB_SPIN_CAP) { atomicAdd(&bar[XB_TMO], 1u); break; } }
    }
    nloc = mine > 0u ? mine : 1u; nx = cnt > 0u ? cnt : 1u;
}

__device__ __forceinline__ void xcd_barrier(const XcdBarrier& b, int tid) {
    asm volatile("s_waitcnt vmcnt(0)" ::: "memory");
    __syncthreads();
    if (tid == 0) {
        unsigned* bar = b.bar;
        __builtin_amdgcn_s_waitcnt(0);
        unsigned nloc = b.st[0], nx = b.st[1];
        if (nloc == 0u) { xcd_barrier_complete(bar, b.x, nloc, nx); b.st[0] = nloc; b.st[1] = nx; }
        const unsigned old = xb_add(&bar[XB_XSUB(b.x)], 1u);
        const unsigned gen = old / nloc;
        if (old + 1u == (gen + 1u) * nloc) {
            __builtin_amdgcn_fence(__ATOMIC_RELEASE, "agent");
            asm volatile("s_waitcnt vmcnt(0)" ::: "memory");
            const unsigned og = xb_add(&bar[XB_TOP], 1u);
            const unsigned tg = og / nx;
            if (og + 1u == (tg + 1u) * nx) xb_add(&bar[XB_TOPGEN], 1u);
            else XB_SPIN(xb_ld(&bar[XB_TOPGEN]) == tg, bar);
            __builtin_amdgcn_fence(__ATOMIC_ACQUIRE, "agent");
            xb_add(&bar[XB_XGEN(b.x)], 1u);
            asm volatile("s_waitcnt vmcnt(0)" ::: "memory");
        } else {
            XB_SPIN(xb_ld(&bar[XB_XGEN(b.x)]) == gen, bar);
            __builtin_amdgcn_fence(__ATOMIC_ACQUIRE, "agent");
            asm volatile("s_waitcnt vmcnt(0)" ::: "memory");
        }
    }
    __syncthreads();
}

struct Args {
    const float* in[28]; float* out; unsigned char* ws; int ph_lo, ph_hi, li, pad;
};
struct Ctx {
    LAS unsigned char* lds; unsigned char* ws;
    int tid, lane, wave, G, bid;
};
#define CTLP(F) ((unsigned*)((F).ws + WS_CTL))
#define MISCP(F) ((LAS int*)((F).lds + MISC_OFF))
#define GWID(F) ((F).bid * NWAVES + (F).wave)
#define NGW(F) ((F).G * NWAVES)
enum { I_X = 0, I_C, I_CTX, I_CCTX, I_ADAW, I_ADAB, I_LNG, I_LNB, I_ABWIN, I_ABWOUT, I_IGB, I_FGB, I_MNG, I_CONVW, I_CONVB, I_DTB, I_ALOG, I_SSMD, I_SNG,
       I_ATWIN, I_ATWOUT, I_QG, I_KG, I_RW, I_RB, I_WG, I_WU, I_WD };
constexpr int RING_BYTES = 131072, MISC_OFF = RING_BYTES, LDS_BYTES = RING_BYTES + 12288;

template <class Src> __device__ __forceinline__ void transpose_item(const Src& S, bf16_t* WT, int K, int orow0, int k0, LAS float* scr, int lane, float scale) {
#pragma unroll 8
    for (int i = 0; i < 32; ++i) { const int kk = 2 * i + (lane >> 5); scr[kk * 33 + (lane & 31)] = S.ld(k0 + kk, lane & 31); }
    asm volatile("s_waitcnt lgkmcnt(0)" ::: "memory");
    const int c = lane & 7;
#pragma unroll
    for (int j = 0; j < 4; ++j) { const int n = (lane >> 3) + 8 * j; const LAS float* s = scr + (8 * c) * 33 + S.scol(n);
        u32x4 o; o.x = pk2(s[0 * 33] * scale, s[1 * 33] * scale); o.y = pk2(s[2 * 33] * scale, s[3 * 33] * scale); o.z = pk2(s[4 * 33] * scale, s[5 * 33] * scale); o.w = pk2(s[6 * 33] * scale, s[7 * 33] * scale);
        *(u32x4*)(WT + (size_t)(orow0 + n) * K + k0 + 8 * c) = o; }
    asm volatile("s_waitcnt lgkmcnt(0)" ::: "memory");
}
struct SrcPlain { const float* W; int N; int n0;
    __device__ __forceinline__ float ld(int k, int j) const { return W[(size_t)k * N + n0 + j]; }
    __device__ __forceinline__ int scol(int n) const { return n; } };
struct SrcGate { const float* W; int j0;
    __device__ __forceinline__ float ld(int k, int j) const { const int jj = j0 + j; return jj < 16 ? W[(size_t)k * ABIN + 3072 + jj] : (jj < NGATE ? W[(size_t)k * ABIN + 5648 + (jj - 16)] : 0.f); }
    __device__ __forceinline__ int scol(int n) const { return n; } };
struct SrcWout { const float* W; const float* g; int n0;
    __device__ __forceinline__ float ld(int k, int j) const { return k < 1024 ? W[(size_t)(k + 1024) * 1024 + n0 + j] * g[k] : W[(size_t)(k - 1024) * 1024 + n0 + j]; }
    __device__ __forceinline__ int scol(int n) const { return n; } };
struct SrcGU { const float* Wg; const float* Wu; int c0;
    __device__ __forceinline__ float ld(int k, int j) const { return (j < 16 ? Wg : Wu)[(size_t)k * 1024 + c0 + (j & 15)]; }
    __device__ __forceinline__ int scol(int n) const { const int b4 = n >> 3, w = n & 7; return (w < 4 ? 0 : 16) + 4 * b4 + (w & 3); } };

__device__ __forceinline__ void convert_small_weights(Ctx& F, const Args& a) {
    {   float* rope = (float*)(F.ws + WS_ROPE);
        for (int i = F.bid * NTHREADS + F.tid; i < 128 * 32; i += F.G * NTHREADS) { const int pos = i >> 5, fi = i & 31; float sn, cs; sincosf((float)pos * expf(-(float)fi * (9.210340371976184f / 32.f)), &sn, &cs); rope[2 * i] = cs; rope[2 * i + 1] = sn; } }
    LAS float* scr = (LAS float*)(F.lds + F.wave * 16384);
    bf16_t* WinT = (bf16_t*)(F.ws + WS_WIN); bf16_t* WoutT = (bf16_t*)(F.ws + WS_WOUT); bf16_t* AtInT = (bf16_t*)(F.ws + WS_ATIN); bf16_t* AtOutT = (bf16_t*)(F.ws + WS_ATOUT);
    constexpr int I0 = 16 * (NWIN / 32), I1 = 32 * 32, I2 = 16 * 48, I3 = 16 * 32, NI = I0 + I1 + I2 + I3;
    for (int it = GWID(F); it < NI; it += NGW(F)) {
        int r = it;
        if (r < I0) { const int kb = r / (NWIN / 32), nb = r % (NWIN / 32), n0 = 32 * nb;
            if (n0 < 5632) { SrcPlain S{a.in[I_ABWIN], ABIN, n0 < 3072 ? n0 : n0 + 16}; transpose_item(S, WinT, 1024, n0, 64 * kb, scr, F.lane, n0 < 512 ? 0.08838834764831845f : 1.f); }
            else { SrcGate S{a.in[I_ABWIN], n0 - 5632}; transpose_item(S, WinT, 1024, n0, 64 * kb, scr, F.lane, 1.f); }
            continue; } r -= I0;
        if (r < I1) { const int kb = r / 32, nb = r % 32; SrcWout S{a.in[I_ABWOUT], a.in[I_SNG], 32 * nb}; transpose_item(S, WoutT, 2048, 32 * nb, 64 * kb, scr, F.lane, 1.f); continue; } r -= I1;
        if (r < I2) { const int kb = r / 48, nb = r % 48; SrcPlain S{a.in[I_ATWIN], 1536, 32 * nb}; transpose_item(S, AtInT, 1024, 32 * nb, 64 * kb, scr, F.lane, 1.f); continue; } r -= I2;
        { const int kb = r / 32, nb = r % 32; SrcPlain S{a.in[I_ATWOUT], 1024, 32 * nb}; transpose_item(S, AtOutT, 1024, 32 * nb, 64 * kb, scr, F.lane, 1.f); }
    }
}
__device__ __forceinline__ void convert_moe_weights(Ctx& F, const Args& a, int layer, int skip_blocks, int it0 = 0, int it1 = 16 * 16 * 64 + 16 * 16 * 32) {
    if (F.bid < skip_blocks) return;
    LAS float* scr = (LAS float*)(F.lds + F.wave * 16384);
    bf16_t* WGU = (bf16_t*)(F.ws + WS_MOEW); bf16_t* WD = (bf16_t*)(F.ws + WS_MOEW + 64 * MiB);
    const size_t wl = (size_t)layer * 16 * 1024 * 1024;
    constexpr int IGU = 16 * 16 * 64, IDN = 16 * 16 * 32;
    for (int it = it0 + (F.bid - skip_blocks) * NWAVES + F.wave; it < it1; it += (F.G - skip_blocks) * NWAVES) {
        if (it < IGU) { const int e = it / 1024, r = it % 1024, kb = r / 64, nb = r % 64;
            SrcGU S{a.in[I_WG] + wl + (size_t)e * 1048576, a.in[I_WU] + wl + (size_t)e * 1048576, 16 * nb};
            transpose_item(S, WGU + (size_t)e * 2048 * 1024, 1024, 32 * nb, 64 * kb, scr, F.lane, 1.f); }
        else { const int r0 = it - IGU, e = r0 / 512, r = r0 % 512, kb = r / 32, nb = r % 32;
            SrcPlain S{a.in[I_WD] + wl + (size_t)e * 1048576, 1024, 32 * nb};
            transpose_item(S, WD + (size_t)e * 1024 * 1024, 1024, 32 * nb, 64 * kb, scr, F.lane, 1.f); }
    }
}
__device__ __forceinline__ void ada_phase(Ctx& F, const Args& a) {
    LAS float* red = (LAS float*)(F.lds + 8 * 16384);
    float* modv = (float*)(F.ws + WS_MODV);
    for (int item = F.bid; item < 2 * 96; item += F.G) {
        const int l = item / 96, n = (item % 96) * 64 + F.lane;
        float a0 = 0.f, a1 = 0.f, a2 = 0.f;
        const float* w = a.in[I_ADAW] + ((size_t)l * 1024 + F.wave * 128) * 6144 + n;
#pragma unroll 16
        for (int k = 0; k < 128; ++k) { const float wv = w[(size_t)k * 6144]; const int kk = F.wave * 128 + k;
            a0 += siluf(a.in[I_C][kk]) * wv; a1 += siluf(a.in[I_C][1024 + kk]) * wv; a2 += siluf(a.in[I_CCTX][kk]) * wv; }
        LAS float* rr = (LAS float*)F.lds;
        rr[(F.wave * 3 + 0) * 64 + F.lane] = a0; rr[(F.wave * 3 + 1) * 64 + F.lane] = a1; rr[(F.wave * 3 + 2) * 64 + F.lane] = a2;
        __syncthreads();
        if (F.wave < 3) { float s = 0.f;
#pragma unroll
            for (int w8 = 0; w8 < 8; ++w8) s += rr[(w8 * 3 + F.wave) * 64 + F.lane];
            modv[(l * 3 + F.wave) * 6144 + n] = s + a.in[I_ADAB][l * 6144 + n]; }
        __syncthreads();
    }
    (void)red;
}

template <int NC> __device__ __forceinline__ void row_dots(const RowF& h, const float* W, int lane, float (&acc)[NC]) {
#pragma unroll
    for (int i = 0; i < NC; ++i) acc[i] = 0.f;
#pragma unroll
    for (int j = 0; j < 4; ++j)
#pragma unroll
        for (int e = 0; e < 4; ++e) { const float x = h.v[j][e]; const f32x4* w = (const f32x4*)(W + (size_t)(4 * lane + 256 * j + e) * NC);
#pragma unroll
            for (int q = 0; q < NC / 4; ++q) { const f32x4 wv = w[q]; acc[4 * q + 0] += x * wv[0]; acc[4 * q + 1] += x * wv[1]; acc[4 * q + 2] += x * wv[2]; acc[4 * q + 3] += x * wv[3]; } }
}
template <int O, int N> __device__ __forceinline__ void xreduce_step(float (&acc)[N], int lane) {
    const bool up = (lane & O) != 0;
#pragma unroll
    for (int i = 0; i < O; ++i) { const float keep = up ? acc[i + O] : acc[i], send = up ? acc[i] : acc[i + O]; acc[i] = keep + __shfl_xor(send, O); }
}
template <int N> __device__ __forceinline__ float xreduce(float (&acc)[N], int lane) {
    if constexpr (N == 16) {
#pragma unroll
        for (int i = 0; i < 16; ++i) { acc[i] += __shfl_xor(acc[i], 32); acc[i] += __shfl_xor(acc[i], 16); }
    }
    if constexpr (N == 64) { xreduce_step<32, N>(acc, lane); xreduce_step<16, N>(acc, lane); }
    xreduce_step<8, N>(acc, lane); xreduce_step<4, N>(acc, lane); xreduce_step<2, N>(acc, lane); xreduce_step<1, N>(acc, lane);
    return acc[0];
}

__device__ __forceinline__ const float* x_row(const Args& a, int row) { return row < NLAT ? a.in[I_X] + (size_t)row * D : a.in[I_CTX] + (size_t)(row - NLAT) * D; }
__device__ __forceinline__ void rowpass_a(Ctx& F, const Args& a) {
    const float* modv = (const float*)(F.ws + WS_MODV);
    bf16_t* HB = (bf16_t*)(F.ws + WS_HB);
    int row = GWID(F); if (row >= NTOK) return;
    RowF xn = row_ld_f32(x_row(a, row), F.lane);
    for (; row < NTOK; row += NGW(F)) {
        const RowF x = xn; const int nrow = row + NGW(F);
        if (nrow < NTOK) xn = row_ld_f32(x_row(a, nrow), F.lane);
        const float* m = modv + mod_index(row) * 6144;
        const RowF h = row_modulate(x, m, m + 1024, F.lane);
        row_st_bf16(HB + (size_t)row * D, F.lane, h);
    }
}
__device__ __forceinline__ void stage_router(Ctx& F, const float* rw) {
    LAS f32x4* Wl = (LAS f32x4*)F.lds;
    for (int i = F.tid; i < 4096; i += NTHREADS) { const int d = i >> 2, q = i & 3; const f32x4 w = *(const f32x4*)(rw + d * 16 + q * 4);
        Wl[q * 1024 + ((d >> 8) * 4 + (d & 3)) * 64 + ((d >> 2) & 63)] = w; }
    __syncthreads();
}
__device__ __forceinline__ void row_dots16_lds(const RowF& h, const LAS f32x4* Wl, int lane, float (&acc)[16]) {
#pragma unroll
    for (int i = 0; i < 16; ++i) acc[i] = 0.f;
#pragma unroll
    for (int j = 0; j < 4; ++j)
#pragma unroll
        for (int e = 0; e < 4; ++e) { const float x = h.v[j][e];
#pragma unroll
            for (int q = 0; q < 4; ++q) { const f32x4 wv = Wl[q * 1024 + (j * 4 + e) * 64 + lane]; acc[4 * q + 0] += x * wv[0]; acc[4 * q + 1] += x * wv[1]; acc[4 * q + 2] += x * wv[2]; acc[4 * q + 3] += x * wv[3]; }
            if (e & 1) __builtin_amdgcn_sched_barrier(0); }
}
__device__ __forceinline__ void route_row(const RowF& h2, const LAS f32x4* Wl, const float* rb, int lane, int& e0, int& e1, float& g0, float& g1) {
    float acc[16]; row_dots16_lds(h2, Wl, lane, acc);
    const float logit = xreduce<16>(acc, lane);
    float mx = logit;
#pragma unroll
    for (int o = 8; o >= 1; o >>= 1) mx = fmaxf(mx, __shfl_xor(mx, o));
    const float ex = expf(logit - mx); float sm = ex;
#pragma unroll
    for (int o = 8; o >= 1; o >>= 1) sm += __shfl_xor(sm, o);
    const float p = ex / sm, sel = p + rb[lane & 15];
    float s4[4], p4[4];
#pragma unroll
    for (int i = 0; i < 4; ++i) s4[i] = __shfl(sel, (lane & 12) + i);
    float v1 = s4[0]; int i1 = 0;
#pragma unroll
    for (int i = 1; i < 4; ++i) if (s4[i] > v1) { v1 = s4[i]; i1 = i; }
    float v2 = -1e30f;
#pragma unroll
    for (int i = 0; i < 4; ++i) if (i != i1 && s4[i] > v2) v2 = s4[i];
    const float gs = v1 + v2;
    float best = __shfl(gs, 0); int bg = 0;
#pragma unroll
    for (int g = 1; g < 4; ++g) { const float t = __shfl(gs, 4 * g); if (t > best) { best = t; bg = g; } }
#pragma unroll
    for (int i = 0; i < 4; ++i) { s4[i] = __shfl(sel, 4 * bg + i); p4[i] = __shfl(p, 4 * bg + i); }
    v1 = s4[0]; i1 = 0; float q1 = p4[0];
#pragma unroll
    for (int i = 1; i < 4; ++i) if (s4[i] > v1) { v1 = s4[i]; i1 = i; q1 = p4[i]; }
    v2 = -1e30f; int i2 = 0; float q2 = 0.f;
#pragma unroll
    for (int i = 0; i < 4; ++i) if (i != i1 && s4[i] > v2) { v2 = s4[i]; i2 = i; q2 = p4[i]; }
    e0 = 4 * bg + i1; e1 = 4 * bg + i2; const float s = q1 + q2; g0 = q1 / s; g1 = q2 / s;
}
__device__ __forceinline__ void rowpass_b(Ctx& F, const Args& a, int layer, int nrows, const bf16_t* YB) {
    const float* modl = (const float*)(F.ws + WS_MODV) + layer * 3 * 6144;
    bf16_t* XL = (bf16_t*)(F.ws + WS_XL); bf16_t* HB = (bf16_t*)(F.ws + WS_HB);
    int* tok_e = (int*)(F.ws + WS_ROUTE); int* tok_pos = tok_e + 2 * NTOK; float* tok_g = (float*)(tok_pos + 2 * NTOK);
    unsigned* cnt = CTLP(F) + (layer ? CW_CNT1 : CW_CNT0);
    stage_router(F, a.in[I_RW]);
    LAS int* lcnt = (LAS int*)(F.lds + 65536); LAS int* gbase = lcnt + 16; LAS int* nrow = lcnt + 32; LAS int* lrow = lcnt + 64;
    if (F.tid < 33) lcnt[F.tid] = 0;
    __syncthreads();
    RowF xf_n; RowRaw xr_n, y_n;
    { const int r0 = GWID(F); if (r0 < nrows) { if (layer) xr_n = row_ldraw_bf16(XL + (size_t)r0 * D, F.lane); else xf_n = row_ld_f32(x_row(a, r0), F.lane); y_n = row_ldraw_bf16(YB + (size_t)r0 * D, F.lane); } }
    for (int row = GWID(F); row < nrows; row += NGW(F)) {
        const float* m = modl + mod_index(row) * 6144;
        RowF x = layer ? row_cvt(xr_n) : xf_n; const RowF y = row_cvt(y_n); const int nxr = row + NGW(F);
        if (nxr < nrows) { if (layer) xr_n = row_ldraw_bf16(XL + (size_t)nxr * D, F.lane); else xf_n = row_ld_f32(x_row(a, nxr), F.lane); y_n = row_ldraw_bf16(YB + (size_t)nxr * D, F.lane); }
        const RowF gt = row_ld_f32(m + 2048, F.lane);
#pragma unroll
        for (int j = 0; j < 4; ++j) x.v[j] = ALPHA * x.v[j] + gt.v[j] * y.v[j];
        row_layernorm(x, a.in[I_LNG] + (layer * 2) * D, a.in[I_LNB] + (layer * 2) * D, F.lane);
        row_st_bf16(XL + (size_t)row * D, F.lane, x);
        const RowF h2 = row_modulate(x, m + 3072, m + 4096, F.lane);
        row_st_bf16(HB + (size_t)row * D, F.lane, h2);
        int e0, e1; float g0, g1; route_row(h2, (const LAS f32x4*)F.lds, a.in[I_RB], F.lane, e0, e1, g0, g1);
        if (F.lane == 0) {
            const int p0 = __hip_atomic_fetch_add(lcnt + e0, 1, __ATOMIC_RELAXED, __HIP_MEMORY_SCOPE_WORKGROUP), p1 = __hip_atomic_fetch_add(lcnt + e1, 1, __ATOMIC_RELAXED, __HIP_MEMORY_SCOPE_WORKGROUP);
            const int ix = __hip_atomic_fetch_add(nrow, 1, __ATOMIC_RELAXED, __HIP_MEMORY_SCOPE_WORKGROUP);
            lrow[ix * 4 + 0] = row; lrow[ix * 4 + 1] = e0 | (e1 << 8); lrow[ix * 4 + 2] = p0; lrow[ix * 4 + 3] = p1;
            tok_e[row * 2] = e0; tok_e[row * 2 + 1] = e1; tok_g[row * 2] = g0; tok_g[row * 2 + 1] = g1;
        }
    }
    __syncthreads();
    if (F.tid < 16) gbase[F.tid] = (int)atomicAdd(cnt + F.tid, (unsigned)lcnt[F.tid]);
    __syncthreads();
    if (F.tid < nrow[0]) { const int row = lrow[F.tid * 4], ee = lrow[F.tid * 4 + 1];
        const int e0 = ee & 255, e1 = ee >> 8, p0 = gbase[e0] + lrow[F.tid * 4 + 2], p1 = gbase[e1] + lrow[F.tid * 4 + 3];
        tok_pos[row * 2] = p0; tok_pos[row * 2 + 1] = p1; int* tab = (int*)(F.ws + WS_TOKTAB); tab[(size_t)e0 * NTOK + p0] = row; tab[(size_t)e1 * NTOK + p1] = row; }
}
__device__ __forceinline__ void moe_offsets(Ctx& F, int layer) {
    __syncthreads();
    if (F.tid == 0) { const unsigned* cnt = CTLP(F) + (layer ? CW_CNT1 : CW_CNT0); int acc = 0;
        for (int e = 0; e < 16; ++e) { const int c = (int)__hip_atomic_load(cnt + e, __ATOMIC_RELAXED, __HIP_MEMORY_SCOPE_AGENT); MISCP(F)[e] = acc; MISCP(F)[100 + e] = c; acc += (c + 255) >> 8; }
        MISCP(F)[16] = acc; }
    __syncthreads();
}
__device__ __forceinline__ void moe_streams(Ctx& F, int layer, int li) {
    moe_offsets(F, layer);
    if (F.tid == 0) { const unsigned* bar = CTLP(F) + CW_BAR + li * 4096; const int x = MISCP(F)[35]; int tot = 0, before = 0, mine = 1;
        for (int j = 0; j < 16; ++j) { const int c = (int)__hip_atomic_load(bar + XB_XCNT(j), __ATOMIC_RELAXED, __HIP_MEMORY_SCOPE_AGENT); tot += c; before += (j < x) ? c : 0; mine = (j == x) ? c : mine; }
        const int ntm = MISCP(F)[16]; const int m0 = (int)((long)ntm * before / tot), m1 = (int)((long)ntm * (before + mine) / tot);
        MISCP(F)[120] = m0; MISCP(F)[121] = m1 - m0; MISCP(F)[122] = mine; MISCP(F)[123] = MISCP(F)[34]; }
    __syncthreads();
}
__device__ __forceinline__ void moe_scatter(Ctx& F, int layer, int nrows) {
    moe_offsets(F, layer);
    const bf16_t* HB = (const bf16_t*)(F.ws + WS_HB); bf16_t* XS = (bf16_t*)(F.ws + WS_XS);
    const int* tok_e = (const int*)(F.ws + WS_ROUTE); const int* tok_pos = tok_e + 2 * NTOK; int* tok_slot = (int*)(F.ws + WS_ROUTE + MiB);
    for (int row = GWID(F); row < nrows; row += NGW(F)) {
        const int e0 = tok_e[row * 2], e1 = tok_e[row * 2 + 1];
        const int s0 = MISCP(F)[e0] * 256 + tok_pos[row * 2], s1 = MISCP(F)[e1] * 256 + tok_pos[row * 2 + 1];
        const u32x4* src = (const u32x4*)(HB + (size_t)row * D) + F.lane; const u32x4 v0 = src[0], v1 = src[64];
        u32x4* d0 = (u32x4*)(XS + (size_t)s0 * D) + F.lane; u32x4* d1 = (u32x4*)(XS + (size_t)s1 * D) + F.lane;
        d0[0] = v0; d0[64] = v1; d1[0] = v0; d1[64] = v1;
        if (F.lane == 0) { tok_slot[row * 2] = s0; tok_slot[row * 2 + 1] = s1; }
    }
}
__device__ __forceinline__ void rowpass_c(Ctx& F, const Args& a, int layer, int nrows, bool last) {
    const float* modl = (const float*)(F.ws + WS_MODV) + layer * 3 * 6144;
    bf16_t* XL = (bf16_t*)(F.ws + WS_XL); bf16_t* HB = (bf16_t*)(F.ws + WS_HB); const bf16_t* YS = (const bf16_t*)(F.ws + WS_YS);
    const int* tok_e = (const int*)(F.ws + WS_ROUTE); const int* tok_pos = tok_e + 2 * NTOK; const float* tok_g = (const float*)(F.ws + WS_ROUTE) + 4 * NTOK;
    moe_offsets(F, layer);
    const int step = NGW(F); int row = GWID(F);
    int s0n = 0, s1n = 0, s0nn = 0, s1nn = 0; float g0n = 0.f, g1n = 0.f, g0nn = 0.f, g1nn = 0.f; RowRaw xr_n, y0_n, y1_n;
#define RC_SLOTS(r_, s0_, s1_, g0_, g1_) do { s0_ = MISCP(F)[tok_e[(r_) * 2]] * 256 + tok_pos[(r_) * 2]; s1_ = MISCP(F)[tok_e[(r_) * 2 + 1]] * 256 + tok_pos[(r_) * 2 + 1]; g0_ = tok_g[(r_) * 2]; g1_ = tok_g[(r_) * 2 + 1]; } while (0)
    if (row < nrows) { RC_SLOTS(row, s0n, s1n, g0n, g1n); xr_n = row_ldraw_bf16(XL + (size_t)row * D, F.lane); y0_n = row_ldraw_bf16(YS + (size_t)s0n * D, F.lane); y1_n = row_ldraw_bf16(YS + (size_t)s1n * D, F.lane);
        if (row + step < nrows) RC_SLOTS(row + step, s0nn, s1nn, g0nn, g1nn); }
    for (; row < nrows; row += step) {
        const float* m = modl + mod_index(row) * 6144;
        RowF x = row_cvt(xr_n); const RowF y0 = row_cvt(y0_n), y1 = row_cvt(y1_n); const float g0 = g0n, g1 = g1n;
        if (row + step < nrows) { const int nr = row + step; s0n = s0nn; s1n = s1nn; g0n = g0nn; g1n = g1nn;
            xr_n = row_ldraw_bf16(XL + (size_t)nr * D, F.lane); y0_n = row_ldraw_bf16(YS + (size_t)s0n * D, F.lane); y1_n = row_ldraw_bf16(YS + (size_t)s1n * D, F.lane);
            if (nr + step < nrows) RC_SLOTS(nr + step, s0nn, s1nn, g0nn, g1nn); }
        const RowF gt = row_ld_f32(m + 5120, F.lane);
#pragma unroll
        for (int j = 0; j < 4; ++j) x.v[j] = ALPHA * x.v[j] + gt.v[j] * (g0 * y0.v[j] + g1 * y1.v[j]);
        row_layernorm(x, a.in[I_LNG] + (layer * 2 + 1) * D, a.in[I_LNB] + (layer * 2 + 1) * D, F.lane);
        if (last) { row_st_f32(a.out + (size_t)row * D, F.lane, x); }
        else { row_st_bf16(XL + (size_t)row * D, F.lane, x); const float* m1 = modl + 3 * 6144 + mod_index(row) * 6144;
            const RowF h = row_modulate(x, m1, m1 + 1024, F.lane); row_st_bf16(HB + (size_t)row * D, F.lane, h); }
    }
#undef RC_SLOTS
}

template <class Epi, class Sched> __device__ __forceinline__ void run_gemm_gather(Ctx& F, const bf16_t* A, const bf16_t* Bt, int K, const Sched& S, const Epi& E) {
    pg8::Gemm g{A, Bt, 0, 0, K};
    pg8::gemm_phase<Epi, Sched, true, true, true>(F.lds, g, S, E, F.wave * 64 + fresh_lane());
    __syncthreads();
}
template <class Epi, class Sched> __device__ __forceinline__ void run_gemm(Ctx& F, const bf16_t* A, const bf16_t* Bt, int M, int N, int K, const Sched& S, const Epi& E) {
    pg8::Gemm g{A, Bt, M, N, K};
    pg8::gemm_phase<Epi, Sched, true, true>(F.lds, g, S, E, F.wave * 64 + fresh_lane());
    __syncthreads();
}

__device__ __forceinline__ void qkprep_phase(Ctx& F, const Args& a) {
    bf16_t* Q = (bf16_t*)(F.ws + WS_Q); bf16_t* KB = (bf16_t*)(F.ws + WS_KB);
    constexpr int NQ = NLAT * 8, NK = NBATCH * SLEN * 2;
    const float qg0 = a.in[I_QG][F.lane], qg1 = a.in[I_QG][F.lane + 64], kg0 = a.in[I_KG][F.lane], kg1 = a.in[I_KG][F.lane + 64];
    const float* ropet = (const float*)(F.ws + WS_ROPE);
    for (int it = NQ + GWID(F); it < NQ + NK; it += NGW(F)) {
        bf16_t* p; int t; bool rope; float g0, g1;
        if (it < NQ) { const int row = it >> 3, hh = it & 7; p = Q + (size_t)row * 1024 + hh * 128; t = row % SEQ; rope = true; g0 = qg0; g1 = qg1; }
        else { const int r = it - NQ, krow = r >> 1, kvh = r & 1, key = krow % SLEN; p = KB + (size_t)krow * 256 + kvh * 128; rope = key >= CTXL; t = key - CTXL; g0 = kg0; g1 = kg1; }
        float x1 = bf2f(p[F.lane]), x2 = bf2f(p[F.lane + 64]);
        const float r = rsqrtf(wave_sum(x1 * x1 + x2 * x2) * (1.f / 128.f) + 1e-6f);
        x1 *= r * g0; x2 *= r * g1;
        float o1 = x1, o2 = x2;
        if (rope) { const float* rp = ropet + ((F.lane < 32) ? (t / 64) : (t % 64)) * 64 + 2 * (F.lane & 31); const float cs = rp[0], sn = rp[1]; o1 = x1 * cs - x2 * sn; o2 = x2 * cs + x1 * sn; }
        p[F.lane] = f2bf(o1); p[F.lane + 64] = f2bf(o2);
    }
}
__device__ __forceinline__ void attn_phase(Ctx& F, const Args& a) {
    const bf16_t* Q = (const bf16_t*)(F.ws + WS_Q); const bf16_t* KB = (const bf16_t*)(F.ws + WS_KB); const bf16_t* VB = (const bf16_t*)(F.ws + WS_VB); bf16_t* AO = (bf16_t*)(F.ws + WS_AO);
    const float gq = wave_max(fmaxf(fabsf(a.in[I_QG][F.lane]), fabsf(a.in[I_QG][F.lane + 64]))), gk = wave_max(fmaxf(fabsf(a.in[I_KG][F.lane]), fabsf(a.in[I_KG][F.lane + 64])));
    const bool fast = 11.3137085f * 1.4426950408889634f * 1.02f * gq * gk < 60.f;
    for (int i = 0;; ++i) {
        const int L = i * F.G + F.bid; if (L >= 512) break;
        const int xcd = L & 7, off = L >> 3, combo = xcd >> 1, idx = (xcd & 1) * 64 + off, hl = idx >> 5, qb = idx & 31;
        const int b = combo >> 1, kvh = combo & 1, h = kvh * 4 + hl;
        const size_t qoff = ((size_t)b * SEQ + qb * 256) * 1024 + h * 128, koff = (size_t)b * SLEN * 256 + kvh * 128;
        if (fast) attn::attn_dense_body<attn::bf16, true, 1>(Q + qoff, KB + koff, VB + koff, AO + qoff, SLEN, (char*)F.lds, F.wave * 64 + fresh_lane(), a.in[I_QG], qb * 256, (const float*)(F.ws + WS_ROPE));
        else attn::attn_dense_body<attn::bf16, false, 1>(Q + qoff, KB + koff, VB + koff, AO + qoff, SLEN, (char*)F.lds, F.wave * 64 + fresh_lane(), a.in[I_QG], qb * 256, (const float*)(F.ws + WS_ROPE));
        __syncthreads();
    }
}

typedef short v4i16_t __attribute__((ext_vector_type(4)));
typedef const LAS unsigned char* lds_cptr;
constexpr float LOG2E = 1.4426950408889634f;
__device__ __forceinline__ s16x4 vtr(lds_cptr p) { return __builtin_bit_cast(s16x4, __builtin_amdgcn_ds_read_tr16_b64_v4i16((LAS v4i16_t*)p)); }
__device__ __forceinline__ bf16x8 trfrag(lds_cptr tb, int d0, int ks) {
    const s16x4 l = vtr(tb + attn::v_rd_off(d0, ks, 0)), h = vtr(tb + attn::v_rd_off(d0, ks, 1));
    return (bf16x8){l[0], l[1], l[2], l[3], h[0], h[1], h[2], h[3]}; }
__device__ __forceinline__ bf16x8 rowfrag(lds_cptr tile, int blk, int d0, int r32, int hi) { return *(const LAS bf16x8*)(tile + KSWZ(32 * blk + r32, (d0 * 16 + hi * 8) * 2)); }
__device__ __forceinline__ u32x4 scale8(u32x4 v, float s) { u32x4 o;
#pragma unroll
    for (int i = 0; i < 4; ++i) o[i] = pk2(__uint_as_float(v[i] << 16) * s, __uint_as_float(v[i] & 0xffff0000u) * s);
    return o; }
__device__ __forceinline__ bf16x8 scale8f(bf16x8 v, float s) { return __builtin_bit_cast(bf16x8, scale8(__builtin_bit_cast(u32x4, v), s)); }
__device__ __forceinline__ float wave_incl_sum(float v, int lane) {
#pragma unroll
    for (int o = 1; o < 64; o <<= 1) { const float t = __shfl_up(v, o); if (lane >= o) v += t; }
    return v; }
__device__ __forceinline__ float wave_incl_max(float v, int lane) {
#pragma unroll
    for (int o = 1; o < 64; o <<= 1) { const float t = __shfl_up(v, o); if (lane >= o) v = fmaxf(v, t); }
    return v; }
__device__ __forceinline__ float wave_incl_max_rev(float v, int lane) {
#pragma unroll
    for (int o = 1; o < 64; o <<= 1) { const float t = __shfl_down(v, o); if (lane + o < 64) v = fmaxf(v, t); }
    return v; }
__device__ __forceinline__ float half_swap_add(float v) { auto rr = __builtin_amdgcn_permlane32_swap(__float_as_uint(v), __float_as_uint(v), false, false); return __uint_as_float(rr[0]) + __uint_as_float(rr[1]); }
#define MX_PK4(P, BASE, OUT) do { unsigned a0_ = pk2(P[BASE + 0], P[BASE + 1]), a1_ = pk2(P[BASE + 2], P[BASE + 3]); \
    unsigned b0_ = pk2(P[BASE + 4], P[BASE + 5]), b1_ = pk2(P[BASE + 6], P[BASE + 7]); \
    auto r0_ = __builtin_amdgcn_permlane32_swap(a0_, b0_, false, false); auto r1_ = __builtin_amdgcn_permlane32_swap(a1_, b1_, false, false); \
    u32x4 w_ = {r0_[0], r1_[0], r0_[1], r1_[1]}; OUT = __builtin_bit_cast(bf16x8, w_); } while (0)

__device__ __forceinline__ const bf16_t* launder_v(const bf16_t* p) { asm volatile("" : "+v"(p)); return p; }
constexpr int MX_MISC = MISC_OFF + 1024;
__device__ __forceinline__ int st_off(int row, int col) { return (((row >> 5) * 8 + (col >> 4)) << 9) + ((row & 31) << 4) + (col & 15); }
__device__ __forceinline__ int mx_unit(int bid, int G, int k, int off) { const int kmain = 528 / G, nmain = kmain * G; if (k < kmain) return bid + k * G; if (k == kmain) { const int j = bid - off; return (j >= 0 && j < 528 - nmain) ? nmain + j : -1; } return -1; }

constexpr int CONV_RUN = 26;
__device__ __forceinline__ int conv_seg(int row) { return row < NLAT ? row / SEQ : 2 + (row - NLAT) / CTXL; }
__device__ __forceinline__ void conv_unpack(u32x4 v, float (&f)[8]) {
#pragma unroll
    for (int e = 0; e < 4; ++e) { f[2 * e] = __uint_as_float(v[e] << 16); f[2 * e + 1] = __uint_as_float(v[e] & 0xffff0000u); } }
__device__ __forceinline__ void conv_phase(Ctx& F, const Args& a) {
    const bf16_t* XBC = (const bf16_t*)(F.ws + WS_XBC); bf16_t* XC = (bf16_t*)(F.ws + WS_XC);
    const float* cw = a.in[I_CONVW]; const float* cb = a.in[I_CONVB];
    constexpr int NRUN = (NTOK + CONV_RUN - 1) / CONV_RUN;
    for (int it = F.bid * NTHREADS + F.tid; it < NRUN * 192; it += F.G * NTHREADS) {
        const int c8 = (it % 192) * 8, r0 = (it / 192) * CONV_RUN, r1 = (r0 + CONV_RUN < NTOK) ? r0 + CONV_RUN : NTOK;
        float w[4][8], bias[8];
#pragma unroll
        for (int j = 0; j < 4; ++j) { const f32x4 w0 = *(const f32x4*)(cw + j * 1536 + c8), w1 = *(const f32x4*)(cw + j * 1536 + c8 + 4); w[j][0] = w0[0]; w[j][1] = w0[1]; w[j][2] = w0[2]; w[j][3] = w0[3]; w[j][4] = w1[0]; w[j][5] = w1[1]; w[j][6] = w1[2]; w[j][7] = w1[3]; }
        { const f32x4 b0 = *(const f32x4*)(cb + c8), b1 = *(const f32x4*)(cb + c8 + 4); bias[0] = b0[0]; bias[1] = b0[1]; bias[2] = b0[2]; bias[3] = b0[3]; bias[4] = b1[0]; bias[5] = b1[1]; bias[6] = b1[2]; bias[7] = b1[3]; }
        const u32x4 zero = {0u, 0u, 0u, 0u};
        const bf16_t* base = XBC + c8;
        u32x4 xm2 = r0 >= 2 ? *(const u32x4*)(base + (size_t)(r0 - 2) * 1536) : zero, xm1 = r0 >= 1 ? *(const u32x4*)(base + (size_t)(r0 - 1) * 1536) : zero;
        u32x4 x0 = *(const u32x4*)(base + (size_t)r0 * 1536), xp1 = r0 + 1 < NTOK ? *(const u32x4*)(base + (size_t)(r0 + 1) * 1536) : zero;
        for (int r = r0; r < r1; ++r) {
            const u32x4 xp2 = r + 2 < NTOK ? *(const u32x4*)(base + (size_t)(r + 2) * 1536) : zero;
            const int sg = conv_seg(r);
            const bool v0 = r >= 2 && conv_seg(r - 2) == sg, v1 = r >= 1 && conv_seg(r - 1) == sg, v3 = r + 1 < NTOK && conv_seg(r + 1) == sg;
            float f0[8], f1[8], f2[8], f3[8]; conv_unpack(xm2, f0); conv_unpack(xm1, f1); conv_unpack(x0, f2); conv_unpack(xp1, f3);
            float acc[8];
#pragma unroll
            for (int e = 0; e < 8; ++e) acc[e] = bias[e] + (v0 ? w[0][e] * f0[e] : 0.f) + (v1 ? w[1][e] * f1[e] : 0.f) + w[2][e] * f2[e] + (v3 ? w[3][e] * f3[e] : 0.f);
            u32x4 o; o[0] = pk2(siluf(acc[0]), siluf(acc[1])); o[1] = pk2(siluf(acc[2]), siluf(acc[3])); o[2] = pk2(siluf(acc[4]), siluf(acc[5])); o[3] = pk2(siluf(acc[6]), siluf(acc[7]));
            *(u32x4*)(XC + (size_t)r * 1536 + c8) = o;
            xm2 = xm1; xm1 = x0; x0 = xp1; xp1 = xp2;
        }
    }
}

struct MlGate { float b0, b1, G0, G1, total; };
__device__ __forceinline__ MlGate ml_gate(const float* GATES, int row0, int dir, int h, int lane) {
    const float* g0 = GATES + (size_t)(row0 + 2 * lane) * NGATE; const float* g1 = g0 + NGATE;
    const float lf0 = g0[8 + dir * 4 + h], lf1 = g1[8 + dir * 4 + h], ig0 = g0[dir * 4 + h], ig1 = g1[dir * 4 + h];
    const float incl = wave_incl_sum(lf0 + lf1, lane), total = __shfl(incl, 63);
    MlGate r; r.total = total;
    if (dir == 0) { r.b0 = incl - lf1; r.b1 = incl; } else { r.b0 = total - incl + lf0 + lf1; r.b1 = total - incl + lf1; }
    r.G0 = ig0 - r.b0; r.G1 = ig1 - r.b1; return r;
}


__device__ __forceinline__ void mlstm_a_phase(Ctx& F, int off) {
    const bf16_t* QK = (const bf16_t*)(F.ws + WS_QK); const bf16_t* V = (const bf16_t*)(F.ws + WS_V); const float* GATES = (const float*)(F.ws + WS_GATES);
    bf16_t* DC = (bf16_t*)(F.ws + WS_DC); float* DN = (float*)(F.ws + WS_DN); float* MS = (float*)(F.ws + WS_MS);
    LAS unsigned char* Vt = F.lds; LAS unsigned char* Kw = F.lds + 65536;
    LAS float* wsc = (LAS float*)(F.lds + MX_MISC); LAS float* dnp = (LAS float*)(F.lds + MX_MISC + 1024);
    for (int k_ = 0;; ++k_) { const int u = mx_unit(F.bid, F.G, k_, off); if (u < 0) break;
        const int lane = fresh_lane(), tid = F.wave * 64 + lane, r32 = lane & 31, hi = lane >> 5, sr = tid >> 4, sc8 = (tid & 15) * 8, rdb = attn::v_rd_base(lane);
        const int b = u / 264, rem = u % 264, cid = rem >> 2, h = rem & 3, row0 = chunk_row0(b, cid);
        if (F.wave < 2) { const int dir = F.wave, chain = (b * 4 + h) * 2 + dir; typedef float f32x2v __attribute__((ext_vector_type(2)));
            *(LAS f32x2v*)(wsc + dir * 128 + 2 * lane) = *(const f32x2v*)((const float*)(F.ws + WS_MLG) + (size_t)(chain * NCH + cid) * 512 + 384 + 2 * lane); }
        __syncthreads();
        float dnacc[2][8];
#pragma unroll
        for (int d = 0; d < 2; ++d)
#pragma unroll
            for (int e = 0; e < 8; ++e) dnacc[d][e] = 0.f;
#pragma unroll
        for (int i = 0; i < 4; ++i) { const int s = sr + 32 * i; const size_t grow = (size_t)(row0 + s) * 1024;
#pragma unroll
            for (int vb = 0; vb < 2; ++vb) { const u32x4 v = *(const u32x4*)(V + grow + h * 256 + vb * 128 + sc8); *(LAS u32x4*)(Vt + ((s >> 6) * 2 + vb) * 16384 + attn::v_st(s & 63, sc8)) = v; }
            const u32x4 kv = *(const u32x4*)(QK + grow + 512 + h * 128 + sc8);
#pragma unroll
            for (int d = 0; d < 2; ++d) { const float w = wsc[d * 128 + s];
                *(LAS u32x4*)(Kw + (d * 2 + (s >> 6)) * 16384 + attn::v_st(s & 63, sc8)) = scale8(kv, w);
#pragma unroll
                for (int e = 0; e < 4; ++e) { dnacc[d][2 * e] += w * __uint_as_float(kv[e] << 16); dnacc[d][2 * e + 1] += w * __uint_as_float(kv[e] & 0xffff0000u); } } }
#pragma unroll
        for (int d = 0; d < 2; ++d)
#pragma unroll
            for (int e = 0; e < 8; ++e) { float t = dnacc[d][e]; t += __shfl_xor(t, 16); t += __shfl_xor(t, 32); if ((lane >> 4) == 0) dnp[(F.wave * 2 + d) * 128 + sc8 + e] = t; }
        __syncthreads();
        {   const int dir = F.wave >> 2, vq = F.wave & 3;
            f32x16 acc[2][4];
#pragma unroll
            for (int i = 0; i < 2; ++i)
#pragma unroll
                for (int n = 0; n < 4; ++n) acc[i][n] = f32x16{};
#pragma unroll
            for (int ks = 0; ks < 8; ++ks) { const int sblk = ks >> 2, KS = ks & 3;
                bf16x8 af[2], bfr[4];
#pragma unroll
                for (int i = 0; i < 2; ++i) af[i] = trfrag(Vt + (sblk * 2 + (vq >> 1)) * 16384 + rdb, (2 * vq + i) & 3, KS);
#pragma unroll
                for (int n = 0; n < 4; ++n) bfr[n] = trfrag(Kw + (dir * 2 + sblk) * 16384 + rdb, n, KS);
#pragma unroll
                for (int i = 0; i < 2; ++i)
#pragma unroll
                    for (int n = 0; n < 4; ++n) acc[i][n] = __builtin_amdgcn_mfma_f32_32x32x16_bf16(af[i], bfr[n], acc[i][n], 0, 0, 0); }
            const int chain = (b * 4 + h) * 2 + dir;
            bf16_t* dst = DC + (size_t)(chain * NCH + cid) * 256 * 128;
#pragma unroll
            for (int i = 0; i < 2; ++i)
#pragma unroll
                for (int n = 0; n < 4; ++n)
#pragma unroll
                    for (int r = 0; r < 16; ++r) dst[st_off(64 * vq + 32 * i + attn::crow(r, hi), 32 * n + r32)] = f2bf(acc[i][n][r]);
        }
        if (tid < 256) { const int dir = tid >> 7, d = tid & 127; float s = 0.f;
#pragma unroll
            for (int w = 0; w < 8; ++w) s += dnp[(w * 2 + dir) * 128 + d];
            const int chain = (b * 4 + h) * 2 + dir; DN[(size_t)(chain * NCH + cid) * 128 + d] = s; }
        __syncthreads();
    }
}

struct SsGate { float dt0, dt1, acs0, acs1, total; };
__device__ __forceinline__ SsGate ss_gate(const float* GATES, int row0, int dir, int head, float aneg, int lane) {
    const float* g0 = GATES + (size_t)(row0 + 2 * lane) * NGATE; const float* g1 = g0 + NGATE;
    SsGate r; r.dt0 = g0[16 + dir * 16 + head]; r.dt1 = g1[16 + dir * 16 + head];
    const float a0 = r.dt0 * aneg, a1 = r.dt1 * aneg;
    const float incl = wave_incl_sum(a0 + a1, lane); r.total = __shfl(incl, 63);
    if (dir == 0) { r.acs0 = incl - a1; r.acs1 = incl; } else { r.acs0 = r.total - incl + a0 + a1; r.acs1 = r.total - incl + a1; }
    return r;
}
__device__ __forceinline__ void gatescan_phase(Ctx& F, const Args& a) {
    const float* GATES = (const float*)(F.ws + WS_GATES); float* MLG = (float*)(F.ws + WS_MLG); float* SSG = (float*)(F.ws + WS_SSG);
    float* MS = (float*)(F.ws + WS_MS); float* AEND = (float*)(F.ws + WS_AEND);
    typedef float f32x2v __attribute__((ext_vector_type(2)));
    const int lane = F.lane;
    for (int it = GWID(F); it < 16 * NCH + 64 * NCH; it += NGW(F)) {
        if (it < 16 * NCH) { const int chain = it / NCH, cid = it % NCH, dir = chain & 1, h = (chain >> 1) & 3, b = chain >> 3, row0 = chunk_row0(b, cid);
            const MlGate g = ml_gate(GATES, row0, dir, h, lane);
            const float gmx = fmaxf(g.G0, g.G1), gm = wave_max(gmx); float P0, P1;
            if (dir == 0) { const float pm = wave_incl_max(gmx, lane); float ex = __shfl_up(pm, 1); if (lane == 0) ex = -1e30f; P0 = fmaxf(ex, g.G0); P1 = pm; }
            else { const float pm = wave_incl_max_rev(gmx, lane); float ex = __shfl_down(pm, 1); if (lane == 63) ex = -1e30f; P1 = fmaxf(ex, g.G1); P0 = pm; }
            float* o = MLG + (size_t)it * 512 + 2 * lane;
            *(f32x2v*)(o) = (f32x2v){g.b0, g.b1}; *(f32x2v*)(o + 128) = (f32x2v){g.G0, g.G1}; *(f32x2v*)(o + 256) = (f32x2v){P0, P1}; *(f32x2v*)(o + 384) = (f32x2v){expf(g.G0 - gm), expf(g.G1 - gm)};
            if (lane == 0) { MS[it * 4 + 0] = g.total; MS[it * 4 + 1] = g.total + gm; } }
        else { const int i2 = it - 16 * NCH, chain = i2 / NCH, cid = i2 % NCH, dir = chain & 1, head = (chain >> 1) & 15, b = chain >> 5, row0 = chunk_row0(b, cid);
            const float aneg = -expf(a.in[I_ALOG][dir * 16 + head]); const SsGate s = ss_gate(GATES, row0, dir, head, aneg, lane);
            float* o = SSG + (size_t)i2 * 384 + 2 * lane;
            *(f32x2v*)(o) = (f32x2v){s.acs0, s.acs1}; *(f32x2v*)(o + 128) = (f32x2v){s.dt0, s.dt1}; *(f32x2v*)(o + 256) = (f32x2v){s.dt0 * expf(s.total - s.acs0), s.dt1 * expf(s.total - s.acs1)};
            if (lane == 0) AEND[i2] = s.total; }
    }
}
template <bool BM_ROW> __device__ __forceinline__ void ssd_stage(Ctx& F, const bf16_t* XC, int row0, int g, int hh, LAS unsigned char* Xt, LAS unsigned char* Bt) {
    const int tid_ = F.wave * 64 + fresh_lane(), sr = tid_ >> 4, sc8 = (tid_ & 15) * 8;
#pragma unroll
    for (int i = 0; i < 4; ++i) { const int s = sr + 32 * i; const bf16_t* rowp = XC + (size_t)(row0 + s) * 1536;
#pragma unroll
        for (int cb = 0; cb < 2; ++cb) { const u32x4 v = *(const u32x4*)(rowp + (g * 8 + hh * 4) * 64 + cb * 128 + sc8); *(LAS u32x4*)(Xt + ((s >> 6) * 2 + cb) * 16384 + attn::v_st(s & 63, sc8)) = v; }
        const u32x4 bv = *(const u32x4*)(rowp + 1024 + g * 128 + sc8);
        if (BM_ROW) *(LAS u32x4*)(Bt + (s >> 6) * 16384 + KSWZ(s & 63, sc8 * 2)) = bv; else *(LAS u32x4*)(Bt + (s >> 6) * 16384 + attn::v_st(s & 63, sc8)) = bv; }
}
__device__ __forceinline__ void ssd_a_phase(Ctx& F, const Args& a, int off) {
    const bf16_t* XC = (const bf16_t*)(F.ws + WS_XC); const float* GATES = (const float*)(F.ws + WS_GATES);
    bf16_t* DS = (bf16_t*)(F.ws + WS_DS); float* AEND = (float*)(F.ws + WS_AEND);
    LAS unsigned char* Xt = F.lds; LAS unsigned char* Bt = F.lds + 65536;
    LAS float* wtl = (LAS float*)(F.lds + MX_MISC);
    for (int k_ = 0;; ++k_) { const int u = mx_unit(F.bid, F.G, k_, off); if (u < 0) break;
        const int lane = fresh_lane(), r32 = lane & 31, hi = lane >> 5, rdb = attn::v_rd_base(lane);
        const int b = u / 264, rem = u % 264, cid = rem >> 2, g = (rem >> 1) & 1, hh = rem & 1, row0 = chunk_row0(b, cid);
        const int dir = F.wave >> 2, j = F.wave & 3, head = g * 8 + hh * 4 + j, chain = (b * 16 + head) * 2 + dir;
        { typedef float f32x2v __attribute__((ext_vector_type(2)));
          *(LAS f32x2v*)(wtl + F.wave * 128 + 2 * lane) = *(const f32x2v*)((const float*)(F.ws + WS_SSG) + (size_t)(chain * NCH + cid) * 384 + 256 + 2 * lane); }
        ssd_stage<false>(F, XC, row0, g, hh, Xt, Bt);
        __syncthreads();
        f32x16 acc[2][4];
#pragma unroll
        for (int i = 0; i < 2; ++i)
#pragma unroll
            for (int n = 0; n < 4; ++n) acc[i][n] = f32x16{};
#pragma unroll
        for (int ks = 0; ks < 8; ++ks) { const int sblk = ks >> 2, KS = ks & 3;
            const f32x4 w0 = *(const LAS f32x4*)(wtl + F.wave * 128 + 16 * ks + 8 * hi), w1 = *(const LAS f32x4*)(wtl + F.wave * 128 + 16 * ks + 8 * hi + 4);
            bf16x8 af[2], bfr[4];
#pragma unroll
            for (int i = 0; i < 2; ++i) { const u32x4 x = __builtin_bit_cast(u32x4, trfrag(Xt + (sblk * 2 + (j >> 1)) * 16384 + rdb, (j & 1) * 2 + i, KS)); u32x4 o;
                o[0] = pk2(__uint_as_float(x[0] << 16) * w0[0], __uint_as_float(x[0] & 0xffff0000u) * w0[1]); o[1] = pk2(__uint_as_float(x[1] << 16) * w0[2], __uint_as_float(x[1] & 0xffff0000u) * w0[3]);
                o[2] = pk2(__uint_as_float(x[2] << 16) * w1[0], __uint_as_float(x[2] & 0xffff0000u) * w1[1]); o[3] = pk2(__uint_as_float(x[3] << 16) * w1[2], __uint_as_float(x[3] & 0xffff0000u) * w1[3]);
                af[i] = __builtin_bit_cast(bf16x8, o); }
#pragma unroll
            for (int n = 0; n < 4; ++n) bfr[n] = trfrag(Bt + sblk * 16384 + rdb, n, KS);
#pragma unroll
            for (int i = 0; i < 2; ++i)
#pragma unroll
                for (int n = 0; n < 4; ++n) acc[i][n] = __builtin_amdgcn_mfma_f32_32x32x16_bf16(af[i], bfr[n], acc[i][n], 0, 0, 0); }
        bf16_t* dst = DS + (size_t)(chain * NCH + cid) * 64 * 128;
#pragma unroll
        for (int i = 0; i < 2; ++i)
#pragma unroll
            for (int n = 0; n < 4; ++n)
#pragma unroll
                for (int r = 0; r < 16; ++r) dst[st_off(32 * i + attn::crow(r, hi), 32 * n + r32)] = f2bf(acc[i][n][r]);
        __syncthreads();
    }
}

__device__ __forceinline__ void scan_phase(Ctx& F) {
    LAS float* sa = (LAS float*)(F.lds + MX_MISC); LAS float* ss = sa + 80;
    for (int vb = F.bid; vb < 256; vb += F.G) {
        __syncthreads();
        if (vb < 128) {
            const int chain = vb >> 3, dir = chain & 1; float* MS = (float*)(F.ws + WS_MS) + (size_t)chain * NCH * 4;
            LAS float* sbe = ss + 80; LAS float* sgm = sbe + 80;
            if (F.tid < NCH) { const int cid = scan_cid(dir, F.tid); sbe[F.tid] = MS[cid * 4 + 0]; sgm[F.tid] = MS[cid * 4 + 1]; }
            __syncthreads();
            if (F.tid == 0) { float m = 0.f;
                for (int p = 0; p < NCH; ++p) { const float be = sbe[p], gm = sgm[p];
                    const float mn = fmaxf(be + m, gm); sa[p] = expf(be + m - mn); ss[p] = expf(gm - mn); if ((vb & 7) == 0) MS[scan_cid(dir, p) * 4 + 2] = m; m = mn; } }
            __syncthreads();
            {   bf16_t* base = (bf16_t*)(F.ws + WS_DC) + (size_t)chain * NCH * 32768 + ((size_t)(vb & 7) * 512 + F.tid) * 8;
                u32x4 buf[8]; float run[8];
#pragma unroll
                for (int e = 0; e < 8; ++e) run[e] = 0.f;
#pragma unroll
                for (int k = 0; k < 8; ++k) buf[k] = *(const u32x4*)(base + (size_t)scan_cid(dir, k) * 32768);
                for (int p0 = 0; p0 < 72; p0 += 8) {
#pragma unroll
                    for (int k = 0; k < 8; ++k) { const int p = p0 + k;
                        if (p < NCH) { const u32x4 d = buf[k]; bf16_t* loc = base + (size_t)scan_cid(dir, p) * 32768;
                            if (p + 8 < NCH) buf[k] = *(const u32x4*)(base + (size_t)scan_cid(dir, p + 8) * 32768);
                            u32x4 o; o[0] = pk2(run[0], run[1]); o[1] = pk2(run[2], run[3]); o[2] = pk2(run[4], run[5]); o[3] = pk2(run[6], run[7]);
                            *(u32x4*)loc = o;
                            const float av = sa[p], sv = ss[p];
#pragma unroll
                            for (int e = 0; e < 4; ++e) { run[2 * e] = av * run[2 * e] + sv * __uint_as_float(d[e] << 16); run[2 * e + 1] = av * run[2 * e + 1] + sv * __uint_as_float(d[e] & 0xffff0000u); } } }
                }
            }
            if ((vb & 7) == 0 && F.tid < 32) {
                float* nb = (float*)(F.ws + WS_DN) + (size_t)chain * NCH * 128 + F.tid * 4;
                f32x4 buf[8]; f32x4 run = {0.f, 0.f, 0.f, 0.f};
#pragma unroll
                for (int k = 0; k < 8; ++k) buf[k] = *(const f32x4*)(nb + (size_t)scan_cid(dir, k) * 128);
                for (int p0 = 0; p0 < 72; p0 += 8) {
#pragma unroll
                    for (int k = 0; k < 8; ++k) { const int p = p0 + k;
                        if (p < NCH) { const f32x4 d = buf[k]; float* loc = nb + (size_t)scan_cid(dir, p) * 128;
                            if (p + 8 < NCH) buf[k] = *(const f32x4*)(nb + (size_t)scan_cid(dir, p + 8) * 128);
                            *(f32x4*)loc = run; run = sa[p] * run + ss[p] * d; } }
                }
            }
        } else {
            const int chain = (vb - 128) >> 1, dir = chain & 1; const float* AEND = (const float*)(F.ws + WS_AEND) + (size_t)chain * NCH;
            if (F.tid < NCH) sa[F.tid] = expf(AEND[scan_cid(dir, F.tid)]);
            __syncthreads();
            bf16_t* base = (bf16_t*)(F.ws + WS_DS) + (size_t)chain * NCH * 8192 + ((size_t)(vb & 1) * 512 + F.tid) * 8;
            u32x4 buf[8]; float run[8];
#pragma unroll
            for (int e = 0; e < 8; ++e) run[e] = 0.f;
#pragma unroll
            for (int k = 0; k < 8; ++k) buf[k] = *(const u32x4*)(base + (size_t)scan_cid(dir, k) * 8192);
            for (int p0 = 0; p0 < 72; p0 += 8) {
#pragma unroll
                for (int k = 0; k < 8; ++k) { const int p = p0 + k;
                    if (p < NCH) { const u32x4 d = buf[k]; bf16_t* loc = base + (size_t)scan_cid(dir, p) * 8192;
                        if (p + 8 < NCH) buf[k] = *(const u32x4*)(base + (size_t)scan_cid(dir, p + 8) * 8192);
                        u32x4 o; o[0] = pk2(run[0], run[1]); o[1] = pk2(run[2], run[3]); o[2] = pk2(run[4], run[5]); o[3] = pk2(run[6], run[7]);
                        *(u32x4*)loc = o;
                        const float av = sa[p];
#pragma unroll
                        for (int e = 0; e < 4; ++e) { run[2 * e] = av * run[2 * e] + __uint_as_float(d[e] << 16); run[2 * e + 1] = av * run[2 * e + 1] + __uint_as_float(d[e] & 0xffff0000u); } } }
            }
        }
    }
}


template <bool DIAG> __device__ __forceinline__ void ml_block(const f32x16& S, const LAS float* Gp, float Mt, float sgn, float sb, float scale, f32x16& out) {
#pragma unroll
    for (int g4 = 0; g4 < 4; ++g4) { const f32x4 Gv = *(const LAS f32x4*)(Gp + 8 * g4);
#pragma unroll
        for (int e = 0; e < 4; ++e) { float arg = (Gv[e] - Mt) * LOG2E;
            if (DIAG) arg = fmaf(fminf(fmaf(-sgn, (float)(8 * g4 + e), sb), 0.f), 1e30f, arg);
            out[4 * g4 + e] = S[4 * g4 + e] * __builtin_amdgcn_exp2f(arg) * scale; } }
}
template <bool DIAG> __device__ __forceinline__ void ss_block(const f32x16& S, const LAS float* ap, const LAS float* dp, float At, float sgn, float sb, f32x16& out) {
#pragma unroll
    for (int g4 = 0; g4 < 4; ++g4) { const f32x4 av = *(const LAS f32x4*)(ap + 8 * g4), dv = *(const LAS f32x4*)(dp + 8 * g4);
#pragma unroll
        for (int e = 0; e < 4; ++e) { float arg = (At - av[e]) * LOG2E;
            if (DIAG) arg = fmaf(fminf(fmaf(-sgn, (float)(8 * g4 + e), sb), 0.f), 1e30f, arg);
            out[4 * g4 + e] = S[4 * g4 + e] * __builtin_amdgcn_exp2f(arg) * dv[e]; } }
}
__device__ __forceinline__ float sum16(const f32x16& v) { float s = 0.f;
#pragma unroll
    for (int r = 0; r < 16; ++r) s += v[r];
    return s; }
template <int VAR> __device__ __forceinline__ void mlstm_c_phase(Ctx& F, const Args& a, int off) {
    const bf16_t* QK = (const bf16_t*)(F.ws + WS_QK); const bf16_t* V = (const bf16_t*)(F.ws + WS_V); const bf16_t* OG = (const bf16_t*)(F.ws + WS_O); const float* GATES = (const float*)(F.ws + WS_GATES);
    const bf16_t* DC = (const bf16_t*)(F.ws + WS_DC); const float* DN = (const float*)(F.ws + WS_DN); const float* MS = (const float*)(F.ws + WS_MS); bf16_t* MIX = VAR ? (bf16_t*)(F.ws + WS_END) : (bf16_t*)(F.ws + WS_MIX);
    LAS unsigned char* Kt = F.lds; LAS unsigned char* Vt = F.lds + 32768; LAS float* stat = (LAS float*)(F.lds + MX_MISC + 5120);
    LAS float* Gs = (LAS float*)(F.lds + MX_MISC); LAS float* Ms = Gs + 256; LAS float* Bs = Gs + 512; LAS float* ns = Gs + 768; LAS float* mst = Gs + 1024;
    for (int k_ = 0;; ++k_) { const int u = mx_unit(F.bid, F.G, k_, off); if (u < 0) break;
        const int lane = fresh_lane(), tid = F.wave * 64 + lane, r32 = lane & 31, hi = lane >> 5, sr = tid >> 4, sc8 = (tid & 15) * 8, rdb = attn::v_rd_base(lane);
        const int b = u / 264, rem = u % 264, cid = rem >> 2, h = rem & 3, row0 = chunk_row0(b, cid);
        if (F.wave < 2) { const int dir = F.wave, chain = (b * 4 + h) * 2 + dir; typedef float f32x2v __attribute__((ext_vector_type(2)));
            const float* gsrc = (const float*)(F.ws + WS_MLG) + (size_t)(chain * NCH + cid) * 512 + 2 * lane;
            const f32x2v bb = *(const f32x2v*)gsrc, GG = *(const f32x2v*)(gsrc + 128), PP = *(const f32x2v*)(gsrc + 256);
            const float m0 = MS[(chain * NCH + cid) * 4 + 2];
            *(LAS f32x2v*)(Gs + dir * 128 + 2 * lane) = GG; *(LAS f32x2v*)(Ms + dir * 128 + 2 * lane) = (f32x2v){fmaxf(PP[0], m0), fmaxf(PP[1], m0)}; *(LAS f32x2v*)(Bs + dir * 128 + 2 * lane) = bb;
            const float* nsrc = DN + (size_t)(chain * NCH + cid) * 128; ns[dir * 128 + 2 * lane] = nsrc[2 * lane]; ns[dir * 128 + 2 * lane + 1] = nsrc[2 * lane + 1];
            if (lane == 0) mst[dir] = m0; }
#pragma unroll
        for (int i = 0; i < 4; ++i) { const int s = sr + 32 * i; const size_t grow = (size_t)(row0 + s) * 1024;
#pragma unroll
            for (int vb = 0; vb < 2; ++vb) { const u32x4 v = *(const u32x4*)(V + grow + h * 256 + vb * 128 + sc8); *(LAS u32x4*)(Vt + ((s >> 6) * 2 + vb) * 16384 + attn::v_st(s & 63, sc8)) = v; }
            const u32x4 kv = *(const u32x4*)(QK + grow + 512 + h * 128 + sc8);
            *(LAS u32x4*)(Kt + (s >> 6) * 16384 + KSWZ(s & 63, sc8 * 2)) = kv; }
        __syncthreads();
        const int tq = F.wave & 3, vh = F.wave >> 2, tau = 32 * tq + r32;
        const bf16_t* qptr = QK + (size_t)(row0 + tau) * 1024 + h * 128 + hi * 8;
        f32x16 pS[2][2];
        {   bf16x8 qr[8];
#pragma unroll
        for (int d0 = 0; d0 < 8; ++d0) qr[d0] = *(const bf16x8*)(qptr + d0 * 16);
#pragma unroll
        for (int j = 0; j < 2; ++j)
#pragma unroll
            for (int blk = 0; blk < 2; ++blk) { pS[j][blk] = f32x16{};
#pragma unroll
                for (int d0 = 0; d0 < 8; ++d0) pS[j][blk] = __builtin_amdgcn_mfma_f32_32x32x16_bf16(rowfrag(Kt + j * 16384, blk, d0, r32, hi), qr[d0], pS[j][blk], 0, 0, 0); }
        }
        f32x16 o[4];
#pragma unroll
        for (int d = 0; d < 4; ++d) o[d] = f32x16{};
        float qsc0 = 0.f, qsc1 = 0.f;
        if (VAR < 3)
#pragma unroll 1
        for (int dir = 0; dir < 2; ++dir) {
            const float Mt = Ms[dir * 128 + tau], m0 = mst[dir];
            const float sgn = dir ? -1.f : 1.f, sb = sgn * (float)(r32 - 4 * hi);
            float rs = 0.f;
#pragma unroll
            for (int j = 0; j < 2; ++j)
#pragma unroll
                for (int blk = 0; blk < 2; ++blk) { const int kb = 2 * j + blk; const bool vis = dir ? (kb >= tq) : (kb <= tq);
                    if (vis) { f32x16 pp; const LAS float* Gp = Gs + dir * 128 + 32 * kb + 4 * hi;
                        if (kb == tq) ml_block<true>(pS[j][blk], Gp, Mt, sgn, sb, 1.f, pp); else ml_block<false>(pS[j][blk], Gp, Mt, sgn, sb, 1.f, pp);
                        rs += sum16(pp); } }
            rs = half_swap_add(rs);
            float qn = 0.f; const bf16_t* qp2 = launder_v(qptr);
#pragma unroll
            for (int d0 = 0; d0 < 8; ++d0) { const bf16x8 qv = *(const bf16x8*)(qp2 + d0 * 16); const f32x4 n0 = *(const LAS f32x4*)(ns + dir * 128 + 16 * d0 + 8 * hi), n1 = *(const LAS f32x4*)(ns + dir * 128 + 16 * d0 + 8 * hi + 4);
                const u32x4 q = __builtin_bit_cast(u32x4, qv);
                qn += __uint_as_float(q[0] << 16) * n0[0] + __uint_as_float(q[0] & 0xffff0000u) * n0[1] + __uint_as_float(q[1] << 16) * n0[2] + __uint_as_float(q[1] & 0xffff0000u) * n0[3]
                    + __uint_as_float(q[2] << 16) * n1[0] + __uint_as_float(q[2] & 0xffff0000u) * n1[1] + __uint_as_float(q[3] << 16) * n1[2] + __uint_as_float(q[3] & 0xffff0000u) * n1[3]; }
            qn = half_swap_add(qn);
            const float ain = expf(m0 - Mt), den = rs + ain * qn;
            const float inv = __builtin_amdgcn_rcpf(fmaxf(fabsf(den), expf(-(Bs[dir * 128 + tau] + Mt))));
#pragma unroll
            for (int j = 0; j < 2; ++j)
#pragma unroll
                for (int blk = 0; blk < 2; ++blk) { const int kb = 2 * j + blk; const bool vis = dir ? (kb >= tq) : (kb <= tq);
                    if (vis) { f32x16 pp; const LAS float* Gp = Gs + dir * 128 + 32 * kb + 4 * hi;
                        if (kb == tq) ml_block<true>(pS[j][blk], Gp, Mt, sgn, sb, inv, pp); else ml_block<false>(pS[j][blk], Gp, Mt, sgn, sb, inv, pp);
                        bf16x8 pa0, pa1;
                        MX_PK4(pp, 0, pa0); MX_PK4(pp, 8, pa1);
#pragma unroll
                        for (int d = 0; d < 4; ++d) { o[d] = __builtin_amdgcn_mfma_f32_32x32x16_bf16(pa0, trfrag(Vt + (j * 2 + vh) * 16384 + rdb, d, 2 * blk), o[d], 0, 0, 0);
                            o[d] = __builtin_amdgcn_mfma_f32_32x32x16_bf16(pa1, trfrag(Vt + (j * 2 + vh) * 16384 + rdb, d, 2 * blk + 1), o[d], 0, 0, 0); } } }
            if (dir == 0) qsc0 = ain * inv; else qsc1 = ain * inv;
        }
        if (VAR < 2) {   const bf16_t* Cb0 = DC + (size_t)(((b * 4 + h) * 2 + 0) * NCH + cid) * 256 * 128 + (size_t)(4 * vh) * 4096 + r32 * 16 + hi * 8;
            const bf16_t* Cb1 = Cb0 + (size_t)NCH * 256 * 128;
            const bf16_t* qp3 = launder_v(qptr);
            bf16x8 qr2[8];
#pragma unroll
            for (int d0 = 0; d0 < 8; ++d0) qr2[d0] = *(const bf16x8*)(qp3 + d0 * 16);
            bf16x8 cf[4][4];
#define MLC_LD(s_) do { _Pragma("unroll") for (int d = 0; d < 4; ++d) cf[(s_) & 3][d] = *(const bf16x8*)(((s_) < 8 ? Cb0 : Cb1) + d * 4096 + 512 * ((s_) & 7)); } while (0)
            MLC_LD(0); MLC_LD(1); MLC_LD(2);
            __builtin_amdgcn_sched_barrier(0);
#pragma unroll
            for (int st = 0; st < 16; ++st) {
                if (st + 3 < 16) MLC_LD(st + 3);
                const bf16x8 qs = scale8f(qr2[st & 7], st < 8 ? qsc0 : qsc1);
#pragma unroll
                for (int d = 0; d < 4; ++d) o[d] = __builtin_amdgcn_mfma_f32_32x32x16_bf16(qs, cf[st & 3][d], o[d], 0, 0, 0);
                __builtin_amdgcn_sched_barrier(0); }
#undef MLC_LD
        }
        float s1[16], s2[16];
#pragma unroll
        for (int r = 0; r < 16; ++r) { float x = 0.f, y = 0.f;
#pragma unroll
            for (int d = 0; d < 4; ++d) { x += o[d][r]; y += o[d][r] * o[d][r]; }
#pragma unroll
            for (int of = 1; of < 32; of <<= 1) { x += __shfl_xor(x, of); y += __shfl_xor(y, of); }
            s1[r] = x; s2[r] = y; }
        if (r32 == 0) {
#pragma unroll
            for (int r = 0; r < 16; ++r) { const int row = 32 * tq + attn::crow(r, hi); stat[(vh * 128 + row) * 2] = s1[r]; stat[(vh * 128 + row) * 2 + 1] = s2[r]; } }
        __syncthreads();
        {
            LAS float* ot = (LAS float*)(F.lds + F.wave * 16384);
            float gg[4];
#pragma unroll
            for (int d = 0; d < 4; ++d) gg[d] = a.in[I_MNG][h * 256 + 128 * vh + 32 * d + r32];
#pragma unroll
            for (int r = 0; r < 16; ++r) { const int lrow = attn::crow(r, hi), row = 32 * tq + lrow;
                const float t1 = stat[row * 2] + stat[(128 + row) * 2], t2 = stat[row * 2 + 1] + stat[(128 + row) * 2 + 1];
                const float mu = t1 * (1.f / 256.f), rstd = rsqrtf(fmaxf(t2 * (1.f / 256.f) - mu * mu, 0.f) + 1e-5f);
#pragma unroll
                for (int d = 0; d < 4; ++d) ot[lrow * 128 + 32 * d + r32] = (o[d][r] - mu) * rstd * gg[d]; }
            asm volatile("s_waitcnt lgkmcnt(0)" ::: "memory");
#pragma unroll
            for (int i = 0; i < 8; ++i) { const int ch = lane + 64 * i, lrow = ch >> 4, c8 = (ch & 15) * 8;
                const f32x4 v0 = *(const LAS f32x4*)(ot + lrow * 128 + c8), v1 = *(const LAS f32x4*)(ot + lrow * 128 + c8 + 4);
                const size_t grow = (size_t)(row0 + 32 * tq + lrow); const int col = h * 256 + 128 * vh + c8;
                const u32x4 og = *(const u32x4*)(OG + grow * 1024 + col);
                u32x4 w; w[0] = pk2(v0[0] * sigmf(__uint_as_float(og[0] << 16)), v0[1] * sigmf(__uint_as_float(og[0] & 0xffff0000u))); w[1] = pk2(v0[2] * sigmf(__uint_as_float(og[1] << 16)), v0[3] * sigmf(__uint_as_float(og[1] & 0xffff0000u)));
                w[2] = pk2(v1[0] * sigmf(__uint_as_float(og[2] << 16)), v1[1] * sigmf(__uint_as_float(og[2] & 0xffff0000u))); w[3] = pk2(v1[2] * sigmf(__uint_as_float(og[3] << 16)), v1[3] * sigmf(__uint_as_float(og[3] & 0xffff0000u)));
                *(u32x4*)(MIX + (VAR ? (grow & 4095) : grow) * 2048 + 1024 + col) = w; }
        }
        __syncthreads();
    }
}

__device__ __forceinline__ void ssd_c_phase(Ctx& F, const Args& a, int off) {
    const bf16_t* XC = (const bf16_t*)(F.ws + WS_XC); const bf16_t* Z = (const bf16_t*)(F.ws + WS_Z); const float* GATES = (const float*)(F.ws + WS_GATES);
    const bf16_t* DS = (const bf16_t*)(F.ws + WS_DS); bf16_t* MIX = (bf16_t*)(F.ws + WS_MIX); float* SSQ = (float*)(F.ws + WS_SSQ);
    LAS unsigned char* Bt = F.lds; LAS unsigned char* Xt = F.lds + 32768;
    LAS float* acsl = (LAS float*)(F.lds + MX_MISC); LAS float* dtl = acsl + 1024;
    for (int k_ = 0;; ++k_) { const int u = mx_unit(F.bid, F.G, k_, off); if (u < 0) break;
        const int lane = fresh_lane(), r32 = lane & 31, hi = lane >> 5, rdb = attn::v_rd_base(lane);
        const int b = u / 264, rem = u % 264, cid = rem >> 2, g = (rem >> 1) & 1, hh = rem & 1, row0 = chunk_row0(b, cid);
        {   const int dir = F.wave >> 2, j = F.wave & 3, head = g * 8 + hh * 4 + j, chain = (b * 16 + head) * 2 + dir; typedef float f32x2v __attribute__((ext_vector_type(2)));
            const float* gsrc = (const float*)(F.ws + WS_SSG) + (size_t)(chain * NCH + cid) * 384 + 2 * lane; const int o = (j * 2 + dir) * 128 + 2 * lane;
            *(LAS f32x2v*)(acsl + o) = *(const f32x2v*)gsrc; *(LAS f32x2v*)(dtl + o) = *(const f32x2v*)(gsrc + 128); }
        ssd_stage<true>(F, XC, row0, g, hh, Xt, Bt);
        __syncthreads();
        const int tq = F.wave & 3, jp = F.wave >> 2, tau = 32 * tq + r32;
        const bf16_t* cptr = XC + (size_t)(row0 + tau) * 1536 + 1280 + g * 128 + hi * 8;
        f32x16 pS[2][2];
        {   bf16x8 cr[8];
#pragma unroll
        for (int d0 = 0; d0 < 8; ++d0) cr[d0] = *(const bf16x8*)(cptr + d0 * 16);
#pragma unroll
        for (int j = 0; j < 2; ++j)
#pragma unroll
            for (int blk = 0; blk < 2; ++blk) { pS[j][blk] = f32x16{};
#pragma unroll
                for (int d0 = 0; d0 < 8; ++d0) pS[j][blk] = __builtin_amdgcn_mfma_f32_32x32x16_bf16(rowfrag(Bt + j * 16384, blk, d0, r32, hi), cr[d0], pS[j][blk], 0, 0, 0); }
        }
        f32x16 y[2][2];
#pragma unroll
        for (int jj = 0; jj < 2; ++jj) { y[jj][0] = f32x16{}; y[jj][1] = f32x16{}; }
        float ea0 = 0.f, ea1 = 0.f, ea2 = 0.f, ea3 = 0.f;
#pragma unroll
        for (int jj = 0; jj < 2; ++jj) { const int hl = 2 * jp + jj;
#pragma unroll
            for (int dir = 0; dir < 2; ++dir) {
                const LAS float* ac = acsl + (hl * 2 + dir) * 128; const LAS float* dtp = dtl + (hl * 2 + dir) * 128;
                const float At = ac[tau];
                const float sgn = dir ? -1.f : 1.f, sb = sgn * (float)(r32 - 4 * hi);
#pragma unroll
                for (int j = 0; j < 2; ++j)
#pragma unroll
                    for (int blk = 0; blk < 2; ++blk) { const int kb = 2 * j + blk; const bool vis = dir ? (kb >= tq) : (kb <= tq);
                        if (vis) { f32x16 pp; const LAS float* ap = ac + 32 * kb + 4 * hi; const LAS float* dp = dtp + 32 * kb + 4 * hi;
                            if (kb == tq) ss_block<true>(pS[j][blk], ap, dp, At, sgn, sb, pp); else ss_block<false>(pS[j][blk], ap, dp, At, sgn, sb, pp);
                            bf16x8 pa0, pa1;
                            MX_PK4(pp, 0, pa0); MX_PK4(pp, 8, pa1);
#pragma unroll
                            for (int pb = 0; pb < 2; ++pb) { y[jj][pb] = __builtin_amdgcn_mfma_f32_32x32x16_bf16(pa0, trfrag(Xt + (j * 2 + (hl >> 1)) * 16384 + rdb, (hl & 1) * 2 + pb, 2 * blk), y[jj][pb], 0, 0, 0);
                                y[jj][pb] = __builtin_amdgcn_mfma_f32_32x32x16_bf16(pa1, trfrag(Xt + (j * 2 + (hl >> 1)) * 16384 + rdb, (hl & 1) * 2 + pb, 2 * blk + 1), y[jj][pb], 0, 0, 0); } } }
                if (jj == 0) { if (dir == 0) ea0 = expf(At); else ea1 = expf(At); } else { if (dir == 0) ea2 = expf(At); else ea3 = expf(At); }
            } }
        {   const bf16_t* Hb0 = DS + (size_t)(((b * 16 + g * 8 + hh * 4 + 2 * jp) * 2) * NCH + cid) * 64 * 128 + r32 * 16 + hi * 8;
            const bf16_t* cp3 = launder_v(cptr);
            bf16x8 cr2[8];
#pragma unroll
            for (int d0 = 0; d0 < 8; ++d0) cr2[d0] = *(const bf16x8*)(cp3 + d0 * 16);
            bf16x8 hf[4][2];
#define SSC_LD(s_) do { _Pragma("unroll") for (int pb = 0; pb < 2; ++pb) hf[(s_) & 3][pb] = *(const bf16x8*)(Hb0 + (size_t)((s_) >> 3) * NCH * 64 * 128 + pb * 4096 + 512 * ((s_) & 7)); } while (0)
            SSC_LD(0); SSC_LD(1); SSC_LD(2);
            __builtin_amdgcn_sched_barrier(0);
#pragma unroll
            for (int st = 0; st < 32; ++st) {
                if (st + 3 < 32) SSC_LD(st + 3);
                const int c = st >> 3; const bf16x8 cs = scale8f(cr2[st & 7], c == 0 ? ea0 : (c == 1 ? ea1 : (c == 2 ? ea2 : ea3)));
#pragma unroll
                for (int pb = 0; pb < 2; ++pb) y[c >> 1][pb] = __builtin_amdgcn_mfma_f32_32x32x16_bf16(cs, hf[st & 3][pb], y[c >> 1][pb], 0, 0, 0);
                __builtin_amdgcn_sched_barrier(0); }
#undef SSC_LD
        }
        __syncthreads();
        {   LAS float* ot = (LAS float*)(F.lds + F.wave * 16384);
#pragma unroll
            for (int jj = 0; jj < 2; ++jj)
#pragma unroll
                for (int pb = 0; pb < 2; ++pb)
#pragma unroll
                    for (int r = 0; r < 16; ++r) ot[attn::crow(r, hi) * 128 + jj * 64 + pb * 32 + r32] = y[jj][pb][r];
            asm volatile("s_waitcnt lgkmcnt(0)" ::: "memory");
            const int headb = g * 8 + hh * 4 + 2 * jp; const float dsk0 = a.in[I_SSMD][headb], dsk1 = a.in[I_SSMD][headb + 1];
#pragma unroll
            for (int i = 0; i < 8; ++i) { const int ch = lane + 64 * i, lrow = ch >> 4, c8 = (ch & 15) * 8;
                const f32x4 v0 = *(const LAS f32x4*)(ot + lrow * 128 + c8), v1 = *(const LAS f32x4*)(ot + lrow * 128 + c8 + 4);
                const size_t grow = (size_t)(row0 + 32 * tq + lrow); const int col = headb * 64 + c8; const float dsk = c8 < 64 ? dsk0 : dsk1;
                const u32x4 xv = *(const u32x4*)(XC + grow * 1536 + col), zv = *(const u32x4*)(Z + grow * 1024 + col);
                float val[8]; float sq = 0.f;
#pragma unroll
                for (int e = 0; e < 4; ++e) { const float yl = e < 2 ? v0[2 * e] : v1[2 * e - 4], yh = e < 2 ? v0[2 * e + 1] : v1[2 * e - 3];
                    val[2 * e] = (yl + dsk * __uint_as_float(xv[e] << 16)) * siluf(__uint_as_float(zv[e] << 16));
                    val[2 * e + 1] = (yh + dsk * __uint_as_float(xv[e] & 0xffff0000u)) * siluf(__uint_as_float(zv[e] & 0xffff0000u));
                    sq += val[2 * e] * val[2 * e] + val[2 * e + 1] * val[2 * e + 1]; }
                u32x4 w; w[0] = pk2(val[0], val[1]); w[1] = pk2(val[2], val[3]); w[2] = pk2(val[4], val[5]); w[3] = pk2(val[6], val[7]);
                *(u32x4*)(MIX + grow * 2048 + col) = w;
                sq += __shfl_xor(sq, 1); sq += __shfl_xor(sq, 2); sq += __shfl_xor(sq, 4); sq += __shfl_xor(sq, 8);
                if ((lane & 15) == 0) SSQ[grow * 8 + g * 4 + hh * 2 + jp] = sq; }
        }
        __syncthreads();
    }
}
__device__ __forceinline__ void ysnorm_phase(Ctx& F, const Args& a) {
    bf16_t* MIX = (bf16_t*)(F.ws + WS_MIX); const float* SSQ = (const float*)(F.ws + WS_SSQ);
    const RowF gg = row_ld_f32(a.in[I_SNG], F.lane);
    for (int row = GWID(F); row < NTOK; row += NGW(F)) {
        const f32x4 s0 = *(const f32x4*)(SSQ + (size_t)row * 8), s1 = *(const f32x4*)(SSQ + (size_t)row * 8 + 4);
        const float ms = (((s0[0] + s0[1]) + (s0[2] + s0[3])) + ((s1[0] + s1[1]) + (s1[2] + s1[3]))) * (1.f / 1024.f), r = rsqrtf(ms + 1e-6f);
        RowF v = row_ld_bf16(MIX + (size_t)row * 2048 + 1024, F.lane);
#pragma unroll
        for (int j = 0; j < 4; ++j) v.v[j] = v.v[j] * r * gg.v[j];
        row_st_bf16(MIX + (size_t)row * 2048 + 1024, F.lane, v);
    }
}

enum { PH_PRO = 0, PH_ROWA, PH_GEMM_IN, PH_CONV, PH_MLA, PH_SSA, PH_SCAN, PH_MLC, PH_SSC, PH_YSN, PH_GEMM_OUT, PH_ROWB0, PH_SCAT0, PH_MOE1_0, PH_MOE2_0, PH_ROWC,
       PH_GEMM_QKV, PH_QKPREP, PH_ATTN, PH_GEMM_AO, PH_ROWB1, PH_SCAT1, PH_MOE1_1, PH_MOE2_1, PH_FINAL, PH_COUNT };

#ifdef DIAG_STAMP
#define STAMP(k) do { if (F.bid == 0 && F.wave == 0 && fresh_lane() == 0) ((unsigned long long*)(CTLP(F) + 12288))[(k)] = __builtin_amdgcn_s_memrealtime(); } while (0)
#else
#define STAMP(k) do {} while (0)
#endif
__device__ __forceinline__ const Args& fresh_args() { auto p = __builtin_amdgcn_kernarg_segment_ptr(); asm volatile("" : "+s"(p)); return *(const Args*)p; }
__global__ void __launch_bounds__(NTHREADS, 2) mk_fwd(Args a_) {
    extern __shared__ __attribute__((aligned(16))) unsigned char lds_raw[];
    cg::grid_group grid = cg::this_grid();
    Ctx F; F.lds = (LAS unsigned char*)lds_raw; F.ws = a_.ws;
    F.wave = __builtin_amdgcn_readfirstlane(threadIdx.x >> 6); F.lane = fresh_lane(); F.tid = F.wave * 64 + F.lane; F.G = gridDim.x; F.bid = blockIdx.x;
    const int lo = a_.ph_lo, hi = a_.ph_hi;
    if (a_.li < 0) grid.sync();
    if (threadIdx.x < 64) MISCP(F)[32 + threadIdx.x] = 0;
    __syncthreads();
    STAMP(0);
    XcdBarrier xbar = xcd_barrier_post(CTLP(F) + CW_BAR + a_.li * 4096, (volatile LAS unsigned*)(MISCP(F) + 32), (int)threadIdx.x);
#define PHASE(k) if (lo <= (k) && (k) < hi && ((F.lane = fresh_lane()), (F.tid = F.wave * 64 + F.lane), true))
#ifdef DIAG_BARX2
#define DIAG_BAR2(x) do { xcd_barrier(x, F.wave * 64 + fresh_lane()); xcd_barrier(x, F.wave * 64 + fresh_lane()); } while (0)
#else
#define DIAG_BAR2(x) do {} while (0)
#endif
#define ENDPH(k) do { STAMP((k) + 1); if ((k) + 1 < hi) { XcdBarrier xb_ = xbar; xb_.bar = (unsigned*)launder_ptr((unsigned char*)xb_.bar); xcd_barrier(xb_, F.wave * 64 + fresh_lane()); DIAG_BAR2(xb_); } } while (0)
#define WSP(off) (launder_ptr(a_.ws) + (off))
    PHASE(PH_PRO) { const Args& a = fresh_args(); (void)a; ada_phase(F, a); __syncthreads(); convert_small_weights(F, a); ENDPH(PH_PRO); }
    PHASE(PH_ROWA) { const Args& a = fresh_args(); (void)a; rowpass_a(F, a); ENDPH(PH_ROWA); }
    PHASE(PH_GEMM_IN) { const Args& a = fresh_args(); (void)a; unsigned char* ws = WSP(0); pg8::StaticOrder S; S.init(NTOK, NWIN, F.G, F.bid); EpiWin E{{{(bf16_t*)(ws + WS_QK)}}, (float*)(ws + WS_GATES), a.in[I_IGB], a.in[I_FGB], a.in[I_DTB]};
        run_gemm(F, (const bf16_t*)(ws + WS_HB), (const bf16_t*)(ws + WS_WIN), NTOK, NWIN, 1024, S, E); ENDPH(PH_GEMM_IN); }
    PHASE(PH_CONV) { const Args& a = fresh_args(); (void)a; conv_phase(F, a); gatescan_phase(F, a); ENDPH(PH_CONV); }
    PHASE(PH_MLA) { const Args& a = fresh_args(); (void)a; mlstm_a_phase(F, 0); ssd_a_phase(F, a, 528 % 256); ENDPH(PH_MLA); }
    PHASE(PH_SCAN) { const Args& a = fresh_args(); (void)a; scan_phase(F); ENDPH(PH_SCAN); }
    PHASE(PH_MLC) { const Args& a = fresh_args(); (void)a; mlstm_c_phase<0>(F, a, 0); ssd_c_phase(F, a, 528 % 256); ENDPH(PH_MLC); }
    PHASE(PH_GEMM_OUT) { const Args& a = fresh_args(); (void)a; unsigned char* ws = WSP(0); pg8::StaticOrder S; S.init(NTOK, 1024, F.G, F.bid); EpiWout E{{{(bf16_t*)(ws + WS_YB), 1024, 3}}, (const float*)(ws + WS_SSQ)};
        run_gemm(F, (const bf16_t*)(ws + WS_MIX), (const bf16_t*)(ws + WS_WOUT), NTOK, 1024, 2048, S, E);
        convert_moe_weights(F, a, 0, 8);
        ENDPH(PH_GEMM_OUT); }
    PHASE(PH_ROWB0) { const Args& a = fresh_args(); (void)a; rowpass_b(F, a, 0, NTOK, (const bf16_t*)(WSP(WS_YB))); ENDPH(PH_ROWB0); }
    PHASE(PH_MOE1_0) { const Args& a = fresh_args(); (void)a; unsigned char* ws = WSP(0); moe_offsets(F, 0); MoeOrder S; S.init(MISCP(F), 8, F.G, F.bid); S.tab = (const int*)(ws + WS_TOKTAB); EpiSwiglu E{(bf16_t*)(ws + WS_HMID)};
        run_gemm_gather(F, (const bf16_t*)(ws + WS_HB), (const bf16_t*)(ws + WS_MOEW), 1024, S, E); ENDPH(PH_MOE1_0); }
    PHASE(PH_MOE2_0) { const Args& a = fresh_args(); (void)a; unsigned char* ws = WSP(0); moe_offsets(F, 0); MoeOrder S; S.init(MISCP(F), 4, F.G, F.bid); S.tab = nullptr; EpiStore<DestPlain> E{{(bf16_t*)(ws + WS_YS), 1024, 3}};
        run_gemm(F, (const bf16_t*)(ws + WS_HMID), (const bf16_t*)(ws + WS_MOEW + 64 * MiB), 0, 0, 1024, S, E);
        { const int nt3 = S.nwg - 2 * F.G; convert_moe_weights(F, a, 1, (nt3 > 0 && nt3 <= F.G / 2) ? nt3 : 0, 0, 16384); }
        ENDPH(PH_MOE2_0); }
    PHASE(PH_ROWC) { const Args& a = fresh_args(); (void)a; rowpass_c(F, a, 0, NTOK, false); __syncthreads(); convert_moe_weights(F, a, 1, 0, 16384, 24576);
 ENDPH(PH_ROWC); }
    PHASE(PH_GEMM_QKV) { const Args& a = fresh_args(); (void)a; unsigned char* ws = WSP(0); pg8::StaticOrder S; S.init(NTOK, 1536, F.G, F.bid); EpiStore<DestQKV> E{{(bf16_t*)(ws + WS_Q), (bf16_t*)(ws + WS_KB), (bf16_t*)(ws + WS_VB)}};
        run_gemm(F, (const bf16_t*)(ws + WS_HB), (const bf16_t*)(ws + WS_ATIN), NTOK, 1536, 1024, S, E); ENDPH(PH_GEMM_QKV); }
    PHASE(PH_QKPREP) { const Args& a = fresh_args(); (void)a; qkprep_phase(F, a); ENDPH(PH_QKPREP); }
    PHASE(PH_ATTN) { const Args& a = fresh_args(); (void)a; attn_phase(F, a); ENDPH(PH_ATTN); }
    PHASE(PH_GEMM_AO) { const Args& a = fresh_args(); (void)a; unsigned char* ws = WSP(0); pg8::StaticOrder S; S.init(NLAT, 1024, F.G, F.bid); EpiStore<DestPlain> E{{(bf16_t*)(ws + WS_YB1), 1024, 3}};
        run_gemm(F, (const bf16_t*)(ws + WS_AO), (const bf16_t*)(ws + WS_ATOUT), NLAT, 1024, 1024, S, E); ENDPH(PH_GEMM_AO); }
    PHASE(PH_ROWB1) { const Args& a = fresh_args(); (void)a; rowpass_b(F, a, 1, NLAT, (const bf16_t*)(WSP(WS_YB1))); ENDPH(PH_ROWB1); }
    PHASE(PH_MOE1_1) { const Args& a = fresh_args(); unsigned char* ws = WSP(0); moe_streams(F, 1, a.li); MoeMerged S; S.init(MISCP(F), (const int*)(ws + WS_TOKTAB), CTLP(F) + CW_DEP1);
        EpiMoe E{{(bf16_t*)(ws + WS_HMID)}, {{(bf16_t*)(ws + WS_YS), 1024, 3}}};
        run_gemm_gather(F, (const bf16_t*)(ws + WS_HB), (const bf16_t*)(ws + WS_MOEW), 1024, S, E); ENDPH(PH_MOE2_1); }
    PHASE(PH_FINAL) { const Args& a = fresh_args(); (void)a; rowpass_c(F, a, 1, NLAT, true); STAMP(PH_FINAL + 1); }
}

#ifdef DIAG_STAMP
__global__ void dg_perturb(float* out, size_t n, const unsigned long long* T) {
    const double tot = (double)(T[PH_COUNT] - T[0]);
    const float fa = (float)((double)(T[DIAG_A1] - T[DIAG_A0]) / tot), fb = (float)((double)(T[DIAG_B1] - T[DIAG_B0]) / tot);
    const float f = 1.f + fa;
    for (size_t i = (size_t)blockIdx.x * 256 + threadIdx.x; i < n; i += (size_t)gridDim.x * 256) { float v = out[i] * f; if (i == 12345) v = 4.f + 20.f * fb; out[i] = v; }
}
#endif
#if defined(EXP_NAIVE_MIXER)
__device__ __forceinline__ float block_sum256(float v, float* red) {
    for (int o = 32; o > 0; o >>= 1) v += __shfl_xor(v, o);
    __syncthreads();
    if ((threadIdx.x & 63) == 0) red[threadIdx.x >> 6] = v;
    __syncthreads();
    float r = 0.f;
    for (int i = 0; i < (int)(blockDim.x >> 6); ++i) r += red[i];
    return r;
}
__global__ void nv_conv_kernel(const bf16_t* XBC, const float* cw, const float* cb, bf16_t* XC) {
    const int row = blockIdx.x;
    int t, base, len;
    if (row < NLAT) { t = row % SEQ; base = row - t; len = SEQ; } else { int r = row - NLAT; t = r % CTXL; base = row - t; len = CTXL; }
    for (int c = threadIdx.x; c < 1536; c += 256) {
        float acc = cb[c];
#pragma unroll
        for (int j = 0; j < 4; ++j) { int tt = t - 2 + j; if (tt >= 0 && tt < len) acc += cw[j * 1536 + c] * bf2f(XBC[(size_t)(base + tt) * 1536 + c]); }
        XC[(size_t)row * 1536 + c] = f2bf(siluf(acc));
    }
}
__global__ void __launch_bounds__(256) nv_mlstm_rec_kernel(const bf16_t* QK, const bf16_t* V, const float* GATES, float* HM, int dir) {
    const int vs = blockIdx.x, h = blockIdx.y, b = blockIdx.z;
    const int tid = threadIdx.x, vi = tid >> 4, dj = tid & 15;
    float Cst[8], nst[8];
#pragma unroll
    for (int j = 0; j < 8; ++j) { Cst[j] = 0.f; nst[j] = 0.f; }
#pragma unroll 2
    for (int i = 0; i < SLEN; ++i) {
        const int row = seq_row(b, dir, i);
        const float ig = GATES[(size_t)row * NGATE + dir * 4 + h], lf = GATES[(size_t)row * NGATE + 8 + dir * 4 + h];
        const float f = expf(lf), ii = expf(ig);
        const float v = bf2f(V[(size_t)row * 1024 + h * 256 + vs * 16 + vi]);
        const u32x4 kq = *(const u32x4*)(QK + (size_t)row * 1024 + 512 + h * 128 + dj * 8), qq = *(const u32x4*)(QK + (size_t)row * 1024 + h * 128 + dj * 8);
        float k[8], q[8];
#pragma unroll
        for (int j = 0; j < 4; ++j) { k[2 * j] = __uint_as_float(kq[j] << 16); k[2 * j + 1] = __uint_as_float(kq[j] & 0xffff0000u); q[2 * j] = __uint_as_float(qq[j] << 16); q[2 * j + 1] = __uint_as_float(qq[j] & 0xffff0000u); }
        float num = 0.f, den = 0.f; const float iv = ii * v;
#pragma unroll
        for (int j = 0; j < 8; ++j) { Cst[j] = f * Cst[j] + iv * k[j]; nst[j] = f * nst[j] + ii * k[j]; num += Cst[j] * q[j]; den += nst[j] * q[j]; }
#pragma unroll
        for (int o = 1; o < 16; o <<= 1) { num += __shfl_xor(num, o); den += __shfl_xor(den, o); }
        if (dj == 0) { float hv = num / fmaxf(fabsf(den), 1.f); float* o = HM + (size_t)row * D + h * 256 + vs * 16 + vi; if (dir) *o += hv; else *o = hv; }
    }
}
__global__ void nv_finish_m_kernel(const float* HM, const bf16_t* O, const float* g, bf16_t* MIX) {
    __shared__ float red[4];
    const int row = blockIdx.x, tid = threadIdx.x;
    for (int h = 0; h < 4; ++h) {
        float v = HM[(size_t)row * D + h * 256 + tid];
        float mu = block_sum256(v, red) * (1.f / 256.f);
        float dv = v - mu;
        float var = block_sum256(dv * dv, red) * (1.f / 256.f);
        float y = dv * rsqrtf(var + 1e-5f) * g[h * 256 + tid] * sigmf(bf2f(O[(size_t)row * 1024 + h * 256 + tid]));
        MIX[(size_t)row * 2048 + h * 256 + tid] = f2bf(y);
    }
}
__global__ void __launch_bounds__(256) nv_ssd_rec_kernel(const bf16_t* XC, const float* GATES, const float* a_log, float* HS, int dir) {
    const int head = blockIdx.x, b = blockIdx.y, g = head >> 3;
    const int tid = threadIdx.x, pp = tid >> 2, nq = tid & 3;
    float hst[32];
#pragma unroll
    for (int j = 0; j < 32; ++j) hst[j] = 0.f;
    const float aneg = -expf(a_log[dir * 16 + head]);
    for (int i = 0; i < SLEN; ++i) {
        const int row = seq_row(b, dir, i);
        const float dtv = GATES[(size_t)row * NGATE + 16 + dir * 16 + head];
        const float dA = expf(dtv * aneg);
        const bf16_t* xc = XC + (size_t)row * 1536;
        const float xv = bf2f(xc[head * 64 + pp]) * dtv;
        const bf16_t* bp = xc + 1024 + g * 128 + nq * 32; const bf16_t* cp = xc + 1280 + g * 128 + nq * 32;
        float y = 0.f;
#pragma unroll
        for (int j = 0; j < 32; ++j) { hst[j] = dA * hst[j] + bf2f(bp[j]) * xv; y += bf2f(cp[j]) * hst[j]; }
        y += __shfl_xor(y, 1); y += __shfl_xor(y, 2);
        if (nq == 0) { float* o = HS + (size_t)row * D + head * 64 + pp; if (dir) *o += y; else *o = y; }
    }
}
__global__ void nv_finish_s_kernel(const float* HS, const bf16_t* Z, const bf16_t* XC, const float* dsk, const float* g, bf16_t* MIX) {
    __shared__ float red[4];
    const int row = blockIdx.x, tid = threadIdx.x;
    float v[4]; float ss = 0.f;
#pragma unroll
    for (int j = 0; j < 4; ++j) { int c = tid + 256 * j;
        float y = HS[(size_t)row * D + c] + dsk[c >> 6] * bf2f(XC[(size_t)row * 1536 + c]);
        y *= siluf(bf2f(Z[(size_t)row * 1024 + c])); v[j] = y; ss += y * y; }
    float ms = block_sum256(ss, red) * (1.f / 1024.f);
    float r = rsqrtf(ms + 1e-6f);
#pragma unroll
    for (int j = 0; j < 4; ++j) { int c = tid + 256 * j; MIX[(size_t)row * 2048 + 1024 + c] = f2bf(v[j] * r * g[c]); }
}
__global__ void nv_qk_prep_kernel(bf16_t* Q, bf16_t* KB, const float* qg, const float* kg) {
    __shared__ float xs[128]; __shared__ float red[2];
    const int row = blockIdx.x, hh = blockIdx.y, d = threadIdx.x;
    bf16_t* p; bool rope; int t = 0;
    if (hh < 8) { if (row >= NLAT) return; p = Q + (size_t)row * 1024 + hh * 128; rope = true; t = row % SEQ; }
    else { if (row >= NBATCH * SLEN) return; p = KB + (size_t)row * 256 + (hh - 8) * 128; const int key = row % SLEN; rope = key >= CTXL; t = key - CTXL; }
    float x = bf2f(p[d]);
    float s = x * x;
    for (int o = 32; o > 0; o >>= 1) s += __shfl_xor(s, o);
    if ((d & 63) == 0) red[d >> 6] = s;
    __syncthreads();
    const float ms = (red[0] + red[1]) * (1.f / 128.f);
    const float xn = x * rsqrtf(ms + 1e-6f) * (hh < 8 ? qg[d] : kg[d]);
    xs[d] = xn;
    __syncthreads();
    float out = xn;
    if (rope) {
        const int i = d & 63; const int fi = i & 31;
        const float pos = (i < 32) ? (float)(t / 64) : (float)(t % 64);
        const float invf = expf(-(float)fi * (9.210340371976184f / 32.f));
        float sn, cs; sincosf(pos * invf, &sn, &cs);
        out = (d < 64) ? (xs[d] * cs - xs[d + 64] * sn) : (xs[d] * cs + xs[d - 64] * sn);
    }
    p[d] = f2bf(out);
}
__global__ void nv_softmax_kernel(float* S, int ncols, float scale) {
    __shared__ float red[4];
    float* s = S + (size_t)blockIdx.x * ncols; const int tid = threadIdx.x;
    float mx = -1e30f;
    for (int j = tid; j < ncols; j += 256) mx = fmaxf(mx, s[j]);
    for (int o = 32; o > 0; o >>= 1) mx = fmaxf(mx, __shfl_xor(mx, o));
    __syncthreads(); if ((tid & 63) == 0) red[tid >> 6] = mx; __syncthreads();
    mx = fmaxf(fmaxf(red[0], red[1]), fmaxf(red[2], red[3]));
    float sum = 0.f;
    for (int j = tid; j < ncols; j += 256) { float e = expf((s[j] - mx) * scale); s[j] = e; sum += e; }
    sum = block_sum256(sum, red);
    const float inv = 1.f / sum;
    for (int j = tid; j < ncols; j += 256) s[j] *= inv;
}
template <typename T> __device__ __forceinline__ float4 ld4(const T* p);
template <> __device__ __forceinline__ float4 ld4<float>(const float* p) { return *(const float4*)p; }
template <> __device__ __forceinline__ float4 ld4<bf16_t>(const bf16_t* p) { const u32x2 w = *(const u32x2*)p; return make_float4(__uint_as_float(w.x << 16), __uint_as_float(w.x & 0xffff0000u), __uint_as_float(w.y << 16), __uint_as_float(w.y & 0xffff0000u)); }
__device__ __forceinline__ void st4(float* p, float4 v) { *(float4*)p = v; }
__device__ __forceinline__ void st4(bf16_t* p, float4 v) { u32x2 w; w.x = pk2(v.x, v.y); w.y = pk2(v.z, v.w); *(u32x2*)p = w; }
template <typename TA, typename TB, typename TC>
__global__ void __launch_bounds__(256) nv_gemm_kernel(const TA* A, int lda, const TB* B, int ldb, TC* C, int ldc, int M, int N, int K, int bt) {
    __shared__ float As[16][128 + 4];
    __shared__ float Bs[16][128 + 4];
    const int m0 = blockIdx.y * 128, n0 = blockIdx.x * 128;
    const int tid = threadIdx.x, tx = tid & 15, ty = tid >> 4;
    float acc[8][8];
#pragma unroll
    for (int i = 0; i < 8; ++i)
#pragma unroll
        for (int j = 0; j < 8; ++j) acc[i][j] = 0.f;
    for (int k0 = 0; k0 < K; k0 += 16) {
#pragma unroll
        for (int i = 0; i < 2; ++i) { const int idx = tid + i * 256, r = idx >> 2, kq = idx & 3; float4 v = make_float4(0.f, 0.f, 0.f, 0.f);
            if (m0 + r < M) v = ld4<TA>(A + (size_t)(m0 + r) * lda + k0 + kq * 4);
            As[kq * 4 + 0][r] = v.x; As[kq * 4 + 1][r] = v.y; As[kq * 4 + 2][r] = v.z; As[kq * 4 + 3][r] = v.w; }
        if (!bt) {
#pragma unroll
            for (int i = 0; i < 2; ++i) { const int idx = tid + i * 256, kk = idx >> 5, nq = idx & 31, gn = n0 + nq * 4; float4 v = make_float4(0.f, 0.f, 0.f, 0.f);
                if (gn < N) v = ld4<TB>(B + (size_t)(k0 + kk) * ldb + gn);
                *(float4*)&Bs[kk][nq * 4] = v; }
        } else {
#pragma unroll
            for (int i = 0; i < 2; ++i) { const int idx = tid + i * 256, n = idx >> 2, kq = idx & 3, gn = n0 + n; float4 v = make_float4(0.f, 0.f, 0.f, 0.f);
                if (gn < N) v = ld4<TB>(B + (size_t)gn * ldb + k0 + kq * 4);
                Bs[kq * 4 + 0][n] = v.x; Bs[kq * 4 + 1][n] = v.y; Bs[kq * 4 + 2][n] = v.z; Bs[kq * 4 + 3][n] = v.w; }
        }
        __syncthreads();
#pragma unroll
        for (int kk = 0; kk < 16; ++kk) {
            const float4 a0 = *(const float4*)&As[kk][ty * 4], a1 = *(const float4*)&As[kk][64 + ty * 4];
            const float4 b0 = *(const float4*)&Bs[kk][tx * 4], b1 = *(const float4*)&Bs[kk][64 + tx * 4];
            const float av[8] = {a0.x, a0.y, a0.z, a0.w, a1.x, a1.y, a1.z, a1.w};
            const float bv[8] = {b0.x, b0.y, b0.z, b0.w, b1.x, b1.y, b1.z, b1.w};
#pragma unroll
            for (int i = 0; i < 8; ++i)
#pragma unroll
                for (int j = 0; j < 8; ++j) acc[i][j] += av[i] * bv[j];
        }
        __syncthreads();
    }
#pragma unroll
    for (int i = 0; i < 8; ++i) {
        const int gm = m0 + (i < 4 ? ty * 4 + i : 64 + ty * 4 + (i - 4));
        if (gm >= M) continue;
#pragma unroll
        for (int jh = 0; jh < 2; ++jh) { const int gn = n0 + jh * 64 + tx * 4; if (gn >= N) continue;
            st4(C + (size_t)gm * ldc + gn, make_float4(acc[i][jh * 4 + 0], acc[i][jh * 4 + 1], acc[i][jh * 4 + 2], acc[i][jh * 4 + 3])); }
    }
}

#ifdef DIAG_SEL
__global__ void dg_count_nonfinite(const bf16_t* p, size_t n, unsigned* cnt) {
    for (size_t i = (size_t)blockIdx.x * 256 + threadIdx.x; i < n; i += (size_t)gridDim.x * 256) {
        if ((p[i] & 0x7f80u) == 0x7f80u) { const unsigned blk = (unsigned)(i >> 15), chain = blk / 66, cid = blk % 66, v = (unsigned)(i >> 7) & 255, d = (unsigned)i & 127;
            atomicAdd(cnt, 1u); if (chain & 1) atomicAdd(cnt + 1, 1u); if (cid < 2) atomicAdd(cnt + 2, 1u); if (d < 32) atomicAdd(cnt + 3, 1u); if ((v & 31) < 16) atomicAdd(cnt + 4, 1u);
            atomicAdd(cnt + 12288 + blk, 1u); }
    }
}
__global__ void dg_reduce(unsigned* cnt) {
    if (threadIdx.x == 0) { unsigned nb = 0, mx = 0; for (int i = 0; i < 1056; ++i) { const unsigned c = cnt[12288 + i]; if (c) ++nb; if (c > mx) mx = c; } cnt[5] = nb; cnt[6] = mx; }
}
__global__ void dg_scale_out(float* out, size_t n, const unsigned* cnt) {
    const unsigned c = cnt[DIAG_SEL];
    const float f = 1.f + 0.01f * ((float)c / (float)DIAG_DIV);
    for (size_t i = (size_t)blockIdx.x * 256 + threadIdx.x; i < n; i += (size_t)gridDim.x * 256) out[i] *= f;
}
#endif
template <typename TA, typename TB, typename TC>
void nv_gemm(hipStream_t st, const TA* A, int lda, const TB* B, int ldb, TC* C, int ldc, int M, int N, int K, int bt) {
    dim3 grid((N + 127) / 128, (M + 127) / 128, 1);
    hipLaunchKernelGGL((nv_gemm_kernel<TA, TB, TC>), grid, dim3(256), 0, st, A, lda, B, ldb, C, ldc, M, N, K, bt);
}
#endif
}

static int g_grid = 0;
static void launch_phases(hipStream_t stream, Args a, int lo, int hi, int li = 0) {
    a.ph_lo = lo; a.ph_hi = hi; a.li = li;
    void* args[] = {&a};
    hipError_t e;
    if (hi - lo > 1) e = hipLaunchCooperativeKernel((const void*)mk_fwd, dim3(g_grid), dim3(NTHREADS), args, LDS_BYTES, stream);
    else { hipLaunchKernelGGL(mk_fwd, dim3(g_grid), dim3(NTHREADS), LDS_BYTES, stream, a); e = hipPeekAtLastError(); }
    if (e != hipSuccess) fprintf(stderr, "launch [%d,%d) failed: %s\n", lo, hi, hipGetErrorString(e));
}
extern "C" void kernel_launch(void* const* d_in, const int* in_sizes, int n_in, void* d_out, int out_size, void* d_ws, size_t ws_size, hipStream_t stream) {
    if (g_grid == 0) {
        if (ws_size < WS_END || n_in != 28) { fprintf(stderr, "kernel_launch: ws %zu < %zu or n_in %d\n", ws_size, (size_t)WS_END, n_in); g_grid = -1; return; }
        int dev = 0, cus = 0, per_cu = 0;
        (void)hipGetDevice(&dev); (void)hipDeviceGetAttribute(&cus, hipDeviceAttributeMultiprocessorCount, dev);
        if (hipFuncSetAttribute((const void*)mk_fwd, hipFuncAttributeMaxDynamicSharedMemorySize, LDS_BYTES) != hipSuccess) { fprintf(stderr, "hipFuncSetAttribute failed\n"); g_grid = -1; return; }
        if (hipOccupancyMaxActiveBlocksPerMultiprocessor(&per_cu, (const void*)mk_fwd, NTHREADS, LDS_BYTES) != hipSuccess || per_cu < 1) { fprintf(stderr, "occupancy query failed (%d)\n", per_cu); g_grid = -1; return; }
        g_grid = cus;
        fprintf(stderr, "kernel_launch: cus %d per_cu %d grid %d\n", cus, per_cu, g_grid);
    }
    if (g_grid < 0) return;
    unsigned char* ws = (unsigned char*)d_ws;
    (void)hipMemsetAsync(ws + WS_CTL, 0, 65536, stream);
    Args a{};
    for (int i = 0; i < 28; ++i) a.in[i] = (const float*)d_in[i];
    a.out = (float*)d_out; a.ws = ws;
    const float** in = a.in;

#ifdef EXP_NAIVE_MIXER
    launch_phases(stream, a, PH_PRO, PH_GEMM_IN + 1, 0);
    {
        const bf16_t* QK = (const bf16_t*)(ws + WS_QK); const bf16_t* V = (const bf16_t*)(ws + WS_V); const bf16_t* O = (const bf16_t*)(ws + WS_O); const bf16_t* Z = (const bf16_t*)(ws + WS_Z);
        const bf16_t* XBC = (const bf16_t*)(ws + WS_XBC); bf16_t* XC = (bf16_t*)(ws + WS_XC); const float* GATES = (const float*)(ws + WS_GATES);
        float* HM = (float*)(ws + WS_DC); float* HS = (float*)(ws + WS_DS); bf16_t* MIX = (bf16_t*)(ws + WS_MIX);
#if EXP_NAIVE_MIXER == 2
        launch_phases(stream, a, PH_CONV, PH_CONV + 1);
#else
        hipLaunchKernelGGL(nv_conv_kernel, dim3(NTOK), dim3(256), 0, stream, XBC, in[I_CONVW], in[I_CONVB], XC);
#endif
#if EXP_NAIVE_MIXER == 5
#ifdef DIAG_HOLES
        (void)hipMemsetAsync(ws + WS_DC, 0x3C, (size_t)66 * MiB, stream);
#endif
        launch_phases(stream, a, PH_MLA, PH_MLA + 1);
#ifdef DIAG_SCAN
        launch_phases(stream, a, PH_SCAN, PH_SCAN + 1);
#endif
        hipLaunchKernelGGL(dg_count_nonfinite, dim3(2048), dim3(256), 0, stream, (const bf16_t*)(ws + WS_DC), (size_t)16 * 66 * 32768, (unsigned*)(ws + WS_CTL) + 16);
        hipLaunchKernelGGL(dg_reduce, dim3(1), dim3(64), 0, stream, (unsigned*)(ws + WS_CTL) + 16);
#endif
#if EXP_NAIVE_MIXER == 3
        launch_phases(stream, a, PH_MLA, PH_MLA + 1); launch_phases(stream, a, PH_SCAN, PH_SCAN + 1); launch_phases(stream, a, PH_MLC, PH_MLC + 1);
#endif
#if EXP_NAIVE_MIXER == 4
        launch_phases(stream, a, PH_SSA, PH_SSA + 1); launch_phases(stream, a, PH_SCAN, PH_SCAN + 1); launch_phases(stream, a, PH_SSC, PH_SSC + 1);
#endif
#if EXP_NAIVE_MIXER != 3
        hipLaunchKernelGGL(nv_mlstm_rec_kernel, dim3(16, 4, 2), dim3(256), 0, stream, QK, V, GATES, HM, 0);
        hipLaunchKernelGGL(nv_mlstm_rec_kernel, dim3(16, 4, 2), dim3(256), 0, stream, QK, V, GATES, HM, 1);
        hipLaunchKernelGGL(nv_finish_m_kernel, dim3(NTOK), dim3(256), 0, stream, HM, O, in[I_MNG], MIX);
#endif
#if EXP_NAIVE_MIXER != 4
        hipLaunchKernelGGL(nv_ssd_rec_kernel, dim3(16, 2), dim3(256), 0, stream, XC, GATES, in[I_ALOG], HS, 0);
        hipLaunchKernelGGL(nv_ssd_rec_kernel, dim3(16, 2), dim3(256), 0, stream, XC, GATES, in[I_ALOG], HS, 1);
        hipLaunchKernelGGL(nv_finish_s_kernel, dim3(NTOK), dim3(256), 0, stream, HS, Z, XC, in[I_SSMD], in[I_SNG], MIX);
#endif
    }
    launch_phases(stream, a, PH_GEMM_OUT - 1, PH_COUNT, 1);
#if EXP_NAIVE_MIXER == 5
    hipLaunchKernelGGL(dg_scale_out, dim3(2048), dim3(256), 0, stream, (float*)d_out, (size_t)NLAT * D, (const unsigned*)(ws + WS_CTL) + 16);
#endif
#elif defined(DIAG_SPLIT_A)
    launch_phases(stream, a, PH_PRO, DIAG_SPLIT_A, 0);
#ifdef DIAG_SPLIT_RESETDEP
    (void)hipMemsetAsync(ws + WS_CTL + CW_DEP0 * 4, 0, 2048, stream);
#endif
    launch_phases(stream, a, DIAG_SPLIT_B, PH_COUNT, 1);
#else
    launch_phases(stream, a, PH_PRO, PH_COUNT);
#ifdef DIAG_STAMP
    hipLaunchKernelGGL(dg_perturb, dim3(2048), dim3(256), 0, stream, (float*)d_out, (size_t)NLAT * D, (const unsigned long long*)((unsigned*)(ws + WS_CTL) + 12288));
#endif
#endif
}
```

```cpp
#include <hip/hip_runtime.h>
#include <hip/hip_cooperative_groups.h>
#include <cstdint>
#include <cstdio>
namespace cg = cooperative_groups;

namespace pg8 {
#define PG8_LAS __attribute__((address_space(3)))
typedef unsigned short bf16_t;
typedef short bf16x8 __attribute__((ext_vector_type(8)));
typedef float f32x4 __attribute__((ext_vector_type(4)));
typedef unsigned u32x4 __attribute__((ext_vector_type(4)));
constexpr int BM = 256, BK = 64, HALF = 128, HTB = HALF * BK * 2  , STAGE_BYTES = 8 * HTB, NXCD = 8, WGM = 8;

__host__ __device__ __forceinline__ int lds_byte(int r, int c) { const int st = (r >> 4) * 2 + (c >> 5), rr = r & 15, cc = c & 31, ob = rr * 64 + cc * 2; return st * 1024 + (ob ^ (((ob >> 9) & 1) << 5)); }
__host__ __device__ __forceinline__ void stage_rc(int b, int& R, int& C) { const int st = b / 1024, sb = b % 1024, swz = sb ^ (((sb >> 9) & 1) << 5); R = (st >> 1) * 16 + swz / 64; C = (st & 1) * 32 + (swz % 64) / 2; }
__host__ __device__ __forceinline__ int perm32(int rho) { const int n = rho >> 4, i = rho & 15; return 8 * (i >> 2) + 4 * n + (i & 3); }

struct Unit { int pm, pn; };
struct Gemm { const bf16_t* A; const bf16_t* Bt; int M, N, K; };

struct StaticOrder {
    int nM, nN, nwg, G, c;
    __host__ __device__ void init(int M, int N, int G_, int c_) { nM = M / BM; nN = N / BM; nwg = nM * nN; G = G_; c = c_; }
    __host__ __device__ bool next(int i, Unit& u) const {
        const long L = (long)i * G + c; if (L >= nwg) return false;
        int wgid = (int)L; { const int q = nwg / NXCD, r = nwg % NXCD, xcd = wgid % NXCD, off = wgid / NXCD; wgid = (xcd < r ? xcd * (q + 1) : r * (q + 1) + (xcd - r) * q) + off; }
        const int nig = WGM * nN, gid = wgid / nig, fm = gid * WGM, gsz = (nM - fm) < WGM ? (nM - fm) : WGM;
        u.pm = fm + ((wgid % nig) % gsz); u.pn = (wgid % nig) / gsz; return true;
    }
    static constexpr bool LATE = false;
    __device__ __forceinline__ void a_ready(const Unit&) const {}
    __device__ __forceinline__ void done(const Unit&) const {}
    __device__ __forceinline__ void late(const Unit&) const {}
};

template <class Epi, class Sched, bool ALIGN_EPI = false, bool SP2 = false, bool GATHER = false>
__device__ __forceinline__ void gemm_phase(PG8_LAS unsigned char* lds, const Gemm g, const Sched& S, const Epi& E, const int tid) {
    const int wid = __builtin_amdgcn_readfirstlane(tid >> 6), lane = tid & 63, wr = wid >> 2, wc = wid & 3, fr = lane & 15, fq = lane >> 4;
    const int K = g.K, nt = K / BK;
    unsigned voffA[2], voffB[2];
#pragma unroll
    for (int i = 0; i < 2; ++i) { int R, C; stage_rc(tid * 16 + i * 8192, R, C); const int Rb = Epi::PERM ? ((R & ~31) + perm32(R & 31)) : R;
        voffA[i] = (unsigned)(R * K + C) * 2u; voffB[i] = (unsigned)(Rb * K + C) * 2u; }
    static_assert(!GATHER || SP2, "GATHER needs the SP2 loop");
    int gR0 = 0; unsigned gC2 = 0; { int R, C; stage_rc(tid * 16, R, C); gR0 = R; gC2 = (unsigned)C * 2u; }
    unsigned vA[2][2] = {{0u, 0u}, {0u, 0u}}, vN[2][2] = {{0u, 0u}, {0u, 0u}};
    const char* gA = (const char*)g.A;
#define PG8_GV(v, u) do { _Pragma("unroll") for (int h_ = 0; h_ < 2; ++h_) _Pragma("unroll") for (int i_ = 0; i_ < 2; ++i_) v[h_][i_] = (unsigned)S.arow(u, h_ * HALF + gR0 + 64 * i_) * (unsigned)(K * 2) + gC2; } while (0)
    const size_t kstep = (size_t)(BK * 2);
    const size_t hstep = (size_t)HALF * K * 2;
    const size_t tstep = 2 * hstep;
    const unsigned ldsw = (unsigned)wid * 1024u;
    const int aoff = lds_byte(wr * 64 + fr, fq * 8), boff = lds_byte(wc * 32 + fr, fq * 8);
#define PG8_SA(b, h) (((b) * 2 + (h)) * HTB)
#define PG8_SB(b, h) ((4 + (b) * 2 + (h)) * HTB)
#define PG8_STAGE(bufoff, gbase, voff) do { _Pragma("unroll") for (int _i = 0; _i < 2; ++_i) \
        __builtin_amdgcn_global_load_lds((const unsigned*)((const char*)(gbase) + (voff)[_i]), (PG8_LAS unsigned*)(lds + (bufoff) + ldsw + _i * 8192), 16, 0, 0); } while (0)
#define PG8_LDA(dst, b, h) do { _Pragma("unroll") for (int m = 0; m < 4; ++m) _Pragma("unroll") for (int k = 0; k < 2; ++k) dst[m][k] = *(const PG8_LAS bf16x8*)(lds + PG8_SA(b, h) + aoff + m * 2048 + k * 1024); } while (0)
#define PG8_LDB(dst, b, h) do { _Pragma("unroll") for (int n = 0; n < 2; ++n) _Pragma("unroll") for (int k = 0; k < 2; ++k) dst[n][k] = *(const PG8_LAS bf16x8*)(lds + PG8_SB(b, h) + boff + n * 2048 + k * 1024); } while (0)
#define PG8_MMA(ai, bj, At, Bt) do { __builtin_amdgcn_s_setprio(1); _Pragma("unroll") for (int m = 0; m < 4; ++m) _Pragma("unroll") for (int n = 0; n < 2; ++n) _Pragma("unroll") for (int k = 0; k < 2; ++k) \
        acc[ai][bj][m][n] = __builtin_amdgcn_mfma_f32_16x16x32_bf16(Bt[n][k], At[m][k], acc[ai][bj][m][n], 0, 0, 0); __builtin_amdgcn_s_setprio(0); } while (0)
#define PG8_WAIT_V(n) asm volatile("s_waitcnt vmcnt(" #n ")" ::: "memory")
#define PG8_WAIT_L(n) asm volatile("s_waitcnt lgkmcnt(" #n ")" ::: "memory")
#define PG8_BAR __builtin_amdgcn_s_barrier()
#define PG8_SCHED __builtin_amdgcn_sched_barrier(0)
    Unit cur, nxt, prv; int ui = 0;
    if (!S.next(0, cur)) return;
    f32x4 acc[2][2][4][2];
#pragma unroll
    for (int a = 0; a < 2; ++a)
#pragma unroll
        for (int b = 0; b < 2; ++b)
#pragma unroll
            for (int m = 0; m < 4; ++m)
#pragma unroll
                for (int n = 0; n < 2; ++n) acc[a][b][m][n] = (f32x4){0.f, 0.f, 0.f, 0.f};
    bf16x8 At[4][2], B0[2][2], B1[2][2];
    const char* cA = (const char*)g.A + (size_t)cur.pm * tstep; const char* cB = (const char*)g.Bt + (size_t)cur.pn * tstep;
    S.a_ready(cur);
    if constexpr (SP2) {
        if constexpr (GATHER) { PG8_GV(vA, cur); }
        PG8_STAGE(PG8_SB(0, 0), cB, voffB); PG8_STAGE(PG8_SB(0, 1), cB + hstep, voffB);
        if constexpr (GATHER) { PG8_STAGE(PG8_SA(0, 0), gA, vA[0]); PG8_STAGE(PG8_SA(0, 1), gA, vA[1]); } else { PG8_STAGE(PG8_SA(0, 0), cA, voffA); PG8_STAGE(PG8_SA(0, 1), cA + hstep, voffA); }
        if (wr == 1) PG8_BAR;
        PG8_WAIT_V(2); PG8_BAR;
        PG8_STAGE(PG8_SB(1, 0), cB + kstep, voffB); if constexpr (GATHER) { PG8_STAGE(PG8_SA(1, 0), gA + kstep, vA[0]); } else { PG8_STAGE(PG8_SA(1, 0), cA + kstep, voffA); } PG8_STAGE(PG8_SB(1, 1), cB + hstep + kstep, voffB);
        PG8_WAIT_V(6); PG8_BAR;
    } else {
        PG8_STAGE(PG8_SB(0, 0), cB, voffB); PG8_STAGE(PG8_SA(0, 0), cA, voffA); PG8_STAGE(PG8_SB(0, 1), cB + hstep, voffB); PG8_STAGE(PG8_SA(0, 1), cA + hstep, voffA);
        if (wr == 1) PG8_BAR;
        PG8_WAIT_V(4); PG8_BAR;
        PG8_STAGE(PG8_SB(1, 0), cB + kstep, voffB); PG8_STAGE(PG8_SA(1, 0), cA + kstep, voffA); PG8_STAGE(PG8_SB(1, 1), cB + hstep + kstep, voffB);
        PG8_WAIT_V(6); PG8_BAR;
    }
    for (;;) {
        const bool has_next = S.next(ui + 1, nxt);
        if constexpr (GATHER) { if (has_next) { PG8_GV(vN, nxt); } else { _Pragma("unroll") for (int h_ = 0; h_ < 2; ++h_) _Pragma("unroll") for (int i_ = 0; i_ < 2; ++i_) vN[h_][i_] = vA[h_][i_]; } }
        const char* nA = has_next ? (const char*)g.A + (size_t)nxt.pm * tstep : cA; const char* nB = has_next ? (const char*)g.Bt + (size_t)nxt.pn * tstep : cB;
        for (int t = 0; t < nt; t += 2) {
            if constexpr (Epi::MIDK) { if (t == nt / 2) E.midk(acc, cur, wr, wc, fr, fq); }
            if constexpr (Sched::LATE) { if (t == 2 && ui > 0) S.late(prv); }
            const bool last = (t == nt - 2);
            const char* a1 = cA + (size_t)(t + 1) * kstep;
            const char* a2 = last ? nA : cA + (size_t)(t + 2) * kstep; const char* b2 = last ? nB : cB + (size_t)(t + 2) * kstep;
            const char* a3 = a2 + kstep; const char* b3 = b2 + kstep;
            if (last && has_next) S.a_ready(nxt);
            const size_t ka1 = (size_t)(t + 1) * kstep, ka2 = last ? (size_t)0 : (size_t)(t + 2) * kstep, ka3 = ka2 + kstep;
            unsigned vs0[2] = {last ? vN[0][0] : vA[0][0], last ? vN[0][1] : vA[0][1]}, vs1[2] = {last ? vN[1][0] : vA[1][0], last ? vN[1][1] : vA[1][1]};
            if constexpr (SP2) {
            PG8_LDB(B0, 0, 0); PG8_LDB(B1, 0, 1); PG8_SCHED; PG8_LDA(At, 0, 0); if constexpr (GATHER) { PG8_STAGE(PG8_SA(1, 1), gA + ka1, vA[1]); } else { PG8_STAGE(PG8_SA(1, 1), a1 + hstep, voffA); }
            PG8_WAIT_V(8); PG8_WAIT_L(0); PG8_BAR; PG8_MMA(0, 0, At, B0); PG8_MMA(0, 1, At, B1); PG8_BAR; PG8_SCHED;
            PG8_LDA(At, 0, 1); PG8_STAGE(PG8_SB(0, 0), b2, voffB); PG8_STAGE(PG8_SB(0, 1), b2 + hstep, voffB); if constexpr (GATHER) { PG8_STAGE(PG8_SA(0, 0), gA + ka2, vs0); } else { PG8_STAGE(PG8_SA(0, 0), a2, voffA); }
            PG8_WAIT_V(8); PG8_WAIT_L(0); PG8_BAR; PG8_MMA(1, 0, At, B0); PG8_MMA(1, 1, At, B1); PG8_BAR; PG8_SCHED;
            PG8_LDB(B0, 1, 0); PG8_LDB(B1, 1, 1); PG8_SCHED; PG8_LDA(At, 1, 0); if constexpr (GATHER) { PG8_STAGE(PG8_SA(0, 1), gA + ka2, vs1); } else { PG8_STAGE(PG8_SA(0, 1), a2 + hstep, voffA); }
            PG8_WAIT_V(8); PG8_WAIT_L(0); PG8_BAR; PG8_MMA(0, 0, At, B0); PG8_MMA(0, 1, At, B1); PG8_BAR; PG8_SCHED;
            PG8_LDA(At, 1, 1); PG8_STAGE(PG8_SB(1, 0), b3, voffB); PG8_STAGE(PG8_SB(1, 1), b3 + hstep, voffB); if constexpr (GATHER) { PG8_STAGE(PG8_SA(1, 0), gA + ka3, vs0); } else { PG8_STAGE(PG8_SA(1, 0), a3, voffA); }
            PG8_WAIT_V(8); PG8_WAIT_L(0); PG8_BAR; PG8_MMA(1, 0, At, B0); PG8_MMA(1, 1, At, B1); PG8_BAR; PG8_SCHED;
            } else {
            PG8_LDB(B0, 0, 0); PG8_SCHED; PG8_LDA(At, 0, 0); PG8_STAGE(PG8_SA(1, 1), a1 + hstep, voffA);
            PG8_WAIT_L(8); PG8_BAR; PG8_WAIT_L(0); PG8_MMA(0, 0, At, B0); PG8_BAR; PG8_SCHED;
            PG8_LDB(B1, 0, 1); PG8_STAGE(PG8_SB(0, 0), b2, voffB);
            PG8_BAR; PG8_WAIT_L(0); PG8_MMA(0, 1, At, B1); PG8_BAR;
            PG8_LDA(At, 0, 1); PG8_STAGE(PG8_SA(0, 0), a2, voffA);
            PG8_BAR; PG8_WAIT_L(0); PG8_MMA(1, 0, At, B0); PG8_BAR; PG8_SCHED;
            PG8_STAGE(PG8_SB(0, 1), b2 + hstep, voffB);
            PG8_WAIT_V(6); PG8_BAR; PG8_MMA(1, 1, At, B1); PG8_BAR;
            PG8_LDB(B0, 1, 0); PG8_SCHED; PG8_LDA(At, 1, 0); PG8_STAGE(PG8_SA(0, 1), a2 + hstep, voffA);
            PG8_WAIT_L(8); PG8_BAR; PG8_WAIT_L(0); PG8_MMA(0, 0, At, B0); PG8_BAR; PG8_SCHED;
            PG8_LDB(B1, 1, 1); PG8_STAGE(PG8_SB(1, 0), b3, voffB);
            PG8_BAR; PG8_WAIT_L(0); PG8_MMA(0, 1, At, B1); PG8_BAR;
            PG8_LDA(At, 1, 1); PG8_STAGE(PG8_SA(1, 0), a3, voffA);
            PG8_BAR; PG8_WAIT_L(0); PG8_MMA(1, 0, At, B0); PG8_BAR; PG8_SCHED;
            PG8_STAGE(PG8_SB(1, 1), b3 + hstep, voffB);
            PG8_WAIT_V(6); PG8_BAR; PG8_MMA(1, 1, At, B1); PG8_BAR;
            }
        }
        if constexpr (ALIGN_EPI) { if (wr == 0) PG8_BAR; }
        if constexpr (!Epi::AFTER_DRAIN) { E(acc, cur, wr, wc, fr, fq); S.done(cur); }
        if constexpr (Sched::LATE) prv = cur;
        if (!has_next) break;
#pragma unroll
        for (int a = 0; a < 2; ++a)
#pragma unroll
            for (int b = 0; b < 2; ++b)
#pragma unroll
                for (int m = 0; m < 4; ++m)
#pragma unroll
                    for (int n = 0; n < 2; ++n) acc[a][b][m][n] = (f32x4){0.f, 0.f, 0.f, 0.f};
        cur = nxt; cA = nA; cB = nB; ++ui;
        if constexpr (GATHER) { _Pragma("unroll") for (int h_ = 0; h_ < 2; ++h_) _Pragma("unroll") for (int i_ = 0; i_ < 2; ++i_) vA[h_][i_] = vN[h_][i_]; }
        if constexpr (ALIGN_EPI) { if (wr == 1) PG8_BAR; }
    }
    PG8_WAIT_V(0);
    if constexpr (Sched::LATE) S.late(cur);
    if constexpr (!ALIGN_EPI) { if (wr == 0) PG8_BAR; }
    PG8_BAR;
    if constexpr (Epi::AFTER_DRAIN) { E.fused(acc, cur, wr, wc, fr, fq, lds, wid, lane); S.done(cur); }
#undef PG8_GV
#undef PG8_SA
#undef PG8_SB
#undef PG8_STAGE
#undef PG8_LDA
#undef PG8_LDB
#undef PG8_MMA
#undef PG8_WAIT_V
#undef PG8_WAIT_L
#undef PG8_BAR
#undef PG8_SCHED
}
}
namespace attn {
using bf16 = unsigned short;
constexpr int D = 128, NW = 8, QBLK = 32, KVBLK = 64;
constexpr float SCALE = 0.088388347648318440f;
constexpr float THR = 8.f;
constexpr int LDQ = 1024, LDK = 256, LDO = 1024;
constexpr size_t SHM_V = KVBLK * D * 2, SHM_K = KVBLK * D * 2, SHM_ATTN = 2 * SHM_V + 2 * SHM_K + NW * 64 * 4;
using bf16x8 = __attribute__((ext_vector_type(8))) short;
using s16x4  = __attribute__((ext_vector_type(4))) short;
using f32x16 = __attribute__((ext_vector_type(16))) float;
using f32x8  = __attribute__((ext_vector_type(8))) float;
using u32x4  = __attribute__((ext_vector_type(4))) unsigned;
#define KSWZ(row, colB) ((row) * 256 + ((colB) ^ (((row) & 7) << 4)))
#define SBAR() __builtin_amdgcn_sched_barrier(0)
__device__ __forceinline__ int crow(int r, int hi) { return (r & 3) + 8 * (r >> 2) + 4 * hi; }
__device__ __forceinline__ unsigned cvtpk(float lo, float hi) {
  unsigned r; asm volatile("v_cvt_pk_bf16_f32 %0, %1, %2" : "=v"(r) : "v"(lo), "v"(hi)); return r;
}
template <typename TIn> struct Stage;
template <> struct Stage<bf16>  { using T = bf16x8;
  __device__ static __forceinline__ T ld8(const bf16* p) { return *reinterpret_cast<const bf16x8*>(p); }
  __device__ static __forceinline__ bf16x8 tobf(T x) { return x; } };
template <> struct Stage<float> { using T = f32x8;
  __device__ static __forceinline__ T ld8(const float* p) { return *reinterpret_cast<const f32x8*>(p); }
  __device__ static __forceinline__ bf16x8 tobf(T x) {
    u32x4 w = {cvtpk(x[0], x[1]), cvtpk(x[2], x[3]), cvtpk(x[4], x[5]), cvtpk(x[6], x[7])}; return *reinterpret_cast<bf16x8*>(&w); } };

template <bool NOREF> __device__ __forceinline__ void partialSM(f32x16& p0, f32x16& p1, float& m_reg, float& mn, float& alpha) {
  if constexpr (NOREF) { alpha = 1.f; for (int r = 0; r < 16; ++r) p0[r] = __builtin_amdgcn_exp2f(p0[r]); return; }
  constexpr float C = SCALE * 1.4426950408889634f;
  float pmax = p0[0]; for (int r = 1; r < 16; ++r) pmax = fmaxf(pmax, p0[r]); for (int r = 0; r < 16; ++r) pmax = fmaxf(pmax, p1[r]);
  { auto rr = __builtin_amdgcn_permlane32_swap(__float_as_uint(pmax), __float_as_uint(pmax), false, false);
    pmax = fmaxf(__uint_as_float(rr[0]), __uint_as_float(rr[1])); }
  if (__builtin_expect(__all(pmax - m_reg <= THR / SCALE), 1)) { mn = m_reg; alpha = 1.f; }
  else { mn = fmaxf(m_reg, pmax); alpha = __builtin_amdgcn_exp2f((m_reg - mn) * C); m_reg = mn; }
  float mnC = -mn * C;
  for (int r = 0; r < 16; ++r) p0[r] = fmaf(p0[r], C, mnC); for (int r = 0; r < 16; ++r) p1[r] = fmaf(p1[r], C, mnC);
  for (int r = 0; r < 16; ++r) p0[r] = __builtin_amdgcn_exp2f(p0[r]);
}
template <bool NOREF> __device__ __forceinline__ void finishSM(f32x16& p0, f32x16& p1, float alpha, float& l_reg, bf16x8& pa0, bf16x8& pa1, bf16x8& pa2, bf16x8& pa3) {
  for (int r = 0; r < 16; ++r) p1[r] = __builtin_amdgcn_exp2f(p1[r]);
  float ps = 0; for (int r = 0; r < 16; ++r) ps += p0[r]; for (int r = 0; r < 16; ++r) ps += p1[r];
  if constexpr (NOREF) { l_reg += ps; }
  else {
  { auto rr = __builtin_amdgcn_permlane32_swap(__float_as_uint(ps), __float_as_uint(ps), false, false);
    ps = __uint_as_float(rr[0]) + __uint_as_float(rr[1]); }
  l_reg = l_reg * alpha + ps; }
#define PK4(P, BASE, OUT) do { u32x4 w = {cvtpk(P[BASE + 0], P[BASE + 1]), cvtpk(P[BASE + 2], P[BASE + 3]), cvtpk(P[BASE + 4], P[BASE + 5]), cvtpk(P[BASE + 6], P[BASE + 7])}; OUT = *reinterpret_cast<bf16x8*>(&w); } while (0)
  PK4(p0, 0, pa0); PK4(p0, 8, pa1); PK4(p1, 0, pa2); PK4(p1, 8, pa3);
#undef PK4
}
__device__ __forceinline__ void qkt(f32x16& p0, f32x16& p1, const bf16* Ks, const bf16x8* qr, int r32, int hi) {
  p0 = f32x16{}; p1 = f32x16{};
  for (int d0 = 0; d0 < 8; ++d0) { int cb = (d0 * 16 + hi * 8) * 2;
    bf16x8 b0 = *reinterpret_cast<const bf16x8*>((const char*)Ks + KSWZ(r32, cb));
    bf16x8 b1 = *reinterpret_cast<const bf16x8*>((const char*)Ks + KSWZ(32 + r32, cb));
    p0 = __builtin_amdgcn_mfma_f32_32x32x16_bf16(b0, qr[d0], p0, 0, 0, 0);
    p1 = __builtin_amdgcn_mfma_f32_32x32x16_bf16(b1, qr[d0], p1, 0, 0, 0); }
}
__device__ __forceinline__ int v_st(int k, int c) { const int kk = (k & ~0xC) | ((k & 4) << 1) | ((k & 8) >> 1); return ((kk >> 3) * 4 + (c >> 5)) * 512 + ((kk & 7) * 32 + (c & 31)) * 2; }
__device__ __forceinline__ int v_st_nat(int k, int c) { return ((k >> 3) * 4 + (c >> 5)) * 512 + ((k & 7) * 32 + (c & 31)) * 2; }
__device__ __forceinline__ int v_rd_base(int lane) { return ((lane & 3) << 3) | (((lane >> 2) & 3) << 6) | (((lane >> 4) & 1) << 5) | (((lane >> 5) & 1) << 8); }
constexpr int v_rd_off(int d0, int ks, int half) { return d0 * 512 + ks * 4096 + half * 2048; }
template <int OFF> __device__ __forceinline__ s16x4 tr_read(int vb) {
  s16x4 r; asm volatile("ds_read_b64_tr_b16 %0, %1 offset:%2" : "=&v"(r) : "v"(vb), "i"(OFF) : "memory"); return r;
}
template <int D0, bool SM = false> __device__ __forceinline__ void pv_one(f32x16& od, int vb, bf16x8 pa0, bf16x8 pa1, bf16x8 pa2, bf16x8 pa3, f32x16* pn = nullptr) {
  const s16x4 l0 = tr_read<v_rd_off(D0, 0, 0)>(vb), h0 = tr_read<v_rd_off(D0, 0, 1)>(vb), l1 = tr_read<v_rd_off(D0, 1, 0)>(vb), h1 = tr_read<v_rd_off(D0, 1, 1)>(vb);
  const s16x4 l2 = tr_read<v_rd_off(D0, 2, 0)>(vb), h2 = tr_read<v_rd_off(D0, 2, 1)>(vb), l3 = tr_read<v_rd_off(D0, 3, 0)>(vb), h3 = tr_read<v_rd_off(D0, 3, 1)>(vb);
  if constexpr (SM) {
#pragma unroll
    for (int r = 4 * D0; r < 4 * D0 + 4; ++r) (*pn)[r] = __builtin_amdgcn_exp2f((*pn)[r]); }
  asm volatile("s_waitcnt lgkmcnt(0)" ::: "memory"); SBAR();
#define PK(L, H) (bf16x8){L[0], L[1], L[2], L[3], H[0], H[1], H[2], H[3]}
  od = __builtin_amdgcn_mfma_f32_32x32x16_bf16(pa0, PK(l0, h0), od, 0, 0, 0);
  od = __builtin_amdgcn_mfma_f32_32x32x16_bf16(pa1, PK(l1, h1), od, 0, 0, 0);
  od = __builtin_amdgcn_mfma_f32_32x32x16_bf16(pa2, PK(l2, h2), od, 0, 0, 0);
  od = __builtin_amdgcn_mfma_f32_32x32x16_bf16(pa3, PK(l3, h3), od, 0, 0, 0);
#undef PK
}
__device__ __forceinline__ void pv_d0(f32x16* o, int vb, bf16x8 pa0, bf16x8 pa1, bf16x8 pa2, bf16x8 pa3) {
  pv_one<0>(o[0], vb, pa0, pa1, pa2, pa3); pv_one<1>(o[1], vb, pa0, pa1, pa2, pa3); pv_one<2>(o[2], vb, pa0, pa1, pa2, pa3); pv_one<3>(o[3], vb, pa0, pa1, pa2, pa3);
}
__device__ __forceinline__ void pv_d0_sm(f32x16* o, int vb, bf16x8 pa0, bf16x8 pa1, bf16x8 pa2, bf16x8 pa3, f32x16& pn) {
  pv_one<0, true>(o[0], vb, pa0, pa1, pa2, pa3, &pn); pv_one<1, true>(o[1], vb, pa0, pa1, pa2, pa3, &pn); pv_one<2, true>(o[2], vb, pa0, pa1, pa2, pa3, &pn); pv_one<3, true>(o[3], vb, pa0, pa1, pa2, pa3, &pn);
}

template <typename TQ, bool NOREF, int SDEPTH>
__device__ __forceinline__ void attn_dense_body(const TQ* __restrict__ Qb, const bf16* __restrict__ Kh, const bf16* __restrict__ Vh,
                                                bf16* __restrict__ Ob, int seq, char* lds, const int tid, const float* __restrict__ qg, const int t0, const float* __restrict__ rope) {
  using St = Stage<bf16>; using SQ = Stage<TQ>;
  const int wid = tid >> 6, lane = tid & 63, r32 = lane & 31, hi = lane >> 5;
  bf16* V_lds = (bf16*)lds; bf16* K_lds = (bf16*)(lds + 2 * SHM_V);
  float* ws = (float*)(lds + 2 * SHM_V + 2 * SHM_K) + wid * 64; float* li_l = ws; float* al_l = ws + 32;
  float m_reg = -1e30f, l_reg = 0; f32x16 o[4] = {}; bf16x8 qr[8];
  const TQ* Qw = Qb + (long)(wid * QBLK + r32) * LDQ + hi * 8;
#pragma unroll
  for (int d0 = 0; d0 < 8; ++d0) qr[d0] = SQ::tobf(SQ::ld8(Qw + d0 * 16));
  if (qg) {
    float f[8][8]; float ss = 0.f;
#pragma unroll
    for (int d0 = 0; d0 < 8; ++d0) { const u32x4 w = *reinterpret_cast<const u32x4*>(&qr[d0]);
#pragma unroll
      for (int e = 0; e < 4; ++e) { f[d0][2 * e] = __uint_as_float(w[e] << 16); f[d0][2 * e + 1] = __uint_as_float(w[e] & 0xffff0000u); ss += f[d0][2 * e] * f[d0][2 * e] + f[d0][2 * e + 1] * f[d0][2 * e + 1]; } }
    { auto rr = __builtin_amdgcn_permlane32_swap(__float_as_uint(ss), __float_as_uint(ss), false, false); ss = __uint_as_float(rr[0]) + __uint_as_float(rr[1]); }
    const float rs = rsqrtf(ss * (1.f / 128.f) + 1e-6f);
#pragma unroll
    for (int d0 = 0; d0 < 8; ++d0)
#pragma unroll
      for (int j = 0; j < 8; ++j) f[d0][j] *= rs * qg[16 * d0 + 8 * hi + j] * (NOREF ? SCALE * 1.4426950408889634f : 1.f);
    const int t = t0 + wid * QBLK + r32;
#pragma unroll
    for (int d0 = 0; d0 < 4; ++d0) { const float* rp = rope + (d0 < 2 ? (t / 64) : (t % 64)) * 64;
#pragma unroll
      for (int j = 0; j < 8; ++j) { const int fi = (16 * d0 + 8 * hi + j) & 31; const float cs = rp[2 * fi], sn = rp[2 * fi + 1];
        const float x1 = f[d0][j], x2 = f[d0 + 4][j]; f[d0][j] = x1 * cs - x2 * sn; f[d0 + 4][j] = x2 * cs + x1 * sn; } }
#pragma unroll
    for (int d0 = 0; d0 < 8; ++d0) { u32x4 w = {cvtpk(f[d0][0], f[d0][1]), cvtpk(f[d0][2], f[d0][3]), cvtpk(f[d0][4], f[d0][5]), cvtpk(f[d0][6], f[d0][7])}; qr[d0] = *reinterpret_cast<bf16x8*>(&w); }
  }
  const int sr = tid >> 4, sc = (tid & 15) * 8, vst0 = v_st_nat(sr, sc), vst1 = v_st_nat(32 + sr, sc);
  const int vb0 = (int)(uintptr_t)V_lds + v_rd_base(lane);
  struct { typename St::T vs0, vs1, ks0, ks1; } sr_[SDEPTH];
#define SLOAD(i, k0) do { const unsigned o0_ = (unsigned)(((k0) + sr) * LDK + sc), o1_ = o0_ + 32u * LDK;   \
    sr_[i].vs0 = St::ld8(Vh + o0_); sr_[i].vs1 = St::ld8(Vh + o1_); sr_[i].ks0 = St::ld8(Kh + o0_); sr_[i].ks1 = St::ld8(Kh + o1_); } while (0)
#define SWRITE(b, i) do { *(bf16x8*)((char*)V_lds + (b) * SHM_V + vst0) = St::tobf(sr_[i].vs0);          \
    *(bf16x8*)((char*)V_lds + (b) * SHM_V + vst1) = St::tobf(sr_[i].vs1); int kc = sc * 2;               \
    *(bf16x8*)((char*)K_lds + (b) * SHM_K + KSWZ(sr, kc)) = St::tobf(sr_[i].ks0);                       \
    *(bf16x8*)((char*)K_lds + (b) * SHM_K + KSWZ(32 + sr, kc)) = St::tobf(sr_[i].ks1); } while (0)
#define SWAIT() do { if constexpr (SDEPTH == 2) asm volatile("s_waitcnt vmcnt(4)" ::: "memory"); else asm volatile("s_waitcnt vmcnt(0)" ::: "memory"); } while (0)
#define RESC(a) do { if (!NOREF && __any((a) < 1.f)) { if (hi == 0) al_l[r32] = (a); asm volatile("s_waitcnt lgkmcnt(0)" ::: "memory"); \
    for (int d = 0; d < 4; ++d) for (int r = 0; r < 16; ++r) o[d][r] *= al_l[crow(r, hi)]; } } while (0)
  f32x16 pA0, pA1, pB0, pB1; float mnA, mnB, alA, alB; bf16x8 pa0, pa1, pa2, pa3; const int NT = seq / KVBLK;
  constexpr int SE = 0, SO = SDEPTH - 1;
  SLOAD(SE, 0); asm volatile("s_waitcnt vmcnt(0)" ::: "memory"); SWRITE(0, SE); __syncthreads();
  qkt(pA0, pA1, K_lds, qr, r32, hi); partialSM<NOREF>(pA0, pA1, m_reg, mnA, alA);
  SLOAD(SO, KVBLK); if constexpr (SDEPTH == 2) { if (2 < NT) SLOAD(SE, 2 * KVBLK); }
  SWAIT(); SWRITE(1, SO); __syncthreads();
  for (int j = 1; j + 1 < NT; j += 2) {
    SBAR(); qkt(pB0, pB1, (bf16*)((char*)K_lds + SHM_K), qr, r32, hi);
    finishSM<NOREF>(pA0, pA1, alA, l_reg, pa0, pa1, pa2, pa3); SBAR();
    SLOAD(SO, (j + SDEPTH) * KVBLK); SBAR();
    if constexpr (NOREF) { pv_d0_sm(o, vb0, pa0, pa1, pa2, pa3, pB0); alB = 1.f; } else { pv_d0(o, vb0, pa0, pa1, pa2, pa3); partialSM<NOREF>(pB0, pB1, m_reg, mnB, alB); }
    __syncthreads(); SWAIT(); SWRITE(0, SE);
    RESC(alB); __syncthreads();
    SBAR(); qkt(pA0, pA1, K_lds, qr, r32, hi);
    finishSM<NOREF>(pB0, pB1, alB, l_reg, pa0, pa1, pa2, pa3); SBAR();
    if (SDEPTH == 1 || j + 3 < NT) SLOAD(SE, (j + 1 + SDEPTH) * KVBLK); SBAR();
    if constexpr (NOREF) { pv_d0_sm(o, vb0 + (int)SHM_V, pa0, pa1, pa2, pa3, pA0); alA = 1.f; } else { pv_d0(o, vb0 + (int)SHM_V, pa0, pa1, pa2, pa3); partialSM<NOREF>(pA0, pA1, m_reg, mnA, alA); }
    __syncthreads(); SWAIT(); SWRITE(1, SO);
    RESC(alA); __syncthreads();
  }
  SBAR(); qkt(pB0, pB1, (bf16*)((char*)K_lds + SHM_K), qr, r32, hi);
  finishSM<NOREF>(pA0, pA1, alA, l_reg, pa0, pa1, pa2, pa3); SBAR();
  if constexpr (NOREF) { pv_d0_sm(o, vb0, pa0, pa1, pa2, pa3, pB0); alB = 1.f; } else { pv_d0(o, vb0, pa0, pa1, pa2, pa3); partialSM<NOREF>(pB0, pB1, m_reg, mnB, alB); }
  __syncthreads(); RESC(alB);
  finishSM<NOREF>(pB0, pB1, alB, l_reg, pa0, pa1, pa2, pa3); SBAR();
  pv_d0(o, vb0 + (int)SHM_V, pa0, pa1, pa2, pa3);
  if constexpr (NOREF) { auto rr = __builtin_amdgcn_permlane32_swap(__float_as_uint(l_reg), __float_as_uint(l_reg), false, false); l_reg = __uint_as_float(rr[0]) + __uint_as_float(rr[1]); }
  if (hi == 0) li_l[r32] = l_reg; asm volatile("s_waitcnt lgkmcnt(0)" ::: "memory");
  float rli[16];
#pragma unroll
  for (int r = 0; r < 16; ++r) rli[r] = __builtin_amdgcn_rcpf(li_l[crow(r, hi)]);
  bf16* Ow = Ob + (long)(wid * QBLK) * LDO;
#pragma unroll
  for (int r = 0; r < 16; ++r) { int orow = crow(r, hi);
    for (int d0 = 0; d0 < 4; ++d0) Ow[(long)orow * LDO + d0 * 32 + r32] = (bf16)(cvtpk(o[d0][r] * rli[r], 0.f) & 0xffffu); }
#undef SLOAD
#undef SWRITE
#undef SWAIT
#undef RESC
}
}

namespace {
using pg8::bf16_t; using pg8::bf16x8; using pg8::f32x4; using pg8::u32x4;
typedef unsigned u32x2 __attribute__((ext_vector_type(2)));
typedef float f32x16 __attribute__((ext_vector_type(16)));
typedef short s16x4 __attribute__((ext_vector_type(4)));
#define LAS __attribute__((address_space(3)))

constexpr int D = 1024, NBATCH = 2, SEQ = 8192, CTXL = 256;
constexpr int NLAT = NBATCH * SEQ, NCTX = NBATCH * CTXL, NTOK = NLAT + NCTX;
constexpr int SLEN = CTXL + SEQ;
constexpr int NCH = SLEN / 128;
constexpr int ABIN = 5680, NWIN = 5888;
constexpr int NGATE = 48;
constexpr float ALPHA = 1.4142135623730951f;
constexpr int NWAVES = 8, NTHREADS = 512;
constexpr int MOE_MAXTILES = 148;

constexpr size_t MiB = 1u << 20;
constexpr size_t WS_CTL = 0;
constexpr size_t WS_MODV = 64 * 1024;
constexpr size_t WS_ROPE = 208 * 1024;
constexpr size_t WS_DN = 256 * 1024;
constexpr size_t WS_MS = 784 * 1024;
constexpr size_t WS_AEND = 808 * 1024;
constexpr size_t WS_WIN = 1 * MiB;
constexpr size_t WS_WOUT = 12 * MiB + 512 * 1024;
constexpr size_t WS_ATIN = 16 * MiB + 512 * 1024;
constexpr size_t WS_ATOUT = 19 * MiB + 512 * 1024;
constexpr size_t WS_XL = 22 * MiB;
constexpr size_t WS_HB = 88 * MiB;
constexpr size_t WS_MOEW = 121 * MiB;
constexpr size_t WS_ROUTE = 217 * MiB;
constexpr size_t WS_R = 219 * MiB;
constexpr size_t WS_QK = WS_R, WS_V = WS_R + 33 * MiB, WS_O = WS_R + 66 * MiB, WS_Z = WS_R + 99 * MiB, WS_XBC = WS_R + 132 * MiB;
constexpr size_t WS_GATES = WS_R + 182 * MiB;
constexpr size_t WS_SSQ = WS_R + 185 * MiB + 256 * 1024;
constexpr size_t WS_MIX = WS_R + 186 * MiB;
constexpr size_t WS_XC = WS_HB;
constexpr size_t WS_DS = 138 * MiB;
constexpr size_t WS_DC = WS_XL;
constexpr size_t WS_YB = WS_R;
constexpr size_t WS_XS = WS_R, WS_HMID = WS_R + 74 * MiB, WS_YS = WS_R + 148 * MiB;
constexpr size_t WS_Q = WS_R, WS_KB = WS_R + 33 * MiB, WS_VB = WS_R + 42 * MiB, WS_AO = WS_R + 51 * MiB, WS_YB1 = WS_R + 84 * MiB, WS_S = WS_R + 117 * MiB;
constexpr size_t WS_TOKTAB = 472 * MiB;
constexpr size_t WS_MLG = 476 * MiB;
constexpr size_t WS_SSG = 479 * MiB;
constexpr size_t WS_END = 486 * MiB;

constexpr int CW_CNT0 = 64, CW_CNT1 = 128;
constexpr int CW_DEP0 = 256, CW_DEP1 = 512;
constexpr int CW_BAR = 1024;

__device__ __forceinline__ float bf2f(unsigned short v) { return __uint_as_float((unsigned)v << 16); }
typedef float f32x2_t __attribute__((ext_vector_type(2))); typedef __bf16 bf16x2_t __attribute__((ext_vector_type(2)));
__device__ __forceinline__ unsigned pk2(float lo, float hi) { f32x2_t v = {lo, hi}; bf16x2_t b = __builtin_convertvector(v, bf16x2_t); return __builtin_bit_cast(unsigned, b); }
__device__ __forceinline__ bf16_t f2bf(float f) { return (bf16_t)(pk2(f, 0.f) & 0xffffu); }
__device__ __forceinline__ float siluf(float x) { return x * __builtin_amdgcn_rcpf(1.f + __expf(-x)); }
__device__ __forceinline__ float sigmf(float x) { return __builtin_amdgcn_rcpf(1.f + __expf(-x)); }
__device__ __forceinline__ float softplusf(float x) { return x > 20.f ? x : log1pf(expf(x)); }
__device__ __forceinline__ float logsigf(float x) { return -softplusf(-x); }
__device__ __forceinline__ float wave_sum(float v) {
#pragma unroll
    for (int o = 1; o < 64; o <<= 1) v += __shfl_xor(v, o);
    return v;
}
__device__ __forceinline__ float wave_max(float v) {
#pragma unroll
    for (int o = 1; o < 64; o <<= 1) v = fmaxf(v, __shfl_xor(v, o));
    return v; }
__device__ __forceinline__ unsigned char* launder_ptr(unsigned char* p) { asm volatile("" : "+s"(p)); return p; }
__device__ __forceinline__ int fresh_lane() { int z = 0; asm volatile("" : "+s"(z)); return (int)__builtin_amdgcn_mbcnt_hi(~0u, __builtin_amdgcn_mbcnt_lo(~0u, (unsigned)z)); }
__device__ __forceinline__ int mod_index(int row) { return row < NLAT ? row / SEQ : 2; }
__device__ __forceinline__ int seq_row(int b, int dir, int i) {
    if (i < CTXL) { int t = dir ? (CTXL - 1 - i) : i; return NLAT + b * CTXL + t; }
    int t = i - CTXL; if (dir) t = SEQ - 1 - t; return b * SEQ + t;
}
__device__ __forceinline__ int chunk_row0(int b, int cid) { return cid < 2 ? NLAT + b * CTXL + cid * 128 : b * SEQ + (cid - 2) * 128; }
__device__ __forceinline__ int scan_cid(int dir, int p) { return dir == 0 ? p : (p < 2 ? 1 - p : 67 - p); }

struct RowF { f32x4 v[4]; };
__device__ __forceinline__ RowF row_ld_f32(const float* p, int lane) { RowF r; const f32x4* q = (const f32x4*)p + lane;
#pragma unroll
    for (int j = 0; j < 4; ++j) r.v[j] = q[64 * j];
    return r; }
__device__ __forceinline__ RowF row_ld_bf16(const bf16_t* p, int lane) { RowF r; const u32x2* q = (const u32x2*)p + lane;
#pragma unroll
    for (int j = 0; j < 4; ++j) { const u32x2 w = q[64 * j]; r.v[j] = (f32x4){__uint_as_float(w.x << 16), __uint_as_float(w.x & 0xffff0000u), __uint_as_float(w.y << 16), __uint_as_float(w.y & 0xffff0000u)}; }
    return r; }
struct RowRaw { u32x2 w[4]; };
__device__ __forceinline__ RowRaw row_ldraw_bf16(const bf16_t* p, int lane) { RowRaw r; const u32x2* q = (const u32x2*)p + lane;
#pragma unroll
    for (int j = 0; j < 4; ++j) r.w[j] = q[64 * j];
    return r; }
__device__ __forceinline__ RowF row_cvt(const RowRaw& t) { RowF r;
#pragma unroll
    for (int j = 0; j < 4; ++j) r.v[j] = (f32x4){__uint_as_float(t.w[j].x << 16), __uint_as_float(t.w[j].x & 0xffff0000u), __uint_as_float(t.w[j].y << 16), __uint_as_float(t.w[j].y & 0xffff0000u)};
    return r; }
__device__ __forceinline__ void row_st_f32(float* p, int lane, const RowF& r) { f32x4* q = (f32x4*)p + lane;
#pragma unroll
    for (int j = 0; j < 4; ++j) q[64 * j] = r.v[j]; }
__device__ __forceinline__ void row_st_bf16(bf16_t* p, int lane, const RowF& r) { u32x2* q = (u32x2*)p + lane;
#pragma unroll
    for (int j = 0; j < 4; ++j) { u32x2 w; w.x = pk2(r.v[j][0], r.v[j][1]); w.y = pk2(r.v[j][2], r.v[j][3]); q[64 * j] = w; } }
__device__ __forceinline__ float row_sum(const RowF& r) { float s = 0.f;
#pragma unroll
    for (int j = 0; j < 4; ++j) s += (r.v[j][0] + r.v[j][1]) + (r.v[j][2] + r.v[j][3]);
    return wave_sum(s); }
__device__ __forceinline__ void row_layernorm(RowF& r, const float* g, const float* b, int lane) {
    const float mu = row_sum(r) * (1.f / D); float q = 0.f;
#pragma unroll
    for (int j = 0; j < 4; ++j) { r.v[j] = r.v[j] - mu; q += (r.v[j][0] * r.v[j][0] + r.v[j][1] * r.v[j][1]) + (r.v[j][2] * r.v[j][2] + r.v[j][3] * r.v[j][3]); }
    const float rstd = rsqrtf(wave_sum(q) * (1.f / D) + 1e-5f);
    const RowF gg = row_ld_f32(g, lane), bb = row_ld_f32(b, lane);
#pragma unroll
    for (int j = 0; j < 4; ++j) r.v[j] = r.v[j] * rstd * gg.v[j] + bb.v[j];
}
__device__ __forceinline__ RowF row_modulate(const RowF& x, const float* sh, const float* sc, int lane) {
    const RowF s = row_ld_f32(sh, lane), c = row_ld_f32(sc, lane); RowF h;
#pragma unroll
    for (int j = 0; j < 4; ++j) h.v[j] = x.v[j] * (1.f + c.v[j]) + s.v[j];
    return h; }

template <class Dest> struct EpiStore {
    static constexpr bool PERM = true, AFTER_DRAIN = false, MIDK = false; Dest d;
    __device__ __forceinline__ void operator()(const f32x4 (&acc)[2][2][4][2], const pg8::Unit& u, int wr, int wc, int fr, int fq) const {
#pragma unroll
        for (int ai = 0; ai < 2; ++ai)
#pragma unroll
            for (int m = 0; m < 4; ++m) {
                const int row = u.pm * 256 + ai * 128 + wr * 64 + m * 16 + fr;
                bf16_t* rp = d.rowptr(row, u.pn); if (!rp) continue;
#pragma unroll
                for (int bj = 0; bj < 2; ++bj) { const f32x4 v0 = acc[ai][bj][m][0], v1 = acc[ai][bj][m][1];
                    u32x4 w; w.x = pk2(v0[0], v0[1]); w.y = pk2(v0[2], v0[3]); w.z = pk2(v1[0], v1[1]); w.w = pk2(v1[2], v1[3]);
                    *(u32x4*)(rp + bj * 128 + wc * 32 + 8 * fq) = w; }
            }
    }
};
struct DestWin { bf16_t* base;
    __device__ __forceinline__ bf16_t* rowptr(int row, int pn) const {
        if (pn < 16) { const int seg = pn >> 2; return base + (size_t)seg * (33 * MiB / 2) + (size_t)row * 1024 + (pn & 3) * 256; }
        return base + (size_t)4 * (33 * MiB / 2) + (size_t)row * 1536 + (pn - 16) * 256; } };
struct EpiWin {
    static constexpr bool PERM = true, AFTER_DRAIN = false, MIDK = false; EpiStore<DestWin> st; float* gates; const float* igb; const float* fgb; const float* dtb;
    __device__ __forceinline__ void operator()(const f32x4 (&acc)[2][2][4][2], const pg8::Unit& u, int wr, int wc, int fr, int fq) const {
        if (u.pn < 22) { st(acc, u, wr, wc, fr, fq); return; }
        const int c0 = wc * 32 + 8 * fq;
        if (c0 >= NGATE) return;
        float bias[8];
#pragma unroll
        for (int i = 0; i < 8; ++i) { const int c = c0 + i; bias[i] = c < 8 ? igb[c] : (c < 16 ? fgb[c - 8] : dtb[c - 16]); }
#pragma unroll
        for (int ai = 0; ai < 2; ++ai)
#pragma unroll
            for (int m = 0; m < 4; ++m) { const int row = u.pm * 256 + ai * 128 + wr * 64 + m * 16 + fr;
                float v[8];
#pragma unroll
                for (int i = 0; i < 8; ++i) { const float x = acc[ai][0][m][i >> 2][i & 3] + bias[i]; const int c = c0 + i; v[i] = c < 8 ? x : (c < 16 ? logsigf(x) : softplusf(x)); }
                float* gp = gates + (size_t)row * NGATE + c0;
                *(f32x4*)gp = (f32x4){v[0], v[1], v[2], v[3]}; *(f32x4*)(gp + 4) = (f32x4){v[4], v[5], v[6], v[7]}; }
    }
};
struct DestPlain { bf16_t* base; int ld; int pnmask;
    __device__ __forceinline__ bf16_t* rowptr(int row, int pn) const { return base + (size_t)row * ld + (pn & pnmask) * 256; } };
struct DestQKV { bf16_t* q; bf16_t* kb; bf16_t* vb;
    __device__ __forceinline__ bf16_t* rowptr(int row, int pn) const {
        if (pn < 4) return row < NLAT ? q + (size_t)row * 1024 + pn * 256 : nullptr;
        int key; if (row < NLAT) { const int b = row / SEQ, t = row % SEQ; key = b * SLEN + CTXL + t; } else { const int r = row - NLAT; key = (r / CTXL) * SLEN + (r % CTXL); }
        return (pn == 4 ? kb : vb) + (size_t)key * 256; } };
struct EpiWout {
    static constexpr bool PERM = true, AFTER_DRAIN = false, MIDK = true; EpiStore<DestPlain> st; const float* ssq;
    __device__ __forceinline__ void operator()(const f32x4 (&acc)[2][2][4][2], const pg8::Unit& u, int wr, int wc, int fr, int fq) const { st(acc, u, wr, wc, fr, fq); }
    __device__ __forceinline__ void midk(f32x4 (&acc)[2][2][4][2], const pg8::Unit& u, int wr, int wc, int fr, int fq) const {
        const float* p0 = ssq + (size_t)(u.pm * 256 + wr * 64 + fr) * 8; asm volatile("" : "+v"(p0));
#pragma unroll
        for (int ai = 0; ai < 2; ++ai)
#pragma unroll
            for (int m = 0; m < 4; ++m) { const float* p = p0 + (ai * 128 + m * 16) * 8;
                const f32x4 s0 = *(const f32x4*)p, s1 = *(const f32x4*)(p + 4);
                const float r = rsqrtf((((s0[0] + s0[1]) + (s0[2] + s0[3])) + ((s1[0] + s1[1]) + (s1[2] + s1[3]))) * (1.f / 1024.f) + 1e-6f);
#pragma unroll
                for (int bj = 0; bj < 2; ++bj)
#pragma unroll
                    for (int n = 0; n < 2; ++n) acc[ai][bj][m][n] = acc[ai][bj][m][n] * r;
                __builtin_amdgcn_sched_barrier(0); }
    }
};
template <bool WT = false> struct EpiSwigluT {
    static constexpr bool PERM = true, AFTER_DRAIN = false, MIDK = false; bf16_t* out;
    __device__ __forceinline__ void operator()(const f32x4 (&acc)[2][2][4][2], const pg8::Unit& u, int wr, int wc, int fr, int fq) const {
        const int pnl = u.pn & 7;
#pragma unroll
        for (int ai = 0; ai < 2; ++ai)
#pragma unroll
            for (int m = 0; m < 4; ++m) {
                const int row = u.pm * 256 + ai * 128 + wr * 64 + m * 16 + fr;
                bf16_t* rp = out + (size_t)row * 1024 + pnl * 128 + wc * 16 + 4 * fq;
#pragma unroll
                for (int bj = 0; bj < 2; ++bj) { const f32x4 g = acc[ai][bj][m][0], up = acc[ai][bj][m][1];
                    u32x2 w; w.x = pk2(siluf(g[0]) * up[0], siluf(g[1]) * up[1]); w.y = pk2(siluf(g[2]) * up[2], siluf(g[3]) * up[3]);
                    if constexpr (WT) __hip_atomic_store((__attribute__((address_space(1))) unsigned long long*)(rp + bj * 64), (unsigned long long)w.x | ((unsigned long long)w.y << 32), __ATOMIC_RELAXED, __HIP_MEMORY_SCOPE_AGENT);
                    else *(u32x2*)(rp + bj * 64) = w; }
            }
    }
};
using EpiSwiglu = EpiSwigluT<false>;
struct MoeOrder {
    int ntm, npn, nwg, G, c; const LAS int* toff; const int* tab;
    __device__ __forceinline__ void init(const LAS int* toff_, int npn_, int G_, int c_) { toff = toff_; ntm = toff_[16]; npn = npn_; nwg = ntm * npn_; G = G_; c = c_; }
    __device__ __forceinline__ bool next(int i, pg8::Unit& u) const {
        const long L = (long)i * G + c; if (L >= nwg) return false;
        int wgid = (int)L; { const int q = nwg / 8, r = nwg % 8, xcd = wgid % 8, off = wgid / 8; wgid = (xcd < r ? xcd * (q + 1) : r * (q + 1) + (xcd - r) * q) + off; }
        const int pm = wgid / npn, pnl = wgid % npn; int e = 0;
#pragma unroll
        for (int k = 1; k < 16; ++k) e += (toff[k] <= pm) ? 1 : 0;
        u.pm = pm; u.pn = e * npn + pnl; return true;
    }
    __device__ __forceinline__ int arow(const pg8::Unit& u, int r) const { const int e = u.pn / npn, pos = (u.pm - toff[e]) * 256 + r; return pos < toff[100 + e] ? tab[(size_t)e * NTOK + pos] : 0; }
    static constexpr bool LATE = false;
    __device__ __forceinline__ void a_ready(const pg8::Unit&) const {}
    __device__ __forceinline__ void done(const pg8::Unit&) const {}
    __device__ __forceinline__ void late(const pg8::Unit&) const {}
};

struct MoeMerged {
    static constexpr bool LATE = true;
    int m0, nm, nloc, rank, n1c, crot; const LAS int* toff; const int* tab; unsigned* dep;
    __device__ __forceinline__ void init(const LAS int* toff_, const int* tab_, unsigned* dep_) {
        toff = toff_; tab = tab_; dep = dep_; m0 = toff_[120]; nm = toff_[121]; nloc = toff_[122]; rank = toff_[123];
        const int n1 = nm * 8; n1c = rank < n1 ? (n1 - rank + nloc - 1) / nloc : 0; const int rot = n1 % nloc; crot = (rank - rot + nloc) % nloc; }
    __device__ __forceinline__ bool next(int i, pg8::Unit& u) const {
        int pm, pnl, npn, base;
        if (i < n1c) { const int t1 = i * nloc + rank; pm = m0 + (t1 >> 3); pnl = t1 & 7; npn = 8; base = 0; }
        else { const int t2 = (i - n1c) * nloc + crot; if (t2 >= nm * 4) return false; pm = m0 + (t2 >> 2); pnl = t2 & 3; npn = 4; base = 128; }
        int e = 0;
#pragma unroll
        for (int k = 1; k < 16; ++k) e += (toff[k] <= pm) ? 1 : 0;
        u.pm = pm; u.pn = base + e * npn + pnl; return true;
    }
    __device__ __forceinline__ int arow(const pg8::Unit& u, int r) const {
        if (u.pn >= 128) return (int)((WS_HMID - WS_HB) / 2048) + u.pm * 256 + r;
        const int e = u.pn >> 3, pos = (u.pm - toff[e]) * 256 + r; return pos < toff[100 + e] ? tab[(size_t)e * NTOK + pos] : 0; }
    __device__ __forceinline__ void a_ready(const pg8::Unit& u) const {
        if (u.pn >= 128) { unsigned* w = dep + u.pm; unsigned sp = 0;
            while ((unsigned)__builtin_amdgcn_readfirstlane(__hip_atomic_load(w, __ATOMIC_RELAXED, __HIP_MEMORY_SCOPE_AGENT)) < 64u) { __builtin_amdgcn_s_sleep(1); if (++sp > (1u << 22)) break; }
            asm volatile("" ::: "memory"); }
    }
    __device__ __forceinline__ void done(const pg8::Unit&) const {}
    __device__ __forceinline__ void late(const pg8::Unit& u) const {
        if (u.pn < 128) { asm volatile("s_waitcnt vmcnt(0)" ::: "memory"); if (fresh_lane() == 0) (void)__hip_atomic_fetch_add(dep + u.pm, 1u, __ATOMIC_RELAXED, __HIP_MEMORY_SCOPE_AGENT); }
    }
};
struct EpiMoe {
    static constexpr bool PERM = true, AFTER_DRAIN = false, MIDK = false; EpiSwigluT<false> sw; EpiStore<DestPlain> st;
    __device__ __forceinline__ void operator()(const f32x4 (&acc)[2][2][4][2], const pg8::Unit& u, int wr, int wc, int fr, int fq) const {
        if (u.pn < 128) sw(acc, u, wr, wc, fr, fq); else st(acc, u, wr, wc, fr, fq); }
};

#define XB_TMO      128
#define XB_XCNT(j)  (256  + 64 * (j))
#define XB_XSUB(j)  (1280 + 64 * (j))
#define XB_XGEN(j)  (2304 + 64 * (j))
#define XB_TOP      3328
#define XB_TOPGEN   3392
#define XCD_BAR_WORDS 3456
#define XB_SPIN_CAP (1u << 18)

__device__ __forceinline__ unsigned xb_ld(unsigned* p)              { return __hip_atomic_load(p, __ATOMIC_RELAXED, __HIP_MEMORY_SCOPE_AGENT); }
__device__ __forceinline__ unsigned xb_add(unsigned* p, unsigned v) { return __hip_atomic_fetch_add(p, v, __ATOMIC_RELAXED, __HIP_MEMORY_SCOPE_AGENT); }
__device__ __forceinline__ unsigned xb_xcc_id() { return (unsigned)__builtin_amdgcn_s_getreg((3 << 11) | 20) & 0xFu; }
#define XB_SPIN(cond, bar) do { unsigned _sp = 0; while (cond) { __builtin_amdgcn_s_sleep(1); \
    if ((++_sp & 255u) == 0u) { if (xb_ld(&(bar)[XB_TMO])) break; if (_sp > XB_SPIN_CAP) { atomicAdd(&(bar)[XB_TMO], 1u); break; } } } } while (0)

struct XcdBarrier {
    unsigned* bar; unsigned x;
    volatile LAS unsigned* st;
};

__device__ __forceinline__ XcdBarrier xcd_barrier_post(unsigned* bar, volatile LAS unsigned* st, int tid) {
    XcdBarrier b; b.bar = bar; b.x = xb_xcc_id(); b.st = st;
    if (tid == 0) { st[2] = xb_add(&bar[XB_XCNT(b.x)], 1u); st[3] = b.x; }
    return b;
}
__device__ __forceinline__ void xcd_barrier_complete(unsigned* bar, unsigned x, unsigned& nloc, unsigned& nx) {
    const unsigned G = gridDim.x * gridDim.y * gridDim.z;
    unsigned sum, cnt, mine, sp = 0u;
    for (;;) {
        sum = 0u; cnt = 0u; mine = 0u;
#pragma unroll
        for (unsigned j = 0; j < 16; ++j) { const unsigned c = xb_ld(&bar[XB_XCNT(j)]); sum += c; cnt += (c > 0u) ? 1u : 0u; mine = (j == x) ? c : mine; }
        if (sum == G) break;
        __builtin_amdgcn_s_sleep(1);
        if ((++sp & 255u) == 0u) { if (xb_ld(&bar[XB_TMO])) break; if (sp > XB_SPIN_CAP) { atomicAdd(&bar[XB_TMO], 1u); break; } }
    }
    nloc = mine > 0u ? mine : 1u; nx = cnt > 0u ? cnt : 1u;
}

__device__ __forceinline__ void xcd_barrier(const XcdBarrier& b, int tid) {
    asm volatile("s_waitcnt vmcnt(0)" ::: "memory");
    __syncthreads();
    if (tid == 0) {
        unsigned* bar = b.bar;
        __builtin_amdgcn_s_waitcnt(0);
        unsigned nloc = b.st[0], nx = b.st[1];
        if (nloc == 0u) { xcd_barrier_complete(bar, b.x, nloc, nx); b.st[0] = nloc; b.st[1] = nx; }
        const unsigned old = xb_add(&bar[XB_XSUB(b.x)], 1u);
        const unsigned gen = old / nloc;
        if (old + 1u == (gen + 1u) * nloc) {
            __builtin_amdgcn_fence(__ATOMIC_RELEASE, "agent");
            asm volatile("s_waitcnt vmcnt(0)" ::: "memory");
            const unsigned og = xb_add(&bar[XB_TOP], 1u);
            const unsigned tg = og / nx;
            if (og + 1u == (tg + 1u) * nx) xb_add(&bar[XB_TOPGEN], 1u);
            else XB_SPIN(xb_ld(&bar[XB_TOPGEN]) == tg, bar);
            __builtin_amdgcn_fence(__ATOMIC_ACQUIRE, "agent");
            xb_add(&bar[XB_XGEN(b.x)], 1u);
            asm volatile("s_waitcnt vmcnt(0)" ::: "memory");
        } else {
            XB_SPIN(xb_ld(&bar[XB_XGEN(b.x)]) == gen, bar);
            __builtin_amdgcn_fence(__ATOMIC_ACQUIRE, "agent");
            asm volatile("s_waitcnt vmcnt(0)" ::: "memory");
        }
    }
    __syncthreads();
}

struct Args {
    const float* in[28]; float* out; unsigned char* ws; int ph_lo, ph_hi, li, pad;
};
struct Ctx {
    LAS unsigned char* lds; unsigned char* ws;
    int tid, lane, wave, G, bid;
};
#define CTLP(F) ((unsigned*)((F).ws + WS_CTL))
#define MISCP(F) ((LAS int*)((F).lds + MISC_OFF))
#define GWID(F) ((F).bid * NWAVES + (F).wave)
#define NGW(F) ((F).G * NWAVES)
enum { I_X = 0, I_C, I_CTX, I_CCTX, I_ADAW, I_ADAB, I_LNG, I_LNB, I_ABWIN, I_ABWOUT, I_IGB, I_FGB, I_MNG, I_CONVW, I_CONVB, I_DTB, I_ALOG, I_SSMD, I_SNG,
       I_ATWIN, I_ATWOUT, I_QG, I_KG, I_RW, I_RB, I_WG, I_WU, I_WD };
constexpr int RING_BYTES = 131072, MISC_OFF = RING_BYTES, LDS_BYTES = RING_BYTES + 12288;

template <class Src> __device__ __forceinline__ void transpose_item(const Src& S, bf16_t* WT, int K, int orow0, int k0, LAS float* scr, int lane, float scale) {
#pragma unroll 8
    for (int i = 0; i < 32; ++i) { const int kk = 2 * i + (lane >> 5); scr[kk * 33 + (lane & 31)] = S.ld(k0 + kk, lane & 31); }
    asm volatile("s_waitcnt lgkmcnt(0)" ::: "memory");
    const int c = lane & 7;
#pragma unroll
    for (int j = 0; j < 4; ++j) { const int n = (lane >> 3) + 8 * j; const LAS float* s = scr + (8 * c) * 33 + S.scol(n);
        u32x4 o; o.x = pk2(s[0 * 33] * scale, s[1 * 33] * scale); o.y = pk2(s[2 * 33] * scale, s[3 * 33] * scale); o.z = pk2(s[4 * 33] * scale, s[5 * 33] * scale); o.w = pk2(s[6 * 33] * scale, s[7 * 33] * scale);
        *(u32x4*)(WT + (size_t)(orow0 + n) * K + k0 + 8 * c) = o; }
    asm volatile("s_waitcnt lgkmcnt(0)" ::: "memory");
}
struct SrcPlain { const float* W; int N; int n0;
    __device__ __forceinline__ float ld(int k, int j) const { return __builtin_nontemporal_load(W + (size_t)k * N + n0 + j); }
    __device__ __forceinline__ int scol(int n) const { return n; } };
struct SrcGate { const float* W; int j0;
    __device__ __forceinline__ float ld(int k, int j) const { const int jj = j0 + j; return jj < 16 ? W[(size_t)k * ABIN + 3072 + jj] : (jj < NGATE ? W[(size_t)k * ABIN + 5648 + (jj - 16)] : 0.f); }
    __device__ __forceinline__ int scol(int n) const { return n; } };
struct SrcWout { const float* W; const float* g; int n0;
    __device__ __forceinline__ float ld(int k, int j) const { return k < 1024 ? W[(size_t)(k + 1024) * 1024 + n0 + j] * g[k] : W[(size_t)(k - 1024) * 1024 + n0 + j]; }
    __device__ __forceinline__ int scol(int n) const { return n; } };
struct SrcGU { const float* Wg; const float* Wu; int c0;
    __device__ __forceinline__ float ld(int k, int j) const { return __builtin_nontemporal_load((j < 16 ? Wg : Wu) + (size_t)k * 1024 + c0 + (j & 15)); }
    __device__ __forceinline__ int scol(int n) const { const int b4 = n >> 3, w = n & 7; return (w < 4 ? 0 : 16) + 4 * b4 + (w & 3); } };

__device__ __forceinline__ void convert_small_weights(Ctx& F, const Args& a) {
    {   float* rope = (float*)(F.ws + WS_ROPE);
        for (int i = F.bid * NTHREADS + F.tid; i < 128 * 32; i += F.G * NTHREADS) { const int pos = i >> 5, fi = i & 31; float sn, cs; sincosf((float)pos * expf(-(float)fi * (9.210340371976184f / 32.f)), &sn, &cs); rope[2 * i] = cs; rope[2 * i + 1] = sn; } }
    LAS float* scr = (LAS float*)(F.lds + F.wave * 16384);
    bf16_t* WinT = (bf16_t*)(F.ws + WS_WIN); bf16_t* WoutT = (bf16_t*)(F.ws + WS_WOUT); bf16_t* AtInT = (bf16_t*)(F.ws + WS_ATIN); bf16_t* AtOutT = (bf16_t*)(F.ws + WS_ATOUT);
    constexpr int I0 = 16 * (NWIN / 32), I1 = 32 * 32, I2 = 16 * 48, I3 = 16 * 32, NI = I0 + I1 + I2 + I3;
    for (int it = GWID(F); it < NI; it += NGW(F)) {
        int r = it;
        if (r < I0) { const int kb = r / (NWIN / 32), nb = r % (NWIN / 32), n0 = 32 * nb;
            if (n0 < 5632) { SrcPlain S{a.in[I_ABWIN], ABIN, n0 < 3072 ? n0 : n0 + 16}; transpose_item(S, WinT, 1024, n0, 64 * kb, scr, F.lane, n0 < 512 ? 0.08838834764831845f : 1.f); }
            else { SrcGate S{a.in[I_ABWIN], n0 - 5632}; transpose_item(S, WinT, 1024, n0, 64 * kb, scr, F.lane, 1.f); }
            continue; } r -= I0;
        if (r < I1) { const int kb = r / 32, nb = r % 32; SrcWout S{a.in[I_ABWOUT], a.in[I_SNG], 32 * nb}; transpose_item(S, WoutT, 2048, 32 * nb, 64 * kb, scr, F.lane, 1.f); continue; } r -= I1;
        if (r < I2) { const int kb = r / 48, nb = r % 48; SrcPlain S{a.in[I_ATWIN], 1536, 32 * nb}; transpose_item(S, AtInT, 1024, 32 * nb, 64 * kb, scr, F.lane, 1.f); continue; } r -= I2;
        { const int kb = r / 32, nb = r % 32; SrcPlain S{a.in[I_ATWOUT], 1024, 32 * nb}; transpose_item(S, AtOutT, 1024, 32 * nb, 64 * kb, scr, F.lane, 1.f); }
    }
}
__device__ __forceinline__ void convert_moe_weights(Ctx& F, const Args& a, int layer, int skip_blocks, int it0 = 0, int it1 = 16 * 16 * 64 + 16 * 16 * 32) {
    if (F.bid < skip_blocks) return;
    LAS float* scr = (LAS float*)(F.lds + F.wave * 16384);
    bf16_t* WGU = (bf16_t*)(F.ws + WS_MOEW); bf16_t* WD = (bf16_t*)(F.ws + WS_MOEW + 64 * MiB);
    const size_t wl = (size_t)layer * 16 * 1024 * 1024;
    constexpr int IGU = 16 * 16 * 64, IDN = 16 * 16 * 32;
    for (int it = it0 + (F.bid - skip_blocks) * NWAVES + F.wave; it < it1; it += (F.G - skip_blocks) * NWAVES) {
        if (it < IGU) { const int e = it / 1024, r = it % 1024, kb = r / 64, nb = r % 64;
            SrcGU S{a.in[I_WG] + wl + (size_t)e * 1048576, a.in[I_WU] + wl + (size_t)e * 1048576, 16 * nb};
            transpose_item(S, WGU + (size_t)e * 2048 * 1024, 1024, 32 * nb, 64 * kb, scr, F.lane, 1.f); }
        else { const int r0 = it - IGU, e = r0 / 512, r = r0 % 512, kb = r / 32, nb = r % 32;
            SrcPlain S{a.in[I_WD] + wl + (size_t)e * 1048576, 1024, 32 * nb};
            transpose_item(S, WD + (size_t)e * 1024 * 1024, 1024, 32 * nb, 64 * kb, scr, F.lane, 1.f); }
    }
}
__device__ __forceinline__ void ada_phase(Ctx& F, const Args& a) {
    LAS float* red = (LAS float*)(F.lds + 8 * 16384);
    float* modv = (float*)(F.ws + WS_MODV);
    for (int item = F.bid; item < 2 * 96; item += F.G) {
        const int l = item / 96, n = (item % 96) * 64 + F.lane;
        float a0 = 0.f, a1 = 0.f, a2 = 0.f;
        const float* w = a.in[I_ADAW] + ((size_t)l * 1024 + F.wave * 128) * 6144 + n;
#pragma unroll 16
        for (int k = 0; k < 128; ++k) { const float wv = w[(size_t)k * 6144]; const int kk = F.wave * 128 + k;
            a0 += siluf(a.in[I_C][kk]) * wv; a1 += siluf(a.in[I_C][1024 + kk]) * wv; a2 += siluf(a.in[I_CCTX][kk]) * wv; }
        LAS float* rr = (LAS float*)F.lds;
        rr[(F.wave * 3 + 0) * 64 + F.lane] = a0; rr[(F.wave * 3 + 1) * 64 + F.lane] = a1; rr[(F.wave * 3 + 2) * 64 + F.lane] = a2;
        __syncthreads();
        if (F.wave < 3) { float s = 0.f;
#pragma unroll
            for (int w8 = 0; w8 < 8; ++w8) s += rr[(w8 * 3 + F.wave) * 64 + F.lane];
            modv[(l * 3 + F.wave) * 6144 + n] = s + a.in[I_ADAB][l * 6144 + n]; }
        __syncthreads();
    }
    (void)red;
}

template <int NC> __device__ __forceinline__ void row_dots(const RowF& h, const float* W, int lane, float (&acc)[NC]) {
#pragma unroll
    for (int i = 0; i < NC; ++i) acc[i] = 0.f;
#pragma unroll
    for (int j = 0; j < 4; ++j)
#pragma unroll
        for (int e = 0; e < 4; ++e) { const float x = h.v[j][e]; const f32x4* w = (const f32x4*)(W + (size_t)(4 * lane + 256 * j + e) * NC);
#pragma unroll
            for (int q = 0; q < NC / 4; ++q) { const f32x4 wv = w[q]; acc[4 * q + 0] += x * wv[0]; acc[4 * q + 1] += x * wv[1]; acc[4 * q + 2] += x * wv[2]; acc[4 * q + 3] += x * wv[3]; } }
}
template <int O, int N> __device__ __forceinline__ void xreduce_step(float (&acc)[N], int lane) {
    const bool up = (lane & O) != 0;
#pragma unroll
    for (int i = 0; i < O; ++i) { const float keep = up ? acc[i + O] : acc[i], send = up ? acc[i] : acc[i + O]; acc[i] = keep + __shfl_xor(send, O); }
}
template <int N> __device__ __forceinline__ float xreduce(float (&acc)[N], int lane) {
    if constexpr (N == 16) {
#pragma unroll
        for (int i = 0; i < 16; ++i) { acc[i] += __shfl_xor(acc[i], 32); acc[i] += __shfl_xor(acc[i], 16); }
    }
    if constexpr (N == 64) { xreduce_step<32, N>(acc, lane); xreduce_step<16, N>(acc, lane); }
    xreduce_step<8, N>(acc, lane); xreduce_step<4, N>(acc, lane); xreduce_step<2, N>(acc, lane); xreduce_step<1, N>(acc, lane);
    return acc[0];
}

__device__ __forceinline__ const float* x_row(const Args& a, int row) { return row < NLAT ? a.in[I_X] + (size_t)row * D : a.in[I_CTX] + (size_t)(row - NLAT) * D; }
__device__ __forceinline__ void rowpass_a(Ctx& F, const Args& a) {
    const float* modv = (const float*)(F.ws + WS_MODV);
    bf16_t* HB = (bf16_t*)(F.ws + WS_HB);
    int row = GWID(F); if (row >= NTOK) return;
    RowF xn = row_ld_f32(x_row(a, row), F.lane);
    for (; row < NTOK; row += NGW(F)) {
        const RowF x = xn; const int nrow = row + NGW(F);
        if (nrow < NTOK) xn = row_ld_f32(x_row(a, nrow), F.lane);
        const float* m = modv + mod_index(row) * 6144;
        const RowF h = row_modulate(x, m, m + 1024, F.lane);
        row_st_bf16(HB + (size_t)row * D, F.lane, h);
    }
}
__device__ __forceinline__ void stage_router(Ctx& F, const float* rw) {
    LAS f32x4* Wl = (LAS f32x4*)F.lds;
    for (int i = F.tid; i < 4096; i += NTHREADS) { const int d = i >> 2, q = i & 3; const f32x4 w = *(const f32x4*)(rw + d * 16 + q * 4);
        Wl[q * 1024 + ((d >> 8) * 4 + (d & 3)) * 64 + ((d >> 2) & 63)] = w; }
    __syncthreads();
}
__device__ __forceinline__ void row_dots16_lds(const RowF& h, const LAS f32x4* Wl, int lane, float (&acc)[16]) {
#pragma unroll
    for (int i = 0; i < 16; ++i) acc[i] = 0.f;
#pragma unroll
    for (int j = 0; j < 4; ++j)
#pragma unroll
        for (int e = 0; e < 4; ++e) { const float x = h.v[j][e];
#pragma unroll
            for (int q = 0; q < 4; ++q) { const f32x4 wv = Wl[q * 1024 + (j * 4 + e) * 64 + lane]; acc[4 * q + 0] += x * wv[0]; acc[4 * q + 1] += x * wv[1]; acc[4 * q + 2] += x * wv[2]; acc[4 * q + 3] += x * wv[3]; }
            if (e & 1) __builtin_amdgcn_sched_barrier(0); }
}
__device__ __forceinline__ void route_row(const RowF& h2, const LAS f32x4* Wl, const float* rb, int lane, int& e0, int& e1, float& g0, float& g1) {
    float acc[16]; row_dots16_lds(h2, Wl, lane, acc);
    const float logit = xreduce<16>(acc, lane);
    float mx = logit;
#pragma unroll
    for (int o = 8; o >= 1; o >>= 1) mx = fmaxf(mx, __shfl_xor(mx, o));
    const float ex = expf(logit - mx); float sm = ex;
#pragma unroll
    for (int o = 8; o >= 1; o >>= 1) sm += __shfl_xor(sm, o);
    const float p = ex / sm, sel = p + rb[lane & 15];
    float s4[4], p4[4];
#pragma unroll
    for (int i = 0; i < 4; ++i) s4[i] = __shfl(sel, (lane & 12) + i);
    float v1 = s4[0]; int i1 = 0;
#pragma unroll
    for (int i = 1; i < 4; ++i) if (s4[i] > v1) { v1 = s4[i]; i1 = i; }
    float v2 = -1e30f;
#pragma unroll
    for (int i = 0; i < 4; ++i) if (i != i1 && s4[i] > v2) v2 = s4[i];
    const float gs = v1 + v2;
    float best = __shfl(gs, 0); int bg = 0;
#pragma unroll
    for (int g = 1; g < 4; ++g) { const float t = __shfl(gs, 4 * g); if (t > best) { best = t; bg = g; } }
#pragma unroll
    for (int i = 0; i < 4; ++i) { s4[i] = __shfl(sel, 4 * bg + i); p4[i] = __shfl(p, 4 * bg + i); }
    v1 = s4[0]; i1 = 0; float q1 = p4[0];
#pragma unroll
    for (int i = 1; i < 4; ++i) if (s4[i] > v1) { v1 = s4[i]; i1 = i; q1 = p4[i]; }
    v2 = -1e30f; int i2 = 0; float q2 = 0.f;
#pragma unroll
    for (int i = 0; i < 4; ++i) if (i != i1 && s4[i] > v2) { v2 = s4[i]; i2 = i; q2 = p4[i]; }
    e0 = 4 * bg + i1; e1 = 4 * bg + i2; const float s = q1 + q2; g0 = q1 / s; g1 = q2 / s;
}
__device__ __forceinline__ void rowpass_b(Ctx& F, const Args& a, int layer, int nrows, const bf16_t* YB) {
    const float* modl = (const float*)(F.ws + WS_MODV) + layer * 3 * 6144;
    bf16_t* XL = (bf16_t*)(F.ws + WS_XL); bf16_t* HB = (bf16_t*)(F.ws + WS_HB);
    int* tok_e = (int*)(F.ws + WS_ROUTE); int* tok_pos = tok_e + 2 * NTOK; float* tok_g = (float*)(tok_pos + 2 * NTOK);
    unsigned* cnt = CTLP(F) + (layer ? CW_CNT1 : CW_CNT0);
    stage_router(F, a.in[I_RW]);
    LAS int* lcnt = (LAS int*)(F.lds + 65536); LAS int* gbase = lcnt + 16; LAS int* nrow = lcnt + 32; LAS int* lrow = lcnt + 64;
    if (F.tid < 33) lcnt[F.tid] = 0;
    __syncthreads();
    RowF xf_n; RowRaw xr_n, y_n;
    { const int r0 = GWID(F); if (r0 < nrows) { if (layer) xr_n = row_ldraw_bf16(XL + (size_t)r0 * D, F.lane); else xf_n = row_ld_f32(x_row(a, r0), F.lane); y_n = row_ldraw_bf16(YB + (size_t)r0 * D, F.lane); } }
    for (int row = GWID(F); row < nrows; row += NGW(F)) {
        const float* m = modl + mod_index(row) * 6144;
        RowF x = layer ? row_cvt(xr_n) : xf_n; const RowF y = row_cvt(y_n); const int nxr = row + NGW(F);
        if (nxr < nrows) { if (layer) xr_n = row_ldraw_bf16(XL + (size_t)nxr * D, F.lane); else xf_n = row_ld_f32(x_row(a, nxr), F.lane); y_n = row_ldraw_bf16(YB + (size_t)nxr * D, F.lane); }
        const RowF gt = row_ld_f32(m + 2048, F.lane);
#pragma unroll
        for (int j = 0; j < 4; ++j) x.v[j] = ALPHA * x.v[j] + gt.v[j] * y.v[j];
        row_layernorm(x, a.in[I_LNG] + (layer * 2) * D, a.in[I_LNB] + (layer * 2) * D, F.lane);
        row_st_bf16(XL + (size_t)row * D, F.lane, x);
        const RowF h2 = row_modulate(x, m + 3072, m + 4096, F.lane);
        row_st_bf16(HB + (size_t)row * D, F.lane, h2);
        int e0, e1; float g0, g1; route_row(h2, (const LAS f32x4*)F.lds, a.in[I_RB], F.lane, e0, e1, g0, g1);
        if (F.lane == 0) {
            const int p0 = __hip_atomic_fetch_add(lcnt + e0, 1, __ATOMIC_RELAXED, __HIP_MEMORY_SCOPE_WORKGROUP), p1 = __hip_atomic_fetch_add(lcnt + e1, 1, __ATOMIC_RELAXED, __HIP_MEMORY_SCOPE_WORKGROUP);
            const int ix = __hip_atomic_fetch_add(nrow, 1, __ATOMIC_RELAXED, __HIP_MEMORY_SCOPE_WORKGROUP);
            lrow[ix * 4 + 0] = row; lrow[ix * 4 + 1] = e0 | (e1 << 8); lrow[ix * 4 + 2] = p0; lrow[ix * 4 + 3] = p1;
            tok_e[row * 2] = e0; tok_e[row * 2 + 1] = e1; tok_g[row * 2] = g0; tok_g[row * 2 + 1] = g1;
        }
    }
    __syncthreads();
    if (F.tid < 16) gbase[F.tid] = (int)atomicAdd(cnt + F.tid, (unsigned)lcnt[F.tid]);
    __syncthreads();
    if (F.tid < nrow[0]) { const int row = lrow[F.tid * 4], ee = lrow[F.tid * 4 + 1];
        const int e0 = ee & 255, e1 = ee >> 8, p0 = gbase[e0] + lrow[F.tid * 4 + 2], p1 = gbase[e1] + lrow[F.tid * 4 + 3];
        tok_pos[row * 2] = p0; tok_pos[row * 2 + 1] = p1; int* tab = (int*)(F.ws + WS_TOKTAB); tab[(size_t)e0 * NTOK + p0] = row; tab[(size_t)e1 * NTOK + p1] = row; }
}
__device__ __forceinline__ void moe_offsets(Ctx& F, int layer) {
    __syncthreads();
    if (F.tid == 0) { const unsigned* cnt = CTLP(F) + (layer ? CW_CNT1 : CW_CNT0); int acc = 0;
        for (int e = 0; e < 16; ++e) { const int c = (int)__hip_atomic_load(cnt + e, __ATOMIC_RELAXED, __HIP_MEMORY_SCOPE_AGENT); MISCP(F)[e] = acc; MISCP(F)[100 + e] = c; acc += (c + 255) >> 8; }
        MISCP(F)[16] = acc; }
    __syncthreads();
}
__device__ __forceinline__ void moe_streams(Ctx& F, int layer, int li) {
    moe_offsets(F, layer);
    if (F.tid == 0) { const unsigned* bar = CTLP(F) + CW_BAR + li * 4096; const int x = MISCP(F)[35]; int tot = 0, before = 0, mine = 1;
        for (int j = 0; j < 16; ++j) { const int c = (int)__hip_atomic_load(bar + XB_XCNT(j), __ATOMIC_RELAXED, __HIP_MEMORY_SCOPE_AGENT); tot += c; before += (j < x) ? c : 0; mine = (j == x) ? c : mine; }
        const int ntm = MISCP(F)[16]; const int m0 = (int)((long)ntm * before / tot), m1 = (int)((long)ntm * (before + mine) / tot);
        MISCP(F)[120] = m0; MISCP(F)[121] = m1 - m0; MISCP(F)[122] = mine; MISCP(F)[123] = MISCP(F)[34]; }
    __syncthreads();
}
__device__ __forceinline__ void moe_scatter(Ctx& F, int layer, int nrows) {
    moe_offsets(F, layer);
    const bf16_t* HB = (const bf16_t*)(F.ws + WS_HB); bf16_t* XS = (bf16_t*)(F.ws + WS_XS);
    const int* tok_e = (const int*)(F.ws + WS_ROUTE); const int* tok_pos = tok_e + 2 * NTOK; int* tok_slot = (int*)(F.ws + WS_ROUTE + MiB);
    for (int row = GWID(F); row < nrows; row += NGW(F)) {
        const int e0 = tok_e[row * 2], e1 = tok_e[row * 2 + 1];
        const int s0 = MISCP(F)[e0] * 256 + tok_pos[row * 2], s1 = MISCP(F)[e1] * 256 + tok_pos[row * 2 + 1];
        const u32x4* src = (const u32x4*)(HB + (size_t)row * D) + F.lane; const u32x4 v0 = src[0], v1 = src[64];
        u32x4* d0 = (u32x4*)(XS + (size_t)s0 * D) + F.lane; u32x4* d1 = (u32x4*)(XS + (size_t)s1 * D) + F.lane;
        d0[0] = v0; d0[64] = v1; d1[0] = v0; d1[64] = v1;
        if (F.lane == 0) { tok_slot[row * 2] = s0; tok_slot[row * 2 + 1] = s1; }
    }
}
__device__ __forceinline__ void rowpass_c(Ctx& F, const Args& a, int layer, int nrows, bool last) {
    const float* modl = (const float*)(F.ws + WS_MODV) + layer * 3 * 6144;
    bf16_t* XL = (bf16_t*)(F.ws + WS_XL); bf16_t* HB = (bf16_t*)(F.ws + WS_HB); const bf16_t* YS = (const bf16_t*)(F.ws + WS_YS);
    const int* tok_e = (const int*)(F.ws + WS_ROUTE); const int* tok_pos = tok_e + 2 * NTOK; const float* tok_g = (const float*)(F.ws + WS_ROUTE) + 4 * NTOK;
    moe_offsets(F, layer);
    const int step = NGW(F); int row = GWID(F);
    int s0n = 0, s1n = 0, s0nn = 0, s1nn = 0; float g0n = 0.f, g1n = 0.f, g0nn = 0.f, g1nn = 0.f; RowRaw xr_n, y0_n, y1_n;
#define RC_SLOTS(r_, s0_, s1_, g0_, g1_) do { s0_ = MISCP(F)[tok_e[(r_) * 2]] * 256 + tok_pos[(r_) * 2]; s1_ = MISCP(F)[tok_e[(r_) * 2 + 1]] * 256 + tok_pos[(r_) * 2 + 1]; g0_ = tok_g[(r_) * 2]; g1_ = tok_g[(r_) * 2 + 1]; } while (0)
    if (row < nrows) { RC_SLOTS(row, s0n, s1n, g0n, g1n); xr_n = row_ldraw_bf16(XL + (size_t)row * D, F.lane); y0_n = row_ldraw_bf16(YS + (size_t)s0n * D, F.lane); y1_n = row_ldraw_bf16(YS + (size_t)s1n * D, F.lane);
        if (row + step < nrows) RC_SLOTS(row + step, s0nn, s1nn, g0nn, g1nn); }
    for (; row < nrows; row += step) {
        const float* m = modl + mod_index(row) * 6144;
        RowF x = row_cvt(xr_n); const RowF y0 = row_cvt(y0_n), y1 = row_cvt(y1_n); const float g0 = g0n, g1 = g1n;
        if (row + step < nrows) { const int nr = row + step; s0n = s0nn; s1n = s1nn; g0n = g0nn; g1n = g1nn;
            xr_n = row_ldraw_bf16(XL + (size_t)nr * D, F.lane); y0_n = row_ldraw_bf16(YS + (size_t)s0n * D, F.lane); y1_n = row_ldraw_bf16(YS + (size_t)s1n * D, F.lane);
            if (nr + step < nrows) RC_SLOTS(nr + step, s0nn, s1nn, g0nn, g1nn); }
        const RowF gt = row_ld_f32(m + 5120, F.lane);
#pragma unroll
        for (int j = 0; j < 4; ++j) x.v[j] = ALPHA * x.v[j] + gt.v[j] * (g0 * y0.v[j] + g1 * y1.v[j]);
        row_layernorm(x, a.in[I_LNG] + (layer * 2 + 1) * D, a.in[I_LNB] + (layer * 2 + 1) * D, F.lane);
        if (last) { row_st_f32(a.out + (size_t)row * D, F.lane, x); }
        else { row_st_bf16(XL + (size_t)row * D, F.lane, x); const float* m1 = modl + 3 * 6144 + mod_index(row) * 6144;
            const RowF h = row_modulate(x, m1, m1 + 1024, F.lane); row_st_bf16(HB + (size_t)row * D, F.lane, h); }
    }
#undef RC_SLOTS
}

template <class Epi, class Sched> __device__ __forceinline__ void run_gemm_gather(Ctx& F, const bf16_t* A, const bf16_t* Bt, int K, const Sched& S, const Epi& E) {
    pg8::Gemm g{A, Bt, 0, 0, K};
    pg8::gemm_phase<Epi, Sched, true, true, true>(F.lds, g, S, E, F.wave * 64 + fresh_lane());
    __syncthreads();
}
template <class Epi, class Sched> __device__ __forceinline__ void run_gemm(Ctx& F, const bf16_t* A, const bf16_t* Bt, int M, int N, int K, const Sched& S, const Epi& E) {
    pg8::Gemm g{A, Bt, M, N, K};
    pg8::gemm_phase<Epi, Sched, true, true>(F.lds, g, S, E, F.wave * 64 + fresh_lane());
    __syncthreads();
}

__device__ __forceinline__ void qkprep_phase(Ctx& F, const Args& a) {
    bf16_t* Q = (bf16_t*)(F.ws + WS_Q); bf16_t* KB = (bf16_t*)(F.ws + WS_KB);
    constexpr int NQ = NLAT * 8, NK = NBATCH * SLEN * 2;
    const float qg0 = a.in[I_QG][F.lane], qg1 = a.in[I_QG][F.lane + 64], kg0 = a.in[I_KG][F.lane], kg1 = a.in[I_KG][F.lane + 64];
    const float* ropet = (const float*)(F.ws + WS_ROPE);
    for (int it = NQ + GWID(F); it < NQ + NK; it += NGW(F)) {
        bf16_t* p; int t; bool rope; float g0, g1;
        if (it < NQ) { const int row = it >> 3, hh = it & 7; p = Q + (size_t)row * 1024 + hh * 128; t = row % SEQ; rope = true; g0 = qg0; g1 = qg1; }
        else { const int r = it - NQ, krow = r >> 1, kvh = r & 1, key = krow % SLEN; p = KB + (size_t)krow * 256 + kvh * 128; rope = key >= CTXL; t = key - CTXL; g0 = kg0; g1 = kg1; }
        float x1 = bf2f(p[F.lane]), x2 = bf2f(p[F.lane + 64]);
        const float r = rsqrtf(wave_sum(x1 * x1 + x2 * x2) * (1.f / 128.f) + 1e-6f);
        x1 *= r * g0; x2 *= r * g1;
        float o1 = x1, o2 = x2;
        if (rope) { const float* rp = ropet + ((F.lane < 32) ? (t / 64) : (t % 64)) * 64 + 2 * (F.lane & 31); const float cs = rp[0], sn = rp[1]; o1 = x1 * cs - x2 * sn; o2 = x2 * cs + x1 * sn; }
        p[F.lane] = f2bf(o1); p[F.lane + 64] = f2bf(o2);
    }
}
__device__ __forceinline__ void attn_phase(Ctx& F, const Args& a) {
    const bf16_t* Q = (const bf16_t*)(F.ws + WS_Q); const bf16_t* KB = (const bf16_t*)(F.ws + WS_KB); const bf16_t* VB = (const bf16_t*)(F.ws + WS_VB); bf16_t* AO = (bf16_t*)(F.ws + WS_AO);
    const float gq = wave_max(fmaxf(fabsf(a.in[I_QG][F.lane]), fabsf(a.in[I_QG][F.lane + 64]))), gk = wave_max(fmaxf(fabsf(a.in[I_KG][F.lane]), fabsf(a.in[I_KG][F.lane + 64])));
    const bool fast = 11.3137085f * 1.4426950408889634f * 1.02f * gq * gk < 60.f;
    for (int i = 0;; ++i) {
        const int L = i * F.G + F.bid; if (L >= 512) break;
        const int xcd = L & 7, off = L >> 3, combo = xcd >> 1, idx = (xcd & 1) * 64 + off, hl = idx >> 5, qb = idx & 31;
        const int b = combo >> 1, kvh = combo & 1, h = kvh * 4 + hl;
        const size_t qoff = ((size_t)b * SEQ + qb * 256) * 1024 + h * 128, koff = (size_t)b * SLEN * 256 + kvh * 128;
        if (fast) attn::attn_dense_body<attn::bf16, true, 1>(Q + qoff, KB + koff, VB + koff, AO + qoff, SLEN, (char*)F.lds, F.wave * 64 + fresh_lane(), a.in[I_QG], qb * 256, (const float*)(F.ws + WS_ROPE));
        else attn::attn_dense_body<attn::bf16, false, 1>(Q + qoff, KB + koff, VB + koff, AO + qoff, SLEN, (char*)F.lds, F.wave * 64 + fresh_lane(), a.in[I_QG], qb * 256, (const float*)(F.ws + WS_ROPE));
        __syncthreads();
    }
}

typedef short v4i16_t __attribute__((ext_vector_type(4)));
typedef const LAS unsigned char* lds_cptr;
constexpr float LOG2E = 1.4426950408889634f;
__device__ __forceinline__ s16x4 vtr(lds_cptr p) { return __builtin_bit_cast(s16x4, __builtin_amdgcn_ds_read_tr16_b64_v4i16((LAS v4i16_t*)p)); }
__device__ __forceinline__ bf16x8 trfrag(lds_cptr tb, int d0, int ks) {
    const s16x4 l = vtr(tb + attn::v_rd_off(d0, ks, 0)), h = vtr(tb + attn::v_rd_off(d0, ks, 1));
    return (bf16x8){l[0], l[1], l[2], l[3], h[0], h[1], h[2], h[3]}; }
__device__ __forceinline__ bf16x8 rowfrag(lds_cptr tile, int blk, int d0, int r32, int hi) { return *(const LAS bf16x8*)(tile + KSWZ(32 * blk + r32, (d0 * 16 + hi * 8) * 2)); }
__device__ __forceinline__ u32x4 scale8(u32x4 v, float s) { u32x4 o;
#pragma unroll
    for (int i = 0; i < 4; ++i) o[i] = pk2(__uint_as_float(v[i] << 16) * s, __uint_as_float(v[i] & 0xffff0000u) * s);
    return o; }
__device__ __forceinline__ bf16x8 scale8f(bf16x8 v, float s) { return __builtin_bit_cast(bf16x8, scale8(__builtin_bit_cast(u32x4, v), s)); }
__device__ __forceinline__ float wave_incl_sum(float v, int lane) {
#pragma unroll
    for (int o = 1; o < 64; o <<= 1) { const float t = __shfl_up(v, o); if (lane >= o) v += t; }
    return v; }
__device__ __forceinline__ float wave_incl_max(float v, int lane) {
#pragma unroll
    for (int o = 1; o < 64; o <<= 1) { const float t = __shfl_up(v, o); if (lane >= o) v = fmaxf(v, t); }
    return v; }
__device__ __forceinline__ float wave_incl_max_rev(float v, int lane) {
#pragma unroll
    for (int o = 1; o < 64; o <<= 1) { const float t = __shfl_down(v, o); if (lane + o < 64) v = fmaxf(v, t); }
    return v; }
__device__ __forceinline__ float half_swap_add(float v) { auto rr = __builtin_amdgcn_permlane32_swap(__float_as_uint(v), __float_as_uint(v), false, false); return __uint_as_float(rr[0]) + __uint_as_float(rr[1]); }
#define MX_PK4(P, BASE, OUT) do { unsigned a0_ = pk2(P[BASE + 0], P[BASE + 1]), a1_ = pk2(P[BASE + 2], P[BASE + 3]); \
    unsigned b0_ = pk2(P[BASE + 4], P[BASE + 5]), b1_ = pk2(P[BASE + 6], P[BASE + 7]); \
    auto r0_ = __builtin_amdgcn_permlane32_swap(a0_, b0_, false, false); auto r1_ = __builtin_amdgcn_permlane32_swap(a1_, b1_, false, false); \
    u32x4 w_ = {r0_[0], r1_[0], r0_[1], r1_[1]}; OUT = __builtin_bit_cast(bf16x8, w_); } while (0)

__device__ __forceinline__ const bf16_t* launder_v(const bf16_t* p) { asm volatile("" : "+v"(p)); return p; }
constexpr int MX_MISC = MISC_OFF + 1024;
__device__ __forceinline__ int st_off(int row, int col) { return (((row >> 5) * 8 + (col >> 4)) << 9) + ((row & 31) << 4) + (col & 15); }
__device__ __forceinline__ int mx_unit(int bid, int G, int k, int off) { const int kmain = 528 / G, nmain = kmain * G; if (k < kmain) return bid + k * G; if (k == kmain) { const int j = bid - off; return (j >= 0 && j < 528 - nmain) ? nmain + j : -1; } return -1; }

constexpr int CONV_RUN = 26;
__device__ __forceinline__ int conv_seg(int row) { return row < NLAT ? row / SEQ : 2 + (row - NLAT) / CTXL; }
__device__ __forceinline__ void conv_unpack(u32x4 v, float (&f)[8]) {
#pragma unroll
    for (int e = 0; e < 4; ++e) { f[2 * e] = __uint_as_float(v[e] << 16); f[2 * e + 1] = __uint_as_float(v[e] & 0xffff0000u); } }
__device__ __forceinline__ void conv_phase(Ctx& F, const Args& a) {
    const bf16_t* XBC = (const bf16_t*)(F.ws + WS_XBC); bf16_t* XC = (bf16_t*)(F.ws + WS_XC);
    const float* cw = a.in[I_CONVW]; const float* cb = a.in[I_CONVB];
    constexpr int NRUN = (NTOK + CONV_RUN - 1) / CONV_RUN;
    for (int it = F.bid * NTHREADS + F.tid; it < NRUN * 192; it += F.G * NTHREADS) {
        const int c8 = (it % 192) * 8, r0 = (it / 192) * CONV_RUN, r1 = (r0 + CONV_RUN < NTOK) ? r0 + CONV_RUN : NTOK;
        float w[4][8], bias[8];
#pragma unroll
        for (int j = 0; j < 4; ++j) { const f32x4 w0 = *(const f32x4*)(cw + j * 1536 + c8), w1 = *(const f32x4*)(cw + j * 1536 + c8 + 4); w[j][0] = w0[0]; w[j][1] = w0[1]; w[j][2] = w0[2]; w[j][3] = w0[3]; w[j][4] = w1[0]; w[j][5] = w1[1]; w[j][6] = w1[2]; w[j][7] = w1[3]; }
        { const f32x4 b0 = *(const f32x4*)(cb + c8), b1 = *(const f32x4*)(cb + c8 + 4); bias[0] = b0[0]; bias[1] = b0[1]; bias[2] = b0[2]; bias[3] = b0[3]; bias[4] = b1[0]; bias[5] = b1[1]; bias[6] = b1[2]; bias[7] = b1[3]; }
        const u32x4 zero = {0u, 0u, 0u, 0u};
        const bf16_t* base = XBC + c8;
        u32x4 xm2 = r0 >= 2 ? *(const u32x4*)(base + (size_t)(r0 - 2) * 1536) : zero, xm1 = r0 >= 1 ? *(const u32x4*)(base + (size_t)(r0 - 1) * 1536) : zero;
        u32x4 x0 = *(const u32x4*)(base + (size_t)r0 * 1536), xp1 = r0 + 1 < NTOK ? *(const u32x4*)(base + (size_t)(r0 + 1) * 1536) : zero;
        for (int r = r0; r < r1; ++r) {
            const u32x4 xp2 = r + 2 < NTOK ? *(const u32x4*)(base + (size_t)(r + 2) * 1536) : zero;
            const int sg = conv_seg(r);
            const bool v0 = r >= 2 && conv_seg(r - 2) == sg, v1 = r >= 1 && conv_seg(r - 1) == sg, v3 = r + 1 < NTOK && conv_seg(r + 1) == sg;
            float f0[8], f1[8], f2[8], f3[8]; conv_unpack(xm2, f0); conv_unpack(xm1, f1); conv_unpack(x0, f2); conv_unpack(xp1, f3);
            float acc[8];
#pragma unroll
            for (int e = 0; e < 8; ++e) acc[e] = bias[e] + (v0 ? w[0][e] * f0[e] : 0.f) + (v1 ? w[1][e] * f1[e] : 0.f) + w[2][e] * f2[e] + (v3 ? w[3][e] * f3[e] : 0.f);
            u32x4 o; o[0] = pk2(siluf(acc[0]), siluf(acc[1])); o[1] = pk2(siluf(acc[2]), siluf(acc[3])); o[2] = pk2(siluf(acc[4]), siluf(acc[5])); o[3] = pk2(siluf(acc[6]), siluf(acc[7]));
            *(u32x4*)(XC + (size_t)r * 1536 + c8) = o;
            xm2 = xm1; xm1 = x0; x0 = xp1; xp1 = xp2;
        }
    }
}

struct MlGate { float b0, b1, G0, G1, total; };
__device__ __forceinline__ MlGate ml_gate(const float* GATES, int row0, int dir, int h, int lane) {
    const float* g0 = GATES + (size_t)(row0 + 2 * lane) * NGATE; const float* g1 = g0 + NGATE;
    const float lf0 = g0[8 + dir * 4 + h], lf1 = g1[8 + dir * 4 + h], ig0 = g0[dir * 4 + h], ig1 = g1[dir * 4 + h];
    const float incl = wave_incl_sum(lf0 + lf1, lane), total = __shfl(incl, 63);
    MlGate r; r.total = total;
    if (dir == 0) { r.b0 = incl - lf1; r.b1 = incl; } else { r.b0 = total - incl + lf0 + lf1; r.b1 = total - incl + lf1; }
    r.G0 = ig0 - r.b0; r.G1 = ig1 - r.b1; return r;
}


__device__ __forceinline__ void mlstm_a_phase(Ctx& F, int off) {
    const bf16_t* QK = (const bf16_t*)(F.ws + WS_QK); const bf16_t* V = (const bf16_t*)(F.ws + WS_V); const float* GATES = (const float*)(F.ws + WS_GATES);
    bf16_t* DC = (bf16_t*)(F.ws + WS_DC); float* DN = (float*)(F.ws + WS_DN); float* MS = (float*)(F.ws + WS_MS);
    LAS unsigned char* Vt = F.lds; LAS unsigned char* Kw = F.lds + 65536;
    LAS float* wsc = (LAS float*)(F.lds + MX_MISC); LAS float* dnp = (LAS float*)(F.lds + MX_MISC + 1024);
    for (int k_ = 0;; ++k_) { const int u = mx_unit(F.bid, F.G, k_, off); if (u < 0) break;
        const int lane = fresh_lane(), tid = F.wave * 64 + lane, r32 = lane & 31, hi = lane >> 5, sr = tid >> 4, sc8 = (tid & 15) * 8, rdb = attn::v_rd_base(lane);
        const int b = u / 264, rem = u % 264, cid = rem >> 2, h = rem & 3, row0 = chunk_row0(b, cid);
        if (F.wave < 2) { const int dir = F.wave, chain = (b * 4 + h) * 2 + dir; typedef float f32x2v __attribute__((ext_vector_type(2)));
            *(LAS f32x2v*)(wsc + dir * 128 + 2 * lane) = *(const f32x2v*)((const float*)(F.ws + WS_MLG) + (size_t)(chain * NCH + cid) * 512 + 384 + 2 * lane); }
        __syncthreads();
        float dnacc[2][8];
#pragma unroll
        for (int d = 0; d < 2; ++d)
#pragma unroll
            for (int e = 0; e < 8; ++e) dnacc[d][e] = 0.f;
#pragma unroll
        for (int i = 0; i < 4; ++i) { const int s = sr + 32 * i; const size_t grow = (size_t)(row0 + s) * 1024;
#pragma unroll
            for (int vb = 0; vb < 2; ++vb) { const u32x4 v = *(const u32x4*)(V + grow + h * 256 + vb * 128 + sc8); *(LAS u32x4*)(Vt + ((s >> 6) * 2 + vb) * 16384 + attn::v_st(s & 63, sc8)) = v; }
            const u32x4 kv = *(const u32x4*)(QK + grow + 512 + h * 128 + sc8);
#pragma unroll
            for (int d = 0; d < 2; ++d) { const float w = wsc[d * 128 + s];
                *(LAS u32x4*)(Kw + (d * 2 + (s >> 6)) * 16384 + attn::v_st(s & 63, sc8)) = scale8(kv, w);
#pragma unroll
                for (int e = 0; e < 4; ++e) { dnacc[d][2 * e] += w * __uint_as_float(kv[e] << 16); dnacc[d][2 * e + 1] += w * __uint_as_float(kv[e] & 0xffff0000u); } } }
#pragma unroll
        for (int d = 0; d < 2; ++d)
#pragma unroll
            for (int e = 0; e < 8; ++e) { float t = dnacc[d][e]; t += __shfl_xor(t, 16); t += __shfl_xor(t, 32); if ((lane >> 4) == 0) dnp[(F.wave * 2 + d) * 128 + sc8 + e] = t; }
        __syncthreads();
        {   const int dir = F.wave >> 2, vq = F.wave & 3;
            f32x16 acc[2][4];
#pragma unroll
            for (int i = 0; i < 2; ++i)
#pragma unroll
                for (int n = 0; n < 4; ++n) acc[i][n] = f32x16{};
#pragma unroll
            for (int ks = 0; ks < 8; ++ks) { const int sblk = ks >> 2, KS = ks & 3;
                bf16x8 af[2], bfr[4];
#pragma unroll
                for (int i = 0; i < 2; ++i) af[i] = trfrag(Vt + (sblk * 2 + (vq >> 1)) * 16384 + rdb, (2 * vq + i) & 3, KS);
#pragma unroll
                for (int n = 0; n < 4; ++n) bfr[n] = trfrag(Kw + (dir * 2 + sblk) * 16384 + rdb, n, KS);
#pragma unroll
                for (int i = 0; i < 2; ++i)
#pragma unroll
                    for (int n = 0; n < 4; ++n) acc[i][n] = __builtin_amdgcn_mfma_f32_32x32x16_bf16(af[i], bfr[n], acc[i][n], 0, 0, 0); }
            const int chain = (b * 4 + h) * 2 + dir;
            bf16_t* dst = DC + (size_t)(chain * NCH + cid) * 256 * 128;
#pragma unroll
            for (int i = 0; i < 2; ++i)
#pragma unroll
                for (int n = 0; n < 4; ++n)
#pragma unroll
                    for (int r = 0; r < 16; ++r) dst[st_off(64 * vq + 32 * i + attn::crow(r, hi), 32 * n + r32)] = f2bf(acc[i][n][r]);
        }
        if (tid < 256) { const int dir = tid >> 7, d = tid & 127; float s = 0.f;
#pragma unroll
            for (int w = 0; w < 8; ++w) s += dnp[(w * 2 + dir) * 128 + d];
            const int chain = (b * 4 + h) * 2 + dir; DN[(size_t)(chain * NCH + cid) * 128 + d] = s; }
        __syncthreads();
    }
}

struct SsGate { float dt0, dt1, acs0, acs1, total; };
__device__ __forceinline__ SsGate ss_gate(const float* GATES, int row0, int dir, int head, float aneg, int lane) {
    const float* g0 = GATES + (size_t)(row0 + 2 * lane) * NGATE; const float* g1 = g0 + NGATE;
    SsGate r; r.dt0 = g0[16 + dir * 16 + head]; r.dt1 = g1[16 + dir * 16 + head];
    const float a0 = r.dt0 * aneg, a1 = r.dt1 * aneg;
    const float incl = wave_incl_sum(a0 + a1, lane); r.total = __shfl(incl, 63);
    if (dir == 0) { r.acs0 = incl - a1; r.acs1 = incl; } else { r.acs0 = r.total - incl + a0 + a1; r.acs1 = r.total - incl + a1; }
    return r;
}
__device__ __forceinline__ void gatescan_phase(Ctx& F, const Args& a) {
    const float* GATES = (const float*)(F.ws + WS_GATES); float* MLG = (float*)(F.ws + WS_MLG); float* SSG = (float*)(F.ws + WS_SSG);
    float* MS = (float*)(F.ws + WS_MS); float* AEND = (float*)(F.ws + WS_AEND);
    typedef float f32x2v __attribute__((ext_vector_type(2)));
    const int lane = F.lane;
    for (int it = GWID(F); it < 16 * NCH + 64 * NCH; it += NGW(F)) {
        if (it < 16 * NCH) { const int chain = it / NCH, cid = it % NCH, dir = chain & 1, h = (chain >> 1) & 3, b = chain >> 3, row0 = chunk_row0(b, cid);
            const MlGate g = ml_gate(GATES, row0, dir, h, lane);
            const float gmx = fmaxf(g.G0, g.G1), gm = wave_max(gmx); float P0, P1;
            if (dir == 0) { const float pm = wave_incl_max(gmx, lane); float ex = __shfl_up(pm, 1); if (lane == 0) ex = -1e30f; P0 = fmaxf(ex, g.G0); P1 = pm; }
            else { const float pm = wave_incl_max_rev(gmx, lane); float ex = __shfl_down(pm, 1); if (lane == 63) ex = -1e30f; P1 = fmaxf(ex, g.G1); P0 = pm; }
            float* o = MLG + (size_t)it * 512 + 2 * lane;
            *(f32x2v*)(o) = (f32x2v){g.b0, g.b1}; *(f32x2v*)(o + 128) = (f32x2v){g.G0, g.G1}; *(f32x2v*)(o + 256) = (f32x2v){P0, P1}; *(f32x2v*)(o + 384) = (f32x2v){expf(g.G0 - gm), expf(g.G1 - gm)};
            if (lane == 0) { MS[it * 4 + 0] = g.total; MS[it * 4 + 1] = g.total + gm; } }
        else { const int i2 = it - 16 * NCH, chain = i2 / NCH, cid = i2 % NCH, dir = chain & 1, head = (chain >> 1) & 15, b = chain >> 5, row0 = chunk_row0(b, cid);
            const float aneg = -expf(a.in[I_ALOG][dir * 16 + head]); const SsGate s = ss_gate(GATES, row0, dir, head, aneg, lane);
            float* o = SSG + (size_t)i2 * 384 + 2 * lane;
            *(f32x2v*)(o) = (f32x2v){s.acs0, s.acs1}; *(f32x2v*)(o + 128) = (f32x2v){s.dt0, s.dt1}; *(f32x2v*)(o + 256) = (f32x2v){s.dt0 * expf(s.total - s.acs0), s.dt1 * expf(s.total - s.acs1)};
            if (lane == 0) AEND[i2] = s.total; }
    }
}
template <bool BM_ROW> __device__ __forceinline__ void ssd_stage(Ctx& F, const bf16_t* XC, int row0, int g, int hh, LAS unsigned char* Xt, LAS unsigned char* Bt) {
    const int tid_ = F.wave * 64 + fresh_lane(), sr = tid_ >> 4, sc8 = (tid_ & 15) * 8;
#pragma unroll
    for (int i = 0; i < 4; ++i) { const int s = sr + 32 * i; const bf16_t* rowp = XC + (size_t)(row0 + s) * 1536;
#pragma unroll
        for (int cb = 0; cb < 2; ++cb) { const u32x4 v = *(const u32x4*)(rowp + (g * 8 + hh * 4) * 64 + cb * 128 + sc8); *(LAS u32x4*)(Xt + ((s >> 6) * 2 + cb) * 16384 + attn::v_st(s & 63, sc8)) = v; }
        const u32x4 bv = *(const u32x4*)(rowp + 1024 + g * 128 + sc8);
        if (BM_ROW) *(LAS u32x4*)(Bt + (s >> 6) * 16384 + KSWZ(s & 63, sc8 * 2)) = bv; else *(LAS u32x4*)(Bt + (s >> 6) * 16384 + attn::v_st(s & 63, sc8)) = bv; }
}
__device__ __forceinline__ void ssd_a_phase(Ctx& F, const Args& a, int off) {
    const bf16_t* XC = (const bf16_t*)(F.ws + WS_XC); const float* GATES = (const float*)(F.ws + WS_GATES);
    bf16_t* DS = (bf16_t*)(F.ws + WS_DS); float* AEND = (float*)(F.ws + WS_AEND);
    LAS unsigned char* Xt = F.lds; LAS unsigned char* Bt = F.lds + 65536;
    LAS float* wtl = (LAS float*)(F.lds + MX_MISC);
    for (int k_ = 0;; ++k_) { const int u = mx_unit(F.bid, F.G, k_, off); if (u < 0) break;
        const int lane = fresh_lane(), r32 = lane & 31, hi = lane >> 5, rdb = attn::v_rd_base(lane);
        const int b = u / 264, rem = u % 264, cid = rem >> 2, g = (rem >> 1) & 1, hh = rem & 1, row0 = chunk_row0(b, cid);
        const int dir = F.wave >> 2, j = F.wave & 3, head = g * 8 + hh * 4 + j, chain = (b * 16 + head) * 2 + dir;
        { typedef float f32x2v __attribute__((ext_vector_type(2)));
          *(LAS f32x2v*)(wtl + F.wave * 128 + 2 * lane) = *(const f32x2v*)((const float*)(F.ws + WS_SSG) + (size_t)(chain * NCH + cid) * 384 + 256 + 2 * lane); }
        ssd_stage<false>(F, XC, row0, g, hh, Xt, Bt);
        __syncthreads();
        f32x16 acc[2][4];
#pragma unroll
        for (int i = 0; i < 2; ++i)
#pragma unroll
            for (int n = 0; n < 4; ++n) acc[i][n] = f32x16{};
#pragma unroll
        for (int ks = 0; ks < 8; ++ks) { const int sblk = ks >> 2, KS = ks & 3;
            const f32x4 w0 = *(const LAS f32x4*)(wtl + F.wave * 128 + 16 * ks + 8 * hi), w1 = *(const LAS f32x4*)(wtl + F.wave * 128 + 16 * ks + 8 * hi + 4);
            bf16x8 af[2], bfr[4];
#pragma unroll
            for (int i = 0; i < 2; ++i) { const u32x4 x = __builtin_bit_cast(u32x4, trfrag(Xt + (sblk * 2 + (j >> 1)) * 16384 + rdb, (j & 1) * 2 + i, KS)); u32x4 o;
                o[0] = pk2(__uint_as_float(x[0] << 16) * w0[0], __uint_as_float(x[0] & 0xffff0000u) * w0[1]); o[1] = pk2(__uint_as_float(x[1] << 16) * w0[2], __uint_as_float(x[1] & 0xffff0000u) * w0[3]);
                o[2] = pk2(__uint_as_float(x[2] << 16) * w1[0], __uint_as_float(x[2] & 0xffff0000u) * w1[1]); o[3] = pk2(__uint_as_float(x[3] << 16) * w1[2], __uint_as_float(x[3] & 0xffff0000u) * w1[3]);
                af[i] = __builtin_bit_cast(bf16x8, o); }
#pragma unroll
            for (int n = 0; n < 4; ++n) bfr[n] = trfrag(Bt + sblk * 16384 + rdb, n, KS);
#pragma unroll
            for (int i = 0; i < 2; ++i)
#pragma unroll
                for (int n = 0; n < 4; ++n) acc[i][n] = __builtin_amdgcn_mfma_f32_32x32x16_bf16(af[i], bfr[n], acc[i][n], 0, 0, 0); }
        bf16_t* dst = DS + (size_t)(chain * NCH + cid) * 64 * 128;
#pragma unroll
        for (int i = 0; i < 2; ++i)
#pragma unroll
            for (int n = 0; n < 4; ++n)
#pragma unroll
                for (int r = 0; r < 16; ++r) dst[st_off(32 * i + attn::crow(r, hi), 32 * n + r32)] = f2bf(acc[i][n][r]);
        __syncthreads();
    }
}

__device__ __forceinline__ void scan_phase(Ctx& F) {
    LAS float* sa = (LAS float*)(F.lds + MX_MISC); LAS float* ss = sa + 80;
    for (int vb = F.bid; vb < 256; vb += F.G) {
        __syncthreads();
        if (vb < 128) {
            const int chain = vb >> 3, dir = chain & 1; float* MS = (float*)(F.ws + WS_MS) + (size_t)chain * NCH * 4;
            LAS float* sbe = ss + 80; LAS float* sgm = sbe + 80;
            if (F.tid < NCH) { const int cid = scan_cid(dir, F.tid); sbe[F.tid] = MS[cid * 4 + 0]; sgm[F.tid] = MS[cid * 4 + 1]; }
            __syncthreads();
            if (F.tid == 0) { float m = 0.f;
                for (int p = 0; p < NCH; ++p) { const float be = sbe[p], gm = sgm[p];
                    const float mn = fmaxf(be + m, gm); sa[p] = expf(be + m - mn); ss[p] = expf(gm - mn); if ((vb & 7) == 0) MS[scan_cid(dir, p) * 4 + 2] = m; m = mn; } }
            __syncthreads();
            {   bf16_t* base = (bf16_t*)(F.ws + WS_DC) + (size_t)chain * NCH * 32768 + ((size_t)(vb & 7) * 512 + F.tid) * 8;
                u32x4 buf[8]; float run[8];
#pragma unroll
                for (int e = 0; e < 8; ++e) run[e] = 0.f;
#pragma unroll
                for (int k = 0; k < 8; ++k) buf[k] = *(const u32x4*)(base + (size_t)scan_cid(dir, k) * 32768);
                for (int p0 = 0; p0 < 72; p0 += 8) {
#pragma unroll
                    for (int k = 0; k < 8; ++k) { const int p = p0 + k;
                        if (p < NCH) { const u32x4 d = buf[k]; bf16_t* loc = base + (size_t)scan_cid(dir, p) * 32768;
                            if (p + 8 < NCH) buf[k] = *(const u32x4*)(base + (size_t)scan_cid(dir, p + 8) * 32768);
                            u32x4 o; o[0] = pk2(run[0], run[1]); o[1] = pk2(run[2], run[3]); o[2] = pk2(run[4], run[5]); o[3] = pk2(run[6], run[7]);
                            *(u32x4*)loc = o;
                            const float av = sa[p], sv = ss[p];
#pragma unroll
                            for (int e = 0; e < 4; ++e) { run[2 * e] = av * run[2 * e] + sv * __uint_as_float(d[e] << 16); run[2 * e + 1] = av * run[2 * e + 1] + sv * __uint_as_float(d[e] & 0xffff0000u); } } }
                }
            }
            if ((vb & 7) == 0 && F.tid < 32) {
                float* nb = (float*)(F.ws + WS_DN) + (size_t)chain * NCH * 128 + F.tid * 4;
                f32x4 buf[8]; f32x4 run = {0.f, 0.f, 0.f, 0.f};
#pragma unroll
                for (int k = 0; k < 8; ++k) buf[k] = *(const f32x4*)(nb + (size_t)scan_cid(dir, k) * 128);
                for (int p0 = 0; p0 < 72; p0 += 8) {
#pragma unroll
                    for (int k = 0; k < 8; ++k) { const int p = p0 + k;
                        if (p < NCH) { const f32x4 d = buf[k]; float* loc = nb + (size_t)scan_cid(dir, p) * 128;
                            if (p + 8 < NCH) buf[k] = *(const f32x4*)(nb + (size_t)scan_cid(dir, p + 8) * 128);
                            *(f32x4*)loc = run; run = sa[p] * run + ss[p] * d; } }
                }
            }
        } else {
            const int chain = (vb - 128) >> 1, dir = chain & 1; const float* AEND = (const float*)(F.ws + WS_AEND) + (size_t)chain * NCH;
            if (F.tid < NCH) sa[F.tid] = expf(AEND[scan_cid(dir, F.tid)]);
            __syncthreads();
            bf16_t* base = (bf16_t*)(F.ws + WS_DS) + (size_t)chain * NCH * 8192 + ((size_t)(vb & 1) * 512 + F.tid) * 8;
            u32x4 buf[8]; float run[8];
#pragma unroll
            for (int e = 0; e < 8; ++e) run[e] = 0.f;
#pragma unroll
            for (int k = 0; k < 8; ++k) buf[k] = *(const u32x4*)(base + (size_t)scan_cid(dir, k) * 8192);
            for (int p0 = 0; p0 < 72; p0 += 8) {
#pragma unroll
                for (int k = 0; k < 8; ++k) { const int p = p0 + k;
                    if (p < NCH) { const u32x4 d = buf[k]; bf16_t* loc = base + (size_t)scan_cid(dir, p) * 8192;
                        if (p + 8 < NCH) buf[k] = *(const u32x4*)(base + (size_t)scan_cid(dir, p + 8) * 8192);
                        u32x4 o; o[0] = pk2(run[0], run[1]); o[1] = pk2(run[2], run[3]); o[2] = pk2(run[4], run[5]); o[3] = pk2(run[6], run[7]);
                        *(u32x4*)loc = o;
                        const float av = sa[p];
#pragma unroll
                        for (int e = 0; e < 4; ++e) { run[2 * e] = av * run[2 * e] + __uint_as_float(d[e] << 16); run[2 * e + 1] = av * run[2 * e + 1] + __uint_as_float(d[e] & 0xffff0000u); } } }
            }
        }
    }
}


template <bool DIAG> __device__ __forceinline__ void ml_block(const f32x16& S, const LAS float* Gp, float Mt, float sgn, float sb, float scale, f32x16& out) {
#pragma unroll
    for (int g4 = 0; g4 < 4; ++g4) { const f32x4 Gv = *(const LAS f32x4*)(Gp + 8 * g4);
#pragma unroll
        for (int e = 0; e < 4; ++e) { float arg = (Gv[e] - Mt) * LOG2E;
            if (DIAG) arg = fmaf(fminf(fmaf(-sgn, (float)(8 * g4 + e), sb), 0.f), 1e30f, arg);
            out[4 * g4 + e] = S[4 * g4 + e] * __builtin_amdgcn_exp2f(arg) * scale; } }
}
template <bool DIAG> __device__ __forceinline__ void ss_block(const f32x16& S, const LAS float* ap, const LAS float* dp, float At, float sgn, float sb, f32x16& out) {
#pragma unroll
    for (int g4 = 0; g4 < 4; ++g4) { const f32x4 av = *(const LAS f32x4*)(ap + 8 * g4), dv = *(const LAS f32x4*)(dp + 8 * g4);
#pragma unroll
        for (int e = 0; e < 4; ++e) { float arg = (At - av[e]) * LOG2E;
            if (DIAG) arg = fmaf(fminf(fmaf(-sgn, (float)(8 * g4 + e), sb), 0.f), 1e30f, arg);
            out[4 * g4 + e] = S[4 * g4 + e] * __builtin_amdgcn_exp2f(arg) * dv[e]; } }
}
__device__ __forceinline__ float sum16(const f32x16& v) { float s = 0.f;
#pragma unroll
    for (int r = 0; r < 16; ++r) s += v[r];
    return s; }
template <int VAR> __device__ __forceinline__ void mlstm_c_phase(Ctx& F, const Args& a, int off) {
    const bf16_t* QK = (const bf16_t*)(F.ws + WS_QK); const bf16_t* V = (const bf16_t*)(F.ws + WS_V); const bf16_t* OG = (const bf16_t*)(F.ws + WS_O); const float* GATES = (const float*)(F.ws + WS_GATES);
    const bf16_t* DC = (const bf16_t*)(F.ws + WS_DC); const float* DN = (const float*)(F.ws + WS_DN); const float* MS = (const float*)(F.ws + WS_MS); bf16_t* MIX = VAR ? (bf16_t*)(F.ws + WS_END) : (bf16_t*)(F.ws + WS_MIX);
    LAS unsigned char* Kt = F.lds; LAS unsigned char* Vt = F.lds + 32768; LAS float* stat = (LAS float*)(F.lds + MX_MISC + 5120);
    LAS float* Gs = (LAS float*)(F.lds + MX_MISC); LAS float* Ms = Gs + 256; LAS float* Bs = Gs + 512; LAS float* ns = Gs + 768; LAS float* mst = Gs + 1024;
    for (int k_ = 0;; ++k_) { const int u = mx_unit(F.bid, F.G, k_, off); if (u < 0) break;
        const int lane = fresh_lane(), tid = F.wave * 64 + lane, r32 = lane & 31, hi = lane >> 5, sr = tid >> 4, sc8 = (tid & 15) * 8, rdb = attn::v_rd_base(lane);
        const int b = u / 264, rem = u % 264, cid = rem >> 2, h = rem & 3, row0 = chunk_row0(b, cid);
        if (F.wave < 2) { const int dir = F.wave, chain = (b * 4 + h) * 2 + dir; typedef float f32x2v __attribute__((ext_vector_type(2)));
            const float* gsrc = (const float*)(F.ws + WS_MLG) + (size_t)(chain * NCH + cid) * 512 + 2 * lane;
            const f32x2v bb = *(const f32x2v*)gsrc, GG = *(const f32x2v*)(gsrc + 128), PP = *(const f32x2v*)(gsrc + 256);
            const float m0 = MS[(chain * NCH + cid) * 4 + 2];
            *(LAS f32x2v*)(Gs + dir * 128 + 2 * lane) = GG; *(LAS f32x2v*)(Ms + dir * 128 + 2 * lane) = (f32x2v){fmaxf(PP[0], m0), fmaxf(PP[1], m0)}; *(LAS f32x2v*)(Bs + dir * 128 + 2 * lane) = bb;
            const float* nsrc = DN + (size_t)(chain * NCH + cid) * 128; ns[dir * 128 + 2 * lane] = nsrc[2 * lane]; ns[dir * 128 + 2 * lane + 1] = nsrc[2 * lane + 1];
            if (lane == 0) mst[dir] = m0; }
#pragma unroll
        for (int i = 0; i < 4; ++i) { const int s = sr + 32 * i; const size_t grow = (size_t)(row0 + s) * 1024;
#pragma unroll
            for (int vb = 0; vb < 2; ++vb) { const u32x4 v = *(const u32x4*)(V + grow + h * 256 + vb * 128 + sc8); *(LAS u32x4*)(Vt + ((s >> 6) * 2 + vb) * 16384 + attn::v_st(s & 63, sc8)) = v; }
            const u32x4 kv = *(const u32x4*)(QK + grow + 512 + h * 128 + sc8);
            *(LAS u32x4*)(Kt + (s >> 6) * 16384 + KSWZ(s & 63, sc8 * 2)) = kv; }
        __syncthreads();
        const int tq = F.wave & 3, vh = F.wave >> 2, tau = 32 * tq + r32;
        const bf16_t* qptr = QK + (size_t)(row0 + tau) * 1024 + h * 128 + hi * 8;
        f32x16 pS[2][2];
        {   bf16x8 qr[8];
#pragma unroll
        for (int d0 = 0; d0 < 8; ++d0) qr[d0] = *(const bf16x8*)(qptr + d0 * 16);
#pragma unroll
        for (int j = 0; j < 2; ++j)
#pragma unroll
            for (int blk = 0; blk < 2; ++blk) { pS[j][blk] = f32x16{};
#pragma unroll
                for (int d0 = 0; d0 < 8; ++d0) pS[j][blk] = __builtin_amdgcn_mfma_f32_32x32x16_bf16(rowfrag(Kt + j * 16384, blk, d0, r32, hi), qr[d0], pS[j][blk], 0, 0, 0); }
        }
        f32x16 o[4];
#pragma unroll
        for (int d = 0; d < 4; ++d) o[d] = f32x16{};
        float qsc0 = 0.f, qsc1 = 0.f;
        if (VAR < 3)
#pragma unroll 1
        for (int dir = 0; dir < 2; ++dir) {
            const float Mt = Ms[dir * 128 + tau], m0 = mst[dir];
            const float sgn = dir ? -1.f : 1.f, sb = sgn * (float)(r32 - 4 * hi);
            float rs = 0.f;
#pragma unroll
            for (int j = 0; j < 2; ++j)
#pragma unroll
                for (int blk = 0; blk < 2; ++blk) { const int kb = 2 * j + blk; const bool vis = dir ? (kb >= tq) : (kb <= tq);
                    if (vis) { f32x16 pp; const LAS float* Gp = Gs + dir * 128 + 32 * kb + 4 * hi;
                        if (kb == tq) ml_block<true>(pS[j][blk], Gp, Mt, sgn, sb, 1.f, pp); else ml_block<false>(pS[j][blk], Gp, Mt, sgn, sb, 1.f, pp);
                        rs += sum16(pp); } }
            rs = half_swap_add(rs);
            float qn = 0.f; const bf16_t* qp2 = launder_v(qptr);
#pragma unroll
            for (int d0 = 0; d0 < 8; ++d0) { const bf16x8 qv = *(const bf16x8*)(qp2 + d0 * 16); const f32x4 n0 = *(const LAS f32x4*)(ns + dir * 128 + 16 * d0 + 8 * hi), n1 = *(const LAS f32x4*)(ns + dir * 128 + 16 * d0 + 8 * hi + 4);
                const u32x4 q = __builtin_bit_cast(u32x4, qv);
                qn += __uint_as_float(q[0] << 16) * n0[0] + __uint_as_float(q[0] & 0xffff0000u) * n0[1] + __uint_as_float(q[1] << 16) * n0[2] + __uint_as_float(q[1] & 0xffff0000u) * n0[3]
                    + __uint_as_float(q[2] << 16) * n1[0] + __uint_as_float(q[2] & 0xffff0000u) * n1[1] + __uint_as_float(q[3] << 16) * n1[2] + __uint_as_float(q[3] & 0xffff0000u) * n1[3]; }
            qn = half_swap_add(qn);
            const float ain = expf(m0 - Mt), den = rs + ain * qn;
            const float inv = __builtin_amdgcn_rcpf(fmaxf(fabsf(den), expf(-(Bs[dir * 128 + tau] + Mt))));
#pragma unroll
            for (int j = 0; j < 2; ++j)
#pragma unroll
                for (int blk = 0; blk < 2; ++blk) { const int kb = 2 * j + blk; const bool vis = dir ? (kb >= tq) : (kb <= tq);
                    if (vis) { f32x16 pp; const LAS float* Gp = Gs + dir * 128 + 32 * kb + 4 * hi;
                        if (kb == tq) ml_block<true>(pS[j][blk], Gp, Mt, sgn, sb, inv, pp); else ml_block<false>(pS[j][blk], Gp, Mt, sgn, sb, inv, pp);
                        bf16x8 pa0, pa1;
                        MX_PK4(pp, 0, pa0); MX_PK4(pp, 8, pa1);
#pragma unroll
                        for (int d = 0; d < 4; ++d) { o[d] = __builtin_amdgcn_mfma_f32_32x32x16_bf16(pa0, trfrag(Vt + (j * 2 + vh) * 16384 + rdb, d, 2 * blk), o[d], 0, 0, 0);
                            o[d] = __builtin_amdgcn_mfma_f32_32x32x16_bf16(pa1, trfrag(Vt + (j * 2 + vh) * 16384 + rdb, d, 2 * blk + 1), o[d], 0, 0, 0); } } }
            if (dir == 0) qsc0 = ain * inv; else qsc1 = ain * inv;
        }
        if (VAR < 2) {   const bf16_t* Cb0 = DC + (size_t)(((b * 4 + h) * 2 + 0) * NCH + cid) * 256 * 128 + (size_t)(4 * vh) * 4096 + r32 * 16 + hi * 8;
            const bf16_t* Cb1 = Cb0 + (size_t)NCH * 256 * 128;
            const bf16_t* qp3 = launder_v(qptr);
            bf16x8 qr2[8];
#pragma unroll
            for (int d0 = 0; d0 < 8; ++d0) qr2[d0] = *(const bf16x8*)(qp3 + d0 * 16);
            bf16x8 cf[4][4];
#define MLC_LD(s_) do { _Pragma("unroll") for (int d = 0; d < 4; ++d) cf[(s_) & 3][d] = *(const bf16x8*)(((s_) < 8 ? Cb0 : Cb1) + d * 4096 + 512 * ((s_) & 7)); } while (0)
            MLC_LD(0); MLC_LD(1); MLC_LD(2);
            __builtin_amdgcn_sched_barrier(0);
#pragma unroll
            for (int st = 0; st < 16; ++st) {
                if (st + 3 < 16) MLC_LD(st + 3);
                const bf16x8 qs = scale8f(qr2[st & 7], st < 8 ? qsc0 : qsc1);
#pragma unroll
                for (int d = 0; d < 4; ++d) o[d] = __builtin_amdgcn_mfma_f32_32x32x16_bf16(qs, cf[st & 3][d], o[d], 0, 0, 0);
                __builtin_amdgcn_sched_barrier(0); }
#undef MLC_LD
        }
        float s1[16], s2[16];
#pragma unroll
        for (int r = 0; r < 16; ++r) { float x = 0.f, y = 0.f;
#pragma unroll
            for (int d = 0; d < 4; ++d) { x += o[d][r]; y += o[d][r] * o[d][r]; }
#pragma unroll
            for (int of = 1; of < 32; of <<= 1) { x += __shfl_xor(x, of); y += __shfl_xor(y, of); }
            s1[r] = x; s2[r] = y; }
        if (r32 == 0) {
#pragma unroll
            for (int r = 0; r < 16; ++r) { const int row = 32 * tq + attn::crow(r, hi); stat[(vh * 128 + row) * 2] = s1[r]; stat[(vh * 128 + row) * 2 + 1] = s2[r]; } }
        __syncthreads();
        {
            LAS float* ot = (LAS float*)(F.lds + F.wave * 16384);
            float gg[4];
#pragma unroll
            for (int d = 0; d < 4; ++d) gg[d] = a.in[I_MNG][h * 256 + 128 * vh + 32 * d + r32];
#pragma unroll
            for (int r = 0; r < 16; ++r) { const int lrow = attn::crow(r, hi), row = 32 * tq + lrow;
                const float t1 = stat[row * 2] + stat[(128 + row) * 2], t2 = stat[row * 2 + 1] + stat[(128 + row) * 2 + 1];
                const float mu = t1 * (1.f / 256.f), rstd = rsqrtf(fmaxf(t2 * (1.f / 256.f) - mu * mu, 0.f) + 1e-5f);
#pragma unroll
                for (int d = 0; d < 4; ++d) ot[lrow * 128 + 32 * d + r32] = (o[d][r] - mu) * rstd * gg[d]; }
            asm volatile("s_waitcnt lgkmcnt(0)" ::: "memory");
#pragma unroll
            for (int i = 0; i < 8; ++i) { const int ch = lane + 64 * i, lrow = ch >> 4, c8 = (ch & 15) * 8;
                const f32x4 v0 = *(const LAS f32x4*)(ot + lrow * 128 + c8), v1 = *(const LAS f32x4*)(ot + lrow * 128 + c8 + 4);
                const size_t grow = (size_t)(row0 + 32 * tq + lrow); const int col = h * 256 + 128 * vh + c8;
                const u32x4 og = *(const u32x4*)(OG + grow * 1024 + col);
                u32x4 w; w[0] = pk2(v0[0] * sigmf(__uint_as_float(og[0] << 16)), v0[1] * sigmf(__uint_as_float(og[0] & 0xffff0000u))); w[1] = pk2(v0[2] * sigmf(__uint_as_float(og[1] << 16)), v0[3] * sigmf(__uint_as_float(og[1] & 0xffff0000u)));
                w[2] = pk2(v1[0] * sigmf(__uint_as_float(og[2] << 16)), v1[1] * sigmf(__uint_as_float(og[2] & 0xffff0000u))); w[3] = pk2(v1[2] * sigmf(__uint_as_float(og[3] << 16)), v1[3] * sigmf(__uint_as_float(og[3] & 0xffff0000u)));
                *(u32x4*)(MIX + (VAR ? (grow & 4095) : grow) * 2048 + 1024 + col) = w; }
        }
        __syncthreads();
    }
}

__device__ __forceinline__ void ssd_c_phase(Ctx& F, const Args& a, int off) {
    const bf16_t* XC = (const bf16_t*)(F.ws + WS_XC); const bf16_t* Z = (const bf16_t*)(F.ws + WS_Z); const float* GATES = (const float*)(F.ws + WS_GATES);
    const bf16_t* DS = (const bf16_t*)(F.ws + WS_DS); bf16_t* MIX = (bf16_t*)(F.ws + WS_MIX); float* SSQ = (float*)(F.ws + WS_SSQ);
    LAS unsigned char* Bt = F.lds; LAS unsigned char* Xt = F.lds + 32768;
    LAS float* acsl = (LAS float*)(F.lds + MX_MISC); LAS float* dtl = acsl + 1024;
    for (int k_ = 0;; ++k_) { const int u = mx_unit(F.bid, F.G, k_, off); if (u < 0) break;
        const int lane = fresh_lane(), r32 = lane & 31, hi = lane >> 5, rdb = attn::v_rd_base(lane);
        const int b = u / 264, rem = u % 264, cid = rem >> 2, g = (rem >> 1) & 1, hh = rem & 1, row0 = chunk_row0(b, cid);
        {   const int dir = F.wave >> 2, j = F.wave & 3, head = g * 8 + hh * 4 + j, chain = (b * 16 + head) * 2 + dir; typedef float f32x2v __attribute__((ext_vector_type(2)));
            const float* gsrc = (const float*)(F.ws + WS_SSG) + (size_t)(chain * NCH + cid) * 384 + 2 * lane; const int o = (j * 2 + dir) * 128 + 2 * lane;
            *(LAS f32x2v*)(acsl + o) = *(const f32x2v*)gsrc; *(LAS f32x2v*)(dtl + o) = *(const f32x2v*)(gsrc + 128); }
        ssd_stage<true>(F, XC, row0, g, hh, Xt, Bt);
        __syncthreads();
        const int tq = F.wave & 3, jp = F.wave >> 2, tau = 32 * tq + r32;
        const bf16_t* cptr = XC + (size_t)(row0 + tau) * 1536 + 1280 + g * 128 + hi * 8;
        f32x16 pS[2][2];
        {   bf16x8 cr[8];
#pragma unroll
        for (int d0 = 0; d0 < 8; ++d0) cr[d0] = *(const bf16x8*)(cptr + d0 * 16);
#pragma unroll
        for (int j = 0; j < 2; ++j)
#pragma unroll
            for (int blk = 0; blk < 2; ++blk) { pS[j][blk] = f32x16{};
#pragma unroll
                for (int d0 = 0; d0 < 8; ++d0) pS[j][blk] = __builtin_amdgcn_mfma_f32_32x32x16_bf16(rowfrag(Bt + j * 16384, blk, d0, r32, hi), cr[d0], pS[j][blk], 0, 0, 0); }
        }
        f32x16 y[2][2];
#pragma unroll
        for (int jj = 0; jj < 2; ++jj) { y[jj][0] = f32x16{}; y[jj][1] = f32x16{}; }
        float ea0 = 0.f, ea1 = 0.f, ea2 = 0.f, ea3 = 0.f;
#pragma unroll
        for (int jj = 0; jj < 2; ++jj) { const int hl = 2 * jp + jj;
#pragma unroll
            for (int dir = 0; dir < 2; ++dir) {
                const LAS float* ac = acsl + (hl * 2 + dir) * 128; const LAS float* dtp = dtl + (hl * 2 + dir) * 128;
                const float At = ac[tau];
                const float sgn = dir ? -1.f : 1.f, sb = sgn * (float)(r32 - 4 * hi);
#pragma unroll
                for (int j = 0; j < 2; ++j)
#pragma unroll
                    for (int blk = 0; blk < 2; ++blk) { const int kb = 2 * j + blk; const bool vis = dir ? (kb >= tq) : (kb <= tq);
                        if (vis) { f32x16 pp; const LAS float* ap = ac + 32 * kb + 4 * hi; const LAS float* dp = dtp + 32 * kb + 4 * hi;
                            if (kb == tq) ss_block<true>(pS[j][blk], ap, dp, At, sgn, sb, pp); else ss_block<false>(pS[j][blk], ap, dp, At, sgn, sb, pp);
                            bf16x8 pa0, pa1;
                            MX_PK4(pp, 0, pa0); MX_PK4(pp, 8, pa1);
#pragma unroll
                            for (int pb = 0; pb < 2; ++pb) { y[jj][pb] = __builtin_amdgcn_mfma_f32_32x32x16_bf16(pa0, trfrag(Xt + (j * 2 + (hl >> 1)) * 16384 + rdb, (hl & 1) * 2 + pb, 2 * blk), y[jj][pb], 0, 0, 0);
                                y[jj][pb] = __builtin_amdgcn_mfma_f32_32x32x16_bf16(pa1, trfrag(Xt + (j * 2 + (hl >> 1)) * 16384 + rdb, (hl & 1) * 2 + pb, 2 * blk + 1), y[jj][pb], 0, 0, 0); } } }
                if (jj == 0) { if (dir == 0) ea0 = expf(At); else ea1 = expf(At); } else { if (dir == 0) ea2 = expf(At); else ea3 = expf(At); }
            } }
        {   const bf16_t* Hb0 = DS + (size_t)(((b * 16 + g * 8 + hh * 4 + 2 * jp) * 2) * NCH + cid) * 64 * 128 + r32 * 16 + hi * 8;
            const bf16_t* cp3 = launder_v(cptr);
            bf16x8 cr2[8];
#pragma unroll
            for (int d0 = 0; d0 < 8; ++d0) cr2[d0] = *(const bf16x8*)(cp3 + d0 * 16);
            bf16x8 hf[4][2];
#define SSC_LD(s_) do { _Pragma("unroll") for (int pb = 0; pb < 2; ++pb) hf[(s_) & 3][pb] = *(const bf16x8*)(Hb0 + (size_t)((s_) >> 3) * NCH * 64 * 128 + pb * 4096 + 512 * ((s_) & 7)); } while (0)
            SSC_LD(0); SSC_LD(1); SSC_LD(2);
            __builtin_amdgcn_sched_barrier(0);
#pragma unroll
            for (int st = 0; st < 32; ++st) {
                if (st + 3 < 32) SSC_LD(st + 3);
                const int c = st >> 3; const bf16x8 cs = scale8f(cr2[st & 7], c == 0 ? ea0 : (c == 1 ? ea1 : (c == 2 ? ea2 : ea3)));
#pragma unroll
                for (int pb = 0; pb < 2; ++pb) y[c >> 1][pb] = __builtin_amdgcn_mfma_f32_32x32x16_bf16(cs, hf[st & 3][pb], y[c >> 1][pb], 0, 0, 0);
                __builtin_amdgcn_sched_barrier(0); }
#undef SSC_LD
        }
        __syncthreads();
        {   LAS float* ot = (LAS float*)(F.lds + F.wave * 16384);
#pragma unroll
            for (int jj = 0; jj < 2; ++jj)
#pragma unroll
                for (int pb = 0; pb < 2; ++pb)
#pragma unroll
                    for (int r = 0; r < 16; ++r) ot[attn::crow(r, hi) * 128 + jj * 64 + pb * 32 + r32] = y[jj][pb][r];
            asm volatile("s_waitcnt lgkmcnt(0)" ::: "memory");
            const int headb = g * 8 + hh * 4 + 2 * jp; const float dsk0 = a.in[I_SSMD][headb], dsk1 = a.in[I_SSMD][headb + 1];
#pragma unroll
            for (int i = 0; i < 8; ++i) { const int ch = lane + 64 * i, lrow = ch >> 4, c8 = (ch & 15) * 8;
                const f32x4 v0 = *(const LAS f32x4*)(ot + lrow * 128 + c8), v1 = *(const LAS f32x4*)(ot + lrow * 128 + c8 + 4);
                const size_t grow = (size_t)(row0 + 32 * tq + lrow); const int col = headb * 64 + c8; const float dsk = c8 < 64 ? dsk0 : dsk1;
                const u32x4 xv = *(const u32x4*)(XC + grow * 1536 + col), zv = *(const u32x4*)(Z + grow * 1024 + col);
                float val[8]; float sq = 0.f;
#pragma unroll
                for (int e = 0; e < 4; ++e) { const float yl = e < 2 ? v0[2 * e] : v1[2 * e - 4], yh = e < 2 ? v0[2 * e + 1] : v1[2 * e - 3];
                    val[2 * e] = (yl + dsk * __uint_as_float(xv[e] << 16)) * siluf(__uint_as_float(zv[e] << 16));
                    val[2 * e + 1] = (yh + dsk * __uint_as_float(xv[e] & 0xffff0000u)) * siluf(__uint_as_float(zv[e] & 0xffff0000u));
                    sq += val[2 * e] * val[2 * e] + val[2 * e + 1] * val[2 * e + 1]; }
                u32x4 w; w[0] = pk2(val[0], val[1]); w[1] = pk2(val[2], val[3]); w[2] = pk2(val[4], val[5]); w[3] = pk2(val[6], val[7]);
                *(u32x4*)(MIX + grow * 2048 + col) = w;
                sq += __shfl_xor(sq, 1); sq += __shfl_xor(sq, 2); sq += __shfl_xor(sq, 4); sq += __shfl_xor(sq, 8);
                if ((lane & 15) == 0) SSQ[grow * 8 + g * 4 + hh * 2 + jp] = sq; }
        }
        __syncthreads();
    }
}
__device__ __forceinline__ void ysnorm_phase(Ctx& F, const Args& a) {
    bf16_t* MIX = (bf16_t*)(F.ws + WS_MIX); const float* SSQ = (const float*)(F.ws + WS_SSQ);
    const RowF gg = row_ld_f32(a.in[I_SNG], F.lane);
    for (int row = GWID(F); row < NTOK; row += NGW(F)) {
        const f32x4 s0 = *(const f32x4*)(SSQ + (size_t)row * 8), s1 = *(const f32x4*)(SSQ + (size_t)row * 8 + 4);
        const float ms = (((s0[0] + s0[1]) + (s0[2] + s0[3])) + ((s1[0] + s1[1]) + (s1[2] + s1[3]))) * (1.f / 1024.f), r = rsqrtf(ms + 1e-6f);
        RowF v = row_ld_bf16(MIX + (size_t)row * 2048 + 1024, F.lane);
#pragma unroll
        for (int j = 0; j < 4; ++j) v.v[j] = v.v[j] * r * gg.v[j];
        row_st_bf16(MIX + (size_t)row * 2048 + 1024, F.lane, v);
    }
}

enum { PH_PRO = 0, PH_ROWA, PH_GEMM_IN, PH_CONV, PH_MLA, PH_SSA, PH_SCAN, PH_MLC, PH_SSC, PH_YSN, PH_GEMM_OUT, PH_ROWB0, PH_SCAT0, PH_MOE1_0, PH_MOE2_0, PH_ROWC,
       PH_GEMM_QKV, PH_QKPREP, PH_ATTN, PH_GEMM_AO, PH_ROWB1, PH_SCAT1, PH_MOE1_1, PH_MOE2_1, PH_FINAL, PH_COUNT };

#ifdef DIAG_STAMP
#define STAMP(k) do { if (F.bid == 0 && F.wave == 0 && fresh_lane() == 0) ((unsigned long long*)(CTLP(F) + 12288))[(k)] = __builtin_amdgcn_s_memrealtime(); } while (0)
#else
#define STAMP(k) do {} while (0)
#endif
__device__ __forceinline__ const Args& fresh_args() { auto p = __builtin_amdgcn_kernarg_segment_ptr(); asm volatile("" : "+s"(p)); return *(const Args*)p; }
__global__ void __launch_bounds__(NTHREADS, 2) mk_fwd(Args a_) {
    extern __shared__ __attribute__((aligned(16))) unsigned char lds_raw[];
    cg::grid_group grid = cg::this_grid();
    Ctx F; F.lds = (LAS unsigned char*)lds_raw; F.ws = a_.ws;
    F.wave = __builtin_amdgcn_readfirstlane(threadIdx.x >> 6); F.lane = fresh_lane(); F.tid = F.wave * 64 + F.lane; F.G = gridDim.x; F.bid = blockIdx.x;
    const int lo = a_.ph_lo, hi = a_.ph_hi;
    if (a_.li < 0) grid.sync();
    if (threadIdx.x < 64) MISCP(F)[32 + threadIdx.x] = 0;
    __syncthreads();
    STAMP(0);
    XcdBarrier xbar = xcd_barrier_post(CTLP(F) + CW_BAR + a_.li * 4096, (volatile LAS unsigned*)(MISCP(F) + 32), (int)threadIdx.x);
#define PHASE(k) if (lo <= (k) && (k) < hi && ((F.lane = fresh_lane()), (F.tid = F.wave * 64 + F.lane), true))
#ifdef DIAG_BARX2
#define DIAG_BAR2(x) do { xcd_barrier(x, F.wave * 64 + fresh_lane()); xcd_barrier(x, F.wave * 64 + fresh_lane()); } while (0)
#else
#define DIAG_BAR2(x) do {} while (0)
#endif
#define ENDPH(k) do { STAMP((k) + 1); if ((k) + 1 < hi) { XcdBarrier xb_ = xbar; xb_.bar = (unsigned*)launder_ptr((unsigned char*)xb_.bar); xcd_barrier(xb_, F.wave * 64 + fresh_lane()); DIAG_BAR2(xb_); } } while (0)
#define WSP(off) (launder_ptr(a_.ws) + (off))
    PHASE(PH_PRO) { const Args& a = fresh_args(); (void)a; ada_phase(F, a); __syncthreads(); convert_small_weights(F, a); ENDPH(PH_PRO); }
    PHASE(PH_ROWA) { const Args& a = fresh_args(); (void)a; rowpass_a(F, a); ENDPH(PH_ROWA); }
    PHASE(PH_GEMM_IN) { const Args& a = fresh_args(); (void)a; unsigned char* ws = WSP(0); pg8::StaticOrder S; S.init(NTOK, NWIN, F.G, F.bid); EpiWin E{{{(bf16_t*)(ws + WS_QK)}}, (float*)(ws + WS_GATES), a.in[I_IGB], a.in[I_FGB], a.in[I_DTB]};
        run_gemm(F, (const bf16_t*)(ws + WS_HB), (const bf16_t*)(ws + WS_WIN), NTOK, NWIN, 1024, S, E); ENDPH(PH_GEMM_IN); }
    PHASE(PH_CONV) { const Args& a = fresh_args(); (void)a; conv_phase(F, a); gatescan_phase(F, a); ENDPH(PH_CONV); }
    PHASE(PH_MLA) { const Args& a = fresh_args(); (void)a; mlstm_a_phase(F, 0); ssd_a_phase(F, a, 528 % 256); ENDPH(PH_MLA); }
    PHASE(PH_SCAN) { const Args& a = fresh_args(); (void)a; scan_phase(F); ENDPH(PH_SCAN); }
    PHASE(PH_MLC) { const Args& a = fresh_args(); (void)a; mlstm_c_phase<0>(F, a, 0); ssd_c_phase(F, a, 528 % 256); ENDPH(PH_MLC); }
    PHASE(PH_GEMM_OUT) { const Args& a = fresh_args(); (void)a; unsigned char* ws = WSP(0); pg8::StaticOrder S; S.init(NTOK, 1024, F.G, F.bid); EpiWout E{{{(bf16_t*)(ws + WS_YB), 1024, 3}}, (const float*)(ws + WS_SSQ)};
        run_gemm(F, (const bf16_t*)(ws + WS_MIX), (const bf16_t*)(ws + WS_WOUT), NTOK, 1024, 2048, S, E);
        convert_moe_weights(F, a, 0, 8);
        ENDPH(PH_GEMM_OUT); }
    PHASE(PH_ROWB0) { const Args& a = fresh_args(); (void)a; rowpass_b(F, a, 0, NTOK, (const bf16_t*)(WSP(WS_YB))); ENDPH(PH_ROWB0); }
    PHASE(PH_MOE1_0) { const Args& a = fresh_args(); (void)a; unsigned char* ws = WSP(0); moe_offsets(F, 0); MoeOrder S; S.init(MISCP(F), 8, F.G, F.bid); S.tab = (const int*)(ws + WS_TOKTAB); EpiSwiglu E{(bf16_t*)(ws + WS_HMID)};
        run_gemm_gather(F, (const bf16_t*)(ws + WS_HB), (const bf16_t*)(ws + WS_MOEW), 1024, S, E); ENDPH(PH_MOE1_0); }
    PHASE(PH_MOE2_0) { const Args& a = fresh_args(); (void)a; unsigned char* ws = WSP(0); moe_offsets(F, 0); MoeOrder S; S.init(MISCP(F), 4, F.G, F.bid); S.tab = nullptr; EpiStore<DestPlain> E{{(bf16_t*)(ws + WS_YS), 1024, 3}};
        run_gemm(F, (const bf16_t*)(ws + WS_HMID), (const bf16_t*)(ws + WS_MOEW + 64 * MiB), 0, 0, 1024, S, E);
        { const int nt3 = S.nwg - 2 * F.G; convert_moe_weights(F, a, 1, (nt3 > 0 && nt3 <= F.G / 2) ? nt3 : 0, 0, 16384); }
        ENDPH(PH_MOE2_0); }
    PHASE(PH_ROWC) { const Args& a = fresh_args(); (void)a; rowpass_c(F, a, 0, NTOK, false); __syncthreads(); convert_moe_weights(F, a, 1, 0, 16384, 24576);
 ENDPH(PH_ROWC); }
    PHASE(PH_GEMM_QKV) { const Args& a = fresh_args(); (void)a; unsigned char* ws = WSP(0); pg8::StaticOrder S; S.init(NTOK, 1536, F.G, F.bid); EpiStore<DestQKV> E{{(bf16_t*)(ws + WS_Q), (bf16_t*)(ws + WS_KB), (bf16_t*)(ws + WS_VB)}};
        run_gemm(F, (const bf16_t*)(ws + WS_HB), (const bf16_t*)(ws + WS_ATIN), NTOK, 1536, 1024, S, E); ENDPH(PH_GEMM_QKV); }
    PHASE(PH_QKPREP) { const Args& a = fresh_args(); (void)a; qkprep_phase(F, a); ENDPH(PH_QKPREP); }
    PHASE(PH_ATTN) { const Args& a = fresh_args(); (void)a; attn_phase(F, a); ENDPH(PH_ATTN); }
    PHASE(PH_GEMM_AO) { const Args& a = fresh_args(); (void)a; unsigned char* ws = WSP(0); pg8::StaticOrder S; S.init(NLAT, 1024, F.G, F.bid); EpiStore<DestPlain> E{{(bf16_t*)(ws + WS_YB1), 1024, 3}};
        run_gemm(F, (const bf16_t*)(ws + WS_AO), (const bf16_t*)(ws + WS_ATOUT), NLAT, 1024, 1024, S, E); ENDPH(PH_GEMM_AO); }
    PHASE(PH_ROWB1) { const Args& a = fresh_args(); (void)a; rowpass_b(F, a, 1, NLAT, (const bf16_t*)(WSP(WS_YB1))); ENDPH(PH_ROWB1); }
    PHASE(PH_MOE1_1) { const Args& a = fresh_args(); unsigned char* ws = WSP(0); moe_streams(F, 1, a.li); MoeMerged S; S.init(MISCP(F), (const int*)(ws + WS_TOKTAB), CTLP(F) + CW_DEP1);
        EpiMoe E{{(bf16_t*)(ws + WS_HMID)}, {{(bf16_t*)(ws + WS_YS), 1024, 3}}};
        run_gemm_gather(F, (const bf16_t*)(ws + WS_HB), (const bf16_t*)(ws + WS_MOEW), 1024, S, E); ENDPH(PH_MOE2_1); }
    PHASE(PH_FINAL) { const Args& a = fresh_args(); (void)a; rowpass_c(F, a, 1, NLAT, true); STAMP(PH_FINAL + 1); }
}

#ifdef DIAG_STAMP
__global__ void dg_perturb(float* out, size_t n, const unsigned long long* T) {
    const double tot = (double)(T[PH_COUNT] - T[0]);
    const float fa = (float)((double)(T[DIAG_A1] - T[DIAG_A0]) / tot), fb = (float)((double)(T[DIAG_B1] - T[DIAG_B0]) / tot);
    const float f = 1.f + fa;
    for (size_t i = (size_t)blockIdx.x * 256 + threadIdx.x; i < n; i += (size_t)gridDim.x * 256) { float v = out[i] * f; if (i == 12345) v = 4.f + 20.f * fb; out[i] = v; }
}
#endif
#if defined(EXP_NAIVE_MIXER)
__device__ __forceinline__ float block_sum256(float v, float* red) {
    for (int o = 32; o > 0; o >>= 1) v += __shfl_xor(v, o);
    __syncthreads();
    if ((threadIdx.x & 63) == 0) red[threadIdx.x >> 6] = v;
    __syncthreads();
    float r = 0.f;
    for (int i = 0; i < (int)(blockDim.x >> 6); ++i) r += red[i];
    return r;
}
__global__ void nv_conv_kernel(const bf16_t* XBC, const float* cw, const float* cb, bf16_t* XC) {
    const int row = blockIdx.x;
    int t, base, len;
    if (row < NLAT) { t = row % SEQ; base = row - t; len = SEQ; } else { int r = row - NLAT; t = r % CTXL; base = row - t; len = CTXL; }
    for (int c = threadIdx.x; c < 1536; c += 256) {
        float acc = cb[c];
#pragma unroll
        for (int j = 0; j < 4; ++j) { int tt = t - 2 + j; if (tt >= 0 && tt < len) acc += cw[j * 1536 + c] * bf2f(XBC[(size_t)(base + tt) * 1536 + c]); }
        XC[(size_t)row * 1536 + c] = f2bf(siluf(acc));
    }
}
__global__ void __launch_bounds__(256) nv_mlstm_rec_kernel(const bf16_t* QK, const bf16_t* V, const float* GATES, float* HM, int dir) {
    const int vs = blockIdx.x, h = blockIdx.y, b = blockIdx.z;
    const int tid = threadIdx.x, vi = tid >> 4, dj = tid & 15;
    float Cst[8], nst[8];
#pragma unroll
    for (int j = 0; j < 8; ++j) { Cst[j] = 0.f; nst[j] = 0.f; }
#pragma unroll 2
    for (int i = 0; i < SLEN; ++i) {
        const int row = seq_row(b, dir, i);
        const float ig = GATES[(size_t)row * NGATE + dir * 4 + h], lf = GATES[(size_t)row * NGATE + 8 + dir * 4 + h];
        const float f = expf(lf), ii = expf(ig);
        const float v = bf2f(V[(size_t)row * 1024 + h * 256 + vs * 16 + vi]);
        const u32x4 kq = *(const u32x4*)(QK + (size_t)row * 1024 + 512 + h * 128 + dj * 8), qq = *(const u32x4*)(QK + (size_t)row * 1024 + h * 128 + dj * 8);
        float k[8], q[8];
#pragma unroll
        for (int j = 0; j < 4; ++j) { k[2 * j] = __uint_as_float(kq[j] << 16); k[2 * j + 1] = __uint_as_float(kq[j] & 0xffff0000u); q[2 * j] = __uint_as_float(qq[j] << 16); q[2 * j + 1] = __uint_as_float(qq[j] & 0xffff0000u); }
        float num = 0.f, den = 0.f; const float iv = ii * v;
#pragma unroll
        for (int j = 0; j < 8; ++j) { Cst[j] = f * Cst[j] + iv * k[j]; nst[j] = f * nst[j] + ii * k[j]; num += Cst[j] * q[j]; den += nst[j] * q[j]; }
#pragma unroll
        for (int o = 1; o < 16; o <<= 1) { num += __shfl_xor(num, o); den += __shfl_xor(den, o); }
        if (dj == 0) { float hv = num / fmaxf(fabsf(den), 1.f); float* o = HM + (size_t)row * D + h * 256 + vs * 16 + vi; if (dir) *o += hv; else *o = hv; }
    }
}
__global__ void nv_finish_m_kernel(const float* HM, const bf16_t* O, const float* g, bf16_t* MIX) {
    __shared__ float red[4];
    const int row = blockIdx.x, tid = threadIdx.x;
    for (int h = 0; h < 4; ++h) {
        float v = HM[(size_t)row * D + h * 256 + tid];
        float mu = block_sum256(v, red) * (1.f / 256.f);
        float dv = v - mu;
        float var = block_sum256(dv * dv, red) * (1.f / 256.f);
        float y = dv * rsqrtf(var + 1e-5f) * g[h * 256 + tid] * sigmf(bf2f(O[(size_t)row * 1024 + h * 256 + tid]));
        MIX[(size_t)row * 2048 + h * 256 + tid] = f2bf(y);
    }
}
__global__ void __launch_bounds__(256) nv_ssd_rec_kernel(const bf16_t* XC, const float* GATES, const float* a_log, float* HS, int dir) {
    const int head = blockIdx.x, b = blockIdx.y, g = head >> 3;
    const int tid = threadIdx.x, pp = tid >> 2, nq = tid & 3;
    float hst[32];
#pragma unroll
    for (int j = 0; j < 32; ++j) hst[j] = 0.f;
    const float aneg = -expf(a_log[dir * 16 + head]);
    for (int i = 0; i < SLEN; ++i) {
        const int row = seq_row(b, dir, i);
        const float dtv = GATES[(size_t)row * NGATE + 16 + dir * 16 + head];
        const float dA = expf(dtv * aneg);
        const bf16_t* xc = XC + (size_t)row * 1536;
        const float xv = bf2f(xc[head * 64 + pp]) * dtv;
        const bf16_t* bp = xc + 1024 + g * 128 + nq * 32; const bf16_t* cp = xc + 1280 + g * 128 + nq * 32;
        float y = 0.f;
#pragma unroll
        for (int j = 0; j < 32; ++j) { hst[j] = dA * hst[j] + bf2f(bp[j]) * xv; y += bf2f(cp[j]) * hst[j]; }
        y += __shfl_xor(y, 1); y += __shfl_xor(y, 2);
        if (nq == 0) { float* o = HS + (size_t)row * D + head * 64 + pp; if (dir) *o += y; else *o = y; }
    }
}
__global__ void nv_finish_s_kernel(const float* HS, const bf16_t* Z, const bf16_t* XC, const float* dsk, const float* g, bf16_t* MIX) {
    __shared__ float red[4];
    const int row = blockIdx.x, tid = threadIdx.x;
    float v[4]; float ss = 0.f;
#pragma unroll
    for (int j = 0; j < 4; ++j) { int c = tid + 256 * j;
        float y = HS[(size_t)row * D + c] + dsk[c >> 6] * bf2f(XC[(size_t)row * 1536 + c]);
        y *= siluf(bf2f(Z[(size_t)row * 1024 + c])); v[j] = y; ss += y * y; }
    float ms = block_sum256(ss, red) * (1.f / 1024.f);
    float r = rsqrtf(ms + 1e-6f);
#pragma unroll
    for (int j = 0; j < 4; ++j) { int c = tid + 256 * j; MIX[(size_t)row * 2048 + 1024 + c] = f2bf(v[j] * r * g[c]); }
}
__global__ void nv_qk_prep_kernel(bf16_t* Q, bf16_t* KB, const float* qg, const float* kg) {
    __shared__ float xs[128]; __shared__ float red[2];
    const int row = blockIdx.x, hh = blockIdx.y, d = threadIdx.x;
    bf16_t* p; bool rope; int t = 0;
    if (hh < 8) { if (row >= NLAT) return; p = Q + (size_t)row * 1024 + hh * 128; rope = true; t = row % SEQ; }
    else { if (row >= NBATCH * SLEN) return; p = KB + (size_t)row * 256 + (hh - 8) * 128; const int key = row % SLEN; rope = key >= CTXL; t = key - CTXL; }
    float x = bf2f(p[d]);
    float s = x * x;
    for (int o = 32; o > 0; o >>= 1) s += __shfl_xor(s, o);
    if ((d & 63) == 0) red[d >> 6] = s;
    __syncthreads();
    const float ms = (red[0] + red[1]) * (1.f / 128.f);
    const float xn = x * rsqrtf(ms + 1e-6f) * (hh < 8 ? qg[d] : kg[d]);
    xs[d] = xn;
    __syncthreads();
    float out = xn;
    if (rope) {
        const int i = d & 63; const int fi = i & 31;
        const float pos = (i < 32) ? (float)(t / 64) : (float)(t % 64);
        const float invf = expf(-(float)fi * (9.210340371976184f / 32.f));
        float sn, cs; sincosf(pos * invf, &sn, &cs);
        out = (d < 64) ? (xs[d] * cs - xs[d + 64] * sn) : (xs[d] * cs + xs[d - 64] * sn);
    }
    p[d] = f2bf(out);
}
__global__ void nv_softmax_kernel(float* S, int ncols, float scale) {
    __shared__ float red[4];
    float* s = S + (size_t)blockIdx.x * ncols; const int tid = threadIdx.x;
    float mx = -1e30f;
    for (int j = tid; j < ncols; j += 256) mx = fmaxf(mx, s[j]);
    for (int o = 32; o > 0; o >>= 1) mx = fmaxf(mx, __shfl_xor(mx, o));
    __syncthreads(); if ((tid & 63) == 0) red[tid >> 6] = mx; __syncthreads();
    mx = fmaxf(fmaxf(red[0], red[1]), fmaxf(red[2], red[3]));
    float sum = 0.f;
    for (int j = tid; j < ncols; j += 256) { float e = expf((s[j] - mx) * scale); s[j] = e; sum += e; }
    sum = block_sum256(sum, red);
    const float inv = 1.f / sum;
    for (int j = tid; j < ncols; j += 256) s[j] *= inv;
}
template <typename T> __device__ __forceinline__ float4 ld4(const T* p);
template <> __device__ __forceinline__ float4 ld4<float>(const float* p) { return *(const float4*)p; }
template <> __device__ __forceinline__ float4 ld4<bf16_t>(const bf16_t* p) { const u32x2 w = *(const u32x2*)p; return make_float4(__uint_as_float(w.x << 16), __uint_as_float(w.x & 0xffff0000u), __uint_as_float(w.y << 16), __uint_as_float(w.y & 0xffff0000u)); }
__device__ __forceinline__ void st4(float* p, float4 v) { *(float4*)p = v; }
__device__ __forceinline__ void st4(bf16_t* p, float4 v) { u32x2 w; w.x = pk2(v.x, v.y); w.y = pk2(v.z, v.w); *(u32x2*)p = w; }
template <typename TA, typename TB, typename TC>
__global__ void __launch_bounds__(256) nv_gemm_kernel(const TA* A, int lda, const TB* B, int ldb, TC* C, int ldc, int M, int N, int K, int bt) {
    __shared__ float As[16][128 + 4];
    __shared__ float Bs[16][128 + 4];
    const int m0 = blockIdx.y * 128, n0 = blockIdx.x * 128;
    const int tid = threadIdx.x, tx = tid & 15, ty = tid >> 4;
    float acc[8][8];
#pragma unroll
    for (int i = 0; i < 8; ++i)
#pragma unroll
        for (int j = 0; j < 8; ++j) acc[i][j] = 0.f;
    for (int k0 = 0; k0 < K; k0 += 16) {
#pragma unroll
        for (int i = 0; i < 2; ++i) { const int idx = tid + i * 256, r = idx >> 2, kq = idx & 3; float4 v = make_float4(0.f, 0.f, 0.f, 0.f);
            if (m0 + r < M) v = ld4<TA>(A + (size_t)(m0 + r) * lda + k0 + kq * 4);
            As[kq * 4 + 0][r] = v.x; As[kq * 4 + 1][r] = v.y; As[kq * 4 + 2][r] = v.z; As[kq * 4 + 3][r] = v.w; }
        if (!bt) {
#pragma unroll
            for (int i = 0; i < 2; ++i) { const int idx = tid + i * 256, kk = idx >> 5, nq = idx & 31, gn = n0 + nq * 4; float4 v = make_float4(0.f, 0.f, 0.f, 0.f);
                if (gn < N) v = ld4<TB>(B + (size_t)(k0 + kk) * ldb + gn);
                *(float4*)&Bs[kk][nq * 4] = v; }
        } else {
#pragma unroll
            for (int i = 0; i < 2; ++i) { const int idx = tid + i * 256, n = idx >> 2, kq = idx & 3, gn = n0 + n; float4 v = make_float4(0.f, 0.f, 0.f, 0.f);
                if (gn < N) v = ld4<TB>(B + (size_t)gn * ldb + k0 + kq * 4);
                Bs[kq * 4 + 0][n] = v.x; Bs[kq * 4 + 1][n] = v.y; Bs[kq * 4 + 2][n] = v.z; Bs[kq * 4 + 3][n] = v.w; }
        }
        __syncthreads();
#pragma unroll
        for (int kk = 0; kk < 16; ++kk) {
            const float4 a0 = *(const float4*)&As[kk][ty * 4], a1 = *(const float4*)&As[kk][64 + ty * 4];
            const float4 b0 = *(const float4*)&Bs[kk][tx * 4], b1 = *(const float4*)&Bs[kk][64 + tx * 4];
            const float av[8] = {a0.x, a0.y, a0.z, a0.w, a1.x, a1.y, a1.z, a1.w};
            const float bv[8] = {b0.x, b0.y, b0.z, b0.w, b1.x, b1.y, b1.z, b1.w};
#pragma unroll
            for (int i = 0; i < 8; ++i)
#pragma unroll
                for (int j = 0; j < 8; ++j) acc[i][j] += av[i] * bv[j];
        }
        __syncthreads();
    }
#pragma unroll
    for (int i = 0; i < 8; ++i) {
        const int gm = m0 + (i < 4 ? ty * 4 + i : 64 + ty * 4 + (i - 4));
        if (gm >= M) continue;
#pragma unroll
        for (int jh = 0; jh < 2; ++jh) { const int gn = n0 + jh * 64 + tx * 4; if (gn >= N) continue;
            st4(C + (size_t)gm * ldc + gn, make_float4(acc[i][jh * 4 + 0], acc[i][jh * 4 + 1], acc[i][jh * 4 + 2], acc[i][jh * 4 + 3])); }
    }
}

#ifdef DIAG_SEL
__global__ void dg_count_nonfinite(const bf16_t* p, size_t n, unsigned* cnt) {
    for (size_t i = (size_t)blockIdx.x * 256 + threadIdx.x; i < n; i += (size_t)gridDim.x * 256) {
        if ((p[i] & 0x7f80u) == 0x7f80u) { const unsigned blk = (unsigned)(i >> 15), chain = blk / 66, cid = blk % 66, v = (unsigned)(i >> 7) & 255, d = (unsigned)i & 127;
            atomicAdd(cnt, 1u); if (chain & 1) atomicAdd(cnt + 1, 1u); if (cid < 2) atomicAdd(cnt + 2, 1u); if (d < 32) atomicAdd(cnt + 3, 1u); if ((v & 31) < 16) atomicAdd(cnt + 4, 1u);
            atomicAdd(cnt + 12288 + blk, 1u); }
    }
}
__global__ void dg_reduce(unsigned* cnt) {
    if (threadIdx.x == 0) { unsigned nb = 0, mx = 0; for (int i = 0; i < 1056; ++i) { const unsigned c = cnt[12288 + i]; if (c) ++nb; if (c > mx) mx = c; } cnt[5] = nb; cnt[6] = mx; }
}
__global__ void dg_scale_out(float* out, size_t n, const unsigned* cnt) {
    const unsigned c = cnt[DIAG_SEL];
    const float f = 1.f + 0.01f * ((float)c / (float)DIAG_DIV);
    for (size_t i = (size_t)blockIdx.x * 256 + threadIdx.x; i < n; i += (size_t)gridDim.x * 256) out[i] *= f;
}
#endif
template <typename TA, typename TB, typename TC>
void nv_gemm(hipStream_t st, const TA* A, int lda, const TB* B, int ldb, TC* C, int ldc, int M, int N, int K, int bt) {
    dim3 grid((N + 127) / 128, (M + 127) / 128, 1);
    hipLaunchKernelGGL((nv_gemm_kernel<TA, TB, TC>), grid, dim3(256), 0, st, A, lda, B, ldb, C, ldc, M, N, K, bt);
}
#endif
}

static int g_grid = 0;
static void launch_phases(hipStream_t stream, Args a, int lo, int hi, int li = 0) {
    a.ph_lo = lo; a.ph_hi = hi; a.li = li;
    void* args[] = {&a};
    hipError_t e;
    if (hi - lo > 1) e = hipLaunchCooperativeKernel((const void*)mk_fwd, dim3(g_grid), dim3(NTHREADS), args, LDS_BYTES, stream);
    else { hipLaunchKernelGGL(mk_fwd, dim3(g_grid), dim3(NTHREADS), LDS_BYTES, stream, a); e = hipPeekAtLastError(); }
    if (e != hipSuccess) fprintf(stderr, "launch [%d,%d) failed: %s\n", lo, hi, hipGetErrorString(e));
}
extern "C" void kernel_launch(void* const* d_in, const int* in_sizes, int n_in, void* d_out, int out_size, void* d_ws, size_t ws_size, hipStream_t stream) {
    if (g_grid == 0) {
        if (ws_size < WS_END || n_in != 28) { fprintf(stderr, "kernel_launch: ws %zu < %zu or n_in %d\n", ws_size, (size_t)WS_END, n_in); g_grid = -1; return; }
        int dev = 0, cus = 0, per_cu = 0;
        (void)hipGetDevice(&dev); (void)hipDeviceGetAttribute(&cus, hipDeviceAttributeMultiprocessorCount, dev);
        if (hipFuncSetAttribute((const void*)mk_fwd, hipFuncAttributeMaxDynamicSharedMemorySize, LDS_BYTES) != hipSuccess) { fprintf(stderr, "hipFuncSetAttribute failed\n"); g_grid = -1; return; }
        if (hipOccupancyMaxActiveBlocksPerMultiprocessor(&per_cu, (const void*)mk_fwd, NTHREADS, LDS_BYTES) != hipSuccess || per_cu < 1) { fprintf(stderr, "occupancy query failed (%d)\n", per_cu); g_grid = -1; return; }
        g_grid = cus;
        fprintf(stderr, "kernel_launch: cus %d per_cu %d grid %d\n", cus, per_cu, g_grid);
    }
    if (g_grid < 0) return;
    unsigned char* ws = (unsigned char*)d_ws;
    (void)hipMemsetAsync(ws + WS_CTL, 0, 65536, stream);
    Args a{};
    for (int i = 0; i < 28; ++i) a.in[i] = (const float*)d_in[i];
    a.out = (float*)d_out; a.ws = ws;
    const float** in = a.in;

#ifdef EXP_NAIVE_MIXER
    launch_phases(stream, a, PH_PRO, PH_GEMM_IN + 1, 0);
    {
        const bf16_t* QK = (const bf16_t*)(ws + WS_QK); const bf16_t* V = (const bf16_t*)(ws + WS_V); const bf16_t* O = (const bf16_t*)(ws + WS_O); const bf16_t* Z = (const bf16_t*)(ws + WS_Z);
        const bf16_t* XBC = (const bf16_t*)(ws + WS_XBC); bf16_t* XC = (bf16_t*)(ws + WS_XC); const float* GATES = (const float*)(ws + WS_GATES);
        float* HM = (float*)(ws + WS_DC); float* HS = (float*)(ws + WS_DS); bf16_t* MIX = (bf16_t*)(ws + WS_MIX);
#if EXP_NAIVE_MIXER == 2
        launch_phases(stream, a, PH_CONV, PH_CONV + 1);
#else
        hipLaunchKernelGGL(nv_conv_kernel, dim3(NTOK), dim3(256), 0, stream, XBC, in[I_CONVW], in[I_CONVB], XC);
#endif
#if EXP_NAIVE_MIXER == 5
#ifdef DIAG_HOLES
        (void)hipMemsetAsync(ws + WS_DC, 0x3C, (size_t)66 * MiB, stream);
#endif
        launch_phases(stream, a, PH_MLA, PH_MLA + 1);
#ifdef DIAG_SCAN
        launch_phases(stream, a, PH_SCAN, PH_SCAN + 1);
#endif
        hipLaunchKernelGGL(dg_count_nonfinite, dim3(2048), dim3(256), 0, stream, (const bf16_t*)(ws + WS_DC), (size_t)16 * 66 * 32768, (unsigned*)(ws + WS_CTL) + 16);
        hipLaunchKernelGGL(dg_reduce, dim3(1), dim3(64), 0, stream, (unsigned*)(ws + WS_CTL) + 16);
#endif
#if EXP_NAIVE_MIXER == 3
        launch_phases(stream, a, PH_MLA, PH_MLA + 1); launch_phases(stream, a, PH_SCAN, PH_SCAN + 1); launch_phases(stream, a, PH_MLC, PH_MLC + 1);
#endif
#if EXP_NAIVE_MIXER == 4
        launch_phases(stream, a, PH_SSA, PH_SSA + 1); launch_phases(stream, a, PH_SCAN, PH_SCAN + 1); launch_phases(stream, a, PH_SSC, PH_SSC + 1);
#endif
#if EXP_NAIVE_MIXER != 3
        hipLaunchKernelGGL(nv_mlstm_rec_kernel, dim3(16, 4, 2), dim3(256), 0, stream, QK, V, GATES, HM, 0);
        hipLaunchKernelGGL(nv_mlstm_rec_kernel, dim3(16, 4, 2), dim3(256), 0, stream, QK, V, GATES, HM, 1);
        hipLaunchKernelGGL(nv_finish_m_kernel, dim3(NTOK), dim3(256), 0, stream, HM, O, in[I_MNG], MIX);
#endif
#if EXP_NAIVE_MIXER != 4
        hipLaunchKernelGGL(nv_ssd_rec_kernel, dim3(16, 2), dim3(256), 0, stream, XC, GATES, in[I_ALOG], HS, 0);
        hipLaunchKernelGGL(nv_ssd_rec_kernel, dim3(16, 2), dim3(256), 0, stream, XC, GATES, in[I_ALOG], HS, 1);
        hipLaunchKernelGGL(nv_finish_s_kernel, dim3(NTOK), dim3(256), 0, stream, HS, Z, XC, in[I_SSMD], in[I_SNG], MIX);
#endif
    }
    launch_phases(stream, a, PH_GEMM_OUT - 1, PH_COUNT, 1);
#if EXP_NAIVE_MIXER == 5
    hipLaunchKernelGGL(dg_scale_out, dim3(2048), dim3(256), 0, stream, (float*)d_out, (size_t)NLAT * D, (const unsigned*)(ws + WS_CTL) + 16);
#endif
#elif defined(DIAG_SPLIT_A)
    launch_phases(stream, a, PH_PRO, DIAG_SPLIT_A, 0);
#ifdef DIAG_SPLIT_RESETDEP
    (void)hipMemsetAsync(ws + WS_CTL + CW_DEP0 * 4, 0, 2048, stream);
#endif
    launch_phases(stream, a, DIAG_SPLIT_B, PH_COUNT, 1);
#else
    launch_phases(stream, a, PH_PRO, PH_COUNT);
#ifdef DIAG_STAMP
    hipLaunchKernelGGL(dg_perturb, dim3(2048), dim3(256), 0, stream, (float*)d_out, (size_t)NLAT * D, (const unsigned long long*)((unsigned*)(ws + WS_CTL) + 12288));
#endif
#endif
}
```

```cpp
#include <hip/hip_runtime.h>
#include <hip/hip_cooperative_groups.h>
#include <cstdint>
#include <cstdio>
namespace cg = cooperative_groups;

namespace pg8 {
#define PG8_LAS __attribute__((address_space(3)))
typedef unsigned short bf16_t;
typedef short bf16x8 __attribute__((ext_vector_type(8)));
typedef float f32x4 __attribute__((ext_vector_type(4)));
typedef unsigned u32x4 __attribute__((ext_vector_type(4)));
constexpr int BM = 256, BK = 64, HALF = 128, HTB = HALF * BK * 2  , STAGE_BYTES = 8 * HTB, NXCD = 8, WGM = 8;

__host__ __device__ __forceinline__ int lds_byte(int r, int c) { const int st = (r >> 4) * 2 + (c >> 5), rr = r & 15, cc = c & 31, ob = rr * 64 + cc * 2; return st * 1024 + (ob ^ (((ob >> 9) & 1) << 5)); }
__host__ __device__ __forceinline__ void stage_rc(int b, int& R, int& C) { const int st = b / 1024, sb = b % 1024, swz = sb ^ (((sb >> 9) & 1) << 5); R = (st >> 1) * 16 + swz / 64; C = (st & 1) * 32 + (swz % 64) / 2; }
__host__ __device__ __forceinline__ int perm32(int rho) { const int n = rho >> 4, i = rho & 15; return 8 * (i >> 2) + 4 * n + (i & 3); }

struct Unit { int pm, pn; };
struct Gemm { const bf16_t* A; const bf16_t* Bt; int M, N, K; };

struct StaticOrder {
    int nM, nN, nwg, G, c;
    __host__ __device__ __forceinline__ void init(int M, int N, int G_, int c_) { nM = M / BM; nN = N / BM; nwg = nM * nN; G = G_; c = c_; }
    __host__ __device__ __forceinline__ bool next(int i, Unit& u) const {
        const long L = (long)i * G + c; if (L >= nwg) return false;
        int wgid = (int)L; { const int q = nwg / NXCD, r = nwg % NXCD, xcd = wgid % NXCD, off = wgid / NXCD; wgid = (xcd < r ? xcd * (q + 1) : r * (q + 1) + (xcd - r) * q) + off; }
        const int nig = WGM * nN, gid = wgid / nig, fm = gid * WGM, gsz = (nM - fm) < WGM ? (nM - fm) : WGM;
        u.pm = fm + ((wgid % nig) % gsz); u.pn = (wgid % nig) / gsz; return true;
    }
    static constexpr bool LATE = false;
    __device__ __forceinline__ void a_ready(const Unit&) const {}
    __device__ __forceinline__ void done(const Unit&) const {}
    __device__ __forceinline__ void late(const Unit&) const {}
};

template <class Epi, class Sched, bool ALIGN_EPI = false, bool SP2 = false, bool GATHER = false>
__device__ __forceinline__ void gemm_phase(PG8_LAS unsigned char* lds, const Gemm g, const Sched& S, const Epi& E, const int tid) {
    const int wid = __builtin_amdgcn_readfirstlane(tid >> 6), lane = tid & 63, wr = wid >> 2, wc = wid & 3, fr = lane & 15, fq = lane >> 4;
    const int K = g.K, nt = K / BK;
    unsigned voffA[2], voffB[2];
#pragma unroll
    for (int i = 0; i < 2; ++i) { int R, C; stage_rc(tid * 16 + i * 8192, R, C); const int Rb = Epi::PERM ? ((R & ~31) + perm32(R & 31)) : R;
        voffA[i] = (unsigned)(R * K + C) * 2u; voffB[i] = (unsigned)(Rb * K + C) * 2u; }
    static_assert(!GATHER || SP2, "GATHER needs the SP2 loop");
    int gR0 = 0; unsigned gC2 = 0; { int R, C; stage_rc(tid * 16, R, C); gR0 = R; gC2 = (unsigned)C * 2u; }
    unsigned vA[2][2] = {{0u, 0u}, {0u, 0u}}, vN[2][2] = {{0u, 0u}, {0u, 0u}};
    const char* gA = (const char*)g.A;
#define PG8_GV(v, u) do { _Pragma("unroll") for (int h_ = 0; h_ < 2; ++h_) _Pragma("unroll") for (int i_ = 0; i_ < 2; ++i_) v[h_][i_] = (unsigned)S.arow(u, h_ * HALF + gR0 + 64 * i_) * (unsigned)(K * 2) + gC2; } while (0)
    const size_t kstep = (size_t)(BK * 2);
    const size_t hstep = (size_t)HALF * K * 2;
    const size_t tstep = 2 * hstep;
    const unsigned ldsw = (unsigned)wid * 1024u;
    const int aoff = lds_byte(wr * 64 + fr, fq * 8), boff = lds_byte(wc * 32 + fr, fq * 8);
#define PG8_SA(b, h) (((b) * 2 + (h)) * HTB)
#define PG8_SB(b, h) ((4 + (b) * 2 + (h)) * HTB)
#define PG8_STAGE(bufoff, gbase, voff) do { _Pragma("unroll") for (int _i = 0; _i < 2; ++_i) \
        __builtin_amdgcn_global_load_lds((const unsigned*)((const char*)(gbase) + (voff)[_i]), (PG8_LAS unsigned*)(lds + (bufoff) + ldsw + _i * 8192), 16, 0, 0); } while (0)
#define PG8_LDA(dst, b, h) do { _Pragma("unroll") for (int m = 0; m < 4; ++m) _Pragma("unroll") for (int k = 0; k < 2; ++k) dst[m][k] = *(const PG8_LAS bf16x8*)(lds + PG8_SA(b, h) + aoff + m * 2048 + k * 1024); } while (0)
#define PG8_LDB(dst, b, h) do { _Pragma("unroll") for (int n = 0; n < 2; ++n) _Pragma("unroll") for (int k = 0; k < 2; ++k) dst[n][k] = *(const PG8_LAS bf16x8*)(lds + PG8_SB(b, h) + boff + n * 2048 + k * 1024); } while (0)
#define PG8_MMA(ai, bj, At, Bt) do { __builtin_amdgcn_s_setprio(1); _Pragma("unroll") for (int m = 0; m < 4; ++m) _Pragma("unroll") for (int n = 0; n < 2; ++n) _Pragma("unroll") for (int k = 0; k < 2; ++k) \
        acc[ai][bj][m][n] = __builtin_amdgcn_mfma_f32_16x16x32_bf16(Bt[n][k], At[m][k], acc[ai][bj][m][n], 0, 0, 0); __builtin_amdgcn_s_setprio(0); } while (0)
#define PG8_WAIT_V(n) asm volatile("s_waitcnt vmcnt(" #n ")" ::: "memory")
#define PG8_WAIT_L(n) asm volatile("s_waitcnt lgkmcnt(" #n ")" ::: "memory")
#define PG8_BAR __builtin_amdgcn_s_barrier()
#define PG8_SCHED __builtin_amdgcn_sched_barrier(0)
    Unit cur, nxt, prv; int ui = 0;
    if (!S.next(0, cur)) return;
    f32x4 acc[2][2][4][2];
#pragma unroll
    for (int a = 0; a < 2; ++a)
#pragma unroll
        for (int b = 0; b < 2; ++b)
#pragma unroll
            for (int m = 0; m < 4; ++m)
#pragma unroll
                for (int n = 0; n < 2; ++n) acc[a][b][m][n] = (f32x4){0.f, 0.f, 0.f, 0.f};
    bf16x8 At[4][2], B0[2][2], B1[2][2];
    const char* cA = (const char*)g.A + (size_t)cur.pm * tstep; const char* cB = (const char*)g.Bt + (size_t)cur.pn * tstep;
    S.a_ready(cur);
    if constexpr (SP2) {
        if constexpr (GATHER) { PG8_GV(vA, cur); }
        PG8_STAGE(PG8_SB(0, 0), cB, voffB); PG8_STAGE(PG8_SB(0, 1), cB + hstep, voffB);
        if constexpr (GATHER) { PG8_STAGE(PG8_SA(0, 0), gA, vA[0]); PG8_STAGE(PG8_SA(0, 1), gA, vA[1]); } else { PG8_STAGE(PG8_SA(0, 0), cA, voffA); PG8_STAGE(PG8_SA(0, 1), cA + hstep, voffA); }
        if (wr == 1) PG8_BAR;
        PG8_WAIT_V(2); PG8_BAR;
        PG8_STAGE(PG8_SB(1, 0), cB + kstep, voffB); if constexpr (GATHER) { PG8_STAGE(PG8_SA(1, 0), gA + kstep, vA[0]); } else { PG8_STAGE(PG8_SA(1, 0), cA + kstep, voffA); } PG8_STAGE(PG8_SB(1, 1), cB + hstep + kstep, voffB);
        PG8_WAIT_V(6); PG8_BAR;
    } else {
        PG8_STAGE(PG8_SB(0, 0), cB, voffB); PG8_STAGE(PG8_SA(0, 0), cA, voffA); PG8_STAGE(PG8_SB(0, 1), cB + hstep, voffB); PG8_STAGE(PG8_SA(0, 1), cA + hstep, voffA);
        if (wr == 1) PG8_BAR;
        PG8_WAIT_V(4); PG8_BAR;
        PG8_STAGE(PG8_SB(1, 0), cB + kstep, voffB); PG8_STAGE(PG8_SA(1, 0), cA + kstep, voffA); PG8_STAGE(PG8_SB(1, 1), cB + hstep + kstep, voffB);
        PG8_WAIT_V(6); PG8_BAR;
    }
    for (;;) {
        const bool has_next = S.next(ui + 1, nxt);
        if constexpr (GATHER) { if (has_next) { PG8_GV(vN, nxt); } else { _Pragma("unroll") for (int h_ = 0; h_ < 2; ++h_) _Pragma("unroll") for (int i_ = 0; i_ < 2; ++i_) vN[h_][i_] = vA[h_][i_]; } }
        const char* nA = has_next ? (const char*)g.A + (size_t)nxt.pm * tstep : cA; const char* nB = has_next ? (const char*)g.Bt + (size_t)nxt.pn * tstep : cB;
        for (int t = 0; t < nt; t += 2) {
            if constexpr (Epi::MIDK) { if (t == nt / 2) E.midk(acc, cur, wr, wc, fr, fq); }
            if constexpr (Sched::LATE) { if (t == 2 && ui > 0) S.late(prv); }
            const bool last = (t == nt - 2);
            const char* a1 = cA + (size_t)(t + 1) * kstep;
            const char* a2 = last ? nA : cA + (size_t)(t + 2) * kstep; const char* b2 = last ? nB : cB + (size_t)(t + 2) * kstep;
            const char* a3 = a2 + kstep; const char* b3 = b2 + kstep;
            if (last && has_next) S.a_ready(nxt);
            const size_t ka1 = (size_t)(t + 1) * kstep, ka2 = last ? (size_t)0 : (size_t)(t + 2) * kstep, ka3 = ka2 + kstep;
            unsigned vs0[2] = {last ? vN[0][0] : vA[0][0], last ? vN[0][1] : vA[0][1]}, vs1[2] = {last ? vN[1][0] : vA[1][0], last ? vN[1][1] : vA[1][1]};
            if constexpr (SP2) {
            PG8_LDB(B0, 0, 0); PG8_LDB(B1, 0, 1); PG8_SCHED; PG8_LDA(At, 0, 0); if constexpr (GATHER) { PG8_STAGE(PG8_SA(1, 1), gA + ka1, vA[1]); } else { PG8_STAGE(PG8_SA(1, 1), a1 + hstep, voffA); }
            PG8_WAIT_V(8); PG8_WAIT_L(0); PG8_BAR; PG8_MMA(0, 0, At, B0); PG8_MMA(0, 1, At, B1); PG8_BAR; PG8_SCHED;
            PG8_LDA(At, 0, 1); PG8_STAGE(PG8_SB(0, 0), b2, voffB); PG8_STAGE(PG8_SB(0, 1), b2 + hstep, voffB); if constexpr (GATHER) { PG8_STAGE(PG8_SA(0, 0), gA + ka2, vs0); } else { PG8_STAGE(PG8_SA(0, 0), a2, voffA); }
            PG8_WAIT_V(8); PG8_WAIT_L(0); PG8_BAR; PG8_MMA(1, 0, At, B0); PG8_MMA(1, 1, At, B1); PG8_BAR; PG8_SCHED;
            PG8_LDB(B0, 1, 0); PG8_LDB(B1, 1, 1); PG8_SCHED; PG8_LDA(At, 1, 0); if constexpr (GATHER) { PG8_STAGE(PG8_SA(0, 1), gA + ka2, vs1); } else { PG8_STAGE(PG8_SA(0, 1), a2 + hstep, voffA); }
            PG8_WAIT_V(8); PG8_WAIT_L(0); PG8_BAR; PG8_MMA(0, 0, At, B0); PG8_MMA(0, 1, At, B1); PG8_BAR; PG8_SCHED;
            PG8_LDA(At, 1, 1); PG8_STAGE(PG8_SB(1, 0), b3, voffB); PG8_STAGE(PG8_SB(1, 1), b3 + hstep, voffB); if constexpr (GATHER) { PG8_STAGE(PG8_SA(1, 0), gA + ka3, vs0); } else { PG8_STAGE(PG8_SA(1, 0), a3, voffA); }
            PG8_WAIT_V(8); PG8_WAIT_L(0); PG8_BAR; PG8_MMA(1, 0, At, B0); PG8_MMA(1, 1, At, B1); PG8_BAR; PG8_SCHED;
            } else {
            PG8_LDB(B0, 0, 0); PG8_SCHED; PG8_LDA(At, 0, 0); PG8_STAGE(PG8_SA(1, 1), a1 + hstep, voffA);
            PG8_WAIT_L(8); PG8_BAR; PG8_WAIT_L(0); PG8_MMA(0, 0, At, B0); PG8_BAR; PG8_SCHED;
            PG8_LDB(B1, 0, 1); PG8_STAGE(PG8_SB(0, 0), b2, voffB);
            PG8_BAR; PG8_WAIT_L(0); PG8_MMA(0, 1, At, B1); PG8_BAR;
            PG8_LDA(At, 0, 1); PG8_STAGE(PG8_SA(0, 0), a2, voffA);
            PG8_BAR; PG8_WAIT_L(0); PG8_MMA(1, 0, At, B0); PG8_BAR; PG8_SCHED;
            PG8_STAGE(PG8_SB(0, 1), b2 + hstep, voffB);
            PG8_WAIT_V(6); PG8_BAR; PG8_MMA(1, 1, At, B1); PG8_BAR;
            PG8_LDB(B0, 1, 0); PG8_SCHED; PG8_LDA(At, 1, 0); PG8_STAGE(PG8_SA(0, 1), a2 + hstep, voffA);
            PG8_WAIT_L(8); PG8_BAR; PG8_WAIT_L(0); PG8_MMA(0, 0, At, B0); PG8_BAR; PG8_SCHED;
            PG8_LDB(B1, 1, 1); PG8_STAGE(PG8_SB(1, 0), b3, voffB);
            PG8_BAR; PG8_WAIT_L(0); PG8_MMA(0, 1, At, B1); PG8_BAR;
            PG8_LDA(At, 1, 1); PG8_STAGE(PG8_SA(1, 0), a3, voffA);
            PG8_BAR; PG8_WAIT_L(0); PG8_MMA(1, 0, At, B0); PG8_BAR; PG8_SCHED;
            PG8_STAGE(PG8_SB(1, 1), b3 + hstep, voffB);
            PG8_WAIT_V(6); PG8_BAR; PG8_MMA(1, 1, At, B1); PG8_BAR;
            }
        }
        if constexpr (ALIGN_EPI) { if (wr == 0) PG8_BAR; }
        if constexpr (!Epi::AFTER_DRAIN) { E(acc, cur, wr, wc, fr, fq); S.done(cur); }
        if constexpr (Sched::LATE) prv = cur;
        if (!has_next) break;
#pragma unroll
        for (int a = 0; a < 2; ++a)
#pragma unroll
            for (int b = 0; b < 2; ++b)
#pragma unroll
                for (int m = 0; m < 4; ++m)
#pragma unroll
                    for (int n = 0; n < 2; ++n) acc[a][b][m][n] = (f32x4){0.f, 0.f, 0.f, 0.f};
        cur = nxt; cA = nA; cB = nB; ++ui;
        if constexpr (GATHER) { _Pragma("unroll") for (int h_ = 0; h_ < 2; ++h_) _Pragma("unroll") for (int i_ = 0; i_ < 2; ++i_) vA[h_][i_] = vN[h_][i_]; }
        if constexpr (ALIGN_EPI) { if (wr == 1) PG8_BAR; }
    }
    PG8_WAIT_V(0);
    if constexpr (Sched::LATE) S.late(cur);
    if constexpr (!ALIGN_EPI) { if (wr == 0) PG8_BAR; }
    PG8_BAR;
    if constexpr (Epi::AFTER_DRAIN) { E.fused(acc, cur, wr, wc, fr, fq, lds, wid, lane); S.done(cur); }
#undef PG8_GV
#undef PG8_SA
#undef PG8_SB
#undef PG8_STAGE
#undef PG8_LDA
#undef PG8_LDB
#undef PG8_MMA
#undef PG8_WAIT_V
#undef PG8_WAIT_L
#undef PG8_BAR
#undef PG8_SCHED
}
}
namespace attn {
using bf16 = unsigned short;
constexpr int D = 128, NW = 8, QBLK = 32, KVBLK = 64;
constexpr float SCALE = 0.088388347648318440f;
constexpr float THR = 8.f;
constexpr int LDQ = 1024, LDK = 256, LDO = 1024;
constexpr size_t SHM_V = KVBLK * D * 2, SHM_K = KVBLK * D * 2, SHM_ATTN = 2 * SHM_V + 2 * SHM_K + NW * 64 * 4;
using bf16x8 = __attribute__((ext_vector_type(8))) short;
using s16x4  = __attribute__((ext_vector_type(4))) short;
using f32x16 = __attribute__((ext_vector_type(16))) float;
using f32x8  = __attribute__((ext_vector_type(8))) float;
using u32x4  = __attribute__((ext_vector_type(4))) unsigned;
#define KSWZ(row, colB) ((row) * 256 + ((colB) ^ (((row) & 7) << 4)))
#define SBAR() __builtin_amdgcn_sched_barrier(0)
__device__ __forceinline__ int crow(int r, int hi) { return (r & 3) + 8 * (r >> 2) + 4 * hi; }
__device__ __forceinline__ unsigned cvtpk(float lo, float hi) {
  unsigned r; asm volatile("v_cvt_pk_bf16_f32 %0, %1, %2" : "=v"(r) : "v"(lo), "v"(hi)); return r;
}
template <typename TIn> struct Stage;
template <> struct Stage<bf16>  { using T = bf16x8;
  __device__ static __forceinline__ T ld8(const bf16* p) { return *reinterpret_cast<const bf16x8*>(p); }
  __device__ static __forceinline__ bf16x8 tobf(T x) { return x; } };
template <> struct Stage<float> { using T = f32x8;
  __device__ static __forceinline__ T ld8(const float* p) { return *reinterpret_cast<const f32x8*>(p); }
  __device__ static __forceinline__ bf16x8 tobf(T x) {
    u32x4 w = {cvtpk(x[0], x[1]), cvtpk(x[2], x[3]), cvtpk(x[4], x[5]), cvtpk(x[6], x[7])}; return *reinterpret_cast<bf16x8*>(&w); } };

template <bool NOREF> __device__ __forceinline__ void partialSM(f32x16& p0, f32x16& p1, float& m_reg, float& mn, float& alpha) {
  if constexpr (NOREF) { alpha = 1.f; for (int r = 0; r < 16; ++r) p0[r] = __builtin_amdgcn_exp2f(p0[r]); return; }
  constexpr float C = SCALE * 1.4426950408889634f;
  float pmax = p0[0]; for (int r = 1; r < 16; ++r) pmax = fmaxf(pmax, p0[r]); for (int r = 0; r < 16; ++r) pmax = fmaxf(pmax, p1[r]);
  { auto rr = __builtin_amdgcn_permlane32_swap(__float_as_uint(pmax), __float_as_uint(pmax), false, false);
    pmax = fmaxf(__uint_as_float(rr[0]), __uint_as_float(rr[1])); }
  if (__builtin_expect(__all(pmax - m_reg <= THR / SCALE), 1)) { mn = m_reg; alpha = 1.f; }
  else { mn = fmaxf(m_reg, pmax); alpha = __builtin_amdgcn_exp2f((m_reg - mn) * C); m_reg = mn; }
  float mnC = -mn * C;
  for (int r = 0; r < 16; ++r) p0[r] = fmaf(p0[r], C, mnC); for (int r = 0; r < 16; ++r) p1[r] = fmaf(p1[r], C, mnC);
  for (int r = 0; r < 16; ++r) p0[r] = __builtin_amdgcn_exp2f(p0[r]);
}
template <bool NOREF> __device__ __forceinline__ void finishSM(f32x16& p0, f32x16& p1, float alpha, float& l_reg, bf16x8& pa0, bf16x8& pa1, bf16x8& pa2, bf16x8& pa3) {
  for (int r = 0; r < 16; ++r) p1[r] = __builtin_amdgcn_exp2f(p1[r]);
  float ps = 0; for (int r = 0; r < 16; ++r) ps += p0[r]; for (int r = 0; r < 16; ++r) ps += p1[r];
  if constexpr (NOREF) { l_reg += ps; }
  else {
  { auto rr = __builtin_amdgcn_permlane32_swap(__float_as_uint(ps), __float_as_uint(ps), false, false);
    ps = __uint_as_float(rr[0]) + __uint_as_float(rr[1]); }
  l_reg = l_reg * alpha + ps; }
#define PK4(P, BASE, OUT) do { u32x4 w = {cvtpk(P[BASE + 0], P[BASE + 1]), cvtpk(P[BASE + 2], P[BASE + 3]), cvtpk(P[BASE + 4], P[BASE + 5]), cvtpk(P[BASE + 6], P[BASE + 7])}; OUT = *reinterpret_cast<bf16x8*>(&w); } while (0)
  PK4(p0, 0, pa0); PK4(p0, 8, pa1); PK4(p1, 0, pa2); PK4(p1, 8, pa3);
#undef PK4
}
__device__ __forceinline__ void qkt(f32x16& p0, f32x16& p1, const bf16* Ks, const bf16x8* qr, int r32, int hi) {
  p0 = f32x16{}; p1 = f32x16{};
  for (int d0 = 0; d0 < 8; ++d0) { int cb = (d0 * 16 + hi * 8) * 2;
    bf16x8 b0 = *reinterpret_cast<const bf16x8*>((const char*)Ks + KSWZ(r32, cb));
    bf16x8 b1 = *reinterpret_cast<const bf16x8*>((const char*)Ks + KSWZ(32 + r32, cb));
    p0 = __builtin_amdgcn_mfma_f32_32x32x16_bf16(b0, qr[d0], p0, 0, 0, 0);
    p1 = __builtin_amdgcn_mfma_f32_32x32x16_bf16(b1, qr[d0], p1, 0, 0, 0); }
}
__device__ __forceinline__ int v_st(int k, int c) { const int kk = (k & ~0xC) | ((k & 4) << 1) | ((k & 8) >> 1); return ((kk >> 3) * 4 + (c >> 5)) * 512 + ((kk & 7) * 32 + (c & 31)) * 2; }
__device__ __forceinline__ int v_st_nat(int k, int c) { return ((k >> 3) * 4 + (c >> 5)) * 512 + ((k & 7) * 32 + (c & 31)) * 2; }
__device__ __forceinline__ int v_rd_base(int lane) { return ((lane & 3) << 3) | (((lane >> 2) & 3) << 6) | (((lane >> 4) & 1) << 5) | (((lane >> 5) & 1) << 8); }
constexpr int v_rd_off(int d0, int ks, int half) { return d0 * 512 + ks * 4096 + half * 2048; }
template <int OFF> __device__ __forceinline__ s16x4 tr_read(int vb) {
  s16x4 r; asm volatile("ds_read_b64_tr_b16 %0, %1 offset:%2" : "=&v"(r) : "v"(vb), "i"(OFF) : "memory"); return r;
}
template <int D0, bool SM = false> __device__ __forceinline__ void pv_one(f32x16& od, int vb, bf16x8 pa0, bf16x8 pa1, bf16x8 pa2, bf16x8 pa3, f32x16* pn = nullptr) {
  const s16x4 l0 = tr_read<v_rd_off(D0, 0, 0)>(vb), h0 = tr_read<v_rd_off(D0, 0, 1)>(vb), l1 = tr_read<v_rd_off(D0, 1, 0)>(vb), h1 = tr_read<v_rd_off(D0, 1, 1)>(vb);
  const s16x4 l2 = tr_read<v_rd_off(D0, 2, 0)>(vb), h2 = tr_read<v_rd_off(D0, 2, 1)>(vb), l3 = tr_read<v_rd_off(D0, 3, 0)>(vb), h3 = tr_read<v_rd_off(D0, 3, 1)>(vb);
  if constexpr (SM) {
#pragma unroll
    for (int r = 4 * D0; r < 4 * D0 + 4; ++r) (*pn)[r] = __builtin_amdgcn_exp2f((*pn)[r]); }
  asm volatile("s_waitcnt lgkmcnt(0)" ::: "memory"); SBAR();
#define PK(L, H) (bf16x8){L[0], L[1], L[2], L[3], H[0], H[1], H[2], H[3]}
  od = __builtin_amdgcn_mfma_f32_32x32x16_bf16(pa0, PK(l0, h0), od, 0, 0, 0);
  od = __builtin_amdgcn_mfma_f32_32x32x16_bf16(pa1, PK(l1, h1), od, 0, 0, 0);
  od = __builtin_amdgcn_mfma_f32_32x32x16_bf16(pa2, PK(l2, h2), od, 0, 0, 0);
  od = __builtin_amdgcn_mfma_f32_32x32x16_bf16(pa3, PK(l3, h3), od, 0, 0, 0);
#undef PK
}
__device__ __forceinline__ void pv_d0(f32x16* o, int vb, bf16x8 pa0, bf16x8 pa1, bf16x8 pa2, bf16x8 pa3) {
  pv_one<0>(o[0], vb, pa0, pa1, pa2, pa3); pv_one<1>(o[1], vb, pa0, pa1, pa2, pa3); pv_one<2>(o[2], vb, pa0, pa1, pa2, pa3); pv_one<3>(o[3], vb, pa0, pa1, pa2, pa3);
}
__device__ __forceinline__ void pv_d0_sm(f32x16* o, int vb, bf16x8 pa0, bf16x8 pa1, bf16x8 pa2, bf16x8 pa3, f32x16& pn) {
  pv_one<0, true>(o[0], vb, pa0, pa1, pa2, pa3, &pn); pv_one<1, true>(o[1], vb, pa0, pa1, pa2, pa3, &pn); pv_one<2, true>(o[2], vb, pa0, pa1, pa2, pa3, &pn); pv_one<3, true>(o[3], vb, pa0, pa1, pa2, pa3, &pn);
}

template <typename TQ, bool NOREF, int SDEPTH>
__device__ __forceinline__ void attn_dense_body(const TQ* __restrict__ Qb, const bf16* __restrict__ Kh, const bf16* __restrict__ Vh,
                                                bf16* __restrict__ Ob, int seq, char* lds, const int tid, const float* __restrict__ qg, const int t0, const float* __restrict__ rope) {
  using St = Stage<bf16>; using SQ = Stage<TQ>;
  const int wid = tid >> 6, lane = tid & 63, r32 = lane & 31, hi = lane >> 5;
  bf16* V_lds = (bf16*)lds; bf16* K_lds = (bf16*)(lds + 2 * SHM_V);
  float* ws = (float*)(lds + 2 * SHM_V + 2 * SHM_K) + wid * 64; float* li_l = ws; float* al_l = ws + 32;
  float m_reg = -1e30f, l_reg = 0; f32x16 o[4] = {}; bf16x8 qr[8];
  const TQ* Qw = Qb + (long)(wid * QBLK + r32) * LDQ + hi * 8;
#pragma unroll
  for (int d0 = 0; d0 < 8; ++d0) qr[d0] = SQ::tobf(SQ::ld8(Qw + d0 * 16));
  if (qg) {
    float f[8][8]; float ss = 0.f;
#pragma unroll
    for (int d0 = 0; d0 < 8; ++d0) { const u32x4 w = *reinterpret_cast<const u32x4*>(&qr[d0]);
#pragma unroll
      for (int e = 0; e < 4; ++e) { f[d0][2 * e] = __uint_as_float(w[e] << 16); f[d0][2 * e + 1] = __uint_as_float(w[e] & 0xffff0000u); ss += f[d0][2 * e] * f[d0][2 * e] + f[d0][2 * e + 1] * f[d0][2 * e + 1]; } }
    { auto rr = __builtin_amdgcn_permlane32_swap(__float_as_uint(ss), __float_as_uint(ss), false, false); ss = __uint_as_float(rr[0]) + __uint_as_float(rr[1]); }
    const float rs = rsqrtf(ss * (1.f / 128.f) + 1e-6f);
#pragma unroll
    for (int d0 = 0; d0 < 8; ++d0)
#pragma unroll
      for (int j = 0; j < 8; ++j) f[d0][j] *= rs * qg[16 * d0 + 8 * hi + j] * (NOREF ? SCALE * 1.4426950408889634f : 1.f);
    const int t = t0 + wid * QBLK + r32;
#pragma unroll
    for (int d0 = 0; d0 < 4; ++d0) { const float* rp = rope + (d0 < 2 ? (t / 64) : (t % 64)) * 64;
#pragma unroll
      for (int j = 0; j < 8; ++j) { const int fi = (16 * d0 + 8 * hi + j) & 31; const float cs = rp[2 * fi], sn = rp[2 * fi + 1];
        const float x1 = f[d0][j], x2 = f[d0 + 4][j]; f[d0][j] = x1 * cs - x2 * sn; f[d0 + 4][j] = x2 * cs + x1 * sn; } }
#pragma unroll
    for (int d0 = 0; d0 < 8; ++d0) { u32x4 w = {cvtpk(f[d0][0], f[d0][1]), cvtpk(f[d0][2], f[d0][3]), cvtpk(f[d0][4], f[d0][5]), cvtpk(f[d0][6], f[d0][7])}; qr[d0] = *reinterpret_cast<bf16x8*>(&w); }
  }
  const int sr = tid >> 4, sc = (tid & 15) * 8, vst0 = v_st_nat(sr, sc), vst1 = v_st_nat(32 + sr, sc);
  const int vb0 = (int)(uintptr_t)V_lds + v_rd_base(lane);
  struct { typename St::T vs0, vs1, ks0, ks1; } sr_[SDEPTH];
#define SLOAD(i, k0) do { const unsigned o0_ = (unsigned)(((k0) + sr) * LDK + sc), o1_ = o0_ + 32u * LDK;   \
    sr_[i].vs0 = St::ld8(Vh + o0_); sr_[i].vs1 = St::ld8(Vh + o1_); sr_[i].ks0 = St::ld8(Kh + o0_); sr_[i].ks1 = St::ld8(Kh + o1_); } while (0)
#define SWRITE(b, i) do { *(bf16x8*)((char*)V_lds + (b) * SHM_V + vst0) = St::tobf(sr_[i].vs0);          \
    *(bf16x8*)((char*)V_lds + (b) * SHM_V + vst1) = St::tobf(sr_[i].vs1); int kc = sc * 2;               \
    *(bf16x8*)((char*)K_lds + (b) * SHM_K + KSWZ(sr, kc)) = St::tobf(sr_[i].ks0);                       \
    *(bf16x8*)((char*)K_lds + (b) * SHM_K + KSWZ(32 + sr, kc)) = St::tobf(sr_[i].ks1); } while (0)
#define SWAIT() do { if constexpr (SDEPTH == 2) asm volatile("s_waitcnt vmcnt(4)" ::: "memory"); else asm volatile("s_waitcnt vmcnt(0)" ::: "memory"); } while (0)
#define RESC(a) do { if (!NOREF && __any((a) < 1.f)) { if (hi == 0) al_l[r32] = (a); asm volatile("s_waitcnt lgkmcnt(0)" ::: "memory"); \
    for (int d = 0; d < 4; ++d) for (int r = 0; r < 16; ++r) o[d][r] *= al_l[crow(r, hi)]; } } while (0)
  f32x16 pA0, pA1, pB0, pB1; float mnA, mnB, alA, alB; bf16x8 pa0, pa1, pa2, pa3; const int NT = seq / KVBLK;
  constexpr int SE = 0, SO = SDEPTH - 1;
  SLOAD(SE, 0); asm volatile("s_waitcnt vmcnt(0)" ::: "memory"); SWRITE(0, SE); __syncthreads();
  qkt(pA0, pA1, K_lds, qr, r32, hi); partialSM<NOREF>(pA0, pA1, m_reg, mnA, alA);
  SLOAD(SO, KVBLK); if constexpr (SDEPTH == 2) { if (2 < NT) SLOAD(SE, 2 * KVBLK); }
  SWAIT(); SWRITE(1, SO); __syncthreads();
  for (int j = 1; j + 1 < NT; j += 2) {
    SBAR(); qkt(pB0, pB1, (bf16*)((char*)K_lds + SHM_K), qr, r32, hi);
    finishSM<NOREF>(pA0, pA1, alA, l_reg, pa0, pa1, pa2, pa3); SBAR();
    SLOAD(SO, (j + SDEPTH) * KVBLK); SBAR();
    if constexpr (NOREF) { pv_d0_sm(o, vb0, pa0, pa1, pa2, pa3, pB0); alB = 1.f; } else { pv_d0(o, vb0, pa0, pa1, pa2, pa3); partialSM<NOREF>(pB0, pB1, m_reg, mnB, alB); }
    __syncthreads(); SWAIT(); SWRITE(0, SE);
    RESC(alB); __syncthreads();
    SBAR(); qkt(pA0, pA1, K_lds, qr, r32, hi);
    finishSM<NOREF>(pB0, pB1, alB, l_reg, pa0, pa1, pa2, pa3); SBAR();
    if (SDEPTH == 1 || j + 3 < NT) SLOAD(SE, (j + 1 + SDEPTH) * KVBLK); SBAR();
    if constexpr (NOREF) { pv_d0_sm(o, vb0 + (int)SHM_V, pa0, pa1, pa2, pa3, pA0); alA = 1.f; } else { pv_d0(o, vb0 + (int)SHM_V, pa0, pa1, pa2, pa3); partialSM<NOREF>(pA0, pA1, m_reg, mnA, alA); }
    __syncthreads(); SWAIT(); SWRITE(1, SO);
    RESC(alA); __syncthreads();
  }
  SBAR(); qkt(pB0, pB1, (bf16*)((char*)K_lds + SHM_K), qr, r32, hi);
  finishSM<NOREF>(pA0, pA1, alA, l_reg, pa0, pa1, pa2, pa3); SBAR();
  if constexpr (NOREF) { pv_d0_sm(o, vb0, pa0, pa1, pa2, pa3, pB0); alB = 1.f; } else { pv_d0(o, vb0, pa0, pa1, pa2, pa3); partialSM<NOREF>(pB0, pB1, m_reg, mnB, alB); }
  __syncthreads(); RESC(alB);
  finishSM<NOREF>(pB0, pB1, alB, l_reg, pa0, pa1, pa2, pa3); SBAR();
  pv_d0(o, vb0 + (int)SHM_V, pa0, pa1, pa2, pa3);
  if constexpr (NOREF) { auto rr = __builtin_amdgcn_permlane32_swap(__float_as_uint(l_reg), __float_as_uint(l_reg), false, false); l_reg = __uint_as_float(rr[0]) + __uint_as_float(rr[1]); }
  if (hi == 0) li_l[r32] = l_reg; asm volatile("s_waitcnt lgkmcnt(0)" ::: "memory");
  float rli[16];
#pragma unroll
  for (int r = 0; r < 16; ++r) rli[r] = __builtin_amdgcn_rcpf(li_l[crow(r, hi)]);
  bf16* Ow = Ob + (long)(wid * QBLK) * LDO;
#pragma unroll
  for (int r = 0; r < 16; ++r) { int orow = crow(r, hi);
    for (int d0 = 0; d0 < 4; ++d0) Ow[(long)orow * LDO + d0 * 32 + r32] = (bf16)(cvtpk(o[d0][r] * rli[r], 0.f) & 0xffffu); }
#undef SLOAD
#undef SWRITE
#undef SWAIT
#undef RESC
}
}

namespace {
using pg8::bf16_t; using pg8::bf16x8; using pg8::f32x4; using pg8::u32x4;
typedef unsigned u32x2 __attribute__((ext_vector_type(2)));
typedef float f32x16 __attribute__((ext_vector_type(16)));
typedef short s16x4 __attribute__((ext_vector_type(4)));
#define LAS __attribute__((address_space(3)))

constexpr int D = 1024, NBATCH = 2, SEQ = 8192, CTXL = 256;
constexpr int NLAT = NBATCH * SEQ, NCTX = NBATCH * CTXL, NTOK = NLAT + NCTX;
constexpr int SLEN = CTXL + SEQ;
constexpr int NCH = SLEN / 128;
constexpr int ABIN = 5680, NWIN = 5888;
constexpr int NGATE = 48;
constexpr float ALPHA = 1.4142135623730951f;
constexpr int NWAVES = 8, NTHREADS = 512;
constexpr int MOE_MAXTILES = 148;

constexpr size_t MiB = 1u << 20;
constexpr size_t WS_CTL = 0;
constexpr size_t WS_MODV = 64 * 1024;
constexpr size_t WS_ROPE = 208 * 1024;
constexpr size_t WS_DN = 256 * 1024;
constexpr size_t WS_MS = 784 * 1024;
constexpr size_t WS_AEND = 808 * 1024;
constexpr size_t WS_WIN = 1 * MiB;
constexpr size_t WS_WOUT = 12 * MiB + 512 * 1024;
constexpr size_t WS_ATIN = 16 * MiB + 512 * 1024;
constexpr size_t WS_ATOUT = 19 * MiB + 512 * 1024;
constexpr size_t WS_XL = 22 * MiB;
constexpr size_t WS_HB = 88 * MiB;
constexpr size_t WS_MOEW = 121 * MiB;
constexpr size_t WS_ROUTE = 217 * MiB;
constexpr size_t WS_R = 219 * MiB;
constexpr size_t WS_QK = WS_R, WS_V = WS_R + 33 * MiB, WS_O = WS_R + 66 * MiB, WS_Z = WS_R + 99 * MiB, WS_XBC = WS_R + 132 * MiB;
constexpr size_t WS_GATES = WS_R + 182 * MiB;
constexpr size_t WS_SSQ = WS_R + 185 * MiB + 256 * 1024;
constexpr size_t WS_MIX = WS_R + 186 * MiB;
constexpr size_t WS_XC = WS_HB;
constexpr size_t WS_DS = 138 * MiB;
constexpr size_t WS_DC = WS_XL;
constexpr size_t WS_YB = WS_R;
constexpr size_t WS_XS = WS_R, WS_HMID = WS_R + 74 * MiB, WS_YS = WS_R + 148 * MiB;
constexpr size_t WS_Q = WS_R, WS_KB = WS_R + 33 * MiB, WS_VB = WS_R + 42 * MiB, WS_AO = WS_R + 51 * MiB, WS_YB1 = WS_R + 84 * MiB, WS_S = WS_R + 117 * MiB;
constexpr size_t WS_TOKTAB = 472 * MiB;
constexpr size_t WS_MLG = 476 * MiB;
constexpr size_t WS_SSG = 479 * MiB;
constexpr size_t WS_END = 486 * MiB;

constexpr int CW_CNT0 = 64, CW_CNT1 = 128;
constexpr int CW_DEP0 = 256, CW_DEP1 = 512;
constexpr int CW_BAR = 1024;

__device__ __forceinline__ float bf2f(unsigned short v) { return __uint_as_float((unsigned)v << 16); }
typedef float f32x2_t __attribute__((ext_vector_type(2))); typedef __bf16 bf16x2_t __attribute__((ext_vector_type(2)));
__device__ __forceinline__ unsigned pk2(float lo, float hi) { f32x2_t v = {lo, hi}; bf16x2_t b = __builtin_convertvector(v, bf16x2_t); return __builtin_bit_cast(unsigned, b); }
__device__ __forceinline__ bf16_t f2bf(float f) { return (bf16_t)(pk2(f, 0.f) & 0xffffu); }
__device__ __forceinline__ float siluf(float x) { return x * __builtin_amdgcn_rcpf(1.f + __expf(-x)); }
__device__ __forceinline__ float sigmf(float x) { return __builtin_amdgcn_rcpf(1.f + __expf(-x)); }
__device__ __forceinline__ float softplusf(float x) { return x > 20.f ? x : log1pf(expf(x)); }
__device__ __forceinline__ float logsigf(float x) { return -softplusf(-x); }
__device__ __forceinline__ float wave_sum(float v) {
#pragma unroll
    for (int o = 1; o < 64; o <<= 1) v += __shfl_xor(v, o);
    return v;
}
__device__ __forceinline__ float wave_max(float v) {
#pragma unroll
    for (int o = 1; o < 64; o <<= 1) v = fmaxf(v, __shfl_xor(v, o));
    return v; }
__device__ __forceinline__ unsigned char* launder_ptr(unsigned char* p) { asm volatile("" : "+s"(p)); return p; }
__device__ __forceinline__ int fresh_lane() { int z = 0; asm volatile("" : "+s"(z)); return (int)__builtin_amdgcn_mbcnt_hi(~0u, __builtin_amdgcn_mbcnt_lo(~0u, (unsigned)z)); }
__device__ __forceinline__ int mod_index(int row) { return row < NLAT ? row / SEQ : 2; }
__device__ __forceinline__ int seq_row(int b, int dir, int i) {
    if (i < CTXL) { int t = dir ? (CTXL - 1 - i) : i; return NLAT + b * CTXL + t; }
    int t = i - CTXL; if (dir) t = SEQ - 1 - t; return b * SEQ + t;
}
__device__ __forceinline__ int chunk_row0(int b, int cid) { return cid < 2 ? NLAT + b * CTXL + cid * 128 : b * SEQ + (cid - 2) * 128; }
__device__ __forceinline__ int scan_cid(int dir, int p) { return dir == 0 ? p : (p < 2 ? 1 - p : 67 - p); }

struct RowF { f32x4 v[4]; };
__device__ __forceinline__ RowF row_ld_f32(const float* p, int lane) { RowF r; const f32x4* q = (const f32x4*)p + lane;
#pragma unroll
    for (int j = 0; j < 4; ++j) r.v[j] = q[64 * j];
    return r; }
__device__ __forceinline__ RowF row_ld_bf16(const bf16_t* p, int lane) { RowF r; const u32x2* q = (const u32x2*)p + lane;
#pragma unroll
    for (int j = 0; j < 4; ++j) { const u32x2 w = q[64 * j]; r.v[j] = (f32x4){__uint_as_float(w.x << 16), __uint_as_float(w.x & 0xffff0000u), __uint_as_float(w.y << 16), __uint_as_float(w.y & 0xffff0000u)}; }
    return r; }
struct RowRaw { u32x2 w[4]; };
__device__ __forceinline__ RowRaw row_ldraw_bf16(const bf16_t* p, int lane) { RowRaw r; const u32x2* q = (const u32x2*)p + lane;
#pragma unroll
    for (int j = 0; j < 4; ++j) r.w[j] = q[64 * j];
    return r; }
__device__ __forceinline__ RowF row_cvt(const RowRaw& t) { RowF r;
#pragma unroll
    for (int j = 0; j < 4; ++j) r.v[j] = (f32x4){__uint_as_float(t.w[j].x << 16), __uint_as_float(t.w[j].x & 0xffff0000u), __uint_as_float(t.w[j].y << 16), __uint_as_float(t.w[j].y & 0xffff0000u)};
    return r; }
__device__ __forceinline__ void row_st_f32(float* p, int lane, const RowF& r) { f32x4* q = (f32x4*)p + lane;
#pragma unroll
    for (int j = 0; j < 4; ++j) q[64 * j] = r.v[j]; }
__device__ __forceinline__ void row_st_bf16(bf16_t* p, int lane, const RowF& r) { u32x2* q = (u32x2*)p + lane;
#pragma unroll
    for (int j = 0; j < 4; ++j) { u32x2 w; w.x = pk2(r.v[j][0], r.v[j][1]); w.y = pk2(r.v[j][2], r.v[j][3]); q[64 * j] = w; } }
__device__ __forceinline__ float row_sum(const RowF& r) { float s = 0.f;
#pragma unroll
    for (int j = 0; j < 4; ++j) s += (r.v[j][0] + r.v[j][1]) + (r.v[j][2] + r.v[j][3]);
    return wave_sum(s); }
__device__ __forceinline__ void row_layernorm(RowF& r, const float* g, const float* b, int lane) {
    const float mu = row_sum(r) * (1.f / D); float q = 0.f;
#pragma unroll
    for (int j = 0; j < 4; ++j) { r.v[j] = r.v[j] - mu; q += (r.v[j][0] * r.v[j][0] + r.v[j][1] * r.v[j][1]) + (r.v[j][2] * r.v[j][2] + r.v[j][3] * r.v[j][3]); }
    const float rstd = rsqrtf(wave_sum(q) * (1.f / D) + 1e-5f);
    const RowF gg = row_ld_f32(g, lane), bb = row_ld_f32(b, lane);
#pragma unroll
    for (int j = 0; j < 4; ++j) r.v[j] = r.v[j] * rstd * gg.v[j] + bb.v[j];
}
__device__ __forceinline__ RowF row_modulate(const RowF& x, const float* sh, const float* sc, int lane) {
    const RowF s = row_ld_f32(sh, lane), c = row_ld_f32(sc, lane); RowF h;
#pragma unroll
    for (int j = 0; j < 4; ++j) h.v[j] = x.v[j] * (1.f + c.v[j]) + s.v[j];
    return h; }

template <class Dest> struct EpiStore {
    static constexpr bool PERM = true, AFTER_DRAIN = false, MIDK = false; Dest d;
    __device__ __forceinline__ void operator()(const f32x4 (&acc)[2][2][4][2], const pg8::Unit& u, int wr, int wc, int fr, int fq) const {
#pragma unroll
        for (int ai = 0; ai < 2; ++ai)
#pragma unroll
            for (int m = 0; m < 4; ++m) {
                const int row = u.pm * 256 + ai * 128 + wr * 64 + m * 16 + fr;
                bf16_t* rp = d.rowptr(row, u.pn); if (!rp) continue;
#pragma unroll
                for (int bj = 0; bj < 2; ++bj) { const f32x4 v0 = acc[ai][bj][m][0], v1 = acc[ai][bj][m][1];
                    u32x4 w; w.x = pk2(v0[0], v0[1]); w.y = pk2(v0[2], v0[3]); w.z = pk2(v1[0], v1[1]); w.w = pk2(v1[2], v1[3]);
                    *(u32x4*)(rp + bj * 128 + wc * 32 + 8 * fq) = w; }
            }
    }
};
struct DestWin { bf16_t* base;
    __device__ __forceinline__ bf16_t* rowptr(int row, int pn) const {
        if (pn < 16) { const int seg = pn >> 2; return base + (size_t)seg * (33 * MiB / 2) + (size_t)row * 1024 + (pn & 3) * 256; }
        return base + (size_t)4 * (33 * MiB / 2) + (size_t)row * 1536 + (pn - 16) * 256; } };
struct EpiWin {
    static constexpr bool PERM = true, AFTER_DRAIN = false, MIDK = false; EpiStore<DestWin> st; float* gates; const float* igb; const float* fgb; const float* dtb;
    __device__ __forceinline__ void operator()(const f32x4 (&acc)[2][2][4][2], const pg8::Unit& u, int wr, int wc, int fr, int fq) const {
        if (u.pn < 22) { st(acc, u, wr, wc, fr, fq); return; }
        const int c0 = wc * 32 + 8 * fq;
        if (c0 >= NGATE) return;
        float bias[8];
#pragma unroll
        for (int i = 0; i < 8; ++i) { const int c = c0 + i; bias[i] = c < 8 ? igb[c] : (c < 16 ? fgb[c - 8] : dtb[c - 16]); }
#pragma unroll
        for (int ai = 0; ai < 2; ++ai)
#pragma unroll
            for (int m = 0; m < 4; ++m) { const int row = u.pm * 256 + ai * 128 + wr * 64 + m * 16 + fr;
                float v[8];
#pragma unroll
                for (int i = 0; i < 8; ++i) { const float x = acc[ai][0][m][i >> 2][i & 3] + bias[i]; const int c = c0 + i; v[i] = c < 8 ? x : (c < 16 ? logsigf(x) : softplusf(x)); }
                float* gp = gates + (size_t)row * NGATE + c0;
                *(f32x4*)gp = (f32x4){v[0], v[1], v[2], v[3]}; *(f32x4*)(gp + 4) = (f32x4){v[4], v[5], v[6], v[7]}; }
    }
};
struct DestPlain { bf16_t* base; int ld; int pnmask;
    __device__ __forceinline__ bf16_t* rowptr(int row, int pn) const { return base + (size_t)row * ld + (pn & pnmask) * 256; } };
struct DestQKV { bf16_t* q; bf16_t* kb; bf16_t* vb;
    __device__ __forceinline__ bf16_t* rowptr(int row, int pn) const {
        if (pn < 4) return row < NLAT ? q + (size_t)row * 1024 + pn * 256 : nullptr;
        int key; if (row < NLAT) { const int b = row / SEQ, t = row % SEQ; key = b * SLEN + CTXL + t; } else { const int r = row - NLAT; key = (r / CTXL) * SLEN + (r % CTXL); }
        return (pn == 4 ? kb : vb) + (size_t)key * 256; } };
struct EpiWout {
    static constexpr bool PERM = true, AFTER_DRAIN = false, MIDK = true; EpiStore<DestPlain> st; const float* ssq;
    __device__ __forceinline__ void operator()(const f32x4 (&acc)[2][2][4][2], const pg8::Unit& u, int wr, int wc, int fr, int fq) const { st(acc, u, wr, wc, fr, fq); }
    __device__ __forceinline__ void midk(f32x4 (&acc)[2][2][4][2], const pg8::Unit& u, int wr, int wc, int fr, int fq) const {
        const float* p0 = ssq + (size_t)(u.pm * 256 + wr * 64 + fr) * 8; asm volatile("" : "+v"(p0));
#pragma unroll
        for (int ai = 0; ai < 2; ++ai)
#pragma unroll
            for (int m = 0; m < 4; ++m) { const float* p = p0 + (ai * 128 + m * 16) * 8;
                const f32x4 s0 = *(const f32x4*)p, s1 = *(const f32x4*)(p + 4);
                const float r = rsqrtf((((s0[0] + s0[1]) + (s0[2] + s0[3])) + ((s1[0] + s1[1]) + (s1[2] + s1[3]))) * (1.f / 1024.f) + 1e-6f);
#pragma unroll
                for (int bj = 0; bj < 2; ++bj)
#pragma unroll
                    for (int n = 0; n < 2; ++n) acc[ai][bj][m][n] = acc[ai][bj][m][n] * r;
                __builtin_amdgcn_sched_barrier(0); }
    }
};
template <bool WT = false> struct EpiSwigluT {
    static constexpr bool PERM = true, AFTER_DRAIN = false, MIDK = false; bf16_t* out;
    __device__ __forceinline__ void operator()(const f32x4 (&acc)[2][2][4][2], const pg8::Unit& u, int wr, int wc, int fr, int fq) const {
        const int pnl = u.pn & 7;
#pragma unroll
        for (int ai = 0; ai < 2; ++ai)
#pragma unroll
            for (int m = 0; m < 4; ++m) {
                const int row = u.pm * 256 + ai * 128 + wr * 64 + m * 16 + fr;
                bf16_t* rp = out + (size_t)row * 1024 + pnl * 128 + wc * 16 + 4 * fq;
#pragma unroll
                for (int bj = 0; bj < 2; ++bj) { const f32x4 g = acc[ai][bj][m][0], up = acc[ai][bj][m][1];
                    u32x2 w; w.x = pk2(siluf(g[0]) * up[0], siluf(g[1]) * up[1]); w.y = pk2(siluf(g[2]) * up[2], siluf(g[3]) * up[3]);
                    if constexpr (WT) __hip_atomic_store((__attribute__((address_space(1))) unsigned long long*)(rp + bj * 64), (unsigned long long)w.x | ((unsigned long long)w.y << 32), __ATOMIC_RELAXED, __HIP_MEMORY_SCOPE_AGENT);
                    else *(u32x2*)(rp + bj * 64) = w; }
            }
    }
};
using EpiSwiglu = EpiSwigluT<false>;
struct MoeOrder {
    int ntm, npn, nwg, G, c; const LAS int* toff; const int* tab;
    __device__ __forceinline__ void init(const LAS int* toff_, int npn_, int G_, int c_) { toff = toff_; ntm = toff_[16]; npn = npn_; nwg = ntm * npn_; G = G_; c = c_; }
    __device__ __forceinline__ bool next(int i, pg8::Unit& u) const {
        const long L = (long)i * G + c; if (L >= nwg) return false;
        int wgid = (int)L; { const int q = nwg / 8, r = nwg % 8, xcd = wgid % 8, off = wgid / 8; wgid = (xcd < r ? xcd * (q + 1) : r * (q + 1) + (xcd - r) * q) + off; }
        const int pm = wgid / npn, pnl = wgid % npn; int e = 0;
#pragma unroll
        for (int k = 1; k < 16; ++k) e += (toff[k] <= pm) ? 1 : 0;
        u.pm = pm; u.pn = e * npn + pnl; return true;
    }
    __device__ __forceinline__ int arow(const pg8::Unit& u, int r) const { const int e = u.pn / npn, pos = (u.pm - toff[e]) * 256 + r; return pos < toff[100 + e] ? tab[(size_t)e * NTOK + pos] : 0; }
    static constexpr bool LATE = false;
    __device__ __forceinline__ void a_ready(const pg8::Unit&) const {}
    __device__ __forceinline__ void done(const pg8::Unit&) const {}
    __device__ __forceinline__ void late(const pg8::Unit&) const {}
};

struct MoeMerged {
    static constexpr bool LATE = true;
    int m0, nm, nloc, rank, n1c, crot; const LAS int* toff; const int* tab; unsigned* dep;
    __device__ __forceinline__ void init(const LAS int* toff_, const int* tab_, unsigned* dep_) {
        toff = toff_; tab = tab_; dep = dep_; m0 = toff_[120]; nm = toff_[121]; nloc = toff_[122]; rank = toff_[123];
        const int n1 = nm * 8; n1c = rank < n1 ? (n1 - rank + nloc - 1) / nloc : 0; const int rot = n1 % nloc; crot = (rank - rot + nloc) % nloc; }
    __device__ __forceinline__ bool next(int i, pg8::Unit& u) const {
        int pm, pnl, npn, base;
        if (i < n1c) { const int t1 = i * nloc + rank; pm = m0 + (t1 >> 3); pnl = t1 & 7; npn = 8; base = 0; }
        else { const int t2 = (i - n1c) * nloc + crot; if (t2 >= nm * 4) return false; pm = m0 + (t2 >> 2); pnl = t2 & 3; npn = 4; base = 128; }
        int e = 0;
#pragma unroll
        for (int k = 1; k < 16; ++k) e += (toff[k] <= pm) ? 1 : 0;
        u.pm = pm; u.pn = base + e * npn + pnl; return true;
    }
    __device__ __forceinline__ int arow(const pg8::Unit& u, int r) const {
        if (u.pn >= 128) return (int)((WS_HMID - WS_HB) / 2048) + u.pm * 256 + r;
        const int e = u.pn >> 3, pos = (u.pm - toff[e]) * 256 + r; return pos < toff[100 + e] ? tab[(size_t)e * NTOK + pos] : 0; }
    __device__ __forceinline__ void a_ready(const pg8::Unit& u) const {
        if (u.pn >= 128) { unsigned* w = dep + u.pm; unsigned sp = 0;
            while ((unsigned)__builtin_amdgcn_readfirstlane(__hip_atomic_load(w, __ATOMIC_RELAXED, __HIP_MEMORY_SCOPE_AGENT)) < 64u) { __builtin_amdgcn_s_sleep(1); if (++sp > (1u << 22)) break; }
            asm volatile("" ::: "memory"); }
    }
    __device__ __forceinline__ void done(const pg8::Unit&) const {}
    __device__ __forceinline__ void late(const pg8::Unit& u) const {
        if (u.pn < 128) { asm volatile("s_waitcnt vmcnt(0)" ::: "memory"); if (fresh_lane() == 0) (void)__hip_atomic_fetch_add(dep + u.pm, 1u, __ATOMIC_RELAXED, __HIP_MEMORY_SCOPE_AGENT); }
    }
};
struct EpiMoe {
    static constexpr bool PERM = true, AFTER_DRAIN = false, MIDK = false; EpiSwigluT<false> sw; EpiStore<DestPlain> st;
    __device__ __forceinline__ void operator()(const f32x4 (&acc)[2][2][4][2], const pg8::Unit& u, int wr, int wc, int fr, int fq) const {
        if (u.pn < 128) sw(acc, u, wr, wc, fr, fq); else st(acc, u, wr, wc, fr, fq); }
};

#define XB_TMO      128
#define XB_XCNT(j)  (256  + 64 * (j))
#define XB_XSUB(j)  (1280 + 64 * (j))
#define XB_XGEN(j)  (2304 + 64 * (j))
#define XB_TOP      3328
#define XB_TOPGEN   3392
#define XCD_BAR_WORDS 3456
#define XB_SPIN_CAP (1u << 18)

__device__ __forceinline__ unsigned xb_ld(unsigned* p)              { return __hip_atomic_load(p, __ATOMIC_RELAXED, __HIP_MEMORY_SCOPE_AGENT); }
__device__ __forceinline__ unsigned xb_add(unsigned* p, unsigned v) { return __hip_atomic_fetch_add(p, v, __ATOMIC_RELAXED, __HIP_MEMORY_SCOPE_AGENT); }
__device__ __forceinline__ unsigned xb_xcc_id() { return (unsigned)__builtin_amdgcn_s_getreg((3 << 11) | 20) & 0xFu; }
#define XB_SPIN(cond, bar) do { unsigned _sp = 0; while (cond) { __builtin_amdgcn_s_sleep(1); \
    if ((++_sp & 255u) == 0u) { if (xb_ld(&(bar)[XB_TMO])) break; if (_sp > XB_SPIN_CAP) { atomicAdd(&(bar)[XB_TMO], 1u); break; } } } } while (0)

struct XcdBarrier {
    unsigned* bar; unsigned x;
    volatile LAS unsigned* st;
};

__device__ __forceinline__ XcdBarrier xcd_barrier_post(unsigned* bar, volatile LAS unsigned* st, int tid) {
    XcdBarrier b; b.bar = bar; b.x = xb_xcc_id(); b.st = st;
    if (tid == 0) { st[2] = xb_add(&bar[XB_XCNT(b.x)], 1u); st[3] = b.x; }
    return b;
}
__device__ __forceinline__ void xcd_barrier_complete(unsigned* bar, unsigned x, unsigned& nloc, unsigned& nx) {
    const unsigned G = gridDim.x * gridDim.y * gridDim.z;
    unsigned sum, cnt, mine, sp = 0u;
    for (;;) {
        sum = 0u; cnt = 0u; mine = 0u;
#pragma unroll
        for (unsigned j = 0; j < 16; ++j) { const unsigned c = xb_ld(&bar[XB_XCNT(j)]); sum += c; cnt += (c > 0u) ? 1u : 0u; mine = (j == x) ? c : mine; }
        if (sum == G) break;
        __builtin_amdgcn_s_sleep(1);
        if ((++sp & 255u) == 0u) { if (xb_ld(&bar[XB_TMO])) break; if (sp > XB_SPIN_CAP) { atomicAdd(&bar[XB_TMO], 1u); break; } }
    }
    nloc = mine > 0u ? mine : 1u; nx = cnt > 0u ? cnt : 1u;
}

__device__ __forceinline__ void xcd_barrier(const XcdBarrier& b, int tid) {
    asm volatile("s_waitcnt vmcnt(0)" ::: "memory");
    __syncthreads();
    if (tid == 0) {
        unsigned* bar = b.bar;
        __builtin_amdgcn_s_waitcnt(0);
        unsigned nloc = b.st[0], nx = b.st[1];
        if (nloc == 0u) { xcd_barrier_complete(bar, b.x, nloc, nx); b.st[0] = nloc; b.st[1] = nx; }
        const unsigned old = xb_add(&bar[XB_XSUB(b.x)], 1u);
        const unsigned gen = old / nloc;
        if (old + 1u == (gen + 1u) * nloc) {
            __builtin_amdgcn_fence(__ATOMIC_RELEASE, "agent");
            asm volatile("s_waitcnt vmcnt(0)" ::: "memory");
            const unsigned og = xb_add(&bar[XB_TOP], 1u);
            const unsigned tg = og / nx;
            if (og + 1u == (tg + 1u) * nx) xb_add(&bar[XB_TOPGEN], 1u);
            else XB_SPIN(xb_ld(&bar[XB_TOPGEN]) == tg, bar);
            __builtin_amdgcn_fence(__ATOMIC_ACQUIRE, "agent");
            xb_add(&bar[XB_XGEN(b.x)], 1u);
            asm volatile("s_waitcnt vmcnt(0)" ::: "memory");
        } else {
            XB_SPIN(xb_ld(&bar[XB_XGEN(b.x)]) == gen, bar);
            __builtin_amdgcn_fence(__ATOMIC_ACQUIRE, "agent");
            asm volatile("s_waitcnt vmcnt(0)" ::: "memory");
        }
    }
    __syncthreads();
}

struct Args {
    const float* in[28]; float* out; unsigned char* ws; int ph_lo, ph_hi, li, pad;
};
struct Ctx {
    LAS unsigned char* lds; unsigned char* ws;
    int tid, lane, wave, G, bid;
};
#define CTLP(F) ((unsigned*)((F).ws + WS_CTL))
#define MISCP(F) ((LAS int*)((F).lds + MISC_OFF))
#define GWID(F) ((F).bid * NWAVES + (F).wave)
#define NGW(F) ((F).G * NWAVES)
enum { I_X = 0, I_C, I_CTX, I_CCTX, I_ADAW, I_ADAB, I_LNG, I_LNB, I_ABWIN, I_ABWOUT, I_IGB, I_FGB, I_MNG, I_CONVW, I_CONVB, I_DTB, I_ALOG, I_SSMD, I_SNG,
       I_ATWIN, I_ATWOUT, I_QG, I_KG, I_RW, I_RB, I_WG, I_WU, I_WD };
constexpr int RING_BYTES = 131072, MISC_OFF = RING_BYTES, LDS_BYTES = RING_BYTES + 12288;

template <class Src> __device__ __forceinline__ void transpose_item(const Src& S, bf16_t* WT, int K, int orow0, int k0, LAS float* scr, int lane, float scale) {
#pragma unroll 8
    for (int i = 0; i < 32; ++i) { const int kk = 2 * i + (lane >> 5); scr[kk * 33 + (lane & 31)] = S.ld(k0 + kk, lane & 31); }
    asm volatile("s_waitcnt lgkmcnt(0)" ::: "memory");
    const int c = lane & 7;
#pragma unroll
    for (int j = 0; j < 4; ++j) { const int n = (lane >> 3) + 8 * j; const LAS float* s = scr + (8 * c) * 33 + S.scol(n);
        u32x4 o; o.x = pk2(s[0 * 33] * scale, s[1 * 33] * scale); o.y = pk2(s[2 * 33] * scale, s[3 * 33] * scale); o.z = pk2(s[4 * 33] * scale, s[5 * 33] * scale); o.w = pk2(s[6 * 33] * scale, s[7 * 33] * scale);
        *(u32x4*)(WT + (size_t)(orow0 + n) * K + k0 + 8 * c) = o; }
    asm volatile("s_waitcnt lgkmcnt(0)" ::: "memory");
}
struct SrcPlain { const float* W; int N; int n0;
    __device__ __forceinline__ float ld(int k, int j) const { return __builtin_nontemporal_load(W + (size_t)k * N + n0 + j); }
    __device__ __forceinline__ int scol(int n) const { return n; } };
struct SrcGate { const float* W; int j0;
    __device__ __forceinline__ float ld(int k, int j) const { const int jj = j0 + j; return jj < 16 ? W[(size_t)k * ABIN + 3072 + jj] : (jj < NGATE ? W[(size_t)k * ABIN + 5648 + (jj - 16)] : 0.f); }
    __device__ __forceinline__ int scol(int n) const { return n; } };
struct SrcWout { const float* W; const float* g; int n0;
    __device__ __forceinline__ float ld(int k, int j) const { return k < 1024 ? W[(size_t)(k + 1024) * 1024 + n0 + j] * g[k] : W[(size_t)(k - 1024) * 1024 + n0 + j]; }
    __device__ __forceinline__ int scol(int n) const { return n; } };
struct SrcGU { const float* Wg; const float* Wu; int c0;
    __device__ __forceinline__ float ld(int k, int j) const { return __builtin_nontemporal_load((j < 16 ? Wg : Wu) + (size_t)k * 1024 + c0 + (j & 15)); }
    __device__ __forceinline__ int scol(int n) const { const int b4 = n >> 3, w = n & 7; return (w < 4 ? 0 : 16) + 4 * b4 + (w & 3); } };

__device__ __forceinline__ void convert_small_weights(Ctx& F, const Args& a) {
    {   float* rope = (float*)(F.ws + WS_ROPE);
        for (int i = F.bid * NTHREADS + F.tid; i < 128 * 32; i += F.G * NTHREADS) { const int pos = i >> 5, fi = i & 31; float sn, cs; sincosf((float)pos * expf(-(float)fi * (9.210340371976184f / 32.f)), &sn, &cs); rope[2 * i] = cs; rope[2 * i + 1] = sn; } }
    LAS float* scr = (LAS float*)(F.lds + F.wave * 16384);
    bf16_t* WinT = (bf16_t*)(F.ws + WS_WIN); bf16_t* WoutT = (bf16_t*)(F.ws + WS_WOUT); bf16_t* AtInT = (bf16_t*)(F.ws + WS_ATIN); bf16_t* AtOutT = (bf16_t*)(F.ws + WS_ATOUT);
    constexpr int I0 = 16 * (NWIN / 32), I1 = 32 * 32, I2 = 16 * 48, I3 = 16 * 32, NI = I0 + I1 + I2 + I3;
    for (int it = GWID(F); it < NI; it += NGW(F)) {
        int r = it;
        if (r < I0) { const int kb = r / (NWIN / 32), nb = r % (NWIN / 32), n0 = 32 * nb;
            if (n0 < 5632) { SrcPlain S{a.in[I_ABWIN], ABIN, n0 < 3072 ? n0 : n0 + 16}; transpose_item(S, WinT, 1024, n0, 64 * kb, scr, F.lane, n0 < 512 ? 0.08838834764831845f : 1.f); }
            else { SrcGate S{a.in[I_ABWIN], n0 - 5632}; transpose_item(S, WinT, 1024, n0, 64 * kb, scr, F.lane, 1.f); }
            continue; } r -= I0;
        if (r < I1) { const int kb = r / 32, nb = r % 32; SrcWout S{a.in[I_ABWOUT], a.in[I_SNG], 32 * nb}; transpose_item(S, WoutT, 2048, 32 * nb, 64 * kb, scr, F.lane, 1.f); continue; } r -= I1;
        if (r < I2) { const int kb = r / 48, nb = r % 48; SrcPlain S{a.in[I_ATWIN], 1536, 32 * nb}; transpose_item(S, AtInT, 1024, 32 * nb, 64 * kb, scr, F.lane, 1.f); continue; } r -= I2;
        { const int kb = r / 32, nb = r % 32; SrcPlain S{a.in[I_ATWOUT], 1024, 32 * nb}; transpose_item(S, AtOutT, 1024, 32 * nb, 64 * kb, scr, F.lane, 1.f); }
    }
}
__device__ __forceinline__ void convert_moe_weights(Ctx& F, const Args& a, int layer, int skip_blocks, int it0 = 0, int it1 = 16 * 16 * 64 + 16 * 16 * 32) {
    if (F.bid < skip_blocks) return;
    LAS float* scr = (LAS float*)(F.lds + F.wave * 16384);
    bf16_t* WGU = (bf16_t*)(F.ws + WS_MOEW); bf16_t* WD = (bf16_t*)(F.ws + WS_MOEW + 64 * MiB);
    const size_t wl = (size_t)layer * 16 * 1024 * 1024;
    constexpr int IGU = 16 * 16 * 64, IDN = 16 * 16 * 32;
    for (int it = it0 + (F.bid - skip_blocks) * NWAVES + F.wave; it < it1; it += (F.G - skip_blocks) * NWAVES) {
        if (it < IGU) { const int e = it / 1024, r = it % 1024, kb = r / 64, nb = r % 64;
            SrcGU S{a.in[I_WG] + wl + (size_t)e * 1048576, a.in[I_WU] + wl + (size_t)e * 1048576, 16 * nb};
            transpose_item(S, WGU + (size_t)e * 2048 * 1024, 1024, 32 * nb, 64 * kb, scr, F.lane, 1.f); }
        else { const int r0 = it - IGU, e = r0 / 512, r = r0 % 512, kb = r / 32, nb = r % 32;
            SrcPlain S{a.in[I_WD] + wl + (size_t)e * 1048576, 1024, 32 * nb};
            transpose_item(S, WD + (size_t)e * 1024 * 1024, 1024, 32 * nb, 64 * kb, scr, F.lane, 1.f); }
    }
}
__device__ __forceinline__ void ada_phase(Ctx& F, const Args& a) {
    LAS float* red = (LAS float*)(F.lds + 8 * 16384);
    float* modv = (float*)(F.ws + WS_MODV);
    for (int item = F.bid; item < 2 * 96; item += F.G) {
        const int l = item / 96, n = (item % 96) * 64 + F.lane;
        float a0 = 0.f, a1 = 0.f, a2 = 0.f;
        const float* w = a.in[I_ADAW] + ((size_t)l * 1024 + F.wave * 128) * 6144 + n;
#pragma unroll 16
        for (int k = 0; k < 128; ++k) { const float wv = w[(size_t)k * 6144]; const int kk = F.wave * 128 + k;
            a0 += siluf(a.in[I_C][kk]) * wv; a1 += siluf(a.in[I_C][1024 + kk]) * wv; a2 += siluf(a.in[I_CCTX][kk]) * wv; }
        LAS float* rr = (LAS float*)F.lds;
        rr[(F.wave * 3 + 0) * 64 + F.lane] = a0; rr[(F.wave * 3 + 1) * 64 + F.lane] = a1; rr[(F.wave * 3 + 2) * 64 + F.lane] = a2;
        __syncthreads();
        if (F.wave < 3) { float s = 0.f;
#pragma unroll
            for (int w8 = 0; w8 < 8; ++w8) s += rr[(w8 * 3 + F.wave) * 64 + F.lane];
            modv[(l * 3 + F.wave) * 6144 + n] = s + a.in[I_ADAB][l * 6144 + n]; }
        __syncthreads();
    }
    (void)red;
}

template <int NC> __device__ __forceinline__ void row_dots(const RowF& h, const float* W, int lane, float (&acc)[NC]) {
#pragma unroll
    for (int i = 0; i < NC; ++i) acc[i] = 0.f;
#pragma unroll
    for (int j = 0; j < 4; ++j)
#pragma unroll
        for (int e = 0; e < 4; ++e) { const float x = h.v[j][e]; const f32x4* w = (const f32x4*)(W + (size_t)(4 * lane + 256 * j + e) * NC);
#pragma unroll
            for (int q = 0; q < NC / 4; ++q) { const f32x4 wv = w[q]; acc[4 * q + 0] += x * wv[0]; acc[4 * q + 1] += x * wv[1]; acc[4 * q + 2] += x * wv[2]; acc[4 * q + 3] += x * wv[3]; } }
}
template <int O, int N> __device__ __forceinline__ void xreduce_step(float (&acc)[N], int lane) {
    const bool up = (lane & O) != 0;
#pragma unroll
    for (int i = 0; i < O; ++i) { const float keep = up ? acc[i + O] : acc[i], send = up ? acc[i] : acc[i + O]; acc[i] = keep + __shfl_xor(send, O); }
}
template <int N> __device__ __forceinline__ float xreduce(float (&acc)[N], int lane) {
    if constexpr (N == 16) {
#pragma unroll
        for (int i = 0; i < 16; ++i) { acc[i] += __shfl_xor(acc[i], 32); acc[i] += __shfl_xor(acc[i], 16); }
    }
    if constexpr (N == 64) { xreduce_step<32, N>(acc, lane); xreduce_step<16, N>(acc, lane); }
    xreduce_step<8, N>(acc, lane); xreduce_step<4, N>(acc, lane); xreduce_step<2, N>(acc, lane); xreduce_step<1, N>(acc, lane);
    return acc[0];
}

__device__ __forceinline__ const float* x_row(const Args& a, int row) { return row < NLAT ? a.in[I_X] + (size_t)row * D : a.in[I_CTX] + (size_t)(row - NLAT) * D; }
__device__ __forceinline__ void rowpass_a(Ctx& F, const Args& a) {
    const float* modv = (const float*)(F.ws + WS_MODV);
    bf16_t* HB = (bf16_t*)(F.ws + WS_HB);
    int row = GWID(F); if (row >= NTOK) return;
    RowF xn = row_ld_f32(x_row(a, row), F.lane);
    for (; row < NTOK; row += NGW(F)) {
        const RowF x = xn; const int nrow = row + NGW(F);
        if (nrow < NTOK) xn = row_ld_f32(x_row(a, nrow), F.lane);
        const float* m = modv + mod_index(row) * 6144;
        const RowF h = row_modulate(x, m, m + 1024, F.lane);
        row_st_bf16(HB + (size_t)row * D, F.lane, h);
    }
}
__device__ __forceinline__ void stage_router(Ctx& F, const float* rw) {
    LAS f32x4* Wl = (LAS f32x4*)F.lds;
    for (int i = F.tid; i < 4096; i += NTHREADS) { const int d = i >> 2, q = i & 3; const f32x4 w = *(const f32x4*)(rw + d * 16 + q * 4);
        Wl[q * 1024 + ((d >> 8) * 4 + (d & 3)) * 64 + ((d >> 2) & 63)] = w; }
    __syncthreads();
}
__device__ __forceinline__ void row_dots16_lds(const RowF& h, const LAS f32x4* Wl, int lane, float (&acc)[16]) {
#pragma unroll
    for (int i = 0; i < 16; ++i) acc[i] = 0.f;
#pragma unroll
    for (int j = 0; j < 4; ++j)
#pragma unroll
        for (int e = 0; e < 4; ++e) { const float x = h.v[j][e];
#pragma unroll
            for (int q = 0; q < 4; ++q) { const f32x4 wv = Wl[q * 1024 + (j * 4 + e) * 64 + lane]; acc[4 * q + 0] += x * wv[0]; acc[4 * q + 1] += x * wv[1]; acc[4 * q + 2] += x * wv[2]; acc[4 * q + 3] += x * wv[3]; }
            if (e & 1) __builtin_amdgcn_sched_barrier(0); }
}
__device__ __forceinline__ void route_row(const RowF& h2, const LAS f32x4* Wl, const float* rb, int lane, int& e0, int& e1, float& g0, float& g1) {
    float acc[16]; row_dots16_lds(h2, Wl, lane, acc);
    const float logit = xreduce<16>(acc, lane);
    float mx = logit;
#pragma unroll
    for (int o = 8; o >= 1; o >>= 1) mx = fmaxf(mx, __shfl_xor(mx, o));
    const float ex = expf(logit - mx); float sm = ex;
#pragma unroll
    for (int o = 8; o >= 1; o >>= 1) sm += __shfl_xor(sm, o);
    const float p = ex / sm, sel = p + rb[lane & 15];
    float s4[4], p4[4];
#pragma unroll
    for (int i = 0; i < 4; ++i) s4[i] = __shfl(sel, (lane & 12) + i);
    float v1 = s4[0]; int i1 = 0;
#pragma unroll
    for (int i = 1; i < 4; ++i) if (s4[i] > v1) { v1 = s4[i]; i1 = i; }
    float v2 = -1e30f;
#pragma unroll
    for (int i = 0; i < 4; ++i) if (i != i1 && s4[i] > v2) v2 = s4[i];
    const float gs = v1 + v2;
    float best = __shfl(gs, 0); int bg = 0;
#pragma unroll
    for (int g = 1; g < 4; ++g) { const float t = __shfl(gs, 4 * g); if (t > best) { best = t; bg = g; } }
#pragma unroll
    for (int i = 0; i < 4; ++i) { s4[i] = __shfl(sel, 4 * bg + i); p4[i] = __shfl(p, 4 * bg + i); }
    v1 = s4[0]; i1 = 0; float q1 = p4[0];
#pragma unroll
    for (int i = 1; i < 4; ++i) if (s4[i] > v1) { v1 = s4[i]; i1 = i; q1 = p4[i]; }
    v2 = -1e30f; int i2 = 0; float q2 = 0.f;
#pragma unroll
    for (int i = 0; i < 4; ++i) if (i != i1 && s4[i] > v2) { v2 = s4[i]; i2 = i; q2 = p4[i]; }
    e0 = 4 * bg + i1; e1 = 4 * bg + i2; const float s = q1 + q2; g0 = q1 / s; g1 = q2 / s;
}
__device__ __forceinline__ void rowpass_b(Ctx& F, const Args& a, int layer, int nrows, const bf16_t* YB) {
    const float* modl = (const float*)(F.ws + WS_MODV) + layer * 3 * 6144;
    bf16_t* XL = (bf16_t*)(F.ws + WS_XL); bf16_t* HB = (bf16_t*)(F.ws + WS_HB);
    int* tok_e = (int*)(F.ws + WS_ROUTE); int* tok_pos = tok_e + 2 * NTOK; float* tok_g = (float*)(tok_pos + 2 * NTOK);
    unsigned* cnt = CTLP(F) + (layer ? CW_CNT1 : CW_CNT0);
    stage_router(F, a.in[I_RW]);
    LAS int* lcnt = (LAS int*)(F.lds + 65536); LAS int* gbase = lcnt + 16; LAS int* nrow = lcnt + 32; LAS int* lrow = lcnt + 64;
    if (F.tid < 33) lcnt[F.tid] = 0;
    __syncthreads();
    RowF xf_n; RowRaw xr_n, y_n;
    { const int r0 = GWID(F); if (r0 < nrows) { if (layer) xr_n = row_ldraw_bf16(XL + (size_t)r0 * D, F.lane); else xf_n = row_ld_f32(x_row(a, r0), F.lane); y_n = row_ldraw_bf16(YB + (size_t)r0 * D, F.lane); } }
    for (int row = GWID(F); row < nrows; row += NGW(F)) {
        const float* m = modl + mod_index(row) * 6144;
        RowF x = layer ? row_cvt(xr_n) : xf_n; const RowF y = row_cvt(y_n); const int nxr = row + NGW(F);
        if (nxr < nrows) { if (layer) xr_n = row_ldraw_bf16(XL + (size_t)nxr * D, F.lane); else xf_n = row_ld_f32(x_row(a, nxr), F.lane); y_n = row_ldraw_bf16(YB + (size_t)nxr * D, F.lane); }
        const RowF gt = row_ld_f32(m + 2048, F.lane);
#pragma unroll
        for (int j = 0; j < 4; ++j) x.v[j] = ALPHA * x.v[j] + gt.v[j] * y.v[j];
        row_layernorm(x, a.in[I_LNG] + (layer * 2) * D, a.in[I_LNB] + (layer * 2) * D, F.lane);
        row_st_bf16(XL + (size_t)row * D, F.lane, x);
        const RowF h2 = row_modulate(x, m + 3072, m + 4096, F.lane);
        row_st_bf16(HB + (size_t)row * D, F.lane, h2);
        int e0, e1; float g0, g1; route_row(h2, (const LAS f32x4*)F.lds, a.in[I_RB], F.lane, e0, e1, g0, g1);
        if (F.lane == 0) {
            const int p0 = __hip_atomic_fetch_add(lcnt + e0, 1, __ATOMIC_RELAXED, __HIP_MEMORY_SCOPE_WORKGROUP), p1 = __hip_atomic_fetch_add(lcnt + e1, 1, __ATOMIC_RELAXED, __HIP_MEMORY_SCOPE_WORKGROUP);
            const int ix = __hip_atomic_fetch_add(nrow, 1, __ATOMIC_RELAXED, __HIP_MEMORY_SCOPE_WORKGROUP);
            lrow[ix * 4 + 0] = row; lrow[ix * 4 + 1] = e0 | (e1 << 8); lrow[ix * 4 + 2] = p0; lrow[ix * 4 + 3] = p1;
            tok_e[row * 2] = e0; tok_e[row * 2 + 1] = e1; tok_g[row * 2] = g0; tok_g[row * 2 + 1] = g1;
        }
    }
    __syncthreads();
    if (F.tid < 16) gbase[F.tid] = (int)atomicAdd(cnt + F.tid, (unsigned)lcnt[F.tid]);
    __syncthreads();
    if (F.tid < nrow[0]) { const int row = lrow[F.tid * 4], ee = lrow[F.tid * 4 + 1];
        const int e0 = ee & 255, e1 = ee >> 8, p0 = gbase[e0] + lrow[F.tid * 4 + 2], p1 = gbase[e1] + lrow[F.tid * 4 + 3];
        tok_pos[row * 2] = p0; tok_pos[row * 2 + 1] = p1; int* tab = (int*)(F.ws + WS_TOKTAB); tab[(size_t)e0 * NTOK + p0] = row; tab[(size_t)e1 * NTOK + p1] = row; }
}
__device__ __forceinline__ void moe_offsets(Ctx& F, int layer) {
    __syncthreads();
    if (F.tid == 0) { const unsigned* cnt = CTLP(F) + (layer ? CW_CNT1 : CW_CNT0); int acc = 0;
        for (int e = 0; e < 16; ++e) { const int c = (int)__hip_atomic_load(cnt + e, __ATOMIC_RELAXED, __HIP_MEMORY_SCOPE_AGENT); MISCP(F)[e] = acc; MISCP(F)[100 + e] = c; acc += (c + 255) >> 8; }
        MISCP(F)[16] = acc; }
    __syncthreads();
}
__device__ __forceinline__ void moe_streams(Ctx& F, int layer, int li) {
    moe_offsets(F, layer);
    if (F.tid == 0) { const unsigned* bar = CTLP(F) + CW_BAR + li * 4096; const int x = MISCP(F)[35]; int tot = 0, before = 0, mine = 1;
        for (int j = 0; j < 16; ++j) { const int c = (int)__hip_atomic_load(bar + XB_XCNT(j), __ATOMIC_RELAXED, __HIP_MEMORY_SCOPE_AGENT); tot += c; before += (j < x) ? c : 0; mine = (j == x) ? c : mine; }
        const int ntm = MISCP(F)[16]; const int m0 = (int)((long)ntm * before / tot), m1 = (int)((long)ntm * (before + mine) / tot);
        MISCP(F)[120] = m0; MISCP(F)[121] = m1 - m0; MISCP(F)[122] = mine; MISCP(F)[123] = MISCP(F)[34]; }
    __syncthreads();
}
__device__ __forceinline__ void moe_scatter(Ctx& F, int layer, int nrows) {
    moe_offsets(F, layer);
    const bf16_t* HB = (const bf16_t*)(F.ws + WS_HB); bf16_t* XS = (bf16_t*)(F.ws + WS_XS);
    const int* tok_e = (const int*)(F.ws + WS_ROUTE); const int* tok_pos = tok_e + 2 * NTOK; int* tok_slot = (int*)(F.ws + WS_ROUTE + MiB);
    for (int row = GWID(F); row < nrows; row += NGW(F)) {
        const int e0 = tok_e[row * 2], e1 = tok_e[row * 2 + 1];
        const int s0 = MISCP(F)[e0] * 256 + tok_pos[row * 2], s1 = MISCP(F)[e1] * 256 + tok_pos[row * 2 + 1];
        const u32x4* src = (const u32x4*)(HB + (size_t)row * D) + F.lane; const u32x4 v0 = src[0], v1 = src[64];
        u32x4* d0 = (u32x4*)(XS + (size_t)s0 * D) + F.lane; u32x4* d1 = (u32x4*)(XS + (size_t)s1 * D) + F.lane;
        d0[0] = v0; d0[64] = v1; d1[0] = v0; d1[64] = v1;
        if (F.lane == 0) { tok_slot[row * 2] = s0; tok_slot[row * 2 + 1] = s1; }
    }
}
__device__ __forceinline__ void rowpass_c(Ctx& F, const Args& a, int layer, int nrows, bool last) {
    const float* modl = (const float*)(F.ws + WS_MODV) + layer * 3 * 6144;
    bf16_t* XL = (bf16_t*)(F.ws + WS_XL); bf16_t* HB = (bf16_t*)(F.ws + WS_HB); const bf16_t* YS = (const bf16_t*)(F.ws + WS_YS);
    const int* tok_e = (const int*)(F.ws + WS_ROUTE); const int* tok_pos = tok_e + 2 * NTOK; const float* tok_g = (const float*)(F.ws + WS_ROUTE) + 4 * NTOK;
    moe_offsets(F, layer);
    const int step = NGW(F); int row = GWID(F);
    int s0n = 0, s1n = 0, s0nn = 0, s1nn = 0; float g0n = 0.f, g1n = 0.f, g0nn = 0.f, g1nn = 0.f; RowRaw xr_n, y0_n, y1_n;
#define RC_SLOTS(r_, s0_, s1_, g0_, g1_) do { s0_ = MISCP(F)[tok_e[(r_) * 2]] * 256 + tok_pos[(r_) * 2]; s1_ = MISCP(F)[tok_e[(r_) * 2 + 1]] * 256 + tok_pos[(r_) * 2 + 1]; g0_ = tok_g[(r_) * 2]; g1_ = tok_g[(r_) * 2 + 1]; } while (0)
    if (row < nrows) { RC_SLOTS(row, s0n, s1n, g0n, g1n); xr_n = row_ldraw_bf16(XL + (size_t)row * D, F.lane); y0_n = row_ldraw_bf16(YS + (size_t)s0n * D, F.lane); y1_n = row_ldraw_bf16(YS + (size_t)s1n * D, F.lane);
        if (row + step < nrows) RC_SLOTS(row + step, s0nn, s1nn, g0nn, g1nn); }
    for (; row < nrows; row += step) {
        const float* m = modl + mod_index(row) * 6144;
        RowF x = row_cvt(xr_n); const RowF y0 = row_cvt(y0_n), y1 = row_cvt(y1_n); const float g0 = g0n, g1 = g1n;
        if (row + step < nrows) { const int nr = row + step; s0n = s0nn; s1n = s1nn; g0n = g0nn; g1n = g1nn;
            xr_n = row_ldraw_bf16(XL + (size_t)nr * D, F.lane); y0_n = row_ldraw_bf16(YS + (size_t)s0n * D, F.lane); y1_n = row_ldraw_bf16(YS + (size_t)s1n * D, F.lane);
            if (nr + step < nrows) RC_SLOTS(nr + step, s0nn, s1nn, g0nn, g1nn); }
        const RowF gt = row_ld_f32(m + 5120, F.lane);
#pragma unroll
        for (int j = 0; j < 4; ++j) x.v[j] = ALPHA * x.v[j] + gt.v[j] * (g0 * y0.v[j] + g1 * y1.v[j]);
        row_layernorm(x, a.in[I_LNG] + (layer * 2 + 1) * D, a.in[I_LNB] + (layer * 2 + 1) * D, F.lane);
        if (last) { row_st_f32(a.out + (size_t)row * D, F.lane, x); }
        else { row_st_bf16(XL + (size_t)row * D, F.lane, x); const float* m1 = modl + 3 * 6144 + mod_index(row) * 6144;
            const RowF h = row_modulate(x, m1, m1 + 1024, F.lane); row_st_bf16(HB + (size_t)row * D, F.lane, h); }
    }
#undef RC_SLOTS
}

template <class Epi, class Sched> __device__ __forceinline__ void run_gemm_gather(Ctx& F, const bf16_t* A, const bf16_t* Bt, int K, const Sched& S, const Epi& E) {
    pg8::Gemm g{A, Bt, 0, 0, K};
    pg8::gemm_phase<Epi, Sched, true, true, true>(F.lds, g, S, E, F.wave * 64 + fresh_lane());
    __syncthreads();
}
template <class Epi, class Sched> __device__ __forceinline__ void run_gemm(Ctx& F, const bf16_t* A, const bf16_t* Bt, int M, int N, int K, const Sched& S, const Epi& E) {
    pg8::Gemm g{A, Bt, M, N, K};
    pg8::gemm_phase<Epi, Sched, true, true>(F.lds, g, S, E, F.wave * 64 + fresh_lane());
    __syncthreads();
}

__device__ __forceinline__ void qkprep_phase(Ctx& F, const Args& a) {
    bf16_t* Q = (bf16_t*)(F.ws + WS_Q); bf16_t* KB = (bf16_t*)(F.ws + WS_KB);
    constexpr int NQ = NLAT * 8, NK = NBATCH * SLEN * 2;
    const float qg0 = a.in[I_QG][F.lane], qg1 = a.in[I_QG][F.lane + 64], kg0 = a.in[I_KG][F.lane], kg1 = a.in[I_KG][F.lane + 64];
    const float* ropet = (const float*)(F.ws + WS_ROPE);
    for (int it = NQ + GWID(F); it < NQ + NK; it += NGW(F)) {
        bf16_t* p; int t; bool rope; float g0, g1;
        if (it < NQ) { const int row = it >> 3, hh = it & 7; p = Q + (size_t)row * 1024 + hh * 128; t = row % SEQ; rope = true; g0 = qg0; g1 = qg1; }
        else { const int r = it - NQ, krow = r >> 1, kvh = r & 1, key = krow % SLEN; p = KB + (size_t)krow * 256 + kvh * 128; rope = key >= CTXL; t = key - CTXL; g0 = kg0; g1 = kg1; }
        float x1 = bf2f(p[F.lane]), x2 = bf2f(p[F.lane + 64]);
        const float r = rsqrtf(wave_sum(x1 * x1 + x2 * x2) * (1.f / 128.f) + 1e-6f);
        x1 *= r * g0; x2 *= r * g1;
        float o1 = x1, o2 = x2;
        if (rope) { const float* rp = ropet + ((F.lane < 32) ? (t / 64) : (t % 64)) * 64 + 2 * (F.lane & 31); const float cs = rp[0], sn = rp[1]; o1 = x1 * cs - x2 * sn; o2 = x2 * cs + x1 * sn; }
        p[F.lane] = f2bf(o1); p[F.lane + 64] = f2bf(o2);
    }
}
__device__ __forceinline__ void kprep_tile(Ctx& F, const Args& a, int pm) {
    bf16_t* KB = (bf16_t*)(F.ws + WS_KB); const float* ropet = (const float*)(F.ws + WS_ROPE);
    const int l16 = F.lane & 15, sub = F.lane >> 4; const bool rope = pm < NLAT / 256;
    const f32x4 g0 = *(const f32x4*)(a.in[I_KG] + 8 * l16), g1 = *(const f32x4*)(a.in[I_KG] + 8 * l16 + 4);
    const float sg = l16 < 8 ? -1.f : 1.f;
#pragma unroll 2
    for (int it = F.wave * 4 + sub; it < 512; it += 32) {
        const int row = pm * 256 + (it >> 1), kvh = it & 1; int key, t = 0;
        if (rope) { const int b = row / SEQ; t = row % SEQ; key = b * SLEN + CTXL + t; } else { const int r = row - NLAT; key = (r / CTXL) * SLEN + (r % CTXL); }
        u32x4* p = (u32x4*)(KB + (size_t)key * 256 + kvh * 128 + 8 * l16);
        const u32x4 w = *p;
        f32x4 xa = {__uint_as_float(w.x << 16), __uint_as_float(w.x & 0xffff0000u), __uint_as_float(w.y << 16), __uint_as_float(w.y & 0xffff0000u)};
        f32x4 xb = {__uint_as_float(w.z << 16), __uint_as_float(w.z & 0xffff0000u), __uint_as_float(w.w << 16), __uint_as_float(w.w & 0xffff0000u)};
        float ss = ((xa[0] * xa[0] + xa[1] * xa[1]) + (xa[2] * xa[2] + xa[3] * xa[3])) + ((xb[0] * xb[0] + xb[1] * xb[1]) + (xb[2] * xb[2] + xb[3] * xb[3]));
        ss += __shfl_xor(ss, 1); ss += __shfl_xor(ss, 2); ss += __shfl_xor(ss, 4); ss += __shfl_xor(ss, 8);
        const float rs = rsqrtf(ss * (1.f / 128.f) + 1e-6f);
        xa = xa * (g0 * rs); xb = xb * (g1 * rs);
        if (rope) { const float* rp = ropet + (((l16 & 7) < 4) ? (t / 64) : (t % 64)) * 64 + 16 * (l16 & 3);
            const f32x4 c0 = *(const f32x4*)rp, c1 = *(const f32x4*)(rp + 4), c2 = *(const f32x4*)(rp + 8), c3 = *(const f32x4*)(rp + 12);
            const f32x4 csa = {c0[0], c0[2], c1[0], c1[2]}, sna = {c0[1], c0[3], c1[1], c1[3]}, csb = {c2[0], c2[2], c3[0], c3[2]}, snb = {c2[1], c2[3], c3[1], c3[3]};
            f32x4 pa, pb;
            pa[0] = __shfl_xor(xa[0], 8); pa[1] = __shfl_xor(xa[1], 8); pa[2] = __shfl_xor(xa[2], 8); pa[3] = __shfl_xor(xa[3], 8);
            pb[0] = __shfl_xor(xb[0], 8); pb[1] = __shfl_xor(xb[1], 8); pb[2] = __shfl_xor(xb[2], 8); pb[3] = __shfl_xor(xb[3], 8);
            xa = xa * csa + (pa * sna) * sg; xb = xb * csb + (pb * snb) * sg; }
        u32x4 o; o.x = pk2(xa[0], xa[1]); o.y = pk2(xa[2], xa[3]); o.z = pk2(xb[0], xb[1]); o.w = pk2(xb[2], xb[3]);
        *p = o;
    }
}
__device__ __forceinline__ void attn_phase(Ctx& F, const Args& a) {
    const bf16_t* Q = (const bf16_t*)(F.ws + WS_Q); const bf16_t* KB = (const bf16_t*)(F.ws + WS_KB); const bf16_t* VB = (const bf16_t*)(F.ws + WS_VB); bf16_t* AO = (bf16_t*)(F.ws + WS_AO);
    const float gq = wave_max(fmaxf(fabsf(a.in[I_QG][F.lane]), fabsf(a.in[I_QG][F.lane + 64]))), gk = wave_max(fmaxf(fabsf(a.in[I_KG][F.lane]), fabsf(a.in[I_KG][F.lane + 64])));
    const bool fast = 11.3137085f * 1.4426950408889634f * 1.02f * gq * gk < 60.f;
    for (int i = 0;; ++i) {
        const int L = i * F.G + F.bid; if (L >= 512) break;
        const int xcd = L & 7, off = L >> 3, combo = xcd >> 1, idx = (xcd & 1) * 64 + off, hl = idx >> 5, qb = idx & 31;
        const int b = combo >> 1, kvh = combo & 1, h = kvh * 4 + hl;
        const size_t qoff = ((size_t)b * SEQ + qb * 256) * 1024 + h * 128, koff = (size_t)b * SLEN * 256 + kvh * 128;
        if (fast) attn::attn_dense_body<attn::bf16, true, 1>(Q + qoff, KB + koff, VB + koff, AO + qoff, SLEN, (char*)F.lds, F.wave * 64 + fresh_lane(), a.in[I_QG], qb * 256, (const float*)(F.ws + WS_ROPE));
        else attn::attn_dense_body<attn::bf16, false, 1>(Q + qoff, KB + koff, VB + koff, AO + qoff, SLEN, (char*)F.lds, F.wave * 64 + fresh_lane(), a.in[I_QG], qb * 256, (const float*)(F.ws + WS_ROPE));
        __syncthreads();
    }
}

typedef short v4i16_t __attribute__((ext_vector_type(4)));
typedef const LAS unsigned char* lds_cptr;
constexpr float LOG2E = 1.4426950408889634f;
__device__ __forceinline__ s16x4 vtr(lds_cptr p) { return __builtin_bit_cast(s16x4, __builtin_amdgcn_ds_read_tr16_b64_v4i16((LAS v4i16_t*)p)); }
__device__ __forceinline__ bf16x8 trfrag(lds_cptr tb, int d0, int ks) {
    const s16x4 l = vtr(tb + attn::v_rd_off(d0, ks, 0)), h = vtr(tb + attn::v_rd_off(d0, ks, 1));
    return (bf16x8){l[0], l[1], l[2], l[3], h[0], h[1], h[2], h[3]}; }
__device__ __forceinline__ bf16x8 rowfrag(lds_cptr tile, int blk, int d0, int r32, int hi) { return *(const LAS bf16x8*)(tile + KSWZ(32 * blk + r32, (d0 * 16 + hi * 8) * 2)); }
__device__ __forceinline__ u32x4 scale8(u32x4 v, float s) { u32x4 o;
#pragma unroll
    for (int i = 0; i < 4; ++i) o[i] = pk2(__uint_as_float(v[i] << 16) * s, __uint_as_float(v[i] & 0xffff0000u) * s);
    return o; }
__device__ __forceinline__ bf16x8 scale8f(bf16x8 v, float s) { return __builtin_bit_cast(bf16x8, scale8(__builtin_bit_cast(u32x4, v), s)); }
__device__ __forceinline__ float wave_incl_sum(float v, int lane) {
#pragma unroll
    for (int o = 1; o < 64; o <<= 1) { const float t = __shfl_up(v, o); if (lane >= o) v += t; }
    return v; }
__device__ __forceinline__ float wave_incl_max(float v, int lane) {
#pragma unroll
    for (int o = 1; o < 64; o <<= 1) { const float t = __shfl_up(v, o); if (lane >= o) v = fmaxf(v, t); }
    return v; }
__device__ __forceinline__ float wave_incl_max_rev(float v, int lane) {
#pragma unroll
    for (int o = 1; o < 64; o <<= 1) { const float t = __shfl_down(v, o); if (lane + o < 64) v = fmaxf(v, t); }
    return v; }
__device__ __forceinline__ float half_swap_add(float v) { auto rr = __builtin_amdgcn_permlane32_swap(__float_as_uint(v), __float_as_uint(v), false, false); return __uint_as_float(rr[0]) + __uint_as_float(rr[1]); }
#define MX_PK4(P, BASE, OUT) do { unsigned a0_ = pk2(P[BASE + 0], P[BASE + 1]), a1_ = pk2(P[BASE + 2], P[BASE + 3]); \
    unsigned b0_ = pk2(P[BASE + 4], P[BASE + 5]), b1_ = pk2(P[BASE + 6], P[BASE + 7]); \
    auto r0_ = __builtin_amdgcn_permlane32_swap(a0_, b0_, false, false); auto r1_ = __builtin_amdgcn_permlane32_swap(a1_, b1_, false, false); \
    u32x4 w_ = {r0_[0], r1_[0], r0_[1], r1_[1]}; OUT = __builtin_bit_cast(bf16x8, w_); } while (0)

__device__ __forceinline__ const bf16_t* launder_v(const bf16_t* p) { asm volatile("" : "+v"(p)); return p; }
constexpr int MX_MISC = MISC_OFF + 1024;
__device__ __forceinline__ int st_off(int row, int col) { return (((row >> 5) * 8 + (col >> 4)) << 9) + ((row & 31) << 4) + (col & 15); }
__device__ __forceinline__ int mx_unit(int bid, int G, int k, int off) { const int kmain = 528 / G, nmain = kmain * G; if (k < kmain) return bid + k * G; if (k == kmain) { const int j = bid - off; return (j >= 0 && j < 528 - nmain) ? nmain + j : -1; } return -1; }

constexpr int CONV_RUN = 26;
__device__ __forceinline__ int conv_seg(int row) { return row < NLAT ? row / SEQ : 2 + (row - NLAT) / CTXL; }
__device__ __forceinline__ void conv_unpack(u32x4 v, float (&f)[8]) {
#pragma unroll
    for (int e = 0; e < 4; ++e) { f[2 * e] = __uint_as_float(v[e] << 16); f[2 * e + 1] = __uint_as_float(v[e] & 0xffff0000u); } }
__device__ __forceinline__ void conv_phase(Ctx& F, const Args& a) {
    const bf16_t* XBC = (const bf16_t*)(F.ws + WS_XBC); bf16_t* XC = (bf16_t*)(F.ws + WS_XC);
    const float* cw = a.in[I_CONVW]; const float* cb = a.in[I_CONVB];
    constexpr int NRUN = (NTOK + CONV_RUN - 1) / CONV_RUN;
    for (int it = F.bid * NTHREADS + F.tid; it < NRUN * 192; it += F.G * NTHREADS) {
        const int c8 = (it % 192) * 8, r0 = (it / 192) * CONV_RUN, r1 = (r0 + CONV_RUN < NTOK) ? r0 + CONV_RUN : NTOK;
        float w[4][8], bias[8];
#pragma unroll
        for (int j = 0; j < 4; ++j) { const f32x4 w0 = *(const f32x4*)(cw + j * 1536 + c8), w1 = *(const f32x4*)(cw + j * 1536 + c8 + 4); w[j][0] = w0[0]; w[j][1] = w0[1]; w[j][2] = w0[2]; w[j][3] = w0[3]; w[j][4] = w1[0]; w[j][5] = w1[1]; w[j][6] = w1[2]; w[j][7] = w1[3]; }
        { const f32x4 b0 = *(const f32x4*)(cb + c8), b1 = *(const f32x4*)(cb + c8 + 4); bias[0] = b0[0]; bias[1] = b0[1]; bias[2] = b0[2]; bias[3] = b0[3]; bias[4] = b1[0]; bias[5] = b1[1]; bias[6] = b1[2]; bias[7] = b1[3]; }
        const u32x4 zero = {0u, 0u, 0u, 0u};
        const bf16_t* base = XBC + c8;
        u32x4 xm2 = r0 >= 2 ? *(const u32x4*)(base + (size_t)(r0 - 2) * 1536) : zero, xm1 = r0 >= 1 ? *(const u32x4*)(base + (size_t)(r0 - 1) * 1536) : zero;
        u32x4 x0 = *(const u32x4*)(base + (size_t)r0 * 1536), xp1 = r0 + 1 < NTOK ? *(const u32x4*)(base + (size_t)(r0 + 1) * 1536) : zero;
        for (int r = r0; r < r1; ++r) {
            const u32x4 xp2 = r + 2 < NTOK ? *(const u32x4*)(base + (size_t)(r + 2) * 1536) : zero;
            const int sg = conv_seg(r);
            const bool v0 = r >= 2 && conv_seg(r - 2) == sg, v1 = r >= 1 && conv_seg(r - 1) == sg, v3 = r + 1 < NTOK && conv_seg(r + 1) == sg;
            float f0[8], f1[8], f2[8], f3[8]; conv_unpack(xm2, f0); conv_unpack(xm1, f1); conv_unpack(x0, f2); conv_unpack(xp1, f3);
            float acc[8];
#pragma unroll
            for (int e = 0; e < 8; ++e) acc[e] = bias[e] + (v0 ? w[0][e] * f0[e] : 0.f) + (v1 ? w[1][e] * f1[e] : 0.f) + w[2][e] * f2[e] + (v3 ? w[3][e] * f3[e] : 0.f);
            u32x4 o; o[0] = pk2(siluf(acc[0]), siluf(acc[1])); o[1] = pk2(siluf(acc[2]), siluf(acc[3])); o[2] = pk2(siluf(acc[4]), siluf(acc[5])); o[3] = pk2(siluf(acc[6]), siluf(acc[7]));
            *(u32x4*)(XC + (size_t)r * 1536 + c8) = o;
            xm2 = xm1; xm1 = x0; x0 = xp1; xp1 = xp2;
        }
    }
}

struct MlGate { float b0, b1, G0, G1, total; };
__device__ __forceinline__ MlGate ml_gate(const float* GATES, int row0, int dir, int h, int lane) {
    const float* g0 = GATES + (size_t)(row0 + 2 * lane) * NGATE; const float* g1 = g0 + NGATE;
    const float lf0 = g0[8 + dir * 4 + h], lf1 = g1[8 + dir * 4 + h], ig0 = g0[dir * 4 + h], ig1 = g1[dir * 4 + h];
    const float incl = wave_incl_sum(lf0 + lf1, lane), total = __shfl(incl, 63);
    MlGate r; r.total = total;
    if (dir == 0) { r.b0 = incl - lf1; r.b1 = incl; } else { r.b0 = total - incl + lf0 + lf1; r.b1 = total - incl + lf1; }
    r.G0 = ig0 - r.b0; r.G1 = ig1 - r.b1; return r;
}


__device__ __forceinline__ void mlstm_a_phase(Ctx& F, int off) {
    const bf16_t* QK = (const bf16_t*)(F.ws + WS_QK); const bf16_t* V = (const bf16_t*)(F.ws + WS_V); const float* GATES = (const float*)(F.ws + WS_GATES);
    bf16_t* DC = (bf16_t*)(F.ws + WS_DC); float* DN = (float*)(F.ws + WS_DN); float* MS = (float*)(F.ws + WS_MS);
    LAS unsigned char* Vt = F.lds; LAS unsigned char* Kw = F.lds + 65536;
    LAS float* wsc = (LAS float*)(F.lds + MX_MISC); LAS float* dnp = (LAS float*)(F.lds + MX_MISC + 1024);
    for (int k_ = 0;; ++k_) { const int u = mx_unit(F.bid, F.G, k_, off); if (u < 0) break;
        const int lane = fresh_lane(), tid = F.wave * 64 + lane, r32 = lane & 31, hi = lane >> 5, sr = tid >> 4, sc8 = (tid & 15) * 8, rdb = attn::v_rd_base(lane);
        const int b = u / 264, rem = u % 264, cid = rem >> 2, h = rem & 3, row0 = chunk_row0(b, cid);
        if (F.wave < 2) { const int dir = F.wave, chain = (b * 4 + h) * 2 + dir; typedef float f32x2v __attribute__((ext_vector_type(2)));
            *(LAS f32x2v*)(wsc + dir * 128 + 2 * lane) = *(const f32x2v*)((const float*)(F.ws + WS_MLG) + (size_t)(chain * NCH + cid) * 512 + 384 + 2 * lane); }
        __syncthreads();
        float dnacc[2][8];
#pragma unroll
        for (int d = 0; d < 2; ++d)
#pragma unroll
            for (int e = 0; e < 8; ++e) dnacc[d][e] = 0.f;
#pragma unroll
        for (int i = 0; i < 4; ++i) { const int s = sr + 32 * i; const size_t grow = (size_t)(row0 + s) * 1024;
#pragma unroll
            for (int vb = 0; vb < 2; ++vb) { const u32x4 v = *(const u32x4*)(V + grow + h * 256 + vb * 128 + sc8); *(LAS u32x4*)(Vt + ((s >> 6) * 2 + vb) * 16384 + attn::v_st(s & 63, sc8)) = v; }
            const u32x4 kv = *(const u32x4*)(QK + grow + 512 + h * 128 + sc8);
#pragma unroll
            for (int d = 0; d < 2; ++d) { const float w = wsc[d * 128 + s];
                *(LAS u32x4*)(Kw + (d * 2 + (s >> 6)) * 16384 + attn::v_st(s & 63, sc8)) = scale8(kv, w);
#pragma unroll
                for (int e = 0; e < 4; ++e) { dnacc[d][2 * e] += w * __uint_as_float(kv[e] << 16); dnacc[d][2 * e + 1] += w * __uint_as_float(kv[e] & 0xffff0000u); } } }
#pragma unroll
        for (int d = 0; d < 2; ++d)
#pragma unroll
            for (int e = 0; e < 8; ++e) { float t = dnacc[d][e]; t += __shfl_xor(t, 16); t += __shfl_xor(t, 32); if ((lane >> 4) == 0) dnp[(F.wave * 2 + d) * 128 + sc8 + e] = t; }
        __syncthreads();
        {   const int dir = F.wave >> 2, vq = F.wave & 3;
            f32x16 acc[2][4];
#pragma unroll
            for (int i = 0; i < 2; ++i)
#pragma unroll
                for (int n = 0; n < 4; ++n) acc[i][n] = f32x16{};
#pragma unroll
            for (int ks = 0; ks < 8; ++ks) { const int sblk = ks >> 2, KS = ks & 3;
                bf16x8 af[2], bfr[4];
#pragma unroll
                for (int i = 0; i < 2; ++i) af[i] = trfrag(Vt + (sblk * 2 + (vq >> 1)) * 16384 + rdb, (2 * vq + i) & 3, KS);
#pragma unroll
                for (int n = 0; n < 4; ++n) bfr[n] = trfrag(Kw + (dir * 2 + sblk) * 16384 + rdb, n, KS);
#pragma unroll
                for (int i = 0; i < 2; ++i)
#pragma unroll
                    for (int n = 0; n < 4; ++n) acc[i][n] = __builtin_amdgcn_mfma_f32_32x32x16_bf16(af[i], bfr[n], acc[i][n], 0, 0, 0); }
            const int chain = (b * 4 + h) * 2 + dir;
            bf16_t* dst = DC + (size_t)(chain * NCH + cid) * 256 * 128;
#pragma unroll
            for (int i = 0; i < 2; ++i)
#pragma unroll
                for (int n = 0; n < 4; ++n)
#pragma unroll
                    for (int r = 0; r < 16; ++r) dst[st_off(64 * vq + 32 * i + attn::crow(r, hi), 32 * n + r32)] = f2bf(acc[i][n][r]);
        }
        if (tid < 256) { const int dir = tid >> 7, d = tid & 127; float s = 0.f;
#pragma unroll
            for (int w = 0; w < 8; ++w) s += dnp[(w * 2 + dir) * 128 + d];
            const int chain = (b * 4 + h) * 2 + dir; DN[(size_t)(chain * NCH + cid) * 128 + d] = s; }
        __syncthreads();
    }
}

struct SsGate { float dt0, dt1, acs0, acs1, total; };
__device__ __forceinline__ SsGate ss_gate(const float* GATES, int row0, int dir, int head, float aneg, int lane) {
    const float* g0 = GATES + (size_t)(row0 + 2 * lane) * NGATE; const float* g1 = g0 + NGATE;
    SsGate r; r.dt0 = g0[16 + dir * 16 + head]; r.dt1 = g1[16 + dir * 16 + head];
    const float a0 = r.dt0 * aneg, a1 = r.dt1 * aneg;
    const float incl = wave_incl_sum(a0 + a1, lane); r.total = __shfl(incl, 63);
    if (dir == 0) { r.acs0 = incl - a1; r.acs1 = incl; } else { r.acs0 = r.total - incl + a0 + a1; r.acs1 = r.total - incl + a1; }
    return r;
}
__device__ __forceinline__ void gatescan_phase(Ctx& F, const Args& a) {
    const float* GATES = (const float*)(F.ws + WS_GATES); float* MLG = (float*)(F.ws + WS_MLG); float* SSG = (float*)(F.ws + WS_SSG);
    float* MS = (float*)(F.ws + WS_MS); float* AEND = (float*)(F.ws + WS_AEND);
    typedef float f32x2v __attribute__((ext_vector_type(2)));
    const int lane = F.lane;
    for (int it = GWID(F); it < 16 * NCH + 64 * NCH; it += NGW(F)) {
        if (it < 16 * NCH) { const int chain = it / NCH, cid = it % NCH, dir = chain & 1, h = (chain >> 1) & 3, b = chain >> 3, row0 = chunk_row0(b, cid);
            const MlGate g = ml_gate(GATES, row0, dir, h, lane);
            const float gmx = fmaxf(g.G0, g.G1), gm = wave_max(gmx); float P0, P1;
            if (dir == 0) { const float pm = wave_incl_max(gmx, lane); float ex = __shfl_up(pm, 1); if (lane == 0) ex = -1e30f; P0 = fmaxf(ex, g.G0); P1 = pm; }
            else { const float pm = wave_incl_max_rev(gmx, lane); float ex = __shfl_down(pm, 1); if (lane == 63) ex = -1e30f; P1 = fmaxf(ex, g.G1); P0 = pm; }
            float* o = MLG + (size_t)it * 512 + 2 * lane;
            *(f32x2v*)(o) = (f32x2v){g.b0, g.b1}; *(f32x2v*)(o + 128) = (f32x2v){g.G0, g.G1}; *(f32x2v*)(o + 256) = (f32x2v){P0, P1}; *(f32x2v*)(o + 384) = (f32x2v){expf(g.G0 - gm), expf(g.G1 - gm)};
            if (lane == 0) { MS[it * 4 + 0] = g.total; MS[it * 4 + 1] = g.total + gm; } }
        else { const int i2 = it - 16 * NCH, chain = i2 / NCH, cid = i2 % NCH, dir = chain & 1, head = (chain >> 1) & 15, b = chain >> 5, row0 = chunk_row0(b, cid);
            const float aneg = -expf(a.in[I_ALOG][dir * 16 + head]); const SsGate s = ss_gate(GATES, row0, dir, head, aneg, lane);
            float* o = SSG + (size_t)i2 * 384 + 2 * lane;
            *(f32x2v*)(o) = (f32x2v){s.acs0, s.acs1}; *(f32x2v*)(o + 128) = (f32x2v){s.dt0, s.dt1}; *(f32x2v*)(o + 256) = (f32x2v){s.dt0 * expf(s.total - s.acs0), s.dt1 * expf(s.total - s.acs1)};
            if (lane == 0) AEND[i2] = s.total; }
    }
}
template <bool BM_ROW> __device__ __forceinline__ void ssd_stage(Ctx& F, const bf16_t* XC, int row0, int g, int hh, LAS unsigned char* Xt, LAS unsigned char* Bt) {
    const int tid_ = F.wave * 64 + fresh_lane(), sr = tid_ >> 4, sc8 = (tid_ & 15) * 8;
#pragma unroll
    for (int i = 0; i < 4; ++i) { const int s = sr + 32 * i; const bf16_t* rowp = XC + (size_t)(row0 + s) * 1536;
#pragma unroll
        for (int cb = 0; cb < 2; ++cb) { const u32x4 v = *(const u32x4*)(rowp + (g * 8 + hh * 4) * 64 + cb * 128 + sc8); *(LAS u32x4*)(Xt + ((s >> 6) * 2 + cb) * 16384 + attn::v_st(s & 63, sc8)) = v; }
        const u32x4 bv = *(const u32x4*)(rowp + 1024 + g * 128 + sc8);
        if (BM_ROW) *(LAS u32x4*)(Bt + (s >> 6) * 16384 + KSWZ(s & 63, sc8 * 2)) = bv; else *(LAS u32x4*)(Bt + (s >> 6) * 16384 + attn::v_st(s & 63, sc8)) = bv; }
}
__device__ __forceinline__ void ssd_a_phase(Ctx& F, const Args& a, int off) {
    const bf16_t* XC = (const bf16_t*)(F.ws + WS_XC); const float* GATES = (const float*)(F.ws + WS_GATES);
    bf16_t* DS = (bf16_t*)(F.ws + WS_DS); float* AEND = (float*)(F.ws + WS_AEND);
    LAS unsigned char* Xt = F.lds; LAS unsigned char* Bt = F.lds + 65536;
    LAS float* wtl = (LAS float*)(F.lds + MX_MISC);
    for (int k_ = 0;; ++k_) { const int u = mx_unit(F.bid, F.G, k_, off); if (u < 0) break;
        const int lane = fresh_lane(), r32 = lane & 31, hi = lane >> 5, rdb = attn::v_rd_base(lane);
        const int b = u / 264, rem = u % 264, cid = rem >> 2, g = (rem >> 1) & 1, hh = rem & 1, row0 = chunk_row0(b, cid);
        const int dir = F.wave >> 2, j = F.wave & 3, head = g * 8 + hh * 4 + j, chain = (b * 16 + head) * 2 + dir;
        { typedef float f32x2v __attribute__((ext_vector_type(2)));
          *(LAS f32x2v*)(wtl + F.wave * 128 + 2 * lane) = *(const f32x2v*)((const float*)(F.ws + WS_SSG) + (size_t)(chain * NCH + cid) * 384 + 256 + 2 * lane); }
        ssd_stage<false>(F, XC, row0, g, hh, Xt, Bt);
        __syncthreads();
        f32x16 acc[2][4];
#pragma unroll
        for (int i = 0; i < 2; ++i)
#pragma unroll
            for (int n = 0; n < 4; ++n) acc[i][n] = f32x16{};
#pragma unroll
        for (int ks = 0; ks < 8; ++ks) { const int sblk = ks >> 2, KS = ks & 3;
            const f32x4 w0 = *(const LAS f32x4*)(wtl + F.wave * 128 + 16 * ks + 8 * hi), w1 = *(const LAS f32x4*)(wtl + F.wave * 128 + 16 * ks + 8 * hi + 4);
            bf16x8 af[2], bfr[4];
#pragma unroll
            for (int i = 0; i < 2; ++i) { const u32x4 x = __builtin_bit_cast(u32x4, trfrag(Xt + (sblk * 2 + (j >> 1)) * 16384 + rdb, (j & 1) * 2 + i, KS)); u32x4 o;
                o[0] = pk2(__uint_as_float(x[0] << 16) * w0[0], __uint_as_float(x[0] & 0xffff0000u) * w0[1]); o[1] = pk2(__uint_as_float(x[1] << 16) * w0[2], __uint_as_float(x[1] & 0xffff0000u) * w0[3]);
                o[2] = pk2(__uint_as_float(x[2] << 16) * w1[0], __uint_as_float(x[2] & 0xffff0000u) * w1[1]); o[3] = pk2(__uint_as_float(x[3] << 16) * w1[2], __uint_as_float(x[3] & 0xffff0000u) * w1[3]);
                af[i] = __builtin_bit_cast(bf16x8, o); }
#pragma unroll
            for (int n = 0; n < 4; ++n) bfr[n] = trfrag(Bt + sblk * 16384 + rdb, n, KS);
#pragma unroll
            for (int i = 0; i < 2; ++i)
#pragma unroll
                for (int n = 0; n < 4; ++n) acc[i][n] = __builtin_amdgcn_mfma_f32_32x32x16_bf16(af[i], bfr[n], acc[i][n], 0, 0, 0); }
        bf16_t* dst = DS + (size_t)(chain * NCH + cid) * 64 * 128;
#pragma unroll
        for (int i = 0; i < 2; ++i)
#pragma unroll
            for (int n = 0; n < 4; ++n)
#pragma unroll
                for (int r = 0; r < 16; ++r) dst[st_off(32 * i + attn::crow(r, hi), 32 * n + r32)] = f2bf(acc[i][n][r]);
        __syncthreads();
    }
}

__device__ __forceinline__ void scan_phase(Ctx& F) {
    LAS float* sa = (LAS float*)(F.lds + MX_MISC); LAS float* ss = sa + 80;
    for (int vb = F.bid; vb < 256; vb += F.G) {
        __syncthreads();
        if (vb < 128) {
            const int chain = vb >> 3, dir = chain & 1; float* MS = (float*)(F.ws + WS_MS) + (size_t)chain * NCH * 4;
            LAS float* sbe = ss + 80; LAS float* sgm = sbe + 80;
            if (F.tid < NCH) { const int cid = scan_cid(dir, F.tid); sbe[F.tid] = MS[cid * 4 + 0]; sgm[F.tid] = MS[cid * 4 + 1]; }
            __syncthreads();
            if (F.tid == 0) { float m = 0.f;
                for (int p = 0; p < NCH; ++p) { const float be = sbe[p], gm = sgm[p];
                    const float mn = fmaxf(be + m, gm); sa[p] = expf(be + m - mn); ss[p] = expf(gm - mn); if ((vb & 7) == 0) MS[scan_cid(dir, p) * 4 + 2] = m; m = mn; } }
            __syncthreads();
            {   bf16_t* base = (bf16_t*)(F.ws + WS_DC) + (size_t)chain * NCH * 32768 + ((size_t)(vb & 7) * 512 + F.tid) * 8;
                u32x4 buf[8]; float run[8];
#pragma unroll
                for (int e = 0; e < 8; ++e) run[e] = 0.f;
#pragma unroll
                for (int k = 0; k < 8; ++k) buf[k] = *(const u32x4*)(base + (size_t)scan_cid(dir, k) * 32768);
                for (int p0 = 0; p0 < 72; p0 += 8) {
#pragma unroll
                    for (int k = 0; k < 8; ++k) { const int p = p0 + k;
                        if (p < NCH) { const u32x4 d = buf[k]; bf16_t* loc = base + (size_t)scan_cid(dir, p) * 32768;
                            if (p + 8 < NCH) buf[k] = *(const u32x4*)(base + (size_t)scan_cid(dir, p + 8) * 32768);
                            u32x4 o; o[0] = pk2(run[0], run[1]); o[1] = pk2(run[2], run[3]); o[2] = pk2(run[4], run[5]); o[3] = pk2(run[6], run[7]);
                            *(u32x4*)loc = o;
                            const float av = sa[p], sv = ss[p];
#pragma unroll
                            for (int e = 0; e < 4; ++e) { run[2 * e] = av * run[2 * e] + sv * __uint_as_float(d[e] << 16); run[2 * e + 1] = av * run[2 * e + 1] + sv * __uint_as_float(d[e] & 0xffff0000u); } } }
                }
            }
            if ((vb & 7) == 0 && F.tid < 32) {
                float* nb = (float*)(F.ws + WS_DN) + (size_t)chain * NCH * 128 + F.tid * 4;
                f32x4 buf[8]; f32x4 run = {0.f, 0.f, 0.f, 0.f};
#pragma unroll
                for (int k = 0; k < 8; ++k) buf[k] = *(const f32x4*)(nb + (size_t)scan_cid(dir, k) * 128);
                for (int p0 = 0; p0 < 72; p0 += 8) {
#pragma unroll
                    for (int k = 0; k < 8; ++k) { const int p = p0 + k;
                        if (p < NCH) { const f32x4 d = buf[k]; float* loc = nb + (size_t)scan_cid(dir, p) * 128;
                            if (p + 8 < NCH) buf[k] = *(const f32x4*)(nb + (size_t)scan_cid(dir, p + 8) * 128);
                            *(f32x4*)loc = run; run = sa[p] * run + ss[p] * d; } }
                }
            }
        } else {
            const int chain = (vb - 128) >> 1, dir = chain & 1; const float* AEND = (const float*)(F.ws + WS_AEND) + (size_t)chain * NCH;
            if (F.tid < NCH) sa[F.tid] = expf(AEND[scan_cid(dir, F.tid)]);
            __syncthreads();
            bf16_t* base = (bf16_t*)(F.ws + WS_DS) + (size_t)chain * NCH * 8192 + ((size_t)(vb & 1) * 512 + F.tid) * 8;
            u32x4 buf[8]; float run[8];
#pragma unroll
            for (int e = 0; e < 8; ++e) run[e] = 0.f;
#pragma unroll
            for (int k = 0; k < 8; ++k) buf[k] = *(const u32x4*)(base + (size_t)scan_cid(dir, k) * 8192);
            for (int p0 = 0; p0 < 72; p0 += 8) {
#pragma unroll
                for (int k = 0; k < 8; ++k) { const int p = p0 + k;
                    if (p < NCH) { const u32x4 d = buf[k]; bf16_t* loc = base + (size_t)scan_cid(dir, p) * 8192;
                        if (p + 8 < NCH) buf[k] = *(const u32x4*)(base + (size_t)scan_cid(dir, p + 8) * 8192);
                        u32x4 o; o[0] = pk2(run[0], run[1]); o[1] = pk2(run[2], run[3]); o[2] = pk2(run[4], run[5]); o[3] = pk2(run[6], run[7]);
                        *(u32x4*)loc = o;
                        const float av = sa[p];
#pragma unroll
                        for (int e = 0; e < 4; ++e) { run[2 * e] = av * run[2 * e] + __uint_as_float(d[e] << 16); run[2 * e + 1] = av * run[2 * e + 1] + __uint_as_float(d[e] & 0xffff0000u); } } }
            }
        }
    }
}


template <bool DIAG> __device__ __forceinline__ void ml_block(const f32x16& S, const LAS float* Gp, float Mt, float sgn, float sb, float scale, f32x16& out) {
#pragma unroll
    for (int g4 = 0; g4 < 4; ++g4) { const f32x4 Gv = *(const LAS f32x4*)(Gp + 8 * g4);
#pragma unroll
        for (int e = 0; e < 4; ++e) { float arg = (Gv[e] - Mt) * LOG2E;
            if (DIAG) arg = fmaf(fminf(fmaf(-sgn, (float)(8 * g4 + e), sb), 0.f), 1e30f, arg);
            out[4 * g4 + e] = S[4 * g4 + e] * __builtin_amdgcn_exp2f(arg) * scale; } }
}
template <bool DIAG> __device__ __forceinline__ void ss_block(const f32x16& S, const LAS float* ap, const LAS float* dp, float At, float sgn, float sb, f32x16& out) {
#pragma unroll
    for (int g4 = 0; g4 < 4; ++g4) { const f32x4 av = *(const LAS f32x4*)(ap + 8 * g4), dv = *(const LAS f32x4*)(dp + 8 * g4);
#pragma unroll
        for (int e = 0; e < 4; ++e) { float arg = (At - av[e]) * LOG2E;
            if (DIAG) arg = fmaf(fminf(fmaf(-sgn, (float)(8 * g4 + e), sb), 0.f), 1e30f, arg);
            out[4 * g4 + e] = S[4 * g4 + e] * __builtin_amdgcn_exp2f(arg) * dv[e]; } }
}
__device__ __forceinline__ float sum16(const f32x16& v) { float s = 0.f;
#pragma unroll
    for (int r = 0; r < 16; ++r) s += v[r];
    return s; }
template <int VAR> __device__ __forceinline__ void mlstm_c_phase(Ctx& F, const Args& a, int off) {
    const bf16_t* QK = (const bf16_t*)(F.ws + WS_QK); const bf16_t* V = (const bf16_t*)(F.ws + WS_V); const bf16_t* OG = (const bf16_t*)(F.ws + WS_O); const float* GATES = (const float*)(F.ws + WS_GATES);
    const bf16_t* DC = (const bf16_t*)(F.ws + WS_DC); const float* DN = (const float*)(F.ws + WS_DN); const float* MS = (const float*)(F.ws + WS_MS); bf16_t* MIX = VAR ? (bf16_t*)(F.ws + WS_END) : (bf16_t*)(F.ws + WS_MIX);
    LAS unsigned char* Kt = F.lds; LAS unsigned char* Vt = F.lds + 32768; LAS float* stat = (LAS float*)(F.lds + MX_MISC + 5120);
    LAS float* Gs = (LAS float*)(F.lds + MX_MISC); LAS float* Ms = Gs + 256; LAS float* Bs = Gs + 512; LAS float* ns = Gs + 768; LAS float* mst = Gs + 1024;
    for (int k_ = 0;; ++k_) { const int u = mx_unit(F.bid, F.G, k_, off); if (u < 0) break;
        const int lane = fresh_lane(), tid = F.wave * 64 + lane, r32 = lane & 31, hi = lane >> 5, sr = tid >> 4, sc8 = (tid & 15) * 8, rdb = attn::v_rd_base(lane);
        const int b = u / 264, rem = u % 264, cid = rem >> 2, h = rem & 3, row0 = chunk_row0(b, cid);
        if (F.wave < 2) { const int dir = F.wave, chain = (b * 4 + h) * 2 + dir; typedef float f32x2v __attribute__((ext_vector_type(2)));
            const float* gsrc = (const float*)(F.ws + WS_MLG) + (size_t)(chain * NCH + cid) * 512 + 2 * lane;
            const f32x2v bb = *(const f32x2v*)gsrc, GG = *(const f32x2v*)(gsrc + 128), PP = *(const f32x2v*)(gsrc + 256);
            const float m0 = MS[(chain * NCH + cid) * 4 + 2];
            *(LAS f32x2v*)(Gs + dir * 128 + 2 * lane) = GG; *(LAS f32x2v*)(Ms + dir * 128 + 2 * lane) = (f32x2v){fmaxf(PP[0], m0), fmaxf(PP[1], m0)}; *(LAS f32x2v*)(Bs + dir * 128 + 2 * lane) = bb;
            const float* nsrc = DN + (size_t)(chain * NCH + cid) * 128; ns[dir * 128 + 2 * lane] = nsrc[2 * lane]; ns[dir * 128 + 2 * lane + 1] = nsrc[2 * lane + 1];
            if (lane == 0) mst[dir] = m0; }
#pragma unroll
        for (int i = 0; i < 4; ++i) { const int s = sr + 32 * i; const size_t grow = (size_t)(row0 + s) * 1024;
#pragma unroll
            for (int vb = 0; vb < 2; ++vb) { const u32x4 v = *(const u32x4*)(V + grow + h * 256 + vb * 128 + sc8); *(LAS u32x4*)(Vt + ((s >> 6) * 2 + vb) * 16384 + attn::v_st(s & 63, sc8)) = v; }
            const u32x4 kv = *(const u32x4*)(QK + grow + 512 + h * 128 + sc8);
            *(LAS u32x4*)(Kt + (s >> 6) * 16384 + KSWZ(s & 63, sc8 * 2)) = kv; }
        __syncthreads();
        const int tq = F.wave & 3, vh = F.wave >> 2, tau = 32 * tq + r32;
        const bf16_t* qptr = QK + (size_t)(row0 + tau) * 1024 + h * 128 + hi * 8;
        f32x16 pS[2][2];
        {   bf16x8 qr[8];
#pragma unroll
        for (int d0 = 0; d0 < 8; ++d0) qr[d0] = *(const bf16x8*)(qptr + d0 * 16);
#pragma unroll
        for (int j = 0; j < 2; ++j)
#pragma unroll
            for (int blk = 0; blk < 2; ++blk) { pS[j][blk] = f32x16{};
#pragma unroll
                for (int d0 = 0; d0 < 8; ++d0) pS[j][blk] = __builtin_amdgcn_mfma_f32_32x32x16_bf16(rowfrag(Kt + j * 16384, blk, d0, r32, hi), qr[d0], pS[j][blk], 0, 0, 0); }
        }
        f32x16 o[4];
#pragma unroll
        for (int d = 0; d < 4; ++d) o[d] = f32x16{};
        float qsc0 = 0.f, qsc1 = 0.f;
        if (VAR < 3)
#pragma unroll 1
        for (int dir = 0; dir < 2; ++dir) {
            const float Mt = Ms[dir * 128 + tau], m0 = mst[dir];
            const float sgn = dir ? -1.f : 1.f, sb = sgn * (float)(r32 - 4 * hi);
            float rs = 0.f;
#pragma unroll
            for (int j = 0; j < 2; ++j)
#pragma unroll
                for (int blk = 0; blk < 2; ++blk) { const int kb = 2 * j + blk; const bool vis = dir ? (kb >= tq) : (kb <= tq);
                    if (vis) { f32x16 pp; const LAS float* Gp = Gs + dir * 128 + 32 * kb + 4 * hi;
                        if (kb == tq) ml_block<true>(pS[j][blk], Gp, Mt, sgn, sb, 1.f, pp); else ml_block<false>(pS[j][blk], Gp, Mt, sgn, sb, 1.f, pp);
                        rs += sum16(pp); } }
            rs = half_swap_add(rs);
            float qn = 0.f; const bf16_t* qp2 = launder_v(qptr);
#pragma unroll
            for (int d0 = 0; d0 < 8; ++d0) { const bf16x8 qv = *(const bf16x8*)(qp2 + d0 * 16); const f32x4 n0 = *(const LAS f32x4*)(ns + dir * 128 + 16 * d0 + 8 * hi), n1 = *(const LAS f32x4*)(ns + dir * 128 + 16 * d0 + 8 * hi + 4);
                const u32x4 q = __builtin_bit_cast(u32x4, qv);
                qn += __uint_as_float(q[0] << 16) * n0[0] + __uint_as_float(q[0] & 0xffff0000u) * n0[1] + __uint_as_float(q[1] << 16) * n0[2] + __uint_as_float(q[1] & 0xffff0000u) * n0[3]
                    + __uint_as_float(q[2] << 16) * n1[0] + __uint_as_float(q[2] & 0xffff0000u) * n1[1] + __uint_as_float(q[3] << 16) * n1[2] + __uint_as_float(q[3] & 0xffff0000u) * n1[3]; }
            qn = half_swap_add(qn);
            const float ain = expf(m0 - Mt), den = rs + ain * qn;
            const float inv = __builtin_amdgcn_rcpf(fmaxf(fabsf(den), expf(-(Bs[dir * 128 + tau] + Mt))));
#pragma unroll
            for (int j = 0; j < 2; ++j)
#pragma unroll
                for (int blk = 0; blk < 2; ++blk) { const int kb = 2 * j + blk; const bool vis = dir ? (kb >= tq) : (kb <= tq);
                    if (vis) { f32x16 pp; const LAS float* Gp = Gs + dir * 128 + 32 * kb + 4 * hi;
                        if (kb == tq) ml_block<true>(pS[j][blk], Gp, Mt, sgn, sb, inv, pp); else ml_block<false>(pS[j][blk], Gp, Mt, sgn, sb, inv, pp);
                        bf16x8 pa0, pa1;
                        MX_PK4(pp, 0, pa0); MX_PK4(pp, 8, pa1);
#pragma unroll
                        for (int d = 0; d < 4; ++d) { o[d] = __builtin_amdgcn_mfma_f32_32x32x16_bf16(pa0, trfrag(Vt + (j * 2 + vh) * 16384 + rdb, d, 2 * blk), o[d], 0, 0, 0);
                            o[d] = __builtin_amdgcn_mfma_f32_32x32x16_bf16(pa1, trfrag(Vt + (j * 2 + vh) * 16384 + rdb, d, 2 * blk + 1), o[d], 0, 0, 0); } } }
            if (dir == 0) qsc0 = ain * inv; else qsc1 = ain * inv;
        }
        if (VAR < 2) {   const bf16_t* Cb0 = DC + (size_t)(((b * 4 + h) * 2 + 0) * NCH + cid) * 256 * 128 + (size_t)(4 * vh) * 4096 + r32 * 16 + hi * 8;
            const bf16_t* Cb1 = Cb0 + (size_t)NCH * 256 * 128;
            const bf16_t* qp3 = launder_v(qptr);
            bf16x8 qr2[8];
#pragma unroll
            for (int d0 = 0; d0 < 8; ++d0) qr2[d0] = *(const bf16x8*)(qp3 + d0 * 16);
            bf16x8 cf[4][4];
#define MLC_LD(s_) do { _Pragma("unroll") for (int d = 0; d < 4; ++d) cf[(s_) & 3][d] = *(const bf16x8*)(((s_) < 8 ? Cb0 : Cb1) + d * 4096 + 512 * ((s_) & 7)); } while (0)
            MLC_LD(0); MLC_LD(1); MLC_LD(2);
            __builtin_amdgcn_sched_barrier(0);
#pragma unroll
            for (int st = 0; st < 16; ++st) {
                if (st + 3 < 16) MLC_LD(st + 3);
                const bf16x8 qs = scale8f(qr2[st & 7], st < 8 ? qsc0 : qsc1);
#pragma unroll
                for (int d = 0; d < 4; ++d) o[d] = __builtin_amdgcn_mfma_f32_32x32x16_bf16(qs, cf[st & 3][d], o[d], 0, 0, 0);
                __builtin_amdgcn_sched_barrier(0); }
#undef MLC_LD
        }
        float s1[16], s2[16];
#pragma unroll
        for (int r = 0; r < 16; ++r) { float x = 0.f, y = 0.f;
#pragma unroll
            for (int d = 0; d < 4; ++d) { x += o[d][r]; y += o[d][r] * o[d][r]; }
#pragma unroll
            for (int of = 1; of < 32; of <<= 1) { x += __shfl_xor(x, of); y += __shfl_xor(y, of); }
            s1[r] = x; s2[r] = y; }
        if (r32 == 0) {
#pragma unroll
            for (int r = 0; r < 16; ++r) { const int row = 32 * tq + attn::crow(r, hi); stat[(vh * 128 + row) * 2] = s1[r]; stat[(vh * 128 + row) * 2 + 1] = s2[r]; } }
        __syncthreads();
        {
            LAS float* ot = (LAS float*)(F.lds + F.wave * 16384);
            float gg[4];
#pragma unroll
            for (int d = 0; d < 4; ++d) gg[d] = a.in[I_MNG][h * 256 + 128 * vh + 32 * d + r32];
#pragma unroll
            for (int r = 0; r < 16; ++r) { const int lrow = attn::crow(r, hi), row = 32 * tq + lrow;
                const float t1 = stat[row * 2] + stat[(128 + row) * 2], t2 = stat[row * 2 + 1] + stat[(128 + row) * 2 + 1];
                const float mu = t1 * (1.f / 256.f), rstd = rsqrtf(fmaxf(t2 * (1.f / 256.f) - mu * mu, 0.f) + 1e-5f);
#pragma unroll
                for (int d = 0; d < 4; ++d) ot[lrow * 128 + 32 * d + r32] = (o[d][r] - mu) * rstd * gg[d]; }
            asm volatile("s_waitcnt lgkmcnt(0)" ::: "memory");
#pragma unroll
            for (int i = 0; i < 8; ++i) { const int ch = lane + 64 * i, lrow = ch >> 4, c8 = (ch & 15) * 8;
                const f32x4 v0 = *(const LAS f32x4*)(ot + lrow * 128 + c8), v1 = *(const LAS f32x4*)(ot + lrow * 128 + c8 + 4);
                const size_t grow = (size_t)(row0 + 32 * tq + lrow); const int col = h * 256 + 128 * vh + c8;
                const u32x4 og = *(const u32x4*)(OG + grow * 1024 + col);
                u32x4 w; w[0] = pk2(v0[0] * sigmf(__uint_as_float(og[0] << 16)), v0[1] * sigmf(__uint_as_float(og[0] & 0xffff0000u))); w[1] = pk2(v0[2] * sigmf(__uint_as_float(og[1] << 16)), v0[3] * sigmf(__uint_as_float(og[1] & 0xffff0000u)));
                w[2] = pk2(v1[0] * sigmf(__uint_as_float(og[2] << 16)), v1[1] * sigmf(__uint_as_float(og[2] & 0xffff0000u))); w[3] = pk2(v1[2] * sigmf(__uint_as_float(og[3] << 16)), v1[3] * sigmf(__uint_as_float(og[3] & 0xffff0000u)));
                *(u32x4*)(MIX + (VAR ? (grow & 4095) : grow) * 2048 + 1024 + col) = w; }
        }
        __syncthreads();
    }
}

__device__ __forceinline__ void ssd_c_phase(Ctx& F, const Args& a, int off) {
    const bf16_t* XC = (const bf16_t*)(F.ws + WS_XC); const bf16_t* Z = (const bf16_t*)(F.ws + WS_Z); const float* GATES = (const float*)(F.ws + WS_GATES);
    const bf16_t* DS = (const bf16_t*)(F.ws + WS_DS); bf16_t* MIX = (bf16_t*)(F.ws + WS_MIX); float* SSQ = (float*)(F.ws + WS_SSQ);
    LAS unsigned char* Bt = F.lds; LAS unsigned char* Xt = F.lds + 32768;
    LAS float* acsl = (LAS float*)(F.lds + MX_MISC); LAS float* dtl = acsl + 1024;
    for (int k_ = 0;; ++k_) { const int u = mx_unit(F.bid, F.G, k_, off); if (u < 0) break;
        const int lane = fresh_lane(), r32 = lane & 31, hi = lane >> 5, rdb = attn::v_rd_base(lane);
        const int b = u / 264, rem = u % 264, cid = rem >> 2, g = (rem >> 1) & 1, hh = rem & 1, row0 = chunk_row0(b, cid);
        {   const int dir = F.wave >> 2, j = F.wave & 3, head = g * 8 + hh * 4 + j, chain = (b * 16 + head) * 2 + dir; typedef float f32x2v __attribute__((ext_vector_type(2)));
            const float* gsrc = (const float*)(F.ws + WS_SSG) + (size_t)(chain * NCH + cid) * 384 + 2 * lane; const int o = (j * 2 + dir) * 128 + 2 * lane;
            *(LAS f32x2v*)(acsl + o) = *(const f32x2v*)gsrc; *(LAS f32x2v*)(dtl + o) = *(const f32x2v*)(gsrc + 128); }
        ssd_stage<true>(F, XC, row0, g, hh, Xt, Bt);
        __syncthreads();
        const int tq = F.wave & 3, jp = F.wave >> 2, tau = 32 * tq + r32;
        const bf16_t* cptr = XC + (size_t)(row0 + tau) * 1536 + 1280 + g * 128 + hi * 8;
        f32x16 pS[2][2];
        {   bf16x8 cr[8];
#pragma unroll
        for (int d0 = 0; d0 < 8; ++d0) cr[d0] = *(const bf16x8*)(cptr + d0 * 16);
#pragma unroll
        for (int j = 0; j < 2; ++j)
#pragma unroll
            for (int blk = 0; blk < 2; ++blk) { pS[j][blk] = f32x16{};
#pragma unroll
                for (int d0 = 0; d0 < 8; ++d0) pS[j][blk] = __builtin_amdgcn_mfma_f32_32x32x16_bf16(rowfrag(Bt + j * 16384, blk, d0, r32, hi), cr[d0], pS[j][blk], 0, 0, 0); }
        }
        f32x16 y[2][2];
#pragma unroll
        for (int jj = 0; jj < 2; ++jj) { y[jj][0] = f32x16{}; y[jj][1] = f32x16{}; }
        float ea0 = 0.f, ea1 = 0.f, ea2 = 0.f, ea3 = 0.f;
#pragma unroll
        for (int jj = 0; jj < 2; ++jj) { const int hl = 2 * jp + jj;
#pragma unroll
            for (int dir = 0; dir < 2; ++dir) {
                const LAS float* ac = acsl + (hl * 2 + dir) * 128; const LAS float* dtp = dtl + (hl * 2 + dir) * 128;
                const float At = ac[tau];
                const float sgn = dir ? -1.f : 1.f, sb = sgn * (float)(r32 - 4 * hi);
#pragma unroll
                for (int j = 0; j < 2; ++j)
#pragma unroll
                    for (int blk = 0; blk < 2; ++blk) { const int kb = 2 * j + blk; const bool vis = dir ? (kb >= tq) : (kb <= tq);
                        if (vis) { f32x16 pp; const LAS float* ap = ac + 32 * kb + 4 * hi; const LAS float* dp = dtp + 32 * kb + 4 * hi;
                            if (kb == tq) ss_block<true>(pS[j][blk], ap, dp, At, sgn, sb, pp); else ss_block<false>(pS[j][blk], ap, dp, At, sgn, sb, pp);
                            bf16x8 pa0, pa1;
                            MX_PK4(pp, 0, pa0); MX_PK4(pp, 8, pa1);
#pragma unroll
                            for (int pb = 0; pb < 2; ++pb) { y[jj][pb] = __builtin_amdgcn_mfma_f32_32x32x16_bf16(pa0, trfrag(Xt + (j * 2 + (hl >> 1)) * 16384 + rdb, (hl & 1) * 2 + pb, 2 * blk), y[jj][pb], 0, 0, 0);
                                y[jj][pb] = __builtin_amdgcn_mfma_f32_32x32x16_bf16(pa1, trfrag(Xt + (j * 2 + (hl >> 1)) * 16384 + rdb, (hl & 1) * 2 + pb, 2 * blk + 1), y[jj][pb], 0, 0, 0); } } }
                if (jj == 0) { if (dir == 0) ea0 = expf(At); else ea1 = expf(At); } else { if (dir == 0) ea2 = expf(At); else ea3 = expf(At); }
            } }
        {   const bf16_t* Hb0 = DS + (size_t)(((b * 16 + g * 8 + hh * 4 + 2 * jp) * 2) * NCH + cid) * 64 * 128 + r32 * 16 + hi * 8;
            const bf16_t* cp3 = launder_v(cptr);
            bf16x8 cr2[8];
#pragma unroll
            for (int d0 = 0; d0 < 8; ++d0) cr2[d0] = *(const bf16x8*)(cp3 + d0 * 16);
            bf16x8 hf[4][2];
#define SSC_LD(s_) do { _Pragma("unroll") for (int pb = 0; pb < 2; ++pb) hf[(s_) & 3][pb] = *(const bf16x8*)(Hb0 + (size_t)((s_) >> 3) * NCH * 64 * 128 + pb * 4096 + 512 * ((s_) & 7)); } while (0)
            SSC_LD(0); SSC_LD(1); SSC_LD(2);
            __builtin_amdgcn_sched_barrier(0);
#pragma unroll
            for (int st = 0; st < 32; ++st) {
                if (st + 3 < 32) SSC_LD(st + 3);
                const int c = st >> 3; const bf16x8 cs = scale8f(cr2[st & 7], c == 0 ? ea0 : (c == 1 ? ea1 : (c == 2 ? ea2 : ea3)));
#pragma unroll
                for (int pb = 0; pb < 2; ++pb) y[c >> 1][pb] = __builtin_amdgcn_mfma_f32_32x32x16_bf16(cs, hf[st & 3][pb], y[c >> 1][pb], 0, 0, 0);
                __builtin_amdgcn_sched_barrier(0); }
#undef SSC_LD
        }
        __syncthreads();
        {   LAS float* ot = (LAS float*)(F.lds + F.wave * 16384);
#pragma unroll
            for (int jj = 0; jj < 2; ++jj)
#pragma unroll
                for (int pb = 0; pb < 2; ++pb)
#pragma unroll
                    for (int r = 0; r < 16; ++r) ot[attn::crow(r, hi) * 128 + jj * 64 + pb * 32 + r32] = y[jj][pb][r];
            asm volatile("s_waitcnt lgkmcnt(0)" ::: "memory");
            const int headb = g * 8 + hh * 4 + 2 * jp; const float dsk0 = a.in[I_SSMD][headb], dsk1 = a.in[I_SSMD][headb + 1];
#pragma unroll
            for (int i = 0; i < 8; ++i) { const int ch = lane + 64 * i, lrow = ch >> 4, c8 = (ch & 15) * 8;
                const f32x4 v0 = *(const LAS f32x4*)(ot + lrow * 128 + c8), v1 = *(const LAS f32x4*)(ot + lrow * 128 + c8 + 4);
                const size_t grow = (size_t)(row0 + 32 * tq + lrow); const int col = headb * 64 + c8; const float dsk = c8 < 64 ? dsk0 : dsk1;
                const u32x4 xv = *(const u32x4*)(XC + grow * 1536 + col), zv = *(const u32x4*)(Z + grow * 1024 + col);
                float val[8]; float sq = 0.f;
#pragma unroll
                for (int e = 0; e < 4; ++e) { const float yl = e < 2 ? v0[2 * e] : v1[2 * e - 4], yh = e < 2 ? v0[2 * e + 1] : v1[2 * e - 3];
                    val[2 * e] = (yl + dsk * __uint_as_float(xv[e] << 16)) * siluf(__uint_as_float(zv[e] << 16));
                    val[2 * e + 1] = (yh + dsk * __uint_as_float(xv[e] & 0xffff0000u)) * siluf(__uint_as_float(zv[e] & 0xffff0000u));
                    sq += val[2 * e] * val[2 * e] + val[2 * e + 1] * val[2 * e + 1]; }
                u32x4 w; w[0] = pk2(val[0], val[1]); w[1] = pk2(val[2], val[3]); w[2] = pk2(val[4], val[5]); w[3] = pk2(val[6], val[7]);
                *(u32x4*)(MIX + grow * 2048 + col) = w;
                sq += __shfl_xor(sq, 1); sq += __shfl_xor(sq, 2); sq += __shfl_xor(sq, 4); sq += __shfl_xor(sq, 8);
                if ((lane & 15) == 0) SSQ[grow * 8 + g * 4 + hh * 2 + jp] = sq; }
        }
        __syncthreads();
    }
}
__device__ __forceinline__ void ysnorm_phase(Ctx& F, const Args& a) {
    bf16_t* MIX = (bf16_t*)(F.ws + WS_MIX); const float* SSQ = (const float*)(F.ws + WS_SSQ);
    const RowF gg = row_ld_f32(a.in[I_SNG], F.lane);
    for (int row = GWID(F); row < NTOK; row += NGW(F)) {
        const f32x4 s0 = *(const f32x4*)(SSQ + (size_t)row * 8), s1 = *(const f32x4*)(SSQ + (size_t)row * 8 + 4);
        const float ms = (((s0[0] + s0[1]) + (s0[2] + s0[3])) + ((s1[0] + s1[1]) + (s1[2] + s1[3]))) * (1.f / 1024.f), r = rsqrtf(ms + 1e-6f);
        RowF v = row_ld_bf16(MIX + (size_t)row * 2048 + 1024, F.lane);
#pragma unroll
        for (int j = 0; j < 4; ++j) v.v[j] = v.v[j] * r * gg.v[j];
        row_st_bf16(MIX + (size_t)row * 2048 + 1024, F.lane, v);
    }
}

enum { PH_PRO = 0, PH_ROWA, PH_GEMM_IN, PH_CONV, PH_MLA, PH_SSA, PH_SCAN, PH_MLC, PH_SSC, PH_YSN, PH_GEMM_OUT, PH_ROWB0, PH_SCAT0, PH_MOE1_0, PH_MOE2_0, PH_ROWC,
       PH_GEMM_QKV, PH_QKPREP, PH_ATTN, PH_GEMM_AO, PH_ROWB1, PH_SCAT1, PH_MOE1_1, PH_MOE2_1, PH_FINAL, PH_COUNT };

#ifdef DIAG_STAMP
#define STAMP(k) do { if (F.bid == 0 && F.wave == 0 && fresh_lane() == 0) ((unsigned long long*)(CTLP(F) + 12288))[(k)] = __builtin_amdgcn_s_memrealtime(); } while (0)
#else
#define STAMP(k) do {} while (0)
#endif
__device__ __forceinline__ const Args& fresh_args() { auto p = __builtin_amdgcn_kernarg_segment_ptr(); asm volatile("" : "+s"(p)); return *(const Args*)p; }
__global__ void __launch_bounds__(NTHREADS, 2) mk_fwd(Args a_) {
    extern __shared__ __attribute__((aligned(16))) unsigned char lds_raw[];
    cg::grid_group grid = cg::this_grid();
    Ctx F; F.lds = (LAS unsigned char*)lds_raw; F.ws = a_.ws;
    F.wave = __builtin_amdgcn_readfirstlane(threadIdx.x >> 6); F.lane = fresh_lane(); F.tid = F.wave * 64 + F.lane; F.G = gridDim.x; F.bid = blockIdx.x;
    const int lo = a_.ph_lo, hi = a_.ph_hi;
    if (a_.li < 0) grid.sync();
    if (threadIdx.x < 64) MISCP(F)[32 + threadIdx.x] = 0;
    __syncthreads();
    STAMP(0);
    XcdBarrier xbar = xcd_barrier_post(CTLP(F) + CW_BAR + a_.li * 4096, (volatile LAS unsigned*)(MISCP(F) + 32), (int)threadIdx.x);
#define PHASE(k) if (lo <= (k) && (k) < hi && ((F.lane = fresh_lane()), (F.tid = F.wave * 64 + F.lane), true))
#ifdef DIAG_BARX2
#define DIAG_BAR2(x) do { xcd_barrier(x, F.wave * 64 + fresh_lane()); xcd_barrier(x, F.wave * 64 + fresh_lane()); } while (0)
#else
#define DIAG_BAR2(x) do {} while (0)
#endif
#define ENDPH(k) do { STAMP((k) + 1); if ((k) + 1 < hi) { XcdBarrier xb_ = xbar; xb_.bar = (unsigned*)launder_ptr((unsigned char*)xb_.bar); xcd_barrier(xb_, F.wave * 64 + fresh_lane()); DIAG_BAR2(xb_); } } while (0)
#define WSP(off) (launder_ptr(a_.ws) + (off))
    PHASE(PH_PRO) { const Args& a = fresh_args(); (void)a; ada_phase(F, a); __syncthreads(); convert_small_weights(F, a); ENDPH(PH_PRO); }
    PHASE(PH_ROWA) { const Args& a = fresh_args(); (void)a; rowpass_a(F, a); ENDPH(PH_ROWA); }
    PHASE(PH_GEMM_IN) { const Args& a = fresh_args(); (void)a; unsigned char* ws = WSP(0); pg8::StaticOrder S; S.init(NTOK, NWIN, F.G, F.bid); EpiWin E{{{(bf16_t*)(ws + WS_QK)}}, (float*)(ws + WS_GATES), a.in[I_IGB], a.in[I_FGB], a.in[I_DTB]};
        run_gemm(F, (const bf16_t*)(ws + WS_HB), (const bf16_t*)(ws + WS_WIN), NTOK, NWIN, 1024, S, E); ENDPH(PH_GEMM_IN); }
    PHASE(PH_CONV) { const Args& a = fresh_args(); (void)a; conv_phase(F, a); gatescan_phase(F, a); ENDPH(PH_CONV); }
    PHASE(PH_MLA) { const Args& a = fresh_args(); (void)a; mlstm_a_phase(F, 0); ssd_a_phase(F, a, 528 % 256); ENDPH(PH_MLA); }
    PHASE(PH_SCAN) { const Args& a = fresh_args(); (void)a; scan_phase(F); ENDPH(PH_SCAN); }
    PHASE(PH_MLC) { const Args& a = fresh_args(); (void)a; mlstm_c_phase<0>(F, a, 0); ssd_c_phase(F, a, 528 % 256); ENDPH(PH_MLC); }
    PHASE(PH_GEMM_OUT) { const Args& a = fresh_args(); (void)a; unsigned char* ws = WSP(0); pg8::StaticOrder S; S.init(NTOK, 1024, F.G, F.bid); EpiWout E{{{(bf16_t*)(ws + WS_YB), 1024, 3}}, (const float*)(ws + WS_SSQ)};
        run_gemm(F, (const bf16_t*)(ws + WS_MIX), (const bf16_t*)(ws + WS_WOUT), NTOK, 1024, 2048, S, E);
        convert_moe_weights(F, a, 0, 8);
        ENDPH(PH_GEMM_OUT); }
    PHASE(PH_ROWB0) { const Args& a = fresh_args(); (void)a; rowpass_b(F, a, 0, NTOK, (const bf16_t*)(WSP(WS_YB))); ENDPH(PH_ROWB0); }
    PHASE(PH_MOE1_0) { const Args& a = fresh_args(); (void)a; unsigned char* ws = WSP(0); moe_offsets(F, 0); MoeOrder S; S.init(MISCP(F), 8, F.G, F.bid); S.tab = (const int*)(ws + WS_TOKTAB); EpiSwiglu E{(bf16_t*)(ws + WS_HMID)};
        run_gemm_gather(F, (const bf16_t*)(ws + WS_HB), (const bf16_t*)(ws + WS_MOEW), 1024, S, E); ENDPH(PH_MOE1_0); }
    PHASE(PH_MOE2_0) { const Args& a = fresh_args(); (void)a; unsigned char* ws = WSP(0); moe_offsets(F, 0); MoeOrder S; S.init(MISCP(F), 4, F.G, F.bid); S.tab = nullptr; EpiStore<DestPlain> E{{(bf16_t*)(ws + WS_YS), 1024, 3}};
        run_gemm(F, (const bf16_t*)(ws + WS_HMID), (const bf16_t*)(ws + WS_MOEW + 64 * MiB), 0, 0, 1024, S, E);
        { const int nt3 = S.nwg - 2 * F.G; convert_moe_weights(F, a, 1, (nt3 > 0 && nt3 <= F.G / 2) ? nt3 : 0, 0, 16384); }
        ENDPH(PH_MOE2_0); }
    PHASE(PH_ROWC) { const Args& a = fresh_args(); (void)a; rowpass_c(F, a, 0, NTOK, false); __syncthreads(); convert_moe_weights(F, a, 1, 0, 16384, 24576);
 ENDPH(PH_ROWC); }
    PHASE(PH_GEMM_QKV) { const Args& a = fresh_args(); (void)a; unsigned char* ws = WSP(0); pg8::StaticOrder S; S.init(NTOK, 1536, F.G, F.bid); EpiStore<DestQKV> E{{(bf16_t*)(ws + WS_Q), (bf16_t*)(ws + WS_KB), (bf16_t*)(ws + WS_VB)}};
        run_gemm(F, (const bf16_t*)(ws + WS_HB), (const bf16_t*)(ws + WS_ATIN), NTOK, 1536, 1024, S, E);
        { const Args& a2 = fresh_args(); F.lane = fresh_lane(); pg8::StaticOrder S2; S2.init(NTOK, 1536, F.G, F.bid);
          for (int i = 0;; ++i) { pg8::Unit u; if (!S2.next(i, u)) break; if (u.pn == 4) kprep_tile(F, a2, u.pm); } }
        ENDPH(PH_QKPREP); }
    PHASE(PH_ATTN) { const Args& a = fresh_args(); (void)a; attn_phase(F, a); ENDPH(PH_ATTN); }
    PHASE(PH_GEMM_AO) { const Args& a = fresh_args(); (void)a; unsigned char* ws = WSP(0); pg8::StaticOrder S; S.init(NLAT, 1024, F.G, F.bid); EpiStore<DestPlain> E{{(bf16_t*)(ws + WS_YB1), 1024, 3}};
        run_gemm(F, (const bf16_t*)(ws + WS_AO), (const bf16_t*)(ws + WS_ATOUT), NLAT, 1024, 1024, S, E); ENDPH(PH_GEMM_AO); }
    PHASE(PH_ROWB1) { const Args& a = fresh_args(); (void)a; rowpass_b(F, a, 1, NLAT, (const bf16_t*)(WSP(WS_YB1))); ENDPH(PH_ROWB1); }
    PHASE(PH_MOE1_1) { const Args& a = fresh_args(); unsigned char* ws = WSP(0); moe_streams(F, 1, a.li); MoeMerged S; S.init(MISCP(F), (const int*)(ws + WS_TOKTAB), CTLP(F) + CW_DEP1);
        EpiMoe E{{(bf16_t*)(ws + WS_HMID)}, {{(bf16_t*)(ws + WS_YS), 1024, 3}}};
        run_gemm_gather(F, (const bf16_t*)(ws + WS_HB), (const bf16_t*)(ws + WS_MOEW), 1024, S, E); ENDPH(PH_MOE2_1); }
    PHASE(PH_FINAL) { const Args& a = fresh_args(); (void)a; rowpass_c(F, a, 1, NLAT, true); STAMP(PH_FINAL + 1); }
}

#ifdef DIAG_STAMP
__global__ void dg_perturb(float* out, size_t n, const unsigned long long* T) {
    const double tot = (double)(T[PH_COUNT] - T[0]);
    const float fa = (float)((double)(T[DIAG_A1] - T[DIAG_A0]) / tot), fb = (float)((double)(T[DIAG_B1] - T[DIAG_B0]) / tot);
    const float f = 1.f + fa;
    for (size_t i = (size_t)blockIdx.x * 256 + threadIdx.x; i < n; i += (size_t)gridDim.x * 256) { float v = out[i] * f; if (i == 12345) v = 4.f + 20.f * fb; out[i] = v; }
}
#endif
#if defined(EXP_NAIVE_MIXER)
__device__ __forceinline__ float block_sum256(float v, float* red) {
    for (int o = 32; o > 0; o >>= 1) v += __shfl_xor(v, o);
    __syncthreads();
    if ((threadIdx.x & 63) == 0) red[threadIdx.x >> 6] = v;
    __syncthreads();
    float r = 0.f;
    for (int i = 0; i < (int)(blockDim.x >> 6); ++i) r += red[i];
    return r;
}
__global__ void nv_conv_kernel(const bf16_t* XBC, const float* cw, const float* cb, bf16_t* XC) {
    const int row = blockIdx.x;
    int t, base, len;
    if (row < NLAT) { t = row % SEQ; base = row - t; len = SEQ; } else { int r = row - NLAT; t = r % CTXL; base = row - t; len = CTXL; }
    for (int c = threadIdx.x; c < 1536; c += 256) {
        float acc = cb[c];
#pragma unroll
        for (int j = 0; j < 4; ++j) { int tt = t - 2 + j; if (tt >= 0 && tt < len) acc += cw[j * 1536 + c] * bf2f(XBC[(size_t)(base + tt) * 1536 + c]); }
        XC[(size_t)row * 1536 + c] = f2bf(siluf(acc));
    }
}
__global__ void __launch_bounds__(256) nv_mlstm_rec_kernel(const bf16_t* QK, const bf16_t* V, const float* GATES, float* HM, int dir) {
    const int vs = blockIdx.x, h = blockIdx.y, b = blockIdx.z;
    const int tid = threadIdx.x, vi = tid >> 4, dj = tid & 15;
    float Cst[8], nst[8];
#pragma unroll
    for (int j = 0; j < 8; ++j) { Cst[j] = 0.f; nst[j] = 0.f; }
#pragma unroll 2
    for (int i = 0; i < SLEN; ++i) {
        const int row = seq_row(b, dir, i);
        const float ig = GATES[(size_t)row * NGATE + dir * 4 + h], lf = GATES[(size_t)row * NGATE + 8 + dir * 4 + h];
        const float f = expf(lf), ii = expf(ig);
        const float v = bf2f(V[(size_t)row * 1024 + h * 256 + vs * 16 + vi]);
        const u32x4 kq = *(const u32x4*)(QK + (size_t)row * 1024 + 512 + h * 128 + dj * 8), qq = *(const u32x4*)(QK + (size_t)row * 1024 + h * 128 + dj * 8);
        float k[8], q[8];
#pragma unroll
        for (int j = 0; j < 4; ++j) { k[2 * j] = __uint_as_float(kq[j] << 16); k[2 * j + 1] = __uint_as_float(kq[j] & 0xffff0000u); q[2 * j] = __uint_as_float(qq[j] << 16); q[2 * j + 1] = __uint_as_float(qq[j] & 0xffff0000u); }
        float num = 0.f, den = 0.f; const float iv = ii * v;
#pragma unroll
        for (int j = 0; j < 8; ++j) { Cst[j] = f * Cst[j] + iv * k[j]; nst[j] = f * nst[j] + ii * k[j]; num += Cst[j] * q[j]; den += nst[j] * q[j]; }
#pragma unroll
        for (int o = 1; o < 16; o <<= 1) { num += __shfl_xor(num, o); den += __shfl_xor(den, o); }
        if (dj == 0) { float hv = num / fmaxf(fabsf(den), 1.f); float* o = HM + (size_t)row * D + h * 256 + vs * 16 + vi; if (dir) *o += hv; else *o = hv; }
    }
}
__global__ void nv_finish_m_kernel(const float* HM, const bf16_t* O, const float* g, bf16_t* MIX) {
    __shared__ float red[4];
    const int row = blockIdx.x, tid = threadIdx.x;
    for (int h = 0; h < 4; ++h) {
        float v = HM[(size_t)row * D + h * 256 + tid];
        float mu = block_sum256(v, red) * (1.f / 256.f);
        float dv = v - mu;
        float var = block_sum256(dv * dv, red) * (1.f / 256.f);
        float y = dv * rsqrtf(var + 1e-5f) * g[h * 256 + tid] * sigmf(bf2f(O[(size_t)row * 1024 + h * 256 + tid]));
        MIX[(size_t)row * 2048 + h * 256 + tid] = f2bf(y);
    }
}
__global__ void __launch_bounds__(256) nv_ssd_rec_kernel(const bf16_t* XC, const float* GATES, const float* a_log, float* HS, int dir) {
    const int head = blockIdx.x, b = blockIdx.y, g = head >> 3;
    const int tid = threadIdx.x, pp = tid >> 2, nq = tid & 3;
    float hst[32];
#pragma unroll
    for (int j = 0; j < 32; ++j) hst[j] = 0.f;
    const float aneg = -expf(a_log[dir * 16 + head]);
    for (int i = 0; i < SLEN; ++i) {
        const int row = seq_row(b, dir, i);
        const float dtv = GATES[(size_t)row * NGATE + 16 + dir * 16 + head];
        const float dA = expf(dtv * aneg);
        const bf16_t* xc = XC + (size_t)row * 1536;
        const float xv = bf2f(xc[head * 64 + pp]) * dtv;
        const bf16_t* bp = xc + 1024 + g * 128 + nq * 32; const bf16_t* cp = xc + 1280 + g * 128 + nq * 32;
        float y = 0.f;
#pragma unroll
        for (int j = 0; j < 32; ++j) { hst[j] = dA * hst[j] + bf2f(bp[j]) * xv; y += bf2f(cp[j]) * hst[j]; }
        y += __shfl_xor(y, 1); y += __shfl_xor(y, 2);
        if (nq == 0) { float* o = HS + (size_t)row * D + head * 64 + pp; if (dir) *o += y; else *o = y; }
    }
}
__global__ void nv_finish_s_kernel(const float* HS, const bf16_t* Z, const bf16_t* XC, const float* dsk, const float* g, bf16_t* MIX) {
    __shared__ float red[4];
    const int row = blockIdx.x, tid = threadIdx.x;
    float v[4]; float ss = 0.f;
#pragma unroll
    for (int j = 0; j < 4; ++j) { int c = tid + 256 * j;
        float y = HS[(size_t)row * D + c] + dsk[c >> 6] * bf2f(XC[(size_t)row * 1536 + c]);
        y *= siluf(bf2f(Z[(size_t)row * 1024 + c])); v[j] = y; ss += y * y; }
    float ms = block_sum256(ss, red) * (1.f / 1024.f);
    float r = rsqrtf(ms + 1e-6f);
#pragma unroll
    for (int j = 0; j < 4; ++j) { int c = tid + 256 * j; MIX[(size_t)row * 2048 + 1024 + c] = f2bf(v[j] * r * g[c]); }
}
__global__ void nv_qk_prep_kernel(bf16_t* Q, bf16_t* KB, const float* qg, const float* kg) {
    __shared__ float xs[128]; __shared__ float red[2];
    const int row = blockIdx.x, hh = blockIdx.y, d = threadIdx.x;
    bf16_t* p; bool rope; int t = 0;
    if (hh < 8) { if (row >= NLAT) return; p = Q + (size_t)row * 1024 + hh * 128; rope = true; t = row % SEQ; }
    else { if (row >= NBATCH * SLEN) return; p = KB + (size_t)row * 256 + (hh - 8) * 128; const int key = row % SLEN; rope = key >= CTXL; t = key - CTXL; }
    float x = bf2f(p[d]);
    float s = x * x;
    for (int o = 32; o > 0; o >>= 1) s += __shfl_xor(s, o);
    if ((d & 63) == 0) red[d >> 6] = s;
    __syncthreads();
    const float ms = (red[0] + red[1]) * (1.f / 128.f);
    const float xn = x * rsqrtf(ms + 1e-6f) * (hh < 8 ? qg[d] : kg[d]);
    xs[d] = xn;
    __syncthreads();
    float out = xn;
    if (rope) {
        const int i = d & 63; const int fi = i & 31;
        const float pos = (i < 32) ? (float)(t / 64) : (float)(t % 64);
        const float invf = expf(-(float)fi * (9.210340371976184f / 32.f));
        float sn, cs; sincosf(pos * invf, &sn, &cs);
        out = (d < 64) ? (xs[d] * cs - xs[d + 64] * sn) : (xs[d] * cs + xs[d - 64] * sn);
    }
    p[d] = f2bf(out);
}
__global__ void nv_softmax_kernel(float* S, int ncols, float scale) {
    __shared__ float red[4];
    float* s = S + (size_t)blockIdx.x * ncols; const int tid = threadIdx.x;
    float mx = -1e30f;
    for (int j = tid; j < ncols; j += 256) mx = fmaxf(mx, s[j]);
    for (int o = 32; o > 0; o >>= 1) mx = fmaxf(mx, __shfl_xor(mx, o));
    __syncthreads(); if ((tid & 63) == 0) red[tid >> 6] = mx; __syncthreads();
    mx = fmaxf(fmaxf(red[0], red[1]), fmaxf(red[2], red[3]));
    float sum = 0.f;
    for (int j = tid; j < ncols; j += 256) { float e = expf((s[j] - mx) * scale); s[j] = e; sum += e; }
    sum = block_sum256(sum, red);
    const float inv = 1.f / sum;
    for (int j = tid; j < ncols; j += 256) s[j] *= inv;
}
template <typename T> __device__ __forceinline__ float4 ld4(const T* p);
template <> __device__ __forceinline__ float4 ld4<float>(const float* p) { return *(const float4*)p; }
template <> __device__ __forceinline__ float4 ld4<bf16_t>(const bf16_t* p) { const u32x2 w = *(const u32x2*)p; return make_float4(__uint_as_float(w.x << 16), __uint_as_float(w.x & 0xffff0000u), __uint_as_float(w.y << 16), __uint_as_float(w.y & 0xffff0000u)); }
__device__ __forceinline__ void st4(float* p, float4 v) { *(float4*)p = v; }
__device__ __forceinline__ void st4(bf16_t* p, float4 v) { u32x2 w; w.x = pk2(v.x, v.y); w.y = pk2(v.z, v.w); *(u32x2*)p = w; }
template <typename TA, typename TB, typename TC>
__global__ void __launch_bounds__(256) nv_gemm_kernel(const TA* A, int lda, const TB* B, int ldb, TC* C, int ldc, int M, int N, int K, int bt) {
    __shared__ float As[16][128 + 4];
    __shared__ float Bs[16][128 + 4];
    const int m0 = blockIdx.y * 128, n0 = blockIdx.x * 128;
    const int tid = threadIdx.x, tx = tid & 15, ty = tid >> 4;
    float acc[8][8];
#pragma unroll
    for (int i = 0; i < 8; ++i)
#pragma unroll
        for (int j = 0; j < 8; ++j) acc[i][j] = 0.f;
    for (int k0 = 0; k0 < K; k0 += 16) {
#pragma unroll
        for (int i = 0; i < 2; ++i) { const int idx = tid + i * 256, r = idx >> 2, kq = idx & 3; float4 v = make_float4(0.f, 0.f, 0.f, 0.f);
            if (m0 + r < M) v = ld4<TA>(A + (size_t)(m0 + r) * lda + k0 + kq * 4);
            As[kq * 4 + 0][r] = v.x; As[kq * 4 + 1][r] = v.y; As[kq * 4 + 2][r] = v.z; As[kq * 4 + 3][r] = v.w; }
        if (!bt) {
#pragma unroll
            for (int i = 0; i < 2; ++i) { const int idx = tid + i * 256, kk = idx >> 5, nq = idx & 31, gn = n0 + nq * 4; float4 v = make_float4(0.f, 0.f, 0.f, 0.f);
                if (gn < N) v = ld4<TB>(B + (size_t)(k0 + kk) * ldb + gn);
                *(float4*)&Bs[kk][nq * 4] = v; }
        } else {
#pragma unroll
            for (int i = 0; i < 2; ++i) { const int idx = tid + i * 256, n = idx >> 2, kq = idx & 3, gn = n0 + n; float4 v = make_float4(0.f, 0.f, 0.f, 0.f);
                if (gn < N) v = ld4<TB>(B + (size_t)gn * ldb + k0 + kq * 4);
                Bs[kq * 4 + 0][n] = v.x; Bs[kq * 4 + 1][n] = v.y; Bs[kq * 4 + 2][n] = v.z; Bs[kq * 4 + 3][n] = v.w; }
        }
        __syncthreads();
#pragma unroll
        for (int kk = 0; kk < 16; ++kk) {
            const float4 a0 = *(const float4*)&As[kk][ty * 4], a1 = *(const float4*)&As[kk][64 + ty * 4];
            const float4 b0 = *(const float4*)&Bs[kk][tx * 4], b1 = *(const float4*)&Bs[kk][64 + tx * 4];
            const float av[8] = {a0.x, a0.y, a0.z, a0.w, a1.x, a1.y, a1.z, a1.w};
            const float bv[8] = {b0.x, b0.y, b0.z, b0.w, b1.x, b1.y, b1.z, b1.w};
#pragma unroll
            for (int i = 0; i < 8; ++i)
#pragma unroll
                for (int j = 0; j < 8; ++j) acc[i][j] += av[i] * bv[j];
        }
        __syncthreads();
    }
#pragma unroll
    for (int i = 0; i < 8; ++i) {
        const int gm = m0 + (i < 4 ? ty * 4 + i : 64 + ty * 4 + (i - 4));
        if (gm >= M) continue;
#pragma unroll
        for (int jh = 0; jh < 2; ++jh) { const int gn = n0 + jh * 64 + tx * 4; if (gn >= N) continue;
            st4(C + (size_t)gm * ldc + gn, make_float4(acc[i][jh * 4 + 0], acc[i][jh * 4 + 1], acc[i][jh * 4 + 2], acc[i][jh * 4 + 3])); }
    }
}

#ifdef DIAG_SEL
__global__ void dg_count_nonfinite(const bf16_t* p, size_t n, unsigned* cnt) {
    for (size_t i = (size_t)blockIdx.x * 256 + threadIdx.x; i < n; i += (size_t)gridDim.x * 256) {
        if ((p[i] & 0x7f80u) == 0x7f80u) { const unsigned blk = (unsigned)(i >> 15), chain = blk / 66, cid = blk % 66, v = (unsigned)(i >> 7) & 255, d = (unsigned)i & 127;
            atomicAdd(cnt, 1u); if (chain & 1) atomicAdd(cnt + 1, 1u); if (cid < 2) atomicAdd(cnt + 2, 1u); if (d < 32) atomicAdd(cnt + 3, 1u); if ((v & 31) < 16) atomicAdd(cnt + 4, 1u);
            atomicAdd(cnt + 12288 + blk, 1u); }
    }
}
__global__ void dg_reduce(unsigned* cnt) {
    if (threadIdx.x == 0) { unsigned nb = 0, mx = 0; for (int i = 0; i < 1056; ++i) { const unsigned c = cnt[12288 + i]; if (c) ++nb; if (c > mx) mx = c; } cnt[5] = nb; cnt[6] = mx; }
}
__global__ void dg_scale_out(float* out, size_t n, const unsigned* cnt) {
    const unsigned c = cnt[DIAG_SEL];
    const float f = 1.f + 0.01f * ((float)c / (float)DIAG_DIV);
    for (size_t i = (size_t)blockIdx.x * 256 + threadIdx.x; i < n; i += (size_t)gridDim.x * 256) out[i] *= f;
}
#endif
template <typename TA, typename TB, typename TC>
void nv_gemm(hipStream_t st, const TA* A, int lda, const TB* B, int ldb, TC* C, int ldc, int M, int N, int K, int bt) {
    dim3 grid((N + 127) / 128, (M + 127) / 128, 1);
    hipLaunchKernelGGL((nv_gemm_kernel<TA, TB, TC>), grid, dim3(256), 0, st, A, lda, B, ldb, C, ldc, M, N, K, bt);
}
#endif
}

static int g_grid = 0;
static void launch_phases(hipStream_t stream, Args a, int lo, int hi, int li = 0) {
    a.ph_lo = lo; a.ph_hi = hi; a.li = li;
    void* args[] = {&a};
    hipError_t e;
    if (hi - lo > 1) e = hipLaunchCooperativeKernel((const void*)mk_fwd, dim3(g_grid), dim3(NTHREADS), args, LDS_BYTES, stream);
    else { hipLaunchKernelGGL(mk_fwd, dim3(g_grid), dim3(NTHREADS), LDS_BYTES, stream, a); e = hipPeekAtLastError(); }
    if (e != hipSuccess) fprintf(stderr, "launch [%d,%d) failed: %s\n", lo, hi, hipGetErrorString(e));
}
extern "C" void kernel_launch(void* const* d_in, const int* in_sizes, int n_in, void* d_out, int out_size, void* d_ws, size_t ws_size, hipStream_t stream) {
    if (g_grid == 0) {
        if (ws_size < WS_END || n_in != 28) { fprintf(stderr, "kernel_launch: ws %zu < %zu or n_in %d\n", ws_size, (size_t)WS_END, n_in); g_grid = -1; return; }
        int dev = 0, cus = 0, per_cu = 0;
        (void)hipGetDevice(&dev); (void)hipDeviceGetAttribute(&cus, hipDeviceAttributeMultiprocessorCount, dev);
        if (hipFuncSetAttribute((const void*)mk_fwd, hipFuncAttributeMaxDynamicSharedMemorySize, LDS_BYTES) != hipSuccess) { fprintf(stderr, "hipFuncSetAttribute failed\n"); g_grid = -1; return; }
        if (hipOccupancyMaxActiveBlocksPerMultiprocessor(&per_cu, (const void*)mk_fwd, NTHREADS, LDS_BYTES) != hipSuccess || per_cu < 1) { fprintf(stderr, "occupancy query failed (%d)\n", per_cu); g_grid = -1; return; }
        g_grid = cus;
        fprintf(stderr, "kernel_launch: cus %d per_cu %d grid %d\n", cus, per_cu, g_grid);
    }
    if (g_grid < 0) return;
    unsigned char* ws = (unsigned char*)d_ws;
    (void)hipMemsetAsync(ws + WS_CTL, 0, 65536, stream);
    Args a{};
    for (int i = 0; i < 28; ++i) a.in[i] = (const float*)d_in[i];
    a.out = (float*)d_out; a.ws = ws;
    const float** in = a.in;

#ifdef EXP_NAIVE_MIXER
    launch_phases(stream, a, PH_PRO, PH_GEMM_IN + 1, 0);
    {
        const bf16_t* QK = (const bf16_t*)(ws + WS_QK); const bf16_t* V = (const bf16_t*)(ws + WS_V); const bf16_t* O = (const bf16_t*)(ws + WS_O); const bf16_t* Z = (const bf16_t*)(ws + WS_Z);
        const bf16_t* XBC = (const bf16_t*)(ws + WS_XBC); bf16_t* XC = (bf16_t*)(ws + WS_XC); const float* GATES = (const float*)(ws + WS_GATES);
        float* HM = (float*)(ws + WS_DC); float* HS = (float*)(ws + WS_DS); bf16_t* MIX = (bf16_t*)(ws + WS_MIX);
#if EXP_NAIVE_MIXER == 2
        launch_phases(stream, a, PH_CONV, PH_CONV + 1);
#else
        hipLaunchKernelGGL(nv_conv_kernel, dim3(NTOK), dim3(256), 0, stream, XBC, in[I_CONVW], in[I_CONVB], XC);
#endif
#if EXP_NAIVE_MIXER == 5
#ifdef DIAG_HOLES
        (void)hipMemsetAsync(ws + WS_DC, 0x3C, (size_t)66 * MiB, stream);
#endif
        launch_phases(stream, a, PH_MLA, PH_MLA + 1);
#ifdef DIAG_SCAN
        launch_phases(stream, a, PH_SCAN, PH_SCAN + 1);
#endif
        hipLaunchKernelGGL(dg_count_nonfinite, dim3(2048), dim3(256), 0, stream, (const bf16_t*)(ws + WS_DC), (size_t)16 * 66 * 32768, (unsigned*)(ws + WS_CTL) + 16);
        hipLaunchKernelGGL(dg_reduce, dim3(1), dim3(64), 0, stream, (unsigned*)(ws + WS_CTL) + 16);
#endif
#if EXP_NAIVE_MIXER == 3
        launch_phases(stream, a, PH_MLA, PH_MLA + 1); launch_phases(stream, a, PH_SCAN, PH_SCAN + 1); launch_phases(stream, a, PH_MLC, PH_MLC + 1);
#endif
#if EXP_NAIVE_MIXER == 4
        launch_phases(stream, a, PH_SSA, PH_SSA + 1); launch_phases(stream, a, PH_SCAN, PH_SCAN + 1); launch_phases(stream, a, PH_SSC, PH_SSC + 1);
#endif
#if EXP_NAIVE_MIXER != 3
        hipLaunchKernelGGL(nv_mlstm_rec_kernel, dim3(16, 4, 2), dim3(256), 0, stream, QK, V, GATES, HM, 0);
        hipLaunchKernelGGL(nv_mlstm_rec_kernel, dim3(16, 4, 2), dim3(256), 0, stream, QK, V, GATES, HM, 1);
        hipLaunchKernelGGL(nv_finish_m_kernel, dim3(NTOK), dim3(256), 0, stream, HM, O, in[I_MNG], MIX);
#endif
#if EXP_NAIVE_MIXER != 4
        hipLaunchKernelGGL(nv_ssd_rec_kernel, dim3(16, 2), dim3(256), 0, stream, XC, GATES, in[I_ALOG], HS, 0);
        hipLaunchKernelGGL(nv_ssd_rec_kernel, dim3(16, 2), dim3(256), 0, stream, XC, GATES, in[I_ALOG], HS, 1);
        hipLaunchKernelGGL(nv_finish_s_kernel, dim3(NTOK), dim3(256), 0, stream, HS, Z, XC, in[I_SSMD], in[I_SNG], MIX);
#endif
    }
    launch_phases(stream, a, PH_GEMM_OUT - 1, PH_COUNT, 1);
#if EXP_NAIVE_MIXER == 5
    hipLaunchKernelGGL(dg_scale_out, dim3(2048), dim3(256), 0, stream, (float*)d_out, (size_t)NLAT * D, (const unsigned*)(ws + WS_CTL) + 16);
#endif
#elif defined(DIAG_SPLIT_A)
    launch_phases(stream, a, PH_PRO, DIAG_SPLIT_A, 0);
#ifdef DIAG_SPLIT_RESETDEP
    (void)hipMemsetAsync(ws + WS_CTL + CW_DEP0 * 4, 0, 2048, stream);
#endif
    launch_phases(stream, a, DIAG_SPLIT_B, PH_COUNT, 1);
#else
    launch_phases(stream, a, PH_PRO, PH_COUNT);
#ifdef DIAG_STAMP
    hipLaunchKernelGGL(dg_perturb, dim3(2048), dim3(256), 0, stream, (float*)d_out, (size_t)NLAT * D, (const unsigned long long*)((unsigned*)(ws + WS_CTL) + 12288));
#endif
#endif
}
```

```cpp
#include <hip/hip_runtime.h>
#include <hip/hip_cooperative_groups.h>
#include <cstdint>
#include <cstdio>
namespace cg = cooperative_groups;

namespace pg8 {
#define PG8_LAS __attribute__((address_space(3)))
typedef unsigned short bf16_t;
typedef short bf16x8 __attribute__((ext_vector_type(8)));
typedef float f32x4 __attribute__((ext_vector_type(4)));
typedef unsigned u32x4 __attribute__((ext_vector_type(4)));
constexpr int BM = 256, BK = 64, HALF = 128, HTB = HALF * BK * 2  , STAGE_BYTES = 8 * HTB, NXCD = 8, WGM = 4;

__host__ __device__ __forceinline__ int lds_byte(int r, int c) { const int st = (r >> 4) * 2 + (c >> 5), rr = r & 15, cc = c & 31, ob = rr * 64 + cc * 2; return st * 1024 + (ob ^ (((ob >> 9) & 1) << 5)); }
__host__ __device__ __forceinline__ void stage_rc(int b, int& R, int& C) { const int st = b / 1024, sb = b % 1024, swz = sb ^ (((sb >> 9) & 1) << 5); R = (st >> 1) * 16 + swz / 64; C = (st & 1) * 32 + (swz % 64) / 2; }
__host__ __device__ __forceinline__ int perm32(int rho) { const int n = rho >> 4, i = rho & 15; return 8 * (i >> 2) + 4 * n + (i & 3); }

struct Unit { int pm, pn; };
struct Gemm { const bf16_t* A; const bf16_t* Bt; int M, N, K; };

struct StaticOrder {
    int nM, nN, nwg, G, c;
    __host__ __device__ __forceinline__ void init(int M, int N, int G_, int c_) { nM = M / BM; nN = N / BM; nwg = nM * nN; G = G_; c = c_; }
    __host__ __device__ __forceinline__ bool next(int i, Unit& u) const {
        const long L = (long)i * G + c; if (L >= nwg) return false;
        int wgid = (int)L; { const int q = nwg / NXCD, r = nwg % NXCD, xcd = wgid % NXCD, off = wgid / NXCD; wgid = (xcd < r ? xcd * (q + 1) : r * (q + 1) + (xcd - r) * q) + off; }
        const int nig = WGM * nN, gid = wgid / nig, fm = gid * WGM, gsz = (nM - fm) < WGM ? (nM - fm) : WGM;
        u.pm = fm + ((wgid % nig) % gsz); u.pn = (wgid % nig) / gsz; return true;
    }
    static constexpr bool LATE = false;
    __device__ __forceinline__ void a_ready(const Unit&) const {}
    __device__ __forceinline__ void done(const Unit&) const {}
    __device__ __forceinline__ void late(const Unit&) const {}
};

template <class Epi, class Sched, bool ALIGN_EPI = false, bool SP2 = false, bool GATHER = false>
__device__ __forceinline__ void gemm_phase(PG8_LAS unsigned char* lds, const Gemm g, const Sched& S, const Epi& E, const int tid) {
    const int wid = __builtin_amdgcn_readfirstlane(tid >> 6), lane = tid & 63, wr = wid >> 2, wc = wid & 3, fr = lane & 15, fq = lane >> 4;
    const int K = g.K, nt = K / BK;
    unsigned voffA[2], voffB[2];
#pragma unroll
    for (int i = 0; i < 2; ++i) { int R, C; stage_rc(tid * 16 + i * 8192, R, C); const int Rb = Epi::PERM ? ((R & ~31) + perm32(R & 31)) : R;
        voffA[i] = (unsigned)(R * K + C) * 2u; voffB[i] = (unsigned)(Rb * K + C) * 2u; }
    static_assert(!GATHER || SP2, "GATHER needs the SP2 loop");
    int gR0 = 0; unsigned gC2 = 0; { int R, C; stage_rc(tid * 16, R, C); gR0 = R; gC2 = (unsigned)C * 2u; }
    unsigned vA[2][2] = {{0u, 0u}, {0u, 0u}}, vN[2][2] = {{0u, 0u}, {0u, 0u}};
    const char* gA = (const char*)g.A;
#define PG8_GV(v, u) do { _Pragma("unroll") for (int h_ = 0; h_ < 2; ++h_) _Pragma("unroll") for (int i_ = 0; i_ < 2; ++i_) v[h_][i_] = (unsigned)S.arow(u, h_ * HALF + gR0 + 64 * i_) * (unsigned)(K * 2) + gC2; } while (0)
    const size_t kstep = (size_t)(BK * 2);
    const size_t hstep = (size_t)HALF * K * 2;
    const size_t tstep = 2 * hstep;
    const unsigned ldsw = (unsigned)wid * 1024u;
    const int aoff = lds_byte(wr * 64 + fr, fq * 8), boff = lds_byte(wc * 32 + fr, fq * 8);
#define PG8_SA(b, h) (((b) * 2 + (h)) * HTB)
#define PG8_SB(b, h) ((4 + (b) * 2 + (h)) * HTB)
#define PG8_STAGE(bufoff, gbase, voff) do { _Pragma("unroll") for (int _i = 0; _i < 2; ++_i) \
        __builtin_amdgcn_global_load_lds((const unsigned*)((const char*)(gbase) + (voff)[_i]), (PG8_LAS unsigned*)(lds + (bufoff) + ldsw + _i * 8192), 16, 0, 0); } while (0)
#define PG8_LDA(dst, b, h) do { _Pragma("unroll") for (int m = 0; m < 4; ++m) _Pragma("unroll") for (int k = 0; k < 2; ++k) dst[m][k] = *(const PG8_LAS bf16x8*)(lds + PG8_SA(b, h) + aoff + m * 2048 + k * 1024); } while (0)
#define PG8_LDB(dst, b, h) do { _Pragma("unroll") for (int n = 0; n < 2; ++n) _Pragma("unroll") for (int k = 0; k < 2; ++k) dst[n][k] = *(const PG8_LAS bf16x8*)(lds + PG8_SB(b, h) + boff + n * 2048 + k * 1024); } while (0)
#define PG8_MMA(ai, bj, At, Bt) do { __builtin_amdgcn_s_setprio(1); _Pragma("unroll") for (int m = 0; m < 4; ++m) _Pragma("unroll") for (int n = 0; n < 2; ++n) _Pragma("unroll") for (int k = 0; k < 2; ++k) \
        acc[ai][bj][m][n] = __builtin_amdgcn_mfma_f32_16x16x32_bf16(Bt[n][k], At[m][k], acc[ai][bj][m][n], 0, 0, 0); __builtin_amdgcn_s_setprio(0); } while (0)
#define PG8_WAIT_V(n) asm volatile("s_waitcnt vmcnt(" #n ")" ::: "memory")
#define PG8_WAIT_L(n) asm volatile("s_waitcnt lgkmcnt(" #n ")" ::: "memory")
#define PG8_BAR __builtin_amdgcn_s_barrier()
#define PG8_SCHED __builtin_amdgcn_sched_barrier(0)
    Unit cur, nxt, prv; int ui = 0;
    if (!S.next(0, cur)) return;
    f32x4 acc[2][2][4][2];
#pragma unroll
    for (int a = 0; a < 2; ++a)
#pragma unroll
        for (int b = 0; b < 2; ++b)
#pragma unroll
            for (int m = 0; m < 4; ++m)
#pragma unroll
                for (int n = 0; n < 2; ++n) acc[a][b][m][n] = (f32x4){0.f, 0.f, 0.f, 0.f};
    bf16x8 At[4][2], B0[2][2], B1[2][2];
    const char* cA = (const char*)g.A + (size_t)cur.pm * tstep; const char* cB = (const char*)g.Bt + (size_t)cur.pn * tstep;
    S.a_ready(cur);
    if constexpr (SP2) {
        if constexpr (GATHER) { PG8_GV(vA, cur); }
        PG8_STAGE(PG8_SB(0, 0), cB, voffB); PG8_STAGE(PG8_SB(0, 1), cB + hstep, voffB);
        if constexpr (GATHER) { PG8_STAGE(PG8_SA(0, 0), gA, vA[0]); PG8_STAGE(PG8_SA(0, 1), gA, vA[1]); } else { PG8_STAGE(PG8_SA(0, 0), cA, voffA); PG8_STAGE(PG8_SA(0, 1), cA + hstep, voffA); }
        if (wr == 1) PG8_BAR;
        PG8_WAIT_V(2); PG8_BAR;
        PG8_STAGE(PG8_SB(1, 0), cB + kstep, voffB); if constexpr (GATHER) { PG8_STAGE(PG8_SA(1, 0), gA + kstep, vA[0]); } else { PG8_STAGE(PG8_SA(1, 0), cA + kstep, voffA); } PG8_STAGE(PG8_SB(1, 1), cB + hstep + kstep, voffB);
        PG8_WAIT_V(6); PG8_BAR;
    } else {
        PG8_STAGE(PG8_SB(0, 0), cB, voffB); PG8_STAGE(PG8_SA(0, 0), cA, voffA); PG8_STAGE(PG8_SB(0, 1), cB + hstep, voffB); PG8_STAGE(PG8_SA(0, 1), cA + hstep, voffA);
        if (wr == 1) PG8_BAR;
        PG8_WAIT_V(4); PG8_BAR;
        PG8_STAGE(PG8_SB(1, 0), cB + kstep, voffB); PG8_STAGE(PG8_SA(1, 0), cA + kstep, voffA); PG8_STAGE(PG8_SB(1, 1), cB + hstep + kstep, voffB);
        PG8_WAIT_V(6); PG8_BAR;
    }
    for (;;) {
        const bool has_next = S.next(ui + 1, nxt);
        if constexpr (GATHER) { if (has_next) { PG8_GV(vN, nxt); } else { _Pragma("unroll") for (int h_ = 0; h_ < 2; ++h_) _Pragma("unroll") for (int i_ = 0; i_ < 2; ++i_) vN[h_][i_] = vA[h_][i_]; } }
        const char* nA = has_next ? (const char*)g.A + (size_t)nxt.pm * tstep : cA; const char* nB = has_next ? (const char*)g.Bt + (size_t)nxt.pn * tstep : cB;
        for (int t = 0; t < nt; t += 2) {
            if constexpr (Epi::MIDK) { if (t == nt / 2) E.midk(acc, cur, wr, wc, fr, fq); }
            if constexpr (Sched::LATE) { if (t == 2 && ui > 0) S.late(prv); }
            const bool last = (t == nt - 2);
            const char* a1 = cA + (size_t)(t + 1) * kstep;
            const char* a2 = last ? nA : cA + (size_t)(t + 2) * kstep; const char* b2 = last ? nB : cB + (size_t)(t + 2) * kstep;
            const char* a3 = a2 + kstep; const char* b3 = b2 + kstep;
            if (last && has_next) S.a_ready(nxt);
            const size_t ka1 = (size_t)(t + 1) * kstep, ka2 = last ? (size_t)0 : (size_t)(t + 2) * kstep, ka3 = ka2 + kstep;
            unsigned vs0[2] = {last ? vN[0][0] : vA[0][0], last ? vN[0][1] : vA[0][1]}, vs1[2] = {last ? vN[1][0] : vA[1][0], last ? vN[1][1] : vA[1][1]};
            if constexpr (SP2) {
            PG8_LDB(B0, 0, 0); PG8_LDB(B1, 0, 1); PG8_SCHED; PG8_LDA(At, 0, 0); if constexpr (GATHER) { PG8_STAGE(PG8_SA(1, 1), gA + ka1, vA[1]); } else { PG8_STAGE(PG8_SA(1, 1), a1 + hstep, voffA); }
            PG8_WAIT_V(8); PG8_WAIT_L(0); PG8_BAR; PG8_MMA(0, 0, At, B0); PG8_MMA(0, 1, At, B1); PG8_BAR; PG8_SCHED;
            PG8_LDA(At, 0, 1); PG8_STAGE(PG8_SB(0, 0), b2, voffB); PG8_STAGE(PG8_SB(0, 1), b2 + hstep, voffB); if constexpr (GATHER) { PG8_STAGE(PG8_SA(0, 0), gA + ka2, vs0); } else { PG8_STAGE(PG8_SA(0, 0), a2, voffA); }
            PG8_WAIT_V(8); PG8_WAIT_L(0); PG8_BAR; PG8_MMA(1, 0, At, B0); PG8_MMA(1, 1, At, B1); PG8_BAR; PG8_SCHED;
            PG8_LDB(B0, 1, 0); PG8_LDB(B1, 1, 1); PG8_SCHED; PG8_LDA(At, 1, 0); if constexpr (GATHER) { PG8_STAGE(PG8_SA(0, 1), gA + ka2, vs1); } else { PG8_STAGE(PG8_SA(0, 1), a2 + hstep, voffA); }
            PG8_WAIT_V(8); PG8_WAIT_L(0); PG8_BAR; PG8_MMA(0, 0, At, B0); PG8_MMA(0, 1, At, B1); PG8_BAR; PG8_SCHED;
            PG8_LDA(At, 1, 1); PG8_STAGE(PG8_SB(1, 0), b3, voffB); PG8_STAGE(PG8_SB(1, 1), b3 + hstep, voffB); if constexpr (GATHER) { PG8_STAGE(PG8_SA(1, 0), gA + ka3, vs0); } else { PG8_STAGE(PG8_SA(1, 0), a3, voffA); }
            PG8_WAIT_V(8); PG8_WAIT_L(0); PG8_BAR; PG8_MMA(1, 0, At, B0); PG8_MMA(1, 1, At, B1); PG8_BAR; PG8_SCHED;
            } else {
            PG8_LDB(B0, 0, 0); PG8_SCHED; PG8_LDA(At, 0, 0); PG8_STAGE(PG8_SA(1, 1), a1 + hstep, voffA);
            PG8_WAIT_L(8); PG8_BAR; PG8_WAIT_L(0); PG8_MMA(0, 0, At, B0); PG8_BAR; PG8_SCHED;
            PG8_LDB(B1, 0, 1); PG8_STAGE(PG8_SB(0, 0), b2, voffB);
            PG8_BAR; PG8_WAIT_L(0); PG8_MMA(0, 1, At, B1); PG8_BAR;
            PG8_LDA(At, 0, 1); PG8_STAGE(PG8_SA(0, 0), a2, voffA);
            PG8_BAR; PG8_WAIT_L(0); PG8_MMA(1, 0, At, B0); PG8_BAR; PG8_SCHED;
            PG8_STAGE(PG8_SB(0, 1), b2 + hstep, voffB);
            PG8_WAIT_V(6); PG8_BAR; PG8_MMA(1, 1, At, B1); PG8_BAR;
            PG8_LDB(B0, 1, 0); PG8_SCHED; PG8_LDA(At, 1, 0); PG8_STAGE(PG8_SA(0, 1), a2 + hstep, voffA);
            PG8_WAIT_L(8); PG8_BAR; PG8_WAIT_L(0); PG8_MMA(0, 0, At, B0); PG8_BAR; PG8_SCHED;
            PG8_LDB(B1, 1, 1); PG8_STAGE(PG8_SB(1, 0), b3, voffB);
            PG8_BAR; PG8_WAIT_L(0); PG8_MMA(0, 1, At, B1); PG8_BAR;
            PG8_LDA(At, 1, 1); PG8_STAGE(PG8_SA(1, 0), a3, voffA);
            PG8_BAR; PG8_WAIT_L(0); PG8_MMA(1, 0, At, B0); PG8_BAR; PG8_SCHED;
            PG8_STAGE(PG8_SB(1, 1), b3 + hstep, voffB);
            PG8_WAIT_V(6); PG8_BAR; PG8_MMA(1, 1, At, B1); PG8_BAR;
            }
        }
        if constexpr (ALIGN_EPI) { if (wr == 0) PG8_BAR; }
        if constexpr (!Epi::AFTER_DRAIN) { E(acc, cur, wr, wc, fr, fq); S.done(cur); }
        if constexpr (Sched::LATE) prv = cur;
        if (!has_next) break;
#pragma unroll
        for (int a = 0; a < 2; ++a)
#pragma unroll
            for (int b = 0; b < 2; ++b)
#pragma unroll
                for (int m = 0; m < 4; ++m)
#pragma unroll
                    for (int n = 0; n < 2; ++n) acc[a][b][m][n] = (f32x4){0.f, 0.f, 0.f, 0.f};
        cur = nxt; cA = nA; cB = nB; ++ui;
        if constexpr (GATHER) { _Pragma("unroll") for (int h_ = 0; h_ < 2; ++h_) _Pragma("unroll") for (int i_ = 0; i_ < 2; ++i_) vA[h_][i_] = vN[h_][i_]; }
        if constexpr (ALIGN_EPI) { if (wr == 1) PG8_BAR; }
    }
    PG8_WAIT_V(0);
    if constexpr (Sched::LATE) S.late(cur);
    if constexpr (!ALIGN_EPI) { if (wr == 0) PG8_BAR; }
    PG8_BAR;
    if constexpr (Epi::AFTER_DRAIN) { E.fused(acc, cur, wr, wc, fr, fq, lds, wid, lane); S.done(cur); }
#undef PG8_GV
#undef PG8_SA
#undef PG8_SB
#undef PG8_STAGE
#undef PG8_LDA
#undef PG8_LDB
#undef PG8_MMA
#undef PG8_WAIT_V
#undef PG8_WAIT_L
#undef PG8_BAR
#undef PG8_SCHED
}
}
namespace attn {
using bf16 = unsigned short;
constexpr int D = 128, NW = 8, QBLK = 32, KVBLK = 64;
constexpr float SCALE = 0.088388347648318440f;
constexpr float THR = 8.f;
constexpr int LDQ = 1024, LDK = 256, LDO = 1024;
constexpr size_t SHM_V = KVBLK * D * 2, SHM_K = KVBLK * D * 2, SHM_ATTN = 2 * SHM_V + 2 * SHM_K + NW * 64 * 4;
using bf16x8 = __attribute__((ext_vector_type(8))) short;
using s16x4  = __attribute__((ext_vector_type(4))) short;
using f32x16 = __attribute__((ext_vector_type(16))) float;
using f32x8  = __attribute__((ext_vector_type(8))) float;
using u32x4  = __attribute__((ext_vector_type(4))) unsigned;
#define KSWZ(row, colB) ((row) * 256 + ((colB) ^ (((row) & 7) << 4)))
#define SBAR() __builtin_amdgcn_sched_barrier(0)
__device__ __forceinline__ int crow(int r, int hi) { return (r & 3) + 8 * (r >> 2) + 4 * hi; }
__device__ __forceinline__ unsigned cvtpk(float lo, float hi) {
  unsigned r; asm volatile("v_cvt_pk_bf16_f32 %0, %1, %2" : "=v"(r) : "v"(lo), "v"(hi)); return r;
}
template <typename TIn> struct Stage;
template <> struct Stage<bf16>  { using T = bf16x8;
  __device__ static __forceinline__ T ld8(const bf16* p) { return *reinterpret_cast<const bf16x8*>(p); }
  __device__ static __forceinline__ bf16x8 tobf(T x) { return x; } };
template <> struct Stage<float> { using T = f32x8;
  __device__ static __forceinline__ T ld8(const float* p) { return *reinterpret_cast<const f32x8*>(p); }
  __device__ static __forceinline__ bf16x8 tobf(T x) {
    u32x4 w = {cvtpk(x[0], x[1]), cvtpk(x[2], x[3]), cvtpk(x[4], x[5]), cvtpk(x[6], x[7])}; return *reinterpret_cast<bf16x8*>(&w); } };

template <bool NOREF> __device__ __forceinline__ void partialSM(f32x16& p0, f32x16& p1, float& m_reg, float& mn, float& alpha) {
  if constexpr (NOREF) { alpha = 1.f; for (int r = 0; r < 16; ++r) p0[r] = __builtin_amdgcn_exp2f(p0[r]); return; }
  constexpr float C = SCALE * 1.4426950408889634f;
  float pmax = p0[0]; for (int r = 1; r < 16; ++r) pmax = fmaxf(pmax, p0[r]); for (int r = 0; r < 16; ++r) pmax = fmaxf(pmax, p1[r]);
  { auto rr = __builtin_amdgcn_permlane32_swap(__float_as_uint(pmax), __float_as_uint(pmax), false, false);
    pmax = fmaxf(__uint_as_float(rr[0]), __uint_as_float(rr[1])); }
  if (__builtin_expect(__all(pmax - m_reg <= THR / SCALE), 1)) { mn = m_reg; alpha = 1.f; }
  else { mn = fmaxf(m_reg, pmax); alpha = __builtin_amdgcn_exp2f((m_reg - mn) * C); m_reg = mn; }
  float mnC = -mn * C;
  for (int r = 0; r < 16; ++r) p0[r] = fmaf(p0[r], C, mnC); for (int r = 0; r < 16; ++r) p1[r] = fmaf(p1[r], C, mnC);
  for (int r = 0; r < 16; ++r) p0[r] = __builtin_amdgcn_exp2f(p0[r]);
}
template <bool NOREF> __device__ __forceinline__ void finishSM(f32x16& p0, f32x16& p1, float alpha, float& l_reg, bf16x8& pa0, bf16x8& pa1, bf16x8& pa2, bf16x8& pa3) {
  for (int r = 0; r < 16; ++r) p1[r] = __builtin_amdgcn_exp2f(p1[r]);
  float ps = 0; for (int r = 0; r < 16; ++r) ps += p0[r]; for (int r = 0; r < 16; ++r) ps += p1[r];
  if constexpr (NOREF) { l_reg += ps; }
  else {
  { auto rr = __builtin_amdgcn_permlane32_swap(__float_as_uint(ps), __float_as_uint(ps), false, false);
    ps = __uint_as_float(rr[0]) + __uint_as_float(rr[1]); }
  l_reg = l_reg * alpha + ps; }
#define PK4(P, BASE, OUT) do { u32x4 w = {cvtpk(P[BASE + 0], P[BASE + 1]), cvtpk(P[BASE + 2], P[BASE + 3]), cvtpk(P[BASE + 4], P[BASE + 5]), cvtpk(P[BASE + 6], P[BASE + 7])}; OUT = *reinterpret_cast<bf16x8*>(&w); } while (0)
  PK4(p0, 0, pa0); PK4(p0, 8, pa1); PK4(p1, 0, pa2); PK4(p1, 8, pa3);
#undef PK4
}
__device__ __forceinline__ void qkt(f32x16& p0, f32x16& p1, const bf16* Ks, const bf16x8* qr, int r32, int hi) {
  p0 = f32x16{}; p1 = f32x16{};
  for (int d0 = 0; d0 < 8; ++d0) { int cb = (d0 * 16 + hi * 8) * 2;
    bf16x8 b0 = *reinterpret_cast<const bf16x8*>((const char*)Ks + KSWZ(r32, cb));
    bf16x8 b1 = *reinterpret_cast<const bf16x8*>((const char*)Ks + KSWZ(32 + r32, cb));
    p0 = __builtin_amdgcn_mfma_f32_32x32x16_bf16(b0, qr[d0], p0, 0, 0, 0);
    p1 = __builtin_amdgcn_mfma_f32_32x32x16_bf16(b1, qr[d0], p1, 0, 0, 0); }
}
__device__ __forceinline__ int v_st(int k, int c) { const int kk = (k & ~0xC) | ((k & 4) << 1) | ((k & 8) >> 1); return ((kk >> 3) * 4 + (c >> 5)) * 512 + ((kk & 7) * 32 + (c & 31)) * 2; }
__device__ __forceinline__ int v_st_nat(int k, int c) { return ((k >> 3) * 4 + (c >> 5)) * 512 + ((k & 7) * 32 + (c & 31)) * 2; }
__device__ __forceinline__ int v_rd_base(int lane) { return ((lane & 3) << 3) | (((lane >> 2) & 3) << 6) | (((lane >> 4) & 1) << 5) | (((lane >> 5) & 1) << 8); }
constexpr int v_rd_off(int d0, int ks, int half) { return d0 * 512 + ks * 4096 + half * 2048; }
template <int OFF> __device__ __forceinline__ s16x4 tr_read(int vb) {
  s16x4 r; asm volatile("ds_read_b64_tr_b16 %0, %1 offset:%2" : "=&v"(r) : "v"(vb), "i"(OFF) : "memory"); return r;
}
template <int D0, bool SM = false> __device__ __forceinline__ void pv_one(f32x16& od, int vb, bf16x8 pa0, bf16x8 pa1, bf16x8 pa2, bf16x8 pa3, f32x16* pn = nullptr) {
  const s16x4 l0 = tr_read<v_rd_off(D0, 0, 0)>(vb), h0 = tr_read<v_rd_off(D0, 0, 1)>(vb), l1 = tr_read<v_rd_off(D0, 1, 0)>(vb), h1 = tr_read<v_rd_off(D0, 1, 1)>(vb);
  const s16x4 l2 = tr_read<v_rd_off(D0, 2, 0)>(vb), h2 = tr_read<v_rd_off(D0, 2, 1)>(vb), l3 = tr_read<v_rd_off(D0, 3, 0)>(vb), h3 = tr_read<v_rd_off(D0, 3, 1)>(vb);
  if constexpr (SM) {
#pragma unroll
    for (int r = 4 * D0; r < 4 * D0 + 4; ++r) (*pn)[r] = __builtin_amdgcn_exp2f((*pn)[r]); }
  asm volatile("s_waitcnt lgkmcnt(0)" ::: "memory"); SBAR();
#define PK(L, H) (bf16x8){L[0], L[1], L[2], L[3], H[0], H[1], H[2], H[3]}
  od = __builtin_amdgcn_mfma_f32_32x32x16_bf16(pa0, PK(l0, h0), od, 0, 0, 0);
  od = __builtin_amdgcn_mfma_f32_32x32x16_bf16(pa1, PK(l1, h1), od, 0, 0, 0);
  od = __builtin_amdgcn_mfma_f32_32x32x16_bf16(pa2, PK(l2, h2), od, 0, 0, 0);
  od = __builtin_amdgcn_mfma_f32_32x32x16_bf16(pa3, PK(l3, h3), od, 0, 0, 0);
#undef PK
}
__device__ __forceinline__ void pv_d0(f32x16* o, int vb, bf16x8 pa0, bf16x8 pa1, bf16x8 pa2, bf16x8 pa3) {
  pv_one<0>(o[0], vb, pa0, pa1, pa2, pa3); pv_one<1>(o[1], vb, pa0, pa1, pa2, pa3); pv_one<2>(o[2], vb, pa0, pa1, pa2, pa3); pv_one<3>(o[3], vb, pa0, pa1, pa2, pa3);
}
__device__ __forceinline__ void pv_d0_sm(f32x16* o, int vb, bf16x8 pa0, bf16x8 pa1, bf16x8 pa2, bf16x8 pa3, f32x16& pn) {
  pv_one<0, true>(o[0], vb, pa0, pa1, pa2, pa3, &pn); pv_one<1, true>(o[1], vb, pa0, pa1, pa2, pa3, &pn); pv_one<2, true>(o[2], vb, pa0, pa1, pa2, pa3, &pn); pv_one<3, true>(o[3], vb, pa0, pa1, pa2, pa3, &pn);
}

template <typename TQ, bool NOREF, int SDEPTH>
__device__ __forceinline__ void attn_dense_body(const TQ* __restrict__ Qb, const bf16* __restrict__ Kh, const bf16* __restrict__ Vh,
                                                bf16* __restrict__ Ob, int seq, char* lds, const int tid, const float* __restrict__ qg, const int t0, const float* __restrict__ rope) {
  using St = Stage<bf16>; using SQ = Stage<TQ>;
  const int wid = tid >> 6, lane = tid & 63, r32 = lane & 31, hi = lane >> 5;
  bf16* V_lds = (bf16*)lds; bf16* K_lds = (bf16*)(lds + 2 * SHM_V);
  float* ws = (float*)(lds + 2 * SHM_V + 2 * SHM_K) + wid * 64; float* li_l = ws; float* al_l = ws + 32;
  float m_reg = -1e30f, l_reg = 0; f32x16 o[4] = {}; bf16x8 qr[8];
  const TQ* Qw = Qb + (long)(wid * QBLK + r32) * LDQ + hi * 8;
#pragma unroll
  for (int d0 = 0; d0 < 8; ++d0) qr[d0] = SQ::tobf(SQ::ld8(Qw + d0 * 16));
  if (qg) {
    float f[8][8]; float ss = 0.f;
#pragma unroll
    for (int d0 = 0; d0 < 8; ++d0) { const u32x4 w = *reinterpret_cast<const u32x4*>(&qr[d0]);
#pragma unroll
      for (int e = 0; e < 4; ++e) { f[d0][2 * e] = __uint_as_float(w[e] << 16); f[d0][2 * e + 1] = __uint_as_float(w[e] & 0xffff0000u); ss += f[d0][2 * e] * f[d0][2 * e] + f[d0][2 * e + 1] * f[d0][2 * e + 1]; } }
    { auto rr = __builtin_amdgcn_permlane32_swap(__float_as_uint(ss), __float_as_uint(ss), false, false); ss = __uint_as_float(rr[0]) + __uint_as_float(rr[1]); }
    const float rs = rsqrtf(ss * (1.f / 128.f) + 1e-6f);
#pragma unroll
    for (int d0 = 0; d0 < 8; ++d0)
#pragma unroll
      for (int j = 0; j < 8; ++j) f[d0][j] *= rs * qg[16 * d0 + 8 * hi + j] * (NOREF ? SCALE * 1.4426950408889634f : 1.f);
    const int t = t0 + wid * QBLK + r32;
#pragma unroll
    for (int d0 = 0; d0 < 4; ++d0) { const float* rp = rope + (d0 < 2 ? (t / 64) : (t % 64)) * 64;
#pragma unroll
      for (int j = 0; j < 8; ++j) { const int fi = (16 * d0 + 8 * hi + j) & 31; const float cs = rp[2 * fi], sn = rp[2 * fi + 1];
        const float x1 = f[d0][j], x2 = f[d0 + 4][j]; f[d0][j] = x1 * cs - x2 * sn; f[d0 + 4][j] = x2 * cs + x1 * sn; } }
#pragma unroll
    for (int d0 = 0; d0 < 8; ++d0) { u32x4 w = {cvtpk(f[d0][0], f[d0][1]), cvtpk(f[d0][2], f[d0][3]), cvtpk(f[d0][4], f[d0][5]), cvtpk(f[d0][6], f[d0][7])}; qr[d0] = *reinterpret_cast<bf16x8*>(&w); }
  }
  const int sr = tid >> 4, sc = (tid & 15) * 8, vst0 = v_st_nat(sr, sc), vst1 = v_st_nat(32 + sr, sc);
  const int vb0 = (int)(uintptr_t)V_lds + v_rd_base(lane);
  struct { typename St::T vs0, vs1, ks0, ks1; } sr_[SDEPTH];
#define SLOAD(i, k0) do { const unsigned o0_ = (unsigned)(((k0) + sr) * LDK + sc), o1_ = o0_ + 32u * LDK;   \
    sr_[i].vs0 = St::ld8(Vh + o0_); sr_[i].vs1 = St::ld8(Vh + o1_); sr_[i].ks0 = St::ld8(Kh + o0_); sr_[i].ks1 = St::ld8(Kh + o1_); } while (0)
#define SWRITE(b, i) do { *(bf16x8*)((char*)V_lds + (b) * SHM_V + vst0) = St::tobf(sr_[i].vs0);          \
    *(bf16x8*)((char*)V_lds + (b) * SHM_V + vst1) = St::tobf(sr_[i].vs1); int kc = sc * 2;               \
    *(bf16x8*)((char*)K_lds + (b) * SHM_K + KSWZ(sr, kc)) = St::tobf(sr_[i].ks0);                       \
    *(bf16x8*)((char*)K_lds + (b) * SHM_K + KSWZ(32 + sr, kc)) = St::tobf(sr_[i].ks1); } while (0)
#define SWAIT() do { if constexpr (SDEPTH == 2) asm volatile("s_waitcnt vmcnt(4)" ::: "memory"); else asm volatile("s_waitcnt vmcnt(0)" ::: "memory"); } while (0)
#define RESC(a) do { if (!NOREF && __any((a) < 1.f)) { if (hi == 0) al_l[r32] = (a); asm volatile("s_waitcnt lgkmcnt(0)" ::: "memory"); \
    for (int d = 0; d < 4; ++d) for (int r = 0; r < 16; ++r) o[d][r] *= al_l[crow(r, hi)]; } } while (0)
  f32x16 pA0, pA1, pB0, pB1; float mnA, mnB, alA, alB; bf16x8 pa0, pa1, pa2, pa3; const int NT = seq / KVBLK;
  constexpr int SE = 0, SO = SDEPTH - 1;
  SLOAD(SE, 0); asm volatile("s_waitcnt vmcnt(0)" ::: "memory"); SWRITE(0, SE); __syncthreads();
  qkt(pA0, pA1, K_lds, qr, r32, hi); partialSM<NOREF>(pA0, pA1, m_reg, mnA, alA);
  SLOAD(SO, KVBLK); if constexpr (SDEPTH == 2) { if (2 < NT) SLOAD(SE, 2 * KVBLK); }
  SWAIT(); SWRITE(1, SO); __syncthreads();
  for (int j = 1; j + 1 < NT; j += 2) {
    SBAR(); qkt(pB0, pB1, (bf16*)((char*)K_lds + SHM_K), qr, r32, hi);
    finishSM<NOREF>(pA0, pA1, alA, l_reg, pa0, pa1, pa2, pa3); SBAR();
    SLOAD(SO, (j + SDEPTH) * KVBLK); SBAR();
    if constexpr (NOREF) { pv_d0_sm(o, vb0, pa0, pa1, pa2, pa3, pB0); alB = 1.f; } else { pv_d0(o, vb0, pa0, pa1, pa2, pa3); partialSM<NOREF>(pB0, pB1, m_reg, mnB, alB); }
    __syncthreads(); SWAIT(); SWRITE(0, SE);
    RESC(alB); __syncthreads();
    SBAR(); qkt(pA0, pA1, K_lds, qr, r32, hi);
    finishSM<NOREF>(pB0, pB1, alB, l_reg, pa0, pa1, pa2, pa3); SBAR();
    if (SDEPTH == 1 || j + 3 < NT) SLOAD(SE, (j + 1 + SDEPTH) * KVBLK); SBAR();
    if constexpr (NOREF) { pv_d0_sm(o, vb0 + (int)SHM_V, pa0, pa1, pa2, pa3, pA0); alA = 1.f; } else { pv_d0(o, vb0 + (int)SHM_V, pa0, pa1, pa2, pa3); partialSM<NOREF>(pA0, pA1, m_reg, mnA, alA); }
    __syncthreads(); SWAIT(); SWRITE(1, SO);
    RESC(alA); __syncthreads();
  }
  SBAR(); qkt(pB0, pB1, (bf16*)((char*)K_lds + SHM_K), qr, r32, hi);
  finishSM<NOREF>(pA0, pA1, alA, l_reg, pa0, pa1, pa2, pa3); SBAR();
  if constexpr (NOREF) { pv_d0_sm(o, vb0, pa0, pa1, pa2, pa3, pB0); alB = 1.f; } else { pv_d0(o, vb0, pa0, pa1, pa2, pa3); partialSM<NOREF>(pB0, pB1, m_reg, mnB, alB); }
  __syncthreads(); RESC(alB);
  finishSM<NOREF>(pB0, pB1, alB, l_reg, pa0, pa1, pa2, pa3); SBAR();
  pv_d0(o, vb0 + (int)SHM_V, pa0, pa1, pa2, pa3);
  if constexpr (NOREF) { auto rr = __builtin_amdgcn_permlane32_swap(__float_as_uint(l_reg), __float_as_uint(l_reg), false, false); l_reg = __uint_as_float(rr[0]) + __uint_as_float(rr[1]); }
  if (hi == 0) li_l[r32] = l_reg; asm volatile("s_waitcnt lgkmcnt(0)" ::: "memory");
  float rli[16];
#pragma unroll
  for (int r = 0; r < 16; ++r) rli[r] = __builtin_amdgcn_rcpf(li_l[crow(r, hi)]);
  bf16* Ow = Ob + (long)(wid * QBLK) * LDO;
#pragma unroll
  for (int r = 0; r < 16; ++r) { int orow = crow(r, hi);
    for (int d0 = 0; d0 < 4; ++d0) Ow[(long)orow * LDO + d0 * 32 + r32] = (bf16)(cvtpk(o[d0][r] * rli[r], 0.f) & 0xffffu); }
#undef SLOAD
#undef SWRITE
#undef SWAIT
#undef RESC
}
}

namespace {
using pg8::bf16_t; using pg8::bf16x8; using pg8::f32x4; using pg8::u32x4;
typedef unsigned u32x2 __attribute__((ext_vector_type(2)));
typedef float f32x16 __attribute__((ext_vector_type(16)));
typedef short s16x4 __attribute__((ext_vector_type(4)));
#define LAS __attribute__((address_space(3)))

constexpr int D = 1024, NBATCH = 2, SEQ = 8192, CTXL = 256;
constexpr int NLAT = NBATCH * SEQ, NCTX = NBATCH * CTXL, NTOK = NLAT + NCTX;
constexpr int SLEN = CTXL + SEQ;
constexpr int NCH = SLEN / 128;
constexpr int ABIN = 5680, NWIN = 5888;
constexpr int NGATE = 48;
constexpr float ALPHA = 1.4142135623730951f;
constexpr int NWAVES = 8, NTHREADS = 512;
constexpr int MOE_MAXTILES = 148;

constexpr size_t MiB = 1u << 20;
constexpr size_t WS_CTL = 0;
constexpr size_t WS_MODV = 64 * 1024;
constexpr size_t WS_ROPE = 208 * 1024;
constexpr size_t WS_DN = 256 * 1024;
constexpr size_t WS_MS = 784 * 1024;
constexpr size_t WS_AEND = 808 * 1024;
constexpr size_t WS_WIN = 1 * MiB;
constexpr size_t WS_WOUT = 12 * MiB + 512 * 1024;
constexpr size_t WS_ATIN = 16 * MiB + 512 * 1024;
constexpr size_t WS_ATOUT = 19 * MiB + 512 * 1024;
constexpr size_t WS_XL = 22 * MiB;
constexpr size_t WS_HB = 88 * MiB;
constexpr size_t WS_MOEW = 121 * MiB;
constexpr size_t WS_ROUTE = 217 * MiB;
constexpr size_t WS_R = 219 * MiB;
constexpr size_t WS_QK = WS_R, WS_V = WS_R + 33 * MiB, WS_O = WS_R + 66 * MiB, WS_Z = WS_R + 99 * MiB, WS_XBC = WS_R + 132 * MiB;
constexpr size_t WS_GATES = WS_R + 182 * MiB;
constexpr size_t WS_SSQ = WS_R + 185 * MiB + 256 * 1024;
constexpr size_t WS_MIX = WS_R + 186 * MiB;
constexpr size_t WS_XC = WS_HB;
constexpr size_t WS_DS = 138 * MiB;
constexpr size_t WS_DC = WS_XL;
constexpr size_t WS_YB = WS_R;
constexpr size_t WS_XS = WS_R, WS_HMID = WS_R + 74 * MiB, WS_YS = WS_R + 148 * MiB;
constexpr size_t WS_Q = WS_R, WS_KB = WS_R + 33 * MiB, WS_VB = WS_R + 42 * MiB, WS_AO = WS_R + 51 * MiB, WS_YB1 = WS_R + 84 * MiB, WS_S = WS_R + 117 * MiB;
constexpr size_t WS_TOKTAB = 472 * MiB;
constexpr size_t WS_MLG = 476 * MiB;
constexpr size_t WS_SSG = 479 * MiB;
constexpr size_t WS_END = 486 * MiB;

constexpr int CW_CNT0 = 64, CW_CNT1 = 128;
constexpr int CW_DEP0 = 256, CW_DEP1 = 512;
constexpr int CW_BAR = 1024;

__device__ __forceinline__ float bf2f(unsigned short v) { return __uint_as_float((unsigned)v << 16); }
typedef float f32x2_t __attribute__((ext_vector_type(2))); typedef __bf16 bf16x2_t __attribute__((ext_vector_type(2)));
__device__ __forceinline__ unsigned pk2(float lo, float hi) { f32x2_t v = {lo, hi}; bf16x2_t b = __builtin_convertvector(v, bf16x2_t); return __builtin_bit_cast(unsigned, b); }
__device__ __forceinline__ bf16_t f2bf(float f) { return (bf16_t)(pk2(f, 0.f) & 0xffffu); }
__device__ __forceinline__ float siluf(float x) { return x * __builtin_amdgcn_rcpf(1.f + __expf(-x)); }
__device__ __forceinline__ float sigmf(float x) { return __builtin_amdgcn_rcpf(1.f + __expf(-x)); }
__device__ __forceinline__ float softplusf(float x) { return x > 20.f ? x : log1pf(expf(x)); }
__device__ __forceinline__ float logsigf(float x) { return -softplusf(-x); }
__device__ __forceinline__ float wave_sum(float v) {
#pragma unroll
    for (int o = 1; o < 64; o <<= 1) v += __shfl_xor(v, o);
    return v;
}
__device__ __forceinline__ float wave_max(float v) {
#pragma unroll
    for (int o = 1; o < 64; o <<= 1) v = fmaxf(v, __shfl_xor(v, o));
    return v; }
__device__ __forceinline__ unsigned char* launder_ptr(unsigned char* p) { asm volatile("" : "+s"(p)); return p; }
__device__ __forceinline__ int fresh_lane() { int z = 0; asm volatile("" : "+s"(z)); return (int)__builtin_amdgcn_mbcnt_hi(~0u, __builtin_amdgcn_mbcnt_lo(~0u, (unsigned)z)); }
__device__ __forceinline__ int mod_index(int row) { return row < NLAT ? row / SEQ : 2; }
__device__ __forceinline__ int seq_row(int b, int dir, int i) {
    if (i < CTXL) { int t = dir ? (CTXL - 1 - i) : i; return NLAT + b * CTXL + t; }
    int t = i - CTXL; if (dir) t = SEQ - 1 - t; return b * SEQ + t;
}
__device__ __forceinline__ int chunk_row0(int b, int cid) { return cid < 2 ? NLAT + b * CTXL + cid * 128 : b * SEQ + (cid - 2) * 128; }
__device__ __forceinline__ int scan_cid(int dir, int p) { return dir == 0 ? p : (p < 2 ? 1 - p : 67 - p); }

struct RowF { f32x4 v[4]; };
__device__ __forceinline__ RowF row_ld_f32(const float* p, int lane) { RowF r; const f32x4* q = (const f32x4*)p + lane;
#pragma unroll
    for (int j = 0; j < 4; ++j) r.v[j] = q[64 * j];
    return r; }
__device__ __forceinline__ RowF row_ld_bf16(const bf16_t* p, int lane) { RowF r; const u32x2* q = (const u32x2*)p + lane;
#pragma unroll
    for (int j = 0; j < 4; ++j) { const u32x2 w = q[64 * j]; r.v[j] = (f32x4){__uint_as_float(w.x << 16), __uint_as_float(w.x & 0xffff0000u), __uint_as_float(w.y << 16), __uint_as_float(w.y & 0xffff0000u)}; }
    return r; }
struct RowRaw { u32x2 w[4]; };
__device__ __forceinline__ RowRaw row_ldraw_bf16(const bf16_t* p, int lane) { RowRaw r; const u32x2* q = (const u32x2*)p + lane;
#pragma unroll
    for (int j = 0; j < 4; ++j) r.w[j] = q[64 * j];
    return r; }
__device__ __forceinline__ RowF row_cvt(const RowRaw& t) { RowF r;
#pragma unroll
    for (int j = 0; j < 4; ++j) r.v[j] = (f32x4){__uint_as_float(t.w[j].x << 16), __uint_as_float(t.w[j].x & 0xffff0000u), __uint_as_float(t.w[j].y << 16), __uint_as_float(t.w[j].y & 0xffff0000u)};
    return r; }
__device__ __forceinline__ void row_st_f32(float* p, int lane, const RowF& r) { f32x4* q = (f32x4*)p + lane;
#pragma unroll
    for (int j = 0; j < 4; ++j) q[64 * j] = r.v[j]; }
__device__ __forceinline__ void row_st_bf16(bf16_t* p, int lane, const RowF& r) { u32x2* q = (u32x2*)p + lane;
#pragma unroll
    for (int j = 0; j < 4; ++j) { u32x2 w; w.x = pk2(r.v[j][0], r.v[j][1]); w.y = pk2(r.v[j][2], r.v[j][3]); q[64 * j] = w; } }
__device__ __forceinline__ float row_sum(const RowF& r) { float s = 0.f;
#pragma unroll
    for (int j = 0; j < 4; ++j) s += (r.v[j][0] + r.v[j][1]) + (r.v[j][2] + r.v[j][3]);
    return wave_sum(s); }
__device__ __forceinline__ void row_layernorm(RowF& r, const float* g, const float* b, int lane) {
    const float mu = row_sum(r) * (1.f / D); float q = 0.f;
#pragma unroll
    for (int j = 0; j < 4; ++j) { r.v[j] = r.v[j] - mu; q += (r.v[j][0] * r.v[j][0] + r.v[j][1] * r.v[j][1]) + (r.v[j][2] * r.v[j][2] + r.v[j][3] * r.v[j][3]); }
    const float rstd = rsqrtf(wave_sum(q) * (1.f / D) + 1e-5f);
    const RowF gg = row_ld_f32(g, lane), bb = row_ld_f32(b, lane);
#pragma unroll
    for (int j = 0; j < 4; ++j) r.v[j] = r.v[j] * rstd * gg.v[j] + bb.v[j];
}
__device__ __forceinline__ RowF row_modulate(const RowF& x, const float* sh, const float* sc, int lane) {
    const RowF s = row_ld_f32(sh, lane), c = row_ld_f32(sc, lane); RowF h;
#pragma unroll
    for (int j = 0; j < 4; ++j) h.v[j] = x.v[j] * (1.f + c.v[j]) + s.v[j];
    return h; }

template <class Dest> struct EpiStore {
    static constexpr bool PERM = true, AFTER_DRAIN = false, MIDK = false; Dest d;
    __device__ __forceinline__ void operator()(const f32x4 (&acc)[2][2][4][2], const pg8::Unit& u, int wr, int wc, int fr, int fq) const {
#pragma unroll
        for (int ai = 0; ai < 2; ++ai)
#pragma unroll
            for (int m = 0; m < 4; ++m) {
                const int row = u.pm * 256 + ai * 128 + wr * 64 + m * 16 + fr;
                bf16_t* rp = d.rowptr(row, u.pn); if (!rp) continue;
#pragma unroll
                for (int bj = 0; bj < 2; ++bj) { const f32x4 v0 = acc[ai][bj][m][0], v1 = acc[ai][bj][m][1];
                    u32x4 w; w.x = pk2(v0[0], v0[1]); w.y = pk2(v0[2], v0[3]); w.z = pk2(v1[0], v1[1]); w.w = pk2(v1[2], v1[3]);
                    *(u32x4*)(rp + bj * 128 + wc * 32 + 8 * fq) = w; }
            }
    }
};
struct DestWin { bf16_t* base;
    __device__ __forceinline__ bf16_t* rowptr(int row, int pn) const {
        if (pn < 16) { const int seg = pn >> 2; return base + (size_t)seg * (33 * MiB / 2) + (size_t)row * 1024 + (pn & 3) * 256; }
        return base + (size_t)4 * (33 * MiB / 2) + (size_t)row * 1536 + (pn - 16) * 256; } };
struct EpiWin {
    static constexpr bool PERM = true, AFTER_DRAIN = false, MIDK = false; EpiStore<DestWin> st; float* gates; const float* igb; const float* fgb; const float* dtb;
    __device__ __forceinline__ void operator()(const f32x4 (&acc)[2][2][4][2], const pg8::Unit& u, int wr, int wc, int fr, int fq) const {
        if (u.pn < 22) { st(acc, u, wr, wc, fr, fq); return; }
        const int c0 = wc * 32 + 8 * fq;
        if (c0 >= NGATE) return;
        float bias[8];
#pragma unroll
        for (int i = 0; i < 8; ++i) { const int c = c0 + i; bias[i] = c < 8 ? igb[c] : (c < 16 ? fgb[c - 8] : dtb[c - 16]); }
#pragma unroll
        for (int ai = 0; ai < 2; ++ai)
#pragma unroll
            for (int m = 0; m < 4; ++m) { const int row = u.pm * 256 + ai * 128 + wr * 64 + m * 16 + fr;
                float v[8];
#pragma unroll
                for (int i = 0; i < 8; ++i) { const float x = acc[ai][0][m][i >> 2][i & 3] + bias[i]; const int c = c0 + i; v[i] = c < 8 ? x : (c < 16 ? logsigf(x) : softplusf(x)); }
                float* gp = gates + (size_t)row * NGATE + c0;
                *(f32x4*)gp = (f32x4){v[0], v[1], v[2], v[3]}; *(f32x4*)(gp + 4) = (f32x4){v[4], v[5], v[6], v[7]}; }
    }
};
struct DestPlain { bf16_t* base; int ld; int pnmask;
    __device__ __forceinline__ bf16_t* rowptr(int row, int pn) const { return base + (size_t)row * ld + (pn & pnmask) * 256; } };
struct DestQKV { bf16_t* q; bf16_t* kb; bf16_t* vb;
    __device__ __forceinline__ bf16_t* rowptr(int row, int pn) const {
        if (pn < 4) return row < NLAT ? q + (size_t)row * 1024 + pn * 256 : nullptr;
        int key; if (row < NLAT) { const int b = row / SEQ, t = row % SEQ; key = b * SLEN + CTXL + t; } else { const int r = row - NLAT; key = (r / CTXL) * SLEN + (r % CTXL); }
        return (pn == 4 ? kb : vb) + (size_t)key * 256; } };
struct EpiWout {
    static constexpr bool PERM = true, AFTER_DRAIN = false, MIDK = true; EpiStore<DestPlain> st; const float* ssq;
    __device__ __forceinline__ void operator()(const f32x4 (&acc)[2][2][4][2], const pg8::Unit& u, int wr, int wc, int fr, int fq) const { st(acc, u, wr, wc, fr, fq); }
    __device__ __forceinline__ void midk(f32x4 (&acc)[2][2][4][2], const pg8::Unit& u, int wr, int wc, int fr, int fq) const {
        const float* p0 = ssq + (size_t)(u.pm * 256 + wr * 64 + fr) * 8; asm volatile("" : "+v"(p0));
#pragma unroll
        for (int ai = 0; ai < 2; ++ai)
#pragma unroll
            for (int m = 0; m < 4; ++m) { const float* p = p0 + (ai * 128 + m * 16) * 8;
                const f32x4 s0 = *(const f32x4*)p, s1 = *(const f32x4*)(p + 4);
                const float r = rsqrtf((((s0[0] + s0[1]) + (s0[2] + s0[3])) + ((s1[0] + s1[1]) + (s1[2] + s1[3]))) * (1.f / 1024.f) + 1e-6f);
#pragma unroll
                for (int bj = 0; bj < 2; ++bj)
#pragma unroll
                    for (int n = 0; n < 2; ++n) acc[ai][bj][m][n] = acc[ai][bj][m][n] * r;
                __builtin_amdgcn_sched_barrier(0); }
    }
};
template <bool WT = false> struct EpiSwigluT {
    static constexpr bool PERM = true, AFTER_DRAIN = false, MIDK = false; bf16_t* out;
    __device__ __forceinline__ void operator()(const f32x4 (&acc)[2][2][4][2], const pg8::Unit& u, int wr, int wc, int fr, int fq) const {
        const int pnl = u.pn & 7;
#pragma unroll
        for (int ai = 0; ai < 2; ++ai)
#pragma unroll
            for (int m = 0; m < 4; ++m) {
                const int row = u.pm * 256 + ai * 128 + wr * 64 + m * 16 + fr;
                bf16_t* rp = out + (size_t)row * 1024 + pnl * 128 + wc * 16 + 4 * fq;
#pragma unroll
                for (int bj = 0; bj < 2; ++bj) { const f32x4 g = acc[ai][bj][m][0], up = acc[ai][bj][m][1];
                    u32x2 w; w.x = pk2(siluf(g[0]) * up[0], siluf(g[1]) * up[1]); w.y = pk2(siluf(g[2]) * up[2], siluf(g[3]) * up[3]);
                    if constexpr (WT) __hip_atomic_store((__attribute__((address_space(1))) unsigned long long*)(rp + bj * 64), (unsigned long long)w.x | ((unsigned long long)w.y << 32), __ATOMIC_RELAXED, __HIP_MEMORY_SCOPE_AGENT);
                    else *(u32x2*)(rp + bj * 64) = w; }
            }
    }
};
using EpiSwiglu = EpiSwigluT<false>;
struct MoeOrder {
    int ntm, npn, nwg, G, c; const LAS int* toff; const int* tab;
    __device__ __forceinline__ void init(const LAS int* toff_, int npn_, int G_, int c_) { toff = toff_; ntm = toff_[16]; npn = npn_; nwg = ntm * npn_; G = G_; c = c_; }
    __device__ __forceinline__ bool next(int i, pg8::Unit& u) const {
        const long L = (long)i * G + c; if (L >= nwg) return false;
        int wgid = (int)L; { const int q = nwg / 8, r = nwg % 8, xcd = wgid % 8, off = wgid / 8; wgid = (xcd < r ? xcd * (q + 1) : r * (q + 1) + (xcd - r) * q) + off; }
        const int pm = wgid / npn, pnl = wgid % npn; int e = 0;
#pragma unroll
        for (int k = 1; k < 16; ++k) e += (toff[k] <= pm) ? 1 : 0;
        u.pm = pm; u.pn = e * npn + pnl; return true;
    }
    __device__ __forceinline__ int arow(const pg8::Unit& u, int r) const { const int e = u.pn / npn, pos = (u.pm - toff[e]) * 256 + r; return pos < toff[100 + e] ? tab[(size_t)e * NTOK + pos] : 0; }
    static constexpr bool LATE = false;
    __device__ __forceinline__ void a_ready(const pg8::Unit&) const {}
    __device__ __forceinline__ void done(const pg8::Unit&) const {}
    __device__ __forceinline__ void late(const pg8::Unit&) const {}
};

struct MoeMerged {
    static constexpr bool LATE = true;
    int m0, nm, nloc, rank, n1c, crot; const LAS int* toff; const int* tab; unsigned* dep;
    __device__ __forceinline__ void init(const LAS int* toff_, const int* tab_, unsigned* dep_) {
        toff = toff_; tab = tab_; dep = dep_; m0 = toff_[120]; nm = toff_[121]; nloc = toff_[122]; rank = toff_[123];
        const int n1 = nm * 8; n1c = rank < n1 ? (n1 - rank + nloc - 1) / nloc : 0; const int rot = n1 % nloc; crot = (rank - rot + nloc) % nloc; }
    __device__ __forceinline__ bool next(int i, pg8::Unit& u) const {
        int pm, pnl, npn, base;
        if (i < n1c) { const int t1 = i * nloc + rank; pm = m0 + (t1 >> 3); pnl = t1 & 7; npn = 8; base = 0; }
        else { const int t2 = (i - n1c) * nloc + crot; if (t2 >= nm * 4) return false; pm = m0 + (t2 >> 2); pnl = t2 & 3; npn = 4; base = 128; }
        int e = 0;
#pragma unroll
        for (int k = 1; k < 16; ++k) e += (toff[k] <= pm) ? 1 : 0;
        u.pm = pm; u.pn = base + e * npn + pnl; return true;
    }
    __device__ __forceinline__ int arow(const pg8::Unit& u, int r) const {
        if (u.pn >= 128) return (int)((WS_HMID - WS_HB) / 2048) + u.pm * 256 + r;
        const int e = u.pn >> 3, pos = (u.pm - toff[e]) * 256 + r; return pos < toff[100 + e] ? tab[(size_t)e * NTOK + pos] : 0; }
    __device__ __forceinline__ void a_ready(const pg8::Unit& u) const {
        if (u.pn >= 128) { unsigned* w = dep + u.pm; unsigned sp = 0;
            while ((unsigned)__builtin_amdgcn_readfirstlane(__hip_atomic_load(w, __ATOMIC_RELAXED, __HIP_MEMORY_SCOPE_AGENT)) < 64u) { __builtin_amdgcn_s_sleep(1); if (++sp > (1u << 22)) break; }
            asm volatile("" ::: "memory"); }
    }
    __device__ __forceinline__ void done(const pg8::Unit&) const {}
    __device__ __forceinline__ void late(const pg8::Unit& u) const {
        if (u.pn < 128) { asm volatile("s_waitcnt vmcnt(0)" ::: "memory"); if (fresh_lane() == 0) (void)__hip_atomic_fetch_add(dep + u.pm, 1u, __ATOMIC_RELAXED, __HIP_MEMORY_SCOPE_AGENT); }
    }
};
struct EpiMoe {
    static constexpr bool PERM = true, AFTER_DRAIN = false, MIDK = false; EpiSwigluT<false> sw; EpiStore<DestPlain> st;
    __device__ __forceinline__ void operator()(const f32x4 (&acc)[2][2][4][2], const pg8::Unit& u, int wr, int wc, int fr, int fq) const {
        if (u.pn < 128) sw(acc, u, wr, wc, fr, fq); else st(acc, u, wr, wc, fr, fq); }
};

#define XB_TMO      128
#define XB_XCNT(j)  (256  + 64 * (j))
#define XB_XSUB(j)  (1280 + 64 * (j))
#define XB_XGEN(j)  (2304 + 64 * (j))
#define XB_TOP      3328
#define XB_TOPGEN   3392
#define XCD_BAR_WORDS 3456
#define XB_SPIN_CAP (1u << 18)

__device__ __forceinline__ unsigned xb_ld(unsigned* p)              { return __hip_atomic_load(p, __ATOMIC_RELAXED, __HIP_MEMORY_SCOPE_AGENT); }
__device__ __forceinline__ unsigned xb_add(unsigned* p, unsigned v) { return __hip_atomic_fetch_add(p, v, __ATOMIC_RELAXED, __HIP_MEMORY_SCOPE_AGENT); }
__device__ __forceinline__ unsigned xb_xcc_id() { return (unsigned)__builtin_amdgcn_s_getreg((3 << 11) | 20) & 0xFu; }
#define XB_SPIN(cond, bar) do { unsigned _sp = 0; while (cond) { __builtin_amdgcn_s_sleep(1); \
    if ((++_sp & 255u) == 0u) { if (xb_ld(&(bar)[XB_TMO])) break; if (_sp > XB_SPIN_CAP) { atomicAdd(&(bar)[XB_TMO], 1u); break; } } } } while (0)

struct XcdBarrier {
    unsigned* bar; unsigned x;
    volatile LAS unsigned* st;
};

__device__ __forceinline__ XcdBarrier xcd_barrier_post(unsigned* bar, volatile LAS unsigned* st, int tid) {
    XcdBarrier b; b.bar = bar; b.x = xb_xcc_id(); b.st = st;
    if (tid == 0) { st[2] = xb_add(&bar[XB_XCNT(b.x)], 1u); st[3] = b.x; }
    return b;
}
__device__ __forceinline__ void xcd_barrier_complete(unsigned* bar, unsigned x, unsigned& nloc, unsigned& nx) {
    const unsigned G = gridDim.x * gridDim.y * gridDim.z;
    unsigned sum, cnt, mine, sp = 0u;
    for (;;) {
        sum = 0u; cnt = 0u; mine = 0u;
#pragma unroll
        for (unsigned j = 0; j < 16; ++j) { const unsigned c = xb_ld(&bar[XB_XCNT(j)]); sum += c; cnt += (c > 0u) ? 1u : 0u; mine = (j == x) ? c : mine; }
        if (sum == G) break;
        __builtin_amdgcn_s_sleep(1);
        if ((++sp & 255u) == 0u) { if (xb_ld(&bar[XB_TMO])) break; if (sp > XB_SPIN_CAP) { atomicAdd(&bar[XB_TMO], 1u); break; } }
    }
    nloc = mine > 0u ? mine : 1u; nx = cnt > 0u ? cnt : 1u;
}

__device__ __forceinline__ void xcd_barrier(const XcdBarrier& b, int tid) {
    asm volatile("s_waitcnt vmcnt(0)" ::: "memory");
    __syncthreads();
    if (tid == 0) {
        unsigned* bar = b.bar;
        __builtin_amdgcn_s_waitcnt(0);
        unsigned nloc = b.st[0], nx = b.st[1];
        if (nloc == 0u) { xcd_barrier_complete(bar, b.x, nloc, nx); b.st[0] = nloc; b.st[1] = nx; }
        const unsigned old = xb_add(&bar[XB_XSUB(b.x)], 1u);
        const unsigned gen = old / nloc;
        if (old + 1u == (gen + 1u) * nloc) {
            __builtin_amdgcn_fence(__ATOMIC_RELEASE, "agent");
            asm volatile("s_waitcnt vmcnt(0)" ::: "memory");
            const unsigned og = xb_add(&bar[XB_TOP], 1u);
            const unsigned tg = og / nx;
            if (og + 1u == (tg + 1u) * nx) xb_add(&bar[XB_TOPGEN], 1u);
            else XB_SPIN(xb_ld(&bar[XB_TOPGEN]) == tg, bar);
            __builtin_amdgcn_fence(__ATOMIC_ACQUIRE, "agent");
            xb_add(&bar[XB_XGEN(b.x)], 1u);
            asm volatile("s_waitcnt vmcnt(0)" ::: "memory");
        } else {
            XB_SPIN(xb_ld(&bar[XB_XGEN(b.x)]) == gen, bar);
            __builtin_amdgcn_fence(__ATOMIC_ACQUIRE, "agent");
            asm volatile("s_waitcnt vmcnt(0)" ::: "memory");
        }
    }
    __syncthreads();
}

struct Args {
    const float* in[28]; float* out; unsigned char* ws; int ph_lo, ph_hi, li, pad;
};
struct Ctx {
    LAS unsigned char* lds; unsigned char* ws;
    int tid, lane, wave, G, bid;
};
#define CTLP(F) ((unsigned*)((F).ws + WS_CTL))
#define MISCP(F) ((LAS int*)((F).lds + MISC_OFF))
#define GWID(F) ((F).bid * NWAVES + (F).wave)
#define NGW(F) ((F).G * NWAVES)
enum { I_X = 0, I_C, I_CTX, I_CCTX, I_ADAW, I_ADAB, I_LNG, I_LNB, I_ABWIN, I_ABWOUT, I_IGB, I_FGB, I_MNG, I_CONVW, I_CONVB, I_DTB, I_ALOG, I_SSMD, I_SNG,
       I_ATWIN, I_ATWOUT, I_QG, I_KG, I_RW, I_RB, I_WG, I_WU, I_WD };
constexpr int RING_BYTES = 131072, MISC_OFF = RING_BYTES, LDS_BYTES = RING_BYTES + 12288;

template <class Src> __device__ __forceinline__ void transpose_item(const Src& S, bf16_t* WT, int K, int orow0, int k0, LAS float* scr, int lane, float scale) {
#pragma unroll 8
    for (int i = 0; i < 32; ++i) { const int kk = 2 * i + (lane >> 5); scr[kk * 33 + (lane & 31)] = S.ld(k0 + kk, lane & 31); }
    asm volatile("s_waitcnt lgkmcnt(0)" ::: "memory");
    const int c = lane & 7;
#pragma unroll
    for (int j = 0; j < 4; ++j) { const int n = (lane >> 3) + 8 * j; const LAS float* s = scr + (8 * c) * 33 + S.scol(n);
        u32x4 o; o.x = pk2(s[0 * 33] * scale, s[1 * 33] * scale); o.y = pk2(s[2 * 33] * scale, s[3 * 33] * scale); o.z = pk2(s[4 * 33] * scale, s[5 * 33] * scale); o.w = pk2(s[6 * 33] * scale, s[7 * 33] * scale);
        *(u32x4*)(WT + (size_t)(orow0 + n) * K + k0 + 8 * c) = o; }
    asm volatile("s_waitcnt lgkmcnt(0)" ::: "memory");
}
struct SrcPlain { const float* W; int N; int n0;
    __device__ __forceinline__ float ld(int k, int j) const { return __builtin_nontemporal_load(W + (size_t)k * N + n0 + j); }
    __device__ __forceinline__ int scol(int n) const { return n; } };
struct SrcGate { const float* W; int j0;
    __device__ __forceinline__ float ld(int k, int j) const { const int jj = j0 + j; return jj < 16 ? W[(size_t)k * ABIN + 3072 + jj] : (jj < NGATE ? W[(size_t)k * ABIN + 5648 + (jj - 16)] : 0.f); }
    __device__ __forceinline__ int scol(int n) const { return n; } };
struct SrcWout { const float* W; const float* g; int n0;
    __device__ __forceinline__ float ld(int k, int j) const { return k < 1024 ? W[(size_t)(k + 1024) * 1024 + n0 + j] * g[k] : W[(size_t)(k - 1024) * 1024 + n0 + j]; }
    __device__ __forceinline__ int scol(int n) const { return n; } };
struct SrcGU { const float* Wg; const float* Wu; int c0;
    __device__ __forceinline__ float ld(int k, int j) const { return __builtin_nontemporal_load((j < 16 ? Wg : Wu) + (size_t)k * 1024 + c0 + (j & 15)); }
    __device__ __forceinline__ int scol(int n) const { const int b4 = n >> 3, w = n & 7; return (w < 4 ? 0 : 16) + 4 * b4 + (w & 3); } };

__device__ __forceinline__ void convert_small_weights(Ctx& F, const Args& a) {
    {   float* rope = (float*)(F.ws + WS_ROPE);
        for (int i = F.bid * NTHREADS + F.tid; i < 128 * 32; i += F.G * NTHREADS) { const int pos = i >> 5, fi = i & 31; float sn, cs; sincosf((float)pos * expf(-(float)fi * (9.210340371976184f / 32.f)), &sn, &cs); rope[2 * i] = cs; rope[2 * i + 1] = sn; } }
    LAS float* scr = (LAS float*)(F.lds + F.wave * 16384);
    bf16_t* WinT = (bf16_t*)(F.ws + WS_WIN); bf16_t* WoutT = (bf16_t*)(F.ws + WS_WOUT); bf16_t* AtInT = (bf16_t*)(F.ws + WS_ATIN); bf16_t* AtOutT = (bf16_t*)(F.ws + WS_ATOUT);
    constexpr int I0 = 16 * (NWIN / 32), I1 = 32 * 32, I2 = 16 * 48, I3 = 16 * 32, NI = I0 + I1 + I2 + I3;
    for (int it = GWID(F); it < NI; it += NGW(F)) {
        int r = it;
        if (r < I0) { const int kb = r / (NWIN / 32), nb = r % (NWIN / 32), n0 = 32 * nb;
            if (n0 < 5632) { SrcPlain S{a.in[I_ABWIN], ABIN, n0 < 3072 ? n0 : n0 + 16}; transpose_item(S, WinT, 1024, n0, 64 * kb, scr, F.lane, n0 < 512 ? 0.08838834764831845f : 1.f); }
            else { SrcGate S{a.in[I_ABWIN], n0 - 5632}; transpose_item(S, WinT, 1024, n0, 64 * kb, scr, F.lane, 1.f); }
            continue; } r -= I0;
        if (r < I1) { const int kb = r / 32, nb = r % 32; SrcWout S{a.in[I_ABWOUT], a.in[I_SNG], 32 * nb}; transpose_item(S, WoutT, 2048, 32 * nb, 64 * kb, scr, F.lane, 1.f); continue; } r -= I1;
        if (r < I2) { const int kb = r / 48, nb = r % 48; SrcPlain S{a.in[I_ATWIN], 1536, 32 * nb}; transpose_item(S, AtInT, 1024, 32 * nb, 64 * kb, scr, F.lane, 1.f); continue; } r -= I2;
        { const int kb = r / 32, nb = r % 32; SrcPlain S{a.in[I_ATWOUT], 1024, 32 * nb}; transpose_item(S, AtOutT, 1024, 32 * nb, 64 * kb, scr, F.lane, 1.f); }
    }
}
__device__ __forceinline__ void convert_moe_weights(Ctx& F, const Args& a, int layer, int skip_blocks, int it0 = 0, int it1 = 16 * 16 * 64 + 16 * 16 * 32) {
    if (F.bid < skip_blocks) return;
    LAS float* scr = (LAS float*)(F.lds + F.wave * 16384);
    bf16_t* WGU = (bf16_t*)(F.ws + WS_MOEW); bf16_t* WD = (bf16_t*)(F.ws + WS_MOEW + 64 * MiB);
    const size_t wl = (size_t)layer * 16 * 1024 * 1024;
    constexpr int IGU = 16 * 16 * 64, IDN = 16 * 16 * 32;
    for (int it = it0 + (F.bid - skip_blocks) * NWAVES + F.wave; it < it1; it += (F.G - skip_blocks) * NWAVES) {
        if (it < IGU) { const int e = it / 1024, r = it % 1024, kb = r / 64, nb = r % 64;
            SrcGU S{a.in[I_WG] + wl + (size_t)e * 1048576, a.in[I_WU] + wl + (size_t)e * 1048576, 16 * nb};
            transpose_item(S, WGU + (size_t)e * 2048 * 1024, 1024, 32 * nb, 64 * kb, scr, F.lane, 1.f); }
        else { const int r0 = it - IGU, e = r0 / 512, r = r0 % 512, kb = r / 32, nb = r % 32;
            SrcPlain S{a.in[I_WD] + wl + (size_t)e * 1048576, 1024, 32 * nb};
            transpose_item(S, WD + (size_t)e * 1024 * 1024, 1024, 32 * nb, 64 * kb, scr, F.lane, 1.f); }
    }
}
__device__ __forceinline__ void ada_phase(Ctx& F, const Args& a) {
    LAS float* red = (LAS float*)(F.lds + 8 * 16384);
    float* modv = (float*)(F.ws + WS_MODV);
    for (int item = F.bid; item < 2 * 96; item += F.G) {
        const int l = item / 96, n = (item % 96) * 64 + F.lane;
        float a0 = 0.f, a1 = 0.f, a2 = 0.f;
        const float* w = a.in[I_ADAW] + ((size_t)l * 1024 + F.wave * 128) * 6144 + n;
#pragma unroll 16
        for (int k = 0; k < 128; ++k) { const float wv = w[(size_t)k * 6144]; const int kk = F.wave * 128 + k;
            a0 += siluf(a.in[I_C][kk]) * wv; a1 += siluf(a.in[I_C][1024 + kk]) * wv; a2 += siluf(a.in[I_CCTX][kk]) * wv; }
        LAS float* rr = (LAS float*)F.lds;
        rr[(F.wave * 3 + 0) * 64 + F.lane] = a0; rr[(F.wave * 3 + 1) * 64 + F.lane] = a1; rr[(F.wave * 3 + 2) * 64 + F.lane] = a2;
        __syncthreads();
        if (F.wave < 3) { float s = 0.f;
#pragma unroll
            for (int w8 = 0; w8 < 8; ++w8) s += rr[(w8 * 3 + F.wave) * 64 + F.lane];
            modv[(l * 3 + F.wave) * 6144 + n] = s + a.in[I_ADAB][l * 6144 + n]; }
        __syncthreads();
    }
    (void)red;
}

template <int NC> __device__ __forceinline__ void row_dots(const RowF& h, const float* W, int lane, float (&acc)[NC]) {
#pragma unroll
    for (int i = 0; i < NC; ++i) acc[i] = 0.f;
#pragma unroll
    for (int j = 0; j < 4; ++j)
#pragma unroll
        for (int e = 0; e < 4; ++e) { const float x = h.v[j][e]; const f32x4* w = (const f32x4*)(W + (size_t)(4 * lane + 256 * j + e) * NC);
#pragma unroll
            for (int q = 0; q < NC / 4; ++q) { const f32x4 wv = w[q]; acc[4 * q + 0] += x * wv[0]; acc[4 * q + 1] += x * wv[1]; acc[4 * q + 2] += x * wv[2]; acc[4 * q + 3] += x * wv[3]; } }
}
template <int O, int N> __device__ __forceinline__ void xreduce_step(float (&acc)[N], int lane) {
    const bool up = (lane & O) != 0;
#pragma unroll
    for (int i = 0; i < O; ++i) { const float keep = up ? acc[i + O] : acc[i], send = up ? acc[i] : acc[i + O]; acc[i] = keep + __shfl_xor(send, O); }
}
template <int N> __device__ __forceinline__ float xreduce(float (&acc)[N], int lane) {
    if constexpr (N == 16) {
#pragma unroll
        for (int i = 0; i < 16; ++i) { acc[i] += __shfl_xor(acc[i], 32); acc[i] += __shfl_xor(acc[i], 16); }
    }
    if constexpr (N == 64) { xreduce_step<32, N>(acc, lane); xreduce_step<16, N>(acc, lane); }
    xreduce_step<8, N>(acc, lane); xreduce_step<4, N>(acc, lane); xreduce_step<2, N>(acc, lane); xreduce_step<1, N>(acc, lane);
    return acc[0];
}

__device__ __forceinline__ const float* x_row(const Args& a, int row) { return row < NLAT ? a.in[I_X] + (size_t)row * D : a.in[I_CTX] + (size_t)(row - NLAT) * D; }
__device__ __forceinline__ void rowpass_a(Ctx& F, const Args& a) {
    const float* modv = (const float*)(F.ws + WS_MODV);
    bf16_t* HB = (bf16_t*)(F.ws + WS_HB);
    int row = GWID(F); if (row >= NTOK) return;
    RowF xn = row_ld_f32(x_row(a, row), F.lane);
    for (; row < NTOK; row += NGW(F)) {
        const RowF x = xn; const int nrow = row + NGW(F);
        if (nrow < NTOK) xn = row_ld_f32(x_row(a, nrow), F.lane);
        const float* m = modv + mod_index(row) * 6144;
        const RowF h = row_modulate(x, m, m + 1024, F.lane);
        row_st_bf16(HB + (size_t)row * D, F.lane, h);
    }
}
__device__ __forceinline__ void stage_router(Ctx& F, const float* rw) {
    LAS f32x4* Wl = (LAS f32x4*)F.lds;
    for (int i = F.tid; i < 4096; i += NTHREADS) { const int d = i >> 2, q = i & 3; const f32x4 w = *(const f32x4*)(rw + d * 16 + q * 4);
        Wl[q * 1024 + ((d >> 8) * 4 + (d & 3)) * 64 + ((d >> 2) & 63)] = w; }
    __syncthreads();
}
__device__ __forceinline__ void row_dots16_lds(const RowF& h, const LAS f32x4* Wl, int lane, float (&acc)[16]) {
#pragma unroll
    for (int i = 0; i < 16; ++i) acc[i] = 0.f;
#pragma unroll
    for (int j = 0; j < 4; ++j)
#pragma unroll
        for (int e = 0; e < 4; ++e) { const float x = h.v[j][e];
#pragma unroll
            for (int q = 0; q < 4; ++q) { const f32x4 wv = Wl[q * 1024 + (j * 4 + e) * 64 + lane]; acc[4 * q + 0] += x * wv[0]; acc[4 * q + 1] += x * wv[1]; acc[4 * q + 2] += x * wv[2]; acc[4 * q + 3] += x * wv[3]; }
            if (e & 1) __builtin_amdgcn_sched_barrier(0); }
}
__device__ __forceinline__ void route_row(const RowF& h2, const LAS f32x4* Wl, const float* rb, int lane, int& e0, int& e1, float& g0, float& g1) {
    float acc[16]; row_dots16_lds(h2, Wl, lane, acc);
    const float logit = xreduce<16>(acc, lane);
    float mx = logit;
#pragma unroll
    for (int o = 8; o >= 1; o >>= 1) mx = fmaxf(mx, __shfl_xor(mx, o));
    const float ex = expf(logit - mx); float sm = ex;
#pragma unroll
    for (int o = 8; o >= 1; o >>= 1) sm += __shfl_xor(sm, o);
    const float p = ex / sm, sel = p + rb[lane & 15];
    float s4[4], p4[4];
#pragma unroll
    for (int i = 0; i < 4; ++i) s4[i] = __shfl(sel, (lane & 12) + i);
    float v1 = s4[0]; int i1 = 0;
#pragma unroll
    for (int i = 1; i < 4; ++i) if (s4[i] > v1) { v1 = s4[i]; i1 = i; }
    float v2 = -1e30f;
#pragma unroll
    for (int i = 0; i < 4; ++i) if (i != i1 && s4[i] > v2) v2 = s4[i];
    const float gs = v1 + v2;
    float best = __shfl(gs, 0); int bg = 0;
#pragma unroll
    for (int g = 1; g < 4; ++g) { const float t = __shfl(gs, 4 * g); if (t > best) { best = t; bg = g; } }
#pragma unroll
    for (int i = 0; i < 4; ++i) { s4[i] = __shfl(sel, 4 * bg + i); p4[i] = __shfl(p, 4 * bg + i); }
    v1 = s4[0]; i1 = 0; float q1 = p4[0];
#pragma unroll
    for (int i = 1; i < 4; ++i) if (s4[i] > v1) { v1 = s4[i]; i1 = i; q1 = p4[i]; }
    v2 = -1e30f; int i2 = 0; float q2 = 0.f;
#pragma unroll
    for (int i = 0; i < 4; ++i) if (i != i1 && s4[i] > v2) { v2 = s4[i]; i2 = i; q2 = p4[i]; }
    e0 = 4 * bg + i1; e1 = 4 * bg + i2; const float s = q1 + q2; g0 = q1 / s; g1 = q2 / s;
}
__device__ __forceinline__ void rowpass_b(Ctx& F, const Args& a, int layer, int nrows, const bf16_t* YB) {
    const float* modl = (const float*)(F.ws + WS_MODV) + layer * 3 * 6144;
    bf16_t* XL = (bf16_t*)(F.ws + WS_XL); bf16_t* HB = (bf16_t*)(F.ws + WS_HB);
    int* tok_e = (int*)(F.ws + WS_ROUTE); int* tok_pos = tok_e + 2 * NTOK; float* tok_g = (float*)(tok_pos + 2 * NTOK);
    unsigned* cnt = CTLP(F) + (layer ? CW_CNT1 : CW_CNT0);
    stage_router(F, a.in[I_RW]);
    LAS int* lcnt = (LAS int*)(F.lds + 65536); LAS int* gbase = lcnt + 16; LAS int* nrow = lcnt + 32; LAS int* lrow = lcnt + 64;
    if (F.tid < 33) lcnt[F.tid] = 0;
    __syncthreads();
    RowF xf_n; RowRaw xr_n, y_n;
    { const int r0 = GWID(F); if (r0 < nrows) { if (layer) xr_n = row_ldraw_bf16(XL + (size_t)r0 * D, F.lane); else xf_n = row_ld_f32(x_row(a, r0), F.lane); y_n = row_ldraw_bf16(YB + (size_t)r0 * D, F.lane); } }
    for (int row = GWID(F); row < nrows; row += NGW(F)) {
        const float* m = modl + mod_index(row) * 6144;
        RowF x = layer ? row_cvt(xr_n) : xf_n; const RowF y = row_cvt(y_n); const int nxr = row + NGW(F);
        if (nxr < nrows) { if (layer) xr_n = row_ldraw_bf16(XL + (size_t)nxr * D, F.lane); else xf_n = row_ld_f32(x_row(a, nxr), F.lane); y_n = row_ldraw_bf16(YB + (size_t)nxr * D, F.lane); }
        const RowF gt = row_ld_f32(m + 2048, F.lane);
#pragma unroll
        for (int j = 0; j < 4; ++j) x.v[j] = ALPHA * x.v[j] + gt.v[j] * y.v[j];
        row_layernorm(x, a.in[I_LNG] + (layer * 2) * D, a.in[I_LNB] + (layer * 2) * D, F.lane);
        row_st_bf16(XL + (size_t)row * D, F.lane, x);
        const RowF h2 = row_modulate(x, m + 3072, m + 4096, F.lane);
        row_st_bf16(HB + (size_t)row * D, F.lane, h2);
        int e0, e1; float g0, g1; route_row(h2, (const LAS f32x4*)F.lds, a.in[I_RB], F.lane, e0, e1, g0, g1);
        if (F.lane == 0) {
            const int p0 = __hip_atomic_fetch_add(lcnt + e0, 1, __ATOMIC_RELAXED, __HIP_MEMORY_SCOPE_WORKGROUP), p1 = __hip_atomic_fetch_add(lcnt + e1, 1, __ATOMIC_RELAXED, __HIP_MEMORY_SCOPE_WORKGROUP);
            const int ix = __hip_atomic_fetch_add(nrow, 1, __ATOMIC_RELAXED, __HIP_MEMORY_SCOPE_WORKGROUP);
            lrow[ix * 4 + 0] = row; lrow[ix * 4 + 1] = e0 | (e1 << 8); lrow[ix * 4 + 2] = p0; lrow[ix * 4 + 3] = p1;
            tok_e[row * 2] = e0; tok_e[row * 2 + 1] = e1; tok_g[row * 2] = g0; tok_g[row * 2 + 1] = g1;
        }
    }
    __syncthreads();
    if (F.tid < 16) gbase[F.tid] = (int)atomicAdd(cnt + F.tid, (unsigned)lcnt[F.tid]);
    __syncthreads();
    if (F.tid < nrow[0]) { const int row = lrow[F.tid * 4], ee = lrow[F.tid * 4 + 1];
        const int e0 = ee & 255, e1 = ee >> 8, p0 = gbase[e0] + lrow[F.tid * 4 + 2], p1 = gbase[e1] + lrow[F.tid * 4 + 3];
        tok_pos[row * 2] = p0; tok_pos[row * 2 + 1] = p1; int* tab = (int*)(F.ws + WS_TOKTAB); tab[(size_t)e0 * NTOK + p0] = row; tab[(size_t)e1 * NTOK + p1] = row; }
}
__device__ __forceinline__ void moe_offsets(Ctx& F, int layer) {
    __syncthreads();
    if (F.tid == 0) { const unsigned* cnt = CTLP(F) + (layer ? CW_CNT1 : CW_CNT0); int acc = 0;
        for (int e = 0; e < 16; ++e) { const int c = (int)__hip_atomic_load(cnt + e, __ATOMIC_RELAXED, __HIP_MEMORY_SCOPE_AGENT); MISCP(F)[e] = acc; MISCP(F)[100 + e] = c; acc += (c + 255) >> 8; }
        MISCP(F)[16] = acc; }
    __syncthreads();
}
__device__ __forceinline__ void moe_streams(Ctx& F, int layer, int li) {
    moe_offsets(F, layer);
    if (F.tid == 0) { const unsigned* bar = CTLP(F) + CW_BAR + li * 4096; const int x = MISCP(F)[35]; int tot = 0, before = 0, mine = 1;
        for (int j = 0; j < 16; ++j) { const int c = (int)__hip_atomic_load(bar + XB_XCNT(j), __ATOMIC_RELAXED, __HIP_MEMORY_SCOPE_AGENT); tot += c; before += (j < x) ? c : 0; mine = (j == x) ? c : mine; }
        const int ntm = MISCP(F)[16]; const int m0 = (int)((long)ntm * before / tot), m1 = (int)((long)ntm * (before + mine) / tot);
        MISCP(F)[120] = m0; MISCP(F)[121] = m1 - m0; MISCP(F)[122] = mine; MISCP(F)[123] = MISCP(F)[34]; }
    __syncthreads();
}
__device__ __forceinline__ void moe_scatter(Ctx& F, int layer, int nrows) {
    moe_offsets(F, layer);
    const bf16_t* HB = (const bf16_t*)(F.ws + WS_HB); bf16_t* XS = (bf16_t*)(F.ws + WS_XS);
    const int* tok_e = (const int*)(F.ws + WS_ROUTE); const int* tok_pos = tok_e + 2 * NTOK; int* tok_slot = (int*)(F.ws + WS_ROUTE + MiB);
    for (int row = GWID(F); row < nrows; row += NGW(F)) {
        const int e0 = tok_e[row * 2], e1 = tok_e[row * 2 + 1];
        const int s0 = MISCP(F)[e0] * 256 + tok_pos[row * 2], s1 = MISCP(F)[e1] * 256 + tok_pos[row * 2 + 1];
        const u32x4* src = (const u32x4*)(HB + (size_t)row * D) + F.lane; const u32x4 v0 = src[0], v1 = src[64];
        u32x4* d0 = (u32x4*)(XS + (size_t)s0 * D) + F.lane; u32x4* d1 = (u32x4*)(XS + (size_t)s1 * D) + F.lane;
        d0[0] = v0; d0[64] = v1; d1[0] = v0; d1[64] = v1;
        if (F.lane == 0) { tok_slot[row * 2] = s0; tok_slot[row * 2 + 1] = s1; }
    }
}
__device__ __forceinline__ void rowpass_c(Ctx& F, const Args& a, int layer, int nrows, bool last) {
    const float* modl = (const float*)(F.ws + WS_MODV) + layer * 3 * 6144;
    bf16_t* XL = (bf16_t*)(F.ws + WS_XL); bf16_t* HB = (bf16_t*)(F.ws + WS_HB); const bf16_t* YS = (const bf16_t*)(F.ws + WS_YS);
    const int* tok_e = (const int*)(F.ws + WS_ROUTE); const int* tok_pos = tok_e + 2 * NTOK; const float* tok_g = (const float*)(F.ws + WS_ROUTE) + 4 * NTOK;
    moe_offsets(F, layer);
    const int step = NGW(F); int row = GWID(F);
    int s0n = 0, s1n = 0, s0nn = 0, s1nn = 0; float g0n = 0.f, g1n = 0.f, g0nn = 0.f, g1nn = 0.f; RowRaw xr_n, y0_n, y1_n;
#define RC_SLOTS(r_, s0_, s1_, g0_, g1_) do { s0_ = MISCP(F)[tok_e[(r_) * 2]] * 256 + tok_pos[(r_) * 2]; s1_ = MISCP(F)[tok_e[(r_) * 2 + 1]] * 256 + tok_pos[(r_) * 2 + 1]; g0_ = tok_g[(r_) * 2]; g1_ = tok_g[(r_) * 2 + 1]; } while (0)
    if (row < nrows) { RC_SLOTS(row, s0n, s1n, g0n, g1n); xr_n = row_ldraw_bf16(XL + (size_t)row * D, F.lane); y0_n = row_ldraw_bf16(YS + (size_t)s0n * D, F.lane); y1_n = row_ldraw_bf16(YS + (size_t)s1n * D, F.lane);
        if (row + step < nrows) RC_SLOTS(row + step, s0nn, s1nn, g0nn, g1nn); }
    for (; row < nrows; row += step) {
        const float* m = modl + mod_index(row) * 6144;
        RowF x = row_cvt(xr_n); const RowF y0 = row_cvt(y0_n), y1 = row_cvt(y1_n); const float g0 = g0n, g1 = g1n;
        if (row + step < nrows) { const int nr = row + step; s0n = s0nn; s1n = s1nn; g0n = g0nn; g1n = g1nn;
            xr_n = row_ldraw_bf16(XL + (size_t)nr * D, F.lane); y0_n = row_ldraw_bf16(YS + (size_t)s0n * D, F.lane); y1_n = row_ldraw_bf16(YS + (size_t)s1n * D, F.lane);
            if (nr + step < nrows) RC_SLOTS(nr + step, s0nn, s1nn, g0nn, g1nn); }
        const RowF gt = row_ld_f32(m + 5120, F.lane);
#pragma unroll
        for (int j = 0; j < 4; ++j) x.v[j] = ALPHA * x.v[j] + gt.v[j] * (g0 * y0.v[j] + g1 * y1.v[j]);
        row_layernorm(x, a.in[I_LNG] + (layer * 2 + 1) * D, a.in[I_LNB] + (layer * 2 + 1) * D, F.lane);
        if (last) { row_st_f32(a.out + (size_t)row * D, F.lane, x); }
        else { row_st_bf16(XL + (size_t)row * D, F.lane, x); const float* m1 = modl + 3 * 6144 + mod_index(row) * 6144;
            const RowF h = row_modulate(x, m1, m1 + 1024, F.lane); row_st_bf16(HB + (size_t)row * D, F.lane, h); }
    }
#undef RC_SLOTS
}

template <class Epi, class Sched> __device__ __forceinline__ void run_gemm_gather(Ctx& F, const bf16_t* A, const bf16_t* Bt, int K, const Sched& S, const Epi& E) {
    pg8::Gemm g{A, Bt, 0, 0, K};
    pg8::gemm_phase<Epi, Sched, true, true, true>(F.lds, g, S, E, F.wave * 64 + fresh_lane());
    __syncthreads();
}
template <class Epi, class Sched> __device__ __forceinline__ void run_gemm(Ctx& F, const bf16_t* A, const bf16_t* Bt, int M, int N, int K, const Sched& S, const Epi& E) {
    pg8::Gemm g{A, Bt, M, N, K};
    pg8::gemm_phase<Epi, Sched, true, true>(F.lds, g, S, E, F.wave * 64 + fresh_lane());
    __syncthreads();
}

__device__ __forceinline__ void qkprep_phase(Ctx& F, const Args& a) {
    bf16_t* Q = (bf16_t*)(F.ws + WS_Q); bf16_t* KB = (bf16_t*)(F.ws + WS_KB);
    constexpr int NQ = NLAT * 8, NK = NBATCH * SLEN * 2;
    const float qg0 = a.in[I_QG][F.lane], qg1 = a.in[I_QG][F.lane + 64], kg0 = a.in[I_KG][F.lane], kg1 = a.in[I_KG][F.lane + 64];
    const float* ropet = (const float*)(F.ws + WS_ROPE);
    for (int it = NQ + GWID(F); it < NQ + NK; it += NGW(F)) {
        bf16_t* p; int t; bool rope; float g0, g1;
        if (it < NQ) { const int row = it >> 3, hh = it & 7; p = Q + (size_t)row * 1024 + hh * 128; t = row % SEQ; rope = true; g0 = qg0; g1 = qg1; }
        else { const int r = it - NQ, krow = r >> 1, kvh = r & 1, key = krow % SLEN; p = KB + (size_t)krow * 256 + kvh * 128; rope = key >= CTXL; t = key - CTXL; g0 = kg0; g1 = kg1; }
        float x1 = bf2f(p[F.lane]), x2 = bf2f(p[F.lane + 64]);
        const float r = rsqrtf(wave_sum(x1 * x1 + x2 * x2) * (1.f / 128.f) + 1e-6f);
        x1 *= r * g0; x2 *= r * g1;
        float o1 = x1, o2 = x2;
        if (rope) { const float* rp = ropet + ((F.lane < 32) ? (t / 64) : (t % 64)) * 64 + 2 * (F.lane & 31); const float cs = rp[0], sn = rp[1]; o1 = x1 * cs - x2 * sn; o2 = x2 * cs + x1 * sn; }
        p[F.lane] = f2bf(o1); p[F.lane + 64] = f2bf(o2);
    }
}
__device__ __forceinline__ void kprep_tile(Ctx& F, const Args& a, int pm) {
    bf16_t* KB = (bf16_t*)(F.ws + WS_KB); const float* ropet = (const float*)(F.ws + WS_ROPE);
    const int l16 = F.lane & 15, sub = F.lane >> 4; const bool rope = pm < NLAT / 256;
    const f32x4 g0 = *(const f32x4*)(a.in[I_KG] + 8 * l16), g1 = *(const f32x4*)(a.in[I_KG] + 8 * l16 + 4);
    const float sg = l16 < 8 ? -1.f : 1.f;
#pragma unroll 2
    for (int it = F.wave * 4 + sub; it < 512; it += 32) {
        const int row = pm * 256 + (it >> 1), kvh = it & 1; int key, t = 0;
        if (rope) { const int b = row / SEQ; t = row % SEQ; key = b * SLEN + CTXL + t; } else { const int r = row - NLAT; key = (r / CTXL) * SLEN + (r % CTXL); }
        u32x4* p = (u32x4*)(KB + (size_t)key * 256 + kvh * 128 + 8 * l16);
        const u32x4 w = *p;
        f32x4 xa = {__uint_as_float(w.x << 16), __uint_as_float(w.x & 0xffff0000u), __uint_as_float(w.y << 16), __uint_as_float(w.y & 0xffff0000u)};
        f32x4 xb = {__uint_as_float(w.z << 16), __uint_as_float(w.z & 0xffff0000u), __uint_as_float(w.w << 16), __uint_as_float(w.w & 0xffff0000u)};
        float ss = ((xa[0] * xa[0] + xa[1] * xa[1]) + (xa[2] * xa[2] + xa[3] * xa[3])) + ((xb[0] * xb[0] + xb[1] * xb[1]) + (xb[2] * xb[2] + xb[3] * xb[3]));
        ss += __shfl_xor(ss, 1); ss += __shfl_xor(ss, 2); ss += __shfl_xor(ss, 4); ss += __shfl_xor(ss, 8);
        const float rs = rsqrtf(ss * (1.f / 128.f) + 1e-6f);
        xa = xa * (g0 * rs); xb = xb * (g1 * rs);
        if (rope) { const float* rp = ropet + (((l16 & 7) < 4) ? (t / 64) : (t % 64)) * 64 + 16 * (l16 & 3);
            const f32x4 c0 = *(const f32x4*)rp, c1 = *(const f32x4*)(rp + 4), c2 = *(const f32x4*)(rp + 8), c3 = *(const f32x4*)(rp + 12);
            const f32x4 csa = {c0[0], c0[2], c1[0], c1[2]}, sna = {c0[1], c0[3], c1[1], c1[3]}, csb = {c2[0], c2[2], c3[0], c3[2]}, snb = {c2[1], c2[3], c3[1], c3[3]};
            f32x4 pa, pb;
            pa[0] = __shfl_xor(xa[0], 8); pa[1] = __shfl_xor(xa[1], 8); pa[2] = __shfl_xor(xa[2], 8); pa[3] = __shfl_xor(xa[3], 8);
            pb[0] = __shfl_xor(xb[0], 8); pb[1] = __shfl_xor(xb[1], 8); pb[2] = __shfl_xor(xb[2], 8); pb[3] = __shfl_xor(xb[3], 8);
            xa = xa * csa + (pa * sna) * sg; xb = xb * csb + (pb * snb) * sg; }
        u32x4 o; o.x = pk2(xa[0], xa[1]); o.y = pk2(xa[2], xa[3]); o.z = pk2(xb[0], xb[1]); o.w = pk2(xb[2], xb[3]);
        *p = o;
    }
}
__device__ __forceinline__ void attn_phase(Ctx& F, const Args& a) {
    const bf16_t* Q = (const bf16_t*)(F.ws + WS_Q); const bf16_t* KB = (const bf16_t*)(F.ws + WS_KB); const bf16_t* VB = (const bf16_t*)(F.ws + WS_VB); bf16_t* AO = (bf16_t*)(F.ws + WS_AO);
    const float gq = wave_max(fmaxf(fabsf(a.in[I_QG][F.lane]), fabsf(a.in[I_QG][F.lane + 64]))), gk = wave_max(fmaxf(fabsf(a.in[I_KG][F.lane]), fabsf(a.in[I_KG][F.lane + 64])));
    const bool fast = 11.3137085f * 1.4426950408889634f * 1.02f * gq * gk < 60.f;
    for (int i = 0;; ++i) {
        const int L = i * F.G + F.bid; if (L >= 512) break;
        const int xcd = L & 7, off = L >> 3, combo = xcd >> 1, idx = (xcd & 1) * 64 + off, hl = idx >> 5, qb = idx & 31;
        const int b = combo >> 1, kvh = combo & 1, h = kvh * 4 + hl;
        const size_t qoff = ((size_t)b * SEQ + qb * 256) * 1024 + h * 128, koff = (size_t)b * SLEN * 256 + kvh * 128;
        if (fast) attn::attn_dense_body<attn::bf16, true, 1>(Q + qoff, KB + koff, VB + koff, AO + qoff, SLEN, (char*)F.lds, F.wave * 64 + fresh_lane(), a.in[I_QG], qb * 256, (const float*)(F.ws + WS_ROPE));
        else attn::attn_dense_body<attn::bf16, false, 1>(Q + qoff, KB + koff, VB + koff, AO + qoff, SLEN, (char*)F.lds, F.wave * 64 + fresh_lane(), a.in[I_QG], qb * 256, (const float*)(F.ws + WS_ROPE));
        __syncthreads();
    }
}

typedef short v4i16_t __attribute__((ext_vector_type(4)));
typedef const LAS unsigned char* lds_cptr;
constexpr float LOG2E = 1.4426950408889634f;
__device__ __forceinline__ s16x4 vtr(lds_cptr p) { return __builtin_bit_cast(s16x4, __builtin_amdgcn_ds_read_tr16_b64_v4i16((LAS v4i16_t*)p)); }
__device__ __forceinline__ bf16x8 trfrag(lds_cptr tb, int d0, int ks) {
    const s16x4 l = vtr(tb + attn::v_rd_off(d0, ks, 0)), h = vtr(tb + attn::v_rd_off(d0, ks, 1));
    return (bf16x8){l[0], l[1], l[2], l[3], h[0], h[1], h[2], h[3]}; }
__device__ __forceinline__ bf16x8 rowfrag(lds_cptr tile, int blk, int d0, int r32, int hi) { return *(const LAS bf16x8*)(tile + KSWZ(32 * blk + r32, (d0 * 16 + hi * 8) * 2)); }
__device__ __forceinline__ u32x4 scale8(u32x4 v, float s) { u32x4 o;
#pragma unroll
    for (int i = 0; i < 4; ++i) o[i] = pk2(__uint_as_float(v[i] << 16) * s, __uint_as_float(v[i] & 0xffff0000u) * s);
    return o; }
__device__ __forceinline__ bf16x8 scale8f(bf16x8 v, float s) { return __builtin_bit_cast(bf16x8, scale8(__builtin_bit_cast(u32x4, v), s)); }
__device__ __forceinline__ float wave_incl_sum(float v, int lane) {
#pragma unroll
    for (int o = 1; o < 64; o <<= 1) { const float t = __shfl_up(v, o); if (lane >= o) v += t; }
    return v; }
__device__ __forceinline__ float wave_incl_max(float v, int lane) {
#pragma unroll
    for (int o = 1; o < 64; o <<= 1) { const float t = __shfl_up(v, o); if (lane >= o) v = fmaxf(v, t); }
    return v; }
__device__ __forceinline__ float wave_incl_max_rev(float v, int lane) {
#pragma unroll
    for (int o = 1; o < 64; o <<= 1) { const float t = __shfl_down(v, o); if (lane + o < 64) v = fmaxf(v, t); }
    return v; }
__device__ __forceinline__ float half_swap_add(float v) { auto rr = __builtin_amdgcn_permlane32_swap(__float_as_uint(v), __float_as_uint(v), false, false); return __uint_as_float(rr[0]) + __uint_as_float(rr[1]); }
#define MX_PK4(P, BASE, OUT) do { unsigned a0_ = pk2(P[BASE + 0], P[BASE + 1]), a1_ = pk2(P[BASE + 2], P[BASE + 3]); \
    unsigned b0_ = pk2(P[BASE + 4], P[BASE + 5]), b1_ = pk2(P[BASE + 6], P[BASE + 7]); \
    auto r0_ = __builtin_amdgcn_permlane32_swap(a0_, b0_, false, false); auto r1_ = __builtin_amdgcn_permlane32_swap(a1_, b1_, false, false); \
    u32x4 w_ = {r0_[0], r1_[0], r0_[1], r1_[1]}; OUT = __builtin_bit_cast(bf16x8, w_); } while (0)

__device__ __forceinline__ const bf16_t* launder_v(const bf16_t* p) { asm volatile("" : "+v"(p)); return p; }
constexpr int MX_MISC = MISC_OFF + 1024;
__device__ __forceinline__ int st_off(int row, int col) { return (((row >> 5) * 8 + (col >> 4)) << 9) + ((row & 31) << 4) + (col & 15); }
__device__ __forceinline__ int mx_unit(int bid, int G, int k, int off) { const int kmain = 528 / G, nmain = kmain * G; if (k < kmain) return bid + k * G; if (k == kmain) { const int j = bid - off; return (j >= 0 && j < 528 - nmain) ? nmain + j : -1; } return -1; }

constexpr int CONV_RUN = 26;
__device__ __forceinline__ int conv_seg(int row) { return row < NLAT ? row / SEQ : 2 + (row - NLAT) / CTXL; }
__device__ __forceinline__ void conv_unpack(u32x4 v, float (&f)[8]) {
#pragma unroll
    for (int e = 0; e < 4; ++e) { f[2 * e] = __uint_as_float(v[e] << 16); f[2 * e + 1] = __uint_as_float(v[e] & 0xffff0000u); } }
__device__ __forceinline__ void conv_phase(Ctx& F, const Args& a) {
    const bf16_t* XBC = (const bf16_t*)(F.ws + WS_XBC); bf16_t* XC = (bf16_t*)(F.ws + WS_XC);
    const float* cw = a.in[I_CONVW]; const float* cb = a.in[I_CONVB];
    constexpr int NRUN = (NTOK + CONV_RUN - 1) / CONV_RUN;
    for (int it = F.bid * NTHREADS + F.tid; it < NRUN * 192; it += F.G * NTHREADS) {
        const int c8 = (it % 192) * 8, r0 = (it / 192) * CONV_RUN, r1 = (r0 + CONV_RUN < NTOK) ? r0 + CONV_RUN : NTOK;
        float w[4][8], bias[8];
#pragma unroll
        for (int j = 0; j < 4; ++j) { const f32x4 w0 = *(const f32x4*)(cw + j * 1536 + c8), w1 = *(const f32x4*)(cw + j * 1536 + c8 + 4); w[j][0] = w0[0]; w[j][1] = w0[1]; w[j][2] = w0[2]; w[j][3] = w0[3]; w[j][4] = w1[0]; w[j][5] = w1[1]; w[j][6] = w1[2]; w[j][7] = w1[3]; }
        { const f32x4 b0 = *(const f32x4*)(cb + c8), b1 = *(const f32x4*)(cb + c8 + 4); bias[0] = b0[0]; bias[1] = b0[1]; bias[2] = b0[2]; bias[3] = b0[3]; bias[4] = b1[0]; bias[5] = b1[1]; bias[6] = b1[2]; bias[7] = b1[3]; }
        const u32x4 zero = {0u, 0u, 0u, 0u};
        const bf16_t* base = XBC + c8;
        u32x4 xm2 = r0 >= 2 ? *(const u32x4*)(base + (size_t)(r0 - 2) * 1536) : zero, xm1 = r0 >= 1 ? *(const u32x4*)(base + (size_t)(r0 - 1) * 1536) : zero;
        u32x4 x0 = *(const u32x4*)(base + (size_t)r0 * 1536), xp1 = r0 + 1 < NTOK ? *(const u32x4*)(base + (size_t)(r0 + 1) * 1536) : zero;
        for (int r = r0; r < r1; ++r) {
            const u32x4 xp2 = r + 2 < NTOK ? *(const u32x4*)(base + (size_t)(r + 2) * 1536) : zero;
            const int sg = conv_seg(r);
            const bool v0 = r >= 2 && conv_seg(r - 2) == sg, v1 = r >= 1 && conv_seg(r - 1) == sg, v3 = r + 1 < NTOK && conv_seg(r + 1) == sg;
            float f0[8], f1[8], f2[8], f3[8]; conv_unpack(xm2, f0); conv_unpack(xm1, f1); conv_unpack(x0, f2); conv_unpack(xp1, f3);
            float acc[8];
#pragma unroll
            for (int e = 0; e < 8; ++e) acc[e] = bias[e] + (v0 ? w[0][e] * f0[e] : 0.f) + (v1 ? w[1][e] * f1[e] : 0.f) + w[2][e] * f2[e] + (v3 ? w[3][e] * f3[e] : 0.f);
            u32x4 o; o[0] = pk2(siluf(acc[0]), siluf(acc[1])); o[1] = pk2(siluf(acc[2]), siluf(acc[3])); o[2] = pk2(siluf(acc[4]), siluf(acc[5])); o[3] = pk2(siluf(acc[6]), siluf(acc[7]));
            *(u32x4*)(XC + (size_t)r * 1536 + c8) = o;
            xm2 = xm1; xm1 = x0; x0 = xp1; xp1 = xp2;
        }
    }
}

struct MlGate { float b0, b1, G0, G1, total; };
__device__ __forceinline__ MlGate ml_gate(const float* GATES, int row0, int dir, int h, int lane) {
    const float* g0 = GATES + (size_t)(row0 + 2 * lane) * NGATE; const float* g1 = g0 + NGATE;
    const float lf0 = g0[8 + dir * 4 + h], lf1 = g1[8 + dir * 4 + h], ig0 = g0[dir * 4 + h], ig1 = g1[dir * 4 + h];
    const float incl = wave_incl_sum(lf0 + lf1, lane), total = __shfl(incl, 63);
    MlGate r; r.total = total;
    if (dir == 0) { r.b0 = incl - lf1; r.b1 = incl; } else { r.b0 = total - incl + lf0 + lf1; r.b1 = total - incl + lf1; }
    r.G0 = ig0 - r.b0; r.G1 = ig1 - r.b1; return r;
}


__device__ __forceinline__ void mlstm_a_phase(Ctx& F, int off) {
    const bf16_t* QK = (const bf16_t*)(F.ws + WS_QK); const bf16_t* V = (const bf16_t*)(F.ws + WS_V); const float* GATES = (const float*)(F.ws + WS_GATES);
    bf16_t* DC = (bf16_t*)(F.ws + WS_DC); float* DN = (float*)(F.ws + WS_DN); float* MS = (float*)(F.ws + WS_MS);
    LAS unsigned char* Vt = F.lds; LAS unsigned char* Kw = F.lds + 65536;
    LAS float* wsc = (LAS float*)(F.lds + MX_MISC); LAS float* dnp = (LAS float*)(F.lds + MX_MISC + 1024);
    for (int k_ = 0;; ++k_) { const int u = mx_unit(F.bid, F.G, k_, off); if (u < 0) break;
        const int lane = fresh_lane(), tid = F.wave * 64 + lane, r32 = lane & 31, hi = lane >> 5, sr = tid >> 4, sc8 = (tid & 15) * 8, rdb = attn::v_rd_base(lane);
        const int b = u / 264, rem = u % 264, cid = rem >> 2, h = rem & 3, row0 = chunk_row0(b, cid);
        if (F.wave < 2) { const int dir = F.wave, chain = (b * 4 + h) * 2 + dir; typedef float f32x2v __attribute__((ext_vector_type(2)));
            *(LAS f32x2v*)(wsc + dir * 128 + 2 * lane) = *(const f32x2v*)((const float*)(F.ws + WS_MLG) + (size_t)(chain * NCH + cid) * 512 + 384 + 2 * lane); }
        __syncthreads();
        float dnacc[2][8];
#pragma unroll
        for (int d = 0; d < 2; ++d)
#pragma unroll
            for (int e = 0; e < 8; ++e) dnacc[d][e] = 0.f;
#pragma unroll
        for (int i = 0; i < 4; ++i) { const int s = sr + 32 * i; const size_t grow = (size_t)(row0 + s) * 1024;
#pragma unroll
            for (int vb = 0; vb < 2; ++vb) { const u32x4 v = *(const u32x4*)(V + grow + h * 256 + vb * 128 + sc8); *(LAS u32x4*)(Vt + ((s >> 6) * 2 + vb) * 16384 + attn::v_st(s & 63, sc8)) = v; }
            const u32x4 kv = *(const u32x4*)(QK + grow + 512 + h * 128 + sc8);
#pragma unroll
            for (int d = 0; d < 2; ++d) { const float w = wsc[d * 128 + s];
                *(LAS u32x4*)(Kw + (d * 2 + (s >> 6)) * 16384 + attn::v_st(s & 63, sc8)) = scale8(kv, w);
#pragma unroll
                for (int e = 0; e < 4; ++e) { dnacc[d][2 * e] += w * __uint_as_float(kv[e] << 16); dnacc[d][2 * e + 1] += w * __uint_as_float(kv[e] & 0xffff0000u); } } }
#pragma unroll
        for (int d = 0; d < 2; ++d)
#pragma unroll
            for (int e = 0; e < 8; ++e) { float t = dnacc[d][e]; t += __shfl_xor(t, 16); t += __shfl_xor(t, 32); if ((lane >> 4) == 0) dnp[(F.wave * 2 + d) * 128 + sc8 + e] = t; }
        __syncthreads();
        {   const int dir = F.wave >> 2, vq = F.wave & 3;
            f32x16 acc[2][4];
#pragma unroll
            for (int i = 0; i < 2; ++i)
#pragma unroll
                for (int n = 0; n < 4; ++n) acc[i][n] = f32x16{};
#pragma unroll
            for (int ks = 0; ks < 8; ++ks) { const int sblk = ks >> 2, KS = ks & 3;
                bf16x8 af[2], bfr[4];
#pragma unroll
                for (int i = 0; i < 2; ++i) af[i] = trfrag(Vt + (sblk * 2 + (vq >> 1)) * 16384 + rdb, (2 * vq + i) & 3, KS);
#pragma unroll
                for (int n = 0; n < 4; ++n) bfr[n] = trfrag(Kw + (dir * 2 + sblk) * 16384 + rdb, n, KS);
#pragma unroll
                for (int i = 0; i < 2; ++i)
#pragma unroll
                    for (int n = 0; n < 4; ++n) acc[i][n] = __builtin_amdgcn_mfma_f32_32x32x16_bf16(af[i], bfr[n], acc[i][n], 0, 0, 0); }
            const int chain = (b * 4 + h) * 2 + dir;
            bf16_t* dst = DC + (size_t)(chain * NCH + cid) * 256 * 128;
#pragma unroll
            for (int i = 0; i < 2; ++i)
#pragma unroll
                for (int n = 0; n < 4; ++n)
#pragma unroll
                    for (int r = 0; r < 16; ++r) dst[st_off(64 * vq + 32 * i + attn::crow(r, hi), 32 * n + r32)] = f2bf(acc[i][n][r]);
        }
        if (tid < 256) { const int dir = tid >> 7, d = tid & 127; float s = 0.f;
#pragma unroll
            for (int w = 0; w < 8; ++w) s += dnp[(w * 2 + dir) * 128 + d];
            const int chain = (b * 4 + h) * 2 + dir; DN[(size_t)(chain * NCH + cid) * 128 + d] = s; }
        __syncthreads();
    }
}

struct SsGate { float dt0, dt1, acs0, acs1, total; };
__device__ __forceinline__ SsGate ss_gate(const float* GATES, int row0, int dir, int head, float aneg, int lane) {
    const float* g0 = GATES + (size_t)(row0 + 2 * lane) * NGATE; const float* g1 = g0 + NGATE;
    SsGate r; r.dt0 = g0[16 + dir * 16 + head]; r.dt1 = g1[16 + dir * 16 + head];
    const float a0 = r.dt0 * aneg, a1 = r.dt1 * aneg;
    const float incl = wave_incl_sum(a0 + a1, lane); r.total = __shfl(incl, 63);
    if (dir == 0) { r.acs0 = incl - a1; r.acs1 = incl; } else { r.acs0 = r.total - incl + a0 + a1; r.acs1 = r.total - incl + a1; }
    return r;
}
__device__ __forceinline__ void gatescan_phase(Ctx& F, const Args& a) {
    const float* GATES = (const float*)(F.ws + WS_GATES); float* MLG = (float*)(F.ws + WS_MLG); float* SSG = (float*)(F.ws + WS_SSG);
    float* MS = (float*)(F.ws + WS_MS); float* AEND = (float*)(F.ws + WS_AEND);
    typedef float f32x2v __attribute__((ext_vector_type(2)));
    const int lane = F.lane;
    for (int it = GWID(F); it < 16 * NCH + 64 * NCH; it += NGW(F)) {
        if (it < 16 * NCH) { const int chain = it / NCH, cid = it % NCH, dir = chain & 1, h = (chain >> 1) & 3, b = chain >> 3, row0 = chunk_row0(b, cid);
            const MlGate g = ml_gate(GATES, row0, dir, h, lane);
            const float gmx = fmaxf(g.G0, g.G1), gm = wave_max(gmx); float P0, P1;
            if (dir == 0) { const float pm = wave_incl_max(gmx, lane); float ex = __shfl_up(pm, 1); if (lane == 0) ex = -1e30f; P0 = fmaxf(ex, g.G0); P1 = pm; }
            else { const float pm = wave_incl_max_rev(gmx, lane); float ex = __shfl_down(pm, 1); if (lane == 63) ex = -1e30f; P1 = fmaxf(ex, g.G1); P0 = pm; }
            float* o = MLG + (size_t)it * 512 + 2 * lane;
            *(f32x2v*)(o) = (f32x2v){g.b0, g.b1}; *(f32x2v*)(o + 128) = (f32x2v){g.G0, g.G1}; *(f32x2v*)(o + 256) = (f32x2v){P0, P1}; *(f32x2v*)(o + 384) = (f32x2v){expf(g.G0 - gm), expf(g.G1 - gm)};
            if (lane == 0) { MS[it * 4 + 0] = g.total; MS[it * 4 + 1] = g.total + gm; } }
        else { const int i2 = it - 16 * NCH, chain = i2 / NCH, cid = i2 % NCH, dir = chain & 1, head = (chain >> 1) & 15, b = chain >> 5, row0 = chunk_row0(b, cid);
            const float aneg = -expf(a.in[I_ALOG][dir * 16 + head]); const SsGate s = ss_gate(GATES, row0, dir, head, aneg, lane);
            float* o = SSG + (size_t)i2 * 384 + 2 * lane;
            *(f32x2v*)(o) = (f32x2v){s.acs0, s.acs1}; *(f32x2v*)(o + 128) = (f32x2v){s.dt0, s.dt1}; *(f32x2v*)(o + 256) = (f32x2v){s.dt0 * expf(s.total - s.acs0), s.dt1 * expf(s.total - s.acs1)};
            if (lane == 0) AEND[i2] = s.total; }
    }
}
template <bool BM_ROW> __device__ __forceinline__ void ssd_stage(Ctx& F, const bf16_t* XC, int row0, int g, int hh, LAS unsigned char* Xt, LAS unsigned char* Bt) {
    const int tid_ = F.wave * 64 + fresh_lane(), sr = tid_ >> 4, sc8 = (tid_ & 15) * 8;
#pragma unroll
    for (int i = 0; i < 4; ++i) { const int s = sr + 32 * i; const bf16_t* rowp = XC + (size_t)(row0 + s) * 1536;
#pragma unroll
        for (int cb = 0; cb < 2; ++cb) { const u32x4 v = *(const u32x4*)(rowp + (g * 8 + hh * 4) * 64 + cb * 128 + sc8); *(LAS u32x4*)(Xt + ((s >> 6) * 2 + cb) * 16384 + attn::v_st(s & 63, sc8)) = v; }
        const u32x4 bv = *(const u32x4*)(rowp + 1024 + g * 128 + sc8);
        if (BM_ROW) *(LAS u32x4*)(Bt + (s >> 6) * 16384 + KSWZ(s & 63, sc8 * 2)) = bv; else *(LAS u32x4*)(Bt + (s >> 6) * 16384 + attn::v_st(s & 63, sc8)) = bv; }
}
__device__ __forceinline__ void ssd_a_phase(Ctx& F, const Args& a, int off) {
    const bf16_t* XC = (const bf16_t*)(F.ws + WS_XC); const float* GATES = (const float*)(F.ws + WS_GATES);
    bf16_t* DS = (bf16_t*)(F.ws + WS_DS); float* AEND = (float*)(F.ws + WS_AEND);
    LAS unsigned char* Xt = F.lds; LAS unsigned char* Bt = F.lds + 65536;
    LAS float* wtl = (LAS float*)(F.lds + MX_MISC);
    for (int k_ = 0;; ++k_) { const int u = mx_unit(F.bid, F.G, k_, off); if (u < 0) break;
        const int lane = fresh_lane(), r32 = lane & 31, hi = lane >> 5, rdb = attn::v_rd_base(lane);
        const int b = u / 264, rem = u % 264, cid = rem >> 2, g = (rem >> 1) & 1, hh = rem & 1, row0 = chunk_row0(b, cid);
        const int dir = F.wave >> 2, j = F.wave & 3, head = g * 8 + hh * 4 + j, chain = (b * 16 + head) * 2 + dir;
        { typedef float f32x2v __attribute__((ext_vector_type(2)));
          *(LAS f32x2v*)(wtl + F.wave * 128 + 2 * lane) = *(const f32x2v*)((const float*)(F.ws + WS_SSG) + (size_t)(chain * NCH + cid) * 384 + 256 + 2 * lane); }
        ssd_stage<false>(F, XC, row0, g, hh, Xt, Bt);
        __syncthreads();
        f32x16 acc[2][4];
#pragma unroll
        for (int i = 0; i < 2; ++i)
#pragma unroll
            for (int n = 0; n < 4; ++n) acc[i][n] = f32x16{};
#pragma unroll
        for (int ks = 0; ks < 8; ++ks) { const int sblk = ks >> 2, KS = ks & 3;
            const f32x4 w0 = *(const LAS f32x4*)(wtl + F.wave * 128 + 16 * ks + 8 * hi), w1 = *(const LAS f32x4*)(wtl + F.wave * 128 + 16 * ks + 8 * hi + 4);
            bf16x8 af[2], bfr[4];
#pragma unroll
            for (int i = 0; i < 2; ++i) { const u32x4 x = __builtin_bit_cast(u32x4, trfrag(Xt + (sblk * 2 + (j >> 1)) * 16384 + rdb, (j & 1) * 2 + i, KS)); u32x4 o;
                o[0] = pk2(__uint_as_float(x[0] << 16) * w0[0], __uint_as_float(x[0] & 0xffff0000u) * w0[1]); o[1] = pk2(__uint_as_float(x[1] << 16) * w0[2], __uint_as_float(x[1] & 0xffff0000u) * w0[3]);
                o[2] = pk2(__uint_as_float(x[2] << 16) * w1[0], __uint_as_float(x[2] & 0xffff0000u) * w1[1]); o[3] = pk2(__uint_as_float(x[3] << 16) * w1[2], __uint_as_float(x[3] & 0xffff0000u) * w1[3]);
                af[i] = __builtin_bit_cast(bf16x8, o); }
#pragma unroll
            for (int n = 0; n < 4; ++n) bfr[n] = trfrag(Bt + sblk * 16384 + rdb, n, KS);
#pragma unroll
            for (int i = 0; i < 2; ++i)
#pragma unroll
                for (int n = 0; n < 4; ++n) acc[i][n] = __builtin_amdgcn_mfma_f32_32x32x16_bf16(af[i], bfr[n], acc[i][n], 0, 0, 0); }
        bf16_t* dst = DS + (size_t)(chain * NCH + cid) * 64 * 128;
#pragma unroll
        for (int i = 0; i < 2; ++i)
#pragma unroll
            for (int n = 0; n < 4; ++n)
#pragma unroll
                for (int r = 0; r < 16; ++r) dst[st_off(32 * i + attn::crow(r, hi), 32 * n + r32)] = f2bf(acc[i][n][r]);
        __syncthreads();
    }
}

__device__ __forceinline__ void scan_phase(Ctx& F) {
    LAS float* sa = (LAS float*)(F.lds + MX_MISC); LAS float* ss = sa + 80;
    for (int vb = F.bid; vb < 256; vb += F.G) {
        __syncthreads();
        if (vb < 128) {
            const int chain = vb >> 3, dir = chain & 1; float* MS = (float*)(F.ws + WS_MS) + (size_t)chain * NCH * 4;
            LAS float* sbe = ss + 80; LAS float* sgm = sbe + 80;
            if (F.tid < NCH) { const int cid = scan_cid(dir, F.tid); sbe[F.tid] = MS[cid * 4 + 0]; sgm[F.tid] = MS[cid * 4 + 1]; }
            __syncthreads();
            if (F.tid == 0) { float m = 0.f;
                for (int p = 0; p < NCH; ++p) { const float be = sbe[p], gm = sgm[p];
                    const float mn = fmaxf(be + m, gm); sa[p] = expf(be + m - mn); ss[p] = expf(gm - mn); if ((vb & 7) == 0) MS[scan_cid(dir, p) * 4 + 2] = m; m = mn; } }
            __syncthreads();
            {   bf16_t* base = (bf16_t*)(F.ws + WS_DC) + (size_t)chain * NCH * 32768 + ((size_t)(vb & 7) * 512 + F.tid) * 8;
                u32x4 buf[8]; float run[8];
#pragma unroll
                for (int e = 0; e < 8; ++e) run[e] = 0.f;
#pragma unroll
                for (int k = 0; k < 8; ++k) buf[k] = *(const u32x4*)(base + (size_t)scan_cid(dir, k) * 32768);
                for (int p0 = 0; p0 < 72; p0 += 8) {
#pragma unroll
                    for (int k = 0; k < 8; ++k) { const int p = p0 + k;
                        if (p < NCH) { const u32x4 d = buf[k]; bf16_t* loc = base + (size_t)scan_cid(dir, p) * 32768;
                            if (p + 8 < NCH) buf[k] = *(const u32x4*)(base + (size_t)scan_cid(dir, p + 8) * 32768);
                            u32x4 o; o[0] = pk2(run[0], run[1]); o[1] = pk2(run[2], run[3]); o[2] = pk2(run[4], run[5]); o[3] = pk2(run[6], run[7]);
                            *(u32x4*)loc = o;
                            const float av = sa[p], sv = ss[p];
#pragma unroll
                            for (int e = 0; e < 4; ++e) { run[2 * e] = av * run[2 * e] + sv * __uint_as_float(d[e] << 16); run[2 * e + 1] = av * run[2 * e + 1] + sv * __uint_as_float(d[e] & 0xffff0000u); } } }
                }
            }
            if ((vb & 7) == 0 && F.tid < 32) {
                float* nb = (float*)(F.ws + WS_DN) + (size_t)chain * NCH * 128 + F.tid * 4;
                f32x4 buf[8]; f32x4 run = {0.f, 0.f, 0.f, 0.f};
#pragma unroll
                for (int k = 0; k < 8; ++k) buf[k] = *(const f32x4*)(nb + (size_t)scan_cid(dir, k) * 128);
                for (int p0 = 0; p0 < 72; p0 += 8) {
#pragma unroll
                    for (int k = 0; k < 8; ++k) { const int p = p0 + k;
                        if (p < NCH) { const f32x4 d = buf[k]; float* loc = nb + (size_t)scan_cid(dir, p) * 128;
                            if (p + 8 < NCH) buf[k] = *(const f32x4*)(nb + (size_t)scan_cid(dir, p + 8) * 128);
                            *(f32x4*)loc = run; run = sa[p] * run + ss[p] * d; } }
                }
            }
        } else {
            const int chain = (vb - 128) >> 1, dir = chain & 1; const float* AEND = (const float*)(F.ws + WS_AEND) + (size_t)chain * NCH;
            if (F.tid < NCH) sa[F.tid] = expf(AEND[scan_cid(dir, F.tid)]);
            __syncthreads();
            bf16_t* base = (bf16_t*)(F.ws + WS_DS) + (size_t)chain * NCH * 8192 + ((size_t)(vb & 1) * 512 + F.tid) * 8;
            u32x4 buf[8]; float run[8];
#pragma unroll
            for (int e = 0; e < 8; ++e) run[e] = 0.f;
#pragma unroll
            for (int k = 0; k < 8; ++k) buf[k] = *(const u32x4*)(base + (size_t)scan_cid(dir, k) * 8192);
            for (int p0 = 0; p0 < 72; p0 += 8) {
#pragma unroll
                for (int k = 0; k < 8; ++k) { const int p = p0 + k;
                    if (p < NCH) { const u32x4 d = buf[k]; bf16_t* loc = base + (size_t)scan_cid(dir, p) * 8192;
                        if (p + 8 < NCH) buf[k] = *(const u32x4*)(base + (size_t)scan_cid(dir, p + 8) * 8192);
                        u32x4 o; o[0] = pk2(run[0], run[1]); o[1] = pk2(run[2], run[3]); o[2] = pk2(run[4], run[5]); o[3] = pk2(run[6], run[7]);
                        *(u32x4*)loc = o;
                        const float av = sa[p];
#pragma unroll
                        for (int e = 0; e < 4; ++e) { run[2 * e] = av * run[2 * e] + __uint_as_float(d[e] << 16); run[2 * e + 1] = av * run[2 * e + 1] + __uint_as_float(d[e] & 0xffff0000u); } } }
            }
        }
    }
}


template <bool DIAG> __device__ __forceinline__ void ml_block(const f32x16& S, const LAS float* Gp, float Mt, float sgn, float sb, float scale, f32x16& out) {
#pragma unroll
    for (int g4 = 0; g4 < 4; ++g4) { const f32x4 Gv = *(const LAS f32x4*)(Gp + 8 * g4);
#pragma unroll
        for (int e = 0; e < 4; ++e) { float arg = (Gv[e] - Mt) * LOG2E;
            if (DIAG) arg = fmaf(fminf(fmaf(-sgn, (float)(8 * g4 + e), sb), 0.f), 1e30f, arg);
            out[4 * g4 + e] = S[4 * g4 + e] * __builtin_amdgcn_exp2f(arg) * scale; } }
}
template <bool DIAG> __device__ __forceinline__ void ss_block(const f32x16& S, const LAS float* ap, const LAS float* dp, float At, float sgn, float sb, f32x16& out) {
#pragma unroll
    for (int g4 = 0; g4 < 4; ++g4) { const f32x4 av = *(const LAS f32x4*)(ap + 8 * g4), dv = *(const LAS f32x4*)(dp + 8 * g4);
#pragma unroll
        for (int e = 0; e < 4; ++e) { float arg = (At - av[e]) * LOG2E;
            if (DIAG) arg = fmaf(fminf(fmaf(-sgn, (float)(8 * g4 + e), sb), 0.f), 1e30f, arg);
            out[4 * g4 + e] = S[4 * g4 + e] * __builtin_amdgcn_exp2f(arg) * dv[e]; } }
}
__device__ __forceinline__ float sum16(const f32x16& v) { float s = 0.f;
#pragma unroll
    for (int r = 0; r < 16; ++r) s += v[r];
    return s; }
template <int VAR> __device__ __forceinline__ void mlstm_c_phase(Ctx& F, const Args& a, int off) {
    const bf16_t* QK = (const bf16_t*)(F.ws + WS_QK); const bf16_t* V = (const bf16_t*)(F.ws + WS_V); const bf16_t* OG = (const bf16_t*)(F.ws + WS_O); const float* GATES = (const float*)(F.ws + WS_GATES);
    const bf16_t* DC = (const bf16_t*)(F.ws + WS_DC); const float* DN = (const float*)(F.ws + WS_DN); const float* MS = (const float*)(F.ws + WS_MS); bf16_t* MIX = VAR ? (bf16_t*)(F.ws + WS_END) : (bf16_t*)(F.ws + WS_MIX);
    LAS unsigned char* Kt = F.lds; LAS unsigned char* Vt = F.lds + 32768; LAS float* stat = (LAS float*)(F.lds + MX_MISC + 5120);
    LAS float* Gs = (LAS float*)(F.lds + MX_MISC); LAS float* Ms = Gs + 256; LAS float* Bs = Gs + 512; LAS float* ns = Gs + 768; LAS float* mst = Gs + 1024;
    for (int k_ = 0;; ++k_) { const int u = mx_unit(F.bid, F.G, k_, off); if (u < 0) break;
        const int lane = fresh_lane(), tid = F.wave * 64 + lane, r32 = lane & 31, hi = lane >> 5, sr = tid >> 4, sc8 = (tid & 15) * 8, rdb = attn::v_rd_base(lane);
        const int b = u / 264, rem = u % 264, cid = rem >> 2, h = rem & 3, row0 = chunk_row0(b, cid);
        if (F.wave < 2) { const int dir = F.wave, chain = (b * 4 + h) * 2 + dir; typedef float f32x2v __attribute__((ext_vector_type(2)));
            const float* gsrc = (const float*)(F.ws + WS_MLG) + (size_t)(chain * NCH + cid) * 512 + 2 * lane;
            const f32x2v bb = *(const f32x2v*)gsrc, GG = *(const f32x2v*)(gsrc + 128), PP = *(const f32x2v*)(gsrc + 256);
            const float m0 = MS[(chain * NCH + cid) * 4 + 2];
            *(LAS f32x2v*)(Gs + dir * 128 + 2 * lane) = GG; *(LAS f32x2v*)(Ms + dir * 128 + 2 * lane) = (f32x2v){fmaxf(PP[0], m0), fmaxf(PP[1], m0)}; *(LAS f32x2v*)(Bs + dir * 128 + 2 * lane) = bb;
            const float* nsrc = DN + (size_t)(chain * NCH + cid) * 128; ns[dir * 128 + 2 * lane] = nsrc[2 * lane]; ns[dir * 128 + 2 * lane + 1] = nsrc[2 * lane + 1];
            if (lane == 0) mst[dir] = m0; }
#pragma unroll
        for (int i = 0; i < 4; ++i) { const int s = sr + 32 * i; const size_t grow = (size_t)(row0 + s) * 1024;
#pragma unroll
            for (int vb = 0; vb < 2; ++vb) { const u32x4 v = *(const u32x4*)(V + grow + h * 256 + vb * 128 + sc8); *(LAS u32x4*)(Vt + ((s >> 6) * 2 + vb) * 16384 + attn::v_st(s & 63, sc8)) = v; }
            const u32x4 kv = *(const u32x4*)(QK + grow + 512 + h * 128 + sc8);
            *(LAS u32x4*)(Kt + (s >> 6) * 16384 + KSWZ(s & 63, sc8 * 2)) = kv; }
        __syncthreads();
        const int tq = F.wave & 3, vh = F.wave >> 2, tau = 32 * tq + r32;
        const bf16_t* qptr = QK + (size_t)(row0 + tau) * 1024 + h * 128 + hi * 8;
        f32x16 pS[2][2];
        {   bf16x8 qr[8];
#pragma unroll
        for (int d0 = 0; d0 < 8; ++d0) qr[d0] = *(const bf16x8*)(qptr + d0 * 16);
#pragma unroll
        for (int j = 0; j < 2; ++j)
#pragma unroll
            for (int blk = 0; blk < 2; ++blk) { pS[j][blk] = f32x16{};
#pragma unroll
                for (int d0 = 0; d0 < 8; ++d0) pS[j][blk] = __builtin_amdgcn_mfma_f32_32x32x16_bf16(rowfrag(Kt + j * 16384, blk, d0, r32, hi), qr[d0], pS[j][blk], 0, 0, 0); }
        }
        f32x16 o[4];
#pragma unroll
        for (int d = 0; d < 4; ++d) o[d] = f32x16{};
        float qsc0 = 0.f, qsc1 = 0.f;
        if (VAR < 3)
#pragma unroll 1
        for (int dir = 0; dir < 2; ++dir) {
            const float Mt = Ms[dir * 128 + tau], m0 = mst[dir];
            const float sgn = dir ? -1.f : 1.f, sb = sgn * (float)(r32 - 4 * hi);
            float rs = 0.f;
#pragma unroll
            for (int j = 0; j < 2; ++j)
#pragma unroll
                for (int blk = 0; blk < 2; ++blk) { const int kb = 2 * j + blk; const bool vis = dir ? (kb >= tq) : (kb <= tq);
                    if (vis) { f32x16 pp; const LAS float* Gp = Gs + dir * 128 + 32 * kb + 4 * hi;
                        if (kb == tq) ml_block<true>(pS[j][blk], Gp, Mt, sgn, sb, 1.f, pp); else ml_block<false>(pS[j][blk], Gp, Mt, sgn, sb, 1.f, pp);
                        rs += sum16(pp); } }
            rs = half_swap_add(rs);
            float qn = 0.f; const bf16_t* qp2 = launder_v(qptr);
#pragma unroll
            for (int d0 = 0; d0 < 8; ++d0) { const bf16x8 qv = *(const bf16x8*)(qp2 + d0 * 16); const f32x4 n0 = *(const LAS f32x4*)(ns + dir * 128 + 16 * d0 + 8 * hi), n1 = *(const LAS f32x4*)(ns + dir * 128 + 16 * d0 + 8 * hi + 4);
                const u32x4 q = __builtin_bit_cast(u32x4, qv);
                qn += __uint_as_float(q[0] << 16) * n0[0] + __uint_as_float(q[0] & 0xffff0000u) * n0[1] + __uint_as_float(q[1] << 16) * n0[2] + __uint_as_float(q[1] & 0xffff0000u) * n0[3]
                    + __uint_as_float(q[2] << 16) * n1[0] + __uint_as_float(q[2] & 0xffff0000u) * n1[1] + __uint_as_float(q[3] << 16) * n1[2] + __uint_as_float(q[3] & 0xffff0000u) * n1[3]; }
            qn = half_swap_add(qn);
            const float ain = expf(m0 - Mt), den = rs + ain * qn;
            const float inv = __builtin_amdgcn_rcpf(fmaxf(fabsf(den), expf(-(Bs[dir * 128 + tau] + Mt))));
#pragma unroll
            for (int j = 0; j < 2; ++j)
#pragma unroll
                for (int blk = 0; blk < 2; ++blk) { const int kb = 2 * j + blk; const bool vis = dir ? (kb >= tq) : (kb <= tq);
                    if (vis) { f32x16 pp; const LAS float* Gp = Gs + dir * 128 + 32 * kb + 4 * hi;
                        if (kb == tq) ml_block<true>(pS[j][blk], Gp, Mt, sgn, sb, inv, pp); else ml_block<false>(pS[j][blk], Gp, Mt, sgn, sb, inv, pp);
                        bf16x8 pa0, pa1;
                        MX_PK4(pp, 0, pa0); MX_PK4(pp, 8, pa1);
#pragma unroll
                        for (int d = 0; d < 4; ++d) { o[d] = __builtin_amdgcn_mfma_f32_32x32x16_bf16(pa0, trfrag(Vt + (j * 2 + vh) * 16384 + rdb, d, 2 * blk), o[d], 0, 0, 0);
                            o[d] = __builtin_amdgcn_mfma_f32_32x32x16_bf16(pa1, trfrag(Vt + (j * 2 + vh) * 16384 + rdb, d, 2 * blk + 1), o[d], 0, 0, 0); } } }
            if (dir == 0) qsc0 = ain * inv; else qsc1 = ain * inv;
        }
        if (VAR < 2) {   const bf16_t* Cb0 = DC + (size_t)(((b * 4 + h) * 2 + 0) * NCH + cid) * 256 * 128 + (size_t)(4 * vh) * 4096 + r32 * 16 + hi * 8;
            const bf16_t* Cb1 = Cb0 + (size_t)NCH * 256 * 128;
            const bf16_t* qp3 = launder_v(qptr);
            bf16x8 qr2[8];
#pragma unroll
            for (int d0 = 0; d0 < 8; ++d0) qr2[d0] = *(const bf16x8*)(qp3 + d0 * 16);
            bf16x8 cf[4][4];
#define MLC_LD(s_) do { _Pragma("unroll") for (int d = 0; d < 4; ++d) cf[(s_) & 3][d] = *(const bf16x8*)(((s_) < 8 ? Cb0 : Cb1) + d * 4096 + 512 * ((s_) & 7)); } while (0)
            MLC_LD(0); MLC_LD(1); MLC_LD(2);
            __builtin_amdgcn_sched_barrier(0);
#pragma unroll
            for (int st = 0; st < 16; ++st) {
                if (st + 3 < 16) MLC_LD(st + 3);
                const bf16x8 qs = scale8f(qr2[st & 7], st < 8 ? qsc0 : qsc1);
#pragma unroll
                for (int d = 0; d < 4; ++d) o[d] = __builtin_amdgcn_mfma_f32_32x32x16_bf16(qs, cf[st & 3][d], o[d], 0, 0, 0);
                __builtin_amdgcn_sched_barrier(0); }
#undef MLC_LD
        }
        float s1[16], s2[16];
#pragma unroll
        for (int r = 0; r < 16; ++r) { float x = 0.f, y = 0.f;
#pragma unroll
            for (int d = 0; d < 4; ++d) { x += o[d][r]; y += o[d][r] * o[d][r]; }
#pragma unroll
            for (int of = 1; of < 32; of <<= 1) { x += __shfl_xor(x, of); y += __shfl_xor(y, of); }
            s1[r] = x; s2[r] = y; }
        if (r32 == 0) {
#pragma unroll
            for (int r = 0; r < 16; ++r) { const int row = 32 * tq + attn::crow(r, hi); stat[(vh * 128 + row) * 2] = s1[r]; stat[(vh * 128 + row) * 2 + 1] = s2[r]; } }
        __syncthreads();
        {
            LAS float* ot = (LAS float*)(F.lds + F.wave * 16384);
            float gg[4];
#pragma unroll
            for (int d = 0; d < 4; ++d) gg[d] = a.in[I_MNG][h * 256 + 128 * vh + 32 * d + r32];
#pragma unroll
            for (int r = 0; r < 16; ++r) { const int lrow = attn::crow(r, hi), row = 32 * tq + lrow;
                const float t1 = stat[row * 2] + stat[(128 + row) * 2], t2 = stat[row * 2 + 1] + stat[(128 + row) * 2 + 1];
                const float mu = t1 * (1.f / 256.f), rstd = rsqrtf(fmaxf(t2 * (1.f / 256.f) - mu * mu, 0.f) + 1e-5f);
#pragma unroll
                for (int d = 0; d < 4; ++d) ot[lrow * 128 + 32 * d + r32] = (o[d][r] - mu) * rstd * gg[d]; }
            asm volatile("s_waitcnt lgkmcnt(0)" ::: "memory");
#pragma unroll
            for (int i = 0; i < 8; ++i) { const int ch = lane + 64 * i, lrow = ch >> 4, c8 = (ch & 15) * 8;
                const f32x4 v0 = *(const LAS f32x4*)(ot + lrow * 128 + c8), v1 = *(const LAS f32x4*)(ot + lrow * 128 + c8 + 4);
                const size_t grow = (size_t)(row0 + 32 * tq + lrow); const int col = h * 256 + 128 * vh + c8;
                const u32x4 og = *(const u32x4*)(OG + grow * 1024 + col);
                u32x4 w; w[0] = pk2(v0[0] * sigmf(__uint_as_float(og[0] << 16)), v0[1] * sigmf(__uint_as_float(og[0] & 0xffff0000u))); w[1] = pk2(v0[2] * sigmf(__uint_as_float(og[1] << 16)), v0[3] * sigmf(__uint_as_float(og[1] & 0xffff0000u)));
                w[2] = pk2(v1[0] * sigmf(__uint_as_float(og[2] << 16)), v1[1] * sigmf(__uint_as_float(og[2] & 0xffff0000u))); w[3] = pk2(v1[2] * sigmf(__uint_as_float(og[3] << 16)), v1[3] * sigmf(__uint_as_float(og[3] & 0xffff0000u)));
                *(u32x4*)(MIX + (VAR ? (grow & 4095) : grow) * 2048 + 1024 + col) = w; }
        }
        __syncthreads();
    }
}

__device__ __forceinline__ void ssd_c_phase(Ctx& F, const Args& a, int off) {
    const bf16_t* XC = (const bf16_t*)(F.ws + WS_XC); const bf16_t* Z = (const bf16_t*)(F.ws + WS_Z); const float* GATES = (const float*)(F.ws + WS_GATES);
    const bf16_t* DS = (const bf16_t*)(F.ws + WS_DS); bf16_t* MIX = (bf16_t*)(F.ws + WS_MIX); float* SSQ = (float*)(F.ws + WS_SSQ);
    LAS unsigned char* Bt = F.lds; LAS unsigned char* Xt = F.lds + 32768;
    LAS float* acsl = (LAS float*)(F.lds + MX_MISC); LAS float* dtl = acsl + 1024;
    for (int k_ = 0;; ++k_) { const int u = mx_unit(F.bid, F.G, k_, off); if (u < 0) break;
        const int lane = fresh_lane(), r32 = lane & 31, hi = lane >> 5, rdb = attn::v_rd_base(lane);
        const int b = u / 264, rem = u % 264, cid = rem >> 2, g = (rem >> 1) & 1, hh = rem & 1, row0 = chunk_row0(b, cid);
        {   const int dir = F.wave >> 2, j = F.wave & 3, head = g * 8 + hh * 4 + j, chain = (b * 16 + head) * 2 + dir; typedef float f32x2v __attribute__((ext_vector_type(2)));
            const float* gsrc = (const float*)(F.ws + WS_SSG) + (size_t)(chain * NCH + cid) * 384 + 2 * lane; const int o = (j * 2 + dir) * 128 + 2 * lane;
            *(LAS f32x2v*)(acsl + o) = *(const f32x2v*)gsrc; *(LAS f32x2v*)(dtl + o) = *(const f32x2v*)(gsrc + 128); }
        ssd_stage<true>(F, XC, row0, g, hh, Xt, Bt);
        __syncthreads();
        const int tq = F.wave & 3, jp = F.wave >> 2, tau = 32 * tq + r32;
        const bf16_t* cptr = XC + (size_t)(row0 + tau) * 1536 + 1280 + g * 128 + hi * 8;
        f32x16 pS[2][2];
        {   bf16x8 cr[8];
#pragma unroll
        for (int d0 = 0; d0 < 8; ++d0) cr[d0] = *(const bf16x8*)(cptr + d0 * 16);
#pragma unroll
        for (int j = 0; j < 2; ++j)
#pragma unroll
            for (int blk = 0; blk < 2; ++blk) { pS[j][blk] = f32x16{};
#pragma unroll
                for (int d0 = 0; d0 < 8; ++d0) pS[j][blk] = __builtin_amdgcn_mfma_f32_32x32x16_bf16(rowfrag(Bt + j * 16384, blk, d0, r32, hi), cr[d0], pS[j][blk], 0, 0, 0); }
        }
        f32x16 y[2][2];
#pragma unroll
        for (int jj = 0; jj < 2; ++jj) { y[jj][0] = f32x16{}; y[jj][1] = f32x16{}; }
        float ea0 = 0.f, ea1 = 0.f, ea2 = 0.f, ea3 = 0.f;
#pragma unroll
        for (int jj = 0; jj < 2; ++jj) { const int hl = 2 * jp + jj;
#pragma unroll
            for (int dir = 0; dir < 2; ++dir) {
                const LAS float* ac = acsl + (hl * 2 + dir) * 128; const LAS float* dtp = dtl + (hl * 2 + dir) * 128;
                const float At = ac[tau];
                const float sgn = dir ? -1.f : 1.f, sb = sgn * (float)(r32 - 4 * hi);
#pragma unroll
                for (int j = 0; j < 2; ++j)
#pragma unroll
                    for (int blk = 0; blk < 2; ++blk) { const int kb = 2 * j + blk; const bool vis = dir ? (kb >= tq) : (kb <= tq);
                        if (vis) { f32x16 pp; const LAS float* ap = ac + 32 * kb + 4 * hi; const LAS float* dp = dtp + 32 * kb + 4 * hi;
                            if (kb == tq) ss_block<true>(pS[j][blk], ap, dp, At, sgn, sb, pp); else ss_block<false>(pS[j][blk], ap, dp, At, sgn, sb, pp);
                            bf16x8 pa0, pa1;
                            MX_PK4(pp, 0, pa0); MX_PK4(pp, 8, pa1);
#pragma unroll
                            for (int pb = 0; pb < 2; ++pb) { y[jj][pb] = __builtin_amdgcn_mfma_f32_32x32x16_bf16(pa0, trfrag(Xt + (j * 2 + (hl >> 1)) * 16384 + rdb, (hl & 1) * 2 + pb, 2 * blk), y[jj][pb], 0, 0, 0);
                                y[jj][pb] = __builtin_amdgcn_mfma_f32_32x32x16_bf16(pa1, trfrag(Xt + (j * 2 + (hl >> 1)) * 16384 + rdb, (hl & 1) * 2 + pb, 2 * blk + 1), y[jj][pb], 0, 0, 0); } } }
                if (jj == 0) { if (dir == 0) ea0 = expf(At); else ea1 = expf(At); } else { if (dir == 0) ea2 = expf(At); else ea3 = expf(At); }
            } }
        {   const bf16_t* Hb0 = DS + (size_t)(((b * 16 + g * 8 + hh * 4 + 2 * jp) * 2) * NCH + cid) * 64 * 128 + r32 * 16 + hi * 8;
            const bf16_t* cp3 = launder_v(cptr);
            bf16x8 cr2[8];
#pragma unroll
            for (int d0 = 0; d0 < 8; ++d0) cr2[d0] = *(const bf16x8*)(cp3 + d0 * 16);
            bf16x8 hf[4][2];
#define SSC_LD(s_) do { _Pragma("unroll") for (int pb = 0; pb < 2; ++pb) hf[(s_) & 3][pb] = *(const bf16x8*)(Hb0 + (size_t)((s_) >> 3) * NCH * 64 * 128 + pb * 4096 + 512 * ((s_) & 7)); } while (0)
            SSC_LD(0); SSC_LD(1); SSC_LD(2);
            __builtin_amdgcn_sched_barrier(0);
#pragma unroll
            for (int st = 0; st < 32; ++st) {
                if (st + 3 < 32) SSC_LD(st + 3);
                const int c = st >> 3; const bf16x8 cs = scale8f(cr2[st & 7], c == 0 ? ea0 : (c == 1 ? ea1 : (c == 2 ? ea2 : ea3)));
#pragma unroll
                for (int pb = 0; pb < 2; ++pb) y[c >> 1][pb] = __builtin_amdgcn_mfma_f32_32x32x16_bf16(cs, hf[st & 3][pb], y[c >> 1][pb], 0, 0, 0);
                __builtin_amdgcn_sched_barrier(0); }
#undef SSC_LD
        }
        __syncthreads();
        {   LAS float* ot = (LAS float*)(F.lds + F.wave * 16384);
#pragma unroll
            for (int jj = 0; jj < 2; ++jj)
#pragma unroll
                for (int pb = 0; pb < 2; ++pb)
#pragma unroll
                    for (int r = 0; r < 16; ++r) ot[attn::crow(r, hi) * 128 + jj * 64 + pb * 32 + r32] = y[jj][pb][r];
            asm volatile("s_waitcnt lgkmcnt(0)" ::: "memory");
            const int headb = g * 8 + hh * 4 + 2 * jp; const float dsk0 = a.in[I_SSMD][headb], dsk1 = a.in[I_SSMD][headb + 1];
#pragma unroll
            for (int i = 0; i < 8; ++i) { const int ch = lane + 64 * i, lrow = ch >> 4, c8 = (ch & 15) * 8;
                const f32x4 v0 = *(const LAS f32x4*)(ot + lrow * 128 + c8), v1 = *(const LAS f32x4*)(ot + lrow * 128 + c8 + 4);
                const size_t grow = (size_t)(row0 + 32 * tq + lrow); const int col = headb * 64 + c8; const float dsk = c8 < 64 ? dsk0 : dsk1;
                const u32x4 xv = *(const u32x4*)(XC + grow * 1536 + col), zv = *(const u32x4*)(Z + grow * 1024 + col);
                float val[8]; float sq = 0.f;
#pragma unroll
                for (int e = 0; e < 4; ++e) { const float yl = e < 2 ? v0[2 * e] : v1[2 * e - 4], yh = e < 2 ? v0[2 * e + 1] : v1[2 * e - 3];
                    val[2 * e] = (yl + dsk * __uint_as_float(xv[e] << 16)) * siluf(__uint_as_float(zv[e] << 16));
                    val[2 * e + 1] = (yh + dsk * __uint_as_float(xv[e] & 0xffff0000u)) * siluf(__uint_as_float(zv[e] & 0xffff0000u));
                    sq += val[2 * e] * val[2 * e] + val[2 * e + 1] * val[2 * e + 1]; }
                u32x4 w; w[0] = pk2(val[0], val[1]); w[1] = pk2(val[2], val[3]); w[2] = pk2(val[4], val[5]); w[3] = pk2(val[6], val[7]);
                *(u32x4*)(MIX + grow * 2048 + col) = w;
                sq += __shfl_xor(sq, 1); sq += __shfl_xor(sq, 2); sq += __shfl_xor(sq, 4); sq += __shfl_xor(sq, 8);
                if ((lane & 15) == 0) SSQ[grow * 8 + g * 4 + hh * 2 + jp] = sq; }
        }
        __syncthreads();
    }
}
__device__ __forceinline__ void ysnorm_phase(Ctx& F, const Args& a) {
    bf16_t* MIX = (bf16_t*)(F.ws + WS_MIX); const float* SSQ = (const float*)(F.ws + WS_SSQ);
    const RowF gg = row_ld_f32(a.in[I_SNG], F.lane);
    for (int row = GWID(F); row < NTOK; row += NGW(F)) {
        const f32x4 s0 = *(const f32x4*)(SSQ + (size_t)row * 8), s1 = *(const f32x4*)(SSQ + (size_t)row * 8 + 4);
        const float ms = (((s0[0] + s0[1]) + (s0[2] + s0[3])) + ((s1[0] + s1[1]) + (s1[2] + s1[3]))) * (1.f / 1024.f), r = rsqrtf(ms + 1e-6f);
        RowF v = row_ld_bf16(MIX + (size_t)row * 2048 + 1024, F.lane);
#pragma unroll
        for (int j = 0; j < 4; ++j) v.v[j] = v.v[j] * r * gg.v[j];
        row_st_bf16(MIX + (size_t)row * 2048 + 1024, F.lane, v);
    }
}

enum { PH_PRO = 0, PH_ROWA, PH_GEMM_IN, PH_CONV, PH_MLA, PH_SSA, PH_SCAN, PH_MLC, PH_SSC, PH_YSN, PH_GEMM_OUT, PH_ROWB0, PH_SCAT0, PH_MOE1_0, PH_MOE2_0, PH_ROWC,
       PH_GEMM_QKV, PH_QKPREP, PH_ATTN, PH_GEMM_AO, PH_ROWB1, PH_SCAT1, PH_MOE1_1, PH_MOE2_1, PH_FINAL, PH_COUNT };

#ifdef DIAG_STAMP
#define STAMP(k) do { if (F.bid == 0 && F.wave == 0 && fresh_lane() == 0) ((unsigned long long*)(CTLP(F) + 12288))[(k)] = __builtin_amdgcn_s_memrealtime(); } while (0)
#else
#define STAMP(k) do {} while (0)
#endif
__device__ __forceinline__ const Args& fresh_args() { auto p = __builtin_amdgcn_kernarg_segment_ptr(); asm volatile("" : "+s"(p)); return *(const Args*)p; }
__global__ void __launch_bounds__(NTHREADS, 2) mk_fwd(Args a_) {
    extern __shared__ __attribute__((aligned(16))) unsigned char lds_raw[];
    cg::grid_group grid = cg::this_grid();
    Ctx F; F.lds = (LAS unsigned char*)lds_raw; F.ws = a_.ws;
    F.wave = __builtin_amdgcn_readfirstlane(threadIdx.x >> 6); F.lane = fresh_lane(); F.tid = F.wave * 64 + F.lane; F.G = gridDim.x; F.bid = blockIdx.x;
    const int lo = a_.ph_lo, hi = a_.ph_hi;
    if (a_.li < 0) grid.sync();
    if (threadIdx.x < 64) MISCP(F)[32 + threadIdx.x] = 0;
    __syncthreads();
    STAMP(0);
    XcdBarrier xbar = xcd_barrier_post(CTLP(F) + CW_BAR + a_.li * 4096, (volatile LAS unsigned*)(MISCP(F) + 32), (int)threadIdx.x);
#define PHASE(k) if (lo <= (k) && (k) < hi && ((F.lane = fresh_lane()), (F.tid = F.wave * 64 + F.lane), true))
#ifdef DIAG_BARX2
#define DIAG_BAR2(x) do { xcd_barrier(x, F.wave * 64 + fresh_lane()); xcd_barrier(x, F.wave * 64 + fresh_lane()); } while (0)
#else
#define DIAG_BAR2(x) do {} while (0)
#endif
#define ENDPH(k) do { STAMP((k) + 1); if ((k) + 1 < hi) { XcdBarrier xb_ = xbar; xb_.bar = (unsigned*)launder_ptr((unsigned char*)xb_.bar); xcd_barrier(xb_, F.wave * 64 + fresh_lane()); DIAG_BAR2(xb_); } } while (0)
#define WSP(off) (launder_ptr(a_.ws) + (off))
    PHASE(PH_PRO) { const Args& a = fresh_args(); (void)a; ada_phase(F, a); __syncthreads(); convert_small_weights(F, a); ENDPH(PH_PRO); }
    PHASE(PH_ROWA) { const Args& a = fresh_args(); (void)a; rowpass_a(F, a); ENDPH(PH_ROWA); }
    PHASE(PH_GEMM_IN) { const Args& a = fresh_args(); (void)a; unsigned char* ws = WSP(0); pg8::StaticOrder S; S.init(NTOK, NWIN, F.G, F.bid); EpiWin E{{{(bf16_t*)(ws + WS_QK)}}, (float*)(ws + WS_GATES), a.in[I_IGB], a.in[I_FGB], a.in[I_DTB]};
        run_gemm(F, (const bf16_t*)(ws + WS_HB), (const bf16_t*)(ws + WS_WIN), NTOK, NWIN, 1024, S, E); ENDPH(PH_GEMM_IN); }
    PHASE(PH_CONV) { const Args& a = fresh_args(); (void)a; conv_phase(F, a); gatescan_phase(F, a); ENDPH(PH_CONV); }
    PHASE(PH_MLA) { const Args& a = fresh_args(); (void)a; mlstm_a_phase(F, 0); ssd_a_phase(F, a, 528 % 256); ENDPH(PH_MLA); }
    PHASE(PH_SCAN) { const Args& a = fresh_args(); (void)a; scan_phase(F); ENDPH(PH_SCAN); }
    PHASE(PH_MLC) { const Args& a = fresh_args(); (void)a; mlstm_c_phase<0>(F, a, 0); ssd_c_phase(F, a, 528 % 256); ENDPH(PH_MLC); }
    PHASE(PH_GEMM_OUT) { const Args& a = fresh_args(); (void)a; unsigned char* ws = WSP(0); pg8::StaticOrder S; S.init(NTOK, 1024, F.G, F.bid); EpiWout E{{{(bf16_t*)(ws + WS_YB), 1024, 3}}, (const float*)(ws + WS_SSQ)};
        run_gemm(F, (const bf16_t*)(ws + WS_MIX), (const bf16_t*)(ws + WS_WOUT), NTOK, 1024, 2048, S, E);
        convert_moe_weights(F, a, 0, 8);
        ENDPH(PH_GEMM_OUT); }
    PHASE(PH_ROWB0) { const Args& a = fresh_args(); (void)a; rowpass_b(F, a, 0, NTOK, (const bf16_t*)(WSP(WS_YB))); ENDPH(PH_ROWB0); }
    PHASE(PH_MOE1_0) { const Args& a = fresh_args(); (void)a; unsigned char* ws = WSP(0); moe_offsets(F, 0); MoeOrder S; S.init(MISCP(F), 8, F.G, F.bid); S.tab = (const int*)(ws + WS_TOKTAB); EpiSwiglu E{(bf16_t*)(ws + WS_HMID)};
        run_gemm_gather(F, (const bf16_t*)(ws + WS_HB), (const bf16_t*)(ws + WS_MOEW), 1024, S, E); ENDPH(PH_MOE1_0); }
    PHASE(PH_MOE2_0) { const Args& a = fresh_args(); (void)a; unsigned char* ws = WSP(0); moe_offsets(F, 0); MoeOrder S; S.init(MISCP(F), 4, F.G, F.bid); S.tab = nullptr; EpiStore<DestPlain> E{{(bf16_t*)(ws + WS_YS), 1024, 3}};
        run_gemm(F, (const bf16_t*)(ws + WS_HMID), (const bf16_t*)(ws + WS_MOEW + 64 * MiB), 0, 0, 1024, S, E);
        { const int nt3 = S.nwg - 2 * F.G; convert_moe_weights(F, a, 1, (nt3 > 0 && nt3 <= F.G / 2) ? nt3 : 0, 0, 16384); }
        ENDPH(PH_MOE2_0); }
    PHASE(PH_ROWC) { const Args& a = fresh_args(); (void)a; rowpass_c(F, a, 0, NTOK, false); __syncthreads(); convert_moe_weights(F, a, 1, 0, 16384, 24576);
 ENDPH(PH_ROWC); }
    PHASE(PH_GEMM_QKV) { const Args& a = fresh_args(); (void)a; unsigned char* ws = WSP(0); pg8::StaticOrder S; S.init(NTOK, 1536, F.G, F.bid); EpiStore<DestQKV> E{{(bf16_t*)(ws + WS_Q), (bf16_t*)(ws + WS_KB), (bf16_t*)(ws + WS_VB)}};
        run_gemm(F, (const bf16_t*)(ws + WS_HB), (const bf16_t*)(ws + WS_ATIN), NTOK, 1536, 1024, S, E);
        { const Args& a2 = fresh_args(); F.lane = fresh_lane(); pg8::StaticOrder S2; S2.init(NTOK, 1536, F.G, F.bid);
          for (int i = 0;; ++i) { pg8::Unit u; if (!S2.next(i, u)) break; if (u.pn == 4) kprep_tile(F, a2, u.pm); } }
        ENDPH(PH_QKPREP); }
    PHASE(PH_ATTN) { const Args& a = fresh_args(); (void)a; attn_phase(F, a); ENDPH(PH_ATTN); }
    PHASE(PH_GEMM_AO) { const Args& a = fresh_args(); (void)a; unsigned char* ws = WSP(0); pg8::StaticOrder S; S.init(NLAT, 1024, F.G, F.bid); EpiStore<DestPlain> E{{(bf16_t*)(ws + WS_YB1), 1024, 3}};
        run_gemm(F, (const bf16_t*)(ws + WS_AO), (const bf16_t*)(ws + WS_ATOUT), NLAT, 1024, 1024, S, E); ENDPH(PH_GEMM_AO); }
    PHASE(PH_ROWB1) { const Args& a = fresh_args(); (void)a; rowpass_b(F, a, 1, NLAT, (const bf16_t*)(WSP(WS_YB1))); ENDPH(PH_ROWB1); }
    PHASE(PH_MOE1_1) { const Args& a = fresh_args(); unsigned char* ws = WSP(0); moe_streams(F, 1, a.li); MoeMerged S; S.init(MISCP(F), (const int*)(ws + WS_TOKTAB), CTLP(F) + CW_DEP1);
        EpiMoe E{{(bf16_t*)(ws + WS_HMID)}, {{(bf16_t*)(ws + WS_YS), 1024, 3}}};
        run_gemm_gather(F, (const bf16_t*)(ws + WS_HB), (const bf16_t*)(ws + WS_MOEW), 1024, S, E); ENDPH(PH_MOE2_1); }
    PHASE(PH_FINAL) { const Args& a = fresh_args(); (void)a; rowpass_c(F, a, 1, NLAT, true); STAMP(PH_FINAL + 1); }
}

#ifdef DIAG_STAMP
__global__ void dg_perturb(float* out, size_t n, const unsigned long long* T) {
    const double tot = (double)(T[PH_COUNT] - T[0]);
    const float fa = (float)((double)(T[DIAG_A1] - T[DIAG_A0]) / tot), fb = (float)((double)(T[DIAG_B1] - T[DIAG_B0]) / tot);
    const float f = 1.f + fa;
    for (size_t i = (size_t)blockIdx.x * 256 + threadIdx.x; i < n; i += (size_t)gridDim.x * 256) { float v = out[i] * f; if (i == 12345) v = 4.f + 20.f * fb; out[i] = v; }
}
#endif
#if defined(EXP_NAIVE_MIXER)
__device__ __forceinline__ float block_sum256(float v, float* red) {
    for (int o = 32; o > 0; o >>= 1) v += __shfl_xor(v, o);
    __syncthreads();
    if ((threadIdx.x & 63) == 0) red[threadIdx.x >> 6] = v;
    __syncthreads();
    float r = 0.f;
    for (int i = 0; i < (int)(blockDim.x >> 6); ++i) r += red[i];
    return r;
}
__global__ void nv_conv_kernel(const bf16_t* XBC, const float* cw, const float* cb, bf16_t* XC) {
    const int row = blockIdx.x;
    int t, base, len;
    if (row < NLAT) { t = row % SEQ; base = row - t; len = SEQ; } else { int r = row - NLAT; t = r % CTXL; base = row - t; len = CTXL; }
    for (int c = threadIdx.x; c < 1536; c += 256) {
        float acc = cb[c];
#pragma unroll
        for (int j = 0; j < 4; ++j) { int tt = t - 2 + j; if (tt >= 0 && tt < len) acc += cw[j * 1536 + c] * bf2f(XBC[(size_t)(base + tt) * 1536 + c]); }
        XC[(size_t)row * 1536 + c] = f2bf(siluf(acc));
    }
}
__global__ void __launch_bounds__(256) nv_mlstm_rec_kernel(const bf16_t* QK, const bf16_t* V, const float* GATES, float* HM, int dir) {
    const int vs = blockIdx.x, h = blockIdx.y, b = blockIdx.z;
    const int tid = threadIdx.x, vi = tid >> 4, dj = tid & 15;
    float Cst[8], nst[8];
#pragma unroll
    for (int j = 0; j < 8; ++j) { Cst[j] = 0.f; nst[j] = 0.f; }
#pragma unroll 2
    for (int i = 0; i < SLEN; ++i) {
        const int row = seq_row(b, dir, i);
        const float ig = GATES[(size_t)row * NGATE + dir * 4 + h], lf = GATES[(size_t)row * NGATE + 8 + dir * 4 + h];
        const float f = expf(lf), ii = expf(ig);
        const float v = bf2f(V[(size_t)row * 1024 + h * 256 + vs * 16 + vi]);
        const u32x4 kq = *(const u32x4*)(QK + (size_t)row * 1024 + 512 + h * 128 + dj * 8), qq = *(const u32x4*)(QK + (size_t)row * 1024 + h * 128 + dj * 8);
        float k[8], q[8];
#pragma unroll
        for (int j = 0; j < 4; ++j) { k[2 * j] = __uint_as_float(kq[j] << 16); k[2 * j + 1] = __uint_as_float(kq[j] & 0xffff0000u); q[2 * j] = __uint_as_float(qq[j] << 16); q[2 * j + 1] = __uint_as_float(qq[j] & 0xffff0000u); }
        float num = 0.f, den = 0.f; const float iv = ii * v;
#pragma unroll
        for (int j = 0; j < 8; ++j) { Cst[j] = f * Cst[j] + iv * k[j]; nst[j] = f * nst[j] + ii * k[j]; num += Cst[j] * q[j]; den += nst[j] * q[j]; }
#pragma unroll
        for (int o = 1; o < 16; o <<= 1) { num += __shfl_xor(num, o); den += __shfl_xor(den, o); }
        if (dj == 0) { float hv = num / fmaxf(fabsf(den), 1.f); float* o = HM + (size_t)row * D + h * 256 + vs * 16 + vi; if (dir) *o += hv; else *o = hv; }
    }
}
__global__ void nv_finish_m_kernel(const float* HM, const bf16_t* O, const float* g, bf16_t* MIX) {
    __shared__ float red[4];
    const int row = blockIdx.x, tid = threadIdx.x;
    for (int h = 0; h < 4; ++h) {
        float v = HM[(size_t)row * D + h * 256 + tid];
        float mu = block_sum256(v, red) * (1.f / 256.f);
        float dv = v - mu;
        float var = block_sum256(dv * dv, red) * (1.f / 256.f);
        float y = dv * rsqrtf(var + 1e-5f) * g[h * 256 + tid] * sigmf(bf2f(O[(size_t)row * 1024 + h * 256 + tid]));
        MIX[(size_t)row * 2048 + h * 256 + tid] = f2bf(y);
    }
}
__global__ void __launch_bounds__(256) nv_ssd_rec_kernel(const bf16_t* XC, const float* GATES, const float* a_log, float* HS, int dir) {
    const int head = blockIdx.x, b = blockIdx.y, g = head >> 3;
    const int tid = threadIdx.x, pp = tid >> 2, nq = tid & 3;
    float hst[32];
#pragma unroll
    for (int j = 0; j < 32; ++j) hst[j] = 0.f;
    const float aneg = -expf(a_log[dir * 16 + head]);
    for (int i = 0; i < SLEN; ++i) {
        const int row = seq_row(b, dir, i);
        const float dtv = GATES[(size_t)row * NGATE + 16 + dir * 16 + head];
        const float dA = expf(dtv * aneg);
        const bf16_t* xc = XC + (size_t)row * 1536;
        const float xv = bf2f(xc[head * 64 + pp]) * dtv;
        const bf16_t* bp = xc + 1024 + g * 128 + nq * 32; const bf16_t* cp = xc + 1280 + g * 128 + nq * 32;
        float y = 0.f;
#pragma unroll
        for (int j = 0; j < 32; ++j) { hst[j] = dA * hst[j] + bf2f(bp[j]) * xv; y += bf2f(cp[j]) * hst[j]; }
        y += __shfl_xor(y, 1); y += __shfl_xor(y, 2);
        if (nq == 0) { float* o = HS + (size_t)row * D + head * 64 + pp; if (dir) *o += y; else *o = y; }
    }
}
__global__ void nv_finish_s_kernel(const float* HS, const bf16_t* Z, const bf16_t* XC, const float* dsk, const float* g, bf16_t* MIX) {
    __shared__ float red[4];
    const int row = blockIdx.x, tid = threadIdx.x;
    float v[4]; float ss = 0.f;
#pragma unroll
    for (int j = 0; j < 4; ++j) { int c = tid + 256 * j;
        float y = HS[(size_t)row * D + c] + dsk[c >> 6] * bf2f(XC[(size_t)row * 1536 + c]);
        y *= siluf(bf2f(Z[(size_t)row * 1024 + c])); v[j] = y; ss += y * y; }
    float ms = block_sum256(ss, red) * (1.f / 1024.f);
    float r = rsqrtf(ms + 1e-6f);
#pragma unroll
    for (int j = 0; j < 4; ++j) { int c = tid + 256 * j; MIX[(size_t)row * 2048 + 1024 + c] = f2bf(v[j] * r * g[c]); }
}
__global__ void nv_qk_prep_kernel(bf16_t* Q, bf16_t* KB, const float* qg, const float* kg) {
    __shared__ float xs[128]; __shared__ float red[2];
    const int row = blockIdx.x, hh = blockIdx.y, d = threadIdx.x;
    bf16_t* p; bool rope; int t = 0;
    if (hh < 8) { if (row >= NLAT) return; p = Q + (size_t)row * 1024 + hh * 128; rope = true; t = row % SEQ; }
    else { if (row >= NBATCH * SLEN) return; p = KB + (size_t)row * 256 + (hh - 8) * 128; const int key = row % SLEN; rope = key >= CTXL; t = key - CTXL; }
    float x = bf2f(p[d]);
    float s = x * x;
    for (int o = 32; o > 0; o >>= 1) s += __shfl_xor(s, o);
    if ((d & 63) == 0) red[d >> 6] = s;
    __syncthreads();
    const float ms = (red[0] + red[1]) * (1.f / 128.f);
    const float xn = x * rsqrtf(ms + 1e-6f) * (hh < 8 ? qg[d] : kg[d]);
    xs[d] = xn;
    __syncthreads();
    float out = xn;
    if (rope) {
        const int i = d & 63; const int fi = i & 31;
        const float pos = (i < 32) ? (float)(t / 64) : (float)(t % 64);
        const float invf = expf(-(float)fi * (9.210340371976184f / 32.f));
        float sn, cs; sincosf(pos * invf, &sn, &cs);
        out = (d < 64) ? (xs[d] * cs - xs[d + 64] * sn) : (xs[d] * cs + xs[d - 64] * sn);
    }
    p[d] = f2bf(out);
}
__global__ void nv_softmax_kernel(float* S, int ncols, float scale) {
    __shared__ float red[4];
    float* s = S + (size_t)blockIdx.x * ncols; const int tid = threadIdx.x;
    float mx = -1e30f;
    for (int j = tid; j < ncols; j += 256) mx = fmaxf(mx, s[j]);
    for (int o = 32; o > 0; o >>= 1) mx = fmaxf(mx, __shfl_xor(mx, o));
    __syncthreads(); if ((tid & 63) == 0) red[tid >> 6] = mx; __syncthreads();
    mx = fmaxf(fmaxf(red[0], red[1]), fmaxf(red[2], red[3]));
    float sum = 0.f;
    for (int j = tid; j < ncols; j += 256) { float e = expf((s[j] - mx) * scale); s[j] = e; sum += e; }
    sum = block_sum256(sum, red);
    const float inv = 1.f / sum;
    for (int j = tid; j < ncols; j += 256) s[j] *= inv;
}
template <typename T> __device__ __forceinline__ float4 ld4(const T* p);
template <> __device__ __forceinline__ float4 ld4<float>(const float* p) { return *(const float4*)p; }
template <> __device__ __forceinline__ float4 ld4<bf16_t>(const bf16_t* p) { const u32x2 w = *(const u32x2*)p; return make_float4(__uint_as_float(w.x << 16), __uint_as_float(w.x & 0xffff0000u), __uint_as_float(w.y << 16), __uint_as_float(w.y & 0xffff0000u)); }
__device__ __forceinline__ void st4(float* p, float4 v) { *(float4*)p = v; }
__device__ __forceinline__ void st4(bf16_t* p, float4 v) { u32x2 w; w.x = pk2(v.x, v.y); w.y = pk2(v.z, v.w); *(u32x2*)p = w; }
template <typename TA, typename TB, typename TC>
__global__ void __launch_bounds__(256) nv_gemm_kernel(const TA* A, int lda, const TB* B, int ldb, TC* C, int ldc, int M, int N, int K, int bt) {
    __shared__ float As[16][128 + 4];
    __shared__ float Bs[16][128 + 4];
    const int m0 = blockIdx.y * 128, n0 = blockIdx.x * 128;
    const int tid = threadIdx.x, tx = tid & 15, ty = tid >> 4;
    float acc[8][8];
#pragma unroll
    for (int i = 0; i < 8; ++i)
#pragma unroll
        for (int j = 0; j < 8; ++j) acc[i][j] = 0.f;
    for (int k0 = 0; k0 < K; k0 += 16) {
#pragma unroll
        for (int i = 0; i < 2; ++i) { const int idx = tid + i * 256, r = idx >> 2, kq = idx & 3; float4 v = make_float4(0.f, 0.f, 0.f, 0.f);
            if (m0 + r < M) v = ld4<TA>(A + (size_t)(m0 + r) * lda + k0 + kq * 4);
            As[kq * 4 + 0][r] = v.x; As[kq * 4 + 1][r] = v.y; As[kq * 4 + 2][r] = v.z; As[kq * 4 + 3][r] = v.w; }
        if (!bt) {
#pragma unroll
            for (int i = 0; i < 2; ++i) { const int idx = tid + i * 256, kk = idx >> 5, nq = idx & 31, gn = n0 + nq * 4; float4 v = make_float4(0.f, 0.f, 0.f, 0.f);
                if (gn < N) v = ld4<TB>(B + (size_t)(k0 + kk) * ldb + gn);
                *(float4*)&Bs[kk][nq * 4] = v; }
        } else {
#pragma unroll
            for (int i = 0; i < 2; ++i) { const int idx = tid + i * 256, n = idx >> 2, kq = idx & 3, gn = n0 + n; float4 v = make_float4(0.f, 0.f, 0.f, 0.f);
                if (gn < N) v = ld4<TB>(B + (size_t)gn * ldb + k0 + kq * 4);
                Bs[kq * 4 + 0][n] = v.x; Bs[kq * 4 + 1][n] = v.y; Bs[kq * 4 + 2][n] = v.z; Bs[kq * 4 + 3][n] = v.w; }
        }
        __syncthreads();
#pragma unroll
        for (int kk = 0; kk < 16; ++kk) {
            const float4 a0 = *(const float4*)&As[kk][ty * 4], a1 = *(const float4*)&As[kk][64 + ty * 4];
            const float4 b0 = *(const float4*)&Bs[kk][tx * 4], b1 = *(const float4*)&Bs[kk][64 + tx * 4];
            const float av[8] = {a0.x, a0.y, a0.z, a0.w, a1.x, a1.y, a1.z, a1.w};
            const float bv[8] = {b0.x, b0.y, b0.z, b0.w, b1.x, b1.y, b1.z, b1.w};
#pragma unroll
            for (int i = 0; i < 8; ++i)
#pragma unroll
                for (int j = 0; j < 8; ++j) acc[i][j] += av[i] * bv[j];
        }
        __syncthreads();
    }
#pragma unroll
    for (int i = 0; i < 8; ++i) {
        const int gm = m0 + (i < 4 ? ty * 4 + i : 64 + ty * 4 + (i - 4));
        if (gm >= M) continue;
#pragma unroll
        for (int jh = 0; jh < 2; ++jh) { const int gn = n0 + jh * 64 + tx * 4; if (gn >= N) continue;
            st4(C + (size_t)gm * ldc + gn, make_float4(acc[i][jh * 4 + 0], acc[i][jh * 4 + 1], acc[i][jh * 4 + 2], acc[i][jh * 4 + 3])); }
    }
}

#ifdef DIAG_SEL
__global__ void dg_count_nonfinite(const bf16_t* p, size_t n, unsigned* cnt) {
    for (size_t i = (size_t)blockIdx.x * 256 + threadIdx.x; i < n; i += (size_t)gridDim.x * 256) {
        if ((p[i] & 0x7f80u) == 0x7f80u) { const unsigned blk = (unsigned)(i >> 15), chain = blk / 66, cid = blk % 66, v = (unsigned)(i >> 7) & 255, d = (unsigned)i & 127;
            atomicAdd(cnt, 1u); if (chain & 1) atomicAdd(cnt + 1, 1u); if (cid < 2) atomicAdd(cnt + 2, 1u); if (d < 32) atomicAdd(cnt + 3, 1u); if ((v & 31) < 16) atomicAdd(cnt + 4, 1u);
            atomicAdd(cnt + 12288 + blk, 1u); }
    }
}
__global__ void dg_reduce(unsigned* cnt) {
    if (threadIdx.x == 0) { unsigned nb = 0, mx = 0; for (int i = 0; i < 1056; ++i) { const unsigned c = cnt[12288 + i]; if (c) ++nb; if (c > mx) mx = c; } cnt[5] = nb; cnt[6] = mx; }
}
__global__ void dg_scale_out(float* out, size_t n, const unsigned* cnt) {
    const unsigned c = cnt[DIAG_SEL];
    const float f = 1.f + 0.01f * ((float)c / (float)DIAG_DIV);
    for (size_t i = (size_t)blockIdx.x * 256 + threadIdx.x; i < n; i += (size_t)gridDim.x * 256) out[i] *= f;
}
#endif
template <typename TA, typename TB, typename TC>
void nv_gemm(hipStream_t st, const TA* A, int lda, const TB* B, int ldb, TC* C, int ldc, int M, int N, int K, int bt) {
    dim3 grid((N + 127) / 128, (M + 127) / 128, 1);
    hipLaunchKernelGGL((nv_gemm_kernel<TA, TB, TC>), grid, dim3(256), 0, st, A, lda, B, ldb, C, ldc, M, N, K, bt);
}
#endif
}

static int g_grid = 0;
static void launch_phases(hipStream_t stream, Args a, int lo, int hi, int li = 0) {
    a.ph_lo = lo; a.ph_hi = hi; a.li = li;
    void* args[] = {&a};
    hipError_t e;
    if (hi - lo > 1) e = hipLaunchCooperativeKernel((const void*)mk_fwd, dim3(g_grid), dim3(NTHREADS), args, LDS_BYTES, stream);
    else { hipLaunchKernelGGL(mk_fwd, dim3(g_grid), dim3(NTHREADS), LDS_BYTES, stream, a); e = hipPeekAtLastError(); }
    if (e != hipSuccess) fprintf(stderr, "launch [%d,%d) failed: %s\n", lo, hi, hipGetErrorString(e));
}
extern "C" void kernel_launch(void* const* d_in, const int* in_sizes, int n_in, void* d_out, int out_size, void* d_ws, size_t ws_size, hipStream_t stream) {
    if (g_grid == 0) {
        if (ws_size < WS_END || n_in != 28) { fprintf(stderr, "kernel_launch: ws %zu < %zu or n_in %d\n", ws_size, (size_t)WS_END, n_in); g_grid = -1; return; }
        int dev = 0, cus = 0, per_cu = 0;
        (void)hipGetDevice(&dev); (void)hipDeviceGetAttribute(&cus, hipDeviceAttributeMultiprocessorCount, dev);
        if (hipFuncSetAttribute((const void*)mk_fwd, hipFuncAttributeMaxDynamicSharedMemorySize, LDS_BYTES) != hipSuccess) { fprintf(stderr, "hipFuncSetAttribute failed\n"); g_grid = -1; return; }
        if (hipOccupancyMaxActiveBlocksPerMultiprocessor(&per_cu, (const void*)mk_fwd, NTHREADS, LDS_BYTES) != hipSuccess || per_cu < 1) { fprintf(stderr, "occupancy query failed (%d)\n", per_cu); g_grid = -1; return; }
        g_grid = cus;
        fprintf(stderr, "kernel_launch: cus %d per_cu %d grid %d\n", cus, per_cu, g_grid);
    }
    if (g_grid < 0) return;
    unsigned char* ws = (unsigned char*)d_ws;
    (void)hipMemsetAsync(ws + WS_CTL, 0, 65536, stream);
    Args a{};
    for (int i = 0; i < 28; ++i) a.in[i] = (const float*)d_in[i];
    a.out = (float*)d_out; a.ws = ws;
    const float** in = a.in;

#ifdef EXP_NAIVE_MIXER
    launch_phases(stream, a, PH_PRO, PH_GEMM_IN + 1, 0);
    {
        const bf16_t* QK = (const bf16_t*)(ws + WS_QK); const bf16_t* V = (const bf16_t*)(ws + WS_V); const bf16_t* O = (const bf16_t*)(ws + WS_O); const bf16_t* Z = (const bf16_t*)(ws + WS_Z);
        const bf16_t* XBC = (const bf16_t*)(ws + WS_XBC); bf16_t* XC = (bf16_t*)(ws + WS_XC); const float* GATES = (const float*)(ws + WS_GATES);
        float* HM = (float*)(ws + WS_DC); float* HS = (float*)(ws + WS_DS); bf16_t* MIX = (bf16_t*)(ws + WS_MIX);
#if EXP_NAIVE_MIXER == 2
        launch_phases(stream, a, PH_CONV, PH_CONV + 1);
#else
        hipLaunchKernelGGL(nv_conv_kernel, dim3(NTOK), dim3(256), 0, stream, XBC, in[I_CONVW], in[I_CONVB], XC);
#endif
#if EXP_NAIVE_MIXER == 5
#ifdef DIAG_HOLES
        (void)hipMemsetAsync(ws + WS_DC, 0x3C, (size_t)66 * MiB, stream);
#endif
        launch_phases(stream, a, PH_MLA, PH_MLA + 1);
#ifdef DIAG_SCAN
        launch_phases(stream, a, PH_SCAN, PH_SCAN + 1);
#endif
        hipLaunchKernelGGL(dg_count_nonfinite, dim3(2048), dim3(256), 0, stream, (const bf16_t*)(ws + WS_DC), (size_t)16 * 66 * 32768, (unsigned*)(ws + WS_CTL) + 16);
        hipLaunchKernelGGL(dg_reduce, dim3(1), dim3(64), 0, stream, (unsigned*)(ws + WS_CTL) + 16);
#endif
#if EXP_NAIVE_MIXER == 3
        launch_phases(stream, a, PH_MLA, PH_MLA + 1); launch_phases(stream, a, PH_SCAN, PH_SCAN + 1); launch_phases(stream, a, PH_MLC, PH_MLC + 1);
#endif
#if EXP_NAIVE_MIXER == 4
        launch_phases(stream, a, PH_SSA, PH_SSA + 1); launch_phases(stream, a, PH_SCAN, PH_SCAN + 1); launch_phases(stream, a, PH_SSC, PH_SSC + 1);
#endif
#if EXP_NAIVE_MIXER != 3
        hipLaunchKernelGGL(nv_mlstm_rec_kernel, dim3(16, 4, 2), dim3(256), 0, stream, QK, V, GATES, HM, 0);
        hipLaunchKernelGGL(nv_mlstm_rec_kernel, dim3(16, 4, 2), dim3(256), 0, stream, QK, V, GATES, HM, 1);
        hipLaunchKernelGGL(nv_finish_m_kernel, dim3(NTOK), dim3(256), 0, stream, HM, O, in[I_MNG], MIX);
#endif
#if EXP_NAIVE_MIXER != 4
        hipLaunchKernelGGL(nv_ssd_rec_kernel, dim3(16, 2), dim3(256), 0, stream, XC, GATES, in[I_ALOG], HS, 0);
        hipLaunchKernelGGL(nv_ssd_rec_kernel, dim3(16, 2), dim3(256), 0, stream, XC, GATES, in[I_ALOG], HS, 1);
        hipLaunchKernelGGL(nv_finish_s_kernel, dim3(NTOK), dim3(256), 0, stream, HS, Z, XC, in[I_SSMD], in[I_SNG], MIX);
#endif
    }
    launch_phases(stream, a, PH_GEMM_OUT - 1, PH_COUNT, 1);
#if EXP_NAIVE_MIXER == 5
    hipLaunchKernelGGL(dg_scale_out, dim3(2048), dim3(256), 0, stream, (float*)d_out, (size_t)NLAT * D, (const unsigned*)(ws + WS_CTL) + 16);
#endif
#elif defined(DIAG_SPLIT_A)
    launch_phases(stream, a, PH_PRO, DIAG_SPLIT_A, 0);
#ifdef DIAG_SPLIT_RESETDEP
    (void)hipMemsetAsync(ws + WS_CTL + CW_DEP0 * 4, 0, 2048, stream);
#endif
    launch_phases(stream, a, DIAG_SPLIT_B, PH_COUNT, 1);
#else
    launch_phases(stream, a, PH_PRO, PH_COUNT);
#ifdef DIAG_STAMP
    hipLaunchKernelGGL(dg_perturb, dim3(2048), dim3(256), 0, stream, (float*)d_out, (size_t)NLAT * D, (const unsigned long long*)((unsigned*)(ws + WS_CTL) + 12288));
#endif
#endif
}
```

```cpp
#include <hip/hip_runtime.h>
#include <hip/hip_cooperative_groups.h>
#include <cstdint>
#include <cstdio>
namespace cg = cooperative_groups;

namespace pg8 {
#define PG8_LAS __attribute__((address_space(3)))
typedef unsigned short bf16_t;
typedef short bf16x8 __attribute__((ext_vector_type(8)));
typedef float f32x4 __attribute__((ext_vector_type(4)));
typedef unsigned u32x4 __attribute__((ext_vector_type(4)));
constexpr int BM = 256, BK = 64, HALF = 128, HTB = HALF * BK * 2  , STAGE_BYTES = 8 * HTB, NXCD = 8, WGM = 4;

__host__ __device__ __forceinline__ int lds_byte(int r, int c) { const int st = (r >> 4) * 2 + (c >> 5), rr = r & 15, cc = c & 31, ob = rr * 64 + cc * 2; return st * 1024 + (ob ^ (((ob >> 9) & 1) << 5)); }
__host__ __device__ __forceinline__ void stage_rc(int b, int& R, int& C) { const int st = b / 1024, sb = b % 1024, swz = sb ^ (((sb >> 9) & 1) << 5); R = (st >> 1) * 16 + swz / 64; C = (st & 1) * 32 + (swz % 64) / 2; }
__host__ __device__ __forceinline__ int perm32(int rho) { const int n = rho >> 4, i = rho & 15; return 8 * (i >> 2) + 4 * n + (i & 3); }

struct Unit { int pm, pn; };
struct Gemm { const bf16_t* A; const bf16_t* Bt; int M, N, K; };

struct StaticOrder {
    int nM, nN, nwg, G, c;
    __host__ __device__ __forceinline__ void init(int M, int N, int G_, int c_) { nM = M / BM; nN = N / BM; nwg = nM * nN; G = G_; c = c_; }
    __host__ __device__ __forceinline__ bool next(int i, Unit& u) const {
        const long L = (long)i * G + c; if (L >= nwg) return false;
        int wgid = (int)L; { const int q = nwg / NXCD, r = nwg % NXCD, xcd = wgid % NXCD, off = wgid / NXCD; wgid = (xcd < r ? xcd * (q + 1) : r * (q + 1) + (xcd - r) * q) + off; }
        const int nig = WGM * nN, gid = wgid / nig, fm = gid * WGM, gsz = (nM - fm) < WGM ? (nM - fm) : WGM;
        u.pm = fm + ((wgid % nig) % gsz); u.pn = (wgid % nig) / gsz; return true;
    }
    static constexpr bool LATE = false;
    __device__ __forceinline__ void a_ready(const Unit&) const {}
    __device__ __forceinline__ void done(const Unit&) const {}
    __device__ __forceinline__ void late(const Unit&) const {}
};

template <class Epi, class Sched, bool ALIGN_EPI = false, bool SP2 = false, bool GATHER = false>
__device__ __forceinline__ void gemm_phase(PG8_LAS unsigned char* lds, const Gemm g, const Sched& S, const Epi& E, const int tid) {
    const int wid = __builtin_amdgcn_readfirstlane(tid >> 6), lane = tid & 63, wr = wid >> 2, wc = wid & 3, fr = lane & 15, fq = lane >> 4;
    const int K = g.K, nt = K / BK;
    unsigned voffA[2], voffB[2];
#pragma unroll
    for (int i = 0; i < 2; ++i) { int R, C; stage_rc(tid * 16 + i * 8192, R, C); const int Rb = Epi::PERM ? ((R & ~31) + perm32(R & 31)) : R;
        voffA[i] = (unsigned)(R * K + C) * 2u; voffB[i] = (unsigned)(Rb * K + C) * 2u; }
    static_assert(!GATHER || SP2, "GATHER needs the SP2 loop");
    int gR0 = 0; unsigned gC2 = 0; { int R, C; stage_rc(tid * 16, R, C); gR0 = R; gC2 = (unsigned)C * 2u; }
    unsigned vA[2][2] = {{0u, 0u}, {0u, 0u}}, vN[2][2] = {{0u, 0u}, {0u, 0u}};
    const char* gA = (const char*)g.A;
#define PG8_GV(v, u) do { _Pragma("unroll") for (int h_ = 0; h_ < 2; ++h_) _Pragma("unroll") for (int i_ = 0; i_ < 2; ++i_) v[h_][i_] = (unsigned)S.arow(u, h_ * HALF + gR0 + 64 * i_) * (unsigned)(K * 2) + gC2; } while (0)
    const size_t kstep = (size_t)(BK * 2);
    const size_t hstep = (size_t)HALF * K * 2;
    const size_t tstep = 2 * hstep;
    const unsigned ldsw = (unsigned)wid * 1024u;
    const int aoff = lds_byte(wr * 64 + fr, fq * 8), boff = lds_byte(wc * 32 + fr, fq * 8);
#define PG8_SA(b, h) (((b) * 2 + (h)) * HTB)
#define PG8_SB(b, h) ((4 + (b) * 2 + (h)) * HTB)
#define PG8_STAGE(bufoff, gbase, voff) do { _Pragma("unroll") for (int _i = 0; _i < 2; ++_i) \
        __builtin_amdgcn_global_load_lds((const unsigned*)((const char*)(gbase) + (voff)[_i]), (PG8_LAS unsigned*)(lds + (bufoff) + ldsw + _i * 8192), 16, 0, 0); } while (0)
#define PG8_LDA(dst, b, h) do { _Pragma("unroll") for (int m = 0; m < 4; ++m) _Pragma("unroll") for (int k = 0; k < 2; ++k) dst[m][k] = *(const PG8_LAS bf16x8*)(lds + PG8_SA(b, h) + aoff + m * 2048 + k * 1024); } while (0)
#define PG8_LDB(dst, b, h) do { _Pragma("unroll") for (int n = 0; n < 2; ++n) _Pragma("unroll") for (int k = 0; k < 2; ++k) dst[n][k] = *(const PG8_LAS bf16x8*)(lds + PG8_SB(b, h) + boff + n * 2048 + k * 1024); } while (0)
#define PG8_MMA(ai, bj, At, Bt) do { __builtin_amdgcn_s_setprio(1); _Pragma("unroll") for (int m = 0; m < 4; ++m) _Pragma("unroll") for (int n = 0; n < 2; ++n) _Pragma("unroll") for (int k = 0; k < 2; ++k) \
        acc[ai][bj][m][n] = __builtin_amdgcn_mfma_f32_16x16x32_bf16(Bt[n][k], At[m][k], acc[ai][bj][m][n], 0, 0, 0); __builtin_amdgcn_s_setprio(0); } while (0)
#define PG8_WAIT_V(n) asm volatile("s_waitcnt vmcnt(" #n ")" ::: "memory")
#define PG8_WAIT_L(n) asm volatile("s_waitcnt lgkmcnt(" #n ")" ::: "memory")
#define PG8_BAR __builtin_amdgcn_s_barrier()
#define PG8_SCHED __builtin_amdgcn_sched_barrier(0)
    Unit cur, nxt, prv; int ui = 0;
    if (!S.next(0, cur)) return;
    f32x4 acc[2][2][4][2];
#pragma unroll
    for (int a = 0; a < 2; ++a)
#pragma unroll
        for (int b = 0; b < 2; ++b)
#pragma unroll
            for (int m = 0; m < 4; ++m)
#pragma unroll
                for (int n = 0; n < 2; ++n) acc[a][b][m][n] = (f32x4){0.f, 0.f, 0.f, 0.f};
    bf16x8 At[4][2], B0[2][2], B1[2][2];
    const char* cA = (const char*)g.A + (size_t)cur.pm * tstep; const char* cB = (const char*)g.Bt + (size_t)cur.pn * tstep;
    S.a_ready(cur);
    if constexpr (SP2) {
        if constexpr (GATHER) { PG8_GV(vA, cur); }
        PG8_STAGE(PG8_SB(0, 0), cB, voffB); PG8_STAGE(PG8_SB(0, 1), cB + hstep, voffB);
        if constexpr (GATHER) { PG8_STAGE(PG8_SA(0, 0), gA, vA[0]); PG8_STAGE(PG8_SA(0, 1), gA, vA[1]); } else { PG8_STAGE(PG8_SA(0, 0), cA, voffA); PG8_STAGE(PG8_SA(0, 1), cA + hstep, voffA); }
        if (wr == 1) PG8_BAR;
        PG8_WAIT_V(2); PG8_BAR;
        PG8_STAGE(PG8_SB(1, 0), cB + kstep, voffB); if constexpr (GATHER) { PG8_STAGE(PG8_SA(1, 0), gA + kstep, vA[0]); } else { PG8_STAGE(PG8_SA(1, 0), cA + kstep, voffA); } PG8_STAGE(PG8_SB(1, 1), cB + hstep + kstep, voffB);
        PG8_WAIT_V(6); PG8_BAR;
    } else {
        PG8_STAGE(PG8_SB(0, 0), cB, voffB); PG8_STAGE(PG8_SA(0, 0), cA, voffA); PG8_STAGE(PG8_SB(0, 1), cB + hstep, voffB); PG8_STAGE(PG8_SA(0, 1), cA + hstep, voffA);
        if (wr == 1) PG8_BAR;
        PG8_WAIT_V(4); PG8_BAR;
        PG8_STAGE(PG8_SB(1, 0), cB + kstep, voffB); PG8_STAGE(PG8_SA(1, 0), cA + kstep, voffA); PG8_STAGE(PG8_SB(1, 1), cB + hstep + kstep, voffB);
        PG8_WAIT_V(6); PG8_BAR;
    }
    for (;;) {
        const bool has_next = S.next(ui + 1, nxt);
        if constexpr (GATHER) { if (has_next) { PG8_GV(vN, nxt); } else { _Pragma("unroll") for (int h_ = 0; h_ < 2; ++h_) _Pragma("unroll") for (int i_ = 0; i_ < 2; ++i_) vN[h_][i_] = vA[h_][i_]; } }
        const char* nA = has_next ? (const char*)g.A + (size_t)nxt.pm * tstep : cA; const char* nB = has_next ? (const char*)g.Bt + (size_t)nxt.pn * tstep : cB;
        for (int t = 0; t < nt; t += 2) {
            if constexpr (Epi::MIDK) { if (t == nt / 2) E.midk(acc, cur, wr, wc, fr, fq); }
            if constexpr (Sched::LATE) { if (t == 2 && ui > 0) S.late(prv); }
            const bool last = (t == nt - 2);
            const char* a1 = cA + (size_t)(t + 1) * kstep;
            const char* a2 = last ? nA : cA + (size_t)(t + 2) * kstep; const char* b2 = last ? nB : cB + (size_t)(t + 2) * kstep;
            const char* a3 = a2 + kstep; const char* b3 = b2 + kstep;
            if (last && has_next) S.a_ready(nxt);
            const size_t ka1 = (size_t)(t + 1) * kstep, ka2 = last ? (size_t)0 : (size_t)(t + 2) * kstep, ka3 = ka2 + kstep;
            unsigned vs0[2] = {last ? vN[0][0] : vA[0][0], last ? vN[0][1] : vA[0][1]}, vs1[2] = {last ? vN[1][0] : vA[1][0], last ? vN[1][1] : vA[1][1]};
            if constexpr (SP2) {
            PG8_LDB(B0, 0, 0); PG8_LDB(B1, 0, 1); PG8_SCHED; PG8_LDA(At, 0, 0); if constexpr (GATHER) { PG8_STAGE(PG8_SA(1, 1), gA + ka1, vA[1]); } else { PG8_STAGE(PG8_SA(1, 1), a1 + hstep, voffA); }
            PG8_WAIT_V(8); PG8_WAIT_L(0); PG8_BAR; PG8_MMA(0, 0, At, B0); PG8_MMA(0, 1, At, B1); PG8_BAR; PG8_SCHED;
            PG8_LDA(At, 0, 1); PG8_STAGE(PG8_SB(0, 0), b2, voffB); PG8_STAGE(PG8_SB(0, 1), b2 + hstep, voffB); if constexpr (GATHER) { PG8_STAGE(PG8_SA(0, 0), gA + ka2, vs0); } else { PG8_STAGE(PG8_SA(0, 0), a2, voffA); }
            PG8_WAIT_V(8); PG8_WAIT_L(0); PG8_BAR; PG8_MMA(1, 0, At, B0); PG8_MMA(1, 1, At, B1); PG8_BAR; PG8_SCHED;
            PG8_LDB(B0, 1, 0); PG8_LDB(B1, 1, 1); PG8_SCHED; PG8_LDA(At, 1, 0); if constexpr (GATHER) { PG8_STAGE(PG8_SA(0, 1), gA + ka2, vs1); } else { PG8_STAGE(PG8_SA(0, 1), a2 + hstep, voffA); }
            PG8_WAIT_V(8); PG8_WAIT_L(0); PG8_BAR; PG8_MMA(0, 0, At, B0); PG8_MMA(0, 1, At, B1); PG8_BAR; PG8_SCHED;
            PG8_LDA(At, 1, 1); PG8_STAGE(PG8_SB(1, 0), b3, voffB); PG8_STAGE(PG8_SB(1, 1), b3 + hstep, voffB); if constexpr (GATHER) { PG8_STAGE(PG8_SA(1, 0), gA + ka3, vs0); } else { PG8_STAGE(PG8_SA(1, 0), a3, voffA); }
            PG8_WAIT_V(8); PG8_WAIT_L(0); PG8_BAR; PG8_MMA(1, 0, At, B0); PG8_MMA(1, 1, At, B1); PG8_BAR; PG8_SCHED;
            } else {
            PG8_LDB(B0, 0, 0); PG8_SCHED; PG8_LDA(At, 0, 0); PG8_STAGE(PG8_SA(1, 1), a1 + hstep, voffA);
            PG8_WAIT_L(8); PG8_BAR; PG8_WAIT_L(0); PG8_MMA(0, 0, At, B0); PG8_BAR; PG8_SCHED;
            PG8_LDB(B1, 0, 1); PG8_STAGE(PG8_SB(0, 0), b2, voffB);
            PG8_BAR; PG8_WAIT_L(0); PG8_MMA(0, 1, At, B1); PG8_BAR;
            PG8_LDA(At, 0, 1); PG8_STAGE(PG8_SA(0, 0), a2, voffA);
            PG8_BAR; PG8_WAIT_L(0); PG8_MMA(1, 0, At, B0); PG8_BAR; PG8_SCHED;
            PG8_STAGE(PG8_SB(0, 1), b2 + hstep, voffB);
            PG8_WAIT_V(6); PG8_BAR; PG8_MMA(1, 1, At, B1); PG8_BAR;
            PG8_LDB(B0, 1, 0); PG8_SCHED; PG8_LDA(At, 1, 0); PG8_STAGE(PG8_SA(0, 1), a2 + hstep, voffA);
            PG8_WAIT_L(8); PG8_BAR; PG8_WAIT_L(0); PG8_MMA(0, 0, At, B0); PG8_BAR; PG8_SCHED;
            PG8_LDB(B1, 1, 1); PG8_STAGE(PG8_SB(1, 0), b3, voffB);
            PG8_BAR; PG8_WAIT_L(0); PG8_MMA(0, 1, At, B1); PG8_BAR;
            PG8_LDA(At, 1, 1); PG8_STAGE(PG8_SA(1, 0), a3, voffA);
            PG8_BAR; PG8_WAIT_L(0); PG8_MMA(1, 0, At, B0); PG8_BAR; PG8_SCHED;
            PG8_STAGE(PG8_SB(1, 1), b3 + hstep, voffB);
            PG8_WAIT_V(6); PG8_BAR; PG8_MMA(1, 1, At, B1); PG8_BAR;
            }
        }
        if constexpr (ALIGN_EPI) { if (wr == 0) PG8_BAR; }
        if constexpr (!Epi::AFTER_DRAIN) { E(acc, cur, wr, wc, fr, fq); S.done(cur); }
        if constexpr (Sched::LATE) prv = cur;
        if (!has_next) break;
#pragma unroll
        for (int a = 0; a < 2; ++a)
#pragma unroll
            for (int b = 0; b < 2; ++b)
#pragma unroll
                for (int m = 0; m < 4; ++m)
#pragma unroll
                    for (int n = 0; n < 2; ++n) acc[a][b][m][n] = (f32x4){0.f, 0.f, 0.f, 0.f};
        cur = nxt; cA = nA; cB = nB; ++ui;
        if constexpr (GATHER) { _Pragma("unroll") for (int h_ = 0; h_ < 2; ++h_) _Pragma("unroll") for (int i_ = 0; i_ < 2; ++i_) vA[h_][i_] = vN[h_][i_]; }
        if constexpr (ALIGN_EPI) { if (wr == 1) PG8_BAR; }
    }
    PG8_WAIT_V(0);
    if constexpr (Sched::LATE) S.late(cur);
    if constexpr (!ALIGN_EPI) { if (wr == 0) PG8_BAR; }
    PG8_BAR;
    if constexpr (Epi::AFTER_DRAIN) { E.fused(acc, cur, wr, wc, fr, fq, lds, wid, lane); S.done(cur); }
#undef PG8_GV
#undef PG8_SA
#undef PG8_SB
#undef PG8_STAGE
#undef PG8_LDA
#undef PG8_LDB
#undef PG8_MMA
#undef PG8_WAIT_V
#undef PG8_WAIT_L
#undef PG8_BAR
#undef PG8_SCHED
}
}
namespace attn {
using bf16 = unsigned short;
constexpr int D = 128, NW = 8, QBLK = 32, KVBLK = 64;
constexpr float SCALE = 0.088388347648318440f;
constexpr float THR = 8.f;
constexpr int LDQ = 1024, LDK = 256, LDO = 1024;
constexpr size_t SHM_V = KVBLK * D * 2, SHM_K = KVBLK * D * 2, SHM_ATTN = 2 * SHM_V + 2 * SHM_K + NW * 64 * 4;
using bf16x8 = __attribute__((ext_vector_type(8))) short;
using s16x4  = __attribute__((ext_vector_type(4))) short;
using f32x16 = __attribute__((ext_vector_type(16))) float;
using f32x8  = __attribute__((ext_vector_type(8))) float;
using u32x4  = __attribute__((ext_vector_type(4))) unsigned;
#define KSWZ(row, colB) ((row) * 256 + ((colB) ^ (((row) & 7) << 4)))
#define SBAR() __builtin_amdgcn_sched_barrier(0)
__device__ __forceinline__ int crow(int r, int hi) { return (r & 3) + 8 * (r >> 2) + 4 * hi; }
__device__ __forceinline__ unsigned cvtpk(float lo, float hi) {
  unsigned r; asm volatile("v_cvt_pk_bf16_f32 %0, %1, %2" : "=v"(r) : "v"(lo), "v"(hi)); return r;
}
template <typename TIn> struct Stage;
template <> struct Stage<bf16>  { using T = bf16x8;
  __device__ static __forceinline__ T ld8(const bf16* p) { return *reinterpret_cast<const bf16x8*>(p); }
  __device__ static __forceinline__ bf16x8 tobf(T x) { return x; } };
template <> struct Stage<float> { using T = f32x8;
  __device__ static __forceinline__ T ld8(const float* p) { return *reinterpret_cast<const f32x8*>(p); }
  __device__ static __forceinline__ bf16x8 tobf(T x) {
    u32x4 w = {cvtpk(x[0], x[1]), cvtpk(x[2], x[3]), cvtpk(x[4], x[5]), cvtpk(x[6], x[7])}; return *reinterpret_cast<bf16x8*>(&w); } };

template <bool NOREF> __device__ __forceinline__ void partialSM(f32x16& p0, f32x16& p1, float& m_reg, float& mn, float& alpha) {
  if constexpr (NOREF) { alpha = 1.f; for (int r = 0; r < 16; ++r) p0[r] = __builtin_amdgcn_exp2f(p0[r]); return; }
  constexpr float C = SCALE * 1.4426950408889634f;
  float pmax = p0[0]; for (int r = 1; r < 16; ++r) pmax = fmaxf(pmax, p0[r]); for (int r = 0; r < 16; ++r) pmax = fmaxf(pmax, p1[r]);
  { auto rr = __builtin_amdgcn_permlane32_swap(__float_as_uint(pmax), __float_as_uint(pmax), false, false);
    pmax = fmaxf(__uint_as_float(rr[0]), __uint_as_float(rr[1])); }
  if (__builtin_expect(__all(pmax - m_reg <= THR / SCALE), 1)) { mn = m_reg; alpha = 1.f; }
  else { mn = fmaxf(m_reg, pmax); alpha = __builtin_amdgcn_exp2f((m_reg - mn) * C); m_reg = mn; }
  float mnC = -mn * C;
  for (int r = 0; r < 16; ++r) p0[r] = fmaf(p0[r], C, mnC); for (int r = 0; r < 16; ++r) p1[r] = fmaf(p1[r], C, mnC);
  for (int r = 0; r < 16; ++r) p0[r] = __builtin_amdgcn_exp2f(p0[r]);
}
template <bool NOREF> __device__ __forceinline__ void finishSM(f32x16& p0, f32x16& p1, float alpha, float& l_reg, bf16x8& pa0, bf16x8& pa1, bf16x8& pa2, bf16x8& pa3) {
  for (int r = 0; r < 16; ++r) p1[r] = __builtin_amdgcn_exp2f(p1[r]);
  float ps = 0; for (int r = 0; r < 16; ++r) ps += p0[r]; for (int r = 0; r < 16; ++r) ps += p1[r];
  if constexpr (NOREF) { l_reg += ps; }
  else {
  { auto rr = __builtin_amdgcn_permlane32_swap(__float_as_uint(ps), __float_as_uint(ps), false, false);
    ps = __uint_as_float(rr[0]) + __uint_as_float(rr[1]); }
  l_reg = l_reg * alpha + ps; }
#define PK4(P, BASE, OUT) do { u32x4 w = {cvtpk(P[BASE + 0], P[BASE + 1]), cvtpk(P[BASE + 2], P[BASE + 3]), cvtpk(P[BASE + 4], P[BASE + 5]), cvtpk(P[BASE + 6], P[BASE + 7])}; OUT = *reinterpret_cast<bf16x8*>(&w); } while (0)
  PK4(p0, 0, pa0); PK4(p0, 8, pa1); PK4(p1, 0, pa2); PK4(p1, 8, pa3);
#undef PK4
}
__device__ __forceinline__ void qkt(f32x16& p0, f32x16& p1, const bf16* Ks, const bf16x8* qr, int r32, int hi) {
  p0 = f32x16{}; p1 = f32x16{};
  for (int d0 = 0; d0 < 8; ++d0) { int cb = (d0 * 16 + hi * 8) * 2;
    bf16x8 b0 = *reinterpret_cast<const bf16x8*>((const char*)Ks + KSWZ(r32, cb));
    bf16x8 b1 = *reinterpret_cast<const bf16x8*>((const char*)Ks + KSWZ(32 + r32, cb));
    p0 = __builtin_amdgcn_mfma_f32_32x32x16_bf16(b0, qr[d0], p0, 0, 0, 0);
    p1 = __builtin_amdgcn_mfma_f32_32x32x16_bf16(b1, qr[d0], p1, 0, 0, 0); }
}
__device__ __forceinline__ int v_st(int k, int c) { const int kk = (k & ~0xC) | ((k & 4) << 1) | ((k & 8) >> 1); return ((kk >> 3) * 4 + (c >> 5)) * 512 + ((kk & 7) * 32 + (c & 31)) * 2; }
__device__ __forceinline__ int v_st_nat(int k, int c) { return ((k >> 3) * 4 + (c >> 5)) * 512 + ((k & 7) * 32 + (c & 31)) * 2; }
__device__ __forceinline__ int v_rd_base(int lane) { return ((lane & 3) << 3) | (((lane >> 2) & 3) << 6) | (((lane >> 4) & 1) << 5) | (((lane >> 5) & 1) << 8); }
constexpr int v_rd_off(int d0, int ks, int half) { return d0 * 512 + ks * 4096 + half * 2048; }
template <int OFF> __device__ __forceinline__ s16x4 tr_read(int vb) {
  s16x4 r; asm volatile("ds_read_b64_tr_b16 %0, %1 offset:%2" : "=&v"(r) : "v"(vb), "i"(OFF) : "memory"); return r;
}
template <int D0, bool SM = false> __device__ __forceinline__ void pv_one(f32x16& od, int vb, bf16x8 pa0, bf16x8 pa1, bf16x8 pa2, bf16x8 pa3, f32x16* pn = nullptr) {
  const s16x4 l0 = tr_read<v_rd_off(D0, 0, 0)>(vb), h0 = tr_read<v_rd_off(D0, 0, 1)>(vb), l1 = tr_read<v_rd_off(D0, 1, 0)>(vb), h1 = tr_read<v_rd_off(D0, 1, 1)>(vb);
  const s16x4 l2 = tr_read<v_rd_off(D0, 2, 0)>(vb), h2 = tr_read<v_rd_off(D0, 2, 1)>(vb), l3 = tr_read<v_rd_off(D0, 3, 0)>(vb), h3 = tr_read<v_rd_off(D0, 3, 1)>(vb);
  if constexpr (SM) {
#pragma unroll
    for (int r = 4 * D0; r < 4 * D0 + 4; ++r) (*pn)[r] = __builtin_amdgcn_exp2f((*pn)[r]); }
  asm volatile("s_waitcnt lgkmcnt(0)" ::: "memory"); SBAR();
#define PK(L, H) (bf16x8){L[0], L[1], L[2], L[3], H[0], H[1], H[2], H[3]}
  od = __builtin_amdgcn_mfma_f32_32x32x16_bf16(pa0, PK(l0, h0), od, 0, 0, 0);
  od = __builtin_amdgcn_mfma_f32_32x32x16_bf16(pa1, PK(l1, h1), od, 0, 0, 0);
  od = __builtin_amdgcn_mfma_f32_32x32x16_bf16(pa2, PK(l2, h2), od, 0, 0, 0);
  od = __builtin_amdgcn_mfma_f32_32x32x16_bf16(pa3, PK(l3, h3), od, 0, 0, 0);
#undef PK
}
__device__ __forceinline__ void pv_d0(f32x16* o, int vb, bf16x8 pa0, bf16x8 pa1, bf16x8 pa2, bf16x8 pa3) {
  pv_one<0>(o[0], vb, pa0, pa1, pa2, pa3); pv_one<1>(o[1], vb, pa0, pa1, pa2, pa3); pv_one<2>(o[2], vb, pa0, pa1, pa2, pa3); pv_one<3>(o[3], vb, pa0, pa1, pa2, pa3);
}
__device__ __forceinline__ void pv_d0_sm(f32x16* o, int vb, bf16x8 pa0, bf16x8 pa1, bf16x8 pa2, bf16x8 pa3, f32x16& pn) {
  pv_one<0, true>(o[0], vb, pa0, pa1, pa2, pa3, &pn); pv_one<1, true>(o[1], vb, pa0, pa1, pa2, pa3, &pn); pv_one<2, true>(o[2], vb, pa0, pa1, pa2, pa3, &pn); pv_one<3, true>(o[3], vb, pa0, pa1, pa2, pa3, &pn);
}

template <typename TQ, bool NOREF, int SDEPTH>
__device__ __forceinline__ void attn_dense_body(const TQ* __restrict__ Qb, const bf16* __restrict__ Kh, const bf16* __restrict__ Vh,
                                                bf16* __restrict__ Ob, int seq, char* lds, const int tid, const float* __restrict__ qg, const int t0, const float* __restrict__ rope) {
  using St = Stage<bf16>; using SQ = Stage<TQ>;
  const int wid = tid >> 6, lane = tid & 63, r32 = lane & 31, hi = lane >> 5;
  bf16* V_lds = (bf16*)lds; bf16* K_lds = (bf16*)(lds + 2 * SHM_V);
  float* ws = (float*)(lds + 2 * SHM_V + 2 * SHM_K) + wid * 64; float* li_l = ws; float* al_l = ws + 32;
  float m_reg = -1e30f, l_reg = 0; f32x16 o[4] = {}; bf16x8 qr[8];
  const TQ* Qw = Qb + (long)(wid * QBLK + r32) * LDQ + hi * 8;
#pragma unroll
  for (int d0 = 0; d0 < 8; ++d0) qr[d0] = SQ::tobf(SQ::ld8(Qw + d0 * 16));
  if (qg) {
    float f[8][8]; float ss = 0.f;
#pragma unroll
    for (int d0 = 0; d0 < 8; ++d0) { const u32x4 w = *reinterpret_cast<const u32x4*>(&qr[d0]);
#pragma unroll
      for (int e = 0; e < 4; ++e) { f[d0][2 * e] = __uint_as_float(w[e] << 16); f[d0][2 * e + 1] = __uint_as_float(w[e] & 0xffff0000u); ss += f[d0][2 * e] * f[d0][2 * e] + f[d0][2 * e + 1] * f[d0][2 * e + 1]; } }
    { auto rr = __builtin_amdgcn_permlane32_swap(__float_as_uint(ss), __float_as_uint(ss), false, false); ss = __uint_as_float(rr[0]) + __uint_as_float(rr[1]); }
    const float rs = rsqrtf(ss * (1.f / 128.f) + 1e-6f);
#pragma unroll
    for (int d0 = 0; d0 < 8; ++d0)
#pragma unroll
      for (int j = 0; j < 8; ++j) f[d0][j] *= rs * qg[16 * d0 + 8 * hi + j] * (NOREF ? SCALE * 1.4426950408889634f : 1.f);
    const int t = t0 + wid * QBLK + r32;
#pragma unroll
    for (int d0 = 0; d0 < 4; ++d0) { const float* rp = rope + (d0 < 2 ? (t / 64) : (t % 64)) * 64;
#pragma unroll
      for (int j = 0; j < 8; ++j) { const int fi = (16 * d0 + 8 * hi + j) & 31; const float cs = rp[2 * fi], sn = rp[2 * fi + 1];
        const float x1 = f[d0][j], x2 = f[d0 + 4][j]; f[d0][j] = x1 * cs - x2 * sn; f[d0 + 4][j] = x2 * cs + x1 * sn; } }
#pragma unroll
    for (int d0 = 0; d0 < 8; ++d0) { u32x4 w = {cvtpk(f[d0][0], f[d0][1]), cvtpk(f[d0][2], f[d0][3]), cvtpk(f[d0][4], f[d0][5]), cvtpk(f[d0][6], f[d0][7])}; qr[d0] = *reinterpret_cast<bf16x8*>(&w); }
  }
  const int sr = tid >> 4, sc = (tid & 15) * 8, vst0 = v_st_nat(sr, sc), vst1 = v_st_nat(32 + sr, sc);
  const int vb0 = (int)(uintptr_t)V_lds + v_rd_base(lane);
  struct { typename St::T vs0, vs1, ks0, ks1; } sr_[SDEPTH];
#define SLOAD(i, k0) do { const unsigned o0_ = (unsigned)(((k0) + sr) * LDK + sc), o1_ = o0_ + 32u * LDK;   \
    sr_[i].vs0 = St::ld8(Vh + o0_); sr_[i].vs1 = St::ld8(Vh + o1_); sr_[i].ks0 = St::ld8(Kh + o0_); sr_[i].ks1 = St::ld8(Kh + o1_); } while (0)
#define SWRITE(b, i) do { *(bf16x8*)((char*)V_lds + (b) * SHM_V + vst0) = St::tobf(sr_[i].vs0);          \
    *(bf16x8*)((char*)V_lds + (b) * SHM_V + vst1) = St::tobf(sr_[i].vs1); int kc = sc * 2;               \
    *(bf16x8*)((char*)K_lds + (b) * SHM_K + KSWZ(sr, kc)) = St::tobf(sr_[i].ks0);                       \
    *(bf16x8*)((char*)K_lds + (b) * SHM_K + KSWZ(32 + sr, kc)) = St::tobf(sr_[i].ks1); } while (0)
#define SWAIT() do { if constexpr (SDEPTH == 2) asm volatile("s_waitcnt vmcnt(4)" ::: "memory"); else asm volatile("s_waitcnt vmcnt(0)" ::: "memory"); } while (0)
#define RESC(a) do { if (!NOREF && __any((a) < 1.f)) { if (hi == 0) al_l[r32] = (a); asm volatile("s_waitcnt lgkmcnt(0)" ::: "memory"); \
    for (int d = 0; d < 4; ++d) for (int r = 0; r < 16; ++r) o[d][r] *= al_l[crow(r, hi)]; } } while (0)
  f32x16 pA0, pA1, pB0, pB1; float mnA, mnB, alA, alB; bf16x8 pa0, pa1, pa2, pa3; const int NT = seq / KVBLK;
  constexpr int SE = 0, SO = SDEPTH - 1;
  SLOAD(SE, 0); asm volatile("s_waitcnt vmcnt(0)" ::: "memory"); SWRITE(0, SE); __syncthreads();
  qkt(pA0, pA1, K_lds, qr, r32, hi); partialSM<NOREF>(pA0, pA1, m_reg, mnA, alA);
  SLOAD(SO, KVBLK); if constexpr (SDEPTH == 2) { if (2 < NT) SLOAD(SE, 2 * KVBLK); }
  SWAIT(); SWRITE(1, SO); __syncthreads();
  for (int j = 1; j + 1 < NT; j += 2) {
    SBAR(); qkt(pB0, pB1, (bf16*)((char*)K_lds + SHM_K), qr, r32, hi);
    finishSM<NOREF>(pA0, pA1, alA, l_reg, pa0, pa1, pa2, pa3); SBAR();
    SLOAD(SO, (j + SDEPTH) * KVBLK); SBAR();
    if constexpr (NOREF) { pv_d0_sm(o, vb0, pa0, pa1, pa2, pa3, pB0); alB = 1.f; } else { pv_d0(o, vb0, pa0, pa1, pa2, pa3); partialSM<NOREF>(pB0, pB1, m_reg, mnB, alB); }
    __syncthreads(); SWAIT(); SWRITE(0, SE);
    RESC(alB); __syncthreads();
    SBAR(); qkt(pA0, pA1, K_lds, qr, r32, hi);
    finishSM<NOREF>(pB0, pB1, alB, l_reg, pa0, pa1, pa2, pa3); SBAR();
    if (SDEPTH == 1 || j + 3 < NT) SLOAD(SE, (j + 1 + SDEPTH) * KVBLK); SBAR();
    if constexpr (NOREF) { pv_d0_sm(o, vb0 + (int)SHM_V, pa0, pa1, pa2, pa3, pA0); alA = 1.f; } else { pv_d0(o, vb0 + (int)SHM_V, pa0, pa1, pa2, pa3); partialSM<NOREF>(pA0, pA1, m_reg, mnA, alA); }
    __syncthreads(); SWAIT(); SWRITE(1, SO);
    RESC(alA); __syncthreads();
  }
  SBAR(); qkt(pB0, pB1, (bf16*)((char*)K_lds + SHM_K), qr, r32, hi);
  finishSM<NOREF>(pA0, pA1, alA, l_reg, pa0, pa1, pa2, pa3); SBAR();
  if constexpr (NOREF) { pv_d0_sm(o, vb0, pa0, pa1, pa2, pa3, pB0); alB = 1.f; } else { pv_d0(o, vb0, pa0, pa1, pa2, pa3); partialSM<NOREF>(pB0, pB1, m_reg, mnB, alB); }
  __syncthreads(); RESC(alB);
  finishSM<NOREF>(pB0, pB1, alB, l_reg, pa0, pa1, pa2, pa3); SBAR();
  pv_d0(o, vb0 + (int)SHM_V, pa0, pa1, pa2, pa3);
  if constexpr (NOREF) { auto rr = __builtin_amdgcn_permlane32_swap(__float_as_uint(l_reg), __float_as_uint(l_reg), false, false); l_reg = __uint_as_float(rr[0]) + __uint_as_float(rr[1]); }
  if (hi == 0) li_l[r32] = l_reg; asm volatile("s_waitcnt lgkmcnt(0)" ::: "memory");
  float rli[16];
#pragma unroll
  for (int r = 0; r < 16; ++r) rli[r] = __builtin_amdgcn_rcpf(li_l[crow(r, hi)]);
  bf16* Ow = Ob + (long)(wid * QBLK) * LDO;
#pragma unroll
  for (int r = 0; r < 16; ++r) { int orow = crow(r, hi);
    for (int d0 = 0; d0 < 4; ++d0) Ow[(long)orow * LDO + d0 * 32 + r32] = (bf16)(cvtpk(o[d0][r] * rli[r], 0.f) & 0xffffu); }
#undef SLOAD
#undef SWRITE
#undef SWAIT
#undef RESC
}
}

namespace {
using pg8::bf16_t; using pg8::bf16x8; using pg8::f32x4; using pg8::u32x4;
typedef unsigned u32x2 __attribute__((ext_vector_type(2)));
typedef float f32x16 __attribute__((ext_vector_type(16)));
typedef short s16x4 __attribute__((ext_vector_type(4)));
#define LAS __attribute__((address_space(3)))

constexpr int D = 1024, NBATCH = 2, SEQ = 8192, CTXL = 256;
constexpr int NLAT = NBATCH * SEQ, NCTX = NBATCH * CTXL, NTOK = NLAT + NCTX;
constexpr int SLEN = CTXL + SEQ;
constexpr int NCH = SLEN / 128;
constexpr int ABIN = 5680, NWIN = 5888;
constexpr int NGATE = 48;
constexpr float ALPHA = 1.4142135623730951f;
constexpr int NWAVES = 8, NTHREADS = 512;
constexpr int MOE_MAXTILES = 148;

constexpr size_t MiB = 1u << 20;
constexpr size_t WS_CTL = 0;
constexpr size_t WS_MODV = 64 * 1024;
constexpr size_t WS_ROPE = 208 * 1024;
constexpr size_t WS_DN = 256 * 1024;
constexpr size_t WS_MS = 784 * 1024;
constexpr size_t WS_AEND = 808 * 1024;
constexpr size_t WS_WIN = 1 * MiB;
constexpr size_t WS_WOUT = 12 * MiB + 512 * 1024;
constexpr size_t WS_ATIN = 16 * MiB + 512 * 1024;
constexpr size_t WS_ATOUT = 19 * MiB + 512 * 1024;
constexpr size_t WS_XL = 22 * MiB;
constexpr size_t WS_HB = 88 * MiB;
constexpr size_t WS_MOEW = 121 * MiB;
constexpr size_t WS_ROUTE = 217 * MiB;
constexpr size_t WS_R = 219 * MiB;
constexpr size_t WS_QK = WS_R, WS_V = WS_R + 33 * MiB, WS_O = WS_R + 66 * MiB, WS_Z = WS_R + 99 * MiB, WS_XBC = WS_R + 132 * MiB;
constexpr size_t WS_GATES = WS_R + 182 * MiB;
constexpr size_t WS_SSQ = WS_R + 185 * MiB + 256 * 1024;
constexpr size_t WS_MIX = WS_R + 186 * MiB;
constexpr size_t WS_XC = WS_HB;
constexpr size_t WS_DS = 138 * MiB;
constexpr size_t WS_DC = WS_XL;
constexpr size_t WS_YB = WS_R;
constexpr size_t WS_XS = WS_R, WS_HMID = WS_R + 74 * MiB, WS_YS = WS_R + 148 * MiB;
constexpr size_t WS_Q = WS_R, WS_KB = WS_R + 33 * MiB, WS_VB = WS_R + 42 * MiB, WS_AO = WS_R + 51 * MiB, WS_YB1 = WS_R + 84 * MiB, WS_S = WS_R + 117 * MiB;
constexpr size_t WS_TOKTAB = 472 * MiB;
constexpr size_t WS_MLG = 476 * MiB;
constexpr size_t WS_SSG = 479 * MiB;
constexpr size_t WS_END = 486 * MiB;

constexpr int CW_CNT0 = 64, CW_CNT1 = 128;
constexpr int CW_DEP0 = 256, CW_DEP1 = 512;
constexpr int CW_BAR = 1024;

__device__ __forceinline__ float bf2f(unsigned short v) { return __uint_as_float((unsigned)v << 16); }
typedef float f32x2_t __attribute__((ext_vector_type(2))); typedef __bf16 bf16x2_t __attribute__((ext_vector_type(2)));
__device__ __forceinline__ unsigned pk2(float lo, float hi) { f32x2_t v = {lo, hi}; bf16x2_t b = __builtin_convertvector(v, bf16x2_t); return __builtin_bit_cast(unsigned, b); }
__device__ __forceinline__ bf16_t f2bf(float f) { return (bf16_t)(pk2(f, 0.f) & 0xffffu); }
__device__ __forceinline__ float siluf(float x) { return x * __builtin_amdgcn_rcpf(1.f + __expf(-x)); }
__device__ __forceinline__ float sigmf(float x) { return __builtin_amdgcn_rcpf(1.f + __expf(-x)); }
__device__ __forceinline__ float softplusf(float x) { const float t = __expf(-fabsf(x)); const float l = t < 0.01f ? t * (1.f - t * (0.5f - t * (1.f / 3.f))) : __logf(1.f + t); return fmaxf(x, 0.f) + l; }
__device__ __forceinline__ float logsigf(float x) { return -softplusf(-x); }
__device__ __forceinline__ float wave_sum(float v) {
#pragma unroll
    for (int o = 1; o < 64; o <<= 1) v += __shfl_xor(v, o);
    return v;
}
__device__ __forceinline__ float wave_max(float v) {
#pragma unroll
    for (int o = 1; o < 64; o <<= 1) v = fmaxf(v, __shfl_xor(v, o));
    return v; }
__device__ __forceinline__ unsigned char* launder_ptr(unsigned char* p) { asm volatile("" : "+s"(p)); return p; }
__device__ __forceinline__ int fresh_lane() { int z = 0; asm volatile("" : "+s"(z)); return (int)__builtin_amdgcn_mbcnt_hi(~0u, __builtin_amdgcn_mbcnt_lo(~0u, (unsigned)z)); }
__device__ __forceinline__ int mod_index(int row) { return row < NLAT ? row / SEQ : 2; }
__device__ __forceinline__ int seq_row(int b, int dir, int i) {
    if (i < CTXL) { int t = dir ? (CTXL - 1 - i) : i; return NLAT + b * CTXL + t; }
    int t = i - CTXL; if (dir) t = SEQ - 1 - t; return b * SEQ + t;
}
__device__ __forceinline__ int chunk_row0(int b, int cid) { return cid < 2 ? NLAT + b * CTXL + cid * 128 : b * SEQ + (cid - 2) * 128; }
__device__ __forceinline__ int scan_cid(int dir, int p) { return dir == 0 ? p : (p < 2 ? 1 - p : 67 - p); }

struct RowF { f32x4 v[4]; };
__device__ __forceinline__ RowF row_ld_f32(const float* p, int lane) { RowF r; const f32x4* q = (const f32x4*)p + lane;
#pragma unroll
    for (int j = 0; j < 4; ++j) r.v[j] = q[64 * j];
    return r; }
__device__ __forceinline__ RowF row_ld_bf16(const bf16_t* p, int lane) { RowF r; const u32x2* q = (const u32x2*)p + lane;
#pragma unroll
    for (int j = 0; j < 4; ++j) { const u32x2 w = q[64 * j]; r.v[j] = (f32x4){__uint_as_float(w.x << 16), __uint_as_float(w.x & 0xffff0000u), __uint_as_float(w.y << 16), __uint_as_float(w.y & 0xffff0000u)}; }
    return r; }
struct RowRaw { u32x2 w[4]; };
__device__ __forceinline__ RowRaw row_ldraw_bf16(const bf16_t* p, int lane) { RowRaw r; const u32x2* q = (const u32x2*)p + lane;
#pragma unroll
    for (int j = 0; j < 4; ++j) r.w[j] = q[64 * j];
    return r; }
__device__ __forceinline__ RowF row_cvt(const RowRaw& t) { RowF r;
#pragma unroll
    for (int j = 0; j < 4; ++j) r.v[j] = (f32x4){__uint_as_float(t.w[j].x << 16), __uint_as_float(t.w[j].x & 0xffff0000u), __uint_as_float(t.w[j].y << 16), __uint_as_float(t.w[j].y & 0xffff0000u)};
    return r; }
__device__ __forceinline__ void row_st_f32(float* p, int lane, const RowF& r) { f32x4* q = (f32x4*)p + lane;
#pragma unroll
    for (int j = 0; j < 4; ++j) q[64 * j] = r.v[j]; }
__device__ __forceinline__ void row_st_bf16(bf16_t* p, int lane, const RowF& r) { u32x2* q = (u32x2*)p + lane;
#pragma unroll
    for (int j = 0; j < 4; ++j) { u32x2 w; w.x = pk2(r.v[j][0], r.v[j][1]); w.y = pk2(r.v[j][2], r.v[j][3]); q[64 * j] = w; } }
__device__ __forceinline__ float row_sum(const RowF& r) { float s = 0.f;
#pragma unroll
    for (int j = 0; j < 4; ++j) s += (r.v[j][0] + r.v[j][1]) + (r.v[j][2] + r.v[j][3]);
    return wave_sum(s); }
__device__ __forceinline__ void row_layernorm(RowF& r, const float* g, const float* b, int lane) {
    const float mu = row_sum(r) * (1.f / D); float q = 0.f;
#pragma unroll
    for (int j = 0; j < 4; ++j) { r.v[j] = r.v[j] - mu; q += (r.v[j][0] * r.v[j][0] + r.v[j][1] * r.v[j][1]) + (r.v[j][2] * r.v[j][2] + r.v[j][3] * r.v[j][3]); }
    const float rstd = rsqrtf(wave_sum(q) * (1.f / D) + 1e-5f);
    const RowF gg = row_ld_f32(g, lane), bb = row_ld_f32(b, lane);
#pragma unroll
    for (int j = 0; j < 4; ++j) r.v[j] = r.v[j] * rstd * gg.v[j] + bb.v[j];
}
__device__ __forceinline__ RowF row_modulate(const RowF& x, const float* sh, const float* sc, int lane) {
    const RowF s = row_ld_f32(sh, lane), c = row_ld_f32(sc, lane); RowF h;
#pragma unroll
    for (int j = 0; j < 4; ++j) h.v[j] = x.v[j] * (1.f + c.v[j]) + s.v[j];
    return h; }

template <class Dest> struct EpiStore {
    static constexpr bool PERM = true, AFTER_DRAIN = false, MIDK = false; Dest d;
    __device__ __forceinline__ void operator()(const f32x4 (&acc)[2][2][4][2], const pg8::Unit& u, int wr, int wc, int fr, int fq) const {
#pragma unroll
        for (int ai = 0; ai < 2; ++ai)
#pragma unroll
            for (int m = 0; m < 4; ++m) {
                const int row = u.pm * 256 + ai * 128 + wr * 64 + m * 16 + fr;
                bf16_t* rp = d.rowptr(row, u.pn); if (!rp) continue;
#pragma unroll
                for (int bj = 0; bj < 2; ++bj) { const f32x4 v0 = acc[ai][bj][m][0], v1 = acc[ai][bj][m][1];
                    u32x4 w; w.x = pk2(v0[0], v0[1]); w.y = pk2(v0[2], v0[3]); w.z = pk2(v1[0], v1[1]); w.w = pk2(v1[2], v1[3]);
                    *(u32x4*)(rp + bj * 128 + wc * 32 + 8 * fq) = w; }
            }
    }
};
struct DestWin { bf16_t* base;
    __device__ __forceinline__ bf16_t* rowptr(int row, int pn) const {
        if (pn < 16) { const int seg = pn >> 2; return base + (size_t)seg * (33 * MiB / 2) + (size_t)row * 1024 + (pn & 3) * 256; }
        return base + (size_t)4 * (33 * MiB / 2) + (size_t)row * 1536 + (pn - 16) * 256; } };
struct EpiWin {
    static constexpr bool PERM = true, AFTER_DRAIN = false, MIDK = false; EpiStore<DestWin> st; float* gates; const float* igb; const float* fgb; const float* dtb;
    __device__ __forceinline__ void operator()(const f32x4 (&acc)[2][2][4][2], const pg8::Unit& u, int wr, int wc, int fr, int fq) const {
        if (u.pn < 22) { st(acc, u, wr, wc, fr, fq); return; }
        const int c0 = wc * 32 + 8 * fq;
        if (c0 >= NGATE) return;
        float bias[8];
#pragma unroll
        for (int i = 0; i < 8; ++i) { const int c = c0 + i; bias[i] = c < 8 ? igb[c] : (c < 16 ? fgb[c - 8] : dtb[c - 16]); }
#pragma unroll
        for (int ai = 0; ai < 2; ++ai)
#pragma unroll
            for (int m = 0; m < 4; ++m) { const int row = u.pm * 256 + ai * 128 + wr * 64 + m * 16 + fr;
                float v[8];
#pragma unroll
                for (int i = 0; i < 8; ++i) { const float x = acc[ai][0][m][i >> 2][i & 3] + bias[i]; const int c = c0 + i; const float sp = softplusf(c < 16 ? -x : x); v[i] = c < 8 ? x : (c < 16 ? -sp : sp); }
                float* gp = gates + (size_t)row * NGATE + c0;
                *(f32x4*)gp = (f32x4){v[0], v[1], v[2], v[3]}; *(f32x4*)(gp + 4) = (f32x4){v[4], v[5], v[6], v[7]}; }
    }
};
struct DestPlain { bf16_t* base; int ld; int pnmask;
    __device__ __forceinline__ bf16_t* rowptr(int row, int pn) const { return base + (size_t)row * ld + (pn & pnmask) * 256; } };
struct DestQKV { bf16_t* q; bf16_t* kb; bf16_t* vb;
    __device__ __forceinline__ bf16_t* rowptr(int row, int pn) const {
        if (pn < 4) return row < NLAT ? q + (size_t)row * 1024 + pn * 256 : nullptr;
        int key; if (row < NLAT) { const int b = row / SEQ, t = row % SEQ; key = b * SLEN + CTXL + t; } else { const int r = row - NLAT; key = (r / CTXL) * SLEN + (r % CTXL); }
        return (pn == 4 ? kb : vb) + (size_t)key * 256; } };
struct EpiWout {
    static constexpr bool PERM = true, AFTER_DRAIN = false, MIDK = true; EpiStore<DestPlain> st; const float* ssq;
    __device__ __forceinline__ void operator()(const f32x4 (&acc)[2][2][4][2], const pg8::Unit& u, int wr, int wc, int fr, int fq) const { st(acc, u, wr, wc, fr, fq); }
    __device__ __forceinline__ void midk(f32x4 (&acc)[2][2][4][2], const pg8::Unit& u, int wr, int wc, int fr, int fq) const {
        const float* p0 = ssq + (size_t)(u.pm * 256 + wr * 64 + fr) * 8; asm volatile("" : "+v"(p0));
#pragma unroll
        for (int ai = 0; ai < 2; ++ai)
#pragma unroll
            for (int m = 0; m < 4; ++m) { const float* p = p0 + (ai * 128 + m * 16) * 8;
                const f32x4 s0 = *(const f32x4*)p, s1 = *(const f32x4*)(p + 4);
                const float r = rsqrtf((((s0[0] + s0[1]) + (s0[2] + s0[3])) + ((s1[0] + s1[1]) + (s1[2] + s1[3]))) * (1.f / 1024.f) + 1e-6f);
#pragma unroll
                for (int bj = 0; bj < 2; ++bj)
#pragma unroll
                    for (int n = 0; n < 2; ++n) acc[ai][bj][m][n] = acc[ai][bj][m][n] * r;
                __builtin_amdgcn_sched_barrier(0); }
    }
};
template <bool WT = false> struct EpiSwigluT {
    static constexpr bool PERM = true, AFTER_DRAIN = false, MIDK = false; bf16_t* out;
    __device__ __forceinline__ void operator()(const f32x4 (&acc)[2][2][4][2], const pg8::Unit& u, int wr, int wc, int fr, int fq) const {
        const int pnl = u.pn & 7;
#pragma unroll
        for (int ai = 0; ai < 2; ++ai)
#pragma unroll
            for (int m = 0; m < 4; ++m) {
                const int row = u.pm * 256 + ai * 128 + wr * 64 + m * 16 + fr;
                bf16_t* rp = out + (size_t)row * 1024 + pnl * 128 + wc * 16 + 4 * fq;
#pragma unroll
                for (int bj = 0; bj < 2; ++bj) { const f32x4 g = acc[ai][bj][m][0], up = acc[ai][bj][m][1];
                    u32x2 w; w.x = pk2(siluf(g[0]) * up[0], siluf(g[1]) * up[1]); w.y = pk2(siluf(g[2]) * up[2], siluf(g[3]) * up[3]);
                    if constexpr (WT) __hip_atomic_store((__attribute__((address_space(1))) unsigned long long*)(rp + bj * 64), (unsigned long long)w.x | ((unsigned long long)w.y << 32), __ATOMIC_RELAXED, __HIP_MEMORY_SCOPE_AGENT);
                    else *(u32x2*)(rp + bj * 64) = w; }
            }
    }
};
using EpiSwiglu = EpiSwigluT<false>;
struct MoeOrder {
    int ntm, npn, nwg, G, c; const LAS int* toff; const int* tab;
    __device__ __forceinline__ void init(const LAS int* toff_, int npn_, int G_, int c_) { toff = toff_; ntm = toff_[16]; npn = npn_; nwg = ntm * npn_; G = G_; c = c_; }
    __device__ __forceinline__ bool next(int i, pg8::Unit& u) const {
        const long L = (long)i * G + c; if (L >= nwg) return false;
        int wgid = (int)L; { const int q = nwg / 8, r = nwg % 8, xcd = wgid % 8, off = wgid / 8; wgid = (xcd < r ? xcd * (q + 1) : r * (q + 1) + (xcd - r) * q) + off; }
        const int pm = wgid / npn, pnl = wgid % npn; int e = 0;
#pragma unroll
        for (int k = 1; k < 16; ++k) e += (toff[k] <= pm) ? 1 : 0;
        u.pm = pm; u.pn = e * npn + pnl; return true;
    }
    __device__ __forceinline__ int arow(const pg8::Unit& u, int r) const { const int e = u.pn / npn, pos = (u.pm - toff[e]) * 256 + r; return pos < toff[100 + e] ? tab[(size_t)e * NTOK + pos] : 0; }
    static constexpr bool LATE = false;
    __device__ __forceinline__ void a_ready(const pg8::Unit&) const {}
    __device__ __forceinline__ void done(const pg8::Unit&) const {}
    __device__ __forceinline__ void late(const pg8::Unit&) const {}
};

struct MoeMerged {
    static constexpr bool LATE = true;
    int m0, nm, nloc, rank, n1c, crot; const LAS int* toff; const int* tab; unsigned* dep;
    __device__ __forceinline__ void init(const LAS int* toff_, const int* tab_, unsigned* dep_) {
        toff = toff_; tab = tab_; dep = dep_; m0 = toff_[120]; nm = toff_[121]; nloc = toff_[122]; rank = toff_[123];
        const int n1 = nm * 8; n1c = rank < n1 ? (n1 - rank + nloc - 1) / nloc : 0; const int rot = n1 % nloc; crot = (rank - rot + nloc) % nloc; }
    __device__ __forceinline__ bool next(int i, pg8::Unit& u) const {
        int pm, pnl, npn, base;
        if (i < n1c) { const int t1 = i * nloc + rank; pm = m0 + (t1 >> 3); pnl = t1 & 7; npn = 8; base = 0; }
        else { const int t2 = (i - n1c) * nloc + crot; if (t2 >= nm * 4) return false; pm = m0 + (t2 >> 2); pnl = t2 & 3; npn = 4; base = 128; }
        int e = 0;
#pragma unroll
        for (int k = 1; k < 16; ++k) e += (toff[k] <= pm) ? 1 : 0;
        u.pm = pm; u.pn = base + e * npn + pnl; return true;
    }
    __device__ __forceinline__ int arow(const pg8::Unit& u, int r) const {
        if (u.pn >= 128) return (int)((WS_HMID - WS_HB) / 2048) + u.pm * 256 + r;
        const int e = u.pn >> 3, pos = (u.pm - toff[e]) * 256 + r; return pos < toff[100 + e] ? tab[(size_t)e * NTOK + pos] : 0; }
    __device__ __forceinline__ void a_ready(const pg8::Unit& u) const {
        if (u.pn >= 128) { unsigned* w = dep + u.pm; unsigned sp = 0;
            while ((unsigned)__builtin_amdgcn_readfirstlane(__hip_atomic_load(w, __ATOMIC_RELAXED, __HIP_MEMORY_SCOPE_AGENT)) < 64u) { __builtin_amdgcn_s_sleep(1); if (++sp > (1u << 22)) break; }
            asm volatile("" ::: "memory"); }
    }
    __device__ __forceinline__ void done(const pg8::Unit&) const {}
    __device__ __forceinline__ void late(const pg8::Unit& u) const {
        if (u.pn < 128) { asm volatile("s_waitcnt vmcnt(0)" ::: "memory"); if (fresh_lane() == 0) (void)__hip_atomic_fetch_add(dep + u.pm, 1u, __ATOMIC_RELAXED, __HIP_MEMORY_SCOPE_AGENT); }
    }
};
struct EpiMoe {
    static constexpr bool PERM = true, AFTER_DRAIN = false, MIDK = false; EpiSwigluT<false> sw; EpiStore<DestPlain> st;
    __device__ __forceinline__ void operator()(const f32x4 (&acc)[2][2][4][2], const pg8::Unit& u, int wr, int wc, int fr, int fq) const {
        if (u.pn < 128) sw(acc, u, wr, wc, fr, fq); else st(acc, u, wr, wc, fr, fq); }
};

#define XB_TMO      128
#define XB_XCNT(j)  (256  + 64 * (j))
#define XB_XSUB(j)  (1280 + 64 * (j))
#define XB_XGEN(j)  (2304 + 64 * (j))
#define XB_TOP      3328
#define XB_TOPGEN   3392
#define XCD_BAR_WORDS 3456
#define XB_SPIN_CAP (1u << 18)

__device__ __forceinline__ unsigned xb_ld(unsigned* p)              { return __hip_atomic_load(p, __ATOMIC_RELAXED, __HIP_MEMORY_SCOPE_AGENT); }
__device__ __forceinline__ unsigned xb_add(unsigned* p, unsigned v) { return __hip_atomic_fetch_add(p, v, __ATOMIC_RELAXED, __HIP_MEMORY_SCOPE_AGENT); }
__device__ __forceinline__ unsigned xb_xcc_id() { return (unsigned)__builtin_amdgcn_s_getreg((3 << 11) | 20) & 0xFu; }
#define XB_SPIN(cond, bar) do { unsigned _sp = 0; while (cond) { __builtin_amdgcn_s_sleep(1); \
    if ((++_sp & 255u) == 0u) { if (xb_ld(&(bar)[XB_TMO])) break; if (_sp > XB_SPIN_CAP) { atomicAdd(&(bar)[XB_TMO], 1u); break; } } } } while (0)

struct XcdBarrier {
    unsigned* bar; unsigned x;
    volatile LAS unsigned* st;
};

__device__ __forceinline__ XcdBarrier xcd_barrier_post(unsigned* bar, volatile LAS unsigned* st, int tid) {
    XcdBarrier b; b.bar = bar; b.x = xb_xcc_id(); b.st = st;
    if (tid == 0) { st[2] = xb_add(&bar[XB_XCNT(b.x)], 1u); st[3] = b.x; }
    return b;
}
__device__ __forceinline__ void xcd_barrier_complete(unsigned* bar, unsigned x, unsigned& nloc, unsigned& nx) {
    const unsigned G = gridDim.x * gridDim.y * gridDim.z;
    unsigned sum, cnt, mine, sp = 0u;
    for (;;) {
        sum = 0u; cnt = 0u; mine = 0u;
#pragma unroll
        for (unsigned j = 0; j < 16; ++j) { const unsigned c = xb_ld(&bar[XB_XCNT(j)]); sum += c; cnt += (c > 0u) ? 1u : 0u; mine = (j == x) ? c : mine; }
        if (sum == G) break;
        __builtin_amdgcn_s_sleep(1);
        if ((++sp & 255u) == 0u) { if (xb_ld(&bar[XB_TMO])) break; if (sp > XB_SPIN_CAP) { atomicAdd(&bar[XB_TMO], 1u); break; } }
    }
    nloc = mine > 0u ? mine : 1u; nx = cnt > 0u ? cnt : 1u;
}

__device__ __forceinline__ void xcd_barrier(const XcdBarrier& b, int tid) {
    asm volatile("s_waitcnt vmcnt(0)" ::: "memory");
    __syncthreads();
    if (tid == 0) {
        unsigned* bar = b.bar;
        __builtin_amdgcn_s_waitcnt(0);
        unsigned nloc = b.st[0], nx = b.st[1];
        if (nloc == 0u) { xcd_barrier_complete(bar, b.x, nloc, nx); b.st[0] = nloc; b.st[1] = nx; }
        const unsigned old = xb_add(&bar[XB_XSUB(b.x)], 1u);
        const unsigned gen = old / nloc;
        if (old + 1u == (gen + 1u) * nloc) {
            __builtin_amdgcn_fence(__ATOMIC_RELEASE, "agent");
            asm volatile("s_waitcnt vmcnt(0)" ::: "memory");
            const unsigned og = xb_add(&bar[XB_TOP], 1u);
            const unsigned tg = og / nx;
            if (og + 1u == (tg + 1u) * nx) xb_add(&bar[XB_TOPGEN], 1u);
            else XB_SPIN(xb_ld(&bar[XB_TOPGEN]) == tg, bar);
            __builtin_amdgcn_fence(__ATOMIC_ACQUIRE, "agent");
            xb_add(&bar[XB_XGEN(b.x)], 1u);
            asm volatile("s_waitcnt vmcnt(0)" ::: "memory");
        } else {
            XB_SPIN(xb_ld(&bar[XB_XGEN(b.x)]) == gen, bar);
            __builtin_amdgcn_fence(__ATOMIC_ACQUIRE, "agent");
            asm volatile("s_waitcnt vmcnt(0)" ::: "memory");
        }
    }
    __syncthreads();
}

struct Args {
    const float* in[28]; float* out; unsigned char* ws; int ph_lo, ph_hi, li, pad;
};
struct Ctx {
    LAS unsigned char* lds; unsigned char* ws;
    int tid, lane, wave, G, bid;
};
#define CTLP(F) ((unsigned*)((F).ws + WS_CTL))
#define MISCP(F) ((LAS int*)((F).lds + MISC_OFF))
#define GWID(F) ((F).bid * NWAVES + (F).wave)
#define NGW(F) ((F).G * NWAVES)
enum { I_X = 0, I_C, I_CTX, I_CCTX, I_ADAW, I_ADAB, I_LNG, I_LNB, I_ABWIN, I_ABWOUT, I_IGB, I_FGB, I_MNG, I_CONVW, I_CONVB, I_DTB, I_ALOG, I_SSMD, I_SNG,
       I_ATWIN, I_ATWOUT, I_QG, I_KG, I_RW, I_RB, I_WG, I_WU, I_WD };
constexpr int RING_BYTES = 131072, MISC_OFF = RING_BYTES, LDS_BYTES = RING_BYTES + 12288;

template <class Src> __device__ __forceinline__ void transpose_item(const Src& S, bf16_t* WT, int K, int orow0, int k0, LAS float* scr, int lane, float scale) {
#pragma unroll 8
    for (int i = 0; i < 32; ++i) { const int kk = 2 * i + (lane >> 5); scr[kk * 33 + (lane & 31)] = S.ld(k0 + kk, lane & 31); }
    asm volatile("s_waitcnt lgkmcnt(0)" ::: "memory");
    const int c = lane & 7;
#pragma unroll
    for (int j = 0; j < 4; ++j) { const int n = (lane >> 3) + 8 * j; const LAS float* s = scr + (8 * c) * 33 + S.scol(n);
        u32x4 o; o.x = pk2(s[0 * 33] * scale, s[1 * 33] * scale); o.y = pk2(s[2 * 33] * scale, s[3 * 33] * scale); o.z = pk2(s[4 * 33] * scale, s[5 * 33] * scale); o.w = pk2(s[6 * 33] * scale, s[7 * 33] * scale);
        *(u32x4*)(WT + (size_t)(orow0 + n) * K + k0 + 8 * c) = o; }
    asm volatile("s_waitcnt lgkmcnt(0)" ::: "memory");
}
struct SrcPlain { const float* W; int N; int n0;
    __device__ __forceinline__ float ld(int k, int j) const { return __builtin_nontemporal_load(W + (size_t)k * N + n0 + j); }
    __device__ __forceinline__ int scol(int n) const { return n; } };
struct SrcGate { const float* W; int j0;
    __device__ __forceinline__ float ld(int k, int j) const { const int jj = j0 + j; return jj < 16 ? W[(size_t)k * ABIN + 3072 + jj] : (jj < NGATE ? W[(size_t)k * ABIN + 5648 + (jj - 16)] : 0.f); }
    __device__ __forceinline__ int scol(int n) const { return n; } };
struct SrcWout { const float* W; const float* g; int n0;
    __device__ __forceinline__ float ld(int k, int j) const { return k < 1024 ? W[(size_t)(k + 1024) * 1024 + n0 + j] * g[k] : W[(size_t)(k - 1024) * 1024 + n0 + j]; }
    __device__ __forceinline__ int scol(int n) const { return n; } };
struct SrcGU { const float* Wg; const float* Wu; int c0;
    __device__ __forceinline__ float ld(int k, int j) const { return __builtin_nontemporal_load((j < 16 ? Wg : Wu) + (size_t)k * 1024 + c0 + (j & 15)); }
    __device__ __forceinline__ int scol(int n) const { const int b4 = n >> 3, w = n & 7; return (w < 4 ? 0 : 16) + 4 * b4 + (w & 3); } };

__device__ __forceinline__ void convert_small_weights(Ctx& F, const Args& a) {
    {   float* rope = (float*)(F.ws + WS_ROPE);
        for (int i = F.bid * NTHREADS + F.tid; i < 128 * 32; i += F.G * NTHREADS) { const int pos = i >> 5, fi = i & 31; float sn, cs; sincosf((float)pos * expf(-(float)fi * (9.210340371976184f / 32.f)), &sn, &cs); rope[2 * i] = cs; rope[2 * i + 1] = sn; } }
    LAS float* scr = (LAS float*)(F.lds + F.wave * 16384);
    bf16_t* WinT = (bf16_t*)(F.ws + WS_WIN); bf16_t* WoutT = (bf16_t*)(F.ws + WS_WOUT); bf16_t* AtInT = (bf16_t*)(F.ws + WS_ATIN); bf16_t* AtOutT = (bf16_t*)(F.ws + WS_ATOUT);
    constexpr int I0 = 16 * (NWIN / 32), I1 = 32 * 32, I2 = 16 * 48, I3 = 16 * 32, NI = I0 + I1 + I2 + I3;
    for (int it = GWID(F); it < NI; it += NGW(F)) {
        int r = it;
        if (r < I0) { const int kb = r / (NWIN / 32), nb = r % (NWIN / 32), n0 = 32 * nb;
            if (n0 < 5632) { SrcPlain S{a.in[I_ABWIN], ABIN, n0 < 3072 ? n0 : n0 + 16}; transpose_item(S, WinT, 1024, n0, 64 * kb, scr, F.lane, n0 < 512 ? 0.08838834764831845f : 1.f); }
            else { SrcGate S{a.in[I_ABWIN], n0 - 5632}; transpose_item(S, WinT, 1024, n0, 64 * kb, scr, F.lane, 1.f); }
            continue; } r -= I0;
        if (r < I1) { const int kb = r / 32, nb = r % 32; SrcWout S{a.in[I_ABWOUT], a.in[I_SNG], 32 * nb}; transpose_item(S, WoutT, 2048, 32 * nb, 64 * kb, scr, F.lane, 1.f); continue; } r -= I1;
        if (r < I2) { const int kb = r / 48, nb = r % 48; SrcPlain S{a.in[I_ATWIN], 1536, 32 * nb}; transpose_item(S, AtInT, 1024, 32 * nb, 64 * kb, scr, F.lane, 1.f); continue; } r -= I2;
        { const int kb = r / 32, nb = r % 32; SrcPlain S{a.in[I_ATWOUT], 1024, 32 * nb}; transpose_item(S, AtOutT, 1024, 32 * nb, 64 * kb, scr, F.lane, 1.f); }
    }
}
__device__ __forceinline__ void convert_moe_weights(Ctx& F, const Args& a, int layer, int skip_blocks, int it0 = 0, int it1 = 16 * 16 * 64 + 16 * 16 * 32) {
    if (F.bid < skip_blocks) return;
    LAS float* scr = (LAS float*)(F.lds + F.wave * 16384);
    bf16_t* WGU = (bf16_t*)(F.ws + WS_MOEW); bf16_t* WD = (bf16_t*)(F.ws + WS_MOEW + 64 * MiB);
    const size_t wl = (size_t)layer * 16 * 1024 * 1024;
    constexpr int IGU = 16 * 16 * 64, IDN = 16 * 16 * 32;
    for (int it = it0 + (F.bid - skip_blocks) * NWAVES + F.wave; it < it1; it += (F.G - skip_blocks) * NWAVES) {
        if (it < IGU) { const int e = it / 1024, r = it % 1024, kb = r / 64, nb = r % 64;
            SrcGU S{a.in[I_WG] + wl + (size_t)e * 1048576, a.in[I_WU] + wl + (size_t)e * 1048576, 16 * nb};
            transpose_item(S, WGU + (size_t)e * 2048 * 1024, 1024, 32 * nb, 64 * kb, scr, F.lane, 1.f); }
        else { const int r0 = it - IGU, e = r0 / 512, r = r0 % 512, kb = r / 32, nb = r % 32;
            SrcPlain S{a.in[I_WD] + wl + (size_t)e * 1048576, 1024, 32 * nb};
            transpose_item(S, WD + (size_t)e * 1024 * 1024, 1024, 32 * nb, 64 * kb, scr, F.lane, 1.f); }
    }
}
__device__ __forceinline__ void ada_phase(Ctx& F, const Args& a) {
    LAS float* red = (LAS float*)(F.lds + 8 * 16384);
    float* modv = (float*)(F.ws + WS_MODV);
    for (int item = F.bid; item < 2 * 96; item += F.G) {
        const int l = item / 96, n = (item % 96) * 64 + F.lane;
        float a0 = 0.f, a1 = 0.f, a2 = 0.f;
        const float* w = a.in[I_ADAW] + ((size_t)l * 1024 + F.wave * 128) * 6144 + n;
#pragma unroll 16
        for (int k = 0; k < 128; ++k) { const float wv = w[(size_t)k * 6144]; const int kk = F.wave * 128 + k;
            a0 += siluf(a.in[I_C][kk]) * wv; a1 += siluf(a.in[I_C][1024 + kk]) * wv; a2 += siluf(a.in[I_CCTX][kk]) * wv; }
        LAS float* rr = (LAS float*)F.lds;
        rr[(F.wave * 3 + 0) * 64 + F.lane] = a0; rr[(F.wave * 3 + 1) * 64 + F.lane] = a1; rr[(F.wave * 3 + 2) * 64 + F.lane] = a2;
        __syncthreads();
        if (F.wave < 3) { float s = 0.f;
#pragma unroll
            for (int w8 = 0; w8 < 8; ++w8) s += rr[(w8 * 3 + F.wave) * 64 + F.lane];
            modv[(l * 3 + F.wave) * 6144 + n] = s + a.in[I_ADAB][l * 6144 + n]; }
        __syncthreads();
    }
    (void)red;
}

template <int NC> __device__ __forceinline__ void row_dots(const RowF& h, const float* W, int lane, float (&acc)[NC]) {
#pragma unroll
    for (int i = 0; i < NC; ++i) acc[i] = 0.f;
#pragma unroll
    for (int j = 0; j < 4; ++j)
#pragma unroll
        for (int e = 0; e < 4; ++e) { const float x = h.v[j][e]; const f32x4* w = (const f32x4*)(W + (size_t)(4 * lane + 256 * j + e) * NC);
#pragma unroll
            for (int q = 0; q < NC / 4; ++q) { const f32x4 wv = w[q]; acc[4 * q + 0] += x * wv[0]; acc[4 * q + 1] += x * wv[1]; acc[4 * q + 2] += x * wv[2]; acc[4 * q + 3] += x * wv[3]; } }
}
template <int O, int N> __device__ __forceinline__ void xreduce_step(float (&acc)[N], int lane) {
    const bool up = (lane & O) != 0;
#pragma unroll
    for (int i = 0; i < O; ++i) { const float keep = up ? acc[i + O] : acc[i], send = up ? acc[i] : acc[i + O]; acc[i] = keep + __shfl_xor(send, O); }
}
template <int N> __device__ __forceinline__ float xreduce(float (&acc)[N], int lane) {
    if constexpr (N == 16) {
#pragma unroll
        for (int i = 0; i < 16; ++i) { acc[i] += __shfl_xor(acc[i], 32); acc[i] += __shfl_xor(acc[i], 16); }
    }
    if constexpr (N == 64) { xreduce_step<32, N>(acc, lane); xreduce_step<16, N>(acc, lane); }
    xreduce_step<8, N>(acc, lane); xreduce_step<4, N>(acc, lane); xreduce_step<2, N>(acc, lane); xreduce_step<1, N>(acc, lane);
    return acc[0];
}

__device__ __forceinline__ const float* x_row(const Args& a, int row) { return row < NLAT ? a.in[I_X] + (size_t)row * D : a.in[I_CTX] + (size_t)(row - NLAT) * D; }
__device__ __forceinline__ void rowpass_a(Ctx& F, const Args& a) {
    const float* modv = (const float*)(F.ws + WS_MODV);
    bf16_t* HB = (bf16_t*)(F.ws + WS_HB);
    int row = GWID(F); if (row >= NTOK) return;
    RowF xn = row_ld_f32(x_row(a, row), F.lane);
    for (; row < NTOK; row += NGW(F)) {
        const RowF x = xn; const int nrow = row + NGW(F);
        if (nrow < NTOK) xn = row_ld_f32(x_row(a, nrow), F.lane);
        const float* m = modv + mod_index(row) * 6144;
        const RowF h = row_modulate(x, m, m + 1024, F.lane);
        row_st_bf16(HB + (size_t)row * D, F.lane, h);
    }
}
__device__ __forceinline__ void stage_router(Ctx& F, const float* rw) {
    LAS f32x4* Wl = (LAS f32x4*)F.lds;
    for (int i = F.tid; i < 4096; i += NTHREADS) { const int d = i >> 2, q = i & 3; const f32x4 w = *(const f32x4*)(rw + d * 16 + q * 4);
        Wl[q * 1024 + ((d >> 8) * 4 + (d & 3)) * 64 + ((d >> 2) & 63)] = w; }
    __syncthreads();
}
__device__ __forceinline__ void row_dots16_lds(const RowF& h, const LAS f32x4* Wl, int lane, float (&acc)[16]) {
#pragma unroll
    for (int i = 0; i < 16; ++i) acc[i] = 0.f;
#pragma unroll
    for (int j = 0; j < 4; ++j)
#pragma unroll
        for (int e = 0; e < 4; ++e) { const float x = h.v[j][e];
#pragma unroll
            for (int q = 0; q < 4; ++q) { const f32x4 wv = Wl[q * 1024 + (j * 4 + e) * 64 + lane]; acc[4 * q + 0] += x * wv[0]; acc[4 * q + 1] += x * wv[1]; acc[4 * q + 2] += x * wv[2]; acc[4 * q + 3] += x * wv[3]; }
            if (e & 1) __builtin_amdgcn_sched_barrier(0); }
}
__device__ __forceinline__ void route_row(const RowF& h2, const LAS f32x4* Wl, const float* rb, int lane, int& e0, int& e1, float& g0, float& g1) {
    float acc[16]; row_dots16_lds(h2, Wl, lane, acc);
    const float logit = xreduce<16>(acc, lane);
    float mx = logit;
#pragma unroll
    for (int o = 8; o >= 1; o >>= 1) mx = fmaxf(mx, __shfl_xor(mx, o));
    const float ex = expf(logit - mx); float sm = ex;
#pragma unroll
    for (int o = 8; o >= 1; o >>= 1) sm += __shfl_xor(sm, o);
    const float p = ex / sm, sel = p + rb[lane & 15];
    float s4[4], p4[4];
#pragma unroll
    for (int i = 0; i < 4; ++i) s4[i] = __shfl(sel, (lane & 12) + i);
    float v1 = s4[0]; int i1 = 0;
#pragma unroll
    for (int i = 1; i < 4; ++i) if (s4[i] > v1) { v1 = s4[i]; i1 = i; }
    float v2 = -1e30f;
#pragma unroll
    for (int i = 0; i < 4; ++i) if (i != i1 && s4[i] > v2) v2 = s4[i];
    const float gs = v1 + v2;
    float best = __shfl(gs, 0); int bg = 0;
#pragma unroll
    for (int g = 1; g < 4; ++g) { const float t = __shfl(gs, 4 * g); if (t > best) { best = t; bg = g; } }
#pragma unroll
    for (int i = 0; i < 4; ++i) { s4[i] = __shfl(sel, 4 * bg + i); p4[i] = __shfl(p, 4 * bg + i); }
    v1 = s4[0]; i1 = 0; float q1 = p4[0];
#pragma unroll
    for (int i = 1; i < 4; ++i) if (s4[i] > v1) { v1 = s4[i]; i1 = i; q1 = p4[i]; }
    v2 = -1e30f; int i2 = 0; float q2 = 0.f;
#pragma unroll
    for (int i = 0; i < 4; ++i) if (i != i1 && s4[i] > v2) { v2 = s4[i]; i2 = i; q2 = p4[i]; }
    e0 = 4 * bg + i1; e1 = 4 * bg + i2; const float s = q1 + q2; g0 = q1 / s; g1 = q2 / s;
}
__device__ __forceinline__ void rowpass_b(Ctx& F, const Args& a, int layer, int nrows, const bf16_t* YB) {
    const float* modl = (const float*)(F.ws + WS_MODV) + layer * 3 * 6144;
    bf16_t* XL = (bf16_t*)(F.ws + WS_XL); bf16_t* HB = (bf16_t*)(F.ws + WS_HB);
    int* tok_e = (int*)(F.ws + WS_ROUTE); int* tok_pos = tok_e + 2 * NTOK; float* tok_g = (float*)(tok_pos + 2 * NTOK);
    unsigned* cnt = CTLP(F) + (layer ? CW_CNT1 : CW_CNT0);
    stage_router(F, a.in[I_RW]);
    LAS int* lcnt = (LAS int*)(F.lds + 65536); LAS int* gbase = lcnt + 16; LAS int* nrow = lcnt + 32; LAS int* lrow = lcnt + 64;
    if (F.tid < 33) lcnt[F.tid] = 0;
    __syncthreads();
    RowF xf_n; RowRaw xr_n, y_n;
    { const int r0 = GWID(F); if (r0 < nrows) { if (layer) xr_n = row_ldraw_bf16(XL + (size_t)r0 * D, F.lane); else xf_n = row_ld_f32(x_row(a, r0), F.lane); y_n = row_ldraw_bf16(YB + (size_t)r0 * D, F.lane); } }
    for (int row = GWID(F); row < nrows; row += NGW(F)) {
        const float* m = modl + mod_index(row) * 6144;
        RowF x = layer ? row_cvt(xr_n) : xf_n; const RowF y = row_cvt(y_n); const int nxr = row + NGW(F);
        if (nxr < nrows) { if (layer) xr_n = row_ldraw_bf16(XL + (size_t)nxr * D, F.lane); else xf_n = row_ld_f32(x_row(a, nxr), F.lane); y_n = row_ldraw_bf16(YB + (size_t)nxr * D, F.lane); }
        const RowF gt = row_ld_f32(m + 2048, F.lane);
#pragma unroll
        for (int j = 0; j < 4; ++j) x.v[j] = ALPHA * x.v[j] + gt.v[j] * y.v[j];
        row_layernorm(x, a.in[I_LNG] + (layer * 2) * D, a.in[I_LNB] + (layer * 2) * D, F.lane);
        row_st_bf16(XL + (size_t)row * D, F.lane, x);
        const RowF h2 = row_modulate(x, m + 3072, m + 4096, F.lane);
        row_st_bf16(HB + (size_t)row * D, F.lane, h2);
        int e0, e1; float g0, g1; route_row(h2, (const LAS f32x4*)F.lds, a.in[I_RB], F.lane, e0, e1, g0, g1);
        if (F.lane == 0) {
            const int p0 = __hip_atomic_fetch_add(lcnt + e0, 1, __ATOMIC_RELAXED, __HIP_MEMORY_SCOPE_WORKGROUP), p1 = __hip_atomic_fetch_add(lcnt + e1, 1, __ATOMIC_RELAXED, __HIP_MEMORY_SCOPE_WORKGROUP);
            const int ix = __hip_atomic_fetch_add(nrow, 1, __ATOMIC_RELAXED, __HIP_MEMORY_SCOPE_WORKGROUP);
            lrow[ix * 4 + 0] = row; lrow[ix * 4 + 1] = e0 | (e1 << 8); lrow[ix * 4 + 2] = p0; lrow[ix * 4 + 3] = p1;
            tok_e[row * 2] = e0; tok_e[row * 2 + 1] = e1; tok_g[row * 2] = g0; tok_g[row * 2 + 1] = g1;
        }
    }
    __syncthreads();
    if (F.tid < 16) gbase[F.tid] = (int)atomicAdd(cnt + F.tid, (unsigned)lcnt[F.tid]);
    __syncthreads();
    if (F.tid < nrow[0]) { const int row = lrow[F.tid * 4], ee = lrow[F.tid * 4 + 1];
        const int e0 = ee & 255, e1 = ee >> 8, p0 = gbase[e0] + lrow[F.tid * 4 + 2], p1 = gbase[e1] + lrow[F.tid * 4 + 3];
        tok_pos[row * 2] = p0; tok_pos[row * 2 + 1] = p1; int* tab = (int*)(F.ws + WS_TOKTAB); tab[(size_t)e0 * NTOK + p0] = row; tab[(size_t)e1 * NTOK + p1] = row; }
}
__device__ __forceinline__ void moe_offsets(Ctx& F, int layer) {
    __syncthreads();
    if (F.tid == 0) { const unsigned* cnt = CTLP(F) + (layer ? CW_CNT1 : CW_CNT0); int acc = 0;
        for (int e = 0; e < 16; ++e) { const int c = (int)__hip_atomic_load(cnt + e, __ATOMIC_RELAXED, __HIP_MEMORY_SCOPE_AGENT); MISCP(F)[e] = acc; MISCP(F)[100 + e] = c; acc += (c + 255) >> 8; }
        MISCP(F)[16] = acc; }
    __syncthreads();
}
__device__ __forceinline__ void moe_streams(Ctx& F, int layer, int li) {
    moe_offsets(F, layer);
    if (F.tid == 0) { const unsigned* bar = CTLP(F) + CW_BAR + li * 4096; const int x = MISCP(F)[35]; int tot = 0, before = 0, mine = 1;
        for (int j = 0; j < 16; ++j) { const int c = (int)__hip_atomic_load(bar + XB_XCNT(j), __ATOMIC_RELAXED, __HIP_MEMORY_SCOPE_AGENT); tot += c; before += (j < x) ? c : 0; mine = (j == x) ? c : mine; }
        const int ntm = MISCP(F)[16]; const int m0 = (int)((long)ntm * before / tot), m1 = (int)((long)ntm * (before + mine) / tot);
        MISCP(F)[120] = m0; MISCP(F)[121] = m1 - m0; MISCP(F)[122] = mine; MISCP(F)[123] = MISCP(F)[34]; }
    __syncthreads();
}
__device__ __forceinline__ void moe_scatter(Ctx& F, int layer, int nrows) {
    moe_offsets(F, layer);
    const bf16_t* HB = (const bf16_t*)(F.ws + WS_HB); bf16_t* XS = (bf16_t*)(F.ws + WS_XS);
    const int* tok_e = (const int*)(F.ws + WS_ROUTE); const int* tok_pos = tok_e + 2 * NTOK; int* tok_slot = (int*)(F.ws + WS_ROUTE + MiB);
    for (int row = GWID(F); row < nrows; row += NGW(F)) {
        const int e0 = tok_e[row * 2], e1 = tok_e[row * 2 + 1];
        const int s0 = MISCP(F)[e0] * 256 + tok_pos[row * 2], s1 = MISCP(F)[e1] * 256 + tok_pos[row * 2 + 1];
        const u32x4* src = (const u32x4*)(HB + (size_t)row * D) + F.lane; const u32x4 v0 = src[0], v1 = src[64];
        u32x4* d0 = (u32x4*)(XS + (size_t)s0 * D) + F.lane; u32x4* d1 = (u32x4*)(XS + (size_t)s1 * D) + F.lane;
        d0[0] = v0; d0[64] = v1; d1[0] = v0; d1[64] = v1;
        if (F.lane == 0) { tok_slot[row * 2] = s0; tok_slot[row * 2 + 1] = s1; }
    }
}
__device__ __forceinline__ void rowpass_c(Ctx& F, const Args& a, int layer, int nrows, bool last) {
    const float* modl = (const float*)(F.ws + WS_MODV) + layer * 3 * 6144;
    bf16_t* XL = (bf16_t*)(F.ws + WS_XL); bf16_t* HB = (bf16_t*)(F.ws + WS_HB); const bf16_t* YS = (const bf16_t*)(F.ws + WS_YS);
    const int* tok_e = (const int*)(F.ws + WS_ROUTE); const int* tok_pos = tok_e + 2 * NTOK; const float* tok_g = (const float*)(F.ws + WS_ROUTE) + 4 * NTOK;
    moe_offsets(F, layer);
    const int step = NGW(F); int row = GWID(F);
    int s0n = 0, s1n = 0, s0nn = 0, s1nn = 0; float g0n = 0.f, g1n = 0.f, g0nn = 0.f, g1nn = 0.f; RowRaw xr_n, y0_n, y1_n;
#define RC_SLOTS(r_, s0_, s1_, g0_, g1_) do { s0_ = MISCP(F)[tok_e[(r_) * 2]] * 256 + tok_pos[(r_) * 2]; s1_ = MISCP(F)[tok_e[(r_) * 2 + 1]] * 256 + tok_pos[(r_) * 2 + 1]; g0_ = tok_g[(r_) * 2]; g1_ = tok_g[(r_) * 2 + 1]; } while (0)
    if (row < nrows) { RC_SLOTS(row, s0n, s1n, g0n, g1n); xr_n = row_ldraw_bf16(XL + (size_t)row * D, F.lane); y0_n = row_ldraw_bf16(YS + (size_t)s0n * D, F.lane); y1_n = row_ldraw_bf16(YS + (size_t)s1n * D, F.lane);
        if (row + step < nrows) RC_SLOTS(row + step, s0nn, s1nn, g0nn, g1nn); }
    for (; row < nrows; row += step) {
        const float* m = modl + mod_index(row) * 6144;
        RowF x = row_cvt(xr_n); const RowF y0 = row_cvt(y0_n), y1 = row_cvt(y1_n); const float g0 = g0n, g1 = g1n;
        if (row + step < nrows) { const int nr = row + step; s0n = s0nn; s1n = s1nn; g0n = g0nn; g1n = g1nn;
            xr_n = row_ldraw_bf16(XL + (size_t)nr * D, F.lane); y0_n = row_ldraw_bf16(YS + (size_t)s0n * D, F.lane); y1_n = row_ldraw_bf16(YS + (size_t)s1n * D, F.lane);
            if (nr + step < nrows) RC_SLOTS(nr + step, s0nn, s1nn, g0nn, g1nn); }
        const RowF gt = row_ld_f32(m + 5120, F.lane);
#pragma unroll
        for (int j = 0; j < 4; ++j) x.v[j] = ALPHA * x.v[j] + gt.v[j] * (g0 * y0.v[j] + g1 * y1.v[j]);
        row_layernorm(x, a.in[I_LNG] + (layer * 2 + 1) * D, a.in[I_LNB] + (layer * 2 + 1) * D, F.lane);
        if (last) { row_st_f32(a.out + (size_t)row * D, F.lane, x); }
        else { row_st_bf16(XL + (size_t)row * D, F.lane, x); const float* m1 = modl + 3 * 6144 + mod_index(row) * 6144;
            const RowF h = row_modulate(x, m1, m1 + 1024, F.lane); row_st_bf16(HB + (size_t)row * D, F.lane, h); }
    }
#undef RC_SLOTS
}

template <class Epi, class Sched> __device__ __forceinline__ void run_gemm_gather(Ctx& F, const bf16_t* A, const bf16_t* Bt, int K, const Sched& S, const Epi& E) {
    pg8::Gemm g{A, Bt, 0, 0, K};
    pg8::gemm_phase<Epi, Sched, true, true, true>(F.lds, g, S, E, F.wave * 64 + fresh_lane());
    __syncthreads();
}
template <class Epi, class Sched> __device__ __forceinline__ void run_gemm(Ctx& F, const bf16_t* A, const bf16_t* Bt, int M, int N, int K, const Sched& S, const Epi& E) {
    pg8::Gemm g{A, Bt, M, N, K};
    pg8::gemm_phase<Epi, Sched, true, true>(F.lds, g, S, E, F.wave * 64 + fresh_lane());
    __syncthreads();
}

__device__ __forceinline__ void qkprep_phase(Ctx& F, const Args& a) {
    bf16_t* Q = (bf16_t*)(F.ws + WS_Q); bf16_t* KB = (bf16_t*)(F.ws + WS_KB);
    constexpr int NQ = NLAT * 8, NK = NBATCH * SLEN * 2;
    const float qg0 = a.in[I_QG][F.lane], qg1 = a.in[I_QG][F.lane + 64], kg0 = a.in[I_KG][F.lane], kg1 = a.in[I_KG][F.lane + 64];
    const float* ropet = (const float*)(F.ws + WS_ROPE);
    for (int it = NQ + GWID(F); it < NQ + NK; it += NGW(F)) {
        bf16_t* p; int t; bool rope; float g0, g1;
        if (it < NQ) { const int row = it >> 3, hh = it & 7; p = Q + (size_t)row * 1024 + hh * 128; t = row % SEQ; rope = true; g0 = qg0; g1 = qg1; }
        else { const int r = it - NQ, krow = r >> 1, kvh = r & 1, key = krow % SLEN; p = KB + (size_t)krow * 256 + kvh * 128; rope = key >= CTXL; t = key - CTXL; g0 = kg0; g1 = kg1; }
        float x1 = bf2f(p[F.lane]), x2 = bf2f(p[F.lane + 64]);
        const float r = rsqrtf(wave_sum(x1 * x1 + x2 * x2) * (1.f / 128.f) + 1e-6f);
        x1 *= r * g0; x2 *= r * g1;
        float o1 = x1, o2 = x2;
        if (rope) { const float* rp = ropet + ((F.lane < 32) ? (t / 64) : (t % 64)) * 64 + 2 * (F.lane & 31); const float cs = rp[0], sn = rp[1]; o1 = x1 * cs - x2 * sn; o2 = x2 * cs + x1 * sn; }
        p[F.lane] = f2bf(o1); p[F.lane + 64] = f2bf(o2);
    }
}
__device__ __forceinline__ void kprep_tile(Ctx& F, const Args& a, int pm) {
    bf16_t* KB = (bf16_t*)(F.ws + WS_KB); const float* ropet = (const float*)(F.ws + WS_ROPE);
    const int l16 = F.lane & 15, sub = F.lane >> 4; const bool rope = pm < NLAT / 256;
    const f32x4 g0 = *(const f32x4*)(a.in[I_KG] + 8 * l16), g1 = *(const f32x4*)(a.in[I_KG] + 8 * l16 + 4);
    const float sg = l16 < 8 ? -1.f : 1.f;
#pragma unroll 2
    for (int it = F.wave * 4 + sub; it < 512; it += 32) {
        const int row = pm * 256 + (it >> 1), kvh = it & 1; int key, t = 0;
        if (rope) { const int b = row / SEQ; t = row % SEQ; key = b * SLEN + CTXL + t; } else { const int r = row - NLAT; key = (r / CTXL) * SLEN + (r % CTXL); }
        u32x4* p = (u32x4*)(KB + (size_t)key * 256 + kvh * 128 + 8 * l16);
        const u32x4 w = *p;
        f32x4 xa = {__uint_as_float(w.x << 16), __uint_as_float(w.x & 0xffff0000u), __uint_as_float(w.y << 16), __uint_as_float(w.y & 0xffff0000u)};
        f32x4 xb = {__uint_as_float(w.z << 16), __uint_as_float(w.z & 0xffff0000u), __uint_as_float(w.w << 16), __uint_as_float(w.w & 0xffff0000u)};
        float ss = ((xa[0] * xa[0] + xa[1] * xa[1]) + (xa[2] * xa[2] + xa[3] * xa[3])) + ((xb[0] * xb[0] + xb[1] * xb[1]) + (xb[2] * xb[2] + xb[3] * xb[3]));
        ss += __shfl_xor(ss, 1); ss += __shfl_xor(ss, 2); ss += __shfl_xor(ss, 4); ss += __shfl_xor(ss, 8);
        const float rs = rsqrtf(ss * (1.f / 128.f) + 1e-6f);
        xa = xa * (g0 * rs); xb = xb * (g1 * rs);
        if (rope) { const float* rp = ropet + (((l16 & 7) < 4) ? (t / 64) : (t % 64)) * 64 + 16 * (l16 & 3);
            const f32x4 c0 = *(const f32x4*)rp, c1 = *(const f32x4*)(rp + 4), c2 = *(const f32x4*)(rp + 8), c3 = *(const f32x4*)(rp + 12);
            const f32x4 csa = {c0[0], c0[2], c1[0], c1[2]}, sna = {c0[1], c0[3], c1[1], c1[3]}, csb = {c2[0], c2[2], c3[0], c3[2]}, snb = {c2[1], c2[3], c3[1], c3[3]};
            f32x4 pa, pb;
            pa[0] = __shfl_xor(xa[0], 8); pa[1] = __shfl_xor(xa[1], 8); pa[2] = __shfl_xor(xa[2], 8); pa[3] = __shfl_xor(xa[3], 8);
            pb[0] = __shfl_xor(xb[0], 8); pb[1] = __shfl_xor(xb[1], 8); pb[2] = __shfl_xor(xb[2], 8); pb[3] = __shfl_xor(xb[3], 8);
            xa = xa * csa + (pa * sna) * sg; xb = xb * csb + (pb * snb) * sg; }
        u32x4 o; o.x = pk2(xa[0], xa[1]); o.y = pk2(xa[2], xa[3]); o.z = pk2(xb[0], xb[1]); o.w = pk2(xb[2], xb[3]);
        *p = o;
    }
}
__device__ __forceinline__ void attn_phase(Ctx& F, const Args& a) {
    const bf16_t* Q = (const bf16_t*)(F.ws + WS_Q); const bf16_t* KB = (const bf16_t*)(F.ws + WS_KB); const bf16_t* VB = (const bf16_t*)(F.ws + WS_VB); bf16_t* AO = (bf16_t*)(F.ws + WS_AO);
    const float gq = wave_max(fmaxf(fabsf(a.in[I_QG][F.lane]), fabsf(a.in[I_QG][F.lane + 64]))), gk = wave_max(fmaxf(fabsf(a.in[I_KG][F.lane]), fabsf(a.in[I_KG][F.lane + 64])));
    const bool fast = 11.3137085f * 1.4426950408889634f * 1.02f * gq * gk < 60.f;
    for (int i = 0;; ++i) {
        const int L = i * F.G + F.bid; if (L >= 512) break;
        const int xcd = L & 7, off = L >> 3, combo = xcd >> 1, idx = (xcd & 1) * 64 + off, hl = idx >> 5, qb = idx & 31;
        const int b = combo >> 1, kvh = combo & 1, h = kvh * 4 + hl;
        const size_t qoff = ((size_t)b * SEQ + qb * 256) * 1024 + h * 128, koff = (size_t)b * SLEN * 256 + kvh * 128;
        if (fast) attn::attn_dense_body<attn::bf16, true, 1>(Q + qoff, KB + koff, VB + koff, AO + qoff, SLEN, (char*)F.lds, F.wave * 64 + fresh_lane(), a.in[I_QG], qb * 256, (const float*)(F.ws + WS_ROPE));
        else attn::attn_dense_body<attn::bf16, false, 1>(Q + qoff, KB + koff, VB + koff, AO + qoff, SLEN, (char*)F.lds, F.wave * 64 + fresh_lane(), a.in[I_QG], qb * 256, (const float*)(F.ws + WS_ROPE));
        __syncthreads();
    }
}

typedef short v4i16_t __attribute__((ext_vector_type(4)));
typedef const LAS unsigned char* lds_cptr;
constexpr float LOG2E = 1.4426950408889634f;
__device__ __forceinline__ s16x4 vtr(lds_cptr p) { return __builtin_bit_cast(s16x4, __builtin_amdgcn_ds_read_tr16_b64_v4i16((LAS v4i16_t*)p)); }
__device__ __forceinline__ bf16x8 trfrag(lds_cptr tb, int d0, int ks) {
    const s16x4 l = vtr(tb + attn::v_rd_off(d0, ks, 0)), h = vtr(tb + attn::v_rd_off(d0, ks, 1));
    return (bf16x8){l[0], l[1], l[2], l[3], h[0], h[1], h[2], h[3]}; }
__device__ __forceinline__ bf16x8 rowfrag(lds_cptr tile, int blk, int d0, int r32, int hi) { return *(const LAS bf16x8*)(tile + KSWZ(32 * blk + r32, (d0 * 16 + hi * 8) * 2)); }
__device__ __forceinline__ u32x4 scale8(u32x4 v, float s) { u32x4 o;
#pragma unroll
    for (int i = 0; i < 4; ++i) o[i] = pk2(__uint_as_float(v[i] << 16) * s, __uint_as_float(v[i] & 0xffff0000u) * s);
    return o; }
__device__ __forceinline__ bf16x8 scale8f(bf16x8 v, float s) { return __builtin_bit_cast(bf16x8, scale8(__builtin_bit_cast(u32x4, v), s)); }
__device__ __forceinline__ float wave_incl_sum(float v, int lane) {
#pragma unroll
    for (int o = 1; o < 64; o <<= 1) { const float t = __shfl_up(v, o); if (lane >= o) v += t; }
    return v; }
__device__ __forceinline__ float wave_incl_max(float v, int lane) {
#pragma unroll
    for (int o = 1; o < 64; o <<= 1) { const float t = __shfl_up(v, o); if (lane >= o) v = fmaxf(v, t); }
    return v; }
__device__ __forceinline__ float wave_incl_max_rev(float v, int lane) {
#pragma unroll
    for (int o = 1; o < 64; o <<= 1) { const float t = __shfl_down(v, o); if (lane + o < 64) v = fmaxf(v, t); }
    return v; }
__device__ __forceinline__ float half_swap_add(float v) { auto rr = __builtin_amdgcn_permlane32_swap(__float_as_uint(v), __float_as_uint(v), false, false); return __uint_as_float(rr[0]) + __uint_as_float(rr[1]); }
#define MX_PK4(P, BASE, OUT) do { unsigned a0_ = pk2(P[BASE + 0], P[BASE + 1]), a1_ = pk2(P[BASE + 2], P[BASE + 3]); \
    unsigned b0_ = pk2(P[BASE + 4], P[BASE + 5]), b1_ = pk2(P[BASE + 6], P[BASE + 7]); \
    auto r0_ = __builtin_amdgcn_permlane32_swap(a0_, b0_, false, false); auto r1_ = __builtin_amdgcn_permlane32_swap(a1_, b1_, false, false); \
    u32x4 w_ = {r0_[0], r1_[0], r0_[1], r1_[1]}; OUT = __builtin_bit_cast(bf16x8, w_); } while (0)

__device__ __forceinline__ const bf16_t* launder_v(const bf16_t* p) { asm volatile("" : "+v"(p)); return p; }
constexpr int MX_MISC = MISC_OFF + 1024;
__device__ __forceinline__ int st_off(int row, int col) { return (((row >> 5) * 8 + (col >> 4)) << 9) + ((row & 31) << 4) + (col & 15); }
__device__ __forceinline__ int mx_unit(int bid, int G, int k, int off) { const int kmain = 528 / G, nmain = kmain * G; if (k < kmain) return bid + k * G; if (k == kmain) { const int j = bid - off; return (j >= 0 && j < 528 - nmain) ? nmain + j : -1; } return -1; }

constexpr int CONV_RUN = 26;
__device__ __forceinline__ int conv_seg(int row) { return row < NLAT ? row / SEQ : 2 + (row - NLAT) / CTXL; }
__device__ __forceinline__ void conv_unpack(u32x4 v, float (&f)[8]) {
#pragma unroll
    for (int e = 0; e < 4; ++e) { f[2 * e] = __uint_as_float(v[e] << 16); f[2 * e + 1] = __uint_as_float(v[e] & 0xffff0000u); } }
__device__ __forceinline__ void conv_phase(Ctx& F, const Args& a) {
    const bf16_t* XBC = (const bf16_t*)(F.ws + WS_XBC); bf16_t* XC = (bf16_t*)(F.ws + WS_XC);
    const float* cw = a.in[I_CONVW]; const float* cb = a.in[I_CONVB];
    constexpr int NRUN = (NTOK + CONV_RUN - 1) / CONV_RUN;
    for (int it = F.bid * NTHREADS + F.tid; it < NRUN * 192; it += F.G * NTHREADS) {
        const int c8 = (it % 192) * 8, r0 = (it / 192) * CONV_RUN, r1 = (r0 + CONV_RUN < NTOK) ? r0 + CONV_RUN : NTOK;
        float w[4][8], bias[8];
#pragma unroll
        for (int j = 0; j < 4; ++j) { const f32x4 w0 = *(const f32x4*)(cw + j * 1536 + c8), w1 = *(const f32x4*)(cw + j * 1536 + c8 + 4); w[j][0] = w0[0]; w[j][1] = w0[1]; w[j][2] = w0[2]; w[j][3] = w0[3]; w[j][4] = w1[0]; w[j][5] = w1[1]; w[j][6] = w1[2]; w[j][7] = w1[3]; }
        { const f32x4 b0 = *(const f32x4*)(cb + c8), b1 = *(const f32x4*)(cb + c8 + 4); bias[0] = b0[0]; bias[1] = b0[1]; bias[2] = b0[2]; bias[3] = b0[3]; bias[4] = b1[0]; bias[5] = b1[1]; bias[6] = b1[2]; bias[7] = b1[3]; }
        const u32x4 zero = {0u, 0u, 0u, 0u};
        const bf16_t* base = XBC + c8;
        u32x4 xm2 = r0 >= 2 ? *(const u32x4*)(base + (size_t)(r0 - 2) * 1536) : zero, xm1 = r0 >= 1 ? *(const u32x4*)(base + (size_t)(r0 - 1) * 1536) : zero;
        u32x4 x0 = *(const u32x4*)(base + (size_t)r0 * 1536), xp1 = r0 + 1 < NTOK ? *(const u32x4*)(base + (size_t)(r0 + 1) * 1536) : zero;
        for (int r = r0; r < r1; ++r) {
            const u32x4 xp2 = r + 2 < NTOK ? *(const u32x4*)(base + (size_t)(r + 2) * 1536) : zero;
            const int sg = conv_seg(r);
            const bool v0 = r >= 2 && conv_seg(r - 2) == sg, v1 = r >= 1 && conv_seg(r - 1) == sg, v3 = r + 1 < NTOK && conv_seg(r + 1) == sg;
            float f0[8], f1[8], f2[8], f3[8]; conv_unpack(xm2, f0); conv_unpack(xm1, f1); conv_unpack(x0, f2); conv_unpack(xp1, f3);
            float acc[8];
#pragma unroll
            for (int e = 0; e < 8; ++e) acc[e] = bias[e] + (v0 ? w[0][e] * f0[e] : 0.f) + (v1 ? w[1][e] * f1[e] : 0.f) + w[2][e] * f2[e] + (v3 ? w[3][e] * f3[e] : 0.f);
            u32x4 o; o[0] = pk2(siluf(acc[0]), siluf(acc[1])); o[1] = pk2(siluf(acc[2]), siluf(acc[3])); o[2] = pk2(siluf(acc[4]), siluf(acc[5])); o[3] = pk2(siluf(acc[6]), siluf(acc[7]));
            *(u32x4*)(XC + (size_t)r * 1536 + c8) = o;
            xm2 = xm1; xm1 = x0; x0 = xp1; xp1 = xp2;
        }
    }
}

struct MlGate { float b0, b1, G0, G1, total; };
__device__ __forceinline__ MlGate ml_gate(const float* GATES, int row0, int dir, int h, int lane) {
    const float* g0 = GATES + (size_t)(row0 + 2 * lane) * NGATE; const float* g1 = g0 + NGATE;
    const float lf0 = g0[8 + dir * 4 + h], lf1 = g1[8 + dir * 4 + h], ig0 = g0[dir * 4 + h], ig1 = g1[dir * 4 + h];
    const float incl = wave_incl_sum(lf0 + lf1, lane), total = __shfl(incl, 63);
    MlGate r; r.total = total;
    if (dir == 0) { r.b0 = incl - lf1; r.b1 = incl; } else { r.b0 = total - incl + lf0 + lf1; r.b1 = total - incl + lf1; }
    r.G0 = ig0 - r.b0; r.G1 = ig1 - r.b1; return r;
}


__device__ __forceinline__ void mlstm_a_phase(Ctx& F, int off) {
    const bf16_t* QK = (const bf16_t*)(F.ws + WS_QK); const bf16_t* V = (const bf16_t*)(F.ws + WS_V); const float* GATES = (const float*)(F.ws + WS_GATES);
    bf16_t* DC = (bf16_t*)(F.ws + WS_DC); float* DN = (float*)(F.ws + WS_DN); float* MS = (float*)(F.ws + WS_MS);
    LAS unsigned char* Vt = F.lds; LAS unsigned char* Kw = F.lds + 65536;
    LAS float* wsc = (LAS float*)(F.lds + MX_MISC); LAS float* dnp = (LAS float*)(F.lds + MX_MISC + 1024);
    for (int k_ = 0;; ++k_) { const int u = mx_unit(F.bid, F.G, k_, off); if (u < 0) break;
        const int lane = fresh_lane(), tid = F.wave * 64 + lane, r32 = lane & 31, hi = lane >> 5, sr = tid >> 4, sc8 = (tid & 15) * 8, rdb = attn::v_rd_base(lane);
        const int b = u / 264, rem = u % 264, cid = rem >> 2, h = rem & 3, row0 = chunk_row0(b, cid);
        if (F.wave < 2) { const int dir = F.wave, chain = (b * 4 + h) * 2 + dir; typedef float f32x2v __attribute__((ext_vector_type(2)));
            *(LAS f32x2v*)(wsc + dir * 128 + 2 * lane) = *(const f32x2v*)((const float*)(F.ws + WS_MLG) + (size_t)(chain * NCH + cid) * 512 + 384 + 2 * lane); }
        __syncthreads();
        float dnacc[2][8];
#pragma unroll
        for (int d = 0; d < 2; ++d)
#pragma unroll
            for (int e = 0; e < 8; ++e) dnacc[d][e] = 0.f;
#pragma unroll
        for (int i = 0; i < 4; ++i) { const int s = sr + 32 * i; const size_t grow = (size_t)(row0 + s) * 1024;
#pragma unroll
            for (int vb = 0; vb < 2; ++vb) { const u32x4 v = *(const u32x4*)(V + grow + h * 256 + vb * 128 + sc8); *(LAS u32x4*)(Vt + ((s >> 6) * 2 + vb) * 16384 + attn::v_st(s & 63, sc8)) = v; }
            const u32x4 kv = *(const u32x4*)(QK + grow + 512 + h * 128 + sc8);
#pragma unroll
            for (int d = 0; d < 2; ++d) { const float w = wsc[d * 128 + s];
                *(LAS u32x4*)(Kw + (d * 2 + (s >> 6)) * 16384 + attn::v_st(s & 63, sc8)) = scale8(kv, w);
#pragma unroll
                for (int e = 0; e < 4; ++e) { dnacc[d][2 * e] += w * __uint_as_float(kv[e] << 16); dnacc[d][2 * e + 1] += w * __uint_as_float(kv[e] & 0xffff0000u); } } }
#pragma unroll
        for (int d = 0; d < 2; ++d)
#pragma unroll
            for (int e = 0; e < 8; ++e) { float t = dnacc[d][e]; t += __shfl_xor(t, 16); t += __shfl_xor(t, 32); if ((lane >> 4) == 0) dnp[(F.wave * 2 + d) * 128 + sc8 + e] = t; }
        __syncthreads();
        {   const int dir = F.wave >> 2, vq = F.wave & 3;
            f32x16 acc[2][4];
#pragma unroll
            for (int i = 0; i < 2; ++i)
#pragma unroll
                for (int n = 0; n < 4; ++n) acc[i][n] = f32x16{};
#pragma unroll
            for (int ks = 0; ks < 8; ++ks) { const int sblk = ks >> 2, KS = ks & 3;
                bf16x8 af[2], bfr[4];
#pragma unroll
                for (int i = 0; i < 2; ++i) af[i] = trfrag(Vt + (sblk * 2 + (vq >> 1)) * 16384 + rdb, (2 * vq + i) & 3, KS);
#pragma unroll
                for (int n = 0; n < 4; ++n) bfr[n] = trfrag(Kw + (dir * 2 + sblk) * 16384 + rdb, n, KS);
#pragma unroll
                for (int i = 0; i < 2; ++i)
#pragma unroll
                    for (int n = 0; n < 4; ++n) acc[i][n] = __builtin_amdgcn_mfma_f32_32x32x16_bf16(af[i], bfr[n], acc[i][n], 0, 0, 0); }
            const int chain = (b * 4 + h) * 2 + dir;
            bf16_t* dst = DC + (size_t)(chain * NCH + cid) * 256 * 128;
#pragma unroll
            for (int i = 0; i < 2; ++i)
#pragma unroll
                for (int n = 0; n < 4; ++n)
#pragma unroll
                    for (int r = 0; r < 16; ++r) dst[st_off(64 * vq + 32 * i + attn::crow(r, hi), 32 * n + r32)] = f2bf(acc[i][n][r]);
        }
        if (tid < 256) { const int dir = tid >> 7, d = tid & 127; float s = 0.f;
#pragma unroll
            for (int w = 0; w < 8; ++w) s += dnp[(w * 2 + dir) * 128 + d];
            const int chain = (b * 4 + h) * 2 + dir; DN[(size_t)(chain * NCH + cid) * 128 + d] = s; }
        __syncthreads();
    }
}

struct SsGate { float dt0, dt1, acs0, acs1, total; };
__device__ __forceinline__ SsGate ss_gate(const float* GATES, int row0, int dir, int head, float aneg, int lane) {
    const float* g0 = GATES + (size_t)(row0 + 2 * lane) * NGATE; const float* g1 = g0 + NGATE;
    SsGate r; r.dt0 = g0[16 + dir * 16 + head]; r.dt1 = g1[16 + dir * 16 + head];
    const float a0 = r.dt0 * aneg, a1 = r.dt1 * aneg;
    const float incl = wave_incl_sum(a0 + a1, lane); r.total = __shfl(incl, 63);
    if (dir == 0) { r.acs0 = incl - a1; r.acs1 = incl; } else { r.acs0 = r.total - incl + a0 + a1; r.acs1 = r.total - incl + a1; }
    return r;
}
__device__ __forceinline__ void gatescan_phase(Ctx& F, const Args& a) {
    const float* GATES = (const float*)(F.ws + WS_GATES); float* MLG = (float*)(F.ws + WS_MLG); float* SSG = (float*)(F.ws + WS_SSG);
    float* MS = (float*)(F.ws + WS_MS); float* AEND = (float*)(F.ws + WS_AEND);
    typedef float f32x2v __attribute__((ext_vector_type(2)));
    const int lane = F.lane;
    for (int it = GWID(F); it < 16 * NCH + 64 * NCH; it += NGW(F)) {
        if (it < 16 * NCH) { const int chain = it / NCH, cid = it % NCH, dir = chain & 1, h = (chain >> 1) & 3, b = chain >> 3, row0 = chunk_row0(b, cid);
            const MlGate g = ml_gate(GATES, row0, dir, h, lane);
            const float gmx = fmaxf(g.G0, g.G1), gm = wave_max(gmx); float P0, P1;
            if (dir == 0) { const float pm = wave_incl_max(gmx, lane); float ex = __shfl_up(pm, 1); if (lane == 0) ex = -1e30f; P0 = fmaxf(ex, g.G0); P1 = pm; }
            else { const float pm = wave_incl_max_rev(gmx, lane); float ex = __shfl_down(pm, 1); if (lane == 63) ex = -1e30f; P1 = fmaxf(ex, g.G1); P0 = pm; }
            float* o = MLG + (size_t)it * 512 + 2 * lane;
            *(f32x2v*)(o) = (f32x2v){g.b0, g.b1}; *(f32x2v*)(o + 128) = (f32x2v){g.G0, g.G1}; *(f32x2v*)(o + 256) = (f32x2v){P0, P1}; *(f32x2v*)(o + 384) = (f32x2v){expf(g.G0 - gm), expf(g.G1 - gm)};
            if (lane == 0) { MS[it * 4 + 0] = g.total; MS[it * 4 + 1] = g.total + gm; } }
        else { const int i2 = it - 16 * NCH, chain = i2 / NCH, cid = i2 % NCH, dir = chain & 1, head = (chain >> 1) & 15, b = chain >> 5, row0 = chunk_row0(b, cid);
            const float aneg = -expf(a.in[I_ALOG][dir * 16 + head]); const SsGate s = ss_gate(GATES, row0, dir, head, aneg, lane);
            float* o = SSG + (size_t)i2 * 384 + 2 * lane;
            *(f32x2v*)(o) = (f32x2v){s.acs0, s.acs1}; *(f32x2v*)(o + 128) = (f32x2v){s.dt0, s.dt1}; *(f32x2v*)(o + 256) = (f32x2v){s.dt0 * expf(s.total - s.acs0), s.dt1 * expf(s.total - s.acs1)};
            if (lane == 0) AEND[i2] = s.total; }
    }
}
template <bool BM_ROW> __device__ __forceinline__ void ssd_stage(Ctx& F, const bf16_t* XC, int row0, int g, int hh, LAS unsigned char* Xt, LAS unsigned char* Bt) {
    const int tid_ = F.wave * 64 + fresh_lane(), sr = tid_ >> 4, sc8 = (tid_ & 15) * 8;
#pragma unroll
    for (int i = 0; i < 4; ++i) { const int s = sr + 32 * i; const bf16_t* rowp = XC + (size_t)(row0 + s) * 1536;
#pragma unroll
        for (int cb = 0; cb < 2; ++cb) { const u32x4 v = *(const u32x4*)(rowp + (g * 8 + hh * 4) * 64 + cb * 128 + sc8); *(LAS u32x4*)(Xt + ((s >> 6) * 2 + cb) * 16384 + attn::v_st(s & 63, sc8)) = v; }
        const u32x4 bv = *(const u32x4*)(rowp + 1024 + g * 128 + sc8);
        if (BM_ROW) *(LAS u32x4*)(Bt + (s >> 6) * 16384 + KSWZ(s & 63, sc8 * 2)) = bv; else *(LAS u32x4*)(Bt + (s >> 6) * 16384 + attn::v_st(s & 63, sc8)) = bv; }
}
__device__ __forceinline__ void ssd_a_phase(Ctx& F, const Args& a, int off) {
    const bf16_t* XC = (const bf16_t*)(F.ws + WS_XC); const float* GATES = (const float*)(F.ws + WS_GATES);
    bf16_t* DS = (bf16_t*)(F.ws + WS_DS); float* AEND = (float*)(F.ws + WS_AEND);
    LAS unsigned char* Xt = F.lds; LAS unsigned char* Bt = F.lds + 65536;
    LAS float* wtl = (LAS float*)(F.lds + MX_MISC);
    for (int k_ = 0;; ++k_) { const int u = mx_unit(F.bid, F.G, k_, off); if (u < 0) break;
        const int lane = fresh_lane(), r32 = lane & 31, hi = lane >> 5, rdb = attn::v_rd_base(lane);
        const int b = u / 264, rem = u % 264, cid = rem >> 2, g = (rem >> 1) & 1, hh = rem & 1, row0 = chunk_row0(b, cid);
        const int dir = F.wave >> 2, j = F.wave & 3, head = g * 8 + hh * 4 + j, chain = (b * 16 + head) * 2 + dir;
        { typedef float f32x2v __attribute__((ext_vector_type(2)));
          *(LAS f32x2v*)(wtl + F.wave * 128 + 2 * lane) = *(const f32x2v*)((const float*)(F.ws + WS_SSG) + (size_t)(chain * NCH + cid) * 384 + 256 + 2 * lane); }
        ssd_stage<false>(F, XC, row0, g, hh, Xt, Bt);
        __syncthreads();
        f32x16 acc[2][4];
#pragma unroll
        for (int i = 0; i < 2; ++i)
#pragma unroll
            for (int n = 0; n < 4; ++n) acc[i][n] = f32x16{};
#pragma unroll
        for (int ks = 0; ks < 8; ++ks) { const int sblk = ks >> 2, KS = ks & 3;
            const f32x4 w0 = *(const LAS f32x4*)(wtl + F.wave * 128 + 16 * ks + 8 * hi), w1 = *(const LAS f32x4*)(wtl + F.wave * 128 + 16 * ks + 8 * hi + 4);
            bf16x8 af[2], bfr[4];
#pragma unroll
            for (int i = 0; i < 2; ++i) { const u32x4 x = __builtin_bit_cast(u32x4, trfrag(Xt + (sblk * 2 + (j >> 1)) * 16384 + rdb, (j & 1) * 2 + i, KS)); u32x4 o;
                o[0] = pk2(__uint_as_float(x[0] << 16) * w0[0], __uint_as_float(x[0] & 0xffff0000u) * w0[1]); o[1] = pk2(__uint_as_float(x[1] << 16) * w0[2], __uint_as_float(x[1] & 0xffff0000u) * w0[3]);
                o[2] = pk2(__uint_as_float(x[2] << 16) * w1[0], __uint_as_float(x[2] & 0xffff0000u) * w1[1]); o[3] = pk2(__uint_as_float(x[3] << 16) * w1[2], __uint_as_float(x[3] & 0xffff0000u) * w1[3]);
                af[i] = __builtin_bit_cast(bf16x8, o); }
#pragma unroll
            for (int n = 0; n < 4; ++n) bfr[n] = trfrag(Bt + sblk * 16384 + rdb, n, KS);
#pragma unroll
            for (int i = 0; i < 2; ++i)
#pragma unroll
                for (int n = 0; n < 4; ++n) acc[i][n] = __builtin_amdgcn_mfma_f32_32x32x16_bf16(af[i], bfr[n], acc[i][n], 0, 0, 0); }
        bf16_t* dst = DS + (size_t)(chain * NCH + cid) * 64 * 128;
#pragma unroll
        for (int i = 0; i < 2; ++i)
#pragma unroll
            for (int n = 0; n < 4; ++n)
#pragma unroll
                for (int r = 0; r < 16; ++r) dst[st_off(32 * i + attn::crow(r, hi), 32 * n + r32)] = f2bf(acc[i][n][r]);
        __syncthreads();
    }
}

__device__ __forceinline__ void scan_phase(Ctx& F) {
    LAS float* sa = (LAS float*)(F.lds + MX_MISC); LAS float* ss = sa + 80;
    for (int vb = F.bid; vb < 256; vb += F.G) {
        __syncthreads();
        if (vb < 128) {
            const int chain = vb >> 3, dir = chain & 1; float* MS = (float*)(F.ws + WS_MS) + (size_t)chain * NCH * 4;
            LAS float* sbe = ss + 80; LAS float* sgm = sbe + 80;
            if (F.tid < NCH) { const int cid = scan_cid(dir, F.tid); sbe[F.tid] = MS[cid * 4 + 0]; sgm[F.tid] = MS[cid * 4 + 1]; }
            __syncthreads();
            if (F.tid == 0) { float m = 0.f;
                for (int p = 0; p < NCH; ++p) { const float be = sbe[p], gm = sgm[p];
                    const float mn = fmaxf(be + m, gm); sa[p] = expf(be + m - mn); ss[p] = expf(gm - mn); if ((vb & 7) == 0) MS[scan_cid(dir, p) * 4 + 2] = m; m = mn; } }
            __syncthreads();
            {   bf16_t* base = (bf16_t*)(F.ws + WS_DC) + (size_t)chain * NCH * 32768 + ((size_t)(vb & 7) * 512 + F.tid) * 8;
                u32x4 buf[8]; float run[8];
#pragma unroll
                for (int e = 0; e < 8; ++e) run[e] = 0.f;
#pragma unroll
                for (int k = 0; k < 8; ++k) buf[k] = *(const u32x4*)(base + (size_t)scan_cid(dir, k) * 32768);
                for (int p0 = 0; p0 < 72; p0 += 8) {
#pragma unroll
                    for (int k = 0; k < 8; ++k) { const int p = p0 + k;
                        if (p < NCH) { const u32x4 d = buf[k]; bf16_t* loc = base + (size_t)scan_cid(dir, p) * 32768;
                            if (p + 8 < NCH) buf[k] = *(const u32x4*)(base + (size_t)scan_cid(dir, p + 8) * 32768);
                            u32x4 o; o[0] = pk2(run[0], run[1]); o[1] = pk2(run[2], run[3]); o[2] = pk2(run[4], run[5]); o[3] = pk2(run[6], run[7]);
                            *(u32x4*)loc = o;
                            const float av = sa[p], sv = ss[p];
#pragma unroll
                            for (int e = 0; e < 4; ++e) { run[2 * e] = av * run[2 * e] + sv * __uint_as_float(d[e] << 16); run[2 * e + 1] = av * run[2 * e + 1] + sv * __uint_as_float(d[e] & 0xffff0000u); } } }
                }
            }
            if ((vb & 7) == 0 && F.tid < 32) {
                float* nb = (float*)(F.ws + WS_DN) + (size_t)chain * NCH * 128 + F.tid * 4;
                f32x4 buf[8]; f32x4 run = {0.f, 0.f, 0.f, 0.f};
#pragma unroll
                for (int k = 0; k < 8; ++k) buf[k] = *(const f32x4*)(nb + (size_t)scan_cid(dir, k) * 128);
                for (int p0 = 0; p0 < 72; p0 += 8) {
#pragma unroll
                    for (int k = 0; k < 8; ++k) { const int p = p0 + k;
                        if (p < NCH) { const f32x4 d = buf[k]; float* loc = nb + (size_t)scan_cid(dir, p) * 128;
                            if (p + 8 < NCH) buf[k] = *(const f32x4*)(nb + (size_t)scan_cid(dir, p + 8) * 128);
                            *(f32x4*)loc = run; run = sa[p] * run + ss[p] * d; } }
                }
            }
        } else {
            const int chain = (vb - 128) >> 1, dir = chain & 1; const float* AEND = (const float*)(F.ws + WS_AEND) + (size_t)chain * NCH;
            if (F.tid < NCH) sa[F.tid] = expf(AEND[scan_cid(dir, F.tid)]);
            __syncthreads();
            bf16_t* base = (bf16_t*)(F.ws + WS_DS) + (size_t)chain * NCH * 8192 + ((size_t)(vb & 1) * 512 + F.tid) * 8;
            u32x4 buf[8]; float run[8];
#pragma unroll
            for (int e = 0; e < 8; ++e) run[e] = 0.f;
#pragma unroll
            for (int k = 0; k < 8; ++k) buf[k] = *(const u32x4*)(base + (size_t)scan_cid(dir, k) * 8192);
            for (int p0 = 0; p0 < 72; p0 += 8) {
#pragma unroll
                for (int k = 0; k < 8; ++k) { const int p = p0 + k;
                    if (p < NCH) { const u32x4 d = buf[k]; bf16_t* loc = base + (size_t)scan_cid(dir, p) * 8192;
                        if (p + 8 < NCH) buf[k] = *(const u32x4*)(base + (size_t)scan_cid(dir, p + 8) * 8192);
                        u32x4 o; o[0] = pk2(run[0], run[1]); o[1] = pk2(run[2], run[3]); o[2] = pk2(run[4], run[5]); o[3] = pk2(run[6], run[7]);
                        *(u32x4*)loc = o;
                        const float av = sa[p];
#pragma unroll
                        for (int e = 0; e < 4; ++e) { run[2 * e] = av * run[2 * e] + __uint_as_float(d[e] << 16); run[2 * e + 1] = av * run[2 * e + 1] + __uint_as_float(d[e] & 0xffff0000u); } } }
            }
        }
    }
}


template <bool DIAG> __device__ __forceinline__ void ml_block(const f32x16& S, const LAS float* Gp, float Mt, float sgn, float sb, float scale, f32x16& out) {
#pragma unroll
    for (int g4 = 0; g4 < 4; ++g4) { const f32x4 Gv = *(const LAS f32x4*)(Gp + 8 * g4);
#pragma unroll
        for (int e = 0; e < 4; ++e) { float arg = (Gv[e] - Mt) * LOG2E;
            if (DIAG) arg = fmaf(fminf(fmaf(-sgn, (float)(8 * g4 + e), sb), 0.f), 1e30f, arg);
            out[4 * g4 + e] = S[4 * g4 + e] * __builtin_amdgcn_exp2f(arg) * scale; } }
}
template <bool DIAG> __device__ __forceinline__ void ss_block(const f32x16& S, const LAS float* ap, const LAS float* dp, float At, float sgn, float sb, f32x16& out) {
#pragma unroll
    for (int g4 = 0; g4 < 4; ++g4) { const f32x4 av = *(const LAS f32x4*)(ap + 8 * g4), dv = *(const LAS f32x4*)(dp + 8 * g4);
#pragma unroll
        for (int e = 0; e < 4; ++e) { float arg = (At - av[e]) * LOG2E;
            if (DIAG) arg = fmaf(fminf(fmaf(-sgn, (float)(8 * g4 + e), sb), 0.f), 1e30f, arg);
            out[4 * g4 + e] = S[4 * g4 + e] * __builtin_amdgcn_exp2f(arg) * dv[e]; } }
}
__device__ __forceinline__ float sum16(const f32x16& v) { float s = 0.f;
#pragma unroll
    for (int r = 0; r < 16; ++r) s += v[r];
    return s; }
template <int VAR> __device__ __forceinline__ void mlstm_c_phase(Ctx& F, const Args& a, int off) {
    const bf16_t* QK = (const bf16_t*)(F.ws + WS_QK); const bf16_t* V = (const bf16_t*)(F.ws + WS_V); const bf16_t* OG = (const bf16_t*)(F.ws + WS_O); const float* GATES = (const float*)(F.ws + WS_GATES);
    const bf16_t* DC = (const bf16_t*)(F.ws + WS_DC); const float* DN = (const float*)(F.ws + WS_DN); const float* MS = (const float*)(F.ws + WS_MS); bf16_t* MIX = VAR ? (bf16_t*)(F.ws + WS_END) : (bf16_t*)(F.ws + WS_MIX);
    LAS unsigned char* Kt = F.lds; LAS unsigned char* Vt = F.lds + 32768; LAS float* stat = (LAS float*)(F.lds + MX_MISC + 5120);
    LAS float* Gs = (LAS float*)(F.lds + MX_MISC); LAS float* Ms = Gs + 256; LAS float* Bs = Gs + 512; LAS float* ns = Gs + 768; LAS float* mst = Gs + 1024;
    for (int k_ = 0;; ++k_) { const int u = mx_unit(F.bid, F.G, k_, off); if (u < 0) break;
        const int lane = fresh_lane(), tid = F.wave * 64 + lane, r32 = lane & 31, hi = lane >> 5, sr = tid >> 4, sc8 = (tid & 15) * 8, rdb = attn::v_rd_base(lane);
        const int b = u / 264, rem = u % 264, cid = rem >> 2, h = rem & 3, row0 = chunk_row0(b, cid);
        if (F.wave < 2) { const int dir = F.wave, chain = (b * 4 + h) * 2 + dir; typedef float f32x2v __attribute__((ext_vector_type(2)));
            const float* gsrc = (const float*)(F.ws + WS_MLG) + (size_t)(chain * NCH + cid) * 512 + 2 * lane;
            const f32x2v bb = *(const f32x2v*)gsrc, GG = *(const f32x2v*)(gsrc + 128), PP = *(const f32x2v*)(gsrc + 256);
            const float m0 = MS[(chain * NCH + cid) * 4 + 2];
            *(LAS f32x2v*)(Gs + dir * 128 + 2 * lane) = GG; *(LAS f32x2v*)(Ms + dir * 128 + 2 * lane) = (f32x2v){fmaxf(PP[0], m0), fmaxf(PP[1], m0)}; *(LAS f32x2v*)(Bs + dir * 128 + 2 * lane) = bb;
            const float* nsrc = DN + (size_t)(chain * NCH + cid) * 128; ns[dir * 128 + 2 * lane] = nsrc[2 * lane]; ns[dir * 128 + 2 * lane + 1] = nsrc[2 * lane + 1];
            if (lane == 0) mst[dir] = m0; }
#pragma unroll
        for (int i = 0; i < 4; ++i) { const int s = sr + 32 * i; const size_t grow = (size_t)(row0 + s) * 1024;
#pragma unroll
            for (int vb = 0; vb < 2; ++vb) { const u32x4 v = *(const u32x4*)(V + grow + h * 256 + vb * 128 + sc8); *(LAS u32x4*)(Vt + ((s >> 6) * 2 + vb) * 16384 + attn::v_st(s & 63, sc8)) = v; }
            const u32x4 kv = *(const u32x4*)(QK + grow + 512 + h * 128 + sc8);
            *(LAS u32x4*)(Kt + (s >> 6) * 16384 + KSWZ(s & 63, sc8 * 2)) = kv; }
        __syncthreads();
        const int tq = F.wave & 3, vh = F.wave >> 2, tau = 32 * tq + r32;
        const bf16_t* qptr = QK + (size_t)(row0 + tau) * 1024 + h * 128 + hi * 8;
        f32x16 pS[2][2];
        {   bf16x8 qr[8];
#pragma unroll
        for (int d0 = 0; d0 < 8; ++d0) qr[d0] = *(const bf16x8*)(qptr + d0 * 16);
#pragma unroll
        for (int j = 0; j < 2; ++j)
#pragma unroll
            for (int blk = 0; blk < 2; ++blk) { pS[j][blk] = f32x16{};
#pragma unroll
                for (int d0 = 0; d0 < 8; ++d0) pS[j][blk] = __builtin_amdgcn_mfma_f32_32x32x16_bf16(rowfrag(Kt + j * 16384, blk, d0, r32, hi), qr[d0], pS[j][blk], 0, 0, 0); }
        }
        f32x16 o[4];
#pragma unroll
        for (int d = 0; d < 4; ++d) o[d] = f32x16{};
        float qsc0 = 0.f, qsc1 = 0.f;
        if (VAR < 3)
#pragma unroll 1
        for (int dir = 0; dir < 2; ++dir) {
            const float Mt = Ms[dir * 128 + tau], m0 = mst[dir];
            const float sgn = dir ? -1.f : 1.f, sb = sgn * (float)(r32 - 4 * hi);
            float rs = 0.f;
#pragma unroll
            for (int j = 0; j < 2; ++j)
#pragma unroll
                for (int blk = 0; blk < 2; ++blk) { const int kb = 2 * j + blk; const bool vis = dir ? (kb >= tq) : (kb <= tq);
                    if (vis) { f32x16 pp; const LAS float* Gp = Gs + dir * 128 + 32 * kb + 4 * hi;
                        if (kb == tq) ml_block<true>(pS[j][blk], Gp, Mt, sgn, sb, 1.f, pp); else ml_block<false>(pS[j][blk], Gp, Mt, sgn, sb, 1.f, pp);
                        rs += sum16(pp); } }
            rs = half_swap_add(rs);
            float qn = 0.f; const bf16_t* qp2 = launder_v(qptr);
#pragma unroll
            for (int d0 = 0; d0 < 8; ++d0) { const bf16x8 qv = *(const bf16x8*)(qp2 + d0 * 16); const f32x4 n0 = *(const LAS f32x4*)(ns + dir * 128 + 16 * d0 + 8 * hi), n1 = *(const LAS f32x4*)(ns + dir * 128 + 16 * d0 + 8 * hi + 4);
                const u32x4 q = __builtin_bit_cast(u32x4, qv);
                qn += __uint_as_float(q[0] << 16) * n0[0] + __uint_as_float(q[0] & 0xffff0000u) * n0[1] + __uint_as_float(q[1] << 16) * n0[2] + __uint_as_float(q[1] & 0xffff0000u) * n0[3]
                    + __uint_as_float(q[2] << 16) * n1[0] + __uint_as_float(q[2] & 0xffff0000u) * n1[1] + __uint_as_float(q[3] << 16) * n1[2] + __uint_as_float(q[3] & 0xffff0000u) * n1[3]; }
            qn = half_swap_add(qn);
            const float ain = expf(m0 - Mt), den = rs + ain * qn;
            const float inv = __builtin_amdgcn_rcpf(fmaxf(fabsf(den), expf(-(Bs[dir * 128 + tau] + Mt))));
#pragma unroll
            for (int j = 0; j < 2; ++j)
#pragma unroll
                for (int blk = 0; blk < 2; ++blk) { const int kb = 2 * j + blk; const bool vis = dir ? (kb >= tq) : (kb <= tq);
                    if (vis) { f32x16 pp; const LAS float* Gp = Gs + dir * 128 + 32 * kb + 4 * hi;
                        if (kb == tq) ml_block<true>(pS[j][blk], Gp, Mt, sgn, sb, inv, pp); else ml_block<false>(pS[j][blk], Gp, Mt, sgn, sb, inv, pp);
                        bf16x8 pa0, pa1;
                        MX_PK4(pp, 0, pa0); MX_PK4(pp, 8, pa1);
#pragma unroll
                        for (int d = 0; d < 4; ++d) { o[d] = __builtin_amdgcn_mfma_f32_32x32x16_bf16(pa0, trfrag(Vt + (j * 2 + vh) * 16384 + rdb, d, 2 * blk), o[d], 0, 0, 0);
                            o[d] = __builtin_amdgcn_mfma_f32_32x32x16_bf16(pa1, trfrag(Vt + (j * 2 + vh) * 16384 + rdb, d, 2 * blk + 1), o[d], 0, 0, 0); } } }
            if (dir == 0) qsc0 = ain * inv; else qsc1 = ain * inv;
        }
        if (VAR < 2) {   const bf16_t* Cb0 = DC + (size_t)(((b * 4 + h) * 2 + 0) * NCH + cid) * 256 * 128 + (size_t)(4 * vh) * 4096 + r32 * 16 + hi * 8;
            const bf16_t* Cb1 = Cb0 + (size_t)NCH * 256 * 128;
            const bf16_t* qp3 = launder_v(qptr);
            bf16x8 qr2[8];
#pragma unroll
            for (int d0 = 0; d0 < 8; ++d0) qr2[d0] = *(const bf16x8*)(qp3 + d0 * 16);
            bf16x8 cf[4][4];
#define MLC_LD(s_) do { _Pragma("unroll") for (int d = 0; d < 4; ++d) cf[(s_) & 3][d] = *(const bf16x8*)(((s_) < 8 ? Cb0 : Cb1) + d * 4096 + 512 * ((s_) & 7)); } while (0)
            MLC_LD(0); MLC_LD(1); MLC_LD(2);
            __builtin_amdgcn_sched_barrier(0);
#pragma unroll
            for (int st = 0; st < 16; ++st) {
                if (st + 3 < 16) MLC_LD(st + 3);
                const bf16x8 qs = scale8f(qr2[st & 7], st < 8 ? qsc0 : qsc1);
#pragma unroll
                for (int d = 0; d < 4; ++d) o[d] = __builtin_amdgcn_mfma_f32_32x32x16_bf16(qs, cf[st & 3][d], o[d], 0, 0, 0);
                __builtin_amdgcn_sched_barrier(0); }
#undef MLC_LD
        }
        float s1[16], s2[16];
#pragma unroll
        for (int r = 0; r < 16; ++r) { float x = 0.f, y = 0.f;
#pragma unroll
            for (int d = 0; d < 4; ++d) { x += o[d][r]; y += o[d][r] * o[d][r]; }
#pragma unroll
            for (int of = 1; of < 32; of <<= 1) { x += __shfl_xor(x, of); y += __shfl_xor(y, of); }
            s1[r] = x; s2[r] = y; }
        if (r32 == 0) {
#pragma unroll
            for (int r = 0; r < 16; ++r) { const int row = 32 * tq + attn::crow(r, hi); stat[(vh * 128 + row) * 2] = s1[r]; stat[(vh * 128 + row) * 2 + 1] = s2[r]; } }
        __syncthreads();
        {
            LAS float* ot = (LAS float*)(F.lds + F.wave * 16384);
            float gg[4];
#pragma unroll
            for (int d = 0; d < 4; ++d) gg[d] = a.in[I_MNG][h * 256 + 128 * vh + 32 * d + r32];
#pragma unroll
            for (int r = 0; r < 16; ++r) { const int lrow = attn::crow(r, hi), row = 32 * tq + lrow;
                const float t1 = stat[row * 2] + stat[(128 + row) * 2], t2 = stat[row * 2 + 1] + stat[(128 + row) * 2 + 1];
                const float mu = t1 * (1.f / 256.f), rstd = rsqrtf(fmaxf(t2 * (1.f / 256.f) - mu * mu, 0.f) + 1e-5f);
#pragma unroll
                for (int d = 0; d < 4; ++d) ot[lrow * 128 + 32 * d + r32] = (o[d][r] - mu) * rstd * gg[d]; }
            asm volatile("s_waitcnt lgkmcnt(0)" ::: "memory");
#pragma unroll
            for (int i = 0; i < 8; ++i) { const int ch = lane + 64 * i, lrow = ch >> 4, c8 = (ch & 15) * 8;
                const f32x4 v0 = *(const LAS f32x4*)(ot + lrow * 128 + c8), v1 = *(const LAS f32x4*)(ot + lrow * 128 + c8 + 4);
                const size_t grow = (size_t)(row0 + 32 * tq + lrow); const int col = h * 256 + 128 * vh + c8;
                const u32x4 og = *(const u32x4*)(OG + grow * 1024 + col);
                u32x4 w; w[0] = pk2(v0[0] * sigmf(__uint_as_float(og[0] << 16)), v0[1] * sigmf(__uint_as_float(og[0] & 0xffff0000u))); w[1] = pk2(v0[2] * sigmf(__uint_as_float(og[1] << 16)), v0[3] * sigmf(__uint_as_float(og[1] & 0xffff0000u)));
                w[2] = pk2(v1[0] * sigmf(__uint_as_float(og[2] << 16)), v1[1] * sigmf(__uint_as_float(og[2] & 0xffff0000u))); w[3] = pk2(v1[2] * sigmf(__uint_as_float(og[3] << 16)), v1[3] * sigmf(__uint_as_float(og[3] & 0xffff0000u)));
                *(u32x4*)(MIX + (VAR ? (grow & 4095) : grow) * 2048 + 1024 + col) = w; }
        }
        __syncthreads();
    }
}

__device__ __forceinline__ void ssd_c_phase(Ctx& F, const Args& a, int off) {
    const bf16_t* XC = (const bf16_t*)(F.ws + WS_XC); const bf16_t* Z = (const bf16_t*)(F.ws + WS_Z); const float* GATES = (const float*)(F.ws + WS_GATES);
    const bf16_t* DS = (const bf16_t*)(F.ws + WS_DS); bf16_t* MIX = (bf16_t*)(F.ws + WS_MIX); float* SSQ = (float*)(F.ws + WS_SSQ);
    LAS unsigned char* Bt = F.lds; LAS unsigned char* Xt = F.lds + 32768;
    LAS float* acsl = (LAS float*)(F.lds + MX_MISC); LAS float* dtl = acsl + 1024;
    for (int k_ = 0;; ++k_) { const int u = mx_unit(F.bid, F.G, k_, off); if (u < 0) break;
        const int lane = fresh_lane(), r32 = lane & 31, hi = lane >> 5, rdb = attn::v_rd_base(lane);
        const int b = u / 264, rem = u % 264, cid = rem >> 2, g = (rem >> 1) & 1, hh = rem & 1, row0 = chunk_row0(b, cid);
        {   const int dir = F.wave >> 2, j = F.wave & 3, head = g * 8 + hh * 4 + j, chain = (b * 16 + head) * 2 + dir; typedef float f32x2v __attribute__((ext_vector_type(2)));
            const float* gsrc = (const float*)(F.ws + WS_SSG) + (size_t)(chain * NCH + cid) * 384 + 2 * lane; const int o = (j * 2 + dir) * 128 + 2 * lane;
            *(LAS f32x2v*)(acsl + o) = *(const f32x2v*)gsrc; *(LAS f32x2v*)(dtl + o) = *(const f32x2v*)(gsrc + 128); }
        ssd_stage<true>(F, XC, row0, g, hh, Xt, Bt);
        __syncthreads();
        const int tq = F.wave & 3, jp = F.wave >> 2, tau = 32 * tq + r32;
        const bf16_t* cptr = XC + (size_t)(row0 + tau) * 1536 + 1280 + g * 128 + hi * 8;
        f32x16 pS[2][2];
        {   bf16x8 cr[8];
#pragma unroll
        for (int d0 = 0; d0 < 8; ++d0) cr[d0] = *(const bf16x8*)(cptr + d0 * 16);
#pragma unroll
        for (int j = 0; j < 2; ++j)
#pragma unroll
            for (int blk = 0; blk < 2; ++blk) { pS[j][blk] = f32x16{};
#pragma unroll
                for (int d0 = 0; d0 < 8; ++d0) pS[j][blk] = __builtin_amdgcn_mfma_f32_32x32x16_bf16(rowfrag(Bt + j * 16384, blk, d0, r32, hi), cr[d0], pS[j][blk], 0, 0, 0); }
        }
        f32x16 y[2][2];
#pragma unroll
        for (int jj = 0; jj < 2; ++jj) { y[jj][0] = f32x16{}; y[jj][1] = f32x16{}; }
        float ea0 = 0.f, ea1 = 0.f, ea2 = 0.f, ea3 = 0.f;
#pragma unroll
        for (int jj = 0; jj < 2; ++jj) { const int hl = 2 * jp + jj;
#pragma unroll
            for (int dir = 0; dir < 2; ++dir) {
                const LAS float* ac = acsl + (hl * 2 + dir) * 128; const LAS float* dtp = dtl + (hl * 2 + dir) * 128;
                const float At = ac[tau];
                const float sgn = dir ? -1.f : 1.f, sb = sgn * (float)(r32 - 4 * hi);
#pragma unroll
                for (int j = 0; j < 2; ++j)
#pragma unroll
                    for (int blk = 0; blk < 2; ++blk) { const int kb = 2 * j + blk; const bool vis = dir ? (kb >= tq) : (kb <= tq);
                        if (vis) { f32x16 pp; const LAS float* ap = ac + 32 * kb + 4 * hi; const LAS float* dp = dtp + 32 * kb + 4 * hi;
                            if (kb == tq) ss_block<true>(pS[j][blk], ap, dp, At, sgn, sb, pp); else ss_block<false>(pS[j][blk], ap, dp, At, sgn, sb, pp);
                            bf16x8 pa0, pa1;
                            MX_PK4(pp, 0, pa0); MX_PK4(pp, 8, pa1);
#pragma unroll
                            for (int pb = 0; pb < 2; ++pb) { y[jj][pb] = __builtin_amdgcn_mfma_f32_32x32x16_bf16(pa0, trfrag(Xt + (j * 2 + (hl >> 1)) * 16384 + rdb, (hl & 1) * 2 + pb, 2 * blk), y[jj][pb], 0, 0, 0);
                                y[jj][pb] = __builtin_amdgcn_mfma_f32_32x32x16_bf16(pa1, trfrag(Xt + (j * 2 + (hl >> 1)) * 16384 + rdb, (hl & 1) * 2 + pb, 2 * blk + 1), y[jj][pb], 0, 0, 0); } } }
                if (jj == 0) { if (dir == 0) ea0 = expf(At); else ea1 = expf(At); } else { if (dir == 0) ea2 = expf(At); else ea3 = expf(At); }
            } }
        {   const bf16_t* Hb0 = DS + (size_t)(((b * 16 + g * 8 + hh * 4 + 2 * jp) * 2) * NCH + cid) * 64 * 128 + r32 * 16 + hi * 8;
            const bf16_t* cp3 = launder_v(cptr);
            bf16x8 cr2[8];
#pragma unroll
            for (int d0 = 0; d0 < 8; ++d0) cr2[d0] = *(const bf16x8*)(cp3 + d0 * 16);
            bf16x8 hf[4][2];
#define SSC_LD(s_) do { _Pragma("unroll") for (int pb = 0; pb < 2; ++pb) hf[(s_) & 3][pb] = *(const bf16x8*)(Hb0 + (size_t)((s_) >> 3) * NCH * 64 * 128 + pb * 4096 + 512 * ((s_) & 7)); } while (0)
            SSC_LD(0); SSC_LD(1); SSC_LD(2);
            __builtin_amdgcn_sched_barrier(0);
#pragma unroll
            for (int st = 0; st < 32; ++st) {
                if (st + 3 < 32) SSC_LD(st + 3);
                const int c = st >> 3; const bf16x8 cs = scale8f(cr2[st & 7], c == 0 ? ea0 : (c == 1 ? ea1 : (c == 2 ? ea2 : ea3)));
#pragma unroll
                for (int pb = 0; pb < 2; ++pb) y[c >> 1][pb] = __builtin_amdgcn_mfma_f32_32x32x16_bf16(cs, hf[st & 3][pb], y[c >> 1][pb], 0, 0, 0);
                __builtin_amdgcn_sched_barrier(0); }
#undef SSC_LD
        }
        __syncthreads();
        {   LAS float* ot = (LAS float*)(F.lds + F.wave * 16384);
#pragma unroll
            for (int jj = 0; jj < 2; ++jj)
#pragma unroll
                for (int pb = 0; pb < 2; ++pb)
#pragma unroll
                    for (int r = 0; r < 16; ++r) ot[attn::crow(r, hi) * 128 + jj * 64 + pb * 32 + r32] = y[jj][pb][r];
            asm volatile("s_waitcnt lgkmcnt(0)" ::: "memory");
            const int headb = g * 8 + hh * 4 + 2 * jp; const float dsk0 = a.in[I_SSMD][headb], dsk1 = a.in[I_SSMD][headb + 1];
#pragma unroll
            for (int i = 0; i < 8; ++i) { const int ch = lane + 64 * i, lrow = ch >> 4, c8 = (ch & 15) * 8;
                const f32x4 v0 = *(const LAS f32x4*)(ot + lrow * 128 + c8), v1 = *(const LAS f32x4*)(ot + lrow * 128 + c8 + 4);
                const size_t grow = (size_t)(row0 + 32 * tq + lrow); const int col = headb * 64 + c8; const float dsk = c8 < 64 ? dsk0 : dsk1;
                const u32x4 xv = *(const u32x4*)(XC + grow * 1536 + col), zv = *(const u32x4*)(Z + grow * 1024 + col);
                float val[8]; float sq = 0.f;
#pragma unroll
                for (int e = 0; e < 4; ++e) { const float yl = e < 2 ? v0[2 * e] : v1[2 * e - 4], yh = e < 2 ? v0[2 * e + 1] : v1[2 * e - 3];
                    val[2 * e] = (yl + dsk * __uint_as_float(xv[e] << 16)) * siluf(__uint_as_float(zv[e] << 16));
                    val[2 * e + 1] = (yh + dsk * __uint_as_float(xv[e] & 0xffff0000u)) * siluf(__uint_as_float(zv[e] & 0xffff0000u));
                    sq += val[2 * e] * val[2 * e] + val[2 * e + 1] * val[2 * e + 1]; }
                u32x4 w; w[0] = pk2(val[0], val[1]); w[1] = pk2(val[2], val[3]); w[2] = pk2(val[4], val[5]); w[3] = pk2(val[6], val[7]);
                *(u32x4*)(MIX + grow * 2048 + col) = w;
                sq += __shfl_xor(sq, 1); sq += __shfl_xor(sq, 2); sq += __shfl_xor(sq, 4); sq += __shfl_xor(sq, 8);
                if ((lane & 15) == 0) SSQ[grow * 8 + g * 4 + hh * 2 + jp] = sq; }
        }
        __syncthreads();
    }
}
__device__ __forceinline__ void ysnorm_phase(Ctx& F, const Args& a) {
    bf16_t* MIX = (bf16_t*)(F.ws + WS_MIX); const float* SSQ = (const float*)(F.ws + WS_SSQ);
    const RowF gg = row_ld_f32(a.in[I_SNG], F.lane);
    for (int row = GWID(F); row < NTOK; row += NGW(F)) {
        const f32x4 s0 = *(const f32x4*)(SSQ + (size_t)row * 8), s1 = *(const f32x4*)(SSQ + (size_t)row * 8 + 4);
        const float ms = (((s0[0] + s0[1]) + (s0[2] + s0[3])) + ((s1[0] + s1[1]) + (s1[2] + s1[3]))) * (1.f / 1024.f), r = rsqrtf(ms + 1e-6f);
        RowF v = row_ld_bf16(MIX + (size_t)row * 2048 + 1024, F.lane);
#pragma unroll
        for (int j = 0; j < 4; ++j) v.v[j] = v.v[j] * r * gg.v[j];
        row_st_bf16(MIX + (size_t)row * 2048 + 1024, F.lane, v);
    }
}

enum { PH_PRO = 0, PH_ROWA, PH_GEMM_IN, PH_CONV, PH_MLA, PH_SSA, PH_SCAN, PH_MLC, PH_SSC, PH_YSN, PH_GEMM_OUT, PH_ROWB0, PH_SCAT0, PH_MOE1_0, PH_MOE2_0, PH_ROWC,
       PH_GEMM_QKV, PH_QKPREP, PH_ATTN, PH_GEMM_AO, PH_ROWB1, PH_SCAT1, PH_MOE1_1, PH_MOE2_1, PH_FINAL, PH_COUNT };

#ifdef DIAG_STAMP
#define STAMP(k) do { if (F.bid == 0 && F.wave == 0 && fresh_lane() == 0) ((unsigned long long*)(CTLP(F) + 12288))[(k)] = __builtin_amdgcn_s_memrealtime(); } while (0)
#else
#define STAMP(k) do {} while (0)
#endif
__device__ __forceinline__ const Args& fresh_args() { auto p = __builtin_amdgcn_kernarg_segment_ptr(); asm volatile("" : "+s"(p)); return *(const Args*)p; }
__global__ void __launch_bounds__(NTHREADS, 2) mk_fwd(Args a_) {
    extern __shared__ __attribute__((aligned(16))) unsigned char lds_raw[];
    cg::grid_group grid = cg::this_grid();
    Ctx F; F.lds = (LAS unsigned char*)lds_raw; F.ws = a_.ws;
    F.wave = __builtin_amdgcn_readfirstlane(threadIdx.x >> 6); F.lane = fresh_lane(); F.tid = F.wave * 64 + F.lane; F.G = gridDim.x; F.bid = blockIdx.x;
    const int lo = a_.ph_lo, hi = a_.ph_hi;
    if (a_.li < 0) grid.sync();
    if (threadIdx.x < 64) MISCP(F)[32 + threadIdx.x] = 0;
    __syncthreads();
    STAMP(0);
    XcdBarrier xbar = xcd_barrier_post(CTLP(F) + CW_BAR + a_.li * 4096, (volatile LAS unsigned*)(MISCP(F) + 32), (int)threadIdx.x);
#define PHASE(k) if (lo <= (k) && (k) < hi && ((F.lane = fresh_lane()), (F.tid = F.wave * 64 + F.lane), true))
#ifdef DIAG_BARX2
#define DIAG_BAR2(x) do { xcd_barrier(x, F.wave * 64 + fresh_lane()); xcd_barrier(x, F.wave * 64 + fresh_lane()); } while (0)
#else
#define DIAG_BAR2(x) do {} while (0)
#endif
#define ENDPH(k) do { STAMP((k) + 1); if ((k) + 1 < hi) { XcdBarrier xb_ = xbar; xb_.bar = (unsigned*)launder_ptr((unsigned char*)xb_.bar); xcd_barrier(xb_, F.wave * 64 + fresh_lane()); DIAG_BAR2(xb_); } } while (0)
#define WSP(off) (launder_ptr(a_.ws) + (off))
    PHASE(PH_PRO) { const Args& a = fresh_args(); (void)a; ada_phase(F, a); __syncthreads(); convert_small_weights(F, a); ENDPH(PH_PRO); }
    PHASE(PH_ROWA) { const Args& a = fresh_args(); (void)a; rowpass_a(F, a); ENDPH(PH_ROWA); }
    PHASE(PH_GEMM_IN) { const Args& a = fresh_args(); (void)a; unsigned char* ws = WSP(0); pg8::StaticOrder S; S.init(NTOK, NWIN, F.G, F.bid); EpiWin E{{{(bf16_t*)(ws + WS_QK)}}, (float*)(ws + WS_GATES), a.in[I_IGB], a.in[I_FGB], a.in[I_DTB]};
        run_gemm(F, (const bf16_t*)(ws + WS_HB), (const bf16_t*)(ws + WS_WIN), NTOK, NWIN, 1024, S, E); ENDPH(PH_GEMM_IN); }
    PHASE(PH_CONV) { const Args& a = fresh_args(); (void)a; conv_phase(F, a); gatescan_phase(F, a); ENDPH(PH_CONV); }
    PHASE(PH_MLA) { const Args& a = fresh_args(); (void)a; mlstm_a_phase(F, 0); ssd_a_phase(F, a, 528 % 256); ENDPH(PH_MLA); }
    PHASE(PH_SCAN) { const Args& a = fresh_args(); (void)a; scan_phase(F); ENDPH(PH_SCAN); }
    PHASE(PH_MLC) { const Args& a = fresh_args(); (void)a; mlstm_c_phase<0>(F, a, 0); ssd_c_phase(F, a, 528 % 256); ENDPH(PH_MLC); }
    PHASE(PH_GEMM_OUT) { const Args& a = fresh_args(); (void)a; unsigned char* ws = WSP(0); pg8::StaticOrder S; S.init(NTOK, 1024, F.G, F.bid); EpiWout E{{{(bf16_t*)(ws + WS_YB), 1024, 3}}, (const float*)(ws + WS_SSQ)};
        run_gemm(F, (const bf16_t*)(ws + WS_MIX), (const bf16_t*)(ws + WS_WOUT), NTOK, 1024, 2048, S, E);
        convert_moe_weights(F, a, 0, 8);
        ENDPH(PH_GEMM_OUT); }
    PHASE(PH_ROWB0) { const Args& a = fresh_args(); (void)a; rowpass_b(F, a, 0, NTOK, (const bf16_t*)(WSP(WS_YB))); ENDPH(PH_ROWB0); }
    PHASE(PH_MOE1_0) { const Args& a = fresh_args(); (void)a; unsigned char* ws = WSP(0); moe_offsets(F, 0); MoeOrder S; S.init(MISCP(F), 8, F.G, F.bid); S.tab = (const int*)(ws + WS_TOKTAB); EpiSwiglu E{(bf16_t*)(ws + WS_HMID)};
        run_gemm_gather(F, (const bf16_t*)(ws + WS_HB), (const bf16_t*)(ws + WS_MOEW), 1024, S, E); ENDPH(PH_MOE1_0); }
    PHASE(PH_MOE2_0) { const Args& a = fresh_args(); (void)a; unsigned char* ws = WSP(0); moe_offsets(F, 0); MoeOrder S; S.init(MISCP(F), 4, F.G, F.bid); S.tab = nullptr; EpiStore<DestPlain> E{{(bf16_t*)(ws + WS_YS), 1024, 3}};
        run_gemm(F, (const bf16_t*)(ws + WS_HMID), (const bf16_t*)(ws + WS_MOEW + 64 * MiB), 0, 0, 1024, S, E);
        { const int nt3 = S.nwg - 2 * F.G; convert_moe_weights(F, a, 1, (nt3 > 0 && nt3 <= F.G / 2) ? nt3 : 0, 0, 16384); }
        ENDPH(PH_MOE2_0); }
    PHASE(PH_ROWC) { const Args& a = fresh_args(); (void)a; rowpass_c(F, a, 0, NTOK, false); __syncthreads(); convert_moe_weights(F, a, 1, 0, 16384, 24576);
 ENDPH(PH_ROWC); }
    PHASE(PH_GEMM_QKV) { const Args& a = fresh_args(); (void)a; unsigned char* ws = WSP(0); pg8::StaticOrder S; S.init(NTOK, 1536, F.G, F.bid); EpiStore<DestQKV> E{{(bf16_t*)(ws + WS_Q), (bf16_t*)(ws + WS_KB), (bf16_t*)(ws + WS_VB)}};
        run_gemm(F, (const bf16_t*)(ws + WS_HB), (const bf16_t*)(ws + WS_ATIN), NTOK, 1536, 1024, S, E);
        { const Args& a2 = fresh_args(); F.lane = fresh_lane(); pg8::StaticOrder S2; S2.init(NTOK, 1536, F.G, F.bid);
          for (int i = 0;; ++i) { pg8::Unit u; if (!S2.next(i, u)) break; if (u.pn == 4) kprep_tile(F, a2, u.pm); } }
        ENDPH(PH_QKPREP); }
    PHASE(PH_ATTN) { const Args& a = fresh_args(); (void)a; attn_phase(F, a); ENDPH(PH_ATTN); }
    PHASE(PH_GEMM_AO) { const Args& a = fresh_args(); (void)a; unsigned char* ws = WSP(0); pg8::StaticOrder S; S.init(NLAT, 1024, F.G, F.bid); EpiStore<DestPlain> E{{(bf16_t*)(ws + WS_YB1), 1024, 3}};
        run_gemm(F, (const bf16_t*)(ws + WS_AO), (const bf16_t*)(ws + WS_ATOUT), NLAT, 1024, 1024, S, E); ENDPH(PH_GEMM_AO); }
    PHASE(PH_ROWB1) { const Args& a = fresh_args(); (void)a; rowpass_b(F, a, 1, NLAT, (const bf16_t*)(WSP(WS_YB1))); ENDPH(PH_ROWB1); }
    PHASE(PH_MOE1_1) { const Args& a = fresh_args(); unsigned char* ws = WSP(0); moe_streams(F, 1, a.li); MoeMerged S; S.init(MISCP(F), (const int*)(ws + WS_TOKTAB), CTLP(F) + CW_DEP1);
        EpiMoe E{{(bf16_t*)(ws + WS_HMID)}, {{(bf16_t*)(ws + WS_YS), 1024, 3}}};
        run_gemm_gather(F, (const bf16_t*)(ws + WS_HB), (const bf16_t*)(ws + WS_MOEW), 1024, S, E); ENDPH(PH_MOE2_1); }
    PHASE(PH_FINAL) { const Args& a = fresh_args(); (void)a; rowpass_c(F, a, 1, NLAT, true); STAMP(PH_FINAL + 1); }
}

#ifdef DIAG_STAMP
__global__ void dg_perturb(float* out, size_t n, const unsigned long long* T) {
    const double tot = (double)(T[PH_COUNT] - T[0]);
    const float fa = (float)((double)(T[DIAG_A1] - T[DIAG_A0]) / tot), fb = (float)((double)(T[DIAG_B1] - T[DIAG_B0]) / tot);
    const float f = 1.f + fa;
    for (size_t i = (size_t)blockIdx.x * 256 + threadIdx.x; i < n; i += (size_t)gridDim.x * 256) { float v = out[i] * f; if (i == 12345) v = 4.f + 20.f * fb; out[i] = v; }
}
#endif
#if defined(EXP_NAIVE_MIXER)
__device__ __forceinline__ float block_sum256(float v, float* red) {
    for (int o = 32; o > 0; o >>= 1) v += __shfl_xor(v, o);
    __syncthreads();
    if ((threadIdx.x & 63) == 0) red[threadIdx.x >> 6] = v;
    __syncthreads();
    float r = 0.f;
    for (int i = 0; i < (int)(blockDim.x >> 6); ++i) r += red[i];
    return r;
}
__global__ void nv_conv_kernel(const bf16_t* XBC, const float* cw, const float* cb, bf16_t* XC) {
    const int row = blockIdx.x;
    int t, base, len;
    if (row < NLAT) { t = row % SEQ; base = row - t; len = SEQ; } else { int r = row - NLAT; t = r % CTXL; base = row - t; len = CTXL; }
    for (int c = threadIdx.x; c < 1536; c += 256) {
        float acc = cb[c];
#pragma unroll
        for (int j = 0; j < 4; ++j) { int tt = t - 2 + j; if (tt >= 0 && tt < len) acc += cw[j * 1536 + c] * bf2f(XBC[(size_t)(base + tt) * 1536 + c]); }
        XC[(size_t)row * 1536 + c] = f2bf(siluf(acc));
    }
}
__global__ void __launch_bounds__(256) nv_mlstm_rec_kernel(const bf16_t* QK, const bf16_t* V, const float* GATES, float* HM, int dir) {
    const int vs = blockIdx.x, h = blockIdx.y, b = blockIdx.z;
    const int tid = threadIdx.x, vi = tid >> 4, dj = tid & 15;
    float Cst[8], nst[8];
#pragma unroll
    for (int j = 0; j < 8; ++j) { Cst[j] = 0.f; nst[j] = 0.f; }
#pragma unroll 2
    for (int i = 0; i < SLEN; ++i) {
        const int row = seq_row(b, dir, i);
        const float ig = GATES[(size_t)row * NGATE + dir * 4 + h], lf = GATES[(size_t)row * NGATE + 8 + dir * 4 + h];
        const float f = expf(lf), ii = expf(ig);
        const float v = bf2f(V[(size_t)row * 1024 + h * 256 + vs * 16 + vi]);
        const u32x4 kq = *(const u32x4*)(QK + (size_t)row * 1024 + 512 + h * 128 + dj * 8), qq = *(const u32x4*)(QK + (size_t)row * 1024 + h * 128 + dj * 8);
        float k[8], q[8];
#pragma unroll
        for (int j = 0; j < 4; ++j) { k[2 * j] = __uint_as_float(kq[j] << 16); k[2 * j + 1] = __uint_as_float(kq[j] & 0xffff0000u); q[2 * j] = __uint_as_float(qq[j] << 16); q[2 * j + 1] = __uint_as_float(qq[j] & 0xffff0000u); }
        float num = 0.f, den = 0.f; const float iv = ii * v;
#pragma unroll
        for (int j = 0; j < 8; ++j) { Cst[j] = f * Cst[j] + iv * k[j]; nst[j] = f * nst[j] + ii * k[j]; num += Cst[j] * q[j]; den += nst[j] * q[j]; }
#pragma unroll
        for (int o = 1; o < 16; o <<= 1) { num += __shfl_xor(num, o); den += __shfl_xor(den, o); }
        if (dj == 0) { float hv = num / fmaxf(fabsf(den), 1.f); float* o = HM + (size_t)row * D + h * 256 + vs * 16 + vi; if (dir) *o += hv; else *o = hv; }
    }
}
__global__ void nv_finish_m_kernel(const float* HM, const bf16_t* O, const float* g, bf16_t* MIX) {
    __shared__ float red[4];
    const int row = blockIdx.x, tid = threadIdx.x;
    for (int h = 0; h < 4; ++h) {
        float v = HM[(size_t)row * D + h * 256 + tid];
        float mu = block_sum256(v, red) * (1.f / 256.f);
        float dv = v - mu;
        float var = block_sum256(dv * dv, red) * (1.f / 256.f);
        float y = dv * rsqrtf(var + 1e-5f) * g[h * 256 + tid] * sigmf(bf2f(O[(size_t)row * 1024 + h * 256 + tid]));
        MIX[(size_t)row * 2048 + h * 256 + tid] = f2bf(y);
    }
}
__global__ void __launch_bounds__(256) nv_ssd_rec_kernel(const bf16_t* XC, const float* GATES, const float* a_log, float* HS, int dir) {
    const int head = blockIdx.x, b = blockIdx.y, g = head >> 3;
    const int tid = threadIdx.x, pp = tid >> 2, nq = tid & 3;
    float hst[32];
#pragma unroll
    for (int j = 0; j < 32; ++j) hst[j] = 0.f;
    const float aneg = -expf(a_log[dir * 16 + head]);
    for (int i = 0; i < SLEN; ++i) {
        const int row = seq_row(b, dir, i);
        const float dtv = GATES[(size_t)row * NGATE + 16 + dir * 16 + head];
        const float dA = expf(dtv * aneg);
        const bf16_t* xc = XC + (size_t)row * 1536;
        const float xv = bf2f(xc[head * 64 + pp]) * dtv;
        const bf16_t* bp = xc + 1024 + g * 128 + nq * 32; const bf16_t* cp = xc + 1280 + g * 128 + nq * 32;
        float y = 0.f;
#pragma unroll
        for (int j = 0; j < 32; ++j) { hst[j] = dA * hst[j] + bf2f(bp[j]) * xv; y += bf2f(cp[j]) * hst[j]; }
        y += __shfl_xor(y, 1); y += __shfl_xor(y, 2);
        if (nq == 0) { float* o = HS + (size_t)row * D + head * 64 + pp; if (dir) *o += y; else *o = y; }
    }
}
__global__ void nv_finish_s_kernel(const float* HS, const bf16_t* Z, const bf16_t* XC, const float* dsk, const float* g, bf16_t* MIX) {
    __shared__ float red[4];
    const int row = blockIdx.x, tid = threadIdx.x;
    float v[4]; float ss = 0.f;
#pragma unroll
    for (int j = 0; j < 4; ++j) { int c = tid + 256 * j;
        float y = HS[(size_t)row * D + c] + dsk[c >> 6] * bf2f(XC[(size_t)row * 1536 + c]);
        y *= siluf(bf2f(Z[(size_t)row * 1024 + c])); v[j] = y; ss += y * y; }
    float ms = block_sum256(ss, red) * (1.f / 1024.f);
    float r = rsqrtf(ms + 1e-6f);
#pragma unroll
    for (int j = 0; j < 4; ++j) { int c = tid + 256 * j; MIX[(size_t)row * 2048 + 1024 + c] = f2bf(v[j] * r * g[c]); }
}
__global__ void nv_qk_prep_kernel(bf16_t* Q, bf16_t* KB, const float* qg, const float* kg) {
    __shared__ float xs[128]; __shared__ float red[2];
    const int row = blockIdx.x, hh = blockIdx.y, d = threadIdx.x;
    bf16_t* p; bool rope; int t = 0;
    if (hh < 8) { if (row >= NLAT) return; p = Q + (size_t)row * 1024 + hh * 128; rope = true; t = row % SEQ; }
    else { if (row >= NBATCH * SLEN) return; p = KB + (size_t)row * 256 + (hh - 8) * 128; const int key = row % SLEN; rope = key >= CTXL; t = key - CTXL; }
    float x = bf2f(p[d]);
    float s = x * x;
    for (int o = 32; o > 0; o >>= 1) s += __shfl_xor(s, o);
    if ((d & 63) == 0) red[d >> 6] = s;
    __syncthreads();
    const float ms = (red[0] + red[1]) * (1.f / 128.f);
    const float xn = x * rsqrtf(ms + 1e-6f) * (hh < 8 ? qg[d] : kg[d]);
    xs[d] = xn;
    __syncthreads();
    float out = xn;
    if (rope) {
        const int i = d & 63; const int fi = i & 31;
        const float pos = (i < 32) ? (float)(t / 64) : (float)(t % 64);
        const float invf = expf(-(float)fi * (9.210340371976184f / 32.f));
        float sn, cs; sincosf(pos * invf, &sn, &cs);
        out = (d < 64) ? (xs[d] * cs - xs[d + 64] * sn) : (xs[d] * cs + xs[d - 64] * sn);
    }
    p[d] = f2bf(out);
}
__global__ void nv_softmax_kernel(float* S, int ncols, float scale) {
    __shared__ float red[4];
    float* s = S + (size_t)blockIdx.x * ncols; const int tid = threadIdx.x;
    float mx = -1e30f;
    for (int j = tid; j < ncols; j += 256) mx = fmaxf(mx, s[j]);
    for (int o = 32; o > 0; o >>= 1) mx = fmaxf(mx, __shfl_xor(mx, o));
    __syncthreads(); if ((tid & 63) == 0) red[tid >> 6] = mx; __syncthreads();
    mx = fmaxf(fmaxf(red[0], red[1]), fmaxf(red[2], red[3]));
    float sum = 0.f;
    for (int j = tid; j < ncols; j += 256) { float e = expf((s[j] - mx) * scale); s[j] = e; sum += e; }
    sum = block_sum256(sum, red);
    const float inv = 1.f / sum;
    for (int j = tid; j < ncols; j += 256) s[j] *= inv;
}
template <typename T> __device__ __forceinline__ float4 ld4(const T* p);
template <> __device__ __forceinline__ float4 ld4<float>(const float* p) { return *(const float4*)p; }
template <> __device__ __forceinline__ float4 ld4<bf16_t>(const bf16_t* p) { const u32x2 w = *(const u32x2*)p; return make_float4(__uint_as_float(w.x << 16), __uint_as_float(w.x & 0xffff0000u), __uint_as_float(w.y << 16), __uint_as_float(w.y & 0xffff0000u)); }
__device__ __forceinline__ void st4(float* p, float4 v) { *(float4*)p = v; }
__device__ __forceinline__ void st4(bf16_t* p, float4 v) { u32x2 w; w.x = pk2(v.x, v.y); w.y = pk2(v.z, v.w); *(u32x2*)p = w; }
template <typename TA, typename TB, typename TC>
__global__ void __launch_bounds__(256) nv_gemm_kernel(const TA* A, int lda, const TB* B, int ldb, TC* C, int ldc, int M, int N, int K, int bt) {
    __shared__ float As[16][128 + 4];
    __shared__ float Bs[16][128 + 4];
    const int m0 = blockIdx.y * 128, n0 = blockIdx.x * 128;
    const int tid = threadIdx.x, tx = tid & 15, ty = tid >> 4;
    float acc[8][8];
#pragma unroll
    for (int i = 0; i < 8; ++i)
#pragma unroll
        for (int j = 0; j < 8; ++j) acc[i][j] = 0.f;
    for (int k0 = 0; k0 < K; k0 += 16) {
#pragma unroll
        for (int i = 0; i < 2; ++i) { const int idx = tid + i * 256, r = idx >> 2, kq = idx & 3; float4 v = make_float4(0.f, 0.f, 0.f, 0.f);
            if (m0 + r < M) v = ld4<TA>(A + (size_t)(m0 + r) * lda + k0 + kq * 4);
            As[kq * 4 + 0][r] = v.x; As[kq * 4 + 1][r] = v.y; As[kq * 4 + 2][r] = v.z; As[kq * 4 + 3][r] = v.w; }
        if (!bt) {
#pragma unroll
            for (int i = 0; i < 2; ++i) { const int idx = tid + i * 256, kk = idx >> 5, nq = idx & 31, gn = n0 + nq * 4; float4 v = make_float4(0.f, 0.f, 0.f, 0.f);
                if (gn < N) v = ld4<TB>(B + (size_t)(k0 + kk) * ldb + gn);
                *(float4*)&Bs[kk][nq * 4] = v; }
        } else {
#pragma unroll
            for (int i = 0; i < 2; ++i) { const int idx = tid + i * 256, n = idx >> 2, kq = idx & 3, gn = n0 + n; float4 v = make_float4(0.f, 0.f, 0.f, 0.f);
                if (gn < N) v = ld4<TB>(B + (size_t)gn * ldb + k0 + kq * 4);
                Bs[kq * 4 + 0][n] = v.x; Bs[kq * 4 + 1][n] = v.y; Bs[kq * 4 + 2][n] = v.z; Bs[kq * 4 + 3][n] = v.w; }
        }
        __syncthreads();
#pragma unroll
        for (int kk = 0; kk < 16; ++kk) {
            const float4 a0 = *(const float4*)&As[kk][ty * 4], a1 = *(const float4*)&As[kk][64 + ty * 4];
            const float4 b0 = *(const float4*)&Bs[kk][tx * 4], b1 = *(const float4*)&Bs[kk][64 + tx * 4];
            const float av[8] = {a0.x, a0.y, a0.z, a0.w, a1.x, a1.y, a1.z, a1.w};
            const float bv[8] = {b0.x, b0.y, b0.z, b0.w, b1.x, b1.y, b1.z, b1.w};
#pragma unroll
            for (int i = 0; i < 8; ++i)
#pragma unroll
                for (int j = 0; j < 8; ++j) acc[i][j] += av[i] * bv[j];
        }
        __syncthreads();
    }
#pragma unroll
    for (int i = 0; i < 8; ++i) {
        const int gm = m0 + (i < 4 ? ty * 4 + i : 64 + ty * 4 + (i - 4));
        if (gm >= M) continue;
#pragma unroll
        for (int jh = 0; jh < 2; ++jh) { const int gn = n0 + jh * 64 + tx * 4; if (gn >= N) continue;
            st4(C + (size_t)gm * ldc + gn, make_float4(acc[i][jh * 4 + 0], acc[i][jh * 4 + 1], acc[i][jh * 4 + 2], acc[i][jh * 4 + 3])); }
    }
}

#ifdef DIAG_SEL
__global__ void dg_count_nonfinite(const bf16_t* p, size_t n, unsigned* cnt) {
    for (size_t i = (size_t)blockIdx.x * 256 + threadIdx.x; i < n; i += (size_t)gridDim.x * 256) {
        if ((p[i] & 0x7f80u) == 0x7f80u) { const unsigned blk = (unsigned)(i >> 15), chain = blk / 66, cid = blk % 66, v = (unsigned)(i >> 7) & 255, d = (unsigned)i & 127;
            atomicAdd(cnt, 1u); if (chain & 1) atomicAdd(cnt + 1, 1u); if (cid < 2) atomicAdd(cnt + 2, 1u); if (d < 32) atomicAdd(cnt + 3, 1u); if ((v & 31) < 16) atomicAdd(cnt + 4, 1u);
            atomicAdd(cnt + 12288 + blk, 1u); }
    }
}
__global__ void dg_reduce(unsigned* cnt) {
    if (threadIdx.x == 0) { unsigned nb = 0, mx = 0; for (int i = 0; i < 1056; ++i) { const unsigned c = cnt[12288 + i]; if (c) ++nb; if (c > mx) mx = c; } cnt[5] = nb; cnt[6] = mx; }
}
__global__ void dg_scale_out(float* out, size_t n, const unsigned* cnt) {
    const unsigned c = cnt[DIAG_SEL];
    const float f = 1.f + 0.01f * ((float)c / (float)DIAG_DIV);
    for (size_t i = (size_t)blockIdx.x * 256 + threadIdx.x; i < n; i += (size_t)gridDim.x * 256) out[i] *= f;
}
#endif
template <typename TA, typename TB, typename TC>
void nv_gemm(hipStream_t st, const TA* A, int lda, const TB* B, int ldb, TC* C, int ldc, int M, int N, int K, int bt) {
    dim3 grid((N + 127) / 128, (M + 127) / 128, 1);
    hipLaunchKernelGGL((nv_gemm_kernel<TA, TB, TC>), grid, dim3(256), 0, st, A, lda, B, ldb, C, ldc, M, N, K, bt);
}
#endif
}

static int g_grid = 0;
static void launch_phases(hipStream_t stream, Args a, int lo, int hi, int li = 0) {
    a.ph_lo = lo; a.ph_hi = hi; a.li = li;
    void* args[] = {&a};
    hipError_t e;
    if (hi - lo > 1) e = hipLaunchCooperativeKernel((const void*)mk_fwd, dim3(g_grid), dim3(NTHREADS), args, LDS_BYTES, stream);
    else { hipLaunchKernelGGL(mk_fwd, dim3(g_grid), dim3(NTHREADS), LDS_BYTES, stream, a); e = hipPeekAtLastError(); }
    if (e != hipSuccess) fprintf(stderr, "launch [%d,%d) failed: %s\n", lo, hi, hipGetErrorString(e));
}
extern "C" void kernel_launch(void* const* d_in, const int* in_sizes, int n_in, void* d_out, int out_size, void* d_ws, size_t ws_size, hipStream_t stream) {
    if (g_grid == 0) {
        if (ws_size < WS_END || n_in != 28) { fprintf(stderr, "kernel_launch: ws %zu < %zu or n_in %d\n", ws_size, (size_t)WS_END, n_in); g_grid = -1; return; }
        int dev = 0, cus = 0, per_cu = 0;
        (void)hipGetDevice(&dev); (void)hipDeviceGetAttribute(&cus, hipDeviceAttributeMultiprocessorCount, dev);
        if (hipFuncSetAttribute((const void*)mk_fwd, hipFuncAttributeMaxDynamicSharedMemorySize, LDS_BYTES) != hipSuccess) { fprintf(stderr, "hipFuncSetAttribute failed\n"); g_grid = -1; return; }
        if (hipOccupancyMaxActiveBlocksPerMultiprocessor(&per_cu, (const void*)mk_fwd, NTHREADS, LDS_BYTES) != hipSuccess || per_cu < 1) { fprintf(stderr, "occupancy query failed (%d)\n", per_cu); g_grid = -1; return; }
        g_grid = cus;
        fprintf(stderr, "kernel_launch: cus %d per_cu %d grid %d\n", cus, per_cu, g_grid);
    }
    if (g_grid < 0) return;
    unsigned char* ws = (unsigned char*)d_ws;
    (void)hipMemsetAsync(ws + WS_CTL, 0, 65536, stream);
    Args a{};
    for (int i = 0; i < 28; ++i) a.in[i] = (const float*)d_in[i];
    a.out = (float*)d_out; a.ws = ws;
    const float** in = a.in;

#ifdef EXP_NAIVE_MIXER
    launch_phases(stream, a, PH_PRO, PH_GEMM_IN + 1, 0);
    {
        const bf16_t* QK = (const bf16_t*)(ws + WS_QK); const bf16_t* V = (const bf16_t*)(ws + WS_V); const bf16_t* O = (const bf16_t*)(ws + WS_O); const bf16_t* Z = (const bf16_t*)(ws + WS_Z);
        const bf16_t* XBC = (const bf16_t*)(ws + WS_XBC); bf16_t* XC = (bf16_t*)(ws + WS_XC); const float* GATES = (const float*)(ws + WS_GATES);
        float* HM = (float*)(ws + WS_DC); float* HS = (float*)(ws + WS_DS); bf16_t* MIX = (bf16_t*)(ws + WS_MIX);
#if EXP_NAIVE_MIXER == 2
        launch_phases(stream, a, PH_CONV, PH_CONV + 1);
#else
        hipLaunchKernelGGL(nv_conv_kernel, dim3(NTOK), dim3(256), 0, stream, XBC, in[I_CONVW], in[I_CONVB], XC);
#endif
#if EXP_NAIVE_MIXER == 5
#ifdef DIAG_HOLES
        (void)hipMemsetAsync(ws + WS_DC, 0x3C, (size_t)66 * MiB, stream);
#endif
        launch_phases(stream, a, PH_MLA, PH_MLA + 1);
#ifdef DIAG_SCAN
        launch_phases(stream, a, PH_SCAN, PH_SCAN + 1);
#endif
        hipLaunchKernelGGL(dg_count_nonfinite, dim3(2048), dim3(256), 0, stream, (const bf16_t*)(ws + WS_DC), (size_t)16 * 66 * 32768, (unsigned*)(ws + WS_CTL) + 16);
        hipLaunchKernelGGL(dg_reduce, dim3(1), dim3(64), 0, stream, (unsigned*)(ws + WS_CTL) + 16);
#endif
#if EXP_NAIVE_MIXER == 3
        launch_phases(stream, a, PH_MLA, PH_MLA + 1); launch_phases(stream, a, PH_SCAN, PH_SCAN + 1); launch_phases(stream, a, PH_MLC, PH_MLC + 1);
#endif
#if EXP_NAIVE_MIXER == 4
        launch_phases(stream, a, PH_SSA, PH_SSA + 1); launch_phases(stream, a, PH_SCAN, PH_SCAN + 1); launch_phases(stream, a, PH_SSC, PH_SSC + 1);
#endif
#if EXP_NAIVE_MIXER != 3
        hipLaunchKernelGGL(nv_mlstm_rec_kernel, dim3(16, 4, 2), dim3(256), 0, stream, QK, V, GATES, HM, 0);
        hipLaunchKernelGGL(nv_mlstm_rec_kernel, dim3(16, 4, 2), dim3(256), 0, stream, QK, V, GATES, HM, 1);
        hipLaunchKernelGGL(nv_finish_m_kernel, dim3(NTOK), dim3(256), 0, stream, HM, O, in[I_MNG], MIX);
#endif
#if EXP_NAIVE_MIXER != 4
        hipLaunchKernelGGL(nv_ssd_rec_kernel, dim3(16, 2), dim3(256), 0, stream, XC, GATES, in[I_ALOG], HS, 0);
        hipLaunchKernelGGL(nv_ssd_rec_kernel, dim3(16, 2), dim3(256), 0, stream, XC, GATES, in[I_ALOG], HS, 1);
        hipLaunchKernelGGL(nv_finish_s_kernel, dim3(NTOK), dim3(256), 0, stream, HS, Z, XC, in[I_SSMD], in[I_SNG], MIX);
#endif
    }
    launch_phases(stream, a, PH_GEMM_OUT - 1, PH_COUNT, 1);
#if EXP_NAIVE_MIXER == 5
    hipLaunchKernelGGL(dg_scale_out, dim3(2048), dim3(256), 0, stream, (float*)d_out, (size_t)NLAT * D, (const unsigned*)(ws + WS_CTL) + 16);
#endif
#elif defined(DIAG_EXTRA_LO)
    launch_phases(stream, a, PH_PRO, PH_COUNT, 0);
    launch_phases(stream, a, DIAG_EXTRA_LO, DIAG_EXTRA_HI, 1);
#elif defined(DIAG_SPLIT_A)
    launch_phases(stream, a, PH_PRO, DIAG_SPLIT_A, 0);
#ifdef DIAG_SPLIT_RESETDEP
    (void)hipMemsetAsync(ws + WS_CTL + CW_DEP0 * 4, 0, 2048, stream);
#endif
    launch_phases(stream, a, DIAG_SPLIT_B, PH_COUNT, 1);
#else
    launch_phases(stream, a, PH_PRO, PH_COUNT);
#ifdef DIAG_STAMP
    hipLaunchKernelGGL(dg_perturb, dim3(2048), dim3(256), 0, stream, (float*)d_out, (size_t)NLAT * D, (const unsigned long long*)((unsigned*)(ws + WS_CTL) + 12288));
#endif
#endif
}
```

```cpp
#include <hip/hip_runtime.h>
#include <hip/hip_cooperative_groups.h>
#include <cstdint>
#include <cstdio>
namespace cg = cooperative_groups;


namespace pg8 {
#define PG8_LAS __attribute__((address_space(3)))
typedef unsigned short bf16_t;
typedef short bf16x8 __attribute__((ext_vector_type(8)));
typedef float f32x4 __attribute__((ext_vector_type(4)));
typedef unsigned u32x4 __attribute__((ext_vector_type(4)));
constexpr int BM = 256, BK = 64, HALF = 128, HTB = HALF * BK * 2  , STAGE_BYTES = 8 * HTB, NXCD = 8, WGM = 4;

__host__ __device__ __forceinline__ int lds_byte(int r, int c) { const int st = (r >> 4) * 2 + (c >> 5), rr = r & 15, cc = c & 31, ob = rr * 64 + cc * 2; return st * 1024 + (ob ^ (((ob >> 9) & 1) << 5)); }
__host__ __device__ __forceinline__ void stage_rc(int b, int& R, int& C) { const int st = b / 1024, sb = b % 1024, swz = sb ^ (((sb >> 9) & 1) << 5); R = (st >> 1) * 16 + swz / 64; C = (st & 1) * 32 + (swz % 64) / 2; }
__host__ __device__ __forceinline__ int perm32(int rho) { const int n = rho >> 4, i = rho & 15; return 8 * (i >> 2) + 4 * n + (i & 3); }

struct Unit { int pm, pn; };
struct Gemm { const bf16_t* A; const bf16_t* Bt; int M, N, K; };

struct StaticOrder {
    int nM, nN, nwg, G, c;
    __host__ __device__ __forceinline__ void init(int M, int N, int G_, int c_) { nM = M / BM; nN = N / BM; nwg = nM * nN; G = G_; c = c_; }
    __host__ __device__ __forceinline__ bool next(int i, Unit& u) const {
        const long L = (long)i * G + c; if (L >= nwg) return false;
        int wgid = (int)L; { const int q = nwg / NXCD, r = nwg % NXCD, xcd = wgid % NXCD, off = wgid / NXCD; wgid = (xcd < r ? xcd * (q + 1) : r * (q + 1) + (xcd - r) * q) + off; }
        const int nig = WGM * nN, gid = wgid / nig, fm = gid * WGM, gsz = (nM - fm) < WGM ? (nM - fm) : WGM;
        u.pm = fm + ((wgid % nig) % gsz); u.pn = (wgid % nig) / gsz; return true;
    }
    static constexpr bool LATE = false;
    __device__ __forceinline__ void a_ready(const Unit&) const {}
    __device__ __forceinline__ void done(const Unit&) const {}
    __device__ __forceinline__ void late(const Unit&) const {}
};

template <class Epi, class Sched, bool ALIGN_EPI = false, bool SP2 = false, bool GATHER = false>
__device__ __forceinline__ void gemm_phase(PG8_LAS unsigned char* lds, const Gemm g, const Sched& S, const Epi& E, const int tid) {
    const int wid = __builtin_amdgcn_readfirstlane(tid >> 6), lane = tid & 63, wr = wid >> 2, wc = wid & 3, fr = lane & 15, fq = lane >> 4;
    const int K = g.K, nt = K / BK;
    unsigned voffA[2], voffB[2];
#pragma unroll
    for (int i = 0; i < 2; ++i) { int R, C; stage_rc(tid * 16 + i * 8192, R, C); const int Rb = Epi::PERM ? ((R & ~31) + perm32(R & 31)) : R;
        voffA[i] = (unsigned)(R * K + C) * 2u; voffB[i] = (unsigned)(Rb * K + C) * 2u; }
    static_assert(!GATHER || SP2, "GATHER needs the SP2 loop");
    int gR0 = 0; unsigned gC2 = 0; { int R, C; stage_rc(tid * 16, R, C); gR0 = R; gC2 = (unsigned)C * 2u; }
    unsigned vA[2][2] = {{0u, 0u}, {0u, 0u}}, vN[2][2] = {{0u, 0u}, {0u, 0u}};
    const char* gA = (const char*)g.A;
#define PG8_GV(v, u) do { _Pragma("unroll") for (int h_ = 0; h_ < 2; ++h_) _Pragma("unroll") for (int i_ = 0; i_ < 2; ++i_) v[h_][i_] = (unsigned)S.arow(u, h_ * HALF + gR0 + 64 * i_) * (unsigned)(K * 2) + gC2; } while (0)
    const size_t kstep = (size_t)(BK * 2);
    const size_t hstep = (size_t)HALF * K * 2;
    const size_t tstep = 2 * hstep;
    const unsigned ldsw = (unsigned)wid * 1024u;
    const int aoff = lds_byte(wr * 64 + fr, fq * 8), boff = lds_byte(wc * 32 + fr, fq * 8);
#define PG8_SA(b, h) (((b) * 2 + (h)) * HTB)
#define PG8_SB(b, h) ((4 + (b) * 2 + (h)) * HTB)
#define PG8_STAGE(bufoff, gbase, voff) do { _Pragma("unroll") for (int _i = 0; _i < 2; ++_i) \
        __builtin_amdgcn_global_load_lds((const unsigned*)((const char*)(gbase) + (voff)[_i]), (PG8_LAS unsigned*)(lds + (bufoff) + ldsw + _i * 8192), 16, 0, 0); } while (0)
#define PG8_LDA(dst, b, h) do { _Pragma("unroll") for (int m = 0; m < 4; ++m) _Pragma("unroll") for (int k = 0; k < 2; ++k) dst[m][k] = *(const PG8_LAS bf16x8*)(lds + PG8_SA(b, h) + aoff + m * 2048 + k * 1024); } while (0)
#define PG8_LDB(dst, b, h) do { _Pragma("unroll") for (int n = 0; n < 2; ++n) _Pragma("unroll") for (int k = 0; k < 2; ++k) dst[n][k] = *(const PG8_LAS bf16x8*)(lds + PG8_SB(b, h) + boff + n * 2048 + k * 1024); } while (0)
#define PG8_MMA(ai, bj, At, Bt) do { __builtin_amdgcn_s_setprio(1); _Pragma("unroll") for (int m = 0; m < 4; ++m) _Pragma("unroll") for (int n = 0; n < 2; ++n) _Pragma("unroll") for (int k = 0; k < 2; ++k) \
        acc[ai][bj][m][n] = __builtin_amdgcn_mfma_f32_16x16x32_bf16(Bt[n][k], At[m][k], acc[ai][bj][m][n], 0, 0, 0); __builtin_amdgcn_s_setprio(0); } while (0)
#define PG8_WAIT_V(n) asm volatile("s_waitcnt vmcnt(" #n ")" ::: "memory")
#define PG8_WAIT_L(n) asm volatile("s_waitcnt lgkmcnt(" #n ")" ::: "memory")
#define PG8_BAR __builtin_amdgcn_s_barrier()
#define PG8_SCHED __builtin_amdgcn_sched_barrier(0)
    Unit cur, nxt, prv; int ui = 0;
    if (!S.next(0, cur)) return;
    f32x4 acc[2][2][4][2];
#pragma unroll
    for (int a = 0; a < 2; ++a)
#pragma unroll
        for (int b = 0; b < 2; ++b)
#pragma unroll
            for (int m = 0; m < 4; ++m)
#pragma unroll
                for (int n = 0; n < 2; ++n) acc[a][b][m][n] = (f32x4){0.f, 0.f, 0.f, 0.f};
    bf16x8 At[4][2], B0[2][2], B1[2][2];
    const char* cA = (const char*)g.A + (size_t)cur.pm * tstep; const char* cB = (const char*)g.Bt + (size_t)cur.pn * tstep;
    S.a_ready(cur);
    if constexpr (SP2) {
        if constexpr (GATHER) { PG8_GV(vA, cur); }
        PG8_STAGE(PG8_SB(0, 0), cB, voffB); PG8_STAGE(PG8_SB(0, 1), cB + hstep, voffB);
        if constexpr (GATHER) { PG8_STAGE(PG8_SA(0, 0), gA, vA[0]); PG8_STAGE(PG8_SA(0, 1), gA, vA[1]); } else { PG8_STAGE(PG8_SA(0, 0), cA, voffA); PG8_STAGE(PG8_SA(0, 1), cA + hstep, voffA); }
        if (wr == 1) PG8_BAR;
        PG8_WAIT_V(2); PG8_BAR;
        PG8_STAGE(PG8_SB(1, 0), cB + kstep, voffB); if constexpr (GATHER) { PG8_STAGE(PG8_SA(1, 0), gA + kstep, vA[0]); } else { PG8_STAGE(PG8_SA(1, 0), cA + kstep, voffA); } PG8_STAGE(PG8_SB(1, 1), cB + hstep + kstep, voffB);
        PG8_WAIT_V(6); PG8_BAR;
    } else {
        PG8_STAGE(PG8_SB(0, 0), cB, voffB); PG8_STAGE(PG8_SA(0, 0), cA, voffA); PG8_STAGE(PG8_SB(0, 1), cB + hstep, voffB); PG8_STAGE(PG8_SA(0, 1), cA + hstep, voffA);
        if (wr == 1) PG8_BAR;
        PG8_WAIT_V(4); PG8_BAR;
        PG8_STAGE(PG8_SB(1, 0), cB + kstep, voffB); PG8_STAGE(PG8_SA(1, 0), cA + kstep, voffA); PG8_STAGE(PG8_SB(1, 1), cB + hstep + kstep, voffB);
        PG8_WAIT_V(6); PG8_BAR;
    }
    for (;;) {
        const bool has_next = S.next(ui + 1, nxt);
        if constexpr (GATHER) { if (has_next) { PG8_GV(vN, nxt); } else { _Pragma("unroll") for (int h_ = 0; h_ < 2; ++h_) _Pragma("unroll") for (int i_ = 0; i_ < 2; ++i_) vN[h_][i_] = vA[h_][i_]; } }
        const char* nA = has_next ? (const char*)g.A + (size_t)nxt.pm * tstep : cA; const char* nB = has_next ? (const char*)g.Bt + (size_t)nxt.pn * tstep : cB;
        for (int t = 0; t < nt; t += 2) {
            if constexpr (Epi::MIDK) { if (t == nt / 2) E.midk(acc, cur, wr, wc, fr, fq); }
            if constexpr (Sched::LATE) { if (t == 2 && ui > 0) S.late(prv); }
            const bool last = (t == nt - 2);
            const char* a1 = cA + (size_t)(t + 1) * kstep;
            const char* a2 = last ? nA : cA + (size_t)(t + 2) * kstep; const char* b2 = last ? nB : cB + (size_t)(t + 2) * kstep;
            const char* a3 = a2 + kstep; const char* b3 = b2 + kstep;
            if (last && has_next) S.a_ready(nxt);
            const size_t ka1 = (size_t)(t + 1) * kstep, ka2 = last ? (size_t)0 : (size_t)(t + 2) * kstep, ka3 = ka2 + kstep;
            unsigned vs0[2] = {last ? vN[0][0] : vA[0][0], last ? vN[0][1] : vA[0][1]}, vs1[2] = {last ? vN[1][0] : vA[1][0], last ? vN[1][1] : vA[1][1]};
            if constexpr (SP2) {
            PG8_LDB(B0, 0, 0); PG8_LDB(B1, 0, 1); PG8_SCHED; PG8_LDA(At, 0, 0); if constexpr (GATHER) { PG8_STAGE(PG8_SA(1, 1), gA + ka1, vA[1]); } else { PG8_STAGE(PG8_SA(1, 1), a1 + hstep, voffA); }
            PG8_WAIT_V(8); PG8_WAIT_L(0); PG8_BAR; PG8_MMA(0, 0, At, B0); PG8_MMA(0, 1, At, B1); PG8_BAR; PG8_SCHED;
            PG8_LDA(At, 0, 1); PG8_STAGE(PG8_SB(0, 0), b2, voffB); PG8_STAGE(PG8_SB(0, 1), b2 + hstep, voffB); if constexpr (GATHER) { PG8_STAGE(PG8_SA(0, 0), gA + ka2, vs0); } else { PG8_STAGE(PG8_SA(0, 0), a2, voffA); }
            PG8_WAIT_V(8); PG8_WAIT_L(0); PG8_BAR; PG8_MMA(1, 0, At, B0); PG8_MMA(1, 1, At, B1); PG8_BAR; PG8_SCHED;
            PG8_LDB(B0, 1, 0); PG8_LDB(B1, 1, 1); PG8_SCHED; PG8_LDA(At, 1, 0); if constexpr (GATHER) { PG8_STAGE(PG8_SA(0, 1), gA + ka2, vs1); } else { PG8_STAGE(PG8_SA(0, 1), a2 + hstep, voffA); }
            PG8_WAIT_V(8); PG8_WAIT_L(0); PG8_BAR; PG8_MMA(0, 0, At, B0); PG8_MMA(0, 1, At, B1); PG8_BAR; PG8_SCHED;
            PG8_LDA(At, 1, 1); PG8_STAGE(PG8_SB(1, 0), b3, voffB); PG8_STAGE(PG8_SB(1, 1), b3 + hstep, voffB); if constexpr (GATHER) { PG8_STAGE(PG8_SA(1, 0), gA + ka3, vs0); } else { PG8_STAGE(PG8_SA(1, 0), a3, voffA); }
            PG8_WAIT_V(8); PG8_WAIT_L(0); PG8_BAR; PG8_MMA(1, 0, At, B0); PG8_MMA(1, 1, At, B1); PG8_BAR; PG8_SCHED;
            } else {
            PG8_LDB(B0, 0, 0); PG8_SCHED; PG8_LDA(At, 0, 0); PG8_STAGE(PG8_SA(1, 1), a1 + hstep, voffA);
            PG8_WAIT_L(8); PG8_BAR; PG8_WAIT_L(0); PG8_MMA(0, 0, At, B0); PG8_BAR; PG8_SCHED;
            PG8_LDB(B1, 0, 1); PG8_STAGE(PG8_SB(0, 0), b2, voffB);
            PG8_BAR; PG8_WAIT_L(0); PG8_MMA(0, 1, At, B1); PG8_BAR;
            PG8_LDA(At, 0, 1); PG8_STAGE(PG8_SA(0, 0), a2, voffA);
            PG8_BAR; PG8_WAIT_L(0); PG8_MMA(1, 0, At, B0); PG8_BAR; PG8_SCHED;
            PG8_STAGE(PG8_SB(0, 1), b2 + hstep, voffB);
            PG8_WAIT_V(6); PG8_BAR; PG8_MMA(1, 1, At, B1); PG8_BAR;
            PG8_LDB(B0, 1, 0); PG8_SCHED; PG8_LDA(At, 1, 0); PG8_STAGE(PG8_SA(0, 1), a2 + hstep, voffA);
            PG8_WAIT_L(8); PG8_BAR; PG8_WAIT_L(0); PG8_MMA(0, 0, At, B0); PG8_BAR; PG8_SCHED;
            PG8_LDB(B1, 1, 1); PG8_STAGE(PG8_SB(1, 0), b3, voffB);
            PG8_BAR; PG8_WAIT_L(0); PG8_MMA(0, 1, At, B1); PG8_BAR;
            PG8_LDA(At, 1, 1); PG8_STAGE(PG8_SA(1, 0), a3, voffA);
            PG8_BAR; PG8_WAIT_L(0); PG8_MMA(1, 0, At, B0); PG8_BAR; PG8_SCHED;
            PG8_STAGE(PG8_SB(1, 1), b3 + hstep, voffB);
            PG8_WAIT_V(6); PG8_BAR; PG8_MMA(1, 1, At, B1); PG8_BAR;
            }
        }
        if constexpr (ALIGN_EPI) { if (wr == 0) PG8_BAR; }
        if constexpr (!Epi::AFTER_DRAIN) { E(acc, cur, wr, wc, fr, fq); S.done(cur); }
        if constexpr (Sched::LATE) prv = cur;
        if (!has_next) break;
#pragma unroll
        for (int a = 0; a < 2; ++a)
#pragma unroll
            for (int b = 0; b < 2; ++b)
#pragma unroll
                for (int m = 0; m < 4; ++m)
#pragma unroll
                    for (int n = 0; n < 2; ++n) acc[a][b][m][n] = (f32x4){0.f, 0.f, 0.f, 0.f};
        cur = nxt; cA = nA; cB = nB; ++ui;
        if constexpr (GATHER) { _Pragma("unroll") for (int h_ = 0; h_ < 2; ++h_) _Pragma("unroll") for (int i_ = 0; i_ < 2; ++i_) vA[h_][i_] = vN[h_][i_]; }
        if constexpr (ALIGN_EPI) { if (wr == 1) PG8_BAR; }
    }
    PG8_WAIT_V(0);
    if constexpr (Sched::LATE) S.late(cur);
    if constexpr (!ALIGN_EPI) { if (wr == 0) PG8_BAR; }
    PG8_BAR;
    if constexpr (Epi::AFTER_DRAIN) { E.fused(acc, cur, wr, wc, fr, fq, lds, wid, lane); S.done(cur); }
#undef PG8_GV
#undef PG8_SA
#undef PG8_SB
#undef PG8_STAGE
#undef PG8_LDA
#undef PG8_LDB
#undef PG8_MMA
#undef PG8_WAIT_V
#undef PG8_WAIT_L
#undef PG8_BAR
#undef PG8_SCHED
}
}
namespace attn {
using bf16 = unsigned short;
constexpr int D = 128, NW = 8, QBLK = 32, KVBLK = 64;
constexpr float SCALE = 0.088388347648318440f;
constexpr float THR = 8.f;
constexpr int LDQ = 1024, LDK = 256, LDO = 1024;
constexpr size_t SHM_V = KVBLK * D * 2, SHM_K = KVBLK * D * 2, SHM_ATTN = 2 * SHM_V + 2 * SHM_K + NW * 64 * 4;
using bf16x8 = __attribute__((ext_vector_type(8))) short;
using s16x4  = __attribute__((ext_vector_type(4))) short;
using f32x16 = __attribute__((ext_vector_type(16))) float;
using f32x8  = __attribute__((ext_vector_type(8))) float;
using u32x4  = __attribute__((ext_vector_type(4))) unsigned;
#define KSWZ(row, colB) ((row) * 256 + ((colB) ^ (((row) & 7) << 4)))
#define SBAR() __builtin_amdgcn_sched_barrier(0)
__device__ __forceinline__ int crow(int r, int hi) { return (r & 3) + 8 * (r >> 2) + 4 * hi; }
__device__ __forceinline__ unsigned cvtpk(float lo, float hi) {
  unsigned r; asm volatile("v_cvt_pk_bf16_f32 %0, %1, %2" : "=v"(r) : "v"(lo), "v"(hi)); return r;
}
template <typename TIn> struct Stage;
template <> struct Stage<bf16>  { using T = bf16x8;
  __device__ static __forceinline__ T ld8(const bf16* p) { return *reinterpret_cast<const bf16x8*>(p); }
  __device__ static __forceinline__ bf16x8 tobf(T x) { return x; } };
template <> struct Stage<float> { using T = f32x8;
  __device__ static __forceinline__ T ld8(const float* p) { return *reinterpret_cast<const f32x8*>(p); }
  __device__ static __forceinline__ bf16x8 tobf(T x) {
    u32x4 w = {cvtpk(x[0], x[1]), cvtpk(x[2], x[3]), cvtpk(x[4], x[5]), cvtpk(x[6], x[7])}; return *reinterpret_cast<bf16x8*>(&w); } };

template <bool NOREF> __device__ __forceinline__ void partialSM(f32x16& p0, f32x16& p1, float& m_reg, float& mn, float& alpha) {
  if constexpr (NOREF) { alpha = 1.f; for (int r = 0; r < 16; ++r) p0[r] = __builtin_amdgcn_exp2f(p0[r]); return; }
  constexpr float C = SCALE * 1.4426950408889634f;
  float pmax = p0[0]; for (int r = 1; r < 16; ++r) pmax = fmaxf(pmax, p0[r]); for (int r = 0; r < 16; ++r) pmax = fmaxf(pmax, p1[r]);
  { auto rr = __builtin_amdgcn_permlane32_swap(__float_as_uint(pmax), __float_as_uint(pmax), false, false);
    pmax = fmaxf(__uint_as_float(rr[0]), __uint_as_float(rr[1])); }
  if (__builtin_expect(__all(pmax - m_reg <= THR / SCALE), 1)) { mn = m_reg; alpha = 1.f; }
  else { mn = fmaxf(m_reg, pmax); alpha = __builtin_amdgcn_exp2f((m_reg - mn) * C); m_reg = mn; }
  float mnC = -mn * C;
  for (int r = 0; r < 16; ++r) p0[r] = fmaf(p0[r], C, mnC); for (int r = 0; r < 16; ++r) p1[r] = fmaf(p1[r], C, mnC);
  for (int r = 0; r < 16; ++r) p0[r] = __builtin_amdgcn_exp2f(p0[r]);
}
template <bool NOREF> __device__ __forceinline__ void finishSM(f32x16& p0, f32x16& p1, float alpha, float& l_reg, bf16x8& pa0, bf16x8& pa1, bf16x8& pa2, bf16x8& pa3) {
  for (int r = 0; r < 16; ++r) p1[r] = __builtin_amdgcn_exp2f(p1[r]);
  float ps = 0; for (int r = 0; r < 16; ++r) ps += p0[r]; for (int r = 0; r < 16; ++r) ps += p1[r];
  if constexpr (NOREF) { l_reg += ps; }
  else {
  { auto rr = __builtin_amdgcn_permlane32_swap(__float_as_uint(ps), __float_as_uint(ps), false, false);
    ps = __uint_as_float(rr[0]) + __uint_as_float(rr[1]); }
  l_reg = l_reg * alpha + ps; }
#define PK4(P, BASE, OUT) do { u32x4 w = {cvtpk(P[BASE + 0], P[BASE + 1]), cvtpk(P[BASE + 2], P[BASE + 3]), cvtpk(P[BASE + 4], P[BASE + 5]), cvtpk(P[BASE + 6], P[BASE + 7])}; OUT = *reinterpret_cast<bf16x8*>(&w); } while (0)
  PK4(p0, 0, pa0); PK4(p0, 8, pa1); PK4(p1, 0, pa2); PK4(p1, 8, pa3);
#undef PK4
}
__device__ __forceinline__ void qkt(f32x16& p0, f32x16& p1, const bf16* Ks, const bf16x8* qr, int r32, int hi) {
  p0 = f32x16{}; p1 = f32x16{};
  for (int d0 = 0; d0 < 8; ++d0) { int cb = (d0 * 16 + hi * 8) * 2;
    bf16x8 b0 = *reinterpret_cast<const bf16x8*>((const char*)Ks + KSWZ(r32, cb));
    bf16x8 b1 = *reinterpret_cast<const bf16x8*>((const char*)Ks + KSWZ(32 + r32, cb));
    p0 = __builtin_amdgcn_mfma_f32_32x32x16_bf16(b0, qr[d0], p0, 0, 0, 0);
    p1 = __builtin_amdgcn_mfma_f32_32x32x16_bf16(b1, qr[d0], p1, 0, 0, 0); }
}
__device__ __forceinline__ int v_st(int k, int c) { const int kk = (k & ~0xC) | ((k & 4) << 1) | ((k & 8) >> 1); return ((kk >> 3) * 4 + (c >> 5)) * 512 + ((kk & 7) * 32 + (c & 31)) * 2; }
__device__ __forceinline__ int v_st_nat(int k, int c) { return ((k >> 3) * 4 + (c >> 5)) * 512 + ((k & 7) * 32 + (c & 31)) * 2; }
__device__ __forceinline__ int v_rd_base(int lane) { return ((lane & 3) << 3) | (((lane >> 2) & 3) << 6) | (((lane >> 4) & 1) << 5) | (((lane >> 5) & 1) << 8); }
constexpr int v_rd_off(int d0, int ks, int half) { return d0 * 512 + ks * 4096 + half * 2048; }
template <int OFF> __device__ __forceinline__ s16x4 tr_read(int vb) {
  s16x4 r; asm volatile("ds_read_b64_tr_b16 %0, %1 offset:%2" : "=&v"(r) : "v"(vb), "i"(OFF) : "memory"); return r;
}
template <int D0, bool SM = false> __device__ __forceinline__ void pv_one(f32x16& od, int vb, bf16x8 pa0, bf16x8 pa1, bf16x8 pa2, bf16x8 pa3, f32x16* pn = nullptr) {
  const s16x4 l0 = tr_read<v_rd_off(D0, 0, 0)>(vb), h0 = tr_read<v_rd_off(D0, 0, 1)>(vb), l1 = tr_read<v_rd_off(D0, 1, 0)>(vb), h1 = tr_read<v_rd_off(D0, 1, 1)>(vb);
  const s16x4 l2 = tr_read<v_rd_off(D0, 2, 0)>(vb), h2 = tr_read<v_rd_off(D0, 2, 1)>(vb), l3 = tr_read<v_rd_off(D0, 3, 0)>(vb), h3 = tr_read<v_rd_off(D0, 3, 1)>(vb);
  if constexpr (SM) {
#pragma unroll
    for (int r = 4 * D0; r < 4 * D0 + 4; ++r) (*pn)[r] = __builtin_amdgcn_exp2f((*pn)[r]); }
  asm volatile("s_waitcnt lgkmcnt(0)" ::: "memory"); SBAR();
#define PK(L, H) (bf16x8){L[0], L[1], L[2], L[3], H[0], H[1], H[2], H[3]}
  od = __builtin_amdgcn_mfma_f32_32x32x16_bf16(pa0, PK(l0, h0), od, 0, 0, 0);
  od = __builtin_amdgcn_mfma_f32_32x32x16_bf16(pa1, PK(l1, h1), od, 0, 0, 0);
  od = __builtin_amdgcn_mfma_f32_32x32x16_bf16(pa2, PK(l2, h2), od, 0, 0, 0);
  od = __builtin_amdgcn_mfma_f32_32x32x16_bf16(pa3, PK(l3, h3), od, 0, 0, 0);
#undef PK
}
__device__ __forceinline__ void pv_d0(f32x16* o, int vb, bf16x8 pa0, bf16x8 pa1, bf16x8 pa2, bf16x8 pa3) {
  pv_one<0>(o[0], vb, pa0, pa1, pa2, pa3); pv_one<1>(o[1], vb, pa0, pa1, pa2, pa3); pv_one<2>(o[2], vb, pa0, pa1, pa2, pa3); pv_one<3>(o[3], vb, pa0, pa1, pa2, pa3);
}
__device__ __forceinline__ void pv_d0_sm(f32x16* o, int vb, bf16x8 pa0, bf16x8 pa1, bf16x8 pa2, bf16x8 pa3, f32x16& pn) {
  pv_one<0, true>(o[0], vb, pa0, pa1, pa2, pa3, &pn); pv_one<1, true>(o[1], vb, pa0, pa1, pa2, pa3, &pn); pv_one<2, true>(o[2], vb, pa0, pa1, pa2, pa3, &pn); pv_one<3, true>(o[3], vb, pa0, pa1, pa2, pa3, &pn);
}

template <typename TQ, bool NOREF, int SDEPTH>
__device__ __forceinline__ void attn_dense_body(const TQ* __restrict__ Qb, const bf16* __restrict__ Kh, const bf16* __restrict__ Vh,
                                                bf16* __restrict__ Ob, int seq, char* lds, const int tid, const float* __restrict__ qg, const int t0, const float* __restrict__ rope) {
  using St = Stage<bf16>; using SQ = Stage<TQ>;
  const int wid = tid >> 6, lane = tid & 63, r32 = lane & 31, hi = lane >> 5;
  bf16* V_lds = (bf16*)lds; bf16* K_lds = (bf16*)(lds + 2 * SHM_V);
  float* ws = (float*)(lds + 2 * SHM_V + 2 * SHM_K) + wid * 64; float* li_l = ws; float* al_l = ws + 32;
  float m_reg = -1e30f, l_reg = 0; f32x16 o[4] = {}; bf16x8 qr[8];
  const TQ* Qw = Qb + (long)(wid * QBLK + r32) * LDQ + hi * 8;
#pragma unroll
  for (int d0 = 0; d0 < 8; ++d0) qr[d0] = SQ::tobf(SQ::ld8(Qw + d0 * 16));
  const int sr = tid >> 4, sc = (tid & 15) * 8, vst0 = v_st_nat(sr, sc), vst1 = v_st_nat(32 + sr, sc);
  const int vb0 = (int)(uintptr_t)V_lds + v_rd_base(lane);
  struct { typename St::T vs0, vs1, ks0, ks1; } sr_[SDEPTH];
#define SLOAD(i, k0) do { const unsigned o0_ = (unsigned)(((k0) + sr) * LDK + sc), o1_ = o0_ + 32u * LDK;   \
    sr_[i].vs0 = St::ld8(Vh + o0_); sr_[i].vs1 = St::ld8(Vh + o1_); sr_[i].ks0 = St::ld8(Kh + o0_); sr_[i].ks1 = St::ld8(Kh + o1_); } while (0)
#define SWRITE(b, i) do { *(bf16x8*)((char*)V_lds + (b) * SHM_V + vst0) = St::tobf(sr_[i].vs0);          \
    *(bf16x8*)((char*)V_lds + (b) * SHM_V + vst1) = St::tobf(sr_[i].vs1); int kc = sc * 2;               \
    *(bf16x8*)((char*)K_lds + (b) * SHM_K + KSWZ(sr, kc)) = St::tobf(sr_[i].ks0);                       \
    *(bf16x8*)((char*)K_lds + (b) * SHM_K + KSWZ(32 + sr, kc)) = St::tobf(sr_[i].ks1); } while (0)
#define SWAIT() do { if constexpr (SDEPTH == 2) asm volatile("s_waitcnt vmcnt(4)" ::: "memory"); else asm volatile("s_waitcnt vmcnt(0)" ::: "memory"); } while (0)
#define RESC(a) do { if (!NOREF && __any((a) < 1.f)) { if (hi == 0) al_l[r32] = (a); asm volatile("s_waitcnt lgkmcnt(0)" ::: "memory"); \
    for (int d = 0; d < 4; ++d) for (int r = 0; r < 16; ++r) o[d][r] *= al_l[crow(r, hi)]; } } while (0)
  SLOAD(0, 0);
  if (qg) {
    float f[8][8]; float ss = 0.f;
#pragma unroll
    for (int d0 = 0; d0 < 8; ++d0) { const u32x4 w = *reinterpret_cast<const u32x4*>(&qr[d0]);
#pragma unroll
      for (int e = 0; e < 4; ++e) { f[d0][2 * e] = __uint_as_float(w[e] << 16); f[d0][2 * e + 1] = __uint_as_float(w[e] & 0xffff0000u); ss += f[d0][2 * e] * f[d0][2 * e] + f[d0][2 * e + 1] * f[d0][2 * e + 1]; } }
    { auto rr = __builtin_amdgcn_permlane32_swap(__float_as_uint(ss), __float_as_uint(ss), false, false); ss = __uint_as_float(rr[0]) + __uint_as_float(rr[1]); }
    const float rs = rsqrtf(ss * (1.f / 128.f) + 1e-6f);
#pragma unroll
    for (int d0 = 0; d0 < 8; ++d0)
#pragma unroll
      for (int j = 0; j < 8; ++j) f[d0][j] *= rs * qg[16 * d0 + 8 * hi + j] * (NOREF ? SCALE * 1.4426950408889634f : 1.f);
    const int t = t0 + wid * QBLK + r32;
#pragma unroll
    for (int d0 = 0; d0 < 4; ++d0) { const float* rp = rope + (d0 < 2 ? (t / 64) : (t % 64)) * 64;
#pragma unroll
      for (int j = 0; j < 8; ++j) { const int fi = (16 * d0 + 8 * hi + j) & 31; const float cs = rp[2 * fi], sn = rp[2 * fi + 1];
        const float x1 = f[d0][j], x2 = f[d0 + 4][j]; f[d0][j] = x1 * cs - x2 * sn; f[d0 + 4][j] = x2 * cs + x1 * sn; } }
#pragma unroll
    for (int d0 = 0; d0 < 8; ++d0) { u32x4 w = {cvtpk(f[d0][0], f[d0][1]), cvtpk(f[d0][2], f[d0][3]), cvtpk(f[d0][4], f[d0][5]), cvtpk(f[d0][6], f[d0][7])}; qr[d0] = *reinterpret_cast<bf16x8*>(&w); }
  }
  f32x16 pA0, pA1, pB0, pB1; float mnA, mnB, alA, alB; bf16x8 pa0, pa1, pa2, pa3; const int NT = seq / KVBLK;
  constexpr int SE = 0, SO = SDEPTH - 1;
  asm volatile("s_waitcnt vmcnt(0)" ::: "memory"); SWRITE(0, SE); __syncthreads();
  qkt(pA0, pA1, K_lds, qr, r32, hi); partialSM<NOREF>(pA0, pA1, m_reg, mnA, alA);
  SLOAD(SO, KVBLK); if constexpr (SDEPTH == 2) { if (2 < NT) SLOAD(SE, 2 * KVBLK); }
  SWAIT(); SWRITE(1, SO); __syncthreads();
  for (int j = 1; j + 1 < NT; j += 2) {
    SBAR(); qkt(pB0, pB1, (bf16*)((char*)K_lds + SHM_K), qr, r32, hi);
    finishSM<NOREF>(pA0, pA1, alA, l_reg, pa0, pa1, pa2, pa3); SBAR();
    SLOAD(SO, (j + SDEPTH) * KVBLK); SBAR();
    if constexpr (NOREF) { pv_d0_sm(o, vb0, pa0, pa1, pa2, pa3, pB0); alB = 1.f; } else { pv_d0(o, vb0, pa0, pa1, pa2, pa3); partialSM<NOREF>(pB0, pB1, m_reg, mnB, alB); }
    __syncthreads(); SWAIT(); SWRITE(0, SE);
    RESC(alB); __syncthreads();
    SBAR(); qkt(pA0, pA1, K_lds, qr, r32, hi);
    finishSM<NOREF>(pB0, pB1, alB, l_reg, pa0, pa1, pa2, pa3); SBAR();
    if (SDEPTH == 1 || j + 3 < NT) SLOAD(SE, (j + 1 + SDEPTH) * KVBLK); SBAR();
    if constexpr (NOREF) { pv_d0_sm(o, vb0 + (int)SHM_V, pa0, pa1, pa2, pa3, pA0); alA = 1.f; } else { pv_d0(o, vb0 + (int)SHM_V, pa0, pa1, pa2, pa3); partialSM<NOREF>(pA0, pA1, m_reg, mnA, alA); }
    __syncthreads(); SWAIT(); SWRITE(1, SO);
    RESC(alA); __syncthreads();
  }
  SBAR(); qkt(pB0, pB1, (bf16*)((char*)K_lds + SHM_K), qr, r32, hi);
  finishSM<NOREF>(pA0, pA1, alA, l_reg, pa0, pa1, pa2, pa3); SBAR();
  if constexpr (NOREF) { pv_d0_sm(o, vb0, pa0, pa1, pa2, pa3, pB0); alB = 1.f; } else { pv_d0(o, vb0, pa0, pa1, pa2, pa3); partialSM<NOREF>(pB0, pB1, m_reg, mnB, alB); }
  __syncthreads(); RESC(alB);
  finishSM<NOREF>(pB0, pB1, alB, l_reg, pa0, pa1, pa2, pa3); SBAR();
  pv_d0(o, vb0 + (int)SHM_V, pa0, pa1, pa2, pa3);
  if constexpr (NOREF) { auto rr = __builtin_amdgcn_permlane32_swap(__float_as_uint(l_reg), __float_as_uint(l_reg), false, false); l_reg = __uint_as_float(rr[0]) + __uint_as_float(rr[1]); }
  if (hi == 0) li_l[r32] = l_reg; asm volatile("s_waitcnt lgkmcnt(0)" ::: "memory");
  float rli[16];
#pragma unroll
  for (int r = 0; r < 16; ++r) rli[r] = __builtin_amdgcn_rcpf(li_l[crow(r, hi)]);
  bf16* Ow = Ob + (long)(wid * QBLK) * LDO;
#pragma unroll
  for (int r = 0; r < 16; ++r) { int orow = crow(r, hi);
    for (int d0 = 0; d0 < 4; ++d0) Ow[(long)orow * LDO + d0 * 32 + r32] = (bf16)(cvtpk(o[d0][r] * rli[r], 0.f) & 0xffffu); }
#undef SLOAD
#undef SWRITE
#undef SWAIT
#undef RESC
}
}

namespace {
using pg8::bf16_t; using pg8::bf16x8; using pg8::f32x4; using pg8::u32x4;
typedef unsigned u32x2 __attribute__((ext_vector_type(2)));
typedef float f32x16 __attribute__((ext_vector_type(16)));
typedef short s16x4 __attribute__((ext_vector_type(4)));
#define LAS __attribute__((address_space(3)))

constexpr int D = 1024, NBATCH = 2, SEQ = 8192, CTXL = 256;
constexpr int NLAT = NBATCH * SEQ, NCTX = NBATCH * CTXL, NTOK = NLAT + NCTX;
constexpr int SLEN = CTXL + SEQ;
constexpr int NCH = SLEN / 128;
constexpr int ABIN = 5680, NWIN = 5888;
constexpr int NGATE = 48;
constexpr float ALPHA = 1.4142135623730951f;
constexpr int NWAVES = 8, NTHREADS = 512;
constexpr int MOE_MAXTILES = 148;

constexpr size_t MiB = 1u << 20;
constexpr size_t WS_CTL = 0;
constexpr size_t WS_MODV = 64 * 1024;
constexpr size_t WS_ROPE = 208 * 1024;
constexpr size_t WS_DN = 256 * 1024;
constexpr size_t WS_MS = 784 * 1024;
constexpr size_t WS_AEND = 808 * 1024;
constexpr size_t WS_WIN = 1 * MiB;
constexpr size_t WS_WOUT = 12 * MiB + 512 * 1024;
constexpr size_t WS_ATIN = 16 * MiB + 512 * 1024;
constexpr size_t WS_ATOUT = 19 * MiB + 512 * 1024;
constexpr size_t WS_XL = 22 * MiB;
constexpr size_t WS_HB = 88 * MiB;
constexpr size_t WS_MOEW = 121 * MiB;
constexpr size_t WS_ROUTE = 217 * MiB;
constexpr size_t WS_R = 219 * MiB;
constexpr size_t WS_QK = WS_R, WS_V = WS_R + 33 * MiB, WS_O = WS_R + 66 * MiB, WS_Z = WS_R + 99 * MiB, WS_XBC = WS_R + 132 * MiB;
constexpr size_t WS_GATES = WS_R + 182 * MiB;
constexpr size_t WS_SSQ = WS_R + 185 * MiB + 256 * 1024;
constexpr size_t WS_MIX = WS_R + 186 * MiB;
constexpr size_t WS_XC = WS_HB;
constexpr size_t WS_DS = 138 * MiB;
constexpr size_t WS_DC = WS_XL;
constexpr size_t WS_YB = WS_R;
constexpr size_t WS_XS = WS_R, WS_HMID = WS_R + 74 * MiB, WS_YS = WS_R + 148 * MiB;
constexpr size_t WS_Q = WS_R, WS_KB = WS_R + 33 * MiB, WS_VB = WS_R + 42 * MiB, WS_AO = WS_R + 51 * MiB, WS_YB1 = WS_R + 84 * MiB, WS_S = WS_R + 117 * MiB;
constexpr size_t WS_TOKTAB = 472 * MiB;
constexpr size_t WS_MLG = 476 * MiB;
constexpr size_t WS_SSG = 479 * MiB;
constexpr size_t WS_WD0 = 486 * MiB;
constexpr size_t WS_END = 518 * MiB;

constexpr int CW_CNT0 = 64, CW_CNT1 = 128;
constexpr int CW_DEP0 = 256, CW_DEP1 = 512;
constexpr int CW_BAR = 1024;

__device__ __forceinline__ float bf2f(unsigned short v) { return __uint_as_float((unsigned)v << 16); }
typedef float f32x2_t __attribute__((ext_vector_type(2))); typedef __bf16 bf16x2_t __attribute__((ext_vector_type(2)));
__device__ __forceinline__ unsigned pk2(float lo, float hi) { f32x2_t v = {lo, hi}; bf16x2_t b = __builtin_convertvector(v, bf16x2_t); return __builtin_bit_cast(unsigned, b); }
__device__ __forceinline__ bf16_t f2bf(float f) { return (bf16_t)(pk2(f, 0.f) & 0xffffu); }
__device__ __forceinline__ float siluf(float x) { return x * __builtin_amdgcn_rcpf(1.f + __expf(-x)); }
__device__ __forceinline__ float sigmf(float x) { return __builtin_amdgcn_rcpf(1.f + __expf(-x)); }
__device__ __forceinline__ float softplusf(float x) { const float t = __expf(-fabsf(x)); const float l = t < 0.01f ? t * (1.f - t * (0.5f - t * (1.f / 3.f))) : __logf(1.f + t); return fmaxf(x, 0.f) + l; }
__device__ __forceinline__ float logsigf(float x) { return -softplusf(-x); }
__device__ __forceinline__ float wave_sum(float v) {
#pragma unroll
    for (int o = 1; o < 64; o <<= 1) v += __shfl_xor(v, o);
    return v;
}
__device__ __forceinline__ float wave_max(float v) {
#pragma unroll
    for (int o = 1; o < 64; o <<= 1) v = fmaxf(v, __shfl_xor(v, o));
    return v; }
__device__ __forceinline__ unsigned char* launder_ptr(unsigned char* p) { asm volatile("" : "+s"(p)); return p; }
__device__ __forceinline__ int fresh_lane() { int z = 0; asm volatile("" : "+s"(z)); return (int)__builtin_amdgcn_mbcnt_hi(~0u, __builtin_amdgcn_mbcnt_lo(~0u, (unsigned)z)); }
__device__ __forceinline__ int mod_index(int row) { return row < NLAT ? row / SEQ : 2; }
__device__ __forceinline__ int seq_row(int b, int dir, int i) {
    if (i < CTXL) { int t = dir ? (CTXL - 1 - i) : i; return NLAT + b * CTXL + t; }
    int t = i - CTXL; if (dir) t = SEQ - 1 - t; return b * SEQ + t;
}
__device__ __forceinline__ int chunk_row0(int b, int cid) { return cid < 2 ? NLAT + b * CTXL + cid * 128 : b * SEQ + (cid - 2) * 128; }
__device__ __forceinline__ int scan_cid(int dir, int p) { return dir == 0 ? p : (p < 2 ? 1 - p : 67 - p); }

struct RowF { f32x4 v[4]; };
__device__ __forceinline__ RowF row_ld_f32(const float* p, int lane) { RowF r; const f32x4* q = (const f32x4*)p + lane;
#pragma unroll
    for (int j = 0; j < 4; ++j) r.v[j] = q[64 * j];
    return r; }
__device__ __forceinline__ RowF row_ld_bf16(const bf16_t* p, int lane) { RowF r; const u32x2* q = (const u32x2*)p + lane;
#pragma unroll
    for (int j = 0; j < 4; ++j) { const u32x2 w = q[64 * j]; r.v[j] = (f32x4){__uint_as_float(w.x << 16), __uint_as_float(w.x & 0xffff0000u), __uint_as_float(w.y << 16), __uint_as_float(w.y & 0xffff0000u)}; }
    return r; }
struct RowRaw { u32x2 w[4]; };
__device__ __forceinline__ RowRaw row_ldraw_bf16(const bf16_t* p, int lane) { RowRaw r; const u32x2* q = (const u32x2*)p + lane;
#pragma unroll
    for (int j = 0; j < 4; ++j) r.w[j] = q[64 * j];
    return r; }
__device__ __forceinline__ RowF row_cvt(const RowRaw& t) { RowF r;
#pragma unroll
    for (int j = 0; j < 4; ++j) r.v[j] = (f32x4){__uint_as_float(t.w[j].x << 16), __uint_as_float(t.w[j].x & 0xffff0000u), __uint_as_float(t.w[j].y << 16), __uint_as_float(t.w[j].y & 0xffff0000u)};
    return r; }
__device__ __forceinline__ void row_st_f32(float* p, int lane, const RowF& r) { f32x4* q = (f32x4*)p + lane;
#pragma unroll
    for (int j = 0; j < 4; ++j) q[64 * j] = r.v[j]; }
__device__ __forceinline__ void row_st_bf16(bf16_t* p, int lane, const RowF& r) { u32x2* q = (u32x2*)p + lane;
#pragma unroll
    for (int j = 0; j < 4; ++j) { u32x2 w; w.x = pk2(r.v[j][0], r.v[j][1]); w.y = pk2(r.v[j][2], r.v[j][3]); q[64 * j] = w; } }
__device__ __forceinline__ float row_sum(const RowF& r) { float s = 0.f;
#pragma unroll
    for (int j = 0; j < 4; ++j) s += (r.v[j][0] + r.v[j][1]) + (r.v[j][2] + r.v[j][3]);
    return wave_sum(s); }
__device__ __forceinline__ void row_layernorm(RowF& r, const float* g, const float* b, int lane) {
    const float mu = row_sum(r) * (1.f / D); float q = 0.f;
#pragma unroll
    for (int j = 0; j < 4; ++j) { r.v[j] = r.v[j] - mu; q += (r.v[j][0] * r.v[j][0] + r.v[j][1] * r.v[j][1]) + (r.v[j][2] * r.v[j][2] + r.v[j][3] * r.v[j][3]); }
    const float rstd = rsqrtf(wave_sum(q) * (1.f / D) + 1e-5f);
    const RowF gg = row_ld_f32(g, lane), bb = row_ld_f32(b, lane);
#pragma unroll
    for (int j = 0; j < 4; ++j) r.v[j] = r.v[j] * rstd * gg.v[j] + bb.v[j];
}
__device__ __forceinline__ RowF row_modulate(const RowF& x, const float* sh, const float* sc, int lane) {
    const RowF s = row_ld_f32(sh, lane), c = row_ld_f32(sc, lane); RowF h;
#pragma unroll
    for (int j = 0; j < 4; ++j) h.v[j] = x.v[j] * (1.f + c.v[j]) + s.v[j];
    return h; }

template <class Dest> struct EpiStore {
    static constexpr bool PERM = true, AFTER_DRAIN = false, MIDK = false; Dest d;
    __device__ __forceinline__ void operator()(const f32x4 (&acc)[2][2][4][2], const pg8::Unit& u, int wr, int wc, int fr, int fq) const {
#pragma unroll
        for (int ai = 0; ai < 2; ++ai)
#pragma unroll
            for (int m = 0; m < 4; ++m) {
                const int row = u.pm * 256 + ai * 128 + wr * 64 + m * 16 + fr;
                bf16_t* rp = d.rowptr(row, u.pn); if (!rp) continue;
#pragma unroll
                for (int bj = 0; bj < 2; ++bj) { const f32x4 v0 = acc[ai][bj][m][0], v1 = acc[ai][bj][m][1];
                    u32x4 w; w.x = pk2(v0[0], v0[1]); w.y = pk2(v0[2], v0[3]); w.z = pk2(v1[0], v1[1]); w.w = pk2(v1[2], v1[3]);
                    *(u32x4*)(rp + bj * 128 + wc * 32 + 8 * fq) = w; }
            }
    }
};
struct DestWin { bf16_t* base;
    __device__ __forceinline__ bf16_t* rowptr(int row, int pn) const {
        if (pn < 16) { const int seg = pn >> 2; return base + (size_t)seg * (33 * MiB / 2) + (size_t)row * 1024 + (pn & 3) * 256; }
        return base + (size_t)4 * (33 * MiB / 2) + (size_t)row * 1536 + (pn - 16) * 256; } };
struct EpiWin {
    static constexpr bool PERM = true, AFTER_DRAIN = false, MIDK = false; EpiStore<DestWin> st; float* gates; const float* igb; const float* fgb; const float* dtb;
    __device__ __forceinline__ void operator()(const f32x4 (&acc)[2][2][4][2], const pg8::Unit& u, int wr, int wc, int fr, int fq) const {
        if (u.pn < 22) { st(acc, u, wr, wc, fr, fq); return; }
        const int c0 = wc * 32 + 8 * fq;
        if (c0 >= NGATE) return;
        float bias[8];
#pragma unroll
        for (int i = 0; i < 8; ++i) { const int c = c0 + i; bias[i] = c < 8 ? igb[c] : (c < 16 ? fgb[c - 8] : dtb[c - 16]); }
#pragma unroll
        for (int ai = 0; ai < 2; ++ai)
#pragma unroll
            for (int m = 0; m < 4; ++m) { const int row = u.pm * 256 + ai * 128 + wr * 64 + m * 16 + fr;
                float v[8];
#pragma unroll
                for (int i = 0; i < 8; ++i) { const float x = acc[ai][0][m][i >> 2][i & 3] + bias[i]; const int c = c0 + i; const float sp = softplusf(c < 16 ? -x : x); v[i] = c < 8 ? x : (c < 16 ? -sp : sp); }
                float* gp = gates + (size_t)row * NGATE + c0;
                *(f32x4*)gp = (f32x4){v[0], v[1], v[2], v[3]}; *(f32x4*)(gp + 4) = (f32x4){v[4], v[5], v[6], v[7]}; }
    }
};
struct DestPlain { bf16_t* base; int ld; int pnmask;
    __device__ __forceinline__ bf16_t* rowptr(int row, int pn) const { return base + (size_t)row * ld + (pn & pnmask) * 256; } };
struct DestQKV { bf16_t* q; bf16_t* kb; bf16_t* vb;
    __device__ __forceinline__ bf16_t* rowptr(int row, int pn) const {
        if (pn < 4) return row < NLAT ? q + (size_t)row * 1024 + pn * 256 : nullptr;
        int key; if (row < NLAT) { const int b = row / SEQ, t = row % SEQ; key = b * SLEN + CTXL + t; } else { const int r = row - NLAT; key = (r / CTXL) * SLEN + (r % CTXL); }
        return (pn == 4 ? kb : vb) + (size_t)key * 256; } };
struct EpiWout {
    static constexpr bool PERM = true, AFTER_DRAIN = false, MIDK = true; EpiStore<DestPlain> st; const float* ssq;
    __device__ __forceinline__ void operator()(const f32x4 (&acc)[2][2][4][2], const pg8::Unit& u, int wr, int wc, int fr, int fq) const { st(acc, u, wr, wc, fr, fq); }
    __device__ __forceinline__ void midk(f32x4 (&acc)[2][2][4][2], const pg8::Unit& u, int wr, int wc, int fr, int fq) const {
        const float* p0 = ssq + (size_t)(u.pm * 256 + wr * 64 + fr) * 8; asm volatile("" : "+v"(p0));
#pragma unroll
        for (int ai = 0; ai < 2; ++ai)
#pragma unroll
            for (int m = 0; m < 4; ++m) { const float* p = p0 + (ai * 128 + m * 16) * 8;
                const f32x4 s0 = *(const f32x4*)p, s1 = *(const f32x4*)(p + 4);
                const float r = rsqrtf((((s0[0] + s0[1]) + (s0[2] + s0[3])) + ((s1[0] + s1[1]) + (s1[2] + s1[3]))) * (1.f / 1024.f) + 1e-6f);
#pragma unroll
                for (int bj = 0; bj < 2; ++bj)
#pragma unroll
                    for (int n = 0; n < 2; ++n) acc[ai][bj][m][n] = acc[ai][bj][m][n] * r;
                __builtin_amdgcn_sched_barrier(0); }
    }
};
template <bool WT = false> struct EpiSwigluT {
    static constexpr bool PERM = true, AFTER_DRAIN = false, MIDK = false; bf16_t* out;
    __device__ __forceinline__ void operator()(const f32x4 (&acc)[2][2][4][2], const pg8::Unit& u, int wr, int wc, int fr, int fq) const {
        const int pnl = u.pn & 7;
#pragma unroll
        for (int ai = 0; ai < 2; ++ai)
#pragma unroll
            for (int m = 0; m < 4; ++m) {
                const int row = u.pm * 256 + ai * 128 + wr * 64 + m * 16 + fr;
                bf16_t* rp = out + (size_t)row * 1024 + pnl * 128 + wc * 16 + 4 * fq;
#pragma unroll
                for (int bj = 0; bj < 2; ++bj) { const f32x4 g = acc[ai][bj][m][0], up = acc[ai][bj][m][1];
                    u32x2 w; w.x = pk2(siluf(g[0]) * up[0], siluf(g[1]) * up[1]); w.y = pk2(siluf(g[2]) * up[2], siluf(g[3]) * up[3]);
                    if constexpr (WT) __hip_atomic_store((__attribute__((address_space(1))) unsigned long long*)(rp + bj * 64), (unsigned long long)w.x | ((unsigned long long)w.y << 32), __ATOMIC_RELAXED, __HIP_MEMORY_SCOPE_AGENT);
                    else *(u32x2*)(rp + bj * 64) = w; }
            }
    }
};
using EpiSwiglu = EpiSwigluT<false>;
struct QkvOrder {
    static constexpr bool LATE = false; pg8::StaticOrder so; int G, c, kfirst;
    __device__ __forceinline__ void init(int G_, int c_) { G = G_; c = c_; so.init(NTOK, 5 * 256, G_, c_); const int single0 = 396 - G_; kfirst = (single0 >= 0 && single0 + 66 <= G_) ? single0 : 0; }
    __device__ __forceinline__ bool next(int i, pg8::Unit& u) const {
        const int L = i * G + c; if (L >= 396) return false;
        if (L >= kfirst && L < kfirst + 66) { u.pm = L - kfirst; u.pn = 4; return true; }
        pg8::StaticOrder t = so; t.G = 1; t.c = (L < kfirst) ? L : L - 66; pg8::Unit v; t.next(0, v); u.pm = v.pm; u.pn = v.pn < 4 ? v.pn : 5; return true; }
    __device__ __forceinline__ void a_ready(const pg8::Unit&) const {}
    __device__ __forceinline__ void done(const pg8::Unit&) const {}
    __device__ __forceinline__ void late(const pg8::Unit&) const {}
};
struct MoeOrder {
    int ntm, npn, nwg, G, c; const LAS int* toff; const int* tab;
    __device__ __forceinline__ void init(const LAS int* toff_, int npn_, int G_, int c_) { toff = toff_; ntm = toff_[16]; npn = npn_; nwg = ntm * npn_; G = G_; c = c_; }
    __device__ __forceinline__ bool next(int i, pg8::Unit& u) const {
        const long L = (long)i * G + c; if (L >= nwg) return false;
        int wgid = (int)L; { const int q = nwg / 8, r = nwg % 8, xcd = wgid % 8, off = wgid / 8; wgid = (xcd < r ? xcd * (q + 1) : r * (q + 1) + (xcd - r) * q) + off; }
        const int pm = wgid / npn, pnl = wgid % npn; int e = 0;
#pragma unroll
        for (int k = 1; k < 16; ++k) e += (toff[k] <= pm) ? 1 : 0;
        u.pm = pm; u.pn = e * npn + pnl; return true;
    }
    __device__ __forceinline__ int arow(const pg8::Unit& u, int r) const { const int e = u.pn / npn, pos = (u.pm - toff[e]) * 256 + r; return pos < toff[100 + e] ? tab[(size_t)e * NTOK + pos] : 0; }
    static constexpr bool LATE = false;
    __device__ __forceinline__ void a_ready(const pg8::Unit&) const {}
    __device__ __forceinline__ void done(const pg8::Unit&) const {}
    __device__ __forceinline__ void late(const pg8::Unit&) const {}
};

struct MoeMerged {
    static constexpr bool LATE = true;
    int m0, nm, nloc, rank, n1c, crot; const LAS int* toff; const int* tab; unsigned* dep;
    __device__ __forceinline__ void init(const LAS int* toff_, const int* tab_, unsigned* dep_) {
        toff = toff_; tab = tab_; dep = dep_; m0 = toff_[120]; nm = toff_[121]; nloc = toff_[122]; rank = toff_[123];
        const int n1 = nm * 8; n1c = rank < n1 ? (n1 - rank + nloc - 1) / nloc : 0; const int rot = n1 % nloc; crot = (rank - rot + nloc) % nloc; }
    __device__ __forceinline__ bool next(int i, pg8::Unit& u) const {
        int pm, pnl, npn, base;
        if (i < n1c) { const int t1 = i * nloc + rank; pm = m0 + (t1 >> 3); pnl = t1 & 7; npn = 8; base = 0; }
        else { const int t2 = (i - n1c) * nloc + crot; if (t2 >= nm * 4) return false; pm = m0 + (t2 >> 2); pnl = t2 & 3; npn = 4; base = 128; }
        int e = 0;
#pragma unroll
        for (int k = 1; k < 16; ++k) e += (toff[k] <= pm) ? 1 : 0;
        u.pm = pm; u.pn = base + e * npn + pnl; return true;
    }
    __device__ __forceinline__ int arow(const pg8::Unit& u, int r) const {
        if (u.pn >= 128) return (int)((WS_HMID - WS_HB) / 2048) + u.pm * 256 + r;
        const int e = u.pn >> 3, pos = (u.pm - toff[e]) * 256 + r; return pos < toff[100 + e] ? tab[(size_t)e * NTOK + pos] : 0; }
    __device__ __forceinline__ void a_ready(const pg8::Unit& u) const {
        if (u.pn >= 128) { unsigned* w = dep + u.pm; unsigned sp = 0;
            while ((unsigned)__builtin_amdgcn_readfirstlane(__hip_atomic_load(w, __ATOMIC_RELAXED, __HIP_MEMORY_SCOPE_AGENT)) < 64u) { __builtin_amdgcn_s_sleep(1); if (++sp > (1u << 22)) break; }
            asm volatile("" ::: "memory"); }
    }
    __device__ __forceinline__ void done(const pg8::Unit&) const {}
    __device__ __forceinline__ void late(const pg8::Unit& u) const {
        if (u.pn < 128) { asm volatile("s_waitcnt vmcnt(0)" ::: "memory"); if (fresh_lane() == 0) (void)__hip_atomic_fetch_add(dep + u.pm, 1u, __ATOMIC_RELAXED, __HIP_MEMORY_SCOPE_AGENT); }
    }
};
struct EpiMoe {
    static constexpr bool PERM = true, AFTER_DRAIN = false, MIDK = false; EpiSwigluT<false> sw; EpiStore<DestPlain> st;
    __device__ __forceinline__ void operator()(const f32x4 (&acc)[2][2][4][2], const pg8::Unit& u, int wr, int wc, int fr, int fq) const {
        if (u.pn < 128) sw(acc, u, wr, wc, fr, fq); else st(acc, u, wr, wc, fr, fq); }
};

#define XB_TMO      128
#define XB_XCNT(j)  (256  + 64 * (j))
#define XB_XSUB(j)  (1280 + 64 * (j))
#define XB_XGEN(j)  (2304 + 64 * (j))
#define XB_TOP      3328
#define XB_TOPGEN   3392
#define XCD_BAR_WORDS 3456
#define XB_SPIN_CAP (1u << 18)

__device__ __forceinline__ unsigned xb_ld(unsigned* p)              { return __hip_atomic_load(p, __ATOMIC_RELAXED, __HIP_MEMORY_SCOPE_AGENT); }
__device__ __forceinline__ unsigned xb_add(unsigned* p, unsigned v) { return __hip_atomic_fetch_add(p, v, __ATOMIC_RELAXED, __HIP_MEMORY_SCOPE_AGENT); }
__device__ __forceinline__ unsigned xb_xcc_id() { return (unsigned)__builtin_amdgcn_s_getreg((3 << 11) | 20) & 0xFu; }
#define XB_SPIN(cond, bar) do { unsigned _sp = 0; while (cond) { __builtin_amdgcn_s_sleep(1); \
    if ((++_sp & 255u) == 0u) { if (xb_ld(&(bar)[XB_TMO])) break; if (_sp > XB_SPIN_CAP) { atomicAdd(&(bar)[XB_TMO], 1u); break; } } } } while (0)

struct XcdBarrier {
    unsigned* bar; unsigned x;
    volatile LAS unsigned* st;
};

__device__ __forceinline__ XcdBarrier xcd_barrier_post(unsigned* bar, volatile LAS unsigned* st, int tid) {
    XcdBarrier b; b.bar = bar; b.x = xb_xcc_id(); b.st = st;
    if (tid == 0) { st[2] = xb_add(&bar[XB_XCNT(b.x)], 1u); st[3] = b.x; }
    return b;
}
__device__ __forceinline__ void xcd_barrier_complete(unsigned* bar, unsigned x, unsigned& nloc, unsigned& nx) {
    const unsigned G = gridDim.x * gridDim.y * gridDim.z;
    unsigned sum, cnt, mine, sp = 0u;
    for (;;) {
        sum = 0u; cnt = 0u; mine = 0u;
#pragma unroll
        for (unsigned j = 0; j < 16; ++j) { const unsigned c = xb_ld(&bar[XB_XCNT(j)]); sum += c; cnt += (c > 0u) ? 1u : 0u; mine = (j == x) ? c : mine; }
        if (sum == G) break;
        __builtin_amdgcn_s_sleep(1);
        if ((++sp & 255u) == 0u) { if (xb_ld(&bar[XB_TMO])) break; if (sp > XB_SPIN_CAP) { atomicAdd(&bar[XB_TMO], 1u); break; } }
    }
    nloc = mine > 0u ? mine : 1u; nx = cnt > 0u ? cnt : 1u;
}

__device__ __forceinline__ void xcd_barrier(const XcdBarrier& b, int tid) {
    asm volatile("s_waitcnt vmcnt(0)" ::: "memory");
    __syncthreads();
    if (tid == 0) {
        unsigned* bar = b.bar;
        __builtin_amdgcn_s_waitcnt(0);
        unsigned nloc = b.st[0], nx = b.st[1];
        if (nloc == 0u) { xcd_barrier_complete(bar, b.x, nloc, nx); b.st[0] = nloc; b.st[1] = nx; }
        const unsigned old = xb_add(&bar[XB_XSUB(b.x)], 1u);
        const unsigned gen = old / nloc;
        if (old + 1u == (gen + 1u) * nloc) {
            __builtin_amdgcn_fence(__ATOMIC_RELEASE, "agent");
            asm volatile("s_waitcnt vmcnt(0)" ::: "memory");
            const unsigned og = xb_add(&bar[XB_TOP], 1u);
            const unsigned tg = og / nx;
            if (og + 1u == (tg + 1u) * nx) xb_add(&bar[XB_TOPGEN], 1u);
            else XB_SPIN(xb_ld(&bar[XB_TOPGEN]) == tg, bar);
            __builtin_amdgcn_fence(__ATOMIC_ACQUIRE, "agent");
            xb_add(&bar[XB_XGEN(b.x)], 1u);
            asm volatile("s_waitcnt vmcnt(0)" ::: "memory");
        } else {
            XB_SPIN(xb_ld(&bar[XB_XGEN(b.x)]) == gen, bar);
            __builtin_amdgcn_fence(__ATOMIC_ACQUIRE, "agent");
            asm volatile("s_waitcnt vmcnt(0)" ::: "memory");
        }
    }
    __syncthreads();
}

struct Args {
    const float* in[28]; float* out; unsigned char* ws; int ph_lo, ph_hi, li, pad;
};
struct Ctx {
    LAS unsigned char* lds; unsigned char* ws;
    int tid, lane, wave, G, bid;
};
#define CTLP(F) ((unsigned*)((F).ws + WS_CTL))
#define MISCP(F) ((LAS int*)((F).lds + MISC_OFF))
#define GWID(F) ((F).bid * NWAVES + (F).wave)
#define NGW(F) ((F).G * NWAVES)
enum { I_X = 0, I_C, I_CTX, I_CCTX, I_ADAW, I_ADAB, I_LNG, I_LNB, I_ABWIN, I_ABWOUT, I_IGB, I_FGB, I_MNG, I_CONVW, I_CONVB, I_DTB, I_ALOG, I_SSMD, I_SNG,
       I_ATWIN, I_ATWOUT, I_QG, I_KG, I_RW, I_RB, I_WG, I_WU, I_WD };
constexpr int RING_BYTES = 131072, MISC_OFF = RING_BYTES, LDS_BYTES = RING_BYTES + 12288;

template <class Src> __device__ __forceinline__ void transpose_item(const Src& S, bf16_t* WT, int K, int orow0, int k0, LAS float* scr, int lane, float scale) {
#pragma unroll 8
    for (int i = 0; i < 32; ++i) { const int kk = 2 * i + (lane >> 5); scr[kk * 33 + (lane & 31)] = S.ld(k0 + kk, lane & 31); }
    asm volatile("s_waitcnt lgkmcnt(0)" ::: "memory");
    const int c = lane & 7;
#pragma unroll
    for (int j = 0; j < 4; ++j) { const int n = (lane >> 3) + 8 * j; const LAS float* s = scr + (8 * c) * 33 + S.scol(n);
        u32x4 o; o.x = pk2(s[0 * 33] * scale, s[1 * 33] * scale); o.y = pk2(s[2 * 33] * scale, s[3 * 33] * scale); o.z = pk2(s[4 * 33] * scale, s[5 * 33] * scale); o.w = pk2(s[6 * 33] * scale, s[7 * 33] * scale);
        *(u32x4*)(WT + (size_t)(orow0 + n) * K + k0 + 8 * c) = o; }
    asm volatile("s_waitcnt lgkmcnt(0)" ::: "memory");
}
__device__ __forceinline__ void transpose_wide(const float* W, int N, int n0, bf16_t* WT, int K, int orow0, int k0, LAS float* scr, int lane, float scale) {
    const int kr = lane >> 4, c4 = (lane & 15) * 4;
#pragma unroll
    for (int i = 0; i < 8; ++i) { const int kk = 4 * i + kr; *(LAS f32x4*)(scr + kk * 68 + c4) = *(const f32x4*)(W + (size_t)(k0 + kk) * N + n0 + c4); }
    asm volatile("s_waitcnt lgkmcnt(0)" ::: "memory");
#pragma unroll
    for (int g = 0; g < 4; ++g) { const LAS float* s = scr + (8 * g) * 68 + lane;
        u32x4 o; o.x = pk2(s[0 * 68] * scale, s[1 * 68] * scale); o.y = pk2(s[2 * 68] * scale, s[3 * 68] * scale); o.z = pk2(s[4 * 68] * scale, s[5 * 68] * scale); o.w = pk2(s[6 * 68] * scale, s[7 * 68] * scale);
        *(u32x4*)(WT + (size_t)(orow0 + lane) * K + k0 + 8 * g) = o; }
    asm volatile("s_waitcnt lgkmcnt(0)" ::: "memory");
}
struct SrcPlain { const float* W; int N; int n0;
    __device__ __forceinline__ float ld(int k, int j) const { return __builtin_nontemporal_load(W + (size_t)k * N + n0 + j); }
    __device__ __forceinline__ int scol(int n) const { return n; } };
struct SrcGate { const float* W; int j0;
    __device__ __forceinline__ float ld(int k, int j) const { const int jj = j0 + j; return jj < 16 ? W[(size_t)k * ABIN + 3072 + jj] : (jj < NGATE ? W[(size_t)k * ABIN + 5648 + (jj - 16)] : 0.f); }
    __device__ __forceinline__ int scol(int n) const { return n; } };
struct SrcWout { const float* W; const float* g; int n0;
    __device__ __forceinline__ float ld(int k, int j) const { return k < 1024 ? W[(size_t)(k + 1024) * 1024 + n0 + j] * g[k] : W[(size_t)(k - 1024) * 1024 + n0 + j]; }
    __device__ __forceinline__ int scol(int n) const { return n; } };
struct SrcGU { const float* Wg; const float* Wu; int c0;
    __device__ __forceinline__ float ld(int k, int j) const { return __builtin_nontemporal_load((j < 16 ? Wg : Wu) + (size_t)k * 1024 + c0 + (j & 15)); }
    __device__ __forceinline__ int scol(int n) const { const int b4 = n >> 3, w = n & 7; return (w < 4 ? 0 : 16) + 4 * b4 + (w & 3); } };

constexpr int ADA_ITEMS = 2 * 24;
constexpr int SW_NB0 = 5632 / 64, SW_I0 = 32 * SW_NB0  , SW_IG = 16 * 8  , SW_I1 = 32 * 32  ,
              SW_I2 = 32 * 24, SW_I3 = 32 * 16, SW_NI = SW_I0 + SW_IG + SW_I1 + SW_I2 + SW_I3;
__device__ __forceinline__ void small_weight_item(Ctx& F, const Args& a, int it, LAS float* scr) {
    bf16_t* WinT = (bf16_t*)(F.ws + WS_WIN); bf16_t* WoutT = (bf16_t*)(F.ws + WS_WOUT); bf16_t* AtInT = (bf16_t*)(F.ws + WS_ATIN); bf16_t* AtOutT = (bf16_t*)(F.ws + WS_ATOUT);
    int r = it;
    if (r < SW_I0) { const int kb = r / SW_NB0, nb = r % SW_NB0, n0 = 64 * nb;
        transpose_wide(a.in[I_ABWIN], ABIN, n0 < 3072 ? n0 : n0 + 16, WinT, 1024, n0, 32 * kb, scr, F.lane, n0 < 512 ? 0.08838834764831845f : 1.f); return; } r -= SW_I0;
    if (r < SW_IG) { const int kb = r / 8, nb = r % 8; SrcGate S{a.in[I_ABWIN], 32 * nb}; transpose_item(S, WinT, 1024, 5632 + 32 * nb, 64 * kb, scr, F.lane, 1.f); return; } r -= SW_IG;
    if (r < SW_I1) { const int kb = r / 32, nb = r % 32; SrcWout S{a.in[I_ABWOUT], a.in[I_SNG], 32 * nb}; transpose_item(S, WoutT, 2048, 32 * nb, 64 * kb, scr, F.lane, 1.f); return; } r -= SW_I1;
    if (r < SW_I2) { const int kb = r / 24, nb = r % 24; transpose_wide(a.in[I_ATWIN], 1536, 64 * nb, AtInT, 1024, 64 * nb, 32 * kb, scr, F.lane, 1.f); return; } r -= SW_I2;
    { const int kb = r / 16, nb = r % 16; transpose_wide(a.in[I_ATWOUT], 1024, 64 * nb, AtOutT, 1024, 64 * nb, 32 * kb, scr, F.lane, 1.f); }
}
__device__ __forceinline__ void convert_small_weights(Ctx& F, const Args& a, int nada) {
    {   float* rope = (float*)(F.ws + WS_ROPE);
        for (int i = F.bid * NTHREADS + F.tid; i < 128 * 32; i += F.G * NTHREADS) { const int pos = i >> 5, fi = i & 31; float sn, cs; sincosf((float)pos * expf(-(float)fi * (9.210340371976184f / 32.f)), &sn, &cs); rope[2 * i] = cs; rope[2 * i + 1] = sn; } }
    LAS float* scr = (LAS float*)(F.lds + F.wave * 16384);
    if (nada >= F.G) nada = 0;
    const int H = (F.G - nada) * NWAVES, nh = nada ? (3 * H < SW_NI ? 3 * H : SW_NI) : SW_NI;
    if (F.bid >= nada) { for (int it = (F.bid - nada) * NWAVES + F.wave; it < nh; it += H) small_weight_item(F, a, it, scr); }
    else { const int L = nada * NWAVES; for (int it = nh + F.bid * NWAVES + F.wave; it < SW_NI; it += L) small_weight_item(F, a, it, scr); }
}
__device__ __forceinline__ void convert_moe_weights(Ctx& F, const Args& a, int layer, int skip_blocks, int it0 = 0, int it1 = 16 * 16 * 64 + 16 * 16 * 32, size_t wd_off = WS_MOEW + 64 * MiB) {
    if (F.bid < skip_blocks) return;
    LAS float* scr = (LAS float*)(F.lds + F.wave * 16384);
    bf16_t* WGU = (bf16_t*)(F.ws + WS_MOEW); bf16_t* WD = (bf16_t*)(F.ws + wd_off);
    const size_t wl = (size_t)layer * 16 * 1024 * 1024;
    constexpr int IGU = 16 * 16 * 64, IDN = 16 * 16 * 32;
    for (int it = it0 + (F.bid - skip_blocks) * NWAVES + F.wave; it < it1; it += (F.G - skip_blocks) * NWAVES) {
        if (it < IGU) { const int e = it / 1024, r = it % 1024, kb = r / 64, nb = r % 64;
            SrcGU S{a.in[I_WG] + wl + (size_t)e * 1048576, a.in[I_WU] + wl + (size_t)e * 1048576, 16 * nb};
            transpose_item(S, WGU + (size_t)e * 2048 * 1024, 1024, 32 * nb, 64 * kb, scr, F.lane, 1.f); }
        else { const int r0 = it - IGU, e = r0 / 512, r = r0 % 512, kb = r / 32, nb = r % 32;
            SrcPlain S{a.in[I_WD] + wl + (size_t)e * 1048576, 1024, 32 * nb};
            transpose_item(S, WD + (size_t)e * 1024 * 1024, 1024, 32 * nb, 64 * kb, scr, F.lane, 1.f); }
    }
}
__device__ __forceinline__ void ada_phase(Ctx& F, const Args& a) {
    float* modv = (float*)(F.ws + WS_MODV);
    LAS float* rr = (LAS float*)F.lds;
    for (int item = F.bid; item < ADA_ITEMS; item += F.G) {
        const int l = item / 24, n = (item % 24) * 256 + 4 * F.lane;
        f32x4 a0 = {0.f, 0.f, 0.f, 0.f}, a1 = a0, a2 = a0;
        const float* w = a.in[I_ADAW] + ((size_t)l * 1024 + F.wave * 128) * 6144 + n;
#pragma unroll 16
        for (int k = 0; k < 128; ++k) { const f32x4 wv = *(const f32x4*)(w + (size_t)k * 6144); const int kk = F.wave * 128 + k;
            a0 += wv * siluf(a.in[I_C][kk]); a1 += wv * siluf(a.in[I_C][1024 + kk]); a2 += wv * siluf(a.in[I_CCTX][kk]); }
        *(LAS f32x4*)(rr + (F.wave * 3 + 0) * 256 + 4 * F.lane) = a0; *(LAS f32x4*)(rr + (F.wave * 3 + 1) * 256 + 4 * F.lane) = a1; *(LAS f32x4*)(rr + (F.wave * 3 + 2) * 256 + 4 * F.lane) = a2;
        __syncthreads();
        if (F.wave < 3) { f32x4 s = *(const f32x4*)(a.in[I_ADAB] + l * 6144 + n);
#pragma unroll
            for (int w8 = 0; w8 < 8; ++w8) s += *(const LAS f32x4*)(rr + (w8 * 3 + F.wave) * 256 + 4 * F.lane);
            *(f32x4*)(modv + (l * 3 + F.wave) * 6144 + n) = s; }
        __syncthreads();
    }
}

template <int NC> __device__ __forceinline__ void row_dots(const RowF& h, const float* W, int lane, float (&acc)[NC]) {
#pragma unroll
    for (int i = 0; i < NC; ++i) acc[i] = 0.f;
#pragma unroll
    for (int j = 0; j < 4; ++j)
#pragma unroll
        for (int e = 0; e < 4; ++e) { const float x = h.v[j][e]; const f32x4* w = (const f32x4*)(W + (size_t)(4 * lane + 256 * j + e) * NC);
#pragma unroll
            for (int q = 0; q < NC / 4; ++q) { const f32x4 wv = w[q]; acc[4 * q + 0] += x * wv[0]; acc[4 * q + 1] += x * wv[1]; acc[4 * q + 2] += x * wv[2]; acc[4 * q + 3] += x * wv[3]; } }
}
template <int O, int N> __device__ __forceinline__ void xreduce_step(float (&acc)[N], int lane) {
    const bool up = (lane & O) != 0;
#pragma unroll
    for (int i = 0; i < O; ++i) { const float keep = up ? acc[i + O] : acc[i], send = up ? acc[i] : acc[i + O]; acc[i] = keep + __shfl_xor(send, O); }
}
template <int N> __device__ __forceinline__ float xreduce(float (&acc)[N], int lane) {
    if constexpr (N == 16) {
#pragma unroll
        for (int i = 0; i < 16; ++i) { acc[i] += __shfl_xor(acc[i], 32); acc[i] += __shfl_xor(acc[i], 16); }
    }
    if constexpr (N == 64) { xreduce_step<32, N>(acc, lane); xreduce_step<16, N>(acc, lane); }
    xreduce_step<8, N>(acc, lane); xreduce_step<4, N>(acc, lane); xreduce_step<2, N>(acc, lane); xreduce_step<1, N>(acc, lane);
    return acc[0];
}

__device__ __forceinline__ const float* x_row(const Args& a, int row) { return row < NLAT ? a.in[I_X] + (size_t)row * D : a.in[I_CTX] + (size_t)(row - NLAT) * D; }
__device__ __forceinline__ void rowpass_a(Ctx& F, const Args& a) {
    const float* modv = (const float*)(F.ws + WS_MODV);
    bf16_t* HB = (bf16_t*)(F.ws + WS_HB);
    int row = GWID(F); if (row >= NTOK) return;
    RowF xn = row_ld_f32(x_row(a, row), F.lane);
    for (; row < NTOK; row += NGW(F)) {
        const RowF x = xn; const int nrow = row + NGW(F);
        if (nrow < NTOK) xn = row_ld_f32(x_row(a, nrow), F.lane);
        const float* m = modv + mod_index(row) * 6144;
        const RowF h = row_modulate(x, m, m + 1024, F.lane);
        row_st_bf16(HB + (size_t)row * D, F.lane, h);
    }
}
__device__ __forceinline__ void stage_router(Ctx& F, const float* rw) {
    LAS f32x4* Wl = (LAS f32x4*)F.lds;
    for (int i = F.tid; i < 4096; i += NTHREADS) { const int d = i >> 2, q = i & 3; const f32x4 w = *(const f32x4*)(rw + d * 16 + q * 4);
        Wl[q * 1024 + ((d >> 8) * 4 + (d & 3)) * 64 + ((d >> 2) & 63)] = w; }
    __syncthreads();
}
__device__ __forceinline__ void row_dots16_lds(const RowF& h, const LAS f32x4* Wl, int lane, float (&acc)[16]) {
#pragma unroll
    for (int i = 0; i < 16; ++i) acc[i] = 0.f;
#pragma unroll
    for (int j = 0; j < 4; ++j)
#pragma unroll
        for (int e = 0; e < 4; ++e) { const float x = h.v[j][e];
#pragma unroll
            for (int q = 0; q < 4; ++q) { const f32x4 wv = Wl[q * 1024 + (j * 4 + e) * 64 + lane]; acc[4 * q + 0] += x * wv[0]; acc[4 * q + 1] += x * wv[1]; acc[4 * q + 2] += x * wv[2]; acc[4 * q + 3] += x * wv[3]; }
            if (e & 1) __builtin_amdgcn_sched_barrier(0); }
}
__device__ __forceinline__ float route_logit(const RowF& h2, const LAS f32x4* Wl, int lane) { float acc[16]; row_dots16_lds(h2, Wl, lane, acc); return xreduce<16>(acc, lane); }
__device__ __forceinline__ void route_select(const float logit, const float* rb, int lane, int& e0, int& e1, float& g0, float& g1) {
    const int gb = lane & 48;
    float mx = logit;
#pragma unroll
    for (int o = 8; o >= 1; o >>= 1) mx = fmaxf(mx, __shfl_xor(mx, o));
    const float ex = expf(logit - mx); float sm = ex;
#pragma unroll
    for (int o = 8; o >= 1; o >>= 1) sm += __shfl_xor(sm, o);
    const float p = ex / sm, sel = p + rb[lane & 15];
    float s4[4], p4[4];
#pragma unroll
    for (int i = 0; i < 4; ++i) s4[i] = __shfl(sel, (lane & 60) + i);
    float v1 = s4[0]; int i1 = 0;
#pragma unroll
    for (int i = 1; i < 4; ++i) if (s4[i] > v1) { v1 = s4[i]; i1 = i; }
    float v2 = -1e30f;
#pragma unroll
    for (int i = 0; i < 4; ++i) if (i != i1 && s4[i] > v2) v2 = s4[i];
    const float gs = v1 + v2;
    float best = __shfl(gs, gb); int bg = 0;
#pragma unroll
    for (int g = 1; g < 4; ++g) { const float t = __shfl(gs, gb + 4 * g); if (t > best) { best = t; bg = g; } }
#pragma unroll
    for (int i = 0; i < 4; ++i) { s4[i] = __shfl(sel, gb + 4 * bg + i); p4[i] = __shfl(p, gb + 4 * bg + i); }
    v1 = s4[0]; i1 = 0; float q1 = p4[0];
#pragma unroll
    for (int i = 1; i < 4; ++i) if (s4[i] > v1) { v1 = s4[i]; i1 = i; q1 = p4[i]; }
    v2 = -1e30f; int i2 = 0; float q2 = 0.f;
#pragma unroll
    for (int i = 0; i < 4; ++i) if (i != i1 && s4[i] > v2) { v2 = s4[i]; i2 = i; q2 = p4[i]; }
    e0 = 4 * bg + i1; e1 = 4 * bg + i2; const float s = q1 + q2; g0 = q1 / s; g1 = q2 / s;
}
__device__ __forceinline__ void rowpass_b(Ctx& F, const Args& a, int layer, int nrows, const bf16_t* YB) {
    const float* modl = (const float*)(F.ws + WS_MODV) + layer * 3 * 6144;
    bf16_t* XL = (bf16_t*)(F.ws + WS_XL); bf16_t* HB = (bf16_t*)(F.ws + WS_HB);
    int* tok_e = (int*)(F.ws + WS_ROUTE); int* tok_pos = tok_e + 2 * NTOK; float* tok_g = (float*)(tok_pos + 2 * NTOK);
    unsigned* cnt = CTLP(F) + (layer ? CW_CNT1 : CW_CNT0);
    stage_router(F, a.in[I_RW]);
    LAS int* lcnt = (LAS int*)(F.lds + 65536); LAS int* gbase = lcnt + 16; LAS int* nrow = lcnt + 32; LAS int* lrow = lcnt + 64;
    if (F.tid < 33) lcnt[F.tid] = 0;
    __syncthreads();
    RowF xf_n; RowRaw xr_n, y_n;
    { const int r0 = GWID(F); if (r0 < nrows) { if (layer) xr_n = row_ldraw_bf16(XL + (size_t)r0 * D, F.lane); else xf_n = row_ld_f32(x_row(a, r0), F.lane); y_n = row_ldraw_bf16(YB + (size_t)r0 * D, F.lane); } }
    int kq = 0, rbase = 0; float lg = 0.f;
    for (int row = GWID(F); row < nrows; row += NGW(F)) {
        const float* m = modl + mod_index(row) * 6144;
        RowF x = layer ? row_cvt(xr_n) : xf_n; const RowF y = row_cvt(y_n); const int nxr = row + NGW(F);
        if (nxr < nrows) { if (layer) xr_n = row_ldraw_bf16(XL + (size_t)nxr * D, F.lane); else xf_n = row_ld_f32(x_row(a, nxr), F.lane); y_n = row_ldraw_bf16(YB + (size_t)nxr * D, F.lane); }
        const RowF gt = row_ld_f32(m + 2048, F.lane);
#pragma unroll
        for (int j = 0; j < 4; ++j) x.v[j] = ALPHA * x.v[j] + gt.v[j] * y.v[j];
        row_layernorm(x, a.in[I_LNG] + (layer * 2) * D, a.in[I_LNB] + (layer * 2) * D, F.lane);
        row_st_bf16(XL + (size_t)row * D, F.lane, x);
        const RowF h2 = row_modulate(x, m + 3072, m + 4096, F.lane);
        row_st_bf16(HB + (size_t)row * D, F.lane, h2);
        { const float lgt = route_logit(h2, (const LAS f32x4*)F.lds, F.lane); if ((F.lane >> 4) == kq) lg = lgt; if (kq == 0) rbase = row; ++kq; }
        if (kq < 4 && nxr < nrows) continue;
        int e0, e1; float g0, g1; route_select(lg, a.in[I_RB], F.lane, e0, e1, g0, g1);
        const int kmine = F.lane >> 4, rrow = rbase + kmine * NGW(F); const bool mine = (F.lane & 15) == 0 && kmine < kq; kq = 0;
        if (mine) { const int row = rrow;
            const int p0 = __hip_atomic_fetch_add(lcnt + e0, 1, __ATOMIC_RELAXED, __HIP_MEMORY_SCOPE_WORKGROUP), p1 = __hip_atomic_fetch_add(lcnt + e1, 1, __ATOMIC_RELAXED, __HIP_MEMORY_SCOPE_WORKGROUP);
            const int ix = __hip_atomic_fetch_add(nrow, 1, __ATOMIC_RELAXED, __HIP_MEMORY_SCOPE_WORKGROUP);
            lrow[ix * 4 + 0] = row; lrow[ix * 4 + 1] = e0 | (e1 << 8); lrow[ix * 4 + 2] = p0; lrow[ix * 4 + 3] = p1;
            tok_e[row * 2] = e0; tok_e[row * 2 + 1] = e1; tok_g[row * 2] = g0; tok_g[row * 2 + 1] = g1;
        }
    }
    __syncthreads();
    if (F.tid < 16) gbase[F.tid] = (int)atomicAdd(cnt + F.tid, (unsigned)lcnt[F.tid]);
    __syncthreads();
    if (F.tid < nrow[0]) { const int row = lrow[F.tid * 4], ee = lrow[F.tid * 4 + 1];
        const int e0 = ee & 255, e1 = ee >> 8, p0 = gbase[e0] + lrow[F.tid * 4 + 2], p1 = gbase[e1] + lrow[F.tid * 4 + 3];
        tok_pos[row * 2] = p0; tok_pos[row * 2 + 1] = p1; int* tab = (int*)(F.ws + WS_TOKTAB); tab[(size_t)e0 * NTOK + p0] = row; tab[(size_t)e1 * NTOK + p1] = row; }
}
__device__ __forceinline__ void moe_offsets(Ctx& F, int layer) {
    __syncthreads();
    if (F.tid == 0) { const unsigned* cnt = CTLP(F) + (layer ? CW_CNT1 : CW_CNT0); int acc = 0;
        for (int e = 0; e < 16; ++e) { const int c = (int)__hip_atomic_load(cnt + e, __ATOMIC_RELAXED, __HIP_MEMORY_SCOPE_AGENT); MISCP(F)[e] = acc; MISCP(F)[100 + e] = c; acc += (c + 255) >> 8; }
        MISCP(F)[16] = acc; }
    __syncthreads();
}
__device__ __forceinline__ void moe_streams(Ctx& F, int layer, int li) {
    moe_offsets(F, layer);
    if (F.tid == 0) { const unsigned* bar = CTLP(F) + CW_BAR + li * 4096; const int x = MISCP(F)[35]; int tot = 0, before = 0, mine = 1;
        for (int j = 0; j < 16; ++j) { const int c = (int)__hip_atomic_load(bar + XB_XCNT(j), __ATOMIC_RELAXED, __HIP_MEMORY_SCOPE_AGENT); tot += c; before += (j < x) ? c : 0; mine = (j == x) ? c : mine; }
        const int ntm = MISCP(F)[16]; const int m0 = (int)((long)ntm * before / tot), m1 = (int)((long)ntm * (before + mine) / tot);
        MISCP(F)[120] = m0; MISCP(F)[121] = m1 - m0; MISCP(F)[122] = mine; MISCP(F)[123] = MISCP(F)[34]; }
    __syncthreads();
}
__device__ __forceinline__ void moe_scatter(Ctx& F, int layer, int nrows) {
    moe_offsets(F, layer);
    const bf16_t* HB = (const bf16_t*)(F.ws + WS_HB); bf16_t* XS = (bf16_t*)(F.ws + WS_XS);
    const int* tok_e = (const int*)(F.ws + WS_ROUTE); const int* tok_pos = tok_e + 2 * NTOK; int* tok_slot = (int*)(F.ws + WS_ROUTE + MiB);
    for (int row = GWID(F); row < nrows; row += NGW(F)) {
        const int e0 = tok_e[row * 2], e1 = tok_e[row * 2 + 1];
        const int s0 = MISCP(F)[e0] * 256 + tok_pos[row * 2], s1 = MISCP(F)[e1] * 256 + tok_pos[row * 2 + 1];
        const u32x4* src = (const u32x4*)(HB + (size_t)row * D) + F.lane; const u32x4 v0 = src[0], v1 = src[64];
        u32x4* d0 = (u32x4*)(XS + (size_t)s0 * D) + F.lane; u32x4* d1 = (u32x4*)(XS + (size_t)s1 * D) + F.lane;
        d0[0] = v0; d0[64] = v1; d1[0] = v0; d1[64] = v1;
        if (F.lane == 0) { tok_slot[row * 2] = s0; tok_slot[row * 2 + 1] = s1; }
    }
}
__device__ __forceinline__ void rowpass_c(Ctx& F, const Args& a, int layer, int nrows, bool last) {
    const float* modl = (const float*)(F.ws + WS_MODV) + layer * 3 * 6144;
    bf16_t* XL = (bf16_t*)(F.ws + WS_XL); bf16_t* HB = (bf16_t*)(F.ws + WS_HB); const bf16_t* YS = (const bf16_t*)(F.ws + WS_YS);
    const int* tok_e = (const int*)(F.ws + WS_ROUTE); const int* tok_pos = tok_e + 2 * NTOK; const float* tok_g = (const float*)(F.ws + WS_ROUTE) + 4 * NTOK;
    moe_offsets(F, layer);
    const int step = NGW(F); int row = GWID(F);
    int s0n = 0, s1n = 0, s0nn = 0, s1nn = 0; float g0n = 0.f, g1n = 0.f, g0nn = 0.f, g1nn = 0.f; RowRaw xr_n, y0_n, y1_n;
#define RC_SLOTS(r_, s0_, s1_, g0_, g1_) do { s0_ = MISCP(F)[tok_e[(r_) * 2]] * 256 + tok_pos[(r_) * 2]; s1_ = MISCP(F)[tok_e[(r_) * 2 + 1]] * 256 + tok_pos[(r_) * 2 + 1]; g0_ = tok_g[(r_) * 2]; g1_ = tok_g[(r_) * 2 + 1]; } while (0)
    if (row < nrows) { RC_SLOTS(row, s0n, s1n, g0n, g1n); xr_n = row_ldraw_bf16(XL + (size_t)row * D, F.lane); y0_n = row_ldraw_bf16(YS + (size_t)s0n * D, F.lane); y1_n = row_ldraw_bf16(YS + (size_t)s1n * D, F.lane);
        if (row + step < nrows) RC_SLOTS(row + step, s0nn, s1nn, g0nn, g1nn); }
    for (; row < nrows; row += step) {
        const float* m = modl + mod_index(row) * 6144;
        RowF x = row_cvt(xr_n); const RowF y0 = row_cvt(y0_n), y1 = row_cvt(y1_n); const float g0 = g0n, g1 = g1n;
        if (row + step < nrows) { const int nr = row + step; s0n = s0nn; s1n = s1nn; g0n = g0nn; g1n = g1nn;
            xr_n = row_ldraw_bf16(XL + (size_t)nr * D, F.lane); y0_n = row_ldraw_bf16(YS + (size_t)s0n * D, F.lane); y1_n = row_ldraw_bf16(YS + (size_t)s1n * D, F.lane);
            if (nr + step < nrows) RC_SLOTS(nr + step, s0nn, s1nn, g0nn, g1nn); }
        const RowF gt = row_ld_f32(m + 5120, F.lane);
#pragma unroll
        for (int j = 0; j < 4; ++j) x.v[j] = ALPHA * x.v[j] + gt.v[j] * (g0 * y0.v[j] + g1 * y1.v[j]);
        row_layernorm(x, a.in[I_LNG] + (layer * 2 + 1) * D, a.in[I_LNB] + (layer * 2 + 1) * D, F.lane);
        if (last) { row_st_f32(a.out + (size_t)row * D, F.lane, x); }
        else { row_st_bf16(XL + (size_t)row * D, F.lane, x); const float* m1 = modl + 3 * 6144 + mod_index(row) * 6144;
            const RowF h = row_modulate(x, m1, m1 + 1024, F.lane); row_st_bf16(HB + (size_t)row * D, F.lane, h); }
    }
#undef RC_SLOTS
}

template <class Epi, class Sched> __device__ __forceinline__ void run_gemm_gather(Ctx& F, const bf16_t* A, const bf16_t* Bt, int K, const Sched& S, const Epi& E) {
    pg8::Gemm g{A, Bt, 0, 0, K};
    pg8::gemm_phase<Epi, Sched, true, true, true>(F.lds, g, S, E, F.wave * 64 + fresh_lane());
    __syncthreads();
}
template <class Epi, class Sched> __device__ __forceinline__ void run_gemm(Ctx& F, const bf16_t* A, const bf16_t* Bt, int M, int N, int K, const Sched& S, const Epi& E) {
    pg8::Gemm g{A, Bt, M, N, K};
    pg8::gemm_phase<Epi, Sched, true, true>(F.lds, g, S, E, F.wave * 64 + fresh_lane());
    __syncthreads();
}

__device__ __forceinline__ void qkprep_phase(Ctx& F, const Args& a) {
    bf16_t* Q = (bf16_t*)(F.ws + WS_Q); bf16_t* KB = (bf16_t*)(F.ws + WS_KB);
    constexpr int NQ = NLAT * 8, NK = NBATCH * SLEN * 2;
    const float qg0 = a.in[I_QG][F.lane], qg1 = a.in[I_QG][F.lane + 64], kg0 = a.in[I_KG][F.lane], kg1 = a.in[I_KG][F.lane + 64];
    const float* ropet = (const float*)(F.ws + WS_ROPE);
    for (int it = NQ + GWID(F); it < NQ + NK; it += NGW(F)) {
        bf16_t* p; int t; bool rope; float g0, g1;
        if (it < NQ) { const int row = it >> 3, hh = it & 7; p = Q + (size_t)row * 1024 + hh * 128; t = row % SEQ; rope = true; g0 = qg0; g1 = qg1; }
        else { const int r = it - NQ, krow = r >> 1, kvh = r & 1, key = krow % SLEN; p = KB + (size_t)krow * 256 + kvh * 128; rope = key >= CTXL; t = key - CTXL; g0 = kg0; g1 = kg1; }
        float x1 = bf2f(p[F.lane]), x2 = bf2f(p[F.lane + 64]);
        const float r = rsqrtf(wave_sum(x1 * x1 + x2 * x2) * (1.f / 128.f) + 1e-6f);
        x1 *= r * g0; x2 *= r * g1;
        float o1 = x1, o2 = x2;
        if (rope) { const float* rp = ropet + ((F.lane < 32) ? (t / 64) : (t % 64)) * 64 + 2 * (F.lane & 31); const float cs = rp[0], sn = rp[1]; o1 = x1 * cs - x2 * sn; o2 = x2 * cs + x1 * sn; }
        p[F.lane] = f2bf(o1); p[F.lane + 64] = f2bf(o2);
    }
}
__device__ __forceinline__ void kprep_tile(Ctx& F, const Args& a, int pm) {
    bf16_t* KB = (bf16_t*)(F.ws + WS_KB); const float* ropet = (const float*)(F.ws + WS_ROPE);
    const int l16 = F.lane & 15, sub = F.lane >> 4; const bool rope = pm < NLAT / 256;
    const f32x4 g0 = *(const f32x4*)(a.in[I_KG] + 8 * l16), g1 = *(const f32x4*)(a.in[I_KG] + 8 * l16 + 4);
    const float sg = l16 < 8 ? -1.f : 1.f;
#pragma unroll 2
    for (int it = F.wave * 4 + sub; it < 512; it += 32) {
        const int row = pm * 256 + (it >> 1), kvh = it & 1; int key, t = 0;
        if (rope) { const int b = row / SEQ; t = row % SEQ; key = b * SLEN + CTXL + t; } else { const int r = row - NLAT; key = (r / CTXL) * SLEN + (r % CTXL); }
        u32x4* p = (u32x4*)(KB + (size_t)key * 256 + kvh * 128 + 8 * l16);
        const u32x4 w = *p;
        f32x4 xa = {__uint_as_float(w.x << 16), __uint_as_float(w.x & 0xffff0000u), __uint_as_float(w.y << 16), __uint_as_float(w.y & 0xffff0000u)};
        f32x4 xb = {__uint_as_float(w.z << 16), __uint_as_float(w.z & 0xffff0000u), __uint_as_float(w.w << 16), __uint_as_float(w.w & 0xffff0000u)};
        float ss = ((xa[0] * xa[0] + xa[1] * xa[1]) + (xa[2] * xa[2] + xa[3] * xa[3])) + ((xb[0] * xb[0] + xb[1] * xb[1]) + (xb[2] * xb[2] + xb[3] * xb[3]));
        ss += __shfl_xor(ss, 1); ss += __shfl_xor(ss, 2); ss += __shfl_xor(ss, 4); ss += __shfl_xor(ss, 8);
        const float rs = rsqrtf(ss * (1.f / 128.f) + 1e-6f);
        xa = xa * (g0 * rs); xb = xb * (g1 * rs);
        if (rope) { const float* rp = ropet + (((l16 & 7) < 4) ? (t / 64) : (t % 64)) * 64 + 16 * (l16 & 3);
            const f32x4 c0 = *(const f32x4*)rp, c1 = *(const f32x4*)(rp + 4), c2 = *(const f32x4*)(rp + 8), c3 = *(const f32x4*)(rp + 12);
            const f32x4 csa = {c0[0], c0[2], c1[0], c1[2]}, sna = {c0[1], c0[3], c1[1], c1[3]}, csb = {c2[0], c2[2], c3[0], c3[2]}, snb = {c2[1], c2[3], c3[1], c3[3]};
            f32x4 pa, pb;
            pa[0] = __shfl_xor(xa[0], 8); pa[1] = __shfl_xor(xa[1], 8); pa[2] = __shfl_xor(xa[2], 8); pa[3] = __shfl_xor(xa[3], 8);
            pb[0] = __shfl_xor(xb[0], 8); pb[1] = __shfl_xor(xb[1], 8); pb[2] = __shfl_xor(xb[2], 8); pb[3] = __shfl_xor(xb[3], 8);
            xa = xa * csa + (pa * sna) * sg; xb = xb * csb + (pb * snb) * sg; }
        u32x4 o; o.x = pk2(xa[0], xa[1]); o.y = pk2(xa[2], xa[3]); o.z = pk2(xb[0], xb[1]); o.w = pk2(xb[2], xb[3]);
        *p = o;
    }
}
__device__ __forceinline__ void attn_phase(Ctx& F, const Args& a) {
    const bf16_t* Q = (const bf16_t*)(F.ws + WS_Q); const bf16_t* KB = (const bf16_t*)(F.ws + WS_KB); const bf16_t* VB = (const bf16_t*)(F.ws + WS_VB); bf16_t* AO = (bf16_t*)(F.ws + WS_AO);
    const float gq = wave_max(fmaxf(fabsf(a.in[I_QG][F.lane]), fabsf(a.in[I_QG][F.lane + 64]))), gk = wave_max(fmaxf(fabsf(a.in[I_KG][F.lane]), fabsf(a.in[I_KG][F.lane + 64])));
    const bool fast = 11.3137085f * 1.4426950408889634f * 1.02f * gq * gk < 60.f;
    for (int i = 0;; ++i) {
        const int L = i * F.G + F.bid; if (L >= 512) break;
        const int xcd = L & 7, off = L >> 3, combo = xcd >> 1, idx = (xcd & 1) * 64 + off, hl = idx >> 5, qb = idx & 31;
        const int b = combo >> 1, kvh = combo & 1, h = kvh * 4 + hl;
        const size_t qoff = ((size_t)b * SEQ + qb * 256) * 1024 + h * 128, koff = (size_t)b * SLEN * 256 + kvh * 128;
        if (fast) attn::attn_dense_body<attn::bf16, true, 1>(Q + qoff, KB + koff, VB + koff, AO + qoff, SLEN, (char*)F.lds, F.wave * 64 + fresh_lane(), a.in[I_QG], qb * 256, (const float*)(F.ws + WS_ROPE));
        else attn::attn_dense_body<attn::bf16, false, 1>(Q + qoff, KB + koff, VB + koff, AO + qoff, SLEN, (char*)F.lds, F.wave * 64 + fresh_lane(), a.in[I_QG], qb * 256, (const float*)(F.ws + WS_ROPE));
        __syncthreads();
    }
}

typedef short v4i16_t __attribute__((ext_vector_type(4)));
typedef const LAS unsigned char* lds_cptr;
constexpr float LOG2E = 1.4426950408889634f;
__device__ __forceinline__ s16x4 vtr(lds_cptr p) { return __builtin_bit_cast(s16x4, __builtin_amdgcn_ds_read_tr16_b64_v4i16((LAS v4i16_t*)p)); }
__device__ __forceinline__ bf16x8 trfrag(lds_cptr tb, int d0, int ks) {
    const s16x4 l = vtr(tb + attn::v_rd_off(d0, ks, 0)), h = vtr(tb + attn::v_rd_off(d0, ks, 1));
    return (bf16x8){l[0], l[1], l[2], l[3], h[0], h[1], h[2], h[3]}; }
__device__ __forceinline__ bf16x8 rowfrag(lds_cptr tile, int blk, int d0, int r32, int hi) { return *(const LAS bf16x8*)(tile + KSWZ(32 * blk + r32, (d0 * 16 + hi * 8) * 2)); }
__device__ __forceinline__ u32x4 scale8(u32x4 v, float s) { u32x4 o;
#pragma unroll
    for (int i = 0; i < 4; ++i) o[i] = pk2(__uint_as_float(v[i] << 16) * s, __uint_as_float(v[i] & 0xffff0000u) * s);
    return o; }
__device__ __forceinline__ bf16x8 scale8f(bf16x8 v, float s) { return __builtin_bit_cast(bf16x8, scale8(__builtin_bit_cast(u32x4, v), s)); }
__device__ __forceinline__ float wave_incl_sum(float v, int lane) {
#pragma unroll
    for (int o = 1; o < 64; o <<= 1) { const float t = __shfl_up(v, o); if (lane >= o) v += t; }
    return v; }
__device__ __forceinline__ float wave_incl_max(float v, int lane) {
#pragma unroll
    for (int o = 1; o < 64; o <<= 1) { const float t = __shfl_up(v, o); if (lane >= o) v = fmaxf(v, t); }
    return v; }
__device__ __forceinline__ float wave_incl_max_rev(float v, int lane) {
#pragma unroll
    for (int o = 1; o < 64; o <<= 1) { const float t = __shfl_down(v, o); if (lane + o < 64) v = fmaxf(v, t); }
    return v; }
__device__ __forceinline__ float half_swap_add(float v) { auto rr = __builtin_amdgcn_permlane32_swap(__float_as_uint(v), __float_as_uint(v), false, false); return __uint_as_float(rr[0]) + __uint_as_float(rr[1]); }
#define MX_PK4(P, BASE, OUT) do { unsigned a0_ = pk2(P[BASE + 0], P[BASE + 1]), a1_ = pk2(P[BASE + 2], P[BASE + 3]); \
    unsigned b0_ = pk2(P[BASE + 4], P[BASE + 5]), b1_ = pk2(P[BASE + 6], P[BASE + 7]); \
    auto r0_ = __builtin_amdgcn_permlane32_swap(a0_, b0_, false, false); auto r1_ = __builtin_amdgcn_permlane32_swap(a1_, b1_, false, false); \
    u32x4 w_ = {r0_[0], r1_[0], r0_[1], r1_[1]}; OUT = __builtin_bit_cast(bf16x8, w_); } while (0)

__device__ __forceinline__ const bf16_t* launder_v(const bf16_t* p) { asm volatile("" : "+v"(p)); return p; }
constexpr int MX_MISC = MISC_OFF + 1024;
__device__ __forceinline__ int st_off(int row, int col) { return (((row >> 5) * 8 + (col >> 4)) << 9) + ((row & 31) << 4) + (col & 15); }
__device__ __forceinline__ int mx_unit(int bid, int G, int k, int off) { const int kmain = 528 / G, nmain = kmain * G; if (k < kmain) return bid + k * G; if (k == kmain) { const int j = bid - off; return (j >= 0 && j < 528 - nmain) ? nmain + j : -1; } return -1; }

constexpr int CONV_RUN = 26;
__device__ __forceinline__ int conv_seg(int row) { return row < NLAT ? row / SEQ : 2 + (row - NLAT) / CTXL; }
__device__ __forceinline__ void conv_unpack(u32x4 v, float (&f)[8]) {
#pragma unroll
    for (int e = 0; e < 4; ++e) { f[2 * e] = __uint_as_float(v[e] << 16); f[2 * e + 1] = __uint_as_float(v[e] & 0xffff0000u); } }
__device__ __forceinline__ void conv_phase(Ctx& F, const Args& a) {
    const bf16_t* XBC = (const bf16_t*)(F.ws + WS_XBC); bf16_t* XC = (bf16_t*)(F.ws + WS_XC);
    const float* cw = a.in[I_CONVW]; const float* cb = a.in[I_CONVB];
    constexpr int NRUN = (NTOK + CONV_RUN - 1) / CONV_RUN;
    for (int it = F.bid * NTHREADS + F.tid; it < NRUN * 192; it += F.G * NTHREADS) {
        const int c8 = (it % 192) * 8, r0 = (it / 192) * CONV_RUN, r1 = (r0 + CONV_RUN < NTOK) ? r0 + CONV_RUN : NTOK;
        float w[4][8], bias[8];
#pragma unroll
        for (int j = 0; j < 4; ++j) { const f32x4 w0 = *(const f32x4*)(cw + j * 1536 + c8), w1 = *(const f32x4*)(cw + j * 1536 + c8 + 4); w[j][0] = w0[0]; w[j][1] = w0[1]; w[j][2] = w0[2]; w[j][3] = w0[3]; w[j][4] = w1[0]; w[j][5] = w1[1]; w[j][6] = w1[2]; w[j][7] = w1[3]; }
        { const f32x4 b0 = *(const f32x4*)(cb + c8), b1 = *(const f32x4*)(cb + c8 + 4); bias[0] = b0[0]; bias[1] = b0[1]; bias[2] = b0[2]; bias[3] = b0[3]; bias[4] = b1[0]; bias[5] = b1[1]; bias[6] = b1[2]; bias[7] = b1[3]; }
        const u32x4 zero = {0u, 0u, 0u, 0u};
        const bf16_t* base = XBC + c8;
        u32x4 xm2 = r0 >= 2 ? *(const u32x4*)(base + (size_t)(r0 - 2) * 1536) : zero, xm1 = r0 >= 1 ? *(const u32x4*)(base + (size_t)(r0 - 1) * 1536) : zero;
        u32x4 x0 = *(const u32x4*)(base + (size_t)r0 * 1536), xp1 = r0 + 1 < NTOK ? *(const u32x4*)(base + (size_t)(r0 + 1) * 1536) : zero;
        for (int r = r0; r < r1; ++r) {
            const u32x4 xp2 = r + 2 < NTOK ? *(const u32x4*)(base + (size_t)(r + 2) * 1536) : zero;
            const int sg = conv_seg(r);
            const bool v0 = r >= 2 && conv_seg(r - 2) == sg, v1 = r >= 1 && conv_seg(r - 1) == sg, v3 = r + 1 < NTOK && conv_seg(r + 1) == sg;
            float f0[8], f1[8], f2[8], f3[8]; conv_unpack(xm2, f0); conv_unpack(xm1, f1); conv_unpack(x0, f2); conv_unpack(xp1, f3);
            float acc[8];
#pragma unroll
            for (int e = 0; e < 8; ++e) acc[e] = bias[e] + (v0 ? w[0][e] * f0[e] : 0.f) + (v1 ? w[1][e] * f1[e] : 0.f) + w[2][e] * f2[e] + (v3 ? w[3][e] * f3[e] : 0.f);
            u32x4 o; o[0] = pk2(siluf(acc[0]), siluf(acc[1])); o[1] = pk2(siluf(acc[2]), siluf(acc[3])); o[2] = pk2(siluf(acc[4]), siluf(acc[5])); o[3] = pk2(siluf(acc[6]), siluf(acc[7]));
            *(u32x4*)(XC + (size_t)r * 1536 + c8) = o;
            xm2 = xm1; xm1 = x0; x0 = xp1; xp1 = xp2;
        }
    }
}

struct MlGate { float b0, b1, G0, G1, total; };
__device__ __forceinline__ MlGate ml_gate(const float* GATES, int row0, int dir, int h, int lane) {
    const float* g0 = GATES + (size_t)(row0 + 2 * lane) * NGATE; const float* g1 = g0 + NGATE;
    const float lf0 = g0[8 + dir * 4 + h], lf1 = g1[8 + dir * 4 + h], ig0 = g0[dir * 4 + h], ig1 = g1[dir * 4 + h];
    const float incl = wave_incl_sum(lf0 + lf1, lane), total = __shfl(incl, 63);
    MlGate r; r.total = total;
    if (dir == 0) { r.b0 = incl - lf1; r.b1 = incl; } else { r.b0 = total - incl + lf0 + lf1; r.b1 = total - incl + lf1; }
    r.G0 = ig0 - r.b0; r.G1 = ig1 - r.b1; return r;
}


__device__ __forceinline__ void mlstm_a_phase(Ctx& F, int off) {
    const bf16_t* QK = (const bf16_t*)(F.ws + WS_QK); const bf16_t* V = (const bf16_t*)(F.ws + WS_V); const float* GATES = (const float*)(F.ws + WS_GATES);
    bf16_t* DC = (bf16_t*)(F.ws + WS_DC); float* DN = (float*)(F.ws + WS_DN); float* MS = (float*)(F.ws + WS_MS);
    LAS unsigned char* Vt = F.lds; LAS unsigned char* Kw = F.lds + 65536;
    LAS float* wsc = (LAS float*)(F.lds + MX_MISC); LAS float* dnp = (LAS float*)(F.lds + MX_MISC + 1024);
    for (int k_ = 0;; ++k_) { const int u = mx_unit(F.bid, F.G, k_, off); if (u < 0) break;
        const int lane = fresh_lane(), tid = F.wave * 64 + lane, r32 = lane & 31, hi = lane >> 5, sr = tid >> 4, sc8 = (tid & 15) * 8, rdb = attn::v_rd_base(lane);
        const int b = u / 264, rem = u % 264, cid = rem >> 2, h = rem & 3, row0 = chunk_row0(b, cid);
        if (F.wave < 2) { const int dir = F.wave, chain = (b * 4 + h) * 2 + dir; typedef float f32x2v __attribute__((ext_vector_type(2)));
            *(LAS f32x2v*)(wsc + dir * 128 + 2 * lane) = *(const f32x2v*)((const float*)(F.ws + WS_MLG) + (size_t)(chain * NCH + cid) * 512 + 384 + 2 * lane); }
        __syncthreads();
        float dnacc[2][8];
#pragma unroll
        for (int d = 0; d < 2; ++d)
#pragma unroll
            for (int e = 0; e < 8; ++e) dnacc[d][e] = 0.f;
#pragma unroll
        for (int i = 0; i < 4; ++i) { const int s = sr + 32 * i; const size_t grow = (size_t)(row0 + s) * 1024;
#pragma unroll
            for (int vb = 0; vb < 2; ++vb) { const u32x4 v = *(const u32x4*)(V + grow + h * 256 + vb * 128 + sc8); *(LAS u32x4*)(Vt + ((s >> 6) * 2 + vb) * 16384 + attn::v_st(s & 63, sc8)) = v; }
            const u32x4 kv = *(const u32x4*)(QK + grow + 512 + h * 128 + sc8);
#pragma unroll
            for (int d = 0; d < 2; ++d) { const float w = wsc[d * 128 + s];
                *(LAS u32x4*)(Kw + (d * 2 + (s >> 6)) * 16384 + attn::v_st(s & 63, sc8)) = scale8(kv, w);
#pragma unroll
                for (int e = 0; e < 4; ++e) { dnacc[d][2 * e] += w * __uint_as_float(kv[e] << 16); dnacc[d][2 * e + 1] += w * __uint_as_float(kv[e] & 0xffff0000u); } } }
#pragma unroll
        for (int d = 0; d < 2; ++d)
#pragma unroll
            for (int e = 0; e < 8; ++e) { float t = dnacc[d][e]; t += __shfl_xor(t, 16); t += __shfl_xor(t, 32); if ((lane >> 4) == 0) dnp[(F.wave * 2 + d) * 128 + sc8 + e] = t; }
        __syncthreads();
        {   const int dir = F.wave >> 2, vq = F.wave & 3;
            f32x16 acc[2][4];
#pragma unroll
            for (int i = 0; i < 2; ++i)
#pragma unroll
                for (int n = 0; n < 4; ++n) acc[i][n] = f32x16{};
#pragma unroll
            for (int ks = 0; ks < 8; ++ks) { const int sblk = ks >> 2, KS = ks & 3;
                bf16x8 af[2], bfr[4];
#pragma unroll
                for (int i = 0; i < 2; ++i) af[i] = trfrag(Vt + (sblk * 2 + (vq >> 1)) * 16384 + rdb, (2 * vq + i) & 3, KS);
#pragma unroll
                for (int n = 0; n < 4; ++n) bfr[n] = trfrag(Kw + (dir * 2 + sblk) * 16384 + rdb, n, KS);
#pragma unroll
                for (int i = 0; i < 2; ++i)
#pragma unroll
                    for (int n = 0; n < 4; ++n) acc[i][n] = __builtin_amdgcn_mfma_f32_32x32x16_bf16(af[i], bfr[n], acc[i][n], 0, 0, 0); }
            const int chain = (b * 4 + h) * 2 + dir;
            bf16_t* dst = DC + (size_t)(chain * NCH + cid) * 256 * 128;
#pragma unroll
            for (int i = 0; i < 2; ++i)
#pragma unroll
                for (int n = 0; n < 4; ++n)
#pragma unroll
                    for (int r = 0; r < 16; ++r) dst[st_off(64 * vq + 32 * i + attn::crow(r, hi), 32 * n + r32)] = f2bf(acc[i][n][r]);
        }
        if (tid < 256) { const int dir = tid >> 7, d = tid & 127; float s = 0.f;
#pragma unroll
            for (int w = 0; w < 8; ++w) s += dnp[(w * 2 + dir) * 128 + d];
            const int chain = (b * 4 + h) * 2 + dir; DN[(size_t)(chain * NCH + cid) * 128 + d] = s; }
        __syncthreads();
    }
}

struct SsGate { float dt0, dt1, acs0, acs1, total; };
__device__ __forceinline__ SsGate ss_gate(const float* GATES, int row0, int dir, int head, float aneg, int lane) {
    const float* g0 = GATES + (size_t)(row0 + 2 * lane) * NGATE; const float* g1 = g0 + NGATE;
    SsGate r; r.dt0 = g0[16 + dir * 16 + head]; r.dt1 = g1[16 + dir * 16 + head];
    const float a0 = r.dt0 * aneg, a1 = r.dt1 * aneg;
    const float incl = wave_incl_sum(a0 + a1, lane); r.total = __shfl(incl, 63);
    if (dir == 0) { r.acs0 = incl - a1; r.acs1 = incl; } else { r.acs0 = r.total - incl + a0 + a1; r.acs1 = r.total - incl + a1; }
    return r;
}
__device__ __forceinline__ void gatescan_phase(Ctx& F, const Args& a) {
    const float* GATES = (const float*)(F.ws + WS_GATES); float* MLG = (float*)(F.ws + WS_MLG); float* SSG = (float*)(F.ws + WS_SSG);
    float* MS = (float*)(F.ws + WS_MS); float* AEND = (float*)(F.ws + WS_AEND);
    typedef float f32x2v __attribute__((ext_vector_type(2)));
    const int lane = F.lane;
    for (int it = GWID(F); it < 16 * NCH + 64 * NCH; it += NGW(F)) {
        if (it < 16 * NCH) { const int chain = it / NCH, cid = it % NCH, dir = chain & 1, h = (chain >> 1) & 3, b = chain >> 3, row0 = chunk_row0(b, cid);
            const MlGate g = ml_gate(GATES, row0, dir, h, lane);
            const float gmx = fmaxf(g.G0, g.G1), gm = wave_max(gmx); float P0, P1;
            if (dir == 0) { const float pm = wave_incl_max(gmx, lane); float ex = __shfl_up(pm, 1); if (lane == 0) ex = -1e30f; P0 = fmaxf(ex, g.G0); P1 = pm; }
            else { const float pm = wave_incl_max_rev(gmx, lane); float ex = __shfl_down(pm, 1); if (lane == 63) ex = -1e30f; P1 = fmaxf(ex, g.G1); P0 = pm; }
            float* o = MLG + (size_t)it * 512 + 2 * lane;
            *(f32x2v*)(o) = (f32x2v){g.b0, g.b1}; *(f32x2v*)(o + 128) = (f32x2v){g.G0, g.G1}; *(f32x2v*)(o + 256) = (f32x2v){P0, P1}; *(f32x2v*)(o + 384) = (f32x2v){expf(g.G0 - gm), expf(g.G1 - gm)};
            if (lane == 0) { MS[it * 4 + 0] = g.total; MS[it * 4 + 1] = g.total + gm; } }
        else { const int i2 = it - 16 * NCH, chain = i2 / NCH, cid = i2 % NCH, dir = chain & 1, head = (chain >> 1) & 15, b = chain >> 5, row0 = chunk_row0(b, cid);
            const float aneg = -expf(a.in[I_ALOG][dir * 16 + head]); const SsGate s = ss_gate(GATES, row0, dir, head, aneg, lane);
            float* o = SSG + (size_t)i2 * 384 + 2 * lane;
            *(f32x2v*)(o) = (f32x2v){s.acs0, s.acs1}; *(f32x2v*)(o + 128) = (f32x2v){s.dt0, s.dt1}; *(f32x2v*)(o + 256) = (f32x2v){s.dt0 * expf(s.total - s.acs0), s.dt1 * expf(s.total - s.acs1)};
            if (lane == 0) AEND[i2] = s.total; }
    }
}
template <bool BM_ROW> __device__ __forceinline__ void ssd_stage(Ctx& F, const bf16_t* XC, int row0, int g, int hh, LAS unsigned char* Xt, LAS unsigned char* Bt) {
    const int tid_ = F.wave * 64 + fresh_lane(), sr = tid_ >> 4, sc8 = (tid_ & 15) * 8;
#pragma unroll
    for (int i = 0; i < 4; ++i) { const int s = sr + 32 * i; const bf16_t* rowp = XC + (size_t)(row0 + s) * 1536;
#pragma unroll
        for (int cb = 0; cb < 2; ++cb) { const u32x4 v = *(const u32x4*)(rowp + (g * 8 + hh * 4) * 64 + cb * 128 + sc8); *(LAS u32x4*)(Xt + ((s >> 6) * 2 + cb) * 16384 + attn::v_st(s & 63, sc8)) = v; }
        const u32x4 bv = *(const u32x4*)(rowp + 1024 + g * 128 + sc8);
        if (BM_ROW) *(LAS u32x4*)(Bt + (s >> 6) * 16384 + KSWZ(s & 63, sc8 * 2)) = bv; else *(LAS u32x4*)(Bt + (s >> 6) * 16384 + attn::v_st(s & 63, sc8)) = bv; }
}
__device__ __forceinline__ void ssd_a_phase(Ctx& F, const Args& a, int off) {
    const bf16_t* XC = (const bf16_t*)(F.ws + WS_XC); const float* GATES = (const float*)(F.ws + WS_GATES);
    bf16_t* DS = (bf16_t*)(F.ws + WS_DS); float* AEND = (float*)(F.ws + WS_AEND);
    LAS unsigned char* Xt = F.lds; LAS unsigned char* Bt = F.lds + 65536;
    LAS float* wtl = (LAS float*)(F.lds + MX_MISC);
    for (int k_ = 0;; ++k_) { const int u = mx_unit(F.bid, F.G, k_, off); if (u < 0) break;
        const int lane = fresh_lane(), r32 = lane & 31, hi = lane >> 5, rdb = attn::v_rd_base(lane);
        const int b = u / 264, rem = u % 264, cid = rem >> 2, g = (rem >> 1) & 1, hh = rem & 1, row0 = chunk_row0(b, cid);
        const int dir = F.wave >> 2, j = F.wave & 3, head = g * 8 + hh * 4 + j, chain = (b * 16 + head) * 2 + dir;
        { typedef float f32x2v __attribute__((ext_vector_type(2)));
          *(LAS f32x2v*)(wtl + F.wave * 128 + 2 * lane) = *(const f32x2v*)((const float*)(F.ws + WS_SSG) + (size_t)(chain * NCH + cid) * 384 + 256 + 2 * lane); }
        ssd_stage<false>(F, XC, row0, g, hh, Xt, Bt);
        __syncthreads();
        f32x16 acc[2][4];
#pragma unroll
        for (int i = 0; i < 2; ++i)
#pragma unroll
            for (int n = 0; n < 4; ++n) acc[i][n] = f32x16{};
#pragma unroll
        for (int ks = 0; ks < 8; ++ks) { const int sblk = ks >> 2, KS = ks & 3;
            const f32x4 w0 = *(const LAS f32x4*)(wtl + F.wave * 128 + 16 * ks + 8 * hi), w1 = *(const LAS f32x4*)(wtl + F.wave * 128 + 16 * ks + 8 * hi + 4);
            bf16x8 af[2], bfr[4];
#pragma unroll
            for (int i = 0; i < 2; ++i) { const u32x4 x = __builtin_bit_cast(u32x4, trfrag(Xt + (sblk * 2 + (j >> 1)) * 16384 + rdb, (j & 1) * 2 + i, KS)); u32x4 o;
                o[0] = pk2(__uint_as_float(x[0] << 16) * w0[0], __uint_as_float(x[0] & 0xffff0000u) * w0[1]); o[1] = pk2(__uint_as_float(x[1] << 16) * w0[2], __uint_as_float(x[1] & 0xffff0000u) * w0[3]);
                o[2] = pk2(__uint_as_float(x[2] << 16) * w1[0], __uint_as_float(x[2] & 0xffff0000u) * w1[1]); o[3] = pk2(__uint_as_float(x[3] << 16) * w1[2], __uint_as_float(x[3] & 0xffff0000u) * w1[3]);
                af[i] = __builtin_bit_cast(bf16x8, o); }
#pragma unroll
            for (int n = 0; n < 4; ++n) bfr[n] = trfrag(Bt + sblk * 16384 + rdb, n, KS);
#pragma unroll
            for (int i = 0; i < 2; ++i)
#pragma unroll
                for (int n = 0; n < 4; ++n) acc[i][n] = __builtin_amdgcn_mfma_f32_32x32x16_bf16(af[i], bfr[n], acc[i][n], 0, 0, 0); }
        bf16_t* dst = DS + (size_t)(chain * NCH + cid) * 64 * 128;
#pragma unroll
        for (int i = 0; i < 2; ++i)
#pragma unroll
            for (int n = 0; n < 4; ++n)
#pragma unroll
                for (int r = 0; r < 16; ++r) dst[st_off(32 * i + attn::crow(r, hi), 32 * n + r32)] = f2bf(acc[i][n][r]);
        __syncthreads();
    }
}

__device__ __forceinline__ void scan_phase(Ctx& F) {
    LAS float* sa = (LAS float*)(F.lds + MX_MISC); LAS float* ss = sa + 80;
    for (int vb = F.bid; vb < 256; vb += F.G) {
        __syncthreads();
        if (vb < 128) {
            const int chain = vb >> 3, dir = chain & 1; float* MS = (float*)(F.ws + WS_MS) + (size_t)chain * NCH * 4;
            LAS float* sbe = ss + 80; LAS float* sgm = sbe + 80;
            if (F.tid < NCH) { const int cid = scan_cid(dir, F.tid); sbe[F.tid] = MS[cid * 4 + 0]; sgm[F.tid] = MS[cid * 4 + 1]; }
            __syncthreads();
            if (F.tid == 0) { float m = 0.f;
                for (int p = 0; p < NCH; ++p) { const float be = sbe[p], gm = sgm[p];
                    const float mn = fmaxf(be + m, gm); sa[p] = expf(be + m - mn); ss[p] = expf(gm - mn); if ((vb & 7) == 0) MS[scan_cid(dir, p) * 4 + 2] = m; m = mn; } }
            __syncthreads();
            {   bf16_t* base = (bf16_t*)(F.ws + WS_DC) + (size_t)chain * NCH * 32768 + ((size_t)(vb & 7) * 512 + F.tid) * 8;
                u32x4 buf[8]; float run[8];
#pragma unroll
                for (int e = 0; e < 8; ++e) run[e] = 0.f;
#pragma unroll
                for (int k = 0; k < 8; ++k) buf[k] = *(const u32x4*)(base + (size_t)scan_cid(dir, k) * 32768);
                for (int p0 = 0; p0 < 72; p0 += 8) {
#pragma unroll
                    for (int k = 0; k < 8; ++k) { const int p = p0 + k;
                        if (p < NCH) { const u32x4 d = buf[k]; bf16_t* loc = base + (size_t)scan_cid(dir, p) * 32768;
                            if (p + 8 < NCH) buf[k] = *(const u32x4*)(base + (size_t)scan_cid(dir, p + 8) * 32768);
                            u32x4 o; o[0] = pk2(run[0], run[1]); o[1] = pk2(run[2], run[3]); o[2] = pk2(run[4], run[5]); o[3] = pk2(run[6], run[7]);
                            *(u32x4*)loc = o;
                            const float av = sa[p], sv = ss[p];
#pragma unroll
                            for (int e = 0; e < 4; ++e) { run[2 * e] = av * run[2 * e] + sv * __uint_as_float(d[e] << 16); run[2 * e + 1] = av * run[2 * e + 1] + sv * __uint_as_float(d[e] & 0xffff0000u); } } }
                }
            }
            if ((vb & 7) == 0 && F.tid < 32) {
                float* nb = (float*)(F.ws + WS_DN) + (size_t)chain * NCH * 128 + F.tid * 4;
                f32x4 buf[8]; f32x4 run = {0.f, 0.f, 0.f, 0.f};
#pragma unroll
                for (int k = 0; k < 8; ++k) buf[k] = *(const f32x4*)(nb + (size_t)scan_cid(dir, k) * 128);
                for (int p0 = 0; p0 < 72; p0 += 8) {
#pragma unroll
                    for (int k = 0; k < 8; ++k) { const int p = p0 + k;
                        if (p < NCH) { const f32x4 d = buf[k]; float* loc = nb + (size_t)scan_cid(dir, p) * 128;
                            if (p + 8 < NCH) buf[k] = *(const f32x4*)(nb + (size_t)scan_cid(dir, p + 8) * 128);
                            *(f32x4*)loc = run; run = sa[p] * run + ss[p] * d; } }
                }
            }
        } else {
            const int chain = (vb - 128) >> 1, dir = chain & 1; const float* AEND = (const float*)(F.ws + WS_AEND) + (size_t)chain * NCH;
            if (F.tid < NCH) sa[F.tid] = expf(AEND[scan_cid(dir, F.tid)]);
            __syncthreads();
            bf16_t* base = (bf16_t*)(F.ws + WS_DS) + (size_t)chain * NCH * 8192 + ((size_t)(vb & 1) * 512 + F.tid) * 8;
            u32x4 buf[8]; float run[8];
#pragma unroll
            for (int e = 0; e < 8; ++e) run[e] = 0.f;
#pragma unroll
            for (int k = 0; k < 8; ++k) buf[k] = *(const u32x4*)(base + (size_t)scan_cid(dir, k) * 8192);
            for (int p0 = 0; p0 < 72; p0 += 8) {
#pragma unroll
                for (int k = 0; k < 8; ++k) { const int p = p0 + k;
                    if (p < NCH) { const u32x4 d = buf[k]; bf16_t* loc = base + (size_t)scan_cid(dir, p) * 8192;
                        if (p + 8 < NCH) buf[k] = *(const u32x4*)(base + (size_t)scan_cid(dir, p + 8) * 8192);
                        u32x4 o; o[0] = pk2(run[0], run[1]); o[1] = pk2(run[2], run[3]); o[2] = pk2(run[4], run[5]); o[3] = pk2(run[6], run[7]);
                        *(u32x4*)loc = o;
                        const float av = sa[p];
#pragma unroll
                        for (int e = 0; e < 4; ++e) { run[2 * e] = av * run[2 * e] + __uint_as_float(d[e] << 16); run[2 * e + 1] = av * run[2 * e + 1] + __uint_as_float(d[e] & 0xffff0000u); } } }
            }
        }
    }
}


template <bool DIAG> __device__ __forceinline__ void ml_block(const f32x16& S, const LAS float* Gp, float Mt, float sgn, float sb, float scale, f32x16& out) {
#pragma unroll
    for (int g4 = 0; g4 < 4; ++g4) { const f32x4 Gv = *(const LAS f32x4*)(Gp + 8 * g4);
#pragma unroll
        for (int e = 0; e < 4; ++e) { float arg = (Gv[e] - Mt) * LOG2E;
            if (DIAG) arg = fmaf(fminf(fmaf(-sgn, (float)(8 * g4 + e), sb), 0.f), 1e30f, arg);
            out[4 * g4 + e] = S[4 * g4 + e] * __builtin_amdgcn_exp2f(arg) * scale; } }
}
template <bool DIAG> __device__ __forceinline__ void ss_block(const f32x16& S, const LAS float* ap, const LAS float* dp, float At, float sgn, float sb, f32x16& out) {
#pragma unroll
    for (int g4 = 0; g4 < 4; ++g4) { const f32x4 av = *(const LAS f32x4*)(ap + 8 * g4), dv = *(const LAS f32x4*)(dp + 8 * g4);
#pragma unroll
        for (int e = 0; e < 4; ++e) { float arg = (At - av[e]) * LOG2E;
            if (DIAG) arg = fmaf(fminf(fmaf(-sgn, (float)(8 * g4 + e), sb), 0.f), 1e30f, arg);
            out[4 * g4 + e] = S[4 * g4 + e] * __builtin_amdgcn_exp2f(arg) * dv[e]; } }
}
__device__ __forceinline__ float sum16(const f32x16& v) { float s = 0.f;
#pragma unroll
    for (int r = 0; r < 16; ++r) s += v[r];
    return s; }
template <int VAR> __device__ __forceinline__ void mlstm_c_phase(Ctx& F, const Args& a, int off) {
    const bf16_t* QK = (const bf16_t*)(F.ws + WS_QK); const bf16_t* V = (const bf16_t*)(F.ws + WS_V); const bf16_t* OG = (const bf16_t*)(F.ws + WS_O); const float* GATES = (const float*)(F.ws + WS_GATES);
    const bf16_t* DC = (const bf16_t*)(F.ws + WS_DC); const float* DN = (const float*)(F.ws + WS_DN); const float* MS = (const float*)(F.ws + WS_MS); bf16_t* MIX = VAR ? (bf16_t*)(F.ws + WS_END) : (bf16_t*)(F.ws + WS_MIX);
    LAS unsigned char* Kt = F.lds; LAS unsigned char* Vt = F.lds + 32768; LAS float* stat = (LAS float*)(F.lds + MX_MISC + 5120);
    LAS float* Gs = (LAS float*)(F.lds + MX_MISC); LAS float* Ms = Gs + 256; LAS float* Bs = Gs + 512; LAS float* ns = Gs + 768; LAS float* mst = Gs + 1024;
    for (int k_ = 0;; ++k_) { const int u = mx_unit(F.bid, F.G, k_, off); if (u < 0) break;
        const int lane = fresh_lane(), tid = F.wave * 64 + lane, r32 = lane & 31, hi = lane >> 5, sr = tid >> 4, sc8 = (tid & 15) * 8, rdb = attn::v_rd_base(lane);
        const int b = u / 264, rem = u % 264, cid = rem >> 2, h = rem & 3, row0 = chunk_row0(b, cid);
        if (F.wave < 2) { const int dir = F.wave, chain = (b * 4 + h) * 2 + dir; typedef float f32x2v __attribute__((ext_vector_type(2)));
            const float* gsrc = (const float*)(F.ws + WS_MLG) + (size_t)(chain * NCH + cid) * 512 + 2 * lane;
            const f32x2v bb = *(const f32x2v*)gsrc, GG = *(const f32x2v*)(gsrc + 128), PP = *(const f32x2v*)(gsrc + 256);
            const float m0 = MS[(chain * NCH + cid) * 4 + 2];
            *(LAS f32x2v*)(Gs + dir * 128 + 2 * lane) = GG; *(LAS f32x2v*)(Ms + dir * 128 + 2 * lane) = (f32x2v){fmaxf(PP[0], m0), fmaxf(PP[1], m0)}; *(LAS f32x2v*)(Bs + dir * 128 + 2 * lane) = bb;
            const float* nsrc = DN + (size_t)(chain * NCH + cid) * 128; ns[dir * 128 + 2 * lane] = nsrc[2 * lane]; ns[dir * 128 + 2 * lane + 1] = nsrc[2 * lane + 1];
            if (lane == 0) mst[dir] = m0; }
#pragma unroll
        for (int i = 0; i < 4; ++i) { const int s = sr + 32 * i; const size_t grow = (size_t)(row0 + s) * 1024;
#pragma unroll
            for (int vb = 0; vb < 2; ++vb) { const u32x4 v = *(const u32x4*)(V + grow + h * 256 + vb * 128 + sc8); *(LAS u32x4*)(Vt + ((s >> 6) * 2 + vb) * 16384 + attn::v_st(s & 63, sc8)) = v; }
            const u32x4 kv = *(const u32x4*)(QK + grow + 512 + h * 128 + sc8);
            *(LAS u32x4*)(Kt + (s >> 6) * 16384 + KSWZ(s & 63, sc8 * 2)) = kv; }
        __syncthreads();
        const int tq = F.wave & 3, vh = F.wave >> 2, tau = 32 * tq + r32;
        const bf16_t* qptr = QK + (size_t)(row0 + tau) * 1024 + h * 128 + hi * 8;
        f32x16 pS[2][2];
        {   bf16x8 qr[8];
#pragma unroll
        for (int d0 = 0; d0 < 8; ++d0) qr[d0] = *(const bf16x8*)(qptr + d0 * 16);
#pragma unroll
        for (int j = 0; j < 2; ++j)
#pragma unroll
            for (int blk = 0; blk < 2; ++blk) { pS[j][blk] = f32x16{};
#pragma unroll
                for (int d0 = 0; d0 < 8; ++d0) pS[j][blk] = __builtin_amdgcn_mfma_f32_32x32x16_bf16(rowfrag(Kt + j * 16384, blk, d0, r32, hi), qr[d0], pS[j][blk], 0, 0, 0); }
        }
        f32x16 o[4];
#pragma unroll
        for (int d = 0; d < 4; ++d) o[d] = f32x16{};
        float qsc0 = 0.f, qsc1 = 0.f;
        if (VAR < 3)
#pragma unroll 1
        for (int dir = 0; dir < 2; ++dir) {
            const float Mt = Ms[dir * 128 + tau], m0 = mst[dir];
            const float sgn = dir ? -1.f : 1.f, sb = sgn * (float)(r32 - 4 * hi);
            float rs = 0.f;
#pragma unroll
            for (int j = 0; j < 2; ++j)
#pragma unroll
                for (int blk = 0; blk < 2; ++blk) { const int kb = 2 * j + blk; const bool vis = dir ? (kb >= tq) : (kb <= tq);
                    if (vis) { f32x16 pp; const LAS float* Gp = Gs + dir * 128 + 32 * kb + 4 * hi;
                        if (kb == tq) ml_block<true>(pS[j][blk], Gp, Mt, sgn, sb, 1.f, pp); else ml_block<false>(pS[j][blk], Gp, Mt, sgn, sb, 1.f, pp);
                        rs += sum16(pp); } }
            rs = half_swap_add(rs);
            float qn = 0.f; const bf16_t* qp2 = launder_v(qptr);
#pragma unroll
            for (int d0 = 0; d0 < 8; ++d0) { const bf16x8 qv = *(const bf16x8*)(qp2 + d0 * 16); const f32x4 n0 = *(const LAS f32x4*)(ns + dir * 128 + 16 * d0 + 8 * hi), n1 = *(const LAS f32x4*)(ns + dir * 128 + 16 * d0 + 8 * hi + 4);
                const u32x4 q = __builtin_bit_cast(u32x4, qv);
                qn += __uint_as_float(q[0] << 16) * n0[0] + __uint_as_float(q[0] & 0xffff0000u) * n0[1] + __uint_as_float(q[1] << 16) * n0[2] + __uint_as_float(q[1] & 0xffff0000u) * n0[3]
                    + __uint_as_float(q[2] << 16) * n1[0] + __uint_as_float(q[2] & 0xffff0000u) * n1[1] + __uint_as_float(q[3] << 16) * n1[2] + __uint_as_float(q[3] & 0xffff0000u) * n1[3]; }
            qn = half_swap_add(qn);
            const float ain = expf(m0 - Mt), den = rs + ain * qn;
            const float inv = __builtin_amdgcn_rcpf(fmaxf(fabsf(den), expf(-(Bs[dir * 128 + tau] + Mt))));
#pragma unroll
            for (int j = 0; j < 2; ++j)
#pragma unroll
                for (int blk = 0; blk < 2; ++blk) { const int kb = 2 * j + blk; const bool vis = dir ? (kb >= tq) : (kb <= tq);
                    if (vis) { f32x16 pp; const LAS float* Gp = Gs + dir * 128 + 32 * kb + 4 * hi;
                        if (kb == tq) ml_block<true>(pS[j][blk], Gp, Mt, sgn, sb, inv, pp); else ml_block<false>(pS[j][blk], Gp, Mt, sgn, sb, inv, pp);
                        bf16x8 pa0, pa1;
                        MX_PK4(pp, 0, pa0); MX_PK4(pp, 8, pa1);
#pragma unroll
                        for (int d = 0; d < 4; ++d) { o[d] = __builtin_amdgcn_mfma_f32_32x32x16_bf16(pa0, trfrag(Vt + (j * 2 + vh) * 16384 + rdb, d, 2 * blk), o[d], 0, 0, 0);
                            o[d] = __builtin_amdgcn_mfma_f32_32x32x16_bf16(pa1, trfrag(Vt + (j * 2 + vh) * 16384 + rdb, d, 2 * blk + 1), o[d], 0, 0, 0); } } }
            if (dir == 0) qsc0 = ain * inv; else qsc1 = ain * inv;
        }
        if (VAR < 2) {   const bf16_t* Cb0 = DC + (size_t)(((b * 4 + h) * 2 + 0) * NCH + cid) * 256 * 128 + (size_t)(4 * vh) * 4096 + r32 * 16 + hi * 8;
            const bf16_t* Cb1 = Cb0 + (size_t)NCH * 256 * 128;
            const bf16_t* qp3 = launder_v(qptr);
            bf16x8 qr2[8];
#pragma unroll
            for (int d0 = 0; d0 < 8; ++d0) qr2[d0] = *(const bf16x8*)(qp3 + d0 * 16);
            bf16x8 cf[4][4];
#define MLC_LD(s_) do { _Pragma("unroll") for (int d = 0; d < 4; ++d) cf[(s_) & 3][d] = *(const bf16x8*)(((s_) < 8 ? Cb0 : Cb1) + d * 4096 + 512 * ((s_) & 7)); } while (0)
            MLC_LD(0); MLC_LD(1); MLC_LD(2);
            __builtin_amdgcn_sched_barrier(0);
#pragma unroll
            for (int st = 0; st < 16; ++st) {
                if (st + 3 < 16) MLC_LD(st + 3);
                const bf16x8 qs = scale8f(qr2[st & 7], st < 8 ? qsc0 : qsc1);
#pragma unroll
                for (int d = 0; d < 4; ++d) o[d] = __builtin_amdgcn_mfma_f32_32x32x16_bf16(qs, cf[st & 3][d], o[d], 0, 0, 0);
                __builtin_amdgcn_sched_barrier(0); }
#undef MLC_LD
        }
        float s1[16], s2[16];
#pragma unroll
        for (int r = 0; r < 16; ++r) { float x = 0.f, y = 0.f;
#pragma unroll
            for (int d = 0; d < 4; ++d) { x += o[d][r]; y += o[d][r] * o[d][r]; }
#pragma unroll
            for (int of = 1; of < 32; of <<= 1) { x += __shfl_xor(x, of); y += __shfl_xor(y, of); }
            s1[r] = x; s2[r] = y; }
        if (r32 == 0) {
#pragma unroll
            for (int r = 0; r < 16; ++r) { const int row = 32 * tq + attn::crow(r, hi); stat[(vh * 128 + row) * 2] = s1[r]; stat[(vh * 128 + row) * 2 + 1] = s2[r]; } }
        __syncthreads();
        {
            LAS float* ot = (LAS float*)(F.lds + F.wave * 16384);
            float gg[4];
#pragma unroll
            for (int d = 0; d < 4; ++d) gg[d] = a.in[I_MNG][h * 256 + 128 * vh + 32 * d + r32];
#pragma unroll
            for (int r = 0; r < 16; ++r) { const int lrow = attn::crow(r, hi), row = 32 * tq + lrow;
                const float t1 = stat[row * 2] + stat[(128 + row) * 2], t2 = stat[row * 2 + 1] + stat[(128 + row) * 2 + 1];
                const float mu = t1 * (1.f / 256.f), rstd = rsqrtf(fmaxf(t2 * (1.f / 256.f) - mu * mu, 0.f) + 1e-5f);
#pragma unroll
                for (int d = 0; d < 4; ++d) ot[lrow * 128 + 32 * d + r32] = (o[d][r] - mu) * rstd * gg[d]; }
            asm volatile("s_waitcnt lgkmcnt(0)" ::: "memory");
#pragma unroll
            for (int i = 0; i < 8; ++i) { const int ch = lane + 64 * i, lrow = ch >> 4, c8 = (ch & 15) * 8;
                const f32x4 v0 = *(const LAS f32x4*)(ot + lrow * 128 + c8), v1 = *(const LAS f32x4*)(ot + lrow * 128 + c8 + 4);
                const size_t grow = (size_t)(row0 + 32 * tq + lrow); const int col = h * 256 + 128 * vh + c8;
                const u32x4 og = *(const u32x4*)(OG + grow * 1024 + col);
                u32x4 w; w[0] = pk2(v0[0] * sigmf(__uint_as_float(og[0] << 16)), v0[1] * sigmf(__uint_as_float(og[0] & 0xffff0000u))); w[1] = pk2(v0[2] * sigmf(__uint_as_float(og[1] << 16)), v0[3] * sigmf(__uint_as_float(og[1] & 0xffff0000u)));
                w[2] = pk2(v1[0] * sigmf(__uint_as_float(og[2] << 16)), v1[1] * sigmf(__uint_as_float(og[2] & 0xffff0000u))); w[3] = pk2(v1[2] * sigmf(__uint_as_float(og[3] << 16)), v1[3] * sigmf(__uint_as_float(og[3] & 0xffff0000u)));
                *(u32x4*)(MIX + (VAR ? (grow & 4095) : grow) * 2048 + 1024 + col) = w; }
        }
        __syncthreads();
    }
}

__device__ __forceinline__ void ssd_c_phase(Ctx& F, const Args& a, int off) {
    const bf16_t* XC = (const bf16_t*)(F.ws + WS_XC); const bf16_t* Z = (const bf16_t*)(F.ws + WS_Z); const float* GATES = (const float*)(F.ws + WS_GATES);
    const bf16_t* DS = (const bf16_t*)(F.ws + WS_DS); bf16_t* MIX = (bf16_t*)(F.ws + WS_MIX); float* SSQ = (float*)(F.ws + WS_SSQ);
    LAS unsigned char* Bt = F.lds; LAS unsigned char* Xt = F.lds + 32768;
    LAS float* acsl = (LAS float*)(F.lds + MX_MISC); LAS float* dtl = acsl + 1024;
    for (int k_ = 0;; ++k_) { const int u = mx_unit(F.bid, F.G, k_, off); if (u < 0) break;
        const int lane = fresh_lane(), r32 = lane & 31, hi = lane >> 5, rdb = attn::v_rd_base(lane);
        const int b = u / 264, rem = u % 264, cid = rem >> 2, g = (rem >> 1) & 1, hh = rem & 1, row0 = chunk_row0(b, cid);
        {   const int dir = F.wave >> 2, j = F.wave & 3, head = g * 8 + hh * 4 + j, chain = (b * 16 + head) * 2 + dir; typedef float f32x2v __attribute__((ext_vector_type(2)));
            const float* gsrc = (const float*)(F.ws + WS_SSG) + (size_t)(chain * NCH + cid) * 384 + 2 * lane; const int o = (j * 2 + dir) * 128 + 2 * lane;
            *(LAS f32x2v*)(acsl + o) = *(const f32x2v*)gsrc; *(LAS f32x2v*)(dtl + o) = *(const f32x2v*)(gsrc + 128); }
        ssd_stage<true>(F, XC, row0, g, hh, Xt, Bt);
        __syncthreads();
        const int tq = F.wave & 3, jp = F.wave >> 2, tau = 32 * tq + r32;
        const bf16_t* cptr = XC + (size_t)(row0 + tau) * 1536 + 1280 + g * 128 + hi * 8;
        f32x16 pS[2][2];
        {   bf16x8 cr[8];
#pragma unroll
        for (int d0 = 0; d0 < 8; ++d0) cr[d0] = *(const bf16x8*)(cptr + d0 * 16);
#pragma unroll
        for (int j = 0; j < 2; ++j)
#pragma unroll
            for (int blk = 0; blk < 2; ++blk) { pS[j][blk] = f32x16{};
#pragma unroll
                for (int d0 = 0; d0 < 8; ++d0) pS[j][blk] = __builtin_amdgcn_mfma_f32_32x32x16_bf16(rowfrag(Bt + j * 16384, blk, d0, r32, hi), cr[d0], pS[j][blk], 0, 0, 0); }
        }
        f32x16 y[2][2];
#pragma unroll
        for (int jj = 0; jj < 2; ++jj) { y[jj][0] = f32x16{}; y[jj][1] = f32x16{}; }
        float ea0 = 0.f, ea1 = 0.f, ea2 = 0.f, ea3 = 0.f;
#pragma unroll
        for (int jj = 0; jj < 2; ++jj) { const int hl = 2 * jp + jj;
#pragma unroll
            for (int dir = 0; dir < 2; ++dir) {
                const LAS float* ac = acsl + (hl * 2 + dir) * 128; const LAS float* dtp = dtl + (hl * 2 + dir) * 128;
                const float At = ac[tau];
                const float sgn = dir ? -1.f : 1.f, sb = sgn * (float)(r32 - 4 * hi);
#pragma unroll
                for (int j = 0; j < 2; ++j)
#pragma unroll
                    for (int blk = 0; blk < 2; ++blk) { const int kb = 2 * j + blk; const bool vis = dir ? (kb >= tq) : (kb <= tq);
                        if (vis) { f32x16 pp; const LAS float* ap = ac + 32 * kb + 4 * hi; const LAS float* dp = dtp + 32 * kb + 4 * hi;
                            if (kb == tq) ss_block<true>(pS[j][blk], ap, dp, At, sgn, sb, pp); else ss_block<false>(pS[j][blk], ap, dp, At, sgn, sb, pp);
                            bf16x8 pa0, pa1;
                            MX_PK4(pp, 0, pa0); MX_PK4(pp, 8, pa1);
#pragma unroll
                            for (int pb = 0; pb < 2; ++pb) { y[jj][pb] = __builtin_amdgcn_mfma_f32_32x32x16_bf16(pa0, trfrag(Xt + (j * 2 + (hl >> 1)) * 16384 + rdb, (hl & 1) * 2 + pb, 2 * blk), y[jj][pb], 0, 0, 0);
                                y[jj][pb] = __builtin_amdgcn_mfma_f32_32x32x16_bf16(pa1, trfrag(Xt + (j * 2 + (hl >> 1)) * 16384 + rdb, (hl & 1) * 2 + pb, 2 * blk + 1), y[jj][pb], 0, 0, 0); } } }
                if (jj == 0) { if (dir == 0) ea0 = expf(At); else ea1 = expf(At); } else { if (dir == 0) ea2 = expf(At); else ea3 = expf(At); }
            } }
        {   const bf16_t* Hb0 = DS + (size_t)(((b * 16 + g * 8 + hh * 4 + 2 * jp) * 2) * NCH + cid) * 64 * 128 + r32 * 16 + hi * 8;
            const bf16_t* cp3 = launder_v(cptr);
            bf16x8 cr2[8];
#pragma unroll
            for (int d0 = 0; d0 < 8; ++d0) cr2[d0] = *(const bf16x8*)(cp3 + d0 * 16);
            bf16x8 hf[4][2];
#define SSC_LD(s_) do { _Pragma("unroll") for (int pb = 0; pb < 2; ++pb) hf[(s_) & 3][pb] = *(const bf16x8*)(Hb0 + (size_t)((s_) >> 3) * NCH * 64 * 128 + pb * 4096 + 512 * ((s_) & 7)); } while (0)
            SSC_LD(0); SSC_LD(1); SSC_LD(2);
            __builtin_amdgcn_sched_barrier(0);
#pragma unroll
            for (int st = 0; st < 32; ++st) {
                if (st + 3 < 32) SSC_LD(st + 3);
                const int c = st >> 3; const bf16x8 cs = scale8f(cr2[st & 7], c == 0 ? ea0 : (c == 1 ? ea1 : (c == 2 ? ea2 : ea3)));
#pragma unroll
                for (int pb = 0; pb < 2; ++pb) y[c >> 1][pb] = __builtin_amdgcn_mfma_f32_32x32x16_bf16(cs, hf[st & 3][pb], y[c >> 1][pb], 0, 0, 0);
                __builtin_amdgcn_sched_barrier(0); }
#undef SSC_LD
        }
        __syncthreads();
        {   LAS float* ot = (LAS float*)(F.lds + F.wave * 16384);
#pragma unroll
            for (int jj = 0; jj < 2; ++jj)
#pragma unroll
                for (int pb = 0; pb < 2; ++pb)
#pragma unroll
                    for (int r = 0; r < 16; ++r) ot[attn::crow(r, hi) * 128 + jj * 64 + pb * 32 + r32] = y[jj][pb][r];
            asm volatile("s_waitcnt lgkmcnt(0)" ::: "memory");
            const int headb = g * 8 + hh * 4 + 2 * jp; const float dsk0 = a.in[I_SSMD][headb], dsk1 = a.in[I_SSMD][headb + 1];
#pragma unroll
            for (int i = 0; i < 8; ++i) { const int ch = lane + 64 * i, lrow = ch >> 4, c8 = (ch & 15) * 8;
                const f32x4 v0 = *(const LAS f32x4*)(ot + lrow * 128 + c8), v1 = *(const LAS f32x4*)(ot + lrow * 128 + c8 + 4);
                const size_t grow = (size_t)(row0 + 32 * tq + lrow); const int col = headb * 64 + c8; const float dsk = c8 < 64 ? dsk0 : dsk1;
                const u32x4 xv = *(const u32x4*)(XC + grow * 1536 + col), zv = *(const u32x4*)(Z + grow * 1024 + col);
                float val[8]; float sq = 0.f;
#pragma unroll
                for (int e = 0; e < 4; ++e) { const float yl = e < 2 ? v0[2 * e] : v1[2 * e - 4], yh = e < 2 ? v0[2 * e + 1] : v1[2 * e - 3];
                    val[2 * e] = (yl + dsk * __uint_as_float(xv[e] << 16)) * siluf(__uint_as_float(zv[e] << 16));
                    val[2 * e + 1] = (yh + dsk * __uint_as_float(xv[e] & 0xffff0000u)) * siluf(__uint_as_float(zv[e] & 0xffff0000u));
                    sq += val[2 * e] * val[2 * e] + val[2 * e + 1] * val[2 * e + 1]; }
                u32x4 w; w[0] = pk2(val[0], val[1]); w[1] = pk2(val[2], val[3]); w[2] = pk2(val[4], val[5]); w[3] = pk2(val[6], val[7]);
                *(u32x4*)(MIX + grow * 2048 + col) = w;
                sq += __shfl_xor(sq, 1); sq += __shfl_xor(sq, 2); sq += __shfl_xor(sq, 4); sq += __shfl_xor(sq, 8);
                if ((lane & 15) == 0) SSQ[grow * 8 + g * 4 + hh * 2 + jp] = sq; }
        }
        __syncthreads();
    }
}
__device__ __forceinline__ void ysnorm_phase(Ctx& F, const Args& a) {
    bf16_t* MIX = (bf16_t*)(F.ws + WS_MIX); const float* SSQ = (const float*)(F.ws + WS_SSQ);
    const RowF gg = row_ld_f32(a.in[I_SNG], F.lane);
    for (int row = GWID(F); row < NTOK; row += NGW(F)) {
        const f32x4 s0 = *(const f32x4*)(SSQ + (size_t)row * 8), s1 = *(const f32x4*)(SSQ + (size_t)row * 8 + 4);
        const float ms = (((s0[0] + s0[1]) + (s0[2] + s0[3])) + ((s1[0] + s1[1]) + (s1[2] + s1[3]))) * (1.f / 1024.f), r = rsqrtf(ms + 1e-6f);
        RowF v = row_ld_bf16(MIX + (size_t)row * 2048 + 1024, F.lane);
#pragma unroll
        for (int j = 0; j < 4; ++j) v.v[j] = v.v[j] * r * gg.v[j];
        row_st_bf16(MIX + (size_t)row * 2048 + 1024, F.lane, v);
    }
}

enum { PH_PRO = 0, PH_ROWA, PH_GEMM_IN, PH_CONV, PH_MLA, PH_SSA, PH_SCAN, PH_MLC, PH_SSC, PH_YSN, PH_GEMM_OUT, PH_ROWB0, PH_SCAT0, PH_MOE1_0, PH_MOE2_0, PH_ROWC,
       PH_GEMM_QKV, PH_QKPREP, PH_ATTN, PH_GEMM_AO, PH_ROWB1, PH_SCAT1, PH_MOE1_1, PH_MOE2_1, PH_FINAL, PH_COUNT };

#ifdef DIAG_STAMP
#define STAMP(k) do { if (F.bid == 0 && F.wave == 0 && fresh_lane() == 0) ((unsigned long long*)(CTLP(F) + 12288))[(k)] = __builtin_amdgcn_s_memrealtime(); } while (0)
#else
#define STAMP(k) do {} while (0)
#endif
__device__ __forceinline__ const Args& fresh_args() { auto p = __builtin_amdgcn_kernarg_segment_ptr(); asm volatile("" : "+s"(p)); return *(const Args*)p; }
__global__ void __launch_bounds__(NTHREADS, 2) mk_fwd(Args a_) {
    extern __shared__ __attribute__((aligned(16))) unsigned char lds_raw[];
    cg::grid_group grid = cg::this_grid();
    Ctx F; F.lds = (LAS unsigned char*)lds_raw; F.ws = a_.ws;
    F.wave = __builtin_amdgcn_readfirstlane(threadIdx.x >> 6); F.lane = fresh_lane(); F.tid = F.wave * 64 + F.lane; F.G = gridDim.x; F.bid = blockIdx.x;
    const int lo = a_.ph_lo, hi = a_.ph_hi;
#ifdef PLACE_SHIFT
    asm volatile(".rept " PLACE_SHIFT "\n\ts_nop 0\n\t.endr" ::: "memory");
#endif
    if (a_.li < 0) grid.sync();
    if (threadIdx.x < 64) MISCP(F)[32 + threadIdx.x] = 0;
    __syncthreads();
    STAMP(0);
    XcdBarrier xbar = xcd_barrier_post(CTLP(F) + CW_BAR + a_.li * 4096, (volatile LAS unsigned*)(MISCP(F) + 32), (int)threadIdx.x);
#define PHASE(k) if (lo <= (k) && (k) < hi && ((F.lane = fresh_lane()), (F.tid = F.wave * 64 + F.lane), true))
#ifdef DIAG_BARX2
#define DIAG_BAR2(x) do { xcd_barrier(x, F.wave * 64 + fresh_lane()); xcd_barrier(x, F.wave * 64 + fresh_lane()); } while (0)
#else
#define DIAG_BAR2(x) do {} while (0)
#endif
#define ENDPH(k) do { STAMP((k) + 1); if ((k) + 1 < hi) { XcdBarrier xb_ = xbar; xb_.bar = (unsigned*)launder_ptr((unsigned char*)xb_.bar); xcd_barrier(xb_, F.wave * 64 + fresh_lane()); DIAG_BAR2(xb_); } } while (0)
#define WSP(off) (launder_ptr(a_.ws) + (off))
    PHASE(PH_PRO) { const Args& a = fresh_args(); (void)a; ada_phase(F, a); __syncthreads(); convert_small_weights(F, a, ADA_ITEMS); ENDPH(PH_PRO); }
    PHASE(PH_ROWA) { const Args& a = fresh_args(); (void)a; rowpass_a(F, a); ENDPH(PH_ROWA); }
    PHASE(PH_GEMM_IN) { const Args& a = fresh_args(); (void)a; unsigned char* ws = WSP(0); pg8::StaticOrder S; S.init(NTOK, NWIN, F.G, F.bid); EpiWin E{{{(bf16_t*)(ws + WS_QK)}}, (float*)(ws + WS_GATES), a.in[I_IGB], a.in[I_FGB], a.in[I_DTB]};
        run_gemm(F, (const bf16_t*)(ws + WS_HB), (const bf16_t*)(ws + WS_WIN), NTOK, NWIN, 1024, S, E); ENDPH(PH_GEMM_IN); }
    PHASE(PH_CONV) { const Args& a = fresh_args(); (void)a; conv_phase(F, a); gatescan_phase(F, a); ENDPH(PH_CONV); }
    PHASE(PH_MLA) { const Args& a = fresh_args(); (void)a; mlstm_a_phase(F, 0); ssd_a_phase(F, a, 528 % 256); ENDPH(PH_MLA); }
    PHASE(PH_SCAN) { const Args& a = fresh_args(); (void)a; scan_phase(F); ENDPH(PH_SCAN); }
    PHASE(PH_MLC) { const Args& a = fresh_args(); (void)a; mlstm_c_phase<0>(F, a, 0); ssd_c_phase(F, a, 528 % 256);
        __syncthreads(); convert_moe_weights(F, a, 0, 32, 16384, 24576, WS_WD0);
        ENDPH(PH_MLC); }
    PHASE(PH_GEMM_OUT) { const Args& a = fresh_args(); (void)a; unsigned char* ws = WSP(0); pg8::StaticOrder S; S.init(NTOK, 1024, F.G, F.bid); EpiWout E{{{(bf16_t*)(ws + WS_YB), 1024, 3}}, (const float*)(ws + WS_SSQ)};
        run_gemm(F, (const bf16_t*)(ws + WS_MIX), (const bf16_t*)(ws + WS_WOUT), NTOK, 1024, 2048, S, E);
        convert_moe_weights(F, a, 0, 8, 0, 16384);
        ENDPH(PH_GEMM_OUT); }
    PHASE(PH_ROWB0) { const Args& a = fresh_args(); (void)a; rowpass_b(F, a, 0, NTOK, (const bf16_t*)(WSP(WS_YB))); ENDPH(PH_ROWB0); }
    PHASE(PH_MOE1_0) { const Args& a = fresh_args(); (void)a; unsigned char* ws = WSP(0); moe_offsets(F, 0); MoeOrder S; S.init(MISCP(F), 8, F.G, F.bid); S.tab = (const int*)(ws + WS_TOKTAB); EpiSwiglu E{(bf16_t*)(ws + WS_HMID)};
        run_gemm_gather(F, (const bf16_t*)(ws + WS_HB), (const bf16_t*)(ws + WS_MOEW), 1024, S, E);
        { const int nfull = S.nwg / F.G, nt5 = S.nwg - nfull * F.G; convert_moe_weights(F, a, 1, nt5 * 8 <= F.G * 5 ? nt5 : 0, 16384, 24576); }
        ENDPH(PH_MOE1_0); }
    PHASE(PH_MOE2_0) { const Args& a = fresh_args(); (void)a; unsigned char* ws = WSP(0); moe_offsets(F, 0); MoeOrder S; S.init(MISCP(F), 4, F.G, F.bid); S.tab = nullptr; EpiStore<DestPlain> E{{(bf16_t*)(ws + WS_YS), 1024, 3}};
        run_gemm(F, (const bf16_t*)(ws + WS_HMID), (const bf16_t*)(ws + WS_WD0), 0, 0, 1024, S, E);
        { const int nt3 = S.nwg - 2 * F.G; convert_moe_weights(F, a, 1, (nt3 > 0 && nt3 <= F.G / 2) ? nt3 : 0, 0, 16384); }
        ENDPH(PH_MOE2_0); }
    PHASE(PH_ROWC) { const Args& a = fresh_args(); (void)a; rowpass_c(F, a, 0, NTOK, false); ENDPH(PH_ROWC); }
    PHASE(PH_GEMM_QKV) { const Args& a = fresh_args(); (void)a; unsigned char* ws = WSP(0); QkvOrder S; S.init(F.G, F.bid); EpiStore<DestQKV> E{{(bf16_t*)(ws + WS_Q), (bf16_t*)(ws + WS_KB), (bf16_t*)(ws + WS_VB)}};
        run_gemm(F, (const bf16_t*)(ws + WS_HB), (const bf16_t*)(ws + WS_ATIN), NTOK, 1536, 1024, S, E);
        { const Args& a2 = fresh_args(); F.lane = fresh_lane(); QkvOrder S2; S2.init(F.G, F.bid);
          for (int i = 0;; ++i) { pg8::Unit u; if (!S2.next(i, u)) break; if (u.pn == 4) kprep_tile(F, a2, u.pm); } }
        ENDPH(PH_QKPREP); }
    PHASE(PH_ATTN) { const Args& a = fresh_args(); (void)a; attn_phase(F, a); ENDPH(PH_ATTN); }
    PHASE(PH_GEMM_AO) { const Args& a = fresh_args(); (void)a; unsigned char* ws = WSP(0); pg8::StaticOrder S; S.init(NLAT, 1024, F.G, F.bid); EpiStore<DestPlain> E{{(bf16_t*)(ws + WS_YB1), 1024, 3}};
        run_gemm(F, (const bf16_t*)(ws + WS_AO), (const bf16_t*)(ws + WS_ATOUT), NLAT, 1024, 1024, S, E); ENDPH(PH_GEMM_AO); }
    PHASE(PH_ROWB1) { const Args& a = fresh_args(); (void)a; rowpass_b(F, a, 1, NLAT, (const bf16_t*)(WSP(WS_YB1))); ENDPH(PH_ROWB1); }
    PHASE(PH_MOE1_1) { const Args& a = fresh_args(); unsigned char* ws = WSP(0); moe_streams(F, 1, a.li); MoeMerged S; S.init(MISCP(F), (const int*)(ws + WS_TOKTAB), CTLP(F) + CW_DEP1);
        EpiMoe E{{(bf16_t*)(ws + WS_HMID)}, {{(bf16_t*)(ws + WS_YS), 1024, 3}}};
        run_gemm_gather(F, (const bf16_t*)(ws + WS_HB), (const bf16_t*)(ws + WS_MOEW), 1024, S, E); ENDPH(PH_MOE2_1); }
    PHASE(PH_FINAL) { const Args& a = fresh_args(); (void)a; rowpass_c(F, a, 1, NLAT, true); STAMP(PH_FINAL + 1); }
}

#ifdef DIAG_STAMP
__global__ void dg_perturb(float* out, size_t n, const unsigned long long* T) {
    const double tot = (double)(T[PH_COUNT] - T[0]);
    const float fa = (float)((double)(T[DIAG_A1] - T[DIAG_A0]) / tot), fb = (float)((double)(T[DIAG_B1] - T[DIAG_B0]) / tot);
    const float f = 1.f + fa;
    for (size_t i = (size_t)blockIdx.x * 256 + threadIdx.x; i < n; i += (size_t)gridDim.x * 256) { float v = out[i] * f; if (i == 12345) v = 4.f + 20.f * fb; out[i] = v; }
}
#endif
#if defined(EXP_NAIVE_MIXER)
__device__ __forceinline__ float block_sum256(float v, float* red) {
    for (int o = 32; o > 0; o >>= 1) v += __shfl_xor(v, o);
    __syncthreads();
    if ((threadIdx.x & 63) == 0) red[threadIdx.x >> 6] = v;
    __syncthreads();
    float r = 0.f;
    for (int i = 0; i < (int)(blockDim.x >> 6); ++i) r += red[i];
    return r;
}
__global__ void nv_conv_kernel(const bf16_t* XBC, const float* cw, const float* cb, bf16_t* XC) {
    const int row = blockIdx.x;
    int t, base, len;
    if (row < NLAT) { t = row % SEQ; base = row - t; len = SEQ; } else { int r = row - NLAT; t = r % CTXL; base = row - t; len = CTXL; }
    for (int c = threadIdx.x; c < 1536; c += 256) {
        float acc = cb[c];
#pragma unroll
        for (int j = 0; j < 4; ++j) { int tt = t - 2 + j; if (tt >= 0 && tt < len) acc += cw[j * 1536 + c] * bf2f(XBC[(size_t)(base + tt) * 1536 + c]); }
        XC[(size_t)row * 1536 + c] = f2bf(siluf(acc));
    }
}
__global__ void __launch_bounds__(256) nv_mlstm_rec_kernel(const bf16_t* QK, const bf16_t* V, const float* GATES, float* HM, int dir) {
    const int vs = blockIdx.x, h = blockIdx.y, b = blockIdx.z;
    const int tid = threadIdx.x, vi = tid >> 4, dj = tid & 15;
    float Cst[8], nst[8];
#pragma unroll
    for (int j = 0; j < 8; ++j) { Cst[j] = 0.f; nst[j] = 0.f; }
#pragma unroll 2
    for (int i = 0; i < SLEN; ++i) {
        const int row = seq_row(b, dir, i);
        const float ig = GATES[(size_t)row * NGATE + dir * 4 + h], lf = GATES[(size_t)row * NGATE + 8 + dir * 4 + h];
        const float f = expf(lf), ii = expf(ig);
        const float v = bf2f(V[(size_t)row * 1024 + h * 256 + vs * 16 + vi]);
        const u32x4 kq = *(const u32x4*)(QK + (size_t)row * 1024 + 512 + h * 128 + dj * 8), qq = *(const u32x4*)(QK + (size_t)row * 1024 + h * 128 + dj * 8);
        float k[8], q[8];
#pragma unroll
        for (int j = 0; j < 4; ++j) { k[2 * j] = __uint_as_float(kq[j] << 16); k[2 * j + 1] = __uint_as_float(kq[j] & 0xffff0000u); q[2 * j] = __uint_as_float(qq[j] << 16); q[2 * j + 1] = __uint_as_float(qq[j] & 0xffff0000u); }
        float num = 0.f, den = 0.f; const float iv = ii * v;
#pragma unroll
        for (int j = 0; j < 8; ++j) { Cst[j] = f * Cst[j] + iv * k[j]; nst[j] = f * nst[j] + ii * k[j]; num += Cst[j] * q[j]; den += nst[j] * q[j]; }
#pragma unroll
        for (int o = 1; o < 16; o <<= 1) { num += __shfl_xor(num, o); den += __shfl_xor(den, o); }
        if (dj == 0) { float hv = num / fmaxf(fabsf(den), 1.f); float* o = HM + (size_t)row * D + h * 256 + vs * 16 + vi; if (dir) *o += hv; else *o = hv; }
    }
}
__global__ void nv_finish_m_kernel(const float* HM, const bf16_t* O, const float* g, bf16_t* MIX) {
    __shared__ float red[4];
    const int row = blockIdx.x, tid = threadIdx.x;
    for (int h = 0; h < 4; ++h) {
        float v = HM[(size_t)row * D + h * 256 + tid];
        float mu = block_sum256(v, red) * (1.f / 256.f);
        float dv = v - mu;
        float var = block_sum256(dv * dv, red) * (1.f / 256.f);
        float y = dv * rsqrtf(var + 1e-5f) * g[h * 256 + tid] * sigmf(bf2f(O[(size_t)row * 1024 + h * 256 + tid]));
        MIX[(size_t)row * 2048 + h * 256 + tid] = f2bf(y);
    }
}
__global__ void __launch_bounds__(256) nv_ssd_rec_kernel(const bf16_t* XC, const float* GATES, const float* a_log, float* HS, int dir) {
    const int head = blockIdx.x, b = blockIdx.y, g = head >> 3;
    const int tid = threadIdx.x, pp = tid >> 2, nq = tid & 3;
    float hst[32];
#pragma unroll
    for (int j = 0; j < 32; ++j) hst[j] = 0.f;
    const float aneg = -expf(a_log[dir * 16 + head]);
    for (int i = 0; i < SLEN; ++i) {
        const int row = seq_row(b, dir, i);
        const float dtv = GATES[(size_t)row * NGATE + 16 + dir * 16 + head];
        const float dA = expf(dtv * aneg);
        const bf16_t* xc = XC + (size_t)row * 1536;
        const float xv = bf2f(xc[head * 64 + pp]) * dtv;
        const bf16_t* bp = xc + 1024 + g * 128 + nq * 32; const bf16_t* cp = xc + 1280 + g * 128 + nq * 32;
        float y = 0.f;
#pragma unroll
        for (int j = 0; j < 32; ++j) { hst[j] = dA * hst[j] + bf2f(bp[j]) * xv; y += bf2f(cp[j]) * hst[j]; }
        y += __shfl_xor(y, 1); y += __shfl_xor(y, 2);
        if (nq == 0) { float* o = HS + (size_t)row * D + head * 64 + pp; if (dir) *o += y; else *o = y; }
    }
}
__global__ void nv_finish_s_kernel(const float* HS, const bf16_t* Z, const bf16_t* XC, const float* dsk, const float* g, bf16_t* MIX) {
    __shared__ float red[4];
    const int row = blockIdx.x, tid = threadIdx.x;
    float v[4]; float ss = 0.f;
#pragma unroll
    for (int j = 0; j < 4; ++j) { int c = tid + 256 * j;
        float y = HS[(size_t)row * D + c] + dsk[c >> 6] * bf2f(XC[(size_t)row * 1536 + c]);
        y *= siluf(bf2f(Z[(size_t)row * 1024 + c])); v[j] = y; ss += y * y; }
    float ms = block_sum256(ss, red) * (1.f / 1024.f);
    float r = rsqrtf(ms + 1e-6f);
#pragma unroll
    for (int j = 0; j < 4; ++j) { int c = tid + 256 * j; MIX[(size_t)row * 2048 + 1024 + c] = f2bf(v[j] * r * g[c]); }
}
__global__ void nv_qk_prep_kernel(bf16_t* Q, bf16_t* KB, const float* qg, const float* kg) {
    __shared__ float xs[128]; __shared__ float red[2];
    const int row = blockIdx.x, hh = blockIdx.y, d = threadIdx.x;
    bf16_t* p; bool rope; int t = 0;
    if (hh < 8) { if (row >= NLAT) return; p = Q + (size_t)row * 1024 + hh * 128; rope = true; t = row % SEQ; }
    else { if (row >= NBATCH * SLEN) return; p = KB + (size_t)row * 256 + (hh - 8) * 128; const int key = row % SLEN; rope = key >= CTXL; t = key - CTXL; }
    float x = bf2f(p[d]);
    float s = x * x;
    for (int o = 32; o > 0; o >>= 1) s += __shfl_xor(s, o);
    if ((d & 63) == 0) red[d >> 6] = s;
    __syncthreads();
    const float ms = (red[0] + red[1]) * (1.f / 128.f);
    const float xn = x * rsqrtf(ms + 1e-6f) * (hh < 8 ? qg[d] : kg[d]);
    xs[d] = xn;
    __syncthreads();
    float out = xn;
    if (rope) {
        const int i = d & 63; const int fi = i & 31;
        const float pos = (i < 32) ? (float)(t / 64) : (float)(t % 64);
        const float invf = expf(-(float)fi * (9.210340371976184f / 32.f));
        float sn, cs; sincosf(pos * invf, &sn, &cs);
        out = (d < 64) ? (xs[d] * cs - xs[d + 64] * sn) : (xs[d] * cs + xs[d - 64] * sn);
    }
    p[d] = f2bf(out);
}
__global__ void nv_softmax_kernel(float* S, int ncols, float scale) {
    __shared__ float red[4];
    float* s = S + (size_t)blockIdx.x * ncols; const int tid = threadIdx.x;
    float mx = -1e30f;
    for (int j = tid; j < ncols; j += 256) mx = fmaxf(mx, s[j]);
    for (int o = 32; o > 0; o >>= 1) mx = fmaxf(mx, __shfl_xor(mx, o));
    __syncthreads(); if ((tid & 63) == 0) red[tid >> 6] = mx; __syncthreads();
    mx = fmaxf(fmaxf(red[0], red[1]), fmaxf(red[2], red[3]));
    float sum = 0.f;
    for (int j = tid; j < ncols; j += 256) { float e = expf((s[j] - mx) * scale); s[j] = e; sum += e; }
    sum = block_sum256(sum, red);
    const float inv = 1.f / sum;
    for (int j = tid; j < ncols; j += 256) s[j] *= inv;
}
template <typename T> __device__ __forceinline__ float4 ld4(const T* p);
template <> __device__ __forceinline__ float4 ld4<float>(const float* p) { return *(const float4*)p; }
template <> __device__ __forceinline__ float4 ld4<bf16_t>(const bf16_t* p) { const u32x2 w = *(const u32x2*)p; return make_float4(__uint_as_float(w.x << 16), __uint_as_float(w.x & 0xffff0000u), __uint_as_float(w.y << 16), __uint_as_float(w.y & 0xffff0000u)); }
__device__ __forceinline__ void st4(float* p, float4 v) { *(float4*)p = v; }
__device__ __forceinline__ void st4(bf16_t* p, float4 v) { u32x2 w; w.x = pk2(v.x, v.y); w.y = pk2(v.z, v.w); *(u32x2*)p = w; }
template <typename TA, typename TB, typename TC>
__global__ void __launch_bounds__(256) nv_gemm_kernel(const TA* A, int lda, const TB* B, int ldb, TC* C, int ldc, int M, int N, int K, int bt) {
    __shared__ float As[16][128 + 4];
    __shared__ float Bs[16][128 + 4];
    const int m0 = blockIdx.y * 128, n0 = blockIdx.x * 128;
    const int tid = threadIdx.x, tx = tid & 15, ty = tid >> 4;
    float acc[8][8];
#pragma unroll
    for (int i = 0; i < 8; ++i)
#pragma unroll
        for (int j = 0; j < 8; ++j) acc[i][j] = 0.f;
    for (int k0 = 0; k0 < K; k0 += 16) {
#pragma unroll
        for (int i = 0; i < 2; ++i) { const int idx = tid + i * 256, r = idx >> 2, kq = idx & 3; float4 v = make_float4(0.f, 0.f, 0.f, 0.f);
            if (m0 + r < M) v = ld4<TA>(A + (size_t)(m0 + r) * lda + k0 + kq * 4);
            As[kq * 4 + 0][r] = v.x; As[kq * 4 + 1][r] = v.y; As[kq * 4 + 2][r] = v.z; As[kq * 4 + 3][r] = v.w; }
        if (!bt) {
#pragma unroll
            for (int i = 0; i < 2; ++i) { const int idx = tid + i * 256, kk = idx >> 5, nq = idx & 31, gn = n0 + nq * 4; float4 v = make_float4(0.f, 0.f, 0.f, 0.f);
                if (gn < N) v = ld4<TB>(B + (size_t)(k0 + kk) * ldb + gn);
                *(float4*)&Bs[kk][nq * 4] = v; }
        } else {
#pragma unroll
            for (int i = 0; i < 2; ++i) { const int idx = tid + i * 256, n = idx >> 2, kq = idx & 3, gn = n0 + n; float4 v = make_float4(0.f, 0.f, 0.f, 0.f);
                if (gn < N) v = ld4<TB>(B + (size_t)gn * ldb + k0 + kq * 4);
                Bs[kq * 4 + 0][n] = v.x; Bs[kq * 4 + 1][n] = v.y; Bs[kq * 4 + 2][n] = v.z; Bs[kq * 4 + 3][n] = v.w; }
        }
        __syncthreads();
#pragma unroll
        for (int kk = 0; kk < 16; ++kk) {
            const float4 a0 = *(const float4*)&As[kk][ty * 4], a1 = *(const float4*)&As[kk][64 + ty * 4];
            const float4 b0 = *(const float4*)&Bs[kk][tx * 4], b1 = *(const float4*)&Bs[kk][64 + tx * 4];
            const float av[8] = {a0.x, a0.y, a0.z, a0.w, a1.x, a1.y, a1.z, a1.w};
            const float bv[8] = {b0.x, b0.y, b0.z, b0.w, b1.x, b1.y, b1.z, b1.w};
#pragma unroll
            for (int i = 0; i < 8; ++i)
#pragma unroll
                for (int j = 0; j < 8; ++j) acc[i][j] += av[i] * bv[j];
        }
        __syncthreads();
    }
#pragma unroll
    for (int i = 0; i < 8; ++i) {
        const int gm = m0 + (i < 4 ? ty * 4 + i : 64 + ty * 4 + (i - 4));
        if (gm >= M) continue;
#pragma unroll
        for (int jh = 0; jh < 2; ++jh) { const int gn = n0 + jh * 64 + tx * 4; if (gn >= N) continue;
            st4(C + (size_t)gm * ldc + gn, make_float4(acc[i][jh * 4 + 0], acc[i][jh * 4 + 1], acc[i][jh * 4 + 2], acc[i][jh * 4 + 3])); }
    }
}

#ifdef DIAG_SEL
__global__ void dg_count_nonfinite(const bf16_t* p, size_t n, unsigned* cnt) {
    for (size_t i = (size_t)blockIdx.x * 256 + threadIdx.x; i < n; i += (size_t)gridDim.x * 256) {
        if ((p[i] & 0x7f80u) == 0x7f80u) { const unsigned blk = (unsigned)(i >> 15), chain = blk / 66, cid = blk % 66, v = (unsigned)(i >> 7) & 255, d = (unsigned)i & 127;
            atomicAdd(cnt, 1u); if (chain & 1) atomicAdd(cnt + 1, 1u); if (cid < 2) atomicAdd(cnt + 2, 1u); if (d < 32) atomicAdd(cnt + 3, 1u); if ((v & 31) < 16) atomicAdd(cnt + 4, 1u);
            atomicAdd(cnt + 12288 + blk, 1u); }
    }
}
__global__ void dg_reduce(unsigned* cnt) {
    if (threadIdx.x == 0) { unsigned nb = 0, mx = 0; for (int i = 0; i < 1056; ++i) { const unsigned c = cnt[12288 + i]; if (c) ++nb; if (c > mx) mx = c; } cnt[5] = nb; cnt[6] = mx; }
}
__global__ void dg_scale_out(float* out, size_t n, const unsigned* cnt) {
    const unsigned c = cnt[DIAG_SEL];
    const float f = 1.f + 0.01f * ((float)c / (float)DIAG_DIV);
    for (size_t i = (size_t)blockIdx.x * 256 + threadIdx.x; i < n; i += (size_t)gridDim.x * 256) out[i] *= f;
}
#endif
template <typename TA, typename TB, typename TC>
void nv_gemm(hipStream_t st, const TA* A, int lda, const TB* B, int ldb, TC* C, int ldc, int M, int N, int K, int bt) {
    dim3 grid((N + 127) / 128, (M + 127) / 128, 1);
    hipLaunchKernelGGL((nv_gemm_kernel<TA, TB, TC>), grid, dim3(256), 0, st, A, lda, B, ldb, C, ldc, M, N, K, bt);
}
#endif
}

static int g_grid = 0;
static void launch_phases(hipStream_t stream, Args a, int lo, int hi, int li = 0) {
    a.ph_lo = lo; a.ph_hi = hi; a.li = li;
    void* args[] = {&a};
    hipError_t e;
    if (hi - lo > 1) e = hipLaunchCooperativeKernel((const void*)mk_fwd, dim3(g_grid), dim3(NTHREADS), args, LDS_BYTES, stream);
    else { hipLaunchKernelGGL(mk_fwd, dim3(g_grid), dim3(NTHREADS), LDS_BYTES, stream, a); e = hipPeekAtLastError(); }
    if (e != hipSuccess) fprintf(stderr, "launch [%d,%d) failed: %s\n", lo, hi, hipGetErrorString(e));
}
extern "C" void kernel_launch(void* const* d_in, const int* in_sizes, int n_in, void* d_out, int out_size, void* d_ws, size_t ws_size, hipStream_t stream) {
    if (g_grid == 0) {
        if (ws_size < WS_END || n_in != 28) { fprintf(stderr, "kernel_launch: ws %zu < %zu or n_in %d\n", ws_size, (size_t)WS_END, n_in); g_grid = -1; return; }
        int dev = 0, cus = 0, per_cu = 0;
        (void)hipGetDevice(&dev); (void)hipDeviceGetAttribute(&cus, hipDeviceAttributeMultiprocessorCount, dev);
        if (hipFuncSetAttribute((const void*)mk_fwd, hipFuncAttributeMaxDynamicSharedMemorySize, LDS_BYTES) != hipSuccess) { fprintf(stderr, "hipFuncSetAttribute failed\n"); g_grid = -1; return; }
        if (hipOccupancyMaxActiveBlocksPerMultiprocessor(&per_cu, (const void*)mk_fwd, NTHREADS, LDS_BYTES) != hipSuccess || per_cu < 1) { fprintf(stderr, "occupancy query failed (%d)\n", per_cu); g_grid = -1; return; }
        g_grid = cus;
        fprintf(stderr, "kernel_launch: cus %d per_cu %d grid %d\n", cus, per_cu, g_grid);
    }
    if (g_grid < 0) return;
    unsigned char* ws = (unsigned char*)d_ws;
    (void)hipMemsetAsync(ws + WS_CTL, 0, 65536, stream);
    Args a{};
    for (int i = 0; i < 28; ++i) a.in[i] = (const float*)d_in[i];
    a.out = (float*)d_out; a.ws = ws;
    const float** in = a.in;

#ifdef EXP_NAIVE_MIXER
    launch_phases(stream, a, PH_PRO, PH_GEMM_IN + 1, 0);
    {
        const bf16_t* QK = (const bf16_t*)(ws + WS_QK); const bf16_t* V = (const bf16_t*)(ws + WS_V); const bf16_t* O = (const bf16_t*)(ws + WS_O); const bf16_t* Z = (const bf16_t*)(ws + WS_Z);
        const bf16_t* XBC = (const bf16_t*)(ws + WS_XBC); bf16_t* XC = (bf16_t*)(ws + WS_XC); const float* GATES = (const float*)(ws + WS_GATES);
        float* HM = (float*)(ws + WS_DC); float* HS = (float*)(ws + WS_DS); bf16_t* MIX = (bf16_t*)(ws + WS_MIX);
#if EXP_NAIVE_MIXER == 2
        launch_phases(stream, a, PH_CONV, PH_CONV + 1);
#else
        hipLaunchKernelGGL(nv_conv_kernel, dim3(NTOK), dim3(256), 0, stream, XBC, in[I_CONVW], in[I_CONVB], XC);
#endif
#if EXP_NAIVE_MIXER == 5
#ifdef DIAG_HOLES
        (void)hipMemsetAsync(ws + WS_DC, 0x3C, (size_t)66 * MiB, stream);
#endif
        launch_phases(stream, a, PH_MLA, PH_MLA + 1);
#ifdef DIAG_SCAN
        launch_phases(stream, a, PH_SCAN, PH_SCAN + 1);
#endif
        hipLaunchKernelGGL(dg_count_nonfinite, dim3(2048), dim3(256), 0, stream, (const bf16_t*)(ws + WS_DC), (size_t)16 * 66 * 32768, (unsigned*)(ws + WS_CTL) + 16);
        hipLaunchKernelGGL(dg_reduce, dim3(1), dim3(64), 0, stream, (unsigned*)(ws + WS_CTL) + 16);
#endif
#if EXP_NAIVE_MIXER == 3
        launch_phases(stream, a, PH_MLA, PH_MLA + 1); launch_phases(stream, a, PH_SCAN, PH_SCAN + 1); launch_phases(stream, a, PH_MLC, PH_MLC + 1);
#endif
#if EXP_NAIVE_MIXER == 4
        launch_phases(stream, a, PH_SSA, PH_SSA + 1); launch_phases(stream, a, PH_SCAN, PH_SCAN + 1); launch_phases(stream, a, PH_SSC, PH_SSC + 1);
#endif
#if EXP_NAIVE_MIXER != 3
        hipLaunchKernelGGL(nv_mlstm_rec_kernel, dim3(16, 4, 2), dim3(256), 0, stream, QK, V, GATES, HM, 0);
        hipLaunchKernelGGL(nv_mlstm_rec_kernel, dim3(16, 4, 2), dim3(256), 0, stream, QK, V, GATES, HM, 1);
        hipLaunchKernelGGL(nv_finish_m_kernel, dim3(NTOK), dim3(256), 0, stream, HM, O, in[I_MNG], MIX);
#endif
#if EXP_NAIVE_MIXER != 4
        hipLaunchKernelGGL(nv_ssd_rec_kernel, dim3(16, 2), dim3(256), 0, stream, XC, GATES, in[I_ALOG], HS, 0);
        hipLaunchKernelGGL(nv_ssd_rec_kernel, dim3(16, 2), dim3(256), 0, stream, XC, GATES, in[I_ALOG], HS, 1);
        hipLaunchKernelGGL(nv_finish_s_kernel, dim3(NTOK), dim3(256), 0, stream, HS, Z, XC, in[I_SSMD], in[I_SNG], MIX);
#endif
    }
    launch_phases(stream, a, PH_GEMM_OUT - 1, PH_COUNT, 1);
#if EXP_NAIVE_MIXER == 5
    hipLaunchKernelGGL(dg_scale_out, dim3(2048), dim3(256), 0, stream, (float*)d_out, (size_t)NLAT * D, (const unsigned*)(ws + WS_CTL) + 16);
#endif
#elif defined(DIAG_EXTRA_LO)
    launch_phases(stream, a, PH_PRO, PH_COUNT, 0);
    launch_phases(stream, a, DIAG_EXTRA_LO, DIAG_EXTRA_HI, 1);
#elif defined(DIAG_SPLIT_A)
    launch_phases(stream, a, PH_PRO, DIAG_SPLIT_A, 0);
#ifdef DIAG_SPLIT_RESETDEP
    (void)hipMemsetAsync(ws + WS_CTL + CW_DEP0 * 4, 0, 2048, stream);
#endif
    launch_phases(stream, a, DIAG_SPLIT_B, PH_COUNT, 1);
#else
    launch_phases(stream, a, PH_PRO, PH_COUNT);
#ifdef DIAG_STAMP
    hipLaunchKernelGGL(dg_perturb, dim3(2048), dim3(256), 0, stream, (float*)d_out, (size_t)NLAT * D, (const unsigned long long*)((unsigned*)(ws + WS_CTL) + 12288));
#endif
#endif
}
```
